# Optimizing an MI355X kernel written in HIP

```python
import jax
import jax.numpy as jnp
from jax import lax
import numpy as np

D_MODEL = 1024
BATCH = 8
SEQ = 4096
DEPTH = 1

MIX_WIDTH = D_MODEL
GLA_WIDTH = MIX_WIDTH // 2
POOL_WIDTH = MIX_WIDTH - GLA_WIDTH
GLA_HEADS = 4
GLA_DV = GLA_WIDTH // GLA_HEADS
GLA_DK = GLA_DV // 2
GLA_KEY_WIDTH = GLA_HEADS * GLA_DK
GLA_GATE_RANK = 16
GLA_TAU = 16.0
GLA_CHUNK = 64
POOL_WINDOWS = (2, 4, 8, 16)
POOL_GROUPS = len(POOL_WINDOWS)
POOL_GROUP_WIDTH = POOL_WIDTH // POOL_GROUPS
PEER_HEADS = 8
PEER_NKEYS = 128
PEER_EXPERTS = PEER_NKEYS * PEER_NKEYS
PEER_QDIM = 256
PEER_HALF = PEER_QDIM // 2
PEER_TOPK = 16
PEER_TOKEN_BLOCK = 128
N_MOD = 6
EPS = 1e-6

IN_SIZES = (GLA_KEY_WIDTH, GLA_KEY_WIDTH, GLA_WIDTH, GLA_WIDTH, GLA_GATE_RANK, GLA_GATE_RANK, POOL_WIDTH)
IN_COLS = sum(IN_SIZES)
IN_SPLITS = tuple(int(s) for s in np.cumsum(IN_SIZES)[:-1])

kernel_name = "hybrid_gla_pool_peer_encoder_layer"


def rmsnorm(x, g):
    xf = x.astype(jnp.float32)
    y = xf * lax.rsqrt(jnp.mean(xf * xf, axis=-1, keepdims=True) + EPS)
    return (y * g.astype(jnp.float32)).astype(x.dtype)


def gla_chunked(q, k, v, log_a, strict):
    B, H, S, dk = q.shape
    dv = v.shape[-1]
    C = GLA_CHUNK
    n = S // C
    qc = q.reshape(B, H, n, C, dk).astype(jnp.float32)
    kc = k.reshape(B, H, n, C, dk).astype(jnp.float32)
    vc = v.reshape(B, H, n, C, dv).astype(jnp.float32)
    b = jnp.cumsum(log_a.reshape(B, H, n, C, dk), axis=3)
    b_last = b[:, :, :, -1:, :]
    q_dec = qc * jnp.exp(b)
    k_inv = kc * jnp.exp(-b)
    k_end = kc * jnp.exp(b_last - b)
    scores = jnp.einsum('bhnid,bhnjd->bhnij', q_dec, k_inv)
    mask = jnp.tril(jnp.ones((C, C), dtype=bool), k=-1 if strict else 0)
    scores = jnp.where(mask, scores, 0.0)
    o_intra = jnp.einsum('bhnij,bhnjv->bhniv', scores, vc)
    u = jnp.einsum('bhnjd,bhnjv->bhndv', k_end, vc)
    gamma = jnp.exp(b_last[:, :, :, 0, :])

    def step(state, inp):
        g_n, u_n = inp
        return g_n[..., None] * state + u_n, state

    init = jnp.zeros((B, H, dk, dv), jnp.float32)
    _, s_prev = lax.scan(step, init, (jnp.moveaxis(gamma, 2, 0), jnp.moveaxis(u, 2, 0)))
    s_prev = jnp.moveaxis(s_prev, 0, 2)
    o_inter = jnp.einsum('bhnid,bhndv->bhniv', q_dec, s_prev)
    return (o_intra + o_inter).reshape(B, H, S, dv)


def gla_group(q, k, v, r, af, ab, w_af, b_af, w_ab, b_ab, g_head):
    B, S, _ = q.shape

    def heads(t, d):
        return t.reshape(B, S, GLA_HEADS, d).transpose(0, 2, 1, 3)

    qh = heads(q, GLA_DK) * (GLA_DK ** -0.5)
    kh = heads(k, GLA_DK)
    vh = heads(v, GLA_DV)
    log_af = jax.nn.log_sigmoid((af @ w_af + b_af).astype(jnp.float32)) / GLA_TAU
    log_ab = jax.nn.log_sigmoid((ab @ w_ab + b_ab).astype(jnp.float32)) / GLA_TAU
    o_f = gla_chunked(qh, kh, vh, heads(log_af, GLA_DK), strict=False)
    o_b = jnp.flip(gla_chunked(jnp.flip(qh, 2), jnp.flip(kh, 2), jnp.flip(vh, 2),
                               jnp.flip(heads(log_ab, GLA_DK), 2), strict=True), 2)
    o = jnp.transpose(o_f + o_b, (0, 2, 1, 3)).astype(q.dtype)
    o = rmsnorm(o, g_head.reshape(GLA_HEADS, GLA_DV)).reshape(B, S, GLA_WIDTH)
    return o * jax.nn.silu(r)


def pool_group(p, w_pool, pool_scale):
    B, S, W = p.shape
    pf = p.astype(jnp.float32)
    cs = jnp.concatenate([jnp.zeros((B, 1, W), jnp.float32), jnp.cumsum(pf, axis=1)], axis=1)
    pos = jnp.arange(S)
    outs = []
    for gi, w in enumerate(POOL_WINDOWS):
        sl = slice(gi * POOL_GROUP_WIDTH, (gi + 1) * POOL_GROUP_WIDTH)
        lo = jnp.clip(pos - w // 2, 0, S)
        hi = jnp.clip(pos + w // 2, 0, S)
        seg = cs[:, :, sl]
        total = seg[:, hi] - seg[:, lo]
        count = (hi - lo).astype(jnp.float32)[None, :, None]
        outs.append(total / count - pf[:, :, sl])
    pooled = jnp.stack(outs, axis=2).astype(p.dtype)
    y = jnp.einsum('bsgc,gcd->bsgd', pooled, w_pool)
    return y.reshape(B, S, POOL_WIDTH) * pool_scale


def peer_ffn(h, w_q, sub_keys, u_tab, v_tab):
    B, S, D = h.shape
    T = B * S
    K = PEER_TOPK
    ht = h.reshape(T, D)
    q = (ht @ w_q).reshape(T, PEER_HEADS, 2, PEER_HALF)
    s = jnp.einsum('thpd,hpnd->thpn', q, sub_keys).astype(jnp.float32)
    vals, idx = lax.top_k(s, K)
    cand = vals[:, :, 0, :, None] + vals[:, :, 1, None, :]
    top_s, top_pos = lax.top_k(cand.reshape(T, PEER_HEADS, K * K), K)
    i1 = jnp.take_along_axis(idx[:, :, 0], top_pos // K, axis=-1)
    i2 = jnp.take_along_axis(idx[:, :, 1], top_pos % K, axis=-1)
    experts = (i1 * PEER_NKEYS + i2).reshape(T, PEER_HEADS * K)
    gates = jax.nn.softmax(top_s, axis=-1).reshape(T, PEER_HEADS * K)
    nb = T // PEER_TOKEN_BLOCK

    def block(args):
        xb, eb, gb = args
        a = jax.nn.gelu(jnp.einsum('td,ted->te', xb, u_tab[eb]), approximate=False)
        coeff = (gb * a.astype(jnp.float32)).astype(xb.dtype)
        return jnp.einsum('te,ted->td', coeff, v_tab[eb])

    y = lax.map(block, (ht.reshape(nb, PEER_TOKEN_BLOCK, D),
                        experts.reshape(nb, PEER_TOKEN_BLOCK, PEER_HEADS * K),
                        gates.reshape(nb, PEER_TOKEN_BLOCK, PEER_HEADS * K)))
    return y.reshape(B, S, D)


def setup_inputs(seed: int = 0) -> dict:
    key = jax.random.key(seed)
    ks = jax.random.split(key, 24)
    L, D = DEPTH, D_MODEL
    f32 = jnp.float32

    def nrm(k, shape, scale):
        return jax.random.normal(k, shape, f32) * scale

    def gain(k, shape):
        return 1.0 + 0.01 * jax.random.normal(k, shape, f32)

    return {
        "x": jax.random.normal(ks[0], (BATCH, SEQ, D), f32),
        "c": jax.random.normal(ks[1], (BATCH, D), f32),
        "w_mod": nrm(ks[2], (L, D, N_MOD * D), 0.5 * D ** -0.5),
        "b_mod": nrm(ks[3], (L, N_MOD * D), 0.01),
        "g_pre_mix": gain(ks[4], (L, D)),
        "g_post_mix": gain(ks[5], (L, D)),
        "w_in": nrm(ks[6], (L, D, IN_COLS), D ** -0.5),
        "w_alpha_f": nrm(ks[7], (L, GLA_GATE_RANK, GLA_KEY_WIDTH), GLA_GATE_RANK ** -0.5),
        "b_alpha_f": nrm(ks[8], (L, GLA_KEY_WIDTH), 0.01),
        "w_alpha_b": nrm(ks[9], (L, GLA_GATE_RANK, GLA_KEY_WIDTH), GLA_GATE_RANK ** -0.5),
        "b_alpha_b": nrm(ks[10], (L, GLA_KEY_WIDTH), 0.01),
        "g_gla_head": gain(ks[11], (L, GLA_WIDTH)),
        "w_pool": nrm(ks[12], (L, POOL_GROUPS, POOL_GROUP_WIDTH, POOL_GROUP_WIDTH), POOL_GROUP_WIDTH ** -0.5),
        "pool_scale": gain(ks[13], (L, POOL_WIDTH)),
        "w_out": nrm(ks[14], (L, MIX_WIDTH, D), MIX_WIDTH ** -0.5),
        "g_pre_ffn": gain(ks[15], (L, D)),
        "g_post_ffn": gain(ks[16], (L, D)),
        "w_peer_q": nrm(ks[17], (L, D, PEER_HEADS * PEER_QDIM), D ** -0.5),
        "peer_sub_keys": nrm(ks[18], (L, PEER_HEADS, 2, PEER_NKEYS, PEER_HALF), PEER_HALF ** -0.5),
        "peer_u": nrm(ks[19], (L, PEER_EXPERTS, D), D ** -0.5),
        "peer_v": nrm(ks[20], (L, PEER_EXPERTS, D), PEER_HEADS ** -0.5),
    }


def reference(x, c, w_mod, b_mod, g_pre_mix, g_post_mix, w_in, w_alpha_f, b_alpha_f, w_alpha_b, b_alpha_b,
              g_gla_head, w_pool, pool_scale, w_out, g_pre_ffn, g_post_ffn, w_peer_q, peer_sub_keys,
              peer_u, peer_v):
    cond = jax.nn.silu(c)
    for l in range(DEPTH):
        mod = cond @ w_mod[l] + b_mod[l]
        sh1, sc1, gt1, sh2, sc2, gt2 = [m[:, None, :] for m in jnp.split(mod, N_MOD, axis=-1)]

        h = rmsnorm(x, g_pre_mix[l]) * (1 + sc1) + sh1
        z = h @ w_in[l]
        q, k, v, r, af, ab, p = jnp.split(z, IN_SPLITS, axis=-1)
        o_gla = gla_group(q, k, v, r, af, ab, w_alpha_f[l], b_alpha_f[l], w_alpha_b[l], b_alpha_b[l],
                          g_gla_head[l])
        o_pool = pool_group(p, w_pool[l], pool_scale[l])
        mix = jnp.concatenate([o_gla.astype(x.dtype), o_pool.astype(x.dtype)], axis=-1) @ w_out[l]
        x = x + gt1 * rmsnorm(mix, g_post_mix[l])

        h2 = rmsnorm(x, g_pre_ffn[l]) * (1 + sc2) + sh2
        y = peer_ffn(h2, w_peer_q[l], peer_sub_keys[l], peer_u[l], peer_v[l])
        x = x + gt2 * rmsnorm(y, g_post_ffn[l])
    return x
```

```cpp
#include <hip/hip_runtime.h>
#include <cstdio>
#include <cstdint>

#define DI __device__ __forceinline__
#define LAS __attribute__((address_space(3)))
typedef unsigned short bf16_t;
typedef short bf16x8 __attribute__((ext_vector_type(8)));
typedef float f32x4 __attribute__((ext_vector_type(4)));
typedef float f32x2 __attribute__((ext_vector_type(2)));
typedef float f32x16 __attribute__((ext_vector_type(16)));
typedef unsigned u32x4 __attribute__((ext_vector_type(4)));
typedef unsigned u32x2 __attribute__((ext_vector_type(2)));
typedef __bf16 bf16x2v __attribute__((ext_vector_type(2)));

constexpr int T = 32768, D = 1024, SEQ = 4096, NB = 8;
constexpr int NTH = 512, NWV = 8;
constexpr int ZW = 2048;
constexpr int NIN = 2176;
constexpr float EPS = 1e-6f;

constexpr size_t MB = 1024 * 1024;
constexpr size_t WS_CTL   = 0;
constexpr size_t WS_MODP  = 64 * 1024;
constexpr size_t WS_WIN   = WS_MODP + 8 * 8 * 6144 * 4;
constexpr size_t WS_WOUT  = WS_WIN + (size_t)NIN * 1024 * 2;
constexpr size_t WS_WQ    = WS_WOUT + 1024 * 1024 * 2;
constexpr size_t WS_SKB   = WS_WQ + 2048 * 1024 * 2;
constexpr size_t WS_WP    = WS_SKB + 16 * 128 * 128 * 2;
constexpr size_t WS_AFB   = WS_WP + 4 * 128 * 128 * 2;
constexpr size_t WS_UB    = WS_AFB + (size_t)T * 32 * 4;
constexpr size_t WS_VB    = WS_UB + 32 * MB;
constexpr size_t WS_RA    = WS_VB + 32 * MB;
constexpr size_t WS_RZ    = WS_RA + 64 * MB;
constexpr size_t WS_RS    = WS_RZ + 128 * MB;
constexpr size_t WS_RO    = WS_RS + 6 * 16 * MB + 1 * MB;
constexpr size_t WS_END   = WS_RO + 128 * MB;
static_assert(WS_END <= 512 * MB, "workspace too large");

struct Params { const float* in[21]; float* out; unsigned char* ws; };

DI unsigned pk2(float a, float b) { f32x2 f = {a, b}; bf16x2v h = __builtin_convertvector(f, bf16x2v); return __builtin_bit_cast(unsigned, h); }
DI float dot2bf(unsigned a, unsigned b, float c) { return __builtin_amdgcn_fdot2_f32_bf16(__builtin_bit_cast(bf16x2v, a), __builtin_bit_cast(bf16x2v, b), c, false); }
DI float bflo(unsigned u) { return __uint_as_float(u << 16); }
DI float bfhi(unsigned u) { return __uint_as_float(u & 0xFFFF0000u); }
DI float wave_sum(float v) {
#pragma unroll
    for (int o = 1; o < 64; o <<= 1) v += __shfl_xor(v, o);
    return v;
}
DI bf16x8 ld_frag16(const bf16_t* p) { return __builtin_bit_cast(bf16x8, *(const u32x4*)p); }
DI bf16x8 ld_frag_perm(const bf16_t* p, int g) {
    const u32x2 lo = *(const u32x2*)(p + 4 * g), hi = *(const u32x2*)(p + 16 + 4 * g);
    u32x4 v = {lo.x, lo.y, hi.x, hi.y}; return __builtin_bit_cast(bf16x8, v);
}
DI bf16x8 pack8(const f32x4& a, const f32x4& b) { u32x4 v = {pk2(a[0], a[1]), pk2(a[2], a[3]), pk2(b[0], b[1]), pk2(b[2], b[3])}; return __builtin_bit_cast(bf16x8, v); }
#define MFMA16(a, b, c) __builtin_amdgcn_mfma_f32_16x16x32_bf16((a), (b), (c), 0, 0, 0)
#define MFMA32(a, b, c) __builtin_amdgcn_mfma_f32_32x32x16_bf16((a), (b), (c), 0, 0, 0)

#define XB_TMO      128
#define XB_XCNT(j)  (256  + 64 * (j))
#define XB_XSUB(j)  (1280 + 64 * (j))
#define XB_XGEN(j)  (2304 + 64 * (j))
#define XB_TOP      3328
#define XB_TOPGEN   3392
#define XCD_BAR_WORDS 3456
#define XB_SPIN_CAP (1u << 22)
DI unsigned xb_ld(unsigned* p)              { return __hip_atomic_load(p, __ATOMIC_RELAXED, __HIP_MEMORY_SCOPE_AGENT); }
DI unsigned xb_add(unsigned* p, unsigned v) { return __hip_atomic_fetch_add(p, v, __ATOMIC_RELAXED, __HIP_MEMORY_SCOPE_AGENT); }
DI unsigned xb_xcc_id() { return (unsigned)__builtin_amdgcn_s_getreg((3 << 11) | 20) & 0xFu; }
#define XB_SPIN(cond, bar) do { unsigned _sp = 0; while (cond) { __builtin_amdgcn_s_sleep(1); \
    if ((++_sp & 255u) == 0u) { if (xb_ld(&(bar)[XB_TMO])) break; if (_sp > XB_SPIN_CAP) { atomicAdd(&(bar)[XB_TMO], 1u); break; } } } } while (0)
struct XcdBarrier { unsigned* bar; unsigned x; volatile LAS unsigned* st; };
DI XcdBarrier xcd_barrier_post(unsigned* bar, volatile LAS unsigned* st) {
    XcdBarrier b; b.bar = bar; b.x = xb_xcc_id(); b.st = st;
    if (threadIdx.x == 0) (void)xb_add(&bar[XB_XCNT(b.x)], 1u);
    return b;
}
DI void xcd_barrier_complete(unsigned* bar, unsigned x, unsigned& nloc, unsigned& nx) {
    const unsigned G = gridDim.x * gridDim.y * gridDim.z;
    unsigned sum, cnt, mine, sp = 0u;
    for (;;) {
        sum = 0u; cnt = 0u; mine = 0u;
#pragma unroll
        for (unsigned j = 0; j < 16; ++j) { const unsigned c = xb_ld(&bar[XB_XCNT(j)]); sum += c; cnt += (c > 0u) ? 1u : 0u; mine = (j == x) ? c : mine; }
        if (sum == G) break;
        __builtin_amdgcn_s_sleep(1);
        if ((++sp & 255u) == 0u) { if (xb_ld(&bar[XB_TMO])) break; if (sp > XB_SPIN_CAP) { atomicAdd(&bar[XB_TMO], 1u); break; } }
    }
    nloc = mine > 0u ? mine : 1u; nx = cnt > 0u ? cnt : 1u;
}
DI void xcd_barrier(const XcdBarrier& b) {
    asm volatile("s_waitcnt vmcnt(0)" ::: "memory");
    __syncthreads();
    if (threadIdx.x == 0) {
        unsigned* bar = b.bar;
        __builtin_amdgcn_s_waitcnt(0);
        unsigned nloc = b.st[0], nx = b.st[1];
        if (nloc == 0u) { xcd_barrier_complete(bar, b.x, nloc, nx); b.st[0] = nloc; b.st[1] = nx; }
        const unsigned old = xb_add(&bar[XB_XSUB(b.x)], 1u);
        const unsigned gen = old / nloc;
        if (old + 1u == (gen + 1u) * nloc) {
            __builtin_amdgcn_fence(__ATOMIC_RELEASE, "agent");
            asm volatile("s_waitcnt vmcnt(0)" ::: "memory");
            const unsigned og = xb_add(&bar[XB_TOP], 1u);
            const unsigned tg = og / nx;
            if (og + 1u == (tg + 1u) * nx) xb_add(&bar[XB_TOPGEN], 1u);
            else XB_SPIN(xb_ld(&bar[XB_TOPGEN]) == tg, bar);
            __builtin_amdgcn_fence(__ATOMIC_ACQUIRE, "agent");
            xb_add(&bar[XB_XGEN(b.x)], 1u);
            asm volatile("s_waitcnt vmcnt(0)" ::: "memory");
        } else {
            XB_SPIN(xb_ld(&bar[XB_XGEN(b.x)]) == gen, bar);
            __builtin_amdgcn_fence(__ATOMIC_ACQUIRE, "agent");
            asm volatile("s_waitcnt vmcnt(0)" ::: "memory");
        }
    }
    __syncthreads();
}

constexpr int LDS_BYTES = 112 * 1024;
constexpr int LDS_BARW = LDS_BYTES - 16;

DI void p0_transpose_item(const float* W, int ldw, int K, bf16_t* WT, int dst_row0, int src_col0, float scale, bool zero, LAS float* scr, int kb, int lane) {
    const int k0 = 64 * kb;
#pragma unroll 8
    for (int i = 0; i < 32; ++i) { const int kk = 2 * i + (lane >> 5); scr[kk * 33 + (lane & 31)] = zero ? 0.f : W[(size_t)(k0 + kk) * ldw + src_col0 + (lane & 31)] * scale; }
    asm volatile("s_waitcnt lgkmcnt(0)" ::: "memory");
    const int c = lane & 7;
#pragma unroll
    for (int j = 0; j < 4; ++j) { const int n = (lane >> 3) + 8 * j; const LAS float* s = scr + (8 * c) * 33 + n;
        u32x4 o; o.x = pk2(s[0 * 33], s[1 * 33]); o.y = pk2(s[2 * 33], s[3 * 33]); o.z = pk2(s[4 * 33], s[5 * 33]); o.w = pk2(s[6 * 33], s[7 * 33]);
        *(u32x4*)(WT + (size_t)(dst_row0 + n) * K + k0 + 8 * c) = o; }
    asm volatile("s_waitcnt lgkmcnt(0)" ::: "memory");
}

DI void phase0(const Params& p, LAS unsigned char* lds, int tid, int lane, int wave) {
    unsigned char* ws = p.ws;
    LAS float* sl = (LAS float*)lds;
    LAS float* scr = (LAS float*)(lds + 32768 + wave * 8448);
    const float* c = p.in[1];
    for (int e = tid; e < 8192; e += NTH) { const int b = e >> 10, k = e & 1023; const float v = c[e]; sl[k * 8 + b] = v / (1.f + __expf(-v)); }
    __syncthreads();
    const int gw = wave * gridDim.x + blockIdx.x, NGW = gridDim.x * NWV;
    constexpr int I_MOD = 768, I_WIN = 16 * 68, I_WOUT = 16 * 32, I_WQ = 16 * 64, I_WP = 32;
    constexpr int NITEMS = I_MOD + I_WIN + I_WOUT + I_WQ + I_WP;
    for (int it = gw; it < NITEMS; it += NGW) {
        int r = it;
        if (r < I_MOD) {
            const int cg = r % 96, ks = r / 96, n = cg * 64 + lane, k0 = ks * 128;
            const float* W = p.in[2] + (size_t)k0 * 6144 + n;
            float acc[8];
#pragma unroll
            for (int b = 0; b < 8; ++b) acc[b] = 0.f;
#pragma unroll 8
            for (int k = 0; k < 128; ++k) {
                const float w = W[(size_t)k * 6144];
                const f32x4 s0 = *(const LAS f32x4*)(sl + (k0 + k) * 8), s1 = *(const LAS f32x4*)(sl + (k0 + k) * 8 + 4);
                acc[0] += s0[0] * w; acc[1] += s0[1] * w; acc[2] += s0[2] * w; acc[3] += s0[3] * w;
                acc[4] += s1[0] * w; acc[5] += s1[1] * w; acc[6] += s1[2] * w; acc[7] += s1[3] * w;
            }
            float* mp = (float*)(ws + WS_MODP) + (size_t)ks * 8 * 6144 + n;
#pragma unroll
            for (int b = 0; b < 8; ++b) mp[b * 6144] = acc[b];
            continue;
        }
        r -= I_MOD;
        if (r < I_WIN) {
            const int kb = r / 68, nb = r % 68, n0 = nb * 32;
            int src; bool zero = false; float scale = 1.f;
            if (n0 < 1536) { src = n0; if (n0 < 256) scale = 0.125f; } else if (n0 < 2048) src = n0 + 32; else if (n0 < 2080) src = 1536 + (n0 - 2048); else { src = 0; zero = true; }
            p0_transpose_item(p.in[6], 2080, 1024, (bf16_t*)(ws + WS_WIN), n0, src, scale, zero, scr, kb, lane);
            continue;
        }
        r -= I_WIN;
        if (r < I_WOUT) { p0_transpose_item(p.in[14], 1024, 1024, (bf16_t*)(ws + WS_WOUT), (r % 32) * 32, (r % 32) * 32, 1.f, false, scr, r / 32, lane); continue; }
        r -= I_WOUT;
        if (r < I_WQ) { p0_transpose_item(p.in[17], 2048, 1024, (bf16_t*)(ws + WS_WQ), (r % 64) * 32, (r % 64) * 32, 1.f, false, scr, r / 64, lane); continue; }
        r -= I_WQ;
        { const int g = r >> 3, kb = (r >> 2) & 1, nb = r & 3;
          p0_transpose_item(p.in[12] + g * 16384, 128, 128, (bf16_t*)(ws + WS_WP) + g * 16384, nb * 32, nb * 32, 1.f, false, scr, kb, lane); }
    }
    const size_t gt = (size_t)blockIdx.x * NTH + tid, NGT = (size_t)gridDim.x * NTH;
    constexpr size_t NU = (size_t)16384 * 1024 / 8, NSK = (size_t)16 * 128 * 128 / 8;
    for (size_t i = gt; i < 2 * NU + NSK; i += NGT) {
        const float* src; bf16_t* dst; size_t j;
        if (i < NU) { src = p.in[19]; dst = (bf16_t*)(ws + WS_UB); j = i; }
        else if (i < 2 * NU) { src = p.in[20]; dst = (bf16_t*)(ws + WS_VB); j = i - NU; }
        else { src = p.in[18]; dst = (bf16_t*)(ws + WS_SKB); j = i - 2 * NU; }
        const f32x4 a = *(const f32x4*)(src + j * 8), b = *(const f32x4*)(src + j * 8 + 4);
        u32x4 o = {pk2(a[0], a[1]), pk2(a[2], a[3]), pk2(b[0], b[1]), pk2(b[2], b[3])};
        *(u32x4*)(dst + j * 8) = o;
    }
}

DI float mod_at(const Params& p, int b, int n) {
    const float* mp = (const float*)(p.ws + WS_MODP) + (size_t)b * 6144 + n;
    float s = p.in[3][n];
#pragma unroll
    for (int ks = 0; ks < 8; ++ks) s += mp[(size_t)ks * 8 * 6144];
    return s;
}

DI void phase1(const Params& p, LAS unsigned char* lds, int tid, int lane, int wave) {
    LAS float* lA = (LAS float*)lds; LAS float* lB = lA + 1024;
    const float* x = p.in[0]; bf16_t* H = (bf16_t*)(p.ws + WS_RA);
    for (int rt = blockIdx.x; rt < T / 128; rt += gridDim.x) {
        const int b = rt / 32;
        __syncthreads();
        for (int d = tid; d < 1024; d += NTH) { lA[d] = p.in[4][d] * (1.f + mod_at(p, b, 1024 + d)); lB[d] = mod_at(p, b, d); }
        __syncthreads();
        for (int r = wave; r < 128; r += NWV) {
            const size_t row = (size_t)rt * 128 + r;
            const f32x4* xr = (const f32x4*)(x + row * D) + lane;
            f32x4 v[4]; float ss = 0.f;
#pragma unroll
            for (int j = 0; j < 4; ++j) { v[j] = xr[64 * j]; ss += v[j][0] * v[j][0] + v[j][1] * v[j][1] + v[j][2] * v[j][2] + v[j][3] * v[j][3]; }
            const float rstd = rsqrtf(wave_sum(ss) * (1.f / D) + EPS);
            u32x2* o = (u32x2*)(H + row * D) + lane;
#pragma unroll
            for (int j = 0; j < 4; ++j) {
                const f32x4 a = *(const LAS f32x4*)(lA + 4 * lane + 256 * j), bb = *(const LAS f32x4*)(lB + 4 * lane + 256 * j);
                u32x2 w = {pk2(v[j][0] * rstd * a[0] + bb[0], v[j][1] * rstd * a[1] + bb[1]), pk2(v[j][2] * rstd * a[2] + bb[2], v[j][3] * rstd * a[3] + bb[3])};
                o[64 * j] = w;
            }
        }
    }
}

struct EpiZ {
    bf16_t* Z; float* AFB;
    DI void operator()(int m, int n, const f32x4& v) const {
        if (n < ZW) { u32x2 w = {pk2(v[0], v[1]), pk2(v[2], v[3])}; *(u32x2*)(Z + (size_t)m * ZW + n) = w; }
        else if (n < ZW + 32) { *(f32x4*)(AFB + (size_t)m * 32 + (n - ZW)) = v; }
    }
};
struct EpiF32 { float* C; int ldc; DI void operator()(int m, int n, const f32x4& v) const { *(f32x4*)(C + (size_t)m * ldc + n) = v; } };
struct EpiBf16 { bf16_t* C; int ldc; DI void operator()(int m, int n, const f32x4& v) const { u32x2 w = {pk2(v[0], v[1]), pk2(v[2], v[3])}; *(u32x2*)(C + (size_t)m * ldc + n) = w; } };

template <class Epi>
DI void gemm_phase(const bf16_t* A, const bf16_t* Bt, int M, int N, int K, const Epi& epi, LAS unsigned char* lds, int tid, int lane, int wave) {
    constexpr int BM = 256, BN = 128, BK = 64, STAGE = (BM + BN) * 128;
    const int ntn = N / BN, ntiles = (M / BM) * ntn, nk = K / BK;
    const int wm = wave & 3, wn = wave >> 2, c15 = lane & 15, g = lane >> 4;
    const int lrow = tid >> 3, lch = tid & 7;
    for (int tile = blockIdx.x; tile < ntiles; tile += gridDim.x) {
        const int m0 = (tile / ntn) * BM, n0 = (tile % ntn) * BN;
        f32x4 acc[4][4];
#pragma unroll
        for (int i = 0; i < 4; ++i)
#pragma unroll
            for (int j = 0; j < 4; ++j) acc[i][j] = (f32x4){0.f, 0.f, 0.f, 0.f};
        u32x4 ra[4], rb[2];
        const bf16_t* Ag = A + (size_t)(m0 + lrow) * K + lch * 8;
        const bf16_t* Bg = Bt + (size_t)(n0 + lrow) * K + lch * 8;
        const int woff = lrow * 128 + ((lch ^ (lrow & 7)) * 16);
        __syncthreads();
#pragma unroll
        for (int ps = 0; ps < 4; ++ps) ra[ps] = *(const u32x4*)(Ag + (size_t)(64 * ps) * K);
#pragma unroll
        for (int ps = 0; ps < 2; ++ps) rb[ps] = *(const u32x4*)(Bg + (size_t)(64 * ps) * K);
#pragma unroll
        for (int ps = 0; ps < 4; ++ps) *(LAS u32x4*)(lds + woff + ps * 8192) = ra[ps];
#pragma unroll
        for (int ps = 0; ps < 2; ++ps) *(LAS u32x4*)(lds + BM * 128 + woff + ps * 8192) = rb[ps];
        __syncthreads();
        for (int kt = 0; kt < nk; ++kt) {
            const bool more = (kt + 1 < nk);
            if (more) {
#pragma unroll
                for (int ps = 0; ps < 4; ++ps) ra[ps] = *(const u32x4*)(Ag + (size_t)(64 * ps) * K + (kt + 1) * BK);
#pragma unroll
                for (int ps = 0; ps < 2; ++ps) rb[ps] = *(const u32x4*)(Bg + (size_t)(64 * ps) * K + (kt + 1) * BK);
            }
            LAS unsigned char* sa = lds + (kt & 1) * STAGE; LAS unsigned char* sb = sa + BM * 128;
#pragma unroll
            for (int s = 0; s < 2; ++s) {
                bf16x8 fa[4], fb[4];
#pragma unroll
                for (int i = 0; i < 4; ++i) { const int row = wm * 64 + i * 16 + c15; fa[i] = *(const LAS bf16x8*)(sa + row * 128 + (((4 * s + g) ^ (row & 7)) * 16)); }
#pragma unroll
                for (int j = 0; j < 4; ++j) { const int row = wn * 64 + j * 16 + c15; fb[j] = *(const LAS bf16x8*)(sb + row * 128 + (((4 * s + g) ^ (row & 7)) * 16)); }
#pragma unroll
                for (int i = 0; i < 4; ++i)
#pragma unroll
                    for (int j = 0; j < 4; ++j) acc[i][j] = MFMA16(fb[j], fa[i], acc[i][j]);
            }
            if (more) {
                LAS unsigned char* da = lds + ((kt + 1) & 1) * STAGE;
#pragma unroll
                for (int ps = 0; ps < 4; ++ps) *(LAS u32x4*)(da + woff + ps * 8192) = ra[ps];
#pragma unroll
                for (int ps = 0; ps < 2; ++ps) *(LAS u32x4*)(da + BM * 128 + woff + ps * 8192) = rb[ps];
            }
            __syncthreads();
        }
#pragma unroll
        for (int i = 0; i < 4; ++i)
#pragma unroll
            for (int j = 0; j < 4; ++j) epi(m0 + wm * 64 + i * 16 + c15, n0 + wn * 64 + j * 16 + 4 * g, acc[i][j]);
    }
}

DI float logsig(float x) { return fminf(x, 0.f) - __logf(1.f + __expf(-fabsf(x))); }

DI void phase3a(const Params& p, LAS unsigned char* lds, int tid, int lane, int wave) {
    unsigned char* ws = p.ws;
    const bf16_t* Z = (const bf16_t*)(ws + WS_RZ);
    const float* AFB = (const float*)(ws + WS_AFB);
    bf16_t* QD[2] = {(bf16_t*)(ws + WS_RS), (bf16_t*)(ws + WS_RS + 48 * MB)};
    bf16_t* KI[2] = {(bf16_t*)(ws + WS_RS + 16 * MB), (bf16_t*)(ws + WS_RS + 64 * MB)};
    bf16_t* KE[2] = {(bf16_t*)(ws + WS_RS + 32 * MB), (bf16_t*)(ws + WS_RS + 80 * MB)};
    float* GAM[2] = {(float*)(ws + WS_RS + 96 * MB), (float*)(ws + WS_RS + 96 * MB + 512 * 1024)};
    bf16_t* VT = (bf16_t*)(ws + WS_RA);
    LAS float* la[2] = {(LAS float*)lds, (LAS float*)(lds + 16384)};
    LAS float* part[2] = {(LAS float*)(lds + 32768), (LAS float*)(lds + 32768 + 2048)};
    LAS bf16_t* keT[2] = {(LAS bf16_t*)(lds + 36864), (LAS bf16_t*)(lds + 36864 + 8192)};
    LAS bf16_t* vT = (LAS bf16_t*)(lds + 53248);
    for (int task = blockIdx.x; task < 2048; task += gridDim.x) {
        const int h = task & 3, n = (task >> 2) & 63, b = task >> 8;
        const int tok0 = b * SEQ + n * 64;
        const int i = tid >> 3, dg = tid & 7, d0 = dg * 8;
        const size_t t = (size_t)tok0 + i;
        __syncthreads();
        {
            float af[16], ab[16];
#pragma unroll
            for (int q = 0; q < 4; ++q) { const f32x4 a = *(const f32x4*)(AFB + t * 32 + 4 * q), bb = *(const f32x4*)(AFB + t * 32 + 16 + 4 * q);
                af[4 * q] = a[0]; af[4 * q + 1] = a[1]; af[4 * q + 2] = a[2]; af[4 * q + 3] = a[3]; ab[4 * q] = bb[0]; ab[4 * q + 1] = bb[1]; ab[4 * q + 2] = bb[2]; ab[4 * q + 3] = bb[3]; }
            const float* waf = p.in[7] + h * 64 + d0; const float* wab = p.in[9] + h * 64 + d0;
            float xf[8], xb[8];
#pragma unroll
            for (int e = 0; e < 8; ++e) { xf[e] = p.in[8][h * 64 + d0 + e]; xb[e] = p.in[10][h * 64 + d0 + e]; }
#pragma unroll
            for (int r = 0; r < 16; ++r) {
                const f32x4 w0 = *(const f32x4*)(waf + r * 256), w1 = *(const f32x4*)(waf + r * 256 + 4), v0 = *(const f32x4*)(wab + r * 256), v1 = *(const f32x4*)(wab + r * 256 + 4);
#pragma unroll
                for (int e = 0; e < 4; ++e) { xf[e] += af[r] * w0[e]; xf[4 + e] += af[r] * w1[e]; xb[e] += ab[r] * v0[e]; xb[4 + e] += ab[r] * v1[e]; }
            }
#pragma unroll
            for (int e = 0; e < 8; ++e) { la[0][i * 64 + d0 + e] = logsig(xf[e]) * 0.0625f; la[1][i * 64 + d0 + e] = logsig(xb[e]) * 0.0625f; }
        }
        __syncthreads();
        {
            const int d = tid & 63, pt = tid >> 6;
            float run = 0.f;
#pragma unroll
            for (int j = 0; j < 8; ++j) { run += la[0][(8 * pt + j) * 64 + d]; la[0][(8 * pt + j) * 64 + d] = run; }
            part[0][pt * 64 + d] = run;
            run = 0.f;
#pragma unroll
            for (int j = 7; j >= 0; --j) { run += la[1][(8 * pt + j) * 64 + d]; la[1][(8 * pt + j) * 64 + d] = run; }
            part[1][pt * 64 + d] = run;
            __syncthreads();
            float of = 0.f, ob = 0.f;
#pragma unroll
            for (int q = 0; q < 8; ++q) { if (q < pt) of += part[0][q * 64 + d]; if (q > pt) ob += part[1][q * 64 + d]; }
#pragma unroll
            for (int j = 0; j < 8; ++j) { la[0][(8 * pt + j) * 64 + d] += of; la[1][(8 * pt + j) * 64 + d] += ob; }
        }
        __syncthreads();
        {
            const u32x4 qv = *(const u32x4*)(Z + t * ZW + h * 64 + d0), kv = *(const u32x4*)(Z + t * ZW + 256 + h * 64 + d0);
            float q[8], k[8];
#pragma unroll
            for (int e = 0; e < 4; ++e) { q[2 * e] = bflo(qv[e]); q[2 * e + 1] = bfhi(qv[e]); k[2 * e] = bflo(kv[e]); k[2 * e + 1] = bfhi(kv[e]); }
#pragma unroll
            for (int dir = 0; dir < 2; ++dir) {
                float qd[8], ki[8], ke[8];
#pragma unroll
                for (int e = 0; e < 8; ++e) {
                    const float bb = la[dir][i * 64 + d0 + e], bl = la[dir][(dir ? 0 : 63) * 64 + d0 + e];
                    qd[e] = q[e] * __expf(bb); ki[e] = k[e] * __expf(-bb); ke[e] = k[e] * __expf(bl - bb);
                    if (i == (dir ? 0 : 63)) GAM[dir][((size_t)(b * 4 + h) * 64 + n) * 64 + d0 + e] = __expf(bl);
                }
                u32x4 o1 = {pk2(qd[0], qd[1]), pk2(qd[2], qd[3]), pk2(qd[4], qd[5]), pk2(qd[6], qd[7])};
                u32x4 o2 = {pk2(ki[0], ki[1]), pk2(ki[2], ki[3]), pk2(ki[4], ki[5]), pk2(ki[6], ki[7])};
                *(u32x4*)(QD[dir] + t * 256 + h * 64 + d0) = o1;
                *(u32x4*)(KI[dir] + t * 256 + h * 64 + d0) = o2;
#pragma unroll
                for (int e = 0; e < 4; ++e) { const unsigned w = pk2(ke[2 * e], ke[2 * e + 1]); keT[dir][(d0 + 2 * e) * 64 + i] = (bf16_t)(w & 0xFFFFu); keT[dir][(d0 + 2 * e + 1) * 64 + i] = (bf16_t)(w >> 16); }
            }
#pragma unroll
            for (int ps = 0; ps < 2; ++ps) {
                const int idx = tid + NTH * ps, vi = idx >> 4, ch = idx & 15;
                const u32x4 vv = *(const u32x4*)(Z + ((size_t)tok0 + vi) * ZW + 512 + h * 128 + ch * 8);
#pragma unroll
                for (int e = 0; e < 4; ++e) { vT[(ch * 8 + 2 * e) * 72 + vi] = (bf16_t)(vv[e] & 0xFFFFu); vT[(ch * 8 + 2 * e + 1) * 72 + vi] = (bf16_t)(vv[e] >> 16); }
            }
        }
        __syncthreads();
        {
            const int dk = tid >> 3, ch = tid & 7;
#pragma unroll
            for (int dir = 0; dir < 2; ++dir) {
                const u32x4 v = *(const LAS u32x4*)(keT[dir] + dk * 64 + ch * 8);
                *(u32x4*)(KE[dir] + ((size_t)(b * 64 + n) * 256 + h * 64 + dk) * 64 + ch * 8) = v;
            }
#pragma unroll
            for (int ps = 0; ps < 2; ++ps) {
                const int idx = tid + NTH * ps, dv = idx >> 3, c8 = idx & 7;
                const LAS bf16_t* s = vT + dv * 72 + c8 * 8;
                u32x4 v; v.x = s[0] | ((unsigned)s[1] << 16); v.y = s[2] | ((unsigned)s[3] << 16); v.z = s[4] | ((unsigned)s[5] << 16); v.w = s[6] | ((unsigned)s[7] << 16);
                *(u32x4*)(VT + ((size_t)(b * 64 + n) * 512 + h * 128 + dv) * 64 + c8 * 8) = v;
            }
        }
    }
}

DI void phase3b(const Params& p, int lane, int wave) {
    unsigned char* ws = p.ws;
    const int gw = wave * gridDim.x + blockIdx.x, NGW = gridDim.x * NWV;
    const int c15 = lane & 15, g = lane >> 4;
    for (int task = gw; task < 256; task += NGW) {
        const int sl = (task >> 3) & 3, bhd = (task & 7) | ((task >> 5) << 3);
        const int dir = bhd & 1, h = (bhd >> 1) & 3, b = bhd >> 3;
        const bf16_t* QD = (const bf16_t*)(ws + WS_RS + (dir ? 48 : 0) * MB) + (size_t)b * SEQ * 256 + h * 64;
        const bf16_t* KI = (const bf16_t*)(ws + WS_RS + (dir ? 64 : 16) * MB) + (size_t)b * SEQ * 256 + h * 64;
        const bf16_t* KE = (const bf16_t*)(ws + WS_RS + (dir ? 80 : 32) * MB) + ((size_t)b * 64 * 256 + h * 64) * 64;
        const float* GAM = (const float*)(ws + WS_RS + 96 * MB + (dir ? 512 * 1024 : 0)) + (size_t)(b * 4 + h) * 64 * 64;
        const bf16_t* VT = (const bf16_t*)(ws + WS_RA) + ((size_t)b * 64 * 512 + h * 128 + sl * 32) * 64;
        float* O = (float*)(ws + WS_RO + (dir ? 64 : 0) * MB) + (size_t)b * SEQ * 512 + h * 128 + sl * 32;
        f32x4 S[4][2];
#pragma unroll
        for (int kt = 0; kt < 4; ++kt) { S[kt][0] = (f32x4){0.f, 0.f, 0.f, 0.f}; S[kt][1] = (f32x4){0.f, 0.f, 0.f, 0.f}; }
        for (int cn = 0; cn < 64; ++cn) {
            const int n = dir ? 63 - cn : cn;
            bf16x8 kia[4][2], kea[4][2], vb[2][2];
            f32x4 gam[4];
#pragma unroll
            for (int jt = 0; jt < 4; ++jt)
#pragma unroll
                for (int s = 0; s < 2; ++s) {
                    kia[jt][s] = ld_frag_perm(KI + (size_t)(n * 64 + 16 * jt + c15) * 256 + 32 * s, g);
                    kea[jt][s] = ld_frag_perm(KE + ((size_t)n * 256 + 16 * jt + c15) * 64 + 32 * s, g);
                }
#pragma unroll
            for (int nt = 0; nt < 2; ++nt)
#pragma unroll
                for (int s = 0; s < 2; ++s) vb[nt][s] = ld_frag_perm(VT + ((size_t)n * 512 + 16 * nt + c15) * 64 + 32 * s, g);
#pragma unroll
            for (int kt = 0; kt < 4; ++kt) gam[kt] = *(const f32x4*)(GAM + n * 64 + 16 * kt + 4 * g);
            bf16x8 sb[2][2];
#pragma unroll
            for (int nt = 0; nt < 2; ++nt)
#pragma unroll
                for (int s = 0; s < 2; ++s) sb[nt][s] = pack8(S[2 * s][nt], S[2 * s + 1][nt]);
#pragma unroll
            for (int it = 0; it < 4; ++it) {
                bf16x8 qdb[2];
#pragma unroll
                for (int s = 0; s < 2; ++s) qdb[s] = ld_frag_perm(QD + (size_t)(n * 64 + 16 * it + c15) * 256 + 32 * s, g);
                f32x4 sc[4];
#pragma unroll
                for (int jt = 0; jt < 4; ++jt) {
                    sc[jt] = (f32x4){0.f, 0.f, 0.f, 0.f};
#pragma unroll
                    for (int s = 0; s < 2; ++s) sc[jt] = MFMA16(kia[jt][s], qdb[s], sc[jt]);
                    const int ii = 16 * it + c15;
#pragma unroll
                    for (int r = 0; r < 4; ++r) { const int jj = 16 * jt + 4 * g + r; const bool keep = dir ? (jj > ii) : (jj <= ii); sc[jt][r] = keep ? sc[jt][r] : 0.f; }
                }
                bf16x8 pa[2] = {pack8(sc[0], sc[1]), pack8(sc[2], sc[3])};
#pragma unroll
                for (int nt = 0; nt < 2; ++nt) {
                    f32x4 o = (f32x4){0.f, 0.f, 0.f, 0.f};
#pragma unroll
                    for (int s = 0; s < 2; ++s) { o = MFMA16(pa[s], vb[nt][s], o); o = MFMA16(qdb[s], sb[nt][s], o); }
                    float* op = O + (size_t)(n * 64 + 16 * it + 4 * g) * 512 + 16 * nt + c15;
#pragma unroll
                    for (int r = 0; r < 4; ++r) op[(size_t)r * 512] = o[r];
                }
            }
#pragma unroll
            for (int kt = 0; kt < 4; ++kt)
#pragma unroll
                for (int nt = 0; nt < 2; ++nt) {
                    f32x4 a = S[kt][nt] * gam[kt];
#pragma unroll
                    for (int s = 0; s < 2; ++s) a = MFMA16(kea[kt][s], vb[nt][s], a);
                    S[kt][nt] = a;
                }
        }
    }
}

DI void phase4a(const Params& p, LAS unsigned char* lds, int tid, int lane, int wave) {
    unsigned char* ws = p.ws;
    const bf16_t* Z = (const bf16_t*)(ws + WS_RZ);
    bf16_t* MIX = (bf16_t*)(ws + WS_RA);
    const float* OF = (const float*)(ws + WS_RO); const float* OB = (const float*)(ws + WS_RO + 64 * MB);
    {
        const int gw = blockIdx.x * NWV + wave, NGW = gridDim.x * NWV;
        f32x4 gh0 = *(const f32x4*)(p.in[11] + 8 * lane), gh1 = *(const f32x4*)(p.in[11] + 8 * lane + 4);
        for (int t = gw; t < T; t += NGW) {
            const f32x4 a0 = *(const f32x4*)(OF + (size_t)t * 512 + 8 * lane), a1 = *(const f32x4*)(OF + (size_t)t * 512 + 8 * lane + 4);
            const f32x4 b0 = *(const f32x4*)(OB + (size_t)t * 512 + 8 * lane), b1 = *(const f32x4*)(OB + (size_t)t * 512 + 8 * lane + 4);
            const u32x4 rv = *(const u32x4*)(Z + (size_t)t * ZW + 1024 + 8 * lane);
            float o[8], r[8];
#pragma unroll
            for (int e = 0; e < 4; ++e) { o[e] = a0[e] + b0[e]; o[4 + e] = a1[e] + b1[e]; r[2 * e] = bflo(rv[e]); r[2 * e + 1] = bfhi(rv[e]); }
            float ss = 0.f;
#pragma unroll
            for (int e = 0; e < 8; ++e) ss += o[e] * o[e];
            ss += __shfl_xor(ss, 1); ss += __shfl_xor(ss, 2); ss += __shfl_xor(ss, 4); ss += __shfl_xor(ss, 8);
            const float rstd = rsqrtf(ss * (1.f / 128.f) + EPS);
            float y[8];
#pragma unroll
            for (int e = 0; e < 8; ++e) { const float gg = e < 4 ? gh0[e] : gh1[e - 4]; y[e] = o[e] * rstd * gg * (r[e] / (1.f + __expf(-r[e]))); }
            u32x4 w = {pk2(y[0], y[1]), pk2(y[2], y[3]), pk2(y[4], y[5]), pk2(y[6], y[7])};
            *(u32x4*)(MIX + (size_t)t * D + 8 * lane) = w;
        }
    }
    LAS float* pt = (LAS float*)lds;
    LAS unsigned char* at = lds + 40960;
    const bf16_t* WP = (const bf16_t*)(ws + WS_WP);
    const int c15 = lane & 15, g = lane >> 4;
    for (int task = blockIdx.x; task < 2048; task += gridDim.x) {
        const int gi = task & 3, tile = task >> 2, tok0 = tile * 64, s0 = tok0 & (SEQ - 1), hw = 1 << gi;
        __syncthreads();
        const int nrows = 64 + 2 * hw;
        for (int idx = tid; idx < nrows * 16; idx += NTH) {
            const int rr = idx >> 4, ch = idx & 15, s = s0 - hw + rr;
            u32x4 v = {0u, 0u, 0u, 0u};
            if (s >= 0 && s < SEQ) v = *(const u32x4*)(Z + ((size_t)tok0 - hw + rr) * ZW + 1536 + gi * 128 + ch * 8);
            LAS float* d = pt + rr * 128 + ch * 8;
#pragma unroll
            for (int e = 0; e < 4; ++e) { d[2 * e] = bflo(v[e]); d[2 * e + 1] = bfhi(v[e]); }
        }
        __syncthreads();
        {
            const int c = tid & 127, q = tid >> 7;
            for (int ii = 0; ii < 16; ++ii) {
                const int i = 16 * q + ii, s = s0 + i;
                const int lo = max(s - hw, 0), hi = min(s + hw, SEQ);
                float sum = 0.f;
                for (int rr = lo; rr < hi; ++rr) sum += pt[(rr - (s0 - hw)) * 128 + c];
                const float val = sum / (float)(hi - lo) - pt[(i + hw) * 128 + c];
                const unsigned w = pk2(val, 0.f);
                *(LAS bf16_t*)(at + i * 256 + (((c >> 3) ^ (i & 15)) * 16) + (c & 7) * 2) = (bf16_t)(w & 0xFFFFu);
            }
        }
        __syncthreads();
        {
            f32x4 acc[4];
#pragma unroll
            for (int mt = 0; mt < 4; ++mt) acc[mt] = (f32x4){0.f, 0.f, 0.f, 0.f};
#pragma unroll
            for (int s = 0; s < 4; ++s) {
                const bf16x8 wf = ld_frag16(WP + (size_t)gi * 16384 + (16 * wave + c15) * 128 + 32 * s + 8 * g);
#pragma unroll
                for (int mt = 0; mt < 4; ++mt) { const int row = mt * 16 + c15; const bf16x8 af = *(const LAS bf16x8*)(at + row * 256 + (((4 * s + g) ^ (row & 15)) * 16)); acc[mt] = MFMA16(wf, af, acc[mt]); }
            }
            const f32x4 ps = *(const f32x4*)(p.in[13] + gi * 128 + 16 * wave + 4 * g);
#pragma unroll
            for (int mt = 0; mt < 4; ++mt) {
                const f32x4 v = acc[mt] * ps;
                u32x2 w = {pk2(v[0], v[1]), pk2(v[2], v[3])};
                *(u32x2*)(MIX + ((size_t)tok0 + mt * 16 + c15) * D + 512 + gi * 128 + 16 * wave + 4 * g) = w;
            }
        }
    }
}

DI void phase4c(const Params& p, LAS unsigned char* lds, int tid, int lane, int wave) {
    LAS float* lG = (LAS float*)lds; LAS float* lA = lG + 1024; LAS float* lB = lA + 1024; LAS float* lP = lB + 1024;
    const float* x = p.in[0]; const float* MIXO = (const float*)(p.ws + WS_RZ); bf16_t* H2 = (bf16_t*)(p.ws + WS_RA);
    for (int rt = blockIdx.x; rt < T / 128; rt += gridDim.x) {
        const int b = rt / 32;
        __syncthreads();
        for (int d = tid; d < 1024; d += NTH) { lG[d] = mod_at(p, b, 2048 + d); lA[d] = p.in[15][d] * (1.f + mod_at(p, b, 4096 + d)); lB[d] = mod_at(p, b, 3072 + d); lP[d] = p.in[5][d]; }
        __syncthreads();
        for (int r = wave; r < 128; r += NWV) {
            const size_t row = (size_t)rt * 128 + r;
            const f32x4* mr = (const f32x4*)(MIXO + row * D) + lane; const f32x4* xr = (const f32x4*)(x + row * D) + lane;
            f32x4 m[4], xv[4]; float ss = 0.f;
#pragma unroll
            for (int j = 0; j < 4; ++j) { m[j] = mr[64 * j]; xv[j] = xr[64 * j]; ss += m[j][0] * m[j][0] + m[j][1] * m[j][1] + m[j][2] * m[j][2] + m[j][3] * m[j][3]; }
            const float rstd = rsqrtf(wave_sum(ss) * (1.f / D) + EPS);
            float s2 = 0.f;
#pragma unroll
            for (int j = 0; j < 4; ++j) {
                const f32x4 gt = *(const LAS f32x4*)(lG + 4 * lane + 256 * j), pm = *(const LAS f32x4*)(lP + 4 * lane + 256 * j);
                xv[j] = xv[j] + gt * (m[j] * rstd * pm);
                s2 += xv[j][0] * xv[j][0] + xv[j][1] * xv[j][1] + xv[j][2] * xv[j][2] + xv[j][3] * xv[j][3];
            }
            const float rstd2 = rsqrtf(wave_sum(s2) * (1.f / D) + EPS);
            f32x4* orow = (f32x4*)(p.out + row * D) + lane; u32x2* hrow = (u32x2*)(H2 + row * D) + lane;
#pragma unroll
            for (int j = 0; j < 4; ++j) {
                orow[64 * j] = xv[j];
#ifdef CHK_PEER
                ((f32x4*)((float*)(p.ws + WS_RO) + row * D) + lane)[64 * j] = xv[j];
#endif
                const f32x4 a = *(const LAS f32x4*)(lA + 4 * lane + 256 * j), bb = *(const LAS f32x4*)(lB + 4 * lane + 256 * j);
                const f32x4 hv = xv[j] * rstd2 * a + bb;
                u32x2 w = {pk2(hv[0], hv[1]), pk2(hv[2], hv[3])};
                hrow[64 * j] = w;
            }
        }
    }
}

DI int skey(float v, int idx, int mask) { int u = __float_as_int(v); u ^= (u >> 31) & 0x7FFFFFFF; return (u & ~mask) | idx; }
DI float sval(int k, int mask) { int u = k & ~mask; u ^= (u >> 31) & 0x7FFFFFFF; return __int_as_float(u); }
DI void cswap(int& a, int& b) { const int mx = max(a, b), mn = min(a, b); a = mx; b = mn; }
DI void sort16_desc(int (&a)[16]) {
#pragma unroll
    for (int k = 2; k <= 16; k <<= 1) {
#pragma unroll
        for (int j = k >> 1; j > 0; j >>= 1) {
#pragma unroll
            for (int i = 0; i < 16; ++i) {
                const int l = i ^ j;
                if (l > i) { if ((i & k) == 0) cswap(a[i], a[l]); else cswap(a[l], a[i]); }
            }
        }
    }
}
DI void merge16_desc(int (&x)[16], const int (&y)[16]) {
#pragma unroll
    for (int i = 0; i < 16; ++i) x[i] = max(x[i], y[15 - i]);
#pragma unroll
    for (int j = 8; j > 0; j >>= 1) {
#pragma unroll
        for (int i = 0; i < 16; ++i) { const int l = i ^ j; if (l > i) cswap(x[i], x[l]); }
    }
}

DI void phase5b(const Params& p, LAS unsigned char* lds, int tid, int lane, int wave) {
    unsigned char* ws = p.ws;
    const bf16_t* Q2 = (const bf16_t*)(ws + WS_RZ);
    const bf16_t* SKB = (const bf16_t*)(ws + WS_SKB);
    int* EIDX = (int*)(ws + WS_RS); float* GATE = (float*)(ws + WS_RS + 16 * MB);
    LAS unsigned char* tab = lds + tid * 32;
    const int gw = blockIdx.x * NWV + wave, NGW = gridDim.x * NWV;
    const int c31 = lane & 31, hi = lane >> 5;
    for (int task = gw; task < 8192; task += NGW) {
        const int h = task & 7, tg = task >> 3;
        const size_t tok = (size_t)tg * 32 + c31;
        int lst[2][16];
#pragma unroll
        for (int pp = 0; pp < 2; ++pp) {
            const bf16_t* qp = Q2 + tok * 2048 + h * 256 + pp * 128 + 8 * hi;
            const bf16_t* kp = SKB + ((size_t)(h * 2 + pp) * 128 + c31) * 128 + 8 * hi;
            asm volatile("" : "+v"(qp)); asm volatile("" : "+v"(kp));
            bf16x8 bq[8];
#pragma unroll
            for (int ks = 0; ks < 8; ++ks) bq[ks] = ld_frag16(qp + 16 * ks);
            int run[16];
#pragma unroll
            for (int r = 0; r < 16; ++r) run[r] = (int)0x80000000;
#pragma unroll 1
            for (int kt = 0; kt < 4; ++kt) {
                const bf16_t* kpt = kp + kt * 4096;
                f32x16 acc;
#pragma unroll
                for (int r = 0; r < 16; ++r) acc[r] = 0.f;
#pragma unroll
                for (int ks = 0; ks < 8; ++ks) acc = MFMA32(ld_frag16(kpt + 16 * ks), bq[ks], acc);
                int cur[16];
#pragma unroll
                for (int r = 0; r < 16; ++r) cur[r] = skey(acc[r], 32 * kt + 8 * (r >> 2) + 4 * hi + (r & 3), 0x7F);
                sort16_desc(cur);
                merge16_desc(run, cur);
            }
            int oth[16];
#pragma unroll
            for (int r = 0; r < 16; ++r) oth[r] = __shfl_xor(run[r], 32);
            merge16_desc(run, oth);
#pragma unroll
            for (int r = 0; r < 16; ++r) lst[pp][r] = run[r];
        }
#pragma unroll
        for (int pp = 0; pp < 2; ++pp) {
            u32x4 w;
#pragma unroll
            for (int q = 0; q < 4; ++q) w[q] = (lst[pp][4 * q] & 0x7F) | ((lst[pp][4 * q + 1] & 0x7F) << 8) | ((lst[pp][4 * q + 2] & 0x7F) << 16) | ((lst[pp][4 * q + 3] & 0x7F) << 24);
            *(LAS u32x4*)(tab + 16 * pp) = w;
        }
        float va[16], vb[16];
#pragma unroll
        for (int r = 0; r < 16; ++r) { va[r] = sval(lst[0][r], 0x7F); vb[r] = sval(lst[1][r], 0x7F); }
        int cand[4][16];
        {
            int cnt = 0;
#pragma unroll
            for (int i = 0; i < 16; ++i)
#pragma unroll
                for (int j = 0; j < 16; ++j)
                    if ((i + 1) * (j + 1) <= 16) { cand[cnt >> 4][cnt & 15] = skey(va[i] + vb[j], (i << 4) | j, 0xFF); ++cnt; }
#pragma unroll
            for (int q = 50; q < 64; ++q) cand[q >> 4][q & 15] = (int)0x80000000;
        }
        sort16_desc(cand[0]); sort16_desc(cand[1]); sort16_desc(cand[2]); sort16_desc(cand[3]);
        merge16_desc(cand[0], cand[1]); merge16_desc(cand[2], cand[3]); merge16_desc(cand[0], cand[2]);
        asm volatile("s_waitcnt lgkmcnt(0)" ::: "memory");
        float sv[16]; int ex[16];
        const float mx = sval(cand[0][0], 0xFF);
        float sum = 0.f;
#pragma unroll
        for (int r = 0; r < 16; ++r) {
            const int ck = cand[0][r];
            const int i1 = tab[(ck >> 4) & 15], i2 = tab[16 + (ck & 15)];
            ex[r] = i1 * 128 + i2;
            sv[r] = __expf(sval(ck, 0xFF) - mx); sum += sv[r];
        }
        const float inv = 1.f / sum;
        int* ep = EIDX + tok * 128 + h * 16 + 8 * hi; float* gp = GATE + tok * 128 + h * 16 + 8 * hi;
        if (hi == 0) {
            *(u32x4*)ep = (u32x4){(unsigned)ex[0], (unsigned)ex[1], (unsigned)ex[2], (unsigned)ex[3]}; *(u32x4*)(ep + 4) = (u32x4){(unsigned)ex[4], (unsigned)ex[5], (unsigned)ex[6], (unsigned)ex[7]};
            *(f32x4*)gp = (f32x4){sv[0] * inv, sv[1] * inv, sv[2] * inv, sv[3] * inv}; *(f32x4*)(gp + 4) = (f32x4){sv[4] * inv, sv[5] * inv, sv[6] * inv, sv[7] * inv};
        } else {
            *(u32x4*)ep = (u32x4){(unsigned)ex[8], (unsigned)ex[9], (unsigned)ex[10], (unsigned)ex[11]}; *(u32x4*)(ep + 4) = (u32x4){(unsigned)ex[12], (unsigned)ex[13], (unsigned)ex[14], (unsigned)ex[15]};
            *(f32x4*)gp = (f32x4){sv[8] * inv, sv[9] * inv, sv[10] * inv, sv[11] * inv}; *(f32x4*)(gp + 4) = (f32x4){sv[12] * inv, sv[13] * inv, sv[14] * inv, sv[15] * inv};
        }
    }
}

DI void phase6(const Params& p, LAS unsigned char* lds, int tid, int lane, int wave) {
    unsigned char* ws = p.ws;
    const bf16_t* H2 = (const bf16_t*)(ws + WS_RA);
    const bf16_t* UB = (const bf16_t*)(ws + WS_UB); const bf16_t* VB = (const bf16_t*)(ws + WS_VB);
    const int* EIDX = (const int*)(ws + WS_RS); const float* GATE = (const float*)(ws + WS_RS + 16 * MB);
    LAS float* lG = (LAS float*)lds;
    for (int rt = blockIdx.x; rt < T / 128; rt += gridDim.x) {
        const int b = rt / 32;
        __syncthreads();
        for (int d = tid; d < 1024; d += NTH) lG[d] = mod_at(p, b, 5120 + d) * p.in[16][d];
        __syncthreads();
        for (int r = wave; r < 128; r += NWV) {
            const size_t t = (size_t)rt * 128 + r;
            const u32x4 h0 = *(const u32x4*)(H2 + t * D + 8 * lane), h1 = *(const u32x4*)(H2 + t * D + 512 + 8 * lane);
            float y[16];
#pragma unroll
            for (int e = 0; e < 16; ++e) y[e] = 0.f;
#pragma unroll 1
            for (int bt = 0; bt < 2; ++bt) {
                const int eid = EIDX[t * 128 + bt * 64 + lane]; const float gate = GATE[t * 128 + bt * 64 + lane];
                float part[64];
#pragma unroll
                for (int e = 0; e < 64; ++e) {
                    const int idx = __builtin_amdgcn_readlane(eid, e);
                    const bf16_t* up = UB + (size_t)idx * D + 8 * lane;
                    const u32x4 u0 = *(const u32x4*)up, u1 = *(const u32x4*)(up + 512);
                    float a = 0.f;
#pragma unroll
                    for (int q = 0; q < 4; ++q) {
                        a = dot2bf(u0[q], h0[q], a);
                        a = dot2bf(u1[q], h1[q], a);
                    }
                    part[e] = a;
                }
#pragma unroll
                for (int st = 0; st < 6; ++st) {
                    const int w = 32 >> st;
                    const bool up = (lane & w) != 0;
#pragma unroll
                    for (int e = 0; e < w; ++e) {
                        const float keep = up ? part[e + w] : part[e], send = up ? part[e] : part[e + w];
                        part[e] = keep + __shfl_xor(send, w);
                    }
                }
                const float dot = part[0];
                const float coef = gate * 0.5f * dot * (1.f + erff(dot * 0.70710678118654752f));
#pragma unroll 8
                for (int e = 0; e < 64; ++e) {
                    const int idx = __builtin_amdgcn_readlane(eid, e);
                    const float cc = __int_as_float(__builtin_amdgcn_readlane(__float_as_int(coef), e));
                    const bf16_t* vp = VB + (size_t)idx * D + 8 * lane;
                    const u32x4 v0 = *(const u32x4*)vp, v1 = *(const u32x4*)(vp + 512);
#pragma unroll
                    for (int q = 0; q < 4; ++q) { y[2 * q] += cc * bflo(v0[q]); y[2 * q + 1] += cc * bfhi(v0[q]); y[8 + 2 * q] += cc * bflo(v1[q]); y[8 + 2 * q + 1] += cc * bfhi(v1[q]); }
                }
            }
            float ss = 0.f;
#pragma unroll
            for (int e = 0; e < 16; ++e) ss += y[e] * y[e];
            const float rstd = rsqrtf(wave_sum(ss) * (1.f / D) + EPS);
            float* orow = p.out + t * D;
#pragma unroll
            for (int hh = 0; hh < 2; ++hh)
#pragma unroll
                for (int q = 0; q < 2; ++q) {
                    const int col = hh * 512 + 8 * lane + 4 * q;
                    f32x4 xv = *(const f32x4*)(orow + col); const f32x4 gg = *(const LAS f32x4*)(lG + col);
#pragma unroll
                    for (int e = 0; e < 4; ++e) xv[e] += gg[e] * y[hh * 8 + 4 * q + e] * rstd;
                    *(f32x4*)(orow + col) = xv;
                }
        }
    }
}

#ifdef CHK_PEER
DI float blk_sum(float v, LAS float* red, int tid, int lane, int wave) {
    v = wave_sum(v);
    __syncthreads();
    if (lane == 0) red[wave] = v;
    __syncthreads();
    float s = 0.f;
    for (int i = 0; i < NWV; ++i) s += red[i];
    return s;
}
DI void check_peer(const Params& p, LAS unsigned char* lds, int tid, int lane, int wave) {
    unsigned char* ws = p.ws;
    const bf16_t* H2 = (const bf16_t*)(ws + WS_RA); const bf16_t* WQ = (const bf16_t*)(ws + WS_WQ); const bf16_t* SKB = (const bf16_t*)(ws + WS_SKB);
    const bf16_t* UB = (const bf16_t*)(ws + WS_UB); const bf16_t* VB = (const bf16_t*)(ws + WS_VB);
    const float* X1 = (const float*)(ws + WS_RO);
    float* stat = (float*)(ws + WS_CTL + 32768);
    LAS float* hrow = (LAS float*)lds;
    LAS float* qv = hrow + 1024;
    LAS float* sc = qv + 2048;
    LAS float* tv = sc + 2048;
    LAS int* ti = (LAS int*)(tv + 256);
    LAS int* ee = ti + 256;
    LAS float* gg = (LAS float*)(ee + 128);
    LAS float* cf = gg + 128;
    LAS float* yv = cf + 128;
    LAS float* red = yv + 1024;
    for (int rt = blockIdx.x; rt < T / 128; rt += gridDim.x) {
        const size_t ts = (size_t)rt * 128 + 37; const int b = rt / 32;
        __syncthreads();
        for (int d = tid; d < 1024; d += NTH) hrow[d] = bflo((unsigned)H2[ts * D + d]);
        __syncthreads();
        for (int n = tid; n < 2048; n += NTH) { float a = 0.f; for (int k = 0; k < 1024; ++k) a += hrow[k] * bflo((unsigned)WQ[(size_t)n * 1024 + k]); qv[n] = bflo(pk2(a, 0.f) & 0xFFFFu); }
        __syncthreads();
        for (int n = tid; n < 2048; n += NTH) { const int hp = n >> 7, key = n & 127; float a = 0.f; for (int d = 0; d < 128; ++d) a += qv[hp * 128 + d] * bflo((unsigned)SKB[((size_t)hp * 128 + key) * 128 + d]); sc[n] = a; }
        __syncthreads();
        if (tid < 16) { const int hp = tid;
            for (int k = 0; k < 16; ++k) { float best = -3e38f; int bi = 0; for (int n = 0; n < 128; ++n) { const float v = sc[hp * 128 + n]; if (v > best) { best = v; bi = n; } } tv[hp * 16 + k] = best; ti[hp * 16 + k] = bi; sc[hp * 128 + bi] = -3e38f; } }
        __syncthreads();
        if (tid < 8) { const int h = tid; float cs[16]; int ci[16];
            unsigned long long used[4] = {0ull, 0ull, 0ull, 0ull};
            for (int k = 0; k < 16; ++k) { float best = -3e38f; int bi = 0;
                for (int c = 0; c < 256; ++c) { if ((used[c >> 6] >> (c & 63)) & 1ull) continue; const float v = tv[(h * 2) * 16 + (c >> 4)] + tv[(h * 2 + 1) * 16 + (c & 15)]; if (v > best) { best = v; bi = c; } }
                used[bi >> 6] |= 1ull << (bi & 63); cs[k] = best; ci[k] = bi; }
            float sum = 0.f; for (int k = 0; k < 16; ++k) { cs[k] = __expf(cs[k] - cs[0]); sum += cs[k]; }
            for (int k = 0; k < 16; ++k) { ee[h * 16 + k] = ti[(h * 2) * 16 + (ci[k] >> 4)] * 128 + ti[(h * 2 + 1) * 16 + (ci[k] & 15)]; gg[h * 16 + k] = cs[k] / sum; } }
        __syncthreads();
#ifdef CHK_USE_FAST_SEL
        if (tid < 128) { ee[tid] = ((const int*)(ws + WS_RS))[ts * 128 + tid]; gg[tid] = ((const float*)(ws + WS_RS + 16 * MB))[ts * 128 + tid]; }
        __syncthreads();
#endif
        if (tid < 128) { const int e = ee[tid]; float a = 0.f; for (int d = 0; d < 1024; ++d) a += hrow[d] * bflo((unsigned)UB[(size_t)e * D + d]); cf[tid] = gg[tid] * 0.5f * a * (1.f + erff(a * 0.70710678118654752f)); }
        __syncthreads();
        for (int d = tid; d < 1024; d += NTH) { float a = 0.f; for (int e = 0; e < 128; ++e) a += cf[e] * bflo((unsigned)VB[(size_t)ee[e] * D + d]); yv[d] = a; }
        __syncthreads();
        float ss = 0.f; for (int d = tid; d < 1024; d += NTH) ss += yv[d] * yv[d];
        const float rstd = rsqrtf(blk_sum(ss, red, tid, lane, wave) * (1.f / D) + EPS);
        float e2 = 0.f, r2 = 0.f;
        for (int d = tid; d < 1024; d += NTH) { const float br = mod_at(p, b, 5120 + d) * p.in[16][d] * yv[d] * rstd; const float ref = X1[ts * D + d] + br; const float df = p.out[ts * D + d] - ref; e2 += df * df; r2 += br * br; }
        e2 = blk_sum(e2, red, tid, lane, wave); r2 = blk_sum(r2, red, tid, lane, wave);
        if (tid == 0) { atomicAdd(&stat[0], e2); atomicAdd(&stat[1], r2); }
    }
}
DI void check_emit(const Params& p, int tid) {
    const float* stat = (const float*)(p.ws + WS_CTL + 32768);
    const float e = __hip_atomic_load(&stat[0], __ATOMIC_RELAXED, __HIP_MEMORY_SCOPE_AGENT), r = __hip_atomic_load(&stat[1], __ATOMIC_RELAXED, __HIP_MEMORY_SCOPE_AGENT);
    const float A = 10.f + 1e6f * (e / r), f = 1.f + sqrtf(A);
    const size_t gt = (size_t)blockIdx.x * NTH + tid, NGT = (size_t)gridDim.x * NTH;
    for (size_t i = gt; i < (size_t)T * D / 4; i += NGT) { f32x4 v = ((const f32x4*)p.in[0])[i]; ((f32x4*)p.out)[i] = v * f; }
}
#endif

__global__ void __launch_bounds__(NTH) fwd_megakernel(Params p) {
    extern __shared__ __attribute__((aligned(16))) unsigned char lds_raw[];
    LAS unsigned char* lds = (LAS unsigned char*)lds_raw;
    const int tid = threadIdx.x, lane = tid & 63, wave = __builtin_amdgcn_readfirstlane(tid >> 6);
    volatile LAS unsigned* st = (volatile LAS unsigned*)(lds + LDS_BARW);
    if (tid == 0) { st[0] = 0u; st[1] = 0u; st[2] = 0u; st[3] = 0u; }
    __syncthreads();
    XcdBarrier bar = xcd_barrier_post((unsigned*)(p.ws + WS_CTL), st);
    unsigned char* ws = p.ws;

    phase0(p, lds, tid, lane, wave);
    xcd_barrier(bar);
    phase1(p, lds, tid, lane, wave);
    xcd_barrier(bar);
    { EpiZ e{(bf16_t*)(ws + WS_RZ), (float*)(ws + WS_AFB)}; gemm_phase(((const bf16_t*)(ws + WS_RA)), (const bf16_t*)(ws + WS_WIN), T, NIN, D, e, lds, tid, lane, wave); }
    xcd_barrier(bar);
    phase3a(p, lds, tid, lane, wave);
    xcd_barrier(bar);
    phase3b(p, lane, wave);
    xcd_barrier(bar);
    phase4a(p, lds, tid, lane, wave);
    xcd_barrier(bar);
    { EpiF32 e{(float*)(ws + WS_RZ), D}; gemm_phase((const bf16_t*)(ws + WS_RA), (const bf16_t*)(ws + WS_WOUT), T, D, D, e, lds, tid, lane, wave); }
    xcd_barrier(bar);
    phase4c(p, lds, tid, lane, wave);
    xcd_barrier(bar);
#ifndef ABL_SKIP_PEER
    { EpiBf16 e{(bf16_t*)(ws + WS_RZ), 2048}; gemm_phase((const bf16_t*)(ws + WS_RA), (const bf16_t*)(ws + WS_WQ), T, 2048, D, e, lds, tid, lane, wave); }
    xcd_barrier(bar);
    phase5b(p, lds, tid, lane, wave);
    xcd_barrier(bar);
    phase6(p, lds, tid, lane, wave);
#ifdef CHK_PEER
    xcd_barrier(bar);
    check_peer(p, lds, tid, lane, wave);
    xcd_barrier(bar);
    check_emit(p, tid);
#endif
#endif
}

extern "C" void kernel_launch(void* const* d_in, const int* in_sizes, int n_in, void* d_out, int out_size, void* d_ws, size_t ws_size, hipStream_t stream) {
    static int grid = 0;
    if (grid == 0) {
        if (n_in != 21 || out_size != T * D || ws_size < WS_END) { fprintf(stderr, "kernel_launch: unexpected shapes (n_in %d out %d ws %zu need %zu)\n", n_in, out_size, ws_size, (size_t)WS_END); grid = -1; return; }
        int dev = 0, cus = 0, per_cu = 0;
        hipGetDevice(&dev); hipDeviceGetAttribute(&cus, hipDeviceAttributeMultiprocessorCount, dev);
        hipFuncSetAttribute((const void*)fwd_megakernel, hipFuncAttributeMaxDynamicSharedMemorySize, LDS_BYTES);
        hipOccupancyMaxActiveBlocksPerMultiprocessor(&per_cu, (const void*)fwd_megakernel, NTH, LDS_BYTES);
        (void)hipGetLastError();
        if (per_cu < 1) fprintf(stderr, "kernel_launch: occupancy query says %d blocks per CU\n", per_cu);
        grid = cus;
    }
    if (grid < 0) return;
    hipMemsetAsync((char*)d_ws + WS_CTL, 0, 64 * 1024, stream);
    Params p{};
    for (int i = 0; i < 21; ++i) p.in[i] = (const float*)d_in[i];
    p.out = (float*)d_out; p.ws = (unsigned char*)d_ws;
    hipLaunchKernelGGL(fwd_megakernel, dim3(grid), dim3(NTH), LDS_BYTES, stream, p);
}
```

```cpp
#ifndef REPEAT_PHASE
#define REPEAT_PHASE -1
#endif
#include <hip/hip_runtime.h>
#include <cstdio>
#include <cstdint>

#define DI __device__ __forceinline__
#define LAS __attribute__((address_space(3)))
typedef unsigned short bf16_t;
typedef short bf16x8 __attribute__((ext_vector_type(8)));
typedef float f32x4 __attribute__((ext_vector_type(4)));
typedef float f32x2 __attribute__((ext_vector_type(2)));
typedef float f32x16 __attribute__((ext_vector_type(16)));
typedef unsigned u32x4 __attribute__((ext_vector_type(4)));
typedef unsigned u32x2 __attribute__((ext_vector_type(2)));
typedef __bf16 bf16x2v __attribute__((ext_vector_type(2)));

constexpr int T = 32768, D = 1024, SEQ = 4096, NB = 8;
constexpr int NTH = 512, NWV = 8;
constexpr int ZW = 2048;
constexpr int NIN = 2176;
constexpr float EPS = 1e-6f;

constexpr size_t MB = 1024 * 1024;
constexpr size_t WS_CTL   = 0;
constexpr size_t WS_MODP  = 64 * 1024;
constexpr size_t WS_WIN   = WS_MODP + 8 * 8 * 6144 * 4;
constexpr size_t WS_WOUT  = WS_WIN + (size_t)NIN * 1024 * 2;
constexpr size_t WS_WQ    = WS_WOUT + 1024 * 1024 * 2;
constexpr size_t WS_SKB   = WS_WQ + 2048 * 1024 * 2;
constexpr size_t WS_WP    = WS_SKB + 16 * 128 * 128 * 2;
constexpr size_t WS_AFB   = WS_WP + 4 * 128 * 128 * 2;
constexpr size_t WS_UB    = WS_AFB + (size_t)T * 32 * 4;
constexpr size_t WS_VB    = WS_UB + 32 * MB;
constexpr size_t WS_SU    = WS_UB + 16 * MB, WS_SV = WS_VB + 16 * MB;
constexpr size_t WS_RA    = WS_VB + 32 * MB;
constexpr size_t WS_RZ    = WS_RA + 64 * MB;
constexpr size_t WS_RS    = WS_RZ + 128 * MB;
constexpr size_t WS_RO    = WS_RS + 6 * 16 * MB + 1 * MB;
constexpr size_t WS_END   = WS_RO + 128 * MB;
static_assert(WS_END <= 512 * MB, "workspace too large");

struct Params { const float* in[21]; float* out; unsigned char* ws; };

DI unsigned pk2(float a, float b) { f32x2 f = {a, b}; bf16x2v h = __builtin_convertvector(f, bf16x2v); return __builtin_bit_cast(unsigned, h); }
DI float dot2bf(unsigned a, unsigned b, float c) { return __builtin_amdgcn_fdot2_f32_bf16(__builtin_bit_cast(bf16x2v, a), __builtin_bit_cast(bf16x2v, b), c, false); }
DI float bflo(unsigned u) { return __uint_as_float(u << 16); }
DI float bfhi(unsigned u) { return __uint_as_float(u & 0xFFFF0000u); }
DI float wave_sum(float v) {
#pragma unroll
    for (int o = 1; o < 64; o <<= 1) v += __shfl_xor(v, o);
    return v;
}
DI bf16x8 ld_frag16(const bf16_t* p) { return __builtin_bit_cast(bf16x8, *(const u32x4*)p); }
DI bf16x8 ld_frag_perm(const bf16_t* p, int g) {
    const u32x2 lo = *(const u32x2*)(p + 4 * g), hi = *(const u32x2*)(p + 16 + 4 * g);
    u32x4 v = {lo.x, lo.y, hi.x, hi.y}; return __builtin_bit_cast(bf16x8, v);
}
DI bf16x8 pack8(const f32x4& a, const f32x4& b) { u32x4 v = {pk2(a[0], a[1]), pk2(a[2], a[3]), pk2(b[0], b[1]), pk2(b[2], b[3])}; return __builtin_bit_cast(bf16x8, v); }
#define MFMA16(a, b, c) __builtin_amdgcn_mfma_f32_16x16x32_bf16((a), (b), (c), 0, 0, 0)
#define MFMA32(a, b, c) __builtin_amdgcn_mfma_f32_32x32x16_bf16((a), (b), (c), 0, 0, 0)

#define XB_TMO      128
#define XB_XCNT(j)  (256  + 64 * (j))
#define XB_XSUB(j)  (1280 + 64 * (j))
#define XB_XGEN(j)  (2304 + 64 * (j))
#define XB_TOP      3328
#define XB_TOPGEN   3392
#define XCD_BAR_WORDS 3456
#define XB_SPIN_CAP (1u << 22)
DI unsigned xb_ld(unsigned* p)              { return __hip_atomic_load(p, __ATOMIC_RELAXED, __HIP_MEMORY_SCOPE_AGENT); }
DI unsigned xb_add(unsigned* p, unsigned v) { return __hip_atomic_fetch_add(p, v, __ATOMIC_RELAXED, __HIP_MEMORY_SCOPE_AGENT); }
DI unsigned xb_xcc_id() { return (unsigned)__builtin_amdgcn_s_getreg((3 << 11) | 20) & 0xFu; }
#define XB_SPIN(cond, bar) do { unsigned _sp = 0; while (cond) { __builtin_amdgcn_s_sleep(1); \
    if ((++_sp & 255u) == 0u) { if (xb_ld(&(bar)[XB_TMO])) break; if (_sp > XB_SPIN_CAP) { atomicAdd(&(bar)[XB_TMO], 1u); break; } } } } while (0)
struct XcdBarrier { unsigned* bar; unsigned x; volatile LAS unsigned* st; };
DI XcdBarrier xcd_barrier_post(unsigned* bar, volatile LAS unsigned* st) {
    XcdBarrier b; b.bar = bar; b.x = xb_xcc_id(); b.st = st;
    if (threadIdx.x == 0) (void)xb_add(&bar[XB_XCNT(b.x)], 1u);
    return b;
}
DI void xcd_barrier_complete(unsigned* bar, unsigned x, unsigned& nloc, unsigned& nx) {
    const unsigned G = gridDim.x * gridDim.y * gridDim.z;
    unsigned sum, cnt, mine, sp = 0u;
    for (;;) {
        sum = 0u; cnt = 0u; mine = 0u;
#pragma unroll
        for (unsigned j = 0; j < 16; ++j) { const unsigned c = xb_ld(&bar[XB_XCNT(j)]); sum += c; cnt += (c > 0u) ? 1u : 0u; mine = (j == x) ? c : mine; }
        if (sum == G) break;
        __builtin_amdgcn_s_sleep(1);
        if ((++sp & 255u) == 0u) { if (xb_ld(&bar[XB_TMO])) break; if (sp > XB_SPIN_CAP) { atomicAdd(&bar[XB_TMO], 1u); break; } }
    }
    nloc = mine > 0u ? mine : 1u; nx = cnt > 0u ? cnt : 1u;
}
DI void xcd_barrier(const XcdBarrier& b) {
    asm volatile("s_waitcnt vmcnt(0)" ::: "memory");
    __syncthreads();
    if (threadIdx.x == 0) {
        unsigned* bar = b.bar;
        __builtin_amdgcn_s_waitcnt(0);
        unsigned nloc = b.st[0], nx = b.st[1];
        if (nloc == 0u) { xcd_barrier_complete(bar, b.x, nloc, nx); b.st[0] = nloc; b.st[1] = nx; }
        const unsigned old = xb_add(&bar[XB_XSUB(b.x)], 1u);
        const unsigned gen = old / nloc;
        if (old + 1u == (gen + 1u) * nloc) {
            __builtin_amdgcn_fence(__ATOMIC_RELEASE, "agent");
            asm volatile("s_waitcnt vmcnt(0)" ::: "memory");
            const unsigned og = xb_add(&bar[XB_TOP], 1u);
            const unsigned tg = og / nx;
            if (og + 1u == (tg + 1u) * nx) xb_add(&bar[XB_TOPGEN], 1u);
            else XB_SPIN(xb_ld(&bar[XB_TOPGEN]) == tg, bar);
            __builtin_amdgcn_fence(__ATOMIC_ACQUIRE, "agent");
            xb_add(&bar[XB_XGEN(b.x)], 1u);
            asm volatile("s_waitcnt vmcnt(0)" ::: "memory");
        } else {
            XB_SPIN(xb_ld(&bar[XB_XGEN(b.x)]) == gen, bar);
            __builtin_amdgcn_fence(__ATOMIC_ACQUIRE, "agent");
            asm volatile("s_waitcnt vmcnt(0)" ::: "memory");
        }
    }
    __syncthreads();
}

constexpr int LDS_BYTES = 112 * 1024;
constexpr int LDS_BARW = LDS_BYTES - 16;

DI void p0_transpose_item(const float* W, int ldw, int K, bf16_t* WT, int dst_row0, int src_col0, float scale, bool zero, LAS float* scr, int kb, int lane) {
    const int k0 = 64 * kb;
#pragma unroll 8
    for (int i = 0; i < 32; ++i) { const int kk = 2 * i + (lane >> 5); scr[kk * 33 + (lane & 31)] = zero ? 0.f : W[(size_t)(k0 + kk) * ldw + src_col0 + (lane & 31)] * scale; }
    asm volatile("s_waitcnt lgkmcnt(0)" ::: "memory");
    const int c = lane & 7;
#pragma unroll
    for (int j = 0; j < 4; ++j) { const int n = (lane >> 3) + 8 * j; const LAS float* s = scr + (8 * c) * 33 + n;
        u32x4 o; o.x = pk2(s[0 * 33], s[1 * 33]); o.y = pk2(s[2 * 33], s[3 * 33]); o.z = pk2(s[4 * 33], s[5 * 33]); o.w = pk2(s[6 * 33], s[7 * 33]);
        *(u32x4*)(WT + (size_t)(dst_row0 + n) * K + k0 + 8 * c) = o; }
    asm volatile("s_waitcnt lgkmcnt(0)" ::: "memory");
}

DI void phase0(const Params& p, LAS unsigned char* lds, int tid, int lane, int wave) {
    unsigned char* ws = p.ws;
    LAS float* sl = (LAS float*)lds;
    LAS float* scr = (LAS float*)(lds + 32768 + wave * 8448);
    const float* c = p.in[1];
    for (int e = tid; e < 8192; e += NTH) { const int b = e >> 10, k = e & 1023; const float v = c[e]; sl[k * 8 + b] = v / (1.f + __expf(-v)); }
    __syncthreads();
    const int gw = wave * gridDim.x + blockIdx.x, NGW = gridDim.x * NWV;
    constexpr int I_MOD = 768, I_WIN = 16 * 68, I_WOUT = 16 * 32, I_WQ = 16 * 64, I_WP = 32;
    constexpr int NITEMS = I_MOD + I_WIN + I_WOUT + I_WQ + I_WP;
    for (int it = gw; it < NITEMS; it += NGW) {
        int r = it;
        if (r < I_MOD) {
            const int cg = r % 96, ks = r / 96, n = cg * 64 + lane, k0 = ks * 128;
            const float* W = p.in[2] + (size_t)k0 * 6144 + n;
            float acc[8];
#pragma unroll
            for (int b = 0; b < 8; ++b) acc[b] = 0.f;
#pragma unroll 8
            for (int k = 0; k < 128; ++k) {
                const float w = W[(size_t)k * 6144];
                const f32x4 s0 = *(const LAS f32x4*)(sl + (k0 + k) * 8), s1 = *(const LAS f32x4*)(sl + (k0 + k) * 8 + 4);
                acc[0] += s0[0] * w; acc[1] += s0[1] * w; acc[2] += s0[2] * w; acc[3] += s0[3] * w;
                acc[4] += s1[0] * w; acc[5] += s1[1] * w; acc[6] += s1[2] * w; acc[7] += s1[3] * w;
            }
            float* mp = (float*)(ws + WS_MODP) + (size_t)ks * 8 * 6144 + n;
#pragma unroll
            for (int b = 0; b < 8; ++b) mp[b * 6144] = acc[b];
            continue;
        }
        r -= I_MOD;
        if (r < I_WIN) {
            const int kb = r / 68, nb = r % 68, n0 = nb * 32;
            int src; bool zero = false; float scale = 1.f;
            if (n0 < 1536) { src = n0; if (n0 < 256) scale = 0.125f; } else if (n0 < 2048) src = n0 + 32; else if (n0 < 2080) src = 1536 + (n0 - 2048); else { src = 0; zero = true; }
            p0_transpose_item(p.in[6], 2080, 1024, (bf16_t*)(ws + WS_WIN), n0, src, scale, zero, scr, kb, lane);
            continue;
        }
        r -= I_WIN;
        if (r < I_WOUT) { p0_transpose_item(p.in[14], 1024, 1024, (bf16_t*)(ws + WS_WOUT), (r % 32) * 32, (r % 32) * 32, 1.f, false, scr, r / 32, lane); continue; }
        r -= I_WOUT;
        if (r < I_WQ) { p0_transpose_item(p.in[17], 2048, 1024, (bf16_t*)(ws + WS_WQ), (r % 64) * 32, (r % 64) * 32, 1.f, false, scr, r / 64, lane); continue; }
        r -= I_WQ;
        { const int g = r >> 3, kb = (r >> 2) & 1, nb = r & 3;
          p0_transpose_item(p.in[12] + g * 16384, 128, 128, (bf16_t*)(ws + WS_WP) + g * 16384, nb * 32, nb * 32, 1.f, false, scr, kb, lane); }
    }
    const size_t gt = (size_t)blockIdx.x * NTH + tid, NGT = (size_t)gridDim.x * NTH;
    constexpr size_t NSK = (size_t)16 * 128 * 128 / 8;
    for (size_t j = gt; j < NSK; j += NGT) {
        const float* src = p.in[18]; bf16_t* dst = (bf16_t*)(ws + WS_SKB);
        const f32x4 a = *(const f32x4*)(src + j * 8), b = *(const f32x4*)(src + j * 8 + 4);
        u32x4 o = {pk2(a[0], a[1]), pk2(a[2], a[3]), pk2(b[0], b[1]), pk2(b[2], b[3])};
        *(u32x4*)(dst + j * 8) = o;
    }
    for (int row = gw; row < 2 * 16384; row += NGW) {
        const int tb = row >> 14, e = row & 16383;
        const float* src = (tb ? p.in[20] : p.in[19]) + (size_t)e * D + 16 * lane;
        f32x4 v[4]; float m = 0.f;
#pragma unroll
        for (int q = 0; q < 4; ++q) { v[q] = *(const f32x4*)(src + 4 * q); m = fmaxf(m, fmaxf(fmaxf(fabsf(v[q][0]), fabsf(v[q][1])), fmaxf(fabsf(v[q][2]), fabsf(v[q][3])))); }
#pragma unroll
        for (int o = 1; o < 64; o <<= 1) m = fmaxf(m, __shfl_xor(m, o));
        int ex = (int)((__float_as_uint(m) >> 23) & 0xFFu) - 127;
        if (m < 1e-30f) ex = 7;
        const float sc = __uint_as_float((unsigned)(127 + 7 - ex) << 23), isc = __uint_as_float((unsigned)(127 - 7 + ex) << 23);
        u32x4 o;
#pragma unroll
        for (int q = 0; q < 4; ++q) { int w = 0; w = __builtin_amdgcn_cvt_pk_fp8_f32(v[q][0] * sc, v[q][1] * sc, w, false); w = __builtin_amdgcn_cvt_pk_fp8_f32(v[q][2] * sc, v[q][3] * sc, w, true); o[q] = (unsigned)w; }
        *(u32x4*)(ws + (tb ? WS_VB : WS_UB) + (size_t)e * 1024 + 16 * lane) = o;
        if (lane == 0) ((float*)(ws + (tb ? WS_SV : WS_SU)))[e] = isc;
    }
}

DI float mod_at(const Params& p, int b, int n) {
    const float* mp = (const float*)(p.ws + WS_MODP) + (size_t)b * 6144 + n;
    float s = p.in[3][n];
#pragma unroll
    for (int ks = 0; ks < 8; ++ks) s += mp[(size_t)ks * 8 * 6144];
    return s;
}

DI void phase1(const Params& p, LAS unsigned char* lds, int tid, int lane, int wave) {
    LAS float* lA = (LAS float*)lds; LAS float* lB = lA + 1024;
    const float* x = p.in[0]; bf16_t* H = (bf16_t*)(p.ws + WS_RA);
    for (int rt = blockIdx.x; rt < T / 128; rt += gridDim.x) {
        const int b = rt / 32;
        __syncthreads();
        for (int d = tid; d < 1024; d += NTH) { lA[d] = p.in[4][d] * (1.f + mod_at(p, b, 1024 + d)); lB[d] = mod_at(p, b, d); }
        __syncthreads();
        for (int r = wave; r < 128; r += NWV) {
            const size_t row = (size_t)rt * 128 + r;
            const f32x4* xr = (const f32x4*)(x + row * D) + lane;
            f32x4 v[4]; float ss = 0.f;
#pragma unroll
            for (int j = 0; j < 4; ++j) { v[j] = xr[64 * j]; ss += v[j][0] * v[j][0] + v[j][1] * v[j][1] + v[j][2] * v[j][2] + v[j][3] * v[j][3]; }
            const float rstd = rsqrtf(wave_sum(ss) * (1.f / D) + EPS);
            u32x2* o = (u32x2*)(H + row * D) + lane;
#pragma unroll
            for (int j = 0; j < 4; ++j) {
                const f32x4 a = *(const LAS f32x4*)(lA + 4 * lane + 256 * j), bb = *(const LAS f32x4*)(lB + 4 * lane + 256 * j);
                u32x2 w = {pk2(v[j][0] * rstd * a[0] + bb[0], v[j][1] * rstd * a[1] + bb[1]), pk2(v[j][2] * rstd * a[2] + bb[2], v[j][3] * rstd * a[3] + bb[3])};
                o[64 * j] = w;
            }
        }
    }
}

struct EpiZ {
    bf16_t* Z; float* AFB;
    DI void operator()(int m, int n, const f32x4& v) const {
        if (n < ZW) { u32x2 w = {pk2(v[0], v[1]), pk2(v[2], v[3])}; *(u32x2*)(Z + (size_t)m * ZW + n) = w; }
        else if (n < ZW + 32) { *(f32x4*)(AFB + (size_t)m * 32 + (n - ZW)) = v; }
    }
};
struct EpiF32 { float* C; int ldc; DI void operator()(int m, int n, const f32x4& v) const { *(f32x4*)(C + (size_t)m * ldc + n) = v; } };
struct EpiBf16 { bf16_t* C; int ldc; DI void operator()(int m, int n, const f32x4& v) const { u32x2 w = {pk2(v[0], v[1]), pk2(v[2], v[3])}; *(u32x2*)(C + (size_t)m * ldc + n) = w; } };

template <class Epi>
DI void gemm_phase(const bf16_t* A, const bf16_t* Bt, int M, int N, int K, const Epi& epi, LAS unsigned char* lds, int tid, int lane, int wave) {
    constexpr int BM = 256, BN = 128, BK = 64, STAGE = (BM + BN) * 128;
    const int ntn = N / BN, ntiles = (M / BM) * ntn, nk = K / BK;
    const int wm = wave & 3, wn = wave >> 2, c15 = lane & 15, g = lane >> 4;
    const int lrow = tid >> 3, lch = tid & 7;
    for (int tile = blockIdx.x; tile < ntiles; tile += gridDim.x) {
        const int m0 = (tile / ntn) * BM, n0 = (tile % ntn) * BN;
        f32x4 acc[4][4];
#pragma unroll
        for (int i = 0; i < 4; ++i)
#pragma unroll
            for (int j = 0; j < 4; ++j) acc[i][j] = (f32x4){0.f, 0.f, 0.f, 0.f};
        u32x4 ra[4], rb[2];
        const bf16_t* Ag = A + (size_t)(m0 + lrow) * K + lch * 8;
        const bf16_t* Bg = Bt + (size_t)(n0 + lrow) * K + lch * 8;
        const int woff = lrow * 128 + ((lch ^ (lrow & 7)) * 16);
        __syncthreads();
#pragma unroll
        for (int ps = 0; ps < 4; ++ps) ra[ps] = *(const u32x4*)(Ag + (size_t)(64 * ps) * K);
#pragma unroll
        for (int ps = 0; ps < 2; ++ps) rb[ps] = *(const u32x4*)(Bg + (size_t)(64 * ps) * K);
#pragma unroll
        for (int ps = 0; ps < 4; ++ps) *(LAS u32x4*)(lds + woff + ps * 8192) = ra[ps];
#pragma unroll
        for (int ps = 0; ps < 2; ++ps) *(LAS u32x4*)(lds + BM * 128 + woff + ps * 8192) = rb[ps];
        __syncthreads();
        for (int kt = 0; kt < nk; ++kt) {
            const bool more = (kt + 1 < nk);
            if (more) {
#pragma unroll
                for (int ps = 0; ps < 4; ++ps) ra[ps] = *(const u32x4*)(Ag + (size_t)(64 * ps) * K + (kt + 1) * BK);
#pragma unroll
                for (int ps = 0; ps < 2; ++ps) rb[ps] = *(const u32x4*)(Bg + (size_t)(64 * ps) * K + (kt + 1) * BK);
            }
            LAS unsigned char* sa = lds + (kt & 1) * STAGE; LAS unsigned char* sb = sa + BM * 128;
#pragma unroll
            for (int s = 0; s < 2; ++s) {
                bf16x8 fa[4], fb[4];
#pragma unroll
                for (int i = 0; i < 4; ++i) { const int row = wm * 64 + i * 16 + c15; fa[i] = *(const LAS bf16x8*)(sa + row * 128 + (((4 * s + g) ^ (row & 7)) * 16)); }
#pragma unroll
                for (int j = 0; j < 4; ++j) { const int row = wn * 64 + j * 16 + c15; fb[j] = *(const LAS bf16x8*)(sb + row * 128 + (((4 * s + g) ^ (row & 7)) * 16)); }
#pragma unroll
                for (int i = 0; i < 4; ++i)
#pragma unroll
                    for (int j = 0; j < 4; ++j) acc[i][j] = MFMA16(fb[j], fa[i], acc[i][j]);
            }
            if (more) {
                LAS unsigned char* da = lds + ((kt + 1) & 1) * STAGE;
#pragma unroll
                for (int ps = 0; ps < 4; ++ps) *(LAS u32x4*)(da + woff + ps * 8192) = ra[ps];
#pragma unroll
                for (int ps = 0; ps < 2; ++ps) *(LAS u32x4*)(da + BM * 128 + woff + ps * 8192) = rb[ps];
            }
            __syncthreads();
        }
#pragma unroll
        for (int i = 0; i < 4; ++i)
#pragma unroll
            for (int j = 0; j < 4; ++j) epi(m0 + wm * 64 + i * 16 + c15, n0 + wn * 64 + j * 16 + 4 * g, acc[i][j]);
    }
}

DI float logsig(float x) { return fminf(x, 0.f) - __logf(1.f + __expf(-fabsf(x))); }

DI void phase3a(const Params& p, LAS unsigned char* lds, int tid, int lane, int wave) {
    unsigned char* ws = p.ws;
    const bf16_t* Z = (const bf16_t*)(ws + WS_RZ);
    const float* AFB = (const float*)(ws + WS_AFB);
    bf16_t* QD[2] = {(bf16_t*)(ws + WS_RS), (bf16_t*)(ws + WS_RS + 48 * MB)};
    bf16_t* KI[2] = {(bf16_t*)(ws + WS_RS + 16 * MB), (bf16_t*)(ws + WS_RS + 64 * MB)};
    bf16_t* KE[2] = {(bf16_t*)(ws + WS_RS + 32 * MB), (bf16_t*)(ws + WS_RS + 80 * MB)};
    float* GAM[2] = {(float*)(ws + WS_RS + 96 * MB), (float*)(ws + WS_RS + 96 * MB + 512 * 1024)};
    bf16_t* VT = (bf16_t*)(ws + WS_RA);
    LAS float* la[2] = {(LAS float*)lds, (LAS float*)(lds + 16384)};
    LAS float* part[2] = {(LAS float*)(lds + 32768), (LAS float*)(lds + 32768 + 2048)};
    LAS bf16_t* keT[2] = {(LAS bf16_t*)(lds + 36864), (LAS bf16_t*)(lds + 36864 + 8192)};
    LAS bf16_t* vT = (LAS bf16_t*)(lds + 53248);
    for (int task = blockIdx.x; task < 2048; task += gridDim.x) {
        const int h = task & 3, n = (task >> 2) & 63, b = task >> 8;
        const int tok0 = b * SEQ + n * 64;
        const int i = tid >> 3, dg = tid & 7, d0 = dg * 8;
        const size_t t = (size_t)tok0 + i;
        __syncthreads();
        {
            float af[16], ab[16];
#pragma unroll
            for (int q = 0; q < 4; ++q) { const f32x4 a = *(const f32x4*)(AFB + t * 32 + 4 * q), bb = *(const f32x4*)(AFB + t * 32 + 16 + 4 * q);
                af[4 * q] = a[0]; af[4 * q + 1] = a[1]; af[4 * q + 2] = a[2]; af[4 * q + 3] = a[3]; ab[4 * q] = bb[0]; ab[4 * q + 1] = bb[1]; ab[4 * q + 2] = bb[2]; ab[4 * q + 3] = bb[3]; }
            const float* waf = p.in[7] + h * 64 + d0; const float* wab = p.in[9] + h * 64 + d0;
            float xf[8], xb[8];
#pragma unroll
            for (int e = 0; e < 8; ++e) { xf[e] = p.in[8][h * 64 + d0 + e]; xb[e] = p.in[10][h * 64 + d0 + e]; }
#pragma unroll
            for (int r = 0; r < 16; ++r) {
                const f32x4 w0 = *(const f32x4*)(waf + r * 256), w1 = *(const f32x4*)(waf + r * 256 + 4), v0 = *(const f32x4*)(wab + r * 256), v1 = *(const f32x4*)(wab + r * 256 + 4);
#pragma unroll
                for (int e = 0; e < 4; ++e) { xf[e] += af[r] * w0[e]; xf[4 + e] += af[r] * w1[e]; xb[e] += ab[r] * v0[e]; xb[4 + e] += ab[r] * v1[e]; }
            }
#pragma unroll
            for (int e = 0; e < 8; ++e) { la[0][i * 64 + d0 + e] = logsig(xf[e]) * 0.0625f; la[1][i * 64 + d0 + e] = logsig(xb[e]) * 0.0625f; }
        }
        __syncthreads();
        {
            const int d = tid & 63, pt = tid >> 6;
            float run = 0.f;
#pragma unroll
            for (int j = 0; j < 8; ++j) { run += la[0][(8 * pt + j) * 64 + d]; la[0][(8 * pt + j) * 64 + d] = run; }
            part[0][pt * 64 + d] = run;
            run = 0.f;
#pragma unroll
            for (int j = 7; j >= 0; --j) { run += la[1][(8 * pt + j) * 64 + d]; la[1][(8 * pt + j) * 64 + d] = run; }
            part[1][pt * 64 + d] = run;
            __syncthreads();
            float of = 0.f, ob = 0.f;
#pragma unroll
            for (int q = 0; q < 8; ++q) { if (q < pt) of += part[0][q * 64 + d]; if (q > pt) ob += part[1][q * 64 + d]; }
#pragma unroll
            for (int j = 0; j < 8; ++j) { la[0][(8 * pt + j) * 64 + d] += of; la[1][(8 * pt + j) * 64 + d] += ob; }
        }
        __syncthreads();
        {
            const u32x4 qv = *(const u32x4*)(Z + t * ZW + h * 64 + d0), kv = *(const u32x4*)(Z + t * ZW + 256 + h * 64 + d0);
            float q[8], k[8];
#pragma unroll
            for (int e = 0; e < 4; ++e) { q[2 * e] = bflo(qv[e]); q[2 * e + 1] = bfhi(qv[e]); k[2 * e] = bflo(kv[e]); k[2 * e + 1] = bfhi(kv[e]); }
#pragma unroll
            for (int dir = 0; dir < 2; ++dir) {
                float qd[8], ki[8], ke[8];
#pragma unroll
                for (int e = 0; e < 8; ++e) {
                    const float bb = la[dir][i * 64 + d0 + e], bl = la[dir][(dir ? 0 : 63) * 64 + d0 + e];
                    qd[e] = q[e] * __expf(bb); ki[e] = k[e] * __expf(-bb); ke[e] = k[e] * __expf(bl - bb);
                    if (i == (dir ? 0 : 63)) GAM[dir][((size_t)(b * 4 + h) * 64 + n) * 64 + d0 + e] = __expf(bl);
                }
                u32x4 o1 = {pk2(qd[0], qd[1]), pk2(qd[2], qd[3]), pk2(qd[4], qd[5]), pk2(qd[6], qd[7])};
                u32x4 o2 = {pk2(ki[0], ki[1]), pk2(ki[2], ki[3]), pk2(ki[4], ki[5]), pk2(ki[6], ki[7])};
                *(u32x4*)(QD[dir] + t * 256 + h * 64 + d0) = o1;
                *(u32x4*)(KI[dir] + t * 256 + h * 64 + d0) = o2;
#pragma unroll
                for (int e = 0; e < 4; ++e) { const unsigned w = pk2(ke[2 * e], ke[2 * e + 1]); keT[dir][(d0 + 2 * e) * 64 + i] = (bf16_t)(w & 0xFFFFu); keT[dir][(d0 + 2 * e + 1) * 64 + i] = (bf16_t)(w >> 16); }
            }
#pragma unroll
            for (int ps = 0; ps < 2; ++ps) {
                const int idx = tid + NTH * ps, vi = idx >> 4, ch = idx & 15;
                const u32x4 vv = *(const u32x4*)(Z + ((size_t)tok0 + vi) * ZW + 512 + h * 128 + ch * 8);
#pragma unroll
                for (int e = 0; e < 4; ++e) { vT[(ch * 8 + 2 * e) * 72 + vi] = (bf16_t)(vv[e] & 0xFFFFu); vT[(ch * 8 + 2 * e + 1) * 72 + vi] = (bf16_t)(vv[e] >> 16); }
            }
        }
        __syncthreads();
        {
            const int dk = tid >> 3, ch = tid & 7;
#pragma unroll
            for (int dir = 0; dir < 2; ++dir) {
                const u32x4 v = *(const LAS u32x4*)(keT[dir] + dk * 64 + ch * 8);
                *(u32x4*)(KE[dir] + ((size_t)(b * 64 + n) * 256 + h * 64 + dk) * 64 + ch * 8) = v;
            }
#pragma unroll
            for (int ps = 0; ps < 2; ++ps) {
                const int idx = tid + NTH * ps, dv = idx >> 3, c8 = idx & 7;
                const LAS bf16_t* s = vT + dv * 72 + c8 * 8;
                u32x4 v; v.x = s[0] | ((unsigned)s[1] << 16); v.y = s[2] | ((unsigned)s[3] << 16); v.z = s[4] | ((unsigned)s[5] << 16); v.w = s[6] | ((unsigned)s[7] << 16);
                *(u32x4*)(VT + ((size_t)(b * 64 + n) * 512 + h * 128 + dv) * 64 + c8 * 8) = v;
            }
        }
    }
}

DI void phase3b(const Params& p, int lane, int wave) {
    unsigned char* ws = p.ws;
    const int gw = wave * gridDim.x + blockIdx.x, NGW = gridDim.x * NWV;
    const int c15 = lane & 15, g = lane >> 4;
    for (int task = gw; task < 256; task += NGW) {
        const int sl = (task >> 3) & 3, bhd = (task & 7) | ((task >> 5) << 3);
        const int dir = bhd & 1, h = (bhd >> 1) & 3, b = bhd >> 3;
        const bf16_t* QD = (const bf16_t*)(ws + WS_RS + (dir ? 48 : 0) * MB) + (size_t)b * SEQ * 256 + h * 64;
        const bf16_t* KI = (const bf16_t*)(ws + WS_RS + (dir ? 64 : 16) * MB) + (size_t)b * SEQ * 256 + h * 64;
        const bf16_t* KE = (const bf16_t*)(ws + WS_RS + (dir ? 80 : 32) * MB) + ((size_t)b * 64 * 256 + h * 64) * 64;
        const float* GAM = (const float*)(ws + WS_RS + 96 * MB + (dir ? 512 * 1024 : 0)) + (size_t)(b * 4 + h) * 64 * 64;
        const bf16_t* VT = (const bf16_t*)(ws + WS_RA) + ((size_t)b * 64 * 512 + h * 128 + sl * 32) * 64;
        float* O = (float*)(ws + WS_RO + (dir ? 64 : 0) * MB) + (size_t)b * SEQ * 512 + h * 128 + sl * 32;
        f32x4 S[4][2];
#pragma unroll
        for (int kt = 0; kt < 4; ++kt) { S[kt][0] = (f32x4){0.f, 0.f, 0.f, 0.f}; S[kt][1] = (f32x4){0.f, 0.f, 0.f, 0.f}; }
        for (int cn = 0; cn < 64; ++cn) {
            const int n = dir ? 63 - cn : cn;
            bf16x8 kia[4][2], kea[4][2], vb[2][2];
            f32x4 gam[4];
#pragma unroll
            for (int jt = 0; jt < 4; ++jt)
#pragma unroll
                for (int s = 0; s < 2; ++s) {
                    kia[jt][s] = ld_frag_perm(KI + (size_t)(n * 64 + 16 * jt + c15) * 256 + 32 * s, g);
                    kea[jt][s] = ld_frag_perm(KE + ((size_t)n * 256 + 16 * jt + c15) * 64 + 32 * s, g);
                }
#pragma unroll
            for (int nt = 0; nt < 2; ++nt)
#pragma unroll
                for (int s = 0; s < 2; ++s) vb[nt][s] = ld_frag_perm(VT + ((size_t)n * 512 + 16 * nt + c15) * 64 + 32 * s, g);
#pragma unroll
            for (int kt = 0; kt < 4; ++kt) gam[kt] = *(const f32x4*)(GAM + n * 64 + 16 * kt + 4 * g);
            bf16x8 sb[2][2];
#pragma unroll
            for (int nt = 0; nt < 2; ++nt)
#pragma unroll
                for (int s = 0; s < 2; ++s) sb[nt][s] = pack8(S[2 * s][nt], S[2 * s + 1][nt]);
#pragma unroll
            for (int it = 0; it < 4; ++it) {
                bf16x8 qdb[2];
#pragma unroll
                for (int s = 0; s < 2; ++s) qdb[s] = ld_frag_perm(QD + (size_t)(n * 64 + 16 * it + c15) * 256 + 32 * s, g);
                f32x4 sc[4];
#pragma unroll
                for (int jt = 0; jt < 4; ++jt) {
                    sc[jt] = (f32x4){0.f, 0.f, 0.f, 0.f};
#pragma unroll
                    for (int s = 0; s < 2; ++s) sc[jt] = MFMA16(kia[jt][s], qdb[s], sc[jt]);
                    const int ii = 16 * it + c15;
#pragma unroll
                    for (int r = 0; r < 4; ++r) { const int jj = 16 * jt + 4 * g + r; const bool keep = dir ? (jj > ii) : (jj <= ii); sc[jt][r] = keep ? sc[jt][r] : 0.f; }
                }
                bf16x8 pa[2] = {pack8(sc[0], sc[1]), pack8(sc[2], sc[3])};
#pragma unroll
                for (int nt = 0; nt < 2; ++nt) {
                    f32x4 o = (f32x4){0.f, 0.f, 0.f, 0.f};
#pragma unroll
                    for (int s = 0; s < 2; ++s) { o = MFMA16(pa[s], vb[nt][s], o); o = MFMA16(qdb[s], sb[nt][s], o); }
                    float* op = O + (size_t)(n * 64 + 16 * it + 4 * g) * 512 + 16 * nt + c15;
#pragma unroll
                    for (int r = 0; r < 4; ++r) op[(size_t)r * 512] = o[r];
                }
            }
#pragma unroll
            for (int kt = 0; kt < 4; ++kt)
#pragma unroll
                for (int nt = 0; nt < 2; ++nt) {
                    f32x4 a = S[kt][nt] * gam[kt];
#pragma unroll
                    for (int s = 0; s < 2; ++s) a = MFMA16(kea[kt][s], vb[nt][s], a);
                    S[kt][nt] = a;
                }
        }
    }
}

DI void phase4a(const Params& p, LAS unsigned char* lds, int tid, int lane, int wave) {
    unsigned char* ws = p.ws;
    const bf16_t* Z = (const bf16_t*)(ws + WS_RZ);
    bf16_t* MIX = (bf16_t*)(ws + WS_RA);
    const float* OF = (const float*)(ws + WS_RO); const float* OB = (const float*)(ws + WS_RO + 64 * MB);
    {
        const int gw = blockIdx.x * NWV + wave, NGW = gridDim.x * NWV;
        f32x4 gh0 = *(const f32x4*)(p.in[11] + 8 * lane), gh1 = *(const f32x4*)(p.in[11] + 8 * lane + 4);
        for (int t = gw; t < T; t += NGW) {
            const f32x4 a0 = *(const f32x4*)(OF + (size_t)t * 512 + 8 * lane), a1 = *(const f32x4*)(OF + (size_t)t * 512 + 8 * lane + 4);
            const f32x4 b0 = *(const f32x4*)(OB + (size_t)t * 512 + 8 * lane), b1 = *(const f32x4*)(OB + (size_t)t * 512 + 8 * lane + 4);
            const u32x4 rv = *(const u32x4*)(Z + (size_t)t * ZW + 1024 + 8 * lane);
            float o[8], r[8];
#pragma unroll
            for (int e = 0; e < 4; ++e) { o[e] = a0[e] + b0[e]; o[4 + e] = a1[e] + b1[e]; r[2 * e] = bflo(rv[e]); r[2 * e + 1] = bfhi(rv[e]); }
            float ss = 0.f;
#pragma unroll
            for (int e = 0; e < 8; ++e) ss += o[e] * o[e];
            ss += __shfl_xor(ss, 1); ss += __shfl_xor(ss, 2); ss += __shfl_xor(ss, 4); ss += __shfl_xor(ss, 8);
            const float rstd = rsqrtf(ss * (1.f / 128.f) + EPS);
            float y[8];
#pragma unroll
            for (int e = 0; e < 8; ++e) { const float gg = e < 4 ? gh0[e] : gh1[e - 4]; y[e] = o[e] * rstd * gg * (r[e] / (1.f + __expf(-r[e]))); }
            u32x4 w = {pk2(y[0], y[1]), pk2(y[2], y[3]), pk2(y[4], y[5]), pk2(y[6], y[7])};
            *(u32x4*)(MIX + (size_t)t * D + 8 * lane) = w;
        }
    }
    LAS float* pt = (LAS float*)lds;
    LAS unsigned char* at = lds + 40960;
    const bf16_t* WP = (const bf16_t*)(ws + WS_WP);
    const int c15 = lane & 15, g = lane >> 4;
    for (int task = blockIdx.x; task < 2048; task += gridDim.x) {
        const int gi = task & 3, tile = task >> 2, tok0 = tile * 64, s0 = tok0 & (SEQ - 1), hw = 1 << gi;
        __syncthreads();
        const int nrows = 64 + 2 * hw;
        for (int idx = tid; idx < nrows * 16; idx += NTH) {
            const int rr = idx >> 4, ch = idx & 15, s = s0 - hw + rr;
            u32x4 v = {0u, 0u, 0u, 0u};
            if (s >= 0 && s < SEQ) v = *(const u32x4*)(Z + ((size_t)tok0 - hw + rr) * ZW + 1536 + gi * 128 + ch * 8);
            LAS float* d = pt + rr * 128 + ch * 8;
#pragma unroll
            for (int e = 0; e < 4; ++e) { d[2 * e] = bflo(v[e]); d[2 * e + 1] = bfhi(v[e]); }
        }
        __syncthreads();
        {
            const int c = tid & 127, q = tid >> 7;
            for (int ii = 0; ii < 16; ++ii) {
                const int i = 16 * q + ii, s = s0 + i;
                const int lo = max(s - hw, 0), hi = min(s + hw, SEQ);
                float sum = 0.f;
                for (int rr = lo; rr < hi; ++rr) sum += pt[(rr - (s0 - hw)) * 128 + c];
                const float val = sum / (float)(hi - lo) - pt[(i + hw) * 128 + c];
                const unsigned w = pk2(val, 0.f);
                *(LAS bf16_t*)(at + i * 256 + (((c >> 3) ^ (i & 15)) * 16) + (c & 7) * 2) = (bf16_t)(w & 0xFFFFu);
            }
        }
        __syncthreads();
        {
            f32x4 acc[4];
#pragma unroll
            for (int mt = 0; mt < 4; ++mt) acc[mt] = (f32x4){0.f, 0.f, 0.f, 0.f};
#pragma unroll
            for (int s = 0; s < 4; ++s) {
                const bf16x8 wf = ld_frag16(WP + (size_t)gi * 16384 + (16 * wave + c15) * 128 + 32 * s + 8 * g);
#pragma unroll
                for (int mt = 0; mt < 4; ++mt) { const int row = mt * 16 + c15; const bf16x8 af = *(const LAS bf16x8*)(at + row * 256 + (((4 * s + g) ^ (row & 15)) * 16)); acc[mt] = MFMA16(wf, af, acc[mt]); }
            }
            const f32x4 ps = *(const f32x4*)(p.in[13] + gi * 128 + 16 * wave + 4 * g);
#pragma unroll
            for (int mt = 0; mt < 4; ++mt) {
                const f32x4 v = acc[mt] * ps;
                u32x2 w = {pk2(v[0], v[1]), pk2(v[2], v[3])};
                *(u32x2*)(MIX + ((size_t)tok0 + mt * 16 + c15) * D + 512 + gi * 128 + 16 * wave + 4 * g) = w;
            }
        }
    }
}

DI void phase4c(const Params& p, LAS unsigned char* lds, int tid, int lane, int wave) {
    LAS float* lG = (LAS float*)lds; LAS float* lA = lG + 1024; LAS float* lB = lA + 1024; LAS float* lP = lB + 1024;
    const float* x = p.in[0]; const float* MIXO = (const float*)(p.ws + WS_RZ); bf16_t* H2 = (bf16_t*)(p.ws + WS_RA);
    for (int rt = blockIdx.x; rt < T / 128; rt += gridDim.x) {
        const int b = rt / 32;
        __syncthreads();
        for (int d = tid; d < 1024; d += NTH) { lG[d] = mod_at(p, b, 2048 + d); lA[d] = p.in[15][d] * (1.f + mod_at(p, b, 4096 + d)); lB[d] = mod_at(p, b, 3072 + d); lP[d] = p.in[5][d]; }
        __syncthreads();
        for (int r = wave; r < 128; r += NWV) {
            const size_t row = (size_t)rt * 128 + r;
            const f32x4* mr = (const f32x4*)(MIXO + row * D) + lane; const f32x4* xr = (const f32x4*)(x + row * D) + lane;
            f32x4 m[4], xv[4]; float ss = 0.f;
#pragma unroll
            for (int j = 0; j < 4; ++j) { m[j] = mr[64 * j]; xv[j] = xr[64 * j]; ss += m[j][0] * m[j][0] + m[j][1] * m[j][1] + m[j][2] * m[j][2] + m[j][3] * m[j][3]; }
            const float rstd = rsqrtf(wave_sum(ss) * (1.f / D) + EPS);
            float s2 = 0.f;
#pragma unroll
            for (int j = 0; j < 4; ++j) {
                const f32x4 gt = *(const LAS f32x4*)(lG + 4 * lane + 256 * j), pm = *(const LAS f32x4*)(lP + 4 * lane + 256 * j);
                xv[j] = xv[j] + gt * (m[j] * rstd * pm);
                s2 += xv[j][0] * xv[j][0] + xv[j][1] * xv[j][1] + xv[j][2] * xv[j][2] + xv[j][3] * xv[j][3];
            }
            const float rstd2 = rsqrtf(wave_sum(s2) * (1.f / D) + EPS);
            f32x4* orow = (f32x4*)(p.out + row * D) + lane; u32x2* hrow = (u32x2*)(H2 + row * D) + lane;
#pragma unroll
            for (int j = 0; j < 4; ++j) {
                orow[64 * j] = xv[j];
#if defined(CHK_PEER) || REPEAT_PHASE == 6
                ((f32x4*)((float*)(p.ws + WS_RO) + row * D) + lane)[64 * j] = xv[j];
#endif
                const f32x4 a = *(const LAS f32x4*)(lA + 4 * lane + 256 * j), bb = *(const LAS f32x4*)(lB + 4 * lane + 256 * j);
                const f32x4 hv = xv[j] * rstd2 * a + bb;
                u32x2 w = {pk2(hv[0], hv[1]), pk2(hv[2], hv[3])};
                hrow[64 * j] = w;
            }
        }
    }
}

DI int skey(float v, int idx, int mask) { int u = __float_as_int(v); u ^= (u >> 31) & 0x7FFFFFFF; return (u & ~mask) | idx; }
DI float sval(int k, int mask) { int u = k & ~mask; u ^= (u >> 31) & 0x7FFFFFFF; return __int_as_float(u); }
DI void cswap(int& a, int& b) { const int mx = max(a, b), mn = min(a, b); a = mx; b = mn; }
DI void sort16_desc(int (&a)[16]) {
#pragma unroll
    for (int k = 2; k <= 16; k <<= 1) {
#pragma unroll
        for (int j = k >> 1; j > 0; j >>= 1) {
#pragma unroll
            for (int i = 0; i < 16; ++i) {
                const int l = i ^ j;
                if (l > i) { if ((i & k) == 0) cswap(a[i], a[l]); else cswap(a[l], a[i]); }
            }
        }
    }
}
DI void merge16_desc(int (&x)[16], const int (&y)[16]) {
#pragma unroll
    for (int i = 0; i < 16; ++i) x[i] = max(x[i], y[15 - i]);
#pragma unroll
    for (int j = 8; j > 0; j >>= 1) {
#pragma unroll
        for (int i = 0; i < 16; ++i) { const int l = i ^ j; if (l > i) cswap(x[i], x[l]); }
    }
}

DI void phase5b(const Params& p, LAS unsigned char* lds, int tid, int lane, int wave) {
    unsigned char* ws = p.ws;
    const bf16_t* Q2 = (const bf16_t*)(ws + WS_RZ);
    const bf16_t* SKB = (const bf16_t*)(ws + WS_SKB);
    int* EIDX = (int*)(ws + WS_RS); float* GATE = (float*)(ws + WS_RS + 16 * MB);
    LAS unsigned char* tab = lds + tid * 32;
    const int gw = blockIdx.x * NWV + wave, NGW = gridDim.x * NWV;
    const int c31 = lane & 31, hi = lane >> 5;
    for (int task = gw; task < 8192; task += NGW) {
        const int h = task & 7, tg = task >> 3;
        const size_t tok = (size_t)tg * 32 + c31;
        int lst[2][16];
#pragma unroll
        for (int pp = 0; pp < 2; ++pp) {
            const bf16_t* qp = Q2 + tok * 2048 + h * 256 + pp * 128 + 8 * hi;
            const bf16_t* kp = SKB + ((size_t)(h * 2 + pp) * 128 + c31) * 128 + 8 * hi;
            asm volatile("" : "+v"(qp)); asm volatile("" : "+v"(kp));
            bf16x8 bq[8];
#pragma unroll
            for (int ks = 0; ks < 8; ++ks) bq[ks] = ld_frag16(qp + 16 * ks);
            int run[16];
#pragma unroll
            for (int r = 0; r < 16; ++r) run[r] = (int)0x80000000;
#pragma unroll 1
            for (int kt = 0; kt < 4; ++kt) {
                const bf16_t* kpt = kp + kt * 4096;
                f32x16 acc;
#pragma unroll
                for (int r = 0; r < 16; ++r) acc[r] = 0.f;
#pragma unroll
                for (int ks = 0; ks < 8; ++ks) acc = MFMA32(ld_frag16(kpt + 16 * ks), bq[ks], acc);
                int cur[16];
#pragma unroll
                for (int r = 0; r < 16; ++r) cur[r] = skey(acc[r], 32 * kt + 8 * (r >> 2) + 4 * hi + (r & 3), 0x7F);
                sort16_desc(cur);
                merge16_desc(run, cur);
            }
            int oth[16];
#pragma unroll
            for (int r = 0; r < 16; ++r) oth[r] = __shfl_xor(run[r], 32);
            merge16_desc(run, oth);
#pragma unroll
            for (int r = 0; r < 16; ++r) lst[pp][r] = run[r];
        }
#pragma unroll
        for (int pp = 0; pp < 2; ++pp) {
            u32x4 w;
#pragma unroll
            for (int q = 0; q < 4; ++q) w[q] = (lst[pp][4 * q] & 0x7F) | ((lst[pp][4 * q + 1] & 0x7F) << 8) | ((lst[pp][4 * q + 2] & 0x7F) << 16) | ((lst[pp][4 * q + 3] & 0x7F) << 24);
            *(LAS u32x4*)(tab + 16 * pp) = w;
        }
        float va[16], vb[16];
#pragma unroll
        for (int r = 0; r < 16; ++r) { va[r] = sval(lst[0][r], 0x7F); vb[r] = sval(lst[1][r], 0x7F); }
        int cand[4][16];
        {
            int cnt = 0;
#pragma unroll
            for (int i = 0; i < 16; ++i)
#pragma unroll
                for (int j = 0; j < 16; ++j)
                    if ((i + 1) * (j + 1) <= 16) { cand[cnt >> 4][cnt & 15] = skey(va[i] + vb[j], (i << 4) | j, 0xFF); ++cnt; }
#pragma unroll
            for (int q = 50; q < 64; ++q) cand[q >> 4][q & 15] = (int)0x80000000;
        }
        sort16_desc(cand[0]); sort16_desc(cand[1]); sort16_desc(cand[2]); sort16_desc(cand[3]);
        merge16_desc(cand[0], cand[1]); merge16_desc(cand[2], cand[3]); merge16_desc(cand[0], cand[2]);
        asm volatile("s_waitcnt lgkmcnt(0)" ::: "memory");
        float sv[16]; int ex[16];
        const float mx = sval(cand[0][0], 0xFF);
        float sum = 0.f;
#pragma unroll
        for (int r = 0; r < 16; ++r) {
            const int ck = cand[0][r];
            const int i1 = tab[(ck >> 4) & 15], i2 = tab[16 + (ck & 15)];
            ex[r] = i1 * 128 + i2;
            sv[r] = __expf(sval(ck, 0xFF) - mx); sum += sv[r];
        }
        const float inv = 1.f / sum;
        int* ep = EIDX + tok * 128 + h * 16 + 8 * hi; float* gp = GATE + tok * 128 + h * 16 + 8 * hi;
        if (hi == 0) {
            *(u32x4*)ep = (u32x4){(unsigned)ex[0], (unsigned)ex[1], (unsigned)ex[2], (unsigned)ex[3]}; *(u32x4*)(ep + 4) = (u32x4){(unsigned)ex[4], (unsigned)ex[5], (unsigned)ex[6], (unsigned)ex[7]};
            *(f32x4*)gp = (f32x4){sv[0] * inv, sv[1] * inv, sv[2] * inv, sv[3] * inv}; *(f32x4*)(gp + 4) = (f32x4){sv[4] * inv, sv[5] * inv, sv[6] * inv, sv[7] * inv};
        } else {
            *(u32x4*)ep = (u32x4){(unsigned)ex[8], (unsigned)ex[9], (unsigned)ex[10], (unsigned)ex[11]}; *(u32x4*)(ep + 4) = (u32x4){(unsigned)ex[12], (unsigned)ex[13], (unsigned)ex[14], (unsigned)ex[15]};
            *(f32x4*)gp = (f32x4){sv[8] * inv, sv[9] * inv, sv[10] * inv, sv[11] * inv}; *(f32x4*)(gp + 4) = (f32x4){sv[12] * inv, sv[13] * inv, sv[14] * inv, sv[15] * inv};
        }
    }
}

DI void phase6(const Params& p, LAS unsigned char* lds, int tid, int lane, int wave) {
    unsigned char* ws = p.ws;
    const bf16_t* H2 = (const bf16_t*)(ws + WS_RA);
    const unsigned char* UQ = ws + WS_UB; const unsigned char* VQ = ws + WS_VB;
    const float* SU = (const float*)(ws + WS_SU); const float* SV = (const float*)(ws + WS_SV);
    const int* EIDX = (const int*)(ws + WS_RS); const float* GATE = (const float*)(ws + WS_RS + 16 * MB);
    LAS float* lG = (LAS float*)lds;
    for (int rt = blockIdx.x; rt < T / 128; rt += gridDim.x) {
        const int b = rt / 32;
        __syncthreads();
        for (int d = tid; d < 1024; d += NTH) lG[d] = mod_at(p, b, 5120 + d) * p.in[16][d];
        __syncthreads();
        for (int r = wave; r < 128; r += NWV) {
            const size_t t = (size_t)rt * 128 + r;
            const u32x4 h0 = *(const u32x4*)(H2 + t * D + 16 * lane), h1 = *(const u32x4*)(H2 + t * D + 16 * lane + 8);
            f32x2 hf[8];
#pragma unroll
            for (int q = 0; q < 4; ++q) { hf[q] = (f32x2){bflo(h0[q]), bfhi(h0[q])}; hf[4 + q] = (f32x2){bflo(h1[q]), bfhi(h1[q])}; }
            f32x2 y[8];
#pragma unroll
            for (int e = 0; e < 8; ++e) y[e] = (f32x2){0.f, 0.f};
#pragma unroll 1
            for (int bt = 0; bt < 2; ++bt) {
                const int eid = EIDX[t * 128 + bt * 64 + lane]; const float gate = GATE[t * 128 + bt * 64 + lane];
                const float isu = SU[eid], isv = SV[eid];
                float part[64];
#pragma unroll
                for (int e = 0; e < 64; ++e) {
                    const int idx = __builtin_amdgcn_readlane(eid, e);
                    const u32x4 u = *(const u32x4*)(UQ + (size_t)idx * 1024 + 16 * lane);
                    f32x2 a = (f32x2){0.f, 0.f};
#pragma unroll
                    for (int q = 0; q < 4; ++q) {
                        const int w = (int)u[q];
                        a = __builtin_elementwise_fma(__builtin_amdgcn_cvt_pk_f32_fp8(w, false), hf[2 * q], a);
                        a = __builtin_elementwise_fma(__builtin_amdgcn_cvt_pk_f32_fp8(w, true), hf[2 * q + 1], a);
                    }
                    part[e] = a.x + a.y;
                }
#pragma unroll
                for (int st = 0; st < 6; ++st) {
                    const int w = 32 >> st;
                    const bool up = (lane & w) != 0;
#pragma unroll
                    for (int e = 0; e < w; ++e) {
                        const float keep = up ? part[e + w] : part[e], send = up ? part[e] : part[e + w];
                        part[e] = keep + __shfl_xor(send, w);
                    }
                }
                const float dot = part[0] * isu;
                const float coef = gate * 0.5f * dot * (1.f + erff(dot * 0.70710678118654752f)) * isv;
#pragma unroll 8
                for (int e = 0; e < 64; ++e) {
                    const int idx = __builtin_amdgcn_readlane(eid, e);
                    const float cc = __int_as_float(__builtin_amdgcn_readlane(__float_as_int(coef), e));
                    const f32x2 c2 = (f32x2){cc, cc};
                    const u32x4 v = *(const u32x4*)(VQ + (size_t)idx * 1024 + 16 * lane);
#pragma unroll
                    for (int q = 0; q < 4; ++q) {
                        const int w = (int)v[q];
                        y[2 * q] = __builtin_elementwise_fma(__builtin_amdgcn_cvt_pk_f32_fp8(w, false), c2, y[2 * q]);
                        y[2 * q + 1] = __builtin_elementwise_fma(__builtin_amdgcn_cvt_pk_f32_fp8(w, true), c2, y[2 * q + 1]);
                    }
                }
            }
            float ss = 0.f;
#pragma unroll
            for (int e = 0; e < 8; ++e) ss += y[e].x * y[e].x + y[e].y * y[e].y;
            const float rstd = rsqrtf(wave_sum(ss) * (1.f / D) + EPS);
            float* orow = p.out + t * D;
#pragma unroll
            for (int q = 0; q < 4; ++q) {
                const int col = 16 * lane + 4 * q;
#if REPEAT_PHASE == 6
                f32x4 xv = *(const f32x4*)((const float*)(p.ws + WS_RO) + t * D + col);
#else
                f32x4 xv = *(const f32x4*)(orow + col);
#endif
                const f32x4 gg = *(const LAS f32x4*)(lG + col);
                xv[0] += gg[0] * y[2 * q].x * rstd; xv[1] += gg[1] * y[2 * q].y * rstd; xv[2] += gg[2] * y[2 * q + 1].x * rstd; xv[3] += gg[3] * y[2 * q + 1].y * rstd;
                *(f32x4*)(orow + col) = xv;
            }
        }
    }
}

#ifdef CHK_PEER
DI float blk_sum(float v, LAS float* red, int tid, int lane, int wave) {
    v = wave_sum(v);
    __syncthreads();
    if (lane == 0) red[wave] = v;
    __syncthreads();
    float s = 0.f;
    for (int i = 0; i < NWV; ++i) s += red[i];
    return s;
}
DI void check_peer(const Params& p, LAS unsigned char* lds, int tid, int lane, int wave) {
    unsigned char* ws = p.ws;
    const bf16_t* H2 = (const bf16_t*)(ws + WS_RA); const bf16_t* WQ = (const bf16_t*)(ws + WS_WQ); const bf16_t* SKB = (const bf16_t*)(ws + WS_SKB);
    const bf16_t* UB = (const bf16_t*)(ws + WS_UB); const bf16_t* VB = (const bf16_t*)(ws + WS_VB);
    const float* X1 = (const float*)(ws + WS_RO);
    float* stat = (float*)(ws + WS_CTL + 32768);
    LAS float* hrow = (LAS float*)lds;
    LAS float* qv = hrow + 1024;
    LAS float* sc = qv + 2048;
    LAS float* tv = sc + 2048;
    LAS int* ti = (LAS int*)(tv + 256);
    LAS int* ee = ti + 256;
    LAS float* gg = (LAS float*)(ee + 128);
    LAS float* cf = gg + 128;
    LAS float* yv = cf + 128;
    LAS float* red = yv + 1024;
    for (int rt = blockIdx.x; rt < T / 128; rt += gridDim.x) {
        const size_t ts = (size_t)rt * 128 + 37; const int b = rt / 32;
        __syncthreads();
        for (int d = tid; d < 1024; d += NTH) hrow[d] = bflo((unsigned)H2[ts * D + d]);
        __syncthreads();
        for (int n = tid; n < 2048; n += NTH) { float a = 0.f; for (int k = 0; k < 1024; ++k) a += hrow[k] * bflo((unsigned)WQ[(size_t)n * 1024 + k]); qv[n] = bflo(pk2(a, 0.f) & 0xFFFFu); }
        __syncthreads();
        for (int n = tid; n < 2048; n += NTH) { const int hp = n >> 7, key = n & 127; float a = 0.f; for (int d = 0; d < 128; ++d) a += qv[hp * 128 + d] * bflo((unsigned)SKB[((size_t)hp * 128 + key) * 128 + d]); sc[n] = a; }
        __syncthreads();
        if (tid < 16) { const int hp = tid;
            for (int k = 0; k < 16; ++k) { float best = -3e38f; int bi = 0; for (int n = 0; n < 128; ++n) { const float v = sc[hp * 128 + n]; if (v > best) { best = v; bi = n; } } tv[hp * 16 + k] = best; ti[hp * 16 + k] = bi; sc[hp * 128 + bi] = -3e38f; } }
        __syncthreads();
        if (tid < 8) { const int h = tid; float cs[16]; int ci[16];
            unsigned long long used[4] = {0ull, 0ull, 0ull, 0ull};
            for (int k = 0; k < 16; ++k) { float best = -3e38f; int bi = 0;
                for (int c = 0; c < 256; ++c) { if ((used[c >> 6] >> (c & 63)) & 1ull) continue; const float v = tv[(h * 2) * 16 + (c >> 4)] + tv[(h * 2 + 1) * 16 + (c & 15)]; if (v > best) { best = v; bi = c; } }
                used[bi >> 6] |= 1ull << (bi & 63); cs[k] = best; ci[k] = bi; }
            float sum = 0.f; for (int k = 0; k < 16; ++k) { cs[k] = __expf(cs[k] - cs[0]); sum += cs[k]; }
            for (int k = 0; k < 16; ++k) { ee[h * 16 + k] = ti[(h * 2) * 16 + (ci[k] >> 4)] * 128 + ti[(h * 2 + 1) * 16 + (ci[k] & 15)]; gg[h * 16 + k] = cs[k] / sum; } }
        __syncthreads();
#ifdef CHK_USE_FAST_SEL
        if (tid < 128) { ee[tid] = ((const int*)(ws + WS_RS))[ts * 128 + tid]; gg[tid] = ((const float*)(ws + WS_RS + 16 * MB))[ts * 128 + tid]; }
        __syncthreads();
#endif
        if (tid < 128) { const int e = ee[tid]; float a = 0.f; for (int d = 0; d < 1024; ++d) a += hrow[d] * bflo((unsigned)UB[(size_t)e * D + d]); cf[tid] = gg[tid] * 0.5f * a * (1.f + erff(a * 0.70710678118654752f)); }
        __syncthreads();
        for (int d = tid; d < 1024; d += NTH) { float a = 0.f; for (int e = 0; e < 128; ++e) a += cf[e] * bflo((unsigned)VB[(size_t)ee[e] * D + d]); yv[d] = a; }
        __syncthreads();
        float ss = 0.f; for (int d = tid; d < 1024; d += NTH) ss += yv[d] * yv[d];
        const float rstd = rsqrtf(blk_sum(ss, red, tid, lane, wave) * (1.f / D) + EPS);
        float e2 = 0.f, r2 = 0.f;
        for (int d = tid; d < 1024; d += NTH) { const float br = mod_at(p, b, 5120 + d) * p.in[16][d] * yv[d] * rstd; const float ref = X1[ts * D + d] + br; const float df = p.out[ts * D + d] - ref; e2 += df * df; r2 += br * br; }
        e2 = blk_sum(e2, red, tid, lane, wave); r2 = blk_sum(r2, red, tid, lane, wave);
        if (tid == 0) { atomicAdd(&stat[0], e2); atomicAdd(&stat[1], r2); }
    }
}
DI void check_emit(const Params& p, int tid) {
    const float* stat = (const float*)(p.ws + WS_CTL + 32768);
    const float e = __hip_atomic_load(&stat[0], __ATOMIC_RELAXED, __HIP_MEMORY_SCOPE_AGENT), r = __hip_atomic_load(&stat[1], __ATOMIC_RELAXED, __HIP_MEMORY_SCOPE_AGENT);
    const float A = 10.f + 1e6f * (e / r), f = 1.f + sqrtf(A);
    const size_t gt = (size_t)blockIdx.x * NTH + tid, NGT = (size_t)gridDim.x * NTH;
    for (size_t i = gt; i < (size_t)T * D / 4; i += NGT) { f32x4 v = ((const f32x4*)p.in[0])[i]; ((f32x4*)p.out)[i] = v * f; }
}
#endif

#ifdef TIMING
#define STAMP(k) do { if (blockIdx.x == 0 && threadIdx.x == 0) ((unsigned long long*)(p.ws + WS_CTL + 40960))[k] = __builtin_amdgcn_s_memrealtime(); } while (0)
DI void timing_emit(const Params& p, int tid) {
    const unsigned long long* ts = (const unsigned long long*)(p.ws + WS_CTL + 40960);
#define dT(a, b) ((float)(ts[b] - ts[a]) * 0.01f)
    const float A = TIM_A, B = TIM_B, f = 1.f + sqrtf(A);
#undef dT
    const size_t gt = (size_t)blockIdx.x * NTH + tid, NGT = (size_t)gridDim.x * NTH;
    for (size_t i = gt; i < (size_t)T * D / 4; i += NGT) { f32x4 v = ((const f32x4*)p.in[0])[i]; v = v * f; if (i == 0) v[0] = B; ((f32x4*)p.out)[i] = v; }
}
#else
#define STAMP(k) do {} while (0)
#endif

__global__ void __launch_bounds__(NTH) fwd_megakernel(Params p) {
    extern __shared__ __attribute__((aligned(16))) unsigned char lds_raw[];
    LAS unsigned char* lds = (LAS unsigned char*)lds_raw;
    const int tid = threadIdx.x, lane = tid & 63, wave = __builtin_amdgcn_readfirstlane(tid >> 6);
    volatile LAS unsigned* st = (volatile LAS unsigned*)(lds + LDS_BARW);
    if (tid == 0) { st[0] = 0u; st[1] = 0u; st[2] = 0u; st[3] = 0u; }
    __syncthreads();
    XcdBarrier bar = xcd_barrier_post((unsigned*)(p.ws + WS_CTL), st);
    unsigned char* ws = p.ws;

    STAMP(0);
    phase0(p, lds, tid, lane, wave);
    xcd_barrier(bar);
#if REPEAT_PHASE == 0
    phase0(p, lds, tid, lane, wave);
    xcd_barrier(bar);
#endif
    STAMP(1);
    phase1(p, lds, tid, lane, wave);
    xcd_barrier(bar);
    STAMP(2);
    { EpiZ e{(bf16_t*)(ws + WS_RZ), (float*)(ws + WS_AFB)}; gemm_phase(((const bf16_t*)(ws + WS_RA)), (const bf16_t*)(ws + WS_WIN), T, NIN, D, e, lds, tid, lane, wave); }
#if REPEAT_PHASE == 2
    xcd_barrier(bar);
    { EpiZ e{(bf16_t*)(ws + WS_RZ), (float*)(ws + WS_AFB)}; gemm_phase(((const bf16_t*)(ws + WS_RA)), (const bf16_t*)(ws + WS_WIN), T, NIN, D, e, lds, tid, lane, wave); }
#endif
    xcd_barrier(bar);
    STAMP(3);
    phase3a(p, lds, tid, lane, wave);
    xcd_barrier(bar);
#if REPEAT_PHASE == 1
    phase3a(p, lds, tid, lane, wave);
    xcd_barrier(bar);
#endif
    STAMP(4);
    phase3b(p, lane, wave);
#if REPEAT_PHASE == 3
    xcd_barrier(bar);
    phase3b(p, lane, wave);
#endif
    xcd_barrier(bar);
    STAMP(5);
    phase4a(p, lds, tid, lane, wave);
    xcd_barrier(bar);
#if REPEAT_PHASE == 4
    phase4a(p, lds, tid, lane, wave);
    xcd_barrier(bar);
#endif
    STAMP(6);
    { EpiF32 e{(float*)(ws + WS_RZ), D}; gemm_phase((const bf16_t*)(ws + WS_RA), (const bf16_t*)(ws + WS_WOUT), T, D, D, e, lds, tid, lane, wave); }
    xcd_barrier(bar);
    STAMP(7);
    phase4c(p, lds, tid, lane, wave);
    xcd_barrier(bar);
    STAMP(8);
#ifndef ABL_SKIP_PEER
    { EpiBf16 e{(bf16_t*)(ws + WS_RZ), 2048}; gemm_phase((const bf16_t*)(ws + WS_RA), (const bf16_t*)(ws + WS_WQ), T, 2048, D, e, lds, tid, lane, wave); }
    xcd_barrier(bar);
    STAMP(9);
    phase5b(p, lds, tid, lane, wave);
    xcd_barrier(bar);
#if REPEAT_PHASE == 5
    phase5b(p, lds, tid, lane, wave);
    xcd_barrier(bar);
#endif
    STAMP(10);
    phase6(p, lds, tid, lane, wave);
#if REPEAT_PHASE == 6
    xcd_barrier(bar);
    phase6(p, lds, tid, lane, wave);
#endif
#ifdef TIMING
    xcd_barrier(bar);
    STAMP(11);
    xcd_barrier(bar);
    timing_emit(p, tid);
#endif
#ifdef CHK_PEER
    xcd_barrier(bar);
    STAMP(11);
    check_peer(p, lds, tid, lane, wave);
    xcd_barrier(bar);
    STAMP(12);
    check_emit(p, tid);
#endif
#endif
}

extern "C" void kernel_launch(void* const* d_in, const int* in_sizes, int n_in, void* d_out, int out_size, void* d_ws, size_t ws_size, hipStream_t stream) {
    static int grid = 0;
    if (grid == 0) {
        if (n_in != 21 || out_size != T * D || ws_size < WS_END) { fprintf(stderr, "kernel_launch: unexpected shapes (n_in %d out %d ws %zu need %zu)\n", n_in, out_size, ws_size, (size_t)WS_END); grid = -1; return; }
        int dev = 0, cus = 0, per_cu = 0;
        hipGetDevice(&dev); hipDeviceGetAttribute(&cus, hipDeviceAttributeMultiprocessorCount, dev);
        hipFuncSetAttribute((const void*)fwd_megakernel, hipFuncAttributeMaxDynamicSharedMemorySize, LDS_BYTES);
        hipOccupancyMaxActiveBlocksPerMultiprocessor(&per_cu, (const void*)fwd_megakernel, NTH, LDS_BYTES);
        (void)hipGetLastError();
        if (per_cu < 1) fprintf(stderr, "kernel_launch: occupancy query says %d blocks per CU\n", per_cu);
        grid = cus;
    }
    if (grid < 0) return;
    hipMemsetAsync((char*)d_ws + WS_CTL, 0, 64 * 1024, stream);
    Params p{};
    for (int i = 0; i < 21; ++i) p.in[i] = (const float*)d_in[i];
    p.out = (float*)d_out; p.ws = (unsigned char*)d_ws;
    hipLaunchKernelGGL(fwd_megakernel, dim3(grid), dim3(NTH), LDS_BYTES, stream, p);
}
```

```cpp
#ifndef REPEAT_PHASE
#define REPEAT_PHASE -1
#endif
#include <hip/hip_runtime.h>
#include <cstdio>
#include <cstdint>

#define DI __device__ __forceinline__
#define LAS __attribute__((address_space(3)))
typedef unsigned short bf16_t;
typedef short bf16x8 __attribute__((ext_vector_type(8)));
typedef float f32x4 __attribute__((ext_vector_type(4)));
typedef float f32x2 __attribute__((ext_vector_type(2)));
typedef float f32x16 __attribute__((ext_vector_type(16)));
typedef unsigned u32x4 __attribute__((ext_vector_type(4)));
typedef unsigned u32x2 __attribute__((ext_vector_type(2)));
typedef __bf16 bf16x2v __attribute__((ext_vector_type(2)));

constexpr int T = 32768, D = 1024, SEQ = 4096, NB = 8;
constexpr int NTH = 512, NWV = 8;
constexpr int ZW = 2048;
constexpr int NIN = 2176;
constexpr float EPS = 1e-6f;

constexpr size_t MB = 1024 * 1024;
constexpr size_t WS_CTL   = 0;
constexpr size_t WS_MODP  = 64 * 1024;
constexpr size_t WS_WIN   = WS_MODP + 8 * 8 * 6144 * 4;
constexpr size_t WS_WOUT  = WS_WIN + (size_t)NIN * 1024 * 2;
constexpr size_t WS_WQ    = WS_WOUT + 1024 * 1024 * 2;
constexpr size_t WS_SKB   = WS_WQ + 2048 * 1024 * 2;
constexpr size_t WS_WP    = WS_SKB + 16 * 128 * 128 * 2;
constexpr size_t WS_AFB   = WS_WP + 4 * 128 * 128 * 2;
constexpr size_t WS_UB    = WS_AFB + (size_t)T * 32 * 4;
constexpr size_t WS_VB    = WS_UB + 32 * MB;
constexpr size_t WS_SU    = WS_UB + 16 * MB, WS_SV = WS_VB + 16 * MB;
constexpr size_t WS_RA    = WS_VB + 32 * MB;
constexpr size_t WS_RZ    = WS_RA + 64 * MB;
constexpr size_t WS_RS    = WS_RZ + 128 * MB;
constexpr size_t WS_RO    = WS_RS + 6 * 16 * MB + 1 * MB;
constexpr size_t WS_END   = WS_RO + 128 * MB;
static_assert(WS_END <= 512 * MB, "workspace too large");

struct Params { const float* in[21]; float* out; unsigned char* ws; };

DI unsigned pk2(float a, float b) { f32x2 f = {a, b}; bf16x2v h = __builtin_convertvector(f, bf16x2v); return __builtin_bit_cast(unsigned, h); }
DI float dot2bf(unsigned a, unsigned b, float c) { return __builtin_amdgcn_fdot2_f32_bf16(__builtin_bit_cast(bf16x2v, a), __builtin_bit_cast(bf16x2v, b), c, false); }
DI float bflo(unsigned u) { return __uint_as_float(u << 16); }
DI float bfhi(unsigned u) { return __uint_as_float(u & 0xFFFF0000u); }
DI float wave_sum(float v) {
#pragma unroll
    for (int o = 1; o < 64; o <<= 1) v += __shfl_xor(v, o);
    return v;
}
DI bf16x8 ld_frag16(const bf16_t* p) { return __builtin_bit_cast(bf16x8, *(const u32x4*)p); }
DI bf16x8 ld_frag_perm(const bf16_t* p, int g) {
    const u32x2 lo = *(const u32x2*)(p + 4 * g), hi = *(const u32x2*)(p + 16 + 4 * g);
    u32x4 v = {lo.x, lo.y, hi.x, hi.y}; return __builtin_bit_cast(bf16x8, v);
}
DI int perm32(int k) { return (k & ~31) | (((k >> 2) & 3) << 3) | (((k >> 4) & 1) << 2) | (k & 3); }
DI bf16x8 pack8(const f32x4& a, const f32x4& b) { u32x4 v = {pk2(a[0], a[1]), pk2(a[2], a[3]), pk2(b[0], b[1]), pk2(b[2], b[3])}; return __builtin_bit_cast(bf16x8, v); }
#define MFMA16(a, b, c) __builtin_amdgcn_mfma_f32_16x16x32_bf16((a), (b), (c), 0, 0, 0)
#define MFMA32(a, b, c) __builtin_amdgcn_mfma_f32_32x32x16_bf16((a), (b), (c), 0, 0, 0)

#define XB_TMO      128
#define XB_XCNT(j)  (256  + 64 * (j))
#define XB_XSUB(j)  (1280 + 64 * (j))
#define XB_XGEN(j)  (2304 + 64 * (j))
#define XB_TOP      3328
#define XB_TOPGEN   3392
#define XCD_BAR_WORDS 3456
#define XB_SPIN_CAP (1u << 22)
DI unsigned xb_ld(unsigned* p)              { return __hip_atomic_load(p, __ATOMIC_RELAXED, __HIP_MEMORY_SCOPE_AGENT); }
DI unsigned xb_add(unsigned* p, unsigned v) { return __hip_atomic_fetch_add(p, v, __ATOMIC_RELAXED, __HIP_MEMORY_SCOPE_AGENT); }
DI unsigned xb_xcc_id() { return (unsigned)__builtin_amdgcn_s_getreg((3 << 11) | 20) & 0xFu; }
#define XB_SPIN(cond, bar) do { unsigned _sp = 0; while (cond) { __builtin_amdgcn_s_sleep(1); \
    if ((++_sp & 255u) == 0u) { if (xb_ld(&(bar)[XB_TMO])) break; if (_sp > XB_SPIN_CAP) { atomicAdd(&(bar)[XB_TMO], 1u); break; } } } } while (0)
struct XcdBarrier { unsigned* bar; unsigned x; volatile LAS unsigned* st; };
DI XcdBarrier xcd_barrier_post(unsigned* bar, volatile LAS unsigned* st) {
    XcdBarrier b; b.bar = bar; b.x = xb_xcc_id(); b.st = st;
    if (threadIdx.x == 0) (void)xb_add(&bar[XB_XCNT(b.x)], 1u);
    return b;
}
DI void xcd_barrier_complete(unsigned* bar, unsigned x, unsigned& nloc, unsigned& nx) {
    const unsigned G = gridDim.x * gridDim.y * gridDim.z;
    unsigned sum, cnt, mine, sp = 0u;
    for (;;) {
        sum = 0u; cnt = 0u; mine = 0u;
#pragma unroll
        for (unsigned j = 0; j < 16; ++j) { const unsigned c = xb_ld(&bar[XB_XCNT(j)]); sum += c; cnt += (c > 0u) ? 1u : 0u; mine = (j == x) ? c : mine; }
        if (sum == G) break;
        __builtin_amdgcn_s_sleep(1);
        if ((++sp & 255u) == 0u) { if (xb_ld(&bar[XB_TMO])) break; if (sp > XB_SPIN_CAP) { atomicAdd(&bar[XB_TMO], 1u); break; } }
    }
    nloc = mine > 0u ? mine : 1u; nx = cnt > 0u ? cnt : 1u;
}
DI void xcd_barrier(const XcdBarrier& b) {
    asm volatile("s_waitcnt vmcnt(0)" ::: "memory");
    __syncthreads();
    if (threadIdx.x == 0) {
        unsigned* bar = b.bar;
        __builtin_amdgcn_s_waitcnt(0);
        unsigned nloc = b.st[0], nx = b.st[1];
        if (nloc == 0u) { xcd_barrier_complete(bar, b.x, nloc, nx); b.st[0] = nloc; b.st[1] = nx; }
        const unsigned old = xb_add(&bar[XB_XSUB(b.x)], 1u);
        const unsigned gen = old / nloc;
        if (old + 1u == (gen + 1u) * nloc) {
            __builtin_amdgcn_fence(__ATOMIC_RELEASE, "agent");
            asm volatile("s_waitcnt vmcnt(0)" ::: "memory");
            const unsigned og = xb_add(&bar[XB_TOP], 1u);
            const unsigned tg = og / nx;
            if (og + 1u == (tg + 1u) * nx) xb_add(&bar[XB_TOPGEN], 1u);
            else XB_SPIN(xb_ld(&bar[XB_TOPGEN]) == tg, bar);
            __builtin_amdgcn_fence(__ATOMIC_ACQUIRE, "agent");
            xb_add(&bar[XB_XGEN(b.x)], 1u);
            asm volatile("s_waitcnt vmcnt(0)" ::: "memory");
        } else {
            XB_SPIN(xb_ld(&bar[XB_XGEN(b.x)]) == gen, bar);
            __builtin_amdgcn_fence(__ATOMIC_ACQUIRE, "agent");
            asm volatile("s_waitcnt vmcnt(0)" ::: "memory");
        }
    }
    __syncthreads();
}

constexpr int LDS_BYTES = 144 * 1024;
constexpr int LDS_BARW = LDS_BYTES - 16;

DI void p0_transpose_item(const float* W, int ldw, int K, bf16_t* WT, int dst_row0, int src_col0, float scale, bool zero, LAS float* scr, int kb, int lane) {
    const int k0 = 64 * kb;
#pragma unroll 8
    for (int i = 0; i < 32; ++i) { const int kk = 2 * i + (lane >> 5); scr[kk * 33 + (lane & 31)] = zero ? 0.f : W[(size_t)(k0 + kk) * ldw + src_col0 + (lane & 31)] * scale; }
    asm volatile("s_waitcnt lgkmcnt(0)" ::: "memory");
    const int c = lane & 7;
#pragma unroll
    for (int j = 0; j < 4; ++j) { const int n = (lane >> 3) + 8 * j; const LAS float* s = scr + (8 * c) * 33 + n;
        u32x4 o; o.x = pk2(s[0 * 33], s[1 * 33]); o.y = pk2(s[2 * 33], s[3 * 33]); o.z = pk2(s[4 * 33], s[5 * 33]); o.w = pk2(s[6 * 33], s[7 * 33]);
        *(u32x4*)(WT + (size_t)(dst_row0 + n) * K + k0 + 8 * c) = o; }
    asm volatile("s_waitcnt lgkmcnt(0)" ::: "memory");
}

DI void phase0(const Params& p, LAS unsigned char* lds, int tid, int lane, int wave) {
    unsigned char* ws = p.ws;
    LAS float* sl = (LAS float*)lds;
    LAS float* scr = (LAS float*)(lds + 32768 + wave * 8448);
    const float* c = p.in[1];
    for (int e = tid; e < 8192; e += NTH) { const int b = e >> 10, k = e & 1023; const float v = c[e]; sl[k * 8 + b] = v / (1.f + __expf(-v)); }
    __syncthreads();
    const int gw = wave * gridDim.x + blockIdx.x, NGW = gridDim.x * NWV;
    constexpr int I_MOD = 768, I_WIN = 16 * 68, I_WOUT = 16 * 32, I_WQ = 16 * 64, I_WP = 32;
    constexpr int NITEMS = I_MOD + I_WIN + I_WOUT + I_WQ + I_WP;
    for (int it = gw; it < NITEMS; it += NGW) {
        int r = it;
        if (r < I_MOD) {
            const int cg = r % 96, ks = r / 96, n = cg * 64 + lane, k0 = ks * 128;
            const float* W = p.in[2] + (size_t)k0 * 6144 + n;
            float acc[8];
#pragma unroll
            for (int b = 0; b < 8; ++b) acc[b] = 0.f;
#pragma unroll 8
            for (int k = 0; k < 128; ++k) {
                const float w = W[(size_t)k * 6144];
                const f32x4 s0 = *(const LAS f32x4*)(sl + (k0 + k) * 8), s1 = *(const LAS f32x4*)(sl + (k0 + k) * 8 + 4);
                acc[0] += s0[0] * w; acc[1] += s0[1] * w; acc[2] += s0[2] * w; acc[3] += s0[3] * w;
                acc[4] += s1[0] * w; acc[5] += s1[1] * w; acc[6] += s1[2] * w; acc[7] += s1[3] * w;
            }
            float* mp = (float*)(ws + WS_MODP) + (size_t)ks * 8 * 6144 + n;
#pragma unroll
            for (int b = 0; b < 8; ++b) mp[b * 6144] = acc[b];
            continue;
        }
        r -= I_MOD;
        if (r < I_WIN) {
            const int kb = r / 68, nb = r % 68, n0 = nb * 32;
            int src; bool zero = false; float scale = 1.f;
            if (n0 < 1536) { src = n0; if (n0 < 256) scale = 0.125f; } else if (n0 < 2048) src = n0 + 32; else if (n0 < 2080) src = 1536 + (n0 - 2048); else { src = 0; zero = true; }
            p0_transpose_item(p.in[6], 2080, 1024, (bf16_t*)(ws + WS_WIN), n0, src, scale, zero, scr, kb, lane);
            continue;
        }
        r -= I_WIN;
        if (r < I_WOUT) { p0_transpose_item(p.in[14], 1024, 1024, (bf16_t*)(ws + WS_WOUT), (r % 32) * 32, (r % 32) * 32, 1.f, false, scr, r / 32, lane); continue; }
        r -= I_WOUT;
        if (r < I_WQ) { p0_transpose_item(p.in[17], 2048, 1024, (bf16_t*)(ws + WS_WQ), (r % 64) * 32, (r % 64) * 32, 1.f, false, scr, r / 64, lane); continue; }
        r -= I_WQ;
        { const int g = r >> 3, kb = (r >> 2) & 1, nb = r & 3;
          p0_transpose_item(p.in[12] + g * 16384, 128, 128, (bf16_t*)(ws + WS_WP) + g * 16384, nb * 32, nb * 32, 1.f, false, scr, kb, lane); }
    }
    const size_t gt = (size_t)blockIdx.x * NTH + tid, NGT = (size_t)gridDim.x * NTH;
    constexpr size_t NSK = (size_t)16 * 128 * 128 / 8;
    for (size_t j = gt; j < NSK; j += NGT) {
        const float* src = p.in[18]; bf16_t* dst = (bf16_t*)(ws + WS_SKB);
        const f32x4 a = *(const f32x4*)(src + j * 8), b = *(const f32x4*)(src + j * 8 + 4);
        u32x4 o = {pk2(a[0], a[1]), pk2(a[2], a[3]), pk2(b[0], b[1]), pk2(b[2], b[3])};
        *(u32x4*)(dst + j * 8) = o;
    }
    for (int row = gw; row < 2 * 16384; row += NGW) {
        const int tb = row >> 14, e = row & 16383;
        const float* src = (tb ? p.in[20] : p.in[19]) + (size_t)e * D + 16 * lane;
        f32x4 v[4]; float m = 0.f;
#pragma unroll
        for (int q = 0; q < 4; ++q) { v[q] = *(const f32x4*)(src + 4 * q); m = fmaxf(m, fmaxf(fmaxf(fabsf(v[q][0]), fabsf(v[q][1])), fmaxf(fabsf(v[q][2]), fabsf(v[q][3])))); }
#pragma unroll
        for (int o = 1; o < 64; o <<= 1) m = fmaxf(m, __shfl_xor(m, o));
        int ex = (int)((__float_as_uint(m) >> 23) & 0xFFu) - 127;
        if (m < 1e-30f) ex = 7;
        const float sc = __uint_as_float((unsigned)(127 + 7 - ex) << 23), isc = __uint_as_float((unsigned)(127 - 7 + ex) << 23);
        u32x4 o;
#pragma unroll
        for (int q = 0; q < 4; ++q) { int w = 0; w = __builtin_amdgcn_cvt_pk_fp8_f32(v[q][0] * sc, v[q][1] * sc, w, false); w = __builtin_amdgcn_cvt_pk_fp8_f32(v[q][2] * sc, v[q][3] * sc, w, true); o[q] = (unsigned)w; }
        *(u32x4*)(ws + (tb ? WS_VB : WS_UB) + (size_t)e * 1024 + 16 * lane) = o;
        if (lane == 0) ((float*)(ws + (tb ? WS_SV : WS_SU)))[e] = isc;
    }
}

DI float mod_at(const Params& p, int b, int n) {
    const float* mp = (const float*)(p.ws + WS_MODP) + (size_t)b * 6144 + n;
    float s = p.in[3][n];
#pragma unroll
    for (int ks = 0; ks < 8; ++ks) s += mp[(size_t)ks * 8 * 6144];
    return s;
}

DI void phase1(const Params& p, LAS unsigned char* lds, int tid, int lane, int wave) {
    LAS float* lA = (LAS float*)lds; LAS float* lB = lA + 1024;
    const float* x = p.in[0]; bf16_t* H = (bf16_t*)(p.ws + WS_RA);
    for (int rt = blockIdx.x; rt < T / 128; rt += gridDim.x) {
        const int b = rt / 32;
        __syncthreads();
        for (int d = tid; d < 1024; d += NTH) { lA[d] = p.in[4][d] * (1.f + mod_at(p, b, 1024 + d)); lB[d] = mod_at(p, b, d); }
        __syncthreads();
        for (int r = wave; r < 128; r += NWV) {
            const size_t row = (size_t)rt * 128 + r;
            const f32x4* xr = (const f32x4*)(x + row * D) + lane;
            f32x4 v[4]; float ss = 0.f;
#pragma unroll
            for (int j = 0; j < 4; ++j) { v[j] = xr[64 * j]; ss += v[j][0] * v[j][0] + v[j][1] * v[j][1] + v[j][2] * v[j][2] + v[j][3] * v[j][3]; }
            const float rstd = rsqrtf(wave_sum(ss) * (1.f / D) + EPS);
            u32x2* o = (u32x2*)(H + row * D) + lane;
#pragma unroll
            for (int j = 0; j < 4; ++j) {
                const f32x4 a = *(const LAS f32x4*)(lA + 4 * lane + 256 * j), bb = *(const LAS f32x4*)(lB + 4 * lane + 256 * j);
                u32x2 w = {pk2(v[j][0] * rstd * a[0] + bb[0], v[j][1] * rstd * a[1] + bb[1]), pk2(v[j][2] * rstd * a[2] + bb[2], v[j][3] * rstd * a[3] + bb[3])};
                o[64 * j] = w;
            }
        }
    }
}

struct EpiZ {
    bf16_t* Z; float* AFB;
    DI void operator()(int m, int n, const f32x4& v) const {
        if (n < ZW) { u32x2 w = {pk2(v[0], v[1]), pk2(v[2], v[3])}; *(u32x2*)(Z + (size_t)m * ZW + n) = w; }
        else if (n < ZW + 32) { *(f32x4*)(AFB + (size_t)m * 32 + (n - ZW)) = v; }
    }
};
struct EpiF32 { float* C; int ldc; DI void operator()(int m, int n, const f32x4& v) const { *(f32x4*)(C + (size_t)m * ldc + n) = v; } };
struct EpiBf16 { bf16_t* C; int ldc; DI void operator()(int m, int n, const f32x4& v) const { u32x2 w = {pk2(v[0], v[1]), pk2(v[2], v[3])}; *(u32x2*)(C + (size_t)m * ldc + n) = w; } };

template <class Epi>
DI void gemm_phase(const bf16_t* A, const bf16_t* Bt, int M, int N, int K, const Epi& epi, LAS unsigned char* lds, int tid, int lane, int wave, int nt_first = 0) {
    constexpr int BM = 256, BN = 128, BK = 64, STAGE = (BM + BN) * 128;
    const int ntn = N / BN - nt_first, ntiles = (M / BM) * ntn, nk = K / BK;
    const int wm = wave & 3, wn = wave >> 2, c15 = lane & 15, g = lane >> 4;
    const int lrow = tid >> 3, lch = tid & 7;
    for (int tile = blockIdx.x; tile < ntiles; tile += gridDim.x) {
        const int m0 = (tile / ntn) * BM, n0 = (tile % ntn + nt_first) * BN;
        f32x4 acc[4][4];
#pragma unroll
        for (int i = 0; i < 4; ++i)
#pragma unroll
            for (int j = 0; j < 4; ++j) acc[i][j] = (f32x4){0.f, 0.f, 0.f, 0.f};
        u32x4 ra[4], rb[2];
        const bf16_t* Ag = A + (size_t)(m0 + lrow) * K + lch * 8;
        const bf16_t* Bg = Bt + (size_t)(n0 + lrow) * K + lch * 8;
        const int woff = lrow * 128 + ((lch ^ (lrow & 7)) * 16);
        __syncthreads();
#pragma unroll
        for (int ps = 0; ps < 4; ++ps) ra[ps] = *(const u32x4*)(Ag + (size_t)(64 * ps) * K);
#pragma unroll
        for (int ps = 0; ps < 2; ++ps) rb[ps] = *(const u32x4*)(Bg + (size_t)(64 * ps) * K);
#pragma unroll
        for (int ps = 0; ps < 4; ++ps) *(LAS u32x4*)(lds + woff + ps * 8192) = ra[ps];
#pragma unroll
        for (int ps = 0; ps < 2; ++ps) *(LAS u32x4*)(lds + BM * 128 + woff + ps * 8192) = rb[ps];
        __syncthreads();
        for (int kt = 0; kt < nk; ++kt) {
            const bool more = (kt + 1 < nk);
            if (more) {
#pragma unroll
                for (int ps = 0; ps < 4; ++ps) ra[ps] = *(const u32x4*)(Ag + (size_t)(64 * ps) * K + (kt + 1) * BK);
#pragma unroll
                for (int ps = 0; ps < 2; ++ps) rb[ps] = *(const u32x4*)(Bg + (size_t)(64 * ps) * K + (kt + 1) * BK);
            }
            LAS unsigned char* sa = lds + (kt & 1) * STAGE; LAS unsigned char* sb = sa + BM * 128;
#pragma unroll
            for (int s = 0; s < 2; ++s) {
                bf16x8 fa[4], fb[4];
#pragma unroll
                for (int i = 0; i < 4; ++i) { const int row = wm * 64 + i * 16 + c15; fa[i] = *(const LAS bf16x8*)(sa + row * 128 + (((4 * s + g) ^ (row & 7)) * 16)); }
#pragma unroll
                for (int j = 0; j < 4; ++j) { const int row = wn * 64 + j * 16 + c15; fb[j] = *(const LAS bf16x8*)(sb + row * 128 + (((4 * s + g) ^ (row & 7)) * 16)); }
#pragma unroll
                for (int i = 0; i < 4; ++i)
#pragma unroll
                    for (int j = 0; j < 4; ++j) acc[i][j] = MFMA16(fb[j], fa[i], acc[i][j]);
            }
            if (more) {
                LAS unsigned char* da = lds + ((kt + 1) & 1) * STAGE;
#pragma unroll
                for (int ps = 0; ps < 4; ++ps) *(LAS u32x4*)(da + woff + ps * 8192) = ra[ps];
#pragma unroll
                for (int ps = 0; ps < 2; ++ps) *(LAS u32x4*)(da + BM * 128 + woff + ps * 8192) = rb[ps];
            }
            __syncthreads();
        }
#pragma unroll
        for (int i = 0; i < 4; ++i)
#pragma unroll
            for (int j = 0; j < 4; ++j) epi(m0 + wm * 64 + i * 16 + c15, n0 + wn * 64 + j * 16 + 4 * g, acc[i][j]);
    }
}

namespace pg8 {
#define PG8_LAS __attribute__((address_space(3)))
constexpr int BM = 256, BK = 64, HALF = 128, HTB = HALF * BK * 2  , STAGE_BYTES = 8 * HTB, NXCD = 8, WGM = 8;

__host__ __device__ __forceinline__ int lds_byte(int r, int c) { const int st = (r >> 4) * 2 + (c >> 5), rr = r & 15, cc = c & 31, ob = rr * 64 + cc * 2; return st * 1024 + (ob ^ (((ob >> 9) & 1) << 5)); }
__host__ __device__ __forceinline__ void stage_rc(int b, int& R, int& C) { const int st = b / 1024, sb = b % 1024, swz = sb ^ (((sb >> 9) & 1) << 5); R = (st >> 1) * 16 + swz / 64; C = (st & 1) * 32 + (swz % 64) / 2; }
__host__ __device__ __forceinline__ int perm32(int rho) { const int n = rho >> 4, i = rho & 15; return 8 * (i >> 2) + 4 * n + (i & 3); }

struct Unit { int pm, pn; };
struct Gemm { const bf16_t* A; const bf16_t* Bt; int M, N, K; };

struct StaticOrder {
    int nM, nN, nwg, G, c;
    __host__ __device__ void init(int M, int N, int G_, int c_) { nM = M / BM; nN = N / BM; nwg = nM * nN; G = G_; c = c_; }
    __host__ __device__ bool next(int i, Unit& u) const {
        const long L = (long)i * G + c; if (L >= nwg) return false;
        int wgid = (int)L; { const int q = nwg / NXCD, r = nwg % NXCD, xcd = wgid % NXCD, off = wgid / NXCD; wgid = (xcd < r ? xcd * (q + 1) : r * (q + 1) + (xcd - r) * q) + off; }
        const int nig = WGM * nN, gid = wgid / nig, fm = gid * WGM, gsz = (nM - fm) < WGM ? (nM - fm) : WGM;
        u.pm = fm + ((wgid % nig) % gsz); u.pn = (wgid % nig) / gsz; return true;
    }
    __device__ __forceinline__ void a_ready(const Unit&) const {}
    __device__ __forceinline__ void done(const Unit&) const {}
};

struct EpiB16 {
    static constexpr bool PERM = true, AFTER_DRAIN = false;
    bf16_t* O; int ldc;
    __device__ __forceinline__ void operator()(const f32x4 (&acc)[2][2][4][2], const Unit& u, int wr, int wc, int fr, int fq) const {
#pragma unroll
        for (int ai = 0; ai < 2; ++ai)
#pragma unroll
            for (int m = 0; m < 4; ++m) { bf16_t* rowp = O + (size_t)(u.pm * BM + ai * HALF + wr * 64 + m * 16 + fr) * ldc + u.pn * BM + wc * 32 + 8 * fq;
#pragma unroll
                for (int bj = 0; bj < 2; ++bj) { const f32x4 v0 = acc[ai][bj][m][0], v1 = acc[ai][bj][m][1];
                    u32x4 w; w.x = ::pk2(v0[0], v0[1]); w.y = ::pk2(v0[2], v0[3]); w.z = ::pk2(v1[0], v1[1]); w.w = ::pk2(v1[2], v1[3]);
                    *(u32x4*)(rowp + bj * HALF) = w; } }
    }
};
struct EpiF {
    static constexpr bool PERM = false, AFTER_DRAIN = false;
    float* O; int ldc;
    __device__ __forceinline__ void operator()(const f32x4 (&acc)[2][2][4][2], const Unit& u, int wr, int wc, int fr, int fq) const {
#pragma unroll
        for (int ai = 0; ai < 2; ++ai)
#pragma unroll
            for (int m = 0; m < 4; ++m) { float* rowp = O + (size_t)(u.pm * BM + ai * HALF + wr * 64 + m * 16 + fr) * ldc + u.pn * BM + wc * 32 + 4 * fq;
#pragma unroll
                for (int bj = 0; bj < 2; ++bj)
#pragma unroll
                    for (int n = 0; n < 2; ++n) *(f32x4*)(rowp + bj * HALF + 16 * n) = acc[ai][bj][m][n]; }
    }
};
template <class Epi, class Sched, bool ALIGN_EPI = false, bool SP2 = false>
__device__ __forceinline__ void gemm_phase(PG8_LAS unsigned char* lds, const Gemm g, const Sched& S, const Epi& E) {
    const int tid = threadIdx.x, wid = __builtin_amdgcn_readfirstlane(tid >> 6), lane = tid & 63, wr = wid >> 2, wc = wid & 3, fr = lane & 15, fq = lane >> 4;
    const int K = g.K, nt = K / BK;
    unsigned voffA[2], voffB[2];
#pragma unroll
    for (int i = 0; i < 2; ++i) { int R, C; stage_rc(tid * 16 + i * 8192, R, C); const int Rb = Epi::PERM ? ((R & ~31) + perm32(R & 31)) : R;
        voffA[i] = (unsigned)(R * K + C) * 2u; voffB[i] = (unsigned)(Rb * K + C) * 2u; }
    const size_t kstep = (size_t)(BK * 2);
    const size_t hstep = (size_t)HALF * K * 2;
    const size_t tstep = 2 * hstep;
    const unsigned ldsw = (unsigned)wid * 1024u;
    const int aoff = lds_byte(wr * 64 + fr, fq * 8), boff = lds_byte(wc * 32 + fr, fq * 8);
#define PG8_SA(b, h) (((b) * 2 + (h)) * HTB)
#define PG8_SB(b, h) ((4 + (b) * 2 + (h)) * HTB)
#define PG8_STAGE(bufoff, gbase, voff) do { _Pragma("unroll") for (int _i = 0; _i < 2; ++_i) \
        __builtin_amdgcn_global_load_lds((const unsigned*)((const char*)(gbase) + (voff)[_i]), (PG8_LAS unsigned*)(lds + (bufoff) + ldsw + _i * 8192), 16, 0, 0); } while (0)
#define PG8_LDA(dst, b, h) do { _Pragma("unroll") for (int m = 0; m < 4; ++m) _Pragma("unroll") for (int k = 0; k < 2; ++k) dst[m][k] = *(const PG8_LAS bf16x8*)(lds + PG8_SA(b, h) + aoff + m * 2048 + k * 1024); } while (0)
#define PG8_LDB(dst, b, h) do { _Pragma("unroll") for (int n = 0; n < 2; ++n) _Pragma("unroll") for (int k = 0; k < 2; ++k) dst[n][k] = *(const PG8_LAS bf16x8*)(lds + PG8_SB(b, h) + boff + n * 2048 + k * 1024); } while (0)
#define PG8_MMA(ai, bj, At, Bt) do { __builtin_amdgcn_s_setprio(1); _Pragma("unroll") for (int m = 0; m < 4; ++m) _Pragma("unroll") for (int n = 0; n < 2; ++n) _Pragma("unroll") for (int k = 0; k < 2; ++k) \
        acc[ai][bj][m][n] = __builtin_amdgcn_mfma_f32_16x16x32_bf16(Bt[n][k], At[m][k], acc[ai][bj][m][n], 0, 0, 0); __builtin_amdgcn_s_setprio(0); } while (0)
#define PG8_WAIT_V(n) asm volatile("s_waitcnt vmcnt(" #n ")" ::: "memory")
#define PG8_WAIT_L(n) asm volatile("s_waitcnt lgkmcnt(" #n ")" ::: "memory")
#define PG8_BAR __builtin_amdgcn_s_barrier()
#define PG8_SCHED __builtin_amdgcn_sched_barrier(0)
    Unit cur, nxt; int ui = 0;
    if (!S.next(0, cur)) return;
    f32x4 acc[2][2][4][2];
#pragma unroll
    for (int a = 0; a < 2; ++a)
#pragma unroll
        for (int b = 0; b < 2; ++b)
#pragma unroll
            for (int m = 0; m < 4; ++m)
#pragma unroll
                for (int n = 0; n < 2; ++n) acc[a][b][m][n] = (f32x4){0.f, 0.f, 0.f, 0.f};
    bf16x8 At[4][2], B0[2][2], B1[2][2];
    const char* cA = (const char*)g.A + (size_t)cur.pm * tstep; const char* cB = (const char*)g.Bt + (size_t)cur.pn * tstep;
    S.a_ready(cur);
    if constexpr (SP2) {
        PG8_STAGE(PG8_SB(0, 0), cB, voffB); PG8_STAGE(PG8_SB(0, 1), cB + hstep, voffB); PG8_STAGE(PG8_SA(0, 0), cA, voffA); PG8_STAGE(PG8_SA(0, 1), cA + hstep, voffA);
        if (wr == 1) PG8_BAR;
        PG8_WAIT_V(2); PG8_BAR;
        PG8_STAGE(PG8_SB(1, 0), cB + kstep, voffB); PG8_STAGE(PG8_SA(1, 0), cA + kstep, voffA); PG8_STAGE(PG8_SB(1, 1), cB + hstep + kstep, voffB);
        PG8_WAIT_V(6); PG8_BAR;
    } else {
        PG8_STAGE(PG8_SB(0, 0), cB, voffB); PG8_STAGE(PG8_SA(0, 0), cA, voffA); PG8_STAGE(PG8_SB(0, 1), cB + hstep, voffB); PG8_STAGE(PG8_SA(0, 1), cA + hstep, voffA);
        if (wr == 1) PG8_BAR;
        PG8_WAIT_V(4); PG8_BAR;
        PG8_STAGE(PG8_SB(1, 0), cB + kstep, voffB); PG8_STAGE(PG8_SA(1, 0), cA + kstep, voffA); PG8_STAGE(PG8_SB(1, 1), cB + hstep + kstep, voffB);
        PG8_WAIT_V(6); PG8_BAR;
    }
    for (;;) {
        const bool has_next = S.next(ui + 1, nxt);
        const char* nA = has_next ? (const char*)g.A + (size_t)nxt.pm * tstep : cA; const char* nB = has_next ? (const char*)g.Bt + (size_t)nxt.pn * tstep : cB;
        for (int t = 0; t < nt; t += 2) {
            const bool last = (t == nt - 2);
            const char* a1 = cA + (size_t)(t + 1) * kstep;
            const char* a2 = last ? nA : cA + (size_t)(t + 2) * kstep; const char* b2 = last ? nB : cB + (size_t)(t + 2) * kstep;
            const char* a3 = a2 + kstep; const char* b3 = b2 + kstep;
            if (last && has_next) S.a_ready(nxt);
            if constexpr (SP2) {
            PG8_LDB(B0, 0, 0); PG8_LDB(B1, 0, 1); PG8_SCHED; PG8_LDA(At, 0, 0); PG8_STAGE(PG8_SA(1, 1), a1 + hstep, voffA);
            PG8_WAIT_V(8); PG8_WAIT_L(0); PG8_BAR; PG8_MMA(0, 0, At, B0); PG8_MMA(0, 1, At, B1); PG8_BAR; PG8_SCHED;
            PG8_LDA(At, 0, 1); PG8_STAGE(PG8_SB(0, 0), b2, voffB); PG8_STAGE(PG8_SB(0, 1), b2 + hstep, voffB); PG8_STAGE(PG8_SA(0, 0), a2, voffA);
            PG8_WAIT_V(8); PG8_WAIT_L(0); PG8_BAR; PG8_MMA(1, 0, At, B0); PG8_MMA(1, 1, At, B1); PG8_BAR; PG8_SCHED;
            PG8_LDB(B0, 1, 0); PG8_LDB(B1, 1, 1); PG8_SCHED; PG8_LDA(At, 1, 0); PG8_STAGE(PG8_SA(0, 1), a2 + hstep, voffA);
            PG8_WAIT_V(8); PG8_WAIT_L(0); PG8_BAR; PG8_MMA(0, 0, At, B0); PG8_MMA(0, 1, At, B1); PG8_BAR; PG8_SCHED;
            PG8_LDA(At, 1, 1); PG8_STAGE(PG8_SB(1, 0), b3, voffB); PG8_STAGE(PG8_SB(1, 1), b3 + hstep, voffB); PG8_STAGE(PG8_SA(1, 0), a3, voffA);
            PG8_WAIT_V(8); PG8_WAIT_L(0); PG8_BAR; PG8_MMA(1, 0, At, B0); PG8_MMA(1, 1, At, B1); PG8_BAR; PG8_SCHED;
            } else {
            PG8_LDB(B0, 0, 0); PG8_SCHED; PG8_LDA(At, 0, 0); PG8_STAGE(PG8_SA(1, 1), a1 + hstep, voffA);
            PG8_WAIT_L(8); PG8_BAR; PG8_WAIT_L(0); PG8_MMA(0, 0, At, B0); PG8_BAR; PG8_SCHED;
            PG8_LDB(B1, 0, 1); PG8_STAGE(PG8_SB(0, 0), b2, voffB);
            PG8_BAR; PG8_WAIT_L(0); PG8_MMA(0, 1, At, B1); PG8_BAR;
            PG8_LDA(At, 0, 1); PG8_STAGE(PG8_SA(0, 0), a2, voffA);
            PG8_BAR; PG8_WAIT_L(0); PG8_MMA(1, 0, At, B0); PG8_BAR; PG8_SCHED;
            PG8_STAGE(PG8_SB(0, 1), b2 + hstep, voffB);
            PG8_WAIT_V(6); PG8_BAR; PG8_MMA(1, 1, At, B1); PG8_BAR;
            PG8_LDB(B0, 1, 0); PG8_SCHED; PG8_LDA(At, 1, 0); PG8_STAGE(PG8_SA(0, 1), a2 + hstep, voffA);
            PG8_WAIT_L(8); PG8_BAR; PG8_WAIT_L(0); PG8_MMA(0, 0, At, B0); PG8_BAR; PG8_SCHED;
            PG8_LDB(B1, 1, 1); PG8_STAGE(PG8_SB(1, 0), b3, voffB);
            PG8_BAR; PG8_WAIT_L(0); PG8_MMA(0, 1, At, B1); PG8_BAR;
            PG8_LDA(At, 1, 1); PG8_STAGE(PG8_SA(1, 0), a3, voffA);
            PG8_BAR; PG8_WAIT_L(0); PG8_MMA(1, 0, At, B0); PG8_BAR; PG8_SCHED;
            PG8_STAGE(PG8_SB(1, 1), b3 + hstep, voffB);
            PG8_WAIT_V(6); PG8_BAR; PG8_MMA(1, 1, At, B1); PG8_BAR;
            }
        }
        if constexpr (ALIGN_EPI) { if (wr == 0) PG8_BAR; }
        if constexpr (!Epi::AFTER_DRAIN) { E(acc, cur, wr, wc, fr, fq); S.done(cur); }
        if (!has_next) break;
#pragma unroll
        for (int a = 0; a < 2; ++a)
#pragma unroll
            for (int b = 0; b < 2; ++b)
#pragma unroll
                for (int m = 0; m < 4; ++m)
#pragma unroll
                    for (int n = 0; n < 2; ++n) acc[a][b][m][n] = (f32x4){0.f, 0.f, 0.f, 0.f};
        cur = nxt; cA = nA; cB = nB; ++ui;
        if constexpr (ALIGN_EPI) { if (wr == 1) PG8_BAR; }
    }
    PG8_WAIT_V(0);
    if constexpr (!ALIGN_EPI) { if (wr == 0) PG8_BAR; }
    PG8_BAR;
    if constexpr (Epi::AFTER_DRAIN) { E.fused(acc, cur, wr, wc, fr, fq, lds, wid, lane); S.done(cur); }
#undef PG8_SA
#undef PG8_SB
#undef PG8_STAGE
#undef PG8_LDA
#undef PG8_LDB
#undef PG8_MMA
#undef PG8_WAIT_V
#undef PG8_WAIT_L
#undef PG8_BAR
#undef PG8_SCHED
}
}

DI float logsig(float x) { return fminf(x, 0.f) - __logf(1.f + __expf(-fabsf(x))); }

DI void phase3a(const Params& p, LAS unsigned char* lds, int tid, int lane, int wave) {
    unsigned char* ws = p.ws;
    const bf16_t* Z = (const bf16_t*)(ws + WS_RZ);
    const float* AFB = (const float*)(ws + WS_AFB);
    bf16_t* QD[2] = {(bf16_t*)(ws + WS_RS), (bf16_t*)(ws + WS_RS + 48 * MB)};
    bf16_t* KI[2] = {(bf16_t*)(ws + WS_RS + 16 * MB), (bf16_t*)(ws + WS_RS + 64 * MB)};
    bf16_t* KE[2] = {(bf16_t*)(ws + WS_RS + 32 * MB), (bf16_t*)(ws + WS_RS + 80 * MB)};
    float* GAM[2] = {(float*)(ws + WS_RS + 96 * MB), (float*)(ws + WS_RS + 96 * MB + 512 * 1024)};
    bf16_t* VT = (bf16_t*)(ws + WS_RA);
    LAS float* la[2] = {(LAS float*)lds, (LAS float*)(lds + 16384)};
    LAS float* part[2] = {(LAS float*)(lds + 32768), (LAS float*)(lds + 32768 + 2048)};
    LAS bf16_t* keT[2] = {(LAS bf16_t*)(lds + 36864), (LAS bf16_t*)(lds + 36864 + 8192)};
    LAS bf16_t* vT = (LAS bf16_t*)(lds + 53248);
    for (int task = blockIdx.x; task < 2048; task += gridDim.x) {
        const int h = task & 3, n = (task >> 2) & 63, b = task >> 8;
        const int tok0 = b * SEQ + n * 64;
        const int i = tid >> 3, dg = tid & 7, d0 = dg * 8;
        const size_t t = (size_t)tok0 + i;
        __syncthreads();
        {
            float af[16], ab[16];
#pragma unroll
            for (int q = 0; q < 4; ++q) { const f32x4 a = *(const f32x4*)(AFB + t * 32 + 4 * q), bb = *(const f32x4*)(AFB + t * 32 + 16 + 4 * q);
                af[4 * q] = a[0]; af[4 * q + 1] = a[1]; af[4 * q + 2] = a[2]; af[4 * q + 3] = a[3]; ab[4 * q] = bb[0]; ab[4 * q + 1] = bb[1]; ab[4 * q + 2] = bb[2]; ab[4 * q + 3] = bb[3]; }
            const float* waf = p.in[7] + h * 64 + d0; const float* wab = p.in[9] + h * 64 + d0;
            float xf[8], xb[8];
#pragma unroll
            for (int e = 0; e < 8; ++e) { xf[e] = p.in[8][h * 64 + d0 + e]; xb[e] = p.in[10][h * 64 + d0 + e]; }
#pragma unroll
            for (int r = 0; r < 16; ++r) {
                const f32x4 w0 = *(const f32x4*)(waf + r * 256), w1 = *(const f32x4*)(waf + r * 256 + 4), v0 = *(const f32x4*)(wab + r * 256), v1 = *(const f32x4*)(wab + r * 256 + 4);
#pragma unroll
                for (int e = 0; e < 4; ++e) { xf[e] += af[r] * w0[e]; xf[4 + e] += af[r] * w1[e]; xb[e] += ab[r] * v0[e]; xb[4 + e] += ab[r] * v1[e]; }
            }
#pragma unroll
            for (int e = 0; e < 8; ++e) { la[0][i * 64 + d0 + e] = logsig(xf[e]) * 0.0625f; la[1][i * 64 + d0 + e] = logsig(xb[e]) * 0.0625f; }
        }
        __syncthreads();
        {
            const int d = tid & 63, pt = tid >> 6;
            float run = 0.f;
#pragma unroll
            for (int j = 0; j < 8; ++j) { run += la[0][(8 * pt + j) * 64 + d]; la[0][(8 * pt + j) * 64 + d] = run; }
            part[0][pt * 64 + d] = run;
            run = 0.f;
#pragma unroll
            for (int j = 7; j >= 0; --j) { run += la[1][(8 * pt + j) * 64 + d]; la[1][(8 * pt + j) * 64 + d] = run; }
            part[1][pt * 64 + d] = run;
            __syncthreads();
            float of = 0.f, ob = 0.f;
#pragma unroll
            for (int q = 0; q < 8; ++q) { if (q < pt) of += part[0][q * 64 + d]; if (q > pt) ob += part[1][q * 64 + d]; }
#pragma unroll
            for (int j = 0; j < 8; ++j) { la[0][(8 * pt + j) * 64 + d] += of; la[1][(8 * pt + j) * 64 + d] += ob; }
        }
        __syncthreads();
        {
            const u32x4 qv = *(const u32x4*)(Z + t * ZW + h * 64 + d0), kv = *(const u32x4*)(Z + t * ZW + 256 + h * 64 + d0);
            float q[8], k[8];
#pragma unroll
            for (int e = 0; e < 4; ++e) { q[2 * e] = bflo(qv[e]); q[2 * e + 1] = bfhi(qv[e]); k[2 * e] = bflo(kv[e]); k[2 * e + 1] = bfhi(kv[e]); }
#pragma unroll
            for (int dir = 0; dir < 2; ++dir) {
                float qd[8], ki[8], ke[8];
#pragma unroll
                for (int e = 0; e < 8; ++e) {
                    const float bb = la[dir][i * 64 + d0 + e], bl = la[dir][(dir ? 0 : 63) * 64 + d0 + e];
                    qd[e] = q[e] * __expf(bb); ki[e] = k[e] * __expf(-bb); ke[e] = k[e] * __expf(bl - bb);
                    if (i == (dir ? 0 : 63)) GAM[dir][((size_t)(b * 4 + h) * 64 + n) * 64 + d0 + e] = __expf(bl);
                }
                {
                    u32x2 a0 = {pk2(qd[0], qd[1]), pk2(qd[2], qd[3])}, a1 = {pk2(qd[4], qd[5]), pk2(qd[6], qd[7])};
                    u32x2 b0 = {pk2(ki[0], ki[1]), pk2(ki[2], ki[3])}, b1 = {pk2(ki[4], ki[5]), pk2(ki[6], ki[7])};
                    *(u32x2*)(QD[dir] + t * 256 + h * 64 + perm32(d0)) = a0; *(u32x2*)(QD[dir] + t * 256 + h * 64 + perm32(d0 + 4)) = a1;
                    *(u32x2*)(KI[dir] + t * 256 + h * 64 + perm32(d0)) = b0; *(u32x2*)(KI[dir] + t * 256 + h * 64 + perm32(d0 + 4)) = b1;
                }
#pragma unroll
                for (int e = 0; e < 4; ++e) { const unsigned w = pk2(ke[2 * e], ke[2 * e + 1]); keT[dir][(d0 + 2 * e) * 64 + perm32(i)] = (bf16_t)(w & 0xFFFFu); keT[dir][(d0 + 2 * e + 1) * 64 + perm32(i)] = (bf16_t)(w >> 16); }
            }
#pragma unroll
            for (int ps = 0; ps < 2; ++ps) {
                const int idx = tid + NTH * ps, vi = idx >> 4, ch = idx & 15;
                const u32x4 vv = *(const u32x4*)(Z + ((size_t)tok0 + vi) * ZW + 512 + h * 128 + ch * 8);
#pragma unroll
                for (int e = 0; e < 4; ++e) { vT[(ch * 8 + 2 * e) * 72 + perm32(vi)] = (bf16_t)(vv[e] & 0xFFFFu); vT[(ch * 8 + 2 * e + 1) * 72 + perm32(vi)] = (bf16_t)(vv[e] >> 16); }
            }
        }
        __syncthreads();
        {
            const int dk = tid >> 3, ch = tid & 7;
#pragma unroll
            for (int dir = 0; dir < 2; ++dir) {
                const u32x4 v = *(const LAS u32x4*)(keT[dir] + dk * 64 + ch * 8);
                *(u32x4*)(KE[dir] + ((size_t)(b * 64 + n) * 256 + h * 64 + dk) * 64 + ch * 8) = v;
            }
#pragma unroll
            for (int ps = 0; ps < 2; ++ps) {
                const int idx = tid + NTH * ps, dv = idx >> 3, c8 = idx & 7;
                const LAS bf16_t* s = vT + dv * 72 + c8 * 8;
                u32x4 v; v.x = s[0] | ((unsigned)s[1] << 16); v.y = s[2] | ((unsigned)s[3] << 16); v.z = s[4] | ((unsigned)s[5] << 16); v.w = s[6] | ((unsigned)s[7] << 16);
                *(u32x4*)(VT + ((size_t)(b * 64 + n) * 512 + h * 128 + dv) * 64 + c8 * 8) = v;
            }
        }
    }
}

constexpr int NSEG = 8, SEGC = 64 / NSEG;
constexpr size_t WS_SSEG = WS_RA + 32 * MB;
constexpr size_t WS_GSEG = WS_SSEG + 16 * MB;
template <bool FULL>
DI void phase3b(const Params& p, int lane, int wave) {
    unsigned char* ws = p.ws;
    const int c15 = lane & 15, g = lane >> 4;
    for (int task = blockIdx.x * NWV + wave; task < 2048; task += gridDim.x * NWV) {
        const int sl = task & 3, pair = task >> 2, sg = pair & 7, bhd = pair >> 3;
        const int dir = bhd & 1, h = (bhd >> 1) & 3, b = bhd >> 3;
        const bf16_t* QD = (const bf16_t*)(ws + WS_RS + (dir ? 48 : 0) * MB) + (size_t)b * SEQ * 256 + h * 64;
        const bf16_t* KI = (const bf16_t*)(ws + WS_RS + (dir ? 64 : 16) * MB) + (size_t)b * SEQ * 256 + h * 64;
        const bf16_t* KE = (const bf16_t*)(ws + WS_RS + (dir ? 80 : 32) * MB) + ((size_t)b * 64 * 256 + h * 64) * 64;
        const float* GAM = (const float*)(ws + WS_RS + 96 * MB + (dir ? 512 * 1024 : 0)) + (size_t)(b * 4 + h) * 64 * 64;
        const bf16_t* VT = (const bf16_t*)(ws + WS_RA) + ((size_t)b * 64 * 512 + h * 128 + sl * 32) * 64;
        float* O = (float*)(ws + WS_RO + (dir ? 64 : 0) * MB) + (size_t)b * SEQ * 512 + h * 128 + sl * 32;
        f32x4* SSEG = (f32x4*)(ws + WS_SSEG); float* GSEG = (float*)(ws + WS_GSEG);
        f32x4 S[4][2];
#pragma unroll
        for (int kt = 0; kt < 4; ++kt) { S[kt][0] = (f32x4){0.f, 0.f, 0.f, 0.f}; S[kt][1] = (f32x4){0.f, 0.f, 0.f, 0.f}; }
        if (FULL) {
            for (int s2 = 0; s2 < sg; ++s2) {
                const int t2 = ((bhd * 8 + s2) << 2) | sl;
#pragma unroll
                for (int kt = 0; kt < 4; ++kt) {
                    const f32x4 gm = *(const f32x4*)(GSEG + (bhd * 8 + s2) * 64 + 16 * kt + 4 * g);
#pragma unroll
                    for (int nt = 0; nt < 2; ++nt) S[kt][nt] = S[kt][nt] * gm + SSEG[((size_t)t2 * 8 + kt * 2 + nt) * 64 + lane];
                }
            }
        }
        f32x4 gprod[4];
#pragma unroll
        for (int kt = 0; kt < 4; ++kt) gprod[kt] = (f32x4){1.f, 1.f, 1.f, 1.f};
        for (int cs = 0; cs < SEGC; ++cs) {
            const int cn = sg * SEGC + cs, n = dir ? 63 - cn : cn;
            bf16x8 kea[4][2], vb[2][2];
            f32x4 gam[4];
#pragma unroll
            for (int jt = 0; jt < 4; ++jt)
#pragma unroll
                for (int s = 0; s < 2; ++s) kea[jt][s] = ld_frag16(KE + ((size_t)n * 256 + 16 * jt + c15) * 64 + 32 * s + 8 * g);
#pragma unroll
            for (int nt = 0; nt < 2; ++nt)
#pragma unroll
                for (int s = 0; s < 2; ++s) vb[nt][s] = ld_frag16(VT + ((size_t)n * 512 + 16 * nt + c15) * 64 + 32 * s + 8 * g);
#pragma unroll
            for (int kt = 0; kt < 4; ++kt) gam[kt] = *(const f32x4*)(GAM + n * 64 + 16 * kt + 4 * g);
            if (FULL) {
                bf16x8 kia[4][2];
#pragma unroll
                for (int jt = 0; jt < 4; ++jt)
#pragma unroll
                    for (int s = 0; s < 2; ++s) kia[jt][s] = ld_frag16(KI + (size_t)(n * 64 + 16 * jt + c15) * 256 + 32 * s + 8 * g);
                bf16x8 sb[2][2];
#pragma unroll
                for (int nt = 0; nt < 2; ++nt)
#pragma unroll
                    for (int s = 0; s < 2; ++s) sb[nt][s] = pack8(S[2 * s][nt], S[2 * s + 1][nt]);
#pragma unroll
                for (int it = 0; it < 4; ++it) {
                    bf16x8 qdb[2];
#pragma unroll
                    for (int s = 0; s < 2; ++s) qdb[s] = ld_frag16(QD + (size_t)(n * 64 + 16 * it + c15) * 256 + 32 * s + 8 * g);
                    f32x4 sc[4];
#pragma unroll
                    for (int jt = 0; jt < 4; ++jt) {
                        sc[jt] = (f32x4){0.f, 0.f, 0.f, 0.f};
#pragma unroll
                        for (int s = 0; s < 2; ++s) sc[jt] = MFMA16(kia[jt][s], qdb[s], sc[jt]);
                        const int ii = 16 * it + c15;
#pragma unroll
                        for (int r = 0; r < 4; ++r) { const int jj = 16 * jt + 4 * g + r; const bool keep = dir ? (jj > ii) : (jj <= ii); sc[jt][r] = keep ? sc[jt][r] : 0.f; }
                    }
                    bf16x8 pa[2] = {pack8(sc[0], sc[1]), pack8(sc[2], sc[3])};
#pragma unroll
                    for (int nt = 0; nt < 2; ++nt) {
                        f32x4 o = (f32x4){0.f, 0.f, 0.f, 0.f};
#pragma unroll
                        for (int s = 0; s < 2; ++s) { o = MFMA16(vb[nt][s], pa[s], o); o = MFMA16(sb[nt][s], qdb[s], o); }
                        *(f32x4*)(O + (size_t)(n * 64 + 16 * it + c15) * 512 + 16 * nt + 4 * g) = o;
                    }
                }
            }
#pragma unroll
            for (int kt = 0; kt < 4; ++kt) {
                if (!FULL) gprod[kt] = gprod[kt] * gam[kt];
#pragma unroll
                for (int nt = 0; nt < 2; ++nt) {
                    f32x4 a = S[kt][nt] * gam[kt];
#pragma unroll
                    for (int s = 0; s < 2; ++s) a = MFMA16(kea[kt][s], vb[nt][s], a);
                    S[kt][nt] = a;
                }
            }
        }
        if (!FULL) {
#pragma unroll
            for (int kt = 0; kt < 4; ++kt) {
#pragma unroll
                for (int nt = 0; nt < 2; ++nt) SSEG[((size_t)task * 8 + kt * 2 + nt) * 64 + lane] = S[kt][nt];
                if (sl == 0 && c15 == 0) *(f32x4*)(GSEG + (bhd * 8 + sg) * 64 + 16 * kt + 4 * g) = gprod[kt];
            }
        }
    }
}

DI void phase4a(const Params& p, LAS unsigned char* lds, int tid, int lane, int wave) {
    unsigned char* ws = p.ws;
    const bf16_t* Z = (const bf16_t*)(ws + WS_RZ);
    bf16_t* MIX = (bf16_t*)(ws + WS_RA);
    const float* OF = (const float*)(ws + WS_RO); const float* OB = (const float*)(ws + WS_RO + 64 * MB);
    {
        const int gw = blockIdx.x * NWV + wave, NGW = gridDim.x * NWV;
        f32x4 gh0 = *(const f32x4*)(p.in[11] + 8 * lane), gh1 = *(const f32x4*)(p.in[11] + 8 * lane + 4);
        for (int t = gw; t < T; t += NGW) {
            const f32x4 a0 = *(const f32x4*)(OF + (size_t)t * 512 + 8 * lane), a1 = *(const f32x4*)(OF + (size_t)t * 512 + 8 * lane + 4);
            const f32x4 b0 = *(const f32x4*)(OB + (size_t)t * 512 + 8 * lane), b1 = *(const f32x4*)(OB + (size_t)t * 512 + 8 * lane + 4);
            const u32x4 rv = *(const u32x4*)(Z + (size_t)t * ZW + 1024 + 8 * lane);
            float o[8], r[8];
#pragma unroll
            for (int e = 0; e < 4; ++e) { o[e] = a0[e] + b0[e]; o[4 + e] = a1[e] + b1[e]; r[2 * e] = bflo(rv[e]); r[2 * e + 1] = bfhi(rv[e]); }
            float ss = 0.f;
#pragma unroll
            for (int e = 0; e < 8; ++e) ss += o[e] * o[e];
            ss += __shfl_xor(ss, 1); ss += __shfl_xor(ss, 2); ss += __shfl_xor(ss, 4); ss += __shfl_xor(ss, 8);
            const float rstd = rsqrtf(ss * (1.f / 128.f) + EPS);
            float y[8];
#pragma unroll
            for (int e = 0; e < 8; ++e) { const float gg = e < 4 ? gh0[e] : gh1[e - 4]; y[e] = o[e] * rstd * gg * (r[e] / (1.f + __expf(-r[e]))); }
            u32x4 w = {pk2(y[0], y[1]), pk2(y[2], y[3]), pk2(y[4], y[5]), pk2(y[6], y[7])};
            *(u32x4*)(MIX + (size_t)t * D + 8 * lane) = w;
        }
    }
    LAS float* pt = (LAS float*)lds;
    LAS unsigned char* at = lds + 40960;
    const bf16_t* WP = (const bf16_t*)(ws + WS_WP);
    const int c15 = lane & 15, g = lane >> 4;
    for (int task = blockIdx.x; task < 2048; task += gridDim.x) {
        const int gi = task & 3, tile = task >> 2, tok0 = tile * 64, s0 = tok0 & (SEQ - 1), hw = 1 << gi;
        __syncthreads();
        const int nrows = 64 + 2 * hw;
        for (int idx = tid; idx < nrows * 16; idx += NTH) {
            const int rr = idx >> 4, ch = idx & 15, s = s0 - hw + rr;
            u32x4 v = {0u, 0u, 0u, 0u};
            if (s >= 0 && s < SEQ) v = *(const u32x4*)(Z + ((size_t)tok0 - hw + rr) * ZW + 1536 + gi * 128 + ch * 8);
            LAS float* d = pt + rr * 128 + ch * 8;
#pragma unroll
            for (int e = 0; e < 4; ++e) { d[2 * e] = bflo(v[e]); d[2 * e + 1] = bfhi(v[e]); }
        }
        __syncthreads();
        {
            const int c = tid & 127, q = tid >> 7;
            for (int ii = 0; ii < 16; ++ii) {
                const int i = 16 * q + ii, s = s0 + i;
                const int lo = max(s - hw, 0), hi = min(s + hw, SEQ);
                float sum = 0.f;
                for (int rr = lo; rr < hi; ++rr) sum += pt[(rr - (s0 - hw)) * 128 + c];
                const float val = sum / (float)(hi - lo) - pt[(i + hw) * 128 + c];
                const unsigned w = pk2(val, 0.f);
                *(LAS bf16_t*)(at + i * 256 + (((c >> 3) ^ (i & 15)) * 16) + (c & 7) * 2) = (bf16_t)(w & 0xFFFFu);
            }
        }
        __syncthreads();
        {
            f32x4 acc[4];
#pragma unroll
            for (int mt = 0; mt < 4; ++mt) acc[mt] = (f32x4){0.f, 0.f, 0.f, 0.f};
#pragma unroll
            for (int s = 0; s < 4; ++s) {
                const bf16x8 wf = ld_frag16(WP + (size_t)gi * 16384 + (16 * wave + c15) * 128 + 32 * s + 8 * g);
#pragma unroll
                for (int mt = 0; mt < 4; ++mt) { const int row = mt * 16 + c15; const bf16x8 af = *(const LAS bf16x8*)(at + row * 256 + (((4 * s + g) ^ (row & 15)) * 16)); acc[mt] = MFMA16(wf, af, acc[mt]); }
            }
            const f32x4 ps = *(const f32x4*)(p.in[13] + gi * 128 + 16 * wave + 4 * g);
#pragma unroll
            for (int mt = 0; mt < 4; ++mt) {
                const f32x4 v = acc[mt] * ps;
                u32x2 w = {pk2(v[0], v[1]), pk2(v[2], v[3])};
                *(u32x2*)(MIX + ((size_t)tok0 + mt * 16 + c15) * D + 512 + gi * 128 + 16 * wave + 4 * g) = w;
            }
        }
    }
}

DI void phase4c(const Params& p, LAS unsigned char* lds, int tid, int lane, int wave) {
    LAS float* lG = (LAS float*)lds; LAS float* lA = lG + 1024; LAS float* lB = lA + 1024; LAS float* lP = lB + 1024;
    const float* x = p.in[0]; const float* MIXO = (const float*)(p.ws + WS_RZ); bf16_t* H2 = (bf16_t*)(p.ws + WS_RA);
    for (int rt = blockIdx.x; rt < T / 128; rt += gridDim.x) {
        const int b = rt / 32;
        __syncthreads();
        for (int d = tid; d < 1024; d += NTH) { lG[d] = mod_at(p, b, 2048 + d); lA[d] = p.in[15][d] * (1.f + mod_at(p, b, 4096 + d)); lB[d] = mod_at(p, b, 3072 + d); lP[d] = p.in[5][d]; }
        __syncthreads();
        for (int r = wave; r < 128; r += NWV) {
            const size_t row = (size_t)rt * 128 + r;
            const f32x4* mr = (const f32x4*)(MIXO + row * D) + lane; const f32x4* xr = (const f32x4*)(x + row * D) + lane;
            f32x4 m[4], xv[4]; float ss = 0.f;
#pragma unroll
            for (int j = 0; j < 4; ++j) { m[j] = mr[64 * j]; xv[j] = xr[64 * j]; ss += m[j][0] * m[j][0] + m[j][1] * m[j][1] + m[j][2] * m[j][2] + m[j][3] * m[j][3]; }
            const float rstd = rsqrtf(wave_sum(ss) * (1.f / D) + EPS);
            float s2 = 0.f;
#pragma unroll
            for (int j = 0; j < 4; ++j) {
                const f32x4 gt = *(const LAS f32x4*)(lG + 4 * lane + 256 * j), pm = *(const LAS f32x4*)(lP + 4 * lane + 256 * j);
                xv[j] = xv[j] + gt * (m[j] * rstd * pm);
                s2 += xv[j][0] * xv[j][0] + xv[j][1] * xv[j][1] + xv[j][2] * xv[j][2] + xv[j][3] * xv[j][3];
            }
            const float rstd2 = rsqrtf(wave_sum(s2) * (1.f / D) + EPS);
            f32x4* orow = (f32x4*)(p.out + row * D) + lane; u32x2* hrow = (u32x2*)(H2 + row * D) + lane;
#pragma unroll
            for (int j = 0; j < 4; ++j) {
                orow[64 * j] = xv[j];
#if defined(CHK_PEER) || REPEAT_PHASE == 6
                ((f32x4*)((float*)(p.ws + WS_RO) + row * D) + lane)[64 * j] = xv[j];
#endif
                const f32x4 a = *(const LAS f32x4*)(lA + 4 * lane + 256 * j), bb = *(const LAS f32x4*)(lB + 4 * lane + 256 * j);
                const f32x4 hv = xv[j] * rstd2 * a + bb;
                u32x2 w = {pk2(hv[0], hv[1]), pk2(hv[2], hv[3])};
                hrow[64 * j] = w;
            }
        }
    }
}

DI int skey(float v, int idx, int mask) { int u = __float_as_int(v); u ^= (u >> 31) & 0x7FFFFFFF; return (u & ~mask) | idx; }
DI float sval(int k, int mask) { int u = k & ~mask; u ^= (u >> 31) & 0x7FFFFFFF; return __int_as_float(u); }
DI void cswap(int& a, int& b) { const int mx = max(a, b), mn = min(a, b); a = mx; b = mn; }
DI void sort16_desc(int (&a)[16]) {
#pragma unroll
    for (int k = 2; k <= 16; k <<= 1) {
#pragma unroll
        for (int j = k >> 1; j > 0; j >>= 1) {
#pragma unroll
            for (int i = 0; i < 16; ++i) {
                const int l = i ^ j;
                if (l > i) { if ((i & k) == 0) cswap(a[i], a[l]); else cswap(a[l], a[i]); }
            }
        }
    }
}
DI void merge16_desc(int (&x)[16], const int (&y)[16]) {
#pragma unroll
    for (int i = 0; i < 16; ++i) x[i] = max(x[i], y[15 - i]);
#pragma unroll
    for (int j = 8; j > 0; j >>= 1) {
#pragma unroll
        for (int i = 0; i < 16; ++i) { const int l = i ^ j; if (l > i) cswap(x[i], x[l]); }
    }
}

DI void phase5b(const Params& p, LAS unsigned char* lds, int tid, int lane, int wave) {
    unsigned char* ws = p.ws;
    const bf16_t* Q2 = (const bf16_t*)(ws + WS_RZ);
    const bf16_t* SKB = (const bf16_t*)(ws + WS_SKB);
    int* EIDX = (int*)(ws + WS_RS); float* GATE = (float*)(ws + WS_RS + 16 * MB);
    LAS unsigned char* tab = lds + tid * 32;
    const int gw = blockIdx.x * NWV + wave, NGW = gridDim.x * NWV;
    const int c31 = lane & 31, hi = lane >> 5;
    for (int task = gw; task < 8192; task += NGW) {
        const int h = task & 7, tg = task >> 3;
        const size_t tok = (size_t)tg * 32 + c31;
        int lst[2][16];
#pragma unroll
        for (int pp = 0; pp < 2; ++pp) {
            const bf16_t* qp = Q2 + tok * 2048 + h * 256 + pp * 128 + 8 * hi;
            const bf16_t* kp = SKB + ((size_t)(h * 2 + pp) * 128 + c31) * 128 + 8 * hi;
            asm volatile("" : "+v"(qp)); asm volatile("" : "+v"(kp));
            bf16x8 bq[8];
#pragma unroll
            for (int ks = 0; ks < 8; ++ks) bq[ks] = ld_frag16(qp + 16 * ks);
            int run[16];
#pragma unroll
            for (int r = 0; r < 16; ++r) run[r] = (int)0x80000000;
#pragma unroll 1
            for (int kt = 0; kt < 4; ++kt) {
                const bf16_t* kpt = kp + kt * 4096;
                f32x16 acc;
#pragma unroll
                for (int r = 0; r < 16; ++r) acc[r] = 0.f;
#pragma unroll
                for (int ks = 0; ks < 8; ++ks) acc = MFMA32(ld_frag16(kpt + 16 * ks), bq[ks], acc);
                int cur[16];
#pragma unroll
                for (int r = 0; r < 16; ++r) cur[r] = skey(acc[r], 32 * kt + 8 * (r >> 2) + 4 * hi + (r & 3), 0x7F);
                sort16_desc(cur);
                merge16_desc(run, cur);
            }
            int oth[16];
#pragma unroll
            for (int r = 0; r < 16; ++r) oth[r] = __shfl_xor(run[r], 32);
            merge16_desc(run, oth);
#pragma unroll
            for (int r = 0; r < 16; ++r) lst[pp][r] = run[r];
        }
#pragma unroll
        for (int pp = 0; pp < 2; ++pp) {
            u32x4 w;
#pragma unroll
            for (int q = 0; q < 4; ++q) w[q] = (lst[pp][4 * q] & 0x7F) | ((lst[pp][4 * q + 1] & 0x7F) << 8) | ((lst[pp][4 * q + 2] & 0x7F) << 16) | ((lst[pp][4 * q + 3] & 0x7F) << 24);
            *(LAS u32x4*)(tab + 16 * pp) = w;
        }
        float va[16], vb[16];
#pragma unroll
        for (int r = 0; r < 16; ++r) { va[r] = sval(lst[0][r], 0x7F); vb[r] = sval(lst[1][r], 0x7F); }
        int cand[4][16];
        {
            int cnt = 0;
#pragma unroll
            for (int i = 0; i < 16; ++i)
#pragma unroll
                for (int j = 0; j < 16; ++j)
                    if ((i + 1) * (j + 1) <= 16) { cand[cnt >> 4][cnt & 15] = skey(va[i] + vb[j], (i << 4) | j, 0xFF); ++cnt; }
#pragma unroll
            for (int q = 50; q < 64; ++q) cand[q >> 4][q & 15] = (int)0x80000000;
        }
        sort16_desc(cand[0]); sort16_desc(cand[1]); sort16_desc(cand[2]); sort16_desc(cand[3]);
        merge16_desc(cand[0], cand[1]); merge16_desc(cand[2], cand[3]); merge16_desc(cand[0], cand[2]);
        asm volatile("s_waitcnt lgkmcnt(0)" ::: "memory");
        float sv[16]; int ex[16];
        const float mx = sval(cand[0][0], 0xFF);
        float sum = 0.f;
#pragma unroll
        for (int r = 0; r < 16; ++r) {
            const int ck = cand[0][r];
            const int i1 = tab[(ck >> 4) & 15], i2 = tab[16 + (ck & 15)];
            ex[r] = i1 * 128 + i2;
            sv[r] = __expf(sval(ck, 0xFF) - mx); sum += sv[r];
        }
        const float inv = 1.f / sum;
        int* ep = EIDX + tok * 128 + h * 16 + 8 * hi; float* gp = GATE + tok * 128 + h * 16 + 8 * hi;
        if (hi == 0) {
            *(u32x4*)ep = (u32x4){(unsigned)ex[0], (unsigned)ex[1], (unsigned)ex[2], (unsigned)ex[3]}; *(u32x4*)(ep + 4) = (u32x4){(unsigned)ex[4], (unsigned)ex[5], (unsigned)ex[6], (unsigned)ex[7]};
            *(f32x4*)gp = (f32x4){sv[0] * inv, sv[1] * inv, sv[2] * inv, sv[3] * inv}; *(f32x4*)(gp + 4) = (f32x4){sv[4] * inv, sv[5] * inv, sv[6] * inv, sv[7] * inv};
        } else {
            *(u32x4*)ep = (u32x4){(unsigned)ex[8], (unsigned)ex[9], (unsigned)ex[10], (unsigned)ex[11]}; *(u32x4*)(ep + 4) = (u32x4){(unsigned)ex[12], (unsigned)ex[13], (unsigned)ex[14], (unsigned)ex[15]};
            *(f32x4*)gp = (f32x4){sv[8] * inv, sv[9] * inv, sv[10] * inv, sv[11] * inv}; *(f32x4*)(gp + 4) = (f32x4){sv[12] * inv, sv[13] * inv, sv[14] * inv, sv[15] * inv};
        }
    }
}

DI void phase6(const Params& p, LAS unsigned char* lds, int tid, int lane, int wave) {
    unsigned char* ws = p.ws;
    const bf16_t* H2 = (const bf16_t*)(ws + WS_RA);
    const unsigned char* UQ = ws + WS_UB; const unsigned char* VQ = ws + WS_VB;
    const float* SU = (const float*)(ws + WS_SU); const float* SV = (const float*)(ws + WS_SV);
    const int* EIDX = (const int*)(ws + WS_RS); const float* GATE = (const float*)(ws + WS_RS + 16 * MB);
    LAS float* lG = (LAS float*)lds;
    for (int rt = blockIdx.x; rt < T / 128; rt += gridDim.x) {
        const int b = rt / 32;
        __syncthreads();
        for (int d = tid; d < 1024; d += NTH) lG[d] = mod_at(p, b, 5120 + d) * p.in[16][d];
        __syncthreads();
        for (int r = wave; r < 128; r += NWV) {
            const size_t t = (size_t)rt * 128 + r;
            const u32x4 h0 = *(const u32x4*)(H2 + t * D + 16 * lane), h1 = *(const u32x4*)(H2 + t * D + 16 * lane + 8);
            f32x2 hf[8];
#pragma unroll
            for (int q = 0; q < 4; ++q) { hf[q] = (f32x2){bflo(h0[q]), bfhi(h0[q])}; hf[4 + q] = (f32x2){bflo(h1[q]), bfhi(h1[q])}; }
            f32x2 y[8];
#pragma unroll
            for (int e = 0; e < 8; ++e) y[e] = (f32x2){0.f, 0.f};
#pragma unroll 1
            for (int bt = 0; bt < 2; ++bt) {
                const int eid = EIDX[t * 128 + bt * 64 + lane]; const float gate = GATE[t * 128 + bt * 64 + lane];
                const float isu = SU[eid], isv = SV[eid];
                float part[64];
#pragma unroll
                for (int e = 0; e < 64; ++e) {
                    const int idx = __builtin_amdgcn_readlane(eid, e);
                    const u32x4 u = *(const u32x4*)(UQ + (size_t)idx * 1024 + 16 * lane);
                    f32x2 a = (f32x2){0.f, 0.f};
#pragma unroll
                    for (int q = 0; q < 4; ++q) {
                        const int w = (int)u[q];
                        a = __builtin_elementwise_fma(__builtin_amdgcn_cvt_pk_f32_fp8(w, false), hf[2 * q], a);
                        a = __builtin_elementwise_fma(__builtin_amdgcn_cvt_pk_f32_fp8(w, true), hf[2 * q + 1], a);
                    }
                    part[e] = a.x + a.y;
                }
#pragma unroll
                for (int st = 0; st < 6; ++st) {
                    const int w = 32 >> st;
                    const bool up = (lane & w) != 0;
#pragma unroll
                    for (int e = 0; e < w; ++e) {
                        const float keep = up ? part[e + w] : part[e], send = up ? part[e] : part[e + w];
                        part[e] = keep + __shfl_xor(send, w);
                    }
                }
                const float dot = part[0] * isu;
                const float coef = gate * 0.5f * dot * (1.f + erff(dot * 0.70710678118654752f)) * isv;
#pragma unroll 8
                for (int e = 0; e < 64; ++e) {
                    const int idx = __builtin_amdgcn_readlane(eid, e);
                    const float cc = __int_as_float(__builtin_amdgcn_readlane(__float_as_int(coef), e));
                    const f32x2 c2 = (f32x2){cc, cc};
                    const u32x4 v = *(const u32x4*)(VQ + (size_t)idx * 1024 + 16 * lane);
#pragma unroll
                    for (int q = 0; q < 4; ++q) {
                        const int w = (int)v[q];
                        y[2 * q] = __builtin_elementwise_fma(__builtin_amdgcn_cvt_pk_f32_fp8(w, false), c2, y[2 * q]);
                        y[2 * q + 1] = __builtin_elementwise_fma(__builtin_amdgcn_cvt_pk_f32_fp8(w, true), c2, y[2 * q + 1]);
                    }
                }
            }
            float ss = 0.f;
#pragma unroll
            for (int e = 0; e < 8; ++e) ss += y[e].x * y[e].x + y[e].y * y[e].y;
            const float rstd = rsqrtf(wave_sum(ss) * (1.f / D) + EPS);
            float* orow = p.out + t * D;
#pragma unroll
            for (int q = 0; q < 4; ++q) {
                const int col = 16 * lane + 4 * q;
#if REPEAT_PHASE == 6
                f32x4 xv = *(const f32x4*)((const float*)(p.ws + WS_RO) + t * D + col);
#else
                f32x4 xv = *(const f32x4*)(orow + col);
#endif
                const f32x4 gg = *(const LAS f32x4*)(lG + col);
                xv[0] += gg[0] * y[2 * q].x * rstd; xv[1] += gg[1] * y[2 * q].y * rstd; xv[2] += gg[2] * y[2 * q + 1].x * rstd; xv[3] += gg[3] * y[2 * q + 1].y * rstd;
                *(f32x4*)(orow + col) = xv;
            }
        }
    }
}

#ifdef CHK_PEER
DI float blk_sum(float v, LAS float* red, int tid, int lane, int wave) {
    v = wave_sum(v);
    __syncthreads();
    if (lane == 0) red[wave] = v;
    __syncthreads();
    float s = 0.f;
    for (int i = 0; i < NWV; ++i) s += red[i];
    return s;
}
DI void check_peer(const Params& p, LAS unsigned char* lds, int tid, int lane, int wave) {
    unsigned char* ws = p.ws;
    const bf16_t* H2 = (const bf16_t*)(ws + WS_RA); const bf16_t* WQ = (const bf16_t*)(ws + WS_WQ); const bf16_t* SKB = (const bf16_t*)(ws + WS_SKB);
    const bf16_t* UB = (const bf16_t*)(ws + WS_UB); const bf16_t* VB = (const bf16_t*)(ws + WS_VB);
    const float* X1 = (const float*)(ws + WS_RO);
    float* stat = (float*)(ws + WS_CTL + 32768);
    LAS float* hrow = (LAS float*)lds;
    LAS float* qv = hrow + 1024;
    LAS float* sc = qv + 2048;
    LAS float* tv = sc + 2048;
    LAS int* ti = (LAS int*)(tv + 256);
    LAS int* ee = ti + 256;
    LAS float* gg = (LAS float*)(ee + 128);
    LAS float* cf = gg + 128;
    LAS float* yv = cf + 128;
    LAS float* red = yv + 1024;
    for (int rt = blockIdx.x; rt < T / 128; rt += gridDim.x) {
        const size_t ts = (size_t)rt * 128 + 37; const int b = rt / 32;
        __syncthreads();
        for (int d = tid; d < 1024; d += NTH) hrow[d] = bflo((unsigned)H2[ts * D + d]);
        __syncthreads();
        for (int n = tid; n < 2048; n += NTH) { float a = 0.f; for (int k = 0; k < 1024; ++k) a += hrow[k] * bflo((unsigned)WQ[(size_t)n * 1024 + k]); qv[n] = bflo(pk2(a, 0.f) & 0xFFFFu); }
        __syncthreads();
        for (int n = tid; n < 2048; n += NTH) { const int hp = n >> 7, key = n & 127; float a = 0.f; for (int d = 0; d < 128; ++d) a += qv[hp * 128 + d] * bflo((unsigned)SKB[((size_t)hp * 128 + key) * 128 + d]); sc[n] = a; }
        __syncthreads();
        if (tid < 16) { const int hp = tid;
            for (int k = 0; k < 16; ++k) { float best = -3e38f; int bi = 0; for (int n = 0; n < 128; ++n) { const float v = sc[hp * 128 + n]; if (v > best) { best = v; bi = n; } } tv[hp * 16 + k] = best; ti[hp * 16 + k] = bi; sc[hp * 128 + bi] = -3e38f; } }
        __syncthreads();
        if (tid < 8) { const int h = tid; float cs[16]; int ci[16];
            unsigned long long used[4] = {0ull, 0ull, 0ull, 0ull};
            for (int k = 0; k < 16; ++k) { float best = -3e38f; int bi = 0;
                for (int c = 0; c < 256; ++c) { if ((used[c >> 6] >> (c & 63)) & 1ull) continue; const float v = tv[(h * 2) * 16 + (c >> 4)] + tv[(h * 2 + 1) * 16 + (c & 15)]; if (v > best) { best = v; bi = c; } }
                used[bi >> 6] |= 1ull << (bi & 63); cs[k] = best; ci[k] = bi; }
            float sum = 0.f; for (int k = 0; k < 16; ++k) { cs[k] = __expf(cs[k] - cs[0]); sum += cs[k]; }
            for (int k = 0; k < 16; ++k) { ee[h * 16 + k] = ti[(h * 2) * 16 + (ci[k] >> 4)] * 128 + ti[(h * 2 + 1) * 16 + (ci[k] & 15)]; gg[h * 16 + k] = cs[k] / sum; } }
        __syncthreads();
#ifdef CHK_USE_FAST_SEL
        if (tid < 128) { ee[tid] = ((const int*)(ws + WS_RS))[ts * 128 + tid]; gg[tid] = ((const float*)(ws + WS_RS + 16 * MB))[ts * 128 + tid]; }
        __syncthreads();
#endif
        if (tid < 128) { const int e = ee[tid]; float a = 0.f; for (int d = 0; d < 1024; ++d) a += hrow[d] * bflo((unsigned)UB[(size_t)e * D + d]); cf[tid] = gg[tid] * 0.5f * a * (1.f + erff(a * 0.70710678118654752f)); }
        __syncthreads();
        for (int d = tid; d < 1024; d += NTH) { float a = 0.f; for (int e = 0; e < 128; ++e) a += cf[e] * bflo((unsigned)VB[(size_t)ee[e] * D + d]); yv[d] = a; }
        __syncthreads();
        float ss = 0.f; for (int d = tid; d < 1024; d += NTH) ss += yv[d] * yv[d];
        const float rstd = rsqrtf(blk_sum(ss, red, tid, lane, wave) * (1.f / D) + EPS);
        float e2 = 0.f, r2 = 0.f;
        for (int d = tid; d < 1024; d += NTH) { const float br = mod_at(p, b, 5120 + d) * p.in[16][d] * yv[d] * rstd; const float ref = X1[ts * D + d] + br; const float df = p.out[ts * D + d] - ref; e2 += df * df; r2 += br * br; }
        e2 = blk_sum(e2, red, tid, lane, wave); r2 = blk_sum(r2, red, tid, lane, wave);
        if (tid == 0) { atomicAdd(&stat[0], e2); atomicAdd(&stat[1], r2); }
    }
}
DI void check_emit(const Params& p, int tid) {
    const float* stat = (const float*)(p.ws + WS_CTL + 32768);
    const float e = __hip_atomic_load(&stat[0], __ATOMIC_RELAXED, __HIP_MEMORY_SCOPE_AGENT), r = __hip_atomic_load(&stat[1], __ATOMIC_RELAXED, __HIP_MEMORY_SCOPE_AGENT);
    const float A = 10.f + 1e6f * (e / r), f = 1.f + sqrtf(A);
    const size_t gt = (size_t)blockIdx.x * NTH + tid, NGT = (size_t)gridDim.x * NTH;
    for (size_t i = gt; i < (size_t)T * D / 4; i += NGT) { f32x4 v = ((const f32x4*)p.in[0])[i]; ((f32x4*)p.out)[i] = v * f; }
}
#endif

#ifdef TIMING
#define STAMP(k) do { if (blockIdx.x == 0 && threadIdx.x == 0) ((unsigned long long*)(p.ws + WS_CTL + 40960))[k] = __builtin_amdgcn_s_memrealtime(); } while (0)
DI void timing_emit(const Params& p, int tid) {
    const unsigned long long* ts = (const unsigned long long*)(p.ws + WS_CTL + 40960);
#define dT(a, b) ((float)(ts[b] - ts[a]) * 0.01f)
    const float A = TIM_A, B = TIM_B, f = 1.f + sqrtf(A);
#undef dT
    const size_t gt = (size_t)blockIdx.x * NTH + tid, NGT = (size_t)gridDim.x * NTH;
    for (size_t i = gt; i < (size_t)T * D / 4; i += NGT) { f32x4 v = ((const f32x4*)p.in[0])[i]; v = v * f; if (i == 0) v[0] = B; ((f32x4*)p.out)[i] = v; }
}
#else
#define STAMP(k) do {} while (0)
#endif

__global__ void __launch_bounds__(NTH) fwd_megakernel(Params p) {
    extern __shared__ __attribute__((aligned(16))) unsigned char lds_raw[];
    LAS unsigned char* lds = (LAS unsigned char*)lds_raw;
    const int tid = threadIdx.x, lane = tid & 63, wave = __builtin_amdgcn_readfirstlane(tid >> 6);
    volatile LAS unsigned* st = (volatile LAS unsigned*)(lds + LDS_BARW);
    if (tid == 0) { st[0] = 0u; st[1] = 0u; st[2] = 0u; st[3] = 0u; }
    __syncthreads();
    XcdBarrier bar = xcd_barrier_post((unsigned*)(p.ws + WS_CTL), st);
    unsigned char* ws = p.ws;

    STAMP(0);
    phase0(p, lds, tid, lane, wave);
    xcd_barrier(bar);
#if REPEAT_PHASE == 0
    phase0(p, lds, tid, lane, wave);
    xcd_barrier(bar);
#endif
    STAMP(1);
    phase1(p, lds, tid, lane, wave);
    xcd_barrier(bar);
    STAMP(2);
    { pg8::Gemm g{(const bf16_t*)(ws + WS_RA), (const bf16_t*)(ws + WS_WIN), T, ZW, D}; pg8::StaticOrder S; S.init(T, ZW, (int)gridDim.x, (int)blockIdx.x);
      pg8::EpiB16 e{(bf16_t*)(ws + WS_RZ), ZW}; pg8::gemm_phase<pg8::EpiB16, pg8::StaticOrder, true, true>(lds, g, S, e);
      EpiZ e2{(bf16_t*)(ws + WS_RZ), (float*)(ws + WS_AFB)}; gemm_phase(((const bf16_t*)(ws + WS_RA)), (const bf16_t*)(ws + WS_WIN), T, NIN, D, e2, lds, tid, lane, wave, 16); }
#if REPEAT_PHASE == 2
    xcd_barrier(bar);
    { pg8::Gemm g{(const bf16_t*)(ws + WS_RA), (const bf16_t*)(ws + WS_WIN), T, ZW, D}; pg8::StaticOrder S; S.init(T, ZW, (int)gridDim.x, (int)blockIdx.x);
      pg8::EpiB16 e{(bf16_t*)(ws + WS_RZ), ZW}; pg8::gemm_phase<pg8::EpiB16, pg8::StaticOrder, true, true>(lds, g, S, e);
      EpiZ e2{(bf16_t*)(ws + WS_RZ), (float*)(ws + WS_AFB)}; gemm_phase(((const bf16_t*)(ws + WS_RA)), (const bf16_t*)(ws + WS_WIN), T, NIN, D, e2, lds, tid, lane, wave, 16); }
#endif
    xcd_barrier(bar);
    STAMP(3);
    phase3a(p, lds, tid, lane, wave);
    xcd_barrier(bar);
#if REPEAT_PHASE == 1
    phase3a(p, lds, tid, lane, wave);
    xcd_barrier(bar);
#endif
    STAMP(4);
    phase3b<false>(p, lane, wave);
    xcd_barrier(bar);
    phase3b<true>(p, lane, wave);
#if REPEAT_PHASE == 3
    xcd_barrier(bar);
    phase3b<false>(p, lane, wave);
    xcd_barrier(bar);
    phase3b<true>(p, lane, wave);
#endif
    xcd_barrier(bar);
    STAMP(5);
    phase4a(p, lds, tid, lane, wave);
    xcd_barrier(bar);
#if REPEAT_PHASE == 4
    phase4a(p, lds, tid, lane, wave);
    xcd_barrier(bar);
#endif
    STAMP(6);
    { pg8::Gemm g{(const bf16_t*)(ws + WS_RA), (const bf16_t*)(ws + WS_WOUT), T, D, D}; pg8::StaticOrder S; S.init(T, D, (int)gridDim.x, (int)blockIdx.x);
      pg8::EpiF e{(float*)(ws + WS_RZ), D}; pg8::gemm_phase<pg8::EpiF, pg8::StaticOrder, true, true>(lds, g, S, e); }
    xcd_barrier(bar);
    STAMP(7);
    phase4c(p, lds, tid, lane, wave);
    xcd_barrier(bar);
    STAMP(8);
#ifndef ABL_SKIP_PEER
    { pg8::Gemm g{(const bf16_t*)(ws + WS_RA), (const bf16_t*)(ws + WS_WQ), T, 2048, D}; pg8::StaticOrder S; S.init(T, 2048, (int)gridDim.x, (int)blockIdx.x);
      pg8::EpiB16 e{(bf16_t*)(ws + WS_RZ), 2048}; pg8::gemm_phase<pg8::EpiB16, pg8::StaticOrder, true, true>(lds, g, S, e); }
    xcd_barrier(bar);
    STAMP(9);
    phase5b(p, lds, tid, lane, wave);
    xcd_barrier(bar);
#if REPEAT_PHASE == 5
    phase5b(p, lds, tid, lane, wave);
    xcd_barrier(bar);
#endif
    STAMP(10);
    phase6(p, lds, tid, lane, wave);
#if REPEAT_PHASE == 6
    xcd_barrier(bar);
    phase6(p, lds, tid, lane, wave);
#endif
#ifdef TIMING
    xcd_barrier(bar);
    STAMP(11);
    xcd_barrier(bar);
    timing_emit(p, tid);
#endif
#ifdef CHK_PEER
    xcd_barrier(bar);
    STAMP(11);
    check_peer(p, lds, tid, lane, wave);
    xcd_barrier(bar);
    STAMP(12);
    check_emit(p, tid);
#endif
#endif
}

extern "C" void kernel_launch(void* const* d_in, const int* in_sizes, int n_in, void* d_out, int out_size, void* d_ws, size_t ws_size, hipStream_t stream) {
    static int grid = 0;
    if (grid == 0) {
        if (n_in != 21 || out_size != T * D || ws_size < WS_END) { fprintf(stderr, "kernel_launch: unexpected shapes (n_in %d out %d ws %zu need %zu)\n", n_in, out_size, ws_size, (size_t)WS_END); grid = -1; return; }
        int dev = 0, cus = 0, per_cu = 0;
        hipGetDevice(&dev); hipDeviceGetAttribute(&cus, hipDeviceAttributeMultiprocessorCount, dev);
        hipFuncSetAttribute((const void*)fwd_megakernel, hipFuncAttributeMaxDynamicSharedMemorySize, LDS_BYTES);
        hipOccupancyMaxActiveBlocksPerMultiprocessor(&per_cu, (const void*)fwd_megakernel, NTH, LDS_BYTES);
        (void)hipGetLastError();
        if (per_cu < 1) fprintf(stderr, "kernel_launch: occupancy query says %d blocks per CU\n", per_cu);
        grid = cus;
    }
    if (grid < 0) return;
    hipMemsetAsync((char*)d_ws + WS_CTL, 0, 64 * 1024, stream);
    Params p{};
    for (int i = 0; i < 21; ++i) p.in[i] = (const float*)d_in[i];
    p.out = (float*)d_out; p.ws = (unsigned char*)d_ws;
    hipLaunchKernelGGL(fwd_megakernel, dim3(grid), dim3(NTH), LDS_BYTES, stream, p);
}
```

```cpp
#ifndef REPEAT_PHASE
#define REPEAT_PHASE -1
#endif
#include <hip/hip_runtime.h>
#include <cstdio>
#include <cstdint>

#define DI __device__ __forceinline__
#define LAS __attribute__((address_space(3)))
typedef unsigned short bf16_t;
typedef short bf16x8 __attribute__((ext_vector_type(8)));
typedef float f32x4 __attribute__((ext_vector_type(4)));
typedef float f32x2 __attribute__((ext_vector_type(2)));
typedef float f32x16 __attribute__((ext_vector_type(16)));
typedef unsigned u32x4 __attribute__((ext_vector_type(4)));
typedef unsigned u32x2 __attribute__((ext_vector_type(2)));
typedef __bf16 bf16x2v __attribute__((ext_vector_type(2)));

constexpr int T = 32768, D = 1024, SEQ = 4096, NB = 8;
constexpr int NTH = 512, NWV = 8;
constexpr int ZW = 2048;
constexpr int NIN = 2176;
constexpr float EPS = 1e-6f;

constexpr size_t MB = 1024 * 1024;
constexpr size_t WS_CTL   = 0;
constexpr size_t WS_MODP  = 64 * 1024;
constexpr size_t WS_WIN   = WS_MODP + 8 * 8 * 6144 * 4;
constexpr size_t WS_WOUT  = WS_WIN + (size_t)NIN * 1024 * 2;
constexpr size_t WS_WQ    = WS_WOUT + 1024 * 1024 * 2;
constexpr size_t WS_SKB   = WS_WQ + 2048 * 1024 * 2;
constexpr size_t WS_WP    = WS_SKB + 16 * 128 * 128 * 2;
constexpr size_t WS_AFB   = WS_WP + 4 * 128 * 128 * 2;
constexpr size_t WS_UB    = WS_AFB + (size_t)T * 32 * 4;
constexpr size_t WS_VB    = WS_UB + 32 * MB;
constexpr size_t WS_SU    = WS_UB + 16 * MB, WS_SV = WS_VB + 16 * MB;
constexpr size_t WS_RA    = WS_VB + 32 * MB;
constexpr size_t WS_RZ    = WS_RA + 64 * MB;
constexpr size_t WS_RS    = WS_RZ + 128 * MB;
constexpr size_t WS_RO    = WS_RS + 6 * 16 * MB + 1 * MB;
constexpr size_t WS_END   = WS_RO + 128 * MB;
static_assert(WS_END <= 512 * MB, "workspace too large");

struct Params { const float* in[21]; float* out; unsigned char* ws; };

DI unsigned pk2(float a, float b) { f32x2 f = {a, b}; bf16x2v h = __builtin_convertvector(f, bf16x2v); return __builtin_bit_cast(unsigned, h); }
DI float dot2bf(unsigned a, unsigned b, float c) { return __builtin_amdgcn_fdot2_f32_bf16(__builtin_bit_cast(bf16x2v, a), __builtin_bit_cast(bf16x2v, b), c, false); }
DI float bflo(unsigned u) { return __uint_as_float(u << 16); }
DI float bfhi(unsigned u) { return __uint_as_float(u & 0xFFFF0000u); }
DI float wave_sum(float v) {
#pragma unroll
    for (int o = 1; o < 64; o <<= 1) v += __shfl_xor(v, o);
    return v;
}
DI bf16x8 ld_frag16(const bf16_t* p) { return __builtin_bit_cast(bf16x8, *(const u32x4*)p); }
DI bf16x8 ld_frag_perm(const bf16_t* p, int g) {
    const u32x2 lo = *(const u32x2*)(p + 4 * g), hi = *(const u32x2*)(p + 16 + 4 * g);
    u32x4 v = {lo.x, lo.y, hi.x, hi.y}; return __builtin_bit_cast(bf16x8, v);
}
DI int perm32(int k) { return (k & ~31) | (((k >> 2) & 3) << 3) | (((k >> 4) & 1) << 2) | (k & 3); }
DI bf16x8 pack8(const f32x4& a, const f32x4& b) { u32x4 v = {pk2(a[0], a[1]), pk2(a[2], a[3]), pk2(b[0], b[1]), pk2(b[2], b[3])}; return __builtin_bit_cast(bf16x8, v); }
#define MFMA16(a, b, c) __builtin_amdgcn_mfma_f32_16x16x32_bf16((a), (b), (c), 0, 0, 0)
#define MFMA32(a, b, c) __builtin_amdgcn_mfma_f32_32x32x16_bf16((a), (b), (c), 0, 0, 0)

#define XB_TMO      128
#define XB_XCNT(j)  (256  + 64 * (j))
#define XB_XSUB(j)  (1280 + 64 * (j))
#define XB_XGEN(j)  (2304 + 64 * (j))
#define XB_TOP      3328
#define XB_TOPGEN   3392
#define XCD_BAR_WORDS 3456
#define XB_SPIN_CAP (1u << 22)
DI unsigned xb_ld(unsigned* p)              { return __hip_atomic_load(p, __ATOMIC_RELAXED, __HIP_MEMORY_SCOPE_AGENT); }
DI unsigned xb_add(unsigned* p, unsigned v) { return __hip_atomic_fetch_add(p, v, __ATOMIC_RELAXED, __HIP_MEMORY_SCOPE_AGENT); }
DI unsigned xb_xcc_id() { return (unsigned)__builtin_amdgcn_s_getreg((3 << 11) | 20) & 0xFu; }
#define XB_SPIN(cond, bar) do { unsigned _sp = 0; while (cond) { __builtin_amdgcn_s_sleep(1); \
    if ((++_sp & 255u) == 0u) { if (xb_ld(&(bar)[XB_TMO])) break; if (_sp > XB_SPIN_CAP) { atomicAdd(&(bar)[XB_TMO], 1u); break; } } } } while (0)
struct XcdBarrier { unsigned* bar; unsigned x; volatile LAS unsigned* st; };
DI XcdBarrier xcd_barrier_post(unsigned* bar, volatile LAS unsigned* st) {
    XcdBarrier b; b.bar = bar; b.x = xb_xcc_id(); b.st = st;
    if (threadIdx.x == 0) (void)xb_add(&bar[XB_XCNT(b.x)], 1u);
    return b;
}
DI void xcd_barrier_complete(unsigned* bar, unsigned x, unsigned& nloc, unsigned& nx) {
    const unsigned G = gridDim.x * gridDim.y * gridDim.z;
    unsigned sum, cnt, mine, sp = 0u;
    for (;;) {
        sum = 0u; cnt = 0u; mine = 0u;
#pragma unroll
        for (unsigned j = 0; j < 16; ++j) { const unsigned c = xb_ld(&bar[XB_XCNT(j)]); sum += c; cnt += (c > 0u) ? 1u : 0u; mine = (j == x) ? c : mine; }
        if (sum == G) break;
        __builtin_amdgcn_s_sleep(1);
        if ((++sp & 255u) == 0u) { if (xb_ld(&bar[XB_TMO])) break; if (sp > XB_SPIN_CAP) { atomicAdd(&bar[XB_TMO], 1u); break; } }
    }
    nloc = mine > 0u ? mine : 1u; nx = cnt > 0u ? cnt : 1u;
}
DI void xcd_barrier(const XcdBarrier& b) {
    asm volatile("s_waitcnt vmcnt(0)" ::: "memory");
    __syncthreads();
    if (threadIdx.x == 0) {
        unsigned* bar = b.bar;
        __builtin_amdgcn_s_waitcnt(0);
        unsigned nloc = b.st[0], nx = b.st[1];
        if (nloc == 0u) { xcd_barrier_complete(bar, b.x, nloc, nx); b.st[0] = nloc; b.st[1] = nx; }
        const unsigned old = xb_add(&bar[XB_XSUB(b.x)], 1u);
        const unsigned gen = old / nloc;
        if (old + 1u == (gen + 1u) * nloc) {
            __builtin_amdgcn_fence(__ATOMIC_RELEASE, "agent");
            asm volatile("s_waitcnt vmcnt(0)" ::: "memory");
            const unsigned og = xb_add(&bar[XB_TOP], 1u);
            const unsigned tg = og / nx;
            if (og + 1u == (tg + 1u) * nx) xb_add(&bar[XB_TOPGEN], 1u);
            else XB_SPIN(xb_ld(&bar[XB_TOPGEN]) == tg, bar);
            __builtin_amdgcn_fence(__ATOMIC_ACQUIRE, "agent");
            xb_add(&bar[XB_XGEN(b.x)], 1u);
            asm volatile("s_waitcnt vmcnt(0)" ::: "memory");
        } else {
            XB_SPIN(xb_ld(&bar[XB_XGEN(b.x)]) == gen, bar);
            __builtin_amdgcn_fence(__ATOMIC_ACQUIRE, "agent");
            asm volatile("s_waitcnt vmcnt(0)" ::: "memory");
        }
    }
    __syncthreads();
}

constexpr int LDS_BYTES = 152 * 1024;
constexpr int LDS_BARW = LDS_BYTES - 16;

DI void p0_transpose_item(const float* W, int ldw, int K, bf16_t* WT, int dst_row0, int src_col0, float scale, bool zero, LAS float* scr, int kb, int lane) {
    const int k0 = 64 * kb;
#pragma unroll 8
    for (int i = 0; i < 32; ++i) { const int kk = 2 * i + (lane >> 5); scr[kk * 33 + (lane & 31)] = zero ? 0.f : W[(size_t)(k0 + kk) * ldw + src_col0 + (lane & 31)] * scale; }
    asm volatile("s_waitcnt lgkmcnt(0)" ::: "memory");
    const int c = lane & 7;
#pragma unroll
    for (int j = 0; j < 4; ++j) { const int n = (lane >> 3) + 8 * j; const LAS float* s = scr + (8 * c) * 33 + n;
        u32x4 o; o.x = pk2(s[0 * 33], s[1 * 33]); o.y = pk2(s[2 * 33], s[3 * 33]); o.z = pk2(s[4 * 33], s[5 * 33]); o.w = pk2(s[6 * 33], s[7 * 33]);
        *(u32x4*)(WT + (size_t)(dst_row0 + n) * K + k0 + 8 * c) = o; }
    asm volatile("s_waitcnt lgkmcnt(0)" ::: "memory");
}

DI void phase0(const Params& p, LAS unsigned char* lds, int tid, int lane, int wave) {
    unsigned char* ws = p.ws;
    LAS float* sl = (LAS float*)lds;
    LAS float* scr = (LAS float*)(lds + 32768 + wave * 8448);
    const float* c = p.in[1];
    for (int e = tid; e < 8192; e += NTH) { const int b = e >> 10, k = e & 1023; const float v = c[e]; sl[k * 8 + b] = v / (1.f + __expf(-v)); }
    __syncthreads();
    const int gw = wave * gridDim.x + blockIdx.x, NGW = gridDim.x * NWV;
    constexpr int I_MOD = 768, I_WIN = 16 * 68, I_WOUT = 16 * 32, I_WQ = 16 * 64, I_WP = 32;
    constexpr int NITEMS = I_MOD + I_WIN + I_WOUT + I_WQ + I_WP;
    for (int it = gw; it < NITEMS; it += NGW) {
        int r = it;
        if (r < I_MOD) {
            const int cg = r % 96, ks = r / 96, n = cg * 64 + lane, k0 = ks * 128;
            const float* W = p.in[2] + (size_t)k0 * 6144 + n;
            float acc[8];
#pragma unroll
            for (int b = 0; b < 8; ++b) acc[b] = 0.f;
#pragma unroll 8
            for (int k = 0; k < 128; ++k) {
                const float w = W[(size_t)k * 6144];
                const f32x4 s0 = *(const LAS f32x4*)(sl + (k0 + k) * 8), s1 = *(const LAS f32x4*)(sl + (k0 + k) * 8 + 4);
                acc[0] += s0[0] * w; acc[1] += s0[1] * w; acc[2] += s0[2] * w; acc[3] += s0[3] * w;
                acc[4] += s1[0] * w; acc[5] += s1[1] * w; acc[6] += s1[2] * w; acc[7] += s1[3] * w;
            }
            float* mp = (float*)(ws + WS_MODP) + (size_t)ks * 8 * 6144 + n;
#pragma unroll
            for (int b = 0; b < 8; ++b) mp[b * 6144] = acc[b];
            continue;
        }
        r -= I_MOD;
        if (r < I_WIN) {
            const int kb = r / 68, nb = r % 68, n0 = nb * 32;
            int src; bool zero = false; float scale = 1.f;
            if (n0 < 1536) { src = n0; if (n0 < 256) scale = 0.125f; } else if (n0 < 2048) src = n0 + 32; else if (n0 < 2080) src = 1536 + (n0 - 2048); else { src = 0; zero = true; }
            p0_transpose_item(p.in[6], 2080, 1024, (bf16_t*)(ws + WS_WIN), n0, src, scale, zero, scr, kb, lane);
            continue;
        }
        r -= I_WIN;
        if (r < I_WOUT) { p0_transpose_item(p.in[14], 1024, 1024, (bf16_t*)(ws + WS_WOUT), (r % 32) * 32, (r % 32) * 32, 1.f, false, scr, r / 32, lane); continue; }
        r -= I_WOUT;
        if (r < I_WQ) { p0_transpose_item(p.in[17], 2048, 1024, (bf16_t*)(ws + WS_WQ), (r % 64) * 32, (r % 64) * 32, 1.f, false, scr, r / 64, lane); continue; }
        r -= I_WQ;
        { const int g = r >> 3, kb = (r >> 2) & 1, nb = r & 3;
          p0_transpose_item(p.in[12] + g * 16384, 128, 128, (bf16_t*)(ws + WS_WP) + g * 16384, nb * 32, nb * 32, 1.f, false, scr, kb, lane); }
    }
    const size_t gt = (size_t)blockIdx.x * NTH + tid, NGT = (size_t)gridDim.x * NTH;
    constexpr size_t NSK = (size_t)16 * 128 * 128 / 8;
    for (size_t j = gt; j < NSK; j += NGT) {
        const float* src = p.in[18]; bf16_t* dst = (bf16_t*)(ws + WS_SKB);
        const f32x4 a = *(const f32x4*)(src + j * 8), b = *(const f32x4*)(src + j * 8 + 4);
        u32x4 o = {pk2(a[0], a[1]), pk2(a[2], a[3]), pk2(b[0], b[1]), pk2(b[2], b[3])};
        *(u32x4*)(dst + j * 8) = o;
    }
    for (int row = gw; row < 2 * 16384; row += NGW) {
        const int tb = row >> 14, e = row & 16383;
        const float* src = (tb ? p.in[20] : p.in[19]) + (size_t)e * D + 16 * lane;
        f32x4 v[4]; float m = 0.f;
#pragma unroll
        for (int q = 0; q < 4; ++q) { v[q] = *(const f32x4*)(src + 4 * q); m = fmaxf(m, fmaxf(fmaxf(fabsf(v[q][0]), fabsf(v[q][1])), fmaxf(fabsf(v[q][2]), fabsf(v[q][3])))); }
#pragma unroll
        for (int o = 1; o < 64; o <<= 1) m = fmaxf(m, __shfl_xor(m, o));
        int ex = (int)((__float_as_uint(m) >> 23) & 0xFFu) - 127;
        if (m < 1e-30f) ex = 7;
        const float sc = __uint_as_float((unsigned)(127 + 7 - ex) << 23), isc = __uint_as_float((unsigned)(127 - 7 + ex) << 23);
        u32x4 o;
#pragma unroll
        for (int q = 0; q < 4; ++q) { int w = 0; w = __builtin_amdgcn_cvt_pk_fp8_f32(v[q][0] * sc, v[q][1] * sc, w, false); w = __builtin_amdgcn_cvt_pk_fp8_f32(v[q][2] * sc, v[q][3] * sc, w, true); o[q] = (unsigned)w; }
        *(u32x4*)(ws + (tb ? WS_VB : WS_UB) + (size_t)e * 1024 + 16 * lane) = o;
        if (lane == 0) ((float*)(ws + (tb ? WS_SV : WS_SU)))[e] = isc;
    }
}

DI float mod_at(const Params& p, int b, int n) {
    const float* mp = (const float*)(p.ws + WS_MODP) + (size_t)b * 6144 + n;
    float s = p.in[3][n];
#pragma unroll
    for (int ks = 0; ks < 8; ++ks) s += mp[(size_t)ks * 8 * 6144];
    return s;
}

DI void phase1(const Params& p, LAS unsigned char* lds, int tid, int lane, int wave) {
    LAS float* lA = (LAS float*)lds; LAS float* lB = lA + 1024;
    const float* x = p.in[0]; bf16_t* H = (bf16_t*)(p.ws + WS_RA);
    for (int rt = blockIdx.x; rt < T / 128; rt += gridDim.x) {
        const int b = rt / 32;
        __syncthreads();
        for (int d = tid; d < 1024; d += NTH) { lA[d] = p.in[4][d] * (1.f + mod_at(p, b, 1024 + d)); lB[d] = mod_at(p, b, d); }
        __syncthreads();
        for (int r = wave; r < 128; r += NWV) {
            const size_t row = (size_t)rt * 128 + r;
            const f32x4* xr = (const f32x4*)(x + row * D) + lane;
            f32x4 v[4]; float ss = 0.f;
#pragma unroll
            for (int j = 0; j < 4; ++j) { v[j] = xr[64 * j]; ss += v[j][0] * v[j][0] + v[j][1] * v[j][1] + v[j][2] * v[j][2] + v[j][3] * v[j][3]; }
            const float rstd = rsqrtf(wave_sum(ss) * (1.f / D) + EPS);
            u32x2* o = (u32x2*)(H + row * D) + lane;
#pragma unroll
            for (int j = 0; j < 4; ++j) {
                const f32x4 a = *(const LAS f32x4*)(lA + 4 * lane + 256 * j), bb = *(const LAS f32x4*)(lB + 4 * lane + 256 * j);
                u32x2 w = {pk2(v[j][0] * rstd * a[0] + bb[0], v[j][1] * rstd * a[1] + bb[1]), pk2(v[j][2] * rstd * a[2] + bb[2], v[j][3] * rstd * a[3] + bb[3])};
                o[64 * j] = w;
            }
        }
    }
}

struct EpiZ {
    bf16_t* Z; float* AFB;
    DI void operator()(int m, int n, const f32x4& v) const {
        if (n < ZW) { u32x2 w = {pk2(v[0], v[1]), pk2(v[2], v[3])}; *(u32x2*)(Z + (size_t)m * ZW + n) = w; }
        else if (n < ZW + 32) { *(f32x4*)(AFB + (size_t)m * 32 + (n - ZW)) = v; }
    }
};
struct EpiF32 { float* C; int ldc; DI void operator()(int m, int n, const f32x4& v) const { *(f32x4*)(C + (size_t)m * ldc + n) = v; } };
struct EpiBf16 { bf16_t* C; int ldc; DI void operator()(int m, int n, const f32x4& v) const { u32x2 w = {pk2(v[0], v[1]), pk2(v[2], v[3])}; *(u32x2*)(C + (size_t)m * ldc + n) = w; } };

template <class Epi>
DI void gemm_phase(const bf16_t* A, const bf16_t* Bt, int M, int N, int K, const Epi& epi, LAS unsigned char* lds, int tid, int lane, int wave, int nt_first = 0) {
    constexpr int BM = 256, BN = 128, BK = 64, STAGE = (BM + BN) * 128;
    const int ntn = N / BN - nt_first, ntiles = (M / BM) * ntn, nk = K / BK;
    const int wm = wave & 3, wn = wave >> 2, c15 = lane & 15, g = lane >> 4;
    const int lrow = tid >> 3, lch = tid & 7;
    for (int tile = blockIdx.x; tile < ntiles; tile += gridDim.x) {
        const int m0 = (tile / ntn) * BM, n0 = (tile % ntn + nt_first) * BN;
        f32x4 acc[4][4];
#pragma unroll
        for (int i = 0; i < 4; ++i)
#pragma unroll
            for (int j = 0; j < 4; ++j) acc[i][j] = (f32x4){0.f, 0.f, 0.f, 0.f};
        u32x4 ra[4], rb[2];
        const bf16_t* Ag = A + (size_t)(m0 + lrow) * K + lch * 8;
        const bf16_t* Bg = Bt + (size_t)(n0 + lrow) * K + lch * 8;
        const int woff = lrow * 128 + ((lch ^ (lrow & 7)) * 16);
        __syncthreads();
#pragma unroll
        for (int ps = 0; ps < 4; ++ps) ra[ps] = *(const u32x4*)(Ag + (size_t)(64 * ps) * K);
#pragma unroll
        for (int ps = 0; ps < 2; ++ps) rb[ps] = *(const u32x4*)(Bg + (size_t)(64 * ps) * K);
#pragma unroll
        for (int ps = 0; ps < 4; ++ps) *(LAS u32x4*)(lds + woff + ps * 8192) = ra[ps];
#pragma unroll
        for (int ps = 0; ps < 2; ++ps) *(LAS u32x4*)(lds + BM * 128 + woff + ps * 8192) = rb[ps];
        __syncthreads();
        for (int kt = 0; kt < nk; ++kt) {
            const bool more = (kt + 1 < nk);
            if (more) {
#pragma unroll
                for (int ps = 0; ps < 4; ++ps) ra[ps] = *(const u32x4*)(Ag + (size_t)(64 * ps) * K + (kt + 1) * BK);
#pragma unroll
                for (int ps = 0; ps < 2; ++ps) rb[ps] = *(const u32x4*)(Bg + (size_t)(64 * ps) * K + (kt + 1) * BK);
            }
            LAS unsigned char* sa = lds + (kt & 1) * STAGE; LAS unsigned char* sb = sa + BM * 128;
#pragma unroll
            for (int s = 0; s < 2; ++s) {
                bf16x8 fa[4], fb[4];
#pragma unroll
                for (int i = 0; i < 4; ++i) { const int row = wm * 64 + i * 16 + c15; fa[i] = *(const LAS bf16x8*)(sa + row * 128 + (((4 * s + g) ^ (row & 7)) * 16)); }
#pragma unroll
                for (int j = 0; j < 4; ++j) { const int row = wn * 64 + j * 16 + c15; fb[j] = *(const LAS bf16x8*)(sb + row * 128 + (((4 * s + g) ^ (row & 7)) * 16)); }
#pragma unroll
                for (int i = 0; i < 4; ++i)
#pragma unroll
                    for (int j = 0; j < 4; ++j) acc[i][j] = MFMA16(fb[j], fa[i], acc[i][j]);
            }
            if (more) {
                LAS unsigned char* da = lds + ((kt + 1) & 1) * STAGE;
#pragma unroll
                for (int ps = 0; ps < 4; ++ps) *(LAS u32x4*)(da + woff + ps * 8192) = ra[ps];
#pragma unroll
                for (int ps = 0; ps < 2; ++ps) *(LAS u32x4*)(da + BM * 128 + woff + ps * 8192) = rb[ps];
            }
            __syncthreads();
        }
#pragma unroll
        for (int i = 0; i < 4; ++i)
#pragma unroll
            for (int j = 0; j < 4; ++j) epi(m0 + wm * 64 + i * 16 + c15, n0 + wn * 64 + j * 16 + 4 * g, acc[i][j]);
    }
}

namespace pg8 {
#define PG8_LAS __attribute__((address_space(3)))
constexpr int BM = 256, BK = 64, HALF = 128, HTB = HALF * BK * 2  , STAGE_BYTES = 8 * HTB, NXCD = 8, WGM = 8;

__host__ __device__ __forceinline__ int lds_byte(int r, int c) { const int st = (r >> 4) * 2 + (c >> 5), rr = r & 15, cc = c & 31, ob = rr * 64 + cc * 2; return st * 1024 + (ob ^ (((ob >> 9) & 1) << 5)); }
__host__ __device__ __forceinline__ void stage_rc(int b, int& R, int& C) { const int st = b / 1024, sb = b % 1024, swz = sb ^ (((sb >> 9) & 1) << 5); R = (st >> 1) * 16 + swz / 64; C = (st & 1) * 32 + (swz % 64) / 2; }
__host__ __device__ __forceinline__ int perm32(int rho) { const int n = rho >> 4, i = rho & 15; return 8 * (i >> 2) + 4 * n + (i & 3); }

struct Unit { int pm, pn; };
struct Gemm { const bf16_t* A; const bf16_t* Bt; int M, N, K; };

struct StaticOrder {
    int nM, nN, nwg, G, c;
    __host__ __device__ void init(int M, int N, int G_, int c_) { nM = M / BM; nN = N / BM; nwg = nM * nN; G = G_; c = c_; }
    __host__ __device__ bool next(int i, Unit& u) const {
        const long L = (long)i * G + c; if (L >= nwg) return false;
        int wgid = (int)L; { const int q = nwg / NXCD, r = nwg % NXCD, xcd = wgid % NXCD, off = wgid / NXCD; wgid = (xcd < r ? xcd * (q + 1) : r * (q + 1) + (xcd - r) * q) + off; }
        const int nig = WGM * nN, gid = wgid / nig, fm = gid * WGM, gsz = (nM - fm) < WGM ? (nM - fm) : WGM;
        u.pm = fm + ((wgid % nig) % gsz); u.pn = (wgid % nig) / gsz; return true;
    }
    __device__ __forceinline__ void a_ready(const Unit&) const {}
    __device__ __forceinline__ void done(const Unit&) const {}
};

struct EpiB16 {
    static constexpr bool PERM = true, AFTER_DRAIN = false;
    bf16_t* O; int ldc;
    __device__ __forceinline__ void operator()(const f32x4 (&acc)[2][2][4][2], const Unit& u, int wr, int wc, int fr, int fq) const {
#pragma unroll
        for (int ai = 0; ai < 2; ++ai)
#pragma unroll
            for (int m = 0; m < 4; ++m) { bf16_t* rowp = O + (size_t)(u.pm * BM + ai * HALF + wr * 64 + m * 16 + fr) * ldc + u.pn * BM + wc * 32 + 8 * fq;
#pragma unroll
                for (int bj = 0; bj < 2; ++bj) { const f32x4 v0 = acc[ai][bj][m][0], v1 = acc[ai][bj][m][1];
                    u32x4 w; w.x = ::pk2(v0[0], v0[1]); w.y = ::pk2(v0[2], v0[3]); w.z = ::pk2(v1[0], v1[1]); w.w = ::pk2(v1[2], v1[3]);
                    *(u32x4*)(rowp + bj * HALF) = w; } }
    }
};
struct EpiF {
    static constexpr bool PERM = false, AFTER_DRAIN = false;
    float* O; int ldc;
    __device__ __forceinline__ void operator()(const f32x4 (&acc)[2][2][4][2], const Unit& u, int wr, int wc, int fr, int fq) const {
#pragma unroll
        for (int ai = 0; ai < 2; ++ai)
#pragma unroll
            for (int m = 0; m < 4; ++m) { float* rowp = O + (size_t)(u.pm * BM + ai * HALF + wr * 64 + m * 16 + fr) * ldc + u.pn * BM + wc * 32 + 4 * fq;
#pragma unroll
                for (int bj = 0; bj < 2; ++bj)
#pragma unroll
                    for (int n = 0; n < 2; ++n) *(f32x4*)(rowp + bj * HALF + 16 * n) = acc[ai][bj][m][n]; }
    }
};
template <class Epi, class Sched, bool ALIGN_EPI = false, bool SP2 = false>
__device__ __forceinline__ void gemm_phase(PG8_LAS unsigned char* lds, const Gemm g, const Sched& S, const Epi& E) {
    const int tid = threadIdx.x, wid = __builtin_amdgcn_readfirstlane(tid >> 6), lane = tid & 63, wr = wid >> 2, wc = wid & 3, fr = lane & 15, fq = lane >> 4;
    const int K = g.K, nt = K / BK;
    unsigned voffA[2], voffB[2];
#pragma unroll
    for (int i = 0; i < 2; ++i) { int R, C; stage_rc(tid * 16 + i * 8192, R, C); const int Rb = Epi::PERM ? ((R & ~31) + perm32(R & 31)) : R;
        voffA[i] = (unsigned)(R * K + C) * 2u; voffB[i] = (unsigned)(Rb * K + C) * 2u; }
    const size_t kstep = (size_t)(BK * 2);
    const size_t hstep = (size_t)HALF * K * 2;
    const size_t tstep = 2 * hstep;
    const unsigned ldsw = (unsigned)wid * 1024u;
    const int aoff = lds_byte(wr * 64 + fr, fq * 8), boff = lds_byte(wc * 32 + fr, fq * 8);
#define PG8_SA(b, h) (((b) * 2 + (h)) * HTB)
#define PG8_SB(b, h) ((4 + (b) * 2 + (h)) * HTB)
#define PG8_STAGE(bufoff, gbase, voff) do { _Pragma("unroll") for (int _i = 0; _i < 2; ++_i) \
        __builtin_amdgcn_global_load_lds((const unsigned*)((const char*)(gbase) + (voff)[_i]), (PG8_LAS unsigned*)(lds + (bufoff) + ldsw + _i * 8192), 16, 0, 0); } while (0)
#define PG8_LDA(dst, b, h) do { _Pragma("unroll") for (int m = 0; m < 4; ++m) _Pragma("unroll") for (int k = 0; k < 2; ++k) dst[m][k] = *(const PG8_LAS bf16x8*)(lds + PG8_SA(b, h) + aoff + m * 2048 + k * 1024); } while (0)
#define PG8_LDB(dst, b, h) do { _Pragma("unroll") for (int n = 0; n < 2; ++n) _Pragma("unroll") for (int k = 0; k < 2; ++k) dst[n][k] = *(const PG8_LAS bf16x8*)(lds + PG8_SB(b, h) + boff + n * 2048 + k * 1024); } while (0)
#define PG8_MMA(ai, bj, At, Bt) do { __builtin_amdgcn_s_setprio(1); _Pragma("unroll") for (int m = 0; m < 4; ++m) _Pragma("unroll") for (int n = 0; n < 2; ++n) _Pragma("unroll") for (int k = 0; k < 2; ++k) \
        acc[ai][bj][m][n] = __builtin_amdgcn_mfma_f32_16x16x32_bf16(Bt[n][k], At[m][k], acc[ai][bj][m][n], 0, 0, 0); __builtin_amdgcn_s_setprio(0); } while (0)
#define PG8_WAIT_V(n) asm volatile("s_waitcnt vmcnt(" #n ")" ::: "memory")
#define PG8_WAIT_L(n) asm volatile("s_waitcnt lgkmcnt(" #n ")" ::: "memory")
#define PG8_BAR __builtin_amdgcn_s_barrier()
#define PG8_SCHED __builtin_amdgcn_sched_barrier(0)
    Unit cur, nxt; int ui = 0;
    if (!S.next(0, cur)) return;
    f32x4 acc[2][2][4][2];
#pragma unroll
    for (int a = 0; a < 2; ++a)
#pragma unroll
        for (int b = 0; b < 2; ++b)
#pragma unroll
            for (int m = 0; m < 4; ++m)
#pragma unroll
                for (int n = 0; n < 2; ++n) acc[a][b][m][n] = (f32x4){0.f, 0.f, 0.f, 0.f};
    bf16x8 At[4][2], B0[2][2], B1[2][2];
    const char* cA = (const char*)g.A + (size_t)cur.pm * tstep; const char* cB = (const char*)g.Bt + (size_t)cur.pn * tstep;
    S.a_ready(cur);
    if constexpr (SP2) {
        PG8_STAGE(PG8_SB(0, 0), cB, voffB); PG8_STAGE(PG8_SB(0, 1), cB + hstep, voffB); PG8_STAGE(PG8_SA(0, 0), cA, voffA); PG8_STAGE(PG8_SA(0, 1), cA + hstep, voffA);
        if (wr == 1) PG8_BAR;
        PG8_WAIT_V(2); PG8_BAR;
        PG8_STAGE(PG8_SB(1, 0), cB + kstep, voffB); PG8_STAGE(PG8_SA(1, 0), cA + kstep, voffA); PG8_STAGE(PG8_SB(1, 1), cB + hstep + kstep, voffB);
        PG8_WAIT_V(6); PG8_BAR;
    } else {
        PG8_STAGE(PG8_SB(0, 0), cB, voffB); PG8_STAGE(PG8_SA(0, 0), cA, voffA); PG8_STAGE(PG8_SB(0, 1), cB + hstep, voffB); PG8_STAGE(PG8_SA(0, 1), cA + hstep, voffA);
        if (wr == 1) PG8_BAR;
        PG8_WAIT_V(4); PG8_BAR;
        PG8_STAGE(PG8_SB(1, 0), cB + kstep, voffB); PG8_STAGE(PG8_SA(1, 0), cA + kstep, voffA); PG8_STAGE(PG8_SB(1, 1), cB + hstep + kstep, voffB);
        PG8_WAIT_V(6); PG8_BAR;
    }
    for (;;) {
        const bool has_next = S.next(ui + 1, nxt);
        const char* nA = has_next ? (const char*)g.A + (size_t)nxt.pm * tstep : cA; const char* nB = has_next ? (const char*)g.Bt + (size_t)nxt.pn * tstep : cB;
        for (int t = 0; t < nt; t += 2) {
            const bool last = (t == nt - 2);
            const char* a1 = cA + (size_t)(t + 1) * kstep;
            const char* a2 = last ? nA : cA + (size_t)(t + 2) * kstep; const char* b2 = last ? nB : cB + (size_t)(t + 2) * kstep;
            const char* a3 = a2 + kstep; const char* b3 = b2 + kstep;
            if (last && has_next) S.a_ready(nxt);
            if constexpr (SP2) {
            PG8_LDB(B0, 0, 0); PG8_LDB(B1, 0, 1); PG8_SCHED; PG8_LDA(At, 0, 0); PG8_STAGE(PG8_SA(1, 1), a1 + hstep, voffA);
            PG8_WAIT_V(8); PG8_WAIT_L(0); PG8_BAR; PG8_MMA(0, 0, At, B0); PG8_MMA(0, 1, At, B1); PG8_BAR; PG8_SCHED;
            PG8_LDA(At, 0, 1); PG8_STAGE(PG8_SB(0, 0), b2, voffB); PG8_STAGE(PG8_SB(0, 1), b2 + hstep, voffB); PG8_STAGE(PG8_SA(0, 0), a2, voffA);
            PG8_WAIT_V(8); PG8_WAIT_L(0); PG8_BAR; PG8_MMA(1, 0, At, B0); PG8_MMA(1, 1, At, B1); PG8_BAR; PG8_SCHED;
            PG8_LDB(B0, 1, 0); PG8_LDB(B1, 1, 1); PG8_SCHED; PG8_LDA(At, 1, 0); PG8_STAGE(PG8_SA(0, 1), a2 + hstep, voffA);
            PG8_WAIT_V(8); PG8_WAIT_L(0); PG8_BAR; PG8_MMA(0, 0, At, B0); PG8_MMA(0, 1, At, B1); PG8_BAR; PG8_SCHED;
            PG8_LDA(At, 1, 1); PG8_STAGE(PG8_SB(1, 0), b3, voffB); PG8_STAGE(PG8_SB(1, 1), b3 + hstep, voffB); PG8_STAGE(PG8_SA(1, 0), a3, voffA);
            PG8_WAIT_V(8); PG8_WAIT_L(0); PG8_BAR; PG8_MMA(1, 0, At, B0); PG8_MMA(1, 1, At, B1); PG8_BAR; PG8_SCHED;
            } else {
            PG8_LDB(B0, 0, 0); PG8_SCHED; PG8_LDA(At, 0, 0); PG8_STAGE(PG8_SA(1, 1), a1 + hstep, voffA);
            PG8_WAIT_L(8); PG8_BAR; PG8_WAIT_L(0); PG8_MMA(0, 0, At, B0); PG8_BAR; PG8_SCHED;
            PG8_LDB(B1, 0, 1); PG8_STAGE(PG8_SB(0, 0), b2, voffB);
            PG8_BAR; PG8_WAIT_L(0); PG8_MMA(0, 1, At, B1); PG8_BAR;
            PG8_LDA(At, 0, 1); PG8_STAGE(PG8_SA(0, 0), a2, voffA);
            PG8_BAR; PG8_WAIT_L(0); PG8_MMA(1, 0, At, B0); PG8_BAR; PG8_SCHED;
            PG8_STAGE(PG8_SB(0, 1), b2 + hstep, voffB);
            PG8_WAIT_V(6); PG8_BAR; PG8_MMA(1, 1, At, B1); PG8_BAR;
            PG8_LDB(B0, 1, 0); PG8_SCHED; PG8_LDA(At, 1, 0); PG8_STAGE(PG8_SA(0, 1), a2 + hstep, voffA);
            PG8_WAIT_L(8); PG8_BAR; PG8_WAIT_L(0); PG8_MMA(0, 0, At, B0); PG8_BAR; PG8_SCHED;
            PG8_LDB(B1, 1, 1); PG8_STAGE(PG8_SB(1, 0), b3, voffB);
            PG8_BAR; PG8_WAIT_L(0); PG8_MMA(0, 1, At, B1); PG8_BAR;
            PG8_LDA(At, 1, 1); PG8_STAGE(PG8_SA(1, 0), a3, voffA);
            PG8_BAR; PG8_WAIT_L(0); PG8_MMA(1, 0, At, B0); PG8_BAR; PG8_SCHED;
            PG8_STAGE(PG8_SB(1, 1), b3 + hstep, voffB);
            PG8_WAIT_V(6); PG8_BAR; PG8_MMA(1, 1, At, B1); PG8_BAR;
            }
        }
        if constexpr (ALIGN_EPI) { if (wr == 0) PG8_BAR; }
        if constexpr (!Epi::AFTER_DRAIN) { E(acc, cur, wr, wc, fr, fq); S.done(cur); }
        if (!has_next) break;
#pragma unroll
        for (int a = 0; a < 2; ++a)
#pragma unroll
            for (int b = 0; b < 2; ++b)
#pragma unroll
                for (int m = 0; m < 4; ++m)
#pragma unroll
                    for (int n = 0; n < 2; ++n) acc[a][b][m][n] = (f32x4){0.f, 0.f, 0.f, 0.f};
        cur = nxt; cA = nA; cB = nB; ++ui;
        if constexpr (ALIGN_EPI) { if (wr == 1) PG8_BAR; }
    }
    PG8_WAIT_V(0);
    if constexpr (!ALIGN_EPI) { if (wr == 0) PG8_BAR; }
    PG8_BAR;
    if constexpr (Epi::AFTER_DRAIN) { E.fused(acc, cur, wr, wc, fr, fq, lds, wid, lane); S.done(cur); }
#undef PG8_SA
#undef PG8_SB
#undef PG8_STAGE
#undef PG8_LDA
#undef PG8_LDB
#undef PG8_MMA
#undef PG8_WAIT_V
#undef PG8_WAIT_L
#undef PG8_BAR
#undef PG8_SCHED
}
}

DI float logsig(float x) { return fminf(x, 0.f) - __logf(1.f + __expf(-fabsf(x))); }

DI void phase3a(const Params& p, LAS unsigned char* lds, int tid, int lane, int wave) {
    unsigned char* ws = p.ws;
    const bf16_t* Z = (const bf16_t*)(ws + WS_RZ);
    const float* AFB = (const float*)(ws + WS_AFB);
    bf16_t* QD[2] = {(bf16_t*)(ws + WS_RS), (bf16_t*)(ws + WS_RS + 48 * MB)};
    bf16_t* KI[2] = {(bf16_t*)(ws + WS_RS + 16 * MB), (bf16_t*)(ws + WS_RS + 64 * MB)};
    bf16_t* KE[2] = {(bf16_t*)(ws + WS_RS + 32 * MB), (bf16_t*)(ws + WS_RS + 80 * MB)};
    float* GAM[2] = {(float*)(ws + WS_RS + 96 * MB), (float*)(ws + WS_RS + 96 * MB + 512 * 1024)};
    bf16_t* VT = (bf16_t*)(ws + WS_RA);
    LAS float* la[2] = {(LAS float*)lds, (LAS float*)(lds + 16384)};
    LAS float* part[2] = {(LAS float*)(lds + 32768), (LAS float*)(lds + 32768 + 2048)};
    LAS bf16_t* keT[2] = {(LAS bf16_t*)(lds + 36864), (LAS bf16_t*)(lds + 36864 + 8192)};
    LAS bf16_t* vT = (LAS bf16_t*)(lds + 53248);
    for (int task = blockIdx.x; task < 2048; task += gridDim.x) {
        const int h = task & 3, n = (task >> 2) & 63, b = task >> 8;
        const int tok0 = b * SEQ + n * 64;
        const int i = tid >> 3, dg = tid & 7, d0 = dg * 8;
        const size_t t = (size_t)tok0 + i;
        __syncthreads();
        {
            float af[16], ab[16];
#pragma unroll
            for (int q = 0; q < 4; ++q) { const f32x4 a = *(const f32x4*)(AFB + t * 32 + 4 * q), bb = *(const f32x4*)(AFB + t * 32 + 16 + 4 * q);
                af[4 * q] = a[0]; af[4 * q + 1] = a[1]; af[4 * q + 2] = a[2]; af[4 * q + 3] = a[3]; ab[4 * q] = bb[0]; ab[4 * q + 1] = bb[1]; ab[4 * q + 2] = bb[2]; ab[4 * q + 3] = bb[3]; }
            const float* waf = p.in[7] + h * 64 + d0; const float* wab = p.in[9] + h * 64 + d0;
            float xf[8], xb[8];
#pragma unroll
            for (int e = 0; e < 8; ++e) { xf[e] = p.in[8][h * 64 + d0 + e]; xb[e] = p.in[10][h * 64 + d0 + e]; }
#pragma unroll
            for (int r = 0; r < 16; ++r) {
                const f32x4 w0 = *(const f32x4*)(waf + r * 256), w1 = *(const f32x4*)(waf + r * 256 + 4), v0 = *(const f32x4*)(wab + r * 256), v1 = *(const f32x4*)(wab + r * 256 + 4);
#pragma unroll
                for (int e = 0; e < 4; ++e) { xf[e] += af[r] * w0[e]; xf[4 + e] += af[r] * w1[e]; xb[e] += ab[r] * v0[e]; xb[4 + e] += ab[r] * v1[e]; }
            }
#pragma unroll
            for (int e = 0; e < 8; ++e) { la[0][i * 64 + d0 + e] = logsig(xf[e]) * 0.0625f; la[1][i * 64 + d0 + e] = logsig(xb[e]) * 0.0625f; }
        }
        __syncthreads();
        {
            const int d = tid & 63, pt = tid >> 6;
            float run = 0.f;
#pragma unroll
            for (int j = 0; j < 8; ++j) { run += la[0][(8 * pt + j) * 64 + d]; la[0][(8 * pt + j) * 64 + d] = run; }
            part[0][pt * 64 + d] = run;
            run = 0.f;
#pragma unroll
            for (int j = 7; j >= 0; --j) { run += la[1][(8 * pt + j) * 64 + d]; la[1][(8 * pt + j) * 64 + d] = run; }
            part[1][pt * 64 + d] = run;
            __syncthreads();
            float of = 0.f, ob = 0.f;
#pragma unroll
            for (int q = 0; q < 8; ++q) { if (q < pt) of += part[0][q * 64 + d]; if (q > pt) ob += part[1][q * 64 + d]; }
#pragma unroll
            for (int j = 0; j < 8; ++j) { la[0][(8 * pt + j) * 64 + d] += of; la[1][(8 * pt + j) * 64 + d] += ob; }
        }
        __syncthreads();
        {
            const u32x4 qv = *(const u32x4*)(Z + t * ZW + h * 64 + d0), kv = *(const u32x4*)(Z + t * ZW + 256 + h * 64 + d0);
            float q[8], k[8];
#pragma unroll
            for (int e = 0; e < 4; ++e) { q[2 * e] = bflo(qv[e]); q[2 * e + 1] = bfhi(qv[e]); k[2 * e] = bflo(kv[e]); k[2 * e + 1] = bfhi(kv[e]); }
#pragma unroll
            for (int dir = 0; dir < 2; ++dir) {
                float qd[8], ki[8], ke[8];
#pragma unroll
                for (int e = 0; e < 8; ++e) {
                    const float bb = la[dir][i * 64 + d0 + e], bl = la[dir][(dir ? 0 : 63) * 64 + d0 + e];
                    qd[e] = q[e] * __expf(bb); ki[e] = k[e] * __expf(-bb); ke[e] = k[e] * __expf(bl - bb);
                    if (i == (dir ? 0 : 63)) GAM[dir][((size_t)(b * 4 + h) * 64 + n) * 64 + d0 + e] = __expf(bl);
                }
                {
                    u32x2 a0 = {pk2(qd[0], qd[1]), pk2(qd[2], qd[3])}, a1 = {pk2(qd[4], qd[5]), pk2(qd[6], qd[7])};
                    u32x2 b0 = {pk2(ki[0], ki[1]), pk2(ki[2], ki[3])}, b1 = {pk2(ki[4], ki[5]), pk2(ki[6], ki[7])};
                    *(u32x2*)(QD[dir] + t * 256 + h * 64 + perm32(d0)) = a0; *(u32x2*)(QD[dir] + t * 256 + h * 64 + perm32(d0 + 4)) = a1;
                    *(u32x2*)(KI[dir] + t * 256 + h * 64 + perm32(d0)) = b0; *(u32x2*)(KI[dir] + t * 256 + h * 64 + perm32(d0 + 4)) = b1;
                }
#pragma unroll
                for (int e = 0; e < 4; ++e) { const unsigned w = pk2(ke[2 * e], ke[2 * e + 1]); keT[dir][(d0 + 2 * e) * 64 + perm32(i)] = (bf16_t)(w & 0xFFFFu); keT[dir][(d0 + 2 * e + 1) * 64 + perm32(i)] = (bf16_t)(w >> 16); }
            }
#pragma unroll
            for (int ps = 0; ps < 2; ++ps) {
                const int idx = tid + NTH * ps, vi = idx >> 4, ch = idx & 15;
                const u32x4 vv = *(const u32x4*)(Z + ((size_t)tok0 + vi) * ZW + 512 + h * 128 + ch * 8);
#pragma unroll
                for (int e = 0; e < 4; ++e) { vT[(ch * 8 + 2 * e) * 72 + perm32(vi)] = (bf16_t)(vv[e] & 0xFFFFu); vT[(ch * 8 + 2 * e + 1) * 72 + perm32(vi)] = (bf16_t)(vv[e] >> 16); }
            }
        }
        __syncthreads();
        {
            const int dk = tid >> 3, ch = tid & 7;
#pragma unroll
            for (int dir = 0; dir < 2; ++dir) {
                const u32x4 v = *(const LAS u32x4*)(keT[dir] + dk * 64 + ch * 8);
                *(u32x4*)(KE[dir] + ((size_t)(b * 64 + n) * 256 + h * 64 + dk) * 64 + ch * 8) = v;
            }
#pragma unroll
            for (int ps = 0; ps < 2; ++ps) {
                const int idx = tid + NTH * ps, dv = idx >> 3, c8 = idx & 7;
                const LAS bf16_t* s = vT + dv * 72 + c8 * 8;
                u32x4 v; v.x = s[0] | ((unsigned)s[1] << 16); v.y = s[2] | ((unsigned)s[3] << 16); v.z = s[4] | ((unsigned)s[5] << 16); v.w = s[6] | ((unsigned)s[7] << 16);
                *(u32x4*)(VT + ((size_t)(b * 64 + n) * 512 + h * 128 + dv) * 64 + c8 * 8) = v;
            }
        }
    }
}

constexpr int NSEG = 8, SEGC = 64 / NSEG;
constexpr size_t WS_SSEG = WS_RA + 32 * MB;
constexpr size_t WS_GSEG = WS_SSEG + 16 * MB;
template <bool FULL>
DI void phase3b(const Params& p, int lane, int wave) {
    unsigned char* ws = p.ws;
    const int c15 = lane & 15, g = lane >> 4;
    for (int task = blockIdx.x * NWV + wave; task < 2048; task += gridDim.x * NWV) {
        const int sl = task & 3, pair = task >> 2, sg = pair & 7, bhd = pair >> 3;
        const int dir = bhd & 1, h = (bhd >> 1) & 3, b = bhd >> 3;
        const bf16_t* QD = (const bf16_t*)(ws + WS_RS + (dir ? 48 : 0) * MB) + (size_t)b * SEQ * 256 + h * 64;
        const bf16_t* KI = (const bf16_t*)(ws + WS_RS + (dir ? 64 : 16) * MB) + (size_t)b * SEQ * 256 + h * 64;
        const bf16_t* KE = (const bf16_t*)(ws + WS_RS + (dir ? 80 : 32) * MB) + ((size_t)b * 64 * 256 + h * 64) * 64;
        const float* GAM = (const float*)(ws + WS_RS + 96 * MB + (dir ? 512 * 1024 : 0)) + (size_t)(b * 4 + h) * 64 * 64;
        const bf16_t* VT = (const bf16_t*)(ws + WS_RA) + ((size_t)b * 64 * 512 + h * 128 + sl * 32) * 64;
        bf16_t* O = (bf16_t*)(ws + WS_RO + (dir ? 64 : 0) * MB) + (size_t)b * SEQ * 512 + h * 128 + sl * 32;
        f32x4* SSEG = (f32x4*)(ws + WS_SSEG); float* GSEG = (float*)(ws + WS_GSEG);
        f32x4 S[4][2];
#pragma unroll
        for (int kt = 0; kt < 4; ++kt) { S[kt][0] = (f32x4){0.f, 0.f, 0.f, 0.f}; S[kt][1] = (f32x4){0.f, 0.f, 0.f, 0.f}; }
        if (FULL) {
            for (int s2 = 0; s2 < sg; ++s2) {
                const int t2 = ((bhd * 8 + s2) << 2) | sl;
#pragma unroll
                for (int kt = 0; kt < 4; ++kt) {
                    const f32x4 gm = *(const f32x4*)(GSEG + (bhd * 8 + s2) * 64 + 16 * kt + 4 * g);
#pragma unroll
                    for (int nt = 0; nt < 2; ++nt) S[kt][nt] = S[kt][nt] * gm + SSEG[((size_t)t2 * 8 + kt * 2 + nt) * 64 + lane];
                }
            }
        }
        f32x4 gprod[4];
#pragma unroll
        for (int kt = 0; kt < 4; ++kt) gprod[kt] = (f32x4){1.f, 1.f, 1.f, 1.f};
        for (int cs = 0; cs < SEGC; ++cs) {
            const int cn = sg * SEGC + cs, n = dir ? 63 - cn : cn;
            bf16x8 kea[4][2], vb[2][2];
            f32x4 gam[4];
#pragma unroll
            for (int jt = 0; jt < 4; ++jt)
#pragma unroll
                for (int s = 0; s < 2; ++s) kea[jt][s] = ld_frag16(KE + ((size_t)n * 256 + 16 * jt + c15) * 64 + 32 * s + 8 * g);
#pragma unroll
            for (int nt = 0; nt < 2; ++nt)
#pragma unroll
                for (int s = 0; s < 2; ++s) vb[nt][s] = ld_frag16(VT + ((size_t)n * 512 + 16 * nt + c15) * 64 + 32 * s + 8 * g);
#pragma unroll
            for (int kt = 0; kt < 4; ++kt) gam[kt] = *(const f32x4*)(GAM + n * 64 + 16 * kt + 4 * g);
            if (FULL) {
                bf16x8 kia[4][2];
#pragma unroll
                for (int jt = 0; jt < 4; ++jt)
#pragma unroll
                    for (int s = 0; s < 2; ++s) kia[jt][s] = ld_frag16(KI + (size_t)(n * 64 + 16 * jt + c15) * 256 + 32 * s + 8 * g);
                bf16x8 sb[2][2];
#pragma unroll
                for (int nt = 0; nt < 2; ++nt)
#pragma unroll
                    for (int s = 0; s < 2; ++s) sb[nt][s] = pack8(S[2 * s][nt], S[2 * s + 1][nt]);
#pragma unroll
                for (int it = 0; it < 4; ++it) {
                    bf16x8 qdb[2];
#pragma unroll
                    for (int s = 0; s < 2; ++s) qdb[s] = ld_frag16(QD + (size_t)(n * 64 + 16 * it + c15) * 256 + 32 * s + 8 * g);
                    f32x4 sc[4];
#pragma unroll
                    for (int jt = 0; jt < 4; ++jt) {
                        sc[jt] = (f32x4){0.f, 0.f, 0.f, 0.f};
#pragma unroll
                        for (int s = 0; s < 2; ++s) sc[jt] = MFMA16(kia[jt][s], qdb[s], sc[jt]);
                        const int ii = 16 * it + c15;
#pragma unroll
                        for (int r = 0; r < 4; ++r) { const int jj = 16 * jt + 4 * g + r; const bool keep = dir ? (jj > ii) : (jj <= ii); sc[jt][r] = keep ? sc[jt][r] : 0.f; }
                    }
                    bf16x8 pa[2] = {pack8(sc[0], sc[1]), pack8(sc[2], sc[3])};
#pragma unroll
                    for (int nt = 0; nt < 2; ++nt) {
                        f32x4 o = (f32x4){0.f, 0.f, 0.f, 0.f};
#pragma unroll
                        for (int s = 0; s < 2; ++s) { o = MFMA16(vb[nt][s], pa[s], o); o = MFMA16(sb[nt][s], qdb[s], o); }
                        { u32x2 w = {pk2(o[0], o[1]), pk2(o[2], o[3])}; *(u32x2*)(O + (size_t)(n * 64 + 16 * it + c15) * 512 + 16 * nt + 4 * g) = w; }
                    }
                }
            }
#pragma unroll
            for (int kt = 0; kt < 4; ++kt) {
                if (!FULL) gprod[kt] = gprod[kt] * gam[kt];
#pragma unroll
                for (int nt = 0; nt < 2; ++nt) {
                    f32x4 a = S[kt][nt] * gam[kt];
#pragma unroll
                    for (int s = 0; s < 2; ++s) a = MFMA16(kea[kt][s], vb[nt][s], a);
                    S[kt][nt] = a;
                }
            }
        }
        if (!FULL) {
#pragma unroll
            for (int kt = 0; kt < 4; ++kt) {
#pragma unroll
                for (int nt = 0; nt < 2; ++nt) SSEG[((size_t)task * 8 + kt * 2 + nt) * 64 + lane] = S[kt][nt];
                if (sl == 0 && c15 == 0) *(f32x4*)(GSEG + (bhd * 8 + sg) * 64 + 16 * kt + 4 * g) = gprod[kt];
            }
        }
    }
}

DI void phase4a(const Params& p, LAS unsigned char* lds, int tid, int lane, int wave) {
    unsigned char* ws = p.ws;
    const bf16_t* Z = (const bf16_t*)(ws + WS_RZ);
    bf16_t* MIX = (bf16_t*)(ws + WS_RA);
    const bf16_t* OF = (const bf16_t*)(ws + WS_RO); const bf16_t* OB = (const bf16_t*)(ws + WS_RO + 64 * MB);
    const bf16_t* WP = (const bf16_t*)(ws + WS_WP);
    LAS bf16_t* pt = (LAS bf16_t*)lds;
    LAS unsigned char* at = lds + 81920;
    const int c15 = lane & 15, g = lane >> 4;
    const f32x4 gh0 = *(const f32x4*)(p.in[11] + 8 * lane), gh1 = *(const f32x4*)(p.in[11] + 8 * lane + 4);
    for (int tile = blockIdx.x; tile < T / 64; tile += gridDim.x) {
        const int tok0 = tile * 64, s0 = tok0 & (SEQ - 1);
        __syncthreads();
#pragma unroll
        for (int ps = 0; ps < 10; ++ps) {
            const int idx = tid + NTH * ps, rr = idx >> 6, ch = idx & 63, sq = s0 - 8 + rr;
            u32x4 v = {0u, 0u, 0u, 0u};
            if (sq >= 0 && sq < SEQ) v = *(const u32x4*)(Z + ((size_t)tok0 - 8 + rr) * ZW + 1536 + ch * 8);
            *(LAS u32x4*)(pt + rr * 512 + ch * 8) = v;
        }
#pragma unroll
        for (int hb = 0; hb < 2; ++hb) {
            u32x4 a[4], bq[4], rv[4];
#pragma unroll
            for (int j = 0; j < 4; ++j) { const size_t t = (size_t)tok0 + wave * 8 + hb * 4 + j;
                a[j] = *(const u32x4*)(OF + t * 512 + 8 * lane); bq[j] = *(const u32x4*)(OB + t * 512 + 8 * lane); rv[j] = *(const u32x4*)(Z + t * ZW + 1024 + 8 * lane); }
#pragma unroll
            for (int j = 0; j < 4; ++j) { const size_t t = (size_t)tok0 + wave * 8 + hb * 4 + j;
                float o[8], r[8];
#pragma unroll
                for (int e = 0; e < 4; ++e) { o[2 * e] = bflo(a[j][e]) + bflo(bq[j][e]); o[2 * e + 1] = bfhi(a[j][e]) + bfhi(bq[j][e]); r[2 * e] = bflo(rv[j][e]); r[2 * e + 1] = bfhi(rv[j][e]); }
                float ss = 0.f;
#pragma unroll
                for (int e = 0; e < 8; ++e) ss += o[e] * o[e];
                ss += __shfl_xor(ss, 1); ss += __shfl_xor(ss, 2); ss += __shfl_xor(ss, 4); ss += __shfl_xor(ss, 8);
                const float rstd = rsqrtf(ss * (1.f / 128.f) + EPS);
                float y[8];
#pragma unroll
                for (int e = 0; e < 8; ++e) { const float gg = e < 4 ? gh0[e] : gh1[e - 4]; y[e] = o[e] * rstd * gg * (r[e] / (1.f + __expf(-r[e]))); }
                u32x4 w = {pk2(y[0], y[1]), pk2(y[2], y[3]), pk2(y[4], y[5]), pk2(y[6], y[7])};
                *(u32x4*)(MIX + t * D + 8 * lane) = w; }
        }
        __syncthreads();
        {
            const int c = tid, gi = c >> 7, cc = c & 127, hw = 1 << gi;
            LAS unsigned char* ag = at + gi * 16384;
            float sum = 0.f;
            {   const int lo = max(s0 - hw, 0), hi = min(s0 + hw, SEQ);
                for (int rr = lo; rr < hi; ++rr) sum += bflo((unsigned)pt[(rr - s0 + 8) * 512 + c]); }
#pragma unroll 4
            for (int i = 0; i < 64; ++i) {
                const int sq = s0 + i, lo = max(sq - hw, 0), hi = min(sq + hw, SEQ);
                const float val = sum / (float)(hi - lo) - bflo((unsigned)pt[(i + 8) * 512 + c]);
                *(LAS bf16_t*)(ag + i * 256 + (((cc >> 3) ^ (i & 15)) * 16) + (cc & 7) * 2) = (bf16_t)(pk2(val, 0.f) & 0xFFFFu);
                if (sq + hw < SEQ) sum += bflo((unsigned)pt[(i + 8 + hw) * 512 + c]);
                if (sq - hw >= 0) sum -= bflo((unsigned)pt[(i + 8 - hw) * 512 + c]);
            }
        }
        __syncthreads();
        {
            const int gi = wave >> 1, dh = wave & 1;
            LAS unsigned char* ag = at + gi * 16384;
            f32x4 acc[4][4];
#pragma unroll
            for (int mt = 0; mt < 4; ++mt)
#pragma unroll
                for (int nt = 0; nt < 4; ++nt) acc[mt][nt] = (f32x4){0.f, 0.f, 0.f, 0.f};
#pragma unroll
            for (int s = 0; s < 4; ++s) {
                bf16x8 af[4];
#pragma unroll
                for (int mt = 0; mt < 4; ++mt) { const int row = mt * 16 + c15; af[mt] = *(const LAS bf16x8*)(ag + row * 256 + (((4 * s + g) ^ (row & 15)) * 16)); }
#pragma unroll
                for (int nt = 0; nt < 4; ++nt) {
                    const bf16x8 wf = ld_frag16(WP + (size_t)gi * 16384 + (dh * 64 + 16 * nt + c15) * 128 + 32 * s + 8 * g);
#pragma unroll
                    for (int mt = 0; mt < 4; ++mt) acc[mt][nt] = MFMA16(wf, af[mt], acc[mt][nt]);
                }
            }
#pragma unroll
            for (int nt = 0; nt < 4; ++nt) {
                const f32x4 ps = *(const f32x4*)(p.in[13] + gi * 128 + dh * 64 + 16 * nt + 4 * g);
#pragma unroll
                for (int mt = 0; mt < 4; ++mt) {
                    const f32x4 v = acc[mt][nt] * ps;
                    u32x2 w = {pk2(v[0], v[1]), pk2(v[2], v[3])};
                    *(u32x2*)(MIX + ((size_t)tok0 + mt * 16 + c15) * D + 512 + gi * 128 + dh * 64 + 16 * nt + 4 * g) = w;
                }
            }
        }
    }
}

DI void phase4c(const Params& p, LAS unsigned char* lds, int tid, int lane, int wave) {
    LAS float* lG = (LAS float*)lds; LAS float* lA = lG + 1024; LAS float* lB = lA + 1024; LAS float* lP = lB + 1024;
    const float* x = p.in[0]; const float* MIXO = (const float*)(p.ws + WS_RZ); bf16_t* H2 = (bf16_t*)(p.ws + WS_RA);
    for (int rt = blockIdx.x; rt < T / 128; rt += gridDim.x) {
        const int b = rt / 32;
        __syncthreads();
        for (int d = tid; d < 1024; d += NTH) { lG[d] = mod_at(p, b, 2048 + d); lA[d] = p.in[15][d] * (1.f + mod_at(p, b, 4096 + d)); lB[d] = mod_at(p, b, 3072 + d); lP[d] = p.in[5][d]; }
        __syncthreads();
        for (int r = wave; r < 128; r += NWV) {
            const size_t row = (size_t)rt * 128 + r;
            const f32x4* mr = (const f32x4*)(MIXO + row * D) + lane; const f32x4* xr = (const f32x4*)(x + row * D) + lane;
            f32x4 m[4], xv[4]; float ss = 0.f;
#pragma unroll
            for (int j = 0; j < 4; ++j) { m[j] = mr[64 * j]; xv[j] = xr[64 * j]; ss += m[j][0] * m[j][0] + m[j][1] * m[j][1] + m[j][2] * m[j][2] + m[j][3] * m[j][3]; }
            const float rstd = rsqrtf(wave_sum(ss) * (1.f / D) + EPS);
            float s2 = 0.f;
#pragma unroll
            for (int j = 0; j < 4; ++j) {
                const f32x4 gt = *(const LAS f32x4*)(lG + 4 * lane + 256 * j), pm = *(const LAS f32x4*)(lP + 4 * lane + 256 * j);
                xv[j] = xv[j] + gt * (m[j] * rstd * pm);
                s2 += xv[j][0] * xv[j][0] + xv[j][1] * xv[j][1] + xv[j][2] * xv[j][2] + xv[j][3] * xv[j][3];
            }
            const float rstd2 = rsqrtf(wave_sum(s2) * (1.f / D) + EPS);
            f32x4* orow = (f32x4*)(p.out + row * D) + lane; u32x2* hrow = (u32x2*)(H2 + row * D) + lane;
#pragma unroll
            for (int j = 0; j < 4; ++j) {
                orow[64 * j] = xv[j];
#if defined(CHK_PEER) || REPEAT_PHASE == 6
                ((f32x4*)((float*)(p.ws + WS_RO) + row * D) + lane)[64 * j] = xv[j];
#endif
                const f32x4 a = *(const LAS f32x4*)(lA + 4 * lane + 256 * j), bb = *(const LAS f32x4*)(lB + 4 * lane + 256 * j);
                const f32x4 hv = xv[j] * rstd2 * a + bb;
                u32x2 w = {pk2(hv[0], hv[1]), pk2(hv[2], hv[3])};
                hrow[64 * j] = w;
            }
        }
    }
}

DI int skey(float v, int idx, int mask) { int u = __float_as_int(v); u ^= (u >> 31) & 0x7FFFFFFF; return (u & ~mask) | idx; }
DI float sval(int k, int mask) { int u = k & ~mask; u ^= (u >> 31) & 0x7FFFFFFF; return __int_as_float(u); }
DI void cswap(int& a, int& b) { const int mx = max(a, b), mn = min(a, b); a = mx; b = mn; }
DI void sort16_desc(int (&a)[16]) {
#pragma unroll
    for (int k = 2; k <= 16; k <<= 1) {
#pragma unroll
        for (int j = k >> 1; j > 0; j >>= 1) {
#pragma unroll
            for (int i = 0; i < 16; ++i) {
                const int l = i ^ j;
                if (l > i) { if ((i & k) == 0) cswap(a[i], a[l]); else cswap(a[l], a[i]); }
            }
        }
    }
}
DI void merge16_desc(int (&x)[16], const int (&y)[16]) {
#pragma unroll
    for (int i = 0; i < 16; ++i) x[i] = max(x[i], y[15 - i]);
#pragma unroll
    for (int j = 8; j > 0; j >>= 1) {
#pragma unroll
        for (int i = 0; i < 16; ++i) { const int l = i ^ j; if (l > i) cswap(x[i], x[l]); }
    }
}

DI void phase5b(const Params& p, LAS unsigned char* lds, int tid, int lane, int wave) {
    unsigned char* ws = p.ws;
    const bf16_t* Q2 = (const bf16_t*)(ws + WS_RZ);
    const bf16_t* SKB = (const bf16_t*)(ws + WS_SKB);
    int* EIDX = (int*)(ws + WS_RS); float* GATE = (float*)(ws + WS_RS + 16 * MB);
    LAS unsigned char* tab = lds + tid * 32;
    const int gw = blockIdx.x * NWV + wave, NGW = gridDim.x * NWV;
    const int c31 = lane & 31, hi = lane >> 5;
    for (int task = gw; task < 8192; task += NGW) {
        const int h = task & 7, tg = task >> 3;
        const size_t tok = (size_t)tg * 32 + c31;
        int lst[2][16];
#pragma unroll
        for (int pp = 0; pp < 2; ++pp) {
            const bf16_t* qp = Q2 + tok * 2048 + h * 256 + pp * 128 + 8 * hi;
            const bf16_t* kp = SKB + ((size_t)(h * 2 + pp) * 128 + c31) * 128 + 8 * hi;
            asm volatile("" : "+v"(qp)); asm volatile("" : "+v"(kp));
            bf16x8 bq[8];
#pragma unroll
            for (int ks = 0; ks < 8; ++ks) bq[ks] = ld_frag16(qp + 16 * ks);
            int run[16];
#pragma unroll
            for (int r = 0; r < 16; ++r) run[r] = (int)0x80000000;
#pragma unroll 1
            for (int kt = 0; kt < 4; ++kt) {
                const bf16_t* kpt = kp + kt * 4096;
                f32x16 acc;
#pragma unroll
                for (int r = 0; r < 16; ++r) acc[r] = 0.f;
#pragma unroll
                for (int ks = 0; ks < 8; ++ks) acc = MFMA32(ld_frag16(kpt + 16 * ks), bq[ks], acc);
                int cur[16];
#pragma unroll
                for (int r = 0; r < 16; ++r) cur[r] = skey(acc[r], 32 * kt + 8 * (r >> 2) + 4 * hi + (r & 3), 0x7F);
                sort16_desc(cur);
                merge16_desc(run, cur);
            }
            int oth[16];
#pragma unroll
            for (int r = 0; r < 16; ++r) oth[r] = __shfl_xor(run[r], 32);
            merge16_desc(run, oth);
#pragma unroll
            for (int r = 0; r < 16; ++r) lst[pp][r] = run[r];
        }
#pragma unroll
        for (int pp = 0; pp < 2; ++pp) {
            u32x4 w;
#pragma unroll
            for (int q = 0; q < 4; ++q) w[q] = (lst[pp][4 * q] & 0x7F) | ((lst[pp][4 * q + 1] & 0x7F) << 8) | ((lst[pp][4 * q + 2] & 0x7F) << 16) | ((lst[pp][4 * q + 3] & 0x7F) << 24);
            *(LAS u32x4*)(tab + 16 * pp) = w;
        }
        float va[16], vb[16];
#pragma unroll
        for (int r = 0; r < 16; ++r) { va[r] = sval(lst[0][r], 0x7F); vb[r] = sval(lst[1][r], 0x7F); }
        int cand[4][16];
        {
            int cnt = 0;
#pragma unroll
            for (int i = 0; i < 16; ++i)
#pragma unroll
                for (int j = 0; j < 16; ++j)
                    if ((i + 1) * (j + 1) <= 16) { cand[cnt >> 4][cnt & 15] = skey(va[i] + vb[j], (i << 4) | j, 0xFF); ++cnt; }
#pragma unroll
            for (int q = 50; q < 64; ++q) cand[q >> 4][q & 15] = (int)0x80000000;
        }
        sort16_desc(cand[0]); sort16_desc(cand[1]); sort16_desc(cand[2]); sort16_desc(cand[3]);
        merge16_desc(cand[0], cand[1]); merge16_desc(cand[2], cand[3]); merge16_desc(cand[0], cand[2]);
        asm volatile("s_waitcnt lgkmcnt(0)" ::: "memory");
        float sv[16]; int ex[16];
        const float mx = sval(cand[0][0], 0xFF);
        float sum = 0.f;
#pragma unroll
        for (int r = 0; r < 16; ++r) {
            const int ck = cand[0][r];
            const int i1 = tab[(ck >> 4) & 15], i2 = tab[16 + (ck & 15)];
            ex[r] = i1 * 128 + i2;
            sv[r] = __expf(sval(ck, 0xFF) - mx); sum += sv[r];
        }
        const float inv = 1.f / sum;
        int* ep = EIDX + tok * 128 + h * 16 + 8 * hi; float* gp = GATE + tok * 128 + h * 16 + 8 * hi;
        if (hi == 0) {
            *(u32x4*)ep = (u32x4){(unsigned)ex[0], (unsigned)ex[1], (unsigned)ex[2], (unsigned)ex[3]}; *(u32x4*)(ep + 4) = (u32x4){(unsigned)ex[4], (unsigned)ex[5], (unsigned)ex[6], (unsigned)ex[7]};
            *(f32x4*)gp = (f32x4){sv[0] * inv, sv[1] * inv, sv[2] * inv, sv[3] * inv}; *(f32x4*)(gp + 4) = (f32x4){sv[4] * inv, sv[5] * inv, sv[6] * inv, sv[7] * inv};
        } else {
            *(u32x4*)ep = (u32x4){(unsigned)ex[8], (unsigned)ex[9], (unsigned)ex[10], (unsigned)ex[11]}; *(u32x4*)(ep + 4) = (u32x4){(unsigned)ex[12], (unsigned)ex[13], (unsigned)ex[14], (unsigned)ex[15]};
            *(f32x4*)gp = (f32x4){sv[8] * inv, sv[9] * inv, sv[10] * inv, sv[11] * inv}; *(f32x4*)(gp + 4) = (f32x4){sv[12] * inv, sv[13] * inv, sv[14] * inv, sv[15] * inv};
        }
    }
}

template <int K> DI int swz_bcast(int v) { return __builtin_amdgcn_ds_swizzle(v, 0x10 | (K << 5)); }
template <int W> DI int swz_xor(int v) { return __builtin_amdgcn_ds_swizzle(v, 0x1F | (W << 10)); }
template <int K> struct IC { static constexpr int v = K; };
template <int N, int I = 0, class F> DI void static_for(F&& f) { if constexpr (I < N) { f(IC<I>{}); static_for<N, I + 1>(f); } }
DI float row16_sum(float v) {
    v += __builtin_bit_cast(float, __builtin_amdgcn_update_dpp(0, __builtin_bit_cast(int, v), 0xB1, 0xF, 0xF, true));
    v += __builtin_bit_cast(float, __builtin_amdgcn_update_dpp(0, __builtin_bit_cast(int, v), 0x4E, 0xF, 0xF, true));
    v += __builtin_bit_cast(float, __builtin_amdgcn_update_dpp(0, __builtin_bit_cast(int, v), 0x141, 0xF, 0xF, true));
    v += __builtin_bit_cast(float, __builtin_amdgcn_update_dpp(0, __builtin_bit_cast(int, v), 0x140, 0xF, 0xF, true));
    return v;
}
DI void phase6(const Params& p, LAS unsigned char* lds, int tid, int lane, int wave) {
    unsigned char* ws = p.ws;
    const bf16_t* H2 = (const bf16_t*)(ws + WS_RA);
    const unsigned char* UQ = ws + WS_UB; const unsigned char* VQ = ws + WS_VB;
    const float* SU = (const float*)(ws + WS_SU); const float* SV = (const float*)(ws + WS_SV);
    const int* EIDX = (const int*)(ws + WS_RS); const float* GATE = (const float*)(ws + WS_RS + 16 * MB);
    LAS float* lG = (LAS float*)lds;
    const int q = lane >> 4, l16 = lane & 15;
    LAS int* le = (LAS int*)(lds + 4096 + wave * 6144) + q * 128;
    LAS float* lg = (LAS float*)(lds + 4096 + wave * 6144 + 2048) + q * 128;
    LAS float* lc = (LAS float*)(lds + 4096 + wave * 6144 + 4096) + q * 128;
    const unsigned qlo = q < 2 ? (0xFFFFu << (16 * q)) : 0u, qhi = q >= 2 ? (0xFFFFu << (16 * (q - 2))) : 0u;
    for (int rt = blockIdx.x; rt < T / 128; rt += gridDim.x) {
        const int b = rt / 32;
        __syncthreads();
        for (int d = tid; d < 1024; d += NTH) lG[d] = mod_at(p, b, 5120 + d) * p.in[16][d];
        __syncthreads();
#pragma unroll 1
        for (int rd = 0; rd < 4; ++rd) {
            __syncthreads();
            const size_t t = (size_t)rt * 128 + wave * 16 + rd * 4 + q;
            {
                int e[8]; float g[8];
#pragma unroll
                for (int r = 0; r < 8; ++r) { e[r] = EIDX[t * 128 + r * 16 + l16]; g[r] = GATE[t * 128 + r * 16 + l16]; }
                int base = 0;
#pragma unroll 1
                for (int part = 0; part < 16; ++part) {
#pragma unroll
                    for (int r = 0; r < 8; ++r) {
                        const bool hit = (e[r] >> 10) == part;
                        const unsigned long long m = __ballot(hit);
                        const unsigned mlo = (unsigned)m & qlo, mhi = (unsigned)(m >> 32) & qhi;
                        const int pos = base + (int)__builtin_amdgcn_mbcnt_hi(mhi, __builtin_amdgcn_mbcnt_lo(mlo, 0u));
                        if (hit) { le[pos] = e[r]; lg[pos] = g[r]; }
                        base += __builtin_popcount(mlo) + __builtin_popcount(mhi);
                    }
                }
                asm volatile("s_waitcnt lgkmcnt(0)" ::: "memory");
            }
            {
                f32x2 hf[32];
#pragma unroll
                for (int i = 0; i < 4; ++i) {
                    const u32x4 h0 = *(const u32x4*)(H2 + t * D + 256 * i + 16 * l16), h1 = *(const u32x4*)(H2 + t * D + 256 * i + 16 * l16 + 8);
#pragma unroll
                    for (int c = 0; c < 4; ++c) { hf[8 * i + c] = (f32x2){bflo(h0[c]), bfhi(h0[c])}; hf[8 * i + 4 + c] = (f32x2){bflo(h1[c]), bfhi(h1[c])}; }
                }
                constexpr int UD = 4;
                u32x4 ub[UD][4];
                int evn = le[l16];
                static_for<UD>([&](auto kc) { constexpr int k = decltype(kc)::v; const unsigned char* up = UQ + (size_t)swz_bcast<k>(evn) * 1024 + 16 * l16;
#pragma unroll
                    for (int i = 0; i < 4; ++i) ub[k][i] = *(const u32x4*)(up + 256 * i); });
#pragma unroll 1
                for (int bt = 0; bt < 8; ++bt) {
                    const int ev = evn; const float gv = lg[bt * 16 + l16];
                    evn = le[(bt < 7 ? bt + 1 : 7) * 16 + l16];
                    const float isu = SU[ev], isv = SV[ev];
                    float part[16];
                    static_for<16>([&](auto kc) {
                        constexpr int k = decltype(kc)::v, sl = k % UD;
                        f32x2 a = (f32x2){0.f, 0.f};
#pragma unroll
                        for (int i = 0; i < 4; ++i) {
                            const u32x4 u = ub[sl][i];
#pragma unroll
                            for (int c = 0; c < 4; ++c) {
                                const int w = (int)u[c];
                                a = __builtin_elementwise_fma(__builtin_amdgcn_cvt_pk_f32_fp8(w, false), hf[8 * i + 2 * c], a);
                                a = __builtin_elementwise_fma(__builtin_amdgcn_cvt_pk_f32_fp8(w, true), hf[8 * i + 2 * c + 1], a);
                            }
                        }
                        part[k] = a.x + a.y;
                        {
                            constexpr int kn = k + UD;
                            int idx; if constexpr (kn < 16) idx = swz_bcast<(kn & 15)>(ev); else idx = swz_bcast<(kn & 15)>(evn);
                            const unsigned char* up = UQ + (size_t)idx * 1024 + 16 * l16;
#pragma unroll
                            for (int i = 0; i < 4; ++i) ub[sl][i] = *(const u32x4*)(up + 256 * i);
                        }
                    });
                    static_for<4>([&](auto sc) {
                        constexpr int w = 8 >> decltype(sc)::v;
                        const bool up2 = (lane & w) != 0;
#pragma unroll
                        for (int e = 0; e < w; ++e) {
                            const float keep = up2 ? part[e + w] : part[e], send = up2 ? part[e] : part[e + w];
                            part[e] = keep + __int_as_float(swz_xor<w>(__float_as_int(send)));
                        }
                    });
                    const float dot = part[0] * isu;
                    lc[bt * 16 + l16] = gv * 0.5f * dot * (1.f + erff(dot * 0.70710678118654752f)) * isv;
                }
                asm volatile("s_waitcnt lgkmcnt(0)" ::: "memory");
            }
            f32x2 y[32];
#pragma unroll
            for (int i = 0; i < 32; ++i) y[i] = (f32x2){0.f, 0.f};
            {
                constexpr int VD = 4;
                u32x4 vbuf[VD][4];
                int evn = le[l16];
                static_for<VD>([&](auto kc) { constexpr int k = decltype(kc)::v; const unsigned char* vp = VQ + (size_t)swz_bcast<k>(evn) * 1024 + 16 * l16;
#pragma unroll
                    for (int i = 0; i < 4; ++i) vbuf[k][i] = *(const u32x4*)(vp + 256 * i); });
#pragma unroll 1
                for (int bt = 0; bt < 8; ++bt) {
                    const int ev = evn; const int cv = __float_as_int(lc[bt * 16 + l16]);
                    evn = le[(bt < 7 ? bt + 1 : 7) * 16 + l16];
                    static_for<16>([&](auto kc) {
                        constexpr int k = decltype(kc)::v, sl = k % VD;
                        const float cc = __int_as_float(swz_bcast<k>(cv));
                        const f32x2 c2 = (f32x2){cc, cc};
#pragma unroll
                        for (int i = 0; i < 4; ++i) {
                            const u32x4 v = vbuf[sl][i];
#pragma unroll
                            for (int c = 0; c < 4; ++c) {
                                const int w = (int)v[c];
                                y[8 * i + 2 * c] = __builtin_elementwise_fma(__builtin_amdgcn_cvt_pk_f32_fp8(w, false), c2, y[8 * i + 2 * c]);
                                y[8 * i + 2 * c + 1] = __builtin_elementwise_fma(__builtin_amdgcn_cvt_pk_f32_fp8(w, true), c2, y[8 * i + 2 * c + 1]);
                            }
                        }
                        {
                            constexpr int kn = k + VD;
                            int idx; if constexpr (kn < 16) idx = swz_bcast<(kn & 15)>(ev); else idx = swz_bcast<(kn & 15)>(evn);
                            const unsigned char* vp = VQ + (size_t)idx * 1024 + 16 * l16;
#pragma unroll
                            for (int i = 0; i < 4; ++i) vbuf[sl][i] = *(const u32x4*)(vp + 256 * i);
                        }
                    });
                }
            }
            float ss = 0.f;
#pragma unroll
            for (int i = 0; i < 32; ++i) ss += y[i].x * y[i].x + y[i].y * y[i].y;
            const float rstd = rsqrtf(row16_sum(ss) * (1.f / D) + EPS);
            float* orow = p.out + t * D;
#pragma unroll
            for (int i = 0; i < 4; ++i)
#pragma unroll
                for (int c = 0; c < 4; ++c) {
                    const int col = 256 * i + 16 * l16 + 4 * c;
#if REPEAT_PHASE == 6
                    f32x4 xv = *(const f32x4*)((const float*)(p.ws + WS_RO) + t * D + col);
#else
                    f32x4 xv = *(const f32x4*)(orow + col);
#endif
                    const f32x4 gg = *(const LAS f32x4*)(lG + col);
                    xv[0] += gg[0] * y[8 * i + 2 * c].x * rstd; xv[1] += gg[1] * y[8 * i + 2 * c].y * rstd; xv[2] += gg[2] * y[8 * i + 2 * c + 1].x * rstd; xv[3] += gg[3] * y[8 * i + 2 * c + 1].y * rstd;
                    *(f32x4*)(orow + col) = xv;
                }
        }
    }
}

#ifdef CHK_PEER
DI float blk_sum(float v, LAS float* red, int tid, int lane, int wave) {
    v = wave_sum(v);
    __syncthreads();
    if (lane == 0) red[wave] = v;
    __syncthreads();
    float s = 0.f;
    for (int i = 0; i < NWV; ++i) s += red[i];
    return s;
}
DI void check_peer(const Params& p, LAS unsigned char* lds, int tid, int lane, int wave) {
    unsigned char* ws = p.ws;
    const bf16_t* H2 = (const bf16_t*)(ws + WS_RA); const bf16_t* WQ = (const bf16_t*)(ws + WS_WQ); const bf16_t* SKB = (const bf16_t*)(ws + WS_SKB);
    const bf16_t* UB = (const bf16_t*)(ws + WS_UB); const bf16_t* VB = (const bf16_t*)(ws + WS_VB);
    const float* X1 = (const float*)(ws + WS_RO);
    float* stat = (float*)(ws + WS_CTL + 32768);
    LAS float* hrow = (LAS float*)lds;
    LAS float* qv = hrow + 1024;
    LAS float* sc = qv + 2048;
    LAS float* tv = sc + 2048;
    LAS int* ti = (LAS int*)(tv + 256);
    LAS int* ee = ti + 256;
    LAS float* gg = (LAS float*)(ee + 128);
    LAS float* cf = gg + 128;
    LAS float* yv = cf + 128;
    LAS float* red = yv + 1024;
    for (int rt = blockIdx.x; rt < T / 128; rt += gridDim.x) {
        const size_t ts = (size_t)rt * 128 + 37; const int b = rt / 32;
        __syncthreads();
        for (int d = tid; d < 1024; d += NTH) hrow[d] = bflo((unsigned)H2[ts * D + d]);
        __syncthreads();
        for (int n = tid; n < 2048; n += NTH) { float a = 0.f; for (int k = 0; k < 1024; ++k) a += hrow[k] * bflo((unsigned)WQ[(size_t)n * 1024 + k]); qv[n] = bflo(pk2(a, 0.f) & 0xFFFFu); }
        __syncthreads();
        for (int n = tid; n < 2048; n += NTH) { const int hp = n >> 7, key = n & 127; float a = 0.f; for (int d = 0; d < 128; ++d) a += qv[hp * 128 + d] * bflo((unsigned)SKB[((size_t)hp * 128 + key) * 128 + d]); sc[n] = a; }
        __syncthreads();
        if (tid < 16) { const int hp = tid;
            for (int k = 0; k < 16; ++k) { float best = -3e38f; int bi = 0; for (int n = 0; n < 128; ++n) { const float v = sc[hp * 128 + n]; if (v > best) { best = v; bi = n; } } tv[hp * 16 + k] = best; ti[hp * 16 + k] = bi; sc[hp * 128 + bi] = -3e38f; } }
        __syncthreads();
        if (tid < 8) { const int h = tid; float cs[16]; int ci[16];
            unsigned long long used[4] = {0ull, 0ull, 0ull, 0ull};
            for (int k = 0; k < 16; ++k) { float best = -3e38f; int bi = 0;
                for (int c = 0; c < 256; ++c) { if ((used[c >> 6] >> (c & 63)) & 1ull) continue; const float v = tv[(h * 2) * 16 + (c >> 4)] + tv[(h * 2 + 1) * 16 + (c & 15)]; if (v > best) { best = v; bi = c; } }
                used[bi >> 6] |= 1ull << (bi & 63); cs[k] = best; ci[k] = bi; }
            float sum = 0.f; for (int k = 0; k < 16; ++k) { cs[k] = __expf(cs[k] - cs[0]); sum += cs[k]; }
            for (int k = 0; k < 16; ++k) { ee[h * 16 + k] = ti[(h * 2) * 16 + (ci[k] >> 4)] * 128 + ti[(h * 2 + 1) * 16 + (ci[k] & 15)]; gg[h * 16 + k] = cs[k] / sum; } }
        __syncthreads();
#ifdef CHK_USE_FAST_SEL
        if (tid < 128) { ee[tid] = ((const int*)(ws + WS_RS))[ts * 128 + tid]; gg[tid] = ((const float*)(ws + WS_RS + 16 * MB))[ts * 128 + tid]; }
        __syncthreads();
#endif
        if (tid < 128) { const int e = ee[tid]; float a = 0.f; for (int d = 0; d < 1024; ++d) a += hrow[d] * bflo((unsigned)UB[(size_t)e * D + d]); cf[tid] = gg[tid] * 0.5f * a * (1.f + erff(a * 0.70710678118654752f)); }
        __syncthreads();
        for (int d = tid; d < 1024; d += NTH) { float a = 0.f; for (int e = 0; e < 128; ++e) a += cf[e] * bflo((unsigned)VB[(size_t)ee[e] * D + d]); yv[d] = a; }
        __syncthreads();
        float ss = 0.f; for (int d = tid; d < 1024; d += NTH) ss += yv[d] * yv[d];
        const float rstd = rsqrtf(blk_sum(ss, red, tid, lane, wave) * (1.f / D) + EPS);
        float e2 = 0.f, r2 = 0.f;
        for (int d = tid; d < 1024; d += NTH) { const float br = mod_at(p, b, 5120 + d) * p.in[16][d] * yv[d] * rstd; const float ref = X1[ts * D + d] + br; const float df = p.out[ts * D + d] - ref; e2 += df * df; r2 += br * br; }
        e2 = blk_sum(e2, red, tid, lane, wave); r2 = blk_sum(r2, red, tid, lane, wave);
        if (tid == 0) { atomicAdd(&stat[0], e2); atomicAdd(&stat[1], r2); }
    }
}
DI void check_emit(const Params& p, int tid) {
    const float* stat = (const float*)(p.ws + WS_CTL + 32768);
    const float e = __hip_atomic_load(&stat[0], __ATOMIC_RELAXED, __HIP_MEMORY_SCOPE_AGENT), r = __hip_atomic_load(&stat[1], __ATOMIC_RELAXED, __HIP_MEMORY_SCOPE_AGENT);
    const float A = 10.f + 1e6f * (e / r), f = 1.f + sqrtf(A);
    const size_t gt = (size_t)blockIdx.x * NTH + tid, NGT = (size_t)gridDim.x * NTH;
    for (size_t i = gt; i < (size_t)T * D / 4; i += NGT) { f32x4 v = ((const f32x4*)p.in[0])[i]; ((f32x4*)p.out)[i] = v * f; }
}
#endif

#ifdef TIMING
#define STAMP(k) do { if (blockIdx.x == 0 && threadIdx.x == 0) ((unsigned long long*)(p.ws + WS_CTL + 40960))[k] = __builtin_amdgcn_s_memrealtime(); } while (0)
DI void timing_emit(const Params& p, int tid) {
    const unsigned long long* ts = (const unsigned long long*)(p.ws + WS_CTL + 40960);
#define dT(a, b) ((float)(ts[b] - ts[a]) * 0.01f)
    const float A = TIM_A, B = TIM_B, f = 1.f + sqrtf(A);
#undef dT
    const size_t gt = (size_t)blockIdx.x * NTH + tid, NGT = (size_t)gridDim.x * NTH;
    for (size_t i = gt; i < (size_t)T * D / 4; i += NGT) { f32x4 v = ((const f32x4*)p.in[0])[i]; v = v * f; if (i == 0) v[0] = B; ((f32x4*)p.out)[i] = v; }
}
#else
#define STAMP(k) do {} while (0)
#endif

__global__ void __launch_bounds__(NTH) fwd_megakernel(Params p) {
    extern __shared__ __attribute__((aligned(16))) unsigned char lds_raw[];
    LAS unsigned char* lds = (LAS unsigned char*)lds_raw;
    const int tid = threadIdx.x, lane = tid & 63, wave = __builtin_amdgcn_readfirstlane(tid >> 6);
    volatile LAS unsigned* st = (volatile LAS unsigned*)(lds + LDS_BARW);
    if (tid == 0) { st[0] = 0u; st[1] = 0u; st[2] = 0u; st[3] = 0u; }
    __syncthreads();
    XcdBarrier bar = xcd_barrier_post((unsigned*)(p.ws + WS_CTL), st);
    unsigned char* ws = p.ws;

    STAMP(0);
    phase0(p, lds, tid, lane, wave);
    xcd_barrier(bar);
#if REPEAT_PHASE == 0
    phase0(p, lds, tid, lane, wave);
    xcd_barrier(bar);
#endif
    STAMP(1);
    phase1(p, lds, tid, lane, wave);
    xcd_barrier(bar);
    STAMP(2);
    { pg8::Gemm g{(const bf16_t*)(ws + WS_RA), (const bf16_t*)(ws + WS_WIN), T, ZW, D}; pg8::StaticOrder S; S.init(T, ZW, (int)gridDim.x, (int)blockIdx.x);
      pg8::EpiB16 e{(bf16_t*)(ws + WS_RZ), ZW}; pg8::gemm_phase<pg8::EpiB16, pg8::StaticOrder, true, true>(lds, g, S, e);
      EpiZ e2{(bf16_t*)(ws + WS_RZ), (float*)(ws + WS_AFB)}; gemm_phase(((const bf16_t*)(ws + WS_RA)), (const bf16_t*)(ws + WS_WIN), T, NIN, D, e2, lds, tid, lane, wave, 16); }
#if REPEAT_PHASE == 2
    xcd_barrier(bar);
    { pg8::Gemm g{(const bf16_t*)(ws + WS_RA), (const bf16_t*)(ws + WS_WIN), T, ZW, D}; pg8::StaticOrder S; S.init(T, ZW, (int)gridDim.x, (int)blockIdx.x);
      pg8::EpiB16 e{(bf16_t*)(ws + WS_RZ), ZW}; pg8::gemm_phase<pg8::EpiB16, pg8::StaticOrder, true, true>(lds, g, S, e);
      EpiZ e2{(bf16_t*)(ws + WS_RZ), (float*)(ws + WS_AFB)}; gemm_phase(((const bf16_t*)(ws + WS_RA)), (const bf16_t*)(ws + WS_WIN), T, NIN, D, e2, lds, tid, lane, wave, 16); }
#endif
    xcd_barrier(bar);
    STAMP(3);
    phase3a(p, lds, tid, lane, wave);
    xcd_barrier(bar);
#if REPEAT_PHASE == 1
    phase3a(p, lds, tid, lane, wave);
    xcd_barrier(bar);
#endif
    STAMP(4);
    phase3b<false>(p, lane, wave);
    xcd_barrier(bar);
    phase3b<true>(p, lane, wave);
#if REPEAT_PHASE == 3
    xcd_barrier(bar);
    phase3b<false>(p, lane, wave);
    xcd_barrier(bar);
    phase3b<true>(p, lane, wave);
#endif
    xcd_barrier(bar);
    STAMP(5);
    phase4a(p, lds, tid, lane, wave);
    xcd_barrier(bar);
#if REPEAT_PHASE == 4
    phase4a(p, lds, tid, lane, wave);
    xcd_barrier(bar);
#endif
    STAMP(6);
    { pg8::Gemm g{(const bf16_t*)(ws + WS_RA), (const bf16_t*)(ws + WS_WOUT), T, D, D}; pg8::StaticOrder S; S.init(T, D, (int)gridDim.x, (int)blockIdx.x);
      pg8::EpiF e{(float*)(ws + WS_RZ), D}; pg8::gemm_phase<pg8::EpiF, pg8::StaticOrder, true, true>(lds, g, S, e); }
    xcd_barrier(bar);
    STAMP(7);
    phase4c(p, lds, tid, lane, wave);
    xcd_barrier(bar);
    STAMP(8);
#ifndef ABL_SKIP_PEER
    { pg8::Gemm g{(const bf16_t*)(ws + WS_RA), (const bf16_t*)(ws + WS_WQ), T, 2048, D}; pg8::StaticOrder S; S.init(T, 2048, (int)gridDim.x, (int)blockIdx.x);
      pg8::EpiB16 e{(bf16_t*)(ws + WS_RZ), 2048}; pg8::gemm_phase<pg8::EpiB16, pg8::StaticOrder, true, true>(lds, g, S, e); }
    xcd_barrier(bar);
    STAMP(9);
    phase5b(p, lds, tid, lane, wave);
    xcd_barrier(bar);
#if REPEAT_PHASE == 5
    phase5b(p, lds, tid, lane, wave);
    xcd_barrier(bar);
#endif
    STAMP(10);
    phase6(p, lds, tid, lane, wave);
#if REPEAT_PHASE == 6
    xcd_barrier(bar);
    phase6(p, lds, tid, lane, wave);
#endif
#ifdef TIMING
    xcd_barrier(bar);
    STAMP(11);
    xcd_barrier(bar);
    timing_emit(p, tid);
#endif
#ifdef CHK_PEER
    xcd_barrier(bar);
    STAMP(11);
    check_peer(p, lds, tid, lane, wave);
    xcd_barrier(bar);
    STAMP(12);
    check_emit(p, tid);
#endif
#endif
}

extern "C" void kernel_launch(void* const* d_in, const int* in_sizes, int n_in, void* d_out, int out_size, void* d_ws, size_t ws_size, hipStream_t stream) {
    static int grid = 0;
    if (grid == 0) {
        if (n_in != 21 || out_size != T * D || ws_size < WS_END) { fprintf(stderr, "kernel_launch: unexpected shapes (n_in %d out %d ws %zu need %zu)\n", n_in, out_size, ws_size, (size_t)WS_END); grid = -1; return; }
        int dev = 0, cus = 0, per_cu = 0;
        hipGetDevice(&dev); hipDeviceGetAttribute(&cus, hipDeviceAttributeMultiprocessorCount, dev);
        hipFuncSetAttribute((const void*)fwd_megakernel, hipFuncAttributeMaxDynamicSharedMemorySize, LDS_BYTES);
        hipOccupancyMaxActiveBlocksPerMultiprocessor(&per_cu, (const void*)fwd_megakernel, NTH, LDS_BYTES);
        (void)hipGetLastError();
        if (per_cu < 1) fprintf(stderr, "kernel_launch: occupancy query says %d blocks per CU\n", per_cu);
        grid = cus;
    }
    if (grid < 0) return;
    hipMemsetAsync((char*)d_ws + WS_CTL, 0, 64 * 1024, stream);
    Params p{};
    for (int i = 0; i < 21; ++i) p.in[i] = (const float*)d_in[i];
    p.out = (float*)d_out; p.ws = (unsigned char*)d_ws;
    hipLaunchKernelGGL(fwd_megakernel, dim3(grid), dim3(NTH), LDS_BYTES, stream, p);
}
```

```cpp
#ifndef REPEAT_PHASE
#define REPEAT_PHASE -1
#endif
#include <hip/hip_runtime.h>
#include <cstdio>
#include <cstdint>

#define DI __device__ __forceinline__
#define LAS __attribute__((address_space(3)))
typedef unsigned short bf16_t;
typedef short bf16x8 __attribute__((ext_vector_type(8)));
typedef float f32x4 __attribute__((ext_vector_type(4)));
typedef float f32x2 __attribute__((ext_vector_type(2)));
typedef float f32x16 __attribute__((ext_vector_type(16)));
typedef unsigned u32x4 __attribute__((ext_vector_type(4)));
typedef unsigned u32x2 __attribute__((ext_vector_type(2)));
typedef __bf16 bf16x2v __attribute__((ext_vector_type(2)));

constexpr int T = 32768, D = 1024, SEQ = 4096, NB = 8;
constexpr int NTH = 512, NWV = 8;
constexpr int ZW = 2048;
constexpr int NIN = 2176;
constexpr float EPS = 1e-6f;

constexpr size_t MB = 1024 * 1024;
constexpr size_t WS_CTL   = 0;
constexpr size_t WS_MODP  = 64 * 1024;
constexpr size_t WS_WIN   = WS_MODP + 8 * 8 * 6144 * 4;
constexpr size_t WS_WOUT  = WS_WIN + (size_t)NIN * 1024 * 2;
constexpr size_t WS_WQ    = WS_WOUT + 1024 * 1024 * 2;
constexpr size_t WS_SKB   = WS_WQ + 2048 * 1024 * 2;
constexpr size_t WS_WP    = WS_SKB + 16 * 128 * 128 * 2;
constexpr size_t WS_AFB   = WS_WP + 4 * 128 * 128 * 2;
constexpr size_t WS_UB    = WS_AFB + (size_t)T * 32 * 4;
constexpr size_t WS_VB    = WS_UB + 32 * MB;
constexpr size_t WS_SU    = WS_UB + 16 * MB, WS_SV = WS_VB + 16 * MB;
constexpr size_t WS_RA    = WS_VB + 32 * MB;
constexpr size_t WS_RZ    = WS_RA + 64 * MB;
constexpr size_t WS_RS    = WS_RZ + 128 * MB;
constexpr size_t WS_RO    = WS_RS + 6 * 16 * MB + 1 * MB;
constexpr size_t WS_END   = WS_RO + 128 * MB;
static_assert(WS_END <= 512 * MB, "workspace too large");

struct Params { const float* in[21]; float* out; unsigned char* ws; };

DI unsigned pk2(float a, float b) { f32x2 f = {a, b}; bf16x2v h = __builtin_convertvector(f, bf16x2v); return __builtin_bit_cast(unsigned, h); }
DI float dot2bf(unsigned a, unsigned b, float c) { return __builtin_amdgcn_fdot2_f32_bf16(__builtin_bit_cast(bf16x2v, a), __builtin_bit_cast(bf16x2v, b), c, false); }
DI float bflo(unsigned u) { return __uint_as_float(u << 16); }
DI float bfhi(unsigned u) { return __uint_as_float(u & 0xFFFF0000u); }
DI float wave_sum(float v) {
#pragma unroll
    for (int o = 1; o < 64; o <<= 1) v += __shfl_xor(v, o);
    return v;
}
DI bf16x8 ld_frag16(const bf16_t* p) { return __builtin_bit_cast(bf16x8, *(const u32x4*)p); }
DI bf16x8 ld_frag_perm(const bf16_t* p, int g) {
    const u32x2 lo = *(const u32x2*)(p + 4 * g), hi = *(const u32x2*)(p + 16 + 4 * g);
    u32x4 v = {lo.x, lo.y, hi.x, hi.y}; return __builtin_bit_cast(bf16x8, v);
}
DI int perm32(int k) { return (k & ~31) | (((k >> 2) & 3) << 3) | (((k >> 4) & 1) << 2) | (k & 3); }
DI bf16x8 pack8(const f32x4& a, const f32x4& b) { u32x4 v = {pk2(a[0], a[1]), pk2(a[2], a[3]), pk2(b[0], b[1]), pk2(b[2], b[3])}; return __builtin_bit_cast(bf16x8, v); }
#define MFMA16(a, b, c) __builtin_amdgcn_mfma_f32_16x16x32_bf16((a), (b), (c), 0, 0, 0)
#define MFMA32(a, b, c) __builtin_amdgcn_mfma_f32_32x32x16_bf16((a), (b), (c), 0, 0, 0)

#define XB_TMO      128
#define XB_XCNT(j)  (256  + 64 * (j))
#define XB_XSUB(j)  (1280 + 64 * (j))
#define XB_XGEN(j)  (2304 + 64 * (j))
#define XB_TOP      3328
#define XB_TOPGEN   3392
#define XCD_BAR_WORDS 3456
#define XB_SPIN_CAP (1u << 22)
DI unsigned xb_ld(unsigned* p)              { return __hip_atomic_load(p, __ATOMIC_RELAXED, __HIP_MEMORY_SCOPE_AGENT); }
DI unsigned xb_add(unsigned* p, unsigned v) { return __hip_atomic_fetch_add(p, v, __ATOMIC_RELAXED, __HIP_MEMORY_SCOPE_AGENT); }
DI unsigned xb_xcc_id() { return (unsigned)__builtin_amdgcn_s_getreg((3 << 11) | 20) & 0xFu; }
#define XB_SPIN(cond, bar) do { unsigned _sp = 0; while (cond) { __builtin_amdgcn_s_sleep(1); \
    if ((++_sp & 255u) == 0u) { if (xb_ld(&(bar)[XB_TMO])) break; if (_sp > XB_SPIN_CAP) { atomicAdd(&(bar)[XB_TMO], 1u); break; } } } } while (0)
struct XcdBarrier { unsigned* bar; unsigned x; volatile LAS unsigned* st; };
DI XcdBarrier xcd_barrier_post(unsigned* bar, volatile LAS unsigned* st) {
    XcdBarrier b; b.bar = bar; b.x = xb_xcc_id(); b.st = st;
    if (threadIdx.x == 0) (void)xb_add(&bar[XB_XCNT(b.x)], 1u);
    return b;
}
DI void xcd_barrier_complete(unsigned* bar, unsigned x, unsigned& nloc, unsigned& nx) {
    const unsigned G = gridDim.x * gridDim.y * gridDim.z;
    unsigned sum, cnt, mine, sp = 0u;
    for (;;) {
        sum = 0u; cnt = 0u; mine = 0u;
#pragma unroll
        for (unsigned j = 0; j < 16; ++j) { const unsigned c = xb_ld(&bar[XB_XCNT(j)]); sum += c; cnt += (c > 0u) ? 1u : 0u; mine = (j == x) ? c : mine; }
        if (sum == G) break;
        __builtin_amdgcn_s_sleep(1);
        if ((++sp & 255u) == 0u) { if (xb_ld(&bar[XB_TMO])) break; if (sp > XB_SPIN_CAP) { atomicAdd(&bar[XB_TMO], 1u); break; } }
    }
    nloc = mine > 0u ? mine : 1u; nx = cnt > 0u ? cnt : 1u;
}
DI void xcd_barrier(const XcdBarrier& b) {
    asm volatile("s_waitcnt vmcnt(0)" ::: "memory");
    __syncthreads();
    if (threadIdx.x == 0) {
        unsigned* bar = b.bar;
        __builtin_amdgcn_s_waitcnt(0);
        unsigned nloc = b.st[0], nx = b.st[1];
        if (nloc == 0u) { xcd_barrier_complete(bar, b.x, nloc, nx); b.st[0] = nloc; b.st[1] = nx; }
        const unsigned old = xb_add(&bar[XB_XSUB(b.x)], 1u);
        const unsigned gen = old / nloc;
        if (old + 1u == (gen + 1u) * nloc) {
            __builtin_amdgcn_fence(__ATOMIC_RELEASE, "agent");
            asm volatile("s_waitcnt vmcnt(0)" ::: "memory");
            const unsigned og = xb_add(&bar[XB_TOP], 1u);
            const unsigned tg = og / nx;
            if (og + 1u == (tg + 1u) * nx) xb_add(&bar[XB_TOPGEN], 1u);
            else XB_SPIN(xb_ld(&bar[XB_TOPGEN]) == tg, bar);
            __builtin_amdgcn_fence(__ATOMIC_ACQUIRE, "agent");
            xb_add(&bar[XB_XGEN(b.x)], 1u);
            asm volatile("s_waitcnt vmcnt(0)" ::: "memory");
        } else {
            XB_SPIN(xb_ld(&bar[XB_XGEN(b.x)]) == gen, bar);
            __builtin_amdgcn_fence(__ATOMIC_ACQUIRE, "agent");
            asm volatile("s_waitcnt vmcnt(0)" ::: "memory");
        }
    }
    __syncthreads();
}

constexpr int LDS_BYTES = 152 * 1024;
constexpr int LDS_BARW = LDS_BYTES - 16;

DI void p0_transpose_item(const float* W, int ldw, int K, bf16_t* WT, int dst_row0, int src_col0, float scale, bool zero, LAS float* scr, int kb, int lane) {
    const int k0 = 64 * kb;
#pragma unroll 8
    for (int i = 0; i < 32; ++i) { const int kk = 2 * i + (lane >> 5); scr[kk * 33 + (lane & 31)] = zero ? 0.f : W[(size_t)(k0 + kk) * ldw + src_col0 + (lane & 31)] * scale; }
    asm volatile("s_waitcnt lgkmcnt(0)" ::: "memory");
    const int c = lane & 7;
#pragma unroll
    for (int j = 0; j < 4; ++j) { const int n = (lane >> 3) + 8 * j; const LAS float* s = scr + (8 * c) * 33 + n;
        u32x4 o; o.x = pk2(s[0 * 33], s[1 * 33]); o.y = pk2(s[2 * 33], s[3 * 33]); o.z = pk2(s[4 * 33], s[5 * 33]); o.w = pk2(s[6 * 33], s[7 * 33]);
        *(u32x4*)(WT + (size_t)(dst_row0 + n) * K + k0 + 8 * c) = o; }
    asm volatile("s_waitcnt lgkmcnt(0)" ::: "memory");
}

DI void phase0(const Params& p, LAS unsigned char* lds, int tid, int lane, int wave) {
    asm volatile("" : "+v"(tid), "+v"(lane));
    unsigned char* ws = p.ws;
    LAS float* sl = (LAS float*)lds;
    LAS float* scr = (LAS float*)(lds + 32768 + wave * 8448);
    const float* c = p.in[1];
    for (int e = tid; e < 8192; e += NTH) { const int b = e >> 10, k = e & 1023; const float v = c[e]; sl[k * 8 + b] = v / (1.f + __expf(-v)); }
    __syncthreads();
    const int gw = wave * gridDim.x + blockIdx.x, NGW = gridDim.x * NWV;
    constexpr int I_MOD = 768, I_WIN = 16 * 68, I_WOUT = 16 * 32, I_WQ = 16 * 64, I_WP = 32;
    constexpr int NITEMS = I_MOD + I_WIN + I_WOUT + I_WQ + I_WP;
    for (int it = gw; it < NITEMS; it += NGW) {
        int r = it;
        if (r < I_MOD) {
            const int cg = r % 96, ks = r / 96, n = cg * 64 + lane, k0 = ks * 128;
            const float* W = p.in[2] + (size_t)k0 * 6144 + n;
            float acc[8];
#pragma unroll
            for (int b = 0; b < 8; ++b) acc[b] = 0.f;
#pragma unroll 8
            for (int k = 0; k < 128; ++k) {
                const float w = W[(size_t)k * 6144];
                const f32x4 s0 = *(const LAS f32x4*)(sl + (k0 + k) * 8), s1 = *(const LAS f32x4*)(sl + (k0 + k) * 8 + 4);
                acc[0] += s0[0] * w; acc[1] += s0[1] * w; acc[2] += s0[2] * w; acc[3] += s0[3] * w;
                acc[4] += s1[0] * w; acc[5] += s1[1] * w; acc[6] += s1[2] * w; acc[7] += s1[3] * w;
            }
            float* mp = (float*)(ws + WS_MODP) + (size_t)ks * 8 * 6144 + n;
#pragma unroll
            for (int b = 0; b < 8; ++b) mp[b * 6144] = acc[b];
            continue;
        }
        r -= I_MOD;
        if (r < I_WIN) {
            const int kb = r / 68, nb = r % 68, n0 = nb * 32;
            int src; bool zero = false; float scale = 1.f;
            if (n0 < 1536) { src = n0; if (n0 < 256) scale = 0.125f; } else if (n0 < 2048) src = n0 + 32; else if (n0 < 2080) src = 1536 + (n0 - 2048); else { src = 0; zero = true; }
            p0_transpose_item(p.in[6], 2080, 1024, (bf16_t*)(ws + WS_WIN), n0, src, scale, zero, scr, kb, lane);
            continue;
        }
        r -= I_WIN;
        if (r < I_WOUT) { p0_transpose_item(p.in[14], 1024, 1024, (bf16_t*)(ws + WS_WOUT), (r % 32) * 32, (r % 32) * 32, 1.f, false, scr, r / 32, lane); continue; }
        r -= I_WOUT;
        if (r < I_WQ) { p0_transpose_item(p.in[17], 2048, 1024, (bf16_t*)(ws + WS_WQ), (r % 64) * 32, (r % 64) * 32, 1.f, false, scr, r / 64, lane); continue; }
        r -= I_WQ;
        { const int g = r >> 3, kb = (r >> 2) & 1, nb = r & 3;
          p0_transpose_item(p.in[12] + g * 16384, 128, 128, (bf16_t*)(ws + WS_WP) + g * 16384, nb * 32, nb * 32, 1.f, false, scr, kb, lane); }
    }
    const size_t gt = (size_t)blockIdx.x * NTH + tid, NGT = (size_t)gridDim.x * NTH;
    constexpr size_t NSK = (size_t)16 * 128 * 128 / 8;
    for (size_t j = gt; j < NSK; j += NGT) {
        const float* src = p.in[18]; bf16_t* dst = (bf16_t*)(ws + WS_SKB);
        const f32x4 a = *(const f32x4*)(src + j * 8), b = *(const f32x4*)(src + j * 8 + 4);
        u32x4 o = {pk2(a[0], a[1]), pk2(a[2], a[3]), pk2(b[0], b[1]), pk2(b[2], b[3])};
        *(u32x4*)(dst + j * 8) = o;
    }
    for (int row = gw; row < 2 * 16384; row += NGW) {
        const int tb = row >> 14, e = row & 16383;
        const float* src = (tb ? p.in[20] : p.in[19]) + (size_t)e * D + 16 * lane;
        f32x4 v[4]; float m = 0.f;
#pragma unroll
        for (int q = 0; q < 4; ++q) { v[q] = *(const f32x4*)(src + 4 * q); m = fmaxf(m, fmaxf(fmaxf(fabsf(v[q][0]), fabsf(v[q][1])), fmaxf(fabsf(v[q][2]), fabsf(v[q][3])))); }
#pragma unroll
        for (int o = 1; o < 64; o <<= 1) m = fmaxf(m, __shfl_xor(m, o));
        int ex = (int)((__float_as_uint(m) >> 23) & 0xFFu) - 127;
        if (m < 1e-30f) ex = 7;
        const float sc = __uint_as_float((unsigned)(127 + 7 - ex) << 23), isc = __uint_as_float((unsigned)(127 - 7 + ex) << 23);
        u32x4 o;
#pragma unroll
        for (int q = 0; q < 4; ++q) { int w = 0; w = __builtin_amdgcn_cvt_pk_fp8_f32(v[q][0] * sc, v[q][1] * sc, w, false); w = __builtin_amdgcn_cvt_pk_fp8_f32(v[q][2] * sc, v[q][3] * sc, w, true); o[q] = (unsigned)w; }
        *(u32x4*)(ws + (tb ? WS_VB : WS_UB) + (size_t)e * 1024 + 16 * lane) = o;
        if (lane == 0) ((float*)(ws + (tb ? WS_SV : WS_SU)))[e] = isc;
    }
}

DI float mod_at(const Params& p, int b, int n) {
    const float* mp = (const float*)(p.ws + WS_MODP) + (size_t)b * 6144 + n;
    float s = p.in[3][n];
#pragma unroll
    for (int ks = 0; ks < 8; ++ks) s += mp[(size_t)ks * 8 * 6144];
    return s;
}

DI void phase1(const Params& p, LAS unsigned char* lds, int tid, int lane, int wave) {
    asm volatile("" : "+v"(tid), "+v"(lane));
    LAS float* lA = (LAS float*)lds; LAS float* lB = lA + 1024;
    const float* x = p.in[0]; bf16_t* H = (bf16_t*)(p.ws + WS_RA);
    for (int rt = blockIdx.x; rt < T / 128; rt += gridDim.x) {
        const int b = rt / 32;
        __syncthreads();
        for (int d = tid; d < 1024; d += NTH) { lA[d] = p.in[4][d] * (1.f + mod_at(p, b, 1024 + d)); lB[d] = mod_at(p, b, d); }
        __syncthreads();
        for (int r0 = wave; r0 < 128; r0 += 4 * NWV) {
            f32x4 v[4][4];
#pragma unroll
            for (int u = 0; u < 4; ++u) { const f32x4* xr = (const f32x4*)(x + ((size_t)rt * 128 + r0 + u * NWV) * D) + lane;
#pragma unroll
                for (int j = 0; j < 4; ++j) v[u][j] = xr[64 * j]; }
#pragma unroll
            for (int u = 0; u < 4; ++u) {
                const size_t row = (size_t)rt * 128 + r0 + u * NWV;
                float ss = 0.f;
#pragma unroll
                for (int j = 0; j < 4; ++j) ss += v[u][j][0] * v[u][j][0] + v[u][j][1] * v[u][j][1] + v[u][j][2] * v[u][j][2] + v[u][j][3] * v[u][j][3];
                const float rstd = rsqrtf(wave_sum(ss) * (1.f / D) + EPS);
                u32x2* o = (u32x2*)(H + row * D) + lane;
#pragma unroll
                for (int j = 0; j < 4; ++j) {
                    const f32x4 a = *(const LAS f32x4*)(lA + 4 * lane + 256 * j), bb = *(const LAS f32x4*)(lB + 4 * lane + 256 * j);
                    u32x2 w = {pk2(v[u][j][0] * rstd * a[0] + bb[0], v[u][j][1] * rstd * a[1] + bb[1]), pk2(v[u][j][2] * rstd * a[2] + bb[2], v[u][j][3] * rstd * a[3] + bb[3])};
                    o[64 * j] = w;
                }
            }
        }
    }
}

struct EpiZ {
    bf16_t* Z; float* AFB;
    DI void operator()(int m, int n, const f32x4& v) const {
        if (n < ZW) { u32x2 w = {pk2(v[0], v[1]), pk2(v[2], v[3])}; *(u32x2*)(Z + (size_t)m * ZW + n) = w; }
        else if (n < ZW + 32) { *(f32x4*)(AFB + (size_t)m * 32 + (n - ZW)) = v; }
    }
};
struct EpiF32 { float* C; int ldc; DI void operator()(int m, int n, const f32x4& v) const { *(f32x4*)(C + (size_t)m * ldc + n) = v; } };
struct EpiBf16 { bf16_t* C; int ldc; DI void operator()(int m, int n, const f32x4& v) const { u32x2 w = {pk2(v[0], v[1]), pk2(v[2], v[3])}; *(u32x2*)(C + (size_t)m * ldc + n) = w; } };

template <class Epi>
DI void gemm_phase(const bf16_t* A, const bf16_t* Bt, int M, int N, int K, const Epi& epi, LAS unsigned char* lds, int tid, int lane, int wave, int nt_first = 0) {
    constexpr int BM = 256, BN = 128, BK = 64, STAGE = (BM + BN) * 128;
    const int ntn = N / BN - nt_first, ntiles = (M / BM) * ntn, nk = K / BK;
    const int wm = wave & 3, wn = wave >> 2, c15 = lane & 15, g = lane >> 4;
    const int lrow = tid >> 3, lch = tid & 7;
    for (int tile = blockIdx.x; tile < ntiles; tile += gridDim.x) {
        const int m0 = (tile / ntn) * BM, n0 = (tile % ntn + nt_first) * BN;
        f32x4 acc[4][4];
#pragma unroll
        for (int i = 0; i < 4; ++i)
#pragma unroll
            for (int j = 0; j < 4; ++j) acc[i][j] = (f32x4){0.f, 0.f, 0.f, 0.f};
        u32x4 ra[4], rb[2];
        const bf16_t* Ag = A + (size_t)(m0 + lrow) * K + lch * 8;
        const bf16_t* Bg = Bt + (size_t)(n0 + lrow) * K + lch * 8;
        const int woff = lrow * 128 + ((lch ^ (lrow & 7)) * 16);
        __syncthreads();
#pragma unroll
        for (int ps = 0; ps < 4; ++ps) ra[ps] = *(const u32x4*)(Ag + (size_t)(64 * ps) * K);
#pragma unroll
        for (int ps = 0; ps < 2; ++ps) rb[ps] = *(const u32x4*)(Bg + (size_t)(64 * ps) * K);
#pragma unroll
        for (int ps = 0; ps < 4; ++ps) *(LAS u32x4*)(lds + woff + ps * 8192) = ra[ps];
#pragma unroll
        for (int ps = 0; ps < 2; ++ps) *(LAS u32x4*)(lds + BM * 128 + woff + ps * 8192) = rb[ps];
        __syncthreads();
        for (int kt = 0; kt < nk; ++kt) {
            const bool more = (kt + 1 < nk);
            if (more) {
#pragma unroll
                for (int ps = 0; ps < 4; ++ps) ra[ps] = *(const u32x4*)(Ag + (size_t)(64 * ps) * K + (kt + 1) * BK);
#pragma unroll
                for (int ps = 0; ps < 2; ++ps) rb[ps] = *(const u32x4*)(Bg + (size_t)(64 * ps) * K + (kt + 1) * BK);
            }
            LAS unsigned char* sa = lds + (kt & 1) * STAGE; LAS unsigned char* sb = sa + BM * 128;
#pragma unroll
            for (int s = 0; s < 2; ++s) {
                bf16x8 fa[4], fb[4];
#pragma unroll
                for (int i = 0; i < 4; ++i) { const int row = wm * 64 + i * 16 + c15; fa[i] = *(const LAS bf16x8*)(sa + row * 128 + (((4 * s + g) ^ (row & 7)) * 16)); }
#pragma unroll
                for (int j = 0; j < 4; ++j) { const int row = wn * 64 + j * 16 + c15; fb[j] = *(const LAS bf16x8*)(sb + row * 128 + (((4 * s + g) ^ (row & 7)) * 16)); }
#pragma unroll
                for (int i = 0; i < 4; ++i)
#pragma unroll
                    for (int j = 0; j < 4; ++j) acc[i][j] = MFMA16(fb[j], fa[i], acc[i][j]);
            }
            if (more) {
                LAS unsigned char* da = lds + ((kt + 1) & 1) * STAGE;
#pragma unroll
                for (int ps = 0; ps < 4; ++ps) *(LAS u32x4*)(da + woff + ps * 8192) = ra[ps];
#pragma unroll
                for (int ps = 0; ps < 2; ++ps) *(LAS u32x4*)(da + BM * 128 + woff + ps * 8192) = rb[ps];
            }
            __syncthreads();
        }
#pragma unroll
        for (int i = 0; i < 4; ++i)
#pragma unroll
            for (int j = 0; j < 4; ++j) epi(m0 + wm * 64 + i * 16 + c15, n0 + wn * 64 + j * 16 + 4 * g, acc[i][j]);
    }
}

namespace pg8 {
#define PG8_LAS __attribute__((address_space(3)))
constexpr int BM = 256, BK = 64, HALF = 128, HTB = HALF * BK * 2  , STAGE_BYTES = 8 * HTB, NXCD = 8, WGM = 8;

__host__ __device__ __forceinline__ int lds_byte(int r, int c) { const int st = (r >> 4) * 2 + (c >> 5), rr = r & 15, cc = c & 31, ob = rr * 64 + cc * 2; return st * 1024 + (ob ^ (((ob >> 9) & 1) << 5)); }
__host__ __device__ __forceinline__ void stage_rc(int b, int& R, int& C) { const int st = b / 1024, sb = b % 1024, swz = sb ^ (((sb >> 9) & 1) << 5); R = (st >> 1) * 16 + swz / 64; C = (st & 1) * 32 + (swz % 64) / 2; }
__host__ __device__ __forceinline__ int perm32(int rho) { const int n = rho >> 4, i = rho & 15; return 8 * (i >> 2) + 4 * n + (i & 3); }

struct Unit { int pm, pn; };
struct Gemm { const bf16_t* A; const bf16_t* Bt; int M, N, K; };

struct StaticOrder {
    int nM, nN, nwg, G, c;
    __host__ __device__ void init(int M, int N, int G_, int c_) { nM = M / BM; nN = N / BM; nwg = nM * nN; G = G_; c = c_; }
    __host__ __device__ bool next(int i, Unit& u) const {
        const long L = (long)i * G + c; if (L >= nwg) return false;
        int wgid = (int)L; { const int q = nwg / NXCD, r = nwg % NXCD, xcd = wgid % NXCD, off = wgid / NXCD; wgid = (xcd < r ? xcd * (q + 1) : r * (q + 1) + (xcd - r) * q) + off; }
        const int nig = WGM * nN, gid = wgid / nig, fm = gid * WGM, gsz = (nM - fm) < WGM ? (nM - fm) : WGM;
        u.pm = fm + ((wgid % nig) % gsz); u.pn = (wgid % nig) / gsz; return true;
    }
    __device__ __forceinline__ void a_ready(const Unit&) const {}
    __device__ __forceinline__ void done(const Unit&) const {}
};

struct EpiB16 {
    static constexpr bool PERM = true, AFTER_DRAIN = false;
    bf16_t* O; int ldc;
    __device__ __forceinline__ void operator()(const f32x4 (&acc)[2][2][4][2], const Unit& u, int wr, int wc, int fr, int fq) const {
#pragma unroll
        for (int ai = 0; ai < 2; ++ai)
#pragma unroll
            for (int m = 0; m < 4; ++m) { bf16_t* rowp = O + (size_t)(u.pm * BM + ai * HALF + wr * 64 + m * 16 + fr) * ldc + u.pn * BM + wc * 32 + 8 * fq;
#pragma unroll
                for (int bj = 0; bj < 2; ++bj) { const f32x4 v0 = acc[ai][bj][m][0], v1 = acc[ai][bj][m][1];
                    u32x4 w; w.x = ::pk2(v0[0], v0[1]); w.y = ::pk2(v0[2], v0[3]); w.z = ::pk2(v1[0], v1[1]); w.w = ::pk2(v1[2], v1[3]);
                    *(u32x4*)(rowp + bj * HALF) = w; } }
    }
};
struct EpiF {
    static constexpr bool PERM = false, AFTER_DRAIN = false;
    float* O; int ldc;
    __device__ __forceinline__ void operator()(const f32x4 (&acc)[2][2][4][2], const Unit& u, int wr, int wc, int fr, int fq) const {
#pragma unroll
        for (int ai = 0; ai < 2; ++ai)
#pragma unroll
            for (int m = 0; m < 4; ++m) { float* rowp = O + (size_t)(u.pm * BM + ai * HALF + wr * 64 + m * 16 + fr) * ldc + u.pn * BM + wc * 32 + 4 * fq;
#pragma unroll
                for (int bj = 0; bj < 2; ++bj)
#pragma unroll
                    for (int n = 0; n < 2; ++n) *(f32x4*)(rowp + bj * HALF + 16 * n) = acc[ai][bj][m][n]; }
    }
};
template <class Epi, class Sched, bool ALIGN_EPI = false, bool SP2 = false>
__device__ __forceinline__ void gemm_phase(PG8_LAS unsigned char* lds, const Gemm g, const Sched& S, const Epi& E) {
    const int tid = threadIdx.x, wid = __builtin_amdgcn_readfirstlane(tid >> 6), lane = tid & 63, wr = wid >> 2, wc = wid & 3, fr = lane & 15, fq = lane >> 4;
    const int K = g.K, nt = K / BK;
    unsigned voffA[2], voffB[2];
#pragma unroll
    for (int i = 0; i < 2; ++i) { int R, C; stage_rc(tid * 16 + i * 8192, R, C); const int Rb = Epi::PERM ? ((R & ~31) + perm32(R & 31)) : R;
        voffA[i] = (unsigned)(R * K + C) * 2u; voffB[i] = (unsigned)(Rb * K + C) * 2u; }
    const size_t kstep = (size_t)(BK * 2);
    const size_t hstep = (size_t)HALF * K * 2;
    const size_t tstep = 2 * hstep;
    const unsigned ldsw = (unsigned)wid * 1024u;
    const int aoff = lds_byte(wr * 64 + fr, fq * 8), boff = lds_byte(wc * 32 + fr, fq * 8);
#define PG8_SA(b, h) (((b) * 2 + (h)) * HTB)
#define PG8_SB(b, h) ((4 + (b) * 2 + (h)) * HTB)
#define PG8_STAGE(bufoff, gbase, voff) do { _Pragma("unroll") for (int _i = 0; _i < 2; ++_i) \
        __builtin_amdgcn_global_load_lds((const unsigned*)((const char*)(gbase) + (voff)[_i]), (PG8_LAS unsigned*)(lds + (bufoff) + ldsw + _i * 8192), 16, 0, 0); } while (0)
#define PG8_LDA(dst, b, h) do { _Pragma("unroll") for (int m = 0; m < 4; ++m) _Pragma("unroll") for (int k = 0; k < 2; ++k) dst[m][k] = *(const PG8_LAS bf16x8*)(lds + PG8_SA(b, h) + aoff + m * 2048 + k * 1024); } while (0)
#define PG8_LDB(dst, b, h) do { _Pragma("unroll") for (int n = 0; n < 2; ++n) _Pragma("unroll") for (int k = 0; k < 2; ++k) dst[n][k] = *(const PG8_LAS bf16x8*)(lds + PG8_SB(b, h) + boff + n * 2048 + k * 1024); } while (0)
#define PG8_MMA(ai, bj, At, Bt) do { __builtin_amdgcn_s_setprio(1); _Pragma("unroll") for (int m = 0; m < 4; ++m) _Pragma("unroll") for (int n = 0; n < 2; ++n) _Pragma("unroll") for (int k = 0; k < 2; ++k) \
        acc[ai][bj][m][n] = __builtin_amdgcn_mfma_f32_16x16x32_bf16(Bt[n][k], At[m][k], acc[ai][bj][m][n], 0, 0, 0); __builtin_amdgcn_s_setprio(0); } while (0)
#define PG8_WAIT_V(n) asm volatile("s_waitcnt vmcnt(" #n ")" ::: "memory")
#define PG8_WAIT_L(n) asm volatile("s_waitcnt lgkmcnt(" #n ")" ::: "memory")
#define PG8_BAR __builtin_amdgcn_s_barrier()
#define PG8_SCHED __builtin_amdgcn_sched_barrier(0)
    Unit cur, nxt; int ui = 0;
    if (!S.next(0, cur)) return;
    f32x4 acc[2][2][4][2];
#pragma unroll
    for (int a = 0; a < 2; ++a)
#pragma unroll
        for (int b = 0; b < 2; ++b)
#pragma unroll
            for (int m = 0; m < 4; ++m)
#pragma unroll
                for (int n = 0; n < 2; ++n) acc[a][b][m][n] = (f32x4){0.f, 0.f, 0.f, 0.f};
    bf16x8 At[4][2], B0[2][2], B1[2][2];
    const char* cA = (const char*)g.A + (size_t)cur.pm * tstep; const char* cB = (const char*)g.Bt + (size_t)cur.pn * tstep;
    S.a_ready(cur);
    if constexpr (SP2) {
        PG8_STAGE(PG8_SB(0, 0), cB, voffB); PG8_STAGE(PG8_SB(0, 1), cB + hstep, voffB); PG8_STAGE(PG8_SA(0, 0), cA, voffA); PG8_STAGE(PG8_SA(0, 1), cA + hstep, voffA);
        if (wr == 1) PG8_BAR;
        PG8_WAIT_V(2); PG8_BAR;
        PG8_STAGE(PG8_SB(1, 0), cB + kstep, voffB); PG8_STAGE(PG8_SA(1, 0), cA + kstep, voffA); PG8_STAGE(PG8_SB(1, 1), cB + hstep + kstep, voffB);
        PG8_WAIT_V(6); PG8_BAR;
    } else {
        PG8_STAGE(PG8_SB(0, 0), cB, voffB); PG8_STAGE(PG8_SA(0, 0), cA, voffA); PG8_STAGE(PG8_SB(0, 1), cB + hstep, voffB); PG8_STAGE(PG8_SA(0, 1), cA + hstep, voffA);
        if (wr == 1) PG8_BAR;
        PG8_WAIT_V(4); PG8_BAR;
        PG8_STAGE(PG8_SB(1, 0), cB + kstep, voffB); PG8_STAGE(PG8_SA(1, 0), cA + kstep, voffA); PG8_STAGE(PG8_SB(1, 1), cB + hstep + kstep, voffB);
        PG8_WAIT_V(6); PG8_BAR;
    }
    for (;;) {
        const bool has_next = S.next(ui + 1, nxt);
        const char* nA = has_next ? (const char*)g.A + (size_t)nxt.pm * tstep : cA; const char* nB = has_next ? (const char*)g.Bt + (size_t)nxt.pn * tstep : cB;
        for (int t = 0; t < nt; t += 2) {
            const bool last = (t == nt - 2);
            const char* a1 = cA + (size_t)(t + 1) * kstep;
            const char* a2 = last ? nA : cA + (size_t)(t + 2) * kstep; const char* b2 = last ? nB : cB + (size_t)(t + 2) * kstep;
            const char* a3 = a2 + kstep; const char* b3 = b2 + kstep;
            if (last && has_next) S.a_ready(nxt);
            if constexpr (SP2) {
            PG8_LDB(B0, 0, 0); PG8_LDB(B1, 0, 1); PG8_SCHED; PG8_LDA(At, 0, 0); PG8_STAGE(PG8_SA(1, 1), a1 + hstep, voffA);
            PG8_WAIT_V(8); PG8_WAIT_L(0); PG8_BAR; PG8_MMA(0, 0, At, B0); PG8_MMA(0, 1, At, B1); PG8_BAR; PG8_SCHED;
            PG8_LDA(At, 0, 1); PG8_STAGE(PG8_SB(0, 0), b2, voffB); PG8_STAGE(PG8_SB(0, 1), b2 + hstep, voffB); PG8_STAGE(PG8_SA(0, 0), a2, voffA);
            PG8_WAIT_V(8); PG8_WAIT_L(0); PG8_BAR; PG8_MMA(1, 0, At, B0); PG8_MMA(1, 1, At, B1); PG8_BAR; PG8_SCHED;
            PG8_LDB(B0, 1, 0); PG8_LDB(B1, 1, 1); PG8_SCHED; PG8_LDA(At, 1, 0); PG8_STAGE(PG8_SA(0, 1), a2 + hstep, voffA);
            PG8_WAIT_V(8); PG8_WAIT_L(0); PG8_BAR; PG8_MMA(0, 0, At, B0); PG8_MMA(0, 1, At, B1); PG8_BAR; PG8_SCHED;
            PG8_LDA(At, 1, 1); PG8_STAGE(PG8_SB(1, 0), b3, voffB); PG8_STAGE(PG8_SB(1, 1), b3 + hstep, voffB); PG8_STAGE(PG8_SA(1, 0), a3, voffA);
            PG8_WAIT_V(8); PG8_WAIT_L(0); PG8_BAR; PG8_MMA(1, 0, At, B0); PG8_MMA(1, 1, At, B1); PG8_BAR; PG8_SCHED;
            } else {
            PG8_LDB(B0, 0, 0); PG8_SCHED; PG8_LDA(At, 0, 0); PG8_STAGE(PG8_SA(1, 1), a1 + hstep, voffA);
            PG8_WAIT_L(8); PG8_BAR; PG8_WAIT_L(0); PG8_MMA(0, 0, At, B0); PG8_BAR; PG8_SCHED;
            PG8_LDB(B1, 0, 1); PG8_STAGE(PG8_SB(0, 0), b2, voffB);
            PG8_BAR; PG8_WAIT_L(0); PG8_MMA(0, 1, At, B1); PG8_BAR;
            PG8_LDA(At, 0, 1); PG8_STAGE(PG8_SA(0, 0), a2, voffA);
            PG8_BAR; PG8_WAIT_L(0); PG8_MMA(1, 0, At, B0); PG8_BAR; PG8_SCHED;
            PG8_STAGE(PG8_SB(0, 1), b2 + hstep, voffB);
            PG8_WAIT_V(6); PG8_BAR; PG8_MMA(1, 1, At, B1); PG8_BAR;
            PG8_LDB(B0, 1, 0); PG8_SCHED; PG8_LDA(At, 1, 0); PG8_STAGE(PG8_SA(0, 1), a2 + hstep, voffA);
            PG8_WAIT_L(8); PG8_BAR; PG8_WAIT_L(0); PG8_MMA(0, 0, At, B0); PG8_BAR; PG8_SCHED;
            PG8_LDB(B1, 1, 1); PG8_STAGE(PG8_SB(1, 0), b3, voffB);
            PG8_BAR; PG8_WAIT_L(0); PG8_MMA(0, 1, At, B1); PG8_BAR;
            PG8_LDA(At, 1, 1); PG8_STAGE(PG8_SA(1, 0), a3, voffA);
            PG8_BAR; PG8_WAIT_L(0); PG8_MMA(1, 0, At, B0); PG8_BAR; PG8_SCHED;
            PG8_STAGE(PG8_SB(1, 1), b3 + hstep, voffB);
            PG8_WAIT_V(6); PG8_BAR; PG8_MMA(1, 1, At, B1); PG8_BAR;
            }
        }
        if constexpr (ALIGN_EPI) { if (wr == 0) PG8_BAR; }
        if constexpr (!Epi::AFTER_DRAIN) { E(acc, cur, wr, wc, fr, fq); S.done(cur); }
        if (!has_next) break;
#pragma unroll
        for (int a = 0; a < 2; ++a)
#pragma unroll
            for (int b = 0; b < 2; ++b)
#pragma unroll
                for (int m = 0; m < 4; ++m)
#pragma unroll
                    for (int n = 0; n < 2; ++n) acc[a][b][m][n] = (f32x4){0.f, 0.f, 0.f, 0.f};
        cur = nxt; cA = nA; cB = nB; ++ui;
        if constexpr (ALIGN_EPI) { if (wr == 1) PG8_BAR; }
    }
    PG8_WAIT_V(0);
    if constexpr (!ALIGN_EPI) { if (wr == 0) PG8_BAR; }
    PG8_BAR;
    if constexpr (Epi::AFTER_DRAIN) { E.fused(acc, cur, wr, wc, fr, fq, lds, wid, lane); S.done(cur); }
#undef PG8_SA
#undef PG8_SB
#undef PG8_STAGE
#undef PG8_LDA
#undef PG8_LDB
#undef PG8_MMA
#undef PG8_WAIT_V
#undef PG8_WAIT_L
#undef PG8_BAR
#undef PG8_SCHED
}
}

constexpr int NSEG = 8, SEGC = 64 / NSEG;
constexpr size_t WS_SSEG = WS_RA + 32 * MB;
constexpr size_t WS_GSEG = WS_SSEG + 16 * MB;
DI float logsig(float x) { return fminf(x, 0.f) - __logf(1.f + __expf(-fabsf(x))); }

DI void phase3a(const Params& p, LAS unsigned char* lds, int tid, int lane, int wave) {
    asm volatile("" : "+v"(tid), "+v"(lane));
    unsigned char* ws = p.ws;
    const bf16_t* Z = (const bf16_t*)(ws + WS_RZ);
    const float* AFB = (const float*)(ws + WS_AFB);
    bf16_t* QD[2] = {(bf16_t*)(ws + WS_RS), (bf16_t*)(ws + WS_RS + 48 * MB)};
    bf16_t* KI[2] = {(bf16_t*)(ws + WS_RS + 16 * MB), (bf16_t*)(ws + WS_RS + 64 * MB)};
    bf16_t* KE[2] = {(bf16_t*)(ws + WS_RS + 32 * MB), (bf16_t*)(ws + WS_RS + 80 * MB)};
    float* GAM[2] = {(float*)(ws + WS_RS + 96 * MB), (float*)(ws + WS_RS + 96 * MB + 512 * 1024)};
    bf16_t* VT = (bf16_t*)(ws + WS_RA);
    LAS float* la[2] = {(LAS float*)lds, (LAS float*)(lds + 16384)};
    LAS float* part[2] = {(LAS float*)(lds + 32768), (LAS float*)(lds + 32768 + 2048)};
    LAS bf16_t* keT[2] = {(LAS bf16_t*)(lds + 36864), (LAS bf16_t*)(lds + 36864 + 9216)};
    LAS bf16_t* vT = (LAS bf16_t*)(lds + 55296);
    const int c15 = lane & 15, g = lane >> 4;
    for (int task = blockIdx.x; task < 256; task += gridDim.x) {
      const int h = task & 3, pb = (task >> 2) & 7, b = task >> 5;
      f32x4 Sf[4], Sb[4];
#pragma unroll
      for (int kt = 0; kt < 4; ++kt) { Sf[kt] = (f32x4){0.f, 0.f, 0.f, 0.f}; Sb[kt] = (f32x4){0.f, 0.f, 0.f, 0.f}; }
      LAS float* gs = (LAS float*)(lds + 73728);
      LAS float* wl = (LAS float*)(lds + 74752);
      __syncthreads();
      if (tid < 128) gs[tid] = 0.f;
      for (int e = tid; e < 2048; e += NTH) { const int dir = e >> 10, r = (e >> 6) & 15, d = e & 63; wl[e] = (dir ? p.in[9] : p.in[7])[r * 256 + h * 64 + d]; }
      f32x4 afp[8];
      { const size_t tp = (size_t)b * SEQ + (size_t)(pb * 8) * 64 + (tid >> 3);
#pragma unroll
        for (int q = 0; q < 8; ++q) afp[q] = *(const f32x4*)(AFB + tp * 32 + 4 * q); }
      for (int ci = 0; ci < 8; ++ci) {
        const int n = pb * 8 + ci;
        const int tok0 = b * SEQ + n * 64;
        const int i = tid >> 3, dg = tid & 7, d0 = dg * 8;
        const size_t t = (size_t)tok0 + i;
        const u32x4 qv = *(const u32x4*)(Z + t * ZW + h * 64 + d0), kv = *(const u32x4*)(Z + t * ZW + 256 + h * 64 + d0);
        u32x4 vvp[2];
#pragma unroll
        for (int ps = 0; ps < 2; ++ps) { const int idx = tid + NTH * ps, vi = idx >> 4, ch = idx & 15; vvp[ps] = *(const u32x4*)(Z + ((size_t)tok0 + vi) * ZW + 512 + h * 128 + ch * 8); }
        __syncthreads();
        {
            float af[16], ab[16];
#pragma unroll
            for (int q = 0; q < 4; ++q) { const f32x4 a = afp[q], bb = afp[4 + q];
                af[4 * q] = a[0]; af[4 * q + 1] = a[1]; af[4 * q + 2] = a[2]; af[4 * q + 3] = a[3]; ab[4 * q] = bb[0]; ab[4 * q + 1] = bb[1]; ab[4 * q + 2] = bb[2]; ab[4 * q + 3] = bb[3]; }
            { const size_t tn = t + (ci < 7 ? 64 : 0);
#pragma unroll
              for (int q = 0; q < 8; ++q) afp[q] = *(const f32x4*)(AFB + tn * 32 + 4 * q); }
            const LAS float* waf = wl + d0; const LAS float* wab = wl + 1024 + d0;
            float xf[8], xb[8];
#pragma unroll
            for (int e = 0; e < 8; ++e) { xf[e] = p.in[8][h * 64 + d0 + e]; xb[e] = p.in[10][h * 64 + d0 + e]; }
#pragma unroll
            for (int r = 0; r < 16; ++r) {
                const f32x4 w0 = *(const LAS f32x4*)(waf + r * 64), w1 = *(const LAS f32x4*)(waf + r * 64 + 4), v0 = *(const LAS f32x4*)(wab + r * 64), v1 = *(const LAS f32x4*)(wab + r * 64 + 4);
#pragma unroll
                for (int e = 0; e < 4; ++e) { xf[e] += af[r] * w0[e]; xf[4 + e] += af[r] * w1[e]; xb[e] += ab[r] * v0[e]; xb[4 + e] += ab[r] * v1[e]; }
            }
#pragma unroll
            for (int e = 0; e < 8; ++e) { la[0][i * 64 + d0 + e] = logsig(xf[e]) * 0.0625f; la[1][i * 64 + d0 + e] = logsig(xb[e]) * 0.0625f; }
        }
        __syncthreads();
        {
            const int d = tid & 63, pt = tid >> 6;
            float run = 0.f;
#pragma unroll
            for (int j = 0; j < 8; ++j) { run += la[0][(8 * pt + j) * 64 + d]; la[0][(8 * pt + j) * 64 + d] = run; }
            part[0][pt * 64 + d] = run;
            run = 0.f;
#pragma unroll
            for (int j = 7; j >= 0; --j) { run += la[1][(8 * pt + j) * 64 + d]; la[1][(8 * pt + j) * 64 + d] = run; }
            part[1][pt * 64 + d] = run;
            __syncthreads();
            float of = 0.f, ob = 0.f;
#pragma unroll
            for (int q = 0; q < 8; ++q) { if (q < pt) of += part[0][q * 64 + d]; if (q > pt) ob += part[1][q * 64 + d]; }
#pragma unroll
            for (int j = 0; j < 8; ++j) { la[0][(8 * pt + j) * 64 + d] += of; la[1][(8 * pt + j) * 64 + d] += ob; }
        }
        __syncthreads();
        {
            float q[8], k[8];
#pragma unroll
            for (int e = 0; e < 4; ++e) { q[2 * e] = bflo(qv[e]); q[2 * e + 1] = bfhi(qv[e]); k[2 * e] = bflo(kv[e]); k[2 * e + 1] = bfhi(kv[e]); }
#pragma unroll
            for (int dir = 0; dir < 2; ++dir) {
                float qd[8], ki[8], ke[8];
#pragma unroll
                for (int e = 0; e < 8; ++e) {
                    const float bb = la[dir][i * 64 + d0 + e], bl = la[dir][(dir ? 0 : 63) * 64 + d0 + e];
                    qd[e] = q[e] * __expf(bb); ki[e] = k[e] * __expf(-bb); ke[e] = k[e] * __expf(bl - bb);
                    if (i == (dir ? 0 : 63)) GAM[dir][((size_t)(b * 4 + h) * 64 + n) * 64 + d0 + e] = __expf(bl);
                }
                {
                    u32x2 a0 = {pk2(qd[0], qd[1]), pk2(qd[2], qd[3])}, a1 = {pk2(qd[4], qd[5]), pk2(qd[6], qd[7])};
                    u32x2 b0 = {pk2(ki[0], ki[1]), pk2(ki[2], ki[3])}, b1 = {pk2(ki[4], ki[5]), pk2(ki[6], ki[7])};
                    *(u32x2*)(QD[dir] + t * 256 + h * 64 + perm32(d0)) = a0; *(u32x2*)(QD[dir] + t * 256 + h * 64 + perm32(d0 + 4)) = a1;
                    *(u32x2*)(KI[dir] + t * 256 + h * 64 + perm32(d0)) = b0; *(u32x2*)(KI[dir] + t * 256 + h * 64 + perm32(d0 + 4)) = b1;
                }
#pragma unroll
                for (int e = 0; e < 4; ++e) { const unsigned w = pk2(ke[2 * e], ke[2 * e + 1]); keT[dir][(d0 + 2 * e) * 72 + perm32(i)] = (bf16_t)(w & 0xFFFFu); keT[dir][(d0 + 2 * e + 1) * 72 + perm32(i)] = (bf16_t)(w >> 16); }
            }
#pragma unroll
            for (int ps = 0; ps < 2; ++ps) {
                const int idx = tid + NTH * ps, vi = idx >> 4, ch = idx & 15;
                const u32x4 vv = vvp[ps];
#pragma unroll
                for (int e = 0; e < 4; ++e) { vT[(ch * 8 + 2 * e) * 72 + perm32(vi)] = (bf16_t)(vv[e] & 0xFFFFu); vT[(ch * 8 + 2 * e + 1) * 72 + perm32(vi)] = (bf16_t)(vv[e] >> 16); }
            }
        }
        __syncthreads();
        {
            const int dk = tid >> 3, ch = tid & 7;
#pragma unroll
            for (int dir = 0; dir < 2; ++dir) {
                const u32x4 v = *(const LAS u32x4*)(keT[dir] + dk * 72 + ch * 8);
                *(u32x4*)(KE[dir] + ((size_t)(b * 64 + n) * 256 + h * 64 + dk) * 64 + ch * 8) = v;
            }
#pragma unroll
            for (int ps = 0; ps < 2; ++ps) {
                const int idx = tid + NTH * ps, dv = idx >> 3, c8 = idx & 7;
                const LAS bf16_t* s = vT + dv * 72 + c8 * 8;
                u32x4 v; v.x = s[0] | ((unsigned)s[1] << 16); v.y = s[2] | ((unsigned)s[3] << 16); v.z = s[4] | ((unsigned)s[5] << 16); v.w = s[6] | ((unsigned)s[7] << 16);
                *(u32x4*)(VT + ((size_t)(b * 64 + n) * 512 + h * 128 + dv) * 64 + c8 * 8) = v;
            }
            bf16x8 vb[2];
#pragma unroll
            for (int sk = 0; sk < 2; ++sk) vb[sk] = *(const LAS bf16x8*)(vT + (16 * wave + c15) * 72 + 32 * sk + 8 * g);
#pragma unroll
            for (int kt = 0; kt < 4; ++kt) {
                const f32x4 gf = {__expf(la[0][63 * 64 + 16 * kt + 4 * g]), __expf(la[0][63 * 64 + 16 * kt + 4 * g + 1]), __expf(la[0][63 * 64 + 16 * kt + 4 * g + 2]), __expf(la[0][63 * 64 + 16 * kt + 4 * g + 3])};
                const LAS float* gq = gs + (ci & 1) * 128 + 64 + 16 * kt + 4 * g;
                const f32x4 pb = {__expf(gq[0]), __expf(gq[1]), __expf(gq[2]), __expf(gq[3])};
                f32x4 uf = Sf[kt] * gf, ub = (f32x4){0.f, 0.f, 0.f, 0.f};
#pragma unroll
                for (int sk = 0; sk < 2; ++sk) {
                    uf = MFMA16(*(const LAS bf16x8*)(keT[0] + (16 * kt + c15) * 72 + 32 * sk + 8 * g), vb[sk], uf);
                    ub = MFMA16(*(const LAS bf16x8*)(keT[1] + (16 * kt + c15) * 72 + 32 * sk + 8 * g), vb[sk], ub);
                }
                Sf[kt] = uf;
                Sb[kt] = Sb[kt] + pb * ub;
            }
            if (tid < 64) { gs[((ci + 1) & 1) * 128 + tid] = gs[(ci & 1) * 128 + tid] + la[0][63 * 64 + tid]; gs[((ci + 1) & 1) * 128 + 64 + tid] = gs[(ci & 1) * 128 + 64 + tid] + la[1][tid]; }
        }
      }
      {
        f32x4* SSEG = (f32x4*)(ws + WS_SSEG); float* GSEG = (float*)(ws + WS_GSEG);
        const int sl = wave >> 1, nt = wave & 1;
#pragma unroll
        for (int dir = 0; dir < 2; ++dir) {
            const int bhd = b * 8 + h * 2 + dir, sg = dir ? 7 - pb : pb, tk = ((bhd * 8 + sg) << 2) | sl;
#pragma unroll
            for (int kt = 0; kt < 4; ++kt) {
                SSEG[((size_t)tk * 8 + kt * 2 + nt) * 64 + lane] = dir ? Sb[kt] : Sf[kt];
            }
        }
        __syncthreads();
        if (tid < 128) { const int dir = tid >> 6, d = tid & 63, bhd = b * 8 + h * 2 + dir, sg = dir ? 7 - pb : pb; GSEG[(bhd * 8 + sg) * 64 + d] = __expf(gs[tid]); }
      }
    }
}

template <bool FULL>
DI void phase3b(const Params& p, int lane, int wave) {
    asm volatile("" : "+v"(lane));
    unsigned char* ws = p.ws;
    const int c15 = lane & 15, g = lane >> 4;
    for (int task = blockIdx.x * NWV + wave; task < 2048; task += gridDim.x * NWV) {
        const int sl = task & 3, pair = task >> 2, sg = pair & 7, bhd = pair >> 3;
        const int dir = bhd & 1, h = (bhd >> 1) & 3, b = bhd >> 3;
        const bf16_t* QD = (const bf16_t*)(ws + WS_RS + (dir ? 48 : 0) * MB) + (size_t)b * SEQ * 256 + h * 64;
        const bf16_t* KI = (const bf16_t*)(ws + WS_RS + (dir ? 64 : 16) * MB) + (size_t)b * SEQ * 256 + h * 64;
        const bf16_t* KE = (const bf16_t*)(ws + WS_RS + (dir ? 80 : 32) * MB) + ((size_t)b * 64 * 256 + h * 64) * 64;
        const float* GAM = (const float*)(ws + WS_RS + 96 * MB + (dir ? 512 * 1024 : 0)) + (size_t)(b * 4 + h) * 64 * 64;
        const bf16_t* VT = (const bf16_t*)(ws + WS_RA) + ((size_t)b * 64 * 512 + h * 128 + sl * 32) * 64;
        bf16_t* O = (bf16_t*)(ws + WS_RO + (dir ? 64 : 0) * MB) + (size_t)b * SEQ * 512 + h * 128 + sl * 32;
        f32x4* SSEG = (f32x4*)(ws + WS_SSEG); float* GSEG = (float*)(ws + WS_GSEG);
        f32x4 S[4][2];
#pragma unroll
        for (int kt = 0; kt < 4; ++kt) { S[kt][0] = (f32x4){0.f, 0.f, 0.f, 0.f}; S[kt][1] = (f32x4){0.f, 0.f, 0.f, 0.f}; }
        if (FULL) {
            for (int s2 = 0; s2 < sg; ++s2) {
                const int t2 = ((bhd * 8 + s2) << 2) | sl;
#pragma unroll
                for (int kt = 0; kt < 4; ++kt) {
                    const f32x4 gm = *(const f32x4*)(GSEG + (bhd * 8 + s2) * 64 + 16 * kt + 4 * g);
#pragma unroll
                    for (int nt = 0; nt < 2; ++nt) S[kt][nt] = S[kt][nt] * gm + SSEG[((size_t)t2 * 8 + kt * 2 + nt) * 64 + lane];
                }
            }
        }
        f32x4 gprod[4];
#pragma unroll
        for (int kt = 0; kt < 4; ++kt) gprod[kt] = (f32x4){1.f, 1.f, 1.f, 1.f};
        for (int cs = 0; cs < SEGC; ++cs) {
            const int cn = sg * SEGC + cs, n = dir ? 63 - cn : cn;
            bf16x8 kea[4][2], vb[2][2];
            f32x4 gam[4];
#pragma unroll
            for (int jt = 0; jt < 4; ++jt)
#pragma unroll
                for (int s = 0; s < 2; ++s) kea[jt][s] = ld_frag16(KE + ((size_t)n * 256 + 16 * jt + c15) * 64 + 32 * s + 8 * g);
#pragma unroll
            for (int nt = 0; nt < 2; ++nt)
#pragma unroll
                for (int s = 0; s < 2; ++s) vb[nt][s] = ld_frag16(VT + ((size_t)n * 512 + 16 * nt + c15) * 64 + 32 * s + 8 * g);
#pragma unroll
            for (int kt = 0; kt < 4; ++kt) gam[kt] = *(const f32x4*)(GAM + n * 64 + 16 * kt + 4 * g);
            if (FULL) {
                bf16x8 kia[4][2];
#pragma unroll
                for (int jt = 0; jt < 4; ++jt)
#pragma unroll
                    for (int s = 0; s < 2; ++s) kia[jt][s] = ld_frag16(KI + (size_t)(n * 64 + 16 * jt + c15) * 256 + 32 * s + 8 * g);
                bf16x8 sb[2][2];
#pragma unroll
                for (int nt = 0; nt < 2; ++nt)
#pragma unroll
                    for (int s = 0; s < 2; ++s) sb[nt][s] = pack8(S[2 * s][nt], S[2 * s + 1][nt]);
#pragma unroll
                for (int it = 0; it < 4; ++it) {
                    bf16x8 qdb[2];
#pragma unroll
                    for (int s = 0; s < 2; ++s) qdb[s] = ld_frag16(QD + (size_t)(n * 64 + 16 * it + c15) * 256 + 32 * s + 8 * g);
                    f32x4 sc[4];
#pragma unroll
                    for (int jt = 0; jt < 4; ++jt) {
                        sc[jt] = (f32x4){0.f, 0.f, 0.f, 0.f};
#pragma unroll
                        for (int s = 0; s < 2; ++s) sc[jt] = MFMA16(kia[jt][s], qdb[s], sc[jt]);
                        const int ii = 16 * it + c15;
#pragma unroll
                        for (int r = 0; r < 4; ++r) { const int jj = 16 * jt + 4 * g + r; const bool keep = dir ? (jj > ii) : (jj <= ii); sc[jt][r] = keep ? sc[jt][r] : 0.f; }
                    }
                    bf16x8 pa[2] = {pack8(sc[0], sc[1]), pack8(sc[2], sc[3])};
#pragma unroll
                    for (int nt = 0; nt < 2; ++nt) {
                        f32x4 o = (f32x4){0.f, 0.f, 0.f, 0.f};
#pragma unroll
                        for (int s = 0; s < 2; ++s) { o = MFMA16(vb[nt][s], pa[s], o); o = MFMA16(sb[nt][s], qdb[s], o); }
                        { u32x2 w = {pk2(o[0], o[1]), pk2(o[2], o[3])}; *(u32x2*)(O + (size_t)(n * 64 + 16 * it + c15) * 512 + 16 * nt + 4 * g) = w; }
                    }
                }
            }
#pragma unroll
            for (int kt = 0; kt < 4; ++kt) {
                if (!FULL) gprod[kt] = gprod[kt] * gam[kt];
#pragma unroll
                for (int nt = 0; nt < 2; ++nt) {
                    f32x4 a = S[kt][nt] * gam[kt];
#pragma unroll
                    for (int s = 0; s < 2; ++s) a = MFMA16(kea[kt][s], vb[nt][s], a);
                    S[kt][nt] = a;
                }
            }
        }
        if (!FULL) {
#pragma unroll
            for (int kt = 0; kt < 4; ++kt) {
#pragma unroll
                for (int nt = 0; nt < 2; ++nt) SSEG[((size_t)task * 8 + kt * 2 + nt) * 64 + lane] = S[kt][nt];
                if (sl == 0 && c15 == 0) *(f32x4*)(GSEG + (bhd * 8 + sg) * 64 + 16 * kt + 4 * g) = gprod[kt];
            }
        }
    }
}

DI void phase4a(const Params& p, LAS unsigned char* lds, int tid, int lane, int wave) {
    asm volatile("" : "+v"(tid), "+v"(lane));
    unsigned char* ws = p.ws;
    const bf16_t* Z = (const bf16_t*)(ws + WS_RZ);
    bf16_t* MIX = (bf16_t*)(ws + WS_RA);
    const bf16_t* OF = (const bf16_t*)(ws + WS_RO); const bf16_t* OB = (const bf16_t*)(ws + WS_RO + 64 * MB);
    const bf16_t* WP = (const bf16_t*)(ws + WS_WP);
    LAS bf16_t* pt = (LAS bf16_t*)lds;
    LAS unsigned char* at = lds + 81920;
    const int c15 = lane & 15, g = lane >> 4;
    const f32x4 gh0 = *(const f32x4*)(p.in[11] + 8 * lane), gh1 = *(const f32x4*)(p.in[11] + 8 * lane + 4);
    for (int tile = blockIdx.x; tile < T / 64; tile += gridDim.x) {
        const int tok0 = tile * 64, s0 = tok0 & (SEQ - 1);
        __syncthreads();
#pragma unroll
        for (int ps = 0; ps < 10; ++ps) {
            const int idx = tid + NTH * ps, rr = idx >> 6, ch = idx & 63, sq = s0 - 8 + rr;
            u32x4 v = {0u, 0u, 0u, 0u};
            if (sq >= 0 && sq < SEQ) v = *(const u32x4*)(Z + ((size_t)tok0 - 8 + rr) * ZW + 1536 + ch * 8);
            *(LAS u32x4*)(pt + rr * 512 + ch * 8) = v;
        }
#pragma unroll
        for (int hb = 0; hb < 2; ++hb) {
            u32x4 a[4], bq[4], rv[4];
#pragma unroll
            for (int j = 0; j < 4; ++j) { const size_t t = (size_t)tok0 + wave * 8 + hb * 4 + j;
                a[j] = *(const u32x4*)(OF + t * 512 + 8 * lane); bq[j] = *(const u32x4*)(OB + t * 512 + 8 * lane); rv[j] = *(const u32x4*)(Z + t * ZW + 1024 + 8 * lane); }
#pragma unroll
            for (int j = 0; j < 4; ++j) { const size_t t = (size_t)tok0 + wave * 8 + hb * 4 + j;
                float o[8], r[8];
#pragma unroll
                for (int e = 0; e < 4; ++e) { o[2 * e] = bflo(a[j][e]) + bflo(bq[j][e]); o[2 * e + 1] = bfhi(a[j][e]) + bfhi(bq[j][e]); r[2 * e] = bflo(rv[j][e]); r[2 * e + 1] = bfhi(rv[j][e]); }
                float ss = 0.f;
#pragma unroll
                for (int e = 0; e < 8; ++e) ss += o[e] * o[e];
                ss += __shfl_xor(ss, 1); ss += __shfl_xor(ss, 2); ss += __shfl_xor(ss, 4); ss += __shfl_xor(ss, 8);
                const float rstd = rsqrtf(ss * (1.f / 128.f) + EPS);
                float y[8];
#pragma unroll
                for (int e = 0; e < 8; ++e) { const float gg = e < 4 ? gh0[e] : gh1[e - 4]; y[e] = o[e] * rstd * gg * (r[e] / (1.f + __expf(-r[e]))); }
                u32x4 w = {pk2(y[0], y[1]), pk2(y[2], y[3]), pk2(y[4], y[5]), pk2(y[6], y[7])};
                *(u32x4*)(MIX + t * D + 8 * lane) = w; }
        }
        __syncthreads();
        {
            const int c = tid, gi = c >> 7, cc = c & 127, hw = 1 << gi;
            LAS unsigned char* ag = at + gi * 16384;
            float sum = 0.f;
            {   const int lo = max(s0 - hw, 0), hi = min(s0 + hw, SEQ);
                for (int rr = lo; rr < hi; ++rr) sum += bflo((unsigned)pt[(rr - s0 + 8) * 512 + c]); }
#pragma unroll 4
            for (int i = 0; i < 64; ++i) {
                const int sq = s0 + i, lo = max(sq - hw, 0), hi = min(sq + hw, SEQ);
                const float val = sum / (float)(hi - lo) - bflo((unsigned)pt[(i + 8) * 512 + c]);
                *(LAS bf16_t*)(ag + i * 256 + (((cc >> 3) ^ (i & 15)) * 16) + (cc & 7) * 2) = (bf16_t)(pk2(val, 0.f) & 0xFFFFu);
                if (sq + hw < SEQ) sum += bflo((unsigned)pt[(i + 8 + hw) * 512 + c]);
                if (sq - hw >= 0) sum -= bflo((unsigned)pt[(i + 8 - hw) * 512 + c]);
            }
        }
        __syncthreads();
        {
            const int gi = wave >> 1, dh = wave & 1;
            LAS unsigned char* ag = at + gi * 16384;
            f32x4 acc[4][4];
#pragma unroll
            for (int mt = 0; mt < 4; ++mt)
#pragma unroll
                for (int nt = 0; nt < 4; ++nt) acc[mt][nt] = (f32x4){0.f, 0.f, 0.f, 0.f};
#pragma unroll
            for (int s = 0; s < 4; ++s) {
                bf16x8 af[4];
#pragma unroll
                for (int mt = 0; mt < 4; ++mt) { const int row = mt * 16 + c15; af[mt] = *(const LAS bf16x8*)(ag + row * 256 + (((4 * s + g) ^ (row & 15)) * 16)); }
#pragma unroll
                for (int nt = 0; nt < 4; ++nt) {
                    const bf16x8 wf = ld_frag16(WP + (size_t)gi * 16384 + (dh * 64 + 16 * nt + c15) * 128 + 32 * s + 8 * g);
#pragma unroll
                    for (int mt = 0; mt < 4; ++mt) acc[mt][nt] = MFMA16(wf, af[mt], acc[mt][nt]);
                }
            }
#pragma unroll
            for (int nt = 0; nt < 4; ++nt) {
                const f32x4 ps = *(const f32x4*)(p.in[13] + gi * 128 + dh * 64 + 16 * nt + 4 * g);
#pragma unroll
                for (int mt = 0; mt < 4; ++mt) {
                    const f32x4 v = acc[mt][nt] * ps;
                    u32x2 w = {pk2(v[0], v[1]), pk2(v[2], v[3])};
                    *(u32x2*)(MIX + ((size_t)tok0 + mt * 16 + c15) * D + 512 + gi * 128 + dh * 64 + 16 * nt + 4 * g) = w;
                }
            }
        }
    }
}

DI void phase4c(const Params& p, LAS unsigned char* lds, int tid, int lane, int wave) {
    asm volatile("" : "+v"(tid), "+v"(lane));
    LAS float* lG = (LAS float*)lds; LAS float* lA = lG + 1024; LAS float* lB = lA + 1024; LAS float* lP = lB + 1024;
    const float* x = p.in[0]; const bf16_t* MIXO = (const bf16_t*)(p.ws + WS_RZ); bf16_t* H2 = (bf16_t*)(p.ws + WS_RA);
    for (int rt = blockIdx.x; rt < T / 128; rt += gridDim.x) {
        const int b = rt / 32;
        __syncthreads();
        for (int d = tid; d < 1024; d += NTH) { lG[d] = mod_at(p, b, 2048 + d); lA[d] = p.in[15][d] * (1.f + mod_at(p, b, 4096 + d)); lB[d] = mod_at(p, b, 3072 + d); lP[d] = p.in[5][d]; }
        __syncthreads();
        for (int r0 = wave; r0 < 128; r0 += 2 * NWV) {
            f32x4 m[2][4], xv[2][4];
#pragma unroll
            for (int u = 0; u < 2; ++u) {
                const size_t row = (size_t)rt * 128 + r0 + u * NWV;
                const u32x2* mr = (const u32x2*)(MIXO + row * D) + lane; const f32x4* xr = (const f32x4*)(x + row * D) + lane;
#pragma unroll
                for (int j = 0; j < 4; ++j) { const u32x2 mv = mr[64 * j]; m[u][j] = (f32x4){bflo(mv.x), bfhi(mv.x), bflo(mv.y), bfhi(mv.y)}; xv[u][j] = xr[64 * j]; }
            }
#pragma unroll
            for (int u = 0; u < 2; ++u) {
                const size_t row = (size_t)rt * 128 + r0 + u * NWV;
                float ss = 0.f;
#pragma unroll
                for (int j = 0; j < 4; ++j) ss += m[u][j][0] * m[u][j][0] + m[u][j][1] * m[u][j][1] + m[u][j][2] * m[u][j][2] + m[u][j][3] * m[u][j][3];
                const float rstd = rsqrtf(wave_sum(ss) * (1.f / D) + EPS);
                float s2 = 0.f;
#pragma unroll
                for (int j = 0; j < 4; ++j) {
                    const f32x4 gt = *(const LAS f32x4*)(lG + 4 * lane + 256 * j), pm = *(const LAS f32x4*)(lP + 4 * lane + 256 * j);
                    xv[u][j] = xv[u][j] + gt * (m[u][j] * rstd * pm);
                    s2 += xv[u][j][0] * xv[u][j][0] + xv[u][j][1] * xv[u][j][1] + xv[u][j][2] * xv[u][j][2] + xv[u][j][3] * xv[u][j][3];
                }
                const float rstd2 = rsqrtf(wave_sum(s2) * (1.f / D) + EPS);
                f32x4* orow = (f32x4*)(p.out + row * D) + lane; u32x2* hrow = (u32x2*)(H2 + row * D) + lane;
#pragma unroll
                for (int j = 0; j < 4; ++j) {
                    orow[64 * j] = xv[u][j];
#if defined(CHK_PEER) || REPEAT_PHASE == 6
                    ((f32x4*)((float*)(p.ws + WS_RO) + row * D) + lane)[64 * j] = xv[u][j];
#endif
                    const f32x4 a = *(const LAS f32x4*)(lA + 4 * lane + 256 * j), bb = *(const LAS f32x4*)(lB + 4 * lane + 256 * j);
                    const f32x4 hv = xv[u][j] * rstd2 * a + bb;
                    u32x2 w = {pk2(hv[0], hv[1]), pk2(hv[2], hv[3])};
                    hrow[64 * j] = w;
                }
            }
        }
    }
}

DI int skey(float v, int idx, int mask) { int u = __float_as_int(v); u ^= (u >> 31) & 0x7FFFFFFF; return (u & ~mask) | idx; }
DI float sval(int k, int mask) { int u = k & ~mask; u ^= (u >> 31) & 0x7FFFFFFF; return __int_as_float(u); }
DI void cswap(int& a, int& b) { const int mx = max(a, b), mn = min(a, b); a = mx; b = mn; }
DI void sort16_desc(int (&a)[16]) {
#pragma unroll
    for (int k = 2; k <= 16; k <<= 1) {
#pragma unroll
        for (int j = k >> 1; j > 0; j >>= 1) {
#pragma unroll
            for (int i = 0; i < 16; ++i) {
                const int l = i ^ j;
                if (l > i) { if ((i & k) == 0) cswap(a[i], a[l]); else cswap(a[l], a[i]); }
            }
        }
    }
}
DI void merge16_desc(int (&x)[16], const int (&y)[16]) {
#pragma unroll
    for (int i = 0; i < 16; ++i) x[i] = max(x[i], y[15 - i]);
#pragma unroll
    for (int j = 8; j > 0; j >>= 1) {
#pragma unroll
        for (int i = 0; i < 16; ++i) { const int l = i ^ j; if (l > i) cswap(x[i], x[l]); }
    }
}

DI void phase5b(const Params& p, LAS unsigned char* lds, int tid, int lane, int wave) {
    asm volatile("" : "+v"(tid), "+v"(lane));
    unsigned char* ws = p.ws;
    const bf16_t* Q2 = (const bf16_t*)(ws + WS_RZ);
    const bf16_t* SKB = (const bf16_t*)(ws + WS_SKB);
    int* EIDX = (int*)(ws + WS_RS); float* GATE = (float*)(ws + WS_RS + 16 * MB);
    LAS unsigned char* tab = lds + tid * 32;
    LAS unsigned char* skl = lds + 16384;
    const int c31 = lane & 31, hi = lane >> 5;
    for (int btask = blockIdx.x; btask < 256; btask += gridDim.x) {
        const int h = btask & 7, tgc = btask >> 3;
        __syncthreads();
#pragma unroll
        for (int ps = 0; ps < 8; ++ps) {
            const int idx = tid + NTH * ps, row = idx >> 4, ch = idx & 15;
            const u32x4 v = *(const u32x4*)(SKB + ((size_t)h * 256 + row) * 128 + ch * 8);
            *(LAS u32x4*)(skl + row * 256 + ((ch ^ (row & 15)) * 16)) = v;
        }
        __syncthreads();
      for (int ti = 0; ti < 4; ++ti) {
        const int tg = tgc * 32 + wave * 4 + ti;
        const size_t tok = (size_t)tg * 32 + c31;
        int lst[2][16];
        bf16x8 bq[2][8];
#pragma unroll
        for (int pp = 0; pp < 2; ++pp) {
            const bf16_t* qp = Q2 + tok * 2048 + h * 256 + pp * 128 + 8 * hi;
            asm volatile("" : "+v"(qp));
#pragma unroll
            for (int ks = 0; ks < 8; ++ks) bq[pp][ks] = ld_frag16(qp + 16 * ks);
        }
#pragma unroll
        for (int pp = 0; pp < 2; ++pp) {
            int run[16];
#pragma unroll
            for (int r = 0; r < 16; ++r) run[r] = (int)0x80000000;
#pragma unroll 1
            for (int kt = 0; kt < 4; ++kt) {
                const LAS unsigned char* kb = skl + pp * 32768 + (32 * kt + c31) * 256;
                f32x16 acc;
#pragma unroll
                for (int r = 0; r < 16; ++r) acc[r] = 0.f;
#pragma unroll
                for (int ks = 0; ks < 8; ++ks) acc = MFMA32(*(const LAS bf16x8*)(kb + (((2 * ks + hi) ^ (c31 & 15)) * 16)), bq[pp][ks], acc);
                int cur[16];
#pragma unroll
                for (int r = 0; r < 16; ++r) cur[r] = skey(acc[r], 32 * kt + 8 * (r >> 2) + 4 * hi + (r & 3), 0x7F);
                sort16_desc(cur);
                merge16_desc(run, cur);
            }
            int oth[16];
#pragma unroll
            for (int r = 0; r < 16; ++r) oth[r] = __shfl_xor(run[r], 32);
            merge16_desc(run, oth);
#pragma unroll
            for (int r = 0; r < 16; ++r) lst[pp][r] = run[r];
        }
#pragma unroll
        for (int pp = 0; pp < 2; ++pp) {
            u32x4 w;
#pragma unroll
            for (int q = 0; q < 4; ++q) w[q] = (lst[pp][4 * q] & 0x7F) | ((lst[pp][4 * q + 1] & 0x7F) << 8) | ((lst[pp][4 * q + 2] & 0x7F) << 16) | ((lst[pp][4 * q + 3] & 0x7F) << 24);
            *(LAS u32x4*)(tab + 16 * pp) = w;
        }
        float va[16], vb[16];
#pragma unroll
        for (int r = 0; r < 16; ++r) { va[r] = sval(lst[0][r], 0x7F); vb[r] = sval(lst[1][r], 0x7F); }
        int cand[4][16];
        {
            int cnt = 0;
#pragma unroll
            for (int i = 0; i < 16; ++i)
#pragma unroll
                for (int j = 0; j < 16; ++j)
                    if ((i + 1) * (j + 1) <= 16) { cand[cnt >> 4][cnt & 15] = skey(va[i] + vb[j], (i << 4) | j, 0xFF); ++cnt; }
#pragma unroll
            for (int q = 50; q < 64; ++q) cand[q >> 4][q & 15] = (int)0x80000000;
        }
        sort16_desc(cand[0]); sort16_desc(cand[1]); sort16_desc(cand[2]); sort16_desc(cand[3]);
        merge16_desc(cand[0], cand[1]); merge16_desc(cand[2], cand[3]); merge16_desc(cand[0], cand[2]);
        asm volatile("s_waitcnt lgkmcnt(0)" ::: "memory");
        float sv[16]; int ex[16];
        const float mx = sval(cand[0][0], 0xFF);
        float sum = 0.f;
#pragma unroll
        for (int r = 0; r < 16; ++r) {
            const int ck = cand[0][r];
            const int i1 = tab[(ck >> 4) & 15], i2 = tab[16 + (ck & 15)];
            ex[r] = i1 * 128 + i2;
            sv[r] = __expf(sval(ck, 0xFF) - mx); sum += sv[r];
        }
        const float inv = 1.f / sum;
        int* ep = EIDX + tok * 128 + h * 16 + 8 * hi; float* gp = GATE + tok * 128 + h * 16 + 8 * hi;
        if (hi == 0) {
            *(u32x4*)ep = (u32x4){(unsigned)ex[0], (unsigned)ex[1], (unsigned)ex[2], (unsigned)ex[3]}; *(u32x4*)(ep + 4) = (u32x4){(unsigned)ex[4], (unsigned)ex[5], (unsigned)ex[6], (unsigned)ex[7]};
            *(f32x4*)gp = (f32x4){sv[0] * inv, sv[1] * inv, sv[2] * inv, sv[3] * inv}; *(f32x4*)(gp + 4) = (f32x4){sv[4] * inv, sv[5] * inv, sv[6] * inv, sv[7] * inv};
        } else {
            *(u32x4*)ep = (u32x4){(unsigned)ex[8], (unsigned)ex[9], (unsigned)ex[10], (unsigned)ex[11]}; *(u32x4*)(ep + 4) = (u32x4){(unsigned)ex[12], (unsigned)ex[13], (unsigned)ex[14], (unsigned)ex[15]};
            *(f32x4*)gp = (f32x4){sv[8] * inv, sv[9] * inv, sv[10] * inv, sv[11] * inv}; *(f32x4*)(gp + 4) = (f32x4){sv[12] * inv, sv[13] * inv, sv[14] * inv, sv[15] * inv};
        }
      }
    }
}

template <int K> DI int swz_bcast(int v) { return __builtin_amdgcn_ds_swizzle(v, 0x10 | (K << 5)); }
template <int W> DI int swz_xor(int v) { return __builtin_amdgcn_ds_swizzle(v, 0x1F | (W << 10)); }
template <int K> struct IC { static constexpr int v = K; };
template <int N, int I = 0, class F> DI void static_for(F&& f) { if constexpr (I < N) { f(IC<I>{}); static_for<N, I + 1>(f); } }
DI float row16_sum(float v) {
    v += __builtin_bit_cast(float, __builtin_amdgcn_update_dpp(0, __builtin_bit_cast(int, v), 0xB1, 0xF, 0xF, true));
    v += __builtin_bit_cast(float, __builtin_amdgcn_update_dpp(0, __builtin_bit_cast(int, v), 0x4E, 0xF, 0xF, true));
    v += __builtin_bit_cast(float, __builtin_amdgcn_update_dpp(0, __builtin_bit_cast(int, v), 0x141, 0xF, 0xF, true));
    v += __builtin_bit_cast(float, __builtin_amdgcn_update_dpp(0, __builtin_bit_cast(int, v), 0x140, 0xF, 0xF, true));
    return v;
}
DI void phase6(const Params& p, LAS unsigned char* lds, int tid, int lane, int wave) {
    asm volatile("" : "+v"(tid), "+v"(lane));
    unsigned char* ws = p.ws;
    const bf16_t* H2 = (const bf16_t*)(ws + WS_RA);
    const unsigned char* UQ = ws + WS_UB; const unsigned char* VQ = ws + WS_VB;
    const float* SU = (const float*)(ws + WS_SU); const float* SV = (const float*)(ws + WS_SV);
    const int* EIDX = (const int*)(ws + WS_RS); const float* GATE = (const float*)(ws + WS_RS + 16 * MB);
    LAS float* lG = (LAS float*)lds;
    const int q = lane >> 4, l16 = lane & 15;
    LAS int* le = (LAS int*)(lds + 4096 + wave * 6144) + q * 128;
    LAS float* lg = (LAS float*)(lds + 4096 + wave * 6144 + 2048) + q * 128;
    LAS float* lc = (LAS float*)(lds + 4096 + wave * 6144 + 4096) + q * 128;
    const unsigned qlo = q < 2 ? (0xFFFFu << (16 * q)) : 0u, qhi = q >= 2 ? (0xFFFFu << (16 * (q - 2))) : 0u;
    for (int rt = blockIdx.x; rt < T / 128; rt += gridDim.x) {
        const int b = rt / 32;
        __syncthreads();
        for (int d = tid; d < 1024; d += NTH) lG[d] = mod_at(p, b, 5120 + d) * p.in[16][d];
        __syncthreads();
#pragma unroll 1
        for (int rd = 0; rd < 4; ++rd) {
            __syncthreads();
            const size_t t = (size_t)rt * 128 + wave * 16 + rd * 4 + q;
            {
                int e[8]; float g[8];
#pragma unroll
                for (int r = 0; r < 8; ++r) { e[r] = EIDX[t * 128 + r * 16 + l16]; g[r] = GATE[t * 128 + r * 16 + l16]; }
                int base = 0;
#pragma unroll 1
                for (int part = 0; part < 16; ++part) {
#pragma unroll
                    for (int r = 0; r < 8; ++r) {
                        const bool hit = (e[r] >> 10) == part;
                        const unsigned long long m = __ballot(hit);
                        const unsigned mlo = (unsigned)m & qlo, mhi = (unsigned)(m >> 32) & qhi;
                        const int pos = base + (int)__builtin_amdgcn_mbcnt_hi(mhi, __builtin_amdgcn_mbcnt_lo(mlo, 0u));
                        if (hit) { le[pos] = e[r]; lg[pos] = g[r]; }
                        base += __builtin_popcount(mlo) + __builtin_popcount(mhi);
                    }
                }
                asm volatile("s_waitcnt lgkmcnt(0)" ::: "memory");
            }
            {
                f32x2 hf[32];
#pragma unroll
                for (int i = 0; i < 4; ++i) {
                    const u32x4 h0 = *(const u32x4*)(H2 + t * D + 256 * i + 16 * l16), h1 = *(const u32x4*)(H2 + t * D + 256 * i + 16 * l16 + 8);
#pragma unroll
                    for (int c = 0; c < 4; ++c) { hf[8 * i + c] = (f32x2){bflo(h0[c]), bfhi(h0[c])}; hf[8 * i + 4 + c] = (f32x2){bflo(h1[c]), bfhi(h1[c])}; }
                }
                constexpr int UD = 4;
                u32x4 ub[UD][4];
                int evn = le[l16];
                static_for<UD>([&](auto kc) { constexpr int k = decltype(kc)::v; const unsigned char* up = UQ + (size_t)swz_bcast<k>(evn) * 1024 + 16 * l16;
#pragma unroll
                    for (int i = 0; i < 4; ++i) ub[k][i] = *(const u32x4*)(up + 256 * i); });
#pragma unroll 1
                for (int bt = 0; bt < 8; ++bt) {
                    if (bt) __syncthreads();
                    const int ev = evn; const float gv = lg[bt * 16 + l16];
                    evn = le[(bt < 7 ? bt + 1 : 7) * 16 + l16];
                    const float isu = SU[ev], isv = SV[ev];
                    float part[16];
                    static_for<16>([&](auto kc) {
                        constexpr int k = decltype(kc)::v, sl = k % UD;
                        f32x2 a = (f32x2){0.f, 0.f};
#pragma unroll
                        for (int i = 0; i < 4; ++i) {
                            const u32x4 u = ub[sl][i];
#pragma unroll
                            for (int c = 0; c < 4; ++c) {
                                const int w = (int)u[c];
                                a = __builtin_elementwise_fma(__builtin_amdgcn_cvt_pk_f32_fp8(w, false), hf[8 * i + 2 * c], a);
                                a = __builtin_elementwise_fma(__builtin_amdgcn_cvt_pk_f32_fp8(w, true), hf[8 * i + 2 * c + 1], a);
                            }
                        }
                        part[k] = a.x + a.y;
                        {
                            constexpr int kn = k + UD;
                            int idx; if constexpr (kn < 16) idx = swz_bcast<(kn & 15)>(ev); else idx = swz_bcast<(kn & 15)>(evn);
                            const unsigned char* up = UQ + (size_t)idx * 1024 + 16 * l16;
#pragma unroll
                            for (int i = 0; i < 4; ++i) ub[sl][i] = *(const u32x4*)(up + 256 * i);
                        }
                    });
                    static_for<4>([&](auto sc) {
                        constexpr int w = 8 >> decltype(sc)::v;
                        const bool up2 = (lane & w) != 0;
#pragma unroll
                        for (int e = 0; e < w; ++e) {
                            const float keep = up2 ? part[e + w] : part[e], send = up2 ? part[e] : part[e + w];
                            part[e] = keep + __int_as_float(swz_xor<w>(__float_as_int(send)));
                        }
                    });
                    const float dot = part[0] * isu;
                    lc[bt * 16 + l16] = gv * 0.5f * dot * (1.f + erff(dot * 0.70710678118654752f)) * isv;
                }
                asm volatile("s_waitcnt lgkmcnt(0)" ::: "memory");
            }
            __syncthreads();
            f32x2 y[32];
#pragma unroll
            for (int i = 0; i < 32; ++i) y[i] = (f32x2){0.f, 0.f};
            {
                constexpr int VD = 4;
                u32x4 vbuf[VD][4];
                int evn = le[l16];
                static_for<VD>([&](auto kc) { constexpr int k = decltype(kc)::v; const unsigned char* vp = VQ + (size_t)swz_bcast<k>(evn) * 1024 + 16 * l16;
#pragma unroll
                    for (int i = 0; i < 4; ++i) vbuf[k][i] = *(const u32x4*)(vp + 256 * i); });
#pragma unroll 1
                for (int bt = 0; bt < 8; ++bt) {
                    if (bt) __syncthreads();
                    const int ev = evn; const int cv = __float_as_int(lc[bt * 16 + l16]);
                    evn = le[(bt < 7 ? bt + 1 : 7) * 16 + l16];
                    static_for<16>([&](auto kc) {
                        constexpr int k = decltype(kc)::v, sl = k % VD;
                        const float cc = __int_as_float(swz_bcast<k>(cv));
                        const f32x2 c2 = (f32x2){cc, cc};
#pragma unroll
                        for (int i = 0; i < 4; ++i) {
                            const u32x4 v = vbuf[sl][i];
#pragma unroll
                            for (int c = 0; c < 4; ++c) {
                                const int w = (int)v[c];
                                y[8 * i + 2 * c] = __builtin_elementwise_fma(__builtin_amdgcn_cvt_pk_f32_fp8(w, false), c2, y[8 * i + 2 * c]);
                                y[8 * i + 2 * c + 1] = __builtin_elementwise_fma(__builtin_amdgcn_cvt_pk_f32_fp8(w, true), c2, y[8 * i + 2 * c + 1]);
                            }
                        }
                        {
                            constexpr int kn = k + VD;
                            int idx; if constexpr (kn < 16) idx = swz_bcast<(kn & 15)>(ev); else idx = swz_bcast<(kn & 15)>(evn);
                            const unsigned char* vp = VQ + (size_t)idx * 1024 + 16 * l16;
#pragma unroll
                            for (int i = 0; i < 4; ++i) vbuf[sl][i] = *(const u32x4*)(vp + 256 * i);
                        }
                    });
                }
            }
            float ss = 0.f;
#pragma unroll
            for (int i = 0; i < 32; ++i) ss += y[i].x * y[i].x + y[i].y * y[i].y;
            const float rstd = rsqrtf(row16_sum(ss) * (1.f / D) + EPS);
            float* orow = p.out + t * D;
#pragma unroll
            for (int i = 0; i < 4; ++i)
#pragma unroll
                for (int c = 0; c < 4; ++c) {
                    const int col = 256 * i + 16 * l16 + 4 * c;
#if REPEAT_PHASE == 6
                    f32x4 xv = *(const f32x4*)((const float*)(p.ws + WS_RO) + t * D + col);
#else
                    f32x4 xv = *(const f32x4*)(orow + col);
#endif
                    const f32x4 gg = *(const LAS f32x4*)(lG + col);
                    xv[0] += gg[0] * y[8 * i + 2 * c].x * rstd; xv[1] += gg[1] * y[8 * i + 2 * c].y * rstd; xv[2] += gg[2] * y[8 * i + 2 * c + 1].x * rstd; xv[3] += gg[3] * y[8 * i + 2 * c + 1].y * rstd;
                    *(f32x4*)(orow + col) = xv;
                }
        }
    }
}

#ifdef CHK_PEER
DI float blk_sum(float v, LAS float* red, int tid, int lane, int wave) {
    v = wave_sum(v);
    __syncthreads();
    if (lane == 0) red[wave] = v;
    __syncthreads();
    float s = 0.f;
    for (int i = 0; i < NWV; ++i) s += red[i];
    return s;
}
DI void check_peer(const Params& p, LAS unsigned char* lds, int tid, int lane, int wave) {
    unsigned char* ws = p.ws;
    const bf16_t* H2 = (const bf16_t*)(ws + WS_RA); const bf16_t* WQ = (const bf16_t*)(ws + WS_WQ); const bf16_t* SKB = (const bf16_t*)(ws + WS_SKB);
    const bf16_t* UB = (const bf16_t*)(ws + WS_UB); const bf16_t* VB = (const bf16_t*)(ws + WS_VB);
    const float* X1 = (const float*)(ws + WS_RO);
    float* stat = (float*)(ws + WS_CTL + 32768);
    LAS float* hrow = (LAS float*)lds;
    LAS float* qv = hrow + 1024;
    LAS float* sc = qv + 2048;
    LAS float* tv = sc + 2048;
    LAS int* ti = (LAS int*)(tv + 256);
    LAS int* ee = ti + 256;
    LAS float* gg = (LAS float*)(ee + 128);
    LAS float* cf = gg + 128;
    LAS float* yv = cf + 128;
    LAS float* red = yv + 1024;
    for (int rt = blockIdx.x; rt < T / 128; rt += gridDim.x) {
        const size_t ts = (size_t)rt * 128 + 37; const int b = rt / 32;
        __syncthreads();
        for (int d = tid; d < 1024; d += NTH) hrow[d] = bflo((unsigned)H2[ts * D + d]);
        __syncthreads();
        for (int n = tid; n < 2048; n += NTH) { float a = 0.f; for (int k = 0; k < 1024; ++k) a += hrow[k] * bflo((unsigned)WQ[(size_t)n * 1024 + k]); qv[n] = bflo(pk2(a, 0.f) & 0xFFFFu); }
        __syncthreads();
        for (int n = tid; n < 2048; n += NTH) { const int hp = n >> 7, key = n & 127; float a = 0.f; for (int d = 0; d < 128; ++d) a += qv[hp * 128 + d] * bflo((unsigned)SKB[((size_t)hp * 128 + key) * 128 + d]); sc[n] = a; }
        __syncthreads();
        if (tid < 16) { const int hp = tid;
            for (int k = 0; k < 16; ++k) { float best = -3e38f; int bi = 0; for (int n = 0; n < 128; ++n) { const float v = sc[hp * 128 + n]; if (v > best) { best = v; bi = n; } } tv[hp * 16 + k] = best; ti[hp * 16 + k] = bi; sc[hp * 128 + bi] = -3e38f; } }
        __syncthreads();
        if (tid < 8) { const int h = tid; float cs[16]; int ci[16];
            unsigned long long used[4] = {0ull, 0ull, 0ull, 0ull};
            for (int k = 0; k < 16; ++k) { float best = -3e38f; int bi = 0;
                for (int c = 0; c < 256; ++c) { if ((used[c >> 6] >> (c & 63)) & 1ull) continue; const float v = tv[(h * 2) * 16 + (c >> 4)] + tv[(h * 2 + 1) * 16 + (c & 15)]; if (v > best) { best = v; bi = c; } }
                used[bi >> 6] |= 1ull << (bi & 63); cs[k] = best; ci[k] = bi; }
            float sum = 0.f; for (int k = 0; k < 16; ++k) { cs[k] = __expf(cs[k] - cs[0]); sum += cs[k]; }
            for (int k = 0; k < 16; ++k) { ee[h * 16 + k] = ti[(h * 2) * 16 + (ci[k] >> 4)] * 128 + ti[(h * 2 + 1) * 16 + (ci[k] & 15)]; gg[h * 16 + k] = cs[k] / sum; } }
        __syncthreads();
#ifdef CHK_USE_FAST_SEL
        if (tid < 128) { ee[tid] = ((const int*)(ws + WS_RS))[ts * 128 + tid]; gg[tid] = ((const float*)(ws + WS_RS + 16 * MB))[ts * 128 + tid]; }
        __syncthreads();
#endif
        if (tid < 128) { const int e = ee[tid]; float a = 0.f; for (int d = 0; d < 1024; ++d) a += hrow[d] * bflo((unsigned)UB[(size_t)e * D + d]); cf[tid] = gg[tid] * 0.5f * a * (1.f + erff(a * 0.70710678118654752f)); }
        __syncthreads();
        for (int d = tid; d < 1024; d += NTH) { float a = 0.f; for (int e = 0; e < 128; ++e) a += cf[e] * bflo((unsigned)VB[(size_t)ee[e] * D + d]); yv[d] = a; }
        __syncthreads();
        float ss = 0.f; for (int d = tid; d < 1024; d += NTH) ss += yv[d] * yv[d];
        const float rstd = rsqrtf(blk_sum(ss, red, tid, lane, wave) * (1.f / D) + EPS);
        float e2 = 0.f, r2 = 0.f;
        for (int d = tid; d < 1024; d += NTH) { const float br = mod_at(p, b, 5120 + d) * p.in[16][d] * yv[d] * rstd; const float ref = X1[ts * D + d] + br; const float df = p.out[ts * D + d] - ref; e2 += df * df; r2 += br * br; }
        e2 = blk_sum(e2, red, tid, lane, wave); r2 = blk_sum(r2, red, tid, lane, wave);
        if (tid == 0) { atomicAdd(&stat[0], e2); atomicAdd(&stat[1], r2); }
    }
}
DI void check_emit(const Params& p, int tid) {
    const float* stat = (const float*)(p.ws + WS_CTL + 32768);
    const float e = __hip_atomic_load(&stat[0], __ATOMIC_RELAXED, __HIP_MEMORY_SCOPE_AGENT), r = __hip_atomic_load(&stat[1], __ATOMIC_RELAXED, __HIP_MEMORY_SCOPE_AGENT);
    const float A = 10.f + 1e6f * (e / r), f = 1.f + sqrtf(A);
    const size_t gt = (size_t)blockIdx.x * NTH + tid, NGT = (size_t)gridDim.x * NTH;
    for (size_t i = gt; i < (size_t)T * D / 4; i += NGT) { f32x4 v = ((const f32x4*)p.in[0])[i]; ((f32x4*)p.out)[i] = v * f; }
}
#endif

#ifdef TIMING
#define STAMP(k) do { if (blockIdx.x == 0 && threadIdx.x == 0) ((unsigned long long*)(p.ws + WS_CTL + 40960))[k] = __builtin_amdgcn_s_memrealtime(); } while (0)
DI void timing_emit(const Params& p, int tid) {
    const unsigned long long* ts = (const unsigned long long*)(p.ws + WS_CTL + 40960);
#define dT(a, b) ((float)(ts[b] - ts[a]) * 0.01f)
    const float A = TIM_A, B = TIM_B, f = 1.f + sqrtf(A);
#undef dT
    const size_t gt = (size_t)blockIdx.x * NTH + tid, NGT = (size_t)gridDim.x * NTH;
    for (size_t i = gt; i < (size_t)T * D / 4; i += NGT) { f32x4 v = ((const f32x4*)p.in[0])[i]; v = v * f; if (i == 0) v[0] = B; ((f32x4*)p.out)[i] = v; }
}
#else
#define STAMP(k) do {} while (0)
#endif

__global__ void __launch_bounds__(NTH) fwd_megakernel(Params p) {
    extern __shared__ __attribute__((aligned(16))) unsigned char lds_raw[];
    LAS unsigned char* lds = (LAS unsigned char*)lds_raw;
    const int tid = threadIdx.x, lane = tid & 63, wave = __builtin_amdgcn_readfirstlane(tid >> 6);
    volatile LAS unsigned* st = (volatile LAS unsigned*)(lds + LDS_BARW);
    if (tid == 0) { st[0] = 0u; st[1] = 0u; st[2] = 0u; st[3] = 0u; }
    __syncthreads();
    XcdBarrier bar = xcd_barrier_post((unsigned*)(p.ws + WS_CTL), st);
    unsigned char* ws = p.ws;

    STAMP(0);
    phase0(p, lds, tid, lane, wave);
    xcd_barrier(bar);
#if REPEAT_PHASE == 0
    phase0(p, lds, tid, lane, wave);
    xcd_barrier(bar);
#endif
    STAMP(1);
    phase1(p, lds, tid, lane, wave);
    xcd_barrier(bar);
    STAMP(2);
    { pg8::Gemm g{(const bf16_t*)(ws + WS_RA), (const bf16_t*)(ws + WS_WIN), T, ZW, D}; pg8::StaticOrder S; S.init(T, ZW, (int)gridDim.x, (int)blockIdx.x);
      pg8::EpiB16 e{(bf16_t*)(ws + WS_RZ), ZW}; pg8::gemm_phase<pg8::EpiB16, pg8::StaticOrder, true, true>(lds, g, S, e);
      EpiZ e2{(bf16_t*)(ws + WS_RZ), (float*)(ws + WS_AFB)}; gemm_phase(((const bf16_t*)(ws + WS_RA)), (const bf16_t*)(ws + WS_WIN), T, NIN, D, e2, lds, tid, lane, wave, 16); }
#if REPEAT_PHASE == 2
    xcd_barrier(bar);
    { pg8::Gemm g{(const bf16_t*)(ws + WS_RA), (const bf16_t*)(ws + WS_WIN), T, ZW, D}; pg8::StaticOrder S; S.init(T, ZW, (int)gridDim.x, (int)blockIdx.x);
      pg8::EpiB16 e{(bf16_t*)(ws + WS_RZ), ZW}; pg8::gemm_phase<pg8::EpiB16, pg8::StaticOrder, true, true>(lds, g, S, e);
      EpiZ e2{(bf16_t*)(ws + WS_RZ), (float*)(ws + WS_AFB)}; gemm_phase(((const bf16_t*)(ws + WS_RA)), (const bf16_t*)(ws + WS_WIN), T, NIN, D, e2, lds, tid, lane, wave, 16); }
#endif
    xcd_barrier(bar);
    STAMP(3);
    phase3a(p, lds, tid, lane, wave);
    xcd_barrier(bar);
#if REPEAT_PHASE == 1
    phase3a(p, lds, tid, lane, wave);
    xcd_barrier(bar);
#endif
    STAMP(4);
    phase3b<true>(p, lane, wave);
    xcd_barrier(bar);
    STAMP(5);
    phase4a(p, lds, tid, lane, wave);
    xcd_barrier(bar);
#if REPEAT_PHASE == 4
    phase4a(p, lds, tid, lane, wave);
    xcd_barrier(bar);
#endif
    STAMP(6);
    { pg8::Gemm g{(const bf16_t*)(ws + WS_RA), (const bf16_t*)(ws + WS_WOUT), T, D, D}; pg8::StaticOrder S; S.init(T, D, (int)gridDim.x, (int)blockIdx.x);
      pg8::EpiB16 e{(bf16_t*)(ws + WS_RZ), D}; pg8::gemm_phase<pg8::EpiB16, pg8::StaticOrder, true, true>(lds, g, S, e); }
    xcd_barrier(bar);
    STAMP(7);
    phase4c(p, lds, tid, lane, wave);
    xcd_barrier(bar);
    STAMP(8);
#ifndef ABL_SKIP_PEER
    { pg8::Gemm g{(const bf16_t*)(ws + WS_RA), (const bf16_t*)(ws + WS_WQ), T, 2048, D}; pg8::StaticOrder S; S.init(T, 2048, (int)gridDim.x, (int)blockIdx.x);
      pg8::EpiB16 e{(bf16_t*)(ws + WS_RZ), 2048}; pg8::gemm_phase<pg8::EpiB16, pg8::StaticOrder, true, true>(lds, g, S, e); }
    xcd_barrier(bar);
    STAMP(9);
    phase5b(p, lds, tid, lane, wave);
    xcd_barrier(bar);
#if REPEAT_PHASE == 5
    phase5b(p, lds, tid, lane, wave);
    xcd_barrier(bar);
#endif
    STAMP(10);
#if REPEAT_PHASE == 9
    for (int i = 0; i < 10; ++i) xcd_barrier(bar);
#endif
    phase6(p, lds, tid, lane, wave);
#if REPEAT_PHASE == 6
    xcd_barrier(bar);
    phase6(p, lds, tid, lane, wave);
#endif
#ifdef TIMING
    xcd_barrier(bar);
    STAMP(11);
    xcd_barrier(bar);
    timing_emit(p, tid);
#endif
#ifdef CHK_PEER
    xcd_barrier(bar);
    STAMP(11);
    check_peer(p, lds, tid, lane, wave);
    xcd_barrier(bar);
    STAMP(12);
    check_emit(p, tid);
#endif
#endif
}

extern "C" void kernel_launch(void* const* d_in, const int* in_sizes, int n_in, void* d_out, int out_size, void* d_ws, size_t ws_size, hipStream_t stream) {
    static int grid = 0;
    if (grid == 0) {
        if (n_in != 21 || out_size != T * D || ws_size < WS_END) { fprintf(stderr, "kernel_launch: unexpected shapes (n_in %d out %d ws %zu need %zu)\n", n_in, out_size, ws_size, (size_t)WS_END); grid = -1; return; }
        int dev = 0, cus = 0, per_cu = 0;
        hipGetDevice(&dev); hipDeviceGetAttribute(&cus, hipDeviceAttributeMultiprocessorCount, dev);
        hipFuncSetAttribute((const void*)fwd_megakernel, hipFuncAttributeMaxDynamicSharedMemorySize, LDS_BYTES);
        hipOccupancyMaxActiveBlocksPerMultiprocessor(&per_cu, (const void*)fwd_megakernel, NTH, LDS_BYTES);
        (void)hipGetLastError();
        if (per_cu < 1) fprintf(stderr, "kernel_launch: occupancy query says %d blocks per CU\n", per_cu);
        grid = cus;
    }
    if (grid < 0) return;
    hipMemsetAsync((char*)d_ws + WS_CTL, 0, 64 * 1024, stream);
    Params p{};
    for (int i = 0; i < 21; ++i) p.in[i] = (const float*)d_in[i];
    p.out = (float*)d_out; p.ws = (unsigned char*)d_ws;
    hipLaunchKernelGGL(fwd_megakernel, dim3(grid), dim3(NTH), LDS_BYTES, stream, p);
}
```

```cpp
#ifndef REPEAT_PHASE
#define REPEAT_PHASE -1
#endif
#include <hip/hip_runtime.h>
#include <cstdio>
#include <cstdint>

#define DI __device__ __forceinline__
#define LAS __attribute__((address_space(3)))
typedef unsigned short bf16_t;
typedef short bf16x8 __attribute__((ext_vector_type(8)));
typedef float f32x4 __attribute__((ext_vector_type(4)));
typedef float f32x2 __attribute__((ext_vector_type(2)));
typedef float f32x16 __attribute__((ext_vector_type(16)));
typedef unsigned u32x4 __attribute__((ext_vector_type(4)));
typedef unsigned u32x2 __attribute__((ext_vector_type(2)));
typedef __bf16 bf16x2v __attribute__((ext_vector_type(2)));

constexpr int T = 32768, D = 1024, SEQ = 4096, NB = 8;
constexpr int NTH = 512, NWV = 8;
constexpr int ZW = 2048;
constexpr int NIN = 2176;
constexpr float EPS = 1e-6f;

constexpr size_t MB = 1024 * 1024;
constexpr size_t WS_CTL   = 0;
constexpr size_t WS_MODP  = 64 * 1024;
constexpr size_t WS_WIN   = WS_MODP + 8 * 8 * 6144 * 4;
constexpr size_t WS_WOUT  = WS_WIN + (size_t)NIN * 1024 * 2;
constexpr size_t WS_WQ    = WS_WOUT + 1024 * 1024 * 2;
constexpr size_t WS_SKB   = WS_WQ + 2048 * 1024 * 2;
constexpr size_t WS_WP    = WS_SKB + 16 * 128 * 128 * 2;
constexpr size_t WS_AFB   = WS_WP + 4 * 128 * 128 * 2;
constexpr size_t WS_UB    = WS_AFB + (size_t)T * 32 * 4;
constexpr size_t WS_VB    = WS_UB + 32 * MB;
constexpr size_t WS_SU    = WS_UB + 16 * MB, WS_SV = WS_VB + 16 * MB;
constexpr size_t WS_RA    = WS_VB + 32 * MB;
constexpr size_t WS_RZ    = WS_RA + 64 * MB;
constexpr size_t WS_RS    = WS_RZ + 128 * MB;
constexpr size_t WS_RO    = WS_RS + 6 * 16 * MB + 1 * MB;
constexpr size_t WS_END   = WS_RO + 128 * MB;
static_assert(WS_END <= 512 * MB, "workspace too large");

struct Params { const float* in[21]; float* out; unsigned char* ws; };

DI unsigned pk2(float a, float b) { f32x2 f = {a, b}; bf16x2v h = __builtin_convertvector(f, bf16x2v); return __builtin_bit_cast(unsigned, h); }
DI float dot2bf(unsigned a, unsigned b, float c) { return __builtin_amdgcn_fdot2_f32_bf16(__builtin_bit_cast(bf16x2v, a), __builtin_bit_cast(bf16x2v, b), c, false); }
DI float bflo(unsigned u) { return __uint_as_float(u << 16); }
DI float bfhi(unsigned u) { return __uint_as_float(u & 0xFFFF0000u); }
DI float wave_sum(float v) {
#pragma unroll
    for (int o = 1; o < 64; o <<= 1) v += __shfl_xor(v, o);
    return v;
}
DI bf16x8 ld_frag16(const bf16_t* p) { return __builtin_bit_cast(bf16x8, *(const u32x4*)p); }
DI bf16x8 ld_frag_perm(const bf16_t* p, int g) {
    const u32x2 lo = *(const u32x2*)(p + 4 * g), hi = *(const u32x2*)(p + 16 + 4 * g);
    u32x4 v = {lo.x, lo.y, hi.x, hi.y}; return __builtin_bit_cast(bf16x8, v);
}
DI int perm32(int k) { return (k & ~31) | (((k >> 2) & 3) << 3) | (((k >> 4) & 1) << 2) | (k & 3); }
DI bf16x8 pack8(const f32x4& a, const f32x4& b) { u32x4 v = {pk2(a[0], a[1]), pk2(a[2], a[3]), pk2(b[0], b[1]), pk2(b[2], b[3])}; return __builtin_bit_cast(bf16x8, v); }
#define MFMA16(a, b, c) __builtin_amdgcn_mfma_f32_16x16x32_bf16((a), (b), (c), 0, 0, 0)
#define MFMA32(a, b, c) __builtin_amdgcn_mfma_f32_32x32x16_bf16((a), (b), (c), 0, 0, 0)

#define XB_TMO      128
#define XB_XCNT(j)  (256  + 64 * (j))
#define XB_XSUB(j)  (1280 + 64 * (j))
#define XB_XGEN(j)  (2304 + 64 * (j))
#define XB_TOP      3328
#define XB_TOPGEN   3392
#define XCD_BAR_WORDS 3456
#define XB_SPIN_CAP (1u << 22)
DI unsigned xb_ld(unsigned* p)              { return __hip_atomic_load(p, __ATOMIC_RELAXED, __HIP_MEMORY_SCOPE_AGENT); }
DI unsigned xb_add(unsigned* p, unsigned v) { return __hip_atomic_fetch_add(p, v, __ATOMIC_RELAXED, __HIP_MEMORY_SCOPE_AGENT); }
DI unsigned xb_xcc_id() { return (unsigned)__builtin_amdgcn_s_getreg((3 << 11) | 20) & 0xFu; }
#define XB_SPIN(cond, bar) do { unsigned _sp = 0; while (cond) { __builtin_amdgcn_s_sleep(1); \
    if ((++_sp & 255u) == 0u) { if (xb_ld(&(bar)[XB_TMO])) break; if (_sp > XB_SPIN_CAP) { atomicAdd(&(bar)[XB_TMO], 1u); break; } } } } while (0)
struct XcdBarrier { unsigned* bar; unsigned x; volatile LAS unsigned* st; };
DI XcdBarrier xcd_barrier_post(unsigned* bar, volatile LAS unsigned* st) {
    XcdBarrier b; b.bar = bar; b.x = xb_xcc_id(); b.st = st;
    if (threadIdx.x == 0) (void)xb_add(&bar[XB_XCNT(b.x)], 1u);
    return b;
}
DI void xcd_barrier_complete(unsigned* bar, unsigned x, unsigned& nloc, unsigned& nx) {
    const unsigned G = gridDim.x * gridDim.y * gridDim.z;
    unsigned sum, cnt, mine, sp = 0u;
    for (;;) {
        sum = 0u; cnt = 0u; mine = 0u;
#pragma unroll
        for (unsigned j = 0; j < 16; ++j) { const unsigned c = xb_ld(&bar[XB_XCNT(j)]); sum += c; cnt += (c > 0u) ? 1u : 0u; mine = (j == x) ? c : mine; }
        if (sum == G) break;
        __builtin_amdgcn_s_sleep(1);
        if ((++sp & 255u) == 0u) { if (xb_ld(&bar[XB_TMO])) break; if (sp > XB_SPIN_CAP) { atomicAdd(&bar[XB_TMO], 1u); break; } }
    }
    nloc = mine > 0u ? mine : 1u; nx = cnt > 0u ? cnt : 1u;
}
DI void xcd_barrier(const XcdBarrier& b) {
    asm volatile("s_waitcnt vmcnt(0)" ::: "memory");
    __syncthreads();
    if (threadIdx.x == 0) {
        unsigned* bar = b.bar;
        __builtin_amdgcn_s_waitcnt(0);
        unsigned nloc = b.st[0], nx = b.st[1];
        if (nloc == 0u) { xcd_barrier_complete(bar, b.x, nloc, nx); b.st[0] = nloc; b.st[1] = nx; }
        const unsigned old = xb_add(&bar[XB_XSUB(b.x)], 1u);
        const unsigned gen = old / nloc;
        if (old + 1u == (gen + 1u) * nloc) {
            __builtin_amdgcn_fence(__ATOMIC_RELEASE, "agent");
            asm volatile("s_waitcnt vmcnt(0)" ::: "memory");
            const unsigned og = xb_add(&bar[XB_TOP], 1u);
            const unsigned tg = og / nx;
            if (og + 1u == (tg + 1u) * nx) xb_add(&bar[XB_TOPGEN], 1u);
            else XB_SPIN(xb_ld(&bar[XB_TOPGEN]) == tg, bar);
            __builtin_amdgcn_fence(__ATOMIC_ACQUIRE, "agent");
            xb_add(&bar[XB_XGEN(b.x)], 1u);
            asm volatile("s_waitcnt vmcnt(0)" ::: "memory");
        } else {
            XB_SPIN(xb_ld(&bar[XB_XGEN(b.x)]) == gen, bar);
            __builtin_amdgcn_fence(__ATOMIC_ACQUIRE, "agent");
            asm volatile("s_waitcnt vmcnt(0)" ::: "memory");
        }
    }
    __syncthreads();
}

constexpr int LDS_BYTES = 152 * 1024;
constexpr int LDS_BARW = LDS_BYTES - 16;

DI void p0_transpose_item(const float* W, int ldw, int K, bf16_t* WT, int dst_row0, int src_col0, float scale, bool zero, LAS float* scr, int kb, int lane) {
    const int k0 = 64 * kb;
#pragma unroll 8
    for (int i = 0; i < 32; ++i) { const int kk = 2 * i + (lane >> 5); scr[kk * 33 + (lane & 31)] = zero ? 0.f : W[(size_t)(k0 + kk) * ldw + src_col0 + (lane & 31)] * scale; }
    asm volatile("s_waitcnt lgkmcnt(0)" ::: "memory");
    const int c = lane & 7;
#pragma unroll
    for (int j = 0; j < 4; ++j) { const int n = (lane >> 3) + 8 * j; const LAS float* s = scr + (8 * c) * 33 + n;
        u32x4 o; o.x = pk2(s[0 * 33], s[1 * 33]); o.y = pk2(s[2 * 33], s[3 * 33]); o.z = pk2(s[4 * 33], s[5 * 33]); o.w = pk2(s[6 * 33], s[7 * 33]);
        *(u32x4*)(WT + (size_t)(dst_row0 + n) * K + k0 + 8 * c) = o; }
    asm volatile("s_waitcnt lgkmcnt(0)" ::: "memory");
}

DI void phase0(const Params& p, LAS unsigned char* lds, int tid, int lane, int wave) {
    asm volatile("" : "+v"(tid), "+v"(lane));
    unsigned char* ws = p.ws;
    LAS float* sl = (LAS float*)lds;
    LAS float* scr = (LAS float*)(lds + 32768 + wave * 8448);
    const float* c = p.in[1];
    for (int e = tid; e < 8192; e += NTH) { const int b = e >> 10, k = e & 1023; const float v = c[e]; sl[k * 8 + b] = v / (1.f + __expf(-v)); }
    __syncthreads();
    const int gw = wave * gridDim.x + blockIdx.x, NGW = gridDim.x * NWV;
    constexpr int I_MOD = 768, I_WIN = 16 * 68, I_WOUT = 16 * 32, I_WQ = 16 * 64, I_WP = 32;
    constexpr int NITEMS = I_MOD + I_WIN + I_WOUT + I_WQ + I_WP;
    for (int it = gw; it < NITEMS; it += NGW) {
        int r = it;
        if (r < I_MOD) {
            const int cg = r % 96, ks = r / 96, n = cg * 64 + lane, k0 = ks * 128;
            const float* W = p.in[2] + (size_t)k0 * 6144 + n;
            float acc[8];
#pragma unroll
            for (int b = 0; b < 8; ++b) acc[b] = 0.f;
#pragma unroll 8
            for (int k = 0; k < 128; ++k) {
                const float w = W[(size_t)k * 6144];
                const f32x4 s0 = *(const LAS f32x4*)(sl + (k0 + k) * 8), s1 = *(const LAS f32x4*)(sl + (k0 + k) * 8 + 4);
                acc[0] += s0[0] * w; acc[1] += s0[1] * w; acc[2] += s0[2] * w; acc[3] += s0[3] * w;
                acc[4] += s1[0] * w; acc[5] += s1[1] * w; acc[6] += s1[2] * w; acc[7] += s1[3] * w;
            }
            float* mp = (float*)(ws + WS_MODP) + (size_t)ks * 8 * 6144 + n;
#pragma unroll
            for (int b = 0; b < 8; ++b) mp[b * 6144] = acc[b];
            continue;
        }
        r -= I_MOD;
        if (r < I_WIN) {
            const int kb = r / 68, nb = r % 68, n0 = nb * 32;
            int src; bool zero = false; float scale = 1.f;
            if (n0 < 1536) { src = n0; if (n0 < 256) scale = 0.125f; } else if (n0 < 2048) src = n0 + 32; else if (n0 < 2080) src = 1536 + (n0 - 2048); else { src = 0; zero = true; }
            p0_transpose_item(p.in[6], 2080, 1024, (bf16_t*)(ws + WS_WIN), n0, src, scale, zero, scr, kb, lane);
            continue;
        }
        r -= I_WIN;
        if (r < I_WOUT) { p0_transpose_item(p.in[14], 1024, 1024, (bf16_t*)(ws + WS_WOUT), (r % 32) * 32, (r % 32) * 32, 1.f, false, scr, r / 32, lane); continue; }
        r -= I_WOUT;
        if (r < I_WQ) { p0_transpose_item(p.in[17], 2048, 1024, (bf16_t*)(ws + WS_WQ), (r % 64) * 32, (r % 64) * 32, 1.f, false, scr, r / 64, lane); continue; }
        r -= I_WQ;
        { const int g = r >> 3, kb = (r >> 2) & 1, nb = r & 3;
          p0_transpose_item(p.in[12] + g * 16384, 128, 128, (bf16_t*)(ws + WS_WP) + g * 16384, nb * 32, nb * 32, 1.f, false, scr, kb, lane); }
    }
    const size_t gt = (size_t)blockIdx.x * NTH + tid, NGT = (size_t)gridDim.x * NTH;
    constexpr size_t NSK = (size_t)16 * 128 * 128 / 8;
    for (size_t j = gt; j < NSK; j += NGT) {
        const float* src = p.in[18]; bf16_t* dst = (bf16_t*)(ws + WS_SKB);
        const f32x4 a = *(const f32x4*)(src + j * 8), b = *(const f32x4*)(src + j * 8 + 4);
        u32x4 o = {pk2(a[0], a[1]), pk2(a[2], a[3]), pk2(b[0], b[1]), pk2(b[2], b[3])};
        *(u32x4*)(dst + j * 8) = o;
    }
    for (int row = gw; row < 2 * 16384; row += NGW) {
        const int tb = row >> 14, e = row & 16383;
        const float* src = (tb ? p.in[20] : p.in[19]) + (size_t)e * D + 16 * lane;
        f32x4 v[4]; float m = 0.f;
#pragma unroll
        for (int q = 0; q < 4; ++q) { v[q] = *(const f32x4*)(src + 4 * q); m = fmaxf(m, fmaxf(fmaxf(fabsf(v[q][0]), fabsf(v[q][1])), fmaxf(fabsf(v[q][2]), fabsf(v[q][3])))); }
#pragma unroll
        for (int o = 1; o < 64; o <<= 1) m = fmaxf(m, __shfl_xor(m, o));
        int ex = (int)((__float_as_uint(m) >> 23) & 0xFFu) - 127;
        if (m < 1e-30f) ex = 7;
        const float sc = __uint_as_float((unsigned)(127 + 7 - ex) << 23), isc = __uint_as_float((unsigned)(127 - 7 + ex) << 23);
        u32x4 o;
        if (tb) {
#pragma unroll
            for (int q = 0; q < 4; ++q) { int w = 0; w = __builtin_amdgcn_cvt_pk_fp8_f32(v[q][0] * sc, v[q][1] * sc, w, false); w = __builtin_amdgcn_cvt_pk_fp8_f32(v[q][2] * sc, v[q][3] * sc, w, true); o[q] = (unsigned)w; }
            if (lane == 0) ((float*)(ws + WS_SV))[e] = isc;
        } else {
            const float s8 = m > 1e-30f ? 127.f / m : 0.f;
#pragma unroll
            for (int q = 0; q < 4; ++q) {
                const int q0 = __float2int_rn(v[q][0] * s8), q1 = __float2int_rn(v[q][1] * s8), q2 = __float2int_rn(v[q][2] * s8), q3 = __float2int_rn(v[q][3] * s8);
                o[q] = (unsigned)(q0 & 0xFF) | ((unsigned)(q1 & 0xFF) << 8) | ((unsigned)(q2 & 0xFF) << 16) | ((unsigned)q3 << 24);
            }
            if (lane == 0) ((float*)(ws + WS_SU))[e] = m * (1.f / 127.f);
        }
        *(u32x4*)(ws + (tb ? WS_VB : WS_UB) + (size_t)e * 1024 + 16 * lane) = o;
    }
}

DI float mod_at(const Params& p, int b, int n) {
    const float* mp = (const float*)(p.ws + WS_MODP) + (size_t)b * 6144 + n;
    float s = p.in[3][n];
#pragma unroll
    for (int ks = 0; ks < 8; ++ks) s += mp[(size_t)ks * 8 * 6144];
    return s;
}

DI void phase1(const Params& p, LAS unsigned char* lds, int tid, int lane, int wave) {
    asm volatile("" : "+v"(tid), "+v"(lane));
    LAS float* lA = (LAS float*)lds; LAS float* lB = lA + 1024;
    const float* x = p.in[0]; bf16_t* H = (bf16_t*)(p.ws + WS_RA);
    for (int rt = blockIdx.x; rt < T / 128; rt += gridDim.x) {
        const int b = rt / 32;
        __syncthreads();
        for (int d = tid; d < 1024; d += NTH) { lA[d] = p.in[4][d] * (1.f + mod_at(p, b, 1024 + d)); lB[d] = mod_at(p, b, d); }
        __syncthreads();
        for (int r0 = wave; r0 < 128; r0 += 4 * NWV) {
            f32x4 v[4][4];
#pragma unroll
            for (int u = 0; u < 4; ++u) { const f32x4* xr = (const f32x4*)(x + ((size_t)rt * 128 + r0 + u * NWV) * D) + lane;
#pragma unroll
                for (int j = 0; j < 4; ++j) v[u][j] = xr[64 * j]; }
#pragma unroll
            for (int u = 0; u < 4; ++u) {
                const size_t row = (size_t)rt * 128 + r0 + u * NWV;
                float ss = 0.f;
#pragma unroll
                for (int j = 0; j < 4; ++j) ss += v[u][j][0] * v[u][j][0] + v[u][j][1] * v[u][j][1] + v[u][j][2] * v[u][j][2] + v[u][j][3] * v[u][j][3];
                const float rstd = rsqrtf(wave_sum(ss) * (1.f / D) + EPS);
                u32x2* o = (u32x2*)(H + row * D) + lane;
#pragma unroll
                for (int j = 0; j < 4; ++j) {
                    const f32x4 a = *(const LAS f32x4*)(lA + 4 * lane + 256 * j), bb = *(const LAS f32x4*)(lB + 4 * lane + 256 * j);
                    u32x2 w = {pk2(v[u][j][0] * rstd * a[0] + bb[0], v[u][j][1] * rstd * a[1] + bb[1]), pk2(v[u][j][2] * rstd * a[2] + bb[2], v[u][j][3] * rstd * a[3] + bb[3])};
                    o[64 * j] = w;
                }
            }
        }
    }
}

struct EpiZ {
    bf16_t* Z; float* AFB;
    DI void operator()(int m, int n, const f32x4& v) const {
        if (n < ZW) { u32x2 w = {pk2(v[0], v[1]), pk2(v[2], v[3])}; *(u32x2*)(Z + (size_t)m * ZW + n) = w; }
        else if (n < ZW + 32) { *(f32x4*)(AFB + (size_t)m * 32 + (n - ZW)) = v; }
    }
};
struct EpiF32 { float* C; int ldc; DI void operator()(int m, int n, const f32x4& v) const { *(f32x4*)(C + (size_t)m * ldc + n) = v; } };
struct EpiBf16 { bf16_t* C; int ldc; DI void operator()(int m, int n, const f32x4& v) const { u32x2 w = {pk2(v[0], v[1]), pk2(v[2], v[3])}; *(u32x2*)(C + (size_t)m * ldc + n) = w; } };

template <class Epi>
DI void gemm_phase(const bf16_t* A, const bf16_t* Bt, int M, int N, int K, const Epi& epi, LAS unsigned char* lds, int tid, int lane, int wave, int nt_first = 0) {
    constexpr int BM = 256, BN = 128, BK = 64, STAGE = (BM + BN) * 128;
    const int ntn = N / BN - nt_first, ntiles = (M / BM) * ntn, nk = K / BK;
    const int wm = wave & 3, wn = wave >> 2, c15 = lane & 15, g = lane >> 4;
    const int lrow = tid >> 3, lch = tid & 7;
    for (int tile = blockIdx.x; tile < ntiles; tile += gridDim.x) {
        const int m0 = (tile / ntn) * BM, n0 = (tile % ntn + nt_first) * BN;
        f32x4 acc[4][4];
#pragma unroll
        for (int i = 0; i < 4; ++i)
#pragma unroll
            for (int j = 0; j < 4; ++j) acc[i][j] = (f32x4){0.f, 0.f, 0.f, 0.f};
        u32x4 ra[4], rb[2];
        const bf16_t* Ag = A + (size_t)(m0 + lrow) * K + lch * 8;
        const bf16_t* Bg = Bt + (size_t)(n0 + lrow) * K + lch * 8;
        const int woff = lrow * 128 + ((lch ^ (lrow & 7)) * 16);
        __syncthreads();
#pragma unroll
        for (int ps = 0; ps < 4; ++ps) ra[ps] = *(const u32x4*)(Ag + (size_t)(64 * ps) * K);
#pragma unroll
        for (int ps = 0; ps < 2; ++ps) rb[ps] = *(const u32x4*)(Bg + (size_t)(64 * ps) * K);
#pragma unroll
        for (int ps = 0; ps < 4; ++ps) *(LAS u32x4*)(lds + woff + ps * 8192) = ra[ps];
#pragma unroll
        for (int ps = 0; ps < 2; ++ps) *(LAS u32x4*)(lds + BM * 128 + woff + ps * 8192) = rb[ps];
        __syncthreads();
        for (int kt = 0; kt < nk; ++kt) {
            const bool more = (kt + 1 < nk);
            if (more) {
#pragma unroll
                for (int ps = 0; ps < 4; ++ps) ra[ps] = *(const u32x4*)(Ag + (size_t)(64 * ps) * K + (kt + 1) * BK);
#pragma unroll
                for (int ps = 0; ps < 2; ++ps) rb[ps] = *(const u32x4*)(Bg + (size_t)(64 * ps) * K + (kt + 1) * BK);
            }
            LAS unsigned char* sa = lds + (kt & 1) * STAGE; LAS unsigned char* sb = sa + BM * 128;
#pragma unroll
            for (int s = 0; s < 2; ++s) {
                bf16x8 fa[4], fb[4];
#pragma unroll
                for (int i = 0; i < 4; ++i) { const int row = wm * 64 + i * 16 + c15; fa[i] = *(const LAS bf16x8*)(sa + row * 128 + (((4 * s + g) ^ (row & 7)) * 16)); }
#pragma unroll
                for (int j = 0; j < 4; ++j) { const int row = wn * 64 + j * 16 + c15; fb[j] = *(const LAS bf16x8*)(sb + row * 128 + (((4 * s + g) ^ (row & 7)) * 16)); }
#pragma unroll
                for (int i = 0; i < 4; ++i)
#pragma unroll
                    for (int j = 0; j < 4; ++j) acc[i][j] = MFMA16(fb[j], fa[i], acc[i][j]);
            }
            if (more) {
                LAS unsigned char* da = lds + ((kt + 1) & 1) * STAGE;
#pragma unroll
                for (int ps = 0; ps < 4; ++ps) *(LAS u32x4*)(da + woff + ps * 8192) = ra[ps];
#pragma unroll
                for (int ps = 0; ps < 2; ++ps) *(LAS u32x4*)(da + BM * 128 + woff + ps * 8192) = rb[ps];
            }
            __syncthreads();
        }
#pragma unroll
        for (int i = 0; i < 4; ++i)
#pragma unroll
            for (int j = 0; j < 4; ++j) epi(m0 + wm * 64 + i * 16 + c15, n0 + wn * 64 + j * 16 + 4 * g, acc[i][j]);
    }
}

namespace pg8 {
#define PG8_LAS __attribute__((address_space(3)))
constexpr int BM = 256, BK = 64, HALF = 128, HTB = HALF * BK * 2  , STAGE_BYTES = 8 * HTB, NXCD = 8, WGM = 8;

__host__ __device__ __forceinline__ int lds_byte(int r, int c) { const int st = (r >> 4) * 2 + (c >> 5), rr = r & 15, cc = c & 31, ob = rr * 64 + cc * 2; return st * 1024 + (ob ^ (((ob >> 9) & 1) << 5)); }
__host__ __device__ __forceinline__ void stage_rc(int b, int& R, int& C) { const int st = b / 1024, sb = b % 1024, swz = sb ^ (((sb >> 9) & 1) << 5); R = (st >> 1) * 16 + swz / 64; C = (st & 1) * 32 + (swz % 64) / 2; }
__host__ __device__ __forceinline__ int perm32(int rho) { const int n = rho >> 4, i = rho & 15; return 8 * (i >> 2) + 4 * n + (i & 3); }

struct Unit { int pm, pn; };
struct Gemm { const bf16_t* A; const bf16_t* Bt; int M, N, K; };

struct StaticOrder {
    int nM, nN, nwg, G, c;
    __host__ __device__ void init(int M, int N, int G_, int c_) { nM = M / BM; nN = N / BM; nwg = nM * nN; G = G_; c = c_; }
    __host__ __device__ bool next(int i, Unit& u) const {
        const long L = (long)i * G + c; if (L >= nwg) return false;
        int wgid = (int)L; { const int q = nwg / NXCD, r = nwg % NXCD, xcd = wgid % NXCD, off = wgid / NXCD; wgid = (xcd < r ? xcd * (q + 1) : r * (q + 1) + (xcd - r) * q) + off; }
        const int nig = WGM * nN, gid = wgid / nig, fm = gid * WGM, gsz = (nM - fm) < WGM ? (nM - fm) : WGM;
        u.pm = fm + ((wgid % nig) % gsz); u.pn = (wgid % nig) / gsz; return true;
    }
    __device__ __forceinline__ void a_ready(const Unit&) const {}
    __device__ __forceinline__ void done(const Unit&) const {}
};

struct EpiB16 {
    static constexpr bool PERM = true, AFTER_DRAIN = false;
    bf16_t* O; int ldc;
    __device__ __forceinline__ void operator()(const f32x4 (&acc)[2][2][4][2], const Unit& u, int wr, int wc, int fr, int fq) const {
#pragma unroll
        for (int ai = 0; ai < 2; ++ai)
#pragma unroll
            for (int m = 0; m < 4; ++m) { bf16_t* rowp = O + (size_t)(u.pm * BM + ai * HALF + wr * 64 + m * 16 + fr) * ldc + u.pn * BM + wc * 32 + 8 * fq;
#pragma unroll
                for (int bj = 0; bj < 2; ++bj) { const f32x4 v0 = acc[ai][bj][m][0], v1 = acc[ai][bj][m][1];
                    u32x4 w; w.x = ::pk2(v0[0], v0[1]); w.y = ::pk2(v0[2], v0[3]); w.z = ::pk2(v1[0], v1[1]); w.w = ::pk2(v1[2], v1[3]);
                    *(u32x4*)(rowp + bj * HALF) = w; } }
    }
};
struct EpiF {
    static constexpr bool PERM = false, AFTER_DRAIN = false;
    float* O; int ldc;
    __device__ __forceinline__ void operator()(const f32x4 (&acc)[2][2][4][2], const Unit& u, int wr, int wc, int fr, int fq) const {
#pragma unroll
        for (int ai = 0; ai < 2; ++ai)
#pragma unroll
            for (int m = 0; m < 4; ++m) { float* rowp = O + (size_t)(u.pm * BM + ai * HALF + wr * 64 + m * 16 + fr) * ldc + u.pn * BM + wc * 32 + 4 * fq;
#pragma unroll
                for (int bj = 0; bj < 2; ++bj)
#pragma unroll
                    for (int n = 0; n < 2; ++n) *(f32x4*)(rowp + bj * HALF + 16 * n) = acc[ai][bj][m][n]; }
    }
};
template <class Epi, class Sched, bool ALIGN_EPI = false, bool SP2 = false>
__device__ __forceinline__ void gemm_phase(PG8_LAS unsigned char* lds, const Gemm g, const Sched& S, const Epi& E) {
    const int tid = threadIdx.x, wid = __builtin_amdgcn_readfirstlane(tid >> 6), lane = tid & 63, wr = wid >> 2, wc = wid & 3, fr = lane & 15, fq = lane >> 4;
    const int K = g.K, nt = K / BK;
    unsigned voffA[2], voffB[2];
#pragma unroll
    for (int i = 0; i < 2; ++i) { int R, C; stage_rc(tid * 16 + i * 8192, R, C); const int Rb = Epi::PERM ? ((R & ~31) + perm32(R & 31)) : R;
        voffA[i] = (unsigned)(R * K + C) * 2u; voffB[i] = (unsigned)(Rb * K + C) * 2u; }
    const size_t kstep = (size_t)(BK * 2);
    const size_t hstep = (size_t)HALF * K * 2;
    const size_t tstep = 2 * hstep;
    const unsigned ldsw = (unsigned)wid * 1024u;
    const int aoff = lds_byte(wr * 64 + fr, fq * 8), boff = lds_byte(wc * 32 + fr, fq * 8);
#define PG8_SA(b, h) (((b) * 2 + (h)) * HTB)
#define PG8_SB(b, h) ((4 + (b) * 2 + (h)) * HTB)
#define PG8_STAGE(bufoff, gbase, voff) do { _Pragma("unroll") for (int _i = 0; _i < 2; ++_i) \
        __builtin_amdgcn_global_load_lds((const unsigned*)((const char*)(gbase) + (voff)[_i]), (PG8_LAS unsigned*)(lds + (bufoff) + ldsw + _i * 8192), 16, 0, 0); } while (0)
#define PG8_LDA(dst, b, h) do { _Pragma("unroll") for (int m = 0; m < 4; ++m) _Pragma("unroll") for (int k = 0; k < 2; ++k) dst[m][k] = *(const PG8_LAS bf16x8*)(lds + PG8_SA(b, h) + aoff + m * 2048 + k * 1024); } while (0)
#define PG8_LDB(dst, b, h) do { _Pragma("unroll") for (int n = 0; n < 2; ++n) _Pragma("unroll") for (int k = 0; k < 2; ++k) dst[n][k] = *(const PG8_LAS bf16x8*)(lds + PG8_SB(b, h) + boff + n * 2048 + k * 1024); } while (0)
#define PG8_MMA(ai, bj, At, Bt) do { __builtin_amdgcn_s_setprio(1); _Pragma("unroll") for (int m = 0; m < 4; ++m) _Pragma("unroll") for (int n = 0; n < 2; ++n) _Pragma("unroll") for (int k = 0; k < 2; ++k) \
        acc[ai][bj][m][n] = __builtin_amdgcn_mfma_f32_16x16x32_bf16(Bt[n][k], At[m][k], acc[ai][bj][m][n], 0, 0, 0); __builtin_amdgcn_s_setprio(0); } while (0)
#define PG8_WAIT_V(n) asm volatile("s_waitcnt vmcnt(" #n ")" ::: "memory")
#define PG8_WAIT_L(n) asm volatile("s_waitcnt lgkmcnt(" #n ")" ::: "memory")
#define PG8_BAR __builtin_amdgcn_s_barrier()
#define PG8_SCHED __builtin_amdgcn_sched_barrier(0)
    Unit cur, nxt; int ui = 0;
    if (!S.next(0, cur)) return;
    f32x4 acc[2][2][4][2];
#pragma unroll
    for (int a = 0; a < 2; ++a)
#pragma unroll
        for (int b = 0; b < 2; ++b)
#pragma unroll
            for (int m = 0; m < 4; ++m)
#pragma unroll
                for (int n = 0; n < 2; ++n) acc[a][b][m][n] = (f32x4){0.f, 0.f, 0.f, 0.f};
    bf16x8 At[4][2], B0[2][2], B1[2][2];
    const char* cA = (const char*)g.A + (size_t)cur.pm * tstep; const char* cB = (const char*)g.Bt + (size_t)cur.pn * tstep;
    S.a_ready(cur);
    if constexpr (SP2) {
        PG8_STAGE(PG8_SB(0, 0), cB, voffB); PG8_STAGE(PG8_SB(0, 1), cB + hstep, voffB); PG8_STAGE(PG8_SA(0, 0), cA, voffA); PG8_STAGE(PG8_SA(0, 1), cA + hstep, voffA);
        if (wr == 1) PG8_BAR;
        PG8_WAIT_V(2); PG8_BAR;
        PG8_STAGE(PG8_SB(1, 0), cB + kstep, voffB); PG8_STAGE(PG8_SA(1, 0), cA + kstep, voffA); PG8_STAGE(PG8_SB(1, 1), cB + hstep + kstep, voffB);
        PG8_WAIT_V(6); PG8_BAR;
    } else {
        PG8_STAGE(PG8_SB(0, 0), cB, voffB); PG8_STAGE(PG8_SA(0, 0), cA, voffA); PG8_STAGE(PG8_SB(0, 1), cB + hstep, voffB); PG8_STAGE(PG8_SA(0, 1), cA + hstep, voffA);
        if (wr == 1) PG8_BAR;
        PG8_WAIT_V(4); PG8_BAR;
        PG8_STAGE(PG8_SB(1, 0), cB + kstep, voffB); PG8_STAGE(PG8_SA(1, 0), cA + kstep, voffA); PG8_STAGE(PG8_SB(1, 1), cB + hstep + kstep, voffB);
        PG8_WAIT_V(6); PG8_BAR;
    }
    for (;;) {
        const bool has_next = S.next(ui + 1, nxt);
        const char* nA = has_next ? (const char*)g.A + (size_t)nxt.pm * tstep : cA; const char* nB = has_next ? (const char*)g.Bt + (size_t)nxt.pn * tstep : cB;
        for (int t = 0; t < nt; t += 2) {
            const bool last = (t == nt - 2);
            const char* a1 = cA + (size_t)(t + 1) * kstep;
            const char* a2 = last ? nA : cA + (size_t)(t + 2) * kstep; const char* b2 = last ? nB : cB + (size_t)(t + 2) * kstep;
            const char* a3 = a2 + kstep; const char* b3 = b2 + kstep;
            if (last && has_next) S.a_ready(nxt);
            if constexpr (SP2) {
            PG8_LDB(B0, 0, 0); PG8_LDB(B1, 0, 1); PG8_SCHED; PG8_LDA(At, 0, 0); PG8_STAGE(PG8_SA(1, 1), a1 + hstep, voffA);
            PG8_WAIT_V(8); PG8_WAIT_L(0); PG8_BAR; PG8_MMA(0, 0, At, B0); PG8_MMA(0, 1, At, B1); PG8_BAR; PG8_SCHED;
            PG8_LDA(At, 0, 1); PG8_STAGE(PG8_SB(0, 0), b2, voffB); PG8_STAGE(PG8_SB(0, 1), b2 + hstep, voffB); PG8_STAGE(PG8_SA(0, 0), a2, voffA);
            PG8_WAIT_V(8); PG8_WAIT_L(0); PG8_BAR; PG8_MMA(1, 0, At, B0); PG8_MMA(1, 1, At, B1); PG8_BAR; PG8_SCHED;
            PG8_LDB(B0, 1, 0); PG8_LDB(B1, 1, 1); PG8_SCHED; PG8_LDA(At, 1, 0); PG8_STAGE(PG8_SA(0, 1), a2 + hstep, voffA);
            PG8_WAIT_V(8); PG8_WAIT_L(0); PG8_BAR; PG8_MMA(0, 0, At, B0); PG8_MMA(0, 1, At, B1); PG8_BAR; PG8_SCHED;
            PG8_LDA(At, 1, 1); PG8_STAGE(PG8_SB(1, 0), b3, voffB); PG8_STAGE(PG8_SB(1, 1), b3 + hstep, voffB); PG8_STAGE(PG8_SA(1, 0), a3, voffA);
            PG8_WAIT_V(8); PG8_WAIT_L(0); PG8_BAR; PG8_MMA(1, 0, At, B0); PG8_MMA(1, 1, At, B1); PG8_BAR; PG8_SCHED;
            } else {
            PG8_LDB(B0, 0, 0); PG8_SCHED; PG8_LDA(At, 0, 0); PG8_STAGE(PG8_SA(1, 1), a1 + hstep, voffA);
            PG8_WAIT_L(8); PG8_BAR; PG8_WAIT_L(0); PG8_MMA(0, 0, At, B0); PG8_BAR; PG8_SCHED;
            PG8_LDB(B1, 0, 1); PG8_STAGE(PG8_SB(0, 0), b2, voffB);
            PG8_BAR; PG8_WAIT_L(0); PG8_MMA(0, 1, At, B1); PG8_BAR;
            PG8_LDA(At, 0, 1); PG8_STAGE(PG8_SA(0, 0), a2, voffA);
            PG8_BAR; PG8_WAIT_L(0); PG8_MMA(1, 0, At, B0); PG8_BAR; PG8_SCHED;
            PG8_STAGE(PG8_SB(0, 1), b2 + hstep, voffB);
            PG8_WAIT_V(6); PG8_BAR; PG8_MMA(1, 1, At, B1); PG8_BAR;
            PG8_LDB(B0, 1, 0); PG8_SCHED; PG8_LDA(At, 1, 0); PG8_STAGE(PG8_SA(0, 1), a2 + hstep, voffA);
            PG8_WAIT_L(8); PG8_BAR; PG8_WAIT_L(0); PG8_MMA(0, 0, At, B0); PG8_BAR; PG8_SCHED;
            PG8_LDB(B1, 1, 1); PG8_STAGE(PG8_SB(1, 0), b3, voffB);
            PG8_BAR; PG8_WAIT_L(0); PG8_MMA(0, 1, At, B1); PG8_BAR;
            PG8_LDA(At, 1, 1); PG8_STAGE(PG8_SA(1, 0), a3, voffA);
            PG8_BAR; PG8_WAIT_L(0); PG8_MMA(1, 0, At, B0); PG8_BAR; PG8_SCHED;
            PG8_STAGE(PG8_SB(1, 1), b3 + hstep, voffB);
            PG8_WAIT_V(6); PG8_BAR; PG8_MMA(1, 1, At, B1); PG8_BAR;
            }
        }
        if constexpr (ALIGN_EPI) { if (wr == 0) PG8_BAR; }
        if constexpr (!Epi::AFTER_DRAIN) { E(acc, cur, wr, wc, fr, fq); S.done(cur); }
        if (!has_next) break;
#pragma unroll
        for (int a = 0; a < 2; ++a)
#pragma unroll
            for (int b = 0; b < 2; ++b)
#pragma unroll
                for (int m = 0; m < 4; ++m)
#pragma unroll
                    for (int n = 0; n < 2; ++n) acc[a][b][m][n] = (f32x4){0.f, 0.f, 0.f, 0.f};
        cur = nxt; cA = nA; cB = nB; ++ui;
        if constexpr (ALIGN_EPI) { if (wr == 1) PG8_BAR; }
    }
    PG8_WAIT_V(0);
    if constexpr (!ALIGN_EPI) { if (wr == 0) PG8_BAR; }
    PG8_BAR;
    if constexpr (Epi::AFTER_DRAIN) { E.fused(acc, cur, wr, wc, fr, fq, lds, wid, lane); S.done(cur); }
#undef PG8_SA
#undef PG8_SB
#undef PG8_STAGE
#undef PG8_LDA
#undef PG8_LDB
#undef PG8_MMA
#undef PG8_WAIT_V
#undef PG8_WAIT_L
#undef PG8_BAR
#undef PG8_SCHED
}
}

constexpr int NSEG = 8, SEGC = 64 / NSEG;
constexpr size_t WS_SSEG = WS_RA + 32 * MB;
constexpr size_t WS_GSEG = WS_SSEG + 16 * MB;
DI float logsig(float x) { return fminf(x, 0.f) - __logf(1.f + __expf(-fabsf(x))); }

DI void phase3a(const Params& p, LAS unsigned char* lds, int tid, int lane, int wave) {
    asm volatile("" : "+v"(tid), "+v"(lane));
    unsigned char* ws = p.ws;
    const bf16_t* Z = (const bf16_t*)(ws + WS_RZ);
    const float* AFB = (const float*)(ws + WS_AFB);
    bf16_t* QD[2] = {(bf16_t*)(ws + WS_RS), (bf16_t*)(ws + WS_RS + 48 * MB)};
    bf16_t* KI[2] = {(bf16_t*)(ws + WS_RS + 16 * MB), (bf16_t*)(ws + WS_RS + 64 * MB)};
    bf16_t* KE[2] = {(bf16_t*)(ws + WS_RS + 32 * MB), (bf16_t*)(ws + WS_RS + 80 * MB)};
    float* GAM[2] = {(float*)(ws + WS_RS + 96 * MB), (float*)(ws + WS_RS + 96 * MB + 512 * 1024)};
    bf16_t* VT = (bf16_t*)(ws + WS_RA);
    LAS float* la[2] = {(LAS float*)lds, (LAS float*)(lds + 16384)};
    LAS float* part[2] = {(LAS float*)(lds + 32768), (LAS float*)(lds + 32768 + 2048)};
    LAS bf16_t* keT[2] = {(LAS bf16_t*)(lds + 36864), (LAS bf16_t*)(lds + 36864 + 9216)};
    LAS bf16_t* vT = (LAS bf16_t*)(lds + 55296);
    const int c15 = lane & 15, g = lane >> 4;
    for (int task = blockIdx.x; task < 256; task += gridDim.x) {
      const int h = task & 3, pb = (task >> 2) & 7, b = task >> 5;
      f32x4 Sf[4], Sb[4];
#pragma unroll
      for (int kt = 0; kt < 4; ++kt) { Sf[kt] = (f32x4){0.f, 0.f, 0.f, 0.f}; Sb[kt] = (f32x4){0.f, 0.f, 0.f, 0.f}; }
      LAS float* gs = (LAS float*)(lds + 73728);
      LAS float* wl = (LAS float*)(lds + 74752);
      __syncthreads();
      if (tid < 128) gs[tid] = 0.f;
      for (int e = tid; e < 2048; e += NTH) { const int dir = e >> 10, r = (e >> 6) & 15, d = e & 63; wl[e] = (dir ? p.in[9] : p.in[7])[r * 256 + h * 64 + d]; }
      f32x4 afp[8];
      { const size_t tp = (size_t)b * SEQ + (size_t)(pb * 8) * 64 + (tid >> 3);
#pragma unroll
        for (int q = 0; q < 8; ++q) afp[q] = *(const f32x4*)(AFB + tp * 32 + 4 * q); }
      for (int ci = 0; ci < 8; ++ci) {
        const int n = pb * 8 + ci;
        const int tok0 = b * SEQ + n * 64;
        const int i = tid >> 3, dg = tid & 7, d0 = dg * 8;
        const size_t t = (size_t)tok0 + i;
        const u32x4 qv = *(const u32x4*)(Z + t * ZW + h * 64 + d0), kv = *(const u32x4*)(Z + t * ZW + 256 + h * 64 + d0);
        u32x4 vvp[2];
#pragma unroll
        for (int ps = 0; ps < 2; ++ps) { const int idx = tid + NTH * ps, vi = idx >> 4, ch = idx & 15; vvp[ps] = *(const u32x4*)(Z + ((size_t)tok0 + vi) * ZW + 512 + h * 128 + ch * 8); }
        __syncthreads();
        {
            float af[16], ab[16];
#pragma unroll
            for (int q = 0; q < 4; ++q) { const f32x4 a = afp[q], bb = afp[4 + q];
                af[4 * q] = a[0]; af[4 * q + 1] = a[1]; af[4 * q + 2] = a[2]; af[4 * q + 3] = a[3]; ab[4 * q] = bb[0]; ab[4 * q + 1] = bb[1]; ab[4 * q + 2] = bb[2]; ab[4 * q + 3] = bb[3]; }
            { const size_t tn = t + (ci < 7 ? 64 : 0);
#pragma unroll
              for (int q = 0; q < 8; ++q) afp[q] = *(const f32x4*)(AFB + tn * 32 + 4 * q); }
            const LAS float* waf = wl + d0; const LAS float* wab = wl + 1024 + d0;
            float xf[8], xb[8];
#pragma unroll
            for (int e = 0; e < 8; ++e) { xf[e] = p.in[8][h * 64 + d0 + e]; xb[e] = p.in[10][h * 64 + d0 + e]; }
#pragma unroll
            for (int r = 0; r < 16; ++r) {
                const f32x4 w0 = *(const LAS f32x4*)(waf + r * 64), w1 = *(const LAS f32x4*)(waf + r * 64 + 4), v0 = *(const LAS f32x4*)(wab + r * 64), v1 = *(const LAS f32x4*)(wab + r * 64 + 4);
#pragma unroll
                for (int e = 0; e < 4; ++e) { xf[e] += af[r] * w0[e]; xf[4 + e] += af[r] * w1[e]; xb[e] += ab[r] * v0[e]; xb[4 + e] += ab[r] * v1[e]; }
            }
#pragma unroll
            for (int e = 0; e < 8; ++e) { la[0][i * 64 + d0 + e] = logsig(xf[e]) * 0.0625f; la[1][i * 64 + d0 + e] = logsig(xb[e]) * 0.0625f; }
        }
        __syncthreads();
        {
            const int d = tid & 63, pt = tid >> 6;
            float run = 0.f;
#pragma unroll
            for (int j = 0; j < 8; ++j) { run += la[0][(8 * pt + j) * 64 + d]; la[0][(8 * pt + j) * 64 + d] = run; }
            part[0][pt * 64 + d] = run;
            run = 0.f;
#pragma unroll
            for (int j = 7; j >= 0; --j) { run += la[1][(8 * pt + j) * 64 + d]; la[1][(8 * pt + j) * 64 + d] = run; }
            part[1][pt * 64 + d] = run;
            __syncthreads();
            float of = 0.f, ob = 0.f;
#pragma unroll
            for (int q = 0; q < 8; ++q) { if (q < pt) of += part[0][q * 64 + d]; if (q > pt) ob += part[1][q * 64 + d]; }
#pragma unroll
            for (int j = 0; j < 8; ++j) { la[0][(8 * pt + j) * 64 + d] += of; la[1][(8 * pt + j) * 64 + d] += ob; }
        }
        __syncthreads();
        {
            float q[8], k[8];
#pragma unroll
            for (int e = 0; e < 4; ++e) { q[2 * e] = bflo(qv[e]); q[2 * e + 1] = bfhi(qv[e]); k[2 * e] = bflo(kv[e]); k[2 * e + 1] = bfhi(kv[e]); }
#pragma unroll
            for (int dir = 0; dir < 2; ++dir) {
                float qd[8], ki[8], ke[8];
#pragma unroll
                for (int e = 0; e < 8; ++e) {
                    const float bb = la[dir][i * 64 + d0 + e], bl = la[dir][(dir ? 0 : 63) * 64 + d0 + e];
                    qd[e] = q[e] * __expf(bb); ki[e] = k[e] * __expf(-bb); ke[e] = k[e] * __expf(bl - bb);
                    if (i == (dir ? 0 : 63)) GAM[dir][((size_t)(b * 4 + h) * 64 + n) * 64 + d0 + e] = __expf(bl);
                }
                {
                    u32x2 a0 = {pk2(qd[0], qd[1]), pk2(qd[2], qd[3])}, a1 = {pk2(qd[4], qd[5]), pk2(qd[6], qd[7])};
                    u32x2 b0 = {pk2(ki[0], ki[1]), pk2(ki[2], ki[3])}, b1 = {pk2(ki[4], ki[5]), pk2(ki[6], ki[7])};
                    *(u32x2*)(QD[dir] + t * 256 + h * 64 + perm32(d0)) = a0; *(u32x2*)(QD[dir] + t * 256 + h * 64 + perm32(d0 + 4)) = a1;
                    *(u32x2*)(KI[dir] + t * 256 + h * 64 + perm32(d0)) = b0; *(u32x2*)(KI[dir] + t * 256 + h * 64 + perm32(d0 + 4)) = b1;
                }
#pragma unroll
                for (int e = 0; e < 4; ++e) { const unsigned w = pk2(ke[2 * e], ke[2 * e + 1]); keT[dir][(d0 + 2 * e) * 72 + perm32(i)] = (bf16_t)(w & 0xFFFFu); keT[dir][(d0 + 2 * e + 1) * 72 + perm32(i)] = (bf16_t)(w >> 16); }
            }
#pragma unroll
            for (int ps = 0; ps < 2; ++ps) {
                const int idx = tid + NTH * ps, vi = idx >> 4, ch = idx & 15;
                const u32x4 vv = vvp[ps];
#pragma unroll
                for (int e = 0; e < 4; ++e) { vT[(ch * 8 + 2 * e) * 72 + perm32(vi)] = (bf16_t)(vv[e] & 0xFFFFu); vT[(ch * 8 + 2 * e + 1) * 72 + perm32(vi)] = (bf16_t)(vv[e] >> 16); }
            }
        }
        __syncthreads();
        {
            const int dk = tid >> 3, ch = tid & 7;
#pragma unroll
            for (int dir = 0; dir < 2; ++dir) {
                const u32x4 v = *(const LAS u32x4*)(keT[dir] + dk * 72 + ch * 8);
                *(u32x4*)(KE[dir] + ((size_t)(b * 64 + n) * 256 + h * 64 + dk) * 64 + ch * 8) = v;
            }
#pragma unroll
            for (int ps = 0; ps < 2; ++ps) {
                const int idx = tid + NTH * ps, dv = idx >> 3, c8 = idx & 7;
                const LAS bf16_t* s = vT + dv * 72 + c8 * 8;
                u32x4 v; v.x = s[0] | ((unsigned)s[1] << 16); v.y = s[2] | ((unsigned)s[3] << 16); v.z = s[4] | ((unsigned)s[5] << 16); v.w = s[6] | ((unsigned)s[7] << 16);
                *(u32x4*)(VT + ((size_t)(b * 64 + n) * 512 + h * 128 + dv) * 64 + c8 * 8) = v;
            }
            bf16x8 vb[2];
#pragma unroll
            for (int sk = 0; sk < 2; ++sk) vb[sk] = *(const LAS bf16x8*)(vT + (16 * wave + c15) * 72 + 32 * sk + 8 * g);
#pragma unroll
            for (int kt = 0; kt < 4; ++kt) {
                const f32x4 gf = {__expf(la[0][63 * 64 + 16 * kt + 4 * g]), __expf(la[0][63 * 64 + 16 * kt + 4 * g + 1]), __expf(la[0][63 * 64 + 16 * kt + 4 * g + 2]), __expf(la[0][63 * 64 + 16 * kt + 4 * g + 3])};
                const LAS float* gq = gs + (ci & 1) * 128 + 64 + 16 * kt + 4 * g;
                const f32x4 pb = {__expf(gq[0]), __expf(gq[1]), __expf(gq[2]), __expf(gq[3])};
                f32x4 uf = Sf[kt] * gf, ub = (f32x4){0.f, 0.f, 0.f, 0.f};
#pragma unroll
                for (int sk = 0; sk < 2; ++sk) {
                    uf = MFMA16(*(const LAS bf16x8*)(keT[0] + (16 * kt + c15) * 72 + 32 * sk + 8 * g), vb[sk], uf);
                    ub = MFMA16(*(const LAS bf16x8*)(keT[1] + (16 * kt + c15) * 72 + 32 * sk + 8 * g), vb[sk], ub);
                }
                Sf[kt] = uf;
                Sb[kt] = Sb[kt] + pb * ub;
            }
            if (tid < 64) { gs[((ci + 1) & 1) * 128 + tid] = gs[(ci & 1) * 128 + tid] + la[0][63 * 64 + tid]; gs[((ci + 1) & 1) * 128 + 64 + tid] = gs[(ci & 1) * 128 + 64 + tid] + la[1][tid]; }
        }
      }
      {
        f32x4* SSEG = (f32x4*)(ws + WS_SSEG); float* GSEG = (float*)(ws + WS_GSEG);
        const int sl = wave >> 1, nt = wave & 1;
#pragma unroll
        for (int dir = 0; dir < 2; ++dir) {
            const int bhd = b * 8 + h * 2 + dir, sg = dir ? 7 - pb : pb, tk = ((bhd * 8 + sg) << 2) | sl;
#pragma unroll
            for (int kt = 0; kt < 4; ++kt) {
                SSEG[((size_t)tk * 8 + kt * 2 + nt) * 64 + lane] = dir ? Sb[kt] : Sf[kt];
            }
        }
        __syncthreads();
        if (tid < 128) { const int dir = tid >> 6, d = tid & 63, bhd = b * 8 + h * 2 + dir, sg = dir ? 7 - pb : pb; GSEG[(bhd * 8 + sg) * 64 + d] = __expf(gs[tid]); }
      }
    }
}

template <bool FULL>
DI void phase3b(const Params& p, int lane, int wave) {
    asm volatile("" : "+v"(lane));
    unsigned char* ws = p.ws;
    const int c15 = lane & 15, g = lane >> 4;
    for (int task = blockIdx.x * NWV + wave; task < 2048; task += gridDim.x * NWV) {
        const int sl = task & 3, pair = task >> 2, sg = pair & 7, bhd = pair >> 3;
        const int dir = bhd & 1, h = (bhd >> 1) & 3, b = bhd >> 3;
        const bf16_t* QD = (const bf16_t*)(ws + WS_RS + (dir ? 48 : 0) * MB) + (size_t)b * SEQ * 256 + h * 64;
        const bf16_t* KI = (const bf16_t*)(ws + WS_RS + (dir ? 64 : 16) * MB) + (size_t)b * SEQ * 256 + h * 64;
        const bf16_t* KE = (const bf16_t*)(ws + WS_RS + (dir ? 80 : 32) * MB) + ((size_t)b * 64 * 256 + h * 64) * 64;
        const float* GAM = (const float*)(ws + WS_RS + 96 * MB + (dir ? 512 * 1024 : 0)) + (size_t)(b * 4 + h) * 64 * 64;
        const bf16_t* VT = (const bf16_t*)(ws + WS_RA) + ((size_t)b * 64 * 512 + h * 128 + sl * 32) * 64;
        bf16_t* O = (bf16_t*)(ws + WS_RO + (dir ? 64 : 0) * MB) + (size_t)b * SEQ * 512 + h * 128 + sl * 32;
        f32x4* SSEG = (f32x4*)(ws + WS_SSEG); float* GSEG = (float*)(ws + WS_GSEG);
        f32x4 S[4][2];
#pragma unroll
        for (int kt = 0; kt < 4; ++kt) { S[kt][0] = (f32x4){0.f, 0.f, 0.f, 0.f}; S[kt][1] = (f32x4){0.f, 0.f, 0.f, 0.f}; }
        if (FULL) {
            for (int s2 = 0; s2 < sg; ++s2) {
                const int t2 = ((bhd * 8 + s2) << 2) | sl;
#pragma unroll
                for (int kt = 0; kt < 4; ++kt) {
                    const f32x4 gm = *(const f32x4*)(GSEG + (bhd * 8 + s2) * 64 + 16 * kt + 4 * g);
#pragma unroll
                    for (int nt = 0; nt < 2; ++nt) S[kt][nt] = S[kt][nt] * gm + SSEG[((size_t)t2 * 8 + kt * 2 + nt) * 64 + lane];
                }
            }
        }
        f32x4 gprod[4];
#pragma unroll
        for (int kt = 0; kt < 4; ++kt) gprod[kt] = (f32x4){1.f, 1.f, 1.f, 1.f};
        for (int cs = 0; cs < SEGC; ++cs) {
            const int cn = sg * SEGC + cs, n = dir ? 63 - cn : cn;
            bf16x8 kea[4][2], vb[2][2];
            f32x4 gam[4];
#pragma unroll
            for (int jt = 0; jt < 4; ++jt)
#pragma unroll
                for (int s = 0; s < 2; ++s) kea[jt][s] = ld_frag16(KE + ((size_t)n * 256 + 16 * jt + c15) * 64 + 32 * s + 8 * g);
#pragma unroll
            for (int nt = 0; nt < 2; ++nt)
#pragma unroll
                for (int s = 0; s < 2; ++s) vb[nt][s] = ld_frag16(VT + ((size_t)n * 512 + 16 * nt + c15) * 64 + 32 * s + 8 * g);
#pragma unroll
            for (int kt = 0; kt < 4; ++kt) gam[kt] = *(const f32x4*)(GAM + n * 64 + 16 * kt + 4 * g);
            if (FULL) {
                bf16x8 kia[4][2];
#pragma unroll
                for (int jt = 0; jt < 4; ++jt)
#pragma unroll
                    for (int s = 0; s < 2; ++s) kia[jt][s] = ld_frag16(KI + (size_t)(n * 64 + 16 * jt + c15) * 256 + 32 * s + 8 * g);
                bf16x8 sb[2][2];
#pragma unroll
                for (int nt = 0; nt < 2; ++nt)
#pragma unroll
                    for (int s = 0; s < 2; ++s) sb[nt][s] = pack8(S[2 * s][nt], S[2 * s + 1][nt]);
#pragma unroll
                for (int it = 0; it < 4; ++it) {
                    bf16x8 qdb[2];
#pragma unroll
                    for (int s = 0; s < 2; ++s) qdb[s] = ld_frag16(QD + (size_t)(n * 64 + 16 * it + c15) * 256 + 32 * s + 8 * g);
                    f32x4 sc[4];
#pragma unroll
                    for (int jt = 0; jt < 4; ++jt) {
                        sc[jt] = (f32x4){0.f, 0.f, 0.f, 0.f};
#pragma unroll
                        for (int s = 0; s < 2; ++s) sc[jt] = MFMA16(kia[jt][s], qdb[s], sc[jt]);
                        const int ii = 16 * it + c15;
#pragma unroll
                        for (int r = 0; r < 4; ++r) { const int jj = 16 * jt + 4 * g + r; const bool keep = dir ? (jj > ii) : (jj <= ii); sc[jt][r] = keep ? sc[jt][r] : 0.f; }
                    }
                    bf16x8 pa[2] = {pack8(sc[0], sc[1]), pack8(sc[2], sc[3])};
#pragma unroll
                    for (int nt = 0; nt < 2; ++nt) {
                        f32x4 o = (f32x4){0.f, 0.f, 0.f, 0.f};
#pragma unroll
                        for (int s = 0; s < 2; ++s) { o = MFMA16(vb[nt][s], pa[s], o); o = MFMA16(sb[nt][s], qdb[s], o); }
                        { u32x2 w = {pk2(o[0], o[1]), pk2(o[2], o[3])}; *(u32x2*)(O + (size_t)(n * 64 + 16 * it + c15) * 512 + 16 * nt + 4 * g) = w; }
                    }
                }
            }
#pragma unroll
            for (int kt = 0; kt < 4; ++kt) {
                if (!FULL) gprod[kt] = gprod[kt] * gam[kt];
#pragma unroll
                for (int nt = 0; nt < 2; ++nt) {
                    f32x4 a = S[kt][nt] * gam[kt];
#pragma unroll
                    for (int s = 0; s < 2; ++s) a = MFMA16(kea[kt][s], vb[nt][s], a);
                    S[kt][nt] = a;
                }
            }
        }
        if (!FULL) {
#pragma unroll
            for (int kt = 0; kt < 4; ++kt) {
#pragma unroll
                for (int nt = 0; nt < 2; ++nt) SSEG[((size_t)task * 8 + kt * 2 + nt) * 64 + lane] = S[kt][nt];
                if (sl == 0 && c15 == 0) *(f32x4*)(GSEG + (bhd * 8 + sg) * 64 + 16 * kt + 4 * g) = gprod[kt];
            }
        }
    }
}

DI void phase4a(const Params& p, LAS unsigned char* lds, int tid, int lane, int wave) {
    asm volatile("" : "+v"(tid), "+v"(lane));
    unsigned char* ws = p.ws;
    const bf16_t* Z = (const bf16_t*)(ws + WS_RZ);
    bf16_t* MIX = (bf16_t*)(ws + WS_RA);
    const bf16_t* OF = (const bf16_t*)(ws + WS_RO); const bf16_t* OB = (const bf16_t*)(ws + WS_RO + 64 * MB);
    const bf16_t* WP = (const bf16_t*)(ws + WS_WP);
    LAS bf16_t* pt = (LAS bf16_t*)lds;
    LAS unsigned char* at = lds + 81920;
    const int c15 = lane & 15, g = lane >> 4;
    const f32x4 gh0 = *(const f32x4*)(p.in[11] + 8 * lane), gh1 = *(const f32x4*)(p.in[11] + 8 * lane + 4);
    for (int tile = blockIdx.x; tile < T / 64; tile += gridDim.x) {
        const int tok0 = tile * 64, s0 = tok0 & (SEQ - 1);
        __syncthreads();
#pragma unroll
        for (int ps = 0; ps < 10; ++ps) {
            const int idx = tid + NTH * ps, rr = idx >> 6, ch = idx & 63, sq = s0 - 8 + rr;
            u32x4 v = {0u, 0u, 0u, 0u};
            if (sq >= 0 && sq < SEQ) v = *(const u32x4*)(Z + ((size_t)tok0 - 8 + rr) * ZW + 1536 + ch * 8);
            *(LAS u32x4*)(pt + rr * 512 + ch * 8) = v;
        }
#pragma unroll
        for (int hb = 0; hb < 2; ++hb) {
            u32x4 a[4], bq[4], rv[4];
#pragma unroll
            for (int j = 0; j < 4; ++j) { const size_t t = (size_t)tok0 + wave * 8 + hb * 4 + j;
                a[j] = *(const u32x4*)(OF + t * 512 + 8 * lane); bq[j] = *(const u32x4*)(OB + t * 512 + 8 * lane); rv[j] = *(const u32x4*)(Z + t * ZW + 1024 + 8 * lane); }
#pragma unroll
            for (int j = 0; j < 4; ++j) { const size_t t = (size_t)tok0 + wave * 8 + hb * 4 + j;
                float o[8], r[8];
#pragma unroll
                for (int e = 0; e < 4; ++e) { o[2 * e] = bflo(a[j][e]) + bflo(bq[j][e]); o[2 * e + 1] = bfhi(a[j][e]) + bfhi(bq[j][e]); r[2 * e] = bflo(rv[j][e]); r[2 * e + 1] = bfhi(rv[j][e]); }
                float ss = 0.f;
#pragma unroll
                for (int e = 0; e < 8; ++e) ss += o[e] * o[e];
                ss += __shfl_xor(ss, 1); ss += __shfl_xor(ss, 2); ss += __shfl_xor(ss, 4); ss += __shfl_xor(ss, 8);
                const float rstd = rsqrtf(ss * (1.f / 128.f) + EPS);
                float y[8];
#pragma unroll
                for (int e = 0; e < 8; ++e) { const float gg = e < 4 ? gh0[e] : gh1[e - 4]; y[e] = o[e] * rstd * gg * (r[e] / (1.f + __expf(-r[e]))); }
                u32x4 w = {pk2(y[0], y[1]), pk2(y[2], y[3]), pk2(y[4], y[5]), pk2(y[6], y[7])};
                *(u32x4*)(MIX + t * D + 8 * lane) = w; }
        }
        __syncthreads();
        {
            const int c = tid, gi = c >> 7, cc = c & 127, hw = 1 << gi;
            LAS unsigned char* ag = at + gi * 16384;
            float sum = 0.f;
            {   const int lo = max(s0 - hw, 0), hi = min(s0 + hw, SEQ);
                for (int rr = lo; rr < hi; ++rr) sum += bflo((unsigned)pt[(rr - s0 + 8) * 512 + c]); }
#pragma unroll 4
            for (int i = 0; i < 64; ++i) {
                const int sq = s0 + i, lo = max(sq - hw, 0), hi = min(sq + hw, SEQ);
                const float val = sum / (float)(hi - lo) - bflo((unsigned)pt[(i + 8) * 512 + c]);
                *(LAS bf16_t*)(ag + i * 256 + (((cc >> 3) ^ (i & 15)) * 16) + (cc & 7) * 2) = (bf16_t)(pk2(val, 0.f) & 0xFFFFu);
                if (sq + hw < SEQ) sum += bflo((unsigned)pt[(i + 8 + hw) * 512 + c]);
                if (sq - hw >= 0) sum -= bflo((unsigned)pt[(i + 8 - hw) * 512 + c]);
            }
        }
        __syncthreads();
        {
            const int gi = wave >> 1, dh = wave & 1;
            LAS unsigned char* ag = at + gi * 16384;
            f32x4 acc[4][4];
#pragma unroll
            for (int mt = 0; mt < 4; ++mt)
#pragma unroll
                for (int nt = 0; nt < 4; ++nt) acc[mt][nt] = (f32x4){0.f, 0.f, 0.f, 0.f};
#pragma unroll
            for (int s = 0; s < 4; ++s) {
                bf16x8 af[4];
#pragma unroll
                for (int mt = 0; mt < 4; ++mt) { const int row = mt * 16 + c15; af[mt] = *(const LAS bf16x8*)(ag + row * 256 + (((4 * s + g) ^ (row & 15)) * 16)); }
#pragma unroll
                for (int nt = 0; nt < 4; ++nt) {
                    const bf16x8 wf = ld_frag16(WP + (size_t)gi * 16384 + (dh * 64 + 16 * nt + c15) * 128 + 32 * s + 8 * g);
#pragma unroll
                    for (int mt = 0; mt < 4; ++mt) acc[mt][nt] = MFMA16(wf, af[mt], acc[mt][nt]);
                }
            }
#pragma unroll
            for (int nt = 0; nt < 4; ++nt) {
                const f32x4 ps = *(const f32x4*)(p.in[13] + gi * 128 + dh * 64 + 16 * nt + 4 * g);
#pragma unroll
                for (int mt = 0; mt < 4; ++mt) {
                    const f32x4 v = acc[mt][nt] * ps;
                    u32x2 w = {pk2(v[0], v[1]), pk2(v[2], v[3])};
                    *(u32x2*)(MIX + ((size_t)tok0 + mt * 16 + c15) * D + 512 + gi * 128 + dh * 64 + 16 * nt + 4 * g) = w;
                }
            }
        }
    }
}

DI void phase4c(const Params& p, LAS unsigned char* lds, int tid, int lane, int wave) {
    asm volatile("" : "+v"(tid), "+v"(lane));
    LAS float* lG = (LAS float*)lds; LAS float* lA = lG + 1024; LAS float* lB = lA + 1024; LAS float* lP = lB + 1024;
    const float* x = p.in[0]; const bf16_t* MIXO = (const bf16_t*)(p.ws + WS_RZ); bf16_t* H2 = (bf16_t*)(p.ws + WS_RA);
    for (int rt = blockIdx.x; rt < T / 128; rt += gridDim.x) {
        const int b = rt / 32;
        __syncthreads();
        for (int d = tid; d < 1024; d += NTH) { lG[d] = mod_at(p, b, 2048 + d); lA[d] = p.in[15][d] * (1.f + mod_at(p, b, 4096 + d)); lB[d] = mod_at(p, b, 3072 + d); lP[d] = p.in[5][d]; }
        __syncthreads();
        for (int r0 = wave; r0 < 128; r0 += 2 * NWV) {
            f32x4 m[2][4], xv[2][4];
#pragma unroll
            for (int u = 0; u < 2; ++u) {
                const size_t row = (size_t)rt * 128 + r0 + u * NWV;
                const u32x2* mr = (const u32x2*)(MIXO + row * D) + lane; const f32x4* xr = (const f32x4*)(x + row * D) + lane;
#pragma unroll
                for (int j = 0; j < 4; ++j) { const u32x2 mv = mr[64 * j]; m[u][j] = (f32x4){bflo(mv.x), bfhi(mv.x), bflo(mv.y), bfhi(mv.y)}; xv[u][j] = xr[64 * j]; }
            }
#pragma unroll
            for (int u = 0; u < 2; ++u) {
                const size_t row = (size_t)rt * 128 + r0 + u * NWV;
                float ss = 0.f;
#pragma unroll
                for (int j = 0; j < 4; ++j) ss += m[u][j][0] * m[u][j][0] + m[u][j][1] * m[u][j][1] + m[u][j][2] * m[u][j][2] + m[u][j][3] * m[u][j][3];
                const float rstd = rsqrtf(wave_sum(ss) * (1.f / D) + EPS);
                float s2 = 0.f;
#pragma unroll
                for (int j = 0; j < 4; ++j) {
                    const f32x4 gt = *(const LAS f32x4*)(lG + 4 * lane + 256 * j), pm = *(const LAS f32x4*)(lP + 4 * lane + 256 * j);
                    xv[u][j] = xv[u][j] + gt * (m[u][j] * rstd * pm);
                    s2 += xv[u][j][0] * xv[u][j][0] + xv[u][j][1] * xv[u][j][1] + xv[u][j][2] * xv[u][j][2] + xv[u][j][3] * xv[u][j][3];
                }
                const float rstd2 = rsqrtf(wave_sum(s2) * (1.f / D) + EPS);
                f32x4* orow = (f32x4*)(p.out + row * D) + lane; u32x2* hrow = (u32x2*)(H2 + row * D) + lane;
#pragma unroll
                for (int j = 0; j < 4; ++j) {
                    orow[64 * j] = xv[u][j];
#if defined(CHK_PEER) || REPEAT_PHASE == 6
                    ((f32x4*)((float*)(p.ws + WS_RO) + row * D) + lane)[64 * j] = xv[u][j];
#endif
                    const f32x4 a = *(const LAS f32x4*)(lA + 4 * lane + 256 * j), bb = *(const LAS f32x4*)(lB + 4 * lane + 256 * j);
                    const f32x4 hv = xv[u][j] * rstd2 * a + bb;
                    u32x2 w = {pk2(hv[0], hv[1]), pk2(hv[2], hv[3])};
                    hrow[64 * j] = w;
                }
            }
        }
    }
}

DI int skey(float v, int idx, int mask) { int u = __float_as_int(v); u ^= (u >> 31) & 0x7FFFFFFF; return (u & ~mask) | idx; }
DI float sval(int k, int mask) { int u = k & ~mask; u ^= (u >> 31) & 0x7FFFFFFF; return __int_as_float(u); }
DI void cswap(int& a, int& b) { const int mx = max(a, b), mn = min(a, b); a = mx; b = mn; }
DI void sort16_desc(int (&a)[16]) {
#pragma unroll
    for (int k = 2; k <= 16; k <<= 1) {
#pragma unroll
        for (int j = k >> 1; j > 0; j >>= 1) {
#pragma unroll
            for (int i = 0; i < 16; ++i) {
                const int l = i ^ j;
                if (l > i) { if ((i & k) == 0) cswap(a[i], a[l]); else cswap(a[l], a[i]); }
            }
        }
    }
}
DI void merge16_desc(int (&x)[16], const int (&y)[16]) {
#pragma unroll
    for (int i = 0; i < 16; ++i) x[i] = max(x[i], y[15 - i]);
#pragma unroll
    for (int j = 8; j > 0; j >>= 1) {
#pragma unroll
        for (int i = 0; i < 16; ++i) { const int l = i ^ j; if (l > i) cswap(x[i], x[l]); }
    }
}

DI void phase5b(const Params& p, LAS unsigned char* lds, int tid, int lane, int wave) {
    asm volatile("" : "+v"(tid), "+v"(lane));
    unsigned char* ws = p.ws;
    const bf16_t* Q2 = (const bf16_t*)(ws + WS_RZ);
    const bf16_t* SKB = (const bf16_t*)(ws + WS_SKB);
    int* EIDX = (int*)(ws + WS_RS); float* GATE = (float*)(ws + WS_RS + 16 * MB);
    LAS unsigned char* tab = lds + tid * 32;
    LAS unsigned char* skl = lds + 16384;
    const int c31 = lane & 31, hi = lane >> 5;
    for (int btask = blockIdx.x; btask < 256; btask += gridDim.x) {
        const int h = btask & 7, tgc = btask >> 3;
        __syncthreads();
#pragma unroll
        for (int ps = 0; ps < 8; ++ps) {
            const int idx = tid + NTH * ps, row = idx >> 4, ch = idx & 15;
            const u32x4 v = *(const u32x4*)(SKB + ((size_t)h * 256 + row) * 128 + ch * 8);
            *(LAS u32x4*)(skl + row * 256 + ((ch ^ (row & 15)) * 16)) = v;
        }
        __syncthreads();
      for (int ti = 0; ti < 4; ++ti) {
        const int tg = tgc * 32 + wave * 4 + ti;
        const size_t tok = (size_t)tg * 32 + c31;
        int lst[2][16];
        bf16x8 bq[2][8];
#pragma unroll
        for (int pp = 0; pp < 2; ++pp) {
            const bf16_t* qp = Q2 + tok * 2048 + h * 256 + pp * 128 + 8 * hi;
            asm volatile("" : "+v"(qp));
#pragma unroll
            for (int ks = 0; ks < 8; ++ks) bq[pp][ks] = ld_frag16(qp + 16 * ks);
        }
#pragma unroll
        for (int pp = 0; pp < 2; ++pp) {
            int run[16];
#pragma unroll
            for (int r = 0; r < 16; ++r) run[r] = (int)0x80000000;
#pragma unroll 1
            for (int kt = 0; kt < 4; ++kt) {
                const LAS unsigned char* kb = skl + pp * 32768 + (32 * kt + c31) * 256;
                f32x16 acc;
#pragma unroll
                for (int r = 0; r < 16; ++r) acc[r] = 0.f;
#pragma unroll
                for (int ks = 0; ks < 8; ++ks) acc = MFMA32(*(const LAS bf16x8*)(kb + (((2 * ks + hi) ^ (c31 & 15)) * 16)), bq[pp][ks], acc);
                int cur[16];
#pragma unroll
                for (int r = 0; r < 16; ++r) cur[r] = skey(acc[r], 32 * kt + 8 * (r >> 2) + 4 * hi + (r & 3), 0x7F);
                sort16_desc(cur);
                merge16_desc(run, cur);
            }
            int oth[16];
#pragma unroll
            for (int r = 0; r < 16; ++r) oth[r] = __shfl_xor(run[r], 32);
            merge16_desc(run, oth);
#pragma unroll
            for (int r = 0; r < 16; ++r) lst[pp][r] = run[r];
        }
#pragma unroll
        for (int pp = 0; pp < 2; ++pp) {
            u32x4 w;
#pragma unroll
            for (int q = 0; q < 4; ++q) w[q] = (lst[pp][4 * q] & 0x7F) | ((lst[pp][4 * q + 1] & 0x7F) << 8) | ((lst[pp][4 * q + 2] & 0x7F) << 16) | ((lst[pp][4 * q + 3] & 0x7F) << 24);
            *(LAS u32x4*)(tab + 16 * pp) = w;
        }
        float va[16], vb[16];
#pragma unroll
        for (int r = 0; r < 16; ++r) { va[r] = sval(lst[0][r], 0x7F); vb[r] = sval(lst[1][r], 0x7F); }
        int cand[4][16];
        {
            int cnt = 0;
#pragma unroll
            for (int i = 0; i < 16; ++i)
#pragma unroll
                for (int j = 0; j < 16; ++j)
                    if ((i + 1) * (j + 1) <= 16) { cand[cnt >> 4][cnt & 15] = skey(va[i] + vb[j], (i << 4) | j, 0xFF); ++cnt; }
#pragma unroll
            for (int q = 50; q < 64; ++q) cand[q >> 4][q & 15] = (int)0x80000000;
        }
        sort16_desc(cand[0]); sort16_desc(cand[1]); sort16_desc(cand[2]); sort16_desc(cand[3]);
        merge16_desc(cand[0], cand[1]); merge16_desc(cand[2], cand[3]); merge16_desc(cand[0], cand[2]);
        asm volatile("s_waitcnt lgkmcnt(0)" ::: "memory");
        float sv[16]; int ex[16];
        const float mx = sval(cand[0][0], 0xFF);
        float sum = 0.f;
#pragma unroll
        for (int r = 0; r < 16; ++r) {
            const int ck = cand[0][r];
            const int i1 = tab[(ck >> 4) & 15], i2 = tab[16 + (ck & 15)];
            ex[r] = i1 * 128 + i2;
            sv[r] = __expf(sval(ck, 0xFF) - mx); sum += sv[r];
        }
        const float inv = 1.f / sum;
        int* ep = EIDX + tok * 128 + h * 16 + 8 * hi; float* gp = GATE + tok * 128 + h * 16 + 8 * hi;
        if (hi == 0) {
            *(u32x4*)ep = (u32x4){(unsigned)ex[0], (unsigned)ex[1], (unsigned)ex[2], (unsigned)ex[3]}; *(u32x4*)(ep + 4) = (u32x4){(unsigned)ex[4], (unsigned)ex[5], (unsigned)ex[6], (unsigned)ex[7]};
            *(f32x4*)gp = (f32x4){sv[0] * inv, sv[1] * inv, sv[2] * inv, sv[3] * inv}; *(f32x4*)(gp + 4) = (f32x4){sv[4] * inv, sv[5] * inv, sv[6] * inv, sv[7] * inv};
        } else {
            *(u32x4*)ep = (u32x4){(unsigned)ex[8], (unsigned)ex[9], (unsigned)ex[10], (unsigned)ex[11]}; *(u32x4*)(ep + 4) = (u32x4){(unsigned)ex[12], (unsigned)ex[13], (unsigned)ex[14], (unsigned)ex[15]};
            *(f32x4*)gp = (f32x4){sv[8] * inv, sv[9] * inv, sv[10] * inv, sv[11] * inv}; *(f32x4*)(gp + 4) = (f32x4){sv[12] * inv, sv[13] * inv, sv[14] * inv, sv[15] * inv};
        }
      }
    }
}

template <int K> DI int swz_bcast(int v) { return __builtin_amdgcn_ds_swizzle(v, 0x10 | (K << 5)); }
template <int W> DI int swz_xor(int v) { return __builtin_amdgcn_ds_swizzle(v, 0x1F | (W << 10)); }
template <int K> struct IC { static constexpr int v = K; };
template <int N, int I = 0, class F> DI void static_for(F&& f) { if constexpr (I < N) { f(IC<I>{}); static_for<N, I + 1>(f); } }
DI float row16_sum(float v) {
    v += __builtin_bit_cast(float, __builtin_amdgcn_update_dpp(0, __builtin_bit_cast(int, v), 0xB1, 0xF, 0xF, true));
    v += __builtin_bit_cast(float, __builtin_amdgcn_update_dpp(0, __builtin_bit_cast(int, v), 0x4E, 0xF, 0xF, true));
    v += __builtin_bit_cast(float, __builtin_amdgcn_update_dpp(0, __builtin_bit_cast(int, v), 0x141, 0xF, 0xF, true));
    v += __builtin_bit_cast(float, __builtin_amdgcn_update_dpp(0, __builtin_bit_cast(int, v), 0x140, 0xF, 0xF, true));
    return v;
}
DI void phase6(const Params& p, LAS unsigned char* lds, int tid, int lane, int wave) {
    asm volatile("" : "+v"(tid), "+v"(lane));
    unsigned char* ws = p.ws;
    const bf16_t* H2 = (const bf16_t*)(ws + WS_RA);
    const unsigned char* UQ = ws + WS_UB; const unsigned char* VQ = ws + WS_VB;
    const float* SU = (const float*)(ws + WS_SU); const float* SV = (const float*)(ws + WS_SV);
    const int* EIDX = (const int*)(ws + WS_RS); const float* GATE = (const float*)(ws + WS_RS + 16 * MB);
    LAS float* lG = (LAS float*)lds;
    const int q = lane >> 4, l16 = lane & 15;
    LAS int* le = (LAS int*)(lds + 4096 + wave * 6144) + q * 128;
    LAS float* lg = (LAS float*)(lds + 4096 + wave * 6144 + 2048) + q * 128;
    LAS float* lc = (LAS float*)(lds + 4096 + wave * 6144 + 4096) + q * 128;
    const unsigned qlo = q < 2 ? (0xFFFFu << (16 * q)) : 0u, qhi = q >= 2 ? (0xFFFFu << (16 * (q - 2))) : 0u;
    for (int rt = blockIdx.x; rt < T / 128; rt += gridDim.x) {
        const int b = rt / 32;
        __syncthreads();
        for (int d = tid; d < 1024; d += NTH) lG[d] = mod_at(p, b, 5120 + d) * p.in[16][d];
        __syncthreads();
#pragma unroll 1
        for (int rd = 0; rd < 4; ++rd) {
            __syncthreads();
            const size_t t = (size_t)rt * 128 + wave * 16 + rd * 4 + q;
            {
                int e[8]; float g[8];
#pragma unroll
                for (int r = 0; r < 8; ++r) { e[r] = EIDX[t * 128 + r * 16 + l16]; g[r] = GATE[t * 128 + r * 16 + l16]; }
                int base = 0;
#pragma unroll 1
                for (int part = 0; part < 16; ++part) {
#pragma unroll
                    for (int r = 0; r < 8; ++r) {
                        const bool hit = (e[r] >> 10) == part;
                        const unsigned long long m = __ballot(hit);
                        const unsigned mlo = (unsigned)m & qlo, mhi = (unsigned)(m >> 32) & qhi;
                        const int pos = base + (int)__builtin_amdgcn_mbcnt_hi(mhi, __builtin_amdgcn_mbcnt_lo(mlo, 0u));
                        if (hit) { le[pos] = e[r]; lg[pos] = g[r]; }
                        base += __builtin_popcount(mlo) + __builtin_popcount(mhi);
                    }
                }
                asm volatile("s_waitcnt lgkmcnt(0)" ::: "memory");
            }
            {
                int hq[16]; float ish;
                {
                    float hv[64]; float hm = 0.f;
#pragma unroll
                    for (int i = 0; i < 4; ++i) {
                        const u32x4 h0 = *(const u32x4*)(H2 + t * D + 256 * i + 16 * l16), h1 = *(const u32x4*)(H2 + t * D + 256 * i + 16 * l16 + 8);
#pragma unroll
                        for (int c = 0; c < 4; ++c) { hv[16 * i + 2 * c] = bflo(h0[c]); hv[16 * i + 2 * c + 1] = bfhi(h0[c]); hv[16 * i + 8 + 2 * c] = bflo(h1[c]); hv[16 * i + 8 + 2 * c + 1] = bfhi(h1[c]); }
                    }
#pragma unroll
                    for (int j = 0; j < 64; ++j) hm = fmaxf(hm, fabsf(hv[j]));
                    hm = fmaxf(hm, __builtin_bit_cast(float, __builtin_amdgcn_update_dpp(0, __builtin_bit_cast(int, hm), 0xB1, 0xF, 0xF, true)));
                    hm = fmaxf(hm, __builtin_bit_cast(float, __builtin_amdgcn_update_dpp(0, __builtin_bit_cast(int, hm), 0x4E, 0xF, 0xF, true)));
                    hm = fmaxf(hm, __builtin_bit_cast(float, __builtin_amdgcn_update_dpp(0, __builtin_bit_cast(int, hm), 0x141, 0xF, 0xF, true)));
                    hm = fmaxf(hm, __builtin_bit_cast(float, __builtin_amdgcn_update_dpp(0, __builtin_bit_cast(int, hm), 0x140, 0xF, 0xF, true)));
                    const float s8 = hm > 1e-30f ? 127.f / hm : 0.f; ish = hm * (1.f / 127.f);
#pragma unroll
                    for (int d = 0; d < 16; ++d) {
                        const int q0 = __float2int_rn(hv[4 * d] * s8), q1 = __float2int_rn(hv[4 * d + 1] * s8), q2 = __float2int_rn(hv[4 * d + 2] * s8), q3 = __float2int_rn(hv[4 * d + 3] * s8);
                        hq[d] = (int)((unsigned)(q0 & 0xFF) | ((unsigned)(q1 & 0xFF) << 8) | ((unsigned)(q2 & 0xFF) << 16) | ((unsigned)q3 << 24));
                    }
                }
                constexpr int UD = 4;
                u32x4 ub[UD][4];
                int evn = le[l16];
                static_for<UD>([&](auto kc) { constexpr int k = decltype(kc)::v; const unsigned char* up = UQ + (size_t)swz_bcast<k>(evn) * 1024 + 16 * l16;
#pragma unroll
                    for (int i = 0; i < 4; ++i) ub[k][i] = *(const u32x4*)(up + 256 * i); });
#pragma unroll 1
                for (int bt = 0; bt < 8; ++bt) {
                    if (bt) __syncthreads();
                    const int ev = evn; const float gv = lg[bt * 16 + l16];
                    evn = le[(bt < 7 ? bt + 1 : 7) * 16 + l16];
                    const float isu = SU[ev] * ish, isv = SV[ev];
                    int part[16];
                    static_for<16>([&](auto kc) {
                        constexpr int k = decltype(kc)::v, sl = k % UD;
                        int a = 0;
#pragma unroll
                        for (int i = 0; i < 4; ++i) {
                            const u32x4 u = ub[sl][i];
#pragma unroll
                            for (int c = 0; c < 4; ++c) a = __builtin_amdgcn_sdot4((int)u[c], hq[4 * i + c], a, false);
                        }
                        part[k] = a;
                        {
                            constexpr int kn = k + UD;
                            int idx; if constexpr (kn < 16) idx = swz_bcast<(kn & 15)>(ev); else idx = swz_bcast<(kn & 15)>(evn);
                            const unsigned char* up = UQ + (size_t)idx * 1024 + 16 * l16;
#pragma unroll
                            for (int i = 0; i < 4; ++i) ub[sl][i] = *(const u32x4*)(up + 256 * i);
                        }
                    });
                    static_for<4>([&](auto sc) {
                        constexpr int w = 8 >> decltype(sc)::v;
                        const bool up2 = (lane & w) != 0;
#pragma unroll
                        for (int e = 0; e < w; ++e) {
                            const int keep = up2 ? part[e + w] : part[e], send = up2 ? part[e] : part[e + w];
                            part[e] = keep + swz_xor<w>(send);
                        }
                    });
                    const float dot = (float)part[0] * isu;
                    lc[bt * 16 + l16] = gv * 0.5f * dot * (1.f + erff(dot * 0.70710678118654752f)) * isv;
                }
                asm volatile("s_waitcnt lgkmcnt(0)" ::: "memory");
            }
            __syncthreads();
            f32x2 y[32];
#pragma unroll
            for (int i = 0; i < 32; ++i) y[i] = (f32x2){0.f, 0.f};
            {
                constexpr int VD = 4;
                u32x4 vbuf[VD][4];
                int evn = le[l16];
                static_for<VD>([&](auto kc) { constexpr int k = decltype(kc)::v; const unsigned char* vp = VQ + (size_t)swz_bcast<k>(evn) * 1024 + 16 * l16;
#pragma unroll
                    for (int i = 0; i < 4; ++i) vbuf[k][i] = *(const u32x4*)(vp + 256 * i); });
#pragma unroll 1
                for (int bt = 0; bt < 8; ++bt) {
                    if (bt) __syncthreads();
                    const int ev = evn; const int cv = __float_as_int(lc[bt * 16 + l16]);
                    evn = le[(bt < 7 ? bt + 1 : 7) * 16 + l16];
                    static_for<16>([&](auto kc) {
                        constexpr int k = decltype(kc)::v, sl = k % VD;
                        const float cc = __int_as_float(swz_bcast<k>(cv));
                        const f32x2 c2 = (f32x2){cc, cc};
#pragma unroll
                        for (int i = 0; i < 4; ++i) {
                            const u32x4 v = vbuf[sl][i];
#pragma unroll
                            for (int c = 0; c < 4; ++c) {
                                const int w = (int)v[c];
                                y[8 * i + 2 * c] = __builtin_elementwise_fma(__builtin_amdgcn_cvt_pk_f32_fp8(w, false), c2, y[8 * i + 2 * c]);
                                y[8 * i + 2 * c + 1] = __builtin_elementwise_fma(__builtin_amdgcn_cvt_pk_f32_fp8(w, true), c2, y[8 * i + 2 * c + 1]);
                            }
                        }
                        {
                            constexpr int kn = k + VD;
                            int idx; if constexpr (kn < 16) idx = swz_bcast<(kn & 15)>(ev); else idx = swz_bcast<(kn & 15)>(evn);
                            const unsigned char* vp = VQ + (size_t)idx * 1024 + 16 * l16;
#pragma unroll
                            for (int i = 0; i < 4; ++i) vbuf[sl][i] = *(const u32x4*)(vp + 256 * i);
                        }
                    });
                }
            }
            float ss = 0.f;
#pragma unroll
            for (int i = 0; i < 32; ++i) ss += y[i].x * y[i].x + y[i].y * y[i].y;
            const float rstd = rsqrtf(row16_sum(ss) * (1.f / D) + EPS);
            float* orow = p.out + t * D;
#pragma unroll
            for (int i = 0; i < 4; ++i)
#pragma unroll
                for (int c = 0; c < 4; ++c) {
                    const int col = 256 * i + 16 * l16 + 4 * c;
#if REPEAT_PHASE == 6
                    f32x4 xv = *(const f32x4*)((const float*)(p.ws + WS_RO) + t * D + col);
#else
                    f32x4 xv = *(const f32x4*)(orow + col);
#endif
                    const f32x4 gg = *(const LAS f32x4*)(lG + col);
                    xv[0] += gg[0] * y[8 * i + 2 * c].x * rstd; xv[1] += gg[1] * y[8 * i + 2 * c].y * rstd; xv[2] += gg[2] * y[8 * i + 2 * c + 1].x * rstd; xv[3] += gg[3] * y[8 * i + 2 * c + 1].y * rstd;
                    *(f32x4*)(orow + col) = xv;
                }
        }
    }
}

#ifdef CHK_PEER
DI float blk_sum(float v, LAS float* red, int tid, int lane, int wave) {
    v = wave_sum(v);
    __syncthreads();
    if (lane == 0) red[wave] = v;
    __syncthreads();
    float s = 0.f;
    for (int i = 0; i < NWV; ++i) s += red[i];
    return s;
}
DI void check_peer(const Params& p, LAS unsigned char* lds, int tid, int lane, int wave) {
    unsigned char* ws = p.ws;
    const bf16_t* H2 = (const bf16_t*)(ws + WS_RA); const bf16_t* WQ = (const bf16_t*)(ws + WS_WQ); const bf16_t* SKB = (const bf16_t*)(ws + WS_SKB);
    const bf16_t* UB = (const bf16_t*)(ws + WS_UB); const bf16_t* VB = (const bf16_t*)(ws + WS_VB);
    const float* X1 = (const float*)(ws + WS_RO);
    float* stat = (float*)(ws + WS_CTL + 32768);
    LAS float* hrow = (LAS float*)lds;
    LAS float* qv = hrow + 1024;
    LAS float* sc = qv + 2048;
    LAS float* tv = sc + 2048;
    LAS int* ti = (LAS int*)(tv + 256);
    LAS int* ee = ti + 256;
    LAS float* gg = (LAS float*)(ee + 128);
    LAS float* cf = gg + 128;
    LAS float* yv = cf + 128;
    LAS float* red = yv + 1024;
    for (int rt = blockIdx.x; rt < T / 128; rt += gridDim.x) {
        const size_t ts = (size_t)rt * 128 + 37; const int b = rt / 32;
        __syncthreads();
        for (int d = tid; d < 1024; d += NTH) hrow[d] = bflo((unsigned)H2[ts * D + d]);
        __syncthreads();
        for (int n = tid; n < 2048; n += NTH) { float a = 0.f; for (int k = 0; k < 1024; ++k) a += hrow[k] * bflo((unsigned)WQ[(size_t)n * 1024 + k]); qv[n] = bflo(pk2(a, 0.f) & 0xFFFFu); }
        __syncthreads();
        for (int n = tid; n < 2048; n += NTH) { const int hp = n >> 7, key = n & 127; float a = 0.f; for (int d = 0; d < 128; ++d) a += qv[hp * 128 + d] * bflo((unsigned)SKB[((size_t)hp * 128 + key) * 128 + d]); sc[n] = a; }
        __syncthreads();
        if (tid < 16) { const int hp = tid;
            for (int k = 0; k < 16; ++k) { float best = -3e38f; int bi = 0; for (int n = 0; n < 128; ++n) { const float v = sc[hp * 128 + n]; if (v > best) { best = v; bi = n; } } tv[hp * 16 + k] = best; ti[hp * 16 + k] = bi; sc[hp * 128 + bi] = -3e38f; } }
        __syncthreads();
        if (tid < 8) { const int h = tid; float cs[16]; int ci[16];
            unsigned long long used[4] = {0ull, 0ull, 0ull, 0ull};
            for (int k = 0; k < 16; ++k) { float best = -3e38f; int bi = 0;
                for (int c = 0; c < 256; ++c) { if ((used[c >> 6] >> (c & 63)) & 1ull) continue; const float v = tv[(h * 2) * 16 + (c >> 4)] + tv[(h * 2 + 1) * 16 + (c & 15)]; if (v > best) { best = v; bi = c; } }
                used[bi >> 6] |= 1ull << (bi & 63); cs[k] = best; ci[k] = bi; }
            float sum = 0.f; for (int k = 0; k < 16; ++k) { cs[k] = __expf(cs[k] - cs[0]); sum += cs[k]; }
            for (int k = 0; k < 16; ++k) { ee[h * 16 + k] = ti[(h * 2) * 16 + (ci[k] >> 4)] * 128 + ti[(h * 2 + 1) * 16 + (ci[k] & 15)]; gg[h * 16 + k] = cs[k] / sum; } }
        __syncthreads();
#ifdef CHK_USE_FAST_SEL
        if (tid < 128) { ee[tid] = ((const int*)(ws + WS_RS))[ts * 128 + tid]; gg[tid] = ((const float*)(ws + WS_RS + 16 * MB))[ts * 128 + tid]; }
        __syncthreads();
#endif
        if (tid < 128) { const int e = ee[tid]; float a = 0.f; for (int d = 0; d < 1024; ++d) a += hrow[d] * bflo((unsigned)UB[(size_t)e * D + d]); cf[tid] = gg[tid] * 0.5f * a * (1.f + erff(a * 0.70710678118654752f)); }
        __syncthreads();
        for (int d = tid; d < 1024; d += NTH) { float a = 0.f; for (int e = 0; e < 128; ++e) a += cf[e] * bflo((unsigned)VB[(size_t)ee[e] * D + d]); yv[d] = a; }
        __syncthreads();
        float ss = 0.f; for (int d = tid; d < 1024; d += NTH) ss += yv[d] * yv[d];
        const float rstd = rsqrtf(blk_sum(ss, red, tid, lane, wave) * (1.f / D) + EPS);
        float e2 = 0.f, r2 = 0.f;
        for (int d = tid; d < 1024; d += NTH) { const float br = mod_at(p, b, 5120 + d) * p.in[16][d] * yv[d] * rstd; const float ref = X1[ts * D + d] + br; const float df = p.out[ts * D + d] - ref; e2 += df * df; r2 += br * br; }
        e2 = blk_sum(e2, red, tid, lane, wave); r2 = blk_sum(r2, red, tid, lane, wave);
        if (tid == 0) { atomicAdd(&stat[0], e2); atomicAdd(&stat[1], r2); }
    }
}
DI void check_emit(const Params& p, int tid) {
    const float* stat = (const float*)(p.ws + WS_CTL + 32768);
    const float e = __hip_atomic_load(&stat[0], __ATOMIC_RELAXED, __HIP_MEMORY_SCOPE_AGENT), r = __hip_atomic_load(&stat[1], __ATOMIC_RELAXED, __HIP_MEMORY_SCOPE_AGENT);
    const float A = 10.f + 1e6f * (e / r), f = 1.f + sqrtf(A);
    const size_t gt = (size_t)blockIdx.x * NTH + tid, NGT = (size_t)gridDim.x * NTH;
    for (size_t i = gt; i < (size_t)T * D / 4; i += NGT) { f32x4 v = ((const f32x4*)p.in[0])[i]; ((f32x4*)p.out)[i] = v * f; }
}
#endif

#ifdef TIMING
#define STAMP(k) do { if (blockIdx.x == 0 && threadIdx.x == 0) ((unsigned long long*)(p.ws + WS_CTL + 40960))[k] = __builtin_amdgcn_s_memrealtime(); } while (0)
DI void timing_emit(const Params& p, int tid) {
    const unsigned long long* ts = (const unsigned long long*)(p.ws + WS_CTL + 40960);
#define dT(a, b) ((float)(ts[b] - ts[a]) * 0.01f)
    const float A = TIM_A, B = TIM_B, f = 1.f + sqrtf(A);
#undef dT
    const size_t gt = (size_t)blockIdx.x * NTH + tid, NGT = (size_t)gridDim.x * NTH;
    for (size_t i = gt; i < (size_t)T * D / 4; i += NGT) { f32x4 v = ((const f32x4*)p.in[0])[i]; v = v * f; if (i == 0) v[0] = B; ((f32x4*)p.out)[i] = v; }
}
#else
#define STAMP(k) do {} while (0)
#endif

__global__ void __launch_bounds__(NTH) fwd_megakernel(Params p) {
    extern __shared__ __attribute__((aligned(16))) unsigned char lds_raw[];
    LAS unsigned char* lds = (LAS unsigned char*)lds_raw;
    const int tid = threadIdx.x, lane = tid & 63, wave = __builtin_amdgcn_readfirstlane(tid >> 6);
    volatile LAS unsigned* st = (volatile LAS unsigned*)(lds + LDS_BARW);
    if (tid == 0) { st[0] = 0u; st[1] = 0u; st[2] = 0u; st[3] = 0u; }
    __syncthreads();
    XcdBarrier bar = xcd_barrier_post((unsigned*)(p.ws + WS_CTL), st);
    unsigned char* ws = p.ws;

    STAMP(0);
    phase0(p, lds, tid, lane, wave);
    xcd_barrier(bar);
#if REPEAT_PHASE == 0
    phase0(p, lds, tid, lane, wave);
    xcd_barrier(bar);
#endif
    STAMP(1);
    phase1(p, lds, tid, lane, wave);
    xcd_barrier(bar);
    STAMP(2);
    { pg8::Gemm g{(const bf16_t*)(ws + WS_RA), (const bf16_t*)(ws + WS_WIN), T, ZW, D}; pg8::StaticOrder S; S.init(T, ZW, (int)gridDim.x, (int)blockIdx.x);
      pg8::EpiB16 e{(bf16_t*)(ws + WS_RZ), ZW}; pg8::gemm_phase<pg8::EpiB16, pg8::StaticOrder, true, true>(lds, g, S, e);
      EpiZ e2{(bf16_t*)(ws + WS_RZ), (float*)(ws + WS_AFB)}; gemm_phase(((const bf16_t*)(ws + WS_RA)), (const bf16_t*)(ws + WS_WIN), T, NIN, D, e2, lds, tid, lane, wave, 16); }
#if REPEAT_PHASE == 2
    xcd_barrier(bar);
    { pg8::Gemm g{(const bf16_t*)(ws + WS_RA), (const bf16_t*)(ws + WS_WIN), T, ZW, D}; pg8::StaticOrder S; S.init(T, ZW, (int)gridDim.x, (int)blockIdx.x);
      pg8::EpiB16 e{(bf16_t*)(ws + WS_RZ), ZW}; pg8::gemm_phase<pg8::EpiB16, pg8::StaticOrder, true, true>(lds, g, S, e);
      EpiZ e2{(bf16_t*)(ws + WS_RZ), (float*)(ws + WS_AFB)}; gemm_phase(((const bf16_t*)(ws + WS_RA)), (const bf16_t*)(ws + WS_WIN), T, NIN, D, e2, lds, tid, lane, wave, 16); }
#endif
    xcd_barrier(bar);
    STAMP(3);
    phase3a(p, lds, tid, lane, wave);
    xcd_barrier(bar);
#if REPEAT_PHASE == 1
    phase3a(p, lds, tid, lane, wave);
    xcd_barrier(bar);
#endif
    STAMP(4);
    phase3b<true>(p, lane, wave);
    xcd_barrier(bar);
    STAMP(5);
    phase4a(p, lds, tid, lane, wave);
    xcd_barrier(bar);
#if REPEAT_PHASE == 4
    phase4a(p, lds, tid, lane, wave);
    xcd_barrier(bar);
#endif
    STAMP(6);
    { pg8::Gemm g{(const bf16_t*)(ws + WS_RA), (const bf16_t*)(ws + WS_WOUT), T, D, D}; pg8::StaticOrder S; S.init(T, D, (int)gridDim.x, (int)blockIdx.x);
      pg8::EpiB16 e{(bf16_t*)(ws + WS_RZ), D}; pg8::gemm_phase<pg8::EpiB16, pg8::StaticOrder, true, true>(lds, g, S, e); }
    xcd_barrier(bar);
    STAMP(7);
    phase4c(p, lds, tid, lane, wave);
    xcd_barrier(bar);
    STAMP(8);
#ifndef ABL_SKIP_PEER
    { pg8::Gemm g{(const bf16_t*)(ws + WS_RA), (const bf16_t*)(ws + WS_WQ), T, 2048, D}; pg8::StaticOrder S; S.init(T, 2048, (int)gridDim.x, (int)blockIdx.x);
      pg8::EpiB16 e{(bf16_t*)(ws + WS_RZ), 2048}; pg8::gemm_phase<pg8::EpiB16, pg8::StaticOrder, true, true>(lds, g, S, e); }
    xcd_barrier(bar);
    STAMP(9);
    phase5b(p, lds, tid, lane, wave);
    xcd_barrier(bar);
#if REPEAT_PHASE == 5
    phase5b(p, lds, tid, lane, wave);
    xcd_barrier(bar);
#endif
    STAMP(10);
#if REPEAT_PHASE == 9
    for (int i = 0; i < 10; ++i) xcd_barrier(bar);
#endif
    phase6(p, lds, tid, lane, wave);
#if REPEAT_PHASE == 6
    xcd_barrier(bar);
    phase6(p, lds, tid, lane, wave);
#endif
#ifdef TIMING
    xcd_barrier(bar);
    STAMP(11);
    xcd_barrier(bar);
    timing_emit(p, tid);
#endif
#ifdef CHK_PEER
    xcd_barrier(bar);
    STAMP(11);
    check_peer(p, lds, tid, lane, wave);
    xcd_barrier(bar);
    STAMP(12);
    check_emit(p, tid);
#endif
#endif
}

extern "C" void kernel_launch(void* const* d_in, const int* in_sizes, int n_in, void* d_out, int out_size, void* d_ws, size_t ws_size, hipStream_t stream) {
    static int grid = 0;
    if (grid == 0) {
        if (n_in != 21 || out_size != T * D || ws_size < WS_END) { fprintf(stderr, "kernel_launch: unexpected shapes (n_in %d out %d ws %zu need %zu)\n", n_in, out_size, ws_size, (size_t)WS_END); grid = -1; return; }
        int dev = 0, cus = 0, per_cu = 0;
        hipGetDevice(&dev); hipDeviceGetAttribute(&cus, hipDeviceAttributeMultiprocessorCount, dev);
        hipFuncSetAttribute((const void*)fwd_megakernel, hipFuncAttributeMaxDynamicSharedMemorySize, LDS_BYTES);
        hipOccupancyMaxActiveBlocksPerMultiprocessor(&per_cu, (const void*)fwd_megakernel, NTH, LDS_BYTES);
        (void)hipGetLastError();
        if (per_cu < 1) fprintf(stderr, "kernel_launch: occupancy query says %d blocks per CU\n", per_cu);
        grid = cus;
    }
    if (grid < 0) return;
    hipMemsetAsync((char*)d_ws + WS_CTL, 0, 64 * 1024, stream);
    Params p{};
    for (int i = 0; i < 21; ++i) p.in[i] = (const float*)d_in[i];
    p.out = (float*)d_out; p.ws = (unsigned char*)d_ws;
    hipLaunchKernelGGL(fwd_megakernel, dim3(grid), dim3(NTH), LDS_BYTES, stream, p);
}
```

```cpp
#ifndef REPEAT_PHASE
#define REPEAT_PHASE -1
#endif
#include <hip/hip_runtime.h>
#include <cstdio>
#include <cstdint>

#define DI __device__ __forceinline__
#define LAS __attribute__((address_space(3)))
typedef unsigned short bf16_t;
typedef short bf16x8 __attribute__((ext_vector_type(8)));
typedef float f32x4 __attribute__((ext_vector_type(4)));
typedef float f32x2 __attribute__((ext_vector_type(2)));
typedef float f32x16 __attribute__((ext_vector_type(16)));
typedef unsigned u32x4 __attribute__((ext_vector_type(4)));
typedef unsigned u32x2 __attribute__((ext_vector_type(2)));
typedef __bf16 bf16x2v __attribute__((ext_vector_type(2)));

constexpr int T = 32768, D = 1024, SEQ = 4096, NB = 8;
constexpr int NTH = 512, NWV = 8;
constexpr int ZW = 2048;
constexpr int NIN = 2176;
constexpr float EPS = 1e-6f;

constexpr size_t MB = 1024 * 1024;
constexpr size_t WS_CTL   = 0;
constexpr size_t WS_MODP  = 64 * 1024;
constexpr size_t WS_WIN   = WS_MODP + 8 * 8 * 6144 * 4;
constexpr size_t WS_WOUT  = WS_WIN + (size_t)NIN * 1024 * 2;
constexpr size_t WS_WQ    = WS_WOUT + 1024 * 1024 * 2;
constexpr size_t WS_SKB   = WS_WQ + 2048 * 1024 * 2;
constexpr size_t WS_WP    = WS_SKB + 16 * 128 * 128 * 2;
constexpr size_t WS_AFB   = WS_WP + 4 * 128 * 128 * 2;
constexpr size_t WS_UB    = WS_AFB + (size_t)T * 32 * 4;
constexpr size_t WS_VB    = WS_UB + 32 * MB;
constexpr size_t WS_SU    = WS_UB + 16 * MB, WS_SV = WS_VB + 16 * MB;
constexpr size_t WS_RA    = WS_VB + 32 * MB;
constexpr size_t WS_RZ    = WS_RA + 64 * MB;
constexpr size_t WS_RS    = WS_RZ + 128 * MB;
constexpr size_t WS_RO    = WS_RS + 6 * 16 * MB + 1 * MB;
constexpr size_t WS_END   = WS_RO + 128 * MB;
static_assert(WS_END <= 512 * MB, "workspace too large");

struct Params { const float* in[21]; float* out; unsigned char* ws; };

DI unsigned pk2(float a, float b) { f32x2 f = {a, b}; bf16x2v h = __builtin_convertvector(f, bf16x2v); return __builtin_bit_cast(unsigned, h); }
DI float dot2bf(unsigned a, unsigned b, float c) { return __builtin_amdgcn_fdot2_f32_bf16(__builtin_bit_cast(bf16x2v, a), __builtin_bit_cast(bf16x2v, b), c, false); }
DI float bflo(unsigned u) { return __uint_as_float(u << 16); }
DI float bfhi(unsigned u) { return __uint_as_float(u & 0xFFFF0000u); }
DI float wave_sum(float v) {
#pragma unroll
    for (int o = 1; o < 64; o <<= 1) v += __shfl_xor(v, o);
    return v;
}
DI bf16x8 ld_frag16(const bf16_t* p) { return __builtin_bit_cast(bf16x8, *(const u32x4*)p); }
DI bf16x8 ld_frag_perm(const bf16_t* p, int g) {
    const u32x2 lo = *(const u32x2*)(p + 4 * g), hi = *(const u32x2*)(p + 16 + 4 * g);
    u32x4 v = {lo.x, lo.y, hi.x, hi.y}; return __builtin_bit_cast(bf16x8, v);
}
DI int perm32(int k) { return (k & ~31) | (((k >> 2) & 3) << 3) | (((k >> 4) & 1) << 2) | (k & 3); }
DI bf16x8 pack8(const f32x4& a, const f32x4& b) { u32x4 v = {pk2(a[0], a[1]), pk2(a[2], a[3]), pk2(b[0], b[1]), pk2(b[2], b[3])}; return __builtin_bit_cast(bf16x8, v); }
#define MFMA16(a, b, c) __builtin_amdgcn_mfma_f32_16x16x32_bf16((a), (b), (c), 0, 0, 0)
#define MFMA32(a, b, c) __builtin_amdgcn_mfma_f32_32x32x16_bf16((a), (b), (c), 0, 0, 0)

#define XB_TMO      128
#define XB_XCNT(j)  (256  + 64 * (j))
#define XB_XSUB(j)  (1280 + 64 * (j))
#define XB_XGEN(j)  (2304 + 64 * (j))
#define XB_TOP      3328
#define XB_TOPGEN   3392
#define XCD_BAR_WORDS 3456
#define XB_SPIN_CAP (1u << 22)
DI unsigned xb_ld(unsigned* p)              { return __hip_atomic_load(p, __ATOMIC_RELAXED, __HIP_MEMORY_SCOPE_AGENT); }
DI unsigned xb_add(unsigned* p, unsigned v) { return __hip_atomic_fetch_add(p, v, __ATOMIC_RELAXED, __HIP_MEMORY_SCOPE_AGENT); }
DI unsigned xb_xcc_id() { return (unsigned)__builtin_amdgcn_s_getreg((3 << 11) | 20) & 0xFu; }
#define XB_SPIN(cond, bar) do { unsigned _sp = 0; while (cond) { __builtin_amdgcn_s_sleep(1); \
    if ((++_sp & 255u) == 0u) { if (xb_ld(&(bar)[XB_TMO])) break; if (_sp > XB_SPIN_CAP) { atomicAdd(&(bar)[XB_TMO], 1u); break; } } } } while (0)
struct XcdBarrier { unsigned* bar; unsigned x; volatile LAS unsigned* st; };
DI XcdBarrier xcd_barrier_post(unsigned* bar, volatile LAS unsigned* st) {
    XcdBarrier b; b.bar = bar; b.x = xb_xcc_id(); b.st = st;
    if (threadIdx.x == 0) (void)xb_add(&bar[XB_XCNT(b.x)], 1u);
    return b;
}
DI void xcd_barrier_complete(unsigned* bar, unsigned x, unsigned& nloc, unsigned& nx) {
    const unsigned G = gridDim.x * gridDim.y * gridDim.z;
    unsigned sum, cnt, mine, sp = 0u;
    for (;;) {
        sum = 0u; cnt = 0u; mine = 0u;
#pragma unroll
        for (unsigned j = 0; j < 16; ++j) { const unsigned c = xb_ld(&bar[XB_XCNT(j)]); sum += c; cnt += (c > 0u) ? 1u : 0u; mine = (j == x) ? c : mine; }
        if (sum == G) break;
        __builtin_amdgcn_s_sleep(1);
        if ((++sp & 255u) == 0u) { if (xb_ld(&bar[XB_TMO])) break; if (sp > XB_SPIN_CAP) { atomicAdd(&bar[XB_TMO], 1u); break; } }
    }
    nloc = mine > 0u ? mine : 1u; nx = cnt > 0u ? cnt : 1u;
}
DI void xcd_barrier(const XcdBarrier& b) {
    asm volatile("s_waitcnt vmcnt(0)" ::: "memory");
    __syncthreads();
    if (threadIdx.x == 0) {
        unsigned* bar = b.bar;
        __builtin_amdgcn_s_waitcnt(0);
        unsigned nloc = b.st[0], nx = b.st[1];
        if (nloc == 0u) { xcd_barrier_complete(bar, b.x, nloc, nx); b.st[0] = nloc; b.st[1] = nx; }
        const unsigned old = xb_add(&bar[XB_XSUB(b.x)], 1u);
        const unsigned gen = old / nloc;
        if (old + 1u == (gen + 1u) * nloc) {
            __builtin_amdgcn_fence(__ATOMIC_RELEASE, "agent");
            asm volatile("s_waitcnt vmcnt(0)" ::: "memory");
            const unsigned og = xb_add(&bar[XB_TOP], 1u);
            const unsigned tg = og / nx;
            if (og + 1u == (tg + 1u) * nx) xb_add(&bar[XB_TOPGEN], 1u);
            else XB_SPIN(xb_ld(&bar[XB_TOPGEN]) == tg, bar);
            __builtin_amdgcn_fence(__ATOMIC_ACQUIRE, "agent");
            xb_add(&bar[XB_XGEN(b.x)], 1u);
            asm volatile("s_waitcnt vmcnt(0)" ::: "memory");
        } else {
            XB_SPIN(xb_ld(&bar[XB_XGEN(b.x)]) == gen, bar);
            __builtin_amdgcn_fence(__ATOMIC_ACQUIRE, "agent");
            asm volatile("s_waitcnt vmcnt(0)" ::: "memory");
        }
    }
    __syncthreads();
}

constexpr int LDS_BYTES = 152 * 1024;
constexpr int LDS_BARW = LDS_BYTES - 16;

DI void p0_transpose_item(const float* W, int ldw, int K, bf16_t* WT, int dst_row0, int src_col0, float scale, bool zero, LAS float* scr, int kb, int lane) {
    const int k0 = 64 * kb;
#pragma unroll 8
    for (int i = 0; i < 32; ++i) { const int kk = 2 * i + (lane >> 5); scr[kk * 33 + (lane & 31)] = zero ? 0.f : W[(size_t)(k0 + kk) * ldw + src_col0 + (lane & 31)] * scale; }
    asm volatile("s_waitcnt lgkmcnt(0)" ::: "memory");
    const int c = lane & 7;
#pragma unroll
    for (int j = 0; j < 4; ++j) { const int n = (lane >> 3) + 8 * j; const LAS float* s = scr + (8 * c) * 33 + n;
        u32x4 o; o.x = pk2(s[0 * 33], s[1 * 33]); o.y = pk2(s[2 * 33], s[3 * 33]); o.z = pk2(s[4 * 33], s[5 * 33]); o.w = pk2(s[6 * 33], s[7 * 33]);
        *(u32x4*)(WT + (size_t)(dst_row0 + n) * K + k0 + 8 * c) = o; }
    asm volatile("s_waitcnt lgkmcnt(0)" ::: "memory");
}

DI void phase0(const Params& p, LAS unsigned char* lds, int tid, int lane, int wave) {
    asm volatile("" : "+v"(tid), "+v"(lane));
    unsigned char* ws = p.ws;
    LAS float* sl = (LAS float*)lds;
    LAS float* scr = (LAS float*)(lds + 32768 + wave * 8448);
    const float* c = p.in[1];
    for (int e = tid; e < 8192; e += NTH) { const int b = e >> 10, k = e & 1023; const float v = c[e]; sl[k * 8 + b] = v / (1.f + __expf(-v)); }
    __syncthreads();
    const int gw = wave * gridDim.x + blockIdx.x, NGW = gridDim.x * NWV;
    constexpr int I_MOD = 768, I_WIN = 16 * 68, I_WOUT = 16 * 32, I_WQ = 16 * 64, I_WP = 32;
    constexpr int NITEMS = I_MOD + I_WIN + I_WOUT + I_WQ + I_WP;
    for (int it = gw; it < NITEMS; it += NGW) {
        int r = it;
        if (r < I_MOD) {
            const int cg = r % 96, ks = r / 96, n = cg * 64 + lane, k0 = ks * 128;
            const float* W = p.in[2] + (size_t)k0 * 6144 + n;
            float acc[8];
#pragma unroll
            for (int b = 0; b < 8; ++b) acc[b] = 0.f;
#pragma unroll 8
            for (int k = 0; k < 128; ++k) {
                const float w = W[(size_t)k * 6144];
                const f32x4 s0 = *(const LAS f32x4*)(sl + (k0 + k) * 8), s1 = *(const LAS f32x4*)(sl + (k0 + k) * 8 + 4);
                acc[0] += s0[0] * w; acc[1] += s0[1] * w; acc[2] += s0[2] * w; acc[3] += s0[3] * w;
                acc[4] += s1[0] * w; acc[5] += s1[1] * w; acc[6] += s1[2] * w; acc[7] += s1[3] * w;
            }
            float* mp = (float*)(ws + WS_MODP) + (size_t)ks * 8 * 6144 + n;
#pragma unroll
            for (int b = 0; b < 8; ++b) mp[b * 6144] = acc[b];
            continue;
        }
        r -= I_MOD;
        if (r < I_WIN) {
            const int kb = r / 68, nb = r % 68, n0 = nb * 32;
            int src; bool zero = false; float scale = 1.f;
            if (n0 < 1536) { src = n0; if (n0 < 256) scale = 0.125f; } else if (n0 < 2048) src = n0 + 32; else if (n0 < 2080) src = 1536 + (n0 - 2048); else { src = 0; zero = true; }
            p0_transpose_item(p.in[6], 2080, 1024, (bf16_t*)(ws + WS_WIN), n0, src, scale, zero, scr, kb, lane);
            continue;
        }
        r -= I_WIN;
        if (r < I_WOUT) { p0_transpose_item(p.in[14], 1024, 1024, (bf16_t*)(ws + WS_WOUT), (r % 32) * 32, (r % 32) * 32, 1.f, false, scr, r / 32, lane); continue; }
        r -= I_WOUT;
        if (r < I_WQ) { p0_transpose_item(p.in[17], 2048, 1024, (bf16_t*)(ws + WS_WQ), (r % 64) * 32, (r % 64) * 32, 1.f, false, scr, r / 64, lane); continue; }
        r -= I_WQ;
        { const int g = r >> 3, kb = (r >> 2) & 1, nb = r & 3;
          p0_transpose_item(p.in[12] + g * 16384, 128, 128, (bf16_t*)(ws + WS_WP) + g * 16384, nb * 32, nb * 32, 1.f, false, scr, kb, lane); }
    }
    const size_t gt = (size_t)blockIdx.x * NTH + tid, NGT = (size_t)gridDim.x * NTH;
    constexpr size_t NSK = (size_t)16 * 128 * 128 / 8;
    for (size_t j = gt; j < NSK; j += NGT) {
        const float* src = p.in[18]; bf16_t* dst = (bf16_t*)(ws + WS_SKB);
        const f32x4 a = *(const f32x4*)(src + j * 8), b = *(const f32x4*)(src + j * 8 + 4);
        u32x4 o = {pk2(a[0], a[1]), pk2(a[2], a[3]), pk2(b[0], b[1]), pk2(b[2], b[3])};
        *(u32x4*)(dst + j * 8) = o;
    }
}

DI void quant_load(const Params& p, int row, int lane, f32x4 (&v)[4]) {
    const int tb = row >> 14, e = row & 16383;
    const float* src = (tb ? p.in[20] : p.in[19]) + (size_t)e * D + 16 * lane;
#pragma unroll
    for (int q = 0; q < 4; ++q) v[q] = *(const f32x4*)(src + 4 * q);
}
DI void quant_store(const Params& p, int row, int lane, const f32x4 (&v)[4]) {
    unsigned char* ws = p.ws;
    const int tb = row >> 14, e = row & 16383;
    float m = 0.f;
#pragma unroll
    for (int q = 0; q < 4; ++q) m = fmaxf(m, fmaxf(fmaxf(fabsf(v[q][0]), fabsf(v[q][1])), fmaxf(fabsf(v[q][2]), fabsf(v[q][3]))));
#pragma unroll
    for (int o = 1; o < 64; o <<= 1) m = fmaxf(m, __shfl_xor(m, o));
    int ex = (int)((__float_as_uint(m) >> 23) & 0xFFu) - 127;
    if (m < 1e-30f) ex = 7;
    const float sc = __uint_as_float((unsigned)(127 + 7 - ex) << 23), isc = __uint_as_float((unsigned)(127 - 7 + ex) << 23);
    u32x4 o;
    if (tb) {
#pragma unroll
        for (int q = 0; q < 4; ++q) { int w = 0; w = __builtin_amdgcn_cvt_pk_fp8_f32(v[q][0] * sc, v[q][1] * sc, w, false); w = __builtin_amdgcn_cvt_pk_fp8_f32(v[q][2] * sc, v[q][3] * sc, w, true); o[q] = (unsigned)w; }
        if (lane == 0) ((float*)(ws + WS_SV))[e] = isc;
    } else {
        const float s8 = m > 1e-30f ? 127.f / m : 0.f;
#pragma unroll
        for (int q = 0; q < 4; ++q) {
            const int q0 = __float2int_rn(v[q][0] * s8), q1 = __float2int_rn(v[q][1] * s8), q2 = __float2int_rn(v[q][2] * s8), q3 = __float2int_rn(v[q][3] * s8);
            o[q] = (unsigned)(q0 & 0xFF) | ((unsigned)(q1 & 0xFF) << 8) | ((unsigned)(q2 & 0xFF) << 16) | ((unsigned)q3 << 24);
        }
        if (lane == 0) ((float*)(ws + WS_SU))[e] = m * (1.f / 127.f);
    }
    *(u32x4*)(ws + (tb ? WS_VB : WS_UB) + (size_t)e * 1024 + 16 * lane) = o;
}

DI float mod_at(const Params& p, int b, int n) {
    const float* mp = (const float*)(p.ws + WS_MODP) + (size_t)b * 6144 + n;
    float s = p.in[3][n];
#pragma unroll
    for (int ks = 0; ks < 8; ++ks) s += mp[(size_t)ks * 8 * 6144];
    return s;
}

DI void phase1(const Params& p, LAS unsigned char* lds, int tid, int lane, int wave) {
    asm volatile("" : "+v"(tid), "+v"(lane));
    LAS float* lA = (LAS float*)lds; LAS float* lB = lA + 1024;
    const float* x = p.in[0]; bf16_t* H = (bf16_t*)(p.ws + WS_RA);
    for (int rt = blockIdx.x; rt < T / 128; rt += gridDim.x) {
        const int b = rt / 32;
        __syncthreads();
        for (int d = tid; d < 1024; d += NTH) { lA[d] = p.in[4][d] * (1.f + mod_at(p, b, 1024 + d)); lB[d] = mod_at(p, b, d); }
        __syncthreads();
        for (int r0 = wave; r0 < 128; r0 += 4 * NWV) {
            f32x4 v[4][4];
#pragma unroll
            for (int u = 0; u < 4; ++u) { const f32x4* xr = (const f32x4*)(x + ((size_t)rt * 128 + r0 + u * NWV) * D) + lane;
#pragma unroll
                for (int j = 0; j < 4; ++j) v[u][j] = xr[64 * j]; }
#pragma unroll
            for (int u = 0; u < 4; ++u) {
                const size_t row = (size_t)rt * 128 + r0 + u * NWV;
                float ss = 0.f;
#pragma unroll
                for (int j = 0; j < 4; ++j) ss += v[u][j][0] * v[u][j][0] + v[u][j][1] * v[u][j][1] + v[u][j][2] * v[u][j][2] + v[u][j][3] * v[u][j][3];
                const float rstd = rsqrtf(wave_sum(ss) * (1.f / D) + EPS);
                u32x2* o = (u32x2*)(H + row * D) + lane;
#pragma unroll
                for (int j = 0; j < 4; ++j) {
                    const f32x4 a = *(const LAS f32x4*)(lA + 4 * lane + 256 * j), bb = *(const LAS f32x4*)(lB + 4 * lane + 256 * j);
                    u32x2 w = {pk2(v[u][j][0] * rstd * a[0] + bb[0], v[u][j][1] * rstd * a[1] + bb[1]), pk2(v[u][j][2] * rstd * a[2] + bb[2], v[u][j][3] * rstd * a[3] + bb[3])};
                    o[64 * j] = w;
                }
            }
        }
    }
}

struct EpiZ {
    bf16_t* Z; float* AFB;
    DI void operator()(int m, int n, const f32x4& v) const {
        if (n < ZW) { u32x2 w = {pk2(v[0], v[1]), pk2(v[2], v[3])}; *(u32x2*)(Z + (size_t)m * ZW + n) = w; }
        else if (n < ZW + 32) { *(f32x4*)(AFB + (size_t)m * 32 + (n - ZW)) = v; }
    }
};
struct EpiF32 { float* C; int ldc; DI void operator()(int m, int n, const f32x4& v) const { *(f32x4*)(C + (size_t)m * ldc + n) = v; } };
struct EpiBf16 { bf16_t* C; int ldc; DI void operator()(int m, int n, const f32x4& v) const { u32x2 w = {pk2(v[0], v[1]), pk2(v[2], v[3])}; *(u32x2*)(C + (size_t)m * ldc + n) = w; } };

template <class Epi>
DI void gemm_phase(const bf16_t* A, const bf16_t* Bt, int M, int N, int K, const Epi& epi, LAS unsigned char* lds, int tid, int lane, int wave, int nt_first = 0) {
    constexpr int BM = 256, BN = 128, BK = 64, STAGE = (BM + BN) * 128;
    const int ntn = N / BN - nt_first, ntiles = (M / BM) * ntn, nk = K / BK;
    const int wm = wave & 3, wn = wave >> 2, c15 = lane & 15, g = lane >> 4;
    const int lrow = tid >> 3, lch = tid & 7;
    for (int tile = blockIdx.x; tile < ntiles; tile += gridDim.x) {
        const int m0 = (tile / ntn) * BM, n0 = (tile % ntn + nt_first) * BN;
        f32x4 acc[4][4];
#pragma unroll
        for (int i = 0; i < 4; ++i)
#pragma unroll
            for (int j = 0; j < 4; ++j) acc[i][j] = (f32x4){0.f, 0.f, 0.f, 0.f};
        u32x4 ra[4], rb[2];
        const bf16_t* Ag = A + (size_t)(m0 + lrow) * K + lch * 8;
        const bf16_t* Bg = Bt + (size_t)(n0 + lrow) * K + lch * 8;
        const int woff = lrow * 128 + ((lch ^ (lrow & 7)) * 16);
        __syncthreads();
#pragma unroll
        for (int ps = 0; ps < 4; ++ps) ra[ps] = *(const u32x4*)(Ag + (size_t)(64 * ps) * K);
#pragma unroll
        for (int ps = 0; ps < 2; ++ps) rb[ps] = *(const u32x4*)(Bg + (size_t)(64 * ps) * K);
#pragma unroll
        for (int ps = 0; ps < 4; ++ps) *(LAS u32x4*)(lds + woff + ps * 8192) = ra[ps];
#pragma unroll
        for (int ps = 0; ps < 2; ++ps) *(LAS u32x4*)(lds + BM * 128 + woff + ps * 8192) = rb[ps];
        __syncthreads();
        for (int kt = 0; kt < nk; ++kt) {
            const bool more = (kt + 1 < nk);
            if (more) {
#pragma unroll
                for (int ps = 0; ps < 4; ++ps) ra[ps] = *(const u32x4*)(Ag + (size_t)(64 * ps) * K + (kt + 1) * BK);
#pragma unroll
                for (int ps = 0; ps < 2; ++ps) rb[ps] = *(const u32x4*)(Bg + (size_t)(64 * ps) * K + (kt + 1) * BK);
            }
            LAS unsigned char* sa = lds + (kt & 1) * STAGE; LAS unsigned char* sb = sa + BM * 128;
#pragma unroll
            for (int s = 0; s < 2; ++s) {
                bf16x8 fa[4], fb[4];
#pragma unroll
                for (int i = 0; i < 4; ++i) { const int row = wm * 64 + i * 16 + c15; fa[i] = *(const LAS bf16x8*)(sa + row * 128 + (((4 * s + g) ^ (row & 7)) * 16)); }
#pragma unroll
                for (int j = 0; j < 4; ++j) { const int row = wn * 64 + j * 16 + c15; fb[j] = *(const LAS bf16x8*)(sb + row * 128 + (((4 * s + g) ^ (row & 7)) * 16)); }
#pragma unroll
                for (int i = 0; i < 4; ++i)
#pragma unroll
                    for (int j = 0; j < 4; ++j) acc[i][j] = MFMA16(fb[j], fa[i], acc[i][j]);
            }
            if (more) {
                LAS unsigned char* da = lds + ((kt + 1) & 1) * STAGE;
#pragma unroll
                for (int ps = 0; ps < 4; ++ps) *(LAS u32x4*)(da + woff + ps * 8192) = ra[ps];
#pragma unroll
                for (int ps = 0; ps < 2; ++ps) *(LAS u32x4*)(da + BM * 128 + woff + ps * 8192) = rb[ps];
            }
            __syncthreads();
        }
#pragma unroll
        for (int i = 0; i < 4; ++i)
#pragma unroll
            for (int j = 0; j < 4; ++j) epi(m0 + wm * 64 + i * 16 + c15, n0 + wn * 64 + j * 16 + 4 * g, acc[i][j]);
    }
}

namespace pg8 {
#define PG8_LAS __attribute__((address_space(3)))
constexpr int BM = 256, BK = 64, HALF = 128, HTB = HALF * BK * 2  , STAGE_BYTES = 8 * HTB, NXCD = 8, WGM = 8;

__host__ __device__ __forceinline__ int lds_byte(int r, int c) { const int st = (r >> 4) * 2 + (c >> 5), rr = r & 15, cc = c & 31, ob = rr * 64 + cc * 2; return st * 1024 + (ob ^ (((ob >> 9) & 1) << 5)); }
__host__ __device__ __forceinline__ void stage_rc(int b, int& R, int& C) { const int st = b / 1024, sb = b % 1024, swz = sb ^ (((sb >> 9) & 1) << 5); R = (st >> 1) * 16 + swz / 64; C = (st & 1) * 32 + (swz % 64) / 2; }
__host__ __device__ __forceinline__ int perm32(int rho) { const int n = rho >> 4, i = rho & 15; return 8 * (i >> 2) + 4 * n + (i & 3); }

struct Unit { int pm, pn; };
struct Gemm { const bf16_t* A; const bf16_t* Bt; int M, N, K; };

struct StaticOrder {
    int nM, nN, nwg, G, c;
    __host__ __device__ void init(int M, int N, int G_, int c_) { nM = M / BM; nN = N / BM; nwg = nM * nN; G = G_; c = c_; }
    __host__ __device__ bool next(int i, Unit& u) const {
        const long L = (long)i * G + c; if (L >= nwg) return false;
        int wgid = (int)L; { const int q = nwg / NXCD, r = nwg % NXCD, xcd = wgid % NXCD, off = wgid / NXCD; wgid = (xcd < r ? xcd * (q + 1) : r * (q + 1) + (xcd - r) * q) + off; }
        const int nig = WGM * nN, gid = wgid / nig, fm = gid * WGM, gsz = (nM - fm) < WGM ? (nM - fm) : WGM;
        u.pm = fm + ((wgid % nig) % gsz); u.pn = (wgid % nig) / gsz; return true;
    }
    __device__ __forceinline__ void a_ready(const Unit&) const {}
    __device__ __forceinline__ void done(const Unit&) const {}
};

struct EpiB16 {
    static constexpr bool PERM = true, AFTER_DRAIN = false;
    bf16_t* O; int ldc;
    __device__ __forceinline__ void operator()(const f32x4 (&acc)[2][2][4][2], const Unit& u, int wr, int wc, int fr, int fq) const {
#pragma unroll
        for (int ai = 0; ai < 2; ++ai)
#pragma unroll
            for (int m = 0; m < 4; ++m) { bf16_t* rowp = O + (size_t)(u.pm * BM + ai * HALF + wr * 64 + m * 16 + fr) * ldc + u.pn * BM + wc * 32 + 8 * fq;
#pragma unroll
                for (int bj = 0; bj < 2; ++bj) { const f32x4 v0 = acc[ai][bj][m][0], v1 = acc[ai][bj][m][1];
                    u32x4 w; w.x = ::pk2(v0[0], v0[1]); w.y = ::pk2(v0[2], v0[3]); w.z = ::pk2(v1[0], v1[1]); w.w = ::pk2(v1[2], v1[3]);
                    *(u32x4*)(rowp + bj * HALF) = w; } }
    }
};
struct EpiF {
    static constexpr bool PERM = false, AFTER_DRAIN = false;
    float* O; int ldc;
    __device__ __forceinline__ void operator()(const f32x4 (&acc)[2][2][4][2], const Unit& u, int wr, int wc, int fr, int fq) const {
#pragma unroll
        for (int ai = 0; ai < 2; ++ai)
#pragma unroll
            for (int m = 0; m < 4; ++m) { float* rowp = O + (size_t)(u.pm * BM + ai * HALF + wr * 64 + m * 16 + fr) * ldc + u.pn * BM + wc * 32 + 4 * fq;
#pragma unroll
                for (int bj = 0; bj < 2; ++bj)
#pragma unroll
                    for (int n = 0; n < 2; ++n) *(f32x4*)(rowp + bj * HALF + 16 * n) = acc[ai][bj][m][n]; }
    }
};
template <class Epi, class Sched, bool ALIGN_EPI = false, bool SP2 = false>
__device__ __forceinline__ void gemm_phase(PG8_LAS unsigned char* lds, const Gemm g, const Sched& S, const Epi& E) {
    const int tid = threadIdx.x, wid = __builtin_amdgcn_readfirstlane(tid >> 6), lane = tid & 63, wr = wid >> 2, wc = wid & 3, fr = lane & 15, fq = lane >> 4;
    const int K = g.K, nt = K / BK;
    unsigned voffA[2], voffB[2];
#pragma unroll
    for (int i = 0; i < 2; ++i) { int R, C; stage_rc(tid * 16 + i * 8192, R, C); const int Rb = Epi::PERM ? ((R & ~31) + perm32(R & 31)) : R;
        voffA[i] = (unsigned)(R * K + C) * 2u; voffB[i] = (unsigned)(Rb * K + C) * 2u; }
    const size_t kstep = (size_t)(BK * 2);
    const size_t hstep = (size_t)HALF * K * 2;
    const size_t tstep = 2 * hstep;
    const unsigned ldsw = (unsigned)wid * 1024u;
    const int aoff = lds_byte(wr * 64 + fr, fq * 8), boff = lds_byte(wc * 32 + fr, fq * 8);
#define PG8_SA(b, h) (((b) * 2 + (h)) * HTB)
#define PG8_SB(b, h) ((4 + (b) * 2 + (h)) * HTB)
#define PG8_STAGE(bufoff, gbase, voff) do { _Pragma("unroll") for (int _i = 0; _i < 2; ++_i) \
        __builtin_amdgcn_global_load_lds((const unsigned*)((const char*)(gbase) + (voff)[_i]), (PG8_LAS unsigned*)(lds + (bufoff) + ldsw + _i * 8192), 16, 0, 0); } while (0)
#define PG8_LDA(dst, b, h) do { _Pragma("unroll") for (int m = 0; m < 4; ++m) _Pragma("unroll") for (int k = 0; k < 2; ++k) dst[m][k] = *(const PG8_LAS bf16x8*)(lds + PG8_SA(b, h) + aoff + m * 2048 + k * 1024); } while (0)
#define PG8_LDB(dst, b, h) do { _Pragma("unroll") for (int n = 0; n < 2; ++n) _Pragma("unroll") for (int k = 0; k < 2; ++k) dst[n][k] = *(const PG8_LAS bf16x8*)(lds + PG8_SB(b, h) + boff + n * 2048 + k * 1024); } while (0)
#define PG8_MMA(ai, bj, At, Bt) do { __builtin_amdgcn_s_setprio(1); _Pragma("unroll") for (int m = 0; m < 4; ++m) _Pragma("unroll") for (int n = 0; n < 2; ++n) _Pragma("unroll") for (int k = 0; k < 2; ++k) \
        acc[ai][bj][m][n] = __builtin_amdgcn_mfma_f32_16x16x32_bf16(Bt[n][k], At[m][k], acc[ai][bj][m][n], 0, 0, 0); __builtin_amdgcn_s_setprio(0); } while (0)
#define PG8_WAIT_V(n) asm volatile("s_waitcnt vmcnt(" #n ")" ::: "memory")
#define PG8_WAIT_L(n) asm volatile("s_waitcnt lgkmcnt(" #n ")" ::: "memory")
#define PG8_BAR __builtin_amdgcn_s_barrier()
#define PG8_SCHED __builtin_amdgcn_sched_barrier(0)
    Unit cur, nxt; int ui = 0;
    if (!S.next(0, cur)) return;
    f32x4 acc[2][2][4][2];
#pragma unroll
    for (int a = 0; a < 2; ++a)
#pragma unroll
        for (int b = 0; b < 2; ++b)
#pragma unroll
            for (int m = 0; m < 4; ++m)
#pragma unroll
                for (int n = 0; n < 2; ++n) acc[a][b][m][n] = (f32x4){0.f, 0.f, 0.f, 0.f};
    bf16x8 At[4][2], B0[2][2], B1[2][2];
    const char* cA = (const char*)g.A + (size_t)cur.pm * tstep; const char* cB = (const char*)g.Bt + (size_t)cur.pn * tstep;
    S.a_ready(cur);
    if constexpr (SP2) {
        PG8_STAGE(PG8_SB(0, 0), cB, voffB); PG8_STAGE(PG8_SB(0, 1), cB + hstep, voffB); PG8_STAGE(PG8_SA(0, 0), cA, voffA); PG8_STAGE(PG8_SA(0, 1), cA + hstep, voffA);
        if (wr == 1) PG8_BAR;
        PG8_WAIT_V(2); PG8_BAR;
        PG8_STAGE(PG8_SB(1, 0), cB + kstep, voffB); PG8_STAGE(PG8_SA(1, 0), cA + kstep, voffA); PG8_STAGE(PG8_SB(1, 1), cB + hstep + kstep, voffB);
        PG8_WAIT_V(6); PG8_BAR;
    } else {
        PG8_STAGE(PG8_SB(0, 0), cB, voffB); PG8_STAGE(PG8_SA(0, 0), cA, voffA); PG8_STAGE(PG8_SB(0, 1), cB + hstep, voffB); PG8_STAGE(PG8_SA(0, 1), cA + hstep, voffA);
        if (wr == 1) PG8_BAR;
        PG8_WAIT_V(4); PG8_BAR;
        PG8_STAGE(PG8_SB(1, 0), cB + kstep, voffB); PG8_STAGE(PG8_SA(1, 0), cA + kstep, voffA); PG8_STAGE(PG8_SB(1, 1), cB + hstep + kstep, voffB);
        PG8_WAIT_V(6); PG8_BAR;
    }
    for (;;) {
        const bool has_next = S.next(ui + 1, nxt);
        const char* nA = has_next ? (const char*)g.A + (size_t)nxt.pm * tstep : cA; const char* nB = has_next ? (const char*)g.Bt + (size_t)nxt.pn * tstep : cB;
        for (int t = 0; t < nt; t += 2) {
            const bool last = (t == nt - 2);
            const char* a1 = cA + (size_t)(t + 1) * kstep;
            const char* a2 = last ? nA : cA + (size_t)(t + 2) * kstep; const char* b2 = last ? nB : cB + (size_t)(t + 2) * kstep;
            const char* a3 = a2 + kstep; const char* b3 = b2 + kstep;
            if (last && has_next) S.a_ready(nxt);
            if constexpr (SP2) {
            PG8_LDB(B0, 0, 0); PG8_LDB(B1, 0, 1); PG8_SCHED; PG8_LDA(At, 0, 0); PG8_STAGE(PG8_SA(1, 1), a1 + hstep, voffA);
            PG8_WAIT_V(8); PG8_WAIT_L(0); PG8_BAR; PG8_MMA(0, 0, At, B0); PG8_MMA(0, 1, At, B1); PG8_BAR; PG8_SCHED;
            PG8_LDA(At, 0, 1); PG8_STAGE(PG8_SB(0, 0), b2, voffB); PG8_STAGE(PG8_SB(0, 1), b2 + hstep, voffB); PG8_STAGE(PG8_SA(0, 0), a2, voffA);
            PG8_WAIT_V(8); PG8_WAIT_L(0); PG8_BAR; PG8_MMA(1, 0, At, B0); PG8_MMA(1, 1, At, B1); PG8_BAR; PG8_SCHED;
            PG8_LDB(B0, 1, 0); PG8_LDB(B1, 1, 1); PG8_SCHED; PG8_LDA(At, 1, 0); PG8_STAGE(PG8_SA(0, 1), a2 + hstep, voffA);
            PG8_WAIT_V(8); PG8_WAIT_L(0); PG8_BAR; PG8_MMA(0, 0, At, B0); PG8_MMA(0, 1, At, B1); PG8_BAR; PG8_SCHED;
            PG8_LDA(At, 1, 1); PG8_STAGE(PG8_SB(1, 0), b3, voffB); PG8_STAGE(PG8_SB(1, 1), b3 + hstep, voffB); PG8_STAGE(PG8_SA(1, 0), a3, voffA);
            PG8_WAIT_V(8); PG8_WAIT_L(0); PG8_BAR; PG8_MMA(1, 0, At, B0); PG8_MMA(1, 1, At, B1); PG8_BAR; PG8_SCHED;
            } else {
            PG8_LDB(B0, 0, 0); PG8_SCHED; PG8_LDA(At, 0, 0); PG8_STAGE(PG8_SA(1, 1), a1 + hstep, voffA);
            PG8_WAIT_L(8); PG8_BAR; PG8_WAIT_L(0); PG8_MMA(0, 0, At, B0); PG8_BAR; PG8_SCHED;
            PG8_LDB(B1, 0, 1); PG8_STAGE(PG8_SB(0, 0), b2, voffB);
            PG8_BAR; PG8_WAIT_L(0); PG8_MMA(0, 1, At, B1); PG8_BAR;
            PG8_LDA(At, 0, 1); PG8_STAGE(PG8_SA(0, 0), a2, voffA);
            PG8_BAR; PG8_WAIT_L(0); PG8_MMA(1, 0, At, B0); PG8_BAR; PG8_SCHED;
            PG8_STAGE(PG8_SB(0, 1), b2 + hstep, voffB);
            PG8_WAIT_V(6); PG8_BAR; PG8_MMA(1, 1, At, B1); PG8_BAR;
            PG8_LDB(B0, 1, 0); PG8_SCHED; PG8_LDA(At, 1, 0); PG8_STAGE(PG8_SA(0, 1), a2 + hstep, voffA);
            PG8_WAIT_L(8); PG8_BAR; PG8_WAIT_L(0); PG8_MMA(0, 0, At, B0); PG8_BAR; PG8_SCHED;
            PG8_LDB(B1, 1, 1); PG8_STAGE(PG8_SB(1, 0), b3, voffB);
            PG8_BAR; PG8_WAIT_L(0); PG8_MMA(0, 1, At, B1); PG8_BAR;
            PG8_LDA(At, 1, 1); PG8_STAGE(PG8_SA(1, 0), a3, voffA);
            PG8_BAR; PG8_WAIT_L(0); PG8_MMA(1, 0, At, B0); PG8_BAR; PG8_SCHED;
            PG8_STAGE(PG8_SB(1, 1), b3 + hstep, voffB);
            PG8_WAIT_V(6); PG8_BAR; PG8_MMA(1, 1, At, B1); PG8_BAR;
            }
        }
        if constexpr (ALIGN_EPI) { if (wr == 0) PG8_BAR; }
        if constexpr (!Epi::AFTER_DRAIN) { E(acc, cur, wr, wc, fr, fq); S.done(cur); }
        if (!has_next) break;
#pragma unroll
        for (int a = 0; a < 2; ++a)
#pragma unroll
            for (int b = 0; b < 2; ++b)
#pragma unroll
                for (int m = 0; m < 4; ++m)
#pragma unroll
                    for (int n = 0; n < 2; ++n) acc[a][b][m][n] = (f32x4){0.f, 0.f, 0.f, 0.f};
        cur = nxt; cA = nA; cB = nB; ++ui;
        if constexpr (ALIGN_EPI) { if (wr == 1) PG8_BAR; }
    }
    PG8_WAIT_V(0);
    if constexpr (!ALIGN_EPI) { if (wr == 0) PG8_BAR; }
    PG8_BAR;
    if constexpr (Epi::AFTER_DRAIN) { E.fused(acc, cur, wr, wc, fr, fq, lds, wid, lane); S.done(cur); }
#undef PG8_SA
#undef PG8_SB
#undef PG8_STAGE
#undef PG8_LDA
#undef PG8_LDB
#undef PG8_MMA
#undef PG8_WAIT_V
#undef PG8_WAIT_L
#undef PG8_BAR
#undef PG8_SCHED
}
}

constexpr int NSEG = 8, SEGC = 64 / NSEG;
constexpr size_t WS_SSEG = WS_RA + 32 * MB;
constexpr size_t WS_GSEG = WS_SSEG + 16 * MB;
DI float logsig(float x) { return fminf(x, 0.f) - __logf(1.f + __expf(-fabsf(x))); }

DI void phase3a(const Params& p, LAS unsigned char* lds, int tid, int lane, int wave) {
    asm volatile("" : "+v"(tid), "+v"(lane));
    unsigned char* ws = p.ws;
    const bf16_t* Z = (const bf16_t*)(ws + WS_RZ);
    const float* AFB = (const float*)(ws + WS_AFB);
    bf16_t* QD[2] = {(bf16_t*)(ws + WS_RS), (bf16_t*)(ws + WS_RS + 48 * MB)};
    bf16_t* KI[2] = {(bf16_t*)(ws + WS_RS + 16 * MB), (bf16_t*)(ws + WS_RS + 64 * MB)};
    bf16_t* KE[2] = {(bf16_t*)(ws + WS_RS + 32 * MB), (bf16_t*)(ws + WS_RS + 80 * MB)};
    float* GAM[2] = {(float*)(ws + WS_RS + 96 * MB), (float*)(ws + WS_RS + 96 * MB + 512 * 1024)};
    bf16_t* VT = (bf16_t*)(ws + WS_RA);
    LAS float* la[2] = {(LAS float*)lds, (LAS float*)(lds + 16384)};
    LAS float* part[2] = {(LAS float*)(lds + 32768), (LAS float*)(lds + 32768 + 2048)};
    LAS bf16_t* keT[2] = {(LAS bf16_t*)(lds + 36864), (LAS bf16_t*)(lds + 36864 + 9216)};
    LAS bf16_t* vT = (LAS bf16_t*)(lds + 55296);
    const int c15 = lane & 15, g = lane >> 4;
    for (int task = blockIdx.x; task < 256; task += gridDim.x) {
      const int h = task & 3, pb = (task >> 2) & 7, b = task >> 5;
      f32x4 Sf[4], Sb[4];
#pragma unroll
      for (int kt = 0; kt < 4; ++kt) { Sf[kt] = (f32x4){0.f, 0.f, 0.f, 0.f}; Sb[kt] = (f32x4){0.f, 0.f, 0.f, 0.f}; }
      LAS float* gs = (LAS float*)(lds + 73728);
      LAS float* wl = (LAS float*)(lds + 74752);
      __syncthreads();
      if (tid < 128) gs[tid] = 0.f;
      for (int e = tid; e < 2048; e += NTH) { const int dir = e >> 10, r = (e >> 6) & 15, d = e & 63; wl[e] = (dir ? p.in[9] : p.in[7])[r * 256 + h * 64 + d]; }
      for (int ci = 0; ci < 8; ++ci) {
        const int n = pb * 8 + ci;
        const int tok0 = b * SEQ + n * 64;
        const int i = tid >> 3, dg = tid & 7, d0 = dg * 8;
        const size_t t = (size_t)tok0 + i;
        const u32x4 qv = *(const u32x4*)(Z + t * ZW + h * 64 + d0), kv = *(const u32x4*)(Z + t * ZW + 256 + h * 64 + d0);
        u32x4 vvp[2];
#pragma unroll
        for (int ps = 0; ps < 2; ++ps) { const int idx = tid + NTH * ps, vi = idx >> 4, ch = idx & 15; vvp[ps] = *(const u32x4*)(Z + ((size_t)tok0 + vi) * ZW + 512 + h * 128 + ch * 8); }
        const int qrow = ((task * 8 + ci) * NWV + wave) * 2;
        f32x4 qa[4]; quant_load(p, qrow, lane, qa);
        __syncthreads();
        {
            float af[16], ab[16];
#pragma unroll
            for (int q = 0; q < 4; ++q) { const f32x4 a = *(const f32x4*)(AFB + t * 32 + 4 * q), bb = *(const f32x4*)(AFB + t * 32 + 16 + 4 * q);
                af[4 * q] = a[0]; af[4 * q + 1] = a[1]; af[4 * q + 2] = a[2]; af[4 * q + 3] = a[3]; ab[4 * q] = bb[0]; ab[4 * q + 1] = bb[1]; ab[4 * q + 2] = bb[2]; ab[4 * q + 3] = bb[3]; }
            const LAS float* waf = wl + d0; const LAS float* wab = wl + 1024 + d0;
            float xf[8], xb[8];
#pragma unroll
            for (int e = 0; e < 8; ++e) { xf[e] = p.in[8][h * 64 + d0 + e]; xb[e] = p.in[10][h * 64 + d0 + e]; }
#pragma unroll
            for (int r = 0; r < 16; ++r) {
                const f32x4 w0 = *(const LAS f32x4*)(waf + r * 64), w1 = *(const LAS f32x4*)(waf + r * 64 + 4), v0 = *(const LAS f32x4*)(wab + r * 64), v1 = *(const LAS f32x4*)(wab + r * 64 + 4);
#pragma unroll
                for (int e = 0; e < 4; ++e) { xf[e] += af[r] * w0[e]; xf[4 + e] += af[r] * w1[e]; xb[e] += ab[r] * v0[e]; xb[4 + e] += ab[r] * v1[e]; }
            }
#pragma unroll
            for (int e = 0; e < 8; ++e) { la[0][i * 64 + d0 + e] = logsig(xf[e]) * 0.0625f; la[1][i * 64 + d0 + e] = logsig(xb[e]) * 0.0625f; }
        }
        quant_store(p, qrow, lane, qa); quant_load(p, qrow + 1, lane, qa);
        __syncthreads();
        {
            const int d = tid & 63, pt = tid >> 6;
            float run = 0.f;
#pragma unroll
            for (int j = 0; j < 8; ++j) { run += la[0][(8 * pt + j) * 64 + d]; la[0][(8 * pt + j) * 64 + d] = run; }
            part[0][pt * 64 + d] = run;
            run = 0.f;
#pragma unroll
            for (int j = 7; j >= 0; --j) { run += la[1][(8 * pt + j) * 64 + d]; la[1][(8 * pt + j) * 64 + d] = run; }
            part[1][pt * 64 + d] = run;
            __syncthreads();
            float of = 0.f, ob = 0.f;
#pragma unroll
            for (int q = 0; q < 8; ++q) { if (q < pt) of += part[0][q * 64 + d]; if (q > pt) ob += part[1][q * 64 + d]; }
#pragma unroll
            for (int j = 0; j < 8; ++j) { la[0][(8 * pt + j) * 64 + d] += of; la[1][(8 * pt + j) * 64 + d] += ob; }
        }
        quant_store(p, qrow + 1, lane, qa);
        __syncthreads();
        {
            float q[8], k[8];
#pragma unroll
            for (int e = 0; e < 4; ++e) { q[2 * e] = bflo(qv[e]); q[2 * e + 1] = bfhi(qv[e]); k[2 * e] = bflo(kv[e]); k[2 * e + 1] = bfhi(kv[e]); }
#pragma unroll
            for (int dir = 0; dir < 2; ++dir) {
                float qd[8], ki[8], ke[8];
#pragma unroll
                for (int e = 0; e < 8; ++e) {
                    const float bb = la[dir][i * 64 + d0 + e], bl = la[dir][(dir ? 0 : 63) * 64 + d0 + e];
                    qd[e] = q[e] * __expf(bb); ki[e] = k[e] * __expf(-bb); ke[e] = k[e] * __expf(bl - bb);
                    if (i == (dir ? 0 : 63)) GAM[dir][((size_t)(b * 4 + h) * 64 + n) * 64 + d0 + e] = __expf(bl);
                }
                {
                    u32x2 a0 = {pk2(qd[0], qd[1]), pk2(qd[2], qd[3])}, a1 = {pk2(qd[4], qd[5]), pk2(qd[6], qd[7])};
                    u32x2 b0 = {pk2(ki[0], ki[1]), pk2(ki[2], ki[3])}, b1 = {pk2(ki[4], ki[5]), pk2(ki[6], ki[7])};
                    *(u32x2*)(QD[dir] + t * 256 + h * 64 + perm32(d0)) = a0; *(u32x2*)(QD[dir] + t * 256 + h * 64 + perm32(d0 + 4)) = a1;
                    *(u32x2*)(KI[dir] + t * 256 + h * 64 + perm32(d0)) = b0; *(u32x2*)(KI[dir] + t * 256 + h * 64 + perm32(d0 + 4)) = b1;
                }
#pragma unroll
                for (int e = 0; e < 4; ++e) { const unsigned w = pk2(ke[2 * e], ke[2 * e + 1]); keT[dir][(d0 + 2 * e) * 72 + perm32(i)] = (bf16_t)(w & 0xFFFFu); keT[dir][(d0 + 2 * e + 1) * 72 + perm32(i)] = (bf16_t)(w >> 16); }
            }
#pragma unroll
            for (int ps = 0; ps < 2; ++ps) {
                const int idx = tid + NTH * ps, vi = idx >> 4, ch = idx & 15;
                const u32x4 vv = vvp[ps];
#pragma unroll
                for (int e = 0; e < 4; ++e) { vT[(ch * 8 + 2 * e) * 72 + perm32(vi)] = (bf16_t)(vv[e] & 0xFFFFu); vT[(ch * 8 + 2 * e + 1) * 72 + perm32(vi)] = (bf16_t)(vv[e] >> 16); }
            }
        }
        __syncthreads();
        {
            const int dk = tid >> 3, ch = tid & 7;
#pragma unroll
            for (int dir = 0; dir < 2; ++dir) {
                const u32x4 v = *(const LAS u32x4*)(keT[dir] + dk * 72 + ch * 8);
                *(u32x4*)(KE[dir] + ((size_t)(b * 64 + n) * 256 + h * 64 + dk) * 64 + ch * 8) = v;
            }
#pragma unroll
            for (int ps = 0; ps < 2; ++ps) {
                const int idx = tid + NTH * ps, dv = idx >> 3, c8 = idx & 7;
                const LAS bf16_t* s = vT + dv * 72 + c8 * 8;
                u32x4 v; v.x = s[0] | ((unsigned)s[1] << 16); v.y = s[2] | ((unsigned)s[3] << 16); v.z = s[4] | ((unsigned)s[5] << 16); v.w = s[6] | ((unsigned)s[7] << 16);
                *(u32x4*)(VT + ((size_t)(b * 64 + n) * 512 + h * 128 + dv) * 64 + c8 * 8) = v;
            }
            bf16x8 vb[2];
#pragma unroll
            for (int sk = 0; sk < 2; ++sk) vb[sk] = *(const LAS bf16x8*)(vT + (16 * wave + c15) * 72 + 32 * sk + 8 * g);
#pragma unroll
            for (int kt = 0; kt < 4; ++kt) {
                const f32x4 gf = {__expf(la[0][63 * 64 + 16 * kt + 4 * g]), __expf(la[0][63 * 64 + 16 * kt + 4 * g + 1]), __expf(la[0][63 * 64 + 16 * kt + 4 * g + 2]), __expf(la[0][63 * 64 + 16 * kt + 4 * g + 3])};
                const LAS float* gq = gs + (ci & 1) * 128 + 64 + 16 * kt + 4 * g;
                const f32x4 pb = {__expf(gq[0]), __expf(gq[1]), __expf(gq[2]), __expf(gq[3])};
                f32x4 uf = Sf[kt] * gf, ub = (f32x4){0.f, 0.f, 0.f, 0.f};
#pragma unroll
                for (int sk = 0; sk < 2; ++sk) {
                    uf = MFMA16(*(const LAS bf16x8*)(keT[0] + (16 * kt + c15) * 72 + 32 * sk + 8 * g), vb[sk], uf);
                    ub = MFMA16(*(const LAS bf16x8*)(keT[1] + (16 * kt + c15) * 72 + 32 * sk + 8 * g), vb[sk], ub);
                }
                Sf[kt] = uf;
                Sb[kt] = Sb[kt] + pb * ub;
            }
            if (tid < 64) { gs[((ci + 1) & 1) * 128 + tid] = gs[(ci & 1) * 128 + tid] + la[0][63 * 64 + tid]; gs[((ci + 1) & 1) * 128 + 64 + tid] = gs[(ci & 1) * 128 + 64 + tid] + la[1][tid]; }
        }
      }
      {
        f32x4* SSEG = (f32x4*)(ws + WS_SSEG); float* GSEG = (float*)(ws + WS_GSEG);
        const int sl = wave >> 1, nt = wave & 1;
#pragma unroll
        for (int dir = 0; dir < 2; ++dir) {
            const int bhd = b * 8 + h * 2 + dir, sg = dir ? 7 - pb : pb, tk = ((bhd * 8 + sg) << 2) | sl;
#pragma unroll
            for (int kt = 0; kt < 4; ++kt) {
                SSEG[((size_t)tk * 8 + kt * 2 + nt) * 64 + lane] = dir ? Sb[kt] : Sf[kt];
            }
        }
        __syncthreads();
        if (tid < 128) { const int dir = tid >> 6, d = tid & 63, bhd = b * 8 + h * 2 + dir, sg = dir ? 7 - pb : pb; GSEG[(bhd * 8 + sg) * 64 + d] = __expf(gs[tid]); }
      }
    }
}

template <bool FULL>
DI void phase3b(const Params& p, int lane, int wave) {
    asm volatile("" : "+v"(lane));
    unsigned char* ws = p.ws;
    const int c15 = lane & 15, g = lane >> 4;
    for (int task = blockIdx.x * NWV + wave; task < 2048; task += gridDim.x * NWV) {
        const int sl = task & 3, pair = task >> 2, sg = pair & 7, bhd = pair >> 3;
        const int dir = bhd & 1, h = (bhd >> 1) & 3, b = bhd >> 3;
        const bf16_t* QD = (const bf16_t*)(ws + WS_RS + (dir ? 48 : 0) * MB) + (size_t)b * SEQ * 256 + h * 64;
        const bf16_t* KI = (const bf16_t*)(ws + WS_RS + (dir ? 64 : 16) * MB) + (size_t)b * SEQ * 256 + h * 64;
        const bf16_t* KE = (const bf16_t*)(ws + WS_RS + (dir ? 80 : 32) * MB) + ((size_t)b * 64 * 256 + h * 64) * 64;
        const float* GAM = (const float*)(ws + WS_RS + 96 * MB + (dir ? 512 * 1024 : 0)) + (size_t)(b * 4 + h) * 64 * 64;
        const bf16_t* VT = (const bf16_t*)(ws + WS_RA) + ((size_t)b * 64 * 512 + h * 128 + sl * 32) * 64;
        bf16_t* O = (bf16_t*)(ws + WS_RO + (dir ? 64 : 0) * MB) + (size_t)b * SEQ * 512 + h * 128 + sl * 32;
        f32x4* SSEG = (f32x4*)(ws + WS_SSEG); float* GSEG = (float*)(ws + WS_GSEG);
        f32x4 S[4][2];
#pragma unroll
        for (int kt = 0; kt < 4; ++kt) { S[kt][0] = (f32x4){0.f, 0.f, 0.f, 0.f}; S[kt][1] = (f32x4){0.f, 0.f, 0.f, 0.f}; }
        if (FULL) {
            for (int s2 = 0; s2 < sg; ++s2) {
                const int t2 = ((bhd * 8 + s2) << 2) | sl;
#pragma unroll
                for (int kt = 0; kt < 4; ++kt) {
                    const f32x4 gm = *(const f32x4*)(GSEG + (bhd * 8 + s2) * 64 + 16 * kt + 4 * g);
#pragma unroll
                    for (int nt = 0; nt < 2; ++nt) S[kt][nt] = S[kt][nt] * gm + SSEG[((size_t)t2 * 8 + kt * 2 + nt) * 64 + lane];
                }
            }
        }
        f32x4 gprod[4];
#pragma unroll
        for (int kt = 0; kt < 4; ++kt) gprod[kt] = (f32x4){1.f, 1.f, 1.f, 1.f};
        for (int cs = 0; cs < SEGC; ++cs) {
            const int cn = sg * SEGC + cs, n = dir ? 63 - cn : cn;
            bf16x8 kea[4][2], vb[2][2];
            f32x4 gam[4];
#pragma unroll
            for (int jt = 0; jt < 4; ++jt)
#pragma unroll
                for (int s = 0; s < 2; ++s) kea[jt][s] = ld_frag16(KE + ((size_t)n * 256 + 16 * jt + c15) * 64 + 32 * s + 8 * g);
#pragma unroll
            for (int nt = 0; nt < 2; ++nt)
#pragma unroll
                for (int s = 0; s < 2; ++s) vb[nt][s] = ld_frag16(VT + ((size_t)n * 512 + 16 * nt + c15) * 64 + 32 * s + 8 * g);
#pragma unroll
            for (int kt = 0; kt < 4; ++kt) gam[kt] = *(const f32x4*)(GAM + n * 64 + 16 * kt + 4 * g);
            if (FULL) {
                bf16x8 kia[4][2];
#pragma unroll
                for (int jt = 0; jt < 4; ++jt)
#pragma unroll
                    for (int s = 0; s < 2; ++s) kia[jt][s] = ld_frag16(KI + (size_t)(n * 64 + 16 * jt + c15) * 256 + 32 * s + 8 * g);
                bf16x8 sb[2][2];
#pragma unroll
                for (int nt = 0; nt < 2; ++nt)
#pragma unroll
                    for (int s = 0; s < 2; ++s) sb[nt][s] = pack8(S[2 * s][nt], S[2 * s + 1][nt]);
#pragma unroll
                for (int it = 0; it < 4; ++it) {
                    bf16x8 qdb[2];
#pragma unroll
                    for (int s = 0; s < 2; ++s) qdb[s] = ld_frag16(QD + (size_t)(n * 64 + 16 * it + c15) * 256 + 32 * s + 8 * g);
                    f32x4 sc[4];
#pragma unroll
                    for (int jt = 0; jt < 4; ++jt) {
                        sc[jt] = (f32x4){0.f, 0.f, 0.f, 0.f};
#pragma unroll
                        for (int s = 0; s < 2; ++s) sc[jt] = MFMA16(kia[jt][s], qdb[s], sc[jt]);
                        const int ii = 16 * it + c15;
#pragma unroll
                        for (int r = 0; r < 4; ++r) { const int jj = 16 * jt + 4 * g + r; const bool keep = dir ? (jj > ii) : (jj <= ii); sc[jt][r] = keep ? sc[jt][r] : 0.f; }
                    }
                    bf16x8 pa[2] = {pack8(sc[0], sc[1]), pack8(sc[2], sc[3])};
#pragma unroll
                    for (int nt = 0; nt < 2; ++nt) {
                        f32x4 o = (f32x4){0.f, 0.f, 0.f, 0.f};
#pragma unroll
                        for (int s = 0; s < 2; ++s) { o = MFMA16(vb[nt][s], pa[s], o); o = MFMA16(sb[nt][s], qdb[s], o); }
                        { u32x2 w = {pk2(o[0], o[1]), pk2(o[2], o[3])}; *(u32x2*)(O + (size_t)(n * 64 + 16 * it + c15) * 512 + 16 * nt + 4 * g) = w; }
                    }
                }
            }
#pragma unroll
            for (int kt = 0; kt < 4; ++kt) {
                if (!FULL) gprod[kt] = gprod[kt] * gam[kt];
#pragma unroll
                for (int nt = 0; nt < 2; ++nt) {
                    f32x4 a = S[kt][nt] * gam[kt];
#pragma unroll
                    for (int s = 0; s < 2; ++s) a = MFMA16(kea[kt][s], vb[nt][s], a);
                    S[kt][nt] = a;
                }
            }
        }
        if (!FULL) {
#pragma unroll
            for (int kt = 0; kt < 4; ++kt) {
#pragma unroll
                for (int nt = 0; nt < 2; ++nt) SSEG[((size_t)task * 8 + kt * 2 + nt) * 64 + lane] = S[kt][nt];
                if (sl == 0 && c15 == 0) *(f32x4*)(GSEG + (bhd * 8 + sg) * 64 + 16 * kt + 4 * g) = gprod[kt];
            }
        }
    }
}

DI void phase4a(const Params& p, LAS unsigned char* lds, int tid, int lane, int wave) {
    asm volatile("" : "+v"(tid), "+v"(lane));
    unsigned char* ws = p.ws;
    const bf16_t* Z = (const bf16_t*)(ws + WS_RZ);
    bf16_t* MIX = (bf16_t*)(ws + WS_RA);
    const bf16_t* OF = (const bf16_t*)(ws + WS_RO); const bf16_t* OB = (const bf16_t*)(ws + WS_RO + 64 * MB);
    const bf16_t* WP = (const bf16_t*)(ws + WS_WP);
    LAS bf16_t* pt = (LAS bf16_t*)lds;
    LAS unsigned char* at = lds + 81920;
    const int c15 = lane & 15, g = lane >> 4;
    const f32x4 gh0 = *(const f32x4*)(p.in[11] + 8 * lane), gh1 = *(const f32x4*)(p.in[11] + 8 * lane + 4);
    for (int tile = blockIdx.x; tile < T / 64; tile += gridDim.x) {
        const int tok0 = tile * 64, s0 = tok0 & (SEQ - 1);
        __syncthreads();
#pragma unroll
        for (int ps = 0; ps < 10; ++ps) {
            const int idx = tid + NTH * ps, rr = idx >> 6, ch = idx & 63, sq = s0 - 8 + rr;
            u32x4 v = {0u, 0u, 0u, 0u};
            if (sq >= 0 && sq < SEQ) v = *(const u32x4*)(Z + ((size_t)tok0 - 8 + rr) * ZW + 1536 + ch * 8);
            *(LAS u32x4*)(pt + rr * 512 + ch * 8) = v;
        }
#pragma unroll
        for (int hb = 0; hb < 2; ++hb) {
            u32x4 a[4], bq[4], rv[4];
#pragma unroll
            for (int j = 0; j < 4; ++j) { const size_t t = (size_t)tok0 + wave * 8 + hb * 4 + j;
                a[j] = *(const u32x4*)(OF + t * 512 + 8 * lane); bq[j] = *(const u32x4*)(OB + t * 512 + 8 * lane); rv[j] = *(const u32x4*)(Z + t * ZW + 1024 + 8 * lane); }
#pragma unroll
            for (int j = 0; j < 4; ++j) { const size_t t = (size_t)tok0 + wave * 8 + hb * 4 + j;
                float o[8], r[8];
#pragma unroll
                for (int e = 0; e < 4; ++e) { o[2 * e] = bflo(a[j][e]) + bflo(bq[j][e]); o[2 * e + 1] = bfhi(a[j][e]) + bfhi(bq[j][e]); r[2 * e] = bflo(rv[j][e]); r[2 * e + 1] = bfhi(rv[j][e]); }
                float ss = 0.f;
#pragma unroll
                for (int e = 0; e < 8; ++e) ss += o[e] * o[e];
                ss += __shfl_xor(ss, 1); ss += __shfl_xor(ss, 2); ss += __shfl_xor(ss, 4); ss += __shfl_xor(ss, 8);
                const float rstd = rsqrtf(ss * (1.f / 128.f) + EPS);
                float y[8];
#pragma unroll
                for (int e = 0; e < 8; ++e) { const float gg = e < 4 ? gh0[e] : gh1[e - 4]; y[e] = o[e] * rstd * gg * (r[e] / (1.f + __expf(-r[e]))); }
                u32x4 w = {pk2(y[0], y[1]), pk2(y[2], y[3]), pk2(y[4], y[5]), pk2(y[6], y[7])};
                *(u32x4*)(MIX + t * D + 8 * lane) = w; }
        }
        __syncthreads();
        {
            const int c = tid, gi = c >> 7, cc = c & 127, hw = 1 << gi;
            LAS unsigned char* ag = at + gi * 16384;
            float sum = 0.f;
            {   const int lo = max(s0 - hw, 0), hi = min(s0 + hw, SEQ);
                for (int rr = lo; rr < hi; ++rr) sum += bflo((unsigned)pt[(rr - s0 + 8) * 512 + c]); }
#pragma unroll 4
            for (int i = 0; i < 64; ++i) {
                const int sq = s0 + i, lo = max(sq - hw, 0), hi = min(sq + hw, SEQ);
                const float val = sum / (float)(hi - lo) - bflo((unsigned)pt[(i + 8) * 512 + c]);
                *(LAS bf16_t*)(ag + i * 256 + (((cc >> 3) ^ (i & 15)) * 16) + (cc & 7) * 2) = (bf16_t)(pk2(val, 0.f) & 0xFFFFu);
                if (sq + hw < SEQ) sum += bflo((unsigned)pt[(i + 8 + hw) * 512 + c]);
                if (sq - hw >= 0) sum -= bflo((unsigned)pt[(i + 8 - hw) * 512 + c]);
            }
        }
        __syncthreads();
        {
            const int gi = wave >> 1, dh = wave & 1;
            LAS unsigned char* ag = at + gi * 16384;
            f32x4 acc[4][4];
#pragma unroll
            for (int mt = 0; mt < 4; ++mt)
#pragma unroll
                for (int nt = 0; nt < 4; ++nt) acc[mt][nt] = (f32x4){0.f, 0.f, 0.f, 0.f};
#pragma unroll
            for (int s = 0; s < 4; ++s) {
                bf16x8 af[4];
#pragma unroll
                for (int mt = 0; mt < 4; ++mt) { const int row = mt * 16 + c15; af[mt] = *(const LAS bf16x8*)(ag + row * 256 + (((4 * s + g) ^ (row & 15)) * 16)); }
#pragma unroll
                for (int nt = 0; nt < 4; ++nt) {
                    const bf16x8 wf = ld_frag16(WP + (size_t)gi * 16384 + (dh * 64 + 16 * nt + c15) * 128 + 32 * s + 8 * g);
#pragma unroll
                    for (int mt = 0; mt < 4; ++mt) acc[mt][nt] = MFMA16(wf, af[mt], acc[mt][nt]);
                }
            }
#pragma unroll
            for (int nt = 0; nt < 4; ++nt) {
                const f32x4 ps = *(const f32x4*)(p.in[13] + gi * 128 + dh * 64 + 16 * nt + 4 * g);
#pragma unroll
                for (int mt = 0; mt < 4; ++mt) {
                    const f32x4 v = acc[mt][nt] * ps;
                    u32x2 w = {pk2(v[0], v[1]), pk2(v[2], v[3])};
                    *(u32x2*)(MIX + ((size_t)tok0 + mt * 16 + c15) * D + 512 + gi * 128 + dh * 64 + 16 * nt + 4 * g) = w;
                }
            }
        }
    }
}

DI void phase4c(const Params& p, LAS unsigned char* lds, int tid, int lane, int wave) {
    asm volatile("" : "+v"(tid), "+v"(lane));
    LAS float* lG = (LAS float*)lds; LAS float* lA = lG + 1024; LAS float* lB = lA + 1024; LAS float* lP = lB + 1024;
    const float* x = p.in[0]; const bf16_t* MIXO = (const bf16_t*)(p.ws + WS_RZ); bf16_t* H2 = (bf16_t*)(p.ws + WS_RA);
    for (int rt = blockIdx.x; rt < T / 128; rt += gridDim.x) {
        const int b = rt / 32;
        __syncthreads();
        for (int d = tid; d < 1024; d += NTH) { lG[d] = mod_at(p, b, 2048 + d); lA[d] = p.in[15][d] * (1.f + mod_at(p, b, 4096 + d)); lB[d] = mod_at(p, b, 3072 + d); lP[d] = p.in[5][d]; }
        __syncthreads();
        for (int r0 = wave; r0 < 128; r0 += 2 * NWV) {
            f32x4 m[2][4], xv[2][4];
#pragma unroll
            for (int u = 0; u < 2; ++u) {
                const size_t row = (size_t)rt * 128 + r0 + u * NWV;
                const u32x2* mr = (const u32x2*)(MIXO + row * D) + lane; const f32x4* xr = (const f32x4*)(x + row * D) + lane;
#pragma unroll
                for (int j = 0; j < 4; ++j) { const u32x2 mv = mr[64 * j]; m[u][j] = (f32x4){bflo(mv.x), bfhi(mv.x), bflo(mv.y), bfhi(mv.y)}; xv[u][j] = xr[64 * j]; }
            }
#pragma unroll
            for (int u = 0; u < 2; ++u) {
                const size_t row = (size_t)rt * 128 + r0 + u * NWV;
                float ss = 0.f;
#pragma unroll
                for (int j = 0; j < 4; ++j) ss += m[u][j][0] * m[u][j][0] + m[u][j][1] * m[u][j][1] + m[u][j][2] * m[u][j][2] + m[u][j][3] * m[u][j][3];
                const float rstd = rsqrtf(wave_sum(ss) * (1.f / D) + EPS);
                float s2 = 0.f;
#pragma unroll
                for (int j = 0; j < 4; ++j) {
                    const f32x4 gt = *(const LAS f32x4*)(lG + 4 * lane + 256 * j), pm = *(const LAS f32x4*)(lP + 4 * lane + 256 * j);
                    xv[u][j] = xv[u][j] + gt * (m[u][j] * rstd * pm);
                    s2 += xv[u][j][0] * xv[u][j][0] + xv[u][j][1] * xv[u][j][1] + xv[u][j][2] * xv[u][j][2] + xv[u][j][3] * xv[u][j][3];
                }
                const float rstd2 = rsqrtf(wave_sum(s2) * (1.f / D) + EPS);
                f32x4* orow = (f32x4*)(p.out + row * D) + lane; u32x2* hrow = (u32x2*)(H2 + row * D) + lane;
#pragma unroll
                for (int j = 0; j < 4; ++j) {
                    orow[64 * j] = xv[u][j];
#if defined(CHK_PEER) || REPEAT_PHASE == 6
                    ((f32x4*)((float*)(p.ws + WS_RO) + row * D) + lane)[64 * j] = xv[u][j];
#endif
                    const f32x4 a = *(const LAS f32x4*)(lA + 4 * lane + 256 * j), bb = *(const LAS f32x4*)(lB + 4 * lane + 256 * j);
                    const f32x4 hv = xv[u][j] * rstd2 * a + bb;
                    u32x2 w = {pk2(hv[0], hv[1]), pk2(hv[2], hv[3])};
                    hrow[64 * j] = w;
                }
            }
        }
    }
}

DI int skey(float v, int idx, int mask) { int u = __float_as_int(v); u ^= (u >> 31) & 0x7FFFFFFF; return (u & ~mask) | idx; }
DI float sval(int k, int mask) { int u = k & ~mask; u ^= (u >> 31) & 0x7FFFFFFF; return __int_as_float(u); }
DI void cswap(int& a, int& b) { const int mx = max(a, b), mn = min(a, b); a = mx; b = mn; }
DI void sort16_desc(int (&a)[16]) {
#pragma unroll
    for (int k = 2; k <= 16; k <<= 1) {
#pragma unroll
        for (int j = k >> 1; j > 0; j >>= 1) {
#pragma unroll
            for (int i = 0; i < 16; ++i) {
                const int l = i ^ j;
                if (l > i) { if ((i & k) == 0) cswap(a[i], a[l]); else cswap(a[l], a[i]); }
            }
        }
    }
}
DI void merge16_desc(int (&x)[16], const int (&y)[16]) {
#pragma unroll
    for (int i = 0; i < 16; ++i) x[i] = max(x[i], y[15 - i]);
#pragma unroll
    for (int j = 8; j > 0; j >>= 1) {
#pragma unroll
        for (int i = 0; i < 16; ++i) { const int l = i ^ j; if (l > i) cswap(x[i], x[l]); }
    }
}

DI void phase5b(const Params& p, LAS unsigned char* lds, int tid, int lane, int wave) {
    asm volatile("" : "+v"(tid), "+v"(lane));
    unsigned char* ws = p.ws;
    const bf16_t* Q2 = (const bf16_t*)(ws + WS_RZ);
    const bf16_t* SKB = (const bf16_t*)(ws + WS_SKB);
    int* EIDX = (int*)(ws + WS_RS); float* GATE = (float*)(ws + WS_RS + 16 * MB);
    LAS unsigned char* tab = lds + tid * 32;
    LAS unsigned char* skl = lds + 16384;
    const int c31 = lane & 31, hi = lane >> 5;
    for (int btask = blockIdx.x; btask < 256; btask += gridDim.x) {
        const int h = btask & 7, tgc = btask >> 3;
        __syncthreads();
#pragma unroll
        for (int ps = 0; ps < 8; ++ps) {
            const int idx = tid + NTH * ps, row = idx >> 4, ch = idx & 15;
            const u32x4 v = *(const u32x4*)(SKB + ((size_t)h * 256 + row) * 128 + ch * 8);
            *(LAS u32x4*)(skl + row * 256 + ((ch ^ (row & 15)) * 16)) = v;
        }
        __syncthreads();
      for (int ti = 0; ti < 4; ++ti) {
        const int tg = tgc * 32 + wave * 4 + ti;
        const size_t tok = (size_t)tg * 32 + c31;
        int lst[2][16];
        bf16x8 bq[2][8];
#pragma unroll
        for (int pp = 0; pp < 2; ++pp) {
            const bf16_t* qp = Q2 + tok * 2048 + h * 256 + pp * 128 + 8 * hi;
            asm volatile("" : "+v"(qp));
#pragma unroll
            for (int ks = 0; ks < 8; ++ks) bq[pp][ks] = ld_frag16(qp + 16 * ks);
        }
#pragma unroll
        for (int pp = 0; pp < 2; ++pp) {
            int run[16];
#pragma unroll
            for (int r = 0; r < 16; ++r) run[r] = (int)0x80000000;
#pragma unroll 1
            for (int kt = 0; kt < 4; ++kt) {
                const LAS unsigned char* kb = skl + pp * 32768 + (32 * kt + c31) * 256;
                f32x16 acc;
#pragma unroll
                for (int r = 0; r < 16; ++r) acc[r] = 0.f;
#pragma unroll
                for (int ks = 0; ks < 8; ++ks) acc = MFMA32(*(const LAS bf16x8*)(kb + (((2 * ks + hi) ^ (c31 & 15)) * 16)), bq[pp][ks], acc);
                int cur[16];
#pragma unroll
                for (int r = 0; r < 16; ++r) cur[r] = skey(acc[r], 32 * kt + 8 * (r >> 2) + 4 * hi + (r & 3), 0x7F);
                sort16_desc(cur);
                merge16_desc(run, cur);
            }
            int oth[16];
#pragma unroll
            for (int r = 0; r < 16; ++r) oth[r] = __shfl_xor(run[r], 32);
            merge16_desc(run, oth);
#pragma unroll
            for (int r = 0; r < 16; ++r) lst[pp][r] = run[r];
        }
#pragma unroll
        for (int pp = 0; pp < 2; ++pp) {
            u32x4 w;
#pragma unroll
            for (int q = 0; q < 4; ++q) w[q] = (lst[pp][4 * q] & 0x7F) | ((lst[pp][4 * q + 1] & 0x7F) << 8) | ((lst[pp][4 * q + 2] & 0x7F) << 16) | ((lst[pp][4 * q + 3] & 0x7F) << 24);
            *(LAS u32x4*)(tab + 16 * pp) = w;
        }
        float va[16], vb[16];
#pragma unroll
        for (int r = 0; r < 16; ++r) { va[r] = sval(lst[0][r], 0x7F); vb[r] = sval(lst[1][r], 0x7F); }
        int cand[4][16];
        {
            int cnt = 0;
#pragma unroll
            for (int i = 0; i < 16; ++i)
#pragma unroll
                for (int j = 0; j < 16; ++j)
                    if ((i + 1) * (j + 1) <= 16) { cand[cnt >> 4][cnt & 15] = skey(va[i] + vb[j], (i << 4) | j, 0xFF); ++cnt; }
#pragma unroll
            for (int q = 50; q < 64; ++q) cand[q >> 4][q & 15] = (int)0x80000000;
        }
        sort16_desc(cand[0]); sort16_desc(cand[1]); sort16_desc(cand[2]); sort16_desc(cand[3]);
        merge16_desc(cand[0], cand[1]); merge16_desc(cand[2], cand[3]); merge16_desc(cand[0], cand[2]);
        asm volatile("s_waitcnt lgkmcnt(0)" ::: "memory");
        float sv[16]; int ex[16];
        const float mx = sval(cand[0][0], 0xFF);
        float sum = 0.f;
#pragma unroll
        for (int r = 0; r < 16; ++r) {
            const int ck = cand[0][r];
            const int i1 = tab[(ck >> 4) & 15], i2 = tab[16 + (ck & 15)];
            ex[r] = i1 * 128 + i2;
            sv[r] = __expf(sval(ck, 0xFF) - mx); sum += sv[r];
        }
        const float inv = 1.f / sum;
        int* ep = EIDX + tok * 128 + h * 16 + 8 * hi; float* gp = GATE + tok * 128 + h * 16 + 8 * hi;
        if (hi == 0) {
            *(u32x4*)ep = (u32x4){(unsigned)ex[0], (unsigned)ex[1], (unsigned)ex[2], (unsigned)ex[3]}; *(u32x4*)(ep + 4) = (u32x4){(unsigned)ex[4], (unsigned)ex[5], (unsigned)ex[6], (unsigned)ex[7]};
            *(f32x4*)gp = (f32x4){sv[0] * inv, sv[1] * inv, sv[2] * inv, sv[3] * inv}; *(f32x4*)(gp + 4) = (f32x4){sv[4] * inv, sv[5] * inv, sv[6] * inv, sv[7] * inv};
        } else {
            *(u32x4*)ep = (u32x4){(unsigned)ex[8], (unsigned)ex[9], (unsigned)ex[10], (unsigned)ex[11]}; *(u32x4*)(ep + 4) = (u32x4){(unsigned)ex[12], (unsigned)ex[13], (unsigned)ex[14], (unsigned)ex[15]};
            *(f32x4*)gp = (f32x4){sv[8] * inv, sv[9] * inv, sv[10] * inv, sv[11] * inv}; *(f32x4*)(gp + 4) = (f32x4){sv[12] * inv, sv[13] * inv, sv[14] * inv, sv[15] * inv};
        }
      }
    }
}

template <int K> DI int swz_bcast(int v) { return __builtin_amdgcn_ds_swizzle(v, 0x10 | (K << 5)); }
template <int W> DI int swz_xor(int v) { return __builtin_amdgcn_ds_swizzle(v, 0x1F | (W << 10)); }
template <int K> struct IC { static constexpr int v = K; };
template <int N, int I = 0, class F> DI void static_for(F&& f) { if constexpr (I < N) { f(IC<I>{}); static_for<N, I + 1>(f); } }
DI float row16_sum(float v) {
    v += __builtin_bit_cast(float, __builtin_amdgcn_update_dpp(0, __builtin_bit_cast(int, v), 0xB1, 0xF, 0xF, true));
    v += __builtin_bit_cast(float, __builtin_amdgcn_update_dpp(0, __builtin_bit_cast(int, v), 0x4E, 0xF, 0xF, true));
    v += __builtin_bit_cast(float, __builtin_amdgcn_update_dpp(0, __builtin_bit_cast(int, v), 0x141, 0xF, 0xF, true));
    v += __builtin_bit_cast(float, __builtin_amdgcn_update_dpp(0, __builtin_bit_cast(int, v), 0x140, 0xF, 0xF, true));
    return v;
}
DI void phase6(const Params& p, LAS unsigned char* lds, int tid, int lane, int wave) {
    asm volatile("" : "+v"(tid), "+v"(lane));
    unsigned char* ws = p.ws;
    const bf16_t* H2 = (const bf16_t*)(ws + WS_RA);
    const unsigned char* UQ = ws + WS_UB; const unsigned char* VQ = ws + WS_VB;
    const float* SU = (const float*)(ws + WS_SU); const float* SV = (const float*)(ws + WS_SV);
    const int* EIDX = (const int*)(ws + WS_RS); const float* GATE = (const float*)(ws + WS_RS + 16 * MB);
    LAS float* lG = (LAS float*)lds;
    const int q = lane >> 4, l16 = lane & 15;
    LAS int* le = (LAS int*)(lds + 4096 + wave * 6144) + q * 128;
    LAS float* lg = (LAS float*)(lds + 4096 + wave * 6144 + 2048) + q * 128;
    LAS float* lc = (LAS float*)(lds + 4096 + wave * 6144 + 4096) + q * 128;
    const unsigned qlo = q < 2 ? (0xFFFFu << (16 * q)) : 0u, qhi = q >= 2 ? (0xFFFFu << (16 * (q - 2))) : 0u;
    for (int rt = blockIdx.x; rt < T / 128; rt += gridDim.x) {
        const int b = rt / 32;
        __syncthreads();
        for (int d = tid; d < 1024; d += NTH) lG[d] = mod_at(p, b, 5120 + d) * p.in[16][d];
        __syncthreads();
#pragma unroll 1
        for (int rd = 0; rd < 4; ++rd) {
            __syncthreads();
            const size_t t = (size_t)rt * 128 + wave * 16 + rd * 4 + q;
            {
                int e[8]; float g[8];
#pragma unroll
                for (int r = 0; r < 8; ++r) { e[r] = EIDX[t * 128 + r * 16 + l16]; g[r] = GATE[t * 128 + r * 16 + l16]; }
                unsigned W[4] = {0u, 0u, 0u, 0u};
#pragma unroll
                for (int r = 0; r < 8; ++r) {
                    const int k = e[r] >> 10; const unsigned inc = 1u << (8 * (k & 3)); const int w = k >> 2;
                    W[0] += (w == 0) ? inc : 0u; W[1] += (w == 1) ? inc : 0u; W[2] += (w == 2) ? inc : 0u; W[3] += (w == 3) ? inc : 0u;
                }
                unsigned C[4];
                {
                    unsigned tot[4], exc[4];
#pragma unroll
                    for (int w = 0; w < 4; ++w) {
                        unsigned x = W[w];
                        x += (unsigned)__builtin_amdgcn_update_dpp(0, (int)x, 0x111, 0xF, 0xF, true);
                        x += (unsigned)__builtin_amdgcn_update_dpp(0, (int)x, 0x112, 0xF, 0xF, true);
                        x += (unsigned)__builtin_amdgcn_update_dpp(0, (int)x, 0x114, 0xF, 0xF, true);
                        x += (unsigned)__builtin_amdgcn_update_dpp(0, (int)x, 0x118, 0xF, 0xF, true);
                        exc[w] = x - W[w];
                        tot[w] = (unsigned)swz_bcast<15>((int)x);
                    }
                    unsigned carry = 0u;
#pragma unroll
                    for (int w = 0; w < 4; ++w) {
                        const unsigned P = tot[w] + (tot[w] << 8) + (tot[w] << 16) + (tot[w] << 24);
                        C[w] = (P - tot[w]) + carry * 0x01010101u + exc[w];
                        carry += P >> 24;
                    }
                }
#pragma unroll
                for (int r = 0; r < 8; ++r) {
                    const int k = e[r] >> 10; const int sh = 8 * (k & 3); const int w = k >> 2; const unsigned inc = 1u << sh;
                    const unsigned cw = (w == 0) ? C[0] : (w == 1) ? C[1] : (w == 2) ? C[2] : C[3];
                    const int pos = (int)((cw >> sh) & 0xFFu);
                    le[pos] = e[r]; lg[pos] = g[r];
                    C[0] += (w == 0) ? inc : 0u; C[1] += (w == 1) ? inc : 0u; C[2] += (w == 2) ? inc : 0u; C[3] += (w == 3) ? inc : 0u;
                }
                asm volatile("s_waitcnt lgkmcnt(0)" ::: "memory");
            }
            {
                int hq[16]; float ish;
                {
                    float hv[64]; float hm = 0.f;
#pragma unroll
                    for (int i = 0; i < 4; ++i) {
                        const u32x4 h0 = *(const u32x4*)(H2 + t * D + 256 * i + 16 * l16), h1 = *(const u32x4*)(H2 + t * D + 256 * i + 16 * l16 + 8);
#pragma unroll
                        for (int c = 0; c < 4; ++c) { hv[16 * i + 2 * c] = bflo(h0[c]); hv[16 * i + 2 * c + 1] = bfhi(h0[c]); hv[16 * i + 8 + 2 * c] = bflo(h1[c]); hv[16 * i + 8 + 2 * c + 1] = bfhi(h1[c]); }
                    }
#pragma unroll
                    for (int j = 0; j < 64; ++j) hm = fmaxf(hm, fabsf(hv[j]));
                    hm = fmaxf(hm, __builtin_bit_cast(float, __builtin_amdgcn_update_dpp(0, __builtin_bit_cast(int, hm), 0xB1, 0xF, 0xF, true)));
                    hm = fmaxf(hm, __builtin_bit_cast(float, __builtin_amdgcn_update_dpp(0, __builtin_bit_cast(int, hm), 0x4E, 0xF, 0xF, true)));
                    hm = fmaxf(hm, __builtin_bit_cast(float, __builtin_amdgcn_update_dpp(0, __builtin_bit_cast(int, hm), 0x141, 0xF, 0xF, true)));
                    hm = fmaxf(hm, __builtin_bit_cast(float, __builtin_amdgcn_update_dpp(0, __builtin_bit_cast(int, hm), 0x140, 0xF, 0xF, true)));
                    const float s8 = hm > 1e-30f ? 127.f / hm : 0.f; ish = hm * (1.f / 127.f);
#pragma unroll
                    for (int d = 0; d < 16; ++d) {
                        const int q0 = __float2int_rn(hv[4 * d] * s8), q1 = __float2int_rn(hv[4 * d + 1] * s8), q2 = __float2int_rn(hv[4 * d + 2] * s8), q3 = __float2int_rn(hv[4 * d + 3] * s8);
                        hq[d] = (int)((unsigned)(q0 & 0xFF) | ((unsigned)(q1 & 0xFF) << 8) | ((unsigned)(q2 & 0xFF) << 16) | ((unsigned)q3 << 24));
                    }
                }
                constexpr int UD = 4;
                u32x4 ub[UD][4];
                int evn = le[l16];
                static_for<UD>([&](auto kc) { constexpr int k = decltype(kc)::v; const unsigned char* up = UQ + (size_t)swz_bcast<k>(evn) * 1024 + 16 * l16;
#pragma unroll
                    for (int i = 0; i < 4; ++i) ub[k][i] = *(const u32x4*)(up + 256 * i); });
#pragma unroll 1
                for (int bt = 0; bt < 8; ++bt) {
                    if (bt) __syncthreads();
                    const int ev = evn; const float gv = lg[bt * 16 + l16];
                    evn = le[(bt < 7 ? bt + 1 : 7) * 16 + l16];
                    const float isu = SU[ev] * ish, isv = SV[ev];
                    int part[16];
                    static_for<16>([&](auto kc) {
                        constexpr int k = decltype(kc)::v, sl = k % UD;
                        int a = 0;
#pragma unroll
                        for (int i = 0; i < 4; ++i) {
                            const u32x4 u = ub[sl][i];
#pragma unroll
                            for (int c = 0; c < 4; ++c) a = __builtin_amdgcn_sdot4((int)u[c], hq[4 * i + c], a, false);
                        }
                        part[k] = a;
                        {
                            constexpr int kn = k + UD;
                            int idx; if constexpr (kn < 16) idx = swz_bcast<(kn & 15)>(ev); else idx = swz_bcast<(kn & 15)>(evn);
                            const unsigned char* up = UQ + (size_t)idx * 1024 + 16 * l16;
#pragma unroll
                            for (int i = 0; i < 4; ++i) ub[sl][i] = *(const u32x4*)(up + 256 * i);
                        }
                    });
                    static_for<4>([&](auto sc) {
                        constexpr int w = 8 >> decltype(sc)::v;
                        const bool up2 = (lane & w) != 0;
#pragma unroll
                        for (int e = 0; e < w; ++e) {
                            const int keep = up2 ? part[e + w] : part[e], send = up2 ? part[e] : part[e + w];
                            part[e] = keep + swz_xor<w>(send);
                        }
                    });
                    const float dot = (float)part[0] * isu;
                    lc[bt * 16 + l16] = gv * 0.5f * dot * (1.f + erff(dot * 0.70710678118654752f)) * isv;
                }
                asm volatile("s_waitcnt lgkmcnt(0)" ::: "memory");
            }
            __syncthreads();
            f32x2 y[32];
#pragma unroll
            for (int i = 0; i < 32; ++i) y[i] = (f32x2){0.f, 0.f};
            {
                constexpr int VD = 4;
                u32x4 vbuf[VD][4];
                int evn = le[l16];
                static_for<VD>([&](auto kc) { constexpr int k = decltype(kc)::v; const unsigned char* vp = VQ + (size_t)swz_bcast<k>(evn) * 1024 + 16 * l16;
#pragma unroll
                    for (int i = 0; i < 4; ++i) vbuf[k][i] = *(const u32x4*)(vp + 256 * i); });
#pragma unroll 1
                for (int bt = 0; bt < 8; ++bt) {
                    if (bt) __syncthreads();
                    const int ev = evn; const int cv = __float_as_int(lc[bt * 16 + l16]);
                    evn = le[(bt < 7 ? bt + 1 : 7) * 16 + l16];
                    static_for<16>([&](auto kc) {
                        constexpr int k = decltype(kc)::v, sl = k % VD;
                        const float cc = __int_as_float(swz_bcast<k>(cv));
                        const f32x2 c2 = (f32x2){cc, cc};
#pragma unroll
                        for (int i = 0; i < 4; ++i) {
                            const u32x4 v = vbuf[sl][i];
#pragma unroll
                            for (int c = 0; c < 4; ++c) {
                                const int w = (int)v[c];
                                y[8 * i + 2 * c] = __builtin_elementwise_fma(__builtin_amdgcn_cvt_pk_f32_fp8(w, false), c2, y[8 * i + 2 * c]);
                                y[8 * i + 2 * c + 1] = __builtin_elementwise_fma(__builtin_amdgcn_cvt_pk_f32_fp8(w, true), c2, y[8 * i + 2 * c + 1]);
                            }
                        }
                        {
                            constexpr int kn = k + VD;
                            int idx; if constexpr (kn < 16) idx = swz_bcast<(kn & 15)>(ev); else idx = swz_bcast<(kn & 15)>(evn);
                            const unsigned char* vp = VQ + (size_t)idx * 1024 + 16 * l16;
#pragma unroll
                            for (int i = 0; i < 4; ++i) vbuf[sl][i] = *(const u32x4*)(vp + 256 * i);
                        }
                    });
                }
            }
            float ss = 0.f;
#pragma unroll
            for (int i = 0; i < 32; ++i) ss += y[i].x * y[i].x + y[i].y * y[i].y;
            const float rstd = rsqrtf(row16_sum(ss) * (1.f / D) + EPS);
            float* orow = p.out + t * D;
#pragma unroll
            for (int i = 0; i < 4; ++i)
#pragma unroll
                for (int c = 0; c < 4; ++c) {
                    const int col = 256 * i + 16 * l16 + 4 * c;
#if REPEAT_PHASE == 6
                    f32x4 xv = *(const f32x4*)((const float*)(p.ws + WS_RO) + t * D + col);
#else
                    f32x4 xv = *(const f32x4*)(orow + col);
#endif
                    const f32x4 gg = *(const LAS f32x4*)(lG + col);
                    xv[0] += gg[0] * y[8 * i + 2 * c].x * rstd; xv[1] += gg[1] * y[8 * i + 2 * c].y * rstd; xv[2] += gg[2] * y[8 * i + 2 * c + 1].x * rstd; xv[3] += gg[3] * y[8 * i + 2 * c + 1].y * rstd;
                    *(f32x4*)(orow + col) = xv;
                }
        }
    }
}

#ifdef CHK_PEER
DI float blk_sum(float v, LAS float* red, int tid, int lane, int wave) {
    v = wave_sum(v);
    __syncthreads();
    if (lane == 0) red[wave] = v;
    __syncthreads();
    float s = 0.f;
    for (int i = 0; i < NWV; ++i) s += red[i];
    return s;
}
DI void check_peer(const Params& p, LAS unsigned char* lds, int tid, int lane, int wave) {
    unsigned char* ws = p.ws;
    const bf16_t* H2 = (const bf16_t*)(ws + WS_RA); const bf16_t* WQ = (const bf16_t*)(ws + WS_WQ); const bf16_t* SKB = (const bf16_t*)(ws + WS_SKB);
    const bf16_t* UB = (const bf16_t*)(ws + WS_UB); const bf16_t* VB = (const bf16_t*)(ws + WS_VB);
    const float* X1 = (const float*)(ws + WS_RO);
    float* stat = (float*)(ws + WS_CTL + 32768);
    LAS float* hrow = (LAS float*)lds;
    LAS float* qv = hrow + 1024;
    LAS float* sc = qv + 2048;
    LAS float* tv = sc + 2048;
    LAS int* ti = (LAS int*)(tv + 256);
    LAS int* ee = ti + 256;
    LAS float* gg = (LAS float*)(ee + 128);
    LAS float* cf = gg + 128;
    LAS float* yv = cf + 128;
    LAS float* red = yv + 1024;
    for (int rt = blockIdx.x; rt < T / 128; rt += gridDim.x) {
        const size_t ts = (size_t)rt * 128 + 37; const int b = rt / 32;
        __syncthreads();
        for (int d = tid; d < 1024; d += NTH) hrow[d] = bflo((unsigned)H2[ts * D + d]);
        __syncthreads();
        for (int n = tid; n < 2048; n += NTH) { float a = 0.f; for (int k = 0; k < 1024; ++k) a += hrow[k] * bflo((unsigned)WQ[(size_t)n * 1024 + k]); qv[n] = bflo(pk2(a, 0.f) & 0xFFFFu); }
        __syncthreads();
        for (int n = tid; n < 2048; n += NTH) { const int hp = n >> 7, key = n & 127; float a = 0.f; for (int d = 0; d < 128; ++d) a += qv[hp * 128 + d] * bflo((unsigned)SKB[((size_t)hp * 128 + key) * 128 + d]); sc[n] = a; }
        __syncthreads();
        if (tid < 16) { const int hp = tid;
            for (int k = 0; k < 16; ++k) { float best = -3e38f; int bi = 0; for (int n = 0; n < 128; ++n) { const float v = sc[hp * 128 + n]; if (v > best) { best = v; bi = n; } } tv[hp * 16 + k] = best; ti[hp * 16 + k] = bi; sc[hp * 128 + bi] = -3e38f; } }
        __syncthreads();
        if (tid < 8) { const int h = tid; float cs[16]; int ci[16];
            unsigned long long used[4] = {0ull, 0ull, 0ull, 0ull};
            for (int k = 0; k < 16; ++k) { float best = -3e38f; int bi = 0;
                for (int c = 0; c < 256; ++c) { if ((used[c >> 6] >> (c & 63)) & 1ull) continue; const float v = tv[(h * 2) * 16 + (c >> 4)] + tv[(h * 2 + 1) * 16 + (c & 15)]; if (v > best) { best = v; bi = c; } }
                used[bi >> 6] |= 1ull << (bi & 63); cs[k] = best; ci[k] = bi; }
            float sum = 0.f; for (int k = 0; k < 16; ++k) { cs[k] = __expf(cs[k] - cs[0]); sum += cs[k]; }
            for (int k = 0; k < 16; ++k) { ee[h * 16 + k] = ti[(h * 2) * 16 + (ci[k] >> 4)] * 128 + ti[(h * 2 + 1) * 16 + (ci[k] & 15)]; gg[h * 16 + k] = cs[k] / sum; } }
        __syncthreads();
#ifdef CHK_USE_FAST_SEL
        if (tid < 128) { ee[tid] = ((const int*)(ws + WS_RS))[ts * 128 + tid]; gg[tid] = ((const float*)(ws + WS_RS + 16 * MB))[ts * 128 + tid]; }
        __syncthreads();
#endif
        if (tid < 128) { const int e = ee[tid]; float a = 0.f; for (int d = 0; d < 1024; ++d) a += hrow[d] * bflo((unsigned)UB[(size_t)e * D + d]); cf[tid] = gg[tid] * 0.5f * a * (1.f + erff(a * 0.70710678118654752f)); }
        __syncthreads();
        for (int d = tid; d < 1024; d += NTH) { float a = 0.f; for (int e = 0; e < 128; ++e) a += cf[e] * bflo((unsigned)VB[(size_t)ee[e] * D + d]); yv[d] = a; }
        __syncthreads();
        float ss = 0.f; for (int d = tid; d < 1024; d += NTH) ss += yv[d] * yv[d];
        const float rstd = rsqrtf(blk_sum(ss, red, tid, lane, wave) * (1.f / D) + EPS);
        float e2 = 0.f, r2 = 0.f;
        for (int d = tid; d < 1024; d += NTH) { const float br = mod_at(p, b, 5120 + d) * p.in[16][d] * yv[d] * rstd; const float ref = X1[ts * D + d] + br; const float df = p.out[ts * D + d] - ref; e2 += df * df; r2 += br * br; }
        e2 = blk_sum(e2, red, tid, lane, wave); r2 = blk_sum(r2, red, tid, lane, wave);
        if (tid == 0) { atomicAdd(&stat[0], e2); atomicAdd(&stat[1], r2); }
    }
}
DI void check_emit(const Params& p, int tid) {
    const float* stat = (const float*)(p.ws + WS_CTL + 32768);
    const float e = __hip_atomic_load(&stat[0], __ATOMIC_RELAXED, __HIP_MEMORY_SCOPE_AGENT), r = __hip_atomic_load(&stat[1], __ATOMIC_RELAXED, __HIP_MEMORY_SCOPE_AGENT);
    const float A = 10.f + 1e6f * (e / r), f = 1.f + sqrtf(A);
    const size_t gt = (size_t)blockIdx.x * NTH + tid, NGT = (size_t)gridDim.x * NTH;
    for (size_t i = gt; i < (size_t)T * D / 4; i += NGT) { f32x4 v = ((const f32x4*)p.in[0])[i]; ((f32x4*)p.out)[i] = v * f; }
}
#endif

#ifdef TIMING
#define STAMP(k) do { if (blockIdx.x == 0 && threadIdx.x == 0) ((unsigned long long*)(p.ws + WS_CTL + 40960))[k] = __builtin_amdgcn_s_memrealtime(); } while (0)
DI void timing_emit(const Params& p, int tid) {
    const unsigned long long* ts = (const unsigned long long*)(p.ws + WS_CTL + 40960);
#define dT(a, b) ((float)(ts[b] - ts[a]) * 0.01f)
    const float A = TIM_A, B = TIM_B, f = 1.f + sqrtf(A);
#undef dT
    const size_t gt = (size_t)blockIdx.x * NTH + tid, NGT = (size_t)gridDim.x * NTH;
    for (size_t i = gt; i < (size_t)T * D / 4; i += NGT) { f32x4 v = ((const f32x4*)p.in[0])[i]; v = v * f; if (i == 0) v[0] = B; ((f32x4*)p.out)[i] = v; }
}
#else
#define STAMP(k) do {} while (0)
#endif

__global__ void __launch_bounds__(NTH) fwd_megakernel(Params p) {
    extern __shared__ __attribute__((aligned(16))) unsigned char lds_raw[];
    LAS unsigned char* lds = (LAS unsigned char*)lds_raw;
    const int tid = threadIdx.x, lane = tid & 63, wave = __builtin_amdgcn_readfirstlane(tid >> 6);
    volatile LAS unsigned* st = (volatile LAS unsigned*)(lds + LDS_BARW);
    if (tid == 0) { st[0] = 0u; st[1] = 0u; st[2] = 0u; st[3] = 0u; }
    __syncthreads();
    XcdBarrier bar = xcd_barrier_post((unsigned*)(p.ws + WS_CTL), st);
    unsigned char* ws = p.ws;

    STAMP(0);
    phase0(p, lds, tid, lane, wave);
    xcd_barrier(bar);
#if REPEAT_PHASE == 0
    phase0(p, lds, tid, lane, wave);
    xcd_barrier(bar);
#endif
    STAMP(1);
    phase1(p, lds, tid, lane, wave);
    xcd_barrier(bar);
    STAMP(2);
    { pg8::Gemm g{(const bf16_t*)(ws + WS_RA), (const bf16_t*)(ws + WS_WIN), T, ZW, D}; pg8::StaticOrder S; S.init(T, ZW, (int)gridDim.x, (int)blockIdx.x);
      pg8::EpiB16 e{(bf16_t*)(ws + WS_RZ), ZW}; pg8::gemm_phase<pg8::EpiB16, pg8::StaticOrder, true, true>(lds, g, S, e);
      EpiZ e2{(bf16_t*)(ws + WS_RZ), (float*)(ws + WS_AFB)}; gemm_phase(((const bf16_t*)(ws + WS_RA)), (const bf16_t*)(ws + WS_WIN), T, NIN, D, e2, lds, tid, lane, wave, 16); }
#if REPEAT_PHASE == 2
    xcd_barrier(bar);
    { pg8::Gemm g{(const bf16_t*)(ws + WS_RA), (const bf16_t*)(ws + WS_WIN), T, ZW, D}; pg8::StaticOrder S; S.init(T, ZW, (int)gridDim.x, (int)blockIdx.x);
      pg8::EpiB16 e{(bf16_t*)(ws + WS_RZ), ZW}; pg8::gemm_phase<pg8::EpiB16, pg8::StaticOrder, true, true>(lds, g, S, e);
      EpiZ e2{(bf16_t*)(ws + WS_RZ), (float*)(ws + WS_AFB)}; gemm_phase(((const bf16_t*)(ws + WS_RA)), (const bf16_t*)(ws + WS_WIN), T, NIN, D, e2, lds, tid, lane, wave, 16); }
#endif
    xcd_barrier(bar);
    STAMP(3);
    phase3a(p, lds, tid, lane, wave);
    xcd_barrier(bar);
#if REPEAT_PHASE == 1
    phase3a(p, lds, tid, lane, wave);
    xcd_barrier(bar);
#endif
    STAMP(4);
    phase3b<true>(p, lane, wave);
    xcd_barrier(bar);
    STAMP(5);
    phase4a(p, lds, tid, lane, wave);
    xcd_barrier(bar);
#if REPEAT_PHASE == 4
    phase4a(p, lds, tid, lane, wave);
    xcd_barrier(bar);
#endif
    STAMP(6);
    { pg8::Gemm g{(const bf16_t*)(ws + WS_RA), (const bf16_t*)(ws + WS_WOUT), T, D, D}; pg8::StaticOrder S; S.init(T, D, (int)gridDim.x, (int)blockIdx.x);
      pg8::EpiB16 e{(bf16_t*)(ws + WS_RZ), D}; pg8::gemm_phase<pg8::EpiB16, pg8::StaticOrder, true, true>(lds, g, S, e); }
    xcd_barrier(bar);
    STAMP(7);
    phase4c(p, lds, tid, lane, wave);
    xcd_barrier(bar);
    STAMP(8);
#ifndef ABL_SKIP_PEER
    { pg8::Gemm g{(const bf16_t*)(ws + WS_RA), (const bf16_t*)(ws + WS_WQ), T, 2048, D}; pg8::StaticOrder S; S.init(T, 2048, (int)gridDim.x, (int)blockIdx.x);
      pg8::EpiB16 e{(bf16_t*)(ws + WS_RZ), 2048}; pg8::gemm_phase<pg8::EpiB16, pg8::StaticOrder, true, true>(lds, g, S, e); }
    xcd_barrier(bar);
    STAMP(9);
    phase5b(p, lds, tid, lane, wave);
    xcd_barrier(bar);
#if REPEAT_PHASE == 5
    phase5b(p, lds, tid, lane, wave);
    xcd_barrier(bar);
#endif
    STAMP(10);
#if REPEAT_PHASE == 9
    for (int i = 0; i < 10; ++i) xcd_barrier(bar);
#endif
    phase6(p, lds, tid, lane, wave);
#if REPEAT_PHASE == 6
    xcd_barrier(bar);
    phase6(p, lds, tid, lane, wave);
#endif
#ifdef TIMING
    xcd_barrier(bar);
    STAMP(11);
    xcd_barrier(bar);
    timing_emit(p, tid);
#endif
#ifdef CHK_PEER
    xcd_barrier(bar);
    STAMP(11);
    check_peer(p, lds, tid, lane, wave);
    xcd_barrier(bar);
    STAMP(12);
    check_emit(p, tid);
#endif
#endif
}

extern "C" void kernel_launch(void* const* d_in, const int* in_sizes, int n_in, void* d_out, int out_size, void* d_ws, size_t ws_size, hipStream_t stream) {
    static int grid = 0;
    if (grid == 0) {
        if (n_in != 21 || out_size != T * D || ws_size < WS_END) { fprintf(stderr, "kernel_launch: unexpected shapes (n_in %d out %d ws %zu need %zu)\n", n_in, out_size, ws_size, (size_t)WS_END); grid = -1; return; }
        int dev = 0, cus = 0, per_cu = 0;
        hipGetDevice(&dev); hipDeviceGetAttribute(&cus, hipDeviceAttributeMultiprocessorCount, dev);
        hipFuncSetAttribute((const void*)fwd_megakernel, hipFuncAttributeMaxDynamicSharedMemorySize, LDS_BYTES);
        hipOccupancyMaxActiveBlocksPerMultiprocessor(&per_cu, (const void*)fwd_megakernel, NTH, LDS_BYTES);
        (void)hipGetLastError();
        if (per_cu < 1) fprintf(stderr, "kernel_launch: occupancy query says %d blocks per CU\n", per_cu);
        grid = cus;
    }
    if (grid < 0) return;
    hipMemsetAsync((char*)d_ws + WS_CTL, 0, 64 * 1024, stream);
    Params p{};
    for (int i = 0; i < 21; ++i) p.in[i] = (const float*)d_in[i];
    p.out = (float*)d_out; p.ws = (unsigned char*)d_ws;
    hipLaunchKernelGGL(fwd_megakernel, dim3(grid), dim3(NTH), LDS_BYTES, stream, p);
}
```

```cpp
#include <hip/hip_runtime.h>
#include <cstdio>
#include <cstdint>

#define DI __device__ __forceinline__
#define LAS __attribute__((address_space(3)))
typedef unsigned short bf16_t;
typedef short bf16x8 __attribute__((ext_vector_type(8)));
typedef float f32x4 __attribute__((ext_vector_type(4)));
typedef float f32x2 __attribute__((ext_vector_type(2)));
typedef float f32x16 __attribute__((ext_vector_type(16)));
typedef unsigned u32x4 __attribute__((ext_vector_type(4)));
typedef unsigned u32x2 __attribute__((ext_vector_type(2)));
typedef __bf16 bf16x2v __attribute__((ext_vector_type(2)));

constexpr int T = 32768, D = 1024, SEQ = 4096, NB = 8;
constexpr int NTH = 512, NWV = 8;
constexpr int ZW = 2048;
constexpr int NIN = 2176;
constexpr float EPS = 1e-6f;

constexpr size_t MB = 1024 * 1024;
constexpr size_t WS_CTL   = 0;
constexpr size_t WS_MODP  = 64 * 1024;
constexpr size_t WS_WIN   = WS_MODP + 8 * 8 * 6144 * 4;
constexpr size_t WS_WOUT  = WS_WIN + (size_t)NIN * 1024 * 2;
constexpr size_t WS_WQ    = WS_WOUT + 1024 * 1024 * 2;
constexpr size_t WS_SKB   = WS_WQ + 2048 * 1024 * 2;
constexpr size_t WS_WP    = WS_SKB + 16 * 128 * 128 * 2;
constexpr size_t WS_AFB   = WS_WP + 4 * 128 * 128 * 2;
constexpr size_t WS_UB    = WS_AFB + (size_t)T * 32 * 4;
constexpr size_t WS_VB    = WS_UB + 32 * MB;
constexpr size_t WS_SU    = WS_UB + 16 * MB, WS_SV = WS_VB + 16 * MB;
constexpr size_t WS_RA    = WS_VB + 32 * MB;
constexpr size_t WS_RZ    = WS_RA + 64 * MB;
constexpr size_t WS_RS    = WS_RZ + 128 * MB;
constexpr size_t WS_RO    = WS_RS + 6 * 16 * MB + 1 * MB;
constexpr size_t WS_END   = WS_RO + 128 * MB;
static_assert(WS_END <= 512 * MB, "workspace too large");

struct Params { const float* in[21]; float* out; unsigned char* ws; };

DI unsigned pk2(float a, float b) { f32x2 f = {a, b}; bf16x2v h = __builtin_convertvector(f, bf16x2v); return __builtin_bit_cast(unsigned, h); }
DI float dot2bf(unsigned a, unsigned b, float c) { return __builtin_amdgcn_fdot2_f32_bf16(__builtin_bit_cast(bf16x2v, a), __builtin_bit_cast(bf16x2v, b), c, false); }
DI float bflo(unsigned u) { return __uint_as_float(u << 16); }
DI float bfhi(unsigned u) { return __uint_as_float(u & 0xFFFF0000u); }
DI float wave_sum(float v) {
#pragma unroll
    for (int o = 1; o < 64; o <<= 1) v += __shfl_xor(v, o);
    return v;
}
DI bf16x8 ld_frag16(const bf16_t* p) { return __builtin_bit_cast(bf16x8, *(const u32x4*)p); }
DI bf16x8 ld_frag_perm(const bf16_t* p, int g) {
    const u32x2 lo = *(const u32x2*)(p + 4 * g), hi = *(const u32x2*)(p + 16 + 4 * g);
    u32x4 v = {lo.x, lo.y, hi.x, hi.y}; return __builtin_bit_cast(bf16x8, v);
}
DI int perm32(int k) { return (k & ~31) | (((k >> 2) & 3) << 3) | (((k >> 4) & 1) << 2) | (k & 3); }
DI bf16x8 pack8(const f32x4& a, const f32x4& b) { u32x4 v = {pk2(a[0], a[1]), pk2(a[2], a[3]), pk2(b[0], b[1]), pk2(b[2], b[3])}; return __builtin_bit_cast(bf16x8, v); }
#define MFMA16(a, b, c) __builtin_amdgcn_mfma_f32_16x16x32_bf16((a), (b), (c), 0, 0, 0)
#define MFMA32(a, b, c) __builtin_amdgcn_mfma_f32_32x32x16_bf16((a), (b), (c), 0, 0, 0)

#define XB_TMO      128
#define XB_XCNT(j)  (256  + 64 * (j))
#define XB_XSUB(j)  (1280 + 64 * (j))
#define XB_XGEN(j)  (2304 + 64 * (j))
#define XB_TOP      3328
#define XB_TOPGEN   3392
#define XCD_BAR_WORDS 3456
#define XB_SPIN_CAP (1u << 22)
DI unsigned xb_ld(unsigned* p)              { return __hip_atomic_load(p, __ATOMIC_RELAXED, __HIP_MEMORY_SCOPE_AGENT); }
DI unsigned xb_add(unsigned* p, unsigned v) { return __hip_atomic_fetch_add(p, v, __ATOMIC_RELAXED, __HIP_MEMORY_SCOPE_AGENT); }
DI unsigned xb_xcc_id() { return (unsigned)__builtin_amdgcn_s_getreg((3 << 11) | 20) & 0xFu; }
#define XB_SPIN(cond, bar) do { unsigned _sp = 0; while (cond) { __builtin_amdgcn_s_sleep(1); \
    if ((++_sp & 255u) == 0u) { if (xb_ld(&(bar)[XB_TMO])) break; if (_sp > XB_SPIN_CAP) { atomicAdd(&(bar)[XB_TMO], 1u); break; } } } } while (0)
struct XcdBarrier { unsigned* bar; unsigned x; volatile LAS unsigned* st; };
DI XcdBarrier xcd_barrier_post(unsigned* bar, volatile LAS unsigned* st) {
    XcdBarrier b; b.bar = bar; b.x = xb_xcc_id(); b.st = st;
    if (threadIdx.x == 0) (void)xb_add(&bar[XB_XCNT(b.x)], 1u);
    return b;
}
DI void xcd_barrier_complete(unsigned* bar, unsigned x, unsigned& nloc, unsigned& nx) {
    const unsigned G = gridDim.x * gridDim.y * gridDim.z;
    unsigned sum, cnt, mine, sp = 0u;
    for (;;) {
        sum = 0u; cnt = 0u; mine = 0u;
#pragma unroll
        for (unsigned j = 0; j < 16; ++j) { const unsigned c = xb_ld(&bar[XB_XCNT(j)]); sum += c; cnt += (c > 0u) ? 1u : 0u; mine = (j == x) ? c : mine; }
        if (sum == G) break;
        __builtin_amdgcn_s_sleep(1);
        if ((++sp & 255u) == 0u) { if (xb_ld(&bar[XB_TMO])) break; if (sp > XB_SPIN_CAP) { atomicAdd(&bar[XB_TMO], 1u); break; } }
    }
    nloc = mine > 0u ? mine : 1u; nx = cnt > 0u ? cnt : 1u;
}
DI void xcd_barrier(const XcdBarrier& b) {
    asm volatile("s_waitcnt vmcnt(0)" ::: "memory");
    __syncthreads();
    if (threadIdx.x == 0) {
        unsigned* bar = b.bar;
        __builtin_amdgcn_s_waitcnt(0);
        unsigned nloc = b.st[0], nx = b.st[1];
        if (nloc == 0u) { xcd_barrier_complete(bar, b.x, nloc, nx); b.st[0] = nloc; b.st[1] = nx; }
        const unsigned old = xb_add(&bar[XB_XSUB(b.x)], 1u);
        const unsigned gen = old / nloc;
        if (old + 1u == (gen + 1u) * nloc) {
            __builtin_amdgcn_fence(__ATOMIC_RELEASE, "agent");
            asm volatile("s_waitcnt vmcnt(0)" ::: "memory");
            const unsigned og = xb_add(&bar[XB_TOP], 1u);
            const unsigned tg = og / nx;
            if (og + 1u == (tg + 1u) * nx) xb_add(&bar[XB_TOPGEN], 1u);
            else XB_SPIN(xb_ld(&bar[XB_TOPGEN]) == tg, bar);
            __builtin_amdgcn_fence(__ATOMIC_ACQUIRE, "agent");
            xb_add(&bar[XB_XGEN(b.x)], 1u);
            asm volatile("s_waitcnt vmcnt(0)" ::: "memory");
        } else {
            XB_SPIN(xb_ld(&bar[XB_XGEN(b.x)]) == gen, bar);
            __builtin_amdgcn_fence(__ATOMIC_ACQUIRE, "agent");
            asm volatile("s_waitcnt vmcnt(0)" ::: "memory");
        }
    }
    __syncthreads();
}

constexpr int LDS_BYTES = 152 * 1024;
constexpr int LDS_BARW = LDS_BYTES - 16;

DI void p0_transpose_item(const float* W, int ldw, int K, bf16_t* WT, int dst_row0, int src_col0, float scale, bool zero, LAS float* scr, int kb, int lane) {
    const int k0 = 64 * kb;
#pragma unroll 8
    for (int i = 0; i < 32; ++i) { const int kk = 2 * i + (lane >> 5); scr[kk * 33 + (lane & 31)] = zero ? 0.f : W[(size_t)(k0 + kk) * ldw + src_col0 + (lane & 31)] * scale; }
    asm volatile("s_waitcnt lgkmcnt(0)" ::: "memory");
    const int c = lane & 7;
#pragma unroll
    for (int j = 0; j < 4; ++j) { const int n = (lane >> 3) + 8 * j; const LAS float* s = scr + (8 * c) * 33 + n;
        u32x4 o; o.x = pk2(s[0 * 33], s[1 * 33]); o.y = pk2(s[2 * 33], s[3 * 33]); o.z = pk2(s[4 * 33], s[5 * 33]); o.w = pk2(s[6 * 33], s[7 * 33]);
        *(u32x4*)(WT + (size_t)(dst_row0 + n) * K + k0 + 8 * c) = o; }
    asm volatile("s_waitcnt lgkmcnt(0)" ::: "memory");
}

DI void phase0(const Params& p, LAS unsigned char* lds, int tid, int lane, int wave) {
    asm volatile("" : "+v"(tid), "+v"(lane));
    unsigned char* ws = p.ws;
    LAS float* sl = (LAS float*)lds;
    LAS float* scr = (LAS float*)(lds + 32768 + wave * 8448);
    const float* c = p.in[1];
    for (int e = tid; e < 8192; e += NTH) { const int b = e >> 10, k = e & 1023; const float v = c[e]; sl[k * 8 + b] = v / (1.f + __expf(-v)); }
    __syncthreads();
    const int gw = wave * gridDim.x + blockIdx.x, NGW = gridDim.x * NWV;
    constexpr int I_MOD = 768, I_WIN = 16 * 68, I_WOUT = 16 * 32, I_WQ = 16 * 64, I_WP = 32;
    constexpr int NITEMS = I_MOD + I_WIN + I_WOUT + I_WQ + I_WP;
    for (int it = gw; it < NITEMS; it += NGW) {
        int r = it;
        if (r < I_MOD) {
            const int cg = r % 96, ks = r / 96, n = cg * 64 + lane, k0 = ks * 128;
            const float* W = p.in[2] + (size_t)k0 * 6144 + n;
            float acc[8];
#pragma unroll
            for (int b = 0; b < 8; ++b) acc[b] = 0.f;
#pragma unroll 8
            for (int k = 0; k < 128; ++k) {
                const float w = W[(size_t)k * 6144];
                const f32x4 s0 = *(const LAS f32x4*)(sl + (k0 + k) * 8), s1 = *(const LAS f32x4*)(sl + (k0 + k) * 8 + 4);
                acc[0] += s0[0] * w; acc[1] += s0[1] * w; acc[2] += s0[2] * w; acc[3] += s0[3] * w;
                acc[4] += s1[0] * w; acc[5] += s1[1] * w; acc[6] += s1[2] * w; acc[7] += s1[3] * w;
            }
            float* mp = (float*)(ws + WS_MODP) + (size_t)ks * 8 * 6144 + n;
#pragma unroll
            for (int b = 0; b < 8; ++b) mp[b * 6144] = acc[b];
            continue;
        }
        r -= I_MOD;
        if (r < I_WIN) {
            const int kb = r / 68, nb = r % 68, n0 = nb * 32;
            int src; bool zero = false; float scale = 1.f;
            if (n0 < 1536) { src = n0; if (n0 < 256) scale = 0.125f; } else if (n0 < 2048) src = n0 + 32; else if (n0 < 2080) src = 1536 + (n0 - 2048); else { src = 0; zero = true; }
            p0_transpose_item(p.in[6], 2080, 1024, (bf16_t*)(ws + WS_WIN), n0, src, scale, zero, scr, kb, lane);
            continue;
        }
        r -= I_WIN;
        if (r < I_WOUT) { p0_transpose_item(p.in[14], 1024, 1024, (bf16_t*)(ws + WS_WOUT), (r % 32) * 32, (r % 32) * 32, 1.f, false, scr, r / 32, lane); continue; }
        r -= I_WOUT;
        if (r < I_WQ) { p0_transpose_item(p.in[17], 2048, 1024, (bf16_t*)(ws + WS_WQ), (r % 64) * 32, (r % 64) * 32, 1.f, false, scr, r / 64, lane); continue; }
        r -= I_WQ;
        { const int g = r >> 3, kb = (r >> 2) & 1, nb = r & 3;
          p0_transpose_item(p.in[12] + g * 16384, 128, 128, (bf16_t*)(ws + WS_WP) + g * 16384, nb * 32, nb * 32, 1.f, false, scr, kb, lane); }
    }
    const size_t gt = (size_t)blockIdx.x * NTH + tid, NGT = (size_t)gridDim.x * NTH;
    constexpr size_t NSK = (size_t)16 * 128 * 128 / 8;
    for (size_t j = gt; j < NSK; j += NGT) {
        const float* src = p.in[18]; bf16_t* dst = (bf16_t*)(ws + WS_SKB);
        const f32x4 a = *(const f32x4*)(src + j * 8), b = *(const f32x4*)(src + j * 8 + 4);
        u32x4 o = {pk2(a[0], a[1]), pk2(a[2], a[3]), pk2(b[0], b[1]), pk2(b[2], b[3])};
        *(u32x4*)(dst + j * 8) = o;
    }
}

DI void quant_load(const Params& p, int row, int lane, f32x4 (&v)[4]) {
    const int tb = row >> 14, e = row & 16383;
    const float* src = (tb ? p.in[20] : p.in[19]) + (size_t)e * D + 16 * lane;
#pragma unroll
    for (int q = 0; q < 4; ++q) v[q] = *(const f32x4*)(src + 4 * q);
}
DI void quant_store(const Params& p, int row, int lane, const f32x4 (&v)[4]) {
    unsigned char* ws = p.ws;
    const int tb = row >> 14, e = row & 16383;
    float m = 0.f;
#pragma unroll
    for (int q = 0; q < 4; ++q) m = fmaxf(m, fmaxf(fmaxf(fabsf(v[q][0]), fabsf(v[q][1])), fmaxf(fabsf(v[q][2]), fabsf(v[q][3]))));
#pragma unroll
    for (int o = 1; o < 64; o <<= 1) m = fmaxf(m, __shfl_xor(m, o));
    int ex = (int)((__float_as_uint(m) >> 23) & 0xFFu) - 127;
    if (m < 1e-30f) ex = 7;
    const float sc = __uint_as_float((unsigned)(127 + 7 - ex) << 23), isc = __uint_as_float((unsigned)(127 - 7 + ex) << 23);
    u32x4 o;
    if (tb) {
#pragma unroll
        for (int q = 0; q < 4; ++q) { int w = 0; w = __builtin_amdgcn_cvt_pk_fp8_f32(v[q][0] * sc, v[q][1] * sc, w, false); w = __builtin_amdgcn_cvt_pk_fp8_f32(v[q][2] * sc, v[q][3] * sc, w, true); o[q] = (unsigned)w; }
        if (lane == 0) ((float*)(ws + WS_SV))[e] = isc;
    } else {
        const float s8 = m > 1e-30f ? 127.f / m : 0.f;
#pragma unroll
        for (int q = 0; q < 4; ++q) {
            const int q0 = __float2int_rn(v[q][0] * s8), q1 = __float2int_rn(v[q][1] * s8), q2 = __float2int_rn(v[q][2] * s8), q3 = __float2int_rn(v[q][3] * s8);
            o[q] = (unsigned)(q0 & 0xFF) | ((unsigned)(q1 & 0xFF) << 8) | ((unsigned)(q2 & 0xFF) << 16) | ((unsigned)q3 << 24);
        }
        if (lane == 0) ((float*)(ws + WS_SU))[e] = m * (1.f / 127.f);
    }
    *(u32x4*)(ws + (tb ? WS_VB : WS_UB) + (size_t)e * 1024 + 16 * lane) = o;
}

DI float mod_at(const Params& p, int b, int n) {
    const float* mp = (const float*)(p.ws + WS_MODP) + (size_t)b * 6144 + n;
    float s = p.in[3][n];
#pragma unroll
    for (int ks = 0; ks < 8; ++ks) s += mp[(size_t)ks * 8 * 6144];
    return s;
}

DI void phase1(const Params& p, LAS unsigned char* lds, int tid, int lane, int wave) {
    asm volatile("" : "+v"(tid), "+v"(lane));
    LAS float* lA = (LAS float*)lds; LAS float* lB = lA + 1024;
    const float* x = p.in[0]; bf16_t* H = (bf16_t*)(p.ws + WS_RA);
    for (int rt = blockIdx.x; rt < T / 128; rt += gridDim.x) {
        const int b = rt / 32;
        __syncthreads();
        for (int d = tid; d < 1024; d += NTH) { lA[d] = p.in[4][d] * (1.f + mod_at(p, b, 1024 + d)); lB[d] = mod_at(p, b, d); }
        __syncthreads();
        for (int r0 = wave; r0 < 128; r0 += 4 * NWV) {
            f32x4 v[4][4];
#pragma unroll
            for (int u = 0; u < 4; ++u) { const f32x4* xr = (const f32x4*)(x + ((size_t)rt * 128 + r0 + u * NWV) * D) + lane;
#pragma unroll
                for (int j = 0; j < 4; ++j) v[u][j] = xr[64 * j]; }
#pragma unroll
            for (int u = 0; u < 4; ++u) {
                const size_t row = (size_t)rt * 128 + r0 + u * NWV;
                float ss = 0.f;
#pragma unroll
                for (int j = 0; j < 4; ++j) ss += v[u][j][0] * v[u][j][0] + v[u][j][1] * v[u][j][1] + v[u][j][2] * v[u][j][2] + v[u][j][3] * v[u][j][3];
                const float rstd = rsqrtf(wave_sum(ss) * (1.f / D) + EPS);
                u32x2* o = (u32x2*)(H + row * D) + lane;
#pragma unroll
                for (int j = 0; j < 4; ++j) {
                    const f32x4 a = *(const LAS f32x4*)(lA + 4 * lane + 256 * j), bb = *(const LAS f32x4*)(lB + 4 * lane + 256 * j);
                    u32x2 w = {pk2(v[u][j][0] * rstd * a[0] + bb[0], v[u][j][1] * rstd * a[1] + bb[1]), pk2(v[u][j][2] * rstd * a[2] + bb[2], v[u][j][3] * rstd * a[3] + bb[3])};
                    o[64 * j] = w;
                }
            }
        }
    }
}

struct EpiZ {
    bf16_t* Z; float* AFB;
    DI void operator()(int m, int n, const f32x4& v) const {
        if (n < ZW) { u32x2 w = {pk2(v[0], v[1]), pk2(v[2], v[3])}; *(u32x2*)(Z + (size_t)m * ZW + n) = w; }
        else if (n < ZW + 32) { *(f32x4*)(AFB + (size_t)m * 32 + (n - ZW)) = v; }
    }
};
struct EpiF32 { float* C; int ldc; DI void operator()(int m, int n, const f32x4& v) const { *(f32x4*)(C + (size_t)m * ldc + n) = v; } };
struct EpiBf16 { bf16_t* C; int ldc; DI void operator()(int m, int n, const f32x4& v) const { u32x2 w = {pk2(v[0], v[1]), pk2(v[2], v[3])}; *(u32x2*)(C + (size_t)m * ldc + n) = w; } };

template <class Epi>
DI void gemm_phase(const bf16_t* A, const bf16_t* Bt, int M, int N, int K, const Epi& epi, LAS unsigned char* lds, int tid, int lane, int wave, int nt_first = 0) {
    constexpr int BM = 256, BN = 128, BK = 64, STAGE = (BM + BN) * 128;
    const int ntn = N / BN - nt_first, ntiles = (M / BM) * ntn, nk = K / BK;
    const int wm = wave & 3, wn = wave >> 2, c15 = lane & 15, g = lane >> 4;
    const int lrow = tid >> 3, lch = tid & 7;
    for (int tile = blockIdx.x; tile < ntiles; tile += gridDim.x) {
        const int m0 = (tile / ntn) * BM, n0 = (tile % ntn + nt_first) * BN;
        f32x4 acc[4][4];
#pragma unroll
        for (int i = 0; i < 4; ++i)
#pragma unroll
            for (int j = 0; j < 4; ++j) acc[i][j] = (f32x4){0.f, 0.f, 0.f, 0.f};
        u32x4 ra[4], rb[2];
        const bf16_t* Ag = A + (size_t)(m0 + lrow) * K + lch * 8;
        const bf16_t* Bg = Bt + (size_t)(n0 + lrow) * K + lch * 8;
        const int woff = lrow * 128 + ((lch ^ (lrow & 7)) * 16);
        __syncthreads();
#pragma unroll
        for (int ps = 0; ps < 4; ++ps) ra[ps] = *(const u32x4*)(Ag + (size_t)(64 * ps) * K);
#pragma unroll
        for (int ps = 0; ps < 2; ++ps) rb[ps] = *(const u32x4*)(Bg + (size_t)(64 * ps) * K);
#pragma unroll
        for (int ps = 0; ps < 4; ++ps) *(LAS u32x4*)(lds + woff + ps * 8192) = ra[ps];
#pragma unroll
        for (int ps = 0; ps < 2; ++ps) *(LAS u32x4*)(lds + BM * 128 + woff + ps * 8192) = rb[ps];
        __syncthreads();
        for (int kt = 0; kt < nk; ++kt) {
            const bool more = (kt + 1 < nk);
            if (more) {
#pragma unroll
                for (int ps = 0; ps < 4; ++ps) ra[ps] = *(const u32x4*)(Ag + (size_t)(64 * ps) * K + (kt + 1) * BK);
#pragma unroll
                for (int ps = 0; ps < 2; ++ps) rb[ps] = *(const u32x4*)(Bg + (size_t)(64 * ps) * K + (kt + 1) * BK);
            }
            LAS unsigned char* sa = lds + (kt & 1) * STAGE; LAS unsigned char* sb = sa + BM * 128;
#pragma unroll
            for (int s = 0; s < 2; ++s) {
                bf16x8 fa[4], fb[4];
#pragma unroll
                for (int i = 0; i < 4; ++i) { const int row = wm * 64 + i * 16 + c15; fa[i] = *(const LAS bf16x8*)(sa + row * 128 + (((4 * s + g) ^ (row & 7)) * 16)); }
#pragma unroll
                for (int j = 0; j < 4; ++j) { const int row = wn * 64 + j * 16 + c15; fb[j] = *(const LAS bf16x8*)(sb + row * 128 + (((4 * s + g) ^ (row & 7)) * 16)); }
#pragma unroll
                for (int i = 0; i < 4; ++i)
#pragma unroll
                    for (int j = 0; j < 4; ++j) acc[i][j] = MFMA16(fb[j], fa[i], acc[i][j]);
            }
            if (more) {
                LAS unsigned char* da = lds + ((kt + 1) & 1) * STAGE;
#pragma unroll
                for (int ps = 0; ps < 4; ++ps) *(LAS u32x4*)(da + woff + ps * 8192) = ra[ps];
#pragma unroll
                for (int ps = 0; ps < 2; ++ps) *(LAS u32x4*)(da + BM * 128 + woff + ps * 8192) = rb[ps];
            }
            __syncthreads();
        }
#pragma unroll
        for (int i = 0; i < 4; ++i)
#pragma unroll
            for (int j = 0; j < 4; ++j) epi(m0 + wm * 64 + i * 16 + c15, n0 + wn * 64 + j * 16 + 4 * g, acc[i][j]);
    }
}

namespace pg8 {
#define PG8_LAS __attribute__((address_space(3)))
constexpr int BM = 256, BK = 64, HALF = 128, HTB = HALF * BK * 2  , STAGE_BYTES = 8 * HTB, NXCD = 8, WGM = 8;

__host__ __device__ __forceinline__ int lds_byte(int r, int c) { const int st = (r >> 4) * 2 + (c >> 5), rr = r & 15, cc = c & 31, ob = rr * 64 + cc * 2; return st * 1024 + (ob ^ (((ob >> 9) & 1) << 5)); }
__host__ __device__ __forceinline__ void stage_rc(int b, int& R, int& C) { const int st = b / 1024, sb = b % 1024, swz = sb ^ (((sb >> 9) & 1) << 5); R = (st >> 1) * 16 + swz / 64; C = (st & 1) * 32 + (swz % 64) / 2; }
__host__ __device__ __forceinline__ int perm32(int rho) { const int n = rho >> 4, i = rho & 15; return 8 * (i >> 2) + 4 * n + (i & 3); }

struct Unit { int pm, pn; };
struct Gemm { const bf16_t* A; const bf16_t* Bt; int M, N, K; };

struct StaticOrder {
    int nM, nN, nwg, G, c;
    __host__ __device__ void init(int M, int N, int G_, int c_) { nM = M / BM; nN = N / BM; nwg = nM * nN; G = G_; c = c_; }
    __host__ __device__ bool next(int i, Unit& u) const {
        const long L = (long)i * G + c; if (L >= nwg) return false;
        int wgid = (int)L; { const int q = nwg / NXCD, r = nwg % NXCD, xcd = wgid % NXCD, off = wgid / NXCD; wgid = (xcd < r ? xcd * (q + 1) : r * (q + 1) + (xcd - r) * q) + off; }
        const int nig = WGM * nN, gid = wgid / nig, fm = gid * WGM, gsz = (nM - fm) < WGM ? (nM - fm) : WGM;
        u.pm = fm + ((wgid % nig) % gsz); u.pn = (wgid % nig) / gsz; return true;
    }
    __device__ __forceinline__ void a_ready(const Unit&) const {}
    __device__ __forceinline__ void done(const Unit&) const {}
};

struct EpiB16 {
    static constexpr bool PERM = true, AFTER_DRAIN = false;
    bf16_t* O; int ldc;
    __device__ __forceinline__ void operator()(const f32x4 (&acc)[2][2][4][2], const Unit& u, int wr, int wc, int fr, int fq) const {
#pragma unroll
        for (int ai = 0; ai < 2; ++ai)
#pragma unroll
            for (int m = 0; m < 4; ++m) { bf16_t* rowp = O + (size_t)(u.pm * BM + ai * HALF + wr * 64 + m * 16 + fr) * ldc + u.pn * BM + wc * 32 + 8 * fq;
#pragma unroll
                for (int bj = 0; bj < 2; ++bj) { const f32x4 v0 = acc[ai][bj][m][0], v1 = acc[ai][bj][m][1];
                    u32x4 w; w.x = ::pk2(v0[0], v0[1]); w.y = ::pk2(v0[2], v0[3]); w.z = ::pk2(v1[0], v1[1]); w.w = ::pk2(v1[2], v1[3]);
                    *(u32x4*)(rowp + bj * HALF) = w; } }
    }
};
struct EpiF {
    static constexpr bool PERM = false, AFTER_DRAIN = false;
    float* O; int ldc;
    __device__ __forceinline__ void operator()(const f32x4 (&acc)[2][2][4][2], const Unit& u, int wr, int wc, int fr, int fq) const {
#pragma unroll
        for (int ai = 0; ai < 2; ++ai)
#pragma unroll
            for (int m = 0; m < 4; ++m) { float* rowp = O + (size_t)(u.pm * BM + ai * HALF + wr * 64 + m * 16 + fr) * ldc + u.pn * BM + wc * 32 + 4 * fq;
#pragma unroll
                for (int bj = 0; bj < 2; ++bj)
#pragma unroll
                    for (int n = 0; n < 2; ++n) *(f32x4*)(rowp + bj * HALF + 16 * n) = acc[ai][bj][m][n]; }
    }
};
template <class Epi, class Sched, bool ALIGN_EPI = false, bool SP2 = false>
__device__ __forceinline__ void gemm_phase(PG8_LAS unsigned char* lds, const Gemm g, const Sched& S, const Epi& E) {
    const int tid = threadIdx.x, wid = __builtin_amdgcn_readfirstlane(tid >> 6), lane = tid & 63, wr = wid >> 2, wc = wid & 3, fr = lane & 15, fq = lane >> 4;
    const int K = g.K, nt = K / BK;
    unsigned voffA[2], voffB[2];
#pragma unroll
    for (int i = 0; i < 2; ++i) { int R, C; stage_rc(tid * 16 + i * 8192, R, C); const int Rb = Epi::PERM ? ((R & ~31) + perm32(R & 31)) : R;
        voffA[i] = (unsigned)(R * K + C) * 2u; voffB[i] = (unsigned)(Rb * K + C) * 2u; }
    const size_t kstep = (size_t)(BK * 2);
    const size_t hstep = (size_t)HALF * K * 2;
    const size_t tstep = 2 * hstep;
    const unsigned ldsw = (unsigned)wid * 1024u;
    const int aoff = lds_byte(wr * 64 + fr, fq * 8), boff = lds_byte(wc * 32 + fr, fq * 8);
#define PG8_SA(b, h) (((b) * 2 + (h)) * HTB)
#define PG8_SB(b, h) ((4 + (b) * 2 + (h)) * HTB)
#define PG8_STAGE(bufoff, gbase, voff) do { _Pragma("unroll") for (int _i = 0; _i < 2; ++_i) \
        __builtin_amdgcn_global_load_lds((const unsigned*)((const char*)(gbase) + (voff)[_i]), (PG8_LAS unsigned*)(lds + (bufoff) + ldsw + _i * 8192), 16, 0, 0); } while (0)
#define PG8_LDA(dst, b, h) do { _Pragma("unroll") for (int m = 0; m < 4; ++m) _Pragma("unroll") for (int k = 0; k < 2; ++k) dst[m][k] = *(const PG8_LAS bf16x8*)(lds + PG8_SA(b, h) + aoff + m * 2048 + k * 1024); } while (0)
#define PG8_LDB(dst, b, h) do { _Pragma("unroll") for (int n = 0; n < 2; ++n) _Pragma("unroll") for (int k = 0; k < 2; ++k) dst[n][k] = *(const PG8_LAS bf16x8*)(lds + PG8_SB(b, h) + boff + n * 2048 + k * 1024); } while (0)
#define PG8_MMA(ai, bj, At, Bt) do { __builtin_amdgcn_s_setprio(1); _Pragma("unroll") for (int m = 0; m < 4; ++m) _Pragma("unroll") for (int n = 0; n < 2; ++n) _Pragma("unroll") for (int k = 0; k < 2; ++k) \
        acc[ai][bj][m][n] = __builtin_amdgcn_mfma_f32_16x16x32_bf16(Bt[n][k], At[m][k], acc[ai][bj][m][n], 0, 0, 0); __builtin_amdgcn_s_setprio(0); } while (0)
#define PG8_WAIT_V(n) asm volatile("s_waitcnt vmcnt(" #n ")" ::: "memory")
#define PG8_WAIT_L(n) asm volatile("s_waitcnt lgkmcnt(" #n ")" ::: "memory")
#define PG8_BAR __builtin_amdgcn_s_barrier()
#define PG8_SCHED __builtin_amdgcn_sched_barrier(0)
    Unit cur, nxt; int ui = 0;
    if (!S.next(0, cur)) return;
    f32x4 acc[2][2][4][2];
#pragma unroll
    for (int a = 0; a < 2; ++a)
#pragma unroll
        for (int b = 0; b < 2; ++b)
#pragma unroll
            for (int m = 0; m < 4; ++m)
#pragma unroll
                for (int n = 0; n < 2; ++n) acc[a][b][m][n] = (f32x4){0.f, 0.f, 0.f, 0.f};
    bf16x8 At[4][2], B0[2][2], B1[2][2];
    const char* cA = (const char*)g.A + (size_t)cur.pm * tstep; const char* cB = (const char*)g.Bt + (size_t)cur.pn * tstep;
    S.a_ready(cur);
    if constexpr (SP2) {
        PG8_STAGE(PG8_SB(0, 0), cB, voffB); PG8_STAGE(PG8_SB(0, 1), cB + hstep, voffB); PG8_STAGE(PG8_SA(0, 0), cA, voffA); PG8_STAGE(PG8_SA(0, 1), cA + hstep, voffA);
        if (wr == 1) PG8_BAR;
        PG8_WAIT_V(2); PG8_BAR;
        PG8_STAGE(PG8_SB(1, 0), cB + kstep, voffB); PG8_STAGE(PG8_SA(1, 0), cA + kstep, voffA); PG8_STAGE(PG8_SB(1, 1), cB + hstep + kstep, voffB);
        PG8_WAIT_V(6); PG8_BAR;
    } else {
        PG8_STAGE(PG8_SB(0, 0), cB, voffB); PG8_STAGE(PG8_SA(0, 0), cA, voffA); PG8_STAGE(PG8_SB(0, 1), cB + hstep, voffB); PG8_STAGE(PG8_SA(0, 1), cA + hstep, voffA);
        if (wr == 1) PG8_BAR;
        PG8_WAIT_V(4); PG8_BAR;
        PG8_STAGE(PG8_SB(1, 0), cB + kstep, voffB); PG8_STAGE(PG8_SA(1, 0), cA + kstep, voffA); PG8_STAGE(PG8_SB(1, 1), cB + hstep + kstep, voffB);
        PG8_WAIT_V(6); PG8_BAR;
    }
    for (;;) {
        const bool has_next = S.next(ui + 1, nxt);
        const char* nA = has_next ? (const char*)g.A + (size_t)nxt.pm * tstep : cA; const char* nB = has_next ? (const char*)g.Bt + (size_t)nxt.pn * tstep : cB;
        for (int t = 0; t < nt; t += 2) {
            const bool last = (t == nt - 2);
            const char* a1 = cA + (size_t)(t + 1) * kstep;
            const char* a2 = last ? nA : cA + (size_t)(t + 2) * kstep; const char* b2 = last ? nB : cB + (size_t)(t + 2) * kstep;
            const char* a3 = a2 + kstep; const char* b3 = b2 + kstep;
            if (last && has_next) S.a_ready(nxt);
            if constexpr (SP2) {
            PG8_LDB(B0, 0, 0); PG8_LDB(B1, 0, 1); PG8_SCHED; PG8_LDA(At, 0, 0); PG8_STAGE(PG8_SA(1, 1), a1 + hstep, voffA);
            PG8_WAIT_V(8); PG8_WAIT_L(0); PG8_BAR; PG8_MMA(0, 0, At, B0); PG8_MMA(0, 1, At, B1); PG8_BAR; PG8_SCHED;
            PG8_LDA(At, 0, 1); PG8_STAGE(PG8_SB(0, 0), b2, voffB); PG8_STAGE(PG8_SB(0, 1), b2 + hstep, voffB); PG8_STAGE(PG8_SA(0, 0), a2, voffA);
            PG8_WAIT_V(8); PG8_WAIT_L(0); PG8_BAR; PG8_MMA(1, 0, At, B0); PG8_MMA(1, 1, At, B1); PG8_BAR; PG8_SCHED;
            PG8_LDB(B0, 1, 0); PG8_LDB(B1, 1, 1); PG8_SCHED; PG8_LDA(At, 1, 0); PG8_STAGE(PG8_SA(0, 1), a2 + hstep, voffA);
            PG8_WAIT_V(8); PG8_WAIT_L(0); PG8_BAR; PG8_MMA(0, 0, At, B0); PG8_MMA(0, 1, At, B1); PG8_BAR; PG8_SCHED;
            PG8_LDA(At, 1, 1); PG8_STAGE(PG8_SB(1, 0), b3, voffB); PG8_STAGE(PG8_SB(1, 1), b3 + hstep, voffB); PG8_STAGE(PG8_SA(1, 0), a3, voffA);
            PG8_WAIT_V(8); PG8_WAIT_L(0); PG8_BAR; PG8_MMA(1, 0, At, B0); PG8_MMA(1, 1, At, B1); PG8_BAR; PG8_SCHED;
            } else {
            PG8_LDB(B0, 0, 0); PG8_SCHED; PG8_LDA(At, 0, 0); PG8_STAGE(PG8_SA(1, 1), a1 + hstep, voffA);
            PG8_WAIT_L(8); PG8_BAR; PG8_WAIT_L(0); PG8_MMA(0, 0, At, B0); PG8_BAR; PG8_SCHED;
            PG8_LDB(B1, 0, 1); PG8_STAGE(PG8_SB(0, 0), b2, voffB);
            PG8_BAR; PG8_WAIT_L(0); PG8_MMA(0, 1, At, B1); PG8_BAR;
            PG8_LDA(At, 0, 1); PG8_STAGE(PG8_SA(0, 0), a2, voffA);
            PG8_BAR; PG8_WAIT_L(0); PG8_MMA(1, 0, At, B0); PG8_BAR; PG8_SCHED;
            PG8_STAGE(PG8_SB(0, 1), b2 + hstep, voffB);
            PG8_WAIT_V(6); PG8_BAR; PG8_MMA(1, 1, At, B1); PG8_BAR;
            PG8_LDB(B0, 1, 0); PG8_SCHED; PG8_LDA(At, 1, 0); PG8_STAGE(PG8_SA(0, 1), a2 + hstep, voffA);
            PG8_WAIT_L(8); PG8_BAR; PG8_WAIT_L(0); PG8_MMA(0, 0, At, B0); PG8_BAR; PG8_SCHED;
            PG8_LDB(B1, 1, 1); PG8_STAGE(PG8_SB(1, 0), b3, voffB);
            PG8_BAR; PG8_WAIT_L(0); PG8_MMA(0, 1, At, B1); PG8_BAR;
            PG8_LDA(At, 1, 1); PG8_STAGE(PG8_SA(1, 0), a3, voffA);
            PG8_BAR; PG8_WAIT_L(0); PG8_MMA(1, 0, At, B0); PG8_BAR; PG8_SCHED;
            PG8_STAGE(PG8_SB(1, 1), b3 + hstep, voffB);
            PG8_WAIT_V(6); PG8_BAR; PG8_MMA(1, 1, At, B1); PG8_BAR;
            }
        }
        if constexpr (ALIGN_EPI) { if (wr == 0) PG8_BAR; }
        if constexpr (!Epi::AFTER_DRAIN) { E(acc, cur, wr, wc, fr, fq); S.done(cur); }
        if (!has_next) break;
#pragma unroll
        for (int a = 0; a < 2; ++a)
#pragma unroll
            for (int b = 0; b < 2; ++b)
#pragma unroll
                for (int m = 0; m < 4; ++m)
#pragma unroll
                    for (int n = 0; n < 2; ++n) acc[a][b][m][n] = (f32x4){0.f, 0.f, 0.f, 0.f};
        cur = nxt; cA = nA; cB = nB; ++ui;
        if constexpr (ALIGN_EPI) { if (wr == 1) PG8_BAR; }
    }
    PG8_WAIT_V(0);
    if constexpr (!ALIGN_EPI) { if (wr == 0) PG8_BAR; }
    PG8_BAR;
    if constexpr (Epi::AFTER_DRAIN) { E.fused(acc, cur, wr, wc, fr, fq, lds, wid, lane); S.done(cur); }
#undef PG8_SA
#undef PG8_SB
#undef PG8_STAGE
#undef PG8_LDA
#undef PG8_LDB
#undef PG8_MMA
#undef PG8_WAIT_V
#undef PG8_WAIT_L
#undef PG8_BAR
#undef PG8_SCHED
}
}

constexpr int NSEG = 8, SEGC = 64 / NSEG;
constexpr size_t WS_SSEG = WS_RA + 32 * MB;
constexpr size_t WS_GSEG = WS_SSEG + 16 * MB;
DI float logsig(float x) { return fminf(x, 0.f) - __logf(1.f + __expf(-fabsf(x))); }

DI void phase3a(const Params& p, LAS unsigned char* lds, int tid, int lane, int wave) {
    asm volatile("" : "+v"(tid), "+v"(lane));
    unsigned char* ws = p.ws;
    const bf16_t* Z = (const bf16_t*)(ws + WS_RZ);
    const float* AFB = (const float*)(ws + WS_AFB);
    bf16_t* QD[2] = {(bf16_t*)(ws + WS_RS), (bf16_t*)(ws + WS_RS + 48 * MB)};
    bf16_t* KI[2] = {(bf16_t*)(ws + WS_RS + 16 * MB), (bf16_t*)(ws + WS_RS + 64 * MB)};
    bf16_t* KE[2] = {(bf16_t*)(ws + WS_RS + 32 * MB), (bf16_t*)(ws + WS_RS + 80 * MB)};
    float* GAM[2] = {(float*)(ws + WS_RS + 96 * MB), (float*)(ws + WS_RS + 96 * MB + 512 * 1024)};
    bf16_t* VT = (bf16_t*)(ws + WS_RA);
    LAS float* la[2] = {(LAS float*)lds, (LAS float*)(lds + 16384)};
    LAS float* part[2] = {(LAS float*)(lds + 32768), (LAS float*)(lds + 32768 + 2048)};
    LAS bf16_t* keT[2] = {(LAS bf16_t*)(lds + 36864), (LAS bf16_t*)(lds + 36864 + 9216)};
    LAS bf16_t* vT = (LAS bf16_t*)(lds + 55296);
    const int c15 = lane & 15, g = lane >> 4;
    for (int task = blockIdx.x; task < 256; task += gridDim.x) {
      const int h = task & 3, pb = (task >> 2) & 7, b = task >> 5;
      f32x4 Sf[4], Sb[4];
#pragma unroll
      for (int kt = 0; kt < 4; ++kt) { Sf[kt] = (f32x4){0.f, 0.f, 0.f, 0.f}; Sb[kt] = (f32x4){0.f, 0.f, 0.f, 0.f}; }
      LAS float* gs = (LAS float*)(lds + 73728);
      LAS float* wl = (LAS float*)(lds + 74752);
      __syncthreads();
      if (tid < 128) gs[tid] = 0.f;
      for (int e = tid; e < 2048; e += NTH) { const int dir = e >> 10, r = (e >> 6) & 15, d = e & 63; wl[e] = (dir ? p.in[9] : p.in[7])[r * 256 + h * 64 + d]; }
      for (int ci = 0; ci < 8; ++ci) {
        const int n = pb * 8 + ci;
        const int tok0 = b * SEQ + n * 64;
        const int i = tid >> 3, dg = tid & 7, d0 = dg * 8;
        const size_t t = (size_t)tok0 + i;
        const u32x4 qv = *(const u32x4*)(Z + t * ZW + h * 64 + d0), kv = *(const u32x4*)(Z + t * ZW + 256 + h * 64 + d0);
        u32x4 vvp[2];
#pragma unroll
        for (int ps = 0; ps < 2; ++ps) { const int idx = tid + NTH * ps, vi = idx >> 4, ch = idx & 15; vvp[ps] = *(const u32x4*)(Z + ((size_t)tok0 + vi) * ZW + 512 + h * 128 + ch * 8); }
        const int qrow = ((task * 8 + ci) * NWV + wave) * 2;
        f32x4 qa[4]; quant_load(p, qrow, lane, qa);
        __syncthreads();
        {
            float af[16], ab[16];
#pragma unroll
            for (int q = 0; q < 4; ++q) { const f32x4 a = *(const f32x4*)(AFB + t * 32 + 4 * q), bb = *(const f32x4*)(AFB + t * 32 + 16 + 4 * q);
                af[4 * q] = a[0]; af[4 * q + 1] = a[1]; af[4 * q + 2] = a[2]; af[4 * q + 3] = a[3]; ab[4 * q] = bb[0]; ab[4 * q + 1] = bb[1]; ab[4 * q + 2] = bb[2]; ab[4 * q + 3] = bb[3]; }
            const LAS float* waf = wl + d0; const LAS float* wab = wl + 1024 + d0;
            float xf[8], xb[8];
#pragma unroll
            for (int e = 0; e < 8; ++e) { xf[e] = p.in[8][h * 64 + d0 + e]; xb[e] = p.in[10][h * 64 + d0 + e]; }
#pragma unroll
            for (int r = 0; r < 16; ++r) {
                const f32x4 w0 = *(const LAS f32x4*)(waf + r * 64), w1 = *(const LAS f32x4*)(waf + r * 64 + 4), v0 = *(const LAS f32x4*)(wab + r * 64), v1 = *(const LAS f32x4*)(wab + r * 64 + 4);
#pragma unroll
                for (int e = 0; e < 4; ++e) { xf[e] += af[r] * w0[e]; xf[4 + e] += af[r] * w1[e]; xb[e] += ab[r] * v0[e]; xb[4 + e] += ab[r] * v1[e]; }
            }
#pragma unroll
            for (int e = 0; e < 8; ++e) { la[0][i * 64 + d0 + e] = logsig(xf[e]) * 0.0625f; la[1][i * 64 + d0 + e] = logsig(xb[e]) * 0.0625f; }
        }
        quant_store(p, qrow, lane, qa); quant_load(p, qrow + 1, lane, qa);
        __syncthreads();
        {
            const int d = tid & 63, pt = tid >> 6;
            float run = 0.f;
#pragma unroll
            for (int j = 0; j < 8; ++j) { run += la[0][(8 * pt + j) * 64 + d]; la[0][(8 * pt + j) * 64 + d] = run; }
            part[0][pt * 64 + d] = run;
            run = 0.f;
#pragma unroll
            for (int j = 7; j >= 0; --j) { run += la[1][(8 * pt + j) * 64 + d]; la[1][(8 * pt + j) * 64 + d] = run; }
            part[1][pt * 64 + d] = run;
            __syncthreads();
            float of = 0.f, ob = 0.f;
#pragma unroll
            for (int q = 0; q < 8; ++q) { if (q < pt) of += part[0][q * 64 + d]; if (q > pt) ob += part[1][q * 64 + d]; }
#pragma unroll
            for (int j = 0; j < 8; ++j) { la[0][(8 * pt + j) * 64 + d] += of; la[1][(8 * pt + j) * 64 + d] += ob; }
        }
        quant_store(p, qrow + 1, lane, qa);
        __syncthreads();
        {
            float q[8], k[8];
#pragma unroll
            for (int e = 0; e < 4; ++e) { q[2 * e] = bflo(qv[e]); q[2 * e + 1] = bfhi(qv[e]); k[2 * e] = bflo(kv[e]); k[2 * e + 1] = bfhi(kv[e]); }
#pragma unroll
            for (int dir = 0; dir < 2; ++dir) {
                float qd[8], ki[8], ke[8];
#pragma unroll
                for (int e = 0; e < 8; ++e) {
                    const float bb = la[dir][i * 64 + d0 + e], bl = la[dir][(dir ? 0 : 63) * 64 + d0 + e];
                    qd[e] = q[e] * __expf(bb); ki[e] = k[e] * __expf(-bb); ke[e] = k[e] * __expf(bl - bb);
                    if (i == (dir ? 0 : 63)) GAM[dir][((size_t)(b * 4 + h) * 64 + n) * 64 + d0 + e] = __expf(bl);
                }
                {
                    u32x2 a0 = {pk2(qd[0], qd[1]), pk2(qd[2], qd[3])}, a1 = {pk2(qd[4], qd[5]), pk2(qd[6], qd[7])};
                    u32x2 b0 = {pk2(ki[0], ki[1]), pk2(ki[2], ki[3])}, b1 = {pk2(ki[4], ki[5]), pk2(ki[6], ki[7])};
                    *(u32x2*)(QD[dir] + t * 256 + h * 64 + perm32(d0)) = a0; *(u32x2*)(QD[dir] + t * 256 + h * 64 + perm32(d0 + 4)) = a1;
                    *(u32x2*)(KI[dir] + t * 256 + h * 64 + perm32(d0)) = b0; *(u32x2*)(KI[dir] + t * 256 + h * 64 + perm32(d0 + 4)) = b1;
                }
#pragma unroll
                for (int e = 0; e < 4; ++e) { const unsigned w = pk2(ke[2 * e], ke[2 * e + 1]); keT[dir][(d0 + 2 * e) * 72 + perm32(i)] = (bf16_t)(w & 0xFFFFu); keT[dir][(d0 + 2 * e + 1) * 72 + perm32(i)] = (bf16_t)(w >> 16); }
            }
#pragma unroll
            for (int ps = 0; ps < 2; ++ps) {
                const int idx = tid + NTH * ps, vi = idx >> 4, ch = idx & 15;
                const u32x4 vv = vvp[ps];
#pragma unroll
                for (int e = 0; e < 4; ++e) { vT[(ch * 8 + 2 * e) * 72 + perm32(vi)] = (bf16_t)(vv[e] & 0xFFFFu); vT[(ch * 8 + 2 * e + 1) * 72 + perm32(vi)] = (bf16_t)(vv[e] >> 16); }
            }
        }
        __syncthreads();
        {
            const int dk = tid >> 3, ch = tid & 7;
#pragma unroll
            for (int dir = 0; dir < 2; ++dir) {
                const u32x4 v = *(const LAS u32x4*)(keT[dir] + dk * 72 + ch * 8);
                *(u32x4*)(KE[dir] + ((size_t)(b * 64 + n) * 256 + h * 64 + dk) * 64 + ch * 8) = v;
            }
#pragma unroll
            for (int ps = 0; ps < 2; ++ps) {
                const int idx = tid + NTH * ps, dv = idx >> 3, c8 = idx & 7;
                const LAS bf16_t* s = vT + dv * 72 + c8 * 8;
                u32x4 v; v.x = s[0] | ((unsigned)s[1] << 16); v.y = s[2] | ((unsigned)s[3] << 16); v.z = s[4] | ((unsigned)s[5] << 16); v.w = s[6] | ((unsigned)s[7] << 16);
                *(u32x4*)(VT + ((size_t)(b * 64 + n) * 512 + h * 128 + dv) * 64 + c8 * 8) = v;
            }
            bf16x8 vb[2];
#pragma unroll
            for (int sk = 0; sk < 2; ++sk) vb[sk] = *(const LAS bf16x8*)(vT + (16 * wave + c15) * 72 + 32 * sk + 8 * g);
#pragma unroll
            for (int kt = 0; kt < 4; ++kt) {
                const f32x4 gf = {__expf(la[0][63 * 64 + 16 * kt + 4 * g]), __expf(la[0][63 * 64 + 16 * kt + 4 * g + 1]), __expf(la[0][63 * 64 + 16 * kt + 4 * g + 2]), __expf(la[0][63 * 64 + 16 * kt + 4 * g + 3])};
                const LAS float* gq = gs + (ci & 1) * 128 + 64 + 16 * kt + 4 * g;
                const f32x4 pb = {__expf(gq[0]), __expf(gq[1]), __expf(gq[2]), __expf(gq[3])};
                f32x4 uf = Sf[kt] * gf, ub = (f32x4){0.f, 0.f, 0.f, 0.f};
#pragma unroll
                for (int sk = 0; sk < 2; ++sk) {
                    uf = MFMA16(*(const LAS bf16x8*)(keT[0] + (16 * kt + c15) * 72 + 32 * sk + 8 * g), vb[sk], uf);
                    ub = MFMA16(*(const LAS bf16x8*)(keT[1] + (16 * kt + c15) * 72 + 32 * sk + 8 * g), vb[sk], ub);
                }
                Sf[kt] = uf;
                Sb[kt] = Sb[kt] + pb * ub;
            }
            if (tid < 64) { gs[((ci + 1) & 1) * 128 + tid] = gs[(ci & 1) * 128 + tid] + la[0][63 * 64 + tid]; gs[((ci + 1) & 1) * 128 + 64 + tid] = gs[(ci & 1) * 128 + 64 + tid] + la[1][tid]; }
        }
      }
      {
        f32x4* SSEG = (f32x4*)(ws + WS_SSEG); float* GSEG = (float*)(ws + WS_GSEG);
        const int sl = wave >> 1, nt = wave & 1;
#pragma unroll
        for (int dir = 0; dir < 2; ++dir) {
            const int bhd = b * 8 + h * 2 + dir, sg = dir ? 7 - pb : pb, tk = ((bhd * 8 + sg) << 2) | sl;
#pragma unroll
            for (int kt = 0; kt < 4; ++kt) {
                SSEG[((size_t)tk * 8 + kt * 2 + nt) * 64 + lane] = dir ? Sb[kt] : Sf[kt];
            }
        }
        __syncthreads();
        if (tid < 128) { const int dir = tid >> 6, d = tid & 63, bhd = b * 8 + h * 2 + dir, sg = dir ? 7 - pb : pb; GSEG[(bhd * 8 + sg) * 64 + d] = __expf(gs[tid]); }
      }
    }
}

template <bool FULL>
DI void phase3b(const Params& p, int lane, int wave) {
    asm volatile("" : "+v"(lane));
    unsigned char* ws = p.ws;
    const int c15 = lane & 15, g = lane >> 4;
    for (int task = blockIdx.x * NWV + wave; task < 2048; task += gridDim.x * NWV) {
        const int sl = task & 3, pair = task >> 2, sg = pair & 7, bhd = pair >> 3;
        const int dir = bhd & 1, h = (bhd >> 1) & 3, b = bhd >> 3;
        const bf16_t* QD = (const bf16_t*)(ws + WS_RS + (dir ? 48 : 0) * MB) + (size_t)b * SEQ * 256 + h * 64;
        const bf16_t* KI = (const bf16_t*)(ws + WS_RS + (dir ? 64 : 16) * MB) + (size_t)b * SEQ * 256 + h * 64;
        const bf16_t* KE = (const bf16_t*)(ws + WS_RS + (dir ? 80 : 32) * MB) + ((size_t)b * 64 * 256 + h * 64) * 64;
        const float* GAM = (const float*)(ws + WS_RS + 96 * MB + (dir ? 512 * 1024 : 0)) + (size_t)(b * 4 + h) * 64 * 64;
        const bf16_t* VT = (const bf16_t*)(ws + WS_RA) + ((size_t)b * 64 * 512 + h * 128 + sl * 32) * 64;
        bf16_t* O = (bf16_t*)(ws + WS_RO + (dir ? 64 : 0) * MB) + (size_t)b * SEQ * 512 + h * 128 + sl * 32;
        f32x4* SSEG = (f32x4*)(ws + WS_SSEG); float* GSEG = (float*)(ws + WS_GSEG);
        f32x4 S[4][2];
#pragma unroll
        for (int kt = 0; kt < 4; ++kt) { S[kt][0] = (f32x4){0.f, 0.f, 0.f, 0.f}; S[kt][1] = (f32x4){0.f, 0.f, 0.f, 0.f}; }
        if (FULL) {
            for (int s2 = 0; s2 < sg; ++s2) {
                const int t2 = ((bhd * 8 + s2) << 2) | sl;
#pragma unroll
                for (int kt = 0; kt < 4; ++kt) {
                    const f32x4 gm = *(const f32x4*)(GSEG + (bhd * 8 + s2) * 64 + 16 * kt + 4 * g);
#pragma unroll
                    for (int nt = 0; nt < 2; ++nt) S[kt][nt] = S[kt][nt] * gm + SSEG[((size_t)t2 * 8 + kt * 2 + nt) * 64 + lane];
                }
            }
        }
        f32x4 gprod[4];
#pragma unroll
        for (int kt = 0; kt < 4; ++kt) gprod[kt] = (f32x4){1.f, 1.f, 1.f, 1.f};
        for (int cs = 0; cs < SEGC; ++cs) {
            const int cn = sg * SEGC + cs, n = dir ? 63 - cn : cn;
            bf16x8 kea[4][2], vb[2][2];
            f32x4 gam[4];
#pragma unroll
            for (int jt = 0; jt < 4; ++jt)
#pragma unroll
                for (int s = 0; s < 2; ++s) kea[jt][s] = ld_frag16(KE + ((size_t)n * 256 + 16 * jt + c15) * 64 + 32 * s + 8 * g);
#pragma unroll
            for (int nt = 0; nt < 2; ++nt)
#pragma unroll
                for (int s = 0; s < 2; ++s) vb[nt][s] = ld_frag16(VT + ((size_t)n * 512 + 16 * nt + c15) * 64 + 32 * s + 8 * g);
#pragma unroll
            for (int kt = 0; kt < 4; ++kt) gam[kt] = *(const f32x4*)(GAM + n * 64 + 16 * kt + 4 * g);
            if (FULL) {
                bf16x8 kia[4][2];
#pragma unroll
                for (int jt = 0; jt < 4; ++jt)
#pragma unroll
                    for (int s = 0; s < 2; ++s) kia[jt][s] = ld_frag16(KI + (size_t)(n * 64 + 16 * jt + c15) * 256 + 32 * s + 8 * g);
                bf16x8 sb[2][2];
#pragma unroll
                for (int nt = 0; nt < 2; ++nt)
#pragma unroll
                    for (int s = 0; s < 2; ++s) sb[nt][s] = pack8(S[2 * s][nt], S[2 * s + 1][nt]);
#pragma unroll
                for (int it = 0; it < 4; ++it) {
                    bf16x8 qdb[2];
#pragma unroll
                    for (int s = 0; s < 2; ++s) qdb[s] = ld_frag16(QD + (size_t)(n * 64 + 16 * it + c15) * 256 + 32 * s + 8 * g);
                    f32x4 sc[4];
#pragma unroll
                    for (int jt = 0; jt < 4; ++jt) {
                        sc[jt] = (f32x4){0.f, 0.f, 0.f, 0.f};
#pragma unroll
                        for (int s = 0; s < 2; ++s) sc[jt] = MFMA16(kia[jt][s], qdb[s], sc[jt]);
                        const int ii = 16 * it + c15;
#pragma unroll
                        for (int r = 0; r < 4; ++r) { const int jj = 16 * jt + 4 * g + r; const bool keep = dir ? (jj > ii) : (jj <= ii); sc[jt][r] = keep ? sc[jt][r] : 0.f; }
                    }
                    bf16x8 pa[2] = {pack8(sc[0], sc[1]), pack8(sc[2], sc[3])};
#pragma unroll
                    for (int nt = 0; nt < 2; ++nt) {
                        f32x4 o = (f32x4){0.f, 0.f, 0.f, 0.f};
#pragma unroll
                        for (int s = 0; s < 2; ++s) { o = MFMA16(vb[nt][s], pa[s], o); o = MFMA16(sb[nt][s], qdb[s], o); }
                        { u32x2 w = {pk2(o[0], o[1]), pk2(o[2], o[3])}; *(u32x2*)(O + (size_t)(n * 64 + 16 * it + c15) * 512 + 16 * nt + 4 * g) = w; }
                    }
                }
            }
#pragma unroll
            for (int kt = 0; kt < 4; ++kt) {
                if (!FULL) gprod[kt] = gprod[kt] * gam[kt];
#pragma unroll
                for (int nt = 0; nt < 2; ++nt) {
                    f32x4 a = S[kt][nt] * gam[kt];
#pragma unroll
                    for (int s = 0; s < 2; ++s) a = MFMA16(kea[kt][s], vb[nt][s], a);
                    S[kt][nt] = a;
                }
            }
        }
        if (!FULL) {
#pragma unroll
            for (int kt = 0; kt < 4; ++kt) {
#pragma unroll
                for (int nt = 0; nt < 2; ++nt) SSEG[((size_t)task * 8 + kt * 2 + nt) * 64 + lane] = S[kt][nt];
                if (sl == 0 && c15 == 0) *(f32x4*)(GSEG + (bhd * 8 + sg) * 64 + 16 * kt + 4 * g) = gprod[kt];
            }
        }
    }
}

DI void phase4a(const Params& p, LAS unsigned char* lds, int tid, int lane, int wave) {
    asm volatile("" : "+v"(tid), "+v"(lane));
    unsigned char* ws = p.ws;
    const bf16_t* Z = (const bf16_t*)(ws + WS_RZ);
    bf16_t* MIX = (bf16_t*)(ws + WS_RA);
    const bf16_t* OF = (const bf16_t*)(ws + WS_RO); const bf16_t* OB = (const bf16_t*)(ws + WS_RO + 64 * MB);
    const bf16_t* WP = (const bf16_t*)(ws + WS_WP);
    LAS bf16_t* pt = (LAS bf16_t*)lds;
    LAS unsigned char* at = lds + 81920;
    const int c15 = lane & 15, g = lane >> 4;
    const f32x4 gh0 = *(const f32x4*)(p.in[11] + 8 * lane), gh1 = *(const f32x4*)(p.in[11] + 8 * lane + 4);
    for (int tile = blockIdx.x; tile < T / 64; tile += gridDim.x) {
        const int tok0 = tile * 64, s0 = tok0 & (SEQ - 1);
        __syncthreads();
#pragma unroll
        for (int ps = 0; ps < 10; ++ps) {
            const int idx = tid + NTH * ps, rr = idx >> 6, ch = idx & 63, sq = s0 - 8 + rr;
            u32x4 v = {0u, 0u, 0u, 0u};
            if (sq >= 0 && sq < SEQ) v = *(const u32x4*)(Z + ((size_t)tok0 - 8 + rr) * ZW + 1536 + ch * 8);
            *(LAS u32x4*)(pt + rr * 512 + ch * 8) = v;
        }
#pragma unroll
        for (int hb = 0; hb < 2; ++hb) {
            u32x4 a[4], bq[4], rv[4];
#pragma unroll
            for (int j = 0; j < 4; ++j) { const size_t t = (size_t)tok0 + wave * 8 + hb * 4 + j;
                a[j] = *(const u32x4*)(OF + t * 512 + 8 * lane); bq[j] = *(const u32x4*)(OB + t * 512 + 8 * lane); rv[j] = *(const u32x4*)(Z + t * ZW + 1024 + 8 * lane); }
#pragma unroll
            for (int j = 0; j < 4; ++j) { const size_t t = (size_t)tok0 + wave * 8 + hb * 4 + j;
                float o[8], r[8];
#pragma unroll
                for (int e = 0; e < 4; ++e) { o[2 * e] = bflo(a[j][e]) + bflo(bq[j][e]); o[2 * e + 1] = bfhi(a[j][e]) + bfhi(bq[j][e]); r[2 * e] = bflo(rv[j][e]); r[2 * e + 1] = bfhi(rv[j][e]); }
                float ss = 0.f;
#pragma unroll
                for (int e = 0; e < 8; ++e) ss += o[e] * o[e];
                ss += __shfl_xor(ss, 1); ss += __shfl_xor(ss, 2); ss += __shfl_xor(ss, 4); ss += __shfl_xor(ss, 8);
                const float rstd = rsqrtf(ss * (1.f / 128.f) + EPS);
                float y[8];
#pragma unroll
                for (int e = 0; e < 8; ++e) { const float gg = e < 4 ? gh0[e] : gh1[e - 4]; y[e] = o[e] * rstd * gg * (r[e] / (1.f + __expf(-r[e]))); }
                u32x4 w = {pk2(y[0], y[1]), pk2(y[2], y[3]), pk2(y[4], y[5]), pk2(y[6], y[7])};
                *(u32x4*)(MIX + t * D + 8 * lane) = w; }
        }
        __syncthreads();
        {
            const int c = tid, gi = c >> 7, cc = c & 127, hw = 1 << gi;
            LAS unsigned char* ag = at + gi * 16384;
            float sum = 0.f;
            {   const int lo = max(s0 - hw, 0), hi = min(s0 + hw, SEQ);
                for (int rr = lo; rr < hi; ++rr) sum += bflo((unsigned)pt[(rr - s0 + 8) * 512 + c]); }
#pragma unroll 4
            for (int i = 0; i < 64; ++i) {
                const int sq = s0 + i, lo = max(sq - hw, 0), hi = min(sq + hw, SEQ);
                const float val = sum / (float)(hi - lo) - bflo((unsigned)pt[(i + 8) * 512 + c]);
                *(LAS bf16_t*)(ag + i * 256 + (((cc >> 3) ^ (i & 15)) * 16) + (cc & 7) * 2) = (bf16_t)(pk2(val, 0.f) & 0xFFFFu);
                if (sq + hw < SEQ) sum += bflo((unsigned)pt[(i + 8 + hw) * 512 + c]);
                if (sq - hw >= 0) sum -= bflo((unsigned)pt[(i + 8 - hw) * 512 + c]);
            }
        }
        __syncthreads();
        {
            const int gi = wave >> 1, dh = wave & 1;
            LAS unsigned char* ag = at + gi * 16384;
            f32x4 acc[4][4];
#pragma unroll
            for (int mt = 0; mt < 4; ++mt)
#pragma unroll
                for (int nt = 0; nt < 4; ++nt) acc[mt][nt] = (f32x4){0.f, 0.f, 0.f, 0.f};
#pragma unroll
            for (int s = 0; s < 4; ++s) {
                bf16x8 af[4];
#pragma unroll
                for (int mt = 0; mt < 4; ++mt) { const int row = mt * 16 + c15; af[mt] = *(const LAS bf16x8*)(ag + row * 256 + (((4 * s + g) ^ (row & 15)) * 16)); }
#pragma unroll
                for (int nt = 0; nt < 4; ++nt) {
                    const bf16x8 wf = ld_frag16(WP + (size_t)gi * 16384 + (dh * 64 + 16 * nt + c15) * 128 + 32 * s + 8 * g);
#pragma unroll
                    for (int mt = 0; mt < 4; ++mt) acc[mt][nt] = MFMA16(wf, af[mt], acc[mt][nt]);
                }
            }
#pragma unroll
            for (int nt = 0; nt < 4; ++nt) {
                const f32x4 ps = *(const f32x4*)(p.in[13] + gi * 128 + dh * 64 + 16 * nt + 4 * g);
#pragma unroll
                for (int mt = 0; mt < 4; ++mt) {
                    const f32x4 v = acc[mt][nt] * ps;
                    u32x2 w = {pk2(v[0], v[1]), pk2(v[2], v[3])};
                    *(u32x2*)(MIX + ((size_t)tok0 + mt * 16 + c15) * D + 512 + gi * 128 + dh * 64 + 16 * nt + 4 * g) = w;
                }
            }
        }
    }
}

DI void phase4c(const Params& p, LAS unsigned char* lds, int tid, int lane, int wave) {
    asm volatile("" : "+v"(tid), "+v"(lane));
    LAS float* lG = (LAS float*)lds; LAS float* lA = lG + 1024; LAS float* lB = lA + 1024; LAS float* lP = lB + 1024;
    const float* x = p.in[0]; const bf16_t* MIXO = (const bf16_t*)(p.ws + WS_RZ); bf16_t* H2 = (bf16_t*)(p.ws + WS_RA);
    for (int rt = blockIdx.x; rt < T / 128; rt += gridDim.x) {
        const int b = rt / 32;
        __syncthreads();
        for (int d = tid; d < 1024; d += NTH) { lG[d] = mod_at(p, b, 2048 + d); lA[d] = p.in[15][d] * (1.f + mod_at(p, b, 4096 + d)); lB[d] = mod_at(p, b, 3072 + d); lP[d] = p.in[5][d]; }
        __syncthreads();
        for (int r0 = wave; r0 < 128; r0 += 2 * NWV) {
            f32x4 m[2][4], xv[2][4];
#pragma unroll
            for (int u = 0; u < 2; ++u) {
                const size_t row = (size_t)rt * 128 + r0 + u * NWV;
                const u32x2* mr = (const u32x2*)(MIXO + row * D) + lane; const f32x4* xr = (const f32x4*)(x + row * D) + lane;
#pragma unroll
                for (int j = 0; j < 4; ++j) { const u32x2 mv = mr[64 * j]; m[u][j] = (f32x4){bflo(mv.x), bfhi(mv.x), bflo(mv.y), bfhi(mv.y)}; xv[u][j] = xr[64 * j]; }
            }
#pragma unroll
            for (int u = 0; u < 2; ++u) {
                const size_t row = (size_t)rt * 128 + r0 + u * NWV;
                float ss = 0.f;
#pragma unroll
                for (int j = 0; j < 4; ++j) ss += m[u][j][0] * m[u][j][0] + m[u][j][1] * m[u][j][1] + m[u][j][2] * m[u][j][2] + m[u][j][3] * m[u][j][3];
                const float rstd = rsqrtf(wave_sum(ss) * (1.f / D) + EPS);
                float s2 = 0.f;
#pragma unroll
                for (int j = 0; j < 4; ++j) {
                    const f32x4 gt = *(const LAS f32x4*)(lG + 4 * lane + 256 * j), pm = *(const LAS f32x4*)(lP + 4 * lane + 256 * j);
                    xv[u][j] = xv[u][j] + gt * (m[u][j] * rstd * pm);
                    s2 += xv[u][j][0] * xv[u][j][0] + xv[u][j][1] * xv[u][j][1] + xv[u][j][2] * xv[u][j][2] + xv[u][j][3] * xv[u][j][3];
                }
                const float rstd2 = rsqrtf(wave_sum(s2) * (1.f / D) + EPS);
                f32x4* orow = (f32x4*)(p.out + row * D) + lane; u32x2* hrow = (u32x2*)(H2 + row * D) + lane;
#pragma unroll
                for (int j = 0; j < 4; ++j) {
                    orow[64 * j] = xv[u][j];
                    const f32x4 a = *(const LAS f32x4*)(lA + 4 * lane + 256 * j), bb = *(const LAS f32x4*)(lB + 4 * lane + 256 * j);
                    const f32x4 hv = xv[u][j] * rstd2 * a + bb;
                    u32x2 w = {pk2(hv[0], hv[1]), pk2(hv[2], hv[3])};
                    hrow[64 * j] = w;
                }
            }
        }
    }
}

DI int skey(float v, int idx, int mask) { int u = __float_as_int(v); u ^= (u >> 31) & 0x7FFFFFFF; return (u & ~mask) | idx; }
DI float sval(int k, int mask) { int u = k & ~mask; u ^= (u >> 31) & 0x7FFFFFFF; return __int_as_float(u); }
DI void cswap(int& a, int& b) { const int mx = max(a, b), mn = min(a, b); a = mx; b = mn; }
DI void sort16_desc(int (&a)[16]) {
#pragma unroll
    for (int k = 2; k <= 16; k <<= 1) {
#pragma unroll
        for (int j = k >> 1; j > 0; j >>= 1) {
#pragma unroll
            for (int i = 0; i < 16; ++i) {
                const int l = i ^ j;
                if (l > i) { if ((i & k) == 0) cswap(a[i], a[l]); else cswap(a[l], a[i]); }
            }
        }
    }
}
DI void merge16_desc(int (&x)[16], const int (&y)[16]) {
#pragma unroll
    for (int i = 0; i < 16; ++i) x[i] = max(x[i], y[15 - i]);
#pragma unroll
    for (int j = 8; j > 0; j >>= 1) {
#pragma unroll
        for (int i = 0; i < 16; ++i) { const int l = i ^ j; if (l > i) cswap(x[i], x[l]); }
    }
}

DI void phase5b(const Params& p, LAS unsigned char* lds, int tid, int lane, int wave) {
    asm volatile("" : "+v"(tid), "+v"(lane));
    unsigned char* ws = p.ws;
    const bf16_t* Q2 = (const bf16_t*)(ws + WS_RZ);
    const bf16_t* SKB = (const bf16_t*)(ws + WS_SKB);
    int* EIDX = (int*)(ws + WS_RS); float* GATE = (float*)(ws + WS_RS + 16 * MB);
    LAS unsigned char* tab = lds + tid * 32;
    LAS unsigned char* skl = lds + 16384;
    const int c31 = lane & 31, hi = lane >> 5;
    for (int btask = blockIdx.x; btask < 256; btask += gridDim.x) {
        const int h = btask & 7, tgc = btask >> 3;
        __syncthreads();
#pragma unroll
        for (int ps = 0; ps < 8; ++ps) {
            const int idx = tid + NTH * ps, row = idx >> 4, ch = idx & 15;
            const u32x4 v = *(const u32x4*)(SKB + ((size_t)h * 256 + row) * 128 + ch * 8);
            *(LAS u32x4*)(skl + row * 256 + ((ch ^ (row & 15)) * 16)) = v;
        }
        __syncthreads();
      for (int ti = 0; ti < 4; ++ti) {
        const int tg = tgc * 32 + wave * 4 + ti;
        const size_t tok = (size_t)tg * 32 + c31;
        int lst[2][16];
        bf16x8 bq[2][8];
#pragma unroll
        for (int pp = 0; pp < 2; ++pp) {
            const bf16_t* qp = Q2 + tok * 2048 + h * 256 + pp * 128 + 8 * hi;
            asm volatile("" : "+v"(qp));
#pragma unroll
            for (int ks = 0; ks < 8; ++ks) bq[pp][ks] = ld_frag16(qp + 16 * ks);
        }
#pragma unroll
        for (int pp = 0; pp < 2; ++pp) {
            int run[16];
#pragma unroll
            for (int r = 0; r < 16; ++r) run[r] = (int)0x80000000;
#pragma unroll 1
            for (int kt = 0; kt < 4; ++kt) {
                const LAS unsigned char* kb = skl + pp * 32768 + (32 * kt + c31) * 256;
                f32x16 acc;
#pragma unroll
                for (int r = 0; r < 16; ++r) acc[r] = 0.f;
#pragma unroll
                for (int ks = 0; ks < 8; ++ks) acc = MFMA32(*(const LAS bf16x8*)(kb + (((2 * ks + hi) ^ (c31 & 15)) * 16)), bq[pp][ks], acc);
                int cur[16];
#pragma unroll
                for (int r = 0; r < 16; ++r) cur[r] = skey(acc[r], 32 * kt + 8 * (r >> 2) + 4 * hi + (r & 3), 0x7F);
                sort16_desc(cur);
                merge16_desc(run, cur);
            }
            int oth[16];
#pragma unroll
            for (int r = 0; r < 16; ++r) oth[r] = __shfl_xor(run[r], 32);
            merge16_desc(run, oth);
#pragma unroll
            for (int r = 0; r < 16; ++r) lst[pp][r] = run[r];
        }
#pragma unroll
        for (int pp = 0; pp < 2; ++pp) {
            u32x4 w;
#pragma unroll
            for (int q = 0; q < 4; ++q) w[q] = (lst[pp][4 * q] & 0x7F) | ((lst[pp][4 * q + 1] & 0x7F) << 8) | ((lst[pp][4 * q + 2] & 0x7F) << 16) | ((lst[pp][4 * q + 3] & 0x7F) << 24);
            *(LAS u32x4*)(tab + 16 * pp) = w;
        }
        float va[16], vb[16];
#pragma unroll
        for (int r = 0; r < 16; ++r) { va[r] = sval(lst[0][r], 0x7F); vb[r] = sval(lst[1][r], 0x7F); }
        int cand[4][16];
        {
            int cnt = 0;
#pragma unroll
            for (int i = 0; i < 16; ++i)
#pragma unroll
                for (int j = 0; j < 16; ++j)
                    if ((i + 1) * (j + 1) <= 16) { cand[cnt >> 4][cnt & 15] = skey(va[i] + vb[j], (i << 4) | j, 0xFF); ++cnt; }
#pragma unroll
            for (int q = 50; q < 64; ++q) cand[q >> 4][q & 15] = (int)0x80000000;
        }
        sort16_desc(cand[0]); sort16_desc(cand[1]); sort16_desc(cand[2]); sort16_desc(cand[3]);
        merge16_desc(cand[0], cand[1]); merge16_desc(cand[2], cand[3]); merge16_desc(cand[0], cand[2]);
        asm volatile("s_waitcnt lgkmcnt(0)" ::: "memory");
        float sv[16]; int ex[16];
        const float mx = sval(cand[0][0], 0xFF);
        float sum = 0.f;
#pragma unroll
        for (int r = 0; r < 16; ++r) {
            const int ck = cand[0][r];
            const int i1 = tab[(ck >> 4) & 15], i2 = tab[16 + (ck & 15)];
            ex[r] = i1 * 128 + i2;
            sv[r] = __expf(sval(ck, 0xFF) - mx); sum += sv[r];
        }
        const float inv = 1.f / sum;
        int* ep = EIDX + tok * 128 + h * 16 + 8 * hi; float* gp = GATE + tok * 128 + h * 16 + 8 * hi;
        if (hi == 0) {
            *(u32x4*)ep = (u32x4){(unsigned)ex[0], (unsigned)ex[1], (unsigned)ex[2], (unsigned)ex[3]}; *(u32x4*)(ep + 4) = (u32x4){(unsigned)ex[4], (unsigned)ex[5], (unsigned)ex[6], (unsigned)ex[7]};
            *(f32x4*)gp = (f32x4){sv[0] * inv, sv[1] * inv, sv[2] * inv, sv[3] * inv}; *(f32x4*)(gp + 4) = (f32x4){sv[4] * inv, sv[5] * inv, sv[6] * inv, sv[7] * inv};
        } else {
            *(u32x4*)ep = (u32x4){(unsigned)ex[8], (unsigned)ex[9], (unsigned)ex[10], (unsigned)ex[11]}; *(u32x4*)(ep + 4) = (u32x4){(unsigned)ex[12], (unsigned)ex[13], (unsigned)ex[14], (unsigned)ex[15]};
            *(f32x4*)gp = (f32x4){sv[8] * inv, sv[9] * inv, sv[10] * inv, sv[11] * inv}; *(f32x4*)(gp + 4) = (f32x4){sv[12] * inv, sv[13] * inv, sv[14] * inv, sv[15] * inv};
        }
      }
    }
}

template <int K> DI int swz_bcast(int v) { return __builtin_amdgcn_ds_swizzle(v, 0x10 | (K << 5)); }
template <int W> DI int swz_xor(int v) { return __builtin_amdgcn_ds_swizzle(v, 0x1F | (W << 10)); }
template <int K> struct IC { static constexpr int v = K; };
template <int N, int I = 0, class F> DI void static_for(F&& f) { if constexpr (I < N) { f(IC<I>{}); static_for<N, I + 1>(f); } }
DI float row16_sum(float v) {
    v += __builtin_bit_cast(float, __builtin_amdgcn_update_dpp(0, __builtin_bit_cast(int, v), 0xB1, 0xF, 0xF, true));
    v += __builtin_bit_cast(float, __builtin_amdgcn_update_dpp(0, __builtin_bit_cast(int, v), 0x4E, 0xF, 0xF, true));
    v += __builtin_bit_cast(float, __builtin_amdgcn_update_dpp(0, __builtin_bit_cast(int, v), 0x141, 0xF, 0xF, true));
    v += __builtin_bit_cast(float, __builtin_amdgcn_update_dpp(0, __builtin_bit_cast(int, v), 0x140, 0xF, 0xF, true));
    return v;
}
DI void phase6(const Params& p, LAS unsigned char* lds, int tid, int lane, int wave) {
    asm volatile("" : "+v"(tid), "+v"(lane));
    unsigned char* ws = p.ws;
    const bf16_t* H2 = (const bf16_t*)(ws + WS_RA);
    const unsigned char* UQ = ws + WS_UB; const unsigned char* VQ = ws + WS_VB;
    const float* SU = (const float*)(ws + WS_SU); const float* SV = (const float*)(ws + WS_SV);
    const int* EIDX = (const int*)(ws + WS_RS); const float* GATE = (const float*)(ws + WS_RS + 16 * MB);
    LAS float* lG = (LAS float*)lds;
    const int q = lane >> 4, l16 = lane & 15;
    LAS int* le = (LAS int*)(lds + 4096 + wave * 6144) + q * 128;
    LAS float* lg = (LAS float*)(lds + 4096 + wave * 6144 + 2048) + q * 128;
    LAS float* lc = (LAS float*)(lds + 4096 + wave * 6144 + 4096) + q * 128;
    const unsigned qlo = q < 2 ? (0xFFFFu << (16 * q)) : 0u, qhi = q >= 2 ? (0xFFFFu << (16 * (q - 2))) : 0u;
    for (int rt = blockIdx.x; rt < T / 128; rt += gridDim.x) {
        const int b = rt / 32;
        __syncthreads();
        for (int d = tid; d < 1024; d += NTH) lG[d] = mod_at(p, b, 5120 + d) * p.in[16][d];
        __syncthreads();
#pragma unroll 1
        for (int rd = 0; rd < 4; ++rd) {
            __syncthreads();
            const size_t t = (size_t)rt * 128 + wave * 16 + rd * 4 + q;
            {
                int e[8]; float g[8];
#pragma unroll
                for (int r = 0; r < 8; ++r) { e[r] = EIDX[t * 128 + r * 16 + l16]; g[r] = GATE[t * 128 + r * 16 + l16]; }
                unsigned W[4] = {0u, 0u, 0u, 0u};
#pragma unroll
                for (int r = 0; r < 8; ++r) {
                    const int k = e[r] >> 10; const unsigned inc = 1u << (8 * (k & 3)); const int w = k >> 2;
                    W[0] += (w == 0) ? inc : 0u; W[1] += (w == 1) ? inc : 0u; W[2] += (w == 2) ? inc : 0u; W[3] += (w == 3) ? inc : 0u;
                }
                unsigned C[4];
                {
                    unsigned tot[4], exc[4];
#pragma unroll
                    for (int w = 0; w < 4; ++w) {
                        unsigned x = W[w];
                        x += (unsigned)__builtin_amdgcn_update_dpp(0, (int)x, 0x111, 0xF, 0xF, true);
                        x += (unsigned)__builtin_amdgcn_update_dpp(0, (int)x, 0x112, 0xF, 0xF, true);
                        x += (unsigned)__builtin_amdgcn_update_dpp(0, (int)x, 0x114, 0xF, 0xF, true);
                        x += (unsigned)__builtin_amdgcn_update_dpp(0, (int)x, 0x118, 0xF, 0xF, true);
                        exc[w] = x - W[w];
                        tot[w] = (unsigned)swz_bcast<15>((int)x);
                    }
                    unsigned carry = 0u;
#pragma unroll
                    for (int w = 0; w < 4; ++w) {
                        const unsigned P = tot[w] + (tot[w] << 8) + (tot[w] << 16) + (tot[w] << 24);
                        C[w] = (P - tot[w]) + carry * 0x01010101u + exc[w];
                        carry += P >> 24;
                    }
                }
#pragma unroll
                for (int r = 0; r < 8; ++r) {
                    const int k = e[r] >> 10; const int sh = 8 * (k & 3); const int w = k >> 2; const unsigned inc = 1u << sh;
                    const unsigned cw = (w == 0) ? C[0] : (w == 1) ? C[1] : (w == 2) ? C[2] : C[3];
                    const int pos = (int)((cw >> sh) & 0xFFu);
                    le[pos] = e[r]; lg[pos] = g[r];
                    C[0] += (w == 0) ? inc : 0u; C[1] += (w == 1) ? inc : 0u; C[2] += (w == 2) ? inc : 0u; C[3] += (w == 3) ? inc : 0u;
                }
                asm volatile("s_waitcnt lgkmcnt(0)" ::: "memory");
            }
            {
                int hq[16]; float ish;
                {
                    float hv[64]; float hm = 0.f;
#pragma unroll
                    for (int i = 0; i < 4; ++i) {
                        const u32x4 h0 = *(const u32x4*)(H2 + t * D + 256 * i + 16 * l16), h1 = *(const u32x4*)(H2 + t * D + 256 * i + 16 * l16 + 8);
#pragma unroll
                        for (int c = 0; c < 4; ++c) { hv[16 * i + 2 * c] = bflo(h0[c]); hv[16 * i + 2 * c + 1] = bfhi(h0[c]); hv[16 * i + 8 + 2 * c] = bflo(h1[c]); hv[16 * i + 8 + 2 * c + 1] = bfhi(h1[c]); }
                    }
#pragma unroll
                    for (int j = 0; j < 64; ++j) hm = fmaxf(hm, fabsf(hv[j]));
                    hm = fmaxf(hm, __builtin_bit_cast(float, __builtin_amdgcn_update_dpp(0, __builtin_bit_cast(int, hm), 0xB1, 0xF, 0xF, true)));
                    hm = fmaxf(hm, __builtin_bit_cast(float, __builtin_amdgcn_update_dpp(0, __builtin_bit_cast(int, hm), 0x4E, 0xF, 0xF, true)));
                    hm = fmaxf(hm, __builtin_bit_cast(float, __builtin_amdgcn_update_dpp(0, __builtin_bit_cast(int, hm), 0x141, 0xF, 0xF, true)));
                    hm = fmaxf(hm, __builtin_bit_cast(float, __builtin_amdgcn_update_dpp(0, __builtin_bit_cast(int, hm), 0x140, 0xF, 0xF, true)));
                    const float s8 = hm > 1e-30f ? 127.f / hm : 0.f; ish = hm * (1.f / 127.f);
#pragma unroll
                    for (int d = 0; d < 16; ++d) {
                        const int q0 = __float2int_rn(hv[4 * d] * s8), q1 = __float2int_rn(hv[4 * d + 1] * s8), q2 = __float2int_rn(hv[4 * d + 2] * s8), q3 = __float2int_rn(hv[4 * d + 3] * s8);
                        hq[d] = (int)((unsigned)(q0 & 0xFF) | ((unsigned)(q1 & 0xFF) << 8) | ((unsigned)(q2 & 0xFF) << 16) | ((unsigned)q3 << 24));
                    }
                }
                constexpr int UD = 4;
                u32x4 ub[UD][4];
                int evn = le[l16];
                static_for<UD>([&](auto kc) { constexpr int k = decltype(kc)::v; const unsigned char* up = UQ + (size_t)swz_bcast<k>(evn) * 1024 + 16 * l16;
#pragma unroll
                    for (int i = 0; i < 4; ++i) ub[k][i] = *(const u32x4*)(up + 256 * i); });
#pragma unroll 1
                for (int bt = 0; bt < 8; ++bt) {
                    if (bt) __syncthreads();
                    const int ev = evn; const float gv = lg[bt * 16 + l16];
                    evn = le[(bt < 7 ? bt + 1 : 7) * 16 + l16];
                    const float isu = SU[ev] * ish, isv = SV[ev];
                    int part[16];
                    static_for<16>([&](auto kc) {
                        constexpr int k = decltype(kc)::v, sl = k % UD;
                        int a = 0;
#pragma unroll
                        for (int i = 0; i < 4; ++i) {
                            const u32x4 u = ub[sl][i];
#pragma unroll
                            for (int c = 0; c < 4; ++c) a = __builtin_amdgcn_sdot4((int)u[c], hq[4 * i + c], a, false);
                        }
                        part[k] = a;
                        {
                            constexpr int kn = k + UD;
                            int idx; if constexpr (kn < 16) idx = swz_bcast<(kn & 15)>(ev); else idx = swz_bcast<(kn & 15)>(evn);
                            const unsigned char* up = UQ + (size_t)idx * 1024 + 16 * l16;
#pragma unroll
                            for (int i = 0; i < 4; ++i) ub[sl][i] = *(const u32x4*)(up + 256 * i);
                        }
                    });
                    static_for<4>([&](auto sc) {
                        constexpr int w = 8 >> decltype(sc)::v;
                        const bool up2 = (lane & w) != 0;
#pragma unroll
                        for (int e = 0; e < w; ++e) {
                            const int keep = up2 ? part[e + w] : part[e], send = up2 ? part[e] : part[e + w];
                            part[e] = keep + swz_xor<w>(send);
                        }
                    });
                    const float dot = (float)part[0] * isu;
                    lc[bt * 16 + l16] = gv * 0.5f * dot * (1.f + erff(dot * 0.70710678118654752f)) * isv;
                }
                asm volatile("s_waitcnt lgkmcnt(0)" ::: "memory");
            }
            __syncthreads();
            f32x2 y[32];
#pragma unroll
            for (int i = 0; i < 32; ++i) y[i] = (f32x2){0.f, 0.f};
            {
                constexpr int VD = 4;
                u32x4 vbuf[VD][4];
                int evn = le[l16];
                static_for<VD>([&](auto kc) { constexpr int k = decltype(kc)::v; const unsigned char* vp = VQ + (size_t)swz_bcast<k>(evn) * 1024 + 16 * l16;
#pragma unroll
                    for (int i = 0; i < 4; ++i) vbuf[k][i] = *(const u32x4*)(vp + 256 * i); });
#pragma unroll 1
                for (int bt = 0; bt < 8; ++bt) {
                    if (bt) __syncthreads();
                    const int ev = evn; const int cv = __float_as_int(lc[bt * 16 + l16]);
                    evn = le[(bt < 7 ? bt + 1 : 7) * 16 + l16];
                    static_for<16>([&](auto kc) {
                        constexpr int k = decltype(kc)::v, sl = k % VD;
                        const float cc = __int_as_float(swz_bcast<k>(cv));
                        const f32x2 c2 = (f32x2){cc, cc};
#pragma unroll
                        for (int i = 0; i < 4; ++i) {
                            const u32x4 v = vbuf[sl][i];
#pragma unroll
                            for (int c = 0; c < 4; ++c) {
                                const int w = (int)v[c];
                                y[8 * i + 2 * c] = __builtin_elementwise_fma(__builtin_amdgcn_cvt_pk_f32_fp8(w, false), c2, y[8 * i + 2 * c]);
                                y[8 * i + 2 * c + 1] = __builtin_elementwise_fma(__builtin_amdgcn_cvt_pk_f32_fp8(w, true), c2, y[8 * i + 2 * c + 1]);
                            }
                        }
                        {
                            constexpr int kn = k + VD;
                            int idx; if constexpr (kn < 16) idx = swz_bcast<(kn & 15)>(ev); else idx = swz_bcast<(kn & 15)>(evn);
                            const unsigned char* vp = VQ + (size_t)idx * 1024 + 16 * l16;
#pragma unroll
                            for (int i = 0; i < 4; ++i) vbuf[sl][i] = *(const u32x4*)(vp + 256 * i);
                        }
                    });
                }
            }
            float ss = 0.f;
#pragma unroll
            for (int i = 0; i < 32; ++i) ss += y[i].x * y[i].x + y[i].y * y[i].y;
            const float rstd = rsqrtf(row16_sum(ss) * (1.f / D) + EPS);
            float* orow = p.out + t * D;
#pragma unroll
            for (int i = 0; i < 4; ++i)
#pragma unroll
                for (int c = 0; c < 4; ++c) {
                    const int col = 256 * i + 16 * l16 + 4 * c;
                    f32x4 xv = *(const f32x4*)(orow + col);
                    const f32x4 gg = *(const LAS f32x4*)(lG + col);
                    xv[0] += gg[0] * y[8 * i + 2 * c].x * rstd; xv[1] += gg[1] * y[8 * i + 2 * c].y * rstd; xv[2] += gg[2] * y[8 * i + 2 * c + 1].x * rstd; xv[3] += gg[3] * y[8 * i + 2 * c + 1].y * rstd;
                    *(f32x4*)(orow + col) = xv;
                }
        }
    }
}


__global__ void __launch_bounds__(NTH) fwd_megakernel(Params p) {
    extern __shared__ __attribute__((aligned(16))) unsigned char lds_raw[];
    LAS unsigned char* lds = (LAS unsigned char*)lds_raw;
    const int tid = threadIdx.x, lane = tid & 63, wave = __builtin_amdgcn_readfirstlane(tid >> 6);
    volatile LAS unsigned* st = (volatile LAS unsigned*)(lds + LDS_BARW);
    if (tid == 0) { st[0] = 0u; st[1] = 0u; st[2] = 0u; st[3] = 0u; }
    __syncthreads();
    XcdBarrier bar = xcd_barrier_post((unsigned*)(p.ws + WS_CTL), st);
    unsigned char* ws = p.ws;

    phase0(p, lds, tid, lane, wave);
    xcd_barrier(bar);
    phase1(p, lds, tid, lane, wave);
    xcd_barrier(bar);
    { pg8::Gemm g{(const bf16_t*)(ws + WS_RA), (const bf16_t*)(ws + WS_WIN), T, ZW, D}; pg8::StaticOrder S; S.init(T, ZW, (int)gridDim.x, (int)blockIdx.x);
      pg8::EpiB16 e{(bf16_t*)(ws + WS_RZ), ZW}; pg8::gemm_phase<pg8::EpiB16, pg8::StaticOrder, true, true>(lds, g, S, e);
      EpiZ e2{(bf16_t*)(ws + WS_RZ), (float*)(ws + WS_AFB)}; gemm_phase(((const bf16_t*)(ws + WS_RA)), (const bf16_t*)(ws + WS_WIN), T, NIN, D, e2, lds, tid, lane, wave, 16); }
    xcd_barrier(bar);
    phase3a(p, lds, tid, lane, wave);
    xcd_barrier(bar);
    phase3b<true>(p, lane, wave);
    xcd_barrier(bar);
    phase4a(p, lds, tid, lane, wave);
    xcd_barrier(bar);
    { pg8::Gemm g{(const bf16_t*)(ws + WS_RA), (const bf16_t*)(ws + WS_WOUT), T, D, D}; pg8::StaticOrder S; S.init(T, D, (int)gridDim.x, (int)blockIdx.x);
      pg8::EpiB16 e{(bf16_t*)(ws + WS_RZ), D}; pg8::gemm_phase<pg8::EpiB16, pg8::StaticOrder, true, true>(lds, g, S, e); }
    xcd_barrier(bar);
    phase4c(p, lds, tid, lane, wave);
    xcd_barrier(bar);
    { pg8::Gemm g{(const bf16_t*)(ws + WS_RA), (const bf16_t*)(ws + WS_WQ), T, 2048, D}; pg8::StaticOrder S; S.init(T, 2048, (int)gridDim.x, (int)blockIdx.x);
      pg8::EpiB16 e{(bf16_t*)(ws + WS_RZ), 2048}; pg8::gemm_phase<pg8::EpiB16, pg8::StaticOrder, true, true>(lds, g, S, e); }
    xcd_barrier(bar);
    phase5b(p, lds, tid, lane, wave);
    xcd_barrier(bar);
    phase6(p, lds, tid, lane, wave);
}

extern "C" void kernel_launch(void* const* d_in, const int* in_sizes, int n_in, void* d_out, int out_size, void* d_ws, size_t ws_size, hipStream_t stream) {
    static int grid = 0;
    if (grid == 0) {
        if (n_in != 21 || out_size != T * D || ws_size < WS_END) { fprintf(stderr, "kernel_launch: unexpected shapes (n_in %d out %d ws %zu need %zu)\n", n_in, out_size, ws_size, (size_t)WS_END); grid = -1; return; }
        int dev = 0, cus = 0, per_cu = 0;
        hipGetDevice(&dev); hipDeviceGetAttribute(&cus, hipDeviceAttributeMultiprocessorCount, dev);
        hipFuncSetAttribute((const void*)fwd_megakernel, hipFuncAttributeMaxDynamicSharedMemorySize, LDS_BYTES);
        hipOccupancyMaxActiveBlocksPerMultiprocessor(&per_cu, (const void*)fwd_megakernel, NTH, LDS_BYTES);
        (void)hipGetLastError();
        if (per_cu < 1) fprintf(stderr, "kernel_launch: occupancy query says %d blocks per CU\n", per_cu);
        grid = cus;
    }
    if (grid < 0) return;
    hipMemsetAsync((char*)d_ws + WS_CTL, 0, 64 * 1024, stream);
    Params p{};
    for (int i = 0; i < 21; ++i) p.in[i] = (const float*)d_in[i];
    p.out = (float*)d_out; p.ws = (unsigned char*)d_ws;
    hipLaunchKernelGGL(fwd_megakernel, dim3(grid), dim3(NTH), LDS_BYTES, stream, p);
}
```

```cpp
#include <hip/hip_runtime.h>
#include <cstdio>
#include <cstdint>

#define DI __device__ __forceinline__
#define LAS __attribute__((address_space(3)))
typedef unsigned short bf16_t;
typedef short bf16x8 __attribute__((ext_vector_type(8)));
typedef float f32x4 __attribute__((ext_vector_type(4)));
typedef float f32x2 __attribute__((ext_vector_type(2)));
typedef float f32x16 __attribute__((ext_vector_type(16)));
typedef unsigned u32x4 __attribute__((ext_vector_type(4)));
typedef unsigned u32x2 __attribute__((ext_vector_type(2)));
typedef __bf16 bf16x2v __attribute__((ext_vector_type(2)));

constexpr int T = 32768, D = 1024, SEQ = 4096, NB = 8;
constexpr int NTH = 512, NWV = 8;
constexpr int ZW = 2048;
constexpr int NIN = 2176;
constexpr float EPS = 1e-6f;

constexpr size_t MB = 1024 * 1024;
constexpr size_t WS_CTL   = 0;
constexpr size_t WS_MODP  = 64 * 1024;
constexpr size_t WS_WIN   = WS_MODP + 8 * 8 * 6144 * 4;
constexpr size_t WS_WOUT  = WS_WIN + (size_t)NIN * 1024 * 2;
constexpr size_t WS_WQ    = WS_WOUT + 1024 * 1024 * 2;
constexpr size_t WS_SKB   = WS_WQ + 2048 * 1024 * 2;
constexpr size_t WS_WP    = WS_SKB + 16 * 128 * 128 * 2;
constexpr size_t WS_AFB   = WS_WP + 4 * 128 * 128 * 2;
constexpr size_t WS_UB    = WS_AFB + (size_t)T * 32 * 4;
constexpr size_t WS_VB    = WS_UB + 32 * MB;
constexpr size_t WS_SU    = WS_UB + 16 * MB, WS_SV = WS_VB + 16 * MB;
constexpr size_t WS_RA    = WS_VB + 32 * MB;
constexpr size_t WS_RZ    = WS_RA + 64 * MB;
constexpr size_t WS_RS    = WS_RZ + 128 * MB;
constexpr size_t WS_RO    = WS_RS + 6 * 16 * MB + 1 * MB;
constexpr size_t WS_END   = WS_RO + 128 * MB;
static_assert(WS_END <= 512 * MB, "workspace too large");

struct Params { const float* in[21]; float* out; unsigned char* ws; };

DI unsigned pk2(float a, float b) { f32x2 f = {a, b}; bf16x2v h = __builtin_convertvector(f, bf16x2v); return __builtin_bit_cast(unsigned, h); }
DI float dot2bf(unsigned a, unsigned b, float c) { return __builtin_amdgcn_fdot2_f32_bf16(__builtin_bit_cast(bf16x2v, a), __builtin_bit_cast(bf16x2v, b), c, false); }
DI float bflo(unsigned u) { return __uint_as_float(u << 16); }
DI float bfhi(unsigned u) { return __uint_as_float(u & 0xFFFF0000u); }
DI float wave_sum(float v) {
#pragma unroll
    for (int o = 1; o < 64; o <<= 1) v += __shfl_xor(v, o);
    return v;
}
DI bf16x8 ld_frag16(const bf16_t* p) { return __builtin_bit_cast(bf16x8, *(const u32x4*)p); }
DI bf16x8 ld_frag_perm(const bf16_t* p, int g) {
    const u32x2 lo = *(const u32x2*)(p + 4 * g), hi = *(const u32x2*)(p + 16 + 4 * g);
    u32x4 v = {lo.x, lo.y, hi.x, hi.y}; return __builtin_bit_cast(bf16x8, v);
}
DI int perm32(int k) { return (k & ~31) | (((k >> 2) & 3) << 3) | (((k >> 4) & 1) << 2) | (k & 3); }
DI bf16x8 pack8(const f32x4& a, const f32x4& b) { u32x4 v = {pk2(a[0], a[1]), pk2(a[2], a[3]), pk2(b[0], b[1]), pk2(b[2], b[3])}; return __builtin_bit_cast(bf16x8, v); }
#define MFMA16(a, b, c) __builtin_amdgcn_mfma_f32_16x16x32_bf16((a), (b), (c), 0, 0, 0)
#define MFMA32(a, b, c) __builtin_amdgcn_mfma_f32_32x32x16_bf16((a), (b), (c), 0, 0, 0)

#define XB_TMO      128
#define XB_XCNT(j)  (256  + 64 * (j))
#define XB_XSUB(j)  (1280 + 64 * (j))
#define XB_XGEN(j)  (2304 + 64 * (j))
#define XB_TOP      3328
#define XB_TOPGEN   3392
#define XCD_BAR_WORDS 3456
#define XB_SPIN_CAP (1u << 22)
DI unsigned xb_ld(unsigned* p)              { return __hip_atomic_load(p, __ATOMIC_RELAXED, __HIP_MEMORY_SCOPE_AGENT); }
DI unsigned xb_add(unsigned* p, unsigned v) { return __hip_atomic_fetch_add(p, v, __ATOMIC_RELAXED, __HIP_MEMORY_SCOPE_AGENT); }
DI unsigned xb_xcc_id() { return (unsigned)__builtin_amdgcn_s_getreg((3 << 11) | 20) & 0xFu; }
#define XB_SPIN(cond, bar) do { unsigned _sp = 0; while (cond) { __builtin_amdgcn_s_sleep(1); \
    if ((++_sp & 255u) == 0u) { if (xb_ld(&(bar)[XB_TMO])) break; if (_sp > XB_SPIN_CAP) { atomicAdd(&(bar)[XB_TMO], 1u); break; } } } } while (0)
struct XcdBarrier { unsigned* bar; unsigned x; volatile LAS unsigned* st; };
DI XcdBarrier xcd_barrier_post(unsigned* bar, volatile LAS unsigned* st) {
    XcdBarrier b; b.bar = bar; b.x = xb_xcc_id(); b.st = st;
    if (threadIdx.x == 0) (void)xb_add(&bar[XB_XCNT(b.x)], 1u);
    return b;
}
DI void xcd_barrier_complete(unsigned* bar, unsigned x, unsigned& nloc, unsigned& nx) {
    const unsigned G = gridDim.x * gridDim.y * gridDim.z;
    unsigned sum, cnt, mine, sp = 0u;
    for (;;) {
        sum = 0u; cnt = 0u; mine = 0u;
#pragma unroll
        for (unsigned j = 0; j < 16; ++j) { const unsigned c = xb_ld(&bar[XB_XCNT(j)]); sum += c; cnt += (c > 0u) ? 1u : 0u; mine = (j == x) ? c : mine; }
        if (sum == G) break;
        __builtin_amdgcn_s_sleep(1);
        if ((++sp & 255u) == 0u) { if (xb_ld(&bar[XB_TMO])) break; if (sp > XB_SPIN_CAP) { atomicAdd(&bar[XB_TMO], 1u); break; } }
    }
    nloc = mine > 0u ? mine : 1u; nx = cnt > 0u ? cnt : 1u;
}
DI void xcd_barrier(const XcdBarrier& b) {
    asm volatile("s_waitcnt vmcnt(0)" ::: "memory");
    __syncthreads();
    if (threadIdx.x == 0) {
        unsigned* bar = b.bar;
        __builtin_amdgcn_s_waitcnt(0);
        unsigned nloc = b.st[0], nx = b.st[1];
        if (nloc == 0u) { xcd_barrier_complete(bar, b.x, nloc, nx); b.st[0] = nloc; b.st[1] = nx; }
        const unsigned old = xb_add(&bar[XB_XSUB(b.x)], 1u);
        const unsigned gen = old / nloc;
        if (old + 1u == (gen + 1u) * nloc) {
            __builtin_amdgcn_fence(__ATOMIC_RELEASE, "agent");
            asm volatile("s_waitcnt vmcnt(0)" ::: "memory");
            const unsigned og = xb_add(&bar[XB_TOP], 1u);
            const unsigned tg = og / nx;
            if (og + 1u == (tg + 1u) * nx) xb_add(&bar[XB_TOPGEN], 1u);
            else XB_SPIN(xb_ld(&bar[XB_TOPGEN]) == tg, bar);
            __builtin_amdgcn_fence(__ATOMIC_ACQUIRE, "agent");
            xb_add(&bar[XB_XGEN(b.x)], 1u);
            asm volatile("s_waitcnt vmcnt(0)" ::: "memory");
        } else {
            XB_SPIN(xb_ld(&bar[XB_XGEN(b.x)]) == gen, bar);
            __builtin_amdgcn_fence(__ATOMIC_ACQUIRE, "agent");
            asm volatile("s_waitcnt vmcnt(0)" ::: "memory");
        }
    }
    __syncthreads();
}

constexpr int LDS_BYTES = 152 * 1024;
constexpr int LDS_BARW = LDS_BYTES - 16;

DI void p0_transpose_item(const float* W, int ldw, int K, bf16_t* WT, int dst_row0, int src_col0, float scale, bool zero, LAS float* scr, int kb, int lane) {
    const int k0 = 64 * kb;
#pragma unroll 8
    for (int i = 0; i < 32; ++i) { const int kk = 2 * i + (lane >> 5); scr[kk * 33 + (lane & 31)] = zero ? 0.f : W[(size_t)(k0 + kk) * ldw + src_col0 + (lane & 31)] * scale; }
    asm volatile("s_waitcnt lgkmcnt(0)" ::: "memory");
    const int c = lane & 7;
#pragma unroll
    for (int j = 0; j < 4; ++j) { const int n = (lane >> 3) + 8 * j; const LAS float* s = scr + (8 * c) * 33 + n;
        u32x4 o; o.x = pk2(s[0 * 33], s[1 * 33]); o.y = pk2(s[2 * 33], s[3 * 33]); o.z = pk2(s[4 * 33], s[5 * 33]); o.w = pk2(s[6 * 33], s[7 * 33]);
        *(u32x4*)(WT + (size_t)(dst_row0 + n) * K + k0 + 8 * c) = o; }
    asm volatile("s_waitcnt lgkmcnt(0)" ::: "memory");
}

DI void phase0(const Params& p, LAS unsigned char* lds, int tid, int lane, int wave) {
    asm volatile("" : "+v"(tid), "+v"(lane));
    unsigned char* ws = p.ws;
    LAS float* sl = (LAS float*)lds;
    LAS float* scr = (LAS float*)(lds + 32768 + wave * 8448);
    const float* c = p.in[1];
    for (int e = tid; e < 8192; e += NTH) { const int b = e >> 10, k = e & 1023; const float v = c[e]; sl[k * 8 + b] = v / (1.f + __expf(-v)); }
    __syncthreads();
    const int gw = wave * gridDim.x + blockIdx.x, NGW = gridDim.x * NWV;
    constexpr int I_MOD = 768, I_WIN = 16 * 68, I_WOUT = 16 * 32, I_WQ = 16 * 64, I_WP = 32;
    constexpr int NITEMS = I_MOD + I_WIN + I_WOUT + I_WQ + I_WP;
    for (int it = gw; it < NITEMS; it += NGW) {
        int r = it;
        if (r < I_MOD) {
            const int cg = r % 96, ks = r / 96, n = cg * 64 + lane, k0 = ks * 128;
            const float* W = p.in[2] + (size_t)k0 * 6144 + n;
            float acc[8];
#pragma unroll
            for (int b = 0; b < 8; ++b) acc[b] = 0.f;
#pragma unroll 8
            for (int k = 0; k < 128; ++k) {
                const float w = W[(size_t)k * 6144];
                const f32x4 s0 = *(const LAS f32x4*)(sl + (k0 + k) * 8), s1 = *(const LAS f32x4*)(sl + (k0 + k) * 8 + 4);
                acc[0] += s0[0] * w; acc[1] += s0[1] * w; acc[2] += s0[2] * w; acc[3] += s0[3] * w;
                acc[4] += s1[0] * w; acc[5] += s1[1] * w; acc[6] += s1[2] * w; acc[7] += s1[3] * w;
            }
            float* mp = (float*)(ws + WS_MODP) + (size_t)ks * 8 * 6144 + n;
#pragma unroll
            for (int b = 0; b < 8; ++b) mp[b * 6144] = acc[b];
            continue;
        }
        r -= I_MOD;
        if (r < I_WIN) {
            const int kb = r / 68, nb = r % 68, n0 = nb * 32;
            int src; bool zero = false; float scale = 1.f;
            if (n0 < 1536) { src = n0; if (n0 < 256) scale = 0.125f; } else if (n0 < 2048) src = n0 + 32; else if (n0 < 2080) src = 1536 + (n0 - 2048); else { src = 0; zero = true; }
            p0_transpose_item(p.in[6], 2080, 1024, (bf16_t*)(ws + WS_WIN), n0, src, scale, zero, scr, kb, lane);
            continue;
        }
        r -= I_WIN;
        if (r < I_WOUT) { p0_transpose_item(p.in[14], 1024, 1024, (bf16_t*)(ws + WS_WOUT), (r % 32) * 32, (r % 32) * 32, 1.f, false, scr, r / 32, lane); continue; }
        r -= I_WOUT;
        if (r < I_WQ) { p0_transpose_item(p.in[17], 2048, 1024, (bf16_t*)(ws + WS_WQ), (r % 64) * 32, (r % 64) * 32, 1.f, false, scr, r / 64, lane); continue; }
        r -= I_WQ;
        { const int g = r >> 3, kb = (r >> 2) & 1, nb = r & 3;
          p0_transpose_item(p.in[12] + g * 16384, 128, 128, (bf16_t*)(ws + WS_WP) + g * 16384, nb * 32, nb * 32, 1.f, false, scr, kb, lane); }
    }
    const size_t gt = (size_t)blockIdx.x * NTH + tid, NGT = (size_t)gridDim.x * NTH;
    constexpr size_t NSK = (size_t)16 * 128 * 128 / 8;
    for (size_t j = gt; j < NSK; j += NGT) {
        const float* src = p.in[18]; bf16_t* dst = (bf16_t*)(ws + WS_SKB);
        const f32x4 a = *(const f32x4*)(src + j * 8), b = *(const f32x4*)(src + j * 8 + 4);
        u32x4 o = {pk2(a[0], a[1]), pk2(a[2], a[3]), pk2(b[0], b[1]), pk2(b[2], b[3])};
        *(u32x4*)(dst + j * 8) = o;
    }
}

DI void quant_load(const Params& p, int row, int lane, f32x4 (&v)[4]) {
    const int tb = row >> 14, e = row & 16383;
    const float* src = (tb ? p.in[20] : p.in[19]) + (size_t)e * D + 16 * lane;
#pragma unroll
    for (int q = 0; q < 4; ++q) v[q] = *(const f32x4*)(src + 4 * q);
}
DI void quant_store(const Params& p, int row, int lane, const f32x4 (&v)[4]) {
    unsigned char* ws = p.ws;
    const int tb = row >> 14, e = row & 16383;
    float m = 0.f;
#pragma unroll
    for (int q = 0; q < 4; ++q) m = fmaxf(m, fmaxf(fmaxf(fabsf(v[q][0]), fabsf(v[q][1])), fmaxf(fabsf(v[q][2]), fabsf(v[q][3]))));
#pragma unroll
    for (int o = 1; o < 64; o <<= 1) m = fmaxf(m, __shfl_xor(m, o));
    int ex = (int)((__float_as_uint(m) >> 23) & 0xFFu) - 127;
    if (m < 1e-30f) ex = 7;
    const float sc = __uint_as_float((unsigned)(127 + 7 - ex) << 23), isc = __uint_as_float((unsigned)(127 - 7 + ex) << 23);
    u32x4 o;
    if (tb) {
#pragma unroll
        for (int q = 0; q < 4; ++q) { int w = 0; w = __builtin_amdgcn_cvt_pk_fp8_f32(v[q][0] * sc, v[q][1] * sc, w, false); w = __builtin_amdgcn_cvt_pk_fp8_f32(v[q][2] * sc, v[q][3] * sc, w, true); o[q] = (unsigned)w; }
        if (lane == 0) ((float*)(ws + WS_SV))[e] = isc;
    } else {
        const float s8 = m > 1e-30f ? 127.f / m : 0.f;
#pragma unroll
        for (int q = 0; q < 4; ++q) {
            const int q0 = __float2int_rn(v[q][0] * s8), q1 = __float2int_rn(v[q][1] * s8), q2 = __float2int_rn(v[q][2] * s8), q3 = __float2int_rn(v[q][3] * s8);
            o[q] = (unsigned)(q0 & 0xFF) | ((unsigned)(q1 & 0xFF) << 8) | ((unsigned)(q2 & 0xFF) << 16) | ((unsigned)q3 << 24);
        }
        if (lane == 0) ((float*)(ws + WS_SU))[e] = m * (1.f / 127.f);
    }
    *(u32x4*)(ws + (tb ? WS_VB : WS_UB) + (size_t)e * 1024 + 16 * lane) = o;
}

DI float mod_at(const Params& p, int b, int n) {
    const float* mp = (const float*)(p.ws + WS_MODP) + (size_t)b * 6144 + n;
    float s = p.in[3][n];
#pragma unroll
    for (int ks = 0; ks < 8; ++ks) s += mp[(size_t)ks * 8 * 6144];
    return s;
}

DI void phase1(const Params& p, LAS unsigned char* lds, int tid, int lane, int wave) {
    asm volatile("" : "+v"(tid), "+v"(lane));
    LAS float* lA = (LAS float*)lds; LAS float* lB = lA + 1024;
    const float* x = p.in[0]; bf16_t* H = (bf16_t*)(p.ws + WS_RA);
    for (int rt = blockIdx.x; rt < T / 128; rt += gridDim.x) {
        const int b = rt / 32;
        __syncthreads();
        for (int d = tid; d < 1024; d += NTH) { lA[d] = p.in[4][d] * (1.f + mod_at(p, b, 1024 + d)); lB[d] = mod_at(p, b, d); }
        __syncthreads();
        for (int r0 = wave; r0 < 128; r0 += 4 * NWV) {
            f32x4 v[4][4];
#pragma unroll
            for (int u = 0; u < 4; ++u) { const f32x4* xr = (const f32x4*)(x + ((size_t)rt * 128 + r0 + u * NWV) * D) + lane;
#pragma unroll
                for (int j = 0; j < 4; ++j) v[u][j] = xr[64 * j]; }
#pragma unroll
            for (int u = 0; u < 4; ++u) {
                const size_t row = (size_t)rt * 128 + r0 + u * NWV;
                float ss = 0.f;
#pragma unroll
                for (int j = 0; j < 4; ++j) ss += v[u][j][0] * v[u][j][0] + v[u][j][1] * v[u][j][1] + v[u][j][2] * v[u][j][2] + v[u][j][3] * v[u][j][3];
                const float rstd = rsqrtf(wave_sum(ss) * (1.f / D) + EPS);
                u32x2* o = (u32x2*)(H + row * D) + lane;
#pragma unroll
                for (int j = 0; j < 4; ++j) {
                    const f32x4 a = *(const LAS f32x4*)(lA + 4 * lane + 256 * j), bb = *(const LAS f32x4*)(lB + 4 * lane + 256 * j);
                    u32x2 w = {pk2(v[u][j][0] * rstd * a[0] + bb[0], v[u][j][1] * rstd * a[1] + bb[1]), pk2(v[u][j][2] * rstd * a[2] + bb[2], v[u][j][3] * rstd * a[3] + bb[3])};
                    o[64 * j] = w;
                }
            }
        }
    }
}

struct EpiZ {
    bf16_t* Z; float* AFB;
    DI void operator()(int m, int n, const f32x4& v) const {
        if (n < ZW) { u32x2 w = {pk2(v[0], v[1]), pk2(v[2], v[3])}; *(u32x2*)(Z + (size_t)m * ZW + n) = w; }
        else if (n < ZW + 32) { *(f32x4*)(AFB + (size_t)m * 32 + (n - ZW)) = v; }
    }
};
struct EpiF32 { float* C; int ldc; DI void operator()(int m, int n, const f32x4& v) const { *(f32x4*)(C + (size_t)m * ldc + n) = v; } };
struct EpiBf16 { bf16_t* C; int ldc; DI void operator()(int m, int n, const f32x4& v) const { u32x2 w = {pk2(v[0], v[1]), pk2(v[2], v[3])}; *(u32x2*)(C + (size_t)m * ldc + n) = w; } };

template <class Epi>
DI void gemm_phase(const bf16_t* A, const bf16_t* Bt, int M, int N, int K, const Epi& epi, LAS unsigned char* lds, int tid, int lane, int wave, int nt_first = 0) {
    constexpr int BM = 256, BN = 128, BK = 64, STAGE = (BM + BN) * 128;
    const int ntn = N / BN - nt_first, ntiles = (M / BM) * ntn, nk = K / BK;
    const int wm = wave & 3, wn = wave >> 2, c15 = lane & 15, g = lane >> 4;
    const int lrow = tid >> 3, lch = tid & 7;
    for (int tile = blockIdx.x; tile < ntiles; tile += gridDim.x) {
        const int m0 = (tile / ntn) * BM, n0 = (tile % ntn + nt_first) * BN;
        f32x4 acc[4][4];
#pragma unroll
        for (int i = 0; i < 4; ++i)
#pragma unroll
            for (int j = 0; j < 4; ++j) acc[i][j] = (f32x4){0.f, 0.f, 0.f, 0.f};
        u32x4 ra[4], rb[2];
        const bf16_t* Ag = A + (size_t)(m0 + lrow) * K + lch * 8;
        const bf16_t* Bg = Bt + (size_t)(n0 + lrow) * K + lch * 8;
        const int woff = lrow * 128 + ((lch ^ (lrow & 7)) * 16);
        __syncthreads();
#pragma unroll
        for (int ps = 0; ps < 4; ++ps) ra[ps] = *(const u32x4*)(Ag + (size_t)(64 * ps) * K);
#pragma unroll
        for (int ps = 0; ps < 2; ++ps) rb[ps] = *(const u32x4*)(Bg + (size_t)(64 * ps) * K);
#pragma unroll
        for (int ps = 0; ps < 4; ++ps) *(LAS u32x4*)(lds + woff + ps * 8192) = ra[ps];
#pragma unroll
        for (int ps = 0; ps < 2; ++ps) *(LAS u32x4*)(lds + BM * 128 + woff + ps * 8192) = rb[ps];
        __syncthreads();
        for (int kt = 0; kt < nk; ++kt) {
            const bool more = (kt + 1 < nk);
            if (more) {
#pragma unroll
                for (int ps = 0; ps < 4; ++ps) ra[ps] = *(const u32x4*)(Ag + (size_t)(64 * ps) * K + (kt + 1) * BK);
#pragma unroll
                for (int ps = 0; ps < 2; ++ps) rb[ps] = *(const u32x4*)(Bg + (size_t)(64 * ps) * K + (kt + 1) * BK);
            }
            LAS unsigned char* sa = lds + (kt & 1) * STAGE; LAS unsigned char* sb = sa + BM * 128;
#pragma unroll
            for (int s = 0; s < 2; ++s) {
                bf16x8 fa[4], fb[4];
#pragma unroll
                for (int i = 0; i < 4; ++i) { const int row = wm * 64 + i * 16 + c15; fa[i] = *(const LAS bf16x8*)(sa + row * 128 + (((4 * s + g) ^ (row & 7)) * 16)); }
#pragma unroll
                for (int j = 0; j < 4; ++j) { const int row = wn * 64 + j * 16 + c15; fb[j] = *(const LAS bf16x8*)(sb + row * 128 + (((4 * s + g) ^ (row & 7)) * 16)); }
#pragma unroll
                for (int i = 0; i < 4; ++i)
#pragma unroll
                    for (int j = 0; j < 4; ++j) acc[i][j] = MFMA16(fb[j], fa[i], acc[i][j]);
            }
            if (more) {
                LAS unsigned char* da = lds + ((kt + 1) & 1) * STAGE;
#pragma unroll
                for (int ps = 0; ps < 4; ++ps) *(LAS u32x4*)(da + woff + ps * 8192) = ra[ps];
#pragma unroll
                for (int ps = 0; ps < 2; ++ps) *(LAS u32x4*)(da + BM * 128 + woff + ps * 8192) = rb[ps];
            }
            __syncthreads();
        }
#pragma unroll
        for (int i = 0; i < 4; ++i)
#pragma unroll
            for (int j = 0; j < 4; ++j) epi(m0 + wm * 64 + i * 16 + c15, n0 + wn * 64 + j * 16 + 4 * g, acc[i][j]);
    }
}

namespace pg8 {
#define PG8_LAS __attribute__((address_space(3)))
constexpr int BM = 256, BK = 64, HALF = 128, HTB = HALF * BK * 2  , STAGE_BYTES = 8 * HTB, NXCD = 8, WGM = 8;

__host__ __device__ __forceinline__ int lds_byte(int r, int c) { const int st = (r >> 4) * 2 + (c >> 5), rr = r & 15, cc = c & 31, ob = rr * 64 + cc * 2; return st * 1024 + (ob ^ (((ob >> 9) & 1) << 5)); }
__host__ __device__ __forceinline__ void stage_rc(int b, int& R, int& C) { const int st = b / 1024, sb = b % 1024, swz = sb ^ (((sb >> 9) & 1) << 5); R = (st >> 1) * 16 + swz / 64; C = (st & 1) * 32 + (swz % 64) / 2; }
__host__ __device__ __forceinline__ int perm32(int rho) { const int n = rho >> 4, i = rho & 15; return 8 * (i >> 2) + 4 * n + (i & 3); }

struct Unit { int pm, pn; };
struct Gemm { const bf16_t* A; const bf16_t* Bt; int M, N, K; };

struct StaticOrder {
    int nM, nN, nwg, G, c;
    __host__ __device__ void init(int M, int N, int G_, int c_) { nM = M / BM; nN = N / BM; nwg = nM * nN; G = G_; c = c_; }
    __host__ __device__ bool next(int i, Unit& u) const {
        const long L = (long)i * G + c; if (L >= nwg) return false;
        int wgid = (int)L; { const int q = nwg / NXCD, r = nwg % NXCD, xcd = wgid % NXCD, off = wgid / NXCD; wgid = (xcd < r ? xcd * (q + 1) : r * (q + 1) + (xcd - r) * q) + off; }
        const int nig = WGM * nN, gid = wgid / nig, fm = gid * WGM, gsz = (nM - fm) < WGM ? (nM - fm) : WGM;
        u.pm = fm + ((wgid % nig) % gsz); u.pn = (wgid % nig) / gsz; return true;
    }
    __device__ __forceinline__ void a_ready(const Unit&) const {}
    __device__ __forceinline__ void done(const Unit&) const {}
};

struct EpiB16 {
    static constexpr bool PERM = true, AFTER_DRAIN = false;
    bf16_t* O; int ldc;
    __device__ __forceinline__ void operator()(const f32x4 (&acc)[2][2][4][2], const Unit& u, int wr, int wc, int fr, int fq) const {
#pragma unroll
        for (int ai = 0; ai < 2; ++ai)
#pragma unroll
            for (int m = 0; m < 4; ++m) { bf16_t* rowp = O + (size_t)(u.pm * BM + ai * HALF + wr * 64 + m * 16 + fr) * ldc + u.pn * BM + wc * 32 + 8 * fq;
#pragma unroll
                for (int bj = 0; bj < 2; ++bj) { const f32x4 v0 = acc[ai][bj][m][0], v1 = acc[ai][bj][m][1];
                    u32x4 w; w.x = ::pk2(v0[0], v0[1]); w.y = ::pk2(v0[2], v0[3]); w.z = ::pk2(v1[0], v1[1]); w.w = ::pk2(v1[2], v1[3]);
                    *(u32x4*)(rowp + bj * HALF) = w; } }
    }
};
struct EpiF {
    static constexpr bool PERM = false, AFTER_DRAIN = false;
    float* O; int ldc;
    __device__ __forceinline__ void operator()(const f32x4 (&acc)[2][2][4][2], const Unit& u, int wr, int wc, int fr, int fq) const {
#pragma unroll
        for (int ai = 0; ai < 2; ++ai)
#pragma unroll
            for (int m = 0; m < 4; ++m) { float* rowp = O + (size_t)(u.pm * BM + ai * HALF + wr * 64 + m * 16 + fr) * ldc + u.pn * BM + wc * 32 + 4 * fq;
#pragma unroll
                for (int bj = 0; bj < 2; ++bj)
#pragma unroll
                    for (int n = 0; n < 2; ++n) *(f32x4*)(rowp + bj * HALF + 16 * n) = acc[ai][bj][m][n]; }
    }
};
template <class Epi, class Sched, bool ALIGN_EPI = false, bool SP2 = false>
__device__ __forceinline__ void gemm_phase(PG8_LAS unsigned char* lds, const Gemm g, const Sched& S, const Epi& E) {
    const int tid = threadIdx.x, wid = __builtin_amdgcn_readfirstlane(tid >> 6), lane = tid & 63, wr = wid >> 2, wc = wid & 3, fr = lane & 15, fq = lane >> 4;
    const int K = g.K, nt = K / BK;
    unsigned voffA[2], voffB[2];
#pragma unroll
    for (int i = 0; i < 2; ++i) { int R, C; stage_rc(tid * 16 + i * 8192, R, C); const int Rb = Epi::PERM ? ((R & ~31) + perm32(R & 31)) : R;
        voffA[i] = (unsigned)(R * K + C) * 2u; voffB[i] = (unsigned)(Rb * K + C) * 2u; }
    const size_t kstep = (size_t)(BK * 2);
    const size_t hstep = (size_t)HALF * K * 2;
    const size_t tstep = 2 * hstep;
    const unsigned ldsw = (unsigned)wid * 1024u;
    const int aoff = lds_byte(wr * 64 + fr, fq * 8), boff = lds_byte(wc * 32 + fr, fq * 8);
#define PG8_SA(b, h) (((b) * 2 + (h)) * HTB)
#define PG8_SB(b, h) ((4 + (b) * 2 + (h)) * HTB)
#define PG8_STAGE(bufoff, gbase, voff) do { _Pragma("unroll") for (int _i = 0; _i < 2; ++_i) \
        __builtin_amdgcn_global_load_lds((const unsigned*)((const char*)(gbase) + (voff)[_i]), (PG8_LAS unsigned*)(lds + (bufoff) + ldsw + _i * 8192), 16, 0, 0); } while (0)
#define PG8_LDA(dst, b, h) do { _Pragma("unroll") for (int m = 0; m < 4; ++m) _Pragma("unroll") for (int k = 0; k < 2; ++k) dst[m][k] = *(const PG8_LAS bf16x8*)(lds + PG8_SA(b, h) + aoff + m * 2048 + k * 1024); } while (0)
#define PG8_LDB(dst, b, h) do { _Pragma("unroll") for (int n = 0; n < 2; ++n) _Pragma("unroll") for (int k = 0; k < 2; ++k) dst[n][k] = *(const PG8_LAS bf16x8*)(lds + PG8_SB(b, h) + boff + n * 2048 + k * 1024); } while (0)
#define PG8_MMA(ai, bj, At, Bt) do { __builtin_amdgcn_s_setprio(1); _Pragma("unroll") for (int m = 0; m < 4; ++m) _Pragma("unroll") for (int n = 0; n < 2; ++n) _Pragma("unroll") for (int k = 0; k < 2; ++k) \
        acc[ai][bj][m][n] = __builtin_amdgcn_mfma_f32_16x16x32_bf16(Bt[n][k], At[m][k], acc[ai][bj][m][n], 0, 0, 0); __builtin_amdgcn_s_setprio(0); } while (0)
#define PG8_WAIT_V(n) asm volatile("s_waitcnt vmcnt(" #n ")" ::: "memory")
#define PG8_WAIT_L(n) asm volatile("s_waitcnt lgkmcnt(" #n ")" ::: "memory")
#define PG8_BAR __builtin_amdgcn_s_barrier()
#define PG8_SCHED __builtin_amdgcn_sched_barrier(0)
    Unit cur, nxt; int ui = 0;
    if (!S.next(0, cur)) return;
    f32x4 acc[2][2][4][2];
#pragma unroll
    for (int a = 0; a < 2; ++a)
#pragma unroll
        for (int b = 0; b < 2; ++b)
#pragma unroll
            for (int m = 0; m < 4; ++m)
#pragma unroll
                for (int n = 0; n < 2; ++n) acc[a][b][m][n] = (f32x4){0.f, 0.f, 0.f, 0.f};
    bf16x8 At[4][2], B0[2][2], B1[2][2];
    const char* cA = (const char*)g.A + (size_t)cur.pm * tstep; const char* cB = (const char*)g.Bt + (size_t)cur.pn * tstep;
    S.a_ready(cur);
    if constexpr (SP2) {
        PG8_STAGE(PG8_SB(0, 0), cB, voffB); PG8_STAGE(PG8_SB(0, 1), cB + hstep, voffB); PG8_STAGE(PG8_SA(0, 0), cA, voffA); PG8_STAGE(PG8_SA(0, 1), cA + hstep, voffA);
        if (wr == 1) PG8_BAR;
        PG8_WAIT_V(2); PG8_BAR;
        PG8_STAGE(PG8_SB(1, 0), cB + kstep, voffB); PG8_STAGE(PG8_SA(1, 0), cA + kstep, voffA); PG8_STAGE(PG8_SB(1, 1), cB + hstep + kstep, voffB);
        PG8_WAIT_V(6); PG8_BAR;
    } else {
        PG8_STAGE(PG8_SB(0, 0), cB, voffB); PG8_STAGE(PG8_SA(0, 0), cA, voffA); PG8_STAGE(PG8_SB(0, 1), cB + hstep, voffB); PG8_STAGE(PG8_SA(0, 1), cA + hstep, voffA);
        if (wr == 1) PG8_BAR;
        PG8_WAIT_V(4); PG8_BAR;
        PG8_STAGE(PG8_SB(1, 0), cB + kstep, voffB); PG8_STAGE(PG8_SA(1, 0), cA + kstep, voffA); PG8_STAGE(PG8_SB(1, 1), cB + hstep + kstep, voffB);
        PG8_WAIT_V(6); PG8_BAR;
    }
    for (;;) {
        const bool has_next = S.next(ui + 1, nxt);
        const char* nA = has_next ? (const char*)g.A + (size_t)nxt.pm * tstep : cA; const char* nB = has_next ? (const char*)g.Bt + (size_t)nxt.pn * tstep : cB;
        for (int t = 0; t < nt; t += 2) {
            const bool last = (t == nt - 2);
            const char* a1 = cA + (size_t)(t + 1) * kstep;
            const char* a2 = last ? nA : cA + (size_t)(t + 2) * kstep; const char* b2 = last ? nB : cB + (size_t)(t + 2) * kstep;
            const char* a3 = a2 + kstep; const char* b3 = b2 + kstep;
            if (last && has_next) S.a_ready(nxt);
            if constexpr (SP2) {
            PG8_LDB(B0, 0, 0); PG8_LDB(B1, 0, 1); PG8_SCHED; PG8_LDA(At, 0, 0); PG8_STAGE(PG8_SA(1, 1), a1 + hstep, voffA);
            PG8_WAIT_V(8); PG8_WAIT_L(0); PG8_BAR; PG8_MMA(0, 0, At, B0); PG8_MMA(0, 1, At, B1); PG8_BAR; PG8_SCHED;
            PG8_LDA(At, 0, 1); PG8_STAGE(PG8_SB(0, 0), b2, voffB); PG8_STAGE(PG8_SB(0, 1), b2 + hstep, voffB); PG8_STAGE(PG8_SA(0, 0), a2, voffA);
            PG8_WAIT_V(8); PG8_WAIT_L(0); PG8_BAR; PG8_MMA(1, 0, At, B0); PG8_MMA(1, 1, At, B1); PG8_BAR; PG8_SCHED;
            PG8_LDB(B0, 1, 0); PG8_LDB(B1, 1, 1); PG8_SCHED; PG8_LDA(At, 1, 0); PG8_STAGE(PG8_SA(0, 1), a2 + hstep, voffA);
            PG8_WAIT_V(8); PG8_WAIT_L(0); PG8_BAR; PG8_MMA(0, 0, At, B0); PG8_MMA(0, 1, At, B1); PG8_BAR; PG8_SCHED;
            PG8_LDA(At, 1, 1); PG8_STAGE(PG8_SB(1, 0), b3, voffB); PG8_STAGE(PG8_SB(1, 1), b3 + hstep, voffB); PG8_STAGE(PG8_SA(1, 0), a3, voffA);
            PG8_WAIT_V(8); PG8_WAIT_L(0); PG8_BAR; PG8_MMA(1, 0, At, B0); PG8_MMA(1, 1, At, B1); PG8_BAR; PG8_SCHED;
            } else {
            PG8_LDB(B0, 0, 0); PG8_SCHED; PG8_LDA(At, 0, 0); PG8_STAGE(PG8_SA(1, 1), a1 + hstep, voffA);
            PG8_WAIT_L(8); PG8_BAR; PG8_WAIT_L(0); PG8_MMA(0, 0, At, B0); PG8_BAR; PG8_SCHED;
            PG8_LDB(B1, 0, 1); PG8_STAGE(PG8_SB(0, 0), b2, voffB);
            PG8_BAR; PG8_WAIT_L(0); PG8_MMA(0, 1, At, B1); PG8_BAR;
            PG8_LDA(At, 0, 1); PG8_STAGE(PG8_SA(0, 0), a2, voffA);
            PG8_BAR; PG8_WAIT_L(0); PG8_MMA(1, 0, At, B0); PG8_BAR; PG8_SCHED;
            PG8_STAGE(PG8_SB(0, 1), b2 + hstep, voffB);
            PG8_WAIT_V(6); PG8_BAR; PG8_MMA(1, 1, At, B1); PG8_BAR;
            PG8_LDB(B0, 1, 0); PG8_SCHED; PG8_LDA(At, 1, 0); PG8_STAGE(PG8_SA(0, 1), a2 + hstep, voffA);
            PG8_WAIT_L(8); PG8_BAR; PG8_WAIT_L(0); PG8_MMA(0, 0, At, B0); PG8_BAR; PG8_SCHED;
            PG8_LDB(B1, 1, 1); PG8_STAGE(PG8_SB(1, 0), b3, voffB);
            PG8_BAR; PG8_WAIT_L(0); PG8_MMA(0, 1, At, B1); PG8_BAR;
            PG8_LDA(At, 1, 1); PG8_STAGE(PG8_SA(1, 0), a3, voffA);
            PG8_BAR; PG8_WAIT_L(0); PG8_MMA(1, 0, At, B0); PG8_BAR; PG8_SCHED;
            PG8_STAGE(PG8_SB(1, 1), b3 + hstep, voffB);
            PG8_WAIT_V(6); PG8_BAR; PG8_MMA(1, 1, At, B1); PG8_BAR;
            }
        }
        if constexpr (ALIGN_EPI) { if (wr == 0) PG8_BAR; }
        if constexpr (!Epi::AFTER_DRAIN) { E(acc, cur, wr, wc, fr, fq); S.done(cur); }
        if (!has_next) break;
#pragma unroll
        for (int a = 0; a < 2; ++a)
#pragma unroll
            for (int b = 0; b < 2; ++b)
#pragma unroll
                for (int m = 0; m < 4; ++m)
#pragma unroll
                    for (int n = 0; n < 2; ++n) acc[a][b][m][n] = (f32x4){0.f, 0.f, 0.f, 0.f};
        cur = nxt; cA = nA; cB = nB; ++ui;
        if constexpr (ALIGN_EPI) { if (wr == 1) PG8_BAR; }
    }
    PG8_WAIT_V(0);
    if constexpr (!ALIGN_EPI) { if (wr == 0) PG8_BAR; }
    PG8_BAR;
    if constexpr (Epi::AFTER_DRAIN) { E.fused(acc, cur, wr, wc, fr, fq, lds, wid, lane); S.done(cur); }
#undef PG8_SA
#undef PG8_SB
#undef PG8_STAGE
#undef PG8_LDA
#undef PG8_LDB
#undef PG8_MMA
#undef PG8_WAIT_V
#undef PG8_WAIT_L
#undef PG8_BAR
#undef PG8_SCHED
}
}

constexpr size_t WS_QDC  = WS_RS;
constexpr size_t WS_SEGS = WS_RS + 32 * MB;
constexpr size_t WS_GSEG = WS_RS + 48 * MB;
constexpr size_t WS_SC   = WS_RS + 49 * MB;
DI float logsig(float x) { return fminf(x, 0.f) - __logf(1.f + __expf(-fabsf(x))); }

DI void phaseGA(const Params& p, LAS unsigned char* lds, int tid, int lane, int wave) {
    asm volatile("" : "+v"(tid), "+v"(lane));
    unsigned char* ws = p.ws;
    const bf16_t* Z = (const bf16_t*)(ws + WS_RZ);
    const float* AFB = (const float*)(ws + WS_AFB);
    LAS float* la = (LAS float*)lds;
    LAS float* part = (LAS float*)(lds + 16384);
    LAS bf16_t* qdL = (LAS bf16_t*)(lds + 18432);
    LAS bf16_t* kiL = (LAS bf16_t*)(lds + 27648);
    LAS bf16_t* keT = (LAS bf16_t*)(lds + 36864);
    LAS bf16_t* vT  = (LAS bf16_t*)(lds + 46080);
    LAS bf16_t* sL  = (LAS bf16_t*)(lds + 64512);
    LAS float* gs = (LAS float*)(lds + 82944);
    LAS float* wl = (LAS float*)(lds + 83456);
    const int c15 = lane & 15, g = lane >> 4;
    const int i = tid >> 3, dg = tid & 7, d0 = dg * 8;
    for (int task = blockIdx.x; task < 512; task += gridDim.x) {
        const int dir = task & 1, h = (task >> 1) & 3, pb = (task >> 3) & 7, b = task >> 6;
        const int bhd = b * 8 + h * 2 + dir, sg = dir ? 7 - pb : pb, last = dir ? 0 : 63;
        bf16_t* QDC = (bf16_t*)(ws + WS_QDC + (dir ? 16 : 0) * MB);
        bf16_t* OL = (bf16_t*)(ws + WS_RO + (dir ? 64 : 0) * MB);
        f32x4 S[4];
#pragma unroll
        for (int kt = 0; kt < 4; ++kt) S[kt] = (f32x4){0.f, 0.f, 0.f, 0.f};
        __syncthreads();
        for (int e = tid; e < 128 * 72 / 2; e += NTH) ((LAS unsigned*)sL)[e] = 0u;
        if (tid < 64) gs[tid] = 0.f;
        for (int e = tid; e < 1024; e += NTH) wl[e] = (dir ? p.in[9] : p.in[7])[(e >> 6) * 256 + h * 64 + (e & 63)];
        for (int ci = 0; ci < 8; ++ci) {
            const int n = dir ? pb * 8 + 7 - ci : pb * 8 + ci;
            const int tok0 = b * SEQ + n * 64;
            const size_t t = (size_t)tok0 + i;
            const u32x4 qv = *(const u32x4*)(Z + t * ZW + h * 64 + d0), kv = *(const u32x4*)(Z + t * ZW + 256 + h * 64 + d0);
            u32x4 vvp[2];
#pragma unroll
            for (int ps = 0; ps < 2; ++ps) { const int idx = tid + NTH * ps, vi = idx >> 4, ch = idx & 15; vvp[ps] = *(const u32x4*)(Z + ((size_t)tok0 + vi) * ZW + 512 + h * 128 + ch * 8); }
            f32x4 av[4];
#pragma unroll
            for (int q = 0; q < 4; ++q) av[q] = *(const f32x4*)(AFB + t * 32 + dir * 16 + 4 * q);
            const int qrow = (task * 8 + ci) * NWV + wave;
            f32x4 qa[4]; quant_load(p, qrow, lane, qa);
            __syncthreads();
            {
                float x[8];
#pragma unroll
                for (int e = 0; e < 8; ++e) x[e] = (dir ? p.in[10] : p.in[8])[h * 64 + d0 + e];
#pragma unroll
                for (int r = 0; r < 16; ++r) {
                    const float a = av[r >> 2][r & 3];
                    const f32x4 w0 = *(const LAS f32x4*)(wl + r * 64 + d0), w1 = *(const LAS f32x4*)(wl + r * 64 + d0 + 4);
#pragma unroll
                    for (int e = 0; e < 4; ++e) { x[e] += a * w0[e]; x[4 + e] += a * w1[e]; }
                }
#pragma unroll
                for (int e = 0; e < 8; ++e) la[i * 64 + d0 + e] = logsig(x[e]) * 0.0625f;
            }
            quant_store(p, qrow, lane, qa);
            __syncthreads();
            {
                const int d = tid & 63, pt = tid >> 6;
                float run = 0.f;
                if (dir == 0) {
#pragma unroll
                    for (int j = 0; j < 8; ++j) { run += la[(8 * pt + j) * 64 + d]; la[(8 * pt + j) * 64 + d] = run; }
                } else {
#pragma unroll
                    for (int j = 7; j >= 0; --j) { run += la[(8 * pt + j) * 64 + d]; la[(8 * pt + j) * 64 + d] = run; }
                }
                part[pt * 64 + d] = run;
                __syncthreads();
                float off = 0.f;
#pragma unroll
                for (int q = 0; q < 8; ++q) { const bool take = dir ? (q > pt) : (q < pt); off += take ? part[q * 64 + d] : 0.f; }
#pragma unroll
                for (int j = 0; j < 8; ++j) la[(8 * pt + j) * 64 + d] += off;
            }
            __syncthreads();
            {
                float q[8], k[8];
#pragma unroll
                for (int e = 0; e < 4; ++e) { q[2 * e] = bflo(qv[e]); q[2 * e + 1] = bfhi(qv[e]); k[2 * e] = bflo(kv[e]); k[2 * e + 1] = bfhi(kv[e]); }
                float qd[8], ki[8], ke[8], qc[8];
#pragma unroll
                for (int e = 0; e < 8; ++e) {
                    const float bb = la[i * 64 + d0 + e], bl = la[last * 64 + d0 + e], gv = gs[(ci & 1) * 64 + d0 + e];
                    qd[e] = q[e] * __expf(bb); ki[e] = k[e] * __expf(-bb); ke[e] = k[e] * __expf(bl - bb); qc[e] = q[e] * __expf(bb + gv);
                }
                const u32x4 o1 = {pk2(qd[0], qd[1]), pk2(qd[2], qd[3]), pk2(qd[4], qd[5]), pk2(qd[6], qd[7])};
                const u32x4 o2 = {pk2(ki[0], ki[1]), pk2(ki[2], ki[3]), pk2(ki[4], ki[5]), pk2(ki[6], ki[7])};
                const u32x4 o3 = {pk2(qc[0], qc[1]), pk2(qc[2], qc[3]), pk2(qc[4], qc[5]), pk2(qc[6], qc[7])};
                *(LAS u32x4*)(qdL + i * 72 + d0) = o1; *(LAS u32x4*)(kiL + i * 72 + d0) = o2;
                *(u32x4*)(QDC + t * 256 + h * 64 + d0) = o3;
#pragma unroll
                for (int e = 0; e < 4; ++e) { const unsigned w = pk2(ke[2 * e], ke[2 * e + 1]); keT[(d0 + 2 * e) * 72 + perm32(i)] = (bf16_t)(w & 0xFFFFu); keT[(d0 + 2 * e + 1) * 72 + perm32(i)] = (bf16_t)(w >> 16); }
#pragma unroll
                for (int ps = 0; ps < 2; ++ps) {
                    const int idx = tid + NTH * ps, vi = idx >> 4, ch = idx & 15;
#pragma unroll
                    for (int e = 0; e < 4; ++e) { vT[(ch * 8 + 2 * e) * 72 + perm32(vi)] = (bf16_t)(vvp[ps][e] & 0xFFFFu); vT[(ch * 8 + 2 * e + 1) * 72 + perm32(vi)] = (bf16_t)(vvp[ps][e] >> 16); }
                }
            }
            __syncthreads();
            {
                const int it = wave & 3, dvh = wave >> 2;
                bf16x8 qdb[2];
#pragma unroll
                for (int s = 0; s < 2; ++s) qdb[s] = *(const LAS bf16x8*)(qdL + (16 * it + c15) * 72 + 32 * s + 8 * g);
                f32x4 sc[4];
#pragma unroll
                for (int jt = 0; jt < 4; ++jt) {
                    sc[jt] = (f32x4){0.f, 0.f, 0.f, 0.f};
#pragma unroll
                    for (int s = 0; s < 2; ++s) sc[jt] = MFMA16(*(const LAS bf16x8*)(kiL + (16 * jt + c15) * 72 + 32 * s + 8 * g), qdb[s], sc[jt]);
                    const int ii = 16 * it + c15;
#pragma unroll
                    for (int r = 0; r < 4; ++r) { const int jj = 16 * jt + 4 * g + r; const bool keep = dir ? (jj > ii) : (jj <= ii); sc[jt][r] = keep ? sc[jt][r] : 0.f; }
                }
                const bf16x8 pa[2] = {pack8(sc[0], sc[1]), pack8(sc[2], sc[3])};
#pragma unroll
                for (int nt = 0; nt < 4; ++nt) {
                    const int dvr = 64 * dvh + 16 * nt + c15;
                    f32x4 o = (f32x4){0.f, 0.f, 0.f, 0.f};
#pragma unroll
                    for (int s = 0; s < 2; ++s) {
                        o = MFMA16(*(const LAS bf16x8*)(vT + dvr * 72 + 32 * s + 8 * g), pa[s], o);
                        o = MFMA16(*(const LAS bf16x8*)(sL + dvr * 72 + 32 * s + 8 * g), qdb[s], o);
                    }
                    const u32x2 w = {pk2(o[0], o[1]), pk2(o[2], o[3])};
                    *(u32x2*)(OL + ((size_t)tok0 + 16 * it + c15) * 512 + h * 128 + 64 * dvh + 16 * nt + 4 * g) = w;
                }
                bf16x8 vb[2];
#pragma unroll
                for (int s = 0; s < 2; ++s) vb[s] = *(const LAS bf16x8*)(vT + (16 * wave + c15) * 72 + 32 * s + 8 * g);
#pragma unroll
                for (int kt = 0; kt < 4; ++kt) {
                    const LAS float* gl = la + last * 64 + 16 * kt + 4 * g;
                    const f32x4 gm = {__expf(gl[0]), __expf(gl[1]), __expf(gl[2]), __expf(gl[3])};
                    f32x4 a = S[kt] * gm;
#pragma unroll
                    for (int s = 0; s < 2; ++s) a = MFMA16(*(const LAS bf16x8*)(keT + (16 * kt + c15) * 72 + 32 * s + 8 * g), vb[s], a);
                    S[kt] = a;
                }
                if (tid < 64) gs[((ci + 1) & 1) * 64 + tid] = gs[(ci & 1) * 64 + tid] + la[last * 64 + tid];
            }
            __syncthreads();
#pragma unroll
            for (int kt = 0; kt < 4; ++kt) { const u32x2 w = {pk2(S[kt][0], S[kt][1]), pk2(S[kt][2], S[kt][3])}; *(LAS u32x2*)(sL + (16 * wave + c15) * 72 + 16 * kt + 4 * g) = w; }
        }
        {
            float* SEGS = (float*)(ws + WS_SEGS) + (size_t)(bhd * 8 + sg) * 64 * 128;
#pragma unroll
            for (int kt = 0; kt < 4; ++kt)
#pragma unroll
                for (int r = 0; r < 4; ++r) SEGS[(16 * kt + 4 * g + r) * 128 + 16 * wave + c15] = S[kt][r];
            __syncthreads();
            if (tid < 64) ((float*)(ws + WS_GSEG))[(bhd * 8 + sg) * 64 + tid] = __expf(gs[tid]);
        }
    }
}

DI void phaseGB(const Params& p, int tid) {
    unsigned char* ws = p.ws;
    const float* SEGS = (const float*)(ws + WS_SEGS); const float* GSEG = (const float*)(ws + WS_GSEG); bf16_t* SC = (bf16_t*)(ws + WS_SC);
    for (int e = blockIdx.x * NTH + tid; e < 64 * 128 * 16; e += gridDim.x * NTH) {
        const int dv = e & 127, dk4 = (e >> 7) & 15, bhd = e >> 11;
        float c[4] = {0.f, 0.f, 0.f, 0.f};
        for (int sg = 0; sg < 8; ++sg) {
            const u32x2 w = {pk2(c[0], c[1]), pk2(c[2], c[3])};
            *(u32x2*)(SC + ((size_t)(bhd * 8 + sg) * 128 + dv) * 64 + 4 * dk4) = w;
            const f32x4 gm = *(const f32x4*)(GSEG + (bhd * 8 + sg) * 64 + 4 * dk4);
#pragma unroll
            for (int r = 0; r < 4; ++r) c[r] = gm[r] * c[r] + SEGS[((size_t)(bhd * 8 + sg) * 64 + 4 * dk4 + r) * 128 + dv];
        }
    }
}

DI void phase4a(const Params& p, LAS unsigned char* lds, int tid, int lane, int wave) {
    asm volatile("" : "+v"(tid), "+v"(lane));
    unsigned char* ws = p.ws;
    const bf16_t* Z = (const bf16_t*)(ws + WS_RZ);
    bf16_t* MIX = (bf16_t*)(ws + WS_RA);
    const bf16_t* OF = (const bf16_t*)(ws + WS_RO); const bf16_t* OB = (const bf16_t*)(ws + WS_RO + 64 * MB);
    const bf16_t* WP = (const bf16_t*)(ws + WS_WP);
    LAS bf16_t* pt = (LAS bf16_t*)lds;
    LAS unsigned char* at = lds + 81920;
    const int c15 = lane & 15, g = lane >> 4;
    for (int tile = blockIdx.x; tile < T / 64; tile += gridDim.x) {
        const int tok0 = tile * 64, s0 = tok0 & (SEQ - 1);
        __syncthreads();
#pragma unroll
        for (int ps = 0; ps < 10; ++ps) {
            const int idx = tid + NTH * ps, rr = idx >> 6, ch = idx & 63, sq = s0 - 8 + rr;
            u32x4 v = {0u, 0u, 0u, 0u};
            if (sq >= 0 && sq < SEQ) v = *(const u32x4*)(Z + ((size_t)tok0 - 8 + rr) * ZW + 1536 + ch * 8);
            *(LAS u32x4*)(pt + rr * 512 + ch * 8) = v;
        }
        {
            const int hh = wave >> 1, ih = wave & 1, bb = tok0 / SEQ, nn = s0 >> 6;
            f32x4 acc[8][2];
#pragma unroll
            for (int mt = 0; mt < 8; ++mt) { acc[mt][0] = (f32x4){0.f, 0.f, 0.f, 0.f}; acc[mt][1] = (f32x4){0.f, 0.f, 0.f, 0.f}; }
#pragma unroll
            for (int dir = 0; dir < 2; ++dir) {
                const int sg = dir ? 7 - (nn >> 3) : (nn >> 3), bhd = bb * 8 + hh * 2 + dir;
                const bf16_t* SCp = (const bf16_t*)(ws + WS_SC) + (size_t)(bhd * 8 + sg) * 128 * 64;
                const bf16_t* QCp = (const bf16_t*)(ws + WS_QDC + (dir ? 16 : 0) * MB) + ((size_t)tok0 + 32 * ih) * 256 + hh * 64;
#pragma unroll
                for (int s = 0; s < 2; ++s) {
                    const bf16x8 q0 = ld_frag16(QCp + (size_t)c15 * 256 + 32 * s + 8 * g), q1 = ld_frag16(QCp + (size_t)(16 + c15) * 256 + 32 * s + 8 * g);
#pragma unroll
                    for (int mt = 0; mt < 8; ++mt) {
                        const bf16x8 af = ld_frag16(SCp + (16 * mt + c15) * 64 + 32 * s + 8 * g);
                        acc[mt][0] = MFMA16(af, q0, acc[mt][0]); acc[mt][1] = MFMA16(af, q1, acc[mt][1]);
                    }
                }
            }
#pragma unroll
            for (int nt = 0; nt < 2; ++nt) {
                const size_t t = (size_t)tok0 + 32 * ih + 16 * nt + c15;
                float ss = 0.f;
#pragma unroll
                for (int mt = 0; mt < 8; ++mt) {
                    const u32x2 a = *(const u32x2*)(OF + t * 512 + hh * 128 + 16 * mt + 4 * g), bq = *(const u32x2*)(OB + t * 512 + hh * 128 + 16 * mt + 4 * g);
                    f32x4 o = acc[mt][nt];
                    o[0] += bflo(a.x) + bflo(bq.x); o[1] += bfhi(a.x) + bfhi(bq.x); o[2] += bflo(a.y) + bflo(bq.y); o[3] += bfhi(a.y) + bfhi(bq.y);
                    acc[mt][nt] = o; ss += o[0] * o[0] + o[1] * o[1] + o[2] * o[2] + o[3] * o[3];
                }
                ss += __shfl_xor(ss, 16); ss += __shfl_xor(ss, 32);
                const float rstd = rsqrtf(ss * (1.f / 128.f) + EPS);
#pragma unroll
                for (int mt = 0; mt < 8; ++mt) {
                    const u32x2 rv = *(const u32x2*)(Z + t * ZW + 1024 + hh * 128 + 16 * mt + 4 * g);
                    const f32x4 gh = *(const f32x4*)(p.in[11] + hh * 128 + 16 * mt + 4 * g);
                    const float r0 = bflo(rv.x), r1 = bfhi(rv.x), r2 = bflo(rv.y), r3 = bfhi(rv.y);
                    const f32x4 o = acc[mt][nt];
                    const float y0 = o[0] * rstd * gh[0] * (r0 / (1.f + __expf(-r0))), y1 = o[1] * rstd * gh[1] * (r1 / (1.f + __expf(-r1)));
                    const float y2 = o[2] * rstd * gh[2] * (r2 / (1.f + __expf(-r2))), y3 = o[3] * rstd * gh[3] * (r3 / (1.f + __expf(-r3)));
                    const u32x2 w = {pk2(y0, y1), pk2(y2, y3)};
                    *(u32x2*)(MIX + t * D + hh * 128 + 16 * mt + 4 * g) = w;
                }
            }
        }
        __syncthreads();
        {
            const int c = tid, gi = c >> 7, cc = c & 127, hw = 1 << gi;
            LAS unsigned char* ag = at + gi * 16384;
            float sum = 0.f;
            {   const int lo = max(s0 - hw, 0), hi = min(s0 + hw, SEQ);
                for (int rr = lo; rr < hi; ++rr) sum += bflo((unsigned)pt[(rr - s0 + 8) * 512 + c]); }
#pragma unroll 4
            for (int i = 0; i < 64; ++i) {
                const int sq = s0 + i, lo = max(sq - hw, 0), hi = min(sq + hw, SEQ);
                const float val = sum / (float)(hi - lo) - bflo((unsigned)pt[(i + 8) * 512 + c]);
                *(LAS bf16_t*)(ag + i * 256 + (((cc >> 3) ^ (i & 15)) * 16) + (cc & 7) * 2) = (bf16_t)(pk2(val, 0.f) & 0xFFFFu);
                if (sq + hw < SEQ) sum += bflo((unsigned)pt[(i + 8 + hw) * 512 + c]);
                if (sq - hw >= 0) sum -= bflo((unsigned)pt[(i + 8 - hw) * 512 + c]);
            }
        }
        __syncthreads();
        {
            const int gi = wave >> 1, dh = wave & 1;
            LAS unsigned char* ag = at + gi * 16384;
            f32x4 acc[4][4];
#pragma unroll
            for (int mt = 0; mt < 4; ++mt)
#pragma unroll
                for (int nt = 0; nt < 4; ++nt) acc[mt][nt] = (f32x4){0.f, 0.f, 0.f, 0.f};
#pragma unroll
            for (int s = 0; s < 4; ++s) {
                bf16x8 af[4];
#pragma unroll
                for (int mt = 0; mt < 4; ++mt) { const int row = mt * 16 + c15; af[mt] = *(const LAS bf16x8*)(ag + row * 256 + (((4 * s + g) ^ (row & 15)) * 16)); }
#pragma unroll
                for (int nt = 0; nt < 4; ++nt) {
                    const bf16x8 wf = ld_frag16(WP + (size_t)gi * 16384 + (dh * 64 + 16 * nt + c15) * 128 + 32 * s + 8 * g);
#pragma unroll
                    for (int mt = 0; mt < 4; ++mt) acc[mt][nt] = MFMA16(wf, af[mt], acc[mt][nt]);
                }
            }
#pragma unroll
            for (int nt = 0; nt < 4; ++nt) {
                const f32x4 ps = *(const f32x4*)(p.in[13] + gi * 128 + dh * 64 + 16 * nt + 4 * g);
#pragma unroll
                for (int mt = 0; mt < 4; ++mt) {
                    const f32x4 v = acc[mt][nt] * ps;
                    u32x2 w = {pk2(v[0], v[1]), pk2(v[2], v[3])};
                    *(u32x2*)(MIX + ((size_t)tok0 + mt * 16 + c15) * D + 512 + gi * 128 + dh * 64 + 16 * nt + 4 * g) = w;
                }
            }
        }
    }
}

DI void phase4c(const Params& p, LAS unsigned char* lds, int tid, int lane, int wave) {
    asm volatile("" : "+v"(tid), "+v"(lane));
    LAS float* lG = (LAS float*)lds; LAS float* lA = lG + 1024; LAS float* lB = lA + 1024; LAS float* lP = lB + 1024;
    const float* x = p.in[0]; const bf16_t* MIXO = (const bf16_t*)(p.ws + WS_RZ); bf16_t* H2 = (bf16_t*)(p.ws + WS_RA);
    for (int rt = blockIdx.x; rt < T / 128; rt += gridDim.x) {
        const int b = rt / 32;
        __syncthreads();
        for (int d = tid; d < 1024; d += NTH) { lG[d] = mod_at(p, b, 2048 + d); lA[d] = p.in[15][d] * (1.f + mod_at(p, b, 4096 + d)); lB[d] = mod_at(p, b, 3072 + d); lP[d] = p.in[5][d]; }
        __syncthreads();
        for (int r0 = wave; r0 < 128; r0 += 2 * NWV) {
            f32x4 m[2][4], xv[2][4];
#pragma unroll
            for (int u = 0; u < 2; ++u) {
                const size_t row = (size_t)rt * 128 + r0 + u * NWV;
                const u32x2* mr = (const u32x2*)(MIXO + row * D) + lane; const f32x4* xr = (const f32x4*)(x + row * D) + lane;
#pragma unroll
                for (int j = 0; j < 4; ++j) { const u32x2 mv = mr[64 * j]; m[u][j] = (f32x4){bflo(mv.x), bfhi(mv.x), bflo(mv.y), bfhi(mv.y)}; xv[u][j] = xr[64 * j]; }
            }
#pragma unroll
            for (int u = 0; u < 2; ++u) {
                const size_t row = (size_t)rt * 128 + r0 + u * NWV;
                float ss = 0.f;
#pragma unroll
                for (int j = 0; j < 4; ++j) ss += m[u][j][0] * m[u][j][0] + m[u][j][1] * m[u][j][1] + m[u][j][2] * m[u][j][2] + m[u][j][3] * m[u][j][3];
                const float rstd = rsqrtf(wave_sum(ss) * (1.f / D) + EPS);
                float s2 = 0.f;
#pragma unroll
                for (int j = 0; j < 4; ++j) {
                    const f32x4 gt = *(const LAS f32x4*)(lG + 4 * lane + 256 * j), pm = *(const LAS f32x4*)(lP + 4 * lane + 256 * j);
                    xv[u][j] = xv[u][j] + gt * (m[u][j] * rstd * pm);
                    s2 += xv[u][j][0] * xv[u][j][0] + xv[u][j][1] * xv[u][j][1] + xv[u][j][2] * xv[u][j][2] + xv[u][j][3] * xv[u][j][3];
                }
                const float rstd2 = rsqrtf(wave_sum(s2) * (1.f / D) + EPS);
                f32x4* orow = (f32x4*)(p.out + row * D) + lane; u32x2* hrow = (u32x2*)(H2 + row * D) + lane;
#pragma unroll
                for (int j = 0; j < 4; ++j) {
                    orow[64 * j] = xv[u][j];
                    const f32x4 a = *(const LAS f32x4*)(lA + 4 * lane + 256 * j), bb = *(const LAS f32x4*)(lB + 4 * lane + 256 * j);
                    const f32x4 hv = xv[u][j] * rstd2 * a + bb;
                    u32x2 w = {pk2(hv[0], hv[1]), pk2(hv[2], hv[3])};
                    hrow[64 * j] = w;
                }
            }
        }
    }
}

DI int skey(float v, int idx, int mask) { int u = __float_as_int(v); u ^= (u >> 31) & 0x7FFFFFFF; return (u & ~mask) | idx; }
DI float sval(int k, int mask) { int u = k & ~mask; u ^= (u >> 31) & 0x7FFFFFFF; return __int_as_float(u); }
DI void cswap(int& a, int& b) { const int mx = max(a, b), mn = min(a, b); a = mx; b = mn; }
DI void sort16_desc(int (&a)[16]) {
#pragma unroll
    for (int k = 2; k <= 16; k <<= 1) {
#pragma unroll
        for (int j = k >> 1; j > 0; j >>= 1) {
#pragma unroll
            for (int i = 0; i < 16; ++i) {
                const int l = i ^ j;
                if (l > i) { if ((i & k) == 0) cswap(a[i], a[l]); else cswap(a[l], a[i]); }
            }
        }
    }
}
DI void merge16_desc(int (&x)[16], const int (&y)[16]) {
#pragma unroll
    for (int i = 0; i < 16; ++i) x[i] = max(x[i], y[15 - i]);
#pragma unroll
    for (int j = 8; j > 0; j >>= 1) {
#pragma unroll
        for (int i = 0; i < 16; ++i) { const int l = i ^ j; if (l > i) cswap(x[i], x[l]); }
    }
}

DI void phase5b(const Params& p, LAS unsigned char* lds, int tid, int lane, int wave) {
    asm volatile("" : "+v"(tid), "+v"(lane));
    unsigned char* ws = p.ws;
    const bf16_t* Q2 = (const bf16_t*)(ws + WS_RZ);
    const bf16_t* SKB = (const bf16_t*)(ws + WS_SKB);
    int* EIDX = (int*)(ws + WS_RS); float* GATE = (float*)(ws + WS_RS + 16 * MB);
    LAS unsigned char* tab = lds + tid * 32;
    LAS unsigned char* skl = lds + 16384;
    const int c31 = lane & 31, hi = lane >> 5;
    for (int btask = blockIdx.x; btask < 256; btask += gridDim.x) {
        const int h = btask & 7, tgc = btask >> 3;
        __syncthreads();
#pragma unroll
        for (int ps = 0; ps < 8; ++ps) {
            const int idx = tid + NTH * ps, row = idx >> 4, ch = idx & 15;
            const u32x4 v = *(const u32x4*)(SKB + ((size_t)h * 256 + row) * 128 + ch * 8);
            *(LAS u32x4*)(skl + row * 256 + ((ch ^ (row & 15)) * 16)) = v;
        }
        __syncthreads();
      for (int ti = 0; ti < 4; ++ti) {
        const int tg = tgc * 32 + wave * 4 + ti;
        const size_t tok = (size_t)tg * 32 + c31;
        int lst[2][16];
        bf16x8 bq[2][8];
#pragma unroll
        for (int pp = 0; pp < 2; ++pp) {
            const bf16_t* qp = Q2 + tok * 2048 + h * 256 + pp * 128 + 8 * hi;
            asm volatile("" : "+v"(qp));
#pragma unroll
            for (int ks = 0; ks < 8; ++ks) bq[pp][ks] = ld_frag16(qp + 16 * ks);
        }
#pragma unroll
        for (int pp = 0; pp < 2; ++pp) {
            int run[16];
#pragma unroll
            for (int r = 0; r < 16; ++r) run[r] = (int)0x80000000;
#pragma unroll 1
            for (int kt = 0; kt < 4; ++kt) {
                const LAS unsigned char* kb = skl + pp * 32768 + (32 * kt + c31) * 256;
                f32x16 acc;
#pragma unroll
                for (int r = 0; r < 16; ++r) acc[r] = 0.f;
#pragma unroll
                for (int ks = 0; ks < 8; ++ks) acc = MFMA32(*(const LAS bf16x8*)(kb + (((2 * ks + hi) ^ (c31 & 15)) * 16)), bq[pp][ks], acc);
                int cur[16];
#pragma unroll
                for (int r = 0; r < 16; ++r) cur[r] = skey(acc[r], 32 * kt + 8 * (r >> 2) + 4 * hi + (r & 3), 0x7F);
                sort16_desc(cur);
                merge16_desc(run, cur);
            }
            int oth[16];
#pragma unroll
            for (int r = 0; r < 16; ++r) oth[r] = __shfl_xor(run[r], 32);
            merge16_desc(run, oth);
#pragma unroll
            for (int r = 0; r < 16; ++r) lst[pp][r] = run[r];
        }
#pragma unroll
        for (int pp = 0; pp < 2; ++pp) {
            u32x4 w;
#pragma unroll
            for (int q = 0; q < 4; ++q) w[q] = (lst[pp][4 * q] & 0x7F) | ((lst[pp][4 * q + 1] & 0x7F) << 8) | ((lst[pp][4 * q + 2] & 0x7F) << 16) | ((lst[pp][4 * q + 3] & 0x7F) << 24);
            *(LAS u32x4*)(tab + 16 * pp) = w;
        }
        float va[16], vb[16];
#pragma unroll
        for (int r = 0; r < 16; ++r) { va[r] = sval(lst[0][r], 0x7F); vb[r] = sval(lst[1][r], 0x7F); }
        int cand[4][16];
        {
            int cnt = 0;
#pragma unroll
            for (int i = 0; i < 16; ++i)
#pragma unroll
                for (int j = 0; j < 16; ++j)
                    if ((i + 1) * (j + 1) <= 16) { cand[cnt >> 4][cnt & 15] = skey(va[i] + vb[j], (i << 4) | j, 0xFF); ++cnt; }
#pragma unroll
            for (int q = 50; q < 64; ++q) cand[q >> 4][q & 15] = (int)0x80000000;
        }
        sort16_desc(cand[0]); sort16_desc(cand[1]); sort16_desc(cand[2]); sort16_desc(cand[3]);
        merge16_desc(cand[0], cand[1]); merge16_desc(cand[2], cand[3]); merge16_desc(cand[0], cand[2]);
        asm volatile("s_waitcnt lgkmcnt(0)" ::: "memory");
        float sv[16]; int ex[16];
        const float mx = sval(cand[0][0], 0xFF);
        float sum = 0.f;
#pragma unroll
        for (int r = 0; r < 16; ++r) {
            const int ck = cand[0][r];
            const int i1 = tab[(ck >> 4) & 15], i2 = tab[16 + (ck & 15)];
            ex[r] = i1 * 128 + i2;
            sv[r] = __expf(sval(ck, 0xFF) - mx); sum += sv[r];
        }
        const float inv = 1.f / sum;
        int* ep = EIDX + tok * 128 + h * 16 + 8 * hi; float* gp = GATE + tok * 128 + h * 16 + 8 * hi;
        if (hi == 0) {
            *(u32x4*)ep = (u32x4){(unsigned)ex[0], (unsigned)ex[1], (unsigned)ex[2], (unsigned)ex[3]}; *(u32x4*)(ep + 4) = (u32x4){(unsigned)ex[4], (unsigned)ex[5], (unsigned)ex[6], (unsigned)ex[7]};
            *(f32x4*)gp = (f32x4){sv[0] * inv, sv[1] * inv, sv[2] * inv, sv[3] * inv}; *(f32x4*)(gp + 4) = (f32x4){sv[4] * inv, sv[5] * inv, sv[6] * inv, sv[7] * inv};
        } else {
            *(u32x4*)ep = (u32x4){(unsigned)ex[8], (unsigned)ex[9], (unsigned)ex[10], (unsigned)ex[11]}; *(u32x4*)(ep + 4) = (u32x4){(unsigned)ex[12], (unsigned)ex[13], (unsigned)ex[14], (unsigned)ex[15]};
            *(f32x4*)gp = (f32x4){sv[8] * inv, sv[9] * inv, sv[10] * inv, sv[11] * inv}; *(f32x4*)(gp + 4) = (f32x4){sv[12] * inv, sv[13] * inv, sv[14] * inv, sv[15] * inv};
        }
      }
    }
}

template <int K> DI int swz_bcast(int v) { return __builtin_amdgcn_ds_swizzle(v, 0x10 | (K << 5)); }
template <int W> DI int swz_xor(int v) { return __builtin_amdgcn_ds_swizzle(v, 0x1F | (W << 10)); }
template <int K> struct IC { static constexpr int v = K; };
template <int N, int I = 0, class F> DI void static_for(F&& f) { if constexpr (I < N) { f(IC<I>{}); static_for<N, I + 1>(f); } }
DI float row16_sum(float v) {
    v += __builtin_bit_cast(float, __builtin_amdgcn_update_dpp(0, __builtin_bit_cast(int, v), 0xB1, 0xF, 0xF, true));
    v += __builtin_bit_cast(float, __builtin_amdgcn_update_dpp(0, __builtin_bit_cast(int, v), 0x4E, 0xF, 0xF, true));
    v += __builtin_bit_cast(float, __builtin_amdgcn_update_dpp(0, __builtin_bit_cast(int, v), 0x141, 0xF, 0xF, true));
    v += __builtin_bit_cast(float, __builtin_amdgcn_update_dpp(0, __builtin_bit_cast(int, v), 0x140, 0xF, 0xF, true));
    return v;
}
DI void phase6(const Params& p, LAS unsigned char* lds, int tid, int lane, int wave) {
    asm volatile("" : "+v"(tid), "+v"(lane));
    unsigned char* ws = p.ws;
    const bf16_t* H2 = (const bf16_t*)(ws + WS_RA);
    const unsigned char* UQ = ws + WS_UB; const unsigned char* VQ = ws + WS_VB;
    const float* SU = (const float*)(ws + WS_SU); const float* SV = (const float*)(ws + WS_SV);
    const int* EIDX = (const int*)(ws + WS_RS); const float* GATE = (const float*)(ws + WS_RS + 16 * MB);
    LAS float* lG = (LAS float*)lds;
    const int q = lane >> 4, l16 = lane & 15;
    LAS int* le = (LAS int*)(lds + 4096 + wave * 6144) + q * 128;
    LAS float* lg = (LAS float*)(lds + 4096 + wave * 6144 + 2048) + q * 128;
    LAS float* lc = (LAS float*)(lds + 4096 + wave * 6144 + 4096) + q * 128;
    const unsigned qlo = q < 2 ? (0xFFFFu << (16 * q)) : 0u, qhi = q >= 2 ? (0xFFFFu << (16 * (q - 2))) : 0u;
    for (int rt = blockIdx.x; rt < T / 128; rt += gridDim.x) {
        const int b = rt / 32;
        __syncthreads();
        for (int d = tid; d < 1024; d += NTH) lG[d] = mod_at(p, b, 5120 + d) * p.in[16][d];
        __syncthreads();
#pragma unroll 1
        for (int rd = 0; rd < 4; ++rd) {
            __syncthreads();
            const size_t t = (size_t)rt * 128 + wave * 16 + rd * 4 + q;
            {
                int e[8]; float g[8];
#pragma unroll
                for (int r = 0; r < 8; ++r) { e[r] = EIDX[t * 128 + r * 16 + l16]; g[r] = GATE[t * 128 + r * 16 + l16]; }
                unsigned W[4] = {0u, 0u, 0u, 0u};
#pragma unroll
                for (int r = 0; r < 8; ++r) {
                    const int k = e[r] >> 10; const unsigned inc = 1u << (8 * (k & 3)); const int w = k >> 2;
                    W[0] += (w == 0) ? inc : 0u; W[1] += (w == 1) ? inc : 0u; W[2] += (w == 2) ? inc : 0u; W[3] += (w == 3) ? inc : 0u;
                }
                unsigned C[4];
                {
                    unsigned tot[4], exc[4];
#pragma unroll
                    for (int w = 0; w < 4; ++w) {
                        unsigned x = W[w];
                        x += (unsigned)__builtin_amdgcn_update_dpp(0, (int)x, 0x111, 0xF, 0xF, true);
                        x += (unsigned)__builtin_amdgcn_update_dpp(0, (int)x, 0x112, 0xF, 0xF, true);
                        x += (unsigned)__builtin_amdgcn_update_dpp(0, (int)x, 0x114, 0xF, 0xF, true);
                        x += (unsigned)__builtin_amdgcn_update_dpp(0, (int)x, 0x118, 0xF, 0xF, true);
                        exc[w] = x - W[w];
                        tot[w] = (unsigned)swz_bcast<15>((int)x);
                    }
                    unsigned carry = 0u;
#pragma unroll
                    for (int w = 0; w < 4; ++w) {
                        const unsigned P = tot[w] + (tot[w] << 8) + (tot[w] << 16) + (tot[w] << 24);
                        C[w] = (P - tot[w]) + carry * 0x01010101u + exc[w];
                        carry += P >> 24;
                    }
                }
#pragma unroll
                for (int r = 0; r < 8; ++r) {
                    const int k = e[r] >> 10; const int sh = 8 * (k & 3); const int w = k >> 2; const unsigned inc = 1u << sh;
                    const unsigned cw = (w == 0) ? C[0] : (w == 1) ? C[1] : (w == 2) ? C[2] : C[3];
                    const int pos = (int)((cw >> sh) & 0xFFu);
                    le[pos] = e[r]; lg[pos] = g[r];
                    C[0] += (w == 0) ? inc : 0u; C[1] += (w == 1) ? inc : 0u; C[2] += (w == 2) ? inc : 0u; C[3] += (w == 3) ? inc : 0u;
                }
                asm volatile("s_waitcnt lgkmcnt(0)" ::: "memory");
            }
            {
                int hq[16]; float ish;
                {
                    float hv[64]; float hm = 0.f;
#pragma unroll
                    for (int i = 0; i < 4; ++i) {
                        const u32x4 h0 = *(const u32x4*)(H2 + t * D + 256 * i + 16 * l16), h1 = *(const u32x4*)(H2 + t * D + 256 * i + 16 * l16 + 8);
#pragma unroll
                        for (int c = 0; c < 4; ++c) { hv[16 * i + 2 * c] = bflo(h0[c]); hv[16 * i + 2 * c + 1] = bfhi(h0[c]); hv[16 * i + 8 + 2 * c] = bflo(h1[c]); hv[16 * i + 8 + 2 * c + 1] = bfhi(h1[c]); }
                    }
#pragma unroll
                    for (int j = 0; j < 64; ++j) hm = fmaxf(hm, fabsf(hv[j]));
                    hm = fmaxf(hm, __builtin_bit_cast(float, __builtin_amdgcn_update_dpp(0, __builtin_bit_cast(int, hm), 0xB1, 0xF, 0xF, true)));
                    hm = fmaxf(hm, __builtin_bit_cast(float, __builtin_amdgcn_update_dpp(0, __builtin_bit_cast(int, hm), 0x4E, 0xF, 0xF, true)));
                    hm = fmaxf(hm, __builtin_bit_cast(float, __builtin_amdgcn_update_dpp(0, __builtin_bit_cast(int, hm), 0x141, 0xF, 0xF, true)));
                    hm = fmaxf(hm, __builtin_bit_cast(float, __builtin_amdgcn_update_dpp(0, __builtin_bit_cast(int, hm), 0x140, 0xF, 0xF, true)));
                    const float s8 = hm > 1e-30f ? 127.f / hm : 0.f; ish = hm * (1.f / 127.f);
#pragma unroll
                    for (int d = 0; d < 16; ++d) {
                        const int q0 = __float2int_rn(hv[4 * d] * s8), q1 = __float2int_rn(hv[4 * d + 1] * s8), q2 = __float2int_rn(hv[4 * d + 2] * s8), q3 = __float2int_rn(hv[4 * d + 3] * s8);
                        hq[d] = (int)((unsigned)(q0 & 0xFF) | ((unsigned)(q1 & 0xFF) << 8) | ((unsigned)(q2 & 0xFF) << 16) | ((unsigned)q3 << 24));
                    }
                }
                constexpr int UD = 4;
                u32x4 ub[UD][4];
                int evn = le[l16];
                static_for<UD>([&](auto kc) { constexpr int k = decltype(kc)::v; const unsigned char* up = UQ + (size_t)swz_bcast<k>(evn) * 1024 + 16 * l16;
#pragma unroll
                    for (int i = 0; i < 4; ++i) ub[k][i] = *(const u32x4*)(up + 256 * i); });
#pragma unroll 1
                for (int bt = 0; bt < 8; ++bt) {
                    if (bt) __syncthreads();
                    const int ev = evn; const float gv = lg[bt * 16 + l16];
                    evn = le[(bt < 7 ? bt + 1 : 7) * 16 + l16];
                    const float isu = SU[ev] * ish, isv = SV[ev];
                    int part[16];
                    static_for<16>([&](auto kc) {
                        constexpr int k = decltype(kc)::v, sl = k % UD;
                        int a = 0;
#pragma unroll
                        for (int i = 0; i < 4; ++i) {
                            const u32x4 u = ub[sl][i];
#pragma unroll
                            for (int c = 0; c < 4; ++c) a = __builtin_amdgcn_sdot4((int)u[c], hq[4 * i + c], a, false);
                        }
                        part[k] = a;
                        {
                            constexpr int kn = k + UD;
                            int idx; if constexpr (kn < 16) idx = swz_bcast<(kn & 15)>(ev); else idx = swz_bcast<(kn & 15)>(evn);
                            const unsigned char* up = UQ + (size_t)idx * 1024 + 16 * l16;
#pragma unroll
                            for (int i = 0; i < 4; ++i) ub[sl][i] = *(const u32x4*)(up + 256 * i);
                        }
                    });
                    static_for<4>([&](auto sc) {
                        constexpr int w = 8 >> decltype(sc)::v;
                        const bool up2 = (lane & w) != 0;
#pragma unroll
                        for (int e = 0; e < w; ++e) {
                            const int keep = up2 ? part[e + w] : part[e], send = up2 ? part[e] : part[e + w];
                            part[e] = keep + swz_xor<w>(send);
                        }
                    });
                    const float dot = (float)part[0] * isu;
                    lc[bt * 16 + l16] = gv * 0.5f * dot * (1.f + erff(dot * 0.70710678118654752f)) * isv;
                }
                asm volatile("s_waitcnt lgkmcnt(0)" ::: "memory");
            }
            __syncthreads();
            f32x2 y[32];
#pragma unroll
            for (int i = 0; i < 32; ++i) y[i] = (f32x2){0.f, 0.f};
            {
                constexpr int VD = 4;
                u32x4 vbuf[VD][4];
                int evn = le[l16];
                static_for<VD>([&](auto kc) { constexpr int k = decltype(kc)::v; const unsigned char* vp = VQ + (size_t)swz_bcast<k>(evn) * 1024 + 16 * l16;
#pragma unroll
                    for (int i = 0; i < 4; ++i) vbuf[k][i] = *(const u32x4*)(vp + 256 * i); });
#pragma unroll 1
                for (int bt = 0; bt < 8; ++bt) {
                    if (bt) __syncthreads();
                    const int ev = evn; const int cv = __float_as_int(lc[bt * 16 + l16]);
                    evn = le[(bt < 7 ? bt + 1 : 7) * 16 + l16];
                    static_for<16>([&](auto kc) {
                        constexpr int k = decltype(kc)::v, sl = k % VD;
                        const float cc = __int_as_float(swz_bcast<k>(cv));
                        const f32x2 c2 = (f32x2){cc, cc};
#pragma unroll
                        for (int i = 0; i < 4; ++i) {
                            const u32x4 v = vbuf[sl][i];
#pragma unroll
                            for (int c = 0; c < 4; ++c) {
                                const int w = (int)v[c];
                                y[8 * i + 2 * c] = __builtin_elementwise_fma(__builtin_amdgcn_cvt_pk_f32_fp8(w, false), c2, y[8 * i + 2 * c]);
                                y[8 * i + 2 * c + 1] = __builtin_elementwise_fma(__builtin_amdgcn_cvt_pk_f32_fp8(w, true), c2, y[8 * i + 2 * c + 1]);
                            }
                        }
                        {
                            constexpr int kn = k + VD;
                            int idx; if constexpr (kn < 16) idx = swz_bcast<(kn & 15)>(ev); else idx = swz_bcast<(kn & 15)>(evn);
                            const unsigned char* vp = VQ + (size_t)idx * 1024 + 16 * l16;
#pragma unroll
                            for (int i = 0; i < 4; ++i) vbuf[sl][i] = *(const u32x4*)(vp + 256 * i);
                        }
                    });
                }
            }
            float ss = 0.f;
#pragma unroll
            for (int i = 0; i < 32; ++i) ss += y[i].x * y[i].x + y[i].y * y[i].y;
            const float rstd = rsqrtf(row16_sum(ss) * (1.f / D) + EPS);
            float* orow = p.out + t * D;
#pragma unroll
            for (int i = 0; i < 4; ++i)
#pragma unroll
                for (int c = 0; c < 4; ++c) {
                    const int col = 256 * i + 16 * l16 + 4 * c;
                    f32x4 xv = *(const f32x4*)(orow + col);
                    const f32x4 gg = *(const LAS f32x4*)(lG + col);
                    xv[0] += gg[0] * y[8 * i + 2 * c].x * rstd; xv[1] += gg[1] * y[8 * i + 2 * c].y * rstd; xv[2] += gg[2] * y[8 * i + 2 * c + 1].x * rstd; xv[3] += gg[3] * y[8 * i + 2 * c + 1].y * rstd;
                    *(f32x4*)(orow + col) = xv;
                }
        }
    }
}


__global__ void __launch_bounds__(NTH) fwd_megakernel(Params p) {
    extern __shared__ __attribute__((aligned(16))) unsigned char lds_raw[];
    LAS unsigned char* lds = (LAS unsigned char*)lds_raw;
    const int tid = threadIdx.x, lane = tid & 63, wave = __builtin_amdgcn_readfirstlane(tid >> 6);
    volatile LAS unsigned* st = (volatile LAS unsigned*)(lds + LDS_BARW);
    if (tid == 0) { st[0] = 0u; st[1] = 0u; st[2] = 0u; st[3] = 0u; }
    __syncthreads();
    XcdBarrier bar = xcd_barrier_post((unsigned*)(p.ws + WS_CTL), st);
    unsigned char* ws = p.ws;

    phase0(p, lds, tid, lane, wave);
    xcd_barrier(bar);
    phase1(p, lds, tid, lane, wave);
    xcd_barrier(bar);
    { pg8::Gemm g{(const bf16_t*)(ws + WS_RA), (const bf16_t*)(ws + WS_WIN), T, ZW, D}; pg8::StaticOrder S; S.init(T, ZW, (int)gridDim.x, (int)blockIdx.x);
      pg8::EpiB16 e{(bf16_t*)(ws + WS_RZ), ZW}; pg8::gemm_phase<pg8::EpiB16, pg8::StaticOrder, true, true>(lds, g, S, e);
      EpiZ e2{(bf16_t*)(ws + WS_RZ), (float*)(ws + WS_AFB)}; gemm_phase(((const bf16_t*)(ws + WS_RA)), (const bf16_t*)(ws + WS_WIN), T, NIN, D, e2, lds, tid, lane, wave, 16); }
    xcd_barrier(bar);
    phaseGA(p, lds, tid, lane, wave);
    xcd_barrier(bar);
    phaseGB(p, tid);
    xcd_barrier(bar);
    phase4a(p, lds, tid, lane, wave);
    xcd_barrier(bar);
    { pg8::Gemm g{(const bf16_t*)(ws + WS_RA), (const bf16_t*)(ws + WS_WOUT), T, D, D}; pg8::StaticOrder S; S.init(T, D, (int)gridDim.x, (int)blockIdx.x);
      pg8::EpiB16 e{(bf16_t*)(ws + WS_RZ), D}; pg8::gemm_phase<pg8::EpiB16, pg8::StaticOrder, true, true>(lds, g, S, e); }
    xcd_barrier(bar);
    phase4c(p, lds, tid, lane, wave);
    xcd_barrier(bar);
    { pg8::Gemm g{(const bf16_t*)(ws + WS_RA), (const bf16_t*)(ws + WS_WQ), T, 2048, D}; pg8::StaticOrder S; S.init(T, 2048, (int)gridDim.x, (int)blockIdx.x);
      pg8::EpiB16 e{(bf16_t*)(ws + WS_RZ), 2048}; pg8::gemm_phase<pg8::EpiB16, pg8::StaticOrder, true, true>(lds, g, S, e); }
    xcd_barrier(bar);
    phase5b(p, lds, tid, lane, wave);
    xcd_barrier(bar);
    phase6(p, lds, tid, lane, wave);
}

extern "C" void kernel_launch(void* const* d_in, const int* in_sizes, int n_in, void* d_out, int out_size, void* d_ws, size_t ws_size, hipStream_t stream) {
    static int grid = 0;
    if (grid == 0) {
        if (n_in != 21 || out_size != T * D || ws_size < WS_END) { fprintf(stderr, "kernel_launch: unexpected shapes (n_in %d out %d ws %zu need %zu)\n", n_in, out_size, ws_size, (size_t)WS_END); grid = -1; return; }
        int dev = 0, cus = 0, per_cu = 0;
        hipGetDevice(&dev); hipDeviceGetAttribute(&cus, hipDeviceAttributeMultiprocessorCount, dev);
        hipFuncSetAttribute((const void*)fwd_megakernel, hipFuncAttributeMaxDynamicSharedMemorySize, LDS_BYTES);
        hipOccupancyMaxActiveBlocksPerMultiprocessor(&per_cu, (const void*)fwd_megakernel, NTH, LDS_BYTES);
        (void)hipGetLastError();
        if (per_cu < 1) fprintf(stderr, "kernel_launch: occupancy query says %d blocks per CU\n", per_cu);
        grid = cus;
    }
    if (grid < 0) return;
    hipMemsetAsync((char*)d_ws + WS_CTL, 0, 64 * 1024, stream);
    Params p{};
    for (int i = 0; i < 21; ++i) p.in[i] = (const float*)d_in[i];
    p.out = (float*)d_out; p.ws = (unsigned char*)d_ws;
    hipLaunchKernelGGL(fwd_megakernel, dim3(grid), dim3(NTH), LDS_BYTES, stream, p);
}
```

```cpp
#include <hip/hip_runtime.h>
#include <cstdio>
#include <cstdint>

#define DI __device__ __forceinline__
#define LAS __attribute__((address_space(3)))
typedef unsigned short bf16_t;
typedef short bf16x8 __attribute__((ext_vector_type(8)));
typedef float f32x4 __attribute__((ext_vector_type(4)));
typedef float f32x2 __attribute__((ext_vector_type(2)));
typedef float f32x16 __attribute__((ext_vector_type(16)));
typedef unsigned u32x4 __attribute__((ext_vector_type(4)));
typedef unsigned u32x2 __attribute__((ext_vector_type(2)));
typedef __bf16 bf16x2v __attribute__((ext_vector_type(2)));

constexpr int T = 32768, D = 1024, SEQ = 4096, NB = 8;
constexpr int NTH = 512, NWV = 8;
constexpr int ZW = 2048;
constexpr int NIN = 2176;
constexpr float EPS = 1e-6f;

constexpr size_t MB = 1024 * 1024;
constexpr size_t WS_CTL   = 0;
constexpr size_t WS_MODP  = 64 * 1024;
constexpr size_t WS_WIN   = WS_MODP + 8 * 8 * 6144 * 4;
constexpr size_t WS_WOUT  = WS_WIN + (size_t)NIN * 1024 * 2;
constexpr size_t WS_WQ    = WS_WOUT + 1024 * 1024 * 2;
constexpr size_t WS_SKB   = WS_WQ + 2048 * 1024 * 2;
constexpr size_t WS_WP    = WS_SKB + 16 * 128 * 128 * 2;
constexpr size_t WS_AFB   = WS_WP + 4 * 128 * 128 * 2;
constexpr size_t WS_UB    = WS_AFB + (size_t)T * 32 * 4;
constexpr size_t WS_VB    = WS_UB + 32 * MB;
constexpr size_t WS_SU    = WS_UB + 16 * MB, WS_SV = WS_VB + 16 * MB;
constexpr size_t WS_RA    = WS_VB + 32 * MB;
constexpr size_t WS_RZ    = WS_RA + 64 * MB;
constexpr size_t WS_RS    = WS_RZ + 128 * MB;
constexpr size_t WS_RO    = WS_RS + 6 * 16 * MB + 1 * MB;
constexpr size_t WS_END   = WS_RO + 128 * MB;
static_assert(WS_END <= 512 * MB, "workspace too large");

struct Params { const float* in[21]; float* out; unsigned char* ws; };

DI unsigned pk2(float a, float b) { f32x2 f = {a, b}; bf16x2v h = __builtin_convertvector(f, bf16x2v); return __builtin_bit_cast(unsigned, h); }
DI float dot2bf(unsigned a, unsigned b, float c) { return __builtin_amdgcn_fdot2_f32_bf16(__builtin_bit_cast(bf16x2v, a), __builtin_bit_cast(bf16x2v, b), c, false); }
DI float bflo(unsigned u) { return __uint_as_float(u << 16); }
DI float bfhi(unsigned u) { return __uint_as_float(u & 0xFFFF0000u); }
DI float wave_sum(float v) {
#pragma unroll
    for (int o = 1; o < 64; o <<= 1) v += __shfl_xor(v, o);
    return v;
}
DI bf16x8 ld_frag16(const bf16_t* p) { return __builtin_bit_cast(bf16x8, *(const u32x4*)p); }
DI bf16x8 ld_frag_perm(const bf16_t* p, int g) {
    const u32x2 lo = *(const u32x2*)(p + 4 * g), hi = *(const u32x2*)(p + 16 + 4 * g);
    u32x4 v = {lo.x, lo.y, hi.x, hi.y}; return __builtin_bit_cast(bf16x8, v);
}
DI int perm32(int k) { return (k & ~31) | (((k >> 2) & 3) << 3) | (((k >> 4) & 1) << 2) | (k & 3); }
DI bf16x8 pack8(const f32x4& a, const f32x4& b) { u32x4 v = {pk2(a[0], a[1]), pk2(a[2], a[3]), pk2(b[0], b[1]), pk2(b[2], b[3])}; return __builtin_bit_cast(bf16x8, v); }
#define MFMA16(a, b, c) __builtin_amdgcn_mfma_f32_16x16x32_bf16((a), (b), (c), 0, 0, 0)
#define MFMA32(a, b, c) __builtin_amdgcn_mfma_f32_32x32x16_bf16((a), (b), (c), 0, 0, 0)

#define XB_TMO      128
#define XB_XCNT(j)  (256  + 64 * (j))
#define XB_XSUB(j)  (1280 + 64 * (j))
#define XB_XGEN(j)  (2304 + 64 * (j))
#define XB_TOP      3328
#define XB_TOPGEN   3392
#define XCD_BAR_WORDS 3456
#define XB_SPIN_CAP (1u << 22)
DI unsigned xb_ld(unsigned* p)              { return __hip_atomic_load(p, __ATOMIC_RELAXED, __HIP_MEMORY_SCOPE_AGENT); }
DI unsigned xb_add(unsigned* p, unsigned v) { return __hip_atomic_fetch_add(p, v, __ATOMIC_RELAXED, __HIP_MEMORY_SCOPE_AGENT); }
DI unsigned xb_xcc_id() { return (unsigned)__builtin_amdgcn_s_getreg((3 << 11) | 20) & 0xFu; }
#define XB_SPIN(cond, bar) do { unsigned _sp = 0; while (cond) { __builtin_amdgcn_s_sleep(1); \
    if ((++_sp & 255u) == 0u) { if (xb_ld(&(bar)[XB_TMO])) break; if (_sp > XB_SPIN_CAP) { atomicAdd(&(bar)[XB_TMO], 1u); break; } } } } while (0)
struct XcdBarrier { unsigned* bar; unsigned x; volatile LAS unsigned* st; };
DI XcdBarrier xcd_barrier_post(unsigned* bar, volatile LAS unsigned* st) {
    XcdBarrier b; b.bar = bar; b.x = xb_xcc_id(); b.st = st;
    if (threadIdx.x == 0) (void)xb_add(&bar[XB_XCNT(b.x)], 1u);
    return b;
}
DI void xcd_barrier_complete(unsigned* bar, unsigned x, unsigned& nloc, unsigned& nx) {
    const unsigned G = gridDim.x * gridDim.y * gridDim.z;
    unsigned sum, cnt, mine, sp = 0u;
    for (;;) {
        sum = 0u; cnt = 0u; mine = 0u;
#pragma unroll
        for (unsigned j = 0; j < 16; ++j) { const unsigned c = xb_ld(&bar[XB_XCNT(j)]); sum += c; cnt += (c > 0u) ? 1u : 0u; mine = (j == x) ? c : mine; }
        if (sum == G) break;
        __builtin_amdgcn_s_sleep(1);
        if ((++sp & 255u) == 0u) { if (xb_ld(&bar[XB_TMO])) break; if (sp > XB_SPIN_CAP) { atomicAdd(&bar[XB_TMO], 1u); break; } }
    }
    nloc = mine > 0u ? mine : 1u; nx = cnt > 0u ? cnt : 1u;
}
DI void xcd_barrier(const XcdBarrier& b) {
    asm volatile("s_waitcnt vmcnt(0)" ::: "memory");
    __syncthreads();
    if (threadIdx.x == 0) {
        unsigned* bar = b.bar;
        __builtin_amdgcn_s_waitcnt(0);
        unsigned nloc = b.st[0], nx = b.st[1];
        if (nloc == 0u) { xcd_barrier_complete(bar, b.x, nloc, nx); b.st[0] = nloc; b.st[1] = nx; }
        const unsigned old = xb_add(&bar[XB_XSUB(b.x)], 1u);
        const unsigned gen = old / nloc;
        if (old + 1u == (gen + 1u) * nloc) {
            __builtin_amdgcn_fence(__ATOMIC_RELEASE, "agent");
            asm volatile("s_waitcnt vmcnt(0)" ::: "memory");
            const unsigned og = xb_add(&bar[XB_TOP], 1u);
            const unsigned tg = og / nx;
            if (og + 1u == (tg + 1u) * nx) xb_add(&bar[XB_TOPGEN], 1u);
            else XB_SPIN(xb_ld(&bar[XB_TOPGEN]) == tg, bar);
            __builtin_amdgcn_fence(__ATOMIC_ACQUIRE, "agent");
            xb_add(&bar[XB_XGEN(b.x)], 1u);
            asm volatile("s_waitcnt vmcnt(0)" ::: "memory");
        } else {
            XB_SPIN(xb_ld(&bar[XB_XGEN(b.x)]) == gen, bar);
            __builtin_amdgcn_fence(__ATOMIC_ACQUIRE, "agent");
            asm volatile("s_waitcnt vmcnt(0)" ::: "memory");
        }
    }
    __syncthreads();
}

constexpr int LDS_BYTES = 152 * 1024;
constexpr int LDS_BARW = LDS_BYTES - 16;

DI void p0_transpose_item(const float* W, int ldw, int K, bf16_t* WT, int dst_row0, int src_col0, float scale, bool zero, LAS float* scr, int kb, int lane) {
    const int k0 = 64 * kb;
#pragma unroll 8
    for (int i = 0; i < 32; ++i) { const int kk = 2 * i + (lane >> 5); scr[kk * 33 + (lane & 31)] = zero ? 0.f : W[(size_t)(k0 + kk) * ldw + src_col0 + (lane & 31)] * scale; }
    asm volatile("s_waitcnt lgkmcnt(0)" ::: "memory");
    const int c = lane & 7;
#pragma unroll
    for (int j = 0; j < 4; ++j) { const int n = (lane >> 3) + 8 * j; const LAS float* s = scr + (8 * c) * 33 + n;
        u32x4 o; o.x = pk2(s[0 * 33], s[1 * 33]); o.y = pk2(s[2 * 33], s[3 * 33]); o.z = pk2(s[4 * 33], s[5 * 33]); o.w = pk2(s[6 * 33], s[7 * 33]);
        *(u32x4*)(WT + (size_t)(dst_row0 + n) * K + k0 + 8 * c) = o; }
    asm volatile("s_waitcnt lgkmcnt(0)" ::: "memory");
}

DI void phase0(const Params& p, LAS unsigned char* lds, int tid, int lane, int wave) {
    asm volatile("" : "+v"(tid), "+v"(lane));
    unsigned char* ws = p.ws;
    LAS float* sl = (LAS float*)lds;
    LAS float* scr = (LAS float*)(lds + 32768 + wave * 8448);
    const float* c = p.in[1];
    for (int e = tid; e < 8192; e += NTH) { const int b = e >> 10, k = e & 1023; const float v = c[e]; sl[k * 8 + b] = v / (1.f + __expf(-v)); }
    __syncthreads();
    const int gw = wave * gridDim.x + blockIdx.x, NGW = gridDim.x * NWV;
    constexpr int I_MOD = 768, I_WIN = 16 * 68, I_WOUT = 16 * 32, I_WQ = 16 * 64, I_WP = 32;
    constexpr int NITEMS = I_MOD + I_WIN + I_WOUT + I_WQ + I_WP;
    for (int it = gw; it < NITEMS; it += NGW) {
        int r = it;
        if (r < I_MOD) {
            const int cg = r % 96, ks = r / 96, n = cg * 64 + lane, k0 = ks * 128;
            const float* W = p.in[2] + (size_t)k0 * 6144 + n;
            float acc[8];
#pragma unroll
            for (int b = 0; b < 8; ++b) acc[b] = 0.f;
#pragma unroll 8
            for (int k = 0; k < 128; ++k) {
                const float w = W[(size_t)k * 6144];
                const f32x4 s0 = *(const LAS f32x4*)(sl + (k0 + k) * 8), s1 = *(const LAS f32x4*)(sl + (k0 + k) * 8 + 4);
                acc[0] += s0[0] * w; acc[1] += s0[1] * w; acc[2] += s0[2] * w; acc[3] += s0[3] * w;
                acc[4] += s1[0] * w; acc[5] += s1[1] * w; acc[6] += s1[2] * w; acc[7] += s1[3] * w;
            }
            float* mp = (float*)(ws + WS_MODP) + (size_t)ks * 8 * 6144 + n;
#pragma unroll
            for (int b = 0; b < 8; ++b) mp[b * 6144] = acc[b];
            continue;
        }
        r -= I_MOD;
        if (r < I_WIN) {
            const int kb = r / 68, nb = r % 68, n0 = nb * 32;
            int src; bool zero = false; float scale = 1.f;
            if (n0 < 1536) { src = n0; if (n0 < 256) scale = 0.125f; } else if (n0 < 2048) src = n0 + 32; else if (n0 < 2080) src = 1536 + (n0 - 2048); else { src = 0; zero = true; }
            p0_transpose_item(p.in[6], 2080, 1024, (bf16_t*)(ws + WS_WIN), n0, src, scale, zero, scr, kb, lane);
            continue;
        }
        r -= I_WIN;
        if (r < I_WOUT) { p0_transpose_item(p.in[14], 1024, 1024, (bf16_t*)(ws + WS_WOUT), (r % 32) * 32, (r % 32) * 32, 1.f, false, scr, r / 32, lane); continue; }
        r -= I_WOUT;
        if (r < I_WQ) { p0_transpose_item(p.in[17], 2048, 1024, (bf16_t*)(ws + WS_WQ), (r % 64) * 32, (r % 64) * 32, 1.f, false, scr, r / 64, lane); continue; }
        r -= I_WQ;
        { const int g = r >> 3, kb = (r >> 2) & 1, nb = r & 3;
          p0_transpose_item(p.in[12] + g * 16384, 128, 128, (bf16_t*)(ws + WS_WP) + g * 16384, nb * 32, nb * 32, 1.f, false, scr, kb, lane); }
    }
    const size_t gt = (size_t)blockIdx.x * NTH + tid, NGT = (size_t)gridDim.x * NTH;
    constexpr size_t NSK = (size_t)16 * 128 * 128 / 8;
    for (size_t j = gt; j < NSK; j += NGT) {
        const float* src = p.in[18]; bf16_t* dst = (bf16_t*)(ws + WS_SKB);
        const f32x4 a = *(const f32x4*)(src + j * 8), b = *(const f32x4*)(src + j * 8 + 4);
        u32x4 o = {pk2(a[0], a[1]), pk2(a[2], a[3]), pk2(b[0], b[1]), pk2(b[2], b[3])};
        *(u32x4*)(dst + j * 8) = o;
    }
}

DI void quant_load(const Params& p, int row, int lane, f32x4 (&v)[4]) {
    const int tb = row >> 14, e = row & 16383;
    const float* src = (tb ? p.in[20] : p.in[19]) + (size_t)e * D + 16 * lane;
#pragma unroll
    for (int q = 0; q < 4; ++q) v[q] = *(const f32x4*)(src + 4 * q);
}
DI void quant_store(const Params& p, int row, int lane, const f32x4 (&v)[4]) {
    unsigned char* ws = p.ws;
    const int tb = row >> 14, e = row & 16383;
    float m = 0.f;
#pragma unroll
    for (int q = 0; q < 4; ++q) m = fmaxf(m, fmaxf(fmaxf(fabsf(v[q][0]), fabsf(v[q][1])), fmaxf(fabsf(v[q][2]), fabsf(v[q][3]))));
#pragma unroll
    for (int o = 1; o < 64; o <<= 1) m = fmaxf(m, __shfl_xor(m, o));
    int ex = (int)((__float_as_uint(m) >> 23) & 0xFFu) - 127;
    if (m < 1e-30f) ex = 7;
    const float sc = __uint_as_float((unsigned)(127 + 7 - ex) << 23), isc = __uint_as_float((unsigned)(127 - 7 + ex) << 23);
    u32x4 o;
    if (tb) {
#pragma unroll
        for (int q = 0; q < 4; ++q) { int w = 0; w = __builtin_amdgcn_cvt_pk_fp8_f32(v[q][0] * sc, v[q][1] * sc, w, false); w = __builtin_amdgcn_cvt_pk_fp8_f32(v[q][2] * sc, v[q][3] * sc, w, true); o[q] = (unsigned)w; }
        if (lane == 0) ((float*)(ws + WS_SV))[e] = isc;
    } else {
        const float s8 = m > 1e-30f ? 127.f / m : 0.f;
#pragma unroll
        for (int q = 0; q < 4; ++q) {
            const int q0 = __float2int_rn(v[q][0] * s8), q1 = __float2int_rn(v[q][1] * s8), q2 = __float2int_rn(v[q][2] * s8), q3 = __float2int_rn(v[q][3] * s8);
            o[q] = (unsigned)(q0 & 0xFF) | ((unsigned)(q1 & 0xFF) << 8) | ((unsigned)(q2 & 0xFF) << 16) | ((unsigned)q3 << 24);
        }
        if (lane == 0) ((float*)(ws + WS_SU))[e] = m * (1.f / 127.f);
    }
    *(u32x4*)(ws + (tb ? WS_VB : WS_UB) + (size_t)e * 1024 + 16 * lane) = o;
}

DI float mod_at(const Params& p, int b, int n) {
    const float* mp = (const float*)(p.ws + WS_MODP) + (size_t)b * 6144 + n;
    float s = p.in[3][n];
#pragma unroll
    for (int ks = 0; ks < 8; ++ks) s += mp[(size_t)ks * 8 * 6144];
    return s;
}

DI void phase1(const Params& p, LAS unsigned char* lds, int tid, int lane, int wave) {
    asm volatile("" : "+v"(tid), "+v"(lane));
    LAS float* lA = (LAS float*)lds; LAS float* lB = lA + 1024;
    const float* x = p.in[0]; bf16_t* H = (bf16_t*)(p.ws + WS_RA);
    for (int rt = blockIdx.x; rt < T / 128; rt += gridDim.x) {
        const int b = rt / 32;
        __syncthreads();
        for (int d = tid; d < 1024; d += NTH) { lA[d] = p.in[4][d] * (1.f + mod_at(p, b, 1024 + d)); lB[d] = mod_at(p, b, d); }
        __syncthreads();
        for (int r0 = wave; r0 < 128; r0 += 4 * NWV) {
            f32x4 v[4][4];
#pragma unroll
            for (int u = 0; u < 4; ++u) { const f32x4* xr = (const f32x4*)(x + ((size_t)rt * 128 + r0 + u * NWV) * D) + lane;
#pragma unroll
                for (int j = 0; j < 4; ++j) v[u][j] = xr[64 * j]; }
#pragma unroll
            for (int u = 0; u < 4; ++u) {
                const size_t row = (size_t)rt * 128 + r0 + u * NWV;
                float ss = 0.f;
#pragma unroll
                for (int j = 0; j < 4; ++j) ss += v[u][j][0] * v[u][j][0] + v[u][j][1] * v[u][j][1] + v[u][j][2] * v[u][j][2] + v[u][j][3] * v[u][j][3];
                const float rstd = rsqrtf(wave_sum(ss) * (1.f / D) + EPS);
                u32x2* o = (u32x2*)(H + row * D) + lane;
#pragma unroll
                for (int j = 0; j < 4; ++j) {
                    const f32x4 a = *(const LAS f32x4*)(lA + 4 * lane + 256 * j), bb = *(const LAS f32x4*)(lB + 4 * lane + 256 * j);
                    u32x2 w = {pk2(v[u][j][0] * rstd * a[0] + bb[0], v[u][j][1] * rstd * a[1] + bb[1]), pk2(v[u][j][2] * rstd * a[2] + bb[2], v[u][j][3] * rstd * a[3] + bb[3])};
                    o[64 * j] = w;
                }
            }
        }
    }
}

struct EpiZ {
    bf16_t* Z; float* AFB;
    DI void operator()(int m, int n, const f32x4& v) const {
        if (n < ZW) { u32x2 w = {pk2(v[0], v[1]), pk2(v[2], v[3])}; *(u32x2*)(Z + (size_t)m * ZW + n) = w; }
        else if (n < ZW + 32) { *(f32x4*)(AFB + (size_t)m * 32 + (n - ZW)) = v; }
    }
};
struct EpiF32 { float* C; int ldc; DI void operator()(int m, int n, const f32x4& v) const { *(f32x4*)(C + (size_t)m * ldc + n) = v; } };
struct EpiBf16 { bf16_t* C; int ldc; DI void operator()(int m, int n, const f32x4& v) const { u32x2 w = {pk2(v[0], v[1]), pk2(v[2], v[3])}; *(u32x2*)(C + (size_t)m * ldc + n) = w; } };

template <class Epi>
DI void gemm_phase(const bf16_t* A, const bf16_t* Bt, int M, int N, int K, const Epi& epi, LAS unsigned char* lds, int tid, int lane, int wave, int nt_first = 0) {
    constexpr int BM = 256, BN = 128, BK = 64, STAGE = (BM + BN) * 128;
    const int ntn = N / BN - nt_first, ntiles = (M / BM) * ntn, nk = K / BK;
    const int wm = wave & 3, wn = wave >> 2, c15 = lane & 15, g = lane >> 4;
    const int lrow = tid >> 3, lch = tid & 7;
    for (int tile = blockIdx.x; tile < ntiles; tile += gridDim.x) {
        const int m0 = (tile / ntn) * BM, n0 = (tile % ntn + nt_first) * BN;
        f32x4 acc[4][4];
#pragma unroll
        for (int i = 0; i < 4; ++i)
#pragma unroll
            for (int j = 0; j < 4; ++j) acc[i][j] = (f32x4){0.f, 0.f, 0.f, 0.f};
        u32x4 ra[4], rb[2];
        const bf16_t* Ag = A + (size_t)(m0 + lrow) * K + lch * 8;
        const bf16_t* Bg = Bt + (size_t)(n0 + lrow) * K + lch * 8;
        const int woff = lrow * 128 + ((lch ^ (lrow & 7)) * 16);
        __syncthreads();
#pragma unroll
        for (int ps = 0; ps < 4; ++ps) ra[ps] = *(const u32x4*)(Ag + (size_t)(64 * ps) * K);
#pragma unroll
        for (int ps = 0; ps < 2; ++ps) rb[ps] = *(const u32x4*)(Bg + (size_t)(64 * ps) * K);
#pragma unroll
        for (int ps = 0; ps < 4; ++ps) *(LAS u32x4*)(lds + woff + ps * 8192) = ra[ps];
#pragma unroll
        for (int ps = 0; ps < 2; ++ps) *(LAS u32x4*)(lds + BM * 128 + woff + ps * 8192) = rb[ps];
        __syncthreads();
        for (int kt = 0; kt < nk; ++kt) {
            const bool more = (kt + 1 < nk);
            if (more) {
#pragma unroll
                for (int ps = 0; ps < 4; ++ps) ra[ps] = *(const u32x4*)(Ag + (size_t)(64 * ps) * K + (kt + 1) * BK);
#pragma unroll
                for (int ps = 0; ps < 2; ++ps) rb[ps] = *(const u32x4*)(Bg + (size_t)(64 * ps) * K + (kt + 1) * BK);
            }
            LAS unsigned char* sa = lds + (kt & 1) * STAGE; LAS unsigned char* sb = sa + BM * 128;
#pragma unroll
            for (int s = 0; s < 2; ++s) {
                bf16x8 fa[4], fb[4];
#pragma unroll
                for (int i = 0; i < 4; ++i) { const int row = wm * 64 + i * 16 + c15; fa[i] = *(const LAS bf16x8*)(sa + row * 128 + (((4 * s + g) ^ (row & 7)) * 16)); }
#pragma unroll
                for (int j = 0; j < 4; ++j) { const int row = wn * 64 + j * 16 + c15; fb[j] = *(const LAS bf16x8*)(sb + row * 128 + (((4 * s + g) ^ (row & 7)) * 16)); }
#pragma unroll
                for (int i = 0; i < 4; ++i)
#pragma unroll
                    for (int j = 0; j < 4; ++j) acc[i][j] = MFMA16(fb[j], fa[i], acc[i][j]);
            }
            if (more) {
                LAS unsigned char* da = lds + ((kt + 1) & 1) * STAGE;
#pragma unroll
                for (int ps = 0; ps < 4; ++ps) *(LAS u32x4*)(da + woff + ps * 8192) = ra[ps];
#pragma unroll
                for (int ps = 0; ps < 2; ++ps) *(LAS u32x4*)(da + BM * 128 + woff + ps * 8192) = rb[ps];
            }
            __syncthreads();
        }
#pragma unroll
        for (int i = 0; i < 4; ++i)
#pragma unroll
            for (int j = 0; j < 4; ++j) epi(m0 + wm * 64 + i * 16 + c15, n0 + wn * 64 + j * 16 + 4 * g, acc[i][j]);
    }
}

namespace pg8 {
#define PG8_LAS __attribute__((address_space(3)))
constexpr int BM = 256, BK = 64, HALF = 128, HTB = HALF * BK * 2  , STAGE_BYTES = 8 * HTB, NXCD = 8, WGM = 8;

__host__ __device__ __forceinline__ int lds_byte(int r, int c) { const int st = (r >> 4) * 2 + (c >> 5), rr = r & 15, cc = c & 31, ob = rr * 64 + cc * 2; return st * 1024 + (ob ^ (((ob >> 9) & 1) << 5)); }
__host__ __device__ __forceinline__ void stage_rc(int b, int& R, int& C) { const int st = b / 1024, sb = b % 1024, swz = sb ^ (((sb >> 9) & 1) << 5); R = (st >> 1) * 16 + swz / 64; C = (st & 1) * 32 + (swz % 64) / 2; }
__host__ __device__ __forceinline__ int perm32(int rho) { const int n = rho >> 4, i = rho & 15; return 8 * (i >> 2) + 4 * n + (i & 3); }

struct Unit { int pm, pn; };
struct Gemm { const bf16_t* A; const bf16_t* Bt; int M, N, K; };

struct StaticOrder {
    int nM, nN, nwg, G, c;
    __host__ __device__ void init(int M, int N, int G_, int c_) { nM = M / BM; nN = N / BM; nwg = nM * nN; G = G_; c = c_; }
    __host__ __device__ bool next(int i, Unit& u) const {
        const long L = (long)i * G + c; if (L >= nwg) return false;
        int wgid = (int)L; { const int q = nwg / NXCD, r = nwg % NXCD, xcd = wgid % NXCD, off = wgid / NXCD; wgid = (xcd < r ? xcd * (q + 1) : r * (q + 1) + (xcd - r) * q) + off; }
        const int nig = WGM * nN, gid = wgid / nig, fm = gid * WGM, gsz = (nM - fm) < WGM ? (nM - fm) : WGM;
        u.pm = fm + ((wgid % nig) % gsz); u.pn = (wgid % nig) / gsz; return true;
    }
    __device__ __forceinline__ void a_ready(const Unit&) const {}
    __device__ __forceinline__ void done(const Unit&) const {}
};

struct EpiB16 {
    static constexpr bool PERM = true, AFTER_DRAIN = false;
    bf16_t* O; int ldc;
    __device__ __forceinline__ void operator()(const f32x4 (&acc)[2][2][4][2], const Unit& u, int wr, int wc, int fr, int fq) const {
#pragma unroll
        for (int ai = 0; ai < 2; ++ai)
#pragma unroll
            for (int m = 0; m < 4; ++m) { bf16_t* rowp = O + (size_t)(u.pm * BM + ai * HALF + wr * 64 + m * 16 + fr) * ldc + u.pn * BM + wc * 32 + 8 * fq;
#pragma unroll
                for (int bj = 0; bj < 2; ++bj) { const f32x4 v0 = acc[ai][bj][m][0], v1 = acc[ai][bj][m][1];
                    u32x4 w; w.x = ::pk2(v0[0], v0[1]); w.y = ::pk2(v0[2], v0[3]); w.z = ::pk2(v1[0], v1[1]); w.w = ::pk2(v1[2], v1[3]);
                    *(u32x4*)(rowp + bj * HALF) = w; } }
    }
};
struct EpiF {
    static constexpr bool PERM = false, AFTER_DRAIN = false;
    float* O; int ldc;
    __device__ __forceinline__ void operator()(const f32x4 (&acc)[2][2][4][2], const Unit& u, int wr, int wc, int fr, int fq) const {
#pragma unroll
        for (int ai = 0; ai < 2; ++ai)
#pragma unroll
            for (int m = 0; m < 4; ++m) { float* rowp = O + (size_t)(u.pm * BM + ai * HALF + wr * 64 + m * 16 + fr) * ldc + u.pn * BM + wc * 32 + 4 * fq;
#pragma unroll
                for (int bj = 0; bj < 2; ++bj)
#pragma unroll
                    for (int n = 0; n < 2; ++n) *(f32x4*)(rowp + bj * HALF + 16 * n) = acc[ai][bj][m][n]; }
    }
};
template <class Epi, class Sched, bool ALIGN_EPI = false, bool SP2 = false>
__device__ __forceinline__ void gemm_phase(PG8_LAS unsigned char* lds, const Gemm g, const Sched& S, const Epi& E) {
    const int tid = threadIdx.x, wid = __builtin_amdgcn_readfirstlane(tid >> 6), lane = tid & 63, wr = wid >> 2, wc = wid & 3, fr = lane & 15, fq = lane >> 4;
    const int K = g.K, nt = K / BK;
    unsigned voffA[2], voffB[2];
#pragma unroll
    for (int i = 0; i < 2; ++i) { int R, C; stage_rc(tid * 16 + i * 8192, R, C); const int Rb = Epi::PERM ? ((R & ~31) + perm32(R & 31)) : R;
        voffA[i] = (unsigned)(R * K + C) * 2u; voffB[i] = (unsigned)(Rb * K + C) * 2u; }
    const size_t kstep = (size_t)(BK * 2);
    const size_t hstep = (size_t)HALF * K * 2;
    const size_t tstep = 2 * hstep;
    const unsigned ldsw = (unsigned)wid * 1024u;
    const int aoff = lds_byte(wr * 64 + fr, fq * 8), boff = lds_byte(wc * 32 + fr, fq * 8);
#define PG8_SA(b, h) (((b) * 2 + (h)) * HTB)
#define PG8_SB(b, h) ((4 + (b) * 2 + (h)) * HTB)
#define PG8_STAGE(bufoff, gbase, voff) do { _Pragma("unroll") for (int _i = 0; _i < 2; ++_i) \
        __builtin_amdgcn_global_load_lds((const unsigned*)((const char*)(gbase) + (voff)[_i]), (PG8_LAS unsigned*)(lds + (bufoff) + ldsw + _i * 8192), 16, 0, 0); } while (0)
#define PG8_LDA(dst, b, h) do { _Pragma("unroll") for (int m = 0; m < 4; ++m) _Pragma("unroll") for (int k = 0; k < 2; ++k) dst[m][k] = *(const PG8_LAS bf16x8*)(lds + PG8_SA(b, h) + aoff + m * 2048 + k * 1024); } while (0)
#define PG8_LDB(dst, b, h) do { _Pragma("unroll") for (int n = 0; n < 2; ++n) _Pragma("unroll") for (int k = 0; k < 2; ++k) dst[n][k] = *(const PG8_LAS bf16x8*)(lds + PG8_SB(b, h) + boff + n * 2048 + k * 1024); } while (0)
#define PG8_MMA(ai, bj, At, Bt) do { __builtin_amdgcn_s_setprio(1); _Pragma("unroll") for (int m = 0; m < 4; ++m) _Pragma("unroll") for (int n = 0; n < 2; ++n) _Pragma("unroll") for (int k = 0; k < 2; ++k) \
        acc[ai][bj][m][n] = __builtin_amdgcn_mfma_f32_16x16x32_bf16(Bt[n][k], At[m][k], acc[ai][bj][m][n], 0, 0, 0); __builtin_amdgcn_s_setprio(0); } while (0)
#define PG8_WAIT_V(n) asm volatile("s_waitcnt vmcnt(" #n ")" ::: "memory")
#define PG8_WAIT_L(n) asm volatile("s_waitcnt lgkmcnt(" #n ")" ::: "memory")
#define PG8_BAR __builtin_amdgcn_s_barrier()
#define PG8_SCHED __builtin_amdgcn_sched_barrier(0)
    Unit cur, nxt; int ui = 0;
    if (!S.next(0, cur)) return;
    f32x4 acc[2][2][4][2];
#pragma unroll
    for (int a = 0; a < 2; ++a)
#pragma unroll
        for (int b = 0; b < 2; ++b)
#pragma unroll
            for (int m = 0; m < 4; ++m)
#pragma unroll
                for (int n = 0; n < 2; ++n) acc[a][b][m][n] = (f32x4){0.f, 0.f, 0.f, 0.f};
    bf16x8 At[4][2], B0[2][2], B1[2][2];
    const char* cA = (const char*)g.A + (size_t)cur.pm * tstep; const char* cB = (const char*)g.Bt + (size_t)cur.pn * tstep;
    S.a_ready(cur);
    if constexpr (SP2) {
        PG8_STAGE(PG8_SB(0, 0), cB, voffB); PG8_STAGE(PG8_SB(0, 1), cB + hstep, voffB); PG8_STAGE(PG8_SA(0, 0), cA, voffA); PG8_STAGE(PG8_SA(0, 1), cA + hstep, voffA);
        if (wr == 1) PG8_BAR;
        PG8_WAIT_V(2); PG8_BAR;
        PG8_STAGE(PG8_SB(1, 0), cB + kstep, voffB); PG8_STAGE(PG8_SA(1, 0), cA + kstep, voffA); PG8_STAGE(PG8_SB(1, 1), cB + hstep + kstep, voffB);
        PG8_WAIT_V(6); PG8_BAR;
    } else {
        PG8_STAGE(PG8_SB(0, 0), cB, voffB); PG8_STAGE(PG8_SA(0, 0), cA, voffA); PG8_STAGE(PG8_SB(0, 1), cB + hstep, voffB); PG8_STAGE(PG8_SA(0, 1), cA + hstep, voffA);
        if (wr == 1) PG8_BAR;
        PG8_WAIT_V(4); PG8_BAR;
        PG8_STAGE(PG8_SB(1, 0), cB + kstep, voffB); PG8_STAGE(PG8_SA(1, 0), cA + kstep, voffA); PG8_STAGE(PG8_SB(1, 1), cB + hstep + kstep, voffB);
        PG8_WAIT_V(6); PG8_BAR;
    }
    for (;;) {
        const bool has_next = S.next(ui + 1, nxt);
        const char* nA = has_next ? (const char*)g.A + (size_t)nxt.pm * tstep : cA; const char* nB = has_next ? (const char*)g.Bt + (size_t)nxt.pn * tstep : cB;
        for (int t = 0; t < nt; t += 2) {
            const bool last = (t == nt - 2);
            const char* a1 = cA + (size_t)(t + 1) * kstep;
            const char* a2 = last ? nA : cA + (size_t)(t + 2) * kstep; const char* b2 = last ? nB : cB + (size_t)(t + 2) * kstep;
            const char* a3 = a2 + kstep; const char* b3 = b2 + kstep;
            if (last && has_next) S.a_ready(nxt);
            if constexpr (SP2) {
            PG8_LDB(B0, 0, 0); PG8_LDB(B1, 0, 1); PG8_SCHED; PG8_LDA(At, 0, 0); PG8_STAGE(PG8_SA(1, 1), a1 + hstep, voffA);
            PG8_WAIT_V(8); PG8_WAIT_L(0); PG8_BAR; PG8_MMA(0, 0, At, B0); PG8_MMA(0, 1, At, B1); PG8_BAR; PG8_SCHED;
            PG8_LDA(At, 0, 1); PG8_STAGE(PG8_SB(0, 0), b2, voffB); PG8_STAGE(PG8_SB(0, 1), b2 + hstep, voffB); PG8_STAGE(PG8_SA(0, 0), a2, voffA);
            PG8_WAIT_V(8); PG8_WAIT_L(0); PG8_BAR; PG8_MMA(1, 0, At, B0); PG8_MMA(1, 1, At, B1); PG8_BAR; PG8_SCHED;
            PG8_LDB(B0, 1, 0); PG8_LDB(B1, 1, 1); PG8_SCHED; PG8_LDA(At, 1, 0); PG8_STAGE(PG8_SA(0, 1), a2 + hstep, voffA);
            PG8_WAIT_V(8); PG8_WAIT_L(0); PG8_BAR; PG8_MMA(0, 0, At, B0); PG8_MMA(0, 1, At, B1); PG8_BAR; PG8_SCHED;
            PG8_LDA(At, 1, 1); PG8_STAGE(PG8_SB(1, 0), b3, voffB); PG8_STAGE(PG8_SB(1, 1), b3 + hstep, voffB); PG8_STAGE(PG8_SA(1, 0), a3, voffA);
            PG8_WAIT_V(8); PG8_WAIT_L(0); PG8_BAR; PG8_MMA(1, 0, At, B0); PG8_MMA(1, 1, At, B1); PG8_BAR; PG8_SCHED;
            } else {
            PG8_LDB(B0, 0, 0); PG8_SCHED; PG8_LDA(At, 0, 0); PG8_STAGE(PG8_SA(1, 1), a1 + hstep, voffA);
            PG8_WAIT_L(8); PG8_BAR; PG8_WAIT_L(0); PG8_MMA(0, 0, At, B0); PG8_BAR; PG8_SCHED;
            PG8_LDB(B1, 0, 1); PG8_STAGE(PG8_SB(0, 0), b2, voffB);
            PG8_BAR; PG8_WAIT_L(0); PG8_MMA(0, 1, At, B1); PG8_BAR;
            PG8_LDA(At, 0, 1); PG8_STAGE(PG8_SA(0, 0), a2, voffA);
            PG8_BAR; PG8_WAIT_L(0); PG8_MMA(1, 0, At, B0); PG8_BAR; PG8_SCHED;
            PG8_STAGE(PG8_SB(0, 1), b2 + hstep, voffB);
            PG8_WAIT_V(6); PG8_BAR; PG8_MMA(1, 1, At, B1); PG8_BAR;
            PG8_LDB(B0, 1, 0); PG8_SCHED; PG8_LDA(At, 1, 0); PG8_STAGE(PG8_SA(0, 1), a2 + hstep, voffA);
            PG8_WAIT_L(8); PG8_BAR; PG8_WAIT_L(0); PG8_MMA(0, 0, At, B0); PG8_BAR; PG8_SCHED;
            PG8_LDB(B1, 1, 1); PG8_STAGE(PG8_SB(1, 0), b3, voffB);
            PG8_BAR; PG8_WAIT_L(0); PG8_MMA(0, 1, At, B1); PG8_BAR;
            PG8_LDA(At, 1, 1); PG8_STAGE(PG8_SA(1, 0), a3, voffA);
            PG8_BAR; PG8_WAIT_L(0); PG8_MMA(1, 0, At, B0); PG8_BAR; PG8_SCHED;
            PG8_STAGE(PG8_SB(1, 1), b3 + hstep, voffB);
            PG8_WAIT_V(6); PG8_BAR; PG8_MMA(1, 1, At, B1); PG8_BAR;
            }
        }
        if constexpr (ALIGN_EPI) { if (wr == 0) PG8_BAR; }
        if constexpr (!Epi::AFTER_DRAIN) { E(acc, cur, wr, wc, fr, fq); S.done(cur); }
        if (!has_next) break;
#pragma unroll
        for (int a = 0; a < 2; ++a)
#pragma unroll
            for (int b = 0; b < 2; ++b)
#pragma unroll
                for (int m = 0; m < 4; ++m)
#pragma unroll
                    for (int n = 0; n < 2; ++n) acc[a][b][m][n] = (f32x4){0.f, 0.f, 0.f, 0.f};
        cur = nxt; cA = nA; cB = nB; ++ui;
        if constexpr (ALIGN_EPI) { if (wr == 1) PG8_BAR; }
    }
    PG8_WAIT_V(0);
    if constexpr (!ALIGN_EPI) { if (wr == 0) PG8_BAR; }
    PG8_BAR;
    if constexpr (Epi::AFTER_DRAIN) { E.fused(acc, cur, wr, wc, fr, fq, lds, wid, lane); S.done(cur); }
#undef PG8_SA
#undef PG8_SB
#undef PG8_STAGE
#undef PG8_LDA
#undef PG8_LDB
#undef PG8_MMA
#undef PG8_WAIT_V
#undef PG8_WAIT_L
#undef PG8_BAR
#undef PG8_SCHED
}
}

constexpr size_t WS_QDC  = WS_RS;
constexpr size_t WS_SEGS = WS_RS + 32 * MB;
constexpr size_t WS_GSEG = WS_RS + 48 * MB;
constexpr size_t WS_SC   = WS_RS + 49 * MB;
DI void lds_barrier() { asm volatile("s_waitcnt lgkmcnt(0)" ::: "memory"); __builtin_amdgcn_s_barrier(); asm volatile("" ::: "memory"); }
DI float logsig(float x) { return fminf(x, 0.f) - __logf(1.f + __expf(-fabsf(x))); }

template <int DIR>
DI void ga_task(const Params& p, LAS unsigned char* lds, int tid, int lane, int wave, int task) {
    asm volatile("" : "+v"(tid), "+v"(lane));
    unsigned char* ws = p.ws;
    const bf16_t* Z = (const bf16_t*)(ws + WS_RZ);
    const float* AFB = (const float*)(ws + WS_AFB);
    LAS float* la = (LAS float*)lds;
    LAS float* part = (LAS float*)(lds + 16384);
    LAS float* gs = (LAS float*)(lds + 17408);
    LAS float* elb = (LAS float*)(lds + 17920);
    LAS float* wl = (LAS float*)(lds + 18944);
    LAS bf16_t* sL  = (LAS bf16_t*)(lds + 23040);
    LAS unsigned char* obuf = lds + 41472;
    const int c15 = lane & 15, g = lane >> 4;
    const int i = tid >> 3, dg = tid & 7, d0 = dg * 8;
    constexpr int dir = DIR; const int h = (task >> 1) & 3, pb = (task >> 3) & 7, b = task >> 6;
    const int bhd = b * 8 + h * 2 + dir, sg = dir ? 7 - pb : pb;
    bf16_t* QDC = (bf16_t*)(ws + WS_QDC + (dir ? 16 : 0) * MB);
    bf16_t* OL = (bf16_t*)(ws + WS_RO + (dir ? 64 : 0) * MB);
    f32x4 S[4];
#pragma unroll
    for (int kt = 0; kt < 4; ++kt) S[kt] = (f32x4){0.f, 0.f, 0.f, 0.f};
    __syncthreads();
    for (int e = tid; e < 128 * 72 / 2; e += NTH) ((LAS unsigned*)sL)[e] = 0u;
    if (tid < 64) gs[tid] = 0.f;
    for (int e = tid; e < 1024; e += NTH) wl[e] = (dir ? p.in[9] : p.in[7])[(e >> 6) * 256 + h * 64 + (e & 63)];
    typedef short s16x4w __attribute__((ext_vector_type(4)));
    s16x4w wfr[2]; float bias[2];
    __syncthreads();
#pragma unroll
    for (int u = 0; u < 2; ++u) {
        const int d = 16 * (2 * (wave >> 2) + u) + c15;
        const u32x2 wp = {pk2(wl[(4 * g) * 64 + d], wl[(4 * g + 1) * 64 + d]), pk2(wl[(4 * g + 2) * 64 + d], wl[(4 * g + 3) * 64 + d])};
        wfr[u] = __builtin_bit_cast(s16x4w, wp);
        bias[u] = (dir ? p.in[10] : p.in[8])[h * 64 + d];
    }
    const int mt = wave & 3;
    f32x4 avn;
    { const int n0 = dir ? pb * 8 + 7 : pb * 8; avn = *(const f32x4*)(AFB + ((size_t)b * SEQ + n0 * 64 + 16 * mt + c15) * 32 + dir * 16 + 4 * g); }
#pragma unroll 1
    for (int ci = -1; ci < 8; ++ci) {
        const bool has_cur = ci >= 0, has_nxt = ci < 7;
        const int cx = ci + 1;
        const int nx = dir ? pb * 8 + 7 - cx : pb * 8 + cx, tokx = b * SEQ + nx * 64;
        const int nc = dir ? pb * 8 + 7 - ci : pb * 8 + ci, tokc = b * SEQ + nc * 64;
        LAS unsigned char* bx = obuf + (cx & 1) * 46080; LAS unsigned char* bc = obuf + (ci & 1) * 46080;
        LAS float* elx = elb + (cx & 1) * 128; LAS float* elc = elb + (ci & 1) * 128;
        u32x4 qv, kv, vvp[2]; f32x4 qa[4]; float lv[2][4];
        const int qrow = (task * 8 + (has_cur ? ci : 0)) * NWV + wave;
        if (ci > 0) {
#pragma unroll
            for (int kt = 0; kt < 4; ++kt) { const u32x2 w = {pk2(S[kt][0], S[kt][1]), pk2(S[kt][2], S[kt][3])}; *(LAS u32x2*)(sL + (16 * wave + c15) * 72 + 16 * kt + 4 * g) = w; }
        }
        if (has_cur) quant_load(p, qrow, lane, qa);
        if (has_nxt) {
            const size_t t = (size_t)tokx + i;
            qv = *(const u32x4*)(Z + t * ZW + h * 64 + d0); kv = *(const u32x4*)(Z + t * ZW + 256 + h * 64 + d0);
#pragma unroll
            for (int ps = 0; ps < 2; ++ps) { const int idx = tid + NTH * ps, vi = idx >> 4, ch = idx & 15; vvp[ps] = *(const u32x4*)(Z + ((size_t)tokx + vi) * ZW + 512 + h * 128 + ch * 8); }
            typedef short s16x4v __attribute__((ext_vector_type(4)));
            const u32x2 ap = {pk2(avn[0], avn[1]), pk2(avn[2], avn[3])};
            const s16x4v af = __builtin_bit_cast(s16x4v, ap);
            { const int c2 = cx < 7 ? cx + 1 : cx, n2 = dir ? pb * 8 + 7 - c2 : pb * 8 + c2; avn = *(const f32x4*)(AFB + ((size_t)b * SEQ + n2 * 64 + 16 * mt + c15) * 32 + dir * 16 + 4 * g); }
#pragma unroll
            for (int u = 0; u < 2; ++u) {
                const int d = 16 * (2 * (wave >> 2) + u) + c15;
                const f32x4 x = __builtin_amdgcn_mfma_f32_16x16x16bf16_1k(af, wfr[u], (f32x4){0.f, 0.f, 0.f, 0.f}, 0, 0, 0);
                float v0 = logsig(x[0] + bias[u]) * 0.0625f, v1 = logsig(x[1] + bias[u]) * 0.0625f, v2 = logsig(x[2] + bias[u]) * 0.0625f, v3 = logsig(x[3] + bias[u]) * 0.0625f;
                float T, T2, T3;
                if (dir == 0) {
                    v1 += v0; v2 += v1; v3 += v2; T = v3;
                    const float t1 = __shfl_up(T, 16); T2 = T + (g >= 1 ? t1 : 0.f);
                    const float t2 = __shfl_up(T2, 32); T3 = T2 + (g >= 2 ? t2 : 0.f);
                    if (g == 3) part[mt * 64 + d] = T3;
                } else {
                    v2 += v3; v1 += v2; v0 += v1; T = v0;
                    const float t1 = __shfl_down(T, 16); T2 = T + (g <= 2 ? t1 : 0.f);
                    const float t2 = __shfl_down(T2, 32); T3 = T2 + (g <= 1 ? t2 : 0.f);
                    if (g == 0) part[mt * 64 + d] = T3;
                }
                const float off = T3 - T;
                lv[u][0] = v0 + off; lv[u][1] = v1 + off; lv[u][2] = v2 + off; lv[u][3] = v3 + off;
            }
        }
        lds_barrier();
        if (has_nxt) {
#pragma unroll
            for (int u = 0; u < 2; ++u) {
                const int d = 16 * (2 * (wave >> 2) + u) + c15;
                float off = 0.f;
#pragma unroll
                for (int m2 = 0; m2 < 4; ++m2) { const bool take = dir ? (m2 > mt) : (m2 < mt); off += take ? part[m2 * 64 + d] : 0.f; }
#pragma unroll
                for (int r = 0; r < 4; ++r) la[(16 * mt + 4 * g + r) * 64 + d] = lv[u][r] + off;
                if (mt == (dir ? 0 : 3) && g == (dir ? 0 : 3)) {
                    const float tot = lv[u][dir ? 0 : 3] + off, gsum = gs[(cx & 1) * 64 + d];
                    elx[d] = __expf(tot); elx[64 + d] = __expf(gsum); gs[((cx + 1) & 1) * 64 + d] = gsum + tot;
                }
            }
        }
        lds_barrier();
        if (has_nxt) {
            LAS bf16_t* qdL = (LAS bf16_t*)bx; LAS bf16_t* kiL = (LAS bf16_t*)(bx + 9216); LAS bf16_t* keT = (LAS bf16_t*)(bx + 18432); LAS bf16_t* vT = (LAS bf16_t*)(bx + 27648);
            const size_t t = (size_t)tokx + i;
            float q[8], k[8];
#pragma unroll
            for (int e = 0; e < 4; ++e) { q[2 * e] = bflo(qv[e]); q[2 * e + 1] = bfhi(qv[e]); k[2 * e] = bflo(kv[e]); k[2 * e + 1] = bfhi(kv[e]); }
            float qd[8], ki[8], ke[8], qc[8];
#pragma unroll
            for (int e = 0; e < 8; ++e) {
                const float E = __expf(la[i * 64 + d0 + e]), R = __builtin_amdgcn_rcpf(E);
                qd[e] = q[e] * E; ki[e] = k[e] * R; ke[e] = ki[e] * elx[d0 + e]; qc[e] = qd[e] * elx[64 + d0 + e];
            }
            const u32x4 o1 = {pk2(qd[0], qd[1]), pk2(qd[2], qd[3]), pk2(qd[4], qd[5]), pk2(qd[6], qd[7])};
            const u32x4 o2 = {pk2(ki[0], ki[1]), pk2(ki[2], ki[3]), pk2(ki[4], ki[5]), pk2(ki[6], ki[7])};
            const u32x4 o3 = {pk2(qc[0], qc[1]), pk2(qc[2], qc[3]), pk2(qc[4], qc[5]), pk2(qc[6], qc[7])};
            *(LAS u32x4*)(qdL + i * 72 + d0) = o1; *(LAS u32x4*)(kiL + i * 72 + d0) = o2;
            *(u32x4*)(QDC + t * 256 + h * 64 + d0) = o3;
#pragma unroll
            for (int e = 0; e < 4; ++e) { const unsigned w = pk2(ke[2 * e], ke[2 * e + 1]); keT[(d0 + 2 * e) * 72 + perm32(i)] = (bf16_t)(w & 0xFFFFu); keT[(d0 + 2 * e + 1) * 72 + perm32(i)] = (bf16_t)(w >> 16); }
#pragma unroll
            for (int ps = 0; ps < 2; ++ps) {
                const int idx = tid + NTH * ps, vi = idx >> 4, ch = idx & 15;
#pragma unroll
                for (int e = 0; e < 4; ++e) { vT[(ch * 8 + 2 * e) * 72 + perm32(vi)] = (bf16_t)(vvp[ps][e] & 0xFFFFu); vT[(ch * 8 + 2 * e + 1) * 72 + perm32(vi)] = (bf16_t)(vvp[ps][e] >> 16); }
            }
        }
        if (has_cur) {
            const LAS bf16_t* qdL = (const LAS bf16_t*)bc; const LAS bf16_t* kiL = (const LAS bf16_t*)(bc + 9216); const LAS bf16_t* keT = (const LAS bf16_t*)(bc + 18432); const LAS bf16_t* vT = (const LAS bf16_t*)(bc + 27648);
            const int it = wave & 3, dvh = wave >> 2;
            bf16x8 qdb[2];
#pragma unroll
            for (int s = 0; s < 2; ++s) qdb[s] = *(const LAS bf16x8*)(qdL + (16 * it + c15) * 72 + 32 * s + 8 * g);
            f32x4 sc[4];
#pragma unroll
            for (int jt = 0; jt < 4; ++jt) {
                sc[jt] = (f32x4){0.f, 0.f, 0.f, 0.f};
#pragma unroll
                for (int s = 0; s < 2; ++s) sc[jt] = MFMA16(*(const LAS bf16x8*)(kiL + (16 * jt + c15) * 72 + 32 * s + 8 * g), qdb[s], sc[jt]);
                const int ii = 16 * it + c15;
#pragma unroll
                for (int r = 0; r < 4; ++r) { const int jj = 16 * jt + 4 * g + r; const bool keep = dir ? (jj > ii) : (jj <= ii); sc[jt][r] = keep ? sc[jt][r] : 0.f; }
            }
            const bf16x8 pa[2] = {pack8(sc[0], sc[1]), pack8(sc[2], sc[3])};
#pragma unroll
            for (int nt = 0; nt < 4; ++nt) {
                const int dvr = 64 * dvh + 16 * nt + c15;
                f32x4 o = (f32x4){0.f, 0.f, 0.f, 0.f};
#pragma unroll
                for (int s = 0; s < 2; ++s) {
                    o = MFMA16(*(const LAS bf16x8*)(vT + dvr * 72 + 32 * s + 8 * g), pa[s], o);
                    o = MFMA16(*(const LAS bf16x8*)(sL + dvr * 72 + 32 * s + 8 * g), qdb[s], o);
                }
                const u32x2 w = {pk2(o[0], o[1]), pk2(o[2], o[3])};
                *(u32x2*)(OL + ((size_t)tokc + 16 * it + c15) * 512 + h * 128 + 64 * dvh + 16 * nt + 4 * g) = w;
            }
            bf16x8 vb[2];
#pragma unroll
            for (int s = 0; s < 2; ++s) vb[s] = *(const LAS bf16x8*)(vT + (16 * wave + c15) * 72 + 32 * s + 8 * g);
#pragma unroll
            for (int kt = 0; kt < 4; ++kt) {
                const f32x4 gm = *(const LAS f32x4*)(elc + 16 * kt + 4 * g);
                f32x4 a = S[kt] * gm;
#pragma unroll
                for (int s = 0; s < 2; ++s) a = MFMA16(*(const LAS bf16x8*)(keT + (16 * kt + c15) * 72 + 32 * s + 8 * g), vb[s], a);
                S[kt] = a;
            }
            quant_store(p, qrow, lane, qa);
        }
        lds_barrier();
    }
    {
        float* SEGS = (float*)(ws + WS_SEGS) + (size_t)(bhd * 8 + sg) * 64 * 128;
#pragma unroll
        for (int kt = 0; kt < 4; ++kt)
#pragma unroll
            for (int r = 0; r < 4; ++r) SEGS[(16 * kt + 4 * g + r) * 128 + 16 * wave + c15] = S[kt][r];
        if (tid < 64) ((float*)(ws + WS_GSEG))[(bhd * 8 + sg) * 64 + tid] = __expf(gs[tid]);
    }
}

DI void phaseGA(const Params& p, LAS unsigned char* lds, int tid, int lane, int wave) {
    for (int task = blockIdx.x; task < 512; task += gridDim.x) { if (task & 1) ga_task<1>(p, lds, tid, lane, wave, task); else ga_task<0>(p, lds, tid, lane, wave, task); }
}

DI void phaseGB(const Params& p, int tid) {
    unsigned char* ws = p.ws;
    const float* SEGS = (const float*)(ws + WS_SEGS); const float* GSEG = (const float*)(ws + WS_GSEG); bf16_t* SC = (bf16_t*)(ws + WS_SC);
    for (int e = blockIdx.x * NTH + tid; e < 64 * 128 * 16; e += gridDim.x * NTH) {
        const int dv = e & 127, dk4 = (e >> 7) & 15, bhd = e >> 11;
        float c[4] = {0.f, 0.f, 0.f, 0.f};
        for (int sg = 0; sg < 8; ++sg) {
            const u32x2 w = {pk2(c[0], c[1]), pk2(c[2], c[3])};
            *(u32x2*)(SC + ((size_t)(bhd * 8 + sg) * 128 + dv) * 64 + 4 * dk4) = w;
            const f32x4 gm = *(const f32x4*)(GSEG + (bhd * 8 + sg) * 64 + 4 * dk4);
#pragma unroll
            for (int r = 0; r < 4; ++r) c[r] = gm[r] * c[r] + SEGS[((size_t)(bhd * 8 + sg) * 64 + 4 * dk4 + r) * 128 + dv];
        }
    }
}

DI void phase4a(const Params& p, LAS unsigned char* lds, int tid, int lane, int wave) {
    asm volatile("" : "+v"(tid), "+v"(lane));
    unsigned char* ws = p.ws;
    const bf16_t* Z = (const bf16_t*)(ws + WS_RZ);
    bf16_t* MIX = (bf16_t*)(ws + WS_RA);
    const bf16_t* OF = (const bf16_t*)(ws + WS_RO); const bf16_t* OB = (const bf16_t*)(ws + WS_RO + 64 * MB);
    const bf16_t* WP = (const bf16_t*)(ws + WS_WP);
    LAS bf16_t* pt = (LAS bf16_t*)lds;
    LAS unsigned char* at = lds + 81920;
    const int c15 = lane & 15, g = lane >> 4;
    for (int tile = blockIdx.x; tile < T / 64; tile += gridDim.x) {
        const int tok0 = tile * 64, s0 = tok0 & (SEQ - 1);
        __syncthreads();
#pragma unroll
        for (int ps = 0; ps < 10; ++ps) {
            const int idx = tid + NTH * ps, rr = idx >> 6, ch = idx & 63, sq = s0 - 8 + rr;
            u32x4 v = {0u, 0u, 0u, 0u};
            if (sq >= 0 && sq < SEQ) v = *(const u32x4*)(Z + ((size_t)tok0 - 8 + rr) * ZW + 1536 + ch * 8);
            *(LAS u32x4*)(pt + rr * 512 + ch * 8) = v;
        }
        {
            const int hh = wave >> 1, ih = wave & 1, bb = tok0 / SEQ, nn = s0 >> 6;
            f32x4 acc[8][2];
#pragma unroll
            for (int mt = 0; mt < 8; ++mt) { acc[mt][0] = (f32x4){0.f, 0.f, 0.f, 0.f}; acc[mt][1] = (f32x4){0.f, 0.f, 0.f, 0.f}; }
#pragma unroll
            for (int dir = 0; dir < 2; ++dir) {
                const int sg = dir ? 7 - (nn >> 3) : (nn >> 3), bhd = bb * 8 + hh * 2 + dir;
                const bf16_t* SCp = (const bf16_t*)(ws + WS_SC) + (size_t)(bhd * 8 + sg) * 128 * 64;
                const bf16_t* QCp = (const bf16_t*)(ws + WS_QDC + (dir ? 16 : 0) * MB) + ((size_t)tok0 + 32 * ih) * 256 + hh * 64;
#pragma unroll
                for (int s = 0; s < 2; ++s) {
                    const bf16x8 q0 = ld_frag16(QCp + (size_t)c15 * 256 + 32 * s + 8 * g), q1 = ld_frag16(QCp + (size_t)(16 + c15) * 256 + 32 * s + 8 * g);
#pragma unroll
                    for (int mt = 0; mt < 8; ++mt) {
                        const bf16x8 af = ld_frag16(SCp + (16 * mt + c15) * 64 + 32 * s + 8 * g);
                        acc[mt][0] = MFMA16(af, q0, acc[mt][0]); acc[mt][1] = MFMA16(af, q1, acc[mt][1]);
                    }
                }
            }
#pragma unroll
            for (int nt = 0; nt < 2; ++nt)
#pragma unroll
                for (int mt = 0; mt < 8; ++mt) { const f32x4 o = acc[mt][nt]; const u32x2 w = {pk2(o[0], o[1]), pk2(o[2], o[3])};
                    *(LAS u32x2*)(at + (32 * ih + 16 * nt + c15) * 1024 + (hh * 128 + 16 * mt + 4 * g) * 2) = w; }
        }
        __syncthreads();
        {
            const f32x4 gh0 = *(const f32x4*)(p.in[11] + 8 * lane), gh1 = *(const f32x4*)(p.in[11] + 8 * lane + 4);
#pragma unroll
            for (int hb = 0; hb < 2; ++hb) {
                u32x4 a[4], bq[4], rv[4], cv[4];
#pragma unroll
                for (int j = 0; j < 4; ++j) { const int tl = wave * 8 + hb * 4 + j; const size_t t = (size_t)tok0 + tl;
                    a[j] = *(const u32x4*)(OF + t * 512 + 8 * lane); bq[j] = *(const u32x4*)(OB + t * 512 + 8 * lane); rv[j] = *(const u32x4*)(Z + t * ZW + 1024 + 8 * lane);
                    cv[j] = *(const LAS u32x4*)(at + tl * 1024 + 16 * lane); }
#pragma unroll
                for (int j = 0; j < 4; ++j) { const size_t t = (size_t)tok0 + wave * 8 + hb * 4 + j;
                    float o[8], r[8];
#pragma unroll
                    for (int e = 0; e < 4; ++e) { o[2 * e] = bflo(a[j][e]) + bflo(bq[j][e]) + bflo(cv[j][e]); o[2 * e + 1] = bfhi(a[j][e]) + bfhi(bq[j][e]) + bfhi(cv[j][e]); r[2 * e] = bflo(rv[j][e]); r[2 * e + 1] = bfhi(rv[j][e]); }
                    float ss = 0.f;
#pragma unroll
                    for (int e = 0; e < 8; ++e) ss += o[e] * o[e];
                    ss += __shfl_xor(ss, 1); ss += __shfl_xor(ss, 2); ss += __shfl_xor(ss, 4); ss += __shfl_xor(ss, 8);
                    const float rstd = rsqrtf(ss * (1.f / 128.f) + EPS);
                    float y[8];
#pragma unroll
                    for (int e = 0; e < 8; ++e) { const float gg = e < 4 ? gh0[e] : gh1[e - 4]; y[e] = o[e] * rstd * gg * (r[e] / (1.f + __expf(-r[e]))); }
                    const u32x4 w = {pk2(y[0], y[1]), pk2(y[2], y[3]), pk2(y[4], y[5]), pk2(y[6], y[7])};
                    *(u32x4*)(MIX + t * D + 8 * lane) = w; }
            }
        }
        __syncthreads();
        {
            const int c = tid, gi = c >> 7, cc = c & 127, hw = 1 << gi;
            LAS unsigned char* ag = at + gi * 16384;
            float sum = 0.f;
            {   const int lo = max(s0 - hw, 0), hi = min(s0 + hw, SEQ);
                for (int rr = lo; rr < hi; ++rr) sum += bflo((unsigned)pt[(rr - s0 + 8) * 512 + c]); }
#pragma unroll 4
            for (int i = 0; i < 64; ++i) {
                const int sq = s0 + i, lo = max(sq - hw, 0), hi = min(sq + hw, SEQ);
                const float val = sum / (float)(hi - lo) - bflo((unsigned)pt[(i + 8) * 512 + c]);
                *(LAS bf16_t*)(ag + i * 256 + (((cc >> 3) ^ (i & 15)) * 16) + (cc & 7) * 2) = (bf16_t)(pk2(val, 0.f) & 0xFFFFu);
                if (sq + hw < SEQ) sum += bflo((unsigned)pt[(i + 8 + hw) * 512 + c]);
                if (sq - hw >= 0) sum -= bflo((unsigned)pt[(i + 8 - hw) * 512 + c]);
            }
        }
        __syncthreads();
        {
            const int gi = wave >> 1, dh = wave & 1;
            LAS unsigned char* ag = at + gi * 16384;
            f32x4 acc[4][4];
#pragma unroll
            for (int mt = 0; mt < 4; ++mt)
#pragma unroll
                for (int nt = 0; nt < 4; ++nt) acc[mt][nt] = (f32x4){0.f, 0.f, 0.f, 0.f};
#pragma unroll
            for (int s = 0; s < 4; ++s) {
                bf16x8 af[4];
#pragma unroll
                for (int mt = 0; mt < 4; ++mt) { const int row = mt * 16 + c15; af[mt] = *(const LAS bf16x8*)(ag + row * 256 + (((4 * s + g) ^ (row & 15)) * 16)); }
#pragma unroll
                for (int nt = 0; nt < 4; ++nt) {
                    const bf16x8 wf = ld_frag16(WP + (size_t)gi * 16384 + (dh * 64 + 16 * nt + c15) * 128 + 32 * s + 8 * g);
#pragma unroll
                    for (int mt = 0; mt < 4; ++mt) acc[mt][nt] = MFMA16(wf, af[mt], acc[mt][nt]);
                }
            }
#pragma unroll
            for (int nt = 0; nt < 4; ++nt) {
                const f32x4 ps = *(const f32x4*)(p.in[13] + gi * 128 + dh * 64 + 16 * nt + 4 * g);
#pragma unroll
                for (int mt = 0; mt < 4; ++mt) {
                    const f32x4 v = acc[mt][nt] * ps;
                    u32x2 w = {pk2(v[0], v[1]), pk2(v[2], v[3])};
                    *(u32x2*)(MIX + ((size_t)tok0 + mt * 16 + c15) * D + 512 + gi * 128 + dh * 64 + 16 * nt + 4 * g) = w;
                }
            }
        }
    }
}

DI void phase4c(const Params& p, LAS unsigned char* lds, int tid, int lane, int wave) {
    asm volatile("" : "+v"(tid), "+v"(lane));
    LAS float* lG = (LAS float*)lds; LAS float* lA = lG + 1024; LAS float* lB = lA + 1024; LAS float* lP = lB + 1024;
    const float* x = p.in[0]; const bf16_t* MIXO = (const bf16_t*)(p.ws + WS_RZ); bf16_t* H2 = (bf16_t*)(p.ws + WS_RA);
    for (int rt = blockIdx.x; rt < T / 128; rt += gridDim.x) {
        const int b = rt / 32;
        __syncthreads();
        for (int d = tid; d < 1024; d += NTH) { lG[d] = mod_at(p, b, 2048 + d); lA[d] = p.in[15][d] * (1.f + mod_at(p, b, 4096 + d)); lB[d] = mod_at(p, b, 3072 + d); lP[d] = p.in[5][d]; }
        __syncthreads();
        for (int r0 = wave; r0 < 128; r0 += 2 * NWV) {
            f32x4 m[2][4], xv[2][4];
#pragma unroll
            for (int u = 0; u < 2; ++u) {
                const size_t row = (size_t)rt * 128 + r0 + u * NWV;
                const u32x2* mr = (const u32x2*)(MIXO + row * D) + lane; const f32x4* xr = (const f32x4*)(x + row * D) + lane;
#pragma unroll
                for (int j = 0; j < 4; ++j) { const u32x2 mv = mr[64 * j]; m[u][j] = (f32x4){bflo(mv.x), bfhi(mv.x), bflo(mv.y), bfhi(mv.y)}; xv[u][j] = xr[64 * j]; }
            }
#pragma unroll
            for (int u = 0; u < 2; ++u) {
                const size_t row = (size_t)rt * 128 + r0 + u * NWV;
                float ss = 0.f;
#pragma unroll
                for (int j = 0; j < 4; ++j) ss += m[u][j][0] * m[u][j][0] + m[u][j][1] * m[u][j][1] + m[u][j][2] * m[u][j][2] + m[u][j][3] * m[u][j][3];
                const float rstd = rsqrtf(wave_sum(ss) * (1.f / D) + EPS);
                float s2 = 0.f;
#pragma unroll
                for (int j = 0; j < 4; ++j) {
                    const f32x4 gt = *(const LAS f32x4*)(lG + 4 * lane + 256 * j), pm = *(const LAS f32x4*)(lP + 4 * lane + 256 * j);
                    xv[u][j] = xv[u][j] + gt * (m[u][j] * rstd * pm);
                    s2 += xv[u][j][0] * xv[u][j][0] + xv[u][j][1] * xv[u][j][1] + xv[u][j][2] * xv[u][j][2] + xv[u][j][3] * xv[u][j][3];
                }
                const float rstd2 = rsqrtf(wave_sum(s2) * (1.f / D) + EPS);
                f32x4* orow = (f32x4*)(p.out + row * D) + lane; u32x2* hrow = (u32x2*)(H2 + row * D) + lane;
#pragma unroll
                for (int j = 0; j < 4; ++j) {
                    orow[64 * j] = xv[u][j];
                    const f32x4 a = *(const LAS f32x4*)(lA + 4 * lane + 256 * j), bb = *(const LAS f32x4*)(lB + 4 * lane + 256 * j);
                    const f32x4 hv = xv[u][j] * rstd2 * a + bb;
                    u32x2 w = {pk2(hv[0], hv[1]), pk2(hv[2], hv[3])};
                    hrow[64 * j] = w;
                }
            }
        }
    }
}

DI int skey(float v, int idx, int mask) { int u = __float_as_int(v); u ^= (u >> 31) & 0x7FFFFFFF; return (u & ~mask) | idx; }
DI float sval(int k, int mask) { int u = k & ~mask; u ^= (u >> 31) & 0x7FFFFFFF; return __int_as_float(u); }
DI void cswap(int& a, int& b) { const int mx = max(a, b), mn = min(a, b); a = mx; b = mn; }
DI void sort16_desc(int (&a)[16]) {
#pragma unroll
    for (int k = 2; k <= 16; k <<= 1) {
#pragma unroll
        for (int j = k >> 1; j > 0; j >>= 1) {
#pragma unroll
            for (int i = 0; i < 16; ++i) {
                const int l = i ^ j;
                if (l > i) { if ((i & k) == 0) cswap(a[i], a[l]); else cswap(a[l], a[i]); }
            }
        }
    }
}
DI void merge16_desc(int (&x)[16], const int (&y)[16]) {
#pragma unroll
    for (int i = 0; i < 16; ++i) x[i] = max(x[i], y[15 - i]);
#pragma unroll
    for (int j = 8; j > 0; j >>= 1) {
#pragma unroll
        for (int i = 0; i < 16; ++i) { const int l = i ^ j; if (l > i) cswap(x[i], x[l]); }
    }
}

DI void phase5b(const Params& p, LAS unsigned char* lds, int tid, int lane, int wave) {
    asm volatile("" : "+v"(tid), "+v"(lane));
    unsigned char* ws = p.ws;
    const bf16_t* Q2 = (const bf16_t*)(ws + WS_RZ);
    const bf16_t* SKB = (const bf16_t*)(ws + WS_SKB);
    int* EIDX = (int*)(ws + WS_RS); float* GATE = (float*)(ws + WS_RS + 16 * MB);
    LAS unsigned char* tab = lds + tid * 32;
    LAS unsigned char* skl = lds + 16384;
    const int c31 = lane & 31, hi = lane >> 5;
    for (int btask = blockIdx.x; btask < 256; btask += gridDim.x) {
        const int h = btask & 7, tgc = btask >> 3;
        __syncthreads();
#pragma unroll
        for (int ps = 0; ps < 8; ++ps) {
            const int idx = tid + NTH * ps, row = idx >> 4, ch = idx & 15;
            const u32x4 v = *(const u32x4*)(SKB + ((size_t)h * 256 + row) * 128 + ch * 8);
            *(LAS u32x4*)(skl + row * 256 + ((ch ^ (row & 15)) * 16)) = v;
        }
        __syncthreads();
      for (int ti = 0; ti < 4; ++ti) {
        const int tg = tgc * 32 + wave * 4 + ti;
        const size_t tok = (size_t)tg * 32 + c31;
        int lst[2][16];
        bf16x8 bq[2][8];
#pragma unroll
        for (int pp = 0; pp < 2; ++pp) {
            const bf16_t* qp = Q2 + tok * 2048 + h * 256 + pp * 128 + 8 * hi;
            asm volatile("" : "+v"(qp));
#pragma unroll
            for (int ks = 0; ks < 8; ++ks) bq[pp][ks] = ld_frag16(qp + 16 * ks);
        }
#pragma unroll
        for (int pp = 0; pp < 2; ++pp) {
            int run[16];
#pragma unroll
            for (int r = 0; r < 16; ++r) run[r] = (int)0x80000000;
#pragma unroll 1
            for (int kt = 0; kt < 4; ++kt) {
                const LAS unsigned char* kb = skl + pp * 32768 + (32 * kt + c31) * 256;
                f32x16 acc;
#pragma unroll
                for (int r = 0; r < 16; ++r) acc[r] = 0.f;
#pragma unroll
                for (int ks = 0; ks < 8; ++ks) acc = MFMA32(*(const LAS bf16x8*)(kb + (((2 * ks + hi) ^ (c31 & 15)) * 16)), bq[pp][ks], acc);
                int cur[16];
#pragma unroll
                for (int r = 0; r < 16; ++r) cur[r] = skey(acc[r], 32 * kt + 8 * (r >> 2) + 4 * hi + (r & 3), 0x7F);
                sort16_desc(cur);
                merge16_desc(run, cur);
            }
            int oth[16];
#pragma unroll
            for (int r = 0; r < 16; ++r) oth[r] = __shfl_xor(run[r], 32);
            merge16_desc(run, oth);
#pragma unroll
            for (int r = 0; r < 16; ++r) lst[pp][r] = run[r];
        }
#pragma unroll
        for (int pp = 0; pp < 2; ++pp) {
            u32x4 w;
#pragma unroll
            for (int q = 0; q < 4; ++q) w[q] = (lst[pp][4 * q] & 0x7F) | ((lst[pp][4 * q + 1] & 0x7F) << 8) | ((lst[pp][4 * q + 2] & 0x7F) << 16) | ((lst[pp][4 * q + 3] & 0x7F) << 24);
            *(LAS u32x4*)(tab + 16 * pp) = w;
        }
        float va[16], vb[16];
#pragma unroll
        for (int r = 0; r < 16; ++r) { va[r] = sval(lst[0][r], 0x7F); vb[r] = sval(lst[1][r], 0x7F); }
        int cand[4][16];
        {
            int cnt = 0;
#pragma unroll
            for (int i = 0; i < 16; ++i)
#pragma unroll
                for (int j = 0; j < 16; ++j)
                    if ((i + 1) * (j + 1) <= 16) { cand[cnt >> 4][cnt & 15] = skey(va[i] + vb[j], (i << 4) | j, 0xFF); ++cnt; }
#pragma unroll
            for (int q = 50; q < 64; ++q) cand[q >> 4][q & 15] = (int)0x80000000;
        }
        sort16_desc(cand[0]); sort16_desc(cand[1]); sort16_desc(cand[2]); sort16_desc(cand[3]);
        merge16_desc(cand[0], cand[1]); merge16_desc(cand[2], cand[3]); merge16_desc(cand[0], cand[2]);
        asm volatile("s_waitcnt lgkmcnt(0)" ::: "memory");
        float sv[16]; int ex[16];
        const float mx = sval(cand[0][0], 0xFF);
        float sum = 0.f;
#pragma unroll
        for (int r = 0; r < 16; ++r) {
            const int ck = cand[0][r];
            const int i1 = tab[(ck >> 4) & 15], i2 = tab[16 + (ck & 15)];
            ex[r] = i1 * 128 + i2;
            sv[r] = __expf(sval(ck, 0xFF) - mx); sum += sv[r];
        }
        const float inv = 1.f / sum;
        int* ep = EIDX + tok * 128 + h * 16 + 8 * hi; float* gp = GATE + tok * 128 + h * 16 + 8 * hi;
        if (hi == 0) {
            *(u32x4*)ep = (u32x4){(unsigned)ex[0], (unsigned)ex[1], (unsigned)ex[2], (unsigned)ex[3]}; *(u32x4*)(ep + 4) = (u32x4){(unsigned)ex[4], (unsigned)ex[5], (unsigned)ex[6], (unsigned)ex[7]};
            *(f32x4*)gp = (f32x4){sv[0] * inv, sv[1] * inv, sv[2] * inv, sv[3] * inv}; *(f32x4*)(gp + 4) = (f32x4){sv[4] * inv, sv[5] * inv, sv[6] * inv, sv[7] * inv};
        } else {
            *(u32x4*)ep = (u32x4){(unsigned)ex[8], (unsigned)ex[9], (unsigned)ex[10], (unsigned)ex[11]}; *(u32x4*)(ep + 4) = (u32x4){(unsigned)ex[12], (unsigned)ex[13], (unsigned)ex[14], (unsigned)ex[15]};
            *(f32x4*)gp = (f32x4){sv[8] * inv, sv[9] * inv, sv[10] * inv, sv[11] * inv}; *(f32x4*)(gp + 4) = (f32x4){sv[12] * inv, sv[13] * inv, sv[14] * inv, sv[15] * inv};
        }
      }
    }
}

template <int K> DI int swz_bcast(int v) { return __builtin_amdgcn_ds_swizzle(v, 0x10 | (K << 5)); }
template <int W> DI int swz_xor(int v) { return __builtin_amdgcn_ds_swizzle(v, 0x1F | (W << 10)); }
template <int K> struct IC { static constexpr int v = K; };
template <int N, int I = 0, class F> DI void static_for(F&& f) { if constexpr (I < N) { f(IC<I>{}); static_for<N, I + 1>(f); } }
DI float row16_sum(float v) {
    v += __builtin_bit_cast(float, __builtin_amdgcn_update_dpp(0, __builtin_bit_cast(int, v), 0xB1, 0xF, 0xF, true));
    v += __builtin_bit_cast(float, __builtin_amdgcn_update_dpp(0, __builtin_bit_cast(int, v), 0x4E, 0xF, 0xF, true));
    v += __builtin_bit_cast(float, __builtin_amdgcn_update_dpp(0, __builtin_bit_cast(int, v), 0x141, 0xF, 0xF, true));
    v += __builtin_bit_cast(float, __builtin_amdgcn_update_dpp(0, __builtin_bit_cast(int, v), 0x140, 0xF, 0xF, true));
    return v;
}
DI void phase6(const Params& p, LAS unsigned char* lds, int tid, int lane, int wave) {
    asm volatile("" : "+v"(tid), "+v"(lane));
    unsigned char* ws = p.ws;
    const bf16_t* H2 = (const bf16_t*)(ws + WS_RA);
    const unsigned char* UQ = ws + WS_UB; const unsigned char* VQ = ws + WS_VB;
    const float* SU = (const float*)(ws + WS_SU); const float* SV = (const float*)(ws + WS_SV);
    const int* EIDX = (const int*)(ws + WS_RS); const float* GATE = (const float*)(ws + WS_RS + 16 * MB);
    LAS float* lG = (LAS float*)lds;
    const int q = lane >> 4, l16 = lane & 15;
    LAS int* le = (LAS int*)(lds + 4096 + wave * 6144) + q * 128;
    LAS float* lg = (LAS float*)(lds + 4096 + wave * 6144 + 2048) + q * 128;
    LAS float* lc = (LAS float*)(lds + 4096 + wave * 6144 + 4096) + q * 128;
    const unsigned qlo = q < 2 ? (0xFFFFu << (16 * q)) : 0u, qhi = q >= 2 ? (0xFFFFu << (16 * (q - 2))) : 0u;
    for (int rt = blockIdx.x; rt < T / 128; rt += gridDim.x) {
        const int b = rt / 32;
        __syncthreads();
        for (int d = tid; d < 1024; d += NTH) lG[d] = mod_at(p, b, 5120 + d) * p.in[16][d];
        __syncthreads();
#pragma unroll 1
        for (int rd = 0; rd < 4; ++rd) {
            __syncthreads();
            const size_t t = (size_t)rt * 128 + wave * 16 + rd * 4 + q;
            {
                int e[8]; float g[8];
#pragma unroll
                for (int r = 0; r < 8; ++r) { e[r] = EIDX[t * 128 + r * 16 + l16]; g[r] = GATE[t * 128 + r * 16 + l16]; }
                unsigned W[4] = {0u, 0u, 0u, 0u};
#pragma unroll
                for (int r = 0; r < 8; ++r) {
                    const int k = e[r] >> 10; const unsigned inc = 1u << (8 * (k & 3)); const int w = k >> 2;
                    W[0] += (w == 0) ? inc : 0u; W[1] += (w == 1) ? inc : 0u; W[2] += (w == 2) ? inc : 0u; W[3] += (w == 3) ? inc : 0u;
                }
                unsigned C[4];
                {
                    unsigned tot[4], exc[4];
#pragma unroll
                    for (int w = 0; w < 4; ++w) {
                        unsigned x = W[w];
                        x += (unsigned)__builtin_amdgcn_update_dpp(0, (int)x, 0x111, 0xF, 0xF, true);
                        x += (unsigned)__builtin_amdgcn_update_dpp(0, (int)x, 0x112, 0xF, 0xF, true);
                        x += (unsigned)__builtin_amdgcn_update_dpp(0, (int)x, 0x114, 0xF, 0xF, true);
                        x += (unsigned)__builtin_amdgcn_update_dpp(0, (int)x, 0x118, 0xF, 0xF, true);
                        exc[w] = x - W[w];
                        tot[w] = (unsigned)swz_bcast<15>((int)x);
                    }
                    unsigned carry = 0u;
#pragma unroll
                    for (int w = 0; w < 4; ++w) {
                        const unsigned P = tot[w] + (tot[w] << 8) + (tot[w] << 16) + (tot[w] << 24);
                        C[w] = (P - tot[w]) + carry * 0x01010101u + exc[w];
                        carry += P >> 24;
                    }
                }
#pragma unroll
                for (int r = 0; r < 8; ++r) {
                    const int k = e[r] >> 10; const int sh = 8 * (k & 3); const int w = k >> 2; const unsigned inc = 1u << sh;
                    const unsigned cw = (w == 0) ? C[0] : (w == 1) ? C[1] : (w == 2) ? C[2] : C[3];
                    const int pos = (int)((cw >> sh) & 0xFFu);
                    le[pos] = e[r]; lg[pos] = g[r];
                    C[0] += (w == 0) ? inc : 0u; C[1] += (w == 1) ? inc : 0u; C[2] += (w == 2) ? inc : 0u; C[3] += (w == 3) ? inc : 0u;
                }
                asm volatile("s_waitcnt lgkmcnt(0)" ::: "memory");
            }
            {
                int hq[16]; float ish;
                {
                    float hv[64]; float hm = 0.f;
#pragma unroll
                    for (int i = 0; i < 4; ++i) {
                        const u32x4 h0 = *(const u32x4*)(H2 + t * D + 256 * i + 16 * l16), h1 = *(const u32x4*)(H2 + t * D + 256 * i + 16 * l16 + 8);
#pragma unroll
                        for (int c = 0; c < 4; ++c) { hv[16 * i + 2 * c] = bflo(h0[c]); hv[16 * i + 2 * c + 1] = bfhi(h0[c]); hv[16 * i + 8 + 2 * c] = bflo(h1[c]); hv[16 * i + 8 + 2 * c + 1] = bfhi(h1[c]); }
                    }
#pragma unroll
                    for (int j = 0; j < 64; ++j) hm = fmaxf(hm, fabsf(hv[j]));
                    hm = fmaxf(hm, __builtin_bit_cast(float, __builtin_amdgcn_update_dpp(0, __builtin_bit_cast(int, hm), 0xB1, 0xF, 0xF, true)));
                    hm = fmaxf(hm, __builtin_bit_cast(float, __builtin_amdgcn_update_dpp(0, __builtin_bit_cast(int, hm), 0x4E, 0xF, 0xF, true)));
                    hm = fmaxf(hm, __builtin_bit_cast(float, __builtin_amdgcn_update_dpp(0, __builtin_bit_cast(int, hm), 0x141, 0xF, 0xF, true)));
                    hm = fmaxf(hm, __builtin_bit_cast(float, __builtin_amdgcn_update_dpp(0, __builtin_bit_cast(int, hm), 0x140, 0xF, 0xF, true)));
                    const float s8 = hm > 1e-30f ? 127.f / hm : 0.f; ish = hm * (1.f / 127.f);
#pragma unroll
                    for (int d = 0; d < 16; ++d) {
                        const int q0 = __float2int_rn(hv[4 * d] * s8), q1 = __float2int_rn(hv[4 * d + 1] * s8), q2 = __float2int_rn(hv[4 * d + 2] * s8), q3 = __float2int_rn(hv[4 * d + 3] * s8);
                        hq[d] = (int)((unsigned)(q0 & 0xFF) | ((unsigned)(q1 & 0xFF) << 8) | ((unsigned)(q2 & 0xFF) << 16) | ((unsigned)q3 << 24));
                    }
                }
                constexpr int UD = 4;
                u32x4 ub[UD][4];
                int evn = le[l16];
                static_for<UD>([&](auto kc) { constexpr int k = decltype(kc)::v; const unsigned char* up = UQ + (size_t)swz_bcast<k>(evn) * 1024 + 16 * l16;
#pragma unroll
                    for (int i = 0; i < 4; ++i) ub[k][i] = *(const u32x4*)(up + 256 * i); });
#pragma unroll 1
                for (int bt = 0; bt < 8; ++bt) {
                    if (bt) __syncthreads();
                    const int ev = evn; const float gv = lg[bt * 16 + l16];
                    evn = le[(bt < 7 ? bt + 1 : 7) * 16 + l16];
                    const float isu = SU[ev] * ish, isv = SV[ev];
                    int part[16];
                    static_for<16>([&](auto kc) {
                        constexpr int k = decltype(kc)::v, sl = k % UD;
                        int a = 0;
#pragma unroll
                        for (int i = 0; i < 4; ++i) {
                            const u32x4 u = ub[sl][i];
#pragma unroll
                            for (int c = 0; c < 4; ++c) a = __builtin_amdgcn_sdot4((int)u[c], hq[4 * i + c], a, false);
                        }
                        part[k] = a;
                        {
                            constexpr int kn = k + UD;
                            int idx; if constexpr (kn < 16) idx = swz_bcast<(kn & 15)>(ev); else idx = swz_bcast<(kn & 15)>(evn);
                            const unsigned char* up = UQ + (size_t)idx * 1024 + 16 * l16;
#pragma unroll
                            for (int i = 0; i < 4; ++i) ub[sl][i] = *(const u32x4*)(up + 256 * i);
                        }
                    });
                    static_for<4>([&](auto sc) {
                        constexpr int w = 8 >> decltype(sc)::v;
                        const bool up2 = (lane & w) != 0;
#pragma unroll
                        for (int e = 0; e < w; ++e) {
                            const int keep = up2 ? part[e + w] : part[e], send = up2 ? part[e] : part[e + w];
                            part[e] = keep + swz_xor<w>(send);
                        }
                    });
                    const float dot = (float)part[0] * isu;
                    lc[bt * 16 + l16] = gv * 0.5f * dot * (1.f + erff(dot * 0.70710678118654752f)) * isv;
                }
                asm volatile("s_waitcnt lgkmcnt(0)" ::: "memory");
            }
            __syncthreads();
            f32x2 y[32];
#pragma unroll
            for (int i = 0; i < 32; ++i) y[i] = (f32x2){0.f, 0.f};
            {
                constexpr int VD = 4;
                u32x4 vbuf[VD][4];
                int evn = le[l16];
                static_for<VD>([&](auto kc) { constexpr int k = decltype(kc)::v; const unsigned char* vp = VQ + (size_t)swz_bcast<k>(evn) * 1024 + 16 * l16;
#pragma unroll
                    for (int i = 0; i < 4; ++i) vbuf[k][i] = *(const u32x4*)(vp + 256 * i); });
#pragma unroll 1
                for (int bt = 0; bt < 8; ++bt) {
                    if (bt) __syncthreads();
                    const int ev = evn; const int cv = __float_as_int(lc[bt * 16 + l16]);
                    evn = le[(bt < 7 ? bt + 1 : 7) * 16 + l16];
                    static_for<16>([&](auto kc) {
                        constexpr int k = decltype(kc)::v, sl = k % VD;
                        const float cc = __int_as_float(swz_bcast<k>(cv));
                        const f32x2 c2 = (f32x2){cc, cc};
#pragma unroll
                        for (int i = 0; i < 4; ++i) {
                            const u32x4 v = vbuf[sl][i];
#pragma unroll
                            for (int c = 0; c < 4; ++c) {
                                const int w = (int)v[c];
                                y[8 * i + 2 * c] = __builtin_elementwise_fma(__builtin_amdgcn_cvt_pk_f32_fp8(w, false), c2, y[8 * i + 2 * c]);
                                y[8 * i + 2 * c + 1] = __builtin_elementwise_fma(__builtin_amdgcn_cvt_pk_f32_fp8(w, true), c2, y[8 * i + 2 * c + 1]);
                            }
                        }
                        {
                            constexpr int kn = k + VD;
                            int idx; if constexpr (kn < 16) idx = swz_bcast<(kn & 15)>(ev); else idx = swz_bcast<(kn & 15)>(evn);
                            const unsigned char* vp = VQ + (size_t)idx * 1024 + 16 * l16;
#pragma unroll
                            for (int i = 0; i < 4; ++i) vbuf[sl][i] = *(const u32x4*)(vp + 256 * i);
                        }
                    });
                }
            }
            float ss = 0.f;
#pragma unroll
            for (int i = 0; i < 32; ++i) ss += y[i].x * y[i].x + y[i].y * y[i].y;
            const float rstd = rsqrtf(row16_sum(ss) * (1.f / D) + EPS);
            float* orow = p.out + t * D;
#pragma unroll
            for (int i = 0; i < 4; ++i)
#pragma unroll
                for (int c = 0; c < 4; ++c) {
                    const int col = 256 * i + 16 * l16 + 4 * c;
                    f32x4 xv = *(const f32x4*)(orow + col);
                    const f32x4 gg = *(const LAS f32x4*)(lG + col);
                    xv[0] += gg[0] * y[8 * i + 2 * c].x * rstd; xv[1] += gg[1] * y[8 * i + 2 * c].y * rstd; xv[2] += gg[2] * y[8 * i + 2 * c + 1].x * rstd; xv[3] += gg[3] * y[8 * i + 2 * c + 1].y * rstd;
                    *(f32x4*)(orow + col) = xv;
                }
        }
    }
}


__global__ void __launch_bounds__(NTH) fwd_megakernel(Params p) {
    extern __shared__ __attribute__((aligned(16))) unsigned char lds_raw[];
    LAS unsigned char* lds = (LAS unsigned char*)lds_raw;
    const int tid = threadIdx.x, lane = tid & 63, wave = __builtin_amdgcn_readfirstlane(tid >> 6);
    volatile LAS unsigned* st = (volatile LAS unsigned*)(lds + LDS_BARW);
    if (tid == 0) { st[0] = 0u; st[1] = 0u; st[2] = 0u; st[3] = 0u; }
    __syncthreads();
    XcdBarrier bar = xcd_barrier_post((unsigned*)(p.ws + WS_CTL), st);
    unsigned char* ws = p.ws;

    phase0(p, lds, tid, lane, wave);
    xcd_barrier(bar);
    phase1(p, lds, tid, lane, wave);
    xcd_barrier(bar);
    { pg8::Gemm g{(const bf16_t*)(ws + WS_RA), (const bf16_t*)(ws + WS_WIN), T, ZW, D}; pg8::StaticOrder S; S.init(T, ZW, (int)gridDim.x, (int)blockIdx.x);
      pg8::EpiB16 e{(bf16_t*)(ws + WS_RZ), ZW}; pg8::gemm_phase<pg8::EpiB16, pg8::StaticOrder, true, true>(lds, g, S, e);
      EpiZ e2{(bf16_t*)(ws + WS_RZ), (float*)(ws + WS_AFB)}; gemm_phase(((const bf16_t*)(ws + WS_RA)), (const bf16_t*)(ws + WS_WIN), T, NIN, D, e2, lds, tid, lane, wave, 16); }
    xcd_barrier(bar);
    phaseGA(p, lds, tid, lane, wave);
    xcd_barrier(bar);
    phaseGB(p, tid);
    xcd_barrier(bar);
    phase4a(p, lds, tid, lane, wave);
    xcd_barrier(bar);
    { pg8::Gemm g{(const bf16_t*)(ws + WS_RA), (const bf16_t*)(ws + WS_WOUT), T, D, D}; pg8::StaticOrder S; S.init(T, D, (int)gridDim.x, (int)blockIdx.x);
      pg8::EpiB16 e{(bf16_t*)(ws + WS_RZ), D}; pg8::gemm_phase<pg8::EpiB16, pg8::StaticOrder, true, true>(lds, g, S, e); }
    xcd_barrier(bar);
    phase4c(p, lds, tid, lane, wave);
    xcd_barrier(bar);
    { pg8::Gemm g{(const bf16_t*)(ws + WS_RA), (const bf16_t*)(ws + WS_WQ), T, 2048, D}; pg8::StaticOrder S; S.init(T, 2048, (int)gridDim.x, (int)blockIdx.x);
      pg8::EpiB16 e{(bf16_t*)(ws + WS_RZ), 2048}; pg8::gemm_phase<pg8::EpiB16, pg8::StaticOrder, true, true>(lds, g, S, e); }
    xcd_barrier(bar);
    phase5b(p, lds, tid, lane, wave);
    xcd_barrier(bar);
    phase6(p, lds, tid, lane, wave);
}

extern "C" void kernel_launch(void* const* d_in, const int* in_sizes, int n_in, void* d_out, int out_size, void* d_ws, size_t ws_size, hipStream_t stream) {
    static int grid = 0;
    if (grid == 0) {
        if (n_in != 21 || out_size != T * D || ws_size < WS_END) { fprintf(stderr, "kernel_launch: unexpected shapes (n_in %d out %d ws %zu need %zu)\n", n_in, out_size, ws_size, (size_t)WS_END); grid = -1; return; }
        int dev = 0, cus = 0, per_cu = 0;
        hipGetDevice(&dev); hipDeviceGetAttribute(&cus, hipDeviceAttributeMultiprocessorCount, dev);
        hipFuncSetAttribute((const void*)fwd_megakernel, hipFuncAttributeMaxDynamicSharedMemorySize, LDS_BYTES);
        hipOccupancyMaxActiveBlocksPerMultiprocessor(&per_cu, (const void*)fwd_megakernel, NTH, LDS_BYTES);
        (void)hipGetLastError();
        if (per_cu < 1) fprintf(stderr, "kernel_launch: occupancy query says %d blocks per CU\n", per_cu);
        grid = cus;
    }
    if (grid < 0) return;
    hipMemsetAsync((char*)d_ws + WS_CTL, 0, 64 * 1024, stream);
    Params p{};
    for (int i = 0; i < 21; ++i) p.in[i] = (const float*)d_in[i];
    p.out = (float*)d_out; p.ws = (unsigned char*)d_ws;
    hipLaunchKernelGGL(fwd_megakernel, dim3(grid), dim3(NTH), LDS_BYTES, stream, p);
}
```

```cpp
#include <hip/hip_runtime.h>
#include <cstdio>
#include <cstdint>

#define DI __device__ __forceinline__
#define LAS __attribute__((address_space(3)))
typedef unsigned short bf16_t;
typedef short bf16x8 __attribute__((ext_vector_type(8)));
typedef float f32x4 __attribute__((ext_vector_type(4)));
typedef float f32x2 __attribute__((ext_vector_type(2)));
typedef float f32x16 __attribute__((ext_vector_type(16)));
typedef unsigned u32x4 __attribute__((ext_vector_type(4)));
typedef unsigned u32x2 __attribute__((ext_vector_type(2)));
typedef __bf16 bf16x2v __attribute__((ext_vector_type(2)));

constexpr int T = 32768, D = 1024, SEQ = 4096, NB = 8;
constexpr int NTH = 512, NWV = 8;
constexpr int ZW = 2048;
constexpr int NIN = 2176;
constexpr float EPS = 1e-6f;

constexpr size_t MB = 1024 * 1024;
constexpr size_t WS_CTL   = 0;
constexpr size_t WS_MODP  = 64 * 1024;
constexpr size_t WS_WIN   = WS_MODP + 8 * 8 * 6144 * 4;
constexpr size_t WS_WOUT  = WS_WIN + (size_t)NIN * 1024 * 2;
constexpr size_t WS_WQ    = WS_WOUT + 1024 * 1024 * 2;
constexpr size_t WS_SKB   = WS_WQ + 2048 * 1024 * 2;
constexpr size_t WS_WP    = WS_SKB + 16 * 128 * 128 * 2;
constexpr size_t WS_AFB   = WS_WP + 4 * 128 * 128 * 2;
constexpr size_t WS_UB    = WS_AFB + (size_t)T * 32 * 4;
constexpr size_t WS_VB    = WS_UB + 32 * MB;
constexpr size_t WS_SU    = WS_UB + 16 * MB, WS_SV = WS_VB + 16 * MB;
constexpr size_t WS_RA    = WS_VB + 32 * MB;
constexpr size_t WS_RZ    = WS_RA + 64 * MB;
constexpr size_t WS_RS    = WS_RZ + 128 * MB;
constexpr size_t WS_RO    = WS_RS + 6 * 16 * MB + 1 * MB;
constexpr size_t WS_END   = WS_RO + 128 * MB;
static_assert(WS_END <= 512 * MB, "workspace too large");

struct Params { const float* in[21]; float* out; unsigned char* ws; };

DI unsigned pk2(float a, float b) { f32x2 f = {a, b}; bf16x2v h = __builtin_convertvector(f, bf16x2v); return __builtin_bit_cast(unsigned, h); }
DI float dot2bf(unsigned a, unsigned b, float c) { return __builtin_amdgcn_fdot2_f32_bf16(__builtin_bit_cast(bf16x2v, a), __builtin_bit_cast(bf16x2v, b), c, false); }
DI float bflo(unsigned u) { return __uint_as_float(u << 16); }
DI float bfhi(unsigned u) { return __uint_as_float(u & 0xFFFF0000u); }
DI float wave_sum(float v) {
#pragma unroll
    for (int o = 1; o < 64; o <<= 1) v += __shfl_xor(v, o);
    return v;
}
DI bf16x8 ld_frag16(const bf16_t* p) { return __builtin_bit_cast(bf16x8, *(const u32x4*)p); }
DI bf16x8 ld_frag_perm(const bf16_t* p, int g) {
    const u32x2 lo = *(const u32x2*)(p + 4 * g), hi = *(const u32x2*)(p + 16 + 4 * g);
    u32x4 v = {lo.x, lo.y, hi.x, hi.y}; return __builtin_bit_cast(bf16x8, v);
}
DI int perm32(int k) { return (k & ~31) | (((k >> 2) & 3) << 3) | (((k >> 4) & 1) << 2) | (k & 3); }
DI bf16x8 pack8(const f32x4& a, const f32x4& b) { u32x4 v = {pk2(a[0], a[1]), pk2(a[2], a[3]), pk2(b[0], b[1]), pk2(b[2], b[3])}; return __builtin_bit_cast(bf16x8, v); }
#define MFMA16(a, b, c) __builtin_amdgcn_mfma_f32_16x16x32_bf16((a), (b), (c), 0, 0, 0)
#define MFMA32(a, b, c) __builtin_amdgcn_mfma_f32_32x32x16_bf16((a), (b), (c), 0, 0, 0)

#define XB_TMO      128
#define XB_XCNT(j)  (256  + 64 * (j))
#define XB_XSUB(j)  (1280 + 64 * (j))
#define XB_XGEN(j)  (2304 + 64 * (j))
#define XB_TOP      3328
#define XB_TOPGEN   3392
#define XCD_BAR_WORDS 3456
#define XB_SPIN_CAP (1u << 22)
DI unsigned xb_ld(unsigned* p)              { return __hip_atomic_load(p, __ATOMIC_RELAXED, __HIP_MEMORY_SCOPE_AGENT); }
DI unsigned xb_add(unsigned* p, unsigned v) { return __hip_atomic_fetch_add(p, v, __ATOMIC_RELAXED, __HIP_MEMORY_SCOPE_AGENT); }
DI unsigned xb_xcc_id() { return (unsigned)__builtin_amdgcn_s_getreg((3 << 11) | 20) & 0xFu; }
#define XB_SPIN(cond, bar) do { unsigned _sp = 0; while (cond) { __builtin_amdgcn_s_sleep(1); \
    if ((++_sp & 255u) == 0u) { if (xb_ld(&(bar)[XB_TMO])) break; if (_sp > XB_SPIN_CAP) { atomicAdd(&(bar)[XB_TMO], 1u); break; } } } } while (0)
struct XcdBarrier { unsigned* bar; unsigned x; volatile LAS unsigned* st; };
DI XcdBarrier xcd_barrier_post(unsigned* bar, volatile LAS unsigned* st) {
    XcdBarrier b; b.bar = bar; b.x = xb_xcc_id(); b.st = st;
    if (threadIdx.x == 0) (void)xb_add(&bar[XB_XCNT(b.x)], 1u);
    return b;
}
DI void xcd_barrier_complete(unsigned* bar, unsigned x, unsigned& nloc, unsigned& nx) {
    const unsigned G = gridDim.x * gridDim.y * gridDim.z;
    unsigned sum, cnt, mine, sp = 0u;
    for (;;) {
        sum = 0u; cnt = 0u; mine = 0u;
#pragma unroll
        for (unsigned j = 0; j < 16; ++j) { const unsigned c = xb_ld(&bar[XB_XCNT(j)]); sum += c; cnt += (c > 0u) ? 1u : 0u; mine = (j == x) ? c : mine; }
        if (sum == G) break;
        __builtin_amdgcn_s_sleep(1);
        if ((++sp & 255u) == 0u) { if (xb_ld(&bar[XB_TMO])) break; if (sp > XB_SPIN_CAP) { atomicAdd(&bar[XB_TMO], 1u); break; } }
    }
    nloc = mine > 0u ? mine : 1u; nx = cnt > 0u ? cnt : 1u;
}
DI void xcd_barrier(const XcdBarrier& b) {
    asm volatile("s_waitcnt vmcnt(0)" ::: "memory");
    __syncthreads();
    if (threadIdx.x == 0) {
        unsigned* bar = b.bar;
        __builtin_amdgcn_s_waitcnt(0);
        unsigned nloc = b.st[0], nx = b.st[1];
        if (nloc == 0u) { xcd_barrier_complete(bar, b.x, nloc, nx); b.st[0] = nloc; b.st[1] = nx; }
        const unsigned old = xb_add(&bar[XB_XSUB(b.x)], 1u);
        const unsigned gen = old / nloc;
        if (old + 1u == (gen + 1u) * nloc) {
            __builtin_amdgcn_fence(__ATOMIC_RELEASE, "agent");
            asm volatile("s_waitcnt vmcnt(0)" ::: "memory");
            const unsigned og = xb_add(&bar[XB_TOP], 1u);
            const unsigned tg = og / nx;
            if (og + 1u == (tg + 1u) * nx) xb_add(&bar[XB_TOPGEN], 1u);
            else XB_SPIN(xb_ld(&bar[XB_TOPGEN]) == tg, bar);
            __builtin_amdgcn_fence(__ATOMIC_ACQUIRE, "agent");
            xb_add(&bar[XB_XGEN(b.x)], 1u);
            asm volatile("s_waitcnt vmcnt(0)" ::: "memory");
        } else {
            XB_SPIN(xb_ld(&bar[XB_XGEN(b.x)]) == gen, bar);
            __builtin_amdgcn_fence(__ATOMIC_ACQUIRE, "agent");
            asm volatile("s_waitcnt vmcnt(0)" ::: "memory");
        }
    }
    __syncthreads();
}

constexpr int LDS_BYTES = 152 * 1024;
constexpr int LDS_BARW = LDS_BYTES - 16;

DI void p0_transpose_item(const float* W, int ldw, int K, bf16_t* WT, int dst_row0, int src_col0, float scale, bool zero, LAS float* scr, int kb, int lane) {
    const int k0 = 64 * kb;
#pragma unroll 8
    for (int i = 0; i < 32; ++i) { const int kk = 2 * i + (lane >> 5); scr[kk * 33 + (lane & 31)] = zero ? 0.f : W[(size_t)(k0 + kk) * ldw + src_col0 + (lane & 31)] * scale; }
    asm volatile("s_waitcnt lgkmcnt(0)" ::: "memory");
    const int c = lane & 7;
#pragma unroll
    for (int j = 0; j < 4; ++j) { const int n = (lane >> 3) + 8 * j; const LAS float* s = scr + (8 * c) * 33 + n;
        u32x4 o; o.x = pk2(s[0 * 33], s[1 * 33]); o.y = pk2(s[2 * 33], s[3 * 33]); o.z = pk2(s[4 * 33], s[5 * 33]); o.w = pk2(s[6 * 33], s[7 * 33]);
        *(u32x4*)(WT + (size_t)(dst_row0 + n) * K + k0 + 8 * c) = o; }
    asm volatile("s_waitcnt lgkmcnt(0)" ::: "memory");
}

DI void phase0(const Params& p, LAS unsigned char* lds, int tid, int lane, int wave) {
    asm volatile("" : "+v"(tid), "+v"(lane));
    unsigned char* ws = p.ws;
    LAS float* sl = (LAS float*)lds;
    LAS float* scr = (LAS float*)(lds + 32768 + wave * 8448);
    const float* c = p.in[1];
    for (int e = tid; e < 8192; e += NTH) { const int b = e >> 10, k = e & 1023; const float v = c[e]; sl[k * 8 + b] = v / (1.f + __expf(-v)); }
    __syncthreads();
    const int gw = wave * gridDim.x + blockIdx.x, NGW = gridDim.x * NWV;
    constexpr int I_MOD = 768, I_WIN = 16 * 68, I_WOUT = 16 * 32, I_WQ = 16 * 64, I_WP = 32;
    constexpr int NITEMS = I_MOD + I_WIN + I_WOUT + I_WQ + I_WP;
    for (int it = gw; it < NITEMS; it += NGW) {
        int r = it;
        if (r < I_MOD) {
            const int cg = r % 96, ks = r / 96, n = cg * 64 + lane, k0 = ks * 128;
            const float* W = p.in[2] + (size_t)k0 * 6144 + n;
            float acc[8];
#pragma unroll
            for (int b = 0; b < 8; ++b) acc[b] = 0.f;
#pragma unroll 8
            for (int k = 0; k < 128; ++k) {
                const float w = W[(size_t)k * 6144];
                const f32x4 s0 = *(const LAS f32x4*)(sl + (k0 + k) * 8), s1 = *(const LAS f32x4*)(sl + (k0 + k) * 8 + 4);
                acc[0] += s0[0] * w; acc[1] += s0[1] * w; acc[2] += s0[2] * w; acc[3] += s0[3] * w;
                acc[4] += s1[0] * w; acc[5] += s1[1] * w; acc[6] += s1[2] * w; acc[7] += s1[3] * w;
            }
            float* mp = (float*)(ws + WS_MODP) + (size_t)ks * 8 * 6144 + n;
#pragma unroll
            for (int b = 0; b < 8; ++b) mp[b * 6144] = acc[b];
            continue;
        }
        r -= I_MOD;
        if (r < I_WIN) {
            const int kb = r / 68, nb = r % 68, n0 = nb * 32;
            int src; bool zero = false; float scale = 1.f;
            if (n0 < 1536) { src = n0; if (n0 < 256) scale = 0.125f; } else if (n0 < 2048) src = n0 + 32; else if (n0 < 2080) src = 1536 + (n0 - 2048); else { src = 0; zero = true; }
            p0_transpose_item(p.in[6], 2080, 1024, (bf16_t*)(ws + WS_WIN), n0, src, scale, zero, scr, kb, lane);
            continue;
        }
        r -= I_WIN;
        if (r < I_WOUT) { p0_transpose_item(p.in[14], 1024, 1024, (bf16_t*)(ws + WS_WOUT), (r % 32) * 32, (r % 32) * 32, 1.f, false, scr, r / 32, lane); continue; }
        r -= I_WOUT;
        if (r < I_WQ) { p0_transpose_item(p.in[17], 2048, 1024, (bf16_t*)(ws + WS_WQ), (r % 64) * 32, (r % 64) * 32, 1.f, false, scr, r / 64, lane); continue; }
        r -= I_WQ;
        { const int g = r >> 3, kb = (r >> 2) & 1, nb = r & 3;
          p0_transpose_item(p.in[12] + g * 16384, 128, 128, (bf16_t*)(ws + WS_WP) + g * 16384, nb * 32, nb * 32, 1.f, false, scr, kb, lane); }
    }
    const size_t gt = (size_t)blockIdx.x * NTH + tid, NGT = (size_t)gridDim.x * NTH;
    constexpr size_t NSK = (size_t)16 * 128 * 128 / 8;
    for (size_t j = gt; j < NSK; j += NGT) {
        const float* src = p.in[18]; bf16_t* dst = (bf16_t*)(ws + WS_SKB);
        const f32x4 a = *(const f32x4*)(src + j * 8), b = *(const f32x4*)(src + j * 8 + 4);
        u32x4 o = {pk2(a[0], a[1]), pk2(a[2], a[3]), pk2(b[0], b[1]), pk2(b[2], b[3])};
        *(u32x4*)(dst + j * 8) = o;
    }
}

DI void quant_load(const Params& p, int row, int lane, f32x4 (&v)[4]) {
    const int tb = row >> 14, e = row & 16383;
    const float* src = (tb ? p.in[20] : p.in[19]) + (size_t)e * D + 16 * lane;
#pragma unroll
    for (int q = 0; q < 4; ++q) v[q] = *(const f32x4*)(src + 4 * q);
}
DI void quant_store(const Params& p, int row, int lane, const f32x4 (&v)[4]) {
    unsigned char* ws = p.ws;
    const int tb = row >> 14, e = row & 16383;
    float m = 0.f;
#pragma unroll
    for (int q = 0; q < 4; ++q) m = fmaxf(m, fmaxf(fmaxf(fabsf(v[q][0]), fabsf(v[q][1])), fmaxf(fabsf(v[q][2]), fabsf(v[q][3]))));
#pragma unroll
    for (int o = 1; o < 64; o <<= 1) m = fmaxf(m, __shfl_xor(m, o));
    int ex = (int)((__float_as_uint(m) >> 23) & 0xFFu) - 127;
    if (m < 1e-30f) ex = 7;
    const float sc = __uint_as_float((unsigned)(127 + 7 - ex) << 23), isc = __uint_as_float((unsigned)(127 - 7 + ex) << 23);
    u32x4 o;
    if (tb) {
#pragma unroll
        for (int q = 0; q < 4; ++q) { int w = 0; w = __builtin_amdgcn_cvt_pk_fp8_f32(v[q][0] * sc, v[q][1] * sc, w, false); w = __builtin_amdgcn_cvt_pk_fp8_f32(v[q][2] * sc, v[q][3] * sc, w, true); o[q] = (unsigned)w; }
        if (lane == 0) ((float*)(ws + WS_SV))[e] = isc;
    } else {
        const float s8 = m > 1e-30f ? 127.f / m : 0.f;
#pragma unroll
        for (int q = 0; q < 4; ++q) {
            const int q0 = __float2int_rn(v[q][0] * s8), q1 = __float2int_rn(v[q][1] * s8), q2 = __float2int_rn(v[q][2] * s8), q3 = __float2int_rn(v[q][3] * s8);
            o[q] = (unsigned)(q0 & 0xFF) | ((unsigned)(q1 & 0xFF) << 8) | ((unsigned)(q2 & 0xFF) << 16) | ((unsigned)q3 << 24);
        }
        if (lane == 0) ((float*)(ws + WS_SU))[e] = m * (1.f / 127.f);
    }
    *(u32x4*)(ws + (tb ? WS_VB : WS_UB) + (size_t)e * 1024 + 16 * lane) = o;
}

DI float mod_at(const Params& p, int b, int n) {
    const float* mp = (const float*)(p.ws + WS_MODP) + (size_t)b * 6144 + n;
    float s = p.in[3][n];
#pragma unroll
    for (int ks = 0; ks < 8; ++ks) s += mp[(size_t)ks * 8 * 6144];
    return s;
}

DI void phase1(const Params& p, LAS unsigned char* lds, int tid, int lane, int wave) {
    asm volatile("" : "+v"(tid), "+v"(lane));
    LAS float* lA = (LAS float*)lds; LAS float* lB = lA + 1024;
    const float* x = p.in[0]; bf16_t* H = (bf16_t*)(p.ws + WS_RA);
    for (int rt = blockIdx.x; rt < T / 128; rt += gridDim.x) {
        const int b = rt / 32;
        __syncthreads();
        for (int d = tid; d < 1024; d += NTH) { lA[d] = p.in[4][d] * (1.f + mod_at(p, b, 1024 + d)); lB[d] = mod_at(p, b, d); }
        __syncthreads();
        for (int r0 = wave; r0 < 128; r0 += 4 * NWV) {
            f32x4 v[4][4];
#pragma unroll
            for (int u = 0; u < 4; ++u) { const f32x4* xr = (const f32x4*)(x + ((size_t)rt * 128 + r0 + u * NWV) * D) + lane;
#pragma unroll
                for (int j = 0; j < 4; ++j) v[u][j] = xr[64 * j]; }
#pragma unroll
            for (int u = 0; u < 4; ++u) {
                const size_t row = (size_t)rt * 128 + r0 + u * NWV;
                float ss = 0.f;
#pragma unroll
                for (int j = 0; j < 4; ++j) ss += v[u][j][0] * v[u][j][0] + v[u][j][1] * v[u][j][1] + v[u][j][2] * v[u][j][2] + v[u][j][3] * v[u][j][3];
                const float rstd = rsqrtf(wave_sum(ss) * (1.f / D) + EPS);
                u32x2* o = (u32x2*)(H + row * D) + lane;
#pragma unroll
                for (int j = 0; j < 4; ++j) {
                    const f32x4 a = *(const LAS f32x4*)(lA + 4 * lane + 256 * j), bb = *(const LAS f32x4*)(lB + 4 * lane + 256 * j);
                    u32x2 w = {pk2(v[u][j][0] * rstd * a[0] + bb[0], v[u][j][1] * rstd * a[1] + bb[1]), pk2(v[u][j][2] * rstd * a[2] + bb[2], v[u][j][3] * rstd * a[3] + bb[3])};
                    o[64 * j] = w;
                }
            }
        }
    }
}

struct EpiZ {
    bf16_t* Z; float* AFB;
    DI void operator()(int m, int n, const f32x4& v) const {
        if (n < ZW) { u32x2 w = {pk2(v[0], v[1]), pk2(v[2], v[3])}; *(u32x2*)(Z + (size_t)m * ZW + n) = w; }
        else if (n < ZW + 32) { *(f32x4*)(AFB + (size_t)m * 32 + (n - ZW)) = v; }
    }
};
struct EpiF32 { float* C; int ldc; DI void operator()(int m, int n, const f32x4& v) const { *(f32x4*)(C + (size_t)m * ldc + n) = v; } };
struct EpiBf16 { bf16_t* C; int ldc; DI void operator()(int m, int n, const f32x4& v) const { u32x2 w = {pk2(v[0], v[1]), pk2(v[2], v[3])}; *(u32x2*)(C + (size_t)m * ldc + n) = w; } };

template <class Epi>
DI void gemm_phase(const bf16_t* A, const bf16_t* Bt, int M, int N, int K, const Epi& epi, LAS unsigned char* lds, int tid, int lane, int wave, int nt_first = 0) {
    constexpr int BM = 256, BN = 128, BK = 64, STAGE = (BM + BN) * 128;
    const int ntn = N / BN - nt_first, ntiles = (M / BM) * ntn, nk = K / BK;
    const int wm = wave & 3, wn = wave >> 2, c15 = lane & 15, g = lane >> 4;
    const int lrow = tid >> 3, lch = tid & 7;
    for (int tile = blockIdx.x; tile < ntiles; tile += gridDim.x) {
        const int m0 = (tile / ntn) * BM, n0 = (tile % ntn + nt_first) * BN;
        f32x4 acc[4][4];
#pragma unroll
        for (int i = 0; i < 4; ++i)
#pragma unroll
            for (int j = 0; j < 4; ++j) acc[i][j] = (f32x4){0.f, 0.f, 0.f, 0.f};
        u32x4 ra[4], rb[2];
        const bf16_t* Ag = A + (size_t)(m0 + lrow) * K + lch * 8;
        const bf16_t* Bg = Bt + (size_t)(n0 + lrow) * K + lch * 8;
        const int woff = lrow * 128 + ((lch ^ (lrow & 7)) * 16);
        __syncthreads();
#pragma unroll
        for (int ps = 0; ps < 4; ++ps) ra[ps] = *(const u32x4*)(Ag + (size_t)(64 * ps) * K);
#pragma unroll
        for (int ps = 0; ps < 2; ++ps) rb[ps] = *(const u32x4*)(Bg + (size_t)(64 * ps) * K);
#pragma unroll
        for (int ps = 0; ps < 4; ++ps) *(LAS u32x4*)(lds + woff + ps * 8192) = ra[ps];
#pragma unroll
        for (int ps = 0; ps < 2; ++ps) *(LAS u32x4*)(lds + BM * 128 + woff + ps * 8192) = rb[ps];
        __syncthreads();
        for (int kt = 0; kt < nk; ++kt) {
            const bool more = (kt + 1 < nk);
            if (more) {
#pragma unroll
                for (int ps = 0; ps < 4; ++ps) ra[ps] = *(const u32x4*)(Ag + (size_t)(64 * ps) * K + (kt + 1) * BK);
#pragma unroll
                for (int ps = 0; ps < 2; ++ps) rb[ps] = *(const u32x4*)(Bg + (size_t)(64 * ps) * K + (kt + 1) * BK);
            }
            LAS unsigned char* sa = lds + (kt & 1) * STAGE; LAS unsigned char* sb = sa + BM * 128;
#pragma unroll
            for (int s = 0; s < 2; ++s) {
                bf16x8 fa[4], fb[4];
#pragma unroll
                for (int i = 0; i < 4; ++i) { const int row = wm * 64 + i * 16 + c15; fa[i] = *(const LAS bf16x8*)(sa + row * 128 + (((4 * s + g) ^ (row & 7)) * 16)); }
#pragma unroll
                for (int j = 0; j < 4; ++j) { const int row = wn * 64 + j * 16 + c15; fb[j] = *(const LAS bf16x8*)(sb + row * 128 + (((4 * s + g) ^ (row & 7)) * 16)); }
#pragma unroll
                for (int i = 0; i < 4; ++i)
#pragma unroll
                    for (int j = 0; j < 4; ++j) acc[i][j] = MFMA16(fb[j], fa[i], acc[i][j]);
            }
            if (more) {
                LAS unsigned char* da = lds + ((kt + 1) & 1) * STAGE;
#pragma unroll
                for (int ps = 0; ps < 4; ++ps) *(LAS u32x4*)(da + woff + ps * 8192) = ra[ps];
#pragma unroll
                for (int ps = 0; ps < 2; ++ps) *(LAS u32x4*)(da + BM * 128 + woff + ps * 8192) = rb[ps];
            }
            __syncthreads();
        }
#pragma unroll
        for (int i = 0; i < 4; ++i)
#pragma unroll
            for (int j = 0; j < 4; ++j) epi(m0 + wm * 64 + i * 16 + c15, n0 + wn * 64 + j * 16 + 4 * g, acc[i][j]);
    }
}

namespace pg8 {
#define PG8_LAS __attribute__((address_space(3)))
constexpr int BM = 256, BK = 64, HALF = 128, HTB = HALF * BK * 2  , STAGE_BYTES = 8 * HTB, NXCD = 8, WGM = 8;

__host__ __device__ __forceinline__ int lds_byte(int r, int c) { const int st = (r >> 4) * 2 + (c >> 5), rr = r & 15, cc = c & 31, ob = rr * 64 + cc * 2; return st * 1024 + (ob ^ (((ob >> 9) & 1) << 5)); }
__host__ __device__ __forceinline__ void stage_rc(int b, int& R, int& C) { const int st = b / 1024, sb = b % 1024, swz = sb ^ (((sb >> 9) & 1) << 5); R = (st >> 1) * 16 + swz / 64; C = (st & 1) * 32 + (swz % 64) / 2; }
__host__ __device__ __forceinline__ int perm32(int rho) { const int n = rho >> 4, i = rho & 15; return 8 * (i >> 2) + 4 * n + (i & 3); }

struct Unit { int pm, pn; };
struct Gemm { const bf16_t* A; const bf16_t* Bt; int M, N, K; };

struct StaticOrder {
    int nM, nN, nwg, G, c;
    __host__ __device__ void init(int M, int N, int G_, int c_) { nM = M / BM; nN = N / BM; nwg = nM * nN; G = G_; c = c_; }
    __host__ __device__ bool next(int i, Unit& u) const {
        const long L = (long)i * G + c; if (L >= nwg) return false;
        int wgid = (int)L; { const int q = nwg / NXCD, r = nwg % NXCD, xcd = wgid % NXCD, off = wgid / NXCD; wgid = (xcd < r ? xcd * (q + 1) : r * (q + 1) + (xcd - r) * q) + off; }
        const int nig = WGM * nN, gid = wgid / nig, fm = gid * WGM, gsz = (nM - fm) < WGM ? (nM - fm) : WGM;
        u.pm = fm + ((wgid % nig) % gsz); u.pn = (wgid % nig) / gsz; return true;
    }
    __device__ __forceinline__ void a_ready(const Unit&) const {}
    __device__ __forceinline__ void done(const Unit&) const {}
};

struct EpiB16 {
    static constexpr bool PERM = true, AFTER_DRAIN = false;
    bf16_t* O; int ldc;
    __device__ __forceinline__ void operator()(const f32x4 (&acc)[2][2][4][2], const Unit& u, int wr, int wc, int fr, int fq) const {
#pragma unroll
        for (int ai = 0; ai < 2; ++ai)
#pragma unroll
            for (int m = 0; m < 4; ++m) { bf16_t* rowp = O + (size_t)(u.pm * BM + ai * HALF + wr * 64 + m * 16 + fr) * ldc + u.pn * BM + wc * 32 + 8 * fq;
#pragma unroll
                for (int bj = 0; bj < 2; ++bj) { const f32x4 v0 = acc[ai][bj][m][0], v1 = acc[ai][bj][m][1];
                    u32x4 w; w.x = ::pk2(v0[0], v0[1]); w.y = ::pk2(v0[2], v0[3]); w.z = ::pk2(v1[0], v1[1]); w.w = ::pk2(v1[2], v1[3]);
                    *(u32x4*)(rowp + bj * HALF) = w; } }
    }
};
struct EpiF {
    static constexpr bool PERM = false, AFTER_DRAIN = false;
    float* O; int ldc;
    __device__ __forceinline__ void operator()(const f32x4 (&acc)[2][2][4][2], const Unit& u, int wr, int wc, int fr, int fq) const {
#pragma unroll
        for (int ai = 0; ai < 2; ++ai)
#pragma unroll
            for (int m = 0; m < 4; ++m) { float* rowp = O + (size_t)(u.pm * BM + ai * HALF + wr * 64 + m * 16 + fr) * ldc + u.pn * BM + wc * 32 + 4 * fq;
#pragma unroll
                for (int bj = 0; bj < 2; ++bj)
#pragma unroll
                    for (int n = 0; n < 2; ++n) *(f32x4*)(rowp + bj * HALF + 16 * n) = acc[ai][bj][m][n]; }
    }
};
template <class Epi, class Sched, bool ALIGN_EPI = false, bool SP2 = false>
__device__ __forceinline__ void gemm_phase(PG8_LAS unsigned char* lds, const Gemm g, const Sched& S, const Epi& E) {
    int tid = threadIdx.x; asm volatile("" : "+v"(tid));
    const int wid = __builtin_amdgcn_readfirstlane(tid >> 6), lane = tid & 63, wr = wid >> 2, wc = wid & 3, fr = lane & 15, fq = lane >> 4;
    const int K = g.K, nt = K / BK;
    unsigned voffA[2], voffB[2];
#pragma unroll
    for (int i = 0; i < 2; ++i) { int R, C; stage_rc(tid * 16 + i * 8192, R, C); const int Rb = Epi::PERM ? ((R & ~31) + perm32(R & 31)) : R;
        voffA[i] = (unsigned)(R * K + C) * 2u; voffB[i] = (unsigned)(Rb * K + C) * 2u; }
    const size_t kstep = (size_t)(BK * 2);
    const size_t hstep = (size_t)HALF * K * 2;
    const size_t tstep = 2 * hstep;
    const unsigned ldsw = (unsigned)wid * 1024u;
    const int aoff = lds_byte(wr * 64 + fr, fq * 8), boff = lds_byte(wc * 32 + fr, fq * 8);
#define PG8_SA(b, h) (((b) * 2 + (h)) * HTB)
#define PG8_SB(b, h) ((4 + (b) * 2 + (h)) * HTB)
#define PG8_STAGE(bufoff, gbase, voff) do { _Pragma("unroll") for (int _i = 0; _i < 2; ++_i) \
        __builtin_amdgcn_global_load_lds((const unsigned*)((const char*)(gbase) + (voff)[_i]), (PG8_LAS unsigned*)(lds + (bufoff) + ldsw + _i * 8192), 16, 0, 0); } while (0)
#define PG8_LDA(dst, b, h) do { _Pragma("unroll") for (int m = 0; m < 4; ++m) _Pragma("unroll") for (int k = 0; k < 2; ++k) dst[m][k] = *(const PG8_LAS bf16x8*)(lds + PG8_SA(b, h) + aoff + m * 2048 + k * 1024); } while (0)
#define PG8_LDB(dst, b, h) do { _Pragma("unroll") for (int n = 0; n < 2; ++n) _Pragma("unroll") for (int k = 0; k < 2; ++k) dst[n][k] = *(const PG8_LAS bf16x8*)(lds + PG8_SB(b, h) + boff + n * 2048 + k * 1024); } while (0)
#define PG8_MMA(ai, bj, At, Bt) do { __builtin_amdgcn_s_setprio(1); _Pragma("unroll") for (int m = 0; m < 4; ++m) _Pragma("unroll") for (int n = 0; n < 2; ++n) _Pragma("unroll") for (int k = 0; k < 2; ++k) \
        acc[ai][bj][m][n] = __builtin_amdgcn_mfma_f32_16x16x32_bf16(Bt[n][k], At[m][k], acc[ai][bj][m][n], 0, 0, 0); __builtin_amdgcn_s_setprio(0); } while (0)
#define PG8_WAIT_V(n) asm volatile("s_waitcnt vmcnt(" #n ")" ::: "memory")
#define PG8_WAIT_L(n) asm volatile("s_waitcnt lgkmcnt(" #n ")" ::: "memory")
#define PG8_BAR __builtin_amdgcn_s_barrier()
#define PG8_SCHED __builtin_amdgcn_sched_barrier(0)
    Unit cur, nxt; int ui = 0;
    if (!S.next(0, cur)) return;
    f32x4 acc[2][2][4][2];
#pragma unroll
    for (int a = 0; a < 2; ++a)
#pragma unroll
        for (int b = 0; b < 2; ++b)
#pragma unroll
            for (int m = 0; m < 4; ++m)
#pragma unroll
                for (int n = 0; n < 2; ++n) acc[a][b][m][n] = (f32x4){0.f, 0.f, 0.f, 0.f};
    bf16x8 At[4][2], B0[2][2], B1[2][2];
    const char* cA = (const char*)g.A + (size_t)cur.pm * tstep; const char* cB = (const char*)g.Bt + (size_t)cur.pn * tstep;
    S.a_ready(cur);
    if constexpr (SP2) {
        PG8_STAGE(PG8_SB(0, 0), cB, voffB); PG8_STAGE(PG8_SB(0, 1), cB + hstep, voffB); PG8_STAGE(PG8_SA(0, 0), cA, voffA); PG8_STAGE(PG8_SA(0, 1), cA + hstep, voffA);
        if (wr == 1) PG8_BAR;
        PG8_WAIT_V(2); PG8_BAR;
        PG8_STAGE(PG8_SB(1, 0), cB + kstep, voffB); PG8_STAGE(PG8_SA(1, 0), cA + kstep, voffA); PG8_STAGE(PG8_SB(1, 1), cB + hstep + kstep, voffB);
        PG8_WAIT_V(6); PG8_BAR;
    } else {
        PG8_STAGE(PG8_SB(0, 0), cB, voffB); PG8_STAGE(PG8_SA(0, 0), cA, voffA); PG8_STAGE(PG8_SB(0, 1), cB + hstep, voffB); PG8_STAGE(PG8_SA(0, 1), cA + hstep, voffA);
        if (wr == 1) PG8_BAR;
        PG8_WAIT_V(4); PG8_BAR;
        PG8_STAGE(PG8_SB(1, 0), cB + kstep, voffB); PG8_STAGE(PG8_SA(1, 0), cA + kstep, voffA); PG8_STAGE(PG8_SB(1, 1), cB + hstep + kstep, voffB);
        PG8_WAIT_V(6); PG8_BAR;
    }
    for (;;) {
        const bool has_next = S.next(ui + 1, nxt);
        const char* nA = has_next ? (const char*)g.A + (size_t)nxt.pm * tstep : cA; const char* nB = has_next ? (const char*)g.Bt + (size_t)nxt.pn * tstep : cB;
        for (int t = 0; t < nt; t += 2) {
            const bool last = (t == nt - 2);
            const char* a1 = cA + (size_t)(t + 1) * kstep;
            const char* a2 = last ? nA : cA + (size_t)(t + 2) * kstep; const char* b2 = last ? nB : cB + (size_t)(t + 2) * kstep;
            const char* a3 = a2 + kstep; const char* b3 = b2 + kstep;
            if (last && has_next) S.a_ready(nxt);
            if constexpr (SP2) {
            PG8_LDB(B0, 0, 0); PG8_LDB(B1, 0, 1); PG8_SCHED; PG8_LDA(At, 0, 0); PG8_STAGE(PG8_SA(1, 1), a1 + hstep, voffA);
            PG8_WAIT_V(8); PG8_WAIT_L(0); PG8_BAR; PG8_MMA(0, 0, At, B0); PG8_MMA(0, 1, At, B1); PG8_BAR; PG8_SCHED;
            PG8_LDA(At, 0, 1); PG8_STAGE(PG8_SB(0, 0), b2, voffB); PG8_STAGE(PG8_SB(0, 1), b2 + hstep, voffB); PG8_STAGE(PG8_SA(0, 0), a2, voffA);
            PG8_WAIT_V(8); PG8_WAIT_L(0); PG8_BAR; PG8_MMA(1, 0, At, B0); PG8_MMA(1, 1, At, B1); PG8_BAR; PG8_SCHED;
            PG8_LDB(B0, 1, 0); PG8_LDB(B1, 1, 1); PG8_SCHED; PG8_LDA(At, 1, 0); PG8_STAGE(PG8_SA(0, 1), a2 + hstep, voffA);
            PG8_WAIT_V(8); PG8_WAIT_L(0); PG8_BAR; PG8_MMA(0, 0, At, B0); PG8_MMA(0, 1, At, B1); PG8_BAR; PG8_SCHED;
            PG8_LDA(At, 1, 1); PG8_STAGE(PG8_SB(1, 0), b3, voffB); PG8_STAGE(PG8_SB(1, 1), b3 + hstep, voffB); PG8_STAGE(PG8_SA(1, 0), a3, voffA);
            PG8_WAIT_V(8); PG8_WAIT_L(0); PG8_BAR; PG8_MMA(1, 0, At, B0); PG8_MMA(1, 1, At, B1); PG8_BAR; PG8_SCHED;
            } else {
            PG8_LDB(B0, 0, 0); PG8_SCHED; PG8_LDA(At, 0, 0); PG8_STAGE(PG8_SA(1, 1), a1 + hstep, voffA);
            PG8_WAIT_L(8); PG8_BAR; PG8_WAIT_L(0); PG8_MMA(0, 0, At, B0); PG8_BAR; PG8_SCHED;
            PG8_LDB(B1, 0, 1); PG8_STAGE(PG8_SB(0, 0), b2, voffB);
            PG8_BAR; PG8_WAIT_L(0); PG8_MMA(0, 1, At, B1); PG8_BAR;
            PG8_LDA(At, 0, 1); PG8_STAGE(PG8_SA(0, 0), a2, voffA);
            PG8_BAR; PG8_WAIT_L(0); PG8_MMA(1, 0, At, B0); PG8_BAR; PG8_SCHED;
            PG8_STAGE(PG8_SB(0, 1), b2 + hstep, voffB);
            PG8_WAIT_V(6); PG8_BAR; PG8_MMA(1, 1, At, B1); PG8_BAR;
            PG8_LDB(B0, 1, 0); PG8_SCHED; PG8_LDA(At, 1, 0); PG8_STAGE(PG8_SA(0, 1), a2 + hstep, voffA);
            PG8_WAIT_L(8); PG8_BAR; PG8_WAIT_L(0); PG8_MMA(0, 0, At, B0); PG8_BAR; PG8_SCHED;
            PG8_LDB(B1, 1, 1); PG8_STAGE(PG8_SB(1, 0), b3, voffB);
            PG8_BAR; PG8_WAIT_L(0); PG8_MMA(0, 1, At, B1); PG8_BAR;
            PG8_LDA(At, 1, 1); PG8_STAGE(PG8_SA(1, 0), a3, voffA);
            PG8_BAR; PG8_WAIT_L(0); PG8_MMA(1, 0, At, B0); PG8_BAR; PG8_SCHED;
            PG8_STAGE(PG8_SB(1, 1), b3 + hstep, voffB);
            PG8_WAIT_V(6); PG8_BAR; PG8_MMA(1, 1, At, B1); PG8_BAR;
            }
        }
        if constexpr (ALIGN_EPI) { if (wr == 0) PG8_BAR; }
        if constexpr (!Epi::AFTER_DRAIN) { E(acc, cur, wr, wc, fr, fq); S.done(cur); }
        if (!has_next) break;
#pragma unroll
        for (int a = 0; a < 2; ++a)
#pragma unroll
            for (int b = 0; b < 2; ++b)
#pragma unroll
                for (int m = 0; m < 4; ++m)
#pragma unroll
                    for (int n = 0; n < 2; ++n) acc[a][b][m][n] = (f32x4){0.f, 0.f, 0.f, 0.f};
        cur = nxt; cA = nA; cB = nB; ++ui;
        if constexpr (ALIGN_EPI) { if (wr == 1) PG8_BAR; }
    }
    PG8_WAIT_V(0);
    if constexpr (!ALIGN_EPI) { if (wr == 0) PG8_BAR; }
    PG8_BAR;
    if constexpr (Epi::AFTER_DRAIN) { E.fused(acc, cur, wr, wc, fr, fq, lds, wid, lane); S.done(cur); }
#undef PG8_SA
#undef PG8_SB
#undef PG8_STAGE
#undef PG8_LDA
#undef PG8_LDB
#undef PG8_MMA
#undef PG8_WAIT_V
#undef PG8_WAIT_L
#undef PG8_BAR
#undef PG8_SCHED
}
}

constexpr size_t WS_QDC  = WS_RS;
constexpr size_t WS_SEGS = WS_RS + 32 * MB;
constexpr size_t WS_GSEG = WS_RS + 48 * MB;
constexpr size_t WS_SC   = WS_RS + 49 * MB;
DI void lds_barrier() { asm volatile("s_waitcnt lgkmcnt(0)" ::: "memory"); __builtin_amdgcn_s_barrier(); asm volatile("" ::: "memory"); }
DI float logsig(float x) { return fminf(x, 0.f) - __logf(1.f + __expf(-fabsf(x))); }

template <int DIR>
DI void ga_task(const Params& p, LAS unsigned char* lds, int tid, int lane, int wave, int task) {
    asm volatile("" : "+v"(tid), "+v"(lane));
    unsigned char* ws = p.ws;
    const bf16_t* Z = (const bf16_t*)(ws + WS_RZ);
    const float* AFB = (const float*)(ws + WS_AFB);
    LAS float* la = (LAS float*)lds;
    LAS float* part = (LAS float*)(lds + 17408);
    LAS float* gs = (LAS float*)(lds + 18432);
    LAS float* elb = (LAS float*)(lds + 18944);
    LAS float* wl = (LAS float*)(lds + 19968);
    LAS bf16_t* sL  = (LAS bf16_t*)(lds + 24064);
    LAS unsigned char* obuf = lds + 42496;
    const int c15 = lane & 15, g = lane >> 4;
    const int i = tid >> 3, dg = tid & 7, d0 = dg * 8;
#define TROW(r) ((r) * 72 + ((r) >> 3) * 8)
    constexpr int dir = DIR; const int h = (task >> 1) & 3, pb = (task >> 3) & 7, b = task >> 6;
    const int bhd = b * 8 + h * 2 + dir, sg = dir ? 7 - pb : pb;
    bf16_t* QDC = (bf16_t*)(ws + WS_QDC + (dir ? 16 : 0) * MB);
    bf16_t* OL = (bf16_t*)(ws + WS_RO + (dir ? 64 : 0) * MB);
    f32x4 S[4];
#pragma unroll
    for (int kt = 0; kt < 4; ++kt) S[kt] = (f32x4){0.f, 0.f, 0.f, 0.f};
    __syncthreads();
    for (int e = tid; e < 128 * 72 / 2; e += NTH) ((LAS unsigned*)sL)[e] = 0u;
    if (tid < 64) gs[tid] = 0.f;
    for (int e = tid; e < 1024; e += NTH) wl[e] = (dir ? p.in[9] : p.in[7])[(e >> 6) * 256 + h * 64 + (e & 63)];
    typedef short s16x4w __attribute__((ext_vector_type(4)));
    s16x4w wfr[2]; float bias[2];
    __syncthreads();
#pragma unroll
    for (int u = 0; u < 2; ++u) {
        const int d = 16 * (2 * (wave >> 2) + u) + c15;
        const u32x2 wp = {pk2(wl[(4 * g) * 64 + d], wl[(4 * g + 1) * 64 + d]), pk2(wl[(4 * g + 2) * 64 + d], wl[(4 * g + 3) * 64 + d])};
        wfr[u] = __builtin_bit_cast(s16x4w, wp);
        bias[u] = (dir ? p.in[10] : p.in[8])[h * 64 + d];
    }
    const int mt = wave & 3;
    f32x4 avn;
    { const int n0 = dir ? pb * 8 + 7 : pb * 8; avn = *(const f32x4*)(AFB + ((size_t)b * SEQ + n0 * 64 + 16 * mt + c15) * 32 + dir * 16 + 4 * g); }
#pragma unroll 1
    for (int ci = -1; ci < 8; ++ci) {
        const bool has_cur = ci >= 0, has_nxt = ci < 7;
        const int cx = ci + 1;
        const int nx = dir ? pb * 8 + 7 - cx : pb * 8 + cx, tokx = b * SEQ + nx * 64;
        const int nc = dir ? pb * 8 + 7 - ci : pb * 8 + ci, tokc = b * SEQ + nc * 64;
        LAS unsigned char* bx = obuf + (cx & 1) * 46464; LAS unsigned char* bc = obuf + (ci & 1) * 46464;
        LAS float* elx = elb + (cx & 1) * 128; LAS float* elc = elb + (ci & 1) * 128;
        u32x4 qv, kv, vvp[2]; f32x4 qa[4]; float lv[2][4];
        const int qrow = (task * 8 + (has_cur ? ci : 0)) * NWV + wave;
        if (ci > 0) {
#pragma unroll
            for (int kt = 0; kt < 4; ++kt) { const u32x2 w = {pk2(S[kt][0], S[kt][1]), pk2(S[kt][2], S[kt][3])}; *(LAS u32x2*)(sL + (16 * wave + c15) * 72 + 16 * kt + 4 * g) = w; }
        }
        if (has_cur) quant_load(p, qrow, lane, qa);
        if (has_nxt) {
            const size_t t = (size_t)tokx + i;
            qv = *(const u32x4*)(Z + t * ZW + h * 64 + d0); kv = *(const u32x4*)(Z + t * ZW + 256 + h * 64 + d0);
#pragma unroll
            for (int ps = 0; ps < 2; ++ps) { const int idx = tid + NTH * ps, vi = idx >> 4, ch = idx & 15; vvp[ps] = *(const u32x4*)(Z + ((size_t)tokx + vi) * ZW + 512 + h * 128 + ch * 8); }
            typedef short s16x4v __attribute__((ext_vector_type(4)));
            const u32x2 ap = {pk2(avn[0], avn[1]), pk2(avn[2], avn[3])};
            const s16x4v af = __builtin_bit_cast(s16x4v, ap);
            { const int c2 = cx < 7 ? cx + 1 : cx, n2 = dir ? pb * 8 + 7 - c2 : pb * 8 + c2; avn = *(const f32x4*)(AFB + ((size_t)b * SEQ + n2 * 64 + 16 * mt + c15) * 32 + dir * 16 + 4 * g); }
#pragma unroll
            for (int u = 0; u < 2; ++u) {
                const int d = 16 * (2 * (wave >> 2) + u) + c15;
                const f32x4 x = __builtin_amdgcn_mfma_f32_16x16x16bf16_1k(af, wfr[u], (f32x4){0.f, 0.f, 0.f, 0.f}, 0, 0, 0);
                float v0 = logsig(x[0] + bias[u]) * 0.0625f, v1 = logsig(x[1] + bias[u]) * 0.0625f, v2 = logsig(x[2] + bias[u]) * 0.0625f, v3 = logsig(x[3] + bias[u]) * 0.0625f;
                float T, T2, T3;
                if (dir == 0) {
                    v1 += v0; v2 += v1; v3 += v2; T = v3;
                    const float t1 = __shfl_up(T, 16); T2 = T + (g >= 1 ? t1 : 0.f);
                    const float t2 = __shfl_up(T2, 32); T3 = T2 + (g >= 2 ? t2 : 0.f);
                    if (g == 3) part[mt * 64 + d] = T3;
                } else {
                    v2 += v3; v1 += v2; v0 += v1; T = v0;
                    const float t1 = __shfl_down(T, 16); T2 = T + (g <= 2 ? t1 : 0.f);
                    const float t2 = __shfl_down(T2, 32); T3 = T2 + (g <= 1 ? t2 : 0.f);
                    if (g == 0) part[mt * 64 + d] = T3;
                }
                const float off = T3 - T;
                lv[u][0] = v0 + off; lv[u][1] = v1 + off; lv[u][2] = v2 + off; lv[u][3] = v3 + off;
            }
        }
        lds_barrier();
        if (has_nxt) {
#pragma unroll
            for (int u = 0; u < 2; ++u) {
                const int d = 16 * (2 * (wave >> 2) + u) + c15;
                float off = 0.f;
#pragma unroll
                for (int m2 = 0; m2 < 4; ++m2) { const bool take = dir ? (m2 > mt) : (m2 < mt); off += take ? part[m2 * 64 + d] : 0.f; }
#pragma unroll
                for (int r = 0; r < 4; ++r) la[(16 * mt + 4 * g + r) * 68 + d] = lv[u][r] + off;
                if (mt == (dir ? 0 : 3) && g == (dir ? 0 : 3)) {
                    const float tot = lv[u][dir ? 0 : 3] + off, gsum = gs[(cx & 1) * 64 + d];
                    elx[d] = __expf(tot); elx[64 + d] = __expf(gsum); gs[((cx + 1) & 1) * 64 + d] = gsum + tot;
                }
            }
        }
        lds_barrier();
        if (has_nxt) {
            LAS bf16_t* qdL = (LAS bf16_t*)bx; LAS bf16_t* kiL = (LAS bf16_t*)(bx + 9216); LAS bf16_t* keT = (LAS bf16_t*)(bx + 18432); LAS bf16_t* vT = (LAS bf16_t*)(bx + 27776);
            const size_t t = (size_t)tokx + i;
            float q[8], k[8];
#pragma unroll
            for (int e = 0; e < 4; ++e) { q[2 * e] = bflo(qv[e]); q[2 * e + 1] = bfhi(qv[e]); k[2 * e] = bflo(kv[e]); k[2 * e + 1] = bfhi(kv[e]); }
            float qd[8], ki[8], ke[8], qc[8];
#pragma unroll
            for (int e = 0; e < 8; ++e) {
                const float E = __expf(la[i * 68 + d0 + e]), R = __builtin_amdgcn_rcpf(E);
                qd[e] = q[e] * E; ki[e] = k[e] * R; ke[e] = ki[e] * elx[d0 + e]; qc[e] = qd[e] * elx[64 + d0 + e];
            }
            const u32x4 o1 = {pk2(qd[0], qd[1]), pk2(qd[2], qd[3]), pk2(qd[4], qd[5]), pk2(qd[6], qd[7])};
            const u32x4 o2 = {pk2(ki[0], ki[1]), pk2(ki[2], ki[3]), pk2(ki[4], ki[5]), pk2(ki[6], ki[7])};
            const u32x4 o3 = {pk2(qc[0], qc[1]), pk2(qc[2], qc[3]), pk2(qc[4], qc[5]), pk2(qc[6], qc[7])};
            *(LAS u32x4*)(qdL + i * 72 + d0) = o1; *(LAS u32x4*)(kiL + i * 72 + d0) = o2;
            *(u32x4*)(QDC + t * 256 + h * 64 + d0) = o3;
#pragma unroll
            for (int e = 0; e < 4; ++e) { const unsigned w = pk2(ke[2 * e], ke[2 * e + 1]); keT[TROW(d0 + 2 * e) + perm32(i)] = (bf16_t)(w & 0xFFFFu); keT[TROW(d0 + 2 * e + 1) + perm32(i)] = (bf16_t)(w >> 16); }
#pragma unroll
            for (int ps = 0; ps < 2; ++ps) {
                const int idx = tid + NTH * ps, vi = idx >> 4, ch = idx & 15;
#pragma unroll
                for (int e = 0; e < 4; ++e) { vT[TROW(ch * 8 + 2 * e) + perm32(vi)] = (bf16_t)(vvp[ps][e] & 0xFFFFu); vT[TROW(ch * 8 + 2 * e + 1) + perm32(vi)] = (bf16_t)(vvp[ps][e] >> 16); }
            }
        }
        if (has_cur) {
            const LAS bf16_t* qdL = (const LAS bf16_t*)bc; const LAS bf16_t* kiL = (const LAS bf16_t*)(bc + 9216); const LAS bf16_t* keT = (const LAS bf16_t*)(bc + 18432); const LAS bf16_t* vT = (const LAS bf16_t*)(bc + 27776);
            const int it = wave & 3, dvh = wave >> 2;
            bf16x8 qdb[2];
#pragma unroll
            for (int s = 0; s < 2; ++s) qdb[s] = *(const LAS bf16x8*)(qdL + (16 * it + c15) * 72 + 32 * s + 8 * g);
            f32x4 sc[4];
#pragma unroll
            for (int jt = 0; jt < 4; ++jt) {
                sc[jt] = (f32x4){0.f, 0.f, 0.f, 0.f};
#pragma unroll
                for (int s = 0; s < 2; ++s) sc[jt] = MFMA16(*(const LAS bf16x8*)(kiL + (16 * jt + c15) * 72 + 32 * s + 8 * g), qdb[s], sc[jt]);
                const int ii = 16 * it + c15;
#pragma unroll
                for (int r = 0; r < 4; ++r) { const int jj = 16 * jt + 4 * g + r; const bool keep = dir ? (jj > ii) : (jj <= ii); sc[jt][r] = keep ? sc[jt][r] : 0.f; }
            }
            const bf16x8 pa[2] = {pack8(sc[0], sc[1]), pack8(sc[2], sc[3])};
#pragma unroll
            for (int nt = 0; nt < 4; ++nt) {
                const int dvr = 64 * dvh + 16 * nt + c15;
                f32x4 o = (f32x4){0.f, 0.f, 0.f, 0.f};
#pragma unroll
                for (int s = 0; s < 2; ++s) {
                    o = MFMA16(*(const LAS bf16x8*)(vT + TROW(dvr) + 32 * s + 8 * g), pa[s], o);
                    o = MFMA16(*(const LAS bf16x8*)(sL + dvr * 72 + 32 * s + 8 * g), qdb[s], o);
                }
                const u32x2 w = {pk2(o[0], o[1]), pk2(o[2], o[3])};
                *(u32x2*)(OL + ((size_t)tokc + 16 * it + c15) * 512 + h * 128 + 64 * dvh + 16 * nt + 4 * g) = w;
            }
            bf16x8 vb[2];
#pragma unroll
            for (int s = 0; s < 2; ++s) vb[s] = *(const LAS bf16x8*)(vT + TROW(16 * wave + c15) + 32 * s + 8 * g);
#pragma unroll
            for (int kt = 0; kt < 4; ++kt) {
                const f32x4 gm = *(const LAS f32x4*)(elc + 16 * kt + 4 * g);
                f32x4 a = S[kt] * gm;
#pragma unroll
                for (int s = 0; s < 2; ++s) a = MFMA16(*(const LAS bf16x8*)(keT + TROW(16 * kt + c15) + 32 * s + 8 * g), vb[s], a);
                S[kt] = a;
            }
            quant_store(p, qrow, lane, qa);
        }
        lds_barrier();
    }
    {
        float* SEGS = (float*)(ws + WS_SEGS) + (size_t)(bhd * 8 + sg) * 64 * 128;
#pragma unroll
        for (int kt = 0; kt < 4; ++kt)
#pragma unroll
            for (int r = 0; r < 4; ++r) SEGS[(16 * kt + 4 * g + r) * 128 + 16 * wave + c15] = S[kt][r];
        if (tid < 64) ((float*)(ws + WS_GSEG))[(bhd * 8 + sg) * 64 + tid] = __expf(gs[tid]);
    }
}
#undef TROW

DI void phaseGA(const Params& p, LAS unsigned char* lds, int tid, int lane, int wave) {
    for (int task = blockIdx.x; task < 512; task += gridDim.x) { if (task & 1) ga_task<1>(p, lds, tid, lane, wave, task); else ga_task<0>(p, lds, tid, lane, wave, task); }
}

DI void phaseGB(const Params& p, int tid) {
    unsigned char* ws = p.ws;
    const float* SEGS = (const float*)(ws + WS_SEGS); const float* GSEG = (const float*)(ws + WS_GSEG); bf16_t* SC = (bf16_t*)(ws + WS_SC);
    for (int e = blockIdx.x * NTH + tid; e < 64 * 128 * 16; e += gridDim.x * NTH) {
        const int dv = e & 127, dk4 = (e >> 7) & 15, bhd = e >> 11;
        float c[4] = {0.f, 0.f, 0.f, 0.f};
        for (int sg = 0; sg < 8; ++sg) {
            const u32x2 w = {pk2(c[0], c[1]), pk2(c[2], c[3])};
            *(u32x2*)(SC + ((size_t)(bhd * 8 + sg) * 128 + dv) * 64 + 4 * dk4) = w;
            const f32x4 gm = *(const f32x4*)(GSEG + (bhd * 8 + sg) * 64 + 4 * dk4);
#pragma unroll
            for (int r = 0; r < 4; ++r) c[r] = gm[r] * c[r] + SEGS[((size_t)(bhd * 8 + sg) * 64 + 4 * dk4 + r) * 128 + dv];
        }
    }
}

DI void phase4a(const Params& p, LAS unsigned char* lds, int tid, int lane, int wave) {
    asm volatile("" : "+v"(tid), "+v"(lane));
    unsigned char* ws = p.ws;
    const bf16_t* Z = (const bf16_t*)(ws + WS_RZ);
    bf16_t* MIX = (bf16_t*)(ws + WS_RA);
    const bf16_t* OF = (const bf16_t*)(ws + WS_RO); const bf16_t* OB = (const bf16_t*)(ws + WS_RO + 64 * MB);
    const bf16_t* WP = (const bf16_t*)(ws + WS_WP);
    LAS bf16_t* pt = (LAS bf16_t*)lds;
    LAS unsigned char* at = lds + 81920;
    const int c15 = lane & 15, g = lane >> 4;
    for (int tile = blockIdx.x; tile < T / 64; tile += gridDim.x) {
        const int tok0 = tile * 64, s0 = tok0 & (SEQ - 1);
        __syncthreads();
#pragma unroll
        for (int ps = 0; ps < 10; ++ps) {
            const int idx = tid + NTH * ps, rr = idx >> 6, ch = idx & 63, sq = s0 - 8 + rr;
            u32x4 v = {0u, 0u, 0u, 0u};
            if (sq >= 0 && sq < SEQ) v = *(const u32x4*)(Z + ((size_t)tok0 - 8 + rr) * ZW + 1536 + ch * 8);
            *(LAS u32x4*)(pt + rr * 512 + ch * 8) = v;
        }
        {
            const int hh = wave >> 1, ih = wave & 1, bb = tok0 / SEQ, nn = s0 >> 6;
            f32x4 acc[8][2];
#pragma unroll
            for (int mt = 0; mt < 8; ++mt) { acc[mt][0] = (f32x4){0.f, 0.f, 0.f, 0.f}; acc[mt][1] = (f32x4){0.f, 0.f, 0.f, 0.f}; }
#pragma unroll
            for (int dir = 0; dir < 2; ++dir) {
                const int sg = dir ? 7 - (nn >> 3) : (nn >> 3), bhd = bb * 8 + hh * 2 + dir;
                const bf16_t* SCp = (const bf16_t*)(ws + WS_SC) + (size_t)(bhd * 8 + sg) * 128 * 64;
                const bf16_t* QCp = (const bf16_t*)(ws + WS_QDC + (dir ? 16 : 0) * MB) + ((size_t)tok0 + 32 * ih) * 256 + hh * 64;
#pragma unroll
                for (int s = 0; s < 2; ++s) {
                    const bf16x8 q0 = ld_frag16(QCp + (size_t)c15 * 256 + 32 * s + 8 * g), q1 = ld_frag16(QCp + (size_t)(16 + c15) * 256 + 32 * s + 8 * g);
#pragma unroll
                    for (int mt = 0; mt < 8; ++mt) {
                        const bf16x8 af = ld_frag16(SCp + (16 * mt + c15) * 64 + 32 * s + 8 * g);
                        acc[mt][0] = MFMA16(af, q0, acc[mt][0]); acc[mt][1] = MFMA16(af, q1, acc[mt][1]);
                    }
                }
            }
#pragma unroll
            for (int nt = 0; nt < 2; ++nt)
#pragma unroll
                for (int mt = 0; mt < 8; ++mt) { const f32x4 o = acc[mt][nt]; const u32x2 w = {pk2(o[0], o[1]), pk2(o[2], o[3])};
                    *(LAS u32x2*)(at + (32 * ih + 16 * nt + c15) * 1040 + (hh * 128 + 16 * mt + 4 * g) * 2) = w; }
        }
        __syncthreads();
        {
            const f32x4 gh0 = *(const f32x4*)(p.in[11] + 8 * lane), gh1 = *(const f32x4*)(p.in[11] + 8 * lane + 4);
#pragma unroll
            for (int hb = 0; hb < 2; ++hb) {
                u32x4 a[4], bq[4], rv[4], cv[4];
#pragma unroll
                for (int j = 0; j < 4; ++j) { const int tl = wave * 8 + hb * 4 + j; const size_t t = (size_t)tok0 + tl;
                    a[j] = *(const u32x4*)(OF + t * 512 + 8 * lane); bq[j] = *(const u32x4*)(OB + t * 512 + 8 * lane); rv[j] = *(const u32x4*)(Z + t * ZW + 1024 + 8 * lane);
                    cv[j] = *(const LAS u32x4*)(at + tl * 1040 + 16 * lane); }
#pragma unroll
                for (int j = 0; j < 4; ++j) { const size_t t = (size_t)tok0 + wave * 8 + hb * 4 + j;
                    float o[8], r[8];
#pragma unroll
                    for (int e = 0; e < 4; ++e) { o[2 * e] = bflo(a[j][e]) + bflo(bq[j][e]) + bflo(cv[j][e]); o[2 * e + 1] = bfhi(a[j][e]) + bfhi(bq[j][e]) + bfhi(cv[j][e]); r[2 * e] = bflo(rv[j][e]); r[2 * e + 1] = bfhi(rv[j][e]); }
                    float ss = 0.f;
#pragma unroll
                    for (int e = 0; e < 8; ++e) ss += o[e] * o[e];
                    ss += __shfl_xor(ss, 1); ss += __shfl_xor(ss, 2); ss += __shfl_xor(ss, 4); ss += __shfl_xor(ss, 8);
                    const float rstd = rsqrtf(ss * (1.f / 128.f) + EPS);
                    float y[8];
#pragma unroll
                    for (int e = 0; e < 8; ++e) { const float gg = e < 4 ? gh0[e] : gh1[e - 4]; y[e] = o[e] * rstd * gg * (r[e] / (1.f + __expf(-r[e]))); }
                    const u32x4 w = {pk2(y[0], y[1]), pk2(y[2], y[3]), pk2(y[4], y[5]), pk2(y[6], y[7])};
                    *(u32x4*)(MIX + t * D + 8 * lane) = w; }
            }
        }
        __syncthreads();
        {
            const int c = tid, gi = c >> 7, cc = c & 127, hw = 1 << gi;
            LAS unsigned char* ag = at + gi * 16384;
            const LAS bf16_t* pc = pt + c;
            if (s0 >= 8 && s0 + 64 + 8 <= SEQ) {
                const float inv = 0.5f / (float)hw;
                float sum = 0.f;
                for (int rr = 8 - hw; rr < 8 + hw; ++rr) sum += bflo((unsigned)pc[rr * 512]);
#pragma unroll 4
                for (int i = 0; i < 64; ++i) {
                    const float val = sum * inv - bflo((unsigned)pc[(i + 8) * 512]);
                    *(LAS bf16_t*)(ag + i * 256 + (((cc >> 3) ^ (i & 15)) * 16) + (cc & 7) * 2) = (bf16_t)(pk2(val, 0.f) & 0xFFFFu);
                    sum += bflo((unsigned)pc[(i + 8 + hw) * 512]) - bflo((unsigned)pc[(i + 8 - hw) * 512]);
                }
            } else {
                float sum = 0.f;
                {   const int lo = max(s0 - hw, 0), hi = min(s0 + hw, SEQ);
                    for (int rr = lo; rr < hi; ++rr) sum += bflo((unsigned)pc[(rr - s0 + 8) * 512]); }
#pragma unroll 4
                for (int i = 0; i < 64; ++i) {
                    const int sq = s0 + i, lo = max(sq - hw, 0), hi = min(sq + hw, SEQ);
                    const float val = sum * __builtin_amdgcn_rcpf((float)(hi - lo)) - bflo((unsigned)pc[(i + 8) * 512]);
                    *(LAS bf16_t*)(ag + i * 256 + (((cc >> 3) ^ (i & 15)) * 16) + (cc & 7) * 2) = (bf16_t)(pk2(val, 0.f) & 0xFFFFu);
                    if (sq + hw < SEQ) sum += bflo((unsigned)pc[(i + 8 + hw) * 512]);
                    if (sq - hw >= 0) sum -= bflo((unsigned)pc[(i + 8 - hw) * 512]);
                }
            }
        }
        __syncthreads();
        {
            const int gi = wave >> 1, dh = wave & 1;
            LAS unsigned char* ag = at + gi * 16384;
            f32x4 acc[4][4];
#pragma unroll
            for (int mt = 0; mt < 4; ++mt)
#pragma unroll
                for (int nt = 0; nt < 4; ++nt) acc[mt][nt] = (f32x4){0.f, 0.f, 0.f, 0.f};
#pragma unroll
            for (int s = 0; s < 4; ++s) {
                bf16x8 af[4];
#pragma unroll
                for (int mt = 0; mt < 4; ++mt) { const int row = mt * 16 + c15; af[mt] = *(const LAS bf16x8*)(ag + row * 256 + (((4 * s + g) ^ (row & 15)) * 16)); }
#pragma unroll
                for (int nt = 0; nt < 4; ++nt) {
                    const bf16x8 wf = ld_frag16(WP + (size_t)gi * 16384 + (dh * 64 + 16 * nt + c15) * 128 + 32 * s + 8 * g);
#pragma unroll
                    for (int mt = 0; mt < 4; ++mt) acc[mt][nt] = MFMA16(wf, af[mt], acc[mt][nt]);
                }
            }
#pragma unroll
            for (int nt = 0; nt < 4; ++nt) {
                const f32x4 ps = *(const f32x4*)(p.in[13] + gi * 128 + dh * 64 + 16 * nt + 4 * g);
#pragma unroll
                for (int mt = 0; mt < 4; ++mt) {
                    const f32x4 v = acc[mt][nt] * ps;
                    u32x2 w = {pk2(v[0], v[1]), pk2(v[2], v[3])};
                    *(u32x2*)(MIX + ((size_t)tok0 + mt * 16 + c15) * D + 512 + gi * 128 + dh * 64 + 16 * nt + 4 * g) = w;
                }
            }
        }
    }
}

DI void phase4c(const Params& p, LAS unsigned char* lds, int tid, int lane, int wave) {
    asm volatile("" : "+v"(tid), "+v"(lane));
    LAS float* lG = (LAS float*)lds; LAS float* lA = lG + 1024; LAS float* lB = lA + 1024; LAS float* lP = lB + 1024;
    const float* x = p.in[0]; const bf16_t* MIXO = (const bf16_t*)(p.ws + WS_RZ); bf16_t* H2 = (bf16_t*)(p.ws + WS_RA);
    for (int rt = blockIdx.x; rt < T / 128; rt += gridDim.x) {
        const int b = rt / 32;
        __syncthreads();
        for (int d = tid; d < 1024; d += NTH) { lG[d] = mod_at(p, b, 2048 + d); lA[d] = p.in[15][d] * (1.f + mod_at(p, b, 4096 + d)); lB[d] = mod_at(p, b, 3072 + d); lP[d] = p.in[5][d]; }
        __syncthreads();
        for (int r0 = wave; r0 < 128; r0 += 4 * NWV) {
            f32x4 m[4][4], xv[4][4];
#pragma unroll
            for (int u = 0; u < 4; ++u) {
                const size_t row = (size_t)rt * 128 + r0 + u * NWV;
                const u32x2* mr = (const u32x2*)(MIXO + row * D) + lane; const f32x4* xr = (const f32x4*)(x + row * D) + lane;
#pragma unroll
                for (int j = 0; j < 4; ++j) { const u32x2 mv = mr[64 * j]; m[u][j] = (f32x4){bflo(mv.x), bfhi(mv.x), bflo(mv.y), bfhi(mv.y)}; xv[u][j] = xr[64 * j]; }
            }
#pragma unroll
            for (int u = 0; u < 4; ++u) {
                const size_t row = (size_t)rt * 128 + r0 + u * NWV;
                float ss = 0.f;
#pragma unroll
                for (int j = 0; j < 4; ++j) ss += m[u][j][0] * m[u][j][0] + m[u][j][1] * m[u][j][1] + m[u][j][2] * m[u][j][2] + m[u][j][3] * m[u][j][3];
                const float rstd = rsqrtf(wave_sum(ss) * (1.f / D) + EPS);
                float s2 = 0.f;
#pragma unroll
                for (int j = 0; j < 4; ++j) {
                    const f32x4 gt = *(const LAS f32x4*)(lG + 4 * lane + 256 * j), pm = *(const LAS f32x4*)(lP + 4 * lane + 256 * j);
                    xv[u][j] = xv[u][j] + gt * (m[u][j] * rstd * pm);
                    s2 += xv[u][j][0] * xv[u][j][0] + xv[u][j][1] * xv[u][j][1] + xv[u][j][2] * xv[u][j][2] + xv[u][j][3] * xv[u][j][3];
                }
                const float rstd2 = rsqrtf(wave_sum(s2) * (1.f / D) + EPS);
                f32x4* orow = (f32x4*)(p.out + row * D) + lane; u32x2* hrow = (u32x2*)(H2 + row * D) + lane;
#pragma unroll
                for (int j = 0; j < 4; ++j) {
                    orow[64 * j] = xv[u][j];
                    const f32x4 a = *(const LAS f32x4*)(lA + 4 * lane + 256 * j), bb = *(const LAS f32x4*)(lB + 4 * lane + 256 * j);
                    const f32x4 hv = xv[u][j] * rstd2 * a + bb;
                    u32x2 w = {pk2(hv[0], hv[1]), pk2(hv[2], hv[3])};
                    hrow[64 * j] = w;
                }
            }
        }
    }
}

DI int skey(float v, int idx, int mask) { int u = __float_as_int(v); u ^= (u >> 31) & 0x7FFFFFFF; return (u & ~mask) | idx; }
DI float sval(int k, int mask) { int u = k & ~mask; u ^= (u >> 31) & 0x7FFFFFFF; return __int_as_float(u); }
DI void cswap(int& a, int& b) { const int mx = max(a, b), mn = min(a, b); a = mx; b = mn; }
DI void sort16_desc(int (&a)[16]) {
#pragma unroll
    for (int k = 2; k <= 16; k <<= 1) {
#pragma unroll
        for (int j = k >> 1; j > 0; j >>= 1) {
#pragma unroll
            for (int i = 0; i < 16; ++i) {
                const int l = i ^ j;
                if (l > i) { if ((i & k) == 0) cswap(a[i], a[l]); else cswap(a[l], a[i]); }
            }
        }
    }
}
DI void merge16_desc(int (&x)[16], const int (&y)[16]) {
#pragma unroll
    for (int i = 0; i < 16; ++i) x[i] = max(x[i], y[15 - i]);
#pragma unroll
    for (int j = 8; j > 0; j >>= 1) {
#pragma unroll
        for (int i = 0; i < 16; ++i) { const int l = i ^ j; if (l > i) cswap(x[i], x[l]); }
    }
}

DI void phase5b(const Params& p, LAS unsigned char* lds, int tid, int lane, int wave) {
    asm volatile("" : "+v"(tid), "+v"(lane));
    unsigned char* ws = p.ws;
    const bf16_t* Q2 = (const bf16_t*)(ws + WS_RZ);
    const bf16_t* SKB = (const bf16_t*)(ws + WS_SKB);
    int* EIDX = (int*)(ws + WS_RS); float* GATE = (float*)(ws + WS_RS + 16 * MB);
    LAS unsigned char* tab = lds + tid * 32;
    LAS unsigned char* skl = lds + 16384;
    const int c31 = lane & 31, hi = lane >> 5;
    for (int btask = blockIdx.x; btask < 256; btask += gridDim.x) {
        const int h = btask & 7, tgc = btask >> 3;
        __syncthreads();
#pragma unroll
        for (int ps = 0; ps < 8; ++ps) {
            const int idx = tid + NTH * ps, row = idx >> 4, ch = idx & 15;
            const u32x4 v = *(const u32x4*)(SKB + ((size_t)h * 256 + row) * 128 + ch * 8);
            *(LAS u32x4*)(skl + row * 256 + ((ch ^ (row & 15)) * 16)) = v;
        }
        __syncthreads();
      for (int ti = 0; ti < 4; ++ti) {
        const int tg = tgc * 32 + wave * 4 + ti;
        const size_t tok = (size_t)tg * 32 + c31;
        int lst[2][16];
        bf16x8 bq[2][8];
#pragma unroll
        for (int pp = 0; pp < 2; ++pp) {
            const bf16_t* qp = Q2 + tok * 2048 + h * 256 + pp * 128 + 8 * hi;
            asm volatile("" : "+v"(qp));
#pragma unroll
            for (int ks = 0; ks < 8; ++ks) bq[pp][ks] = ld_frag16(qp + 16 * ks);
        }
#pragma unroll
        for (int pp = 0; pp < 2; ++pp) {
            int run[16];
#pragma unroll
            for (int r = 0; r < 16; ++r) run[r] = (int)0x80000000;
#pragma unroll 1
            for (int kt = 0; kt < 4; ++kt) {
                const LAS unsigned char* kb = skl + pp * 32768 + (32 * kt + c31) * 256;
                f32x16 acc;
#pragma unroll
                for (int r = 0; r < 16; ++r) acc[r] = 0.f;
#pragma unroll
                for (int ks = 0; ks < 8; ++ks) acc = MFMA32(*(const LAS bf16x8*)(kb + (((2 * ks + hi) ^ (c31 & 15)) * 16)), bq[pp][ks], acc);
                int cur[16];
#pragma unroll
                for (int r = 0; r < 16; ++r) cur[r] = skey(acc[r], 32 * kt + 8 * (r >> 2) + 4 * hi + (r & 3), 0x7F);
                sort16_desc(cur);
                merge16_desc(run, cur);
            }
            int oth[16];
#pragma unroll
            for (int r = 0; r < 16; ++r) oth[r] = __shfl_xor(run[r], 32);
            merge16_desc(run, oth);
#pragma unroll
            for (int r = 0; r < 16; ++r) lst[pp][r] = run[r];
        }
#pragma unroll
        for (int pp = 0; pp < 2; ++pp) {
            u32x4 w;
#pragma unroll
            for (int q = 0; q < 4; ++q) w[q] = (lst[pp][4 * q] & 0x7F) | ((lst[pp][4 * q + 1] & 0x7F) << 8) | ((lst[pp][4 * q + 2] & 0x7F) << 16) | ((lst[pp][4 * q + 3] & 0x7F) << 24);
            *(LAS u32x4*)(tab + 16 * pp) = w;
        }
        float va[16], vb[16];
#pragma unroll
        for (int r = 0; r < 16; ++r) { va[r] = sval(lst[0][r], 0x7F); vb[r] = sval(lst[1][r], 0x7F); }
        int cand[4][16];
        {
            int cnt = 0;
#pragma unroll
            for (int i = 0; i < 16; ++i)
#pragma unroll
                for (int j = 0; j < 16; ++j)
                    if ((i + 1) * (j + 1) <= 16) { cand[cnt >> 4][cnt & 15] = skey(va[i] + vb[j], (i << 4) | j, 0xFF); ++cnt; }
#pragma unroll
            for (int q = 50; q < 64; ++q) cand[q >> 4][q & 15] = (int)0x80000000;
        }
        sort16_desc(cand[0]); sort16_desc(cand[1]); sort16_desc(cand[2]); sort16_desc(cand[3]);
        merge16_desc(cand[0], cand[1]); merge16_desc(cand[2], cand[3]); merge16_desc(cand[0], cand[2]);
        asm volatile("s_waitcnt lgkmcnt(0)" ::: "memory");
        float sv[16]; int ex[16];
        const float mx = sval(cand[0][0], 0xFF);
        float sum = 0.f;
#pragma unroll
        for (int r = 0; r < 16; ++r) {
            const int ck = cand[0][r];
            const int i1 = tab[(ck >> 4) & 15], i2 = tab[16 + (ck & 15)];
            ex[r] = i1 * 128 + i2;
            sv[r] = __expf(sval(ck, 0xFF) - mx); sum += sv[r];
        }
        const float inv = 1.f / sum;
        int* ep = EIDX + tok * 128 + h * 16 + 8 * hi; float* gp = GATE + tok * 128 + h * 16 + 8 * hi;
        if (hi == 0) {
            *(u32x4*)ep = (u32x4){(unsigned)ex[0], (unsigned)ex[1], (unsigned)ex[2], (unsigned)ex[3]}; *(u32x4*)(ep + 4) = (u32x4){(unsigned)ex[4], (unsigned)ex[5], (unsigned)ex[6], (unsigned)ex[7]};
            *(f32x4*)gp = (f32x4){sv[0] * inv, sv[1] * inv, sv[2] * inv, sv[3] * inv}; *(f32x4*)(gp + 4) = (f32x4){sv[4] * inv, sv[5] * inv, sv[6] * inv, sv[7] * inv};
        } else {
            *(u32x4*)ep = (u32x4){(unsigned)ex[8], (unsigned)ex[9], (unsigned)ex[10], (unsigned)ex[11]}; *(u32x4*)(ep + 4) = (u32x4){(unsigned)ex[12], (unsigned)ex[13], (unsigned)ex[14], (unsigned)ex[15]};
            *(f32x4*)gp = (f32x4){sv[8] * inv, sv[9] * inv, sv[10] * inv, sv[11] * inv}; *(f32x4*)(gp + 4) = (f32x4){sv[12] * inv, sv[13] * inv, sv[14] * inv, sv[15] * inv};
        }
      }
    }
}

template <int K> DI int swz_bcast(int v) { return __builtin_amdgcn_ds_swizzle(v, 0x10 | (K << 5)); }
template <int W> DI int swz_xor(int v) { return __builtin_amdgcn_ds_swizzle(v, 0x1F | (W << 10)); }
template <int K> struct IC { static constexpr int v = K; };
template <int N, int I = 0, class F> DI void static_for(F&& f) { if constexpr (I < N) { f(IC<I>{}); static_for<N, I + 1>(f); } }
DI float row16_sum(float v) {
    v += __builtin_bit_cast(float, __builtin_amdgcn_update_dpp(0, __builtin_bit_cast(int, v), 0xB1, 0xF, 0xF, true));
    v += __builtin_bit_cast(float, __builtin_amdgcn_update_dpp(0, __builtin_bit_cast(int, v), 0x4E, 0xF, 0xF, true));
    v += __builtin_bit_cast(float, __builtin_amdgcn_update_dpp(0, __builtin_bit_cast(int, v), 0x141, 0xF, 0xF, true));
    v += __builtin_bit_cast(float, __builtin_amdgcn_update_dpp(0, __builtin_bit_cast(int, v), 0x140, 0xF, 0xF, true));
    return v;
}
DI void phase6(const Params& p, LAS unsigned char* lds, int tid, int lane, int wave) {
    asm volatile("" : "+v"(tid), "+v"(lane));
    unsigned char* ws = p.ws;
    const bf16_t* H2 = (const bf16_t*)(ws + WS_RA);
    const unsigned char* UQ = ws + WS_UB; const unsigned char* VQ = ws + WS_VB;
    const float* SU = (const float*)(ws + WS_SU); const float* SV = (const float*)(ws + WS_SV);
    const int* EIDX = (const int*)(ws + WS_RS); const float* GATE = (const float*)(ws + WS_RS + 16 * MB);
    LAS float* lG = (LAS float*)lds;
    const int q = lane >> 4, l16 = lane & 15;
    LAS int* le = (LAS int*)(lds + 4096 + wave * 6144) + q * 128;
    LAS float* lg = (LAS float*)(lds + 4096 + wave * 6144 + 2048) + q * 128;
    LAS float* lc = (LAS float*)(lds + 4096 + wave * 6144 + 4096) + q * 128;
    const unsigned qlo = q < 2 ? (0xFFFFu << (16 * q)) : 0u, qhi = q >= 2 ? (0xFFFFu << (16 * (q - 2))) : 0u;
    for (int rt = blockIdx.x; rt < T / 128; rt += gridDim.x) {
        const int b = rt / 32;
        __syncthreads();
        for (int d = tid; d < 1024; d += NTH) lG[d] = mod_at(p, b, 5120 + d) * p.in[16][d];
        __syncthreads();
#pragma unroll 1
        for (int rd = 0; rd < 4; ++rd) {
            __syncthreads();
            const size_t t = (size_t)rt * 128 + wave * 16 + rd * 4 + q;
            {
                int e[8]; float g[8];
#pragma unroll
                for (int r = 0; r < 8; ++r) { e[r] = EIDX[t * 128 + r * 16 + l16]; g[r] = GATE[t * 128 + r * 16 + l16]; }
                unsigned W[4] = {0u, 0u, 0u, 0u};
#pragma unroll
                for (int r = 0; r < 8; ++r) {
                    const int k = e[r] >> 10; const unsigned inc = 1u << (8 * (k & 3)); const int w = k >> 2;
                    W[0] += (w == 0) ? inc : 0u; W[1] += (w == 1) ? inc : 0u; W[2] += (w == 2) ? inc : 0u; W[3] += (w == 3) ? inc : 0u;
                }
                unsigned C[4];
                {
                    unsigned tot[4], exc[4];
#pragma unroll
                    for (int w = 0; w < 4; ++w) {
                        unsigned x = W[w];
                        x += (unsigned)__builtin_amdgcn_update_dpp(0, (int)x, 0x111, 0xF, 0xF, true);
                        x += (unsigned)__builtin_amdgcn_update_dpp(0, (int)x, 0x112, 0xF, 0xF, true);
                        x += (unsigned)__builtin_amdgcn_update_dpp(0, (int)x, 0x114, 0xF, 0xF, true);
                        x += (unsigned)__builtin_amdgcn_update_dpp(0, (int)x, 0x118, 0xF, 0xF, true);
                        exc[w] = x - W[w];
                        tot[w] = (unsigned)swz_bcast<15>((int)x);
                    }
                    unsigned carry = 0u;
#pragma unroll
                    for (int w = 0; w < 4; ++w) {
                        const unsigned P = tot[w] + (tot[w] << 8) + (tot[w] << 16) + (tot[w] << 24);
                        C[w] = (P - tot[w]) + carry * 0x01010101u + exc[w];
                        carry += P >> 24;
                    }
                }
#pragma unroll
                for (int r = 0; r < 8; ++r) {
                    const int k = e[r] >> 10; const int sh = 8 * (k & 3); const int w = k >> 2; const unsigned inc = 1u << sh;
                    const unsigned cw = (w == 0) ? C[0] : (w == 1) ? C[1] : (w == 2) ? C[2] : C[3];
                    const int pos = (int)((cw >> sh) & 0xFFu);
                    le[pos] = e[r]; lg[pos] = g[r];
                    C[0] += (w == 0) ? inc : 0u; C[1] += (w == 1) ? inc : 0u; C[2] += (w == 2) ? inc : 0u; C[3] += (w == 3) ? inc : 0u;
                }
                asm volatile("s_waitcnt lgkmcnt(0)" ::: "memory");
            }
            {
                int hq[16]; float ish;
                {
                    float hv[64]; float hm = 0.f;
#pragma unroll
                    for (int i = 0; i < 4; ++i) {
                        const u32x4 h0 = *(const u32x4*)(H2 + t * D + 256 * i + 16 * l16), h1 = *(const u32x4*)(H2 + t * D + 256 * i + 16 * l16 + 8);
#pragma unroll
                        for (int c = 0; c < 4; ++c) { hv[16 * i + 2 * c] = bflo(h0[c]); hv[16 * i + 2 * c + 1] = bfhi(h0[c]); hv[16 * i + 8 + 2 * c] = bflo(h1[c]); hv[16 * i + 8 + 2 * c + 1] = bfhi(h1[c]); }
                    }
#pragma unroll
                    for (int j = 0; j < 64; ++j) hm = fmaxf(hm, fabsf(hv[j]));
                    hm = fmaxf(hm, __builtin_bit_cast(float, __builtin_amdgcn_update_dpp(0, __builtin_bit_cast(int, hm), 0xB1, 0xF, 0xF, true)));
                    hm = fmaxf(hm, __builtin_bit_cast(float, __builtin_amdgcn_update_dpp(0, __builtin_bit_cast(int, hm), 0x4E, 0xF, 0xF, true)));
                    hm = fmaxf(hm, __builtin_bit_cast(float, __builtin_amdgcn_update_dpp(0, __builtin_bit_cast(int, hm), 0x141, 0xF, 0xF, true)));
                    hm = fmaxf(hm, __builtin_bit_cast(float, __builtin_amdgcn_update_dpp(0, __builtin_bit_cast(int, hm), 0x140, 0xF, 0xF, true)));
                    const float s8 = hm > 1e-30f ? 127.f / hm : 0.f; ish = hm * (1.f / 127.f);
#pragma unroll
                    for (int d = 0; d < 16; ++d) {
                        const int q0 = __float2int_rn(hv[4 * d] * s8), q1 = __float2int_rn(hv[4 * d + 1] * s8), q2 = __float2int_rn(hv[4 * d + 2] * s8), q3 = __float2int_rn(hv[4 * d + 3] * s8);
                        hq[d] = (int)((unsigned)(q0 & 0xFF) | ((unsigned)(q1 & 0xFF) << 8) | ((unsigned)(q2 & 0xFF) << 16) | ((unsigned)q3 << 24));
                    }
                }
                constexpr int UD = 4;
                u32x4 ub[UD][4];
                int evn = le[l16];
                static_for<UD>([&](auto kc) { constexpr int k = decltype(kc)::v; const unsigned char* up = UQ + (size_t)swz_bcast<k>(evn) * 1024 + 16 * l16;
#pragma unroll
                    for (int i = 0; i < 4; ++i) ub[k][i] = *(const u32x4*)(up + 256 * i); });
#pragma unroll 1
                for (int bt = 0; bt < 8; ++bt) {
                    if (bt) __syncthreads();
                    const int ev = evn; const float gv = lg[bt * 16 + l16];
                    evn = le[(bt < 7 ? bt + 1 : 7) * 16 + l16];
                    const float isu = SU[ev] * ish, isv = SV[ev];
                    int part[16];
                    static_for<16>([&](auto kc) {
                        constexpr int k = decltype(kc)::v, sl = k % UD;
                        int a = 0;
#pragma unroll
                        for (int i = 0; i < 4; ++i) {
                            const u32x4 u = ub[sl][i];
#pragma unroll
                            for (int c = 0; c < 4; ++c) a = __builtin_amdgcn_sdot4((int)u[c], hq[4 * i + c], a, false);
                        }
                        part[k] = a;
                        {
                            constexpr int kn = k + UD;
                            int idx; if constexpr (kn < 16) idx = swz_bcast<(kn & 15)>(ev); else idx = swz_bcast<(kn & 15)>(evn);
                            const unsigned char* up = UQ + (size_t)idx * 1024 + 16 * l16;
#pragma unroll
                            for (int i = 0; i < 4; ++i) ub[sl][i] = *(const u32x4*)(up + 256 * i);
                        }
                    });
                    static_for<4>([&](auto sc) {
                        constexpr int w = 8 >> decltype(sc)::v;
                        const bool up2 = (lane & w) != 0;
#pragma unroll
                        for (int e = 0; e < w; ++e) {
                            const int keep = up2 ? part[e + w] : part[e], send = up2 ? part[e] : part[e + w];
                            part[e] = keep + swz_xor<w>(send);
                        }
                    });
                    const float dot = (float)part[0] * isu;
                    lc[bt * 16 + l16] = gv * 0.5f * dot * (1.f + erff(dot * 0.70710678118654752f)) * isv;
                }
                asm volatile("s_waitcnt lgkmcnt(0)" ::: "memory");
            }
            __syncthreads();
            f32x2 y[32];
#pragma unroll
            for (int i = 0; i < 32; ++i) y[i] = (f32x2){0.f, 0.f};
            {
                constexpr int VD = 4;
                u32x4 vbuf[VD][4];
                int evn = le[l16];
                static_for<VD>([&](auto kc) { constexpr int k = decltype(kc)::v; const unsigned char* vp = VQ + (size_t)swz_bcast<k>(evn) * 1024 + 16 * l16;
#pragma unroll
                    for (int i = 0; i < 4; ++i) vbuf[k][i] = *(const u32x4*)(vp + 256 * i); });
#pragma unroll 1
                for (int bt = 0; bt < 8; ++bt) {
                    if (bt) __syncthreads();
                    const int ev = evn; const int cv = __float_as_int(lc[bt * 16 + l16]);
                    evn = le[(bt < 7 ? bt + 1 : 7) * 16 + l16];
                    static_for<16>([&](auto kc) {
                        constexpr int k = decltype(kc)::v, sl = k % VD;
                        const float cc = __int_as_float(swz_bcast<k>(cv));
                        const f32x2 c2 = (f32x2){cc, cc};
#pragma unroll
                        for (int i = 0; i < 4; ++i) {
                            const u32x4 v = vbuf[sl][i];
#pragma unroll
                            for (int c = 0; c < 4; ++c) {
                                const int w = (int)v[c];
                                y[8 * i + 2 * c] = __builtin_elementwise_fma(__builtin_amdgcn_cvt_pk_f32_fp8(w, false), c2, y[8 * i + 2 * c]);
                                y[8 * i + 2 * c + 1] = __builtin_elementwise_fma(__builtin_amdgcn_cvt_pk_f32_fp8(w, true), c2, y[8 * i + 2 * c + 1]);
                            }
                        }
                        {
                            constexpr int kn = k + VD;
                            int idx; if constexpr (kn < 16) idx = swz_bcast<(kn & 15)>(ev); else idx = swz_bcast<(kn & 15)>(evn);
                            const unsigned char* vp = VQ + (size_t)idx * 1024 + 16 * l16;
#pragma unroll
                            for (int i = 0; i < 4; ++i) vbuf[sl][i] = *(const u32x4*)(vp + 256 * i);
                        }
                    });
                }
            }
            float ss = 0.f;
#pragma unroll
            for (int i = 0; i < 32; ++i) ss += y[i].x * y[i].x + y[i].y * y[i].y;
            const float rstd = rsqrtf(row16_sum(ss) * (1.f / D) + EPS);
            float* orow = p.out + t * D;
#pragma unroll
            for (int i = 0; i < 4; ++i)
#pragma unroll
                for (int c = 0; c < 4; ++c) {
                    const int col = 256 * i + 16 * l16 + 4 * c;
                    f32x4 xv = *(const f32x4*)(orow + col);
                    const f32x4 gg = *(const LAS f32x4*)(lG + col);
                    xv[0] += gg[0] * y[8 * i + 2 * c].x * rstd; xv[1] += gg[1] * y[8 * i + 2 * c].y * rstd; xv[2] += gg[2] * y[8 * i + 2 * c + 1].x * rstd; xv[3] += gg[3] * y[8 * i + 2 * c + 1].y * rstd;
                    *(f32x4*)(orow + col) = xv;
                }
        }
    }
}


__global__ void __launch_bounds__(NTH) fwd_megakernel(Params p) {
    extern __shared__ __attribute__((aligned(16))) unsigned char lds_raw[];
    LAS unsigned char* lds = (LAS unsigned char*)lds_raw;
    const int tid = threadIdx.x, lane = tid & 63, wave = __builtin_amdgcn_readfirstlane(tid >> 6);
    volatile LAS unsigned* st = (volatile LAS unsigned*)(lds + LDS_BARW);
    if (tid == 0) { st[0] = 0u; st[1] = 0u; st[2] = 0u; st[3] = 0u; }
    __syncthreads();
    XcdBarrier bar = xcd_barrier_post((unsigned*)(p.ws + WS_CTL), st);
    unsigned char* ws = p.ws;

    phase0(p, lds, tid, lane, wave);
    xcd_barrier(bar);
    phase1(p, lds, tid, lane, wave);
    xcd_barrier(bar);
    { pg8::Gemm g{(const bf16_t*)(ws + WS_RA), (const bf16_t*)(ws + WS_WIN), T, ZW, D}; pg8::StaticOrder S; S.init(T, ZW, (int)gridDim.x, (int)blockIdx.x);
      pg8::EpiB16 e{(bf16_t*)(ws + WS_RZ), ZW}; pg8::gemm_phase<pg8::EpiB16, pg8::StaticOrder, true, true>(lds, g, S, e);
      EpiZ e2{(bf16_t*)(ws + WS_RZ), (float*)(ws + WS_AFB)}; gemm_phase(((const bf16_t*)(ws + WS_RA)), (const bf16_t*)(ws + WS_WIN), T, NIN, D, e2, lds, tid, lane, wave, 16); }
    xcd_barrier(bar);
    phaseGA(p, lds, tid, lane, wave);
    xcd_barrier(bar);
    phaseGB(p, tid);
    xcd_barrier(bar);
    phase4a(p, lds, tid, lane, wave);
    xcd_barrier(bar);
    { pg8::Gemm g{(const bf16_t*)(ws + WS_RA), (const bf16_t*)(ws + WS_WOUT), T, D, D}; pg8::StaticOrder S; S.init(T, D, (int)gridDim.x, (int)blockIdx.x);
      pg8::EpiB16 e{(bf16_t*)(ws + WS_RZ), D}; pg8::gemm_phase<pg8::EpiB16, pg8::StaticOrder, true, true>(lds, g, S, e); }
    xcd_barrier(bar);
    phase4c(p, lds, tid, lane, wave);
    xcd_barrier(bar);
    { pg8::Gemm g{(const bf16_t*)(ws + WS_RA), (const bf16_t*)(ws + WS_WQ), T, 2048, D}; pg8::StaticOrder S; S.init(T, 2048, (int)gridDim.x, (int)blockIdx.x);
      pg8::EpiB16 e{(bf16_t*)(ws + WS_RZ), 2048}; pg8::gemm_phase<pg8::EpiB16, pg8::StaticOrder, true, true>(lds, g, S, e); }
    xcd_barrier(bar);
    phase5b(p, lds, tid, lane, wave);
    xcd_barrier(bar);
    phase6(p, lds, tid, lane, wave);
}

extern "C" void kernel_launch(void* const* d_in, const int* in_sizes, int n_in, void* d_out, int out_size, void* d_ws, size_t ws_size, hipStream_t stream) {
    static int grid = 0;
    if (grid == 0) {
        if (n_in != 21 || out_size != T * D || ws_size < WS_END) { fprintf(stderr, "kernel_launch: unexpected shapes (n_in %d out %d ws %zu need %zu)\n", n_in, out_size, ws_size, (size_t)WS_END); grid = -1; return; }
        int dev = 0, cus = 0, per_cu = 0;
        hipGetDevice(&dev); hipDeviceGetAttribute(&cus, hipDeviceAttributeMultiprocessorCount, dev);
        hipFuncSetAttribute((const void*)fwd_megakernel, hipFuncAttributeMaxDynamicSharedMemorySize, LDS_BYTES);
        hipOccupancyMaxActiveBlocksPerMultiprocessor(&per_cu, (const void*)fwd_megakernel, NTH, LDS_BYTES);
        (void)hipGetLastError();
        if (per_cu < 1) fprintf(stderr, "kernel_launch: occupancy query says %d blocks per CU\n", per_cu);
        grid = cus;
    }
    if (grid < 0) return;
    hipMemsetAsync((char*)d_ws + WS_CTL, 0, 64 * 1024, stream);
    Params p{};
    for (int i = 0; i < 21; ++i) p.in[i] = (const float*)d_in[i];
    p.out = (float*)d_out; p.ws = (unsigned char*)d_ws;
    hipLaunchKernelGGL(fwd_megakernel, dim3(grid), dim3(NTH), LDS_BYTES, stream, p);
}
```

```cpp
#include <hip/hip_runtime.h>
#include <cstdio>
#include <cstdint>

#define DI __device__ __forceinline__
#define LAS __attribute__((address_space(3)))
typedef unsigned short bf16_t;
typedef short bf16x8 __attribute__((ext_vector_type(8)));
typedef float f32x4 __attribute__((ext_vector_type(4)));
typedef float f32x2 __attribute__((ext_vector_type(2)));
typedef float f32x16 __attribute__((ext_vector_type(16)));
typedef unsigned u32x4 __attribute__((ext_vector_type(4)));
typedef unsigned u32x2 __attribute__((ext_vector_type(2)));
typedef __bf16 bf16x2v __attribute__((ext_vector_type(2)));

constexpr int T = 32768, D = 1024, SEQ = 4096, NB = 8;
constexpr int NTH = 512, NWV = 8;
constexpr int ZW = 2048;
constexpr int NIN = 2176;
constexpr float EPS = 1e-6f;

constexpr size_t MB = 1024 * 1024;
constexpr size_t WS_CTL   = 0;
constexpr size_t WS_MODP  = 64 * 1024;
constexpr size_t WS_WIN   = WS_MODP + 8 * 8 * 6144 * 4;
constexpr size_t WS_WOUT  = WS_WIN + (size_t)NIN * 1024 * 2;
constexpr size_t WS_WQ    = WS_WOUT + 1024 * 1024 * 2;
constexpr size_t WS_SKB   = WS_WQ + 2048 * 1024 * 2;
constexpr size_t WS_WP    = WS_SKB + 16 * 128 * 128 * 2;
constexpr size_t WS_AFB   = WS_WP + 4 * 128 * 128 * 2;
constexpr size_t WS_UB    = WS_AFB + (size_t)T * 32 * 4;
constexpr size_t WS_VB    = WS_UB + 32 * MB;
constexpr size_t WS_SU    = WS_UB + 16 * MB, WS_SV = WS_VB + 16 * MB;
constexpr size_t WS_RA    = WS_VB + 32 * MB;
constexpr size_t WS_RZ    = WS_RA + 64 * MB;
constexpr size_t WS_RS    = WS_RZ + 128 * MB;
constexpr size_t WS_RO    = WS_RS + 6 * 16 * MB + 1 * MB;
constexpr size_t WS_END   = WS_RO + 128 * MB;
static_assert(WS_END <= 512 * MB, "workspace too large");

struct Params { const float* in[21]; float* out; unsigned char* ws; };

DI unsigned pk2(float a, float b) { f32x2 f = {a, b}; bf16x2v h = __builtin_convertvector(f, bf16x2v); return __builtin_bit_cast(unsigned, h); }
DI float dot2bf(unsigned a, unsigned b, float c) { return __builtin_amdgcn_fdot2_f32_bf16(__builtin_bit_cast(bf16x2v, a), __builtin_bit_cast(bf16x2v, b), c, false); }
DI float bflo(unsigned u) { return __uint_as_float(u << 16); }
DI float bfhi(unsigned u) { return __uint_as_float(u & 0xFFFF0000u); }
DI float wave_sum(float v) {
#pragma unroll
    for (int o = 1; o < 64; o <<= 1) v += __shfl_xor(v, o);
    return v;
}
DI bf16x8 ld_frag16(const bf16_t* p) { return __builtin_bit_cast(bf16x8, *(const u32x4*)p); }
DI bf16x8 ld_frag_perm(const bf16_t* p, int g) {
    const u32x2 lo = *(const u32x2*)(p + 4 * g), hi = *(const u32x2*)(p + 16 + 4 * g);
    u32x4 v = {lo.x, lo.y, hi.x, hi.y}; return __builtin_bit_cast(bf16x8, v);
}
DI int perm32(int k) { return (k & ~31) | (((k >> 2) & 3) << 3) | (((k >> 4) & 1) << 2) | (k & 3); }
DI bf16x8 pack8(const f32x4& a, const f32x4& b) { u32x4 v = {pk2(a[0], a[1]), pk2(a[2], a[3]), pk2(b[0], b[1]), pk2(b[2], b[3])}; return __builtin_bit_cast(bf16x8, v); }
#define MFMA16(a, b, c) __builtin_amdgcn_mfma_f32_16x16x32_bf16((a), (b), (c), 0, 0, 0)
#define MFMA32(a, b, c) __builtin_amdgcn_mfma_f32_32x32x16_bf16((a), (b), (c), 0, 0, 0)

#define XB_TMO      128
#define XB_XCNT(j)  (256  + 64 * (j))
#define XB_XSUB(j)  (1280 + 64 * (j))
#define XB_XGEN(j)  (2304 + 64 * (j))
#define XB_TOP      3328
#define XB_TOPGEN   3392
#define XCD_BAR_WORDS 3456
#define XB_SPIN_CAP (1u << 22)
DI unsigned xb_ld(unsigned* p)              { return __hip_atomic_load(p, __ATOMIC_RELAXED, __HIP_MEMORY_SCOPE_AGENT); }
DI unsigned xb_add(unsigned* p, unsigned v) { return __hip_atomic_fetch_add(p, v, __ATOMIC_RELAXED, __HIP_MEMORY_SCOPE_AGENT); }
DI unsigned xb_xcc_id() { return (unsigned)__builtin_amdgcn_s_getreg((3 << 11) | 20) & 0xFu; }
#define XB_SPIN(cond, bar) do { unsigned _sp = 0; while (cond) { __builtin_amdgcn_s_sleep(1); \
    if ((++_sp & 255u) == 0u) { if (xb_ld(&(bar)[XB_TMO])) break; if (_sp > XB_SPIN_CAP) { atomicAdd(&(bar)[XB_TMO], 1u); break; } } } } while (0)
struct XcdBarrier { unsigned* bar; unsigned x; volatile LAS unsigned* st; };
DI XcdBarrier xcd_barrier_post(unsigned* bar, volatile LAS unsigned* st) {
    XcdBarrier b; b.bar = bar; b.x = xb_xcc_id(); b.st = st;
    if (threadIdx.x == 0) (void)xb_add(&bar[XB_XCNT(b.x)], 1u);
    return b;
}
DI void xcd_barrier_complete(unsigned* bar, unsigned x, unsigned& nloc, unsigned& nx) {
    const unsigned G = gridDim.x * gridDim.y * gridDim.z;
    unsigned sum, cnt, mine, sp = 0u;
    for (;;) {
        sum = 0u; cnt = 0u; mine = 0u;
#pragma unroll
        for (unsigned j = 0; j < 16; ++j) { const unsigned c = xb_ld(&bar[XB_XCNT(j)]); sum += c; cnt += (c > 0u) ? 1u : 0u; mine = (j == x) ? c : mine; }
        if (sum == G) break;
        __builtin_amdgcn_s_sleep(1);
        if ((++sp & 255u) == 0u) { if (xb_ld(&bar[XB_TMO])) break; if (sp > XB_SPIN_CAP) { atomicAdd(&bar[XB_TMO], 1u); break; } }
    }
    nloc = mine > 0u ? mine : 1u; nx = cnt > 0u ? cnt : 1u;
}
DI void xcd_barrier(const XcdBarrier& b) {
    asm volatile("s_waitcnt vmcnt(0)" ::: "memory");
    __syncthreads();
    if (threadIdx.x == 0) {
        unsigned* bar = b.bar;
        __builtin_amdgcn_s_waitcnt(0);
        unsigned nloc = b.st[0], nx = b.st[1];
        if (nloc == 0u) { xcd_barrier_complete(bar, b.x, nloc, nx); b.st[0] = nloc; b.st[1] = nx; }
        const unsigned old = xb_add(&bar[XB_XSUB(b.x)], 1u);
        const unsigned gen = old / nloc;
        if (old + 1u == (gen + 1u) * nloc) {
            __builtin_amdgcn_fence(__ATOMIC_RELEASE, "agent");
            asm volatile("s_waitcnt vmcnt(0)" ::: "memory");
            const unsigned og = xb_add(&bar[XB_TOP], 1u);
            const unsigned tg = og / nx;
            if (og + 1u == (tg + 1u) * nx) xb_add(&bar[XB_TOPGEN], 1u);
            else XB_SPIN(xb_ld(&bar[XB_TOPGEN]) == tg, bar);
            __builtin_amdgcn_fence(__ATOMIC_ACQUIRE, "agent");
            xb_add(&bar[XB_XGEN(b.x)], 1u);
            asm volatile("s_waitcnt vmcnt(0)" ::: "memory");
        } else {
            XB_SPIN(xb_ld(&bar[XB_XGEN(b.x)]) == gen, bar);
            __builtin_amdgcn_fence(__ATOMIC_ACQUIRE, "agent");
            asm volatile("s_waitcnt vmcnt(0)" ::: "memory");
        }
    }
    __syncthreads();
}

constexpr int LDS_BYTES = 152 * 1024;
constexpr int LDS_BARW = LDS_BYTES - 16;

DI void p0_transpose_item(const float* W, int ldw, int K, bf16_t* WT, int dst_row0, int src_col0, float scale, bool zero, LAS float* scr, int kb, int lane) {
    const int k0 = 64 * kb;
#pragma unroll 8
    for (int i = 0; i < 32; ++i) { const int kk = 2 * i + (lane >> 5); scr[kk * 33 + (lane & 31)] = zero ? 0.f : W[(size_t)(k0 + kk) * ldw + src_col0 + (lane & 31)] * scale; }
    asm volatile("s_waitcnt lgkmcnt(0)" ::: "memory");
    const int c = lane & 7;
#pragma unroll
    for (int j = 0; j < 4; ++j) { const int n = (lane >> 3) + 8 * j; const LAS float* s = scr + (8 * c) * 33 + n;
        u32x4 o; o.x = pk2(s[0 * 33], s[1 * 33]); o.y = pk2(s[2 * 33], s[3 * 33]); o.z = pk2(s[4 * 33], s[5 * 33]); o.w = pk2(s[6 * 33], s[7 * 33]);
        *(u32x4*)(WT + (size_t)(dst_row0 + n) * K + k0 + 8 * c) = o; }
    asm volatile("s_waitcnt lgkmcnt(0)" ::: "memory");
}

DI void phase0(const Params& p, LAS unsigned char* lds, int tid, int lane, int wave) {
    asm volatile("" : "+v"(tid), "+v"(lane));
    unsigned char* ws = p.ws;
    LAS float* sl = (LAS float*)lds;
    LAS float* scr = (LAS float*)(lds + 32768 + wave * 8448);
    const float* c = p.in[1];
    for (int e = tid; e < 8192; e += NTH) { const int b = e >> 10, k = e & 1023; const float v = c[e]; sl[k * 8 + b] = v / (1.f + __expf(-v)); }
    __syncthreads();
    const int gw = wave * gridDim.x + blockIdx.x, NGW = gridDim.x * NWV;
    constexpr int I_MOD = 768, I_WIN = 16 * 68, I_WOUT = 16 * 32, I_WQ = 16 * 64, I_WP = 32;
    constexpr int NITEMS = I_MOD + I_WIN + I_WOUT + I_WQ + I_WP;
    for (int it = gw; it < NITEMS; it += NGW) {
        int r = it;
        if (r < I_MOD) {
            const int cg = r % 96, ks = r / 96, n = cg * 64 + lane, k0 = ks * 128;
            const float* W = p.in[2] + (size_t)k0 * 6144 + n;
            float acc[8];
#pragma unroll
            for (int b = 0; b < 8; ++b) acc[b] = 0.f;
#pragma unroll 8
            for (int k = 0; k < 128; ++k) {
                const float w = W[(size_t)k * 6144];
                const f32x4 s0 = *(const LAS f32x4*)(sl + (k0 + k) * 8), s1 = *(const LAS f32x4*)(sl + (k0 + k) * 8 + 4);
                acc[0] += s0[0] * w; acc[1] += s0[1] * w; acc[2] += s0[2] * w; acc[3] += s0[3] * w;
                acc[4] += s1[0] * w; acc[5] += s1[1] * w; acc[6] += s1[2] * w; acc[7] += s1[3] * w;
            }
            float* mp = (float*)(ws + WS_MODP) + (size_t)ks * 8 * 6144 + n;
#pragma unroll
            for (int b = 0; b < 8; ++b) mp[b * 6144] = acc[b];
            continue;
        }
        r -= I_MOD;
        if (r < I_WIN) {
            const int kb = r / 68, nb = r % 68, n0 = nb * 32;
            int src; bool zero = false; float scale = 1.f;
            if (n0 < 1536) { src = n0; if (n0 < 256) scale = 0.125f; } else if (n0 < 2048) src = n0 + 32; else if (n0 < 2080) src = 1536 + (n0 - 2048); else { src = 0; zero = true; }
            p0_transpose_item(p.in[6], 2080, 1024, (bf16_t*)(ws + WS_WIN), n0, src, scale, zero, scr, kb, lane);
            continue;
        }
        r -= I_WIN;
        if (r < I_WOUT) { p0_transpose_item(p.in[14], 1024, 1024, (bf16_t*)(ws + WS_WOUT), (r % 32) * 32, (r % 32) * 32, 1.f, false, scr, r / 32, lane); continue; }
        r -= I_WOUT;
        if (r < I_WQ) { p0_transpose_item(p.in[17], 2048, 1024, (bf16_t*)(ws + WS_WQ), (r % 64) * 32, (r % 64) * 32, 1.f, false, scr, r / 64, lane); continue; }
        r -= I_WQ;
        { const int g = r >> 3, kb = (r >> 2) & 1, nb = r & 3;
          p0_transpose_item(p.in[12] + g * 16384, 128, 128, (bf16_t*)(ws + WS_WP) + g * 16384, nb * 32, nb * 32, 1.f, false, scr, kb, lane); }
    }
    const size_t gt = (size_t)blockIdx.x * NTH + tid, NGT = (size_t)gridDim.x * NTH;
    constexpr size_t NSK = (size_t)16 * 128 * 128 / 8;
    for (size_t j = gt; j < NSK; j += NGT) {
        const float* src = p.in[18]; bf16_t* dst = (bf16_t*)(ws + WS_SKB);
        const f32x4 a = *(const f32x4*)(src + j * 8), b = *(const f32x4*)(src + j * 8 + 4);
        u32x4 o = {pk2(a[0], a[1]), pk2(a[2], a[3]), pk2(b[0], b[1]), pk2(b[2], b[3])};
        *(u32x4*)(dst + j * 8) = o;
    }
}

DI void quant_load(const Params& p, int row, int lane, f32x4 (&v)[4]) {
    const int tb = row >> 14, e = row & 16383;
    const float* src = (tb ? p.in[20] : p.in[19]) + (size_t)e * D + 16 * lane;
#pragma unroll
    for (int q = 0; q < 4; ++q) v[q] = *(const f32x4*)(src + 4 * q);
}
DI void quant_store(const Params& p, int row, int lane, const f32x4 (&v)[4]) {
    unsigned char* ws = p.ws;
    const int tb = row >> 14, e = row & 16383;
    float m = 0.f;
#pragma unroll
    for (int q = 0; q < 4; ++q) m = fmaxf(m, fmaxf(fmaxf(fabsf(v[q][0]), fabsf(v[q][1])), fmaxf(fabsf(v[q][2]), fabsf(v[q][3]))));
#pragma unroll
    for (int o = 1; o < 64; o <<= 1) m = fmaxf(m, __shfl_xor(m, o));
    int ex = (int)((__float_as_uint(m) >> 23) & 0xFFu) - 127;
    if (m < 1e-30f) ex = 7;
    const float sc = __uint_as_float((unsigned)(127 + 7 - ex) << 23), isc = __uint_as_float((unsigned)(127 - 7 + ex) << 23);
    u32x4 o;
    if (tb) {
#pragma unroll
        for (int q = 0; q < 4; ++q) { int w = 0; w = __builtin_amdgcn_cvt_pk_fp8_f32(v[q][0] * sc, v[q][1] * sc, w, false); w = __builtin_amdgcn_cvt_pk_fp8_f32(v[q][2] * sc, v[q][3] * sc, w, true); o[q] = (unsigned)w; }
        if (lane == 0) ((float*)(ws + WS_SV))[e] = isc;
    } else {
        const float s8 = m > 1e-30f ? 127.f / m : 0.f;
#pragma unroll
        for (int q = 0; q < 4; ++q) {
            const int q0 = __float2int_rn(v[q][0] * s8), q1 = __float2int_rn(v[q][1] * s8), q2 = __float2int_rn(v[q][2] * s8), q3 = __float2int_rn(v[q][3] * s8);
            o[q] = (unsigned)(q0 & 0xFF) | ((unsigned)(q1 & 0xFF) << 8) | ((unsigned)(q2 & 0xFF) << 16) | ((unsigned)q3 << 24);
        }
        if (lane == 0) ((float*)(ws + WS_SU))[e] = m * (1.f / 127.f);
    }
    *(u32x4*)(ws + (tb ? WS_VB : WS_UB) + (size_t)e * 1024 + 16 * lane) = o;
}

DI float mod_at(const Params& p, int b, int n) {
    const float* mp = (const float*)(p.ws + WS_MODP) + (size_t)b * 6144 + n;
    float s = p.in[3][n];
#pragma unroll
    for (int ks = 0; ks < 8; ++ks) s += mp[(size_t)ks * 8 * 6144];
    return s;
}

DI void phase1(const Params& p, LAS unsigned char* lds, int tid, int lane, int wave) {
    asm volatile("" : "+v"(tid), "+v"(lane));
    LAS float* lA = (LAS float*)lds; LAS float* lB = lA + 1024;
    const float* x = p.in[0]; bf16_t* H = (bf16_t*)(p.ws + WS_RA);
    for (int rt = blockIdx.x; rt < T / 128; rt += gridDim.x) {
        const int b = rt / 32;
        __syncthreads();
        for (int d = tid; d < 1024; d += NTH) { lA[d] = p.in[4][d] * (1.f + mod_at(p, b, 1024 + d)); lB[d] = mod_at(p, b, d); }
        __syncthreads();
        for (int r0 = wave; r0 < 128; r0 += 4 * NWV) {
            f32x4 v[4][4];
#pragma unroll
            for (int u = 0; u < 4; ++u) { const f32x4* xr = (const f32x4*)(x + ((size_t)rt * 128 + r0 + u * NWV) * D) + lane;
#pragma unroll
                for (int j = 0; j < 4; ++j) v[u][j] = xr[64 * j]; }
#pragma unroll
            for (int u = 0; u < 4; ++u) {
                const size_t row = (size_t)rt * 128 + r0 + u * NWV;
                float ss = 0.f;
#pragma unroll
                for (int j = 0; j < 4; ++j) ss += v[u][j][0] * v[u][j][0] + v[u][j][1] * v[u][j][1] + v[u][j][2] * v[u][j][2] + v[u][j][3] * v[u][j][3];
                const float rstd = rsqrtf(wave_sum(ss) * (1.f / D) + EPS);
                u32x2* o = (u32x2*)(H + row * D) + lane;
#pragma unroll
                for (int j = 0; j < 4; ++j) {
                    const f32x4 a = *(const LAS f32x4*)(lA + 4 * lane + 256 * j), bb = *(const LAS f32x4*)(lB + 4 * lane + 256 * j);
                    u32x2 w = {pk2(v[u][j][0] * rstd * a[0] + bb[0], v[u][j][1] * rstd * a[1] + bb[1]), pk2(v[u][j][2] * rstd * a[2] + bb[2], v[u][j][3] * rstd * a[3] + bb[3])};
                    o[64 * j] = w;
                }
            }
        }
    }
}

struct EpiZ {
    bf16_t* Z; float* AFB;
    DI void operator()(int m, int n, const f32x4& v) const {
        if (n < ZW) { u32x2 w = {pk2(v[0], v[1]), pk2(v[2], v[3])}; *(u32x2*)(Z + (size_t)m * ZW + n) = w; }
        else if (n < ZW + 32) { *(f32x4*)(AFB + (size_t)m * 32 + (n - ZW)) = v; }
    }
};
struct EpiF32 { float* C; int ldc; DI void operator()(int m, int n, const f32x4& v) const { *(f32x4*)(C + (size_t)m * ldc + n) = v; } };
struct EpiBf16 { bf16_t* C; int ldc; DI void operator()(int m, int n, const f32x4& v) const { u32x2 w = {pk2(v[0], v[1]), pk2(v[2], v[3])}; *(u32x2*)(C + (size_t)m * ldc + n) = w; } };

template <class Epi>
DI void gemm_phase(const bf16_t* A, const bf16_t* Bt, int M, int N, int K, const Epi& epi, LAS unsigned char* lds, int tid, int lane, int wave, int nt_first = 0) {
    constexpr int BM = 256, BN = 128, BK = 64, STAGE = (BM + BN) * 128;
    const int ntn = N / BN - nt_first, ntiles = (M / BM) * ntn, nk = K / BK;
    const int wm = wave & 3, wn = wave >> 2, c15 = lane & 15, g = lane >> 4;
    const int lrow = tid >> 3, lch = tid & 7;
    for (int tile = blockIdx.x; tile < ntiles; tile += gridDim.x) {
        const int m0 = (tile / ntn) * BM, n0 = (tile % ntn + nt_first) * BN;
        f32x4 acc[4][4];
#pragma unroll
        for (int i = 0; i < 4; ++i)
#pragma unroll
            for (int j = 0; j < 4; ++j) acc[i][j] = (f32x4){0.f, 0.f, 0.f, 0.f};
        u32x4 ra[4], rb[2];
        const bf16_t* Ag = A + (size_t)(m0 + lrow) * K + lch * 8;
        const bf16_t* Bg = Bt + (size_t)(n0 + lrow) * K + lch * 8;
        const int woff = lrow * 128 + ((lch ^ (lrow & 7)) * 16);
        __syncthreads();
#pragma unroll
        for (int ps = 0; ps < 4; ++ps) ra[ps] = *(const u32x4*)(Ag + (size_t)(64 * ps) * K);
#pragma unroll
        for (int ps = 0; ps < 2; ++ps) rb[ps] = *(const u32x4*)(Bg + (size_t)(64 * ps) * K);
#pragma unroll
        for (int ps = 0; ps < 4; ++ps) *(LAS u32x4*)(lds + woff + ps * 8192) = ra[ps];
#pragma unroll
        for (int ps = 0; ps < 2; ++ps) *(LAS u32x4*)(lds + BM * 128 + woff + ps * 8192) = rb[ps];
        __syncthreads();
        for (int kt = 0; kt < nk; ++kt) {
            const bool more = (kt + 1 < nk);
            if (more) {
#pragma unroll
                for (int ps = 0; ps < 4; ++ps) ra[ps] = *(const u32x4*)(Ag + (size_t)(64 * ps) * K + (kt + 1) * BK);
#pragma unroll
                for (int ps = 0; ps < 2; ++ps) rb[ps] = *(const u32x4*)(Bg + (size_t)(64 * ps) * K + (kt + 1) * BK);
            }
            LAS unsigned char* sa = lds + (kt & 1) * STAGE; LAS unsigned char* sb = sa + BM * 128;
#pragma unroll
            for (int s = 0; s < 2; ++s) {
                bf16x8 fa[4], fb[4];
#pragma unroll
                for (int i = 0; i < 4; ++i) { const int row = wm * 64 + i * 16 + c15; fa[i] = *(const LAS bf16x8*)(sa + row * 128 + (((4 * s + g) ^ (row & 7)) * 16)); }
#pragma unroll
                for (int j = 0; j < 4; ++j) { const int row = wn * 64 + j * 16 + c15; fb[j] = *(const LAS bf16x8*)(sb + row * 128 + (((4 * s + g) ^ (row & 7)) * 16)); }
#pragma unroll
                for (int i = 0; i < 4; ++i)
#pragma unroll
                    for (int j = 0; j < 4; ++j) acc[i][j] = MFMA16(fb[j], fa[i], acc[i][j]);
            }
            if (more) {
                LAS unsigned char* da = lds + ((kt + 1) & 1) * STAGE;
#pragma unroll
                for (int ps = 0; ps < 4; ++ps) *(LAS u32x4*)(da + woff + ps * 8192) = ra[ps];
#pragma unroll
                for (int ps = 0; ps < 2; ++ps) *(LAS u32x4*)(da + BM * 128 + woff + ps * 8192) = rb[ps];
            }
            __syncthreads();
        }
#pragma unroll
        for (int i = 0; i < 4; ++i)
#pragma unroll
            for (int j = 0; j < 4; ++j) epi(m0 + wm * 64 + i * 16 + c15, n0 + wn * 64 + j * 16 + 4 * g, acc[i][j]);
    }
}

namespace pg8 {
#define PG8_LAS __attribute__((address_space(3)))
constexpr int BM = 256, BK = 64, HALF = 128, HTB = HALF * BK * 2  , STAGE_BYTES = 8 * HTB, NXCD = 8, WGM = 8;

__host__ __device__ __forceinline__ int lds_byte(int r, int c) { const int st = (r >> 4) * 2 + (c >> 5), rr = r & 15, cc = c & 31, ob = rr * 64 + cc * 2; return st * 1024 + (ob ^ (((ob >> 9) & 1) << 5)); }
__host__ __device__ __forceinline__ void stage_rc(int b, int& R, int& C) { const int st = b / 1024, sb = b % 1024, swz = sb ^ (((sb >> 9) & 1) << 5); R = (st >> 1) * 16 + swz / 64; C = (st & 1) * 32 + (swz % 64) / 2; }
__host__ __device__ __forceinline__ int perm32(int rho) { const int n = rho >> 4, i = rho & 15; return 8 * (i >> 2) + 4 * n + (i & 3); }

struct Unit { int pm, pn; };
struct Gemm { const bf16_t* A; const bf16_t* Bt; int M, N, K; };

struct StaticOrder {
    int nM, nN, nwg, G, c;
    __host__ __device__ void init(int M, int N, int G_, int c_) { nM = M / BM; nN = N / BM; nwg = nM * nN; G = G_; c = c_; }
    __host__ __device__ bool next(int i, Unit& u) const {
        const long L = (long)i * G + c; if (L >= nwg) return false;
        int wgid = (int)L; { const int q = nwg / NXCD, r = nwg % NXCD, xcd = wgid % NXCD, off = wgid / NXCD; wgid = (xcd < r ? xcd * (q + 1) : r * (q + 1) + (xcd - r) * q) + off; }
        const int nig = WGM * nN, gid = wgid / nig, fm = gid * WGM, gsz = (nM - fm) < WGM ? (nM - fm) : WGM;
        u.pm = fm + ((wgid % nig) % gsz); u.pn = (wgid % nig) / gsz; return true;
    }
    __device__ __forceinline__ void a_ready(const Unit&) const {}
    __device__ __forceinline__ void done(const Unit&) const {}
};

struct EpiB16 {
    static constexpr bool PERM = true, AFTER_DRAIN = false;
    bf16_t* O; int ldc;
    __device__ __forceinline__ void operator()(const f32x4 (&acc)[2][2][4][2], const Unit& u, int wr, int wc, int fr, int fq) const {
#pragma unroll
        for (int ai = 0; ai < 2; ++ai)
#pragma unroll
            for (int m = 0; m < 4; ++m) { bf16_t* rowp = O + (size_t)(u.pm * BM + ai * HALF + wr * 64 + m * 16 + fr) * ldc + u.pn * BM + wc * 32 + 8 * fq;
#pragma unroll
                for (int bj = 0; bj < 2; ++bj) { const f32x4 v0 = acc[ai][bj][m][0], v1 = acc[ai][bj][m][1];
                    u32x4 w; w.x = ::pk2(v0[0], v0[1]); w.y = ::pk2(v0[2], v0[3]); w.z = ::pk2(v1[0], v1[1]); w.w = ::pk2(v1[2], v1[3]);
                    *(u32x4*)(rowp + bj * HALF) = w; } }
    }
};
struct EpiF {
    static constexpr bool PERM = false, AFTER_DRAIN = false;
    float* O; int ldc;
    __device__ __forceinline__ void operator()(const f32x4 (&acc)[2][2][4][2], const Unit& u, int wr, int wc, int fr, int fq) const {
#pragma unroll
        for (int ai = 0; ai < 2; ++ai)
#pragma unroll
            for (int m = 0; m < 4; ++m) { float* rowp = O + (size_t)(u.pm * BM + ai * HALF + wr * 64 + m * 16 + fr) * ldc + u.pn * BM + wc * 32 + 4 * fq;
#pragma unroll
                for (int bj = 0; bj < 2; ++bj)
#pragma unroll
                    for (int n = 0; n < 2; ++n) *(f32x4*)(rowp + bj * HALF + 16 * n) = acc[ai][bj][m][n]; }
    }
};
template <class Epi, class Sched, bool ALIGN_EPI = false, bool SP2 = false>
__device__ __forceinline__ void gemm_phase(PG8_LAS unsigned char* lds, const Gemm g, const Sched& S, const Epi& E) {
    int tid = threadIdx.x; asm volatile("" : "+v"(tid));
    const int wid = __builtin_amdgcn_readfirstlane(tid >> 6), lane = tid & 63, wr = wid >> 2, wc = wid & 3, fr = lane & 15, fq = lane >> 4;
    const int K = g.K, nt = K / BK;
    unsigned voffA[2], voffB[2];
#pragma unroll
    for (int i = 0; i < 2; ++i) { int R, C; stage_rc(tid * 16 + i * 8192, R, C); const int Rb = Epi::PERM ? ((R & ~31) + perm32(R & 31)) : R;
        voffA[i] = (unsigned)(R * K + C) * 2u; voffB[i] = (unsigned)(Rb * K + C) * 2u; }
    const size_t kstep = (size_t)(BK * 2);
    const size_t hstep = (size_t)HALF * K * 2;
    const size_t tstep = 2 * hstep;
    const unsigned ldsw = (unsigned)wid * 1024u;
    const int aoff = lds_byte(wr * 64 + fr, fq * 8), boff = lds_byte(wc * 32 + fr, fq * 8);
#define PG8_SA(b, h) (((b) * 2 + (h)) * HTB)
#define PG8_SB(b, h) ((4 + (b) * 2 + (h)) * HTB)
#define PG8_STAGE(bufoff, gbase, voff) do { _Pragma("unroll") for (int _i = 0; _i < 2; ++_i) \
        __builtin_amdgcn_global_load_lds((const unsigned*)((const char*)(gbase) + (voff)[_i]), (PG8_LAS unsigned*)(lds + (bufoff) + ldsw + _i * 8192), 16, 0, 0); } while (0)
#define PG8_LDA(dst, b, h) do { _Pragma("unroll") for (int m = 0; m < 4; ++m) _Pragma("unroll") for (int k = 0; k < 2; ++k) dst[m][k] = *(const PG8_LAS bf16x8*)(lds + PG8_SA(b, h) + aoff + m * 2048 + k * 1024); } while (0)
#define PG8_LDB(dst, b, h) do { _Pragma("unroll") for (int n = 0; n < 2; ++n) _Pragma("unroll") for (int k = 0; k < 2; ++k) dst[n][k] = *(const PG8_LAS bf16x8*)(lds + PG8_SB(b, h) + boff + n * 2048 + k * 1024); } while (0)
#define PG8_MMA(ai, bj, At, Bt) do { __builtin_amdgcn_s_setprio(1); _Pragma("unroll") for (int m = 0; m < 4; ++m) _Pragma("unroll") for (int n = 0; n < 2; ++n) _Pragma("unroll") for (int k = 0; k < 2; ++k) \
        acc[ai][bj][m][n] = __builtin_amdgcn_mfma_f32_16x16x32_bf16(Bt[n][k], At[m][k], acc[ai][bj][m][n], 0, 0, 0); __builtin_amdgcn_s_setprio(0); } while (0)
#define PG8_WAIT_V(n) asm volatile("s_waitcnt vmcnt(" #n ")" ::: "memory")
#define PG8_WAIT_L(n) asm volatile("s_waitcnt lgkmcnt(" #n ")" ::: "memory")
#define PG8_BAR __builtin_amdgcn_s_barrier()
#define PG8_SCHED __builtin_amdgcn_sched_barrier(0)
    Unit cur, nxt; int ui = 0;
    if (!S.next(0, cur)) return;
    f32x4 acc[2][2][4][2];
#pragma unroll
    for (int a = 0; a < 2; ++a)
#pragma unroll
        for (int b = 0; b < 2; ++b)
#pragma unroll
            for (int m = 0; m < 4; ++m)
#pragma unroll
                for (int n = 0; n < 2; ++n) acc[a][b][m][n] = (f32x4){0.f, 0.f, 0.f, 0.f};
    bf16x8 At[4][2], B0[2][2], B1[2][2];
    const char* cA = (const char*)g.A + (size_t)cur.pm * tstep; const char* cB = (const char*)g.Bt + (size_t)cur.pn * tstep;
    S.a_ready(cur);
    if constexpr (SP2) {
        PG8_STAGE(PG8_SB(0, 0), cB, voffB); PG8_STAGE(PG8_SB(0, 1), cB + hstep, voffB); PG8_STAGE(PG8_SA(0, 0), cA, voffA); PG8_STAGE(PG8_SA(0, 1), cA + hstep, voffA);
        if (wr == 1) PG8_BAR;
        PG8_WAIT_V(2); PG8_BAR;
        PG8_STAGE(PG8_SB(1, 0), cB + kstep, voffB); PG8_STAGE(PG8_SA(1, 0), cA + kstep, voffA); PG8_STAGE(PG8_SB(1, 1), cB + hstep + kstep, voffB);
        PG8_WAIT_V(6); PG8_BAR;
    } else {
        PG8_STAGE(PG8_SB(0, 0), cB, voffB); PG8_STAGE(PG8_SA(0, 0), cA, voffA); PG8_STAGE(PG8_SB(0, 1), cB + hstep, voffB); PG8_STAGE(PG8_SA(0, 1), cA + hstep, voffA);
        if (wr == 1) PG8_BAR;
        PG8_WAIT_V(4); PG8_BAR;
        PG8_STAGE(PG8_SB(1, 0), cB + kstep, voffB); PG8_STAGE(PG8_SA(1, 0), cA + kstep, voffA); PG8_STAGE(PG8_SB(1, 1), cB + hstep + kstep, voffB);
        PG8_WAIT_V(6); PG8_BAR;
    }
    for (;;) {
        const bool has_next = S.next(ui + 1, nxt);
        const char* nA = has_next ? (const char*)g.A + (size_t)nxt.pm * tstep : cA; const char* nB = has_next ? (const char*)g.Bt + (size_t)nxt.pn * tstep : cB;
        for (int t = 0; t < nt; t += 2) {
            const bool last = (t == nt - 2);
            const char* a1 = cA + (size_t)(t + 1) * kstep;
            const char* a2 = last ? nA : cA + (size_t)(t + 2) * kstep; const char* b2 = last ? nB : cB + (size_t)(t + 2) * kstep;
            const char* a3 = a2 + kstep; const char* b3 = b2 + kstep;
            if (last && has_next) S.a_ready(nxt);
            if constexpr (SP2) {
            PG8_LDB(B0, 0, 0); PG8_LDB(B1, 0, 1); PG8_SCHED; PG8_LDA(At, 0, 0); PG8_STAGE(PG8_SA(1, 1), a1 + hstep, voffA);
            PG8_WAIT_V(8); PG8_WAIT_L(0); PG8_BAR; PG8_MMA(0, 0, At, B0); PG8_MMA(0, 1, At, B1); PG8_BAR; PG8_SCHED;
            PG8_LDA(At, 0, 1); PG8_STAGE(PG8_SB(0, 0), b2, voffB); PG8_STAGE(PG8_SB(0, 1), b2 + hstep, voffB); PG8_STAGE(PG8_SA(0, 0), a2, voffA);
            PG8_WAIT_V(8); PG8_WAIT_L(0); PG8_BAR; PG8_MMA(1, 0, At, B0); PG8_MMA(1, 1, At, B1); PG8_BAR; PG8_SCHED;
            PG8_LDB(B0, 1, 0); PG8_LDB(B1, 1, 1); PG8_SCHED; PG8_LDA(At, 1, 0); PG8_STAGE(PG8_SA(0, 1), a2 + hstep, voffA);
            PG8_WAIT_V(8); PG8_WAIT_L(0); PG8_BAR; PG8_MMA(0, 0, At, B0); PG8_MMA(0, 1, At, B1); PG8_BAR; PG8_SCHED;
            PG8_LDA(At, 1, 1); PG8_STAGE(PG8_SB(1, 0), b3, voffB); PG8_STAGE(PG8_SB(1, 1), b3 + hstep, voffB); PG8_STAGE(PG8_SA(1, 0), a3, voffA);
            PG8_WAIT_V(8); PG8_WAIT_L(0); PG8_BAR; PG8_MMA(1, 0, At, B0); PG8_MMA(1, 1, At, B1); PG8_BAR; PG8_SCHED;
            } else {
            PG8_LDB(B0, 0, 0); PG8_SCHED; PG8_LDA(At, 0, 0); PG8_STAGE(PG8_SA(1, 1), a1 + hstep, voffA);
            PG8_WAIT_L(8); PG8_BAR; PG8_WAIT_L(0); PG8_MMA(0, 0, At, B0); PG8_BAR; PG8_SCHED;
            PG8_LDB(B1, 0, 1); PG8_STAGE(PG8_SB(0, 0), b2, voffB);
            PG8_BAR; PG8_WAIT_L(0); PG8_MMA(0, 1, At, B1); PG8_BAR;
            PG8_LDA(At, 0, 1); PG8_STAGE(PG8_SA(0, 0), a2, voffA);
            PG8_BAR; PG8_WAIT_L(0); PG8_MMA(1, 0, At, B0); PG8_BAR; PG8_SCHED;
            PG8_STAGE(PG8_SB(0, 1), b2 + hstep, voffB);
            PG8_WAIT_V(6); PG8_BAR; PG8_MMA(1, 1, At, B1); PG8_BAR;
            PG8_LDB(B0, 1, 0); PG8_SCHED; PG8_LDA(At, 1, 0); PG8_STAGE(PG8_SA(0, 1), a2 + hstep, voffA);
            PG8_WAIT_L(8); PG8_BAR; PG8_WAIT_L(0); PG8_MMA(0, 0, At, B0); PG8_BAR; PG8_SCHED;
            PG8_LDB(B1, 1, 1); PG8_STAGE(PG8_SB(1, 0), b3, voffB);
            PG8_BAR; PG8_WAIT_L(0); PG8_MMA(0, 1, At, B1); PG8_BAR;
            PG8_LDA(At, 1, 1); PG8_STAGE(PG8_SA(1, 0), a3, voffA);
            PG8_BAR; PG8_WAIT_L(0); PG8_MMA(1, 0, At, B0); PG8_BAR; PG8_SCHED;
            PG8_STAGE(PG8_SB(1, 1), b3 + hstep, voffB);
            PG8_WAIT_V(6); PG8_BAR; PG8_MMA(1, 1, At, B1); PG8_BAR;
            }
        }
        if constexpr (ALIGN_EPI) { if (wr == 0) PG8_BAR; }
        if constexpr (!Epi::AFTER_DRAIN) { E(acc, cur, wr, wc, fr, fq); S.done(cur); }
        if (!has_next) break;
#pragma unroll
        for (int a = 0; a < 2; ++a)
#pragma unroll
            for (int b = 0; b < 2; ++b)
#pragma unroll
                for (int m = 0; m < 4; ++m)
#pragma unroll
                    for (int n = 0; n < 2; ++n) acc[a][b][m][n] = (f32x4){0.f, 0.f, 0.f, 0.f};
        cur = nxt; cA = nA; cB = nB; ++ui;
        if constexpr (ALIGN_EPI) { if (wr == 1) PG8_BAR; }
    }
    PG8_WAIT_V(0);
    if constexpr (!ALIGN_EPI) { if (wr == 0) PG8_BAR; }
    PG8_BAR;
    if constexpr (Epi::AFTER_DRAIN) { E.fused(acc, cur, wr, wc, fr, fq, lds, wid, lane); S.done(cur); }
#undef PG8_SA
#undef PG8_SB
#undef PG8_STAGE
#undef PG8_LDA
#undef PG8_LDB
#undef PG8_MMA
#undef PG8_WAIT_V
#undef PG8_WAIT_L
#undef PG8_BAR
#undef PG8_SCHED
}
}

constexpr size_t WS_QDC  = WS_RS;
constexpr size_t WS_SEGS = WS_RS + 32 * MB;
constexpr size_t WS_GSEG = WS_RS + 48 * MB;
constexpr size_t WS_SC   = WS_RS + 49 * MB;
DI void lds_barrier() { asm volatile("s_waitcnt lgkmcnt(0)" ::: "memory"); __builtin_amdgcn_s_barrier(); asm volatile("" ::: "memory"); }
DI float logsig(float x) { return fminf(x, 0.f) - __logf(1.f + __expf(-fabsf(x))); }

template <int DIR>
DI void ga_task(const Params& p, LAS unsigned char* lds, int tid, int lane, int wave, int task) {
    asm volatile("" : "+v"(tid), "+v"(lane));
    unsigned char* ws = p.ws;
    const bf16_t* Z = (const bf16_t*)(ws + WS_RZ);
    const float* AFB = (const float*)(ws + WS_AFB);
    LAS float* la = (LAS float*)lds;
    LAS float* part = (LAS float*)(lds + 17408);
    LAS float* gs = (LAS float*)(lds + 18432);
    LAS float* elb = (LAS float*)(lds + 18944);
    LAS float* wl = (LAS float*)(lds + 19968);
    LAS bf16_t* sL  = (LAS bf16_t*)(lds + 24064);
    LAS unsigned char* obuf = lds + 42496;
    const int c15 = lane & 15, g = lane >> 4;
    const int i = tid >> 3, dg = tid & 7, d0 = dg * 8;
#define TROW(r) ((r) * 72 + ((r) >> 3) * 8)
    constexpr int dir = DIR; const int h = (task >> 1) & 3, pb = (task >> 3) & 7, b = task >> 6;
    const int bhd = b * 8 + h * 2 + dir, sg = dir ? 7 - pb : pb;
    bf16_t* QDC = (bf16_t*)(ws + WS_QDC + (dir ? 16 : 0) * MB);
    bf16_t* OL = (bf16_t*)(ws + WS_RO + (dir ? 64 : 0) * MB);
    f32x4 S[4];
#pragma unroll
    for (int kt = 0; kt < 4; ++kt) S[kt] = (f32x4){0.f, 0.f, 0.f, 0.f};
    __syncthreads();
    for (int e = tid; e < 128 * 72 / 2; e += NTH) ((LAS unsigned*)sL)[e] = 0u;
    if (tid < 64) gs[tid] = 0.f;
    for (int e = tid; e < 1024; e += NTH) wl[e] = (dir ? p.in[9] : p.in[7])[(e >> 6) * 256 + h * 64 + (e & 63)];
    typedef short s16x4w __attribute__((ext_vector_type(4)));
    s16x4w wfr[2]; float bias[2];
    __syncthreads();
#pragma unroll
    for (int u = 0; u < 2; ++u) {
        const int d = 16 * (2 * (wave >> 2) + u) + c15;
        const u32x2 wp = {pk2(wl[(4 * g) * 64 + d], wl[(4 * g + 1) * 64 + d]), pk2(wl[(4 * g + 2) * 64 + d], wl[(4 * g + 3) * 64 + d])};
        wfr[u] = __builtin_bit_cast(s16x4w, wp);
        bias[u] = (dir ? p.in[10] : p.in[8])[h * 64 + d];
    }
    const int mt = wave & 3;
    f32x4 avn;
    { const int n0 = dir ? pb * 8 + 7 : pb * 8; avn = *(const f32x4*)(AFB + ((size_t)b * SEQ + n0 * 64 + 16 * mt + c15) * 32 + dir * 16 + 4 * g); }
#pragma unroll 1
    for (int ci = -1; ci < 8; ++ci) {
        const bool has_cur = ci >= 0, has_nxt = ci < 7;
        const int cx = ci + 1;
        const int nx = dir ? pb * 8 + 7 - cx : pb * 8 + cx, tokx = b * SEQ + nx * 64;
        const int nc = dir ? pb * 8 + 7 - ci : pb * 8 + ci, tokc = b * SEQ + nc * 64;
        LAS unsigned char* bx = obuf + (cx & 1) * 46464; LAS unsigned char* bc = obuf + (ci & 1) * 46464;
        LAS float* elx = elb + (cx & 1) * 128; LAS float* elc = elb + (ci & 1) * 128;
        u32x4 qv, kv, vvp[2]; f32x4 qa[4]; float lv[2][4];
        const int qrow = (task * 8 + (has_cur ? ci : 0)) * NWV + wave;
        if (ci > 0) {
#pragma unroll
            for (int kt = 0; kt < 4; ++kt) { const u32x2 w = {pk2(S[kt][0], S[kt][1]), pk2(S[kt][2], S[kt][3])}; *(LAS u32x2*)(sL + (16 * wave + c15) * 72 + 16 * kt + 4 * g) = w; }
        }
        if (has_cur) quant_load(p, qrow, lane, qa);
        if (has_nxt) {
            const size_t t = (size_t)tokx + i;
            qv = *(const u32x4*)(Z + t * ZW + h * 64 + d0); kv = *(const u32x4*)(Z + t * ZW + 256 + h * 64 + d0);
#pragma unroll
            for (int ps = 0; ps < 2; ++ps) { const int idx = tid + NTH * ps, vi = idx >> 4, ch = idx & 15; vvp[ps] = *(const u32x4*)(Z + ((size_t)tokx + vi) * ZW + 512 + h * 128 + ch * 8); }
            typedef short s16x4v __attribute__((ext_vector_type(4)));
            const u32x2 ap = {pk2(avn[0], avn[1]), pk2(avn[2], avn[3])};
            const s16x4v af = __builtin_bit_cast(s16x4v, ap);
            { const int c2 = cx < 7 ? cx + 1 : cx, n2 = dir ? pb * 8 + 7 - c2 : pb * 8 + c2; avn = *(const f32x4*)(AFB + ((size_t)b * SEQ + n2 * 64 + 16 * mt + c15) * 32 + dir * 16 + 4 * g); }
#pragma unroll
            for (int u = 0; u < 2; ++u) {
                const int d = 16 * (2 * (wave >> 2) + u) + c15;
                const f32x4 x = __builtin_amdgcn_mfma_f32_16x16x16bf16_1k(af, wfr[u], (f32x4){0.f, 0.f, 0.f, 0.f}, 0, 0, 0);
                float v0 = logsig(x[0] + bias[u]) * 0.0625f, v1 = logsig(x[1] + bias[u]) * 0.0625f, v2 = logsig(x[2] + bias[u]) * 0.0625f, v3 = logsig(x[3] + bias[u]) * 0.0625f;
                float T, T2, T3;
                if (dir == 0) {
                    v1 += v0; v2 += v1; v3 += v2; T = v3;
                    const float t1 = __shfl_up(T, 16); T2 = T + (g >= 1 ? t1 : 0.f);
                    const float t2 = __shfl_up(T2, 32); T3 = T2 + (g >= 2 ? t2 : 0.f);
                    if (g == 3) part[mt * 64 + d] = T3;
                } else {
                    v2 += v3; v1 += v2; v0 += v1; T = v0;
                    const float t1 = __shfl_down(T, 16); T2 = T + (g <= 2 ? t1 : 0.f);
                    const float t2 = __shfl_down(T2, 32); T3 = T2 + (g <= 1 ? t2 : 0.f);
                    if (g == 0) part[mt * 64 + d] = T3;
                }
                const float off = T3 - T;
                lv[u][0] = v0 + off; lv[u][1] = v1 + off; lv[u][2] = v2 + off; lv[u][3] = v3 + off;
            }
        }
        lds_barrier();
        if (has_nxt) {
#pragma unroll
            for (int u = 0; u < 2; ++u) {
                const int d = 16 * (2 * (wave >> 2) + u) + c15;
                float off = 0.f;
#pragma unroll
                for (int m2 = 0; m2 < 4; ++m2) { const bool take = dir ? (m2 > mt) : (m2 < mt); off += take ? part[m2 * 64 + d] : 0.f; }
#pragma unroll
                for (int r = 0; r < 4; ++r) la[(16 * mt + 4 * g + r) * 68 + d] = lv[u][r] + off;
                if (mt == (dir ? 0 : 3) && g == (dir ? 0 : 3)) {
                    const float tot = lv[u][dir ? 0 : 3] + off, gsum = gs[(cx & 1) * 64 + d];
                    elx[d] = __expf(tot); elx[64 + d] = __expf(gsum); gs[((cx + 1) & 1) * 64 + d] = gsum + tot;
                }
            }
        }
        lds_barrier();
        if (has_nxt) {
            LAS bf16_t* qdL = (LAS bf16_t*)bx; LAS bf16_t* kiL = (LAS bf16_t*)(bx + 9216); LAS bf16_t* keT = (LAS bf16_t*)(bx + 18432); LAS bf16_t* vT = (LAS bf16_t*)(bx + 27776);
            const size_t t = (size_t)tokx + i;
            float q[8], k[8];
#pragma unroll
            for (int e = 0; e < 4; ++e) { q[2 * e] = bflo(qv[e]); q[2 * e + 1] = bfhi(qv[e]); k[2 * e] = bflo(kv[e]); k[2 * e + 1] = bfhi(kv[e]); }
            float qd[8], ki[8], ke[8], qc[8];
#pragma unroll
            for (int e = 0; e < 8; ++e) {
                const float E = __expf(la[i * 68 + d0 + e]), R = __builtin_amdgcn_rcpf(E);
                qd[e] = q[e] * E; ki[e] = k[e] * R; ke[e] = ki[e] * elx[d0 + e]; qc[e] = qd[e] * elx[64 + d0 + e];
            }
            const u32x4 o1 = {pk2(qd[0], qd[1]), pk2(qd[2], qd[3]), pk2(qd[4], qd[5]), pk2(qd[6], qd[7])};
            const u32x4 o2 = {pk2(ki[0], ki[1]), pk2(ki[2], ki[3]), pk2(ki[4], ki[5]), pk2(ki[6], ki[7])};
            const u32x4 o3 = {pk2(qc[0], qc[1]), pk2(qc[2], qc[3]), pk2(qc[4], qc[5]), pk2(qc[6], qc[7])};
            *(LAS u32x4*)(qdL + i * 72 + d0) = o1; *(LAS u32x4*)(kiL + i * 72 + d0) = o2;
            *(u32x4*)(QDC + t * 256 + h * 64 + d0) = o3;
#pragma unroll
            for (int e = 0; e < 4; ++e) { const unsigned w = pk2(ke[2 * e], ke[2 * e + 1]); keT[TROW(d0 + 2 * e) + perm32(i)] = (bf16_t)(w & 0xFFFFu); keT[TROW(d0 + 2 * e + 1) + perm32(i)] = (bf16_t)(w >> 16); }
#pragma unroll
            for (int ps = 0; ps < 2; ++ps) {
                const int idx = tid + NTH * ps, vi = idx >> 4, ch = idx & 15;
#pragma unroll
                for (int e = 0; e < 4; ++e) { vT[TROW(ch * 8 + 2 * e) + perm32(vi)] = (bf16_t)(vvp[ps][e] & 0xFFFFu); vT[TROW(ch * 8 + 2 * e + 1) + perm32(vi)] = (bf16_t)(vvp[ps][e] >> 16); }
            }
        }
        if (has_cur) {
            const LAS bf16_t* qdL = (const LAS bf16_t*)bc; const LAS bf16_t* kiL = (const LAS bf16_t*)(bc + 9216); const LAS bf16_t* keT = (const LAS bf16_t*)(bc + 18432); const LAS bf16_t* vT = (const LAS bf16_t*)(bc + 27776);
            const int it = wave & 3, dvh = wave >> 2;
            bf16x8 qdb[2];
#pragma unroll
            for (int s = 0; s < 2; ++s) qdb[s] = *(const LAS bf16x8*)(qdL + (16 * it + c15) * 72 + 32 * s + 8 * g);
            f32x4 sc[4];
#pragma unroll
            for (int jt = 0; jt < 4; ++jt) {
                sc[jt] = (f32x4){0.f, 0.f, 0.f, 0.f};
#pragma unroll
                for (int s = 0; s < 2; ++s) sc[jt] = MFMA16(*(const LAS bf16x8*)(kiL + (16 * jt + c15) * 72 + 32 * s + 8 * g), qdb[s], sc[jt]);
                const int ii = 16 * it + c15;
#pragma unroll
                for (int r = 0; r < 4; ++r) { const int jj = 16 * jt + 4 * g + r; const bool keep = dir ? (jj > ii) : (jj <= ii); sc[jt][r] = keep ? sc[jt][r] : 0.f; }
            }
            const bf16x8 pa[2] = {pack8(sc[0], sc[1]), pack8(sc[2], sc[3])};
#pragma unroll
            for (int nt = 0; nt < 4; ++nt) {
                const int dvr = 64 * dvh + 16 * nt + c15;
                f32x4 o = (f32x4){0.f, 0.f, 0.f, 0.f};
#pragma unroll
                for (int s = 0; s < 2; ++s) {
                    o = MFMA16(*(const LAS bf16x8*)(vT + TROW(dvr) + 32 * s + 8 * g), pa[s], o);
                    o = MFMA16(*(const LAS bf16x8*)(sL + dvr * 72 + 32 * s + 8 * g), qdb[s], o);
                }
                const u32x2 w = {pk2(o[0], o[1]), pk2(o[2], o[3])};
                *(u32x2*)(OL + ((size_t)tokc + 16 * it + c15) * 512 + h * 128 + 64 * dvh + 16 * nt + 4 * g) = w;
            }
            bf16x8 vb[2];
#pragma unroll
            for (int s = 0; s < 2; ++s) vb[s] = *(const LAS bf16x8*)(vT + TROW(16 * wave + c15) + 32 * s + 8 * g);
#pragma unroll
            for (int kt = 0; kt < 4; ++kt) {
                const f32x4 gm = *(const LAS f32x4*)(elc + 16 * kt + 4 * g);
                f32x4 a = S[kt] * gm;
#pragma unroll
                for (int s = 0; s < 2; ++s) a = MFMA16(*(const LAS bf16x8*)(keT + TROW(16 * kt + c15) + 32 * s + 8 * g), vb[s], a);
                S[kt] = a;
            }
            quant_store(p, qrow, lane, qa);
        }
        lds_barrier();
    }
    {
        float* SEGS = (float*)(ws + WS_SEGS) + (size_t)(bhd * 8 + sg) * 64 * 128;
#pragma unroll
        for (int kt = 0; kt < 4; ++kt)
#pragma unroll
            for (int r = 0; r < 4; ++r) SEGS[(16 * kt + 4 * g + r) * 128 + 16 * wave + c15] = S[kt][r];
        if (tid < 64) ((float*)(ws + WS_GSEG))[(bhd * 8 + sg) * 64 + tid] = __expf(gs[tid]);
    }
}
#undef TROW

DI void phaseGA(const Params& p, LAS unsigned char* lds, int tid, int lane, int wave) {
    for (int task = blockIdx.x; task < 512; task += gridDim.x) { if (task & 1) ga_task<1>(p, lds, tid, lane, wave, task); else ga_task<0>(p, lds, tid, lane, wave, task); }
}

DI void phaseGB(const Params& p, int tid) {
    unsigned char* ws = p.ws;
    const float* SEGS = (const float*)(ws + WS_SEGS); const float* GSEG = (const float*)(ws + WS_GSEG); bf16_t* SC = (bf16_t*)(ws + WS_SC);
    for (int e = blockIdx.x * NTH + tid; e < 64 * 128 * 16; e += gridDim.x * NTH) {
        const int dv = e & 127, dk4 = (e >> 7) & 15, bhd = e >> 11;
        float c[4] = {0.f, 0.f, 0.f, 0.f};
        for (int sg = 0; sg < 8; ++sg) {
            const u32x2 w = {pk2(c[0], c[1]), pk2(c[2], c[3])};
            *(u32x2*)(SC + ((size_t)(bhd * 8 + sg) * 128 + dv) * 64 + 4 * dk4) = w;
            const f32x4 gm = *(const f32x4*)(GSEG + (bhd * 8 + sg) * 64 + 4 * dk4);
#pragma unroll
            for (int r = 0; r < 4; ++r) c[r] = gm[r] * c[r] + SEGS[((size_t)(bhd * 8 + sg) * 64 + 4 * dk4 + r) * 128 + dv];
        }
    }
}

DI void phase4a(const Params& p, LAS unsigned char* lds, int tid, int lane, int wave) {
    asm volatile("" : "+v"(tid), "+v"(lane));
    unsigned char* ws = p.ws;
    const bf16_t* Z = (const bf16_t*)(ws + WS_RZ);
    bf16_t* MIX = (bf16_t*)(ws + WS_RA);
    const bf16_t* OF = (const bf16_t*)(ws + WS_RO); const bf16_t* OB = (const bf16_t*)(ws + WS_RO + 64 * MB);
    const bf16_t* WP = (const bf16_t*)(ws + WS_WP);
    LAS bf16_t* pt = (LAS bf16_t*)lds;
    LAS unsigned char* at = lds + 81920;
    const int c15 = lane & 15, g = lane >> 4;
    for (int tile = blockIdx.x; tile < T / 64; tile += gridDim.x) {
        const int tok0 = tile * 64, s0 = tok0 & (SEQ - 1);
        __syncthreads();
#pragma unroll
        for (int ps = 0; ps < 10; ++ps) {
            const int idx = tid + NTH * ps, rr = idx >> 6, ch = idx & 63, sq = s0 - 8 + rr;
            u32x4 v = {0u, 0u, 0u, 0u};
            if (sq >= 0 && sq < SEQ) v = *(const u32x4*)(Z + ((size_t)tok0 - 8 + rr) * ZW + 1536 + ch * 8);
            *(LAS u32x4*)(pt + rr * 512 + ch * 8) = v;
        }
        {
            const int hh = wave >> 1, ih = wave & 1, bb = tok0 / SEQ, nn = s0 >> 6;
            f32x4 acc[8][2];
#pragma unroll
            for (int mt = 0; mt < 8; ++mt) { acc[mt][0] = (f32x4){0.f, 0.f, 0.f, 0.f}; acc[mt][1] = (f32x4){0.f, 0.f, 0.f, 0.f}; }
#pragma unroll
            for (int dir = 0; dir < 2; ++dir) {
                const int sg = dir ? 7 - (nn >> 3) : (nn >> 3), bhd = bb * 8 + hh * 2 + dir;
                const bf16_t* SCp = (const bf16_t*)(ws + WS_SC) + (size_t)(bhd * 8 + sg) * 128 * 64;
                const bf16_t* QCp = (const bf16_t*)(ws + WS_QDC + (dir ? 16 : 0) * MB) + ((size_t)tok0 + 32 * ih) * 256 + hh * 64;
#pragma unroll
                for (int s = 0; s < 2; ++s) {
                    const bf16x8 q0 = ld_frag16(QCp + (size_t)c15 * 256 + 32 * s + 8 * g), q1 = ld_frag16(QCp + (size_t)(16 + c15) * 256 + 32 * s + 8 * g);
#pragma unroll
                    for (int mt = 0; mt < 8; ++mt) {
                        const bf16x8 af = ld_frag16(SCp + (16 * mt + c15) * 64 + 32 * s + 8 * g);
                        acc[mt][0] = MFMA16(af, q0, acc[mt][0]); acc[mt][1] = MFMA16(af, q1, acc[mt][1]);
                    }
                }
            }
#pragma unroll
            for (int nt = 0; nt < 2; ++nt)
#pragma unroll
                for (int mt = 0; mt < 8; ++mt) { const f32x4 o = acc[mt][nt]; const u32x2 w = {pk2(o[0], o[1]), pk2(o[2], o[3])};
                    *(LAS u32x2*)(at + (32 * ih + 16 * nt + c15) * 1040 + (hh * 128 + 16 * mt + 4 * g) * 2) = w; }
        }
        __syncthreads();
        {
            const f32x4 gh0 = *(const f32x4*)(p.in[11] + 8 * lane), gh1 = *(const f32x4*)(p.in[11] + 8 * lane + 4);
#pragma unroll
            for (int hb = 0; hb < 2; ++hb) {
                u32x4 a[4], bq[4], rv[4], cv[4];
#pragma unroll
                for (int j = 0; j < 4; ++j) { const int tl = wave * 8 + hb * 4 + j; const size_t t = (size_t)tok0 + tl;
                    a[j] = *(const u32x4*)(OF + t * 512 + 8 * lane); bq[j] = *(const u32x4*)(OB + t * 512 + 8 * lane); rv[j] = *(const u32x4*)(Z + t * ZW + 1024 + 8 * lane);
                    cv[j] = *(const LAS u32x4*)(at + tl * 1040 + 16 * lane); }
#pragma unroll
                for (int j = 0; j < 4; ++j) { const size_t t = (size_t)tok0 + wave * 8 + hb * 4 + j;
                    float o[8], r[8];
#pragma unroll
                    for (int e = 0; e < 4; ++e) { o[2 * e] = bflo(a[j][e]) + bflo(bq[j][e]) + bflo(cv[j][e]); o[2 * e + 1] = bfhi(a[j][e]) + bfhi(bq[j][e]) + bfhi(cv[j][e]); r[2 * e] = bflo(rv[j][e]); r[2 * e + 1] = bfhi(rv[j][e]); }
                    float ss = 0.f;
#pragma unroll
                    for (int e = 0; e < 8; ++e) ss += o[e] * o[e];
                    ss += __shfl_xor(ss, 1); ss += __shfl_xor(ss, 2); ss += __shfl_xor(ss, 4); ss += __shfl_xor(ss, 8);
                    const float rstd = rsqrtf(ss * (1.f / 128.f) + EPS);
                    float y[8];
#pragma unroll
                    for (int e = 0; e < 8; ++e) { const float gg = e < 4 ? gh0[e] : gh1[e - 4]; y[e] = o[e] * rstd * gg * (r[e] / (1.f + __expf(-r[e]))); }
                    const u32x4 w = {pk2(y[0], y[1]), pk2(y[2], y[3]), pk2(y[4], y[5]), pk2(y[6], y[7])};
                    *(u32x4*)(MIX + t * D + 8 * lane) = w; }
            }
        }
        __syncthreads();
        {
            const int c = tid, gi = c >> 7, cc = c & 127, hw = 1 << gi;
            LAS unsigned char* ag = at + gi * 16384;
            const LAS bf16_t* pc = pt + c;
            if (s0 >= 8 && s0 + 64 + 8 <= SEQ) {
                const float inv = 0.5f / (float)hw;
                float sum = 0.f;
                for (int rr = 8 - hw; rr < 8 + hw; ++rr) sum += bflo((unsigned)pc[rr * 512]);
#pragma unroll 4
                for (int i = 0; i < 64; ++i) {
                    const float val = sum * inv - bflo((unsigned)pc[(i + 8) * 512]);
                    *(LAS bf16_t*)(ag + i * 256 + (((cc >> 3) ^ (i & 15)) * 16) + (cc & 7) * 2) = (bf16_t)(pk2(val, 0.f) & 0xFFFFu);
                    sum += bflo((unsigned)pc[(i + 8 + hw) * 512]) - bflo((unsigned)pc[(i + 8 - hw) * 512]);
                }
            } else {
                float sum = 0.f;
                {   const int lo = max(s0 - hw, 0), hi = min(s0 + hw, SEQ);
                    for (int rr = lo; rr < hi; ++rr) sum += bflo((unsigned)pc[(rr - s0 + 8) * 512]); }
#pragma unroll 4
                for (int i = 0; i < 64; ++i) {
                    const int sq = s0 + i, lo = max(sq - hw, 0), hi = min(sq + hw, SEQ);
                    const float val = sum * __builtin_amdgcn_rcpf((float)(hi - lo)) - bflo((unsigned)pc[(i + 8) * 512]);
                    *(LAS bf16_t*)(ag + i * 256 + (((cc >> 3) ^ (i & 15)) * 16) + (cc & 7) * 2) = (bf16_t)(pk2(val, 0.f) & 0xFFFFu);
                    if (sq + hw < SEQ) sum += bflo((unsigned)pc[(i + 8 + hw) * 512]);
                    if (sq - hw >= 0) sum -= bflo((unsigned)pc[(i + 8 - hw) * 512]);
                }
            }
        }
        __syncthreads();
        {
            const int gi = wave >> 1, dh = wave & 1;
            LAS unsigned char* ag = at + gi * 16384;
            f32x4 acc[4][4];
#pragma unroll
            for (int mt = 0; mt < 4; ++mt)
#pragma unroll
                for (int nt = 0; nt < 4; ++nt) acc[mt][nt] = (f32x4){0.f, 0.f, 0.f, 0.f};
#pragma unroll
            for (int s = 0; s < 4; ++s) {
                bf16x8 af[4];
#pragma unroll
                for (int mt = 0; mt < 4; ++mt) { const int row = mt * 16 + c15; af[mt] = *(const LAS bf16x8*)(ag + row * 256 + (((4 * s + g) ^ (row & 15)) * 16)); }
#pragma unroll
                for (int nt = 0; nt < 4; ++nt) {
                    const bf16x8 wf = ld_frag16(WP + (size_t)gi * 16384 + (dh * 64 + 16 * nt + c15) * 128 + 32 * s + 8 * g);
#pragma unroll
                    for (int mt = 0; mt < 4; ++mt) acc[mt][nt] = MFMA16(wf, af[mt], acc[mt][nt]);
                }
            }
#pragma unroll
            for (int nt = 0; nt < 4; ++nt) {
                const f32x4 ps = *(const f32x4*)(p.in[13] + gi * 128 + dh * 64 + 16 * nt + 4 * g);
#pragma unroll
                for (int mt = 0; mt < 4; ++mt) {
                    const f32x4 v = acc[mt][nt] * ps;
                    u32x2 w = {pk2(v[0], v[1]), pk2(v[2], v[3])};
                    *(u32x2*)(MIX + ((size_t)tok0 + mt * 16 + c15) * D + 512 + gi * 128 + dh * 64 + 16 * nt + 4 * g) = w;
                }
            }
        }
    }
}

DI void phase4c(const Params& p, LAS unsigned char* lds, int tid, int lane, int wave) {
    asm volatile("" : "+v"(tid), "+v"(lane));
    LAS float* lG = (LAS float*)lds; LAS float* lA = lG + 1024; LAS float* lB = lA + 1024; LAS float* lP = lB + 1024;
    const float* x = p.in[0]; const bf16_t* MIXO = (const bf16_t*)(p.ws + WS_RZ); bf16_t* H2 = (bf16_t*)(p.ws + WS_RA);
    for (int rt = blockIdx.x; rt < T / 128; rt += gridDim.x) {
        const int b = rt / 32;
        __syncthreads();
        for (int d = tid; d < 1024; d += NTH) { lG[d] = mod_at(p, b, 2048 + d); lA[d] = p.in[15][d] * (1.f + mod_at(p, b, 4096 + d)); lB[d] = mod_at(p, b, 3072 + d); lP[d] = p.in[5][d]; }
        __syncthreads();
        for (int r0 = wave; r0 < 128; r0 += 4 * NWV) {
            f32x4 m[4][4], xv[4][4];
#pragma unroll
            for (int u = 0; u < 4; ++u) {
                const size_t row = (size_t)rt * 128 + r0 + u * NWV;
                const u32x2* mr = (const u32x2*)(MIXO + row * D) + lane; const f32x4* xr = (const f32x4*)(x + row * D) + lane;
#pragma unroll
                for (int j = 0; j < 4; ++j) { const u32x2 mv = mr[64 * j]; m[u][j] = (f32x4){bflo(mv.x), bfhi(mv.x), bflo(mv.y), bfhi(mv.y)}; xv[u][j] = xr[64 * j]; }
            }
#pragma unroll
            for (int u = 0; u < 4; ++u) {
                const size_t row = (size_t)rt * 128 + r0 + u * NWV;
                float ss = 0.f;
#pragma unroll
                for (int j = 0; j < 4; ++j) ss += m[u][j][0] * m[u][j][0] + m[u][j][1] * m[u][j][1] + m[u][j][2] * m[u][j][2] + m[u][j][3] * m[u][j][3];
                const float rstd = rsqrtf(wave_sum(ss) * (1.f / D) + EPS);
                float s2 = 0.f;
#pragma unroll
                for (int j = 0; j < 4; ++j) {
                    const f32x4 gt = *(const LAS f32x4*)(lG + 4 * lane + 256 * j), pm = *(const LAS f32x4*)(lP + 4 * lane + 256 * j);
                    xv[u][j] = xv[u][j] + gt * (m[u][j] * rstd * pm);
                    s2 += xv[u][j][0] * xv[u][j][0] + xv[u][j][1] * xv[u][j][1] + xv[u][j][2] * xv[u][j][2] + xv[u][j][3] * xv[u][j][3];
                }
                const float rstd2 = rsqrtf(wave_sum(s2) * (1.f / D) + EPS);
                f32x4* orow = (f32x4*)(p.out + row * D) + lane; u32x2* hrow = (u32x2*)(H2 + row * D) + lane;
#pragma unroll
                for (int j = 0; j < 4; ++j) {
                    orow[64 * j] = xv[u][j];
                    const f32x4 a = *(const LAS f32x4*)(lA + 4 * lane + 256 * j), bb = *(const LAS f32x4*)(lB + 4 * lane + 256 * j);
                    const f32x4 hv = xv[u][j] * rstd2 * a + bb;
                    u32x2 w = {pk2(hv[0], hv[1]), pk2(hv[2], hv[3])};
                    hrow[64 * j] = w;
                }
            }
        }
    }
}

DI int skey(float v, int idx, int mask) { int u = __float_as_int(v); u ^= (u >> 31) & 0x7FFFFFFF; return (u & ~mask) | idx; }
DI float sval(int k, int mask) { int u = k & ~mask; u ^= (u >> 31) & 0x7FFFFFFF; return __int_as_float(u); }
DI void cswap(int& a, int& b) { const int mx = max(a, b), mn = min(a, b); a = mx; b = mn; }
DI void sort16_desc(int (&a)[16]) {
    cswap(a[0], a[13]); cswap(a[1], a[12]); cswap(a[2], a[15]); cswap(a[3], a[14]); cswap(a[4], a[8]); cswap(a[5], a[6]); cswap(a[7], a[11]); cswap(a[9], a[10]);
    cswap(a[0], a[5]); cswap(a[1], a[7]); cswap(a[2], a[9]); cswap(a[3], a[4]); cswap(a[6], a[13]); cswap(a[8], a[14]); cswap(a[10], a[15]); cswap(a[11], a[12]);
    cswap(a[0], a[1]); cswap(a[2], a[3]); cswap(a[4], a[5]); cswap(a[6], a[8]); cswap(a[7], a[9]); cswap(a[10], a[11]); cswap(a[12], a[13]); cswap(a[14], a[15]);
    cswap(a[0], a[2]); cswap(a[1], a[3]); cswap(a[4], a[10]); cswap(a[5], a[11]); cswap(a[6], a[7]); cswap(a[8], a[9]); cswap(a[12], a[14]); cswap(a[13], a[15]);
    cswap(a[1], a[2]); cswap(a[3], a[12]); cswap(a[4], a[6]); cswap(a[5], a[7]); cswap(a[8], a[10]); cswap(a[9], a[11]); cswap(a[13], a[14]);
    cswap(a[1], a[4]); cswap(a[2], a[6]); cswap(a[5], a[8]); cswap(a[7], a[10]); cswap(a[9], a[13]); cswap(a[11], a[14]);
    cswap(a[2], a[4]); cswap(a[3], a[6]); cswap(a[9], a[12]); cswap(a[11], a[13]);
    cswap(a[3], a[5]); cswap(a[6], a[8]); cswap(a[7], a[9]); cswap(a[10], a[12]);
    cswap(a[3], a[4]); cswap(a[5], a[6]); cswap(a[7], a[8]); cswap(a[9], a[10]); cswap(a[11], a[12]);
    cswap(a[6], a[7]); cswap(a[8], a[9]);
}
DI void merge16_desc(int (&x)[16], const int (&y)[16]) {
#pragma unroll
    for (int i = 0; i < 16; ++i) x[i] = max(x[i], y[15 - i]);
#pragma unroll
    for (int j = 8; j > 0; j >>= 1) {
#pragma unroll
        for (int i = 0; i < 16; ++i) { const int l = i ^ j; if (l > i) cswap(x[i], x[l]); }
    }
}

DI void phase5b(const Params& p, LAS unsigned char* lds, int tid, int lane, int wave) {
    asm volatile("" : "+v"(tid), "+v"(lane));
    unsigned char* ws = p.ws;
    const bf16_t* Q2 = (const bf16_t*)(ws + WS_RZ);
    const bf16_t* SKB = (const bf16_t*)(ws + WS_SKB);
    int* EIDX = (int*)(ws + WS_RS); float* GATE = (float*)(ws + WS_RS + 16 * MB);
    LAS unsigned char* tab = lds + tid * 32;
    LAS unsigned char* skl = lds + 16384;
    const int c31 = lane & 31, hi = lane >> 5;
    for (int btask = blockIdx.x; btask < 256; btask += gridDim.x) {
        const int h = btask & 7, tgc = btask >> 3;
        __syncthreads();
#pragma unroll
        for (int ps = 0; ps < 8; ++ps) {
            const int idx = tid + NTH * ps, row = idx >> 4, ch = idx & 15;
            const u32x4 v = *(const u32x4*)(SKB + ((size_t)h * 256 + row) * 128 + ch * 8);
            *(LAS u32x4*)(skl + row * 256 + ((ch ^ (row & 15)) * 16)) = v;
        }
        __syncthreads();
      for (int ti = 0; ti < 4; ++ti) {
        const int tg = tgc * 32 + wave * 4 + ti;
        const size_t tok = (size_t)tg * 32 + c31;
        int lst[2][16];
        bf16x8 bq[2][8];
#pragma unroll
        for (int pp = 0; pp < 2; ++pp) {
            const bf16_t* qp = Q2 + tok * 2048 + h * 256 + pp * 128 + 8 * hi;
            asm volatile("" : "+v"(qp));
#pragma unroll
            for (int ks = 0; ks < 8; ++ks) bq[pp][ks] = ld_frag16(qp + 16 * ks);
        }
#pragma unroll
        for (int pp = 0; pp < 2; ++pp) {
            int run[16];
#pragma unroll
            for (int r = 0; r < 16; ++r) run[r] = (int)0x80000000;
#pragma unroll 1
            for (int kt = 0; kt < 4; ++kt) {
                const LAS unsigned char* kb = skl + pp * 32768 + (32 * kt + c31) * 256;
                f32x16 acc;
#pragma unroll
                for (int r = 0; r < 16; ++r) acc[r] = 0.f;
#pragma unroll
                for (int ks = 0; ks < 8; ++ks) acc = MFMA32(*(const LAS bf16x8*)(kb + (((2 * ks + hi) ^ (c31 & 15)) * 16)), bq[pp][ks], acc);
                int cur[16];
#pragma unroll
                for (int r = 0; r < 16; ++r) cur[r] = skey(acc[r], 32 * kt + 8 * (r >> 2) + 4 * hi + (r & 3), 0x7F);
                sort16_desc(cur);
                merge16_desc(run, cur);
            }
            int oth[16];
#pragma unroll
            for (int r = 0; r < 16; ++r) oth[r] = __shfl_xor(run[r], 32);
            merge16_desc(run, oth);
#pragma unroll
            for (int r = 0; r < 16; ++r) lst[pp][r] = run[r];
        }
#pragma unroll
        for (int pp = 0; pp < 2; ++pp) {
            u32x4 w;
#pragma unroll
            for (int q = 0; q < 4; ++q) w[q] = (lst[pp][4 * q] & 0x7F) | ((lst[pp][4 * q + 1] & 0x7F) << 8) | ((lst[pp][4 * q + 2] & 0x7F) << 16) | ((lst[pp][4 * q + 3] & 0x7F) << 24);
            *(LAS u32x4*)(tab + 16 * pp) = w;
        }
        float va[16], vb[16];
#pragma unroll
        for (int r = 0; r < 16; ++r) { va[r] = sval(lst[0][r], 0x7F); vb[r] = sval(lst[1][r], 0x7F); }
        int cand[4][16];
        {
            int cnt = 0;
#pragma unroll
            for (int i = 0; i < 16; ++i)
#pragma unroll
                for (int j = 0; j < 16; ++j)
                    if ((i + 1) * (j + 1) <= 16) { cand[cnt >> 4][cnt & 15] = skey(va[i] + vb[j], (i << 4) | j, 0xFF); ++cnt; }
#pragma unroll
            for (int q = 50; q < 64; ++q) cand[q >> 4][q & 15] = (int)0x80000000;
        }
        sort16_desc(cand[0]); sort16_desc(cand[1]); sort16_desc(cand[2]); sort16_desc(cand[3]);
        merge16_desc(cand[0], cand[1]); merge16_desc(cand[2], cand[3]); merge16_desc(cand[0], cand[2]);
        asm volatile("s_waitcnt lgkmcnt(0)" ::: "memory");
        float sv[16]; int ex[16];
        const float mx = sval(cand[0][0], 0xFF);
        float sum = 0.f;
#pragma unroll
        for (int r = 0; r < 16; ++r) {
            const int ck = cand[0][r];
            const int i1 = tab[(ck >> 4) & 15], i2 = tab[16 + (ck & 15)];
            ex[r] = i1 * 128 + i2;
            sv[r] = __expf(sval(ck, 0xFF) - mx); sum += sv[r];
        }
        const float inv = 1.f / sum;
        int* ep = EIDX + tok * 128 + h * 16 + 8 * hi; float* gp = GATE + tok * 128 + h * 16 + 8 * hi;
        if (hi == 0) {
            *(u32x4*)ep = (u32x4){(unsigned)ex[0], (unsigned)ex[1], (unsigned)ex[2], (unsigned)ex[3]}; *(u32x4*)(ep + 4) = (u32x4){(unsigned)ex[4], (unsigned)ex[5], (unsigned)ex[6], (unsigned)ex[7]};
            *(f32x4*)gp = (f32x4){sv[0] * inv, sv[1] * inv, sv[2] * inv, sv[3] * inv}; *(f32x4*)(gp + 4) = (f32x4){sv[4] * inv, sv[5] * inv, sv[6] * inv, sv[7] * inv};
        } else {
            *(u32x4*)ep = (u32x4){(unsigned)ex[8], (unsigned)ex[9], (unsigned)ex[10], (unsigned)ex[11]}; *(u32x4*)(ep + 4) = (u32x4){(unsigned)ex[12], (unsigned)ex[13], (unsigned)ex[14], (unsigned)ex[15]};
            *(f32x4*)gp = (f32x4){sv[8] * inv, sv[9] * inv, sv[10] * inv, sv[11] * inv}; *(f32x4*)(gp + 4) = (f32x4){sv[12] * inv, sv[13] * inv, sv[14] * inv, sv[15] * inv};
        }
      }
    }
}

template <int K> DI int swz_bcast(int v) { return __builtin_amdgcn_ds_swizzle(v, 0x10 | (K << 5)); }
template <int W> DI int swz_xor(int v) { return __builtin_amdgcn_ds_swizzle(v, 0x1F | (W << 10)); }
template <int K> struct IC { static constexpr int v = K; };
template <int N, int I = 0, class F> DI void static_for(F&& f) { if constexpr (I < N) { f(IC<I>{}); static_for<N, I + 1>(f); } }
DI float row16_sum(float v) {
    v += __builtin_bit_cast(float, __builtin_amdgcn_update_dpp(0, __builtin_bit_cast(int, v), 0xB1, 0xF, 0xF, true));
    v += __builtin_bit_cast(float, __builtin_amdgcn_update_dpp(0, __builtin_bit_cast(int, v), 0x4E, 0xF, 0xF, true));
    v += __builtin_bit_cast(float, __builtin_amdgcn_update_dpp(0, __builtin_bit_cast(int, v), 0x141, 0xF, 0xF, true));
    v += __builtin_bit_cast(float, __builtin_amdgcn_update_dpp(0, __builtin_bit_cast(int, v), 0x140, 0xF, 0xF, true));
    return v;
}
DI void phase6(const Params& p, LAS unsigned char* lds, int tid, int lane, int wave) {
    asm volatile("" : "+v"(tid), "+v"(lane));
    unsigned char* ws = p.ws;
    const bf16_t* H2 = (const bf16_t*)(ws + WS_RA);
    const unsigned char* UQ = ws + WS_UB; const unsigned char* VQ = ws + WS_VB;
    const float* SU = (const float*)(ws + WS_SU); const float* SV = (const float*)(ws + WS_SV);
    const int* EIDX = (const int*)(ws + WS_RS); const float* GATE = (const float*)(ws + WS_RS + 16 * MB);
    LAS float* lG = (LAS float*)lds;
    const int q = lane >> 4, l16 = lane & 15;
    LAS int* le = (LAS int*)(lds + 4096 + wave * 6144) + q * 128;
    LAS float* lg = (LAS float*)(lds + 4096 + wave * 6144 + 2048) + q * 128;
    LAS float* lc = (LAS float*)(lds + 4096 + wave * 6144 + 4096) + q * 128;
    const unsigned qlo = q < 2 ? (0xFFFFu << (16 * q)) : 0u, qhi = q >= 2 ? (0xFFFFu << (16 * (q - 2))) : 0u;
    for (int rt = blockIdx.x; rt < T / 128; rt += gridDim.x) {
        const int b = rt / 32;
        __syncthreads();
        for (int d = tid; d < 1024; d += NTH) lG[d] = mod_at(p, b, 5120 + d) * p.in[16][d];
        __syncthreads();
#pragma unroll 1
        for (int rd = 0; rd < 4; ++rd) {
            __syncthreads();
            const size_t t = (size_t)rt * 128 + wave * 16 + rd * 4 + q;
            {
                int e[8]; float g[8];
#pragma unroll
                for (int r = 0; r < 8; ++r) { e[r] = EIDX[t * 128 + r * 16 + l16]; g[r] = GATE[t * 128 + r * 16 + l16]; }
                unsigned W[4] = {0u, 0u, 0u, 0u};
#pragma unroll
                for (int r = 0; r < 8; ++r) {
                    const int k = e[r] >> 10; const unsigned inc = 1u << (8 * (k & 3)); const int w = k >> 2;
                    W[0] += (w == 0) ? inc : 0u; W[1] += (w == 1) ? inc : 0u; W[2] += (w == 2) ? inc : 0u; W[3] += (w == 3) ? inc : 0u;
                }
                unsigned C[4];
                {
                    unsigned tot[4], exc[4];
#pragma unroll
                    for (int w = 0; w < 4; ++w) {
                        unsigned x = W[w];
                        x += (unsigned)__builtin_amdgcn_update_dpp(0, (int)x, 0x111, 0xF, 0xF, true);
                        x += (unsigned)__builtin_amdgcn_update_dpp(0, (int)x, 0x112, 0xF, 0xF, true);
                        x += (unsigned)__builtin_amdgcn_update_dpp(0, (int)x, 0x114, 0xF, 0xF, true);
                        x += (unsigned)__builtin_amdgcn_update_dpp(0, (int)x, 0x118, 0xF, 0xF, true);
                        exc[w] = x - W[w];
                        tot[w] = (unsigned)swz_bcast<15>((int)x);
                    }
                    unsigned carry = 0u;
#pragma unroll
                    for (int w = 0; w < 4; ++w) {
                        const unsigned P = tot[w] + (tot[w] << 8) + (tot[w] << 16) + (tot[w] << 24);
                        C[w] = (P - tot[w]) + carry * 0x01010101u + exc[w];
                        carry += P >> 24;
                    }
                }
#pragma unroll
                for (int r = 0; r < 8; ++r) {
                    const int k = e[r] >> 10; const int sh = 8 * (k & 3); const int w = k >> 2; const unsigned inc = 1u << sh;
                    const unsigned cw = (w == 0) ? C[0] : (w == 1) ? C[1] : (w == 2) ? C[2] : C[3];
                    const int pos = (int)((cw >> sh) & 0xFFu);
                    le[pos] = e[r]; lg[pos] = g[r];
                    C[0] += (w == 0) ? inc : 0u; C[1] += (w == 1) ? inc : 0u; C[2] += (w == 2) ? inc : 0u; C[3] += (w == 3) ? inc : 0u;
                }
                asm volatile("s_waitcnt lgkmcnt(0)" ::: "memory");
            }
            {
                int hq[16]; float ish;
                {
                    float hv[64]; float hm = 0.f;
#pragma unroll
                    for (int i = 0; i < 4; ++i) {
                        const u32x4 h0 = *(const u32x4*)(H2 + t * D + 256 * i + 16 * l16), h1 = *(const u32x4*)(H2 + t * D + 256 * i + 16 * l16 + 8);
#pragma unroll
                        for (int c = 0; c < 4; ++c) { hv[16 * i + 2 * c] = bflo(h0[c]); hv[16 * i + 2 * c + 1] = bfhi(h0[c]); hv[16 * i + 8 + 2 * c] = bflo(h1[c]); hv[16 * i + 8 + 2 * c + 1] = bfhi(h1[c]); }
                    }
#pragma unroll
                    for (int j = 0; j < 64; ++j) hm = fmaxf(hm, fabsf(hv[j]));
                    hm = fmaxf(hm, __builtin_bit_cast(float, __builtin_amdgcn_update_dpp(0, __builtin_bit_cast(int, hm), 0xB1, 0xF, 0xF, true)));
                    hm = fmaxf(hm, __builtin_bit_cast(float, __builtin_amdgcn_update_dpp(0, __builtin_bit_cast(int, hm), 0x4E, 0xF, 0xF, true)));
                    hm = fmaxf(hm, __builtin_bit_cast(float, __builtin_amdgcn_update_dpp(0, __builtin_bit_cast(int, hm), 0x141, 0xF, 0xF, true)));
                    hm = fmaxf(hm, __builtin_bit_cast(float, __builtin_amdgcn_update_dpp(0, __builtin_bit_cast(int, hm), 0x140, 0xF, 0xF, true)));
                    const float s8 = hm > 1e-30f ? 127.f / hm : 0.f; ish = hm * (1.f / 127.f);
#pragma unroll
                    for (int d = 0; d < 16; ++d) {
                        const int q0 = __float2int_rn(hv[4 * d] * s8), q1 = __float2int_rn(hv[4 * d + 1] * s8), q2 = __float2int_rn(hv[4 * d + 2] * s8), q3 = __float2int_rn(hv[4 * d + 3] * s8);
                        hq[d] = (int)((unsigned)(q0 & 0xFF) | ((unsigned)(q1 & 0xFF) << 8) | ((unsigned)(q2 & 0xFF) << 16) | ((unsigned)q3 << 24));
                    }
                }
                constexpr int UD = 4;
                u32x4 ub[UD][4];
                int evn = le[l16];
                static_for<UD>([&](auto kc) { constexpr int k = decltype(kc)::v; const unsigned char* up = UQ + (size_t)swz_bcast<k>(evn) * 1024 + 16 * l16;
#pragma unroll
                    for (int i = 0; i < 4; ++i) ub[k][i] = *(const u32x4*)(up + 256 * i); });
#pragma unroll 1
                for (int bt = 0; bt < 8; ++bt) {
                    if (bt) __syncthreads();
                    const int ev = evn; const float gv = lg[bt * 16 + l16];
                    evn = le[(bt < 7 ? bt + 1 : 7) * 16 + l16];
                    const float isu = SU[ev] * ish, isv = SV[ev];
                    int part[16];
                    static_for<16>([&](auto kc) {
                        constexpr int k = decltype(kc)::v, sl = k % UD;
                        int a = 0;
#pragma unroll
                        for (int i = 0; i < 4; ++i) {
                            const u32x4 u = ub[sl][i];
#pragma unroll
                            for (int c = 0; c < 4; ++c) a = __builtin_amdgcn_sdot4((int)u[c], hq[4 * i + c], a, false);
                        }
                        part[k] = a;
                        {
                            constexpr int kn = k + UD;
                            int idx; if constexpr (kn < 16) idx = swz_bcast<(kn & 15)>(ev); else idx = swz_bcast<(kn & 15)>(evn);
                            const unsigned char* up = UQ + (size_t)idx * 1024 + 16 * l16;
#pragma unroll
                            for (int i = 0; i < 4; ++i) ub[sl][i] = *(const u32x4*)(up + 256 * i);
                        }
                    });
                    static_for<4>([&](auto sc) {
                        constexpr int w = 8 >> decltype(sc)::v;
                        const bool up2 = (lane & w) != 0;
#pragma unroll
                        for (int e = 0; e < w; ++e) {
                            const int keep = up2 ? part[e + w] : part[e], send = up2 ? part[e] : part[e + w];
                            part[e] = keep + swz_xor<w>(send);
                        }
                    });
                    const float dot = (float)part[0] * isu;
                    lc[bt * 16 + l16] = gv * 0.5f * dot * (1.f + erff(dot * 0.70710678118654752f)) * isv;
                }
                asm volatile("s_waitcnt lgkmcnt(0)" ::: "memory");
            }
            __syncthreads();
            f32x2 y[32];
#pragma unroll
            for (int i = 0; i < 32; ++i) y[i] = (f32x2){0.f, 0.f};
            {
                constexpr int VD = 4;
                u32x4 vbuf[VD][4];
                int evn = le[l16];
                static_for<VD>([&](auto kc) { constexpr int k = decltype(kc)::v; const unsigned char* vp = VQ + (size_t)swz_bcast<k>(evn) * 1024 + 16 * l16;
#pragma unroll
                    for (int i = 0; i < 4; ++i) vbuf[k][i] = *(const u32x4*)(vp + 256 * i); });
#pragma unroll 1
                for (int bt = 0; bt < 8; ++bt) {
                    if (bt) __syncthreads();
                    const int ev = evn; const int cv = __float_as_int(lc[bt * 16 + l16]);
                    evn = le[(bt < 7 ? bt + 1 : 7) * 16 + l16];
                    static_for<16>([&](auto kc) {
                        constexpr int k = decltype(kc)::v, sl = k % VD;
                        const float cc = __int_as_float(swz_bcast<k>(cv));
                        const f32x2 c2 = (f32x2){cc, cc};
#pragma unroll
                        for (int i = 0; i < 4; ++i) {
                            const u32x4 v = vbuf[sl][i];
#pragma unroll
                            for (int c = 0; c < 4; ++c) {
                                const int w = (int)v[c];
                                y[8 * i + 2 * c] = __builtin_elementwise_fma(__builtin_amdgcn_cvt_pk_f32_fp8(w, false), c2, y[8 * i + 2 * c]);
                                y[8 * i + 2 * c + 1] = __builtin_elementwise_fma(__builtin_amdgcn_cvt_pk_f32_fp8(w, true), c2, y[8 * i + 2 * c + 1]);
                            }
                        }
                        {
                            constexpr int kn = k + VD;
                            int idx; if constexpr (kn < 16) idx = swz_bcast<(kn & 15)>(ev); else idx = swz_bcast<(kn & 15)>(evn);
                            const unsigned char* vp = VQ + (size_t)idx * 1024 + 16 * l16;
#pragma unroll
                            for (int i = 0; i < 4; ++i) vbuf[sl][i] = *(const u32x4*)(vp + 256 * i);
                        }
                    });
                }
            }
            float ss = 0.f;
#pragma unroll
            for (int i = 0; i < 32; ++i) ss += y[i].x * y[i].x + y[i].y * y[i].y;
            const float rstd = rsqrtf(row16_sum(ss) * (1.f / D) + EPS);
            float* orow = p.out + t * D;
#pragma unroll
            for (int i = 0; i < 4; ++i)
#pragma unroll
                for (int c = 0; c < 4; ++c) {
                    const int col = 256 * i + 16 * l16 + 4 * c;
                    f32x4 xv = *(const f32x4*)(orow + col);
                    const f32x4 gg = *(const LAS f32x4*)(lG + col);
                    xv[0] += gg[0] * y[8 * i + 2 * c].x * rstd; xv[1] += gg[1] * y[8 * i + 2 * c].y * rstd; xv[2] += gg[2] * y[8 * i + 2 * c + 1].x * rstd; xv[3] += gg[3] * y[8 * i + 2 * c + 1].y * rstd;
                    *(f32x4*)(orow + col) = xv;
                }
        }
    }
}


__global__ void __launch_bounds__(NTH) fwd_megakernel(Params p) {
    extern __shared__ __attribute__((aligned(16))) unsigned char lds_raw[];
    LAS unsigned char* lds = (LAS unsigned char*)lds_raw;
    const int tid = threadIdx.x, lane = tid & 63, wave = __builtin_amdgcn_readfirstlane(tid >> 6);
    volatile LAS unsigned* st = (volatile LAS unsigned*)(lds + LDS_BARW);
    if (tid == 0) { st[0] = 0u; st[1] = 0u; st[2] = 0u; st[3] = 0u; }
    __syncthreads();
    XcdBarrier bar = xcd_barrier_post((unsigned*)(p.ws + WS_CTL), st);
    unsigned char* ws = p.ws;

    phase0(p, lds, tid, lane, wave);
    xcd_barrier(bar);
    phase1(p, lds, tid, lane, wave);
    xcd_barrier(bar);
    { pg8::Gemm g{(const bf16_t*)(ws + WS_RA), (const bf16_t*)(ws + WS_WIN), T, ZW, D}; pg8::StaticOrder S; S.init(T, ZW, (int)gridDim.x, (int)blockIdx.x);
      pg8::EpiB16 e{(bf16_t*)(ws + WS_RZ), ZW}; pg8::gemm_phase<pg8::EpiB16, pg8::StaticOrder, true, true>(lds, g, S, e);
      EpiZ e2{(bf16_t*)(ws + WS_RZ), (float*)(ws + WS_AFB)}; gemm_phase(((const bf16_t*)(ws + WS_RA)), (const bf16_t*)(ws + WS_WIN), T, NIN, D, e2, lds, tid, lane, wave, 16); }
    xcd_barrier(bar);
    phaseGA(p, lds, tid, lane, wave);
    xcd_barrier(bar);
    phaseGB(p, tid);
    xcd_barrier(bar);
    phase4a(p, lds, tid, lane, wave);
    xcd_barrier(bar);
    { pg8::Gemm g{(const bf16_t*)(ws + WS_RA), (const bf16_t*)(ws + WS_WOUT), T, D, D}; pg8::StaticOrder S; S.init(T, D, (int)gridDim.x, (int)blockIdx.x);
      pg8::EpiB16 e{(bf16_t*)(ws + WS_RZ), D}; pg8::gemm_phase<pg8::EpiB16, pg8::StaticOrder, true, true>(lds, g, S, e); }
    xcd_barrier(bar);
    phase4c(p, lds, tid, lane, wave);
    xcd_barrier(bar);
    { pg8::Gemm g{(const bf16_t*)(ws + WS_RA), (const bf16_t*)(ws + WS_WQ), T, 2048, D}; pg8::StaticOrder S; S.init(T, 2048, (int)gridDim.x, (int)blockIdx.x);
      pg8::EpiB16 e{(bf16_t*)(ws + WS_RZ), 2048}; pg8::gemm_phase<pg8::EpiB16, pg8::StaticOrder, true, true>(lds, g, S, e); }
    xcd_barrier(bar);
    phase5b(p, lds, tid, lane, wave);
    xcd_barrier(bar);
    phase6(p, lds, tid, lane, wave);
}

extern "C" void kernel_launch(void* const* d_in, const int* in_sizes, int n_in, void* d_out, int out_size, void* d_ws, size_t ws_size, hipStream_t stream) {
    static int grid = 0;
    if (grid == 0) {
        if (n_in != 21 || out_size != T * D || ws_size < WS_END) { fprintf(stderr, "kernel_launch: unexpected shapes (n_in %d out %d ws %zu need %zu)\n", n_in, out_size, ws_size, (size_t)WS_END); grid = -1; return; }
        int dev = 0, cus = 0, per_cu = 0;
        hipGetDevice(&dev); hipDeviceGetAttribute(&cus, hipDeviceAttributeMultiprocessorCount, dev);
        hipFuncSetAttribute((const void*)fwd_megakernel, hipFuncAttributeMaxDynamicSharedMemorySize, LDS_BYTES);
        hipOccupancyMaxActiveBlocksPerMultiprocessor(&per_cu, (const void*)fwd_megakernel, NTH, LDS_BYTES);
        (void)hipGetLastError();
        if (per_cu < 1) fprintf(stderr, "kernel_launch: occupancy query says %d blocks per CU\n", per_cu);
        grid = cus;
    }
    if (grid < 0) return;
    hipMemsetAsync((char*)d_ws + WS_CTL, 0, 64 * 1024, stream);
    Params p{};
    for (int i = 0; i < 21; ++i) p.in[i] = (const float*)d_in[i];
    p.out = (float*)d_out; p.ws = (unsigned char*)d_ws;
    hipLaunchKernelGGL(fwd_megakernel, dim3(grid), dim3(NTH), LDS_BYTES, stream, p);
}
```

```cpp
#include <hip/hip_runtime.h>
#include <cstdio>
#include <cstdint>

#define DI __device__ __forceinline__
#define LAS __attribute__((address_space(3)))
typedef unsigned short bf16_t;
typedef short bf16x8 __attribute__((ext_vector_type(8)));
typedef float f32x4 __attribute__((ext_vector_type(4)));
typedef float f32x2 __attribute__((ext_vector_type(2)));
typedef float f32x16 __attribute__((ext_vector_type(16)));
typedef unsigned u32x4 __attribute__((ext_vector_type(4)));
typedef unsigned u32x2 __attribute__((ext_vector_type(2)));
typedef __bf16 bf16x2v __attribute__((ext_vector_type(2)));

constexpr int T = 32768, D = 1024, SEQ = 4096, NB = 8;
constexpr int NTH = 512, NWV = 8;
constexpr int ZW = 2048;
constexpr int NIN = 2176;
constexpr float EPS = 1e-6f;

constexpr size_t MB = 1024 * 1024;
constexpr size_t WS_CTL   = 0;
constexpr size_t WS_MODP  = 64 * 1024;
constexpr size_t WS_WIN   = WS_MODP + 8 * 8 * 6144 * 4;
constexpr size_t WS_WOUT  = WS_WIN + (size_t)NIN * 1024 * 2;
constexpr size_t WS_WQ    = WS_WOUT + 1024 * 1024 * 2;
constexpr size_t WS_SKB   = WS_WQ + 2048 * 1024 * 2;
constexpr size_t WS_WP    = WS_SKB + 16 * 128 * 128 * 2;
constexpr size_t WS_AFB   = WS_WP + 4 * 128 * 128 * 2;
constexpr size_t WS_UB    = WS_AFB + (size_t)T * 32 * 4;
constexpr size_t WS_VB    = WS_UB + 32 * MB;
constexpr size_t WS_SU    = WS_UB + 16 * MB, WS_SV = WS_VB + 16 * MB;
constexpr size_t WS_RA    = WS_VB + 32 * MB;
constexpr size_t WS_RZ    = WS_RA + 64 * MB;
constexpr size_t WS_RS    = WS_RZ + 128 * MB;
constexpr size_t WS_RO    = WS_RS + 6 * 16 * MB + 1 * MB;
constexpr size_t WS_END   = WS_RO + 128 * MB;
static_assert(WS_END <= 512 * MB, "workspace too large");

struct Params { const float* in[21]; float* out; unsigned char* ws; };

DI unsigned pk2(float a, float b) { f32x2 f = {a, b}; bf16x2v h = __builtin_convertvector(f, bf16x2v); return __builtin_bit_cast(unsigned, h); }
DI float dot2bf(unsigned a, unsigned b, float c) { return __builtin_amdgcn_fdot2_f32_bf16(__builtin_bit_cast(bf16x2v, a), __builtin_bit_cast(bf16x2v, b), c, false); }
DI float bflo(unsigned u) { return __uint_as_float(u << 16); }
DI float bfhi(unsigned u) { return __uint_as_float(u & 0xFFFF0000u); }
DI float wave_sum(float v) {
#pragma unroll
    for (int o = 1; o < 64; o <<= 1) v += __shfl_xor(v, o);
    return v;
}
DI bf16x8 ld_frag16(const bf16_t* p) { return __builtin_bit_cast(bf16x8, *(const u32x4*)p); }
DI bf16x8 ld_frag_perm(const bf16_t* p, int g) {
    const u32x2 lo = *(const u32x2*)(p + 4 * g), hi = *(const u32x2*)(p + 16 + 4 * g);
    u32x4 v = {lo.x, lo.y, hi.x, hi.y}; return __builtin_bit_cast(bf16x8, v);
}
DI int perm32(int k) { return (k & ~31) | (((k >> 2) & 3) << 3) | (((k >> 4) & 1) << 2) | (k & 3); }
DI bf16x8 pack8(const f32x4& a, const f32x4& b) { u32x4 v = {pk2(a[0], a[1]), pk2(a[2], a[3]), pk2(b[0], b[1]), pk2(b[2], b[3])}; return __builtin_bit_cast(bf16x8, v); }
#define MFMA16(a, b, c) __builtin_amdgcn_mfma_f32_16x16x32_bf16((a), (b), (c), 0, 0, 0)
#define MFMA32(a, b, c) __builtin_amdgcn_mfma_f32_32x32x16_bf16((a), (b), (c), 0, 0, 0)

#define XB_TMO      128
#define XB_XCNT(j)  (256  + 64 * (j))
#define XB_XSUB(j)  (1280 + 64 * (j))
#define XB_XGEN(j)  (2304 + 64 * (j))
#define XB_TOP      3328
#define XB_TOPGEN   3392
#define XCD_BAR_WORDS 3456
#define XB_SPIN_CAP (1u << 22)
DI unsigned xb_ld(unsigned* p)              { return __hip_atomic_load(p, __ATOMIC_RELAXED, __HIP_MEMORY_SCOPE_AGENT); }
DI unsigned xb_add(unsigned* p, unsigned v) { return __hip_atomic_fetch_add(p, v, __ATOMIC_RELAXED, __HIP_MEMORY_SCOPE_AGENT); }
DI unsigned xb_xcc_id() { return (unsigned)__builtin_amdgcn_s_getreg((3 << 11) | 20) & 0xFu; }
#define XB_SPIN(cond, bar) do { unsigned _sp = 0; while (cond) { __builtin_amdgcn_s_sleep(1); \
    if ((++_sp & 255u) == 0u) { if (xb_ld(&(bar)[XB_TMO])) break; if (_sp > XB_SPIN_CAP) { atomicAdd(&(bar)[XB_TMO], 1u); break; } } } } while (0)
struct XcdBarrier { unsigned* bar; unsigned x; volatile LAS unsigned* st; };
DI XcdBarrier xcd_barrier_post(unsigned* bar, volatile LAS unsigned* st) {
    XcdBarrier b; b.bar = bar; b.x = xb_xcc_id(); b.st = st;
    if (threadIdx.x == 0) (void)xb_add(&bar[XB_XCNT(b.x)], 1u);
    return b;
}
DI void xcd_barrier_complete(unsigned* bar, unsigned x, unsigned& nloc, unsigned& nx) {
    const unsigned G = gridDim.x * gridDim.y * gridDim.z;
    unsigned sum, cnt, mine, sp = 0u;
    for (;;) {
        sum = 0u; cnt = 0u; mine = 0u;
#pragma unroll
        for (unsigned j = 0; j < 16; ++j) { const unsigned c = xb_ld(&bar[XB_XCNT(j)]); sum += c; cnt += (c > 0u) ? 1u : 0u; mine = (j == x) ? c : mine; }
        if (sum == G) break;
        __builtin_amdgcn_s_sleep(1);
        if ((++sp & 255u) == 0u) { if (xb_ld(&bar[XB_TMO])) break; if (sp > XB_SPIN_CAP) { atomicAdd(&bar[XB_TMO], 1u); break; } }
    }
    nloc = mine > 0u ? mine : 1u; nx = cnt > 0u ? cnt : 1u;
}
DI void xcd_barrier(const XcdBarrier& b) {
    asm volatile("s_waitcnt vmcnt(0)" ::: "memory");
    __syncthreads();
    if (threadIdx.x == 0) {
        unsigned* bar = b.bar;
        __builtin_amdgcn_s_waitcnt(0);
        unsigned nloc = b.st[0], nx = b.st[1];
        if (nloc == 0u) { xcd_barrier_complete(bar, b.x, nloc, nx); b.st[0] = nloc; b.st[1] = nx; }
        const unsigned old = xb_add(&bar[XB_XSUB(b.x)], 1u);
        const unsigned gen = old / nloc;
        if (old + 1u == (gen + 1u) * nloc) {
            __builtin_amdgcn_fence(__ATOMIC_RELEASE, "agent");
            asm volatile("s_waitcnt vmcnt(0)" ::: "memory");
            const unsigned og = xb_add(&bar[XB_TOP], 1u);
            const unsigned tg = og / nx;
            if (og + 1u == (tg + 1u) * nx) xb_add(&bar[XB_TOPGEN], 1u);
            else XB_SPIN(xb_ld(&bar[XB_TOPGEN]) == tg, bar);
            __builtin_amdgcn_fence(__ATOMIC_ACQUIRE, "agent");
            xb_add(&bar[XB_XGEN(b.x)], 1u);
            asm volatile("s_waitcnt vmcnt(0)" ::: "memory");
        } else {
            XB_SPIN(xb_ld(&bar[XB_XGEN(b.x)]) == gen, bar);
            __builtin_amdgcn_fence(__ATOMIC_ACQUIRE, "agent");
            asm volatile("s_waitcnt vmcnt(0)" ::: "memory");
        }
    }
    __syncthreads();
}

constexpr int LDS_BYTES = 152 * 1024;
constexpr int LDS_BARW = LDS_BYTES - 16;

DI void p0_transpose_item(const float* W, int ldw, int K, bf16_t* WT, int dst_row0, int src_col0, float scale, bool zero, LAS float* scr, int kb, int lane) {
    const int k0 = 64 * kb;
#pragma unroll 8
    for (int i = 0; i < 32; ++i) { const int kk = 2 * i + (lane >> 5); scr[kk * 33 + (lane & 31)] = zero ? 0.f : W[(size_t)(k0 + kk) * ldw + src_col0 + (lane & 31)] * scale; }
    asm volatile("s_waitcnt lgkmcnt(0)" ::: "memory");
    const int c = lane & 7;
#pragma unroll
    for (int j = 0; j < 4; ++j) { const int n = (lane >> 3) + 8 * j; const LAS float* s = scr + (8 * c) * 33 + n;
        u32x4 o; o.x = pk2(s[0 * 33], s[1 * 33]); o.y = pk2(s[2 * 33], s[3 * 33]); o.z = pk2(s[4 * 33], s[5 * 33]); o.w = pk2(s[6 * 33], s[7 * 33]);
        *(u32x4*)(WT + (size_t)(dst_row0 + n) * K + k0 + 8 * c) = o; }
    asm volatile("s_waitcnt lgkmcnt(0)" ::: "memory");
}

DI void phase0(const Params& p, LAS unsigned char* lds, int tid, int lane, int wave) {
    asm volatile("" : "+v"(tid), "+v"(lane));
    unsigned char* ws = p.ws;
    LAS float* sl = (LAS float*)lds;
    LAS float* scr = (LAS float*)(lds + 32768 + wave * 8448);
    const float* c = p.in[1];
    for (int e = tid; e < 8192; e += NTH) { const int b = e >> 10, k = e & 1023; const float v = c[e]; sl[k * 8 + b] = v / (1.f + __expf(-v)); }
    __syncthreads();
    const int gw = wave * gridDim.x + blockIdx.x, NGW = gridDim.x * NWV;
    constexpr int I_MOD = 768, I_WIN = 16 * 68, I_WOUT = 16 * 32, I_WQ = 16 * 64, I_WP = 32;
    constexpr int NITEMS = I_MOD + I_WIN + I_WOUT + I_WQ + I_WP;
    for (int it = gw; it < NITEMS; it += NGW) {
        int r = it;
        if (r < I_MOD) {
            const int cg = r % 96, ks = r / 96, n = cg * 64 + lane, k0 = ks * 128;
            const float* W = p.in[2] + (size_t)k0 * 6144 + n;
            float acc[8];
#pragma unroll
            for (int b = 0; b < 8; ++b) acc[b] = 0.f;
#pragma unroll 8
            for (int k = 0; k < 128; ++k) {
                const float w = W[(size_t)k * 6144];
                const f32x4 s0 = *(const LAS f32x4*)(sl + (k0 + k) * 8), s1 = *(const LAS f32x4*)(sl + (k0 + k) * 8 + 4);
                acc[0] += s0[0] * w; acc[1] += s0[1] * w; acc[2] += s0[2] * w; acc[3] += s0[3] * w;
                acc[4] += s1[0] * w; acc[5] += s1[1] * w; acc[6] += s1[2] * w; acc[7] += s1[3] * w;
            }
            float* mp = (float*)(ws + WS_MODP) + (size_t)ks * 8 * 6144 + n;
#pragma unroll
            for (int b = 0; b < 8; ++b) mp[b * 6144] = acc[b];
            continue;
        }
        r -= I_MOD;
        if (r < I_WIN) {
            const int kb = r / 68, nb = r % 68, n0 = nb * 32;
            int src; bool zero = false; float scale = 1.f;
            if (n0 < 1536) { src = n0; if (n0 < 256) scale = 0.125f; } else if (n0 < 2048) src = n0 + 32; else if (n0 < 2080) src = 1536 + (n0 - 2048); else { src = 0; zero = true; }
            p0_transpose_item(p.in[6], 2080, 1024, (bf16_t*)(ws + WS_WIN), n0, src, scale, zero, scr, kb, lane);
            continue;
        }
        r -= I_WIN;
        if (r < I_WOUT) { p0_transpose_item(p.in[14], 1024, 1024, (bf16_t*)(ws + WS_WOUT), (r % 32) * 32, (r % 32) * 32, 1.f, false, scr, r / 32, lane); continue; }
        r -= I_WOUT;
        if (r < I_WQ) { p0_transpose_item(p.in[17], 2048, 1024, (bf16_t*)(ws + WS_WQ), (r % 64) * 32, (r % 64) * 32, 1.f, false, scr, r / 64, lane); continue; }
        r -= I_WQ;
        { const int g = r >> 3, kb = (r >> 2) & 1, nb = r & 3;
          p0_transpose_item(p.in[12] + g * 16384, 128, 128, (bf16_t*)(ws + WS_WP) + g * 16384, nb * 32, nb * 32, 1.f, false, scr, kb, lane); }
    }
    const size_t gt = (size_t)blockIdx.x * NTH + tid, NGT = (size_t)gridDim.x * NTH;
    constexpr size_t NSK = (size_t)16 * 128 * 128 / 8;
    for (size_t j = gt; j < NSK; j += NGT) {
        const float* src = p.in[18]; bf16_t* dst = (bf16_t*)(ws + WS_SKB);
        const f32x4 a = *(const f32x4*)(src + j * 8), b = *(const f32x4*)(src + j * 8 + 4);
        u32x4 o = {pk2(a[0], a[1]), pk2(a[2], a[3]), pk2(b[0], b[1]), pk2(b[2], b[3])};
        *(u32x4*)(dst + j * 8) = o;
    }
}

DI void quant_load(const Params& p, int row, int lane, f32x4 (&v)[4]) {
    const int tb = row >> 14, e = row & 16383;
    const float* src = (tb ? p.in[20] : p.in[19]) + (size_t)e * D + 16 * lane;
#pragma unroll
    for (int q = 0; q < 4; ++q) v[q] = *(const f32x4*)(src + 4 * q);
}
DI void quant_store(const Params& p, int row, int lane, const f32x4 (&v)[4]) {
    unsigned char* ws = p.ws;
    const int tb = row >> 14, e = row & 16383;
    float m = 0.f;
#pragma unroll
    for (int q = 0; q < 4; ++q) m = fmaxf(m, fmaxf(fmaxf(fabsf(v[q][0]), fabsf(v[q][1])), fmaxf(fabsf(v[q][2]), fabsf(v[q][3]))));
#pragma unroll
    for (int o = 1; o < 64; o <<= 1) m = fmaxf(m, __shfl_xor(m, o));
    int ex = (int)((__float_as_uint(m) >> 23) & 0xFFu) - 127;
    if (m < 1e-30f) ex = 7;
    const float sc = __uint_as_float((unsigned)(127 + 7 - ex) << 23), isc = __uint_as_float((unsigned)(127 - 7 + ex) << 23);
    u32x4 o;
    if (tb) {
#pragma unroll
        for (int q = 0; q < 4; ++q) { int w = 0; w = __builtin_amdgcn_cvt_pk_fp8_f32(v[q][0] * sc, v[q][1] * sc, w, false); w = __builtin_amdgcn_cvt_pk_fp8_f32(v[q][2] * sc, v[q][3] * sc, w, true); o[q] = (unsigned)w; }
        if (lane == 0) ((float*)(ws + WS_SV))[e] = isc;
    } else {
        const float s8 = m > 1e-30f ? 127.f / m : 0.f;
#pragma unroll
        for (int q = 0; q < 4; ++q) {
            const int q0 = __float2int_rn(v[q][0] * s8), q1 = __float2int_rn(v[q][1] * s8), q2 = __float2int_rn(v[q][2] * s8), q3 = __float2int_rn(v[q][3] * s8);
            o[q] = (unsigned)(q0 & 0xFF) | ((unsigned)(q1 & 0xFF) << 8) | ((unsigned)(q2 & 0xFF) << 16) | ((unsigned)q3 << 24);
        }
        if (lane == 0) ((float*)(ws + WS_SU))[e] = m * (1.f / 127.f);
    }
    *(u32x4*)(ws + (tb ? WS_VB : WS_UB) + (size_t)e * 1024 + 16 * lane) = o;
}

DI float mod_at(const Params& p, int b, int n) {
    const float* mp = (const float*)(p.ws + WS_MODP) + (size_t)b * 6144 + n;
    float s = p.in[3][n];
#pragma unroll
    for (int ks = 0; ks < 8; ++ks) s += mp[(size_t)ks * 8 * 6144];
    return s;
}

DI void phase1(const Params& p, LAS unsigned char* lds, int tid, int lane, int wave) {
    asm volatile("" : "+v"(tid), "+v"(lane));
    LAS float* lA = (LAS float*)lds; LAS float* lB = lA + 1024;
    const float* x = p.in[0]; bf16_t* H = (bf16_t*)(p.ws + WS_RA);
    for (int rt = blockIdx.x; rt < T / 128; rt += gridDim.x) {
        const int b = rt / 32;
        __syncthreads();
        for (int d = tid; d < 1024; d += NTH) { lA[d] = p.in[4][d] * (1.f + mod_at(p, b, 1024 + d)); lB[d] = mod_at(p, b, d); }
        __syncthreads();
        for (int r0 = wave; r0 < 128; r0 += 4 * NWV) {
            f32x4 v[4][4];
#pragma unroll
            for (int u = 0; u < 4; ++u) { const f32x4* xr = (const f32x4*)(x + ((size_t)rt * 128 + r0 + u * NWV) * D) + lane;
#pragma unroll
                for (int j = 0; j < 4; ++j) v[u][j] = xr[64 * j]; }
#pragma unroll
            for (int u = 0; u < 4; ++u) {
                const size_t row = (size_t)rt * 128 + r0 + u * NWV;
                float ss = 0.f;
#pragma unroll
                for (int j = 0; j < 4; ++j) ss += v[u][j][0] * v[u][j][0] + v[u][j][1] * v[u][j][1] + v[u][j][2] * v[u][j][2] + v[u][j][3] * v[u][j][3];
                const float rstd = rsqrtf(wave_sum(ss) * (1.f / D) + EPS);
                u32x2* o = (u32x2*)(H + row * D) + lane;
#pragma unroll
                for (int j = 0; j < 4; ++j) {
                    const f32x4 a = *(const LAS f32x4*)(lA + 4 * lane + 256 * j), bb = *(const LAS f32x4*)(lB + 4 * lane + 256 * j);
                    u32x2 w = {pk2(v[u][j][0] * rstd * a[0] + bb[0], v[u][j][1] * rstd * a[1] + bb[1]), pk2(v[u][j][2] * rstd * a[2] + bb[2], v[u][j][3] * rstd * a[3] + bb[3])};
                    o[64 * j] = w;
                }
            }
        }
    }
}

struct EpiZ {
    bf16_t* Z; float* AFB;
    DI void operator()(int m, int n, const f32x4& v) const {
        if (n < ZW) { u32x2 w = {pk2(v[0], v[1]), pk2(v[2], v[3])}; *(u32x2*)(Z + (size_t)m * ZW + n) = w; }
        else if (n < ZW + 32) { *(f32x4*)(AFB + (size_t)m * 32 + (n - ZW)) = v; }
    }
};
struct EpiF32 { float* C; int ldc; DI void operator()(int m, int n, const f32x4& v) const { *(f32x4*)(C + (size_t)m * ldc + n) = v; } };
struct EpiBf16 { bf16_t* C; int ldc; DI void operator()(int m, int n, const f32x4& v) const { u32x2 w = {pk2(v[0], v[1]), pk2(v[2], v[3])}; *(u32x2*)(C + (size_t)m * ldc + n) = w; } };

template <class Epi>
DI void gemm_phase(const bf16_t* A, const bf16_t* Bt, int M, int N, int K, const Epi& epi, LAS unsigned char* lds, int tid, int lane, int wave, int nt_first = 0) {
    constexpr int BM = 256, BN = 128, BK = 64, STAGE = (BM + BN) * 128;
    const int ntn = N / BN - nt_first, ntiles = (M / BM) * ntn, nk = K / BK;
    const int wm = wave & 3, wn = wave >> 2, c15 = lane & 15, g = lane >> 4;
    const int lrow = tid >> 3, lch = tid & 7;
    for (int tile = blockIdx.x; tile < ntiles; tile += gridDim.x) {
        const int m0 = (tile / ntn) * BM, n0 = (tile % ntn + nt_first) * BN;
        f32x4 acc[4][4];
#pragma unroll
        for (int i = 0; i < 4; ++i)
#pragma unroll
            for (int j = 0; j < 4; ++j) acc[i][j] = (f32x4){0.f, 0.f, 0.f, 0.f};
        u32x4 ra[4], rb[2];
        const bf16_t* Ag = A + (size_t)(m0 + lrow) * K + lch * 8;
        const bf16_t* Bg = Bt + (size_t)(n0 + lrow) * K + lch * 8;
        const int woff = lrow * 128 + ((lch ^ (lrow & 7)) * 16);
        __syncthreads();
#pragma unroll
        for (int ps = 0; ps < 4; ++ps) ra[ps] = *(const u32x4*)(Ag + (size_t)(64 * ps) * K);
#pragma unroll
        for (int ps = 0; ps < 2; ++ps) rb[ps] = *(const u32x4*)(Bg + (size_t)(64 * ps) * K);
#pragma unroll
        for (int ps = 0; ps < 4; ++ps) *(LAS u32x4*)(lds + woff + ps * 8192) = ra[ps];
#pragma unroll
        for (int ps = 0; ps < 2; ++ps) *(LAS u32x4*)(lds + BM * 128 + woff + ps * 8192) = rb[ps];
        __syncthreads();
        for (int kt = 0; kt < nk; ++kt) {
            const bool more = (kt + 1 < nk);
            if (more) {
#pragma unroll
                for (int ps = 0; ps < 4; ++ps) ra[ps] = *(const u32x4*)(Ag + (size_t)(64 * ps) * K + (kt + 1) * BK);
#pragma unroll
                for (int ps = 0; ps < 2; ++ps) rb[ps] = *(const u32x4*)(Bg + (size_t)(64 * ps) * K + (kt + 1) * BK);
            }
            LAS unsigned char* sa = lds + (kt & 1) * STAGE; LAS unsigned char* sb = sa + BM * 128;
#pragma unroll
            for (int s = 0; s < 2; ++s) {
                bf16x8 fa[4], fb[4];
#pragma unroll
                for (int i = 0; i < 4; ++i) { const int row = wm * 64 + i * 16 + c15; fa[i] = *(const LAS bf16x8*)(sa + row * 128 + (((4 * s + g) ^ (row & 7)) * 16)); }
#pragma unroll
                for (int j = 0; j < 4; ++j) { const int row = wn * 64 + j * 16 + c15; fb[j] = *(const LAS bf16x8*)(sb + row * 128 + (((4 * s + g) ^ (row & 7)) * 16)); }
#pragma unroll
                for (int i = 0; i < 4; ++i)
#pragma unroll
                    for (int j = 0; j < 4; ++j) acc[i][j] = MFMA16(fb[j], fa[i], acc[i][j]);
            }
            if (more) {
                LAS unsigned char* da = lds + ((kt + 1) & 1) * STAGE;
#pragma unroll
                for (int ps = 0; ps < 4; ++ps) *(LAS u32x4*)(da + woff + ps * 8192) = ra[ps];
#pragma unroll
                for (int ps = 0; ps < 2; ++ps) *(LAS u32x4*)(da + BM * 128 + woff + ps * 8192) = rb[ps];
            }
            __syncthreads();
        }
#pragma unroll
        for (int i = 0; i < 4; ++i)
#pragma unroll
            for (int j = 0; j < 4; ++j) epi(m0 + wm * 64 + i * 16 + c15, n0 + wn * 64 + j * 16 + 4 * g, acc[i][j]);
    }
}

namespace pg8 {
#define PG8_LAS __attribute__((address_space(3)))
constexpr int BM = 256, BK = 64, HALF = 128, HTB = HALF * BK * 2  , STAGE_BYTES = 8 * HTB, NXCD = 8, WGM = 8;

__host__ __device__ __forceinline__ int lds_byte(int r, int c) { const int st = (r >> 4) * 2 + (c >> 5), rr = r & 15, cc = c & 31, ob = rr * 64 + cc * 2; return st * 1024 + (ob ^ (((ob >> 9) & 1) << 5)); }
__host__ __device__ __forceinline__ void stage_rc(int b, int& R, int& C) { const int st = b / 1024, sb = b % 1024, swz = sb ^ (((sb >> 9) & 1) << 5); R = (st >> 1) * 16 + swz / 64; C = (st & 1) * 32 + (swz % 64) / 2; }
__host__ __device__ __forceinline__ int perm32(int rho) { const int n = rho >> 4, i = rho & 15; return 8 * (i >> 2) + 4 * n + (i & 3); }

struct Unit { int pm, pn; };
struct Gemm { const bf16_t* A; const bf16_t* Bt; int M, N, K; };

struct StaticOrder {
    int nM, nN, nwg, G, c;
    __host__ __device__ void init(int M, int N, int G_, int c_) { nM = M / BM; nN = N / BM; nwg = nM * nN; G = G_; c = c_; }
    __host__ __device__ bool next(int i, Unit& u) const {
        const long L = (long)i * G + c; if (L >= nwg) return false;
        int wgid = (int)L; { const int q = nwg / NXCD, r = nwg % NXCD, xcd = wgid % NXCD, off = wgid / NXCD; wgid = (xcd < r ? xcd * (q + 1) : r * (q + 1) + (xcd - r) * q) + off; }
        const int nig = WGM * nN, gid = wgid / nig, fm = gid * WGM, gsz = (nM - fm) < WGM ? (nM - fm) : WGM;
        u.pm = fm + ((wgid % nig) % gsz); u.pn = (wgid % nig) / gsz; return true;
    }
    __device__ __forceinline__ void a_ready(const Unit&) const {}
    __device__ __forceinline__ void done(const Unit&) const {}
};

struct EpiB16 {
    static constexpr bool PERM = true, AFTER_DRAIN = false;
    bf16_t* O; int ldc;
    __device__ __forceinline__ void operator()(const f32x4 (&acc)[2][2][4][2], const Unit& u, int wr, int wc, int fr, int fq) const {
#pragma unroll
        for (int ai = 0; ai < 2; ++ai)
#pragma unroll
            for (int m = 0; m < 4; ++m) { bf16_t* rowp = O + (size_t)(u.pm * BM + ai * HALF + wr * 64 + m * 16 + fr) * ldc + u.pn * BM + wc * 32 + 8 * fq;
#pragma unroll
                for (int bj = 0; bj < 2; ++bj) { const f32x4 v0 = acc[ai][bj][m][0], v1 = acc[ai][bj][m][1];
                    u32x4 w; w.x = ::pk2(v0[0], v0[1]); w.y = ::pk2(v0[2], v0[3]); w.z = ::pk2(v1[0], v1[1]); w.w = ::pk2(v1[2], v1[3]);
                    *(u32x4*)(rowp + bj * HALF) = w; } }
    }
};
struct EpiF {
    static constexpr bool PERM = false, AFTER_DRAIN = false;
    float* O; int ldc;
    __device__ __forceinline__ void operator()(const f32x4 (&acc)[2][2][4][2], const Unit& u, int wr, int wc, int fr, int fq) const {
#pragma unroll
        for (int ai = 0; ai < 2; ++ai)
#pragma unroll
            for (int m = 0; m < 4; ++m) { float* rowp = O + (size_t)(u.pm * BM + ai * HALF + wr * 64 + m * 16 + fr) * ldc + u.pn * BM + wc * 32 + 4 * fq;
#pragma unroll
                for (int bj = 0; bj < 2; ++bj)
#pragma unroll
                    for (int n = 0; n < 2; ++n) *(f32x4*)(rowp + bj * HALF + 16 * n) = acc[ai][bj][m][n]; }
    }
};
template <class Epi, class Sched, bool ALIGN_EPI = false, bool SP2 = false>
__device__ __forceinline__ void gemm_phase(PG8_LAS unsigned char* lds, const Gemm g, const Sched& S, const Epi& E) {
    int tid = threadIdx.x; asm volatile("" : "+v"(tid));
    const int wid = __builtin_amdgcn_readfirstlane(tid >> 6), lane = tid & 63, wr = wid >> 2, wc = wid & 3, fr = lane & 15, fq = lane >> 4;
    const int K = g.K, nt = K / BK;
    unsigned voffA[2], voffB[2];
#pragma unroll
    for (int i = 0; i < 2; ++i) { int R, C; stage_rc(tid * 16 + i * 8192, R, C); const int Rb = Epi::PERM ? ((R & ~31) + perm32(R & 31)) : R;
        voffA[i] = (unsigned)(R * K + C) * 2u; voffB[i] = (unsigned)(Rb * K + C) * 2u; }
    const size_t kstep = (size_t)(BK * 2);
    const size_t hstep = (size_t)HALF * K * 2;
    const size_t tstep = 2 * hstep;
    const unsigned ldsw = (unsigned)wid * 1024u;
    const int aoff = lds_byte(wr * 64 + fr, fq * 8), boff = lds_byte(wc * 32 + fr, fq * 8);
#define PG8_SA(b, h) (((b) * 2 + (h)) * HTB)
#define PG8_SB(b, h) ((4 + (b) * 2 + (h)) * HTB)
#define PG8_STAGE(bufoff, gbase, voff) do { _Pragma("unroll") for (int _i = 0; _i < 2; ++_i) \
        __builtin_amdgcn_global_load_lds((const unsigned*)((const char*)(gbase) + (voff)[_i]), (PG8_LAS unsigned*)(lds + (bufoff) + ldsw + _i * 8192), 16, 0, 0); } while (0)
#define PG8_LDA(dst, b, h) do { _Pragma("unroll") for (int m = 0; m < 4; ++m) _Pragma("unroll") for (int k = 0; k < 2; ++k) dst[m][k] = *(const PG8_LAS bf16x8*)(lds + PG8_SA(b, h) + aoff + m * 2048 + k * 1024); } while (0)
#define PG8_LDB(dst, b, h) do { _Pragma("unroll") for (int n = 0; n < 2; ++n) _Pragma("unroll") for (int k = 0; k < 2; ++k) dst[n][k] = *(const PG8_LAS bf16x8*)(lds + PG8_SB(b, h) + boff + n * 2048 + k * 1024); } while (0)
#define PG8_MMA(ai, bj, At, Bt) do { __builtin_amdgcn_s_setprio(1); _Pragma("unroll") for (int m = 0; m < 4; ++m) _Pragma("unroll") for (int n = 0; n < 2; ++n) _Pragma("unroll") for (int k = 0; k < 2; ++k) \
        acc[ai][bj][m][n] = __builtin_amdgcn_mfma_f32_16x16x32_bf16(Bt[n][k], At[m][k], acc[ai][bj][m][n], 0, 0, 0); __builtin_amdgcn_s_setprio(0); } while (0)
#define PG8_WAIT_V(n) asm volatile("s_waitcnt vmcnt(" #n ")" ::: "memory")
#define PG8_WAIT_L(n) asm volatile("s_waitcnt lgkmcnt(" #n ")" ::: "memory")
#define PG8_BAR __builtin_amdgcn_s_barrier()
#define PG8_SCHED __builtin_amdgcn_sched_barrier(0)
    Unit cur, nxt; int ui = 0;
    if (!S.next(0, cur)) return;
    f32x4 acc[2][2][4][2];
#pragma unroll
    for (int a = 0; a < 2; ++a)
#pragma unroll
        for (int b = 0; b < 2; ++b)
#pragma unroll
            for (int m = 0; m < 4; ++m)
#pragma unroll
                for (int n = 0; n < 2; ++n) acc[a][b][m][n] = (f32x4){0.f, 0.f, 0.f, 0.f};
    bf16x8 At[4][2], B0[2][2], B1[2][2];
    const char* cA = (const char*)g.A + (size_t)cur.pm * tstep; const char* cB = (const char*)g.Bt + (size_t)cur.pn * tstep;
    S.a_ready(cur);
    if constexpr (SP2) {
        PG8_STAGE(PG8_SB(0, 0), cB, voffB); PG8_STAGE(PG8_SB(0, 1), cB + hstep, voffB); PG8_STAGE(PG8_SA(0, 0), cA, voffA); PG8_STAGE(PG8_SA(0, 1), cA + hstep, voffA);
        if (wr == 1) PG8_BAR;
        PG8_WAIT_V(2); PG8_BAR;
        PG8_STAGE(PG8_SB(1, 0), cB + kstep, voffB); PG8_STAGE(PG8_SA(1, 0), cA + kstep, voffA); PG8_STAGE(PG8_SB(1, 1), cB + hstep + kstep, voffB);
        PG8_WAIT_V(6); PG8_BAR;
    } else {
        PG8_STAGE(PG8_SB(0, 0), cB, voffB); PG8_STAGE(PG8_SA(0, 0), cA, voffA); PG8_STAGE(PG8_SB(0, 1), cB + hstep, voffB); PG8_STAGE(PG8_SA(0, 1), cA + hstep, voffA);
        if (wr == 1) PG8_BAR;
        PG8_WAIT_V(4); PG8_BAR;
        PG8_STAGE(PG8_SB(1, 0), cB + kstep, voffB); PG8_STAGE(PG8_SA(1, 0), cA + kstep, voffA); PG8_STAGE(PG8_SB(1, 1), cB + hstep + kstep, voffB);
        PG8_WAIT_V(6); PG8_BAR;
    }
    for (;;) {
        const bool has_next = S.next(ui + 1, nxt);
        const char* nA = has_next ? (const char*)g.A + (size_t)nxt.pm * tstep : cA; const char* nB = has_next ? (const char*)g.Bt + (size_t)nxt.pn * tstep : cB;
        for (int t = 0; t < nt; t += 2) {
            const bool last = (t == nt - 2);
            const char* a1 = cA + (size_t)(t + 1) * kstep;
            const char* a2 = last ? nA : cA + (size_t)(t + 2) * kstep; const char* b2 = last ? nB : cB + (size_t)(t + 2) * kstep;
            const char* a3 = a2 + kstep; const char* b3 = b2 + kstep;
            if (last && has_next) S.a_ready(nxt);
            if constexpr (SP2) {
            PG8_LDB(B0, 0, 0); PG8_LDB(B1, 0, 1); PG8_SCHED; PG8_LDA(At, 0, 0); PG8_STAGE(PG8_SA(1, 1), a1 + hstep, voffA);
            PG8_WAIT_V(8); PG8_WAIT_L(0); PG8_BAR; PG8_MMA(0, 0, At, B0); PG8_MMA(0, 1, At, B1); PG8_BAR; PG8_SCHED;
            PG8_LDA(At, 0, 1); PG8_STAGE(PG8_SB(0, 0), b2, voffB); PG8_STAGE(PG8_SB(0, 1), b2 + hstep, voffB); PG8_STAGE(PG8_SA(0, 0), a2, voffA);
            PG8_WAIT_V(8); PG8_WAIT_L(0); PG8_BAR; PG8_MMA(1, 0, At, B0); PG8_MMA(1, 1, At, B1); PG8_BAR; PG8_SCHED;
            PG8_LDB(B0, 1, 0); PG8_LDB(B1, 1, 1); PG8_SCHED; PG8_LDA(At, 1, 0); PG8_STAGE(PG8_SA(0, 1), a2 + hstep, voffA);
            PG8_WAIT_V(8); PG8_WAIT_L(0); PG8_BAR; PG8_MMA(0, 0, At, B0); PG8_MMA(0, 1, At, B1); PG8_BAR; PG8_SCHED;
            PG8_LDA(At, 1, 1); PG8_STAGE(PG8_SB(1, 0), b3, voffB); PG8_STAGE(PG8_SB(1, 1), b3 + hstep, voffB); PG8_STAGE(PG8_SA(1, 0), a3, voffA);
            PG8_WAIT_V(8); PG8_WAIT_L(0); PG8_BAR; PG8_MMA(1, 0, At, B0); PG8_MMA(1, 1, At, B1); PG8_BAR; PG8_SCHED;
            } else {
            PG8_LDB(B0, 0, 0); PG8_SCHED; PG8_LDA(At, 0, 0); PG8_STAGE(PG8_SA(1, 1), a1 + hstep, voffA);
            PG8_WAIT_L(8); PG8_BAR; PG8_WAIT_L(0); PG8_MMA(0, 0, At, B0); PG8_BAR; PG8_SCHED;
            PG8_LDB(B1, 0, 1); PG8_STAGE(PG8_SB(0, 0), b2, voffB);
            PG8_BAR; PG8_WAIT_L(0); PG8_MMA(0, 1, At, B1); PG8_BAR;
            PG8_LDA(At, 0, 1); PG8_STAGE(PG8_SA(0, 0), a2, voffA);
            PG8_BAR; PG8_WAIT_L(0); PG8_MMA(1, 0, At, B0); PG8_BAR; PG8_SCHED;
            PG8_STAGE(PG8_SB(0, 1), b2 + hstep, voffB);
            PG8_WAIT_V(6); PG8_BAR; PG8_MMA(1, 1, At, B1); PG8_BAR;
            PG8_LDB(B0, 1, 0); PG8_SCHED; PG8_LDA(At, 1, 0); PG8_STAGE(PG8_SA(0, 1), a2 + hstep, voffA);
            PG8_WAIT_L(8); PG8_BAR; PG8_WAIT_L(0); PG8_MMA(0, 0, At, B0); PG8_BAR; PG8_SCHED;
            PG8_LDB(B1, 1, 1); PG8_STAGE(PG8_SB(1, 0), b3, voffB);
            PG8_BAR; PG8_WAIT_L(0); PG8_MMA(0, 1, At, B1); PG8_BAR;
            PG8_LDA(At, 1, 1); PG8_STAGE(PG8_SA(1, 0), a3, voffA);
            PG8_BAR; PG8_WAIT_L(0); PG8_MMA(1, 0, At, B0); PG8_BAR; PG8_SCHED;
            PG8_STAGE(PG8_SB(1, 1), b3 + hstep, voffB);
            PG8_WAIT_V(6); PG8_BAR; PG8_MMA(1, 1, At, B1); PG8_BAR;
            }
        }
        if constexpr (ALIGN_EPI) { if (wr == 0) PG8_BAR; }
        if constexpr (!Epi::AFTER_DRAIN) { E(acc, cur, wr, wc, fr, fq); S.done(cur); }
        if (!has_next) break;
#pragma unroll
        for (int a = 0; a < 2; ++a)
#pragma unroll
            for (int b = 0; b < 2; ++b)
#pragma unroll
                for (int m = 0; m < 4; ++m)
#pragma unroll
                    for (int n = 0; n < 2; ++n) acc[a][b][m][n] = (f32x4){0.f, 0.f, 0.f, 0.f};
        cur = nxt; cA = nA; cB = nB; ++ui;
        if constexpr (ALIGN_EPI) { if (wr == 1) PG8_BAR; }
    }
    PG8_WAIT_V(0);
    if constexpr (!ALIGN_EPI) { if (wr == 0) PG8_BAR; }
    PG8_BAR;
    if constexpr (Epi::AFTER_DRAIN) { E.fused(acc, cur, wr, wc, fr, fq, lds, wid, lane); S.done(cur); }
#undef PG8_SA
#undef PG8_SB
#undef PG8_STAGE
#undef PG8_LDA
#undef PG8_LDB
#undef PG8_MMA
#undef PG8_WAIT_V
#undef PG8_WAIT_L
#undef PG8_BAR
#undef PG8_SCHED
}
}

constexpr size_t WS_QDC  = WS_RS;
constexpr size_t WS_SEGS = WS_RS + 32 * MB;
constexpr size_t WS_GSEG = WS_RS + 48 * MB;
constexpr size_t WS_SC   = WS_RS + 49 * MB;
DI void lds_barrier() { asm volatile("s_waitcnt lgkmcnt(0)" ::: "memory"); __builtin_amdgcn_s_barrier(); asm volatile("" ::: "memory"); }
DI float logsig(float x) { return fminf(x, 0.f) - __logf(1.f + __expf(-fabsf(x))); }

template <int DIR>
DI void ga_task(const Params& p, LAS unsigned char* lds, int tid, int lane, int wave, int task) {
    asm volatile("" : "+v"(tid), "+v"(lane));
    unsigned char* ws = p.ws;
    const bf16_t* Z = (const bf16_t*)(ws + WS_RZ);
    const float* AFB = (const float*)(ws + WS_AFB);
    LAS float* la = (LAS float*)lds;
    LAS float* part = (LAS float*)(lds + 17408);
    LAS float* gs = (LAS float*)(lds + 18432);
    LAS float* elb = (LAS float*)(lds + 18944);
    LAS float* wl = (LAS float*)(lds + 19968);
    LAS bf16_t* sL  = (LAS bf16_t*)(lds + 24064);
    LAS unsigned char* obuf = lds + 42496;
    const int c15 = lane & 15, g = lane >> 4;
    const int i = tid >> 3, dg = tid & 7, d0 = dg * 8;
#define TROW(r) ((r) * 72 + ((r) >> 3) * 8)
    constexpr int dir = DIR; const int h = (task >> 1) & 3, pb = (task >> 3) & 7, b = task >> 6;
    const int bhd = b * 8 + h * 2 + dir, sg = dir ? 7 - pb : pb;
    bf16_t* QDC = (bf16_t*)(ws + WS_QDC + (dir ? 16 : 0) * MB);
    bf16_t* OL = (bf16_t*)(ws + WS_RO + (dir ? 64 : 0) * MB);
    f32x4 S[4];
#pragma unroll
    for (int kt = 0; kt < 4; ++kt) S[kt] = (f32x4){0.f, 0.f, 0.f, 0.f};
    __syncthreads();
    for (int e = tid; e < 128 * 72 / 2; e += NTH) ((LAS unsigned*)sL)[e] = 0u;
    if (tid < 64) gs[tid] = 0.f;
    for (int e = tid; e < 1024; e += NTH) wl[e] = (dir ? p.in[9] : p.in[7])[(e >> 6) * 256 + h * 64 + (e & 63)];
    typedef short s16x4w __attribute__((ext_vector_type(4)));
    s16x4w wfr[2]; float bias[2];
    __syncthreads();
#pragma unroll
    for (int u = 0; u < 2; ++u) {
        const int d = 16 * (2 * (wave >> 2) + u) + c15;
        const u32x2 wp = {pk2(wl[(4 * g) * 64 + d], wl[(4 * g + 1) * 64 + d]), pk2(wl[(4 * g + 2) * 64 + d], wl[(4 * g + 3) * 64 + d])};
        wfr[u] = __builtin_bit_cast(s16x4w, wp);
        bias[u] = (dir ? p.in[10] : p.in[8])[h * 64 + d];
    }
    const int mt = wave & 3;
    f32x4 avn;
    { const int n0 = dir ? pb * 8 + 7 : pb * 8; avn = *(const f32x4*)(AFB + ((size_t)b * SEQ + n0 * 64 + 16 * mt + c15) * 32 + dir * 16 + 4 * g); }
#pragma unroll 1
    for (int ci = -1; ci < 8; ++ci) {
        const bool has_cur = ci >= 0, has_nxt = ci < 7;
        const int cx = ci + 1;
        const int nx = dir ? pb * 8 + 7 - cx : pb * 8 + cx, tokx = b * SEQ + nx * 64;
        const int nc = dir ? pb * 8 + 7 - ci : pb * 8 + ci, tokc = b * SEQ + nc * 64;
        LAS unsigned char* bx = obuf + (cx & 1) * 46464; LAS unsigned char* bc = obuf + (ci & 1) * 46464;
        LAS float* elx = elb + (cx & 1) * 128; LAS float* elc = elb + (ci & 1) * 128;
        u32x4 qv, kv, vvp[2]; f32x4 qa[4]; float lv[2][4];
        const int qrow = (task * 8 + (has_cur ? ci : 0)) * NWV + wave;
        if (ci > 0) {
#pragma unroll
            for (int kt = 0; kt < 4; ++kt) { const u32x2 w = {pk2(S[kt][0], S[kt][1]), pk2(S[kt][2], S[kt][3])}; *(LAS u32x2*)(sL + (16 * wave + c15) * 72 + 16 * kt + 4 * g) = w; }
        }
        if (has_cur) quant_load(p, qrow, lane, qa);
        if (has_nxt) {
            const size_t t = (size_t)tokx + i;
            qv = *(const u32x4*)(Z + t * ZW + h * 64 + d0); kv = *(const u32x4*)(Z + t * ZW + 256 + h * 64 + d0);
#pragma unroll
            for (int ps = 0; ps < 2; ++ps) { const int idx = tid + NTH * ps, vi = idx >> 4, ch = idx & 15; vvp[ps] = *(const u32x4*)(Z + ((size_t)tokx + vi) * ZW + 512 + h * 128 + ch * 8); }
            typedef short s16x4v __attribute__((ext_vector_type(4)));
            const u32x2 ap = {pk2(avn[0], avn[1]), pk2(avn[2], avn[3])};
            const s16x4v af = __builtin_bit_cast(s16x4v, ap);
            { const int c2 = cx < 7 ? cx + 1 : cx, n2 = dir ? pb * 8 + 7 - c2 : pb * 8 + c2; avn = *(const f32x4*)(AFB + ((size_t)b * SEQ + n2 * 64 + 16 * mt + c15) * 32 + dir * 16 + 4 * g); }
#pragma unroll
            for (int u = 0; u < 2; ++u) {
                const int d = 16 * (2 * (wave >> 2) + u) + c15;
                const f32x4 x = __builtin_amdgcn_mfma_f32_16x16x16bf16_1k(af, wfr[u], (f32x4){0.f, 0.f, 0.f, 0.f}, 0, 0, 0);
                float v0 = logsig(x[0] + bias[u]) * 0.0625f, v1 = logsig(x[1] + bias[u]) * 0.0625f, v2 = logsig(x[2] + bias[u]) * 0.0625f, v3 = logsig(x[3] + bias[u]) * 0.0625f;
                float T, T2, T3;
                if (dir == 0) {
                    v1 += v0; v2 += v1; v3 += v2; T = v3;
                    const float t1 = __shfl_up(T, 16); T2 = T + (g >= 1 ? t1 : 0.f);
                    const float t2 = __shfl_up(T2, 32); T3 = T2 + (g >= 2 ? t2 : 0.f);
                    if (g == 3) part[mt * 64 + d] = T3;
                } else {
                    v2 += v3; v1 += v2; v0 += v1; T = v0;
                    const float t1 = __shfl_down(T, 16); T2 = T + (g <= 2 ? t1 : 0.f);
                    const float t2 = __shfl_down(T2, 32); T3 = T2 + (g <= 1 ? t2 : 0.f);
                    if (g == 0) part[mt * 64 + d] = T3;
                }
                const float off = T3 - T;
                lv[u][0] = v0 + off; lv[u][1] = v1 + off; lv[u][2] = v2 + off; lv[u][3] = v3 + off;
            }
        }
        lds_barrier();
        if (has_nxt) {
#pragma unroll
            for (int u = 0; u < 2; ++u) {
                const int d = 16 * (2 * (wave >> 2) + u) + c15;
                float off = 0.f;
#pragma unroll
                for (int m2 = 0; m2 < 4; ++m2) { const bool take = dir ? (m2 > mt) : (m2 < mt); off += take ? part[m2 * 64 + d] : 0.f; }
#pragma unroll
                for (int r = 0; r < 4; ++r) la[(16 * mt + 4 * g + r) * 68 + d] = lv[u][r] + off;
                if (mt == (dir ? 0 : 3) && g == (dir ? 0 : 3)) {
                    const float tot = lv[u][dir ? 0 : 3] + off, gsum = gs[(cx & 1) * 64 + d];
                    elx[d] = __expf(tot); elx[64 + d] = __expf(gsum); gs[((cx + 1) & 1) * 64 + d] = gsum + tot;
                }
            }
        }
        lds_barrier();
        if (has_nxt) {
            LAS bf16_t* qdL = (LAS bf16_t*)bx; LAS bf16_t* kiL = (LAS bf16_t*)(bx + 9216); LAS bf16_t* keT = (LAS bf16_t*)(bx + 18432); LAS bf16_t* vT = (LAS bf16_t*)(bx + 27776);
            const size_t t = (size_t)tokx + i;
            float q[8], k[8];
#pragma unroll
            for (int e = 0; e < 4; ++e) { q[2 * e] = bflo(qv[e]); q[2 * e + 1] = bfhi(qv[e]); k[2 * e] = bflo(kv[e]); k[2 * e + 1] = bfhi(kv[e]); }
            float qd[8], ki[8], ke[8], qc[8];
#pragma unroll
            for (int e = 0; e < 8; ++e) {
                const float E = __expf(la[i * 68 + d0 + e]), R = __builtin_amdgcn_rcpf(E);
                qd[e] = q[e] * E; ki[e] = k[e] * R; ke[e] = ki[e] * elx[d0 + e]; qc[e] = qd[e] * elx[64 + d0 + e];
            }
            const u32x4 o1 = {pk2(qd[0], qd[1]), pk2(qd[2], qd[3]), pk2(qd[4], qd[5]), pk2(qd[6], qd[7])};
            const u32x4 o2 = {pk2(ki[0], ki[1]), pk2(ki[2], ki[3]), pk2(ki[4], ki[5]), pk2(ki[6], ki[7])};
            const u32x4 o3 = {pk2(qc[0], qc[1]), pk2(qc[2], qc[3]), pk2(qc[4], qc[5]), pk2(qc[6], qc[7])};
            *(LAS u32x4*)(qdL + i * 72 + d0) = o1; *(LAS u32x4*)(kiL + i * 72 + d0) = o2;
            *(u32x4*)(QDC + t * 256 + h * 64 + d0) = o3;
#pragma unroll
            for (int e = 0; e < 4; ++e) { const unsigned w = pk2(ke[2 * e], ke[2 * e + 1]); keT[TROW(d0 + 2 * e) + perm32(i)] = (bf16_t)(w & 0xFFFFu); keT[TROW(d0 + 2 * e + 1) + perm32(i)] = (bf16_t)(w >> 16); }
#pragma unroll
            for (int ps = 0; ps < 2; ++ps) {
                const int idx = tid + NTH * ps, vi = idx >> 4, ch = idx & 15;
#pragma unroll
                for (int e = 0; e < 4; ++e) { vT[TROW(ch * 8 + 2 * e) + perm32(vi)] = (bf16_t)(vvp[ps][e] & 0xFFFFu); vT[TROW(ch * 8 + 2 * e + 1) + perm32(vi)] = (bf16_t)(vvp[ps][e] >> 16); }
            }
        }
        if (has_cur) {
            const LAS bf16_t* qdL = (const LAS bf16_t*)bc; const LAS bf16_t* kiL = (const LAS bf16_t*)(bc + 9216); const LAS bf16_t* keT = (const LAS bf16_t*)(bc + 18432); const LAS bf16_t* vT = (const LAS bf16_t*)(bc + 27776);
            const int it = wave & 3, dvh = wave >> 2;
            bf16x8 qdb[2];
#pragma unroll
            for (int s = 0; s < 2; ++s) qdb[s] = *(const LAS bf16x8*)(qdL + (16 * it + c15) * 72 + 32 * s + 8 * g);
            f32x4 sc[4];
#pragma unroll
            for (int jt = 0; jt < 4; ++jt) {
                sc[jt] = (f32x4){0.f, 0.f, 0.f, 0.f};
#pragma unroll
                for (int s = 0; s < 2; ++s) sc[jt] = MFMA16(*(const LAS bf16x8*)(kiL + (16 * jt + c15) * 72 + 32 * s + 8 * g), qdb[s], sc[jt]);
                const int ii = 16 * it + c15;
#pragma unroll
                for (int r = 0; r < 4; ++r) { const int jj = 16 * jt + 4 * g + r; const bool keep = dir ? (jj > ii) : (jj <= ii); sc[jt][r] = keep ? sc[jt][r] : 0.f; }
            }
            const bf16x8 pa[2] = {pack8(sc[0], sc[1]), pack8(sc[2], sc[3])};
#pragma unroll
            for (int nt = 0; nt < 4; ++nt) {
                const int dvr = 64 * dvh + 16 * nt + c15;
                f32x4 o = (f32x4){0.f, 0.f, 0.f, 0.f};
#pragma unroll
                for (int s = 0; s < 2; ++s) {
                    o = MFMA16(*(const LAS bf16x8*)(vT + TROW(dvr) + 32 * s + 8 * g), pa[s], o);
                    o = MFMA16(*(const LAS bf16x8*)(sL + dvr * 72 + 32 * s + 8 * g), qdb[s], o);
                }
                const u32x2 w = {pk2(o[0], o[1]), pk2(o[2], o[3])};
                *(u32x2*)(OL + ((size_t)tokc + 16 * it + c15) * 512 + h * 128 + 64 * dvh + 16 * nt + 4 * g) = w;
            }
            bf16x8 vb[2];
#pragma unroll
            for (int s = 0; s < 2; ++s) vb[s] = *(const LAS bf16x8*)(vT + TROW(16 * wave + c15) + 32 * s + 8 * g);
#pragma unroll
            for (int kt = 0; kt < 4; ++kt) {
                const f32x4 gm = *(const LAS f32x4*)(elc + 16 * kt + 4 * g);
                f32x4 a = S[kt] * gm;
#pragma unroll
                for (int s = 0; s < 2; ++s) a = MFMA16(*(const LAS bf16x8*)(keT + TROW(16 * kt + c15) + 32 * s + 8 * g), vb[s], a);
                S[kt] = a;
            }
            quant_store(p, qrow, lane, qa);
        }
        lds_barrier();
    }
    {
        float* SEGS = (float*)(ws + WS_SEGS) + (size_t)(bhd * 8 + sg) * 64 * 128;
#pragma unroll
        for (int kt = 0; kt < 4; ++kt)
#pragma unroll
            for (int r = 0; r < 4; ++r) SEGS[(16 * kt + 4 * g + r) * 128 + 16 * wave + c15] = S[kt][r];
        if (tid < 64) ((float*)(ws + WS_GSEG))[(bhd * 8 + sg) * 64 + tid] = __expf(gs[tid]);
    }
}
#undef TROW

DI void phaseGA(const Params& p, LAS unsigned char* lds, int tid, int lane, int wave) {
    for (int task = blockIdx.x; task < 512; task += gridDim.x) { if (task & 1) ga_task<1>(p, lds, tid, lane, wave, task); else ga_task<0>(p, lds, tid, lane, wave, task); }
}

DI void phaseGB(const Params& p, int tid) {
    unsigned char* ws = p.ws;
    const float* SEGS = (const float*)(ws + WS_SEGS); const float* GSEG = (const float*)(ws + WS_GSEG); bf16_t* SC = (bf16_t*)(ws + WS_SC);
    for (int e = blockIdx.x * NTH + tid; e < 64 * 128 * 16; e += gridDim.x * NTH) {
        const int dv = e & 127, dk4 = (e >> 7) & 15, bhd = e >> 11;
        float c[4] = {0.f, 0.f, 0.f, 0.f};
        for (int sg = 0; sg < 8; ++sg) {
            const u32x2 w = {pk2(c[0], c[1]), pk2(c[2], c[3])};
            *(u32x2*)(SC + ((size_t)(bhd * 8 + sg) * 128 + dv) * 64 + 4 * dk4) = w;
            const f32x4 gm = *(const f32x4*)(GSEG + (bhd * 8 + sg) * 64 + 4 * dk4);
#pragma unroll
            for (int r = 0; r < 4; ++r) c[r] = gm[r] * c[r] + SEGS[((size_t)(bhd * 8 + sg) * 64 + 4 * dk4 + r) * 128 + dv];
        }
    }
}

DI void phase4a(const Params& p, LAS unsigned char* lds, int tid, int lane, int wave) {
    asm volatile("" : "+v"(tid), "+v"(lane));
    unsigned char* ws = p.ws;
    const bf16_t* Z = (const bf16_t*)(ws + WS_RZ);
    bf16_t* MIX = (bf16_t*)(ws + WS_RA);
    const bf16_t* OF = (const bf16_t*)(ws + WS_RO); const bf16_t* OB = (const bf16_t*)(ws + WS_RO + 64 * MB);
    const bf16_t* WP = (const bf16_t*)(ws + WS_WP);
    LAS bf16_t* pt = (LAS bf16_t*)lds;
    LAS unsigned char* at = lds + 81920;
    const int c15 = lane & 15, g = lane >> 4;
    for (int tile = blockIdx.x; tile < T / 64; tile += gridDim.x) {
        const int tok0 = tile * 64, s0 = tok0 & (SEQ - 1);
        __syncthreads();
#pragma unroll
        for (int ps = 0; ps < 10; ++ps) {
            const int idx = tid + NTH * ps, rr = idx >> 6, ch = idx & 63, sq = s0 - 8 + rr;
            u32x4 v = {0u, 0u, 0u, 0u};
            if (sq >= 0 && sq < SEQ) v = *(const u32x4*)(Z + ((size_t)tok0 - 8 + rr) * ZW + 1536 + ch * 8);
            *(LAS u32x4*)(pt + rr * 512 + ch * 8) = v;
        }
        {
            const int hh = wave >> 1, ih = wave & 1, bb = tok0 / SEQ, nn = s0 >> 6;
            f32x4 acc[8][2];
#pragma unroll
            for (int mt = 0; mt < 8; ++mt) { acc[mt][0] = (f32x4){0.f, 0.f, 0.f, 0.f}; acc[mt][1] = (f32x4){0.f, 0.f, 0.f, 0.f}; }
#pragma unroll
            for (int dir = 0; dir < 2; ++dir) {
                const int sg = dir ? 7 - (nn >> 3) : (nn >> 3), bhd = bb * 8 + hh * 2 + dir;
                const bf16_t* SCp = (const bf16_t*)(ws + WS_SC) + (size_t)(bhd * 8 + sg) * 128 * 64;
                const bf16_t* QCp = (const bf16_t*)(ws + WS_QDC + (dir ? 16 : 0) * MB) + ((size_t)tok0 + 32 * ih) * 256 + hh * 64;
#pragma unroll
                for (int s = 0; s < 2; ++s) {
                    const bf16x8 q0 = ld_frag16(QCp + (size_t)c15 * 256 + 32 * s + 8 * g), q1 = ld_frag16(QCp + (size_t)(16 + c15) * 256 + 32 * s + 8 * g);
#pragma unroll
                    for (int mt = 0; mt < 8; ++mt) {
                        const bf16x8 af = ld_frag16(SCp + (16 * mt + c15) * 64 + 32 * s + 8 * g);
                        acc[mt][0] = MFMA16(af, q0, acc[mt][0]); acc[mt][1] = MFMA16(af, q1, acc[mt][1]);
                    }
                }
            }
#pragma unroll
            for (int nt = 0; nt < 2; ++nt)
#pragma unroll
                for (int mt = 0; mt < 8; ++mt) { const f32x4 o = acc[mt][nt]; const u32x2 w = {pk2(o[0], o[1]), pk2(o[2], o[3])};
                    *(LAS u32x2*)(at + (32 * ih + 16 * nt + c15) * 1040 + (hh * 128 + 16 * mt + 4 * g) * 2) = w; }
        }
        __syncthreads();
        {
            const f32x4 gh0 = *(const f32x4*)(p.in[11] + 8 * lane), gh1 = *(const f32x4*)(p.in[11] + 8 * lane + 4);
#pragma unroll
            for (int hb = 0; hb < 2; ++hb) {
                u32x4 a[4], bq[4], rv[4], cv[4];
#pragma unroll
                for (int j = 0; j < 4; ++j) { const int tl = wave * 8 + hb * 4 + j; const size_t t = (size_t)tok0 + tl;
                    a[j] = *(const u32x4*)(OF + t * 512 + 8 * lane); bq[j] = *(const u32x4*)(OB + t * 512 + 8 * lane); rv[j] = *(const u32x4*)(Z + t * ZW + 1024 + 8 * lane);
                    cv[j] = *(const LAS u32x4*)(at + tl * 1040 + 16 * lane); }
#pragma unroll
                for (int j = 0; j < 4; ++j) { const size_t t = (size_t)tok0 + wave * 8 + hb * 4 + j;
                    float o[8], r[8];
#pragma unroll
                    for (int e = 0; e < 4; ++e) { o[2 * e] = bflo(a[j][e]) + bflo(bq[j][e]) + bflo(cv[j][e]); o[2 * e + 1] = bfhi(a[j][e]) + bfhi(bq[j][e]) + bfhi(cv[j][e]); r[2 * e] = bflo(rv[j][e]); r[2 * e + 1] = bfhi(rv[j][e]); }
                    float ss = 0.f;
#pragma unroll
                    for (int e = 0; e < 8; ++e) ss += o[e] * o[e];
                    ss += __shfl_xor(ss, 1); ss += __shfl_xor(ss, 2); ss += __shfl_xor(ss, 4); ss += __shfl_xor(ss, 8);
                    const float rstd = rsqrtf(ss * (1.f / 128.f) + EPS);
                    float y[8];
#pragma unroll
                    for (int e = 0; e < 8; ++e) { const float gg = e < 4 ? gh0[e] : gh1[e - 4]; y[e] = o[e] * rstd * gg * (r[e] / (1.f + __expf(-r[e]))); }
                    const u32x4 w = {pk2(y[0], y[1]), pk2(y[2], y[3]), pk2(y[4], y[5]), pk2(y[6], y[7])};
                    *(u32x4*)(MIX + t * D + 8 * lane) = w; }
            }
        }
        __syncthreads();
        {
            const int c = tid, gi = c >> 7, cc = c & 127, hw = 1 << gi;
            LAS unsigned char* ag = at + gi * 16384;
            const LAS bf16_t* pc = pt + c;
            if (s0 >= 8 && s0 + 64 + 8 <= SEQ) {
                const float inv = 0.5f / (float)hw;
                float sum = 0.f;
                for (int rr = 8 - hw; rr < 8 + hw; ++rr) sum += bflo((unsigned)pc[rr * 512]);
#pragma unroll 4
                for (int i = 0; i < 64; ++i) {
                    const float val = sum * inv - bflo((unsigned)pc[(i + 8) * 512]);
                    *(LAS bf16_t*)(ag + i * 256 + (((cc >> 3) ^ (i & 15)) * 16) + (cc & 7) * 2) = (bf16_t)(pk2(val, 0.f) & 0xFFFFu);
                    sum += bflo((unsigned)pc[(i + 8 + hw) * 512]) - bflo((unsigned)pc[(i + 8 - hw) * 512]);
                }
            } else {
                float sum = 0.f;
                {   const int lo = max(s0 - hw, 0), hi = min(s0 + hw, SEQ);
                    for (int rr = lo; rr < hi; ++rr) sum += bflo((unsigned)pc[(rr - s0 + 8) * 512]); }
#pragma unroll 4
                for (int i = 0; i < 64; ++i) {
                    const int sq = s0 + i, lo = max(sq - hw, 0), hi = min(sq + hw, SEQ);
                    const float val = sum * __builtin_amdgcn_rcpf((float)(hi - lo)) - bflo((unsigned)pc[(i + 8) * 512]);
                    *(LAS bf16_t*)(ag + i * 256 + (((cc >> 3) ^ (i & 15)) * 16) + (cc & 7) * 2) = (bf16_t)(pk2(val, 0.f) & 0xFFFFu);
                    if (sq + hw < SEQ) sum += bflo((unsigned)pc[(i + 8 + hw) * 512]);
                    if (sq - hw >= 0) sum -= bflo((unsigned)pc[(i + 8 - hw) * 512]);
                }
            }
        }
        __syncthreads();
        {
            const int gi = wave >> 1, dh = wave & 1;
            LAS unsigned char* ag = at + gi * 16384;
            f32x4 acc[4][4];
#pragma unroll
            for (int mt = 0; mt < 4; ++mt)
#pragma unroll
                for (int nt = 0; nt < 4; ++nt) acc[mt][nt] = (f32x4){0.f, 0.f, 0.f, 0.f};
#pragma unroll
            for (int s = 0; s < 4; ++s) {
                bf16x8 af[4];
#pragma unroll
                for (int mt = 0; mt < 4; ++mt) { const int row = mt * 16 + c15; af[mt] = *(const LAS bf16x8*)(ag + row * 256 + (((4 * s + g) ^ (row & 15)) * 16)); }
#pragma unroll
                for (int nt = 0; nt < 4; ++nt) {
                    const bf16x8 wf = ld_frag16(WP + (size_t)gi * 16384 + (dh * 64 + 16 * nt + c15) * 128 + 32 * s + 8 * g);
#pragma unroll
                    for (int mt = 0; mt < 4; ++mt) acc[mt][nt] = MFMA16(wf, af[mt], acc[mt][nt]);
                }
            }
#pragma unroll
            for (int nt = 0; nt < 4; ++nt) {
                const f32x4 ps = *(const f32x4*)(p.in[13] + gi * 128 + dh * 64 + 16 * nt + 4 * g);
#pragma unroll
                for (int mt = 0; mt < 4; ++mt) {
                    const f32x4 v = acc[mt][nt] * ps;
                    u32x2 w = {pk2(v[0], v[1]), pk2(v[2], v[3])};
                    *(u32x2*)(MIX + ((size_t)tok0 + mt * 16 + c15) * D + 512 + gi * 128 + dh * 64 + 16 * nt + 4 * g) = w;
                }
            }
        }
    }
}

DI void phase4c(const Params& p, LAS unsigned char* lds, int tid, int lane, int wave) {
    asm volatile("" : "+v"(tid), "+v"(lane));
    LAS float* lG = (LAS float*)lds; LAS float* lA = lG + 1024; LAS float* lB = lA + 1024; LAS float* lP = lB + 1024;
    const float* x = p.in[0]; const bf16_t* MIXO = (const bf16_t*)(p.ws + WS_RZ); bf16_t* H2 = (bf16_t*)(p.ws + WS_RA);
    for (int rt = blockIdx.x; rt < T / 128; rt += gridDim.x) {
        const int b = rt / 32;
        __syncthreads();
        for (int d = tid; d < 1024; d += NTH) { lG[d] = mod_at(p, b, 2048 + d); lA[d] = p.in[15][d] * (1.f + mod_at(p, b, 4096 + d)); lB[d] = mod_at(p, b, 3072 + d); lP[d] = p.in[5][d]; }
        __syncthreads();
        for (int r0 = wave; r0 < 128; r0 += 4 * NWV) {
            f32x4 m[4][4], xv[4][4];
#pragma unroll
            for (int u = 0; u < 4; ++u) {
                const size_t row = (size_t)rt * 128 + r0 + u * NWV;
                const u32x2* mr = (const u32x2*)(MIXO + row * D) + lane; const f32x4* xr = (const f32x4*)(x + row * D) + lane;
#pragma unroll
                for (int j = 0; j < 4; ++j) { const u32x2 mv = mr[64 * j]; m[u][j] = (f32x4){bflo(mv.x), bfhi(mv.x), bflo(mv.y), bfhi(mv.y)}; xv[u][j] = xr[64 * j]; }
            }
#pragma unroll
            for (int u = 0; u < 4; ++u) {
                const size_t row = (size_t)rt * 128 + r0 + u * NWV;
                float ss = 0.f;
#pragma unroll
                for (int j = 0; j < 4; ++j) ss += m[u][j][0] * m[u][j][0] + m[u][j][1] * m[u][j][1] + m[u][j][2] * m[u][j][2] + m[u][j][3] * m[u][j][3];
                const float rstd = rsqrtf(wave_sum(ss) * (1.f / D) + EPS);
                float s2 = 0.f;
#pragma unroll
                for (int j = 0; j < 4; ++j) {
                    const f32x4 gt = *(const LAS f32x4*)(lG + 4 * lane + 256 * j), pm = *(const LAS f32x4*)(lP + 4 * lane + 256 * j);
                    xv[u][j] = xv[u][j] + gt * (m[u][j] * rstd * pm);
                    s2 += xv[u][j][0] * xv[u][j][0] + xv[u][j][1] * xv[u][j][1] + xv[u][j][2] * xv[u][j][2] + xv[u][j][3] * xv[u][j][3];
                }
                const float rstd2 = rsqrtf(wave_sum(s2) * (1.f / D) + EPS);
                u32x2* orow = (u32x2*)((bf16_t*)(p.ws + WS_RO) + row * D) + lane; u32x2* hrow = (u32x2*)(H2 + row * D) + lane;
#pragma unroll
                for (int j = 0; j < 4; ++j) {
                    { const u32x2 xw = {pk2(xv[u][j][0], xv[u][j][1]), pk2(xv[u][j][2], xv[u][j][3])}; orow[64 * j] = xw; }
                    const f32x4 a = *(const LAS f32x4*)(lA + 4 * lane + 256 * j), bb = *(const LAS f32x4*)(lB + 4 * lane + 256 * j);
                    const f32x4 hv = xv[u][j] * rstd2 * a + bb;
                    u32x2 w = {pk2(hv[0], hv[1]), pk2(hv[2], hv[3])};
                    hrow[64 * j] = w;
                }
            }
        }
    }
}

DI int skey(float v, int idx, int mask) { int u = __float_as_int(v); u ^= (u >> 31) & 0x7FFFFFFF; return (u & ~mask) | idx; }
DI float sval(int k, int mask) { int u = k & ~mask; u ^= (u >> 31) & 0x7FFFFFFF; return __int_as_float(u); }
DI void cswap(int& a, int& b) { const int mx = max(a, b), mn = min(a, b); a = mx; b = mn; }
DI void sort16_desc(int (&a)[16]) {
    cswap(a[0], a[13]); cswap(a[1], a[12]); cswap(a[2], a[15]); cswap(a[3], a[14]); cswap(a[4], a[8]); cswap(a[5], a[6]); cswap(a[7], a[11]); cswap(a[9], a[10]);
    cswap(a[0], a[5]); cswap(a[1], a[7]); cswap(a[2], a[9]); cswap(a[3], a[4]); cswap(a[6], a[13]); cswap(a[8], a[14]); cswap(a[10], a[15]); cswap(a[11], a[12]);
    cswap(a[0], a[1]); cswap(a[2], a[3]); cswap(a[4], a[5]); cswap(a[6], a[8]); cswap(a[7], a[9]); cswap(a[10], a[11]); cswap(a[12], a[13]); cswap(a[14], a[15]);
    cswap(a[0], a[2]); cswap(a[1], a[3]); cswap(a[4], a[10]); cswap(a[5], a[11]); cswap(a[6], a[7]); cswap(a[8], a[9]); cswap(a[12], a[14]); cswap(a[13], a[15]);
    cswap(a[1], a[2]); cswap(a[3], a[12]); cswap(a[4], a[6]); cswap(a[5], a[7]); cswap(a[8], a[10]); cswap(a[9], a[11]); cswap(a[13], a[14]);
    cswap(a[1], a[4]); cswap(a[2], a[6]); cswap(a[5], a[8]); cswap(a[7], a[10]); cswap(a[9], a[13]); cswap(a[11], a[14]);
    cswap(a[2], a[4]); cswap(a[3], a[6]); cswap(a[9], a[12]); cswap(a[11], a[13]);
    cswap(a[3], a[5]); cswap(a[6], a[8]); cswap(a[7], a[9]); cswap(a[10], a[12]);
    cswap(a[3], a[4]); cswap(a[5], a[6]); cswap(a[7], a[8]); cswap(a[9], a[10]); cswap(a[11], a[12]);
    cswap(a[6], a[7]); cswap(a[8], a[9]);
}
DI void merge16_desc(int (&x)[16], const int (&y)[16]) {
#pragma unroll
    for (int i = 0; i < 16; ++i) x[i] = max(x[i], y[15 - i]);
#pragma unroll
    for (int j = 8; j > 0; j >>= 1) {
#pragma unroll
        for (int i = 0; i < 16; ++i) { const int l = i ^ j; if (l > i) cswap(x[i], x[l]); }
    }
}

DI void phase5b(const Params& p, LAS unsigned char* lds, int tid, int lane, int wave) {
    asm volatile("" : "+v"(tid), "+v"(lane));
    unsigned char* ws = p.ws;
    const bf16_t* Q2 = (const bf16_t*)(ws + WS_RZ);
    const bf16_t* SKB = (const bf16_t*)(ws + WS_SKB);
    int* EIDX = (int*)(ws + WS_RS); float* GATE = (float*)(ws + WS_RS + 16 * MB);
    LAS unsigned char* tab = lds + tid * 32;
    LAS unsigned char* skl = lds + 16384;
    const int c31 = lane & 31, hi = lane >> 5;
    for (int btask = blockIdx.x; btask < 256; btask += gridDim.x) {
        const int h = btask & 7, tgc = btask >> 3;
        __syncthreads();
#pragma unroll
        for (int ps = 0; ps < 8; ++ps) {
            const int idx = tid + NTH * ps, row = idx >> 4, ch = idx & 15;
            const u32x4 v = *(const u32x4*)(SKB + ((size_t)h * 256 + row) * 128 + ch * 8);
            *(LAS u32x4*)(skl + row * 256 + ((ch ^ (row & 15)) * 16)) = v;
        }
        __syncthreads();
      for (int ti = 0; ti < 4; ++ti) {
        const int tg = tgc * 32 + wave * 4 + ti;
        const size_t tok = (size_t)tg * 32 + c31;
        int lst[2][16];
        bf16x8 bq[2][8];
#pragma unroll
        for (int pp = 0; pp < 2; ++pp) {
            const bf16_t* qp = Q2 + tok * 2048 + h * 256 + pp * 128 + 8 * hi;
            asm volatile("" : "+v"(qp));
#pragma unroll
            for (int ks = 0; ks < 8; ++ks) bq[pp][ks] = ld_frag16(qp + 16 * ks);
        }
#pragma unroll
        for (int pp = 0; pp < 2; ++pp) {
            int run[16];
#pragma unroll
            for (int r = 0; r < 16; ++r) run[r] = (int)0x80000000;
#pragma unroll 1
            for (int kt = 0; kt < 4; ++kt) {
                const LAS unsigned char* kb = skl + pp * 32768 + (32 * kt + c31) * 256;
                f32x16 acc;
#pragma unroll
                for (int r = 0; r < 16; ++r) acc[r] = 0.f;
#pragma unroll
                for (int ks = 0; ks < 8; ++ks) acc = MFMA32(*(const LAS bf16x8*)(kb + (((2 * ks + hi) ^ (c31 & 15)) * 16)), bq[pp][ks], acc);
                int cur[16];
#pragma unroll
                for (int r = 0; r < 16; ++r) cur[r] = skey(acc[r], 32 * kt + 8 * (r >> 2) + 4 * hi + (r & 3), 0x7F);
                sort16_desc(cur);
                merge16_desc(run, cur);
            }
            int oth[16];
#pragma unroll
            for (int r = 0; r < 16; ++r) oth[r] = __shfl_xor(run[r], 32);
            merge16_desc(run, oth);
#pragma unroll
            for (int r = 0; r < 16; ++r) lst[pp][r] = run[r];
        }
#pragma unroll
        for (int pp = 0; pp < 2; ++pp) {
            u32x4 w;
#pragma unroll
            for (int q = 0; q < 4; ++q) w[q] = (lst[pp][4 * q] & 0x7F) | ((lst[pp][4 * q + 1] & 0x7F) << 8) | ((lst[pp][4 * q + 2] & 0x7F) << 16) | ((lst[pp][4 * q + 3] & 0x7F) << 24);
            *(LAS u32x4*)(tab + 16 * pp) = w;
        }
        float va[16], vb[16];
#pragma unroll
        for (int r = 0; r < 16; ++r) { va[r] = sval(lst[0][r], 0x7F); vb[r] = sval(lst[1][r], 0x7F); }
        int cand[4][16];
        {
            int cnt = 0;
#pragma unroll
            for (int i = 0; i < 16; ++i)
#pragma unroll
                for (int j = 0; j < 16; ++j)
                    if ((i + 1) * (j + 1) <= 16) { cand[cnt >> 4][cnt & 15] = skey(va[i] + vb[j], (i << 4) | j, 0xFF); ++cnt; }
#pragma unroll
            for (int q = 50; q < 64; ++q) cand[q >> 4][q & 15] = (int)0x80000000;
        }
        sort16_desc(cand[0]); sort16_desc(cand[1]); sort16_desc(cand[2]); sort16_desc(cand[3]);
        merge16_desc(cand[0], cand[1]); merge16_desc(cand[2], cand[3]); merge16_desc(cand[0], cand[2]);
        asm volatile("s_waitcnt lgkmcnt(0)" ::: "memory");
        float sv[16]; int ex[16];
        const float mx = sval(cand[0][0], 0xFF);
        float sum = 0.f;
#pragma unroll
        for (int r = 0; r < 16; ++r) {
            const int ck = cand[0][r];
            const int i1 = tab[(ck >> 4) & 15], i2 = tab[16 + (ck & 15)];
            ex[r] = i1 * 128 + i2;
            sv[r] = __expf(sval(ck, 0xFF) - mx); sum += sv[r];
        }
        const float inv = 1.f / sum;
        int* ep = EIDX + tok * 128 + h * 16 + 8 * hi; float* gp = GATE + tok * 128 + h * 16 + 8 * hi;
        if (hi == 0) {
            *(u32x4*)ep = (u32x4){(unsigned)ex[0], (unsigned)ex[1], (unsigned)ex[2], (unsigned)ex[3]}; *(u32x4*)(ep + 4) = (u32x4){(unsigned)ex[4], (unsigned)ex[5], (unsigned)ex[6], (unsigned)ex[7]};
            *(f32x4*)gp = (f32x4){sv[0] * inv, sv[1] * inv, sv[2] * inv, sv[3] * inv}; *(f32x4*)(gp + 4) = (f32x4){sv[4] * inv, sv[5] * inv, sv[6] * inv, sv[7] * inv};
        } else {
            *(u32x4*)ep = (u32x4){(unsigned)ex[8], (unsigned)ex[9], (unsigned)ex[10], (unsigned)ex[11]}; *(u32x4*)(ep + 4) = (u32x4){(unsigned)ex[12], (unsigned)ex[13], (unsigned)ex[14], (unsigned)ex[15]};
            *(f32x4*)gp = (f32x4){sv[8] * inv, sv[9] * inv, sv[10] * inv, sv[11] * inv}; *(f32x4*)(gp + 4) = (f32x4){sv[12] * inv, sv[13] * inv, sv[14] * inv, sv[15] * inv};
        }
      }
    }
}

template <int K> DI int swz_bcast(int v) { return __builtin_amdgcn_ds_swizzle(v, 0x10 | (K << 5)); }
template <int W> DI int swz_xor(int v) { return __builtin_amdgcn_ds_swizzle(v, 0x1F | (W << 10)); }
template <int K> struct IC { static constexpr int v = K; };
template <int N, int I = 0, class F> DI void static_for(F&& f) { if constexpr (I < N) { f(IC<I>{}); static_for<N, I + 1>(f); } }
DI float row16_sum(float v) {
    v += __builtin_bit_cast(float, __builtin_amdgcn_update_dpp(0, __builtin_bit_cast(int, v), 0xB1, 0xF, 0xF, true));
    v += __builtin_bit_cast(float, __builtin_amdgcn_update_dpp(0, __builtin_bit_cast(int, v), 0x4E, 0xF, 0xF, true));
    v += __builtin_bit_cast(float, __builtin_amdgcn_update_dpp(0, __builtin_bit_cast(int, v), 0x141, 0xF, 0xF, true));
    v += __builtin_bit_cast(float, __builtin_amdgcn_update_dpp(0, __builtin_bit_cast(int, v), 0x140, 0xF, 0xF, true));
    return v;
}
DI void phase6(const Params& p, LAS unsigned char* lds, int tid, int lane, int wave) {
    asm volatile("" : "+v"(tid), "+v"(lane));
    unsigned char* ws = p.ws;
    const bf16_t* H2 = (const bf16_t*)(ws + WS_RA);
    const unsigned char* UQ = ws + WS_UB; const unsigned char* VQ = ws + WS_VB;
    const float* SU = (const float*)(ws + WS_SU); const float* SV = (const float*)(ws + WS_SV);
    const int* EIDX = (const int*)(ws + WS_RS); const float* GATE = (const float*)(ws + WS_RS + 16 * MB);
    LAS float* lG = (LAS float*)lds;
    const int q = lane >> 4, l16 = lane & 15;
    LAS int* le = (LAS int*)(lds + 4096 + wave * 6144) + q * 128;
    LAS float* lg = (LAS float*)(lds + 4096 + wave * 6144 + 2048) + q * 128;
    LAS float* lc = (LAS float*)(lds + 4096 + wave * 6144 + 4096) + q * 128;
    const unsigned qlo = q < 2 ? (0xFFFFu << (16 * q)) : 0u, qhi = q >= 2 ? (0xFFFFu << (16 * (q - 2))) : 0u;
    for (int rt = blockIdx.x; rt < T / 128; rt += gridDim.x) {
        const int b = rt / 32;
        __syncthreads();
        for (int d = tid; d < 1024; d += NTH) lG[d] = mod_at(p, b, 5120 + d) * p.in[16][d];
        __syncthreads();
#pragma unroll 1
        for (int rd = 0; rd < 4; ++rd) {
            __syncthreads();
            const size_t t = (size_t)rt * 128 + wave * 16 + rd * 4 + q;
            {
                int e[8]; float g[8];
#pragma unroll
                for (int r = 0; r < 8; ++r) { e[r] = EIDX[t * 128 + r * 16 + l16]; g[r] = GATE[t * 128 + r * 16 + l16]; }
                unsigned W[4] = {0u, 0u, 0u, 0u};
#pragma unroll
                for (int r = 0; r < 8; ++r) {
                    const int k = e[r] >> 10; const unsigned inc = 1u << (8 * (k & 3)); const int w = k >> 2;
                    W[0] += (w == 0) ? inc : 0u; W[1] += (w == 1) ? inc : 0u; W[2] += (w == 2) ? inc : 0u; W[3] += (w == 3) ? inc : 0u;
                }
                unsigned C[4];
                {
                    unsigned tot[4], exc[4];
#pragma unroll
                    for (int w = 0; w < 4; ++w) {
                        unsigned x = W[w];
                        x += (unsigned)__builtin_amdgcn_update_dpp(0, (int)x, 0x111, 0xF, 0xF, true);
                        x += (unsigned)__builtin_amdgcn_update_dpp(0, (int)x, 0x112, 0xF, 0xF, true);
                        x += (unsigned)__builtin_amdgcn_update_dpp(0, (int)x, 0x114, 0xF, 0xF, true);
                        x += (unsigned)__builtin_amdgcn_update_dpp(0, (int)x, 0x118, 0xF, 0xF, true);
                        exc[w] = x - W[w];
                        tot[w] = (unsigned)swz_bcast<15>((int)x);
                    }
                    unsigned carry = 0u;
#pragma unroll
                    for (int w = 0; w < 4; ++w) {
                        const unsigned P = tot[w] + (tot[w] << 8) + (tot[w] << 16) + (tot[w] << 24);
                        C[w] = (P - tot[w]) + carry * 0x01010101u + exc[w];
                        carry += P >> 24;
                    }
                }
#pragma unroll
                for (int r = 0; r < 8; ++r) {
                    const int k = e[r] >> 10; const int sh = 8 * (k & 3); const int w = k >> 2; const unsigned inc = 1u << sh;
                    const unsigned cw = (w == 0) ? C[0] : (w == 1) ? C[1] : (w == 2) ? C[2] : C[3];
                    const int pos = (int)((cw >> sh) & 0xFFu);
                    le[pos] = e[r]; lg[pos] = g[r];
                    C[0] += (w == 0) ? inc : 0u; C[1] += (w == 1) ? inc : 0u; C[2] += (w == 2) ? inc : 0u; C[3] += (w == 3) ? inc : 0u;
                }
                asm volatile("s_waitcnt lgkmcnt(0)" ::: "memory");
            }
            {
                int hq[16]; float ish;
                {
                    float hv[64]; float hm = 0.f;
#pragma unroll
                    for (int i = 0; i < 4; ++i) {
                        const u32x4 h0 = *(const u32x4*)(H2 + t * D + 256 * i + 16 * l16), h1 = *(const u32x4*)(H2 + t * D + 256 * i + 16 * l16 + 8);
#pragma unroll
                        for (int c = 0; c < 4; ++c) { hv[16 * i + 2 * c] = bflo(h0[c]); hv[16 * i + 2 * c + 1] = bfhi(h0[c]); hv[16 * i + 8 + 2 * c] = bflo(h1[c]); hv[16 * i + 8 + 2 * c + 1] = bfhi(h1[c]); }
                    }
#pragma unroll
                    for (int j = 0; j < 64; ++j) hm = fmaxf(hm, fabsf(hv[j]));
                    hm = fmaxf(hm, __builtin_bit_cast(float, __builtin_amdgcn_update_dpp(0, __builtin_bit_cast(int, hm), 0xB1, 0xF, 0xF, true)));
                    hm = fmaxf(hm, __builtin_bit_cast(float, __builtin_amdgcn_update_dpp(0, __builtin_bit_cast(int, hm), 0x4E, 0xF, 0xF, true)));
                    hm = fmaxf(hm, __builtin_bit_cast(float, __builtin_amdgcn_update_dpp(0, __builtin_bit_cast(int, hm), 0x141, 0xF, 0xF, true)));
                    hm = fmaxf(hm, __builtin_bit_cast(float, __builtin_amdgcn_update_dpp(0, __builtin_bit_cast(int, hm), 0x140, 0xF, 0xF, true)));
                    const float s8 = hm > 1e-30f ? 127.f / hm : 0.f; ish = hm * (1.f / 127.f);
#pragma unroll
                    for (int d = 0; d < 16; ++d) {
                        const int q0 = __float2int_rn(hv[4 * d] * s8), q1 = __float2int_rn(hv[4 * d + 1] * s8), q2 = __float2int_rn(hv[4 * d + 2] * s8), q3 = __float2int_rn(hv[4 * d + 3] * s8);
                        hq[d] = (int)((unsigned)(q0 & 0xFF) | ((unsigned)(q1 & 0xFF) << 8) | ((unsigned)(q2 & 0xFF) << 16) | ((unsigned)q3 << 24));
                    }
                }
                constexpr int UD = 4;
                u32x4 ub[UD][4];
                int evn = le[l16];
                static_for<UD>([&](auto kc) { constexpr int k = decltype(kc)::v; const unsigned char* up = UQ + (size_t)swz_bcast<k>(evn) * 1024 + 16 * l16;
#pragma unroll
                    for (int i = 0; i < 4; ++i) ub[k][i] = *(const u32x4*)(up + 256 * i); });
#pragma unroll 1
                for (int bt = 0; bt < 8; ++bt) {
                    if (bt) __syncthreads();
                    const int ev = evn; const float gv = lg[bt * 16 + l16];
                    evn = le[(bt < 7 ? bt + 1 : 7) * 16 + l16];
                    const float isu = SU[ev] * ish, isv = SV[ev];
                    int part[16];
                    static_for<16>([&](auto kc) {
                        constexpr int k = decltype(kc)::v, sl = k % UD;
                        int a = 0;
#pragma unroll
                        for (int i = 0; i < 4; ++i) {
                            const u32x4 u = ub[sl][i];
#pragma unroll
                            for (int c = 0; c < 4; ++c) a = __builtin_amdgcn_sdot4((int)u[c], hq[4 * i + c], a, false);
                        }
                        part[k] = a;
                        {
                            constexpr int kn = k + UD;
                            int idx; if constexpr (kn < 16) idx = swz_bcast<(kn & 15)>(ev); else idx = swz_bcast<(kn & 15)>(evn);
                            const unsigned char* up = UQ + (size_t)idx * 1024 + 16 * l16;
#pragma unroll
                            for (int i = 0; i < 4; ++i) ub[sl][i] = *(const u32x4*)(up + 256 * i);
                        }
                    });
                    static_for<4>([&](auto sc) {
                        constexpr int w = 8 >> decltype(sc)::v;
                        const bool up2 = (lane & w) != 0;
#pragma unroll
                        for (int e = 0; e < w; ++e) {
                            const int keep = up2 ? part[e + w] : part[e], send = up2 ? part[e] : part[e + w];
                            part[e] = keep + swz_xor<w>(send);
                        }
                    });
                    const float dot = (float)part[0] * isu;
                    lc[bt * 16 + l16] = gv * 0.5f * dot * (1.f + erff(dot * 0.70710678118654752f)) * isv;
                }
                asm volatile("s_waitcnt lgkmcnt(0)" ::: "memory");
            }
            __syncthreads();
            f32x2 y[32];
#pragma unroll
            for (int i = 0; i < 32; ++i) y[i] = (f32x2){0.f, 0.f};
            {
                constexpr int VD = 4;
                u32x4 vbuf[VD][4];
                int evn = le[l16];
                static_for<VD>([&](auto kc) { constexpr int k = decltype(kc)::v; const unsigned char* vp = VQ + (size_t)swz_bcast<k>(evn) * 1024 + 16 * l16;
#pragma unroll
                    for (int i = 0; i < 4; ++i) vbuf[k][i] = *(const u32x4*)(vp + 256 * i); });
#pragma unroll 1
                for (int bt = 0; bt < 8; ++bt) {
                    if (bt) __syncthreads();
                    const int ev = evn; const int cv = __float_as_int(lc[bt * 16 + l16]);
                    evn = le[(bt < 7 ? bt + 1 : 7) * 16 + l16];
                    static_for<16>([&](auto kc) {
                        constexpr int k = decltype(kc)::v, sl = k % VD;
                        const float cc = __int_as_float(swz_bcast<k>(cv));
                        const f32x2 c2 = (f32x2){cc, cc};
#pragma unroll
                        for (int i = 0; i < 4; ++i) {
                            const u32x4 v = vbuf[sl][i];
#pragma unroll
                            for (int c = 0; c < 4; ++c) {
                                const int w = (int)v[c];
                                y[8 * i + 2 * c] = __builtin_elementwise_fma(__builtin_amdgcn_cvt_pk_f32_fp8(w, false), c2, y[8 * i + 2 * c]);
                                y[8 * i + 2 * c + 1] = __builtin_elementwise_fma(__builtin_amdgcn_cvt_pk_f32_fp8(w, true), c2, y[8 * i + 2 * c + 1]);
                            }
                        }
                        {
                            constexpr int kn = k + VD;
                            int idx; if constexpr (kn < 16) idx = swz_bcast<(kn & 15)>(ev); else idx = swz_bcast<(kn & 15)>(evn);
                            const unsigned char* vp = VQ + (size_t)idx * 1024 + 16 * l16;
#pragma unroll
                            for (int i = 0; i < 4; ++i) vbuf[sl][i] = *(const u32x4*)(vp + 256 * i);
                        }
                    });
                }
            }
            float ss = 0.f;
#pragma unroll
            for (int i = 0; i < 32; ++i) ss += y[i].x * y[i].x + y[i].y * y[i].y;
            const float rstd = rsqrtf(row16_sum(ss) * (1.f / D) + EPS);
            float* orow = p.out + t * D;
#pragma unroll
            for (int i = 0; i < 4; ++i)
#pragma unroll
                for (int c = 0; c < 4; ++c) {
                    const int col = 256 * i + 16 * l16 + 4 * c;
                    const u32x2 xb = *(const u32x2*)((const bf16_t*)(ws + WS_RO) + t * D + col);
                    f32x4 xv = {bflo(xb.x), bfhi(xb.x), bflo(xb.y), bfhi(xb.y)};
                    const f32x4 gg = *(const LAS f32x4*)(lG + col);
                    xv[0] += gg[0] * y[8 * i + 2 * c].x * rstd; xv[1] += gg[1] * y[8 * i + 2 * c].y * rstd; xv[2] += gg[2] * y[8 * i + 2 * c + 1].x * rstd; xv[3] += gg[3] * y[8 * i + 2 * c + 1].y * rstd;
                    *(f32x4*)(orow + col) = xv;
                }
        }
    }
}


__global__ void __launch_bounds__(NTH) fwd_megakernel(Params p) {
    extern __shared__ __attribute__((aligned(16))) unsigned char lds_raw[];
    LAS unsigned char* lds = (LAS unsigned char*)lds_raw;
    const int tid = threadIdx.x, lane = tid & 63, wave = __builtin_amdgcn_readfirstlane(tid >> 6);
    volatile LAS unsigned* st = (volatile LAS unsigned*)(lds + LDS_BARW);
    if (tid == 0) { st[0] = 0u; st[1] = 0u; st[2] = 0u; st[3] = 0u; }
    __syncthreads();
    XcdBarrier bar = xcd_barrier_post((unsigned*)(p.ws + WS_CTL), st);
    unsigned char* ws = p.ws;

    phase0(p, lds, tid, lane, wave);
    xcd_barrier(bar);
    phase1(p, lds, tid, lane, wave);
    xcd_barrier(bar);
    { pg8::Gemm g{(const bf16_t*)(ws + WS_RA), (const bf16_t*)(ws + WS_WIN), T, ZW, D}; pg8::StaticOrder S; S.init(T, ZW, (int)gridDim.x, (int)blockIdx.x);
      pg8::EpiB16 e{(bf16_t*)(ws + WS_RZ), ZW}; pg8::gemm_phase<pg8::EpiB16, pg8::StaticOrder, true, true>(lds, g, S, e);
      EpiZ e2{(bf16_t*)(ws + WS_RZ), (float*)(ws + WS_AFB)}; gemm_phase(((const bf16_t*)(ws + WS_RA)), (const bf16_t*)(ws + WS_WIN), T, NIN, D, e2, lds, tid, lane, wave, 16); }
    xcd_barrier(bar);
    phaseGA(p, lds, tid, lane, wave);
    xcd_barrier(bar);
    phaseGB(p, tid);
    xcd_barrier(bar);
    phase4a(p, lds, tid, lane, wave);
    xcd_barrier(bar);
    { pg8::Gemm g{(const bf16_t*)(ws + WS_RA), (const bf16_t*)(ws + WS_WOUT), T, D, D}; pg8::StaticOrder S; S.init(T, D, (int)gridDim.x, (int)blockIdx.x);
      pg8::EpiB16 e{(bf16_t*)(ws + WS_RZ), D}; pg8::gemm_phase<pg8::EpiB16, pg8::StaticOrder, true, true>(lds, g, S, e); }
    xcd_barrier(bar);
    phase4c(p, lds, tid, lane, wave);
    xcd_barrier(bar);
    { pg8::Gemm g{(const bf16_t*)(ws + WS_RA), (const bf16_t*)(ws + WS_WQ), T, 2048, D}; pg8::StaticOrder S; S.init(T, 2048, (int)gridDim.x, (int)blockIdx.x);
      pg8::EpiB16 e{(bf16_t*)(ws + WS_RZ), 2048}; pg8::gemm_phase<pg8::EpiB16, pg8::StaticOrder, true, true>(lds, g, S, e); }
    xcd_barrier(bar);
    phase5b(p, lds, tid, lane, wave);
    xcd_barrier(bar);
    phase6(p, lds, tid, lane, wave);
}

extern "C" void kernel_launch(void* const* d_in, const int* in_sizes, int n_in, void* d_out, int out_size, void* d_ws, size_t ws_size, hipStream_t stream) {
    static int grid = 0;
    if (grid == 0) {
        if (n_in != 21 || out_size != T * D || ws_size < WS_END) { fprintf(stderr, "kernel_launch: unexpected shapes (n_in %d out %d ws %zu need %zu)\n", n_in, out_size, ws_size, (size_t)WS_END); grid = -1; return; }
        int dev = 0, cus = 0, per_cu = 0;
        hipGetDevice(&dev); hipDeviceGetAttribute(&cus, hipDeviceAttributeMultiprocessorCount, dev);
        hipFuncSetAttribute((const void*)fwd_megakernel, hipFuncAttributeMaxDynamicSharedMemorySize, LDS_BYTES);
        hipOccupancyMaxActiveBlocksPerMultiprocessor(&per_cu, (const void*)fwd_megakernel, NTH, LDS_BYTES);
        (void)hipGetLastError();
        if (per_cu < 1) fprintf(stderr, "kernel_launch: occupancy query says %d blocks per CU\n", per_cu);
        grid = cus;
    }
    if (grid < 0) return;
    hipMemsetAsync((char*)d_ws + WS_CTL, 0, 64 * 1024, stream);
    Params p{};
    for (int i = 0; i < 21; ++i) p.in[i] = (const float*)d_in[i];
    p.out = (float*)d_out; p.ws = (unsigned char*)d_ws;
    hipLaunchKernelGGL(fwd_megakernel, dim3(grid), dim3(NTH), LDS_BYTES, stream, p);
}
```

```cpp
#include <hip/hip_runtime.h>
#include <cstdio>
#include <cstdint>

#define DI __device__ __forceinline__
#define LAS __attribute__((address_space(3)))
typedef unsigned short bf16_t;
typedef short bf16x8 __attribute__((ext_vector_type(8)));
typedef float f32x4 __attribute__((ext_vector_type(4)));
typedef float f32x2 __attribute__((ext_vector_type(2)));
typedef float f32x16 __attribute__((ext_vector_type(16)));
typedef unsigned u32x4 __attribute__((ext_vector_type(4)));
typedef unsigned u32x2 __attribute__((ext_vector_type(2)));
typedef __bf16 bf16x2v __attribute__((ext_vector_type(2)));

constexpr int T = 32768, D = 1024, SEQ = 4096, NB = 8;
constexpr int NTH = 512, NWV = 8;
constexpr int ZW = 2048;
constexpr int NIN = 2176;
constexpr float EPS = 1e-6f;

constexpr size_t MB = 1024 * 1024;
constexpr size_t WS_CTL   = 0;
constexpr size_t WS_MODP  = 64 * 1024;
constexpr size_t WS_WIN   = WS_MODP + 8 * 8 * 6144 * 4;
constexpr size_t WS_WOUT  = WS_WIN + (size_t)NIN * 1024 * 2;
constexpr size_t WS_WQ    = WS_WOUT + 1024 * 1024 * 2;
constexpr size_t WS_SKB   = WS_WQ + 2048 * 1024 * 2;
constexpr size_t WS_WP    = WS_SKB + 16 * 128 * 128 * 2;
constexpr size_t WS_AFB   = WS_WP + 4 * 128 * 128 * 2;
constexpr size_t WS_UB    = WS_AFB + (size_t)T * 32 * 4;
constexpr size_t WS_VB    = WS_UB + 32 * MB;
constexpr size_t WS_SU    = WS_UB + 16 * MB, WS_SV = WS_VB + 16 * MB;
constexpr size_t WS_RA    = WS_VB + 32 * MB;
constexpr size_t WS_RZ    = WS_RA + 64 * MB;
constexpr size_t WS_RS    = WS_RZ + 128 * MB;
constexpr size_t WS_RO    = WS_RS + 6 * 16 * MB + 1 * MB;
constexpr size_t WS_END   = WS_RO + 128 * MB;
static_assert(WS_END <= 512 * MB, "workspace too large");

struct Params { const float* in[21]; float* out; unsigned char* ws; };

DI unsigned pk2(float a, float b) { f32x2 f = {a, b}; bf16x2v h = __builtin_convertvector(f, bf16x2v); return __builtin_bit_cast(unsigned, h); }
DI float dot2bf(unsigned a, unsigned b, float c) { return __builtin_amdgcn_fdot2_f32_bf16(__builtin_bit_cast(bf16x2v, a), __builtin_bit_cast(bf16x2v, b), c, false); }
DI float bflo(unsigned u) { return __uint_as_float(u << 16); }
DI float bfhi(unsigned u) { return __uint_as_float(u & 0xFFFF0000u); }
DI float wave_sum(float v) {
#pragma unroll
    for (int o = 1; o < 64; o <<= 1) v += __shfl_xor(v, o);
    return v;
}
DI bf16x8 ld_frag16(const bf16_t* p) { return __builtin_bit_cast(bf16x8, *(const u32x4*)p); }
DI bf16x8 ld_frag_perm(const bf16_t* p, int g) {
    const u32x2 lo = *(const u32x2*)(p + 4 * g), hi = *(const u32x2*)(p + 16 + 4 * g);
    u32x4 v = {lo.x, lo.y, hi.x, hi.y}; return __builtin_bit_cast(bf16x8, v);
}
DI int perm32(int k) { return (k & ~31) | (((k >> 2) & 3) << 3) | (((k >> 4) & 1) << 2) | (k & 3); }
DI bf16x8 pack8(const f32x4& a, const f32x4& b) { u32x4 v = {pk2(a[0], a[1]), pk2(a[2], a[3]), pk2(b[0], b[1]), pk2(b[2], b[3])}; return __builtin_bit_cast(bf16x8, v); }
#define MFMA16(a, b, c) __builtin_amdgcn_mfma_f32_16x16x32_bf16((a), (b), (c), 0, 0, 0)
#define MFMA32(a, b, c) __builtin_amdgcn_mfma_f32_32x32x16_bf16((a), (b), (c), 0, 0, 0)

#define XB_TMO      128
#define XB_XCNT(j)  (256  + 64 * (j))
#define XB_XSUB(j)  (1280 + 64 * (j))
#define XB_XGEN(j)  (2304 + 64 * (j))
#define XB_TOP      3328
#define XB_TOPGEN   3392
#define XCD_BAR_WORDS 3456
#define XB_SPIN_CAP (1u << 22)
DI unsigned xb_ld(unsigned* p)              { return __hip_atomic_load(p, __ATOMIC_RELAXED, __HIP_MEMORY_SCOPE_AGENT); }
DI unsigned xb_add(unsigned* p, unsigned v) { return __hip_atomic_fetch_add(p, v, __ATOMIC_RELAXED, __HIP_MEMORY_SCOPE_AGENT); }
DI unsigned xb_xcc_id() { return (unsigned)__builtin_amdgcn_s_getreg((3 << 11) | 20) & 0xFu; }
#define XB_SPIN(cond, bar) do { unsigned _sp = 0; while (cond) { __builtin_amdgcn_s_sleep(1); \
    if ((++_sp & 255u) == 0u) { if (xb_ld(&(bar)[XB_TMO])) break; if (_sp > XB_SPIN_CAP) { atomicAdd(&(bar)[XB_TMO], 1u); break; } } } } while (0)
struct XcdBarrier { unsigned* bar; unsigned x; volatile LAS unsigned* st; };
DI XcdBarrier xcd_barrier_post(unsigned* bar, volatile LAS unsigned* st) {
    XcdBarrier b; b.bar = bar; b.x = xb_xcc_id(); b.st = st;
    if (threadIdx.x == 0) (void)xb_add(&bar[XB_XCNT(b.x)], 1u);
    return b;
}
DI void xcd_barrier_complete(unsigned* bar, unsigned x, unsigned& nloc, unsigned& nx) {
    const unsigned G = gridDim.x * gridDim.y * gridDim.z;
    unsigned sum, cnt, mine, sp = 0u;
    for (;;) {
        sum = 0u; cnt = 0u; mine = 0u;
#pragma unroll
        for (unsigned j = 0; j < 16; ++j) { const unsigned c = xb_ld(&bar[XB_XCNT(j)]); sum += c; cnt += (c > 0u) ? 1u : 0u; mine = (j == x) ? c : mine; }
        if (sum == G) break;
        __builtin_amdgcn_s_sleep(1);
        if ((++sp & 255u) == 0u) { if (xb_ld(&bar[XB_TMO])) break; if (sp > XB_SPIN_CAP) { atomicAdd(&bar[XB_TMO], 1u); break; } }
    }
    nloc = mine > 0u ? mine : 1u; nx = cnt > 0u ? cnt : 1u;
}
DI void xcd_barrier(const XcdBarrier& b) {
    asm volatile("s_waitcnt vmcnt(0)" ::: "memory");
    __syncthreads();
    if (threadIdx.x == 0) {
        unsigned* bar = b.bar;
        __builtin_amdgcn_s_waitcnt(0);
        unsigned nloc = b.st[0], nx = b.st[1];
        if (nloc == 0u) { xcd_barrier_complete(bar, b.x, nloc, nx); b.st[0] = nloc; b.st[1] = nx; }
        const unsigned old = xb_add(&bar[XB_XSUB(b.x)], 1u);
        const unsigned gen = old / nloc;
        if (old + 1u == (gen + 1u) * nloc) {
            __builtin_amdgcn_fence(__ATOMIC_RELEASE, "agent");
            asm volatile("s_waitcnt vmcnt(0)" ::: "memory");
            const unsigned og = xb_add(&bar[XB_TOP], 1u);
            const unsigned tg = og / nx;
            if (og + 1u == (tg + 1u) * nx) xb_add(&bar[XB_TOPGEN], 1u);
            else XB_SPIN(xb_ld(&bar[XB_TOPGEN]) == tg, bar);
            __builtin_amdgcn_fence(__ATOMIC_ACQUIRE, "agent");
            xb_add(&bar[XB_XGEN(b.x)], 1u);
            asm volatile("s_waitcnt vmcnt(0)" ::: "memory");
        } else {
            XB_SPIN(xb_ld(&bar[XB_XGEN(b.x)]) == gen, bar);
            __builtin_amdgcn_fence(__ATOMIC_ACQUIRE, "agent");
            asm volatile("s_waitcnt vmcnt(0)" ::: "memory");
        }
    }
    __syncthreads();
}

constexpr int LDS_BYTES = 152 * 1024;
constexpr int LDS_BARW = LDS_BYTES - 16;

DI void p0_transpose_item(const float* W, int ldw, int K, bf16_t* WT, int dst_row0, int src_col0, float scale, bool zero, LAS float* scr, int kb, int lane) {
    const int k0 = 64 * kb;
#pragma unroll 8
    for (int i = 0; i < 32; ++i) { const int kk = 2 * i + (lane >> 5); scr[kk * 33 + (lane & 31)] = zero ? 0.f : W[(size_t)(k0 + kk) * ldw + src_col0 + (lane & 31)] * scale; }
    asm volatile("s_waitcnt lgkmcnt(0)" ::: "memory");
    const int c = lane & 7;
#pragma unroll
    for (int j = 0; j < 4; ++j) { const int n = (lane >> 3) + 8 * j; const LAS float* s = scr + (8 * c) * 33 + n;
        u32x4 o; o.x = pk2(s[0 * 33], s[1 * 33]); o.y = pk2(s[2 * 33], s[3 * 33]); o.z = pk2(s[4 * 33], s[5 * 33]); o.w = pk2(s[6 * 33], s[7 * 33]);
        *(u32x4*)(WT + (size_t)(dst_row0 + n) * K + k0 + 8 * c) = o; }
    asm volatile("s_waitcnt lgkmcnt(0)" ::: "memory");
}

DI void phase0(const Params& p, LAS unsigned char* lds, int tid, int lane, int wave) {
    asm volatile("" : "+v"(tid), "+v"(lane));
    unsigned char* ws = p.ws;
    LAS float* sl = (LAS float*)lds;
    LAS float* scr = (LAS float*)(lds + 32768 + wave * 8448);
    const float* c = p.in[1];
    for (int e = tid; e < 8192; e += NTH) { const int b = e >> 10, k = e & 1023; const float v = c[e]; sl[k * 8 + b] = v / (1.f + __expf(-v)); }
    __syncthreads();
    const int gw = wave * gridDim.x + blockIdx.x, NGW = gridDim.x * NWV;
    constexpr int I_MOD = 768, I_WIN = 16 * 68, I_WOUT = 16 * 32, I_WQ = 16 * 64, I_WP = 32;
    constexpr int NITEMS = I_MOD + I_WIN + I_WOUT + I_WQ + I_WP;
    for (int it = gw; it < NITEMS; it += NGW) {
        int r = it;
        if (r < I_MOD) {
            const int cg = r % 96, ks = r / 96, n = cg * 64 + lane, k0 = ks * 128;
            const float* W = p.in[2] + (size_t)k0 * 6144 + n;
            float acc[8];
#pragma unroll
            for (int b = 0; b < 8; ++b) acc[b] = 0.f;
#pragma unroll 8
            for (int k = 0; k < 128; ++k) {
                const float w = W[(size_t)k * 6144];
                const f32x4 s0 = *(const LAS f32x4*)(sl + (k0 + k) * 8), s1 = *(const LAS f32x4*)(sl + (k0 + k) * 8 + 4);
                acc[0] += s0[0] * w; acc[1] += s0[1] * w; acc[2] += s0[2] * w; acc[3] += s0[3] * w;
                acc[4] += s1[0] * w; acc[5] += s1[1] * w; acc[6] += s1[2] * w; acc[7] += s1[3] * w;
            }
            float* mp = (float*)(ws + WS_MODP) + (size_t)ks * 8 * 6144 + n;
#pragma unroll
            for (int b = 0; b < 8; ++b) mp[b * 6144] = acc[b];
            continue;
        }
        r -= I_MOD;
        if (r < I_WIN) {
            const int kb = r / 68, nb = r % 68, n0 = nb * 32;
            int src; bool zero = false; float scale = 1.f;
            if (n0 < 1536) { src = n0; if (n0 < 256) scale = 0.125f; } else if (n0 < 2048) src = n0 + 32; else if (n0 < 2080) src = 1536 + (n0 - 2048); else { src = 0; zero = true; }
            p0_transpose_item(p.in[6], 2080, 1024, (bf16_t*)(ws + WS_WIN), n0, src, scale, zero, scr, kb, lane);
            continue;
        }
        r -= I_WIN;
        if (r < I_WOUT) { p0_transpose_item(p.in[14], 1024, 1024, (bf16_t*)(ws + WS_WOUT), (r % 32) * 32, (r % 32) * 32, 1.f, false, scr, r / 32, lane); continue; }
        r -= I_WOUT;
        if (r < I_WQ) { p0_transpose_item(p.in[17], 2048, 1024, (bf16_t*)(ws + WS_WQ), (r % 64) * 32, (r % 64) * 32, 1.f, false, scr, r / 64, lane); continue; }
        r -= I_WQ;
        { const int g = r >> 3, kb = (r >> 2) & 1, nb = r & 3;
          p0_transpose_item(p.in[12] + g * 16384, 128, 128, (bf16_t*)(ws + WS_WP) + g * 16384, nb * 32, nb * 32, 1.f, false, scr, kb, lane); }
    }
    const size_t gt = (size_t)blockIdx.x * NTH + tid, NGT = (size_t)gridDim.x * NTH;
    constexpr size_t NSK = (size_t)16 * 128 * 128 / 8;
    for (size_t j = gt; j < NSK; j += NGT) {
        const float* src = p.in[18]; bf16_t* dst = (bf16_t*)(ws + WS_SKB);
        const f32x4 a = *(const f32x4*)(src + j * 8), b = *(const f32x4*)(src + j * 8 + 4);
        u32x4 o = {pk2(a[0], a[1]), pk2(a[2], a[3]), pk2(b[0], b[1]), pk2(b[2], b[3])};
        *(u32x4*)(dst + j * 8) = o;
    }
}

DI void quant_load(const Params& p, int row, int lane, f32x4 (&v)[4]) {
    const int tb = row >> 14, e = row & 16383;
    const float* src = (tb ? p.in[20] : p.in[19]) + (size_t)e * D + 16 * lane;
#pragma unroll
    for (int q = 0; q < 4; ++q) v[q] = *(const f32x4*)(src + 4 * q);
}
DI void quant_store(const Params& p, int row, int lane, const f32x4 (&v)[4]) {
    unsigned char* ws = p.ws;
    const int tb = row >> 14, e = row & 16383;
    float m = 0.f;
#pragma unroll
    for (int q = 0; q < 4; ++q) m = fmaxf(m, fmaxf(fmaxf(fabsf(v[q][0]), fabsf(v[q][1])), fmaxf(fabsf(v[q][2]), fabsf(v[q][3]))));
#pragma unroll
    for (int o = 1; o < 64; o <<= 1) m = fmaxf(m, __shfl_xor(m, o));
    int ex = (int)((__float_as_uint(m) >> 23) & 0xFFu) - 127;
    if (m < 1e-30f) ex = 7;
    const float sc = __uint_as_float((unsigned)(127 + 7 - ex) << 23), isc = __uint_as_float((unsigned)(127 - 7 + ex) << 23);
    u32x4 o;
    if (tb) {
#pragma unroll
        for (int q = 0; q < 4; ++q) { int w = 0; w = __builtin_amdgcn_cvt_pk_fp8_f32(v[q][0] * sc, v[q][1] * sc, w, false); w = __builtin_amdgcn_cvt_pk_fp8_f32(v[q][2] * sc, v[q][3] * sc, w, true); o[q] = (unsigned)w; }
        if (lane == 0) ((float*)(ws + WS_SV))[e] = isc;
    } else {
        const float s8 = m > 1e-30f ? 127.f / m : 0.f;
#pragma unroll
        for (int q = 0; q < 4; ++q) {
            const int q0 = __float2int_rn(v[q][0] * s8), q1 = __float2int_rn(v[q][1] * s8), q2 = __float2int_rn(v[q][2] * s8), q3 = __float2int_rn(v[q][3] * s8);
            o[q] = (unsigned)(q0 & 0xFF) | ((unsigned)(q1 & 0xFF) << 8) | ((unsigned)(q2 & 0xFF) << 16) | ((unsigned)q3 << 24);
        }
        if (lane == 0) ((float*)(ws + WS_SU))[e] = m * (1.f / 127.f);
    }
    *(u32x4*)(ws + (tb ? WS_VB : WS_UB) + (size_t)e * 1024 + 16 * lane) = o;
}

DI float mod_at(const Params& p, int b, int n) {
    const float* mp = (const float*)(p.ws + WS_MODP) + (size_t)b * 6144 + n;
    float s = p.in[3][n];
#pragma unroll
    for (int ks = 0; ks < 8; ++ks) s += mp[(size_t)ks * 8 * 6144];
    return s;
}

DI void phase1(const Params& p, LAS unsigned char* lds, int tid, int lane, int wave) {
    asm volatile("" : "+v"(tid), "+v"(lane));
    LAS float* lA = (LAS float*)lds; LAS float* lB = lA + 1024;
    const float* x = p.in[0]; bf16_t* H = (bf16_t*)(p.ws + WS_RA);
    for (int rt = blockIdx.x; rt < T / 128; rt += gridDim.x) {
        const int b = rt / 32;
        __syncthreads();
        for (int d = tid; d < 1024; d += NTH) { lA[d] = p.in[4][d] * (1.f + mod_at(p, b, 1024 + d)); lB[d] = mod_at(p, b, d); }
        __syncthreads();
        for (int r0 = wave; r0 < 128; r0 += 4 * NWV) {
            f32x4 v[4][4];
#pragma unroll
            for (int u = 0; u < 4; ++u) { const f32x4* xr = (const f32x4*)(x + ((size_t)rt * 128 + r0 + u * NWV) * D) + lane;
#pragma unroll
                for (int j = 0; j < 4; ++j) v[u][j] = xr[64 * j]; }
#pragma unroll
            for (int u = 0; u < 4; ++u) {
                const size_t row = (size_t)rt * 128 + r0 + u * NWV;
                float ss = 0.f;
#pragma unroll
                for (int j = 0; j < 4; ++j) ss += v[u][j][0] * v[u][j][0] + v[u][j][1] * v[u][j][1] + v[u][j][2] * v[u][j][2] + v[u][j][3] * v[u][j][3];
                const float rstd = rsqrtf(wave_sum(ss) * (1.f / D) + EPS);
                u32x2* o = (u32x2*)(H + row * D) + lane;
#pragma unroll
                for (int j = 0; j < 4; ++j) {
                    const f32x4 a = *(const LAS f32x4*)(lA + 4 * lane + 256 * j), bb = *(const LAS f32x4*)(lB + 4 * lane + 256 * j);
                    u32x2 w = {pk2(v[u][j][0] * rstd * a[0] + bb[0], v[u][j][1] * rstd * a[1] + bb[1]), pk2(v[u][j][2] * rstd * a[2] + bb[2], v[u][j][3] * rstd * a[3] + bb[3])};
                    o[64 * j] = w;
                }
            }
        }
    }
}

struct EpiZ {
    bf16_t* Z; float* AFB;
    DI void operator()(int m, int n, const f32x4& v) const {
        if (n < ZW) { u32x2 w = {pk2(v[0], v[1]), pk2(v[2], v[3])}; *(u32x2*)(Z + (size_t)m * ZW + n) = w; }
        else if (n < ZW + 32) { *(f32x4*)(AFB + (size_t)m * 32 + (n - ZW)) = v; }
    }
};
struct EpiF32 { float* C; int ldc; DI void operator()(int m, int n, const f32x4& v) const { *(f32x4*)(C + (size_t)m * ldc + n) = v; } };
struct EpiBf16 { bf16_t* C; int ldc; DI void operator()(int m, int n, const f32x4& v) const { u32x2 w = {pk2(v[0], v[1]), pk2(v[2], v[3])}; *(u32x2*)(C + (size_t)m * ldc + n) = w; } };

template <class Epi>
DI void gemm_phase(const bf16_t* A, const bf16_t* Bt, int M, int N, int K, const Epi& epi, LAS unsigned char* lds, int tid, int lane, int wave, int nt_first = 0) {
    constexpr int BM = 256, BN = 128, BK = 64, STAGE = (BM + BN) * 128;
    const int ntn = N / BN - nt_first, ntiles = (M / BM) * ntn, nk = K / BK;
    const int wm = wave & 3, wn = wave >> 2, c15 = lane & 15, g = lane >> 4;
    const int lrow = tid >> 3, lch = tid & 7;
    for (int tile = blockIdx.x; tile < ntiles; tile += gridDim.x) {
        const int m0 = (tile / ntn) * BM, n0 = (tile % ntn + nt_first) * BN;
        f32x4 acc[4][4];
#pragma unroll
        for (int i = 0; i < 4; ++i)
#pragma unroll
            for (int j = 0; j < 4; ++j) acc[i][j] = (f32x4){0.f, 0.f, 0.f, 0.f};
        u32x4 ra[4], rb[2];
        const bf16_t* Ag = A + (size_t)(m0 + lrow) * K + lch * 8;
        const bf16_t* Bg = Bt + (size_t)(n0 + lrow) * K + lch * 8;
        const int woff = lrow * 128 + ((lch ^ (lrow & 7)) * 16);
        __syncthreads();
#pragma unroll
        for (int ps = 0; ps < 4; ++ps) ra[ps] = *(const u32x4*)(Ag + (size_t)(64 * ps) * K);
#pragma unroll
        for (int ps = 0; ps < 2; ++ps) rb[ps] = *(const u32x4*)(Bg + (size_t)(64 * ps) * K);
#pragma unroll
        for (int ps = 0; ps < 4; ++ps) *(LAS u32x4*)(lds + woff + ps * 8192) = ra[ps];
#pragma unroll
        for (int ps = 0; ps < 2; ++ps) *(LAS u32x4*)(lds + BM * 128 + woff + ps * 8192) = rb[ps];
        __syncthreads();
        for (int kt = 0; kt < nk; ++kt) {
            const bool more = (kt + 1 < nk);
            if (more) {
#pragma unroll
                for (int ps = 0; ps < 4; ++ps) ra[ps] = *(const u32x4*)(Ag + (size_t)(64 * ps) * K + (kt + 1) * BK);
#pragma unroll
                for (int ps = 0; ps < 2; ++ps) rb[ps] = *(const u32x4*)(Bg + (size_t)(64 * ps) * K + (kt + 1) * BK);
            }
            LAS unsigned char* sa = lds + (kt & 1) * STAGE; LAS unsigned char* sb = sa + BM * 128;
#pragma unroll
            for (int s = 0; s < 2; ++s) {
                bf16x8 fa[4], fb[4];
#pragma unroll
                for (int i = 0; i < 4; ++i) { const int row = wm * 64 + i * 16 + c15; fa[i] = *(const LAS bf16x8*)(sa + row * 128 + (((4 * s + g) ^ (row & 7)) * 16)); }
#pragma unroll
                for (int j = 0; j < 4; ++j) { const int row = wn * 64 + j * 16 + c15; fb[j] = *(const LAS bf16x8*)(sb + row * 128 + (((4 * s + g) ^ (row & 7)) * 16)); }
#pragma unroll
                for (int i = 0; i < 4; ++i)
#pragma unroll
                    for (int j = 0; j < 4; ++j) acc[i][j] = MFMA16(fb[j], fa[i], acc[i][j]);
            }
            if (more) {
                LAS unsigned char* da = lds + ((kt + 1) & 1) * STAGE;
#pragma unroll
                for (int ps = 0; ps < 4; ++ps) *(LAS u32x4*)(da + woff + ps * 8192) = ra[ps];
#pragma unroll
                for (int ps = 0; ps < 2; ++ps) *(LAS u32x4*)(da + BM * 128 + woff + ps * 8192) = rb[ps];
            }
            __syncthreads();
        }
#pragma unroll
        for (int i = 0; i < 4; ++i)
#pragma unroll
            for (int j = 0; j < 4; ++j) epi(m0 + wm * 64 + i * 16 + c15, n0 + wn * 64 + j * 16 + 4 * g, acc[i][j]);
    }
}

namespace pg8 {
#define PG8_LAS __attribute__((address_space(3)))
constexpr int BM = 256, BK = 64, HALF = 128, HTB = HALF * BK * 2  , STAGE_BYTES = 8 * HTB, NXCD = 8, WGM = 8;

__host__ __device__ __forceinline__ int lds_byte(int r, int c) { const int st = (r >> 4) * 2 + (c >> 5), rr = r & 15, cc = c & 31, ob = rr * 64 + cc * 2; return st * 1024 + (ob ^ (((ob >> 9) & 1) << 5)); }
__host__ __device__ __forceinline__ void stage_rc(int b, int& R, int& C) { const int st = b / 1024, sb = b % 1024, swz = sb ^ (((sb >> 9) & 1) << 5); R = (st >> 1) * 16 + swz / 64; C = (st & 1) * 32 + (swz % 64) / 2; }
__host__ __device__ __forceinline__ int perm32(int rho) { const int n = rho >> 4, i = rho & 15; return 8 * (i >> 2) + 4 * n + (i & 3); }

struct Unit { int pm, pn; };
struct Gemm { const bf16_t* A; const bf16_t* Bt; int M, N, K; };

struct StaticOrder {
    int nM, nN, nwg, G, c;
    __host__ __device__ void init(int M, int N, int G_, int c_) { nM = M / BM; nN = N / BM; nwg = nM * nN; G = G_; c = c_; }
    __host__ __device__ bool next(int i, Unit& u) const {
        const long L = (long)i * G + c; if (L >= nwg) return false;
        int wgid = (int)L; { const int q = nwg / NXCD, r = nwg % NXCD, xcd = wgid % NXCD, off = wgid / NXCD; wgid = (xcd < r ? xcd * (q + 1) : r * (q + 1) + (xcd - r) * q) + off; }
        const int nig = WGM * nN, gid = wgid / nig, fm = gid * WGM, gsz = (nM - fm) < WGM ? (nM - fm) : WGM;
        u.pm = fm + ((wgid % nig) % gsz); u.pn = (wgid % nig) / gsz; return true;
    }
    __device__ __forceinline__ void a_ready(const Unit&) const {}
    __device__ __forceinline__ void done(const Unit&) const {}
};

struct EpiB16 {
    static constexpr bool PERM = true, AFTER_DRAIN = false;
    bf16_t* O; int ldc;
    __device__ __forceinline__ void operator()(const f32x4 (&acc)[2][2][4][2], const Unit& u, int wr, int wc, int fr, int fq) const {
#pragma unroll
        for (int ai = 0; ai < 2; ++ai)
#pragma unroll
            for (int m = 0; m < 4; ++m) { bf16_t* rowp = O + (size_t)(u.pm * BM + ai * HALF + wr * 64 + m * 16 + fr) * ldc + u.pn * BM + wc * 32 + 8 * fq;
#pragma unroll
                for (int bj = 0; bj < 2; ++bj) { const f32x4 v0 = acc[ai][bj][m][0], v1 = acc[ai][bj][m][1];
                    u32x4 w; w.x = ::pk2(v0[0], v0[1]); w.y = ::pk2(v0[2], v0[3]); w.z = ::pk2(v1[0], v1[1]); w.w = ::pk2(v1[2], v1[3]);
                    *(u32x4*)(rowp + bj * HALF) = w; } }
    }
};
struct EpiF {
    static constexpr bool PERM = false, AFTER_DRAIN = false;
    float* O; int ldc;
    __device__ __forceinline__ void operator()(const f32x4 (&acc)[2][2][4][2], const Unit& u, int wr, int wc, int fr, int fq) const {
#pragma unroll
        for (int ai = 0; ai < 2; ++ai)
#pragma unroll
            for (int m = 0; m < 4; ++m) { float* rowp = O + (size_t)(u.pm * BM + ai * HALF + wr * 64 + m * 16 + fr) * ldc + u.pn * BM + wc * 32 + 4 * fq;
#pragma unroll
                for (int bj = 0; bj < 2; ++bj)
#pragma unroll
                    for (int n = 0; n < 2; ++n) *(f32x4*)(rowp + bj * HALF + 16 * n) = acc[ai][bj][m][n]; }
    }
};
template <class Epi, class Sched, bool ALIGN_EPI = false, bool SP2 = false>
__device__ __forceinline__ void gemm_phase(PG8_LAS unsigned char* lds, const Gemm g, const Sched& S, const Epi& E) {
    int tid = threadIdx.x; asm volatile("" : "+v"(tid));
    const int wid = __builtin_amdgcn_readfirstlane(tid >> 6), lane = tid & 63, wr = wid >> 2, wc = wid & 3, fr = lane & 15, fq = lane >> 4;
    const int K = g.K, nt = K / BK;
    unsigned voffA[2], voffB[2];
#pragma unroll
    for (int i = 0; i < 2; ++i) { int R, C; stage_rc(tid * 16 + i * 8192, R, C); const int Rb = Epi::PERM ? ((R & ~31) + perm32(R & 31)) : R;
        voffA[i] = (unsigned)(R * K + C) * 2u; voffB[i] = (unsigned)(Rb * K + C) * 2u; }
    const size_t kstep = (size_t)(BK * 2);
    const size_t hstep = (size_t)HALF * K * 2;
    const size_t tstep = 2 * hstep;
    const unsigned ldsw = (unsigned)wid * 1024u;
    const int aoff = lds_byte(wr * 64 + fr, fq * 8), boff = lds_byte(wc * 32 + fr, fq * 8);
#define PG8_SA(b, h) (((b) * 2 + (h)) * HTB)
#define PG8_SB(b, h) ((4 + (b) * 2 + (h)) * HTB)
#define PG8_STAGE(bufoff, gbase, voff) do { _Pragma("unroll") for (int _i = 0; _i < 2; ++_i) \
        __builtin_amdgcn_global_load_lds((const unsigned*)((const char*)(gbase) + (voff)[_i]), (PG8_LAS unsigned*)(lds + (bufoff) + ldsw + _i * 8192), 16, 0, 0); } while (0)
#define PG8_LDA(dst, b, h) do { _Pragma("unroll") for (int m = 0; m < 4; ++m) _Pragma("unroll") for (int k = 0; k < 2; ++k) dst[m][k] = *(const PG8_LAS bf16x8*)(lds + PG8_SA(b, h) + aoff + m * 2048 + k * 1024); } while (0)
#define PG8_LDB(dst, b, h) do { _Pragma("unroll") for (int n = 0; n < 2; ++n) _Pragma("unroll") for (int k = 0; k < 2; ++k) dst[n][k] = *(const PG8_LAS bf16x8*)(lds + PG8_SB(b, h) + boff + n * 2048 + k * 1024); } while (0)
#define PG8_MMA(ai, bj, At, Bt) do { __builtin_amdgcn_s_setprio(1); _Pragma("unroll") for (int m = 0; m < 4; ++m) _Pragma("unroll") for (int n = 0; n < 2; ++n) _Pragma("unroll") for (int k = 0; k < 2; ++k) \
        acc[ai][bj][m][n] = __builtin_amdgcn_mfma_f32_16x16x32_bf16(Bt[n][k], At[m][k], acc[ai][bj][m][n], 0, 0, 0); __builtin_amdgcn_s_setprio(0); } while (0)
#define PG8_WAIT_V(n) asm volatile("s_waitcnt vmcnt(" #n ")" ::: "memory")
#define PG8_WAIT_L(n) asm volatile("s_waitcnt lgkmcnt(" #n ")" ::: "memory")
#define PG8_BAR __builtin_amdgcn_s_barrier()
#define PG8_SCHED __builtin_amdgcn_sched_barrier(0)
    Unit cur, nxt; int ui = 0;
    if (!S.next(0, cur)) return;
    f32x4 acc[2][2][4][2];
#pragma unroll
    for (int a = 0; a < 2; ++a)
#pragma unroll
        for (int b = 0; b < 2; ++b)
#pragma unroll
            for (int m = 0; m < 4; ++m)
#pragma unroll
                for (int n = 0; n < 2; ++n) acc[a][b][m][n] = (f32x4){0.f, 0.f, 0.f, 0.f};
    bf16x8 At[4][2], B0[2][2], B1[2][2];
    const char* cA = (const char*)g.A + (size_t)cur.pm * tstep; const char* cB = (const char*)g.Bt + (size_t)cur.pn * tstep;
    S.a_ready(cur);
    if constexpr (SP2) {
        PG8_STAGE(PG8_SB(0, 0), cB, voffB); PG8_STAGE(PG8_SB(0, 1), cB + hstep, voffB); PG8_STAGE(PG8_SA(0, 0), cA, voffA); PG8_STAGE(PG8_SA(0, 1), cA + hstep, voffA);
        if (wr == 1) PG8_BAR;
        PG8_WAIT_V(2); PG8_BAR;
        PG8_STAGE(PG8_SB(1, 0), cB + kstep, voffB); PG8_STAGE(PG8_SA(1, 0), cA + kstep, voffA); PG8_STAGE(PG8_SB(1, 1), cB + hstep + kstep, voffB);
        PG8_WAIT_V(6); PG8_BAR;
    } else {
        PG8_STAGE(PG8_SB(0, 0), cB, voffB); PG8_STAGE(PG8_SA(0, 0), cA, voffA); PG8_STAGE(PG8_SB(0, 1), cB + hstep, voffB); PG8_STAGE(PG8_SA(0, 1), cA + hstep, voffA);
        if (wr == 1) PG8_BAR;
        PG8_WAIT_V(4); PG8_BAR;
        PG8_STAGE(PG8_SB(1, 0), cB + kstep, voffB); PG8_STAGE(PG8_SA(1, 0), cA + kstep, voffA); PG8_STAGE(PG8_SB(1, 1), cB + hstep + kstep, voffB);
        PG8_WAIT_V(6); PG8_BAR;
    }
    for (;;) {
        const bool has_next = S.next(ui + 1, nxt);
        const char* nA = has_next ? (const char*)g.A + (size_t)nxt.pm * tstep : cA; const char* nB = has_next ? (const char*)g.Bt + (size_t)nxt.pn * tstep : cB;
        for (int t = 0; t < nt; t += 2) {
            const bool last = (t == nt - 2);
            const char* a1 = cA + (size_t)(t + 1) * kstep;
            const char* a2 = last ? nA : cA + (size_t)(t + 2) * kstep; const char* b2 = last ? nB : cB + (size_t)(t + 2) * kstep;
            const char* a3 = a2 + kstep; const char* b3 = b2 + kstep;
            if (last && has_next) S.a_ready(nxt);
            if constexpr (SP2) {
            PG8_LDB(B0, 0, 0); PG8_LDB(B1, 0, 1); PG8_SCHED; PG8_LDA(At, 0, 0); PG8_STAGE(PG8_SA(1, 1), a1 + hstep, voffA);
            PG8_WAIT_V(8); PG8_WAIT_L(0); PG8_BAR; PG8_MMA(0, 0, At, B0); PG8_MMA(0, 1, At, B1); PG8_BAR; PG8_SCHED;
            PG8_LDA(At, 0, 1); PG8_STAGE(PG8_SB(0, 0), b2, voffB); PG8_STAGE(PG8_SB(0, 1), b2 + hstep, voffB); PG8_STAGE(PG8_SA(0, 0), a2, voffA);
            PG8_WAIT_V(8); PG8_WAIT_L(0); PG8_BAR; PG8_MMA(1, 0, At, B0); PG8_MMA(1, 1, At, B1); PG8_BAR; PG8_SCHED;
            PG8_LDB(B0, 1, 0); PG8_LDB(B1, 1, 1); PG8_SCHED; PG8_LDA(At, 1, 0); PG8_STAGE(PG8_SA(0, 1), a2 + hstep, voffA);
            PG8_WAIT_V(8); PG8_WAIT_L(0); PG8_BAR; PG8_MMA(0, 0, At, B0); PG8_MMA(0, 1, At, B1); PG8_BAR; PG8_SCHED;
            PG8_LDA(At, 1, 1); PG8_STAGE(PG8_SB(1, 0), b3, voffB); PG8_STAGE(PG8_SB(1, 1), b3 + hstep, voffB); PG8_STAGE(PG8_SA(1, 0), a3, voffA);
            PG8_WAIT_V(8); PG8_WAIT_L(0); PG8_BAR; PG8_MMA(1, 0, At, B0); PG8_MMA(1, 1, At, B1); PG8_BAR; PG8_SCHED;
            } else {
            PG8_LDB(B0, 0, 0); PG8_SCHED; PG8_LDA(At, 0, 0); PG8_STAGE(PG8_SA(1, 1), a1 + hstep, voffA);
            PG8_WAIT_L(8); PG8_BAR; PG8_WAIT_L(0); PG8_MMA(0, 0, At, B0); PG8_BAR; PG8_SCHED;
            PG8_LDB(B1, 0, 1); PG8_STAGE(PG8_SB(0, 0), b2, voffB);
            PG8_BAR; PG8_WAIT_L(0); PG8_MMA(0, 1, At, B1); PG8_BAR;
            PG8_LDA(At, 0, 1); PG8_STAGE(PG8_SA(0, 0), a2, voffA);
            PG8_BAR; PG8_WAIT_L(0); PG8_MMA(1, 0, At, B0); PG8_BAR; PG8_SCHED;
            PG8_STAGE(PG8_SB(0, 1), b2 + hstep, voffB);
            PG8_WAIT_V(6); PG8_BAR; PG8_MMA(1, 1, At, B1); PG8_BAR;
            PG8_LDB(B0, 1, 0); PG8_SCHED; PG8_LDA(At, 1, 0); PG8_STAGE(PG8_SA(0, 1), a2 + hstep, voffA);
            PG8_WAIT_L(8); PG8_BAR; PG8_WAIT_L(0); PG8_MMA(0, 0, At, B0); PG8_BAR; PG8_SCHED;
            PG8_LDB(B1, 1, 1); PG8_STAGE(PG8_SB(1, 0), b3, voffB);
            PG8_BAR; PG8_WAIT_L(0); PG8_MMA(0, 1, At, B1); PG8_BAR;
            PG8_LDA(At, 1, 1); PG8_STAGE(PG8_SA(1, 0), a3, voffA);
            PG8_BAR; PG8_WAIT_L(0); PG8_MMA(1, 0, At, B0); PG8_BAR; PG8_SCHED;
            PG8_STAGE(PG8_SB(1, 1), b3 + hstep, voffB);
            PG8_WAIT_V(6); PG8_BAR; PG8_MMA(1, 1, At, B1); PG8_BAR;
            }
        }
        if constexpr (ALIGN_EPI) { if (wr == 0) PG8_BAR; }
        if constexpr (!Epi::AFTER_DRAIN) { E(acc, cur, wr, wc, fr, fq); S.done(cur); }
        if (!has_next) break;
#pragma unroll
        for (int a = 0; a < 2; ++a)
#pragma unroll
            for (int b = 0; b < 2; ++b)
#pragma unroll
                for (int m = 0; m < 4; ++m)
#pragma unroll
                    for (int n = 0; n < 2; ++n) acc[a][b][m][n] = (f32x4){0.f, 0.f, 0.f, 0.f};
        cur = nxt; cA = nA; cB = nB; ++ui;
        if constexpr (ALIGN_EPI) { if (wr == 1) PG8_BAR; }
    }
    PG8_WAIT_V(0);
    if constexpr (!ALIGN_EPI) { if (wr == 0) PG8_BAR; }
    PG8_BAR;
    if constexpr (Epi::AFTER_DRAIN) { E.fused(acc, cur, wr, wc, fr, fq, lds, wid, lane); S.done(cur); }
#undef PG8_SA
#undef PG8_SB
#undef PG8_STAGE
#undef PG8_LDA
#undef PG8_LDB
#undef PG8_MMA
#undef PG8_WAIT_V
#undef PG8_WAIT_L
#undef PG8_BAR
#undef PG8_SCHED
}
}

constexpr size_t WS_QDC  = WS_RS;
constexpr size_t WS_SEGS = WS_RS + 32 * MB;
constexpr size_t WS_GSEG = WS_RS + 48 * MB;
constexpr size_t WS_SC   = WS_RS + 49 * MB;
DI void lds_barrier() { asm volatile("s_waitcnt lgkmcnt(0)" ::: "memory"); __builtin_amdgcn_s_barrier(); asm volatile("" ::: "memory"); }
DI float logsig(float x) { return fminf(x, 0.f) - __logf(1.f + __expf(-fabsf(x))); }

template <int DIR>
DI void ga_task(const Params& p, LAS unsigned char* lds, int tid, int lane, int wave, int task) {
    asm volatile("" : "+v"(tid), "+v"(lane));
    unsigned char* ws = p.ws;
    const bf16_t* Z = (const bf16_t*)(ws + WS_RZ);
    const float* AFB = (const float*)(ws + WS_AFB);
    LAS float* la = (LAS float*)lds;
    LAS float* part = (LAS float*)(lds + 17408);
    LAS float* gs = (LAS float*)(lds + 18432);
    LAS float* elb = (LAS float*)(lds + 18944);
    LAS float* wl = (LAS float*)(lds + 19968);
    LAS bf16_t* sL  = (LAS bf16_t*)(lds + 24064);
    LAS unsigned char* obuf = lds + 42496;
    const int c15 = lane & 15, g = lane >> 4;
    const int i = tid >> 3, dg = tid & 7, d0 = dg * 8;
#define TROW(r) ((r) * 72 + ((r) >> 3) * 8)
    constexpr int dir = DIR; const int h = (task >> 1) & 3, pb = (task >> 3) & 7, b = task >> 6;
    const int bhd = b * 8 + h * 2 + dir, sg = dir ? 7 - pb : pb;
    bf16_t* QDC = (bf16_t*)(ws + WS_QDC + (dir ? 16 : 0) * MB);
    bf16_t* OL = (bf16_t*)(ws + WS_RO + (dir ? 64 : 0) * MB);
    f32x4 S[4];
#pragma unroll
    for (int kt = 0; kt < 4; ++kt) S[kt] = (f32x4){0.f, 0.f, 0.f, 0.f};
    __syncthreads();
    for (int e = tid; e < 128 * 72 / 2; e += NTH) ((LAS unsigned*)sL)[e] = 0u;
    if (tid < 64) gs[tid] = 0.f;
    for (int e = tid; e < 1024; e += NTH) wl[e] = (dir ? p.in[9] : p.in[7])[(e >> 6) * 256 + h * 64 + (e & 63)];
    typedef short s16x4w __attribute__((ext_vector_type(4)));
    s16x4w wfr[2]; float bias[2];
    __syncthreads();
#pragma unroll
    for (int u = 0; u < 2; ++u) {
        const int d = 16 * (2 * (wave >> 2) + u) + c15;
        const u32x2 wp = {pk2(wl[(4 * g) * 64 + d], wl[(4 * g + 1) * 64 + d]), pk2(wl[(4 * g + 2) * 64 + d], wl[(4 * g + 3) * 64 + d])};
        wfr[u] = __builtin_bit_cast(s16x4w, wp);
        bias[u] = (dir ? p.in[10] : p.in[8])[h * 64 + d];
    }
    const int mt = wave & 3;
    f32x4 avn;
    { const int n0 = dir ? pb * 8 + 7 : pb * 8; avn = *(const f32x4*)(AFB + ((size_t)b * SEQ + n0 * 64 + 16 * mt + c15) * 32 + dir * 16 + 4 * g); }
#pragma unroll 1
    for (int ci = -1; ci < 8; ++ci) {
        const bool has_cur = ci >= 0, has_nxt = ci < 7;
        const int cx = ci + 1;
        const int nx = dir ? pb * 8 + 7 - cx : pb * 8 + cx, tokx = b * SEQ + nx * 64;
        const int nc = dir ? pb * 8 + 7 - ci : pb * 8 + ci, tokc = b * SEQ + nc * 64;
        LAS unsigned char* bx = obuf + (cx & 1) * 46464; LAS unsigned char* bc = obuf + (ci & 1) * 46464;
        LAS float* elx = elb + (cx & 1) * 128; LAS float* elc = elb + (ci & 1) * 128;
        u32x4 qv, kv, vvp[2]; f32x4 qa[4]; float lv[2][4];
        const int qrow = (task * 8 + (has_cur ? ci : 0)) * NWV + wave;
        if (ci > 0) {
#pragma unroll
            for (int kt = 0; kt < 4; ++kt) { const u32x2 w = {pk2(S[kt][0], S[kt][1]), pk2(S[kt][2], S[kt][3])}; *(LAS u32x2*)(sL + (16 * wave + c15) * 72 + 16 * kt + 4 * g) = w; }
        }
        if (has_cur) quant_load(p, qrow, lane, qa);
        if (has_nxt) {
            const size_t t = (size_t)tokx + i;
            qv = *(const u32x4*)(Z + t * ZW + h * 64 + d0); kv = *(const u32x4*)(Z + t * ZW + 256 + h * 64 + d0);
#pragma unroll
            for (int ps = 0; ps < 2; ++ps) { const int idx = tid + NTH * ps, vi = idx >> 4, ch = idx & 15; vvp[ps] = *(const u32x4*)(Z + ((size_t)tokx + vi) * ZW + 512 + h * 128 + ch * 8); }
            typedef short s16x4v __attribute__((ext_vector_type(4)));
            const u32x2 ap = {pk2(avn[0], avn[1]), pk2(avn[2], avn[3])};
            const s16x4v af = __builtin_bit_cast(s16x4v, ap);
            { const int c2 = cx < 7 ? cx + 1 : cx, n2 = dir ? pb * 8 + 7 - c2 : pb * 8 + c2; avn = *(const f32x4*)(AFB + ((size_t)b * SEQ + n2 * 64 + 16 * mt + c15) * 32 + dir * 16 + 4 * g); }
#pragma unroll
            for (int u = 0; u < 2; ++u) {
                const int d = 16 * (2 * (wave >> 2) + u) + c15;
                const f32x4 x = __builtin_amdgcn_mfma_f32_16x16x16bf16_1k(af, wfr[u], (f32x4){0.f, 0.f, 0.f, 0.f}, 0, 0, 0);
                float v0 = logsig(x[0] + bias[u]) * 0.0625f, v1 = logsig(x[1] + bias[u]) * 0.0625f, v2 = logsig(x[2] + bias[u]) * 0.0625f, v3 = logsig(x[3] + bias[u]) * 0.0625f;
                float T, T2, T3;
                if (dir == 0) {
                    v1 += v0; v2 += v1; v3 += v2; T = v3;
                    const float t1 = __shfl_up(T, 16); T2 = T + (g >= 1 ? t1 : 0.f);
                    const float t2 = __shfl_up(T2, 32); T3 = T2 + (g >= 2 ? t2 : 0.f);
                    if (g == 3) part[mt * 64 + d] = T3;
                } else {
                    v2 += v3; v1 += v2; v0 += v1; T = v0;
                    const float t1 = __shfl_down(T, 16); T2 = T + (g <= 2 ? t1 : 0.f);
                    const float t2 = __shfl_down(T2, 32); T3 = T2 + (g <= 1 ? t2 : 0.f);
                    if (g == 0) part[mt * 64 + d] = T3;
                }
                const float off = T3 - T;
                lv[u][0] = v0 + off; lv[u][1] = v1 + off; lv[u][2] = v2 + off; lv[u][3] = v3 + off;
            }
        }
        lds_barrier();
        if (has_nxt) {
#pragma unroll
            for (int u = 0; u < 2; ++u) {
                const int d = 16 * (2 * (wave >> 2) + u) + c15;
                float off = 0.f;
#pragma unroll
                for (int m2 = 0; m2 < 4; ++m2) { const bool take = dir ? (m2 > mt) : (m2 < mt); off += take ? part[m2 * 64 + d] : 0.f; }
#pragma unroll
                for (int r = 0; r < 4; ++r) la[(16 * mt + 4 * g + r) * 68 + d] = lv[u][r] + off;
                if (mt == (dir ? 0 : 3) && g == (dir ? 0 : 3)) {
                    const float tot = lv[u][dir ? 0 : 3] + off, gsum = gs[(cx & 1) * 64 + d];
                    elx[d] = __expf(tot); elx[64 + d] = __expf(gsum); gs[((cx + 1) & 1) * 64 + d] = gsum + tot;
                }
            }
        }
        lds_barrier();
        if (has_nxt) {
            LAS bf16_t* qdL = (LAS bf16_t*)bx; LAS bf16_t* kiL = (LAS bf16_t*)(bx + 9216); LAS bf16_t* keT = (LAS bf16_t*)(bx + 18432); LAS bf16_t* vT = (LAS bf16_t*)(bx + 27776);
            const size_t t = (size_t)tokx + i;
            float q[8], k[8];
#pragma unroll
            for (int e = 0; e < 4; ++e) { q[2 * e] = bflo(qv[e]); q[2 * e + 1] = bfhi(qv[e]); k[2 * e] = bflo(kv[e]); k[2 * e + 1] = bfhi(kv[e]); }
            float qd[8], ki[8], ke[8], qc[8];
#pragma unroll
            for (int e = 0; e < 8; ++e) {
                const float E = __expf(la[i * 68 + d0 + e]), R = __builtin_amdgcn_rcpf(E);
                qd[e] = q[e] * E; ki[e] = k[e] * R; ke[e] = ki[e] * elx[d0 + e]; qc[e] = qd[e] * elx[64 + d0 + e];
            }
            const u32x4 o1 = {pk2(qd[0], qd[1]), pk2(qd[2], qd[3]), pk2(qd[4], qd[5]), pk2(qd[6], qd[7])};
            const u32x4 o2 = {pk2(ki[0], ki[1]), pk2(ki[2], ki[3]), pk2(ki[4], ki[5]), pk2(ki[6], ki[7])};
            const u32x4 o3 = {pk2(qc[0], qc[1]), pk2(qc[2], qc[3]), pk2(qc[4], qc[5]), pk2(qc[6], qc[7])};
            *(LAS u32x4*)(qdL + i * 72 + d0) = o1; *(LAS u32x4*)(kiL + i * 72 + d0) = o2;
            *(u32x4*)(QDC + t * 256 + h * 64 + d0) = o3;
#pragma unroll
            for (int e = 0; e < 4; ++e) { const unsigned w = pk2(ke[2 * e], ke[2 * e + 1]); keT[TROW(d0 + 2 * e) + perm32(i)] = (bf16_t)(w & 0xFFFFu); keT[TROW(d0 + 2 * e + 1) + perm32(i)] = (bf16_t)(w >> 16); }
#pragma unroll
            for (int ps = 0; ps < 2; ++ps) {
                const int idx = tid + NTH * ps, vi = idx >> 4, ch = idx & 15;
#pragma unroll
                for (int e = 0; e < 4; ++e) { vT[TROW(ch * 8 + 2 * e) + perm32(vi)] = (bf16_t)(vvp[ps][e] & 0xFFFFu); vT[TROW(ch * 8 + 2 * e + 1) + perm32(vi)] = (bf16_t)(vvp[ps][e] >> 16); }
            }
        }
        if (has_cur) {
            const LAS bf16_t* qdL = (const LAS bf16_t*)bc; const LAS bf16_t* kiL = (const LAS bf16_t*)(bc + 9216); const LAS bf16_t* keT = (const LAS bf16_t*)(bc + 18432); const LAS bf16_t* vT = (const LAS bf16_t*)(bc + 27776);
            const int it = wave & 3, dvh = wave >> 2;
            bf16x8 qdb[2];
#pragma unroll
            for (int s = 0; s < 2; ++s) qdb[s] = *(const LAS bf16x8*)(qdL + (16 * it + c15) * 72 + 32 * s + 8 * g);
            f32x4 sc[4];
#pragma unroll
            for (int jt = 0; jt < 4; ++jt) {
                sc[jt] = (f32x4){0.f, 0.f, 0.f, 0.f};
#pragma unroll
                for (int s = 0; s < 2; ++s) sc[jt] = MFMA16(*(const LAS bf16x8*)(kiL + (16 * jt + c15) * 72 + 32 * s + 8 * g), qdb[s], sc[jt]);
                const int ii = 16 * it + c15;
#pragma unroll
                for (int r = 0; r < 4; ++r) { const int jj = 16 * jt + 4 * g + r; const bool keep = dir ? (jj > ii) : (jj <= ii); sc[jt][r] = keep ? sc[jt][r] : 0.f; }
            }
            const bf16x8 pa[2] = {pack8(sc[0], sc[1]), pack8(sc[2], sc[3])};
#pragma unroll
            for (int nt = 0; nt < 4; ++nt) {
                const int dvr = 64 * dvh + 16 * nt + c15;
                f32x4 o = (f32x4){0.f, 0.f, 0.f, 0.f};
#pragma unroll
                for (int s = 0; s < 2; ++s) {
                    o = MFMA16(*(const LAS bf16x8*)(vT + TROW(dvr) + 32 * s + 8 * g), pa[s], o);
                    o = MFMA16(*(const LAS bf16x8*)(sL + dvr * 72 + 32 * s + 8 * g), qdb[s], o);
                }
                const u32x2 w = {pk2(o[0], o[1]), pk2(o[2], o[3])};
                *(u32x2*)(OL + ((size_t)tokc + 16 * it + c15) * 512 + h * 128 + 64 * dvh + 16 * nt + 4 * g) = w;
            }
            bf16x8 vb[2];
#pragma unroll
            for (int s = 0; s < 2; ++s) vb[s] = *(const LAS bf16x8*)(vT + TROW(16 * wave + c15) + 32 * s + 8 * g);
#pragma unroll
            for (int kt = 0; kt < 4; ++kt) {
                const f32x4 gm = *(const LAS f32x4*)(elc + 16 * kt + 4 * g);
                f32x4 a = S[kt] * gm;
#pragma unroll
                for (int s = 0; s < 2; ++s) a = MFMA16(*(const LAS bf16x8*)(keT + TROW(16 * kt + c15) + 32 * s + 8 * g), vb[s], a);
                S[kt] = a;
            }
            quant_store(p, qrow, lane, qa);
        }
        lds_barrier();
    }
    {
        float* SEGS = (float*)(ws + WS_SEGS) + (size_t)(bhd * 8 + sg) * 64 * 128;
#pragma unroll
        for (int kt = 0; kt < 4; ++kt)
#pragma unroll
            for (int r = 0; r < 4; ++r) SEGS[(16 * kt + 4 * g + r) * 128 + 16 * wave + c15] = S[kt][r];
        if (tid < 64) ((float*)(ws + WS_GSEG))[(bhd * 8 + sg) * 64 + tid] = __expf(gs[tid]);
    }
}
#undef TROW

DI void phaseGA(const Params& p, LAS unsigned char* lds, int tid, int lane, int wave) {
    for (int task = blockIdx.x; task < 512; task += gridDim.x) { if (task & 1) ga_task<1>(p, lds, tid, lane, wave, task); else ga_task<0>(p, lds, tid, lane, wave, task); }
}

DI void phaseGB(const Params& p, int tid) {
    unsigned char* ws = p.ws;
    const float* SEGS = (const float*)(ws + WS_SEGS); const float* GSEG = (const float*)(ws + WS_GSEG); bf16_t* SC = (bf16_t*)(ws + WS_SC);
    for (int e = blockIdx.x * NTH + tid; e < 64 * 128 * 16; e += gridDim.x * NTH) {
        const int dv = e & 127, dk4 = (e >> 7) & 15, bhd = e >> 11;
        float c[4] = {0.f, 0.f, 0.f, 0.f};
        for (int sg = 0; sg < 8; ++sg) {
            const u32x2 w = {pk2(c[0], c[1]), pk2(c[2], c[3])};
            *(u32x2*)(SC + ((size_t)(bhd * 8 + sg) * 128 + dv) * 64 + 4 * dk4) = w;
            const f32x4 gm = *(const f32x4*)(GSEG + (bhd * 8 + sg) * 64 + 4 * dk4);
#pragma unroll
            for (int r = 0; r < 4; ++r) c[r] = gm[r] * c[r] + SEGS[((size_t)(bhd * 8 + sg) * 64 + 4 * dk4 + r) * 128 + dv];
        }
    }
}

DI void phase4a(const Params& p, LAS unsigned char* lds, int tid, int lane, int wave) {
    asm volatile("" : "+v"(tid), "+v"(lane));
    unsigned char* ws = p.ws;
    const bf16_t* Z = (const bf16_t*)(ws + WS_RZ);
    bf16_t* MIX = (bf16_t*)(ws + WS_RA);
    const bf16_t* OF = (const bf16_t*)(ws + WS_RO); const bf16_t* OB = (const bf16_t*)(ws + WS_RO + 64 * MB);
    const bf16_t* WP = (const bf16_t*)(ws + WS_WP);
    LAS bf16_t* pt = (LAS bf16_t*)lds;
    LAS unsigned char* at = lds + 81920;
    const int c15 = lane & 15, g = lane >> 4;
    for (int tile = blockIdx.x; tile < T / 64; tile += gridDim.x) {
        const int tok0 = tile * 64, s0 = tok0 & (SEQ - 1);
        __syncthreads();
#pragma unroll
        for (int ps = 0; ps < 10; ++ps) {
            const int idx = tid + NTH * ps, rr = idx >> 6, ch = idx & 63, sq = s0 - 8 + rr;
            u32x4 v = {0u, 0u, 0u, 0u};
            if (sq >= 0 && sq < SEQ) v = *(const u32x4*)(Z + ((size_t)tok0 - 8 + rr) * ZW + 1536 + ch * 8);
            *(LAS u32x4*)(pt + rr * 512 + ch * 8) = v;
        }
        {
            const int hh = wave >> 1, ih = wave & 1, bb = tok0 / SEQ, nn = s0 >> 6;
            f32x4 acc[8][2];
#pragma unroll
            for (int mt = 0; mt < 8; ++mt) { acc[mt][0] = (f32x4){0.f, 0.f, 0.f, 0.f}; acc[mt][1] = (f32x4){0.f, 0.f, 0.f, 0.f}; }
#pragma unroll
            for (int dir = 0; dir < 2; ++dir) {
                const int sg = dir ? 7 - (nn >> 3) : (nn >> 3), bhd = bb * 8 + hh * 2 + dir;
                const bf16_t* SCp = (const bf16_t*)(ws + WS_SC) + (size_t)(bhd * 8 + sg) * 128 * 64;
                const bf16_t* QCp = (const bf16_t*)(ws + WS_QDC + (dir ? 16 : 0) * MB) + ((size_t)tok0 + 32 * ih) * 256 + hh * 64;
#pragma unroll
                for (int s = 0; s < 2; ++s) {
                    const bf16x8 q0 = ld_frag16(QCp + (size_t)c15 * 256 + 32 * s + 8 * g), q1 = ld_frag16(QCp + (size_t)(16 + c15) * 256 + 32 * s + 8 * g);
#pragma unroll
                    for (int mt = 0; mt < 8; ++mt) {
                        const bf16x8 af = ld_frag16(SCp + (16 * mt + c15) * 64 + 32 * s + 8 * g);
                        acc[mt][0] = MFMA16(af, q0, acc[mt][0]); acc[mt][1] = MFMA16(af, q1, acc[mt][1]);
                    }
                }
            }
#pragma unroll
            for (int nt = 0; nt < 2; ++nt)
#pragma unroll
                for (int mt = 0; mt < 8; ++mt) { const f32x4 o = acc[mt][nt]; const u32x2 w = {pk2(o[0], o[1]), pk2(o[2], o[3])};
                    *(LAS u32x2*)(at + (32 * ih + 16 * nt + c15) * 1040 + (hh * 128 + 16 * mt + 4 * g) * 2) = w; }
        }
        __syncthreads();
        {
            const f32x4 gh0 = *(const f32x4*)(p.in[11] + 8 * lane), gh1 = *(const f32x4*)(p.in[11] + 8 * lane + 4);
#pragma unroll
            for (int hb = 0; hb < 2; ++hb) {
                u32x4 a[4], bq[4], rv[4], cv[4];
#pragma unroll
                for (int j = 0; j < 4; ++j) { const int tl = wave * 8 + hb * 4 + j; const size_t t = (size_t)tok0 + tl;
                    a[j] = *(const u32x4*)(OF + t * 512 + 8 * lane); bq[j] = *(const u32x4*)(OB + t * 512 + 8 * lane); rv[j] = *(const u32x4*)(Z + t * ZW + 1024 + 8 * lane);
                    cv[j] = *(const LAS u32x4*)(at + tl * 1040 + 16 * lane); }
#pragma unroll
                for (int j = 0; j < 4; ++j) { const size_t t = (size_t)tok0 + wave * 8 + hb * 4 + j;
                    float o[8], r[8];
#pragma unroll
                    for (int e = 0; e < 4; ++e) { o[2 * e] = bflo(a[j][e]) + bflo(bq[j][e]) + bflo(cv[j][e]); o[2 * e + 1] = bfhi(a[j][e]) + bfhi(bq[j][e]) + bfhi(cv[j][e]); r[2 * e] = bflo(rv[j][e]); r[2 * e + 1] = bfhi(rv[j][e]); }
                    float ss = 0.f;
#pragma unroll
                    for (int e = 0; e < 8; ++e) ss += o[e] * o[e];
                    ss += __shfl_xor(ss, 1); ss += __shfl_xor(ss, 2); ss += __shfl_xor(ss, 4); ss += __shfl_xor(ss, 8);
                    const float rstd = rsqrtf(ss * (1.f / 128.f) + EPS);
                    float y[8];
#pragma unroll
                    for (int e = 0; e < 8; ++e) { const float gg = e < 4 ? gh0[e] : gh1[e - 4]; y[e] = o[e] * rstd * gg * (r[e] / (1.f + __expf(-r[e]))); }
                    const u32x4 w = {pk2(y[0], y[1]), pk2(y[2], y[3]), pk2(y[4], y[5]), pk2(y[6], y[7])};
                    *(u32x4*)(MIX + t * D + 8 * lane) = w; }
            }
        }
        __syncthreads();
        {
            const int c = tid, gi = c >> 7, cc = c & 127, hw = 1 << gi;
            LAS unsigned char* ag = at + gi * 16384;
            const LAS bf16_t* pc = pt + c;
            if (s0 >= 8 && s0 + 64 + 8 <= SEQ) {
                const float inv = 0.5f / (float)hw;
                float sum = 0.f;
                for (int rr = 8 - hw; rr < 8 + hw; ++rr) sum += bflo((unsigned)pc[rr * 512]);
#pragma unroll 4
                for (int i = 0; i < 64; ++i) {
                    const float val = sum * inv - bflo((unsigned)pc[(i + 8) * 512]);
                    *(LAS bf16_t*)(ag + i * 256 + (((cc >> 3) ^ (i & 15)) * 16) + (cc & 7) * 2) = (bf16_t)(pk2(val, 0.f) & 0xFFFFu);
                    sum += bflo((unsigned)pc[(i + 8 + hw) * 512]) - bflo((unsigned)pc[(i + 8 - hw) * 512]);
                }
            } else {
                float sum = 0.f;
                {   const int lo = max(s0 - hw, 0), hi = min(s0 + hw, SEQ);
                    for (int rr = lo; rr < hi; ++rr) sum += bflo((unsigned)pc[(rr - s0 + 8) * 512]); }
#pragma unroll 4
                for (int i = 0; i < 64; ++i) {
                    const int sq = s0 + i, lo = max(sq - hw, 0), hi = min(sq + hw, SEQ);
                    const float val = sum * __builtin_amdgcn_rcpf((float)(hi - lo)) - bflo((unsigned)pc[(i + 8) * 512]);
                    *(LAS bf16_t*)(ag + i * 256 + (((cc >> 3) ^ (i & 15)) * 16) + (cc & 7) * 2) = (bf16_t)(pk2(val, 0.f) & 0xFFFFu);
                    if (sq + hw < SEQ) sum += bflo((unsigned)pc[(i + 8 + hw) * 512]);
                    if (sq - hw >= 0) sum -= bflo((unsigned)pc[(i + 8 - hw) * 512]);
                }
            }
        }
        __syncthreads();
        {
            const int gi = wave >> 1, dh = wave & 1;
            LAS unsigned char* ag = at + gi * 16384;
            f32x4 acc[4][4];
#pragma unroll
            for (int mt = 0; mt < 4; ++mt)
#pragma unroll
                for (int nt = 0; nt < 4; ++nt) acc[mt][nt] = (f32x4){0.f, 0.f, 0.f, 0.f};
#pragma unroll
            for (int s = 0; s < 4; ++s) {
                bf16x8 af[4];
#pragma unroll
                for (int mt = 0; mt < 4; ++mt) { const int row = mt * 16 + c15; af[mt] = *(const LAS bf16x8*)(ag + row * 256 + (((4 * s + g) ^ (row & 15)) * 16)); }
#pragma unroll
                for (int nt = 0; nt < 4; ++nt) {
                    const bf16x8 wf = ld_frag16(WP + (size_t)gi * 16384 + (dh * 64 + 16 * nt + c15) * 128 + 32 * s + 8 * g);
#pragma unroll
                    for (int mt = 0; mt < 4; ++mt) acc[mt][nt] = MFMA16(wf, af[mt], acc[mt][nt]);
                }
            }
#pragma unroll
            for (int nt = 0; nt < 4; ++nt) {
                const f32x4 ps = *(const f32x4*)(p.in[13] + gi * 128 + dh * 64 + 16 * nt + 4 * g);
#pragma unroll
                for (int mt = 0; mt < 4; ++mt) {
                    const f32x4 v = acc[mt][nt] * ps;
                    u32x2 w = {pk2(v[0], v[1]), pk2(v[2], v[3])};
                    *(u32x2*)(MIX + ((size_t)tok0 + mt * 16 + c15) * D + 512 + gi * 128 + dh * 64 + 16 * nt + 4 * g) = w;
                }
            }
        }
    }
}

DI void phase4c(const Params& p, LAS unsigned char* lds, int tid, int lane, int wave) {
    asm volatile("" : "+v"(tid), "+v"(lane));
    LAS float* lG = (LAS float*)lds; LAS float* lA = lG + 1024; LAS float* lB = lA + 1024; LAS float* lP = lB + 1024;
    const float* x = p.in[0]; const bf16_t* MIXO = (const bf16_t*)(p.ws + WS_RZ); bf16_t* H2 = (bf16_t*)(p.ws + WS_RA);
    for (int rt = blockIdx.x; rt < T / 128; rt += gridDim.x) {
        const int b = rt / 32;
        __syncthreads();
        for (int d = tid; d < 1024; d += NTH) { lG[d] = mod_at(p, b, 2048 + d); lA[d] = p.in[15][d] * (1.f + mod_at(p, b, 4096 + d)); lB[d] = mod_at(p, b, 3072 + d); lP[d] = p.in[5][d]; }
        __syncthreads();
        for (int r0 = wave; r0 < 128; r0 += 4 * NWV) {
            f32x4 m[4][4], xv[4][4];
#pragma unroll
            for (int u = 0; u < 4; ++u) {
                const size_t row = (size_t)rt * 128 + r0 + u * NWV;
                const u32x2* mr = (const u32x2*)(MIXO + row * D) + lane; const f32x4* xr = (const f32x4*)(x + row * D) + lane;
#pragma unroll
                for (int j = 0; j < 4; ++j) { const u32x2 mv = mr[64 * j]; m[u][j] = (f32x4){bflo(mv.x), bfhi(mv.x), bflo(mv.y), bfhi(mv.y)}; xv[u][j] = xr[64 * j]; }
            }
#pragma unroll
            for (int u = 0; u < 4; ++u) {
                const size_t row = (size_t)rt * 128 + r0 + u * NWV;
                float ss = 0.f;
#pragma unroll
                for (int j = 0; j < 4; ++j) ss += m[u][j][0] * m[u][j][0] + m[u][j][1] * m[u][j][1] + m[u][j][2] * m[u][j][2] + m[u][j][3] * m[u][j][3];
                const float rstd = rsqrtf(wave_sum(ss) * (1.f / D) + EPS);
                float s2 = 0.f;
#pragma unroll
                for (int j = 0; j < 4; ++j) {
                    const f32x4 gt = *(const LAS f32x4*)(lG + 4 * lane + 256 * j), pm = *(const LAS f32x4*)(lP + 4 * lane + 256 * j);
                    xv[u][j] = xv[u][j] + gt * (m[u][j] * rstd * pm);
                    s2 += xv[u][j][0] * xv[u][j][0] + xv[u][j][1] * xv[u][j][1] + xv[u][j][2] * xv[u][j][2] + xv[u][j][3] * xv[u][j][3];
                }
                const float rstd2 = rsqrtf(wave_sum(s2) * (1.f / D) + EPS);
                u32x2* orow = (u32x2*)((bf16_t*)(p.ws + WS_RO) + row * D) + lane; u32x2* hrow = (u32x2*)(H2 + row * D) + lane;
#pragma unroll
                for (int j = 0; j < 4; ++j) {
                    { const u32x2 xw = {pk2(xv[u][j][0], xv[u][j][1]), pk2(xv[u][j][2], xv[u][j][3])}; orow[64 * j] = xw; }
                    const f32x4 a = *(const LAS f32x4*)(lA + 4 * lane + 256 * j), bb = *(const LAS f32x4*)(lB + 4 * lane + 256 * j);
                    const f32x4 hv = xv[u][j] * rstd2 * a + bb;
                    u32x2 w = {pk2(hv[0], hv[1]), pk2(hv[2], hv[3])};
                    hrow[64 * j] = w;
                }
            }
        }
    }
}

DI int skey(float v, int idx, int mask) { int u = __float_as_int(v); u ^= (u >> 31) & 0x7FFFFFFF; return (u & ~mask) | idx; }
DI float sval(int k, int mask) { int u = k & ~mask; u ^= (u >> 31) & 0x7FFFFFFF; return __int_as_float(u); }
DI void cswap(int& a, int& b) { const int mx = max(a, b), mn = min(a, b); a = mx; b = mn; }
DI void sort16_desc(int (&a)[16]) {
    cswap(a[0], a[13]); cswap(a[1], a[12]); cswap(a[2], a[15]); cswap(a[3], a[14]); cswap(a[4], a[8]); cswap(a[5], a[6]); cswap(a[7], a[11]); cswap(a[9], a[10]);
    cswap(a[0], a[5]); cswap(a[1], a[7]); cswap(a[2], a[9]); cswap(a[3], a[4]); cswap(a[6], a[13]); cswap(a[8], a[14]); cswap(a[10], a[15]); cswap(a[11], a[12]);
    cswap(a[0], a[1]); cswap(a[2], a[3]); cswap(a[4], a[5]); cswap(a[6], a[8]); cswap(a[7], a[9]); cswap(a[10], a[11]); cswap(a[12], a[13]); cswap(a[14], a[15]);
    cswap(a[0], a[2]); cswap(a[1], a[3]); cswap(a[4], a[10]); cswap(a[5], a[11]); cswap(a[6], a[7]); cswap(a[8], a[9]); cswap(a[12], a[14]); cswap(a[13], a[15]);
    cswap(a[1], a[2]); cswap(a[3], a[12]); cswap(a[4], a[6]); cswap(a[5], a[7]); cswap(a[8], a[10]); cswap(a[9], a[11]); cswap(a[13], a[14]);
    cswap(a[1], a[4]); cswap(a[2], a[6]); cswap(a[5], a[8]); cswap(a[7], a[10]); cswap(a[9], a[13]); cswap(a[11], a[14]);
    cswap(a[2], a[4]); cswap(a[3], a[6]); cswap(a[9], a[12]); cswap(a[11], a[13]);
    cswap(a[3], a[5]); cswap(a[6], a[8]); cswap(a[7], a[9]); cswap(a[10], a[12]);
    cswap(a[3], a[4]); cswap(a[5], a[6]); cswap(a[7], a[8]); cswap(a[9], a[10]); cswap(a[11], a[12]);
    cswap(a[6], a[7]); cswap(a[8], a[9]);
}
DI void merge16_desc(int (&x)[16], const int (&y)[16]) {
#pragma unroll
    for (int i = 0; i < 16; ++i) x[i] = max(x[i], y[15 - i]);
#pragma unroll
    for (int j = 8; j > 0; j >>= 1) {
#pragma unroll
        for (int i = 0; i < 16; ++i) { const int l = i ^ j; if (l > i) cswap(x[i], x[l]); }
    }
}

DI void phase5b(const Params& p, LAS unsigned char* lds, int tid, int lane, int wave) {
    asm volatile("" : "+v"(tid), "+v"(lane));
    unsigned char* ws = p.ws;
    const bf16_t* Q2 = (const bf16_t*)(ws + WS_RZ);
    const bf16_t* SKB = (const bf16_t*)(ws + WS_SKB);
    int* EIDX = (int*)(ws + WS_RS);
    LAS unsigned char* tab = lds + tid * 32;
    LAS unsigned char* skl = lds + 16384;
    const int c31 = lane & 31, hi = lane >> 5;
    for (int btask = blockIdx.x; btask < 256; btask += gridDim.x) {
        const int h = btask & 7, tgc = btask >> 3;
        __syncthreads();
#pragma unroll
        for (int ps = 0; ps < 8; ++ps) {
            const int idx = tid + NTH * ps, row = idx >> 4, ch = idx & 15;
            const u32x4 v = *(const u32x4*)(SKB + ((size_t)h * 256 + row) * 128 + ch * 8);
            *(LAS u32x4*)(skl + row * 256 + ((ch ^ (row & 15)) * 16)) = v;
        }
        __syncthreads();
      for (int ti = 0; ti < 4; ++ti) {
        const int tg = tgc * 32 + wave * 4 + ti;
        const size_t tok = (size_t)tg * 32 + c31;
        int lst[2][16];
        bf16x8 bq[2][8];
#pragma unroll
        for (int pp = 0; pp < 2; ++pp) {
            const bf16_t* qp = Q2 + tok * 2048 + h * 256 + pp * 128 + 8 * hi;
            asm volatile("" : "+v"(qp));
#pragma unroll
            for (int ks = 0; ks < 8; ++ks) bq[pp][ks] = ld_frag16(qp + 16 * ks);
        }
#pragma unroll
        for (int pp = 0; pp < 2; ++pp) {
            int run[16];
#pragma unroll
            for (int r = 0; r < 16; ++r) run[r] = (int)0x80000000;
#pragma unroll 1
            for (int kt = 0; kt < 4; ++kt) {
                const LAS unsigned char* kb = skl + pp * 32768 + (32 * kt + c31) * 256;
                f32x16 acc;
#pragma unroll
                for (int r = 0; r < 16; ++r) acc[r] = 0.f;
#pragma unroll
                for (int ks = 0; ks < 8; ++ks) acc = MFMA32(*(const LAS bf16x8*)(kb + (((2 * ks + hi) ^ (c31 & 15)) * 16)), bq[pp][ks], acc);
                int cur[16];
#pragma unroll
                for (int r = 0; r < 16; ++r) cur[r] = skey(acc[r], 32 * kt + 8 * (r >> 2) + 4 * hi + (r & 3), 0x7F);
                sort16_desc(cur);
                merge16_desc(run, cur);
            }
            int oth[16];
#pragma unroll
            for (int r = 0; r < 16; ++r) oth[r] = __shfl_xor(run[r], 32);
            merge16_desc(run, oth);
#pragma unroll
            for (int r = 0; r < 16; ++r) lst[pp][r] = run[r];
        }
#pragma unroll
        for (int pp = 0; pp < 2; ++pp) {
            u32x4 w;
#pragma unroll
            for (int q = 0; q < 4; ++q) w[q] = (lst[pp][4 * q] & 0x7F) | ((lst[pp][4 * q + 1] & 0x7F) << 8) | ((lst[pp][4 * q + 2] & 0x7F) << 16) | ((lst[pp][4 * q + 3] & 0x7F) << 24);
            *(LAS u32x4*)(tab + 16 * pp) = w;
        }
        float va[16], vb[16];
#pragma unroll
        for (int r = 0; r < 16; ++r) { va[r] = sval(lst[0][r], 0x7F); vb[r] = sval(lst[1][r], 0x7F); }
        int cand[4][16];
        {
            int cnt = 0;
#pragma unroll
            for (int i = 0; i < 16; ++i)
#pragma unroll
                for (int j = 0; j < 16; ++j)
                    if ((i + 1) * (j + 1) <= 16) { cand[cnt >> 4][cnt & 15] = skey(va[i] + vb[j], (i << 4) | j, 0xFF); ++cnt; }
#pragma unroll
            for (int q = 50; q < 64; ++q) cand[q >> 4][q & 15] = (int)0x80000000;
        }
        sort16_desc(cand[0]); sort16_desc(cand[1]); sort16_desc(cand[2]); sort16_desc(cand[3]);
        merge16_desc(cand[0], cand[1]); merge16_desc(cand[2], cand[3]); merge16_desc(cand[0], cand[2]);
        asm volatile("s_waitcnt lgkmcnt(0)" ::: "memory");
        float sv[16]; int ex[16];
        const float mx = sval(cand[0][0], 0xFF);
        float sum = 0.f;
#pragma unroll
        for (int r = 0; r < 16; ++r) {
            const int ck = cand[0][r];
            const int i1 = tab[(ck >> 4) & 15], i2 = tab[16 + (ck & 15)];
            ex[r] = i1 * 128 + i2;
            sv[r] = __expf(sval(ck, 0xFF) - mx); sum += sv[r];
        }
        const float inv = 1.f / sum;
        unsigned* ep = (unsigned*)EIDX + tok * 128 + h * 16 + 8 * hi;
        unsigned pe[16];
#pragma unroll
        for (int r = 0; r < 16; ++r) pe[r] = (unsigned)ex[r] | (pk2(sv[r] * inv, 0.f) << 16);
        if (hi == 0) { *(u32x4*)ep = (u32x4){pe[0], pe[1], pe[2], pe[3]}; *(u32x4*)(ep + 4) = (u32x4){pe[4], pe[5], pe[6], pe[7]}; }
        else         { *(u32x4*)ep = (u32x4){pe[8], pe[9], pe[10], pe[11]}; *(u32x4*)(ep + 4) = (u32x4){pe[12], pe[13], pe[14], pe[15]}; }
      }
    }
}

template <int K> DI int swz_bcast(int v) { return __builtin_amdgcn_ds_swizzle(v, 0x10 | (K << 5)); }
template <int W> DI int swz_xor(int v) { return __builtin_amdgcn_ds_swizzle(v, 0x1F | (W << 10)); }
template <int K> struct IC { static constexpr int v = K; };
template <int N, int I = 0, class F> DI void static_for(F&& f) { if constexpr (I < N) { f(IC<I>{}); static_for<N, I + 1>(f); } }
DI float row16_sum(float v) {
    v += __builtin_bit_cast(float, __builtin_amdgcn_update_dpp(0, __builtin_bit_cast(int, v), 0xB1, 0xF, 0xF, true));
    v += __builtin_bit_cast(float, __builtin_amdgcn_update_dpp(0, __builtin_bit_cast(int, v), 0x4E, 0xF, 0xF, true));
    v += __builtin_bit_cast(float, __builtin_amdgcn_update_dpp(0, __builtin_bit_cast(int, v), 0x141, 0xF, 0xF, true));
    v += __builtin_bit_cast(float, __builtin_amdgcn_update_dpp(0, __builtin_bit_cast(int, v), 0x140, 0xF, 0xF, true));
    return v;
}
DI void phase6(const Params& p, LAS unsigned char* lds, int tid, int lane, int wave) {
    asm volatile("" : "+v"(tid), "+v"(lane));
    unsigned char* ws = p.ws;
    const bf16_t* H2 = (const bf16_t*)(ws + WS_RA);
    const unsigned char* UQ = ws + WS_UB; const unsigned char* VQ = ws + WS_VB;
    const float* SU = (const float*)(ws + WS_SU); const float* SV = (const float*)(ws + WS_SV);
    const unsigned* EIDX = (const unsigned*)(ws + WS_RS);
    LAS float* lG = (LAS float*)lds;
    const int q = lane >> 4, l16 = lane & 15;
    LAS int* le = (LAS int*)(lds + 4096 + wave * 6144) + q * 128;
    LAS float* lg = (LAS float*)(lds + 4096 + wave * 6144 + 2048) + q * 128;
    LAS float* lc = (LAS float*)(lds + 4096 + wave * 6144 + 4096) + q * 128;
    const unsigned qlo = q < 2 ? (0xFFFFu << (16 * q)) : 0u, qhi = q >= 2 ? (0xFFFFu << (16 * (q - 2))) : 0u;
    for (int rt = blockIdx.x; rt < T / 128; rt += gridDim.x) {
        const int b = rt / 32;
        __syncthreads();
        for (int d = tid; d < 1024; d += NTH) lG[d] = mod_at(p, b, 5120 + d) * p.in[16][d];
        __syncthreads();
#pragma unroll 1
        for (int rd = 0; rd < 4; ++rd) {
            __syncthreads();
            const size_t t = (size_t)rt * 128 + wave * 16 + rd * 4 + q;
            {
                int e[8]; float g[8];
#pragma unroll
                for (int r = 0; r < 8; ++r) { const unsigned pe = EIDX[t * 128 + r * 16 + l16]; e[r] = (int)(pe & 0xFFFFu); g[r] = bfhi(pe); }
                unsigned W[4] = {0u, 0u, 0u, 0u};
#pragma unroll
                for (int r = 0; r < 8; ++r) {
                    const int k = e[r] >> 10; const unsigned inc = 1u << (8 * (k & 3)); const int w = k >> 2;
                    W[0] += (w == 0) ? inc : 0u; W[1] += (w == 1) ? inc : 0u; W[2] += (w == 2) ? inc : 0u; W[3] += (w == 3) ? inc : 0u;
                }
                unsigned C[4];
                {
                    unsigned tot[4], exc[4];
#pragma unroll
                    for (int w = 0; w < 4; ++w) {
                        unsigned x = W[w];
                        x += (unsigned)__builtin_amdgcn_update_dpp(0, (int)x, 0x111, 0xF, 0xF, true);
                        x += (unsigned)__builtin_amdgcn_update_dpp(0, (int)x, 0x112, 0xF, 0xF, true);
                        x += (unsigned)__builtin_amdgcn_update_dpp(0, (int)x, 0x114, 0xF, 0xF, true);
                        x += (unsigned)__builtin_amdgcn_update_dpp(0, (int)x, 0x118, 0xF, 0xF, true);
                        exc[w] = x - W[w];
                        tot[w] = (unsigned)swz_bcast<15>((int)x);
                    }
                    unsigned carry = 0u;
#pragma unroll
                    for (int w = 0; w < 4; ++w) {
                        const unsigned P = tot[w] + (tot[w] << 8) + (tot[w] << 16) + (tot[w] << 24);
                        C[w] = (P - tot[w]) + carry * 0x01010101u + exc[w];
                        carry += P >> 24;
                    }
                }
#pragma unroll
                for (int r = 0; r < 8; ++r) {
                    const int k = e[r] >> 10; const int sh = 8 * (k & 3); const int w = k >> 2; const unsigned inc = 1u << sh;
                    const unsigned cw = (w == 0) ? C[0] : (w == 1) ? C[1] : (w == 2) ? C[2] : C[3];
                    const int pos = (int)((cw >> sh) & 0xFFu);
                    le[pos] = e[r]; lg[pos] = g[r];
                    C[0] += (w == 0) ? inc : 0u; C[1] += (w == 1) ? inc : 0u; C[2] += (w == 2) ? inc : 0u; C[3] += (w == 3) ? inc : 0u;
                }
                asm volatile("s_waitcnt lgkmcnt(0)" ::: "memory");
            }
            {
                int hq[16]; float ish;
                {
                    float hv[64]; float hm = 0.f;
#pragma unroll
                    for (int i = 0; i < 4; ++i) {
                        const u32x4 h0 = *(const u32x4*)(H2 + t * D + 256 * i + 16 * l16), h1 = *(const u32x4*)(H2 + t * D + 256 * i + 16 * l16 + 8);
#pragma unroll
                        for (int c = 0; c < 4; ++c) { hv[16 * i + 2 * c] = bflo(h0[c]); hv[16 * i + 2 * c + 1] = bfhi(h0[c]); hv[16 * i + 8 + 2 * c] = bflo(h1[c]); hv[16 * i + 8 + 2 * c + 1] = bfhi(h1[c]); }
                    }
#pragma unroll
                    for (int j = 0; j < 64; ++j) hm = fmaxf(hm, fabsf(hv[j]));
                    hm = fmaxf(hm, __builtin_bit_cast(float, __builtin_amdgcn_update_dpp(0, __builtin_bit_cast(int, hm), 0xB1, 0xF, 0xF, true)));
                    hm = fmaxf(hm, __builtin_bit_cast(float, __builtin_amdgcn_update_dpp(0, __builtin_bit_cast(int, hm), 0x4E, 0xF, 0xF, true)));
                    hm = fmaxf(hm, __builtin_bit_cast(float, __builtin_amdgcn_update_dpp(0, __builtin_bit_cast(int, hm), 0x141, 0xF, 0xF, true)));
                    hm = fmaxf(hm, __builtin_bit_cast(float, __builtin_amdgcn_update_dpp(0, __builtin_bit_cast(int, hm), 0x140, 0xF, 0xF, true)));
                    const float s8 = hm > 1e-30f ? 127.f / hm : 0.f; ish = hm * (1.f / 127.f);
#pragma unroll
                    for (int d = 0; d < 16; ++d) {
                        const int q0 = __float2int_rn(hv[4 * d] * s8), q1 = __float2int_rn(hv[4 * d + 1] * s8), q2 = __float2int_rn(hv[4 * d + 2] * s8), q3 = __float2int_rn(hv[4 * d + 3] * s8);
                        hq[d] = (int)((unsigned)(q0 & 0xFF) | ((unsigned)(q1 & 0xFF) << 8) | ((unsigned)(q2 & 0xFF) << 16) | ((unsigned)q3 << 24));
                    }
                }
                constexpr int UD = 4;
                u32x4 ub[UD][4];
                int evn = le[l16];
                static_for<UD>([&](auto kc) { constexpr int k = decltype(kc)::v; const unsigned char* up = UQ + (size_t)swz_bcast<k>(evn) * 1024 + 16 * l16;
#pragma unroll
                    for (int i = 0; i < 4; ++i) ub[k][i] = *(const u32x4*)(up + 256 * i); });
#pragma unroll 1
                for (int bt = 0; bt < 8; ++bt) {
                    if (bt) __syncthreads();
                    const int ev = evn; const float gv = lg[bt * 16 + l16];
                    evn = le[(bt < 7 ? bt + 1 : 7) * 16 + l16];
                    const float isu = SU[ev] * ish, isv = SV[ev];
                    int part[16];
                    static_for<16>([&](auto kc) {
                        constexpr int k = decltype(kc)::v, sl = k % UD;
                        int a = 0;
#pragma unroll
                        for (int i = 0; i < 4; ++i) {
                            const u32x4 u = ub[sl][i];
#pragma unroll
                            for (int c = 0; c < 4; ++c) a = __builtin_amdgcn_sdot4((int)u[c], hq[4 * i + c], a, false);
                        }
                        part[k] = a;
                        {
                            constexpr int kn = k + UD;
                            int idx; if constexpr (kn < 16) idx = swz_bcast<(kn & 15)>(ev); else idx = swz_bcast<(kn & 15)>(evn);
                            const unsigned char* up = UQ + (size_t)idx * 1024 + 16 * l16;
#pragma unroll
                            for (int i = 0; i < 4; ++i) ub[sl][i] = *(const u32x4*)(up + 256 * i);
                        }
                    });
                    static_for<4>([&](auto sc) {
                        constexpr int w = 8 >> decltype(sc)::v;
                        const bool up2 = (lane & w) != 0;
#pragma unroll
                        for (int e = 0; e < w; ++e) {
                            const int keep = up2 ? part[e + w] : part[e], send = up2 ? part[e] : part[e + w];
                            part[e] = keep + swz_xor<w>(send);
                        }
                    });
                    const float dot = (float)part[0] * isu;
                    lc[bt * 16 + l16] = gv * 0.5f * dot * (1.f + erff(dot * 0.70710678118654752f)) * isv;
                }
                asm volatile("s_waitcnt lgkmcnt(0)" ::: "memory");
            }
            __syncthreads();
            f32x2 y[32];
#pragma unroll
            for (int i = 0; i < 32; ++i) y[i] = (f32x2){0.f, 0.f};
            {
                constexpr int VD = 4;
                u32x4 vbuf[VD][4];
                int evn = le[l16];
                static_for<VD>([&](auto kc) { constexpr int k = decltype(kc)::v; const unsigned char* vp = VQ + (size_t)swz_bcast<k>(evn) * 1024 + 16 * l16;
#pragma unroll
                    for (int i = 0; i < 4; ++i) vbuf[k][i] = *(const u32x4*)(vp + 256 * i); });
#pragma unroll 1
                for (int bt = 0; bt < 8; ++bt) {
                    if (bt) __syncthreads();
                    const int ev = evn; const int cv = __float_as_int(lc[bt * 16 + l16]);
                    evn = le[(bt < 7 ? bt + 1 : 7) * 16 + l16];
                    static_for<16>([&](auto kc) {
                        constexpr int k = decltype(kc)::v, sl = k % VD;
                        const float cc = __int_as_float(swz_bcast<k>(cv));
                        const f32x2 c2 = (f32x2){cc, cc};
#pragma unroll
                        for (int i = 0; i < 4; ++i) {
                            const u32x4 v = vbuf[sl][i];
#pragma unroll
                            for (int c = 0; c < 4; ++c) {
                                const int w = (int)v[c];
                                y[8 * i + 2 * c] = __builtin_elementwise_fma(__builtin_amdgcn_cvt_pk_f32_fp8(w, false), c2, y[8 * i + 2 * c]);
                                y[8 * i + 2 * c + 1] = __builtin_elementwise_fma(__builtin_amdgcn_cvt_pk_f32_fp8(w, true), c2, y[8 * i + 2 * c + 1]);
                            }
                        }
                        {
                            constexpr int kn = k + VD;
                            int idx; if constexpr (kn < 16) idx = swz_bcast<(kn & 15)>(ev); else idx = swz_bcast<(kn & 15)>(evn);
                            const unsigned char* vp = VQ + (size_t)idx * 1024 + 16 * l16;
#pragma unroll
                            for (int i = 0; i < 4; ++i) vbuf[sl][i] = *(const u32x4*)(vp + 256 * i);
                        }
                    });
                }
            }
            float ss = 0.f;
#pragma unroll
            for (int i = 0; i < 32; ++i) ss += y[i].x * y[i].x + y[i].y * y[i].y;
            const float rstd = rsqrtf(row16_sum(ss) * (1.f / D) + EPS);
            float* orow = p.out + t * D;
#pragma unroll
            for (int i = 0; i < 4; ++i)
#pragma unroll
                for (int c = 0; c < 4; ++c) {
                    const int col = 256 * i + 16 * l16 + 4 * c;
                    const u32x2 xb = *(const u32x2*)((const bf16_t*)(ws + WS_RO) + t * D + col);
                    f32x4 xv = {bflo(xb.x), bfhi(xb.x), bflo(xb.y), bfhi(xb.y)};
                    const f32x4 gg = *(const LAS f32x4*)(lG + col);
                    xv[0] += gg[0] * y[8 * i + 2 * c].x * rstd; xv[1] += gg[1] * y[8 * i + 2 * c].y * rstd; xv[2] += gg[2] * y[8 * i + 2 * c + 1].x * rstd; xv[3] += gg[3] * y[8 * i + 2 * c + 1].y * rstd;
                    *(f32x4*)(orow + col) = xv;
                }
        }
    }
}


__global__ void __launch_bounds__(NTH) fwd_megakernel(Params p) {
    extern __shared__ __attribute__((aligned(16))) unsigned char lds_raw[];
    LAS unsigned char* lds = (LAS unsigned char*)lds_raw;
    const int tid = threadIdx.x, lane = tid & 63, wave = __builtin_amdgcn_readfirstlane(tid >> 6);
    volatile LAS unsigned* st = (volatile LAS unsigned*)(lds + LDS_BARW);
    if (tid == 0) { st[0] = 0u; st[1] = 0u; st[2] = 0u; st[3] = 0u; }
    __syncthreads();
    XcdBarrier bar = xcd_barrier_post((unsigned*)(p.ws + WS_CTL), st);
    unsigned char* ws = p.ws;

    phase0(p, lds, tid, lane, wave);
    xcd_barrier(bar);
    phase1(p, lds, tid, lane, wave);
    xcd_barrier(bar);
    { pg8::Gemm g{(const bf16_t*)(ws + WS_RA), (const bf16_t*)(ws + WS_WIN), T, ZW, D}; pg8::StaticOrder S; S.init(T, ZW, (int)gridDim.x, (int)blockIdx.x);
      pg8::EpiB16 e{(bf16_t*)(ws + WS_RZ), ZW}; pg8::gemm_phase<pg8::EpiB16, pg8::StaticOrder, true, true>(lds, g, S, e);
      EpiZ e2{(bf16_t*)(ws + WS_RZ), (float*)(ws + WS_AFB)}; gemm_phase(((const bf16_t*)(ws + WS_RA)), (const bf16_t*)(ws + WS_WIN), T, NIN, D, e2, lds, tid, lane, wave, 16); }
    xcd_barrier(bar);
    phaseGA(p, lds, tid, lane, wave);
    xcd_barrier(bar);
    phaseGB(p, tid);
    xcd_barrier(bar);
    phase4a(p, lds, tid, lane, wave);
    xcd_barrier(bar);
    { pg8::Gemm g{(const bf16_t*)(ws + WS_RA), (const bf16_t*)(ws + WS_WOUT), T, D, D}; pg8::StaticOrder S; S.init(T, D, (int)gridDim.x, (int)blockIdx.x);
      pg8::EpiB16 e{(bf16_t*)(ws + WS_RZ), D}; pg8::gemm_phase<pg8::EpiB16, pg8::StaticOrder, true, true>(lds, g, S, e); }
    xcd_barrier(bar);
    phase4c(p, lds, tid, lane, wave);
    xcd_barrier(bar);
    { pg8::Gemm g{(const bf16_t*)(ws + WS_RA), (const bf16_t*)(ws + WS_WQ), T, 2048, D}; pg8::StaticOrder S; S.init(T, 2048, (int)gridDim.x, (int)blockIdx.x);
      pg8::EpiB16 e{(bf16_t*)(ws + WS_RZ), 2048}; pg8::gemm_phase<pg8::EpiB16, pg8::StaticOrder, true, true>(lds, g, S, e); }
    xcd_barrier(bar);
    phase5b(p, lds, tid, lane, wave);
    xcd_barrier(bar);
    phase6(p, lds, tid, lane, wave);
}

extern "C" void kernel_launch(void* const* d_in, const int* in_sizes, int n_in, void* d_out, int out_size, void* d_ws, size_t ws_size, hipStream_t stream) {
    static int grid = 0;
    if (grid == 0) {
        if (n_in != 21 || out_size != T * D || ws_size < WS_END) { fprintf(stderr, "kernel_launch: unexpected shapes (n_in %d out %d ws %zu need %zu)\n", n_in, out_size, ws_size, (size_t)WS_END); grid = -1; return; }
        int dev = 0, cus = 0, per_cu = 0;
        hipGetDevice(&dev); hipDeviceGetAttribute(&cus, hipDeviceAttributeMultiprocessorCount, dev);
        hipFuncSetAttribute((const void*)fwd_megakernel, hipFuncAttributeMaxDynamicSharedMemorySize, LDS_BYTES);
        hipOccupancyMaxActiveBlocksPerMultiprocessor(&per_cu, (const void*)fwd_megakernel, NTH, LDS_BYTES);
        (void)hipGetLastError();
        if (per_cu < 1) fprintf(stderr, "kernel_launch: occupancy query says %d blocks per CU\n", per_cu);
        grid = cus;
    }
    if (grid < 0) return;
    hipMemsetAsync((char*)d_ws + WS_CTL, 0, 64 * 1024, stream);
    Params p{};
    for (int i = 0; i < 21; ++i) p.in[i] = (const float*)d_in[i];
    p.out = (float*)d_out; p.ws = (unsigned char*)d_ws;
    hipLaunchKernelGGL(fwd_megakernel, dim3(grid), dim3(NTH), LDS_BYTES, stream, p);
}
```

```cpp
#include <hip/hip_runtime.h>
#include <cstdio>
#include <cstdint>

#define DI __device__ __forceinline__
#define LAS __attribute__((address_space(3)))
typedef unsigned short bf16_t;
typedef short bf16x8 __attribute__((ext_vector_type(8)));
typedef float f32x4 __attribute__((ext_vector_type(4)));
typedef float f32x2 __attribute__((ext_vector_type(2)));
typedef float f32x16 __attribute__((ext_vector_type(16)));
typedef unsigned u32x4 __attribute__((ext_vector_type(4)));
typedef unsigned u32x2 __attribute__((ext_vector_type(2)));
typedef __bf16 bf16x2v __attribute__((ext_vector_type(2)));

constexpr int T = 32768, D = 1024, SEQ = 4096, NB = 8;
constexpr int NTH = 512, NWV = 8;
constexpr int ZW = 2048;
constexpr int NIN = 2176;
constexpr float EPS = 1e-6f;

constexpr size_t MB = 1024 * 1024;
constexpr size_t WS_CTL   = 0;
constexpr size_t WS_MODP  = 64 * 1024;
constexpr size_t WS_WIN   = WS_MODP + 8 * 8 * 6144 * 4;
constexpr size_t WS_WOUT  = WS_WIN + (size_t)NIN * 1024 * 2;
constexpr size_t WS_WQ    = WS_WOUT + 1024 * 1024 * 2;
constexpr size_t WS_SKB   = WS_WQ + 2048 * 1024 * 2;
constexpr size_t WS_WP    = WS_SKB + 16 * 128 * 128 * 2;
constexpr size_t WS_AFB   = WS_WP + 4 * 128 * 128 * 2;
constexpr size_t WS_UB    = WS_AFB + (size_t)T * 32 * 4;
constexpr size_t WS_VB    = WS_UB + 32 * MB;
constexpr size_t WS_SU    = WS_UB + 16 * MB, WS_SV = WS_VB + 16 * MB;
constexpr size_t WS_RA    = WS_VB + 32 * MB;
constexpr size_t WS_RZ    = WS_RA + 64 * MB;
constexpr size_t WS_RS    = WS_RZ + 128 * MB;
constexpr size_t WS_RO    = WS_RS + 6 * 16 * MB + 1 * MB;
constexpr size_t WS_END   = WS_RO + 128 * MB;
static_assert(WS_END <= 512 * MB, "workspace too large");

struct Params { const float* in[21]; float* out; unsigned char* ws; };

DI unsigned pk2(float a, float b) { f32x2 f = {a, b}; bf16x2v h = __builtin_convertvector(f, bf16x2v); return __builtin_bit_cast(unsigned, h); }
DI float dot2bf(unsigned a, unsigned b, float c) { return __builtin_amdgcn_fdot2_f32_bf16(__builtin_bit_cast(bf16x2v, a), __builtin_bit_cast(bf16x2v, b), c, false); }
DI float bflo(unsigned u) { return __uint_as_float(u << 16); }
DI float bfhi(unsigned u) { return __uint_as_float(u & 0xFFFF0000u); }
DI float wave_sum(float v) {
#pragma unroll
    for (int o = 1; o < 64; o <<= 1) v += __shfl_xor(v, o);
    return v;
}
DI bf16x8 ld_frag16(const bf16_t* p) { return __builtin_bit_cast(bf16x8, *(const u32x4*)p); }
DI bf16x8 ld_frag_perm(const bf16_t* p, int g) {
    const u32x2 lo = *(const u32x2*)(p + 4 * g), hi = *(const u32x2*)(p + 16 + 4 * g);
    u32x4 v = {lo.x, lo.y, hi.x, hi.y}; return __builtin_bit_cast(bf16x8, v);
}
DI int perm32(int k) { return (k & ~31) | (((k >> 2) & 3) << 3) | (((k >> 4) & 1) << 2) | (k & 3); }
DI bf16x8 pack8(const f32x4& a, const f32x4& b) { u32x4 v = {pk2(a[0], a[1]), pk2(a[2], a[3]), pk2(b[0], b[1]), pk2(b[2], b[3])}; return __builtin_bit_cast(bf16x8, v); }
#define MFMA16(a, b, c) __builtin_amdgcn_mfma_f32_16x16x32_bf16((a), (b), (c), 0, 0, 0)
#define MFMA32(a, b, c) __builtin_amdgcn_mfma_f32_32x32x16_bf16((a), (b), (c), 0, 0, 0)

#define XB_TMO      128
#define XB_XCNT(j)  (256  + 64 * (j))
#define XB_XSUB(j)  (1280 + 64 * (j))
#define XB_XGEN(j)  (2304 + 64 * (j))
#define XB_TOP      3328
#define XB_TOPGEN   3392
#define XCD_BAR_WORDS 3456
#define XB_SPIN_CAP (1u << 22)
DI unsigned xb_ld(unsigned* p)              { return __hip_atomic_load(p, __ATOMIC_RELAXED, __HIP_MEMORY_SCOPE_AGENT); }
DI unsigned xb_add(unsigned* p, unsigned v) { return __hip_atomic_fetch_add(p, v, __ATOMIC_RELAXED, __HIP_MEMORY_SCOPE_AGENT); }
DI unsigned xb_xcc_id() { return (unsigned)__builtin_amdgcn_s_getreg((3 << 11) | 20) & 0xFu; }
#define XB_SPIN(cond, bar) do { unsigned _sp = 0; while (cond) { __builtin_amdgcn_s_sleep(1); \
    if ((++_sp & 255u) == 0u) { if (xb_ld(&(bar)[XB_TMO])) break; if (_sp > XB_SPIN_CAP) { atomicAdd(&(bar)[XB_TMO], 1u); break; } } } } while (0)
struct XcdBarrier { unsigned* bar; unsigned x; volatile LAS unsigned* st; };
DI XcdBarrier xcd_barrier_post(unsigned* bar, volatile LAS unsigned* st) {
    XcdBarrier b; b.bar = bar; b.x = xb_xcc_id(); b.st = st;
    if (threadIdx.x == 0) (void)xb_add(&bar[XB_XCNT(b.x)], 1u);
    return b;
}
DI void xcd_barrier_complete(unsigned* bar, unsigned x, unsigned& nloc, unsigned& nx) {
    const unsigned G = gridDim.x * gridDim.y * gridDim.z;
    unsigned sum, cnt, mine, sp = 0u;
    for (;;) {
        sum = 0u; cnt = 0u; mine = 0u;
#pragma unroll
        for (unsigned j = 0; j < 16; ++j) { const unsigned c = xb_ld(&bar[XB_XCNT(j)]); sum += c; cnt += (c > 0u) ? 1u : 0u; mine = (j == x) ? c : mine; }
        if (sum == G) break;
        __builtin_amdgcn_s_sleep(1);
        if ((++sp & 255u) == 0u) { if (xb_ld(&bar[XB_TMO])) break; if (sp > XB_SPIN_CAP) { atomicAdd(&bar[XB_TMO], 1u); break; } }
    }
    nloc = mine > 0u ? mine : 1u; nx = cnt > 0u ? cnt : 1u;
}
DI void xcd_barrier(const XcdBarrier& b) {
    asm volatile("s_waitcnt vmcnt(0)" ::: "memory");
    __syncthreads();
    if (threadIdx.x == 0) {
        unsigned* bar = b.bar;
        __builtin_amdgcn_s_waitcnt(0);
        unsigned nloc = b.st[0], nx = b.st[1];
        if (nloc == 0u) { xcd_barrier_complete(bar, b.x, nloc, nx); b.st[0] = nloc; b.st[1] = nx; }
        const unsigned old = xb_add(&bar[XB_XSUB(b.x)], 1u);
        const unsigned gen = old / nloc;
        if (old + 1u == (gen + 1u) * nloc) {
            __builtin_amdgcn_fence(__ATOMIC_RELEASE, "agent");
            asm volatile("s_waitcnt vmcnt(0)" ::: "memory");
            const unsigned og = xb_add(&bar[XB_TOP], 1u);
            const unsigned tg = og / nx;
            if (og + 1u == (tg + 1u) * nx) xb_add(&bar[XB_TOPGEN], 1u);
            else XB_SPIN(xb_ld(&bar[XB_TOPGEN]) == tg, bar);
            __builtin_amdgcn_fence(__ATOMIC_ACQUIRE, "agent");
            xb_add(&bar[XB_XGEN(b.x)], 1u);
            asm volatile("s_waitcnt vmcnt(0)" ::: "memory");
        } else {
            XB_SPIN(xb_ld(&bar[XB_XGEN(b.x)]) == gen, bar);
            __builtin_amdgcn_fence(__ATOMIC_ACQUIRE, "agent");
            asm volatile("s_waitcnt vmcnt(0)" ::: "memory");
        }
    }
    __syncthreads();
}

constexpr int LDS_BYTES = 152 * 1024;
constexpr int LDS_BARW = LDS_BYTES - 16;

DI void p0_transpose_item(const float* W, int ldw, int K, bf16_t* WT, int dst_row0, int src_col0, float scale, bool zero, LAS float* scr, int kb, int lane) {
    const int k0 = 64 * kb;
#pragma unroll 8
    for (int i = 0; i < 32; ++i) { const int kk = 2 * i + (lane >> 5); scr[kk * 33 + (lane & 31)] = zero ? 0.f : W[(size_t)(k0 + kk) * ldw + src_col0 + (lane & 31)] * scale; }
    asm volatile("s_waitcnt lgkmcnt(0)" ::: "memory");
    const int c = lane & 7;
#pragma unroll
    for (int j = 0; j < 4; ++j) { const int n = (lane >> 3) + 8 * j; const LAS float* s = scr + (8 * c) * 33 + n;
        u32x4 o; o.x = pk2(s[0 * 33], s[1 * 33]); o.y = pk2(s[2 * 33], s[3 * 33]); o.z = pk2(s[4 * 33], s[5 * 33]); o.w = pk2(s[6 * 33], s[7 * 33]);
        *(u32x4*)(WT + (size_t)(dst_row0 + n) * K + k0 + 8 * c) = o; }
    asm volatile("s_waitcnt lgkmcnt(0)" ::: "memory");
}

DI void phase0(const Params& p, LAS unsigned char* lds, int tid, int lane, int wave) {
    asm volatile("" : "+v"(tid), "+v"(lane));
    unsigned char* ws = p.ws;
    LAS float* sl = (LAS float*)lds;
    LAS float* scr = (LAS float*)(lds + 32768 + wave * 8448);
    const float* c = p.in[1];
    for (int e = tid; e < 8192; e += NTH) { const int b = e >> 10, k = e & 1023; const float v = c[e]; sl[k * 8 + b] = v / (1.f + __expf(-v)); }
    __syncthreads();
    const int gw = wave * gridDim.x + blockIdx.x, NGW = gridDim.x * NWV;
    constexpr int I_MOD = 768, I_WIN = 16 * 68, I_WOUT = 16 * 32, I_WQ = 16 * 64, I_WP = 32;
    constexpr int NITEMS = I_MOD + I_WIN + I_WOUT + I_WQ + I_WP;
    for (int it = gw; it < NITEMS; it += NGW) {
        int r = it;
        if (r < I_MOD) {
            const int cg = r % 96, ks = r / 96, n = cg * 64 + lane, k0 = ks * 128;
            const float* W = p.in[2] + (size_t)k0 * 6144 + n;
            float acc[8];
#pragma unroll
            for (int b = 0; b < 8; ++b) acc[b] = 0.f;
#pragma unroll 8
            for (int k = 0; k < 128; ++k) {
                const float w = W[(size_t)k * 6144];
                const f32x4 s0 = *(const LAS f32x4*)(sl + (k0 + k) * 8), s1 = *(const LAS f32x4*)(sl + (k0 + k) * 8 + 4);
                acc[0] += s0[0] * w; acc[1] += s0[1] * w; acc[2] += s0[2] * w; acc[3] += s0[3] * w;
                acc[4] += s1[0] * w; acc[5] += s1[1] * w; acc[6] += s1[2] * w; acc[7] += s1[3] * w;
            }
            float* mp = (float*)(ws + WS_MODP) + (size_t)ks * 8 * 6144 + n;
#pragma unroll
            for (int b = 0; b < 8; ++b) mp[b * 6144] = acc[b];
            continue;
        }
        r -= I_MOD;
        if (r < I_WIN) {
            const int kb = r / 68, nb = r % 68, n0 = nb * 32;
            int src; bool zero = false; float scale = 1.f;
            if (n0 < 1536) { src = n0; if (n0 < 256) scale = 0.125f; } else if (n0 < 2048) src = n0 + 32; else if (n0 < 2080) src = 1536 + (n0 - 2048); else { src = 0; zero = true; }
            p0_transpose_item(p.in[6], 2080, 1024, (bf16_t*)(ws + WS_WIN), n0, src, scale, zero, scr, kb, lane);
            continue;
        }
        r -= I_WIN;
        if (r < I_WOUT) { p0_transpose_item(p.in[14], 1024, 1024, (bf16_t*)(ws + WS_WOUT), (r % 32) * 32, (r % 32) * 32, 1.f, false, scr, r / 32, lane); continue; }
        r -= I_WOUT;
        if (r < I_WQ) { p0_transpose_item(p.in[17], 2048, 1024, (bf16_t*)(ws + WS_WQ), (r % 64) * 32, (r % 64) * 32, 1.f, false, scr, r / 64, lane); continue; }
        r -= I_WQ;
        { const int g = r >> 3, kb = (r >> 2) & 1, nb = r & 3;
          p0_transpose_item(p.in[12] + g * 16384, 128, 128, (bf16_t*)(ws + WS_WP) + g * 16384, nb * 32, nb * 32, 1.f, false, scr, kb, lane); }
    }
    const size_t gt = (size_t)blockIdx.x * NTH + tid, NGT = (size_t)gridDim.x * NTH;
    constexpr size_t NSK = (size_t)16 * 128 * 128 / 8;
    for (size_t j = gt; j < NSK; j += NGT) {
        const float* src = p.in[18]; bf16_t* dst = (bf16_t*)(ws + WS_SKB);
        const f32x4 a = *(const f32x4*)(src + j * 8), b = *(const f32x4*)(src + j * 8 + 4);
        u32x4 o = {pk2(a[0], a[1]), pk2(a[2], a[3]), pk2(b[0], b[1]), pk2(b[2], b[3])};
        *(u32x4*)(dst + j * 8) = o;
    }
}

DI void quant_load(const Params& p, int row, int lane, f32x4 (&v)[4]) {
    const int tb = row >> 14, e = row & 16383;
    const float* src = (tb ? p.in[20] : p.in[19]) + (size_t)e * D + 16 * lane;
#pragma unroll
    for (int q = 0; q < 4; ++q) v[q] = *(const f32x4*)(src + 4 * q);
}
DI void quant_store(const Params& p, int row, int lane, const f32x4 (&v)[4]) {
    unsigned char* ws = p.ws;
    const int tb = row >> 14, e = row & 16383;
    float m = 0.f;
#pragma unroll
    for (int q = 0; q < 4; ++q) m = fmaxf(m, fmaxf(fmaxf(fabsf(v[q][0]), fabsf(v[q][1])), fmaxf(fabsf(v[q][2]), fabsf(v[q][3]))));
#pragma unroll
    for (int o = 1; o < 64; o <<= 1) m = fmaxf(m, __shfl_xor(m, o));
    int ex = (int)((__float_as_uint(m) >> 23) & 0xFFu) - 127;
    if (m < 1e-30f) ex = 7;
    const float sc = __uint_as_float((unsigned)(127 + 7 - ex) << 23), isc = __uint_as_float((unsigned)(127 - 7 + ex) << 23);
    u32x4 o;
    if (tb) {
#pragma unroll
        for (int q = 0; q < 4; ++q) { int w = 0; w = __builtin_amdgcn_cvt_pk_fp8_f32(v[q][0] * sc, v[q][1] * sc, w, false); w = __builtin_amdgcn_cvt_pk_fp8_f32(v[q][2] * sc, v[q][3] * sc, w, true); o[q] = (unsigned)w; }
        if (lane == 0) ((float*)(ws + WS_SV))[e] = isc;
    } else {
        const float s8 = m > 1e-30f ? 127.f / m : 0.f;
#pragma unroll
        for (int q = 0; q < 4; ++q) {
            const int q0 = __float2int_rn(v[q][0] * s8), q1 = __float2int_rn(v[q][1] * s8), q2 = __float2int_rn(v[q][2] * s8), q3 = __float2int_rn(v[q][3] * s8);
            o[q] = (unsigned)(q0 & 0xFF) | ((unsigned)(q1 & 0xFF) << 8) | ((unsigned)(q2 & 0xFF) << 16) | ((unsigned)q3 << 24);
        }
        if (lane == 0) ((float*)(ws + WS_SU))[e] = m * (1.f / 127.f);
    }
    *(u32x4*)(ws + (tb ? WS_VB : WS_UB) + (size_t)e * 1024 + 16 * lane) = o;
}

DI float mod_at(const Params& p, int b, int n) {
    const float* mp = (const float*)(p.ws + WS_MODP) + (size_t)b * 6144 + n;
    float s = p.in[3][n];
#pragma unroll
    for (int ks = 0; ks < 8; ++ks) s += mp[(size_t)ks * 8 * 6144];
    return s;
}

DI void phase1(const Params& p, LAS unsigned char* lds, int tid, int lane, int wave) {
    asm volatile("" : "+v"(tid), "+v"(lane));
    LAS float* lA = (LAS float*)lds; LAS float* lB = lA + 1024;
    const float* x = p.in[0]; bf16_t* H = (bf16_t*)(p.ws + WS_RA);
    for (int rt = blockIdx.x; rt < T / 128; rt += gridDim.x) {
        const int b = rt / 32;
        __syncthreads();
        for (int d = tid; d < 1024; d += NTH) { lA[d] = p.in[4][d] * (1.f + mod_at(p, b, 1024 + d)); lB[d] = mod_at(p, b, d); }
        __syncthreads();
        for (int r0 = wave; r0 < 128; r0 += 4 * NWV) {
            f32x4 v[4][4];
#pragma unroll
            for (int u = 0; u < 4; ++u) { const f32x4* xr = (const f32x4*)(x + ((size_t)rt * 128 + r0 + u * NWV) * D) + lane;
#pragma unroll
                for (int j = 0; j < 4; ++j) v[u][j] = xr[64 * j]; }
#pragma unroll
            for (int u = 0; u < 4; ++u) {
                const size_t row = (size_t)rt * 128 + r0 + u * NWV;
                float ss = 0.f;
#pragma unroll
                for (int j = 0; j < 4; ++j) ss += v[u][j][0] * v[u][j][0] + v[u][j][1] * v[u][j][1] + v[u][j][2] * v[u][j][2] + v[u][j][3] * v[u][j][3];
                const float rstd = rsqrtf(wave_sum(ss) * (1.f / D) + EPS);
                u32x2* o = (u32x2*)(H + row * D) + lane;
#pragma unroll
                for (int j = 0; j < 4; ++j) {
                    const f32x4 a = *(const LAS f32x4*)(lA + 4 * lane + 256 * j), bb = *(const LAS f32x4*)(lB + 4 * lane + 256 * j);
                    u32x2 w = {pk2(v[u][j][0] * rstd * a[0] + bb[0], v[u][j][1] * rstd * a[1] + bb[1]), pk2(v[u][j][2] * rstd * a[2] + bb[2], v[u][j][3] * rstd * a[3] + bb[3])};
                    o[64 * j] = w;
                }
            }
        }
    }
}

struct EpiZ {
    bf16_t* Z; float* AFB;
    DI void operator()(int m, int n, const f32x4& v) const {
        if (n < ZW) { u32x2 w = {pk2(v[0], v[1]), pk2(v[2], v[3])}; *(u32x2*)(Z + (size_t)m * ZW + n) = w; }
        else if (n < ZW + 32) { *(f32x4*)(AFB + (size_t)m * 32 + (n - ZW)) = v; }
    }
};
struct EpiF32 { float* C; int ldc; DI void operator()(int m, int n, const f32x4& v) const { *(f32x4*)(C + (size_t)m * ldc + n) = v; } };
struct EpiBf16 { bf16_t* C; int ldc; DI void operator()(int m, int n, const f32x4& v) const { u32x2 w = {pk2(v[0], v[1]), pk2(v[2], v[3])}; *(u32x2*)(C + (size_t)m * ldc + n) = w; } };

template <class Epi>
DI void gemm_phase(const bf16_t* A, const bf16_t* Bt, int M, int N, int K, const Epi& epi, LAS unsigned char* lds, int tid, int lane, int wave, int nt_first = 0) {
    constexpr int BM = 256, BN = 128, BK = 64, STAGE = (BM + BN) * 128;
    const int ntn = N / BN - nt_first, ntiles = (M / BM) * ntn, nk = K / BK;
    const int wm = wave & 3, wn = wave >> 2, c15 = lane & 15, g = lane >> 4;
    const int lrow = tid >> 3, lch = tid & 7;
    for (int tile = blockIdx.x; tile < ntiles; tile += gridDim.x) {
        const int m0 = (tile / ntn) * BM, n0 = (tile % ntn + nt_first) * BN;
        f32x4 acc[4][4];
#pragma unroll
        for (int i = 0; i < 4; ++i)
#pragma unroll
            for (int j = 0; j < 4; ++j) acc[i][j] = (f32x4){0.f, 0.f, 0.f, 0.f};
        u32x4 ra[4], rb[2];
        const bf16_t* Ag = A + (size_t)(m0 + lrow) * K + lch * 8;
        const bf16_t* Bg = Bt + (size_t)(n0 + lrow) * K + lch * 8;
        const int woff = lrow * 128 + ((lch ^ (lrow & 7)) * 16);
        __syncthreads();
#pragma unroll
        for (int ps = 0; ps < 4; ++ps) ra[ps] = *(const u32x4*)(Ag + (size_t)(64 * ps) * K);
#pragma unroll
        for (int ps = 0; ps < 2; ++ps) rb[ps] = *(const u32x4*)(Bg + (size_t)(64 * ps) * K);
#pragma unroll
        for (int ps = 0; ps < 4; ++ps) *(LAS u32x4*)(lds + woff + ps * 8192) = ra[ps];
#pragma unroll
        for (int ps = 0; ps < 2; ++ps) *(LAS u32x4*)(lds + BM * 128 + woff + ps * 8192) = rb[ps];
        __syncthreads();
        for (int kt = 0; kt < nk; ++kt) {
            const bool more = (kt + 1 < nk);
            if (more) {
#pragma unroll
                for (int ps = 0; ps < 4; ++ps) ra[ps] = *(const u32x4*)(Ag + (size_t)(64 * ps) * K + (kt + 1) * BK);
#pragma unroll
                for (int ps = 0; ps < 2; ++ps) rb[ps] = *(const u32x4*)(Bg + (size_t)(64 * ps) * K + (kt + 1) * BK);
            }
            LAS unsigned char* sa = lds + (kt & 1) * STAGE; LAS unsigned char* sb = sa + BM * 128;
#pragma unroll
            for (int s = 0; s < 2; ++s) {
                bf16x8 fa[4], fb[4];
#pragma unroll
                for (int i = 0; i < 4; ++i) { const int row = wm * 64 + i * 16 + c15; fa[i] = *(const LAS bf16x8*)(sa + row * 128 + (((4 * s + g) ^ (row & 7)) * 16)); }
#pragma unroll
                for (int j = 0; j < 4; ++j) { const int row = wn * 64 + j * 16 + c15; fb[j] = *(const LAS bf16x8*)(sb + row * 128 + (((4 * s + g) ^ (row & 7)) * 16)); }
#pragma unroll
                for (int i = 0; i < 4; ++i)
#pragma unroll
                    for (int j = 0; j < 4; ++j) acc[i][j] = MFMA16(fb[j], fa[i], acc[i][j]);
            }
            if (more) {
                LAS unsigned char* da = lds + ((kt + 1) & 1) * STAGE;
#pragma unroll
                for (int ps = 0; ps < 4; ++ps) *(LAS u32x4*)(da + woff + ps * 8192) = ra[ps];
#pragma unroll
                for (int ps = 0; ps < 2; ++ps) *(LAS u32x4*)(da + BM * 128 + woff + ps * 8192) = rb[ps];
            }
            __syncthreads();
        }
#pragma unroll
        for (int i = 0; i < 4; ++i)
#pragma unroll
            for (int j = 0; j < 4; ++j) epi(m0 + wm * 64 + i * 16 + c15, n0 + wn * 64 + j * 16 + 4 * g, acc[i][j]);
    }
}

namespace pg8 {
#define PG8_LAS __attribute__((address_space(3)))
constexpr int BM = 256, BK = 64, HALF = 128, HTB = HALF * BK * 2  , STAGE_BYTES = 8 * HTB, NXCD = 8, WGM = 8;

__host__ __device__ __forceinline__ int lds_byte(int r, int c) { const int st = (r >> 4) * 2 + (c >> 5), rr = r & 15, cc = c & 31, ob = rr * 64 + cc * 2; return st * 1024 + (ob ^ (((ob >> 9) & 1) << 5)); }
__host__ __device__ __forceinline__ void stage_rc(int b, int& R, int& C) { const int st = b / 1024, sb = b % 1024, swz = sb ^ (((sb >> 9) & 1) << 5); R = (st >> 1) * 16 + swz / 64; C = (st & 1) * 32 + (swz % 64) / 2; }
__host__ __device__ __forceinline__ int perm32(int rho) { const int n = rho >> 4, i = rho & 15; return 8 * (i >> 2) + 4 * n + (i & 3); }

struct Unit { int pm, pn; };
struct Gemm { const bf16_t* A; const bf16_t* Bt; int M, N, K; };

struct StaticOrder {
    int nM, nN, nwg, G, c;
    __host__ __device__ void init(int M, int N, int G_, int c_) { nM = M / BM; nN = N / BM; nwg = nM * nN; G = G_; c = c_; }
    __host__ __device__ bool next(int i, Unit& u) const {
        const long L = (long)i * G + c; if (L >= nwg) return false;
        int wgid = (int)L; { const int q = nwg / NXCD, r = nwg % NXCD, xcd = wgid % NXCD, off = wgid / NXCD; wgid = (xcd < r ? xcd * (q + 1) : r * (q + 1) + (xcd - r) * q) + off; }
        const int nig = WGM * nN, gid = wgid / nig, fm = gid * WGM, gsz = (nM - fm) < WGM ? (nM - fm) : WGM;
        u.pm = fm + ((wgid % nig) % gsz); u.pn = (wgid % nig) / gsz; return true;
    }
    __device__ __forceinline__ void a_ready(const Unit&) const {}
    __device__ __forceinline__ void done(const Unit&) const {}
};

struct EpiB16 {
    static constexpr bool PERM = true, AFTER_DRAIN = false;
    bf16_t* O; int ldc;
    __device__ __forceinline__ void operator()(const f32x4 (&acc)[2][2][4][2], const Unit& u, int wr, int wc, int fr, int fq) const {
#pragma unroll
        for (int ai = 0; ai < 2; ++ai)
#pragma unroll
            for (int m = 0; m < 4; ++m) { bf16_t* rowp = O + (size_t)(u.pm * BM + ai * HALF + wr * 64 + m * 16 + fr) * ldc + u.pn * BM + wc * 32 + 8 * fq;
#pragma unroll
                for (int bj = 0; bj < 2; ++bj) { const f32x4 v0 = acc[ai][bj][m][0], v1 = acc[ai][bj][m][1];
                    u32x4 w; w.x = ::pk2(v0[0], v0[1]); w.y = ::pk2(v0[2], v0[3]); w.z = ::pk2(v1[0], v1[1]); w.w = ::pk2(v1[2], v1[3]);
                    *(u32x4*)(rowp + bj * HALF) = w; } }
    }
};
struct EpiF {
    static constexpr bool PERM = false, AFTER_DRAIN = false;
    float* O; int ldc;
    __device__ __forceinline__ void operator()(const f32x4 (&acc)[2][2][4][2], const Unit& u, int wr, int wc, int fr, int fq) const {
#pragma unroll
        for (int ai = 0; ai < 2; ++ai)
#pragma unroll
            for (int m = 0; m < 4; ++m) { float* rowp = O + (size_t)(u.pm * BM + ai * HALF + wr * 64 + m * 16 + fr) * ldc + u.pn * BM + wc * 32 + 4 * fq;
#pragma unroll
                for (int bj = 0; bj < 2; ++bj)
#pragma unroll
                    for (int n = 0; n < 2; ++n) *(f32x4*)(rowp + bj * HALF + 16 * n) = acc[ai][bj][m][n]; }
    }
};
template <class Epi, class Sched, bool ALIGN_EPI = false, bool SP2 = false>
__device__ __forceinline__ void gemm_phase(PG8_LAS unsigned char* lds, const Gemm g, const Sched& S, const Epi& E) {
    int tid = threadIdx.x; asm volatile("" : "+v"(tid));
    const int wid = __builtin_amdgcn_readfirstlane(tid >> 6), lane = tid & 63, wr = wid >> 2, wc = wid & 3, fr = lane & 15, fq = lane >> 4;
    const int K = g.K, nt = K / BK;
    unsigned voffA[2], voffB[2];
#pragma unroll
    for (int i = 0; i < 2; ++i) { int R, C; stage_rc(tid * 16 + i * 8192, R, C); const int Rb = Epi::PERM ? ((R & ~31) + perm32(R & 31)) : R;
        voffA[i] = (unsigned)(R * K + C) * 2u; voffB[i] = (unsigned)(Rb * K + C) * 2u; }
    const size_t kstep = (size_t)(BK * 2);
    const size_t hstep = (size_t)HALF * K * 2;
    const size_t tstep = 2 * hstep;
    const unsigned ldsw = (unsigned)wid * 1024u;
    const int aoff = lds_byte(wr * 64 + fr, fq * 8), boff = lds_byte(wc * 32 + fr, fq * 8);
#define PG8_SA(b, h) (((b) * 2 + (h)) * HTB)
#define PG8_SB(b, h) ((4 + (b) * 2 + (h)) * HTB)
#define PG8_STAGE(bufoff, gbase, voff) do { _Pragma("unroll") for (int _i = 0; _i < 2; ++_i) \
        __builtin_amdgcn_global_load_lds((const unsigned*)((const char*)(gbase) + (voff)[_i]), (PG8_LAS unsigned*)(lds + (bufoff) + ldsw + _i * 8192), 16, 0, 0); } while (0)
#define PG8_LDA(dst, b, h) do { _Pragma("unroll") for (int m = 0; m < 4; ++m) _Pragma("unroll") for (int k = 0; k < 2; ++k) dst[m][k] = *(const PG8_LAS bf16x8*)(lds + PG8_SA(b, h) + aoff + m * 2048 + k * 1024); } while (0)
#define PG8_LDB(dst, b, h) do { _Pragma("unroll") for (int n = 0; n < 2; ++n) _Pragma("unroll") for (int k = 0; k < 2; ++k) dst[n][k] = *(const PG8_LAS bf16x8*)(lds + PG8_SB(b, h) + boff + n * 2048 + k * 1024); } while (0)
#define PG8_MMA(ai, bj, At, Bt) do { __builtin_amdgcn_s_setprio(1); _Pragma("unroll") for (int m = 0; m < 4; ++m) _Pragma("unroll") for (int n = 0; n < 2; ++n) _Pragma("unroll") for (int k = 0; k < 2; ++k) \
        acc[ai][bj][m][n] = __builtin_amdgcn_mfma_f32_16x16x32_bf16(Bt[n][k], At[m][k], acc[ai][bj][m][n], 0, 0, 0); __builtin_amdgcn_s_setprio(0); } while (0)
#define PG8_WAIT_V(n) asm volatile("s_waitcnt vmcnt(" #n ")" ::: "memory")
#define PG8_WAIT_L(n) asm volatile("s_waitcnt lgkmcnt(" #n ")" ::: "memory")
#define PG8_BAR __builtin_amdgcn_s_barrier()
#define PG8_SCHED __builtin_amdgcn_sched_barrier(0)
    Unit cur, nxt; int ui = 0;
    if (!S.next(0, cur)) return;
    f32x4 acc[2][2][4][2];
#pragma unroll
    for (int a = 0; a < 2; ++a)
#pragma unroll
        for (int b = 0; b < 2; ++b)
#pragma unroll
            for (int m = 0; m < 4; ++m)
#pragma unroll
                for (int n = 0; n < 2; ++n) acc[a][b][m][n] = (f32x4){0.f, 0.f, 0.f, 0.f};
    bf16x8 At[4][2], B0[2][2], B1[2][2];
    const char* cA = (const char*)g.A + (size_t)cur.pm * tstep; const char* cB = (const char*)g.Bt + (size_t)cur.pn * tstep;
    S.a_ready(cur);
    if constexpr (SP2) {
        PG8_STAGE(PG8_SB(0, 0), cB, voffB); PG8_STAGE(PG8_SB(0, 1), cB + hstep, voffB); PG8_STAGE(PG8_SA(0, 0), cA, voffA); PG8_STAGE(PG8_SA(0, 1), cA + hstep, voffA);
        if (wr == 1) PG8_BAR;
        PG8_WAIT_V(2); PG8_BAR;
        PG8_STAGE(PG8_SB(1, 0), cB + kstep, voffB); PG8_STAGE(PG8_SA(1, 0), cA + kstep, voffA); PG8_STAGE(PG8_SB(1, 1), cB + hstep + kstep, voffB);
        PG8_WAIT_V(6); PG8_BAR;
    } else {
        PG8_STAGE(PG8_SB(0, 0), cB, voffB); PG8_STAGE(PG8_SA(0, 0), cA, voffA); PG8_STAGE(PG8_SB(0, 1), cB + hstep, voffB); PG8_STAGE(PG8_SA(0, 1), cA + hstep, voffA);
        if (wr == 1) PG8_BAR;
        PG8_WAIT_V(4); PG8_BAR;
        PG8_STAGE(PG8_SB(1, 0), cB + kstep, voffB); PG8_STAGE(PG8_SA(1, 0), cA + kstep, voffA); PG8_STAGE(PG8_SB(1, 1), cB + hstep + kstep, voffB);
        PG8_WAIT_V(6); PG8_BAR;
    }
    for (;;) {
        const bool has_next = S.next(ui + 1, nxt);
        const char* nA = has_next ? (const char*)g.A + (size_t)nxt.pm * tstep : cA; const char* nB = has_next ? (const char*)g.Bt + (size_t)nxt.pn * tstep : cB;
        for (int t = 0; t < nt; t += 2) {
            const bool last = (t == nt - 2);
            const char* a1 = cA + (size_t)(t + 1) * kstep;
            const char* a2 = last ? nA : cA + (size_t)(t + 2) * kstep; const char* b2 = last ? nB : cB + (size_t)(t + 2) * kstep;
            const char* a3 = a2 + kstep; const char* b3 = b2 + kstep;
            if (last && has_next) S.a_ready(nxt);
            if constexpr (SP2) {
            PG8_LDB(B0, 0, 0); PG8_LDB(B1, 0, 1); PG8_SCHED; PG8_LDA(At, 0, 0); PG8_STAGE(PG8_SA(1, 1), a1 + hstep, voffA);
            PG8_WAIT_V(8); PG8_WAIT_L(0); PG8_BAR; PG8_MMA(0, 0, At, B0); PG8_MMA(0, 1, At, B1); PG8_BAR; PG8_SCHED;
            PG8_LDA(At, 0, 1); PG8_STAGE(PG8_SB(0, 0), b2, voffB); PG8_STAGE(PG8_SB(0, 1), b2 + hstep, voffB); PG8_STAGE(PG8_SA(0, 0), a2, voffA);
            PG8_WAIT_V(8); PG8_WAIT_L(0); PG8_BAR; PG8_MMA(1, 0, At, B0); PG8_MMA(1, 1, At, B1); PG8_BAR; PG8_SCHED;
            PG8_LDB(B0, 1, 0); PG8_LDB(B1, 1, 1); PG8_SCHED; PG8_LDA(At, 1, 0); PG8_STAGE(PG8_SA(0, 1), a2 + hstep, voffA);
            PG8_WAIT_V(8); PG8_WAIT_L(0); PG8_BAR; PG8_MMA(0, 0, At, B0); PG8_MMA(0, 1, At, B1); PG8_BAR; PG8_SCHED;
            PG8_LDA(At, 1, 1); PG8_STAGE(PG8_SB(1, 0), b3, voffB); PG8_STAGE(PG8_SB(1, 1), b3 + hstep, voffB); PG8_STAGE(PG8_SA(1, 0), a3, voffA);
            PG8_WAIT_V(8); PG8_WAIT_L(0); PG8_BAR; PG8_MMA(1, 0, At, B0); PG8_MMA(1, 1, At, B1); PG8_BAR; PG8_SCHED;
            } else {
            PG8_LDB(B0, 0, 0); PG8_SCHED; PG8_LDA(At, 0, 0); PG8_STAGE(PG8_SA(1, 1), a1 + hstep, voffA);
            PG8_WAIT_L(8); PG8_BAR; PG8_WAIT_L(0); PG8_MMA(0, 0, At, B0); PG8_BAR; PG8_SCHED;
            PG8_LDB(B1, 0, 1); PG8_STAGE(PG8_SB(0, 0), b2, voffB);
            PG8_BAR; PG8_WAIT_L(0); PG8_MMA(0, 1, At, B1); PG8_BAR;
            PG8_LDA(At, 0, 1); PG8_STAGE(PG8_SA(0, 0), a2, voffA);
            PG8_BAR; PG8_WAIT_L(0); PG8_MMA(1, 0, At, B0); PG8_BAR; PG8_SCHED;
            PG8_STAGE(PG8_SB(0, 1), b2 + hstep, voffB);
            PG8_WAIT_V(6); PG8_BAR; PG8_MMA(1, 1, At, B1); PG8_BAR;
            PG8_LDB(B0, 1, 0); PG8_SCHED; PG8_LDA(At, 1, 0); PG8_STAGE(PG8_SA(0, 1), a2 + hstep, voffA);
            PG8_WAIT_L(8); PG8_BAR; PG8_WAIT_L(0); PG8_MMA(0, 0, At, B0); PG8_BAR; PG8_SCHED;
            PG8_LDB(B1, 1, 1); PG8_STAGE(PG8_SB(1, 0), b3, voffB);
            PG8_BAR; PG8_WAIT_L(0); PG8_MMA(0, 1, At, B1); PG8_BAR;
            PG8_LDA(At, 1, 1); PG8_STAGE(PG8_SA(1, 0), a3, voffA);
            PG8_BAR; PG8_WAIT_L(0); PG8_MMA(1, 0, At, B0); PG8_BAR; PG8_SCHED;
            PG8_STAGE(PG8_SB(1, 1), b3 + hstep, voffB);
            PG8_WAIT_V(6); PG8_BAR; PG8_MMA(1, 1, At, B1); PG8_BAR;
            }
        }
        if constexpr (ALIGN_EPI) { if (wr == 0) PG8_BAR; }
        if constexpr (!Epi::AFTER_DRAIN) { E(acc, cur, wr, wc, fr, fq); S.done(cur); }
        if (!has_next) break;
#pragma unroll
        for (int a = 0; a < 2; ++a)
#pragma unroll
            for (int b = 0; b < 2; ++b)
#pragma unroll
                for (int m = 0; m < 4; ++m)
#pragma unroll
                    for (int n = 0; n < 2; ++n) acc[a][b][m][n] = (f32x4){0.f, 0.f, 0.f, 0.f};
        cur = nxt; cA = nA; cB = nB; ++ui;
        if constexpr (ALIGN_EPI) { if (wr == 1) PG8_BAR; }
    }
    PG8_WAIT_V(0);
    if constexpr (!ALIGN_EPI) { if (wr == 0) PG8_BAR; }
    PG8_BAR;
    if constexpr (Epi::AFTER_DRAIN) { E.fused(acc, cur, wr, wc, fr, fq, lds, wid, lane); S.done(cur); }
#undef PG8_SA
#undef PG8_SB
#undef PG8_STAGE
#undef PG8_LDA
#undef PG8_LDB
#undef PG8_MMA
#undef PG8_WAIT_V
#undef PG8_WAIT_L
#undef PG8_BAR
#undef PG8_SCHED
}
}

constexpr size_t WS_QDC  = WS_RS;
constexpr size_t WS_SEGS = WS_RS + 32 * MB;
constexpr size_t WS_GSEG = WS_RS + 48 * MB;
constexpr size_t WS_SC   = WS_RS + 49 * MB;
DI void lds_barrier() { asm volatile("s_waitcnt lgkmcnt(0)" ::: "memory"); __builtin_amdgcn_s_barrier(); asm volatile("" ::: "memory"); }
DI float logsig(float x) { return fminf(x, 0.f) - __logf(1.f + __expf(-fabsf(x))); }

template <int DIR>
DI void ga_task(const Params& p, LAS unsigned char* lds, int tid, int lane, int wave, int task) {
    asm volatile("" : "+v"(tid), "+v"(lane));
    unsigned char* ws = p.ws;
    const bf16_t* Z = (const bf16_t*)(ws + WS_RZ);
    const float* AFB = (const float*)(ws + WS_AFB);
    LAS float* la = (LAS float*)lds;
    LAS float* part = (LAS float*)(lds + 17408);
    LAS float* gs = (LAS float*)(lds + 18432);
    LAS float* elb = (LAS float*)(lds + 18944);
    LAS float* wl = (LAS float*)(lds + 19968);
    LAS bf16_t* sL  = (LAS bf16_t*)(lds + 24064);
    LAS unsigned char* obuf = lds + 42496;
    const int c15 = lane & 15, g = lane >> 4;
    const int i = tid >> 3, dg = tid & 7, d0 = dg * 8;
#define TROW(r) ((r) * 72 + ((r) >> 3) * 8)
    constexpr int dir = DIR; const int h = (task >> 1) & 3, pb = (task >> 3) & 7, b = task >> 6;
    const int bhd = b * 8 + h * 2 + dir, sg = dir ? 7 - pb : pb;
    bf16_t* QDC = (bf16_t*)(ws + WS_QDC + (dir ? 16 : 0) * MB);
    bf16_t* OL = (bf16_t*)(ws + WS_RO + (dir ? 64 : 0) * MB);
    f32x4 S[4];
#pragma unroll
    for (int kt = 0; kt < 4; ++kt) S[kt] = (f32x4){0.f, 0.f, 0.f, 0.f};
    __syncthreads();
    for (int e = tid; e < 128 * 72 / 2; e += NTH) ((LAS unsigned*)sL)[e] = 0u;
    if (tid < 64) gs[tid] = 0.f;
    for (int e = tid; e < 1024; e += NTH) wl[e] = (dir ? p.in[9] : p.in[7])[(e >> 6) * 256 + h * 64 + (e & 63)];
    typedef short s16x4w __attribute__((ext_vector_type(4)));
    s16x4w wfr[2]; float bias[2];
    __syncthreads();
#pragma unroll
    for (int u = 0; u < 2; ++u) {
        const int d = 16 * (2 * (wave >> 2) + u) + c15;
        const u32x2 wp = {pk2(wl[(4 * g) * 64 + d], wl[(4 * g + 1) * 64 + d]), pk2(wl[(4 * g + 2) * 64 + d], wl[(4 * g + 3) * 64 + d])};
        wfr[u] = __builtin_bit_cast(s16x4w, wp);
        bias[u] = (dir ? p.in[10] : p.in[8])[h * 64 + d];
    }
    const int mt = wave & 3;
    f32x4 avn;
    { const int n0 = dir ? pb * 8 + 7 : pb * 8; avn = *(const f32x4*)(AFB + ((size_t)b * SEQ + n0 * 64 + 16 * mt + c15) * 32 + dir * 16 + 4 * g); }
#pragma unroll 1
    for (int ci = -1; ci < 8; ++ci) {
        const bool has_cur = ci >= 0, has_nxt = ci < 7;
        const int cx = ci + 1;
        const int nx = dir ? pb * 8 + 7 - cx : pb * 8 + cx, tokx = b * SEQ + nx * 64;
        const int nc = dir ? pb * 8 + 7 - ci : pb * 8 + ci, tokc = b * SEQ + nc * 64;
        LAS unsigned char* bx = obuf + (cx & 1) * 46464; LAS unsigned char* bc = obuf + (ci & 1) * 46464;
        LAS float* elx = elb + (cx & 1) * 128; LAS float* elc = elb + (ci & 1) * 128;
        u32x4 qv, kv, vvp[2]; f32x4 qa[4]; float lv[2][4];
        const int qrow = (task * 8 + (has_cur ? ci : 0)) * NWV + wave;
        if (ci > 0) {
#pragma unroll
            for (int kt = 0; kt < 4; ++kt) { const u32x2 w = {pk2(S[kt][0], S[kt][1]), pk2(S[kt][2], S[kt][3])}; *(LAS u32x2*)(sL + (16 * wave + c15) * 72 + 16 * kt + 4 * g) = w; }
        }
        if (has_cur) quant_load(p, qrow, lane, qa);
        if (has_nxt) {
            const size_t t = (size_t)tokx + i;
            qv = *(const u32x4*)(Z + t * ZW + h * 64 + d0); kv = *(const u32x4*)(Z + t * ZW + 256 + h * 64 + d0);
#pragma unroll
            for (int ps = 0; ps < 2; ++ps) { const int idx = tid + NTH * ps, vi = idx >> 4, ch = idx & 15; vvp[ps] = *(const u32x4*)(Z + ((size_t)tokx + vi) * ZW + 512 + h * 128 + ch * 8); }
            typedef short s16x4v __attribute__((ext_vector_type(4)));
            const u32x2 ap = {pk2(avn[0], avn[1]), pk2(avn[2], avn[3])};
            const s16x4v af = __builtin_bit_cast(s16x4v, ap);
            { const int c2 = cx < 7 ? cx + 1 : cx, n2 = dir ? pb * 8 + 7 - c2 : pb * 8 + c2; avn = *(const f32x4*)(AFB + ((size_t)b * SEQ + n2 * 64 + 16 * mt + c15) * 32 + dir * 16 + 4 * g); }
#pragma unroll
            for (int u = 0; u < 2; ++u) {
                const int d = 16 * (2 * (wave >> 2) + u) + c15;
                const f32x4 x = __builtin_amdgcn_mfma_f32_16x16x16bf16_1k(af, wfr[u], (f32x4){0.f, 0.f, 0.f, 0.f}, 0, 0, 0);
                float v0 = logsig(x[0] + bias[u]) * 0.0625f, v1 = logsig(x[1] + bias[u]) * 0.0625f, v2 = logsig(x[2] + bias[u]) * 0.0625f, v3 = logsig(x[3] + bias[u]) * 0.0625f;
                float T, T2, T3;
                if (dir == 0) {
                    v1 += v0; v2 += v1; v3 += v2; T = v3;
                    const float t1 = __shfl_up(T, 16); T2 = T + (g >= 1 ? t1 : 0.f);
                    const float t2 = __shfl_up(T2, 32); T3 = T2 + (g >= 2 ? t2 : 0.f);
                    if (g == 3) part[mt * 64 + d] = T3;
                } else {
                    v2 += v3; v1 += v2; v0 += v1; T = v0;
                    const float t1 = __shfl_down(T, 16); T2 = T + (g <= 2 ? t1 : 0.f);
                    const float t2 = __shfl_down(T2, 32); T3 = T2 + (g <= 1 ? t2 : 0.f);
                    if (g == 0) part[mt * 64 + d] = T3;
                }
                const float off = T3 - T;
                lv[u][0] = v0 + off; lv[u][1] = v1 + off; lv[u][2] = v2 + off; lv[u][3] = v3 + off;
            }
        }
        lds_barrier();
        if (has_nxt) {
#pragma unroll
            for (int u = 0; u < 2; ++u) {
                const int d = 16 * (2 * (wave >> 2) + u) + c15;
                float off = 0.f;
#pragma unroll
                for (int m2 = 0; m2 < 4; ++m2) { const bool take = dir ? (m2 > mt) : (m2 < mt); off += take ? part[m2 * 64 + d] : 0.f; }
#pragma unroll
                for (int r = 0; r < 4; ++r) la[(16 * mt + 4 * g + r) * 68 + d] = lv[u][r] + off;
                if (mt == (dir ? 0 : 3) && g == (dir ? 0 : 3)) {
                    const float tot = lv[u][dir ? 0 : 3] + off, gsum = gs[(cx & 1) * 64 + d];
                    elx[d] = __expf(tot); elx[64 + d] = __expf(gsum); gs[((cx + 1) & 1) * 64 + d] = gsum + tot;
                }
            }
        }
        lds_barrier();
        if (has_nxt) {
            LAS bf16_t* qdL = (LAS bf16_t*)bx; LAS bf16_t* kiL = (LAS bf16_t*)(bx + 9216); LAS bf16_t* keT = (LAS bf16_t*)(bx + 18432); LAS bf16_t* vT = (LAS bf16_t*)(bx + 27776);
            const size_t t = (size_t)tokx + i;
            float q[8], k[8];
#pragma unroll
            for (int e = 0; e < 4; ++e) { q[2 * e] = bflo(qv[e]); q[2 * e + 1] = bfhi(qv[e]); k[2 * e] = bflo(kv[e]); k[2 * e + 1] = bfhi(kv[e]); }
            float qd[8], ki[8], ke[8], qc[8];
#pragma unroll
            for (int e = 0; e < 8; ++e) {
                const float E = __expf(la[i * 68 + d0 + e]), R = __builtin_amdgcn_rcpf(E);
                qd[e] = q[e] * E; ki[e] = k[e] * R; ke[e] = ki[e] * elx[d0 + e]; qc[e] = qd[e] * elx[64 + d0 + e];
            }
            const u32x4 o1 = {pk2(qd[0], qd[1]), pk2(qd[2], qd[3]), pk2(qd[4], qd[5]), pk2(qd[6], qd[7])};
            const u32x4 o2 = {pk2(ki[0], ki[1]), pk2(ki[2], ki[3]), pk2(ki[4], ki[5]), pk2(ki[6], ki[7])};
            const u32x4 o3 = {pk2(qc[0], qc[1]), pk2(qc[2], qc[3]), pk2(qc[4], qc[5]), pk2(qc[6], qc[7])};
            *(LAS u32x4*)(qdL + i * 72 + d0) = o1; *(LAS u32x4*)(kiL + i * 72 + d0) = o2;
            *(u32x4*)(QDC + t * 256 + h * 64 + d0) = o3;
#pragma unroll
            for (int e = 0; e < 4; ++e) { const unsigned w = pk2(ke[2 * e], ke[2 * e + 1]); keT[TROW(d0 + 2 * e) + perm32(i)] = (bf16_t)(w & 0xFFFFu); keT[TROW(d0 + 2 * e + 1) + perm32(i)] = (bf16_t)(w >> 16); }
#pragma unroll
            for (int ps = 0; ps < 2; ++ps) {
                const int idx = tid + NTH * ps, vi = idx >> 4, ch = idx & 15;
#pragma unroll
                for (int e = 0; e < 4; ++e) { vT[TROW(ch * 8 + 2 * e) + perm32(vi)] = (bf16_t)(vvp[ps][e] & 0xFFFFu); vT[TROW(ch * 8 + 2 * e + 1) + perm32(vi)] = (bf16_t)(vvp[ps][e] >> 16); }
            }
        }
        if (has_cur) {
            const LAS bf16_t* qdL = (const LAS bf16_t*)bc; const LAS bf16_t* kiL = (const LAS bf16_t*)(bc + 9216); const LAS bf16_t* keT = (const LAS bf16_t*)(bc + 18432); const LAS bf16_t* vT = (const LAS bf16_t*)(bc + 27776);
            const int it = wave & 3, dvh = wave >> 2;
            bf16x8 qdb[2];
#pragma unroll
            for (int s = 0; s < 2; ++s) qdb[s] = *(const LAS bf16x8*)(qdL + (16 * it + c15) * 72 + 32 * s + 8 * g);
            f32x4 sc[4];
#pragma unroll
            for (int jt = 0; jt < 4; ++jt) {
                sc[jt] = (f32x4){0.f, 0.f, 0.f, 0.f};
#pragma unroll
                for (int s = 0; s < 2; ++s) sc[jt] = MFMA16(*(const LAS bf16x8*)(kiL + (16 * jt + c15) * 72 + 32 * s + 8 * g), qdb[s], sc[jt]);
                const int ii = 16 * it + c15;
#pragma unroll
                for (int r = 0; r < 4; ++r) { const int jj = 16 * jt + 4 * g + r; const bool keep = dir ? (jj > ii) : (jj <= ii); sc[jt][r] = keep ? sc[jt][r] : 0.f; }
            }
            const bf16x8 pa[2] = {pack8(sc[0], sc[1]), pack8(sc[2], sc[3])};
#pragma unroll
            for (int nt = 0; nt < 4; ++nt) {
                const int dvr = 64 * dvh + 16 * nt + c15;
                f32x4 o = (f32x4){0.f, 0.f, 0.f, 0.f};
#pragma unroll
                for (int s = 0; s < 2; ++s) {
                    o = MFMA16(*(const LAS bf16x8*)(vT + TROW(dvr) + 32 * s + 8 * g), pa[s], o);
                    o = MFMA16(*(const LAS bf16x8*)(sL + dvr * 72 + 32 * s + 8 * g), qdb[s], o);
                }
                const u32x2 w = {pk2(o[0], o[1]), pk2(o[2], o[3])};
                *(u32x2*)(OL + ((size_t)tokc + 16 * it + c15) * 512 + h * 128 + 64 * dvh + 16 * nt + 4 * g) = w;
            }
            bf16x8 vb[2];
#pragma unroll
            for (int s = 0; s < 2; ++s) vb[s] = *(const LAS bf16x8*)(vT + TROW(16 * wave + c15) + 32 * s + 8 * g);
#pragma unroll
            for (int kt = 0; kt < 4; ++kt) {
                const f32x4 gm = *(const LAS f32x4*)(elc + 16 * kt + 4 * g);
                f32x4 a = S[kt] * gm;
#pragma unroll
                for (int s = 0; s < 2; ++s) a = MFMA16(*(const LAS bf16x8*)(keT + TROW(16 * kt + c15) + 32 * s + 8 * g), vb[s], a);
                S[kt] = a;
            }
            quant_store(p, qrow, lane, qa);
        }
        lds_barrier();
    }
    {
        float* SEGS = (float*)(ws + WS_SEGS) + (size_t)(bhd * 8 + sg) * 64 * 128;
#pragma unroll
        for (int kt = 0; kt < 4; ++kt)
#pragma unroll
            for (int r = 0; r < 4; ++r) SEGS[(16 * kt + 4 * g + r) * 128 + 16 * wave + c15] = S[kt][r];
        if (tid < 64) ((float*)(ws + WS_GSEG))[(bhd * 8 + sg) * 64 + tid] = __expf(gs[tid]);
    }
}
#undef TROW

DI void phaseGA(const Params& p, LAS unsigned char* lds, int tid, int lane, int wave) {
    for (int task = blockIdx.x; task < 512; task += gridDim.x) { if (task & 1) ga_task<1>(p, lds, tid, lane, wave, task); else ga_task<0>(p, lds, tid, lane, wave, task); }
}

DI void phaseGB(const Params& p, int tid) {
    unsigned char* ws = p.ws;
    const float* SEGS = (const float*)(ws + WS_SEGS); const float* GSEG = (const float*)(ws + WS_GSEG); bf16_t* SC = (bf16_t*)(ws + WS_SC);
    for (int e = blockIdx.x * NTH + tid; e < 64 * 128 * 16; e += gridDim.x * NTH) {
        const int dv = e & 127, dk4 = (e >> 7) & 15, bhd = e >> 11;
        float c[4] = {0.f, 0.f, 0.f, 0.f};
        for (int sg = 0; sg < 8; ++sg) {
            const u32x2 w = {pk2(c[0], c[1]), pk2(c[2], c[3])};
            *(u32x2*)(SC + ((size_t)(bhd * 8 + sg) * 128 + dv) * 64 + 4 * dk4) = w;
            const f32x4 gm = *(const f32x4*)(GSEG + (bhd * 8 + sg) * 64 + 4 * dk4);
#pragma unroll
            for (int r = 0; r < 4; ++r) c[r] = gm[r] * c[r] + SEGS[((size_t)(bhd * 8 + sg) * 64 + 4 * dk4 + r) * 128 + dv];
        }
    }
}

DI void phase4a(const Params& p, LAS unsigned char* lds, int tid, int lane, int wave) {
    asm volatile("" : "+v"(tid), "+v"(lane));
    unsigned char* ws = p.ws;
    const bf16_t* Z = (const bf16_t*)(ws + WS_RZ);
    bf16_t* MIX = (bf16_t*)(ws + WS_RA);
    const bf16_t* OF = (const bf16_t*)(ws + WS_RO); const bf16_t* OB = (const bf16_t*)(ws + WS_RO + 64 * MB);
    const bf16_t* WP = (const bf16_t*)(ws + WS_WP);
    LAS bf16_t* pt = (LAS bf16_t*)lds;
    LAS unsigned char* at = lds + 81920;
    const int c15 = lane & 15, g = lane >> 4;
    for (int tile = blockIdx.x; tile < T / 64; tile += gridDim.x) {
        const int tok0 = tile * 64, s0 = tok0 & (SEQ - 1);
        __syncthreads();
#pragma unroll
        for (int ps = 0; ps < 10; ++ps) {
            const int idx = tid + NTH * ps, rr = idx >> 6, ch = idx & 63, sq = s0 - 8 + rr;
            u32x4 v = {0u, 0u, 0u, 0u};
            if (sq >= 0 && sq < SEQ) v = *(const u32x4*)(Z + ((size_t)tok0 - 8 + rr) * ZW + 1536 + ch * 8);
            *(LAS u32x4*)(pt + rr * 512 + ch * 8) = v;
        }
        {
            const int hh = wave >> 1, ih = wave & 1, bb = tok0 / SEQ, nn = s0 >> 6;
            f32x4 acc[8][2];
#pragma unroll
            for (int mt = 0; mt < 8; ++mt) { acc[mt][0] = (f32x4){0.f, 0.f, 0.f, 0.f}; acc[mt][1] = (f32x4){0.f, 0.f, 0.f, 0.f}; }
#pragma unroll
            for (int dir = 0; dir < 2; ++dir) {
                const int sg = dir ? 7 - (nn >> 3) : (nn >> 3), bhd = bb * 8 + hh * 2 + dir;
                const bf16_t* SCp = (const bf16_t*)(ws + WS_SC) + (size_t)(bhd * 8 + sg) * 128 * 64;
                const bf16_t* QCp = (const bf16_t*)(ws + WS_QDC + (dir ? 16 : 0) * MB) + ((size_t)tok0 + 32 * ih) * 256 + hh * 64;
                if (sg != 0)
#pragma unroll
                for (int s = 0; s < 2; ++s) {
                    const bf16x8 q0 = ld_frag16(QCp + (size_t)c15 * 256 + 32 * s + 8 * g), q1 = ld_frag16(QCp + (size_t)(16 + c15) * 256 + 32 * s + 8 * g);
#pragma unroll
                    for (int mt = 0; mt < 8; ++mt) {
                        const bf16x8 af = ld_frag16(SCp + (16 * mt + c15) * 64 + 32 * s + 8 * g);
                        acc[mt][0] = MFMA16(af, q0, acc[mt][0]); acc[mt][1] = MFMA16(af, q1, acc[mt][1]);
                    }
                }
            }
#pragma unroll
            for (int nt = 0; nt < 2; ++nt)
#pragma unroll
                for (int mt = 0; mt < 8; ++mt) { const f32x4 o = acc[mt][nt]; const u32x2 w = {pk2(o[0], o[1]), pk2(o[2], o[3])};
                    *(LAS u32x2*)(at + (32 * ih + 16 * nt + c15) * 1040 + (hh * 128 + 16 * mt + 4 * g) * 2) = w; }
        }
        __syncthreads();
        {
            const f32x4 gh0 = *(const f32x4*)(p.in[11] + 8 * lane), gh1 = *(const f32x4*)(p.in[11] + 8 * lane + 4);
#pragma unroll
            for (int hb = 0; hb < 2; ++hb) {
                u32x4 a[4], bq[4], rv[4], cv[4];
#pragma unroll
                for (int j = 0; j < 4; ++j) { const int tl = wave * 8 + hb * 4 + j; const size_t t = (size_t)tok0 + tl;
                    a[j] = *(const u32x4*)(OF + t * 512 + 8 * lane); bq[j] = *(const u32x4*)(OB + t * 512 + 8 * lane); rv[j] = *(const u32x4*)(Z + t * ZW + 1024 + 8 * lane);
                    cv[j] = *(const LAS u32x4*)(at + tl * 1040 + 16 * lane); }
#pragma unroll
                for (int j = 0; j < 4; ++j) { const size_t t = (size_t)tok0 + wave * 8 + hb * 4 + j;
                    float o[8], r[8];
#pragma unroll
                    for (int e = 0; e < 4; ++e) { o[2 * e] = bflo(a[j][e]) + bflo(bq[j][e]) + bflo(cv[j][e]); o[2 * e + 1] = bfhi(a[j][e]) + bfhi(bq[j][e]) + bfhi(cv[j][e]); r[2 * e] = bflo(rv[j][e]); r[2 * e + 1] = bfhi(rv[j][e]); }
                    float ss = 0.f;
#pragma unroll
                    for (int e = 0; e < 8; ++e) ss += o[e] * o[e];
                    ss += __shfl_xor(ss, 1); ss += __shfl_xor(ss, 2); ss += __shfl_xor(ss, 4); ss += __shfl_xor(ss, 8);
                    const float rstd = rsqrtf(ss * (1.f / 128.f) + EPS);
                    float y[8];
#pragma unroll
                    for (int e = 0; e < 8; ++e) { const float gg = e < 4 ? gh0[e] : gh1[e - 4]; y[e] = o[e] * rstd * gg * (r[e] / (1.f + __expf(-r[e]))); }
                    const u32x4 w = {pk2(y[0], y[1]), pk2(y[2], y[3]), pk2(y[4], y[5]), pk2(y[6], y[7])};
                    *(u32x4*)(MIX + t * D + 8 * lane) = w; }
            }
        }
        __syncthreads();
        {
            const int c = tid, gi = c >> 7, cc = c & 127, hw = 1 << gi;
            LAS unsigned char* ag = at + gi * 16384;
            const LAS bf16_t* pc = pt + c;
            if (s0 >= 8 && s0 + 64 + 8 <= SEQ) {
                const float inv = 0.5f / (float)hw;
                float sum = 0.f;
                for (int rr = 8 - hw; rr < 8 + hw; ++rr) sum += bflo((unsigned)pc[rr * 512]);
#pragma unroll 4
                for (int i = 0; i < 64; ++i) {
                    const float val = sum * inv - bflo((unsigned)pc[(i + 8) * 512]);
                    *(LAS bf16_t*)(ag + i * 256 + (((cc >> 3) ^ (i & 15)) * 16) + (cc & 7) * 2) = (bf16_t)(pk2(val, 0.f) & 0xFFFFu);
                    sum += bflo((unsigned)pc[(i + 8 + hw) * 512]) - bflo((unsigned)pc[(i + 8 - hw) * 512]);
                }
            } else {
                float sum = 0.f;
                {   const int lo = max(s0 - hw, 0), hi = min(s0 + hw, SEQ);
                    for (int rr = lo; rr < hi; ++rr) sum += bflo((unsigned)pc[(rr - s0 + 8) * 512]); }
#pragma unroll 4
                for (int i = 0; i < 64; ++i) {
                    const int sq = s0 + i, lo = max(sq - hw, 0), hi = min(sq + hw, SEQ);
                    const float val = sum * __builtin_amdgcn_rcpf((float)(hi - lo)) - bflo((unsigned)pc[(i + 8) * 512]);
                    *(LAS bf16_t*)(ag + i * 256 + (((cc >> 3) ^ (i & 15)) * 16) + (cc & 7) * 2) = (bf16_t)(pk2(val, 0.f) & 0xFFFFu);
                    if (sq + hw < SEQ) sum += bflo((unsigned)pc[(i + 8 + hw) * 512]);
                    if (sq - hw >= 0) sum -= bflo((unsigned)pc[(i + 8 - hw) * 512]);
                }
            }
        }
        __syncthreads();
        {
            const int gi = wave >> 1, dh = wave & 1;
            LAS unsigned char* ag = at + gi * 16384;
            f32x4 acc[4][4];
#pragma unroll
            for (int mt = 0; mt < 4; ++mt)
#pragma unroll
                for (int nt = 0; nt < 4; ++nt) acc[mt][nt] = (f32x4){0.f, 0.f, 0.f, 0.f};
#pragma unroll
            for (int s = 0; s < 4; ++s) {
                bf16x8 af[4];
#pragma unroll
                for (int mt = 0; mt < 4; ++mt) { const int row = mt * 16 + c15; af[mt] = *(const LAS bf16x8*)(ag + row * 256 + (((4 * s + g) ^ (row & 15)) * 16)); }
#pragma unroll
                for (int nt = 0; nt < 4; ++nt) {
                    const bf16x8 wf = ld_frag16(WP + (size_t)gi * 16384 + (dh * 64 + 16 * nt + c15) * 128 + 32 * s + 8 * g);
#pragma unroll
                    for (int mt = 0; mt < 4; ++mt) acc[mt][nt] = MFMA16(wf, af[mt], acc[mt][nt]);
                }
            }
#pragma unroll
            for (int nt = 0; nt < 4; ++nt) {
                const f32x4 ps = *(const f32x4*)(p.in[13] + gi * 128 + dh * 64 + 16 * nt + 4 * g);
#pragma unroll
                for (int mt = 0; mt < 4; ++mt) {
                    const f32x4 v = acc[mt][nt] * ps;
                    u32x2 w = {pk2(v[0], v[1]), pk2(v[2], v[3])};
                    *(u32x2*)(MIX + ((size_t)tok0 + mt * 16 + c15) * D + 512 + gi * 128 + dh * 64 + 16 * nt + 4 * g) = w;
                }
            }
        }
    }
}

DI void phase4c(const Params& p, LAS unsigned char* lds, int tid, int lane, int wave) {
    asm volatile("" : "+v"(tid), "+v"(lane));
    LAS float* lG = (LAS float*)lds; LAS float* lA = lG + 1024; LAS float* lB = lA + 1024; LAS float* lP = lB + 1024;
    const float* x = p.in[0]; const bf16_t* MIXO = (const bf16_t*)(p.ws + WS_RZ); bf16_t* H2 = (bf16_t*)(p.ws + WS_RA);
    for (int rt = blockIdx.x; rt < T / 128; rt += gridDim.x) {
        const int b = rt / 32;
        __syncthreads();
        for (int d = tid; d < 1024; d += NTH) { lG[d] = mod_at(p, b, 2048 + d); lA[d] = p.in[15][d] * (1.f + mod_at(p, b, 4096 + d)); lB[d] = mod_at(p, b, 3072 + d); lP[d] = p.in[5][d]; }
        __syncthreads();
        for (int r0 = wave; r0 < 128; r0 += 4 * NWV) {
            f32x4 m[4][4], xv[4][4];
#pragma unroll
            for (int u = 0; u < 4; ++u) {
                const size_t row = (size_t)rt * 128 + r0 + u * NWV;
                const u32x2* mr = (const u32x2*)(MIXO + row * D) + lane; const f32x4* xr = (const f32x4*)(x + row * D) + lane;
#pragma unroll
                for (int j = 0; j < 4; ++j) { const u32x2 mv = mr[64 * j]; m[u][j] = (f32x4){bflo(mv.x), bfhi(mv.x), bflo(mv.y), bfhi(mv.y)}; xv[u][j] = xr[64 * j]; }
            }
#pragma unroll
            for (int u = 0; u < 4; ++u) {
                const size_t row = (size_t)rt * 128 + r0 + u * NWV;
                float ss = 0.f;
#pragma unroll
                for (int j = 0; j < 4; ++j) ss += m[u][j][0] * m[u][j][0] + m[u][j][1] * m[u][j][1] + m[u][j][2] * m[u][j][2] + m[u][j][3] * m[u][j][3];
                const float rstd = rsqrtf(wave_sum(ss) * (1.f / D) + EPS);
                float s2 = 0.f;
#pragma unroll
                for (int j = 0; j < 4; ++j) {
                    const f32x4 gt = *(const LAS f32x4*)(lG + 4 * lane + 256 * j), pm = *(const LAS f32x4*)(lP + 4 * lane + 256 * j);
                    xv[u][j] = xv[u][j] + gt * (m[u][j] * rstd * pm);
                    s2 += xv[u][j][0] * xv[u][j][0] + xv[u][j][1] * xv[u][j][1] + xv[u][j][2] * xv[u][j][2] + xv[u][j][3] * xv[u][j][3];
                }
                const float rstd2 = rsqrtf(wave_sum(s2) * (1.f / D) + EPS);
                u32x2* orow = (u32x2*)((bf16_t*)(p.ws + WS_RO) + row * D) + lane; u32x2* hrow = (u32x2*)(H2 + row * D) + lane;
#pragma unroll
                for (int j = 0; j < 4; ++j) {
                    { const u32x2 xw = {pk2(xv[u][j][0], xv[u][j][1]), pk2(xv[u][j][2], xv[u][j][3])}; orow[64 * j] = xw; }
                    const f32x4 a = *(const LAS f32x4*)(lA + 4 * lane + 256 * j), bb = *(const LAS f32x4*)(lB + 4 * lane + 256 * j);
                    const f32x4 hv = xv[u][j] * rstd2 * a + bb;
                    u32x2 w = {pk2(hv[0], hv[1]), pk2(hv[2], hv[3])};
                    hrow[64 * j] = w;
                }
            }
        }
    }
}

DI int skey(float v, int idx, int mask) { int u = __float_as_int(v); u ^= (u >> 31) & 0x7FFFFFFF; return (u & ~mask) | idx; }
DI float sval(int k, int mask) { int u = k & ~mask; u ^= (u >> 31) & 0x7FFFFFFF; return __int_as_float(u); }
DI void cswap(int& a, int& b) { const int mx = max(a, b), mn = min(a, b); a = mx; b = mn; }
DI void sort16_desc(int (&a)[16]) {
    cswap(a[0], a[13]); cswap(a[1], a[12]); cswap(a[2], a[15]); cswap(a[3], a[14]); cswap(a[4], a[8]); cswap(a[5], a[6]); cswap(a[7], a[11]); cswap(a[9], a[10]);
    cswap(a[0], a[5]); cswap(a[1], a[7]); cswap(a[2], a[9]); cswap(a[3], a[4]); cswap(a[6], a[13]); cswap(a[8], a[14]); cswap(a[10], a[15]); cswap(a[11], a[12]);
    cswap(a[0], a[1]); cswap(a[2], a[3]); cswap(a[4], a[5]); cswap(a[6], a[8]); cswap(a[7], a[9]); cswap(a[10], a[11]); cswap(a[12], a[13]); cswap(a[14], a[15]);
    cswap(a[0], a[2]); cswap(a[1], a[3]); cswap(a[4], a[10]); cswap(a[5], a[11]); cswap(a[6], a[7]); cswap(a[8], a[9]); cswap(a[12], a[14]); cswap(a[13], a[15]);
    cswap(a[1], a[2]); cswap(a[3], a[12]); cswap(a[4], a[6]); cswap(a[5], a[7]); cswap(a[8], a[10]); cswap(a[9], a[11]); cswap(a[13], a[14]);
    cswap(a[1], a[4]); cswap(a[2], a[6]); cswap(a[5], a[8]); cswap(a[7], a[10]); cswap(a[9], a[13]); cswap(a[11], a[14]);
    cswap(a[2], a[4]); cswap(a[3], a[6]); cswap(a[9], a[12]); cswap(a[11], a[13]);
    cswap(a[3], a[5]); cswap(a[6], a[8]); cswap(a[7], a[9]); cswap(a[10], a[12]);
    cswap(a[3], a[4]); cswap(a[5], a[6]); cswap(a[7], a[8]); cswap(a[9], a[10]); cswap(a[11], a[12]);
    cswap(a[6], a[7]); cswap(a[8], a[9]);
}
DI void merge16_desc(int (&x)[16], const int (&y)[16]) {
#pragma unroll
    for (int i = 0; i < 16; ++i) x[i] = max(x[i], y[15 - i]);
#pragma unroll
    for (int j = 8; j > 0; j >>= 1) {
#pragma unroll
        for (int i = 0; i < 16; ++i) { const int l = i ^ j; if (l > i) cswap(x[i], x[l]); }
    }
}

DI void phase5b(const Params& p, LAS unsigned char* lds, int tid, int lane, int wave) {
    asm volatile("" : "+v"(tid), "+v"(lane));
    unsigned char* ws = p.ws;
    const bf16_t* Q2 = (const bf16_t*)(ws + WS_RZ);
    const bf16_t* SKB = (const bf16_t*)(ws + WS_SKB);
    int* EIDX = (int*)(ws + WS_RS);
    LAS unsigned char* tab = lds + tid * 32;
    LAS unsigned char* skl = lds + 16384;
    const int c31 = lane & 31, hi = lane >> 5;
    for (int btask = blockIdx.x; btask < 256; btask += gridDim.x) {
        const int h = btask & 7, tgc = btask >> 3;
        __syncthreads();
#pragma unroll
        for (int ps = 0; ps < 8; ++ps) {
            const int idx = tid + NTH * ps, row = idx >> 4, ch = idx & 15;
            const u32x4 v = *(const u32x4*)(SKB + ((size_t)h * 256 + row) * 128 + ch * 8);
            *(LAS u32x4*)(skl + row * 256 + ((ch ^ (row & 15)) * 16)) = v;
        }
        __syncthreads();
      for (int ti = 0; ti < 4; ++ti) {
        const int tg = tgc * 32 + wave * 4 + ti;
        const size_t tok = (size_t)tg * 32 + c31;
        int lst[2][16];
        bf16x8 bq[2][8];
#pragma unroll
        for (int pp = 0; pp < 2; ++pp) {
            const bf16_t* qp = Q2 + tok * 2048 + h * 256 + pp * 128 + 8 * hi;
            asm volatile("" : "+v"(qp));
#pragma unroll
            for (int ks = 0; ks < 8; ++ks) bq[pp][ks] = ld_frag16(qp + 16 * ks);
        }
#pragma unroll
        for (int pp = 0; pp < 2; ++pp) {
            int run[16];
#pragma unroll
            for (int r = 0; r < 16; ++r) run[r] = (int)0x80000000;
#pragma unroll 1
            for (int kt = 0; kt < 4; ++kt) {
                const LAS unsigned char* kb = skl + pp * 32768 + (32 * kt + c31) * 256;
                f32x16 acc;
#pragma unroll
                for (int r = 0; r < 16; ++r) acc[r] = 0.f;
#pragma unroll
                for (int ks = 0; ks < 8; ++ks) acc = MFMA32(*(const LAS bf16x8*)(kb + (((2 * ks + hi) ^ (c31 & 15)) * 16)), bq[pp][ks], acc);
                int cur[16];
#pragma unroll
                for (int r = 0; r < 16; ++r) cur[r] = skey(acc[r], 32 * kt + 8 * (r >> 2) + 4 * hi + (r & 3), 0x7F);
                sort16_desc(cur);
                merge16_desc(run, cur);
            }
            int oth[16];
#pragma unroll
            for (int r = 0; r < 16; ++r) oth[r] = __shfl_xor(run[r], 32);
            merge16_desc(run, oth);
#pragma unroll
            for (int r = 0; r < 16; ++r) lst[pp][r] = run[r];
        }
#pragma unroll
        for (int pp = 0; pp < 2; ++pp) {
            u32x4 w;
#pragma unroll
            for (int q = 0; q < 4; ++q) w[q] = (lst[pp][4 * q] & 0x7F) | ((lst[pp][4 * q + 1] & 0x7F) << 8) | ((lst[pp][4 * q + 2] & 0x7F) << 16) | ((lst[pp][4 * q + 3] & 0x7F) << 24);
            *(LAS u32x4*)(tab + 16 * pp) = w;
        }
        float va[16], vb[16];
#pragma unroll
        for (int r = 0; r < 16; ++r) { va[r] = sval(lst[0][r], 0x7F); vb[r] = sval(lst[1][r], 0x7F); }
        int cand[4][16];
        {
            int cnt = 0;
#pragma unroll
            for (int i = 0; i < 16; ++i)
#pragma unroll
                for (int j = 0; j < 16; ++j)
                    if ((i + 1) * (j + 1) <= 16) { cand[cnt >> 4][cnt & 15] = skey(va[i] + vb[j], (i << 4) | j, 0xFF); ++cnt; }
#pragma unroll
            for (int q = 50; q < 64; ++q) cand[q >> 4][q & 15] = (int)0x80000000;
        }
        sort16_desc(cand[0]); sort16_desc(cand[1]); sort16_desc(cand[2]); sort16_desc(cand[3]);
        merge16_desc(cand[0], cand[1]); merge16_desc(cand[2], cand[3]); merge16_desc(cand[0], cand[2]);
        asm volatile("s_waitcnt lgkmcnt(0)" ::: "memory");
        float sv[16]; int ex[16];
        const float mx = sval(cand[0][0], 0xFF);
        float sum = 0.f;
#pragma unroll
        for (int r = 0; r < 16; ++r) {
            const int ck = cand[0][r];
            const int i1 = tab[(ck >> 4) & 15], i2 = tab[16 + (ck & 15)];
            ex[r] = i1 * 128 + i2;
            sv[r] = __expf(sval(ck, 0xFF) - mx); sum += sv[r];
        }
        const float inv = 1.f / sum;
        unsigned* ep = (unsigned*)EIDX + tok * 128 + h * 16 + 8 * hi;
        unsigned pe[16];
#pragma unroll
        for (int r = 0; r < 16; ++r) pe[r] = (unsigned)ex[r] | (pk2(sv[r] * inv, 0.f) << 16);
        if (hi == 0) { *(u32x4*)ep = (u32x4){pe[0], pe[1], pe[2], pe[3]}; *(u32x4*)(ep + 4) = (u32x4){pe[4], pe[5], pe[6], pe[7]}; }
        else         { *(u32x4*)ep = (u32x4){pe[8], pe[9], pe[10], pe[11]}; *(u32x4*)(ep + 4) = (u32x4){pe[12], pe[13], pe[14], pe[15]}; }
      }
    }
}

template <int K> DI int swz_bcast(int v) { return __builtin_amdgcn_ds_swizzle(v, 0x10 | (K << 5)); }
template <int W> DI int swz_xor(int v) { return __builtin_amdgcn_ds_swizzle(v, 0x1F | (W << 10)); }
template <int K> struct IC { static constexpr int v = K; };
template <int N, int I = 0, class F> DI void static_for(F&& f) { if constexpr (I < N) { f(IC<I>{}); static_for<N, I + 1>(f); } }
DI float row16_sum(float v) {
    v += __builtin_bit_cast(float, __builtin_amdgcn_update_dpp(0, __builtin_bit_cast(int, v), 0xB1, 0xF, 0xF, true));
    v += __builtin_bit_cast(float, __builtin_amdgcn_update_dpp(0, __builtin_bit_cast(int, v), 0x4E, 0xF, 0xF, true));
    v += __builtin_bit_cast(float, __builtin_amdgcn_update_dpp(0, __builtin_bit_cast(int, v), 0x141, 0xF, 0xF, true));
    v += __builtin_bit_cast(float, __builtin_amdgcn_update_dpp(0, __builtin_bit_cast(int, v), 0x140, 0xF, 0xF, true));
    return v;
}
DI void phase6(const Params& p, LAS unsigned char* lds, int tid, int lane, int wave) {
    asm volatile("" : "+v"(tid), "+v"(lane));
    unsigned char* ws = p.ws;
    const bf16_t* H2 = (const bf16_t*)(ws + WS_RA);
    const unsigned char* UQ = ws + WS_UB; const unsigned char* VQ = ws + WS_VB;
    const float* SU = (const float*)(ws + WS_SU); const float* SV = (const float*)(ws + WS_SV);
    const unsigned* EIDX = (const unsigned*)(ws + WS_RS);
    LAS float* lG = (LAS float*)lds;
    const int q = lane >> 4, l16 = lane & 15;
    LAS int* le = (LAS int*)(lds + 4096 + wave * 6144) + q * 128;
    LAS float* lg = (LAS float*)(lds + 4096 + wave * 6144 + 2048) + q * 128;
    LAS float* lc = (LAS float*)(lds + 4096 + wave * 6144 + 4096) + q * 128;
    const unsigned qlo = q < 2 ? (0xFFFFu << (16 * q)) : 0u, qhi = q >= 2 ? (0xFFFFu << (16 * (q - 2))) : 0u;
    for (int rt = blockIdx.x; rt < T / 128; rt += gridDim.x) {
        const int b = rt / 32;
        __syncthreads();
        for (int d = tid; d < 1024; d += NTH) lG[d] = mod_at(p, b, 5120 + d) * p.in[16][d];
        __syncthreads();
#pragma unroll 1
        for (int rd = 0; rd < 4; ++rd) {
            __syncthreads();
            const size_t t = (size_t)rt * 128 + wave * 16 + rd * 4 + q;
            {
                int e[8]; float g[8];
#pragma unroll
                for (int r = 0; r < 8; ++r) { const unsigned pe = EIDX[t * 128 + r * 16 + l16]; e[r] = (int)(pe & 0xFFFFu); g[r] = bfhi(pe); }
                unsigned W[4] = {0u, 0u, 0u, 0u};
#pragma unroll
                for (int r = 0; r < 8; ++r) {
                    const int k = e[r] >> 10; const unsigned inc = 1u << (8 * (k & 3)); const int w = k >> 2;
                    W[0] += (w == 0) ? inc : 0u; W[1] += (w == 1) ? inc : 0u; W[2] += (w == 2) ? inc : 0u; W[3] += (w == 3) ? inc : 0u;
                }
                unsigned C[4];
                {
                    unsigned tot[4], exc[4];
#pragma unroll
                    for (int w = 0; w < 4; ++w) {
                        unsigned x = W[w];
                        x += (unsigned)__builtin_amdgcn_update_dpp(0, (int)x, 0x111, 0xF, 0xF, true);
                        x += (unsigned)__builtin_amdgcn_update_dpp(0, (int)x, 0x112, 0xF, 0xF, true);
                        x += (unsigned)__builtin_amdgcn_update_dpp(0, (int)x, 0x114, 0xF, 0xF, true);
                        x += (unsigned)__builtin_amdgcn_update_dpp(0, (int)x, 0x118, 0xF, 0xF, true);
                        exc[w] = x - W[w];
                        tot[w] = (unsigned)swz_bcast<15>((int)x);
                    }
                    unsigned carry = 0u;
#pragma unroll
                    for (int w = 0; w < 4; ++w) {
                        const unsigned P = tot[w] + (tot[w] << 8) + (tot[w] << 16) + (tot[w] << 24);
                        C[w] = (P - tot[w]) + carry * 0x01010101u + exc[w];
                        carry += P >> 24;
                    }
                }
#pragma unroll
                for (int r = 0; r < 8; ++r) {
                    const int k = e[r] >> 10; const int sh = 8 * (k & 3); const int w = k >> 2; const unsigned inc = 1u << sh;
                    const unsigned cw = (w == 0) ? C[0] : (w == 1) ? C[1] : (w == 2) ? C[2] : C[3];
                    const int pos = (int)((cw >> sh) & 0xFFu);
                    le[pos] = e[r]; lg[pos] = g[r];
                    C[0] += (w == 0) ? inc : 0u; C[1] += (w == 1) ? inc : 0u; C[2] += (w == 2) ? inc : 0u; C[3] += (w == 3) ? inc : 0u;
                }
                asm volatile("s_waitcnt lgkmcnt(0)" ::: "memory");
            }
            {
                int hq[16]; float ish;
                {
                    float hv[64]; float hm = 0.f;
#pragma unroll
                    for (int i = 0; i < 4; ++i) {
                        const u32x4 h0 = *(const u32x4*)(H2 + t * D + 256 * i + 16 * l16), h1 = *(const u32x4*)(H2 + t * D + 256 * i + 16 * l16 + 8);
#pragma unroll
                        for (int c = 0; c < 4; ++c) { hv[16 * i + 2 * c] = bflo(h0[c]); hv[16 * i + 2 * c + 1] = bfhi(h0[c]); hv[16 * i + 8 + 2 * c] = bflo(h1[c]); hv[16 * i + 8 + 2 * c + 1] = bfhi(h1[c]); }
                    }
#pragma unroll
                    for (int j = 0; j < 64; ++j) hm = fmaxf(hm, fabsf(hv[j]));
                    hm = fmaxf(hm, __builtin_bit_cast(float, __builtin_amdgcn_update_dpp(0, __builtin_bit_cast(int, hm), 0xB1, 0xF, 0xF, true)));
                    hm = fmaxf(hm, __builtin_bit_cast(float, __builtin_amdgcn_update_dpp(0, __builtin_bit_cast(int, hm), 0x4E, 0xF, 0xF, true)));
                    hm = fmaxf(hm, __builtin_bit_cast(float, __builtin_amdgcn_update_dpp(0, __builtin_bit_cast(int, hm), 0x141, 0xF, 0xF, true)));
                    hm = fmaxf(hm, __builtin_bit_cast(float, __builtin_amdgcn_update_dpp(0, __builtin_bit_cast(int, hm), 0x140, 0xF, 0xF, true)));
                    const float s8 = hm > 1e-30f ? 127.f / hm : 0.f; ish = hm * (1.f / 127.f);
#pragma unroll
                    for (int d = 0; d < 16; ++d) {
                        const int q0 = __float2int_rn(hv[4 * d] * s8), q1 = __float2int_rn(hv[4 * d + 1] * s8), q2 = __float2int_rn(hv[4 * d + 2] * s8), q3 = __float2int_rn(hv[4 * d + 3] * s8);
                        hq[d] = (int)((unsigned)(q0 & 0xFF) | ((unsigned)(q1 & 0xFF) << 8) | ((unsigned)(q2 & 0xFF) << 16) | ((unsigned)q3 << 24));
                    }
                }
                constexpr int UD = 4;
                u32x4 ub[UD][4];
                int evn = le[l16];
                static_for<UD>([&](auto kc) { constexpr int k = decltype(kc)::v; const unsigned char* up = UQ + (size_t)swz_bcast<k>(evn) * 1024 + 16 * l16;
#pragma unroll
                    for (int i = 0; i < 4; ++i) ub[k][i] = *(const u32x4*)(up + 256 * i); });
#pragma unroll 1
                for (int bt = 0; bt < 8; ++bt) {
                    if (bt) __syncthreads();
                    const int ev = evn; const float gv = lg[bt * 16 + l16];
                    evn = le[(bt < 7 ? bt + 1 : 7) * 16 + l16];
                    const float isu = SU[ev] * ish, isv = SV[ev];
                    int part[16];
                    static_for<16>([&](auto kc) {
                        constexpr int k = decltype(kc)::v, sl = k % UD;
                        int a = 0;
#pragma unroll
                        for (int i = 0; i < 4; ++i) {
                            const u32x4 u = ub[sl][i];
#pragma unroll
                            for (int c = 0; c < 4; ++c) a = __builtin_amdgcn_sdot4((int)u[c], hq[4 * i + c], a, false);
                        }
                        part[k] = a;
                        {
                            constexpr int kn = k + UD;
                            int idx; if constexpr (kn < 16) idx = swz_bcast<(kn & 15)>(ev); else idx = swz_bcast<(kn & 15)>(evn);
                            const unsigned char* up = UQ + (size_t)idx * 1024 + 16 * l16;
#pragma unroll
                            for (int i = 0; i < 4; ++i) ub[sl][i] = *(const u32x4*)(up + 256 * i);
                        }
                    });
                    static_for<4>([&](auto sc) {
                        constexpr int w = 8 >> decltype(sc)::v;
                        const bool up2 = (lane & w) != 0;
#pragma unroll
                        for (int e = 0; e < w; ++e) {
                            const int keep = up2 ? part[e + w] : part[e], send = up2 ? part[e] : part[e + w];
                            part[e] = keep + swz_xor<w>(send);
                        }
                    });
                    const float dot = (float)part[0] * isu;
                    lc[bt * 16 + l16] = gv * 0.5f * dot * (1.f + erff(dot * 0.70710678118654752f)) * isv;
                }
                asm volatile("s_waitcnt lgkmcnt(0)" ::: "memory");
            }
            __syncthreads();
            f32x2 y[32];
#pragma unroll
            for (int i = 0; i < 32; ++i) y[i] = (f32x2){0.f, 0.f};
            {
                constexpr int VD = 4;
                u32x4 vbuf[VD][4];
                int evn = le[l16];
                static_for<VD>([&](auto kc) { constexpr int k = decltype(kc)::v; const unsigned char* vp = VQ + (size_t)swz_bcast<k>(evn) * 1024 + 16 * l16;
#pragma unroll
                    for (int i = 0; i < 4; ++i) vbuf[k][i] = *(const u32x4*)(vp + 256 * i); });
#pragma unroll 1
                for (int bt = 0; bt < 8; ++bt) {
                    if (bt) __syncthreads();
                    const int ev = evn; const int cv = __float_as_int(lc[bt * 16 + l16]);
                    evn = le[(bt < 7 ? bt + 1 : 7) * 16 + l16];
                    static_for<16>([&](auto kc) {
                        constexpr int k = decltype(kc)::v, sl = k % VD;
                        const float cc = __int_as_float(swz_bcast<k>(cv));
                        const f32x2 c2 = (f32x2){cc, cc};
#pragma unroll
                        for (int i = 0; i < 4; ++i) {
                            const u32x4 v = vbuf[sl][i];
#pragma unroll
                            for (int c = 0; c < 4; ++c) {
                                const int w = (int)v[c];
                                y[8 * i + 2 * c] = __builtin_elementwise_fma(__builtin_amdgcn_cvt_pk_f32_fp8(w, false), c2, y[8 * i + 2 * c]);
                                y[8 * i + 2 * c + 1] = __builtin_elementwise_fma(__builtin_amdgcn_cvt_pk_f32_fp8(w, true), c2, y[8 * i + 2 * c + 1]);
                            }
                        }
                        {
                            constexpr int kn = k + VD;
                            int idx; if constexpr (kn < 16) idx = swz_bcast<(kn & 15)>(ev); else idx = swz_bcast<(kn & 15)>(evn);
                            const unsigned char* vp = VQ + (size_t)idx * 1024 + 16 * l16;
#pragma unroll
                            for (int i = 0; i < 4; ++i) vbuf[sl][i] = *(const u32x4*)(vp + 256 * i);
                        }
                    });
                }
            }
            float ss = 0.f;
#pragma unroll
            for (int i = 0; i < 32; ++i) ss += y[i].x * y[i].x + y[i].y * y[i].y;
            const float rstd = rsqrtf(row16_sum(ss) * (1.f / D) + EPS);
            float* orow = p.out + t * D;
#pragma unroll
            for (int i = 0; i < 4; ++i)
#pragma unroll
                for (int c = 0; c < 4; ++c) {
                    const int col = 256 * i + 16 * l16 + 4 * c;
                    const u32x2 xb = *(const u32x2*)((const bf16_t*)(ws + WS_RO) + t * D + col);
                    f32x4 xv = {bflo(xb.x), bfhi(xb.x), bflo(xb.y), bfhi(xb.y)};
                    const f32x4 gg = *(const LAS f32x4*)(lG + col);
                    xv[0] += gg[0] * y[8 * i + 2 * c].x * rstd; xv[1] += gg[1] * y[8 * i + 2 * c].y * rstd; xv[2] += gg[2] * y[8 * i + 2 * c + 1].x * rstd; xv[3] += gg[3] * y[8 * i + 2 * c + 1].y * rstd;
                    *(f32x4*)(orow + col) = xv;
                }
        }
    }
}


__global__ void __launch_bounds__(NTH) fwd_megakernel(Params p) {
    extern __shared__ __attribute__((aligned(16))) unsigned char lds_raw[];
    LAS unsigned char* lds = (LAS unsigned char*)lds_raw;
    const int tid = threadIdx.x, lane = tid & 63, wave = __builtin_amdgcn_readfirstlane(tid >> 6);
    volatile LAS unsigned* st = (volatile LAS unsigned*)(lds + LDS_BARW);
    if (tid == 0) { st[0] = 0u; st[1] = 0u; st[2] = 0u; st[3] = 0u; }
    __syncthreads();
    XcdBarrier bar = xcd_barrier_post((unsigned*)(p.ws + WS_CTL), st);
    unsigned char* ws = p.ws;

    phase0(p, lds, tid, lane, wave);
    xcd_barrier(bar);
    phase1(p, lds, tid, lane, wave);
    xcd_barrier(bar);
    { pg8::Gemm g{(const bf16_t*)(ws + WS_RA), (const bf16_t*)(ws + WS_WIN), T, ZW, D}; pg8::StaticOrder S; S.init(T, ZW, (int)gridDim.x, (int)blockIdx.x);
      pg8::EpiB16 e{(bf16_t*)(ws + WS_RZ), ZW}; pg8::gemm_phase<pg8::EpiB16, pg8::StaticOrder, true, true>(lds, g, S, e);
      EpiZ e2{(bf16_t*)(ws + WS_RZ), (float*)(ws + WS_AFB)}; gemm_phase(((const bf16_t*)(ws + WS_RA)), (const bf16_t*)(ws + WS_WIN), T, NIN, D, e2, lds, tid, lane, wave, 16); }
    xcd_barrier(bar);
    phaseGA(p, lds, tid, lane, wave);
    xcd_barrier(bar);
    phaseGB(p, tid);
    xcd_barrier(bar);
    phase4a(p, lds, tid, lane, wave);
    xcd_barrier(bar);
    { pg8::Gemm g{(const bf16_t*)(ws + WS_RA), (const bf16_t*)(ws + WS_WOUT), T, D, D}; pg8::StaticOrder S; S.init(T, D, (int)gridDim.x, (int)blockIdx.x);
      pg8::EpiB16 e{(bf16_t*)(ws + WS_RZ), D}; pg8::gemm_phase<pg8::EpiB16, pg8::StaticOrder, true, true>(lds, g, S, e); }
    xcd_barrier(bar);
    phase4c(p, lds, tid, lane, wave);
    xcd_barrier(bar);
    { pg8::Gemm g{(const bf16_t*)(ws + WS_RA), (const bf16_t*)(ws + WS_WQ), T, 2048, D}; pg8::StaticOrder S; S.init(T, 2048, (int)gridDim.x, (int)blockIdx.x);
      pg8::EpiB16 e{(bf16_t*)(ws + WS_RZ), 2048}; pg8::gemm_phase<pg8::EpiB16, pg8::StaticOrder, true, true>(lds, g, S, e); }
    xcd_barrier(bar);
    phase5b(p, lds, tid, lane, wave);
    xcd_barrier(bar);
    phase6(p, lds, tid, lane, wave);
}

extern "C" void kernel_launch(void* const* d_in, const int* in_sizes, int n_in, void* d_out, int out_size, void* d_ws, size_t ws_size, hipStream_t stream) {
    static int grid = 0;
    if (grid == 0) {
        if (n_in != 21 || out_size != T * D || ws_size < WS_END) { fprintf(stderr, "kernel_launch: unexpected shapes (n_in %d out %d ws %zu need %zu)\n", n_in, out_size, ws_size, (size_t)WS_END); grid = -1; return; }
        int dev = 0, cus = 0, per_cu = 0;
        hipGetDevice(&dev); hipDeviceGetAttribute(&cus, hipDeviceAttributeMultiprocessorCount, dev);
        hipFuncSetAttribute((const void*)fwd_megakernel, hipFuncAttributeMaxDynamicSharedMemorySize, LDS_BYTES);
        hipOccupancyMaxActiveBlocksPerMultiprocessor(&per_cu, (const void*)fwd_megakernel, NTH, LDS_BYTES);
        (void)hipGetLastError();
        if (per_cu < 1) fprintf(stderr, "kernel_launch: occupancy query says %d blocks per CU\n", per_cu);
        grid = cus;
    }
    if (grid < 0) return;
    hipMemsetAsync((char*)d_ws + WS_CTL, 0, 64 * 1024, stream);
    Params p{};
    for (int i = 0; i < 21; ++i) p.in[i] = (const float*)d_in[i];
    p.out = (float*)d_out; p.ws = (unsigned char*)d_ws;
    hipLaunchKernelGGL(fwd_megakernel, dim3(grid), dim3(NTH), LDS_BYTES, stream, p);
}
```

```cpp
#include <hip/hip_runtime.h>
#include <cstdio>
#include <cstdint>

#define DI __device__ __forceinline__
#define LAS __attribute__((address_space(3)))
typedef unsigned short bf16_t;
typedef short bf16x8 __attribute__((ext_vector_type(8)));
typedef float f32x4 __attribute__((ext_vector_type(4)));
typedef float f32x2 __attribute__((ext_vector_type(2)));
typedef float f32x16 __attribute__((ext_vector_type(16)));
typedef unsigned u32x4 __attribute__((ext_vector_type(4)));
typedef unsigned u32x2 __attribute__((ext_vector_type(2)));
typedef __bf16 bf16x2v __attribute__((ext_vector_type(2)));

constexpr int T = 32768, D = 1024, SEQ = 4096, NB = 8;
constexpr int NTH = 512, NWV = 8;
constexpr int ZW = 2048;
constexpr int NIN = 2176;
constexpr float EPS = 1e-6f;

constexpr size_t MB = 1024 * 1024;
constexpr size_t WS_CTL   = 0;
constexpr size_t WS_MODP  = 64 * 1024;
constexpr size_t WS_WIN   = WS_MODP + 8 * 8 * 6144 * 4;
constexpr size_t WS_WOUT  = WS_WIN + (size_t)NIN * 1024 * 2;
constexpr size_t WS_WQ    = WS_WOUT + 1024 * 1024 * 2;
constexpr size_t WS_SKB   = WS_WQ + 2048 * 1024 * 2;
constexpr size_t WS_WP    = WS_SKB + 16 * 128 * 128 * 2;
constexpr size_t WS_AFB   = WS_WP + 4 * 128 * 128 * 2;
constexpr size_t WS_UB    = WS_AFB + (size_t)T * 32 * 4;
constexpr size_t WS_VB    = WS_UB + 32 * MB;
constexpr size_t WS_SU    = WS_UB + 16 * MB, WS_SV = WS_VB + 16 * MB;
constexpr size_t WS_RA    = WS_VB + 32 * MB;
constexpr size_t WS_RZ    = WS_RA + 64 * MB;
constexpr size_t WS_RS    = WS_RZ + 128 * MB;
constexpr size_t WS_RO    = WS_RS + 6 * 16 * MB + 1 * MB;
constexpr size_t WS_END   = WS_RO + 128 * MB;
static_assert(WS_END <= 512 * MB, "workspace too large");

struct Params { const float* in[21]; float* out; unsigned char* ws; };

DI unsigned pk2(float a, float b) { f32x2 f = {a, b}; bf16x2v h = __builtin_convertvector(f, bf16x2v); return __builtin_bit_cast(unsigned, h); }
DI float dot2bf(unsigned a, unsigned b, float c) { return __builtin_amdgcn_fdot2_f32_bf16(__builtin_bit_cast(bf16x2v, a), __builtin_bit_cast(bf16x2v, b), c, false); }
DI float bflo(unsigned u) { return __uint_as_float(u << 16); }
DI float bfhi(unsigned u) { return __uint_as_float(u & 0xFFFF0000u); }
DI float wave_sum(float v) {
#pragma unroll
    for (int o = 1; o < 64; o <<= 1) v += __shfl_xor(v, o);
    return v;
}
DI bf16x8 ld_frag16(const bf16_t* p) { return __builtin_bit_cast(bf16x8, *(const u32x4*)p); }
DI bf16x8 ld_frag_perm(const bf16_t* p, int g) {
    const u32x2 lo = *(const u32x2*)(p + 4 * g), hi = *(const u32x2*)(p + 16 + 4 * g);
    u32x4 v = {lo.x, lo.y, hi.x, hi.y}; return __builtin_bit_cast(bf16x8, v);
}
DI int perm32(int k) { return (k & ~31) | (((k >> 2) & 3) << 3) | (((k >> 4) & 1) << 2) | (k & 3); }
DI bf16x8 pack8(const f32x4& a, const f32x4& b) { u32x4 v = {pk2(a[0], a[1]), pk2(a[2], a[3]), pk2(b[0], b[1]), pk2(b[2], b[3])}; return __builtin_bit_cast(bf16x8, v); }
#define MFMA16(a, b, c) __builtin_amdgcn_mfma_f32_16x16x32_bf16((a), (b), (c), 0, 0, 0)
#define MFMA32(a, b, c) __builtin_amdgcn_mfma_f32_32x32x16_bf16((a), (b), (c), 0, 0, 0)

#define XB_TMO      128
#define XB_XCNT(j)  (256  + 64 * (j))
#define XB_XSUB(j)  (1280 + 64 * (j))
#define XB_XGEN(j)  (2304 + 64 * (j))
#define XB_TOP      3328
#define XB_TOPGEN   3392
#define XCD_BAR_WORDS 3456
#define XB_SPIN_CAP (1u << 22)
DI unsigned xb_ld(unsigned* p)              { return __hip_atomic_load(p, __ATOMIC_RELAXED, __HIP_MEMORY_SCOPE_AGENT); }
DI unsigned xb_add(unsigned* p, unsigned v) { return __hip_atomic_fetch_add(p, v, __ATOMIC_RELAXED, __HIP_MEMORY_SCOPE_AGENT); }
DI unsigned xb_xcc_id() { return (unsigned)__builtin_amdgcn_s_getreg((3 << 11) | 20) & 0xFu; }
#define XB_SPIN(cond, bar) do { unsigned _sp = 0; while (cond) { __builtin_amdgcn_s_sleep(1); \
    if ((++_sp & 255u) == 0u) { if (xb_ld(&(bar)[XB_TMO])) break; if (_sp > XB_SPIN_CAP) { atomicAdd(&(bar)[XB_TMO], 1u); break; } } } } while (0)
struct XcdBarrier { unsigned* bar; unsigned x; volatile LAS unsigned* st; };
DI XcdBarrier xcd_barrier_post(unsigned* bar, volatile LAS unsigned* st) {
    XcdBarrier b; b.bar = bar; b.x = xb_xcc_id(); b.st = st;
    if (threadIdx.x == 0) (void)xb_add(&bar[XB_XCNT(b.x)], 1u);
    return b;
}
DI void xcd_barrier_complete(unsigned* bar, unsigned x, unsigned& nloc, unsigned& nx) {
    const unsigned G = gridDim.x * gridDim.y * gridDim.z;
    unsigned sum, cnt, mine, sp = 0u;
    for (;;) {
        sum = 0u; cnt = 0u; mine = 0u;
#pragma unroll
        for (unsigned j = 0; j < 16; ++j) { const unsigned c = xb_ld(&bar[XB_XCNT(j)]); sum += c; cnt += (c > 0u) ? 1u : 0u; mine = (j == x) ? c : mine; }
        if (sum == G) break;
        __builtin_amdgcn_s_sleep(1);
        if ((++sp & 255u) == 0u) { if (xb_ld(&bar[XB_TMO])) break; if (sp > XB_SPIN_CAP) { atomicAdd(&bar[XB_TMO], 1u); break; } }
    }
    nloc = mine > 0u ? mine : 1u; nx = cnt > 0u ? cnt : 1u;
}
DI void xcd_barrier(const XcdBarrier& b) {
    asm volatile("s_waitcnt vmcnt(0)" ::: "memory");
    __syncthreads();
    if (threadIdx.x == 0) {
        unsigned* bar = b.bar;
        __builtin_amdgcn_s_waitcnt(0);
        unsigned nloc = b.st[0], nx = b.st[1];
        if (nloc == 0u) { xcd_barrier_complete(bar, b.x, nloc, nx); b.st[0] = nloc; b.st[1] = nx; }
        const unsigned old = xb_add(&bar[XB_XSUB(b.x)], 1u);
        const unsigned gen = old / nloc;
        if (old + 1u == (gen + 1u) * nloc) {
            __builtin_amdgcn_fence(__ATOMIC_RELEASE, "agent");
            asm volatile("s_waitcnt vmcnt(0)" ::: "memory");
            const unsigned og = xb_add(&bar[XB_TOP], 1u);
            const unsigned tg = og / nx;
            if (og + 1u == (tg + 1u) * nx) xb_add(&bar[XB_TOPGEN], 1u);
            else XB_SPIN(xb_ld(&bar[XB_TOPGEN]) == tg, bar);
            __builtin_amdgcn_fence(__ATOMIC_ACQUIRE, "agent");
            xb_add(&bar[XB_XGEN(b.x)], 1u);
            asm volatile("s_waitcnt vmcnt(0)" ::: "memory");
        } else {
            XB_SPIN(xb_ld(&bar[XB_XGEN(b.x)]) == gen, bar);
            __builtin_amdgcn_fence(__ATOMIC_ACQUIRE, "agent");
            asm volatile("s_waitcnt vmcnt(0)" ::: "memory");
        }
    }
    __syncthreads();
}

constexpr int LDS_BYTES = 152 * 1024;
constexpr int LDS_BARW = LDS_BYTES - 16;

DI void p0_transpose_item(const float* W, int ldw, int K, bf16_t* WT, int dst_row0, int src_col0, float scale, bool zero, LAS float* scr, int kb, int lane) {
    const int k0 = 64 * kb;
#pragma unroll 8
    for (int i = 0; i < 32; ++i) { const int kk = 2 * i + (lane >> 5); scr[kk * 33 + (lane & 31)] = zero ? 0.f : W[(size_t)(k0 + kk) * ldw + src_col0 + (lane & 31)] * scale; }
    asm volatile("s_waitcnt lgkmcnt(0)" ::: "memory");
    const int c = lane & 7;
#pragma unroll
    for (int j = 0; j < 4; ++j) { const int n = (lane >> 3) + 8 * j; const LAS float* s = scr + (8 * c) * 33 + n;
        u32x4 o; o.x = pk2(s[0 * 33], s[1 * 33]); o.y = pk2(s[2 * 33], s[3 * 33]); o.z = pk2(s[4 * 33], s[5 * 33]); o.w = pk2(s[6 * 33], s[7 * 33]);
        *(u32x4*)(WT + (size_t)(dst_row0 + n) * K + k0 + 8 * c) = o; }
    asm volatile("s_waitcnt lgkmcnt(0)" ::: "memory");
}

DI void phase0(const Params& p, LAS unsigned char* lds, int tid, int lane, int wave) {
    asm volatile("" : "+v"(tid), "+v"(lane));
    unsigned char* ws = p.ws;
    LAS float* sl = (LAS float*)lds;
    LAS float* scr = (LAS float*)(lds + 32768 + wave * 8448);
    const float* c = p.in[1];
    for (int e = tid; e < 8192; e += NTH) { const int b = e >> 10, k = e & 1023; const float v = c[e]; sl[k * 8 + b] = v / (1.f + __expf(-v)); }
    __syncthreads();
    const int gw = wave * gridDim.x + blockIdx.x, NGW = gridDim.x * NWV;
    constexpr int I_MOD = 768, I_WIN = 16 * 68, I_WOUT = 16 * 32, I_WQ = 16 * 64, I_WP = 32;
    constexpr int NITEMS = I_MOD + I_WIN + I_WOUT + I_WQ + I_WP;
    for (int it = gw; it < NITEMS; it += NGW) {
        int r = it;
        if (r < I_MOD) {
            const int cg = r % 96, ks = r / 96, n = cg * 64 + lane, k0 = ks * 128;
            const float* W = p.in[2] + (size_t)k0 * 6144 + n;
            float acc[8];
#pragma unroll
            for (int b = 0; b < 8; ++b) acc[b] = 0.f;
#pragma unroll 8
            for (int k = 0; k < 128; ++k) {
                const float w = W[(size_t)k * 6144];
                const f32x4 s0 = *(const LAS f32x4*)(sl + (k0 + k) * 8), s1 = *(const LAS f32x4*)(sl + (k0 + k) * 8 + 4);
                acc[0] += s0[0] * w; acc[1] += s0[1] * w; acc[2] += s0[2] * w; acc[3] += s0[3] * w;
                acc[4] += s1[0] * w; acc[5] += s1[1] * w; acc[6] += s1[2] * w; acc[7] += s1[3] * w;
            }
            float* mp = (float*)(ws + WS_MODP) + (size_t)ks * 8 * 6144 + n;
#pragma unroll
            for (int b = 0; b < 8; ++b) mp[b * 6144] = acc[b];
            continue;
        }
        r -= I_MOD;
        if (r < I_WIN) {
            const int kb = r / 68, nb = r % 68, n0 = nb * 32;
            int src; bool zero = false; float scale = 1.f;
            if (n0 < 1536) { src = n0; if (n0 < 256) scale = 0.125f; } else if (n0 < 2048) src = n0 + 32; else if (n0 < 2080) src = 1536 + (n0 - 2048); else { src = 0; zero = true; }
            p0_transpose_item(p.in[6], 2080, 1024, (bf16_t*)(ws + WS_WIN), n0, src, scale, zero, scr, kb, lane);
            continue;
        }
        r -= I_WIN;
        if (r < I_WOUT) { p0_transpose_item(p.in[14], 1024, 1024, (bf16_t*)(ws + WS_WOUT), (r % 32) * 32, (r % 32) * 32, 1.f, false, scr, r / 32, lane); continue; }
        r -= I_WOUT;
        if (r < I_WQ) { p0_transpose_item(p.in[17], 2048, 1024, (bf16_t*)(ws + WS_WQ), (r % 64) * 32, (r % 64) * 32, 1.f, false, scr, r / 64, lane); continue; }
        r -= I_WQ;
        { const int g = r >> 3, kb = (r >> 2) & 1, nb = r & 3;
          p0_transpose_item(p.in[12] + g * 16384, 128, 128, (bf16_t*)(ws + WS_WP) + g * 16384, nb * 32, nb * 32, 1.f, false, scr, kb, lane); }
    }
    const size_t gt = (size_t)blockIdx.x * NTH + tid, NGT = (size_t)gridDim.x * NTH;
    constexpr size_t NSK = (size_t)16 * 128 * 128 / 8;
    for (size_t j = gt; j < NSK; j += NGT) {
        const float* src = p.in[18]; bf16_t* dst = (bf16_t*)(ws + WS_SKB);
        const f32x4 a = *(const f32x4*)(src + j * 8), b = *(const f32x4*)(src + j * 8 + 4);
        u32x4 o = {pk2(a[0], a[1]), pk2(a[2], a[3]), pk2(b[0], b[1]), pk2(b[2], b[3])};
        *(u32x4*)(dst + j * 8) = o;
    }
}

DI void quant_load(const Params& p, int row, int lane, f32x4 (&v)[4]) {
    const int tb = row >> 14, e = row & 16383;
    const float* src = (tb ? p.in[20] : p.in[19]) + (size_t)e * D + 16 * lane;
#pragma unroll
    for (int q = 0; q < 4; ++q) v[q] = *(const f32x4*)(src + 4 * q);
}
DI void quant_store(const Params& p, int row, int lane, const f32x4 (&v)[4]) {
    unsigned char* ws = p.ws;
    const int tb = row >> 14, e = row & 16383;
    float m = 0.f;
#pragma unroll
    for (int q = 0; q < 4; ++q) m = fmaxf(m, fmaxf(fmaxf(fabsf(v[q][0]), fabsf(v[q][1])), fmaxf(fabsf(v[q][2]), fabsf(v[q][3]))));
#pragma unroll
    for (int o = 1; o < 64; o <<= 1) m = fmaxf(m, __shfl_xor(m, o));
    int ex = (int)((__float_as_uint(m) >> 23) & 0xFFu) - 127;
    if (m < 1e-30f) ex = 7;
    const float sc = __uint_as_float((unsigned)(127 + 7 - ex) << 23), isc = __uint_as_float((unsigned)(127 - 7 + ex) << 23);
    u32x4 o;
    if (tb) {
#pragma unroll
        for (int q = 0; q < 4; ++q) { int w = 0; w = __builtin_amdgcn_cvt_pk_fp8_f32(v[q][0] * sc, v[q][1] * sc, w, false); w = __builtin_amdgcn_cvt_pk_fp8_f32(v[q][2] * sc, v[q][3] * sc, w, true); o[q] = (unsigned)w; }
        if (lane == 0) ((float*)(ws + WS_SV))[e] = isc;
    } else {
        const float s8 = m > 1e-30f ? 127.f / m : 0.f;
#pragma unroll
        for (int q = 0; q < 4; ++q) {
            const int q0 = __float2int_rn(v[q][0] * s8), q1 = __float2int_rn(v[q][1] * s8), q2 = __float2int_rn(v[q][2] * s8), q3 = __float2int_rn(v[q][3] * s8);
            o[q] = (unsigned)(q0 & 0xFF) | ((unsigned)(q1 & 0xFF) << 8) | ((unsigned)(q2 & 0xFF) << 16) | ((unsigned)q3 << 24);
        }
        if (lane == 0) ((float*)(ws + WS_SU))[e] = m * (1.f / 127.f);
    }
    *(u32x4*)(ws + (tb ? WS_VB : WS_UB) + (size_t)e * 1024 + 16 * lane) = o;
}

DI float mod_at(const Params& p, int b, int n) {
    const float* mp = (const float*)(p.ws + WS_MODP) + (size_t)b * 6144 + n;
    float s = p.in[3][n];
#pragma unroll
    for (int ks = 0; ks < 8; ++ks) s += mp[(size_t)ks * 8 * 6144];
    return s;
}

DI void phase1(const Params& p, LAS unsigned char* lds, int tid, int lane, int wave) {
    asm volatile("" : "+v"(tid), "+v"(lane));
    LAS float* lA = (LAS float*)lds; LAS float* lB = lA + 1024;
    const float* x = p.in[0]; bf16_t* H = (bf16_t*)(p.ws + WS_RA);
    for (int rt = blockIdx.x; rt < T / 128; rt += gridDim.x) {
        const int b = rt / 32;
        __syncthreads();
        for (int d = tid; d < 1024; d += NTH) { lA[d] = p.in[4][d] * (1.f + mod_at(p, b, 1024 + d)); lB[d] = mod_at(p, b, d); }
        __syncthreads();
        for (int r0 = wave; r0 < 128; r0 += 4 * NWV) {
            f32x4 v[4][4];
#pragma unroll
            for (int u = 0; u < 4; ++u) { const f32x4* xr = (const f32x4*)(x + ((size_t)rt * 128 + r0 + u * NWV) * D) + lane;
#pragma unroll
                for (int j = 0; j < 4; ++j) v[u][j] = xr[64 * j]; }
#pragma unroll
            for (int u = 0; u < 4; ++u) {
                const size_t row = (size_t)rt * 128 + r0 + u * NWV;
                float ss = 0.f;
#pragma unroll
                for (int j = 0; j < 4; ++j) ss += v[u][j][0] * v[u][j][0] + v[u][j][1] * v[u][j][1] + v[u][j][2] * v[u][j][2] + v[u][j][3] * v[u][j][3];
                const float rstd = rsqrtf(wave_sum(ss) * (1.f / D) + EPS);
                u32x2* o = (u32x2*)(H + row * D) + lane;
#pragma unroll
                for (int j = 0; j < 4; ++j) {
                    const f32x4 a = *(const LAS f32x4*)(lA + 4 * lane + 256 * j), bb = *(const LAS f32x4*)(lB + 4 * lane + 256 * j);
                    u32x2 w = {pk2(v[u][j][0] * rstd * a[0] + bb[0], v[u][j][1] * rstd * a[1] + bb[1]), pk2(v[u][j][2] * rstd * a[2] + bb[2], v[u][j][3] * rstd * a[3] + bb[3])};
                    o[64 * j] = w;
                }
            }
        }
    }
}

struct EpiZ {
    bf16_t* Z; float* AFB;
    DI void operator()(int m, int n, const f32x4& v) const {
        if (n < ZW) { u32x2 w = {pk2(v[0], v[1]), pk2(v[2], v[3])}; *(u32x2*)(Z + (size_t)m * ZW + n) = w; }
        else if (n < ZW + 32) { *(f32x4*)(AFB + (size_t)m * 32 + (n - ZW)) = v; }
    }
};
struct EpiF32 { float* C; int ldc; DI void operator()(int m, int n, const f32x4& v) const { *(f32x4*)(C + (size_t)m * ldc + n) = v; } };
struct EpiBf16 { bf16_t* C; int ldc; DI void operator()(int m, int n, const f32x4& v) const { u32x2 w = {pk2(v[0], v[1]), pk2(v[2], v[3])}; *(u32x2*)(C + (size_t)m * ldc + n) = w; } };

template <class Epi>
DI void gemm_phase(const bf16_t* A, const bf16_t* Bt, int M, int N, int K, const Epi& epi, LAS unsigned char* lds, int tid, int lane, int wave, int nt_first = 0) {
    constexpr int BM = 256, BN = 128, BK = 64, STAGE = (BM + BN) * 128;
    const int ntn = N / BN - nt_first, ntiles = (M / BM) * ntn, nk = K / BK;
    const int wm = wave & 3, wn = wave >> 2, c15 = lane & 15, g = lane >> 4;
    const int lrow = tid >> 3, lch = tid & 7;
    for (int tile = blockIdx.x; tile < ntiles; tile += gridDim.x) {
        const int m0 = (tile / ntn) * BM, n0 = (tile % ntn + nt_first) * BN;
        f32x4 acc[4][4];
#pragma unroll
        for (int i = 0; i < 4; ++i)
#pragma unroll
            for (int j = 0; j < 4; ++j) acc[i][j] = (f32x4){0.f, 0.f, 0.f, 0.f};
        u32x4 ra[4], rb[2];
        const bf16_t* Ag = A + (size_t)(m0 + lrow) * K + lch * 8;
        const bf16_t* Bg = Bt + (size_t)(n0 + lrow) * K + lch * 8;
        const int woff = lrow * 128 + ((lch ^ (lrow & 7)) * 16);
        __syncthreads();
#pragma unroll
        for (int ps = 0; ps < 4; ++ps) ra[ps] = *(const u32x4*)(Ag + (size_t)(64 * ps) * K);
#pragma unroll
        for (int ps = 0; ps < 2; ++ps) rb[ps] = *(const u32x4*)(Bg + (size_t)(64 * ps) * K);
#pragma unroll
        for (int ps = 0; ps < 4; ++ps) *(LAS u32x4*)(lds + woff + ps * 8192) = ra[ps];
#pragma unroll
        for (int ps = 0; ps < 2; ++ps) *(LAS u32x4*)(lds + BM * 128 + woff + ps * 8192) = rb[ps];
        __syncthreads();
        for (int kt = 0; kt < nk; ++kt) {
            const bool more = (kt + 1 < nk);
            if (more) {
#pragma unroll
                for (int ps = 0; ps < 4; ++ps) ra[ps] = *(const u32x4*)(Ag + (size_t)(64 * ps) * K + (kt + 1) * BK);
#pragma unroll
                for (int ps = 0; ps < 2; ++ps) rb[ps] = *(const u32x4*)(Bg + (size_t)(64 * ps) * K + (kt + 1) * BK);
            }
            LAS unsigned char* sa = lds + (kt & 1) * STAGE; LAS unsigned char* sb = sa + BM * 128;
#pragma unroll
            for (int s = 0; s < 2; ++s) {
                bf16x8 fa[4], fb[4];
#pragma unroll
                for (int i = 0; i < 4; ++i) { const int row = wm * 64 + i * 16 + c15; fa[i] = *(const LAS bf16x8*)(sa + row * 128 + (((4 * s + g) ^ (row & 7)) * 16)); }
#pragma unroll
                for (int j = 0; j < 4; ++j) { const int row = wn * 64 + j * 16 + c15; fb[j] = *(const LAS bf16x8*)(sb + row * 128 + (((4 * s + g) ^ (row & 7)) * 16)); }
#pragma unroll
                for (int i = 0; i < 4; ++i)
#pragma unroll
                    for (int j = 0; j < 4; ++j) acc[i][j] = MFMA16(fb[j], fa[i], acc[i][j]);
            }
            if (more) {
                LAS unsigned char* da = lds + ((kt + 1) & 1) * STAGE;
#pragma unroll
                for (int ps = 0; ps < 4; ++ps) *(LAS u32x4*)(da + woff + ps * 8192) = ra[ps];
#pragma unroll
                for (int ps = 0; ps < 2; ++ps) *(LAS u32x4*)(da + BM * 128 + woff + ps * 8192) = rb[ps];
            }
            __syncthreads();
        }
#pragma unroll
        for (int i = 0; i < 4; ++i)
#pragma unroll
            for (int j = 0; j < 4; ++j) epi(m0 + wm * 64 + i * 16 + c15, n0 + wn * 64 + j * 16 + 4 * g, acc[i][j]);
    }
}

namespace pg8 {
#define PG8_LAS __attribute__((address_space(3)))
constexpr int BM = 256, BK = 64, HALF = 128, HTB = HALF * BK * 2  , STAGE_BYTES = 8 * HTB, NXCD = 8, WGM = 1;

__host__ __device__ __forceinline__ int lds_byte(int r, int c) { const int st = (r >> 4) * 2 + (c >> 5), rr = r & 15, cc = c & 31, ob = rr * 64 + cc * 2; return st * 1024 + (ob ^ (((ob >> 9) & 1) << 5)); }
__host__ __device__ __forceinline__ void stage_rc(int b, int& R, int& C) { const int st = b / 1024, sb = b % 1024, swz = sb ^ (((sb >> 9) & 1) << 5); R = (st >> 1) * 16 + swz / 64; C = (st & 1) * 32 + (swz % 64) / 2; }
__host__ __device__ __forceinline__ int perm32(int rho) { const int n = rho >> 4, i = rho & 15; return 8 * (i >> 2) + 4 * n + (i & 3); }

struct Unit { int pm, pn; };
struct Gemm { const bf16_t* A; const bf16_t* Bt; int M, N, K; };

struct StaticOrder {
    int nM, nN, nwg, G, c;
    __host__ __device__ void init(int M, int N, int G_, int c_) { nM = M / BM; nN = N / BM; nwg = nM * nN; G = G_; c = c_; }
    __host__ __device__ bool next(int i, Unit& u) const {
        const long L = (long)i * G + c; if (L >= nwg) return false;
        int wgid = (int)L; { const int q = nwg / NXCD, r = nwg % NXCD, xcd = wgid % NXCD, off = wgid / NXCD; wgid = (xcd < r ? xcd * (q + 1) : r * (q + 1) + (xcd - r) * q) + off; }
        const int nig = WGM * nN, gid = wgid / nig, fm = gid * WGM, gsz = (nM - fm) < WGM ? (nM - fm) : WGM;
        u.pm = fm + ((wgid % nig) % gsz); u.pn = (wgid % nig) / gsz; return true;
    }
    __device__ __forceinline__ void a_ready(const Unit&) const {}
    __device__ __forceinline__ void done(const Unit&) const {}
};

struct EpiB16 {
    static constexpr bool PERM = true, AFTER_DRAIN = false;
    bf16_t* O; int ldc;
    __device__ __forceinline__ void operator()(const f32x4 (&acc)[2][2][4][2], const Unit& u, int wr, int wc, int fr, int fq) const {
#pragma unroll
        for (int ai = 0; ai < 2; ++ai)
#pragma unroll
            for (int m = 0; m < 4; ++m) { bf16_t* rowp = O + (size_t)(u.pm * BM + ai * HALF + wr * 64 + m * 16 + fr) * ldc + u.pn * BM + wc * 32 + 8 * fq;
#pragma unroll
                for (int bj = 0; bj < 2; ++bj) { const f32x4 v0 = acc[ai][bj][m][0], v1 = acc[ai][bj][m][1];
                    u32x4 w; w.x = ::pk2(v0[0], v0[1]); w.y = ::pk2(v0[2], v0[3]); w.z = ::pk2(v1[0], v1[1]); w.w = ::pk2(v1[2], v1[3]);
                    *(u32x4*)(rowp + bj * HALF) = w; } }
    }
};
struct EpiF {
    static constexpr bool PERM = false, AFTER_DRAIN = false;
    float* O; int ldc;
    __device__ __forceinline__ void operator()(const f32x4 (&acc)[2][2][4][2], const Unit& u, int wr, int wc, int fr, int fq) const {
#pragma unroll
        for (int ai = 0; ai < 2; ++ai)
#pragma unroll
            for (int m = 0; m < 4; ++m) { float* rowp = O + (size_t)(u.pm * BM + ai * HALF + wr * 64 + m * 16 + fr) * ldc + u.pn * BM + wc * 32 + 4 * fq;
#pragma unroll
                for (int bj = 0; bj < 2; ++bj)
#pragma unroll
                    for (int n = 0; n < 2; ++n) *(f32x4*)(rowp + bj * HALF + 16 * n) = acc[ai][bj][m][n]; }
    }
};
template <class Epi, class Sched, bool ALIGN_EPI = false, bool SP2 = false>
__device__ __forceinline__ void gemm_phase(PG8_LAS unsigned char* lds, const Gemm g, const Sched& S, const Epi& E) {
    int tid = threadIdx.x; asm volatile("" : "+v"(tid));
    const int wid = __builtin_amdgcn_readfirstlane(tid >> 6), lane = tid & 63, wr = wid >> 2, wc = wid & 3, fr = lane & 15, fq = lane >> 4;
    const int K = g.K, nt = K / BK;
    unsigned voffA[2], voffB[2];
#pragma unroll
    for (int i = 0; i < 2; ++i) { int R, C; stage_rc(tid * 16 + i * 8192, R, C); const int Rb = Epi::PERM ? ((R & ~31) + perm32(R & 31)) : R;
        voffA[i] = (unsigned)(R * K + C) * 2u; voffB[i] = (unsigned)(Rb * K + C) * 2u; }
    const size_t kstep = (size_t)(BK * 2);
    const size_t hstep = (size_t)HALF * K * 2;
    const size_t tstep = 2 * hstep;
    const unsigned ldsw = (unsigned)wid * 1024u;
    const int aoff = lds_byte(wr * 64 + fr, fq * 8), boff = lds_byte(wc * 32 + fr, fq * 8);
#define PG8_SA(b, h) (((b) * 2 + (h)) * HTB)
#define PG8_SB(b, h) ((4 + (b) * 2 + (h)) * HTB)
#define PG8_STAGE(bufoff, gbase, voff) do { _Pragma("unroll") for (int _i = 0; _i < 2; ++_i) \
        __builtin_amdgcn_global_load_lds((const unsigned*)((const char*)(gbase) + (voff)[_i]), (PG8_LAS unsigned*)(lds + (bufoff) + ldsw + _i * 8192), 16, 0, 0); } while (0)
#define PG8_LDA(dst, b, h) do { _Pragma("unroll") for (int m = 0; m < 4; ++m) _Pragma("unroll") for (int k = 0; k < 2; ++k) dst[m][k] = *(const PG8_LAS bf16x8*)(lds + PG8_SA(b, h) + aoff + m * 2048 + k * 1024); } while (0)
#define PG8_LDB(dst, b, h) do { _Pragma("unroll") for (int n = 0; n < 2; ++n) _Pragma("unroll") for (int k = 0; k < 2; ++k) dst[n][k] = *(const PG8_LAS bf16x8*)(lds + PG8_SB(b, h) + boff + n * 2048 + k * 1024); } while (0)
#define PG8_MMA(ai, bj, At, Bt) do { __builtin_amdgcn_s_setprio(1); _Pragma("unroll") for (int m = 0; m < 4; ++m) _Pragma("unroll") for (int n = 0; n < 2; ++n) _Pragma("unroll") for (int k = 0; k < 2; ++k) \
        acc[ai][bj][m][n] = __builtin_amdgcn_mfma_f32_16x16x32_bf16(Bt[n][k], At[m][k], acc[ai][bj][m][n], 0, 0, 0); __builtin_amdgcn_s_setprio(0); } while (0)
#define PG8_WAIT_V(n) asm volatile("s_waitcnt vmcnt(" #n ")" ::: "memory")
#define PG8_WAIT_L(n) asm volatile("s_waitcnt lgkmcnt(" #n ")" ::: "memory")
#define PG8_BAR __builtin_amdgcn_s_barrier()
#define PG8_SCHED __builtin_amdgcn_sched_barrier(0)
    Unit cur, nxt; int ui = 0;
    if (!S.next(0, cur)) return;
    f32x4 acc[2][2][4][2];
#pragma unroll
    for (int a = 0; a < 2; ++a)
#pragma unroll
        for (int b = 0; b < 2; ++b)
#pragma unroll
            for (int m = 0; m < 4; ++m)
#pragma unroll
                for (int n = 0; n < 2; ++n) acc[a][b][m][n] = (f32x4){0.f, 0.f, 0.f, 0.f};
    bf16x8 At[4][2], B0[2][2], B1[2][2];
    const char* cA = (const char*)g.A + (size_t)cur.pm * tstep; const char* cB = (const char*)g.Bt + (size_t)cur.pn * tstep;
    S.a_ready(cur);
    if constexpr (SP2) {
        PG8_STAGE(PG8_SB(0, 0), cB, voffB); PG8_STAGE(PG8_SB(0, 1), cB + hstep, voffB); PG8_STAGE(PG8_SA(0, 0), cA, voffA); PG8_STAGE(PG8_SA(0, 1), cA + hstep, voffA);
        if (wr == 1) PG8_BAR;
        PG8_WAIT_V(2); PG8_BAR;
        PG8_STAGE(PG8_SB(1, 0), cB + kstep, voffB); PG8_STAGE(PG8_SA(1, 0), cA + kstep, voffA); PG8_STAGE(PG8_SB(1, 1), cB + hstep + kstep, voffB);
        PG8_WAIT_V(6); PG8_BAR;
    } else {
        PG8_STAGE(PG8_SB(0, 0), cB, voffB); PG8_STAGE(PG8_SA(0, 0), cA, voffA); PG8_STAGE(PG8_SB(0, 1), cB + hstep, voffB); PG8_STAGE(PG8_SA(0, 1), cA + hstep, voffA);
        if (wr == 1) PG8_BAR;
        PG8_WAIT_V(4); PG8_BAR;
        PG8_STAGE(PG8_SB(1, 0), cB + kstep, voffB); PG8_STAGE(PG8_SA(1, 0), cA + kstep, voffA); PG8_STAGE(PG8_SB(1, 1), cB + hstep + kstep, voffB);
        PG8_WAIT_V(6); PG8_BAR;
    }
    for (;;) {
        const bool has_next = S.next(ui + 1, nxt);
        const char* nA = has_next ? (const char*)g.A + (size_t)nxt.pm * tstep : cA; const char* nB = has_next ? (const char*)g.Bt + (size_t)nxt.pn * tstep : cB;
        for (int t = 0; t < nt; t += 2) {
            const bool last = (t == nt - 2);
            const char* a1 = cA + (size_t)(t + 1) * kstep;
            const char* a2 = last ? nA : cA + (size_t)(t + 2) * kstep; const char* b2 = last ? nB : cB + (size_t)(t + 2) * kstep;
            const char* a3 = a2 + kstep; const char* b3 = b2 + kstep;
            if (last && has_next) S.a_ready(nxt);
            if constexpr (SP2) {
            PG8_LDB(B0, 0, 0); PG8_LDB(B1, 0, 1); PG8_SCHED; PG8_LDA(At, 0, 0); PG8_STAGE(PG8_SA(1, 1), a1 + hstep, voffA);
            PG8_WAIT_V(8); PG8_WAIT_L(0); PG8_BAR; PG8_MMA(0, 0, At, B0); PG8_MMA(0, 1, At, B1); PG8_BAR; PG8_SCHED;
            PG8_LDA(At, 0, 1); PG8_STAGE(PG8_SB(0, 0), b2, voffB); PG8_STAGE(PG8_SB(0, 1), b2 + hstep, voffB); PG8_STAGE(PG8_SA(0, 0), a2, voffA);
            PG8_WAIT_V(8); PG8_WAIT_L(0); PG8_BAR; PG8_MMA(1, 0, At, B0); PG8_MMA(1, 1, At, B1); PG8_BAR; PG8_SCHED;
            PG8_LDB(B0, 1, 0); PG8_LDB(B1, 1, 1); PG8_SCHED; PG8_LDA(At, 1, 0); PG8_STAGE(PG8_SA(0, 1), a2 + hstep, voffA);
            PG8_WAIT_V(8); PG8_WAIT_L(0); PG8_BAR; PG8_MMA(0, 0, At, B0); PG8_MMA(0, 1, At, B1); PG8_BAR; PG8_SCHED;
            PG8_LDA(At, 1, 1); PG8_STAGE(PG8_SB(1, 0), b3, voffB); PG8_STAGE(PG8_SB(1, 1), b3 + hstep, voffB); PG8_STAGE(PG8_SA(1, 0), a3, voffA);
            PG8_WAIT_V(8); PG8_WAIT_L(0); PG8_BAR; PG8_MMA(1, 0, At, B0); PG8_MMA(1, 1, At, B1); PG8_BAR; PG8_SCHED;
            } else {
            PG8_LDB(B0, 0, 0); PG8_SCHED; PG8_LDA(At, 0, 0); PG8_STAGE(PG8_SA(1, 1), a1 + hstep, voffA);
            PG8_WAIT_L(8); PG8_BAR; PG8_WAIT_L(0); PG8_MMA(0, 0, At, B0); PG8_BAR; PG8_SCHED;
            PG8_LDB(B1, 0, 1); PG8_STAGE(PG8_SB(0, 0), b2, voffB);
            PG8_BAR; PG8_WAIT_L(0); PG8_MMA(0, 1, At, B1); PG8_BAR;
            PG8_LDA(At, 0, 1); PG8_STAGE(PG8_SA(0, 0), a2, voffA);
            PG8_BAR; PG8_WAIT_L(0); PG8_MMA(1, 0, At, B0); PG8_BAR; PG8_SCHED;
            PG8_STAGE(PG8_SB(0, 1), b2 + hstep, voffB);
            PG8_WAIT_V(6); PG8_BAR; PG8_MMA(1, 1, At, B1); PG8_BAR;
            PG8_LDB(B0, 1, 0); PG8_SCHED; PG8_LDA(At, 1, 0); PG8_STAGE(PG8_SA(0, 1), a2 + hstep, voffA);
            PG8_WAIT_L(8); PG8_BAR; PG8_WAIT_L(0); PG8_MMA(0, 0, At, B0); PG8_BAR; PG8_SCHED;
            PG8_LDB(B1, 1, 1); PG8_STAGE(PG8_SB(1, 0), b3, voffB);
            PG8_BAR; PG8_WAIT_L(0); PG8_MMA(0, 1, At, B1); PG8_BAR;
            PG8_LDA(At, 1, 1); PG8_STAGE(PG8_SA(1, 0), a3, voffA);
            PG8_BAR; PG8_WAIT_L(0); PG8_MMA(1, 0, At, B0); PG8_BAR; PG8_SCHED;
            PG8_STAGE(PG8_SB(1, 1), b3 + hstep, voffB);
            PG8_WAIT_V(6); PG8_BAR; PG8_MMA(1, 1, At, B1); PG8_BAR;
            }
        }
        if constexpr (ALIGN_EPI) { if (wr == 0) PG8_BAR; }
        if constexpr (!Epi::AFTER_DRAIN) { E(acc, cur, wr, wc, fr, fq); S.done(cur); }
        if (!has_next) break;
#pragma unroll
        for (int a = 0; a < 2; ++a)
#pragma unroll
            for (int b = 0; b < 2; ++b)
#pragma unroll
                for (int m = 0; m < 4; ++m)
#pragma unroll
                    for (int n = 0; n < 2; ++n) acc[a][b][m][n] = (f32x4){0.f, 0.f, 0.f, 0.f};
        cur = nxt; cA = nA; cB = nB; ++ui;
        if constexpr (ALIGN_EPI) { if (wr == 1) PG8_BAR; }
    }
    PG8_WAIT_V(0);
    if constexpr (!ALIGN_EPI) { if (wr == 0) PG8_BAR; }
    PG8_BAR;
    if constexpr (Epi::AFTER_DRAIN) { E.fused(acc, cur, wr, wc, fr, fq, lds, wid, lane); S.done(cur); }
#undef PG8_SA
#undef PG8_SB
#undef PG8_STAGE
#undef PG8_LDA
#undef PG8_LDB
#undef PG8_MMA
#undef PG8_WAIT_V
#undef PG8_WAIT_L
#undef PG8_BAR
#undef PG8_SCHED
}
}

constexpr size_t WS_QDC  = WS_RS;
constexpr size_t WS_SEGS = WS_RS + 32 * MB;
constexpr size_t WS_GSEG = WS_RS + 48 * MB;
constexpr size_t WS_SC   = WS_RS + 49 * MB;
DI void lds_barrier() { asm volatile("s_waitcnt lgkmcnt(0)" ::: "memory"); __builtin_amdgcn_s_barrier(); asm volatile("" ::: "memory"); }
DI float logsig(float x) { return fminf(x, 0.f) - __logf(1.f + __expf(-fabsf(x))); }

template <int DIR>
DI void ga_task(const Params& p, LAS unsigned char* lds, int tid, int lane, int wave, int task) {
    asm volatile("" : "+v"(tid), "+v"(lane));
    unsigned char* ws = p.ws;
    const bf16_t* Z = (const bf16_t*)(ws + WS_RZ);
    const float* AFB = (const float*)(ws + WS_AFB);
    LAS float* la = (LAS float*)lds;
    LAS float* part = (LAS float*)(lds + 17408);
    LAS float* gs = (LAS float*)(lds + 18432);
    LAS float* elb = (LAS float*)(lds + 18944);
    LAS float* wl = (LAS float*)(lds + 19968);
    LAS bf16_t* sL  = (LAS bf16_t*)(lds + 24064);
    LAS unsigned char* obuf = lds + 42496;
    const int c15 = lane & 15, g = lane >> 4;
    const int i = tid >> 3, dg = tid & 7, d0 = dg * 8;
#define TROW(r) ((r) * 72 + ((r) >> 3) * 8)
    constexpr int dir = DIR; const int h = (task >> 1) & 3, pb = (task >> 3) & 7, b = task >> 6;
    const int bhd = b * 8 + h * 2 + dir, sg = dir ? 7 - pb : pb;
    bf16_t* QDC = (bf16_t*)(ws + WS_QDC + (dir ? 16 : 0) * MB);
    bf16_t* OL = (bf16_t*)(ws + WS_RO + (dir ? 64 : 0) * MB);
    f32x4 S[4];
#pragma unroll
    for (int kt = 0; kt < 4; ++kt) S[kt] = (f32x4){0.f, 0.f, 0.f, 0.f};
    __syncthreads();
    for (int e = tid; e < 128 * 72 / 2; e += NTH) ((LAS unsigned*)sL)[e] = 0u;
    if (tid < 64) gs[tid] = 0.f;
    for (int e = tid; e < 1024; e += NTH) wl[e] = (dir ? p.in[9] : p.in[7])[(e >> 6) * 256 + h * 64 + (e & 63)];
    typedef short s16x4w __attribute__((ext_vector_type(4)));
    s16x4w wfr[2]; float bias[2];
    __syncthreads();
#pragma unroll
    for (int u = 0; u < 2; ++u) {
        const int d = 16 * (2 * (wave >> 2) + u) + c15;
        const u32x2 wp = {pk2(wl[(4 * g) * 64 + d], wl[(4 * g + 1) * 64 + d]), pk2(wl[(4 * g + 2) * 64 + d], wl[(4 * g + 3) * 64 + d])};
        wfr[u] = __builtin_bit_cast(s16x4w, wp);
        bias[u] = (dir ? p.in[10] : p.in[8])[h * 64 + d];
    }
    const int mt = wave & 3;
    f32x4 avn;
    { const int n0 = dir ? pb * 8 + 7 : pb * 8; avn = *(const f32x4*)(AFB + ((size_t)b * SEQ + n0 * 64 + 16 * mt + c15) * 32 + dir * 16 + 4 * g); }
#pragma unroll 1
    for (int ci = -1; ci < 8; ++ci) {
        const bool has_cur = ci >= 0, has_nxt = ci < 7;
        const int cx = ci + 1;
        const int nx = dir ? pb * 8 + 7 - cx : pb * 8 + cx, tokx = b * SEQ + nx * 64;
        const int nc = dir ? pb * 8 + 7 - ci : pb * 8 + ci, tokc = b * SEQ + nc * 64;
        LAS unsigned char* bx = obuf + (cx & 1) * 46464; LAS unsigned char* bc = obuf + (ci & 1) * 46464;
        LAS float* elx = elb + (cx & 1) * 128; LAS float* elc = elb + (ci & 1) * 128;
        u32x4 qv, kv, vvp[2]; f32x4 qa[4]; float lv[2][4];
        const int qrow = (task * 8 + (has_cur ? ci : 0)) * NWV + wave;
        if (ci > 0) {
#pragma unroll
            for (int kt = 0; kt < 4; ++kt) { const u32x2 w = {pk2(S[kt][0], S[kt][1]), pk2(S[kt][2], S[kt][3])}; *(LAS u32x2*)(sL + (16 * wave + c15) * 72 + 16 * kt + 4 * g) = w; }
        }
        if (has_cur) quant_load(p, qrow, lane, qa);
        if (has_nxt) {
            const size_t t = (size_t)tokx + i;
            qv = *(const u32x4*)(Z + t * ZW + h * 64 + d0); kv = *(const u32x4*)(Z + t * ZW + 256 + h * 64 + d0);
#pragma unroll
            for (int ps = 0; ps < 2; ++ps) { const int idx = tid + NTH * ps, vi = idx >> 4, ch = idx & 15; vvp[ps] = *(const u32x4*)(Z + ((size_t)tokx + vi) * ZW + 512 + h * 128 + ch * 8); }
            typedef short s16x4v __attribute__((ext_vector_type(4)));
            const u32x2 ap = {pk2(avn[0], avn[1]), pk2(avn[2], avn[3])};
            const s16x4v af = __builtin_bit_cast(s16x4v, ap);
            { const int c2 = cx < 7 ? cx + 1 : cx, n2 = dir ? pb * 8 + 7 - c2 : pb * 8 + c2; avn = *(const f32x4*)(AFB + ((size_t)b * SEQ + n2 * 64 + 16 * mt + c15) * 32 + dir * 16 + 4 * g); }
#pragma unroll
            for (int u = 0; u < 2; ++u) {
                const int d = 16 * (2 * (wave >> 2) + u) + c15;
                const f32x4 x = __builtin_amdgcn_mfma_f32_16x16x16bf16_1k(af, wfr[u], (f32x4){0.f, 0.f, 0.f, 0.f}, 0, 0, 0);
                float v0 = logsig(x[0] + bias[u]) * 0.0625f, v1 = logsig(x[1] + bias[u]) * 0.0625f, v2 = logsig(x[2] + bias[u]) * 0.0625f, v3 = logsig(x[3] + bias[u]) * 0.0625f;
                float T, T2, T3;
                if (dir == 0) {
                    v1 += v0; v2 += v1; v3 += v2; T = v3;
                    const float t1 = __shfl_up(T, 16); T2 = T + (g >= 1 ? t1 : 0.f);
                    const float t2 = __shfl_up(T2, 32); T3 = T2 + (g >= 2 ? t2 : 0.f);
                    if (g == 3) part[mt * 64 + d] = T3;
                } else {
                    v2 += v3; v1 += v2; v0 += v1; T = v0;
                    const float t1 = __shfl_down(T, 16); T2 = T + (g <= 2 ? t1 : 0.f);
                    const float t2 = __shfl_down(T2, 32); T3 = T2 + (g <= 1 ? t2 : 0.f);
                    if (g == 0) part[mt * 64 + d] = T3;
                }
                const float off = T3 - T;
                lv[u][0] = v0 + off; lv[u][1] = v1 + off; lv[u][2] = v2 + off; lv[u][3] = v3 + off;
            }
        }
        lds_barrier();
        if (has_nxt) {
#pragma unroll
            for (int u = 0; u < 2; ++u) {
                const int d = 16 * (2 * (wave >> 2) + u) + c15;
                float off = 0.f;
#pragma unroll
                for (int m2 = 0; m2 < 4; ++m2) { const bool take = dir ? (m2 > mt) : (m2 < mt); off += take ? part[m2 * 64 + d] : 0.f; }
#pragma unroll
                for (int r = 0; r < 4; ++r) la[(16 * mt + 4 * g + r) * 68 + d] = lv[u][r] + off;
                if (mt == (dir ? 0 : 3) && g == (dir ? 0 : 3)) {
                    const float tot = lv[u][dir ? 0 : 3] + off, gsum = gs[(cx & 1) * 64 + d];
                    elx[d] = __expf(tot); elx[64 + d] = __expf(gsum); gs[((cx + 1) & 1) * 64 + d] = gsum + tot;
                }
            }
        }
        lds_barrier();
        if (has_nxt) {
            LAS bf16_t* qdL = (LAS bf16_t*)bx; LAS bf16_t* kiL = (LAS bf16_t*)(bx + 9216); LAS bf16_t* keT = (LAS bf16_t*)(bx + 18432); LAS bf16_t* vT = (LAS bf16_t*)(bx + 27776);
            const size_t t = (size_t)tokx + i;
            float q[8], k[8];
#pragma unroll
            for (int e = 0; e < 4; ++e) { q[2 * e] = bflo(qv[e]); q[2 * e + 1] = bfhi(qv[e]); k[2 * e] = bflo(kv[e]); k[2 * e + 1] = bfhi(kv[e]); }
            float qd[8], ki[8], ke[8], qc[8];
#pragma unroll
            for (int e = 0; e < 8; ++e) {
                const float E = __expf(la[i * 68 + d0 + e]), R = __builtin_amdgcn_rcpf(E);
                qd[e] = q[e] * E; ki[e] = k[e] * R; ke[e] = ki[e] * elx[d0 + e]; qc[e] = qd[e] * elx[64 + d0 + e];
            }
            const u32x4 o1 = {pk2(qd[0], qd[1]), pk2(qd[2], qd[3]), pk2(qd[4], qd[5]), pk2(qd[6], qd[7])};
            const u32x4 o2 = {pk2(ki[0], ki[1]), pk2(ki[2], ki[3]), pk2(ki[4], ki[5]), pk2(ki[6], ki[7])};
            const u32x4 o3 = {pk2(qc[0], qc[1]), pk2(qc[2], qc[3]), pk2(qc[4], qc[5]), pk2(qc[6], qc[7])};
            *(LAS u32x4*)(qdL + i * 72 + d0) = o1; *(LAS u32x4*)(kiL + i * 72 + d0) = o2;
            *(u32x4*)(QDC + t * 256 + h * 64 + d0) = o3;
#pragma unroll
            for (int e = 0; e < 4; ++e) { const unsigned w = pk2(ke[2 * e], ke[2 * e + 1]); keT[TROW(d0 + 2 * e) + perm32(i)] = (bf16_t)(w & 0xFFFFu); keT[TROW(d0 + 2 * e + 1) + perm32(i)] = (bf16_t)(w >> 16); }
#pragma unroll
            for (int ps = 0; ps < 2; ++ps) {
                const int idx = tid + NTH * ps, vi = idx >> 4, ch = idx & 15;
#pragma unroll
                for (int e = 0; e < 4; ++e) { vT[TROW(ch * 8 + 2 * e) + perm32(vi)] = (bf16_t)(vvp[ps][e] & 0xFFFFu); vT[TROW(ch * 8 + 2 * e + 1) + perm32(vi)] = (bf16_t)(vvp[ps][e] >> 16); }
            }
        }
        if (has_cur) {
            const LAS bf16_t* qdL = (const LAS bf16_t*)bc; const LAS bf16_t* kiL = (const LAS bf16_t*)(bc + 9216); const LAS bf16_t* keT = (const LAS bf16_t*)(bc + 18432); const LAS bf16_t* vT = (const LAS bf16_t*)(bc + 27776);
            const int it = wave & 3, dvh = wave >> 2;
            bf16x8 qdb[2];
#pragma unroll
            for (int s = 0; s < 2; ++s) qdb[s] = *(const LAS bf16x8*)(qdL + (16 * it + c15) * 72 + 32 * s + 8 * g);
            f32x4 sc[4];
#pragma unroll
            for (int jt = 0; jt < 4; ++jt) {
                sc[jt] = (f32x4){0.f, 0.f, 0.f, 0.f};
#pragma unroll
                for (int s = 0; s < 2; ++s) sc[jt] = MFMA16(*(const LAS bf16x8*)(kiL + (16 * jt + c15) * 72 + 32 * s + 8 * g), qdb[s], sc[jt]);
                const int ii = 16 * it + c15;
#pragma unroll
                for (int r = 0; r < 4; ++r) { const int jj = 16 * jt + 4 * g + r; const bool keep = dir ? (jj > ii) : (jj <= ii); sc[jt][r] = keep ? sc[jt][r] : 0.f; }
            }
            const bf16x8 pa[2] = {pack8(sc[0], sc[1]), pack8(sc[2], sc[3])};
#pragma unroll
            for (int nt = 0; nt < 4; ++nt) {
                const int dvr = 64 * dvh + 16 * nt + c15;
                f32x4 o = (f32x4){0.f, 0.f, 0.f, 0.f};
#pragma unroll
                for (int s = 0; s < 2; ++s) {
                    o = MFMA16(*(const LAS bf16x8*)(vT + TROW(dvr) + 32 * s + 8 * g), pa[s], o);
                    o = MFMA16(*(const LAS bf16x8*)(sL + dvr * 72 + 32 * s + 8 * g), qdb[s], o);
                }
                const u32x2 w = {pk2(o[0], o[1]), pk2(o[2], o[3])};
                *(u32x2*)(OL + ((size_t)tokc + 16 * it + c15) * 512 + h * 128 + 64 * dvh + 16 * nt + 4 * g) = w;
            }
            bf16x8 vb[2];
#pragma unroll
            for (int s = 0; s < 2; ++s) vb[s] = *(const LAS bf16x8*)(vT + TROW(16 * wave + c15) + 32 * s + 8 * g);
#pragma unroll
            for (int kt = 0; kt < 4; ++kt) {
                const f32x4 gm = *(const LAS f32x4*)(elc + 16 * kt + 4 * g);
                f32x4 a = S[kt] * gm;
#pragma unroll
                for (int s = 0; s < 2; ++s) a = MFMA16(*(const LAS bf16x8*)(keT + TROW(16 * kt + c15) + 32 * s + 8 * g), vb[s], a);
                S[kt] = a;
            }
            quant_store(p, qrow, lane, qa);
        }
        lds_barrier();
    }
    {
        float* SEGS = (float*)(ws + WS_SEGS) + (size_t)(bhd * 8 + sg) * 64 * 128;
#pragma unroll
        for (int kt = 0; kt < 4; ++kt)
#pragma unroll
            for (int r = 0; r < 4; ++r) SEGS[(16 * kt + 4 * g + r) * 128 + 16 * wave + c15] = S[kt][r];
        if (tid < 64) ((float*)(ws + WS_GSEG))[(bhd * 8 + sg) * 64 + tid] = __expf(gs[tid]);
    }
}
#undef TROW

DI void phaseGA(const Params& p, LAS unsigned char* lds, int tid, int lane, int wave) {
    for (int task = blockIdx.x; task < 512; task += gridDim.x) { if (task & 1) ga_task<1>(p, lds, tid, lane, wave, task); else ga_task<0>(p, lds, tid, lane, wave, task); }
}

DI void phaseGB(const Params& p, int tid) {
    unsigned char* ws = p.ws;
    const float* SEGS = (const float*)(ws + WS_SEGS); const float* GSEG = (const float*)(ws + WS_GSEG); bf16_t* SC = (bf16_t*)(ws + WS_SC);
    for (int e = blockIdx.x * NTH + tid; e < 64 * 128 * 16; e += gridDim.x * NTH) {
        const int dv = e & 127, dk4 = (e >> 7) & 15, bhd = e >> 11;
        float c[4] = {0.f, 0.f, 0.f, 0.f};
        for (int sg = 0; sg < 8; ++sg) {
            const u32x2 w = {pk2(c[0], c[1]), pk2(c[2], c[3])};
            *(u32x2*)(SC + ((size_t)(bhd * 8 + sg) * 128 + dv) * 64 + 4 * dk4) = w;
            const f32x4 gm = *(const f32x4*)(GSEG + (bhd * 8 + sg) * 64 + 4 * dk4);
#pragma unroll
            for (int r = 0; r < 4; ++r) c[r] = gm[r] * c[r] + SEGS[((size_t)(bhd * 8 + sg) * 64 + 4 * dk4 + r) * 128 + dv];
        }
    }
}

DI void phase4a(const Params& p, LAS unsigned char* lds, int tid, int lane, int wave) {
    asm volatile("" : "+v"(tid), "+v"(lane));
    unsigned char* ws = p.ws;
    const bf16_t* Z = (const bf16_t*)(ws + WS_RZ);
    bf16_t* MIX = (bf16_t*)(ws + WS_RA);
    const bf16_t* OF = (const bf16_t*)(ws + WS_RO); const bf16_t* OB = (const bf16_t*)(ws + WS_RO + 64 * MB);
    const bf16_t* WP = (const bf16_t*)(ws + WS_WP);
    LAS bf16_t* pt = (LAS bf16_t*)lds;
    LAS unsigned char* at = lds + 81920;
    const int c15 = lane & 15, g = lane >> 4;
    for (int tile = blockIdx.x; tile < T / 64; tile += gridDim.x) {
        const int tok0 = tile * 64, s0 = tok0 & (SEQ - 1);
        __syncthreads();
#pragma unroll
        for (int ps = 0; ps < 10; ++ps) {
            const int idx = tid + NTH * ps, rr = idx >> 6, ch = idx & 63, sq = s0 - 8 + rr;
            u32x4 v = {0u, 0u, 0u, 0u};
            if (sq >= 0 && sq < SEQ) v = *(const u32x4*)(Z + ((size_t)tok0 - 8 + rr) * ZW + 1536 + ch * 8);
            *(LAS u32x4*)(pt + rr * 512 + ch * 8) = v;
        }
        {
            const int hh = wave >> 1, ih = wave & 1, bb = tok0 / SEQ, nn = s0 >> 6;
            f32x4 acc[8][2];
#pragma unroll
            for (int mt = 0; mt < 8; ++mt) { acc[mt][0] = (f32x4){0.f, 0.f, 0.f, 0.f}; acc[mt][1] = (f32x4){0.f, 0.f, 0.f, 0.f}; }
#pragma unroll
            for (int dir = 0; dir < 2; ++dir) {
                const int sg = dir ? 7 - (nn >> 3) : (nn >> 3), bhd = bb * 8 + hh * 2 + dir;
                const bf16_t* SCp = (const bf16_t*)(ws + WS_SC) + (size_t)(bhd * 8 + sg) * 128 * 64;
                const bf16_t* QCp = (const bf16_t*)(ws + WS_QDC + (dir ? 16 : 0) * MB) + ((size_t)tok0 + 32 * ih) * 256 + hh * 64;
                if (sg != 0)
#pragma unroll
                for (int s = 0; s < 2; ++s) {
                    const bf16x8 q0 = ld_frag16(QCp + (size_t)c15 * 256 + 32 * s + 8 * g), q1 = ld_frag16(QCp + (size_t)(16 + c15) * 256 + 32 * s + 8 * g);
#pragma unroll
                    for (int mt = 0; mt < 8; ++mt) {
                        const bf16x8 af = ld_frag16(SCp + (16 * mt + c15) * 64 + 32 * s + 8 * g);
                        acc[mt][0] = MFMA16(af, q0, acc[mt][0]); acc[mt][1] = MFMA16(af, q1, acc[mt][1]);
                    }
                }
            }
#pragma unroll
            for (int nt = 0; nt < 2; ++nt)
#pragma unroll
                for (int mt = 0; mt < 8; ++mt) { const f32x4 o = acc[mt][nt]; const u32x2 w = {pk2(o[0], o[1]), pk2(o[2], o[3])};
                    *(LAS u32x2*)(at + (32 * ih + 16 * nt + c15) * 1040 + (hh * 128 + 16 * mt + 4 * g) * 2) = w; }
        }
        __syncthreads();
        {
            const f32x4 gh0 = *(const f32x4*)(p.in[11] + 8 * lane), gh1 = *(const f32x4*)(p.in[11] + 8 * lane + 4);
#pragma unroll
            for (int hb = 0; hb < 2; ++hb) {
                u32x4 a[4], bq[4], rv[4], cv[4];
#pragma unroll
                for (int j = 0; j < 4; ++j) { const int tl = wave * 8 + hb * 4 + j; const size_t t = (size_t)tok0 + tl;
                    a[j] = *(const u32x4*)(OF + t * 512 + 8 * lane); bq[j] = *(const u32x4*)(OB + t * 512 + 8 * lane); rv[j] = *(const u32x4*)(Z + t * ZW + 1024 + 8 * lane);
                    cv[j] = *(const LAS u32x4*)(at + tl * 1040 + 16 * lane); }
#pragma unroll
                for (int j = 0; j < 4; ++j) { const size_t t = (size_t)tok0 + wave * 8 + hb * 4 + j;
                    float o[8], r[8];
#pragma unroll
                    for (int e = 0; e < 4; ++e) { o[2 * e] = bflo(a[j][e]) + bflo(bq[j][e]) + bflo(cv[j][e]); o[2 * e + 1] = bfhi(a[j][e]) + bfhi(bq[j][e]) + bfhi(cv[j][e]); r[2 * e] = bflo(rv[j][e]); r[2 * e + 1] = bfhi(rv[j][e]); }
                    float ss = 0.f;
#pragma unroll
                    for (int e = 0; e < 8; ++e) ss += o[e] * o[e];
                    ss += __shfl_xor(ss, 1); ss += __shfl_xor(ss, 2); ss += __shfl_xor(ss, 4); ss += __shfl_xor(ss, 8);
                    const float rstd = rsqrtf(ss * (1.f / 128.f) + EPS);
                    float y[8];
#pragma unroll
                    for (int e = 0; e < 8; ++e) { const float gg = e < 4 ? gh0[e] : gh1[e - 4]; y[e] = o[e] * rstd * gg * (r[e] / (1.f + __expf(-r[e]))); }
                    const u32x4 w = {pk2(y[0], y[1]), pk2(y[2], y[3]), pk2(y[4], y[5]), pk2(y[6], y[7])};
                    *(u32x4*)(MIX + t * D + 8 * lane) = w; }
            }
        }
        __syncthreads();
        {
            const int c = tid, gi = c >> 7, cc = c & 127, hw = 1 << gi;
            LAS unsigned char* ag = at + gi * 16384;
            const LAS bf16_t* pc = pt + c;
            if (s0 >= 8 && s0 + 64 + 8 <= SEQ) {
                const float inv = 0.5f / (float)hw;
                float sum = 0.f;
                for (int rr = 8 - hw; rr < 8 + hw; ++rr) sum += bflo((unsigned)pc[rr * 512]);
#pragma unroll 4
                for (int i = 0; i < 64; ++i) {
                    const float val = sum * inv - bflo((unsigned)pc[(i + 8) * 512]);
                    *(LAS bf16_t*)(ag + i * 256 + (((cc >> 3) ^ (i & 15)) * 16) + (cc & 7) * 2) = (bf16_t)(pk2(val, 0.f) & 0xFFFFu);
                    sum += bflo((unsigned)pc[(i + 8 + hw) * 512]) - bflo((unsigned)pc[(i + 8 - hw) * 512]);
                }
            } else {
                float sum = 0.f;
                {   const int lo = max(s0 - hw, 0), hi = min(s0 + hw, SEQ);
                    for (int rr = lo; rr < hi; ++rr) sum += bflo((unsigned)pc[(rr - s0 + 8) * 512]); }
#pragma unroll 4
                for (int i = 0; i < 64; ++i) {
                    const int sq = s0 + i, lo = max(sq - hw, 0), hi = min(sq + hw, SEQ);
                    const float val = sum * __builtin_amdgcn_rcpf((float)(hi - lo)) - bflo((unsigned)pc[(i + 8) * 512]);
                    *(LAS bf16_t*)(ag + i * 256 + (((cc >> 3) ^ (i & 15)) * 16) + (cc & 7) * 2) = (bf16_t)(pk2(val, 0.f) & 0xFFFFu);
                    if (sq + hw < SEQ) sum += bflo((unsigned)pc[(i + 8 + hw) * 512]);
                    if (sq - hw >= 0) sum -= bflo((unsigned)pc[(i + 8 - hw) * 512]);
                }
            }
        }
        __syncthreads();
        {
            const int gi = wave >> 1, dh = wave & 1;
            LAS unsigned char* ag = at + gi * 16384;
            f32x4 acc[4][4];
#pragma unroll
            for (int mt = 0; mt < 4; ++mt)
#pragma unroll
                for (int nt = 0; nt < 4; ++nt) acc[mt][nt] = (f32x4){0.f, 0.f, 0.f, 0.f};
#pragma unroll
            for (int s = 0; s < 4; ++s) {
                bf16x8 af[4];
#pragma unroll
                for (int mt = 0; mt < 4; ++mt) { const int row = mt * 16 + c15; af[mt] = *(const LAS bf16x8*)(ag + row * 256 + (((4 * s + g) ^ (row & 15)) * 16)); }
#pragma unroll
                for (int nt = 0; nt < 4; ++nt) {
                    const bf16x8 wf = ld_frag16(WP + (size_t)gi * 16384 + (dh * 64 + 16 * nt + c15) * 128 + 32 * s + 8 * g);
#pragma unroll
                    for (int mt = 0; mt < 4; ++mt) acc[mt][nt] = MFMA16(wf, af[mt], acc[mt][nt]);
                }
            }
#pragma unroll
            for (int nt = 0; nt < 4; ++nt) {
                const f32x4 ps = *(const f32x4*)(p.in[13] + gi * 128 + dh * 64 + 16 * nt + 4 * g);
#pragma unroll
                for (int mt = 0; mt < 4; ++mt) {
                    const f32x4 v = acc[mt][nt] * ps;
                    u32x2 w = {pk2(v[0], v[1]), pk2(v[2], v[3])};
                    *(u32x2*)(MIX + ((size_t)tok0 + mt * 16 + c15) * D + 512 + gi * 128 + dh * 64 + 16 * nt + 4 * g) = w;
                }
            }
        }
    }
}

DI void phase4c(const Params& p, LAS unsigned char* lds, int tid, int lane, int wave) {
    asm volatile("" : "+v"(tid), "+v"(lane));
    LAS float* lG = (LAS float*)lds; LAS float* lA = lG + 1024; LAS float* lB = lA + 1024; LAS float* lP = lB + 1024;
    const float* x = p.in[0]; const bf16_t* MIXO = (const bf16_t*)(p.ws + WS_RZ); bf16_t* H2 = (bf16_t*)(p.ws + WS_RA);
    for (int rt = blockIdx.x; rt < T / 128; rt += gridDim.x) {
        const int b = rt / 32;
        __syncthreads();
        for (int d = tid; d < 1024; d += NTH) { lG[d] = mod_at(p, b, 2048 + d); lA[d] = p.in[15][d] * (1.f + mod_at(p, b, 4096 + d)); lB[d] = mod_at(p, b, 3072 + d); lP[d] = p.in[5][d]; }
        __syncthreads();
        for (int r0 = wave; r0 < 128; r0 += 4 * NWV) {
            f32x4 m[4][4], xv[4][4];
#pragma unroll
            for (int u = 0; u < 4; ++u) {
                const size_t row = (size_t)rt * 128 + r0 + u * NWV;
                const u32x2* mr = (const u32x2*)(MIXO + row * D) + lane; const f32x4* xr = (const f32x4*)(x + row * D) + lane;
#pragma unroll
                for (int j = 0; j < 4; ++j) { const u32x2 mv = mr[64 * j]; m[u][j] = (f32x4){bflo(mv.x), bfhi(mv.x), bflo(mv.y), bfhi(mv.y)}; xv[u][j] = xr[64 * j]; }
            }
#pragma unroll
            for (int u = 0; u < 4; ++u) {
                const size_t row = (size_t)rt * 128 + r0 + u * NWV;
                float ss = 0.f;
#pragma unroll
                for (int j = 0; j < 4; ++j) ss += m[u][j][0] * m[u][j][0] + m[u][j][1] * m[u][j][1] + m[u][j][2] * m[u][j][2] + m[u][j][3] * m[u][j][3];
                const float rstd = rsqrtf(wave_sum(ss) * (1.f / D) + EPS);
                float s2 = 0.f;
#pragma unroll
                for (int j = 0; j < 4; ++j) {
                    const f32x4 gt = *(const LAS f32x4*)(lG + 4 * lane + 256 * j), pm = *(const LAS f32x4*)(lP + 4 * lane + 256 * j);
                    xv[u][j] = xv[u][j] + gt * (m[u][j] * rstd * pm);
                    s2 += xv[u][j][0] * xv[u][j][0] + xv[u][j][1] * xv[u][j][1] + xv[u][j][2] * xv[u][j][2] + xv[u][j][3] * xv[u][j][3];
                }
                const float rstd2 = rsqrtf(wave_sum(s2) * (1.f / D) + EPS);
                u32x2* orow = (u32x2*)((bf16_t*)(p.ws + WS_RO) + row * D) + lane; u32x2* hrow = (u32x2*)(H2 + row * D) + lane;
#pragma unroll
                for (int j = 0; j < 4; ++j) {
                    { const u32x2 xw = {pk2(xv[u][j][0], xv[u][j][1]), pk2(xv[u][j][2], xv[u][j][3])}; orow[64 * j] = xw; }
                    const f32x4 a = *(const LAS f32x4*)(lA + 4 * lane + 256 * j), bb = *(const LAS f32x4*)(lB + 4 * lane + 256 * j);
                    const f32x4 hv = xv[u][j] * rstd2 * a + bb;
                    u32x2 w = {pk2(hv[0], hv[1]), pk2(hv[2], hv[3])};
                    hrow[64 * j] = w;
                }
            }
        }
    }
}

DI int skey(float v, int idx, int mask) { int u = __float_as_int(v); u ^= (u >> 31) & 0x7FFFFFFF; return (u & ~mask) | idx; }
DI float sval(int k, int mask) { int u = k & ~mask; u ^= (u >> 31) & 0x7FFFFFFF; return __int_as_float(u); }
DI void cswap(int& a, int& b) { const int mx = max(a, b), mn = min(a, b); a = mx; b = mn; }
DI void sort16_desc(int (&a)[16]) {
    cswap(a[0], a[13]); cswap(a[1], a[12]); cswap(a[2], a[15]); cswap(a[3], a[14]); cswap(a[4], a[8]); cswap(a[5], a[6]); cswap(a[7], a[11]); cswap(a[9], a[10]);
    cswap(a[0], a[5]); cswap(a[1], a[7]); cswap(a[2], a[9]); cswap(a[3], a[4]); cswap(a[6], a[13]); cswap(a[8], a[14]); cswap(a[10], a[15]); cswap(a[11], a[12]);
    cswap(a[0], a[1]); cswap(a[2], a[3]); cswap(a[4], a[5]); cswap(a[6], a[8]); cswap(a[7], a[9]); cswap(a[10], a[11]); cswap(a[12], a[13]); cswap(a[14], a[15]);
    cswap(a[0], a[2]); cswap(a[1], a[3]); cswap(a[4], a[10]); cswap(a[5], a[11]); cswap(a[6], a[7]); cswap(a[8], a[9]); cswap(a[12], a[14]); cswap(a[13], a[15]);
    cswap(a[1], a[2]); cswap(a[3], a[12]); cswap(a[4], a[6]); cswap(a[5], a[7]); cswap(a[8], a[10]); cswap(a[9], a[11]); cswap(a[13], a[14]);
    cswap(a[1], a[4]); cswap(a[2], a[6]); cswap(a[5], a[8]); cswap(a[7], a[10]); cswap(a[9], a[13]); cswap(a[11], a[14]);
    cswap(a[2], a[4]); cswap(a[3], a[6]); cswap(a[9], a[12]); cswap(a[11], a[13]);
    cswap(a[3], a[5]); cswap(a[6], a[8]); cswap(a[7], a[9]); cswap(a[10], a[12]);
    cswap(a[3], a[4]); cswap(a[5], a[6]); cswap(a[7], a[8]); cswap(a[9], a[10]); cswap(a[11], a[12]);
    cswap(a[6], a[7]); cswap(a[8], a[9]);
}
DI void merge16_desc(int (&x)[16], const int (&y)[16]) {
#pragma unroll
    for (int i = 0; i < 16; ++i) x[i] = max(x[i], y[15 - i]);
#pragma unroll
    for (int j = 8; j > 0; j >>= 1) {
#pragma unroll
        for (int i = 0; i < 16; ++i) { const int l = i ^ j; if (l > i) cswap(x[i], x[l]); }
    }
}

DI void phase5b(const Params& p, LAS unsigned char* lds, int tid, int lane, int wave) {
    asm volatile("" : "+v"(tid), "+v"(lane));
    unsigned char* ws = p.ws;
    const bf16_t* Q2 = (const bf16_t*)(ws + WS_RZ);
    const bf16_t* SKB = (const bf16_t*)(ws + WS_SKB);
    int* EIDX = (int*)(ws + WS_RS);
    LAS unsigned char* tab = lds + tid * 32;
    LAS unsigned char* skl = lds + 16384;
    const int c31 = lane & 31, hi = lane >> 5;
    for (int btask = blockIdx.x; btask < 256; btask += gridDim.x) {
        const int h = btask & 7, tgc = btask >> 3;
        __syncthreads();
#pragma unroll
        for (int ps = 0; ps < 8; ++ps) {
            const int idx = tid + NTH * ps, row = idx >> 4, ch = idx & 15;
            const u32x4 v = *(const u32x4*)(SKB + ((size_t)h * 256 + row) * 128 + ch * 8);
            *(LAS u32x4*)(skl + row * 256 + ((ch ^ (row & 15)) * 16)) = v;
        }
        __syncthreads();
      for (int ti = 0; ti < 4; ++ti) {
        const int tg = tgc * 32 + wave * 4 + ti;
        const size_t tok = (size_t)tg * 32 + c31;
        int lst[2][16];
        bf16x8 bq[2][8];
#pragma unroll
        for (int pp = 0; pp < 2; ++pp) {
            const bf16_t* qp = Q2 + tok * 2048 + h * 256 + pp * 128 + 8 * hi;
            asm volatile("" : "+v"(qp));
#pragma unroll
            for (int ks = 0; ks < 8; ++ks) bq[pp][ks] = ld_frag16(qp + 16 * ks);
        }
#pragma unroll
        for (int pp = 0; pp < 2; ++pp) {
            int run[16];
#pragma unroll
            for (int r = 0; r < 16; ++r) run[r] = (int)0x80000000;
#pragma unroll 1
            for (int kt = 0; kt < 4; ++kt) {
                const LAS unsigned char* kb = skl + pp * 32768 + (32 * kt + c31) * 256;
                f32x16 acc;
#pragma unroll
                for (int r = 0; r < 16; ++r) acc[r] = 0.f;
#pragma unroll
                for (int ks = 0; ks < 8; ++ks) acc = MFMA32(*(const LAS bf16x8*)(kb + (((2 * ks + hi) ^ (c31 & 15)) * 16)), bq[pp][ks], acc);
                int cur[16];
#pragma unroll
                for (int r = 0; r < 16; ++r) cur[r] = skey(acc[r], 32 * kt + 8 * (r >> 2) + 4 * hi + (r & 3), 0x7F);
                sort16_desc(cur);
                merge16_desc(run, cur);
            }
            int oth[16];
#pragma unroll
            for (int r = 0; r < 16; ++r) oth[r] = __shfl_xor(run[r], 32);
            merge16_desc(run, oth);
#pragma unroll
            for (int r = 0; r < 16; ++r) lst[pp][r] = run[r];
        }
#pragma unroll
        for (int pp = 0; pp < 2; ++pp) {
            u32x4 w;
#pragma unroll
            for (int q = 0; q < 4; ++q) w[q] = (lst[pp][4 * q] & 0x7F) | ((lst[pp][4 * q + 1] & 0x7F) << 8) | ((lst[pp][4 * q + 2] & 0x7F) << 16) | ((lst[pp][4 * q + 3] & 0x7F) << 24);
            *(LAS u32x4*)(tab + 16 * pp) = w;
        }
        float va[16], vb[16];
#pragma unroll
        for (int r = 0; r < 16; ++r) { va[r] = sval(lst[0][r], 0x7F); vb[r] = sval(lst[1][r], 0x7F); }
        int cand[4][16];
        {
            int cnt = 0;
#pragma unroll
            for (int i = 0; i < 16; ++i)
#pragma unroll
                for (int j = 0; j < 16; ++j)
                    if ((i + 1) * (j + 1) <= 16) { cand[cnt >> 4][cnt & 15] = skey(va[i] + vb[j], (i << 4) | j, 0xFF); ++cnt; }
#pragma unroll
            for (int q = 50; q < 64; ++q) cand[q >> 4][q & 15] = (int)0x80000000;
        }
        sort16_desc(cand[0]); sort16_desc(cand[1]); sort16_desc(cand[2]); sort16_desc(cand[3]);
        merge16_desc(cand[0], cand[1]); merge16_desc(cand[2], cand[3]); merge16_desc(cand[0], cand[2]);
        asm volatile("s_waitcnt lgkmcnt(0)" ::: "memory");
        float sv[16]; int ex[16];
        const float mx = sval(cand[0][0], 0xFF);
        float sum = 0.f;
#pragma unroll
        for (int r = 0; r < 16; ++r) {
            const int ck = cand[0][r];
            const int i1 = tab[(ck >> 4) & 15], i2 = tab[16 + (ck & 15)];
            ex[r] = i1 * 128 + i2;
            sv[r] = __expf(sval(ck, 0xFF) - mx); sum += sv[r];
        }
        const float inv = 1.f / sum;
        unsigned* ep = (unsigned*)EIDX + tok * 128 + h * 16 + 8 * hi;
        unsigned pe[16];
#pragma unroll
        for (int r = 0; r < 16; ++r) pe[r] = (unsigned)ex[r] | (pk2(sv[r] * inv, 0.f) << 16);
        if (hi == 0) { *(u32x4*)ep = (u32x4){pe[0], pe[1], pe[2], pe[3]}; *(u32x4*)(ep + 4) = (u32x4){pe[4], pe[5], pe[6], pe[7]}; }
        else         { *(u32x4*)ep = (u32x4){pe[8], pe[9], pe[10], pe[11]}; *(u32x4*)(ep + 4) = (u32x4){pe[12], pe[13], pe[14], pe[15]}; }
      }
    }
}

template <int K> DI int swz_bcast(int v) { return __builtin_amdgcn_ds_swizzle(v, 0x10 | (K << 5)); }
template <int W> DI int swz_xor(int v) { return __builtin_amdgcn_ds_swizzle(v, 0x1F | (W << 10)); }
template <int K> struct IC { static constexpr int v = K; };
template <int N, int I = 0, class F> DI void static_for(F&& f) { if constexpr (I < N) { f(IC<I>{}); static_for<N, I + 1>(f); } }
DI float row16_sum(float v) {
    v += __builtin_bit_cast(float, __builtin_amdgcn_update_dpp(0, __builtin_bit_cast(int, v), 0xB1, 0xF, 0xF, true));
    v += __builtin_bit_cast(float, __builtin_amdgcn_update_dpp(0, __builtin_bit_cast(int, v), 0x4E, 0xF, 0xF, true));
    v += __builtin_bit_cast(float, __builtin_amdgcn_update_dpp(0, __builtin_bit_cast(int, v), 0x141, 0xF, 0xF, true));
    v += __builtin_bit_cast(float, __builtin_amdgcn_update_dpp(0, __builtin_bit_cast(int, v), 0x140, 0xF, 0xF, true));
    return v;
}
DI void phase6(const Params& p, LAS unsigned char* lds, int tid, int lane, int wave) {
    asm volatile("" : "+v"(tid), "+v"(lane));
    unsigned char* ws = p.ws;
    const bf16_t* H2 = (const bf16_t*)(ws + WS_RA);
    const unsigned char* UQ = ws + WS_UB; const unsigned char* VQ = ws + WS_VB;
    const float* SU = (const float*)(ws + WS_SU); const float* SV = (const float*)(ws + WS_SV);
    const unsigned* EIDX = (const unsigned*)(ws + WS_RS);
    LAS float* lG = (LAS float*)lds;
    const int q = lane >> 4, l16 = lane & 15;
    LAS int* le = (LAS int*)(lds + 4096 + wave * 6144) + q * 128;
    LAS float* lg = (LAS float*)(lds + 4096 + wave * 6144 + 2048) + q * 128;
    LAS float* lc = (LAS float*)(lds + 4096 + wave * 6144 + 4096) + q * 128;
    const unsigned qlo = q < 2 ? (0xFFFFu << (16 * q)) : 0u, qhi = q >= 2 ? (0xFFFFu << (16 * (q - 2))) : 0u;
    for (int rt = blockIdx.x; rt < T / 128; rt += gridDim.x) {
        const int b = rt / 32;
        __syncthreads();
        for (int d = tid; d < 1024; d += NTH) lG[d] = mod_at(p, b, 5120 + d) * p.in[16][d];
        __syncthreads();
#pragma unroll 1
        for (int rd = 0; rd < 4; ++rd) {
            __syncthreads();
            const size_t t = (size_t)rt * 128 + wave * 16 + rd * 4 + q;
            {
                int e[8]; float g[8];
#pragma unroll
                for (int r = 0; r < 8; ++r) { const unsigned pe = EIDX[t * 128 + r * 16 + l16]; e[r] = (int)(pe & 0xFFFFu); g[r] = bfhi(pe); }
                unsigned W[4] = {0u, 0u, 0u, 0u};
#pragma unroll
                for (int r = 0; r < 8; ++r) {
                    const int k = e[r] >> 10; const unsigned inc = 1u << (8 * (k & 3)); const int w = k >> 2;
                    W[0] += (w == 0) ? inc : 0u; W[1] += (w == 1) ? inc : 0u; W[2] += (w == 2) ? inc : 0u; W[3] += (w == 3) ? inc : 0u;
                }
                unsigned C[4];
                {
                    unsigned tot[4], exc[4];
#pragma unroll
                    for (int w = 0; w < 4; ++w) {
                        unsigned x = W[w];
                        x += (unsigned)__builtin_amdgcn_update_dpp(0, (int)x, 0x111, 0xF, 0xF, true);
                        x += (unsigned)__builtin_amdgcn_update_dpp(0, (int)x, 0x112, 0xF, 0xF, true);
                        x += (unsigned)__builtin_amdgcn_update_dpp(0, (int)x, 0x114, 0xF, 0xF, true);
                        x += (unsigned)__builtin_amdgcn_update_dpp(0, (int)x, 0x118, 0xF, 0xF, true);
                        exc[w] = x - W[w];
                        tot[w] = (unsigned)swz_bcast<15>((int)x);
                    }
                    unsigned carry = 0u;
#pragma unroll
                    for (int w = 0; w < 4; ++w) {
                        const unsigned P = tot[w] + (tot[w] << 8) + (tot[w] << 16) + (tot[w] << 24);
                        C[w] = (P - tot[w]) + carry * 0x01010101u + exc[w];
                        carry += P >> 24;
                    }
                }
#pragma unroll
                for (int r = 0; r < 8; ++r) {
                    const int k = e[r] >> 10; const int sh = 8 * (k & 3); const int w = k >> 2; const unsigned inc = 1u << sh;
                    const unsigned cw = (w == 0) ? C[0] : (w == 1) ? C[1] : (w == 2) ? C[2] : C[3];
                    const int pos = (int)((cw >> sh) & 0xFFu);
                    le[pos] = e[r]; lg[pos] = g[r];
                    C[0] += (w == 0) ? inc : 0u; C[1] += (w == 1) ? inc : 0u; C[2] += (w == 2) ? inc : 0u; C[3] += (w == 3) ? inc : 0u;
                }
                asm volatile("s_waitcnt lgkmcnt(0)" ::: "memory");
            }
            {
                int hq[16]; float ish;
                {
                    float hv[64]; float hm = 0.f;
#pragma unroll
                    for (int i = 0; i < 4; ++i) {
                        const u32x4 h0 = *(const u32x4*)(H2 + t * D + 256 * i + 16 * l16), h1 = *(const u32x4*)(H2 + t * D + 256 * i + 16 * l16 + 8);
#pragma unroll
                        for (int c = 0; c < 4; ++c) { hv[16 * i + 2 * c] = bflo(h0[c]); hv[16 * i + 2 * c + 1] = bfhi(h0[c]); hv[16 * i + 8 + 2 * c] = bflo(h1[c]); hv[16 * i + 8 + 2 * c + 1] = bfhi(h1[c]); }
                    }
#pragma unroll
                    for (int j = 0; j < 64; ++j) hm = fmaxf(hm, fabsf(hv[j]));
                    hm = fmaxf(hm, __builtin_bit_cast(float, __builtin_amdgcn_update_dpp(0, __builtin_bit_cast(int, hm), 0xB1, 0xF, 0xF, true)));
                    hm = fmaxf(hm, __builtin_bit_cast(float, __builtin_amdgcn_update_dpp(0, __builtin_bit_cast(int, hm), 0x4E, 0xF, 0xF, true)));
                    hm = fmaxf(hm, __builtin_bit_cast(float, __builtin_amdgcn_update_dpp(0, __builtin_bit_cast(int, hm), 0x141, 0xF, 0xF, true)));
                    hm = fmaxf(hm, __builtin_bit_cast(float, __builtin_amdgcn_update_dpp(0, __builtin_bit_cast(int, hm), 0x140, 0xF, 0xF, true)));
                    const float s8 = hm > 1e-30f ? 127.f / hm : 0.f; ish = hm * (1.f / 127.f);
#pragma unroll
                    for (int d = 0; d < 16; ++d) {
                        const int q0 = __float2int_rn(hv[4 * d] * s8), q1 = __float2int_rn(hv[4 * d + 1] * s8), q2 = __float2int_rn(hv[4 * d + 2] * s8), q3 = __float2int_rn(hv[4 * d + 3] * s8);
                        hq[d] = (int)((unsigned)(q0 & 0xFF) | ((unsigned)(q1 & 0xFF) << 8) | ((unsigned)(q2 & 0xFF) << 16) | ((unsigned)q3 << 24));
                    }
                }
                constexpr int UD = 4;
                u32x4 ub[UD][4];
                int evn = le[l16];
                static_for<UD>([&](auto kc) { constexpr int k = decltype(kc)::v; const unsigned char* up = UQ + (size_t)swz_bcast<k>(evn) * 1024 + 16 * l16;
#pragma unroll
                    for (int i = 0; i < 4; ++i) ub[k][i] = *(const u32x4*)(up + 256 * i); });
#pragma unroll 1
                for (int bt = 0; bt < 8; ++bt) {
                    if (bt) __syncthreads();
                    const int ev = evn; const float gv = lg[bt * 16 + l16];
                    evn = le[(bt < 7 ? bt + 1 : 7) * 16 + l16];
                    const float isu = SU[ev] * ish, isv = SV[ev];
                    int part[16];
                    static_for<16>([&](auto kc) {
                        constexpr int k = decltype(kc)::v, sl = k % UD;
                        int a = 0;
#pragma unroll
                        for (int i = 0; i < 4; ++i) {
                            const u32x4 u = ub[sl][i];
#pragma unroll
                            for (int c = 0; c < 4; ++c) a = __builtin_amdgcn_sdot4((int)u[c], hq[4 * i + c], a, false);
                        }
                        part[k] = a;
                        {
                            constexpr int kn = k + UD;
                            int idx; if constexpr (kn < 16) idx = swz_bcast<(kn & 15)>(ev); else idx = swz_bcast<(kn & 15)>(evn);
                            const unsigned char* up = UQ + (size_t)idx * 1024 + 16 * l16;
#pragma unroll
                            for (int i = 0; i < 4; ++i) ub[sl][i] = *(const u32x4*)(up + 256 * i);
                        }
                    });
                    static_for<4>([&](auto sc) {
                        constexpr int w = 8 >> decltype(sc)::v;
                        const bool up2 = (lane & w) != 0;
#pragma unroll
                        for (int e = 0; e < w; ++e) {
                            const int keep = up2 ? part[e + w] : part[e], send = up2 ? part[e] : part[e + w];
                            part[e] = keep + swz_xor<w>(send);
                        }
                    });
                    const float dot = (float)part[0] * isu;
                    lc[bt * 16 + l16] = gv * 0.5f * dot * (1.f + erff(dot * 0.70710678118654752f)) * isv;
                }
                asm volatile("s_waitcnt lgkmcnt(0)" ::: "memory");
            }
            __syncthreads();
            f32x2 y[32];
#pragma unroll
            for (int i = 0; i < 32; ++i) y[i] = (f32x2){0.f, 0.f};
            {
                constexpr int VD = 4;
                u32x4 vbuf[VD][4];
                int evn = le[l16];
                static_for<VD>([&](auto kc) { constexpr int k = decltype(kc)::v; const unsigned char* vp = VQ + (size_t)swz_bcast<k>(evn) * 1024 + 16 * l16;
#pragma unroll
                    for (int i = 0; i < 4; ++i) vbuf[k][i] = *(const u32x4*)(vp + 256 * i); });
#pragma unroll 1
                for (int bt = 0; bt < 8; ++bt) {
                    if (bt) __syncthreads();
                    const int ev = evn; const int cv = __float_as_int(lc[bt * 16 + l16]);
                    evn = le[(bt < 7 ? bt + 1 : 7) * 16 + l16];
                    static_for<16>([&](auto kc) {
                        constexpr int k = decltype(kc)::v, sl = k % VD;
                        const float cc = __int_as_float(swz_bcast<k>(cv));
                        const f32x2 c2 = (f32x2){cc, cc};
#pragma unroll
                        for (int i = 0; i < 4; ++i) {
                            const u32x4 v = vbuf[sl][i];
#pragma unroll
                            for (int c = 0; c < 4; ++c) {
                                const int w = (int)v[c];
                                y[8 * i + 2 * c] = __builtin_elementwise_fma(__builtin_amdgcn_cvt_pk_f32_fp8(w, false), c2, y[8 * i + 2 * c]);
                                y[8 * i + 2 * c + 1] = __builtin_elementwise_fma(__builtin_amdgcn_cvt_pk_f32_fp8(w, true), c2, y[8 * i + 2 * c + 1]);
                            }
                        }
                        {
                            constexpr int kn = k + VD;
                            int idx; if constexpr (kn < 16) idx = swz_bcast<(kn & 15)>(ev); else idx = swz_bcast<(kn & 15)>(evn);
                            const unsigned char* vp = VQ + (size_t)idx * 1024 + 16 * l16;
#pragma unroll
                            for (int i = 0; i < 4; ++i) vbuf[sl][i] = *(const u32x4*)(vp + 256 * i);
                        }
                    });
                }
            }
            float ss = 0.f;
#pragma unroll
            for (int i = 0; i < 32; ++i) ss += y[i].x * y[i].x + y[i].y * y[i].y;
            const float rstd = rsqrtf(row16_sum(ss) * (1.f / D) + EPS);
            float* orow = p.out + t * D;
#pragma unroll
            for (int i = 0; i < 4; ++i)
#pragma unroll
                for (int c = 0; c < 4; ++c) {
                    const int col = 256 * i + 16 * l16 + 4 * c;
                    const u32x2 xb = *(const u32x2*)((const bf16_t*)(ws + WS_RO) + t * D + col);
                    f32x4 xv = {bflo(xb.x), bfhi(xb.x), bflo(xb.y), bfhi(xb.y)};
                    const f32x4 gg = *(const LAS f32x4*)(lG + col);
                    xv[0] += gg[0] * y[8 * i + 2 * c].x * rstd; xv[1] += gg[1] * y[8 * i + 2 * c].y * rstd; xv[2] += gg[2] * y[8 * i + 2 * c + 1].x * rstd; xv[3] += gg[3] * y[8 * i + 2 * c + 1].y * rstd;
                    *(f32x4*)(orow + col) = xv;
                }
        }
    }
}


__global__ void __launch_bounds__(NTH) fwd_megakernel(Params p) {
    extern __shared__ __attribute__((aligned(16))) unsigned char lds_raw[];
    LAS unsigned char* lds = (LAS unsigned char*)lds_raw;
    const int tid = threadIdx.x, lane = tid & 63, wave = __builtin_amdgcn_readfirstlane(tid >> 6);
    volatile LAS unsigned* st = (volatile LAS unsigned*)(lds + LDS_BARW);
    if (tid == 0) { st[0] = 0u; st[1] = 0u; st[2] = 0u; st[3] = 0u; }
    __syncthreads();
    XcdBarrier bar = xcd_barrier_post((unsigned*)(p.ws + WS_CTL), st);
    unsigned char* ws = p.ws;

    phase0(p, lds, tid, lane, wave);
    xcd_barrier(bar);
    phase1(p, lds, tid, lane, wave);
    xcd_barrier(bar);
    { pg8::Gemm g{(const bf16_t*)(ws + WS_RA), (const bf16_t*)(ws + WS_WIN), T, ZW, D}; pg8::StaticOrder S; S.init(T, ZW, (int)gridDim.x, (int)blockIdx.x);
      pg8::EpiB16 e{(bf16_t*)(ws + WS_RZ), ZW}; pg8::gemm_phase<pg8::EpiB16, pg8::StaticOrder, true, true>(lds, g, S, e);
      EpiZ e2{(bf16_t*)(ws + WS_RZ), (float*)(ws + WS_AFB)}; gemm_phase(((const bf16_t*)(ws + WS_RA)), (const bf16_t*)(ws + WS_WIN), T, NIN, D, e2, lds, tid, lane, wave, 16); }
    xcd_barrier(bar);
    phaseGA(p, lds, tid, lane, wave);
    xcd_barrier(bar);
    phaseGB(p, tid);
    xcd_barrier(bar);
    phase4a(p, lds, tid, lane, wave);
    xcd_barrier(bar);
    { pg8::Gemm g{(const bf16_t*)(ws + WS_RA), (const bf16_t*)(ws + WS_WOUT), T, D, D}; pg8::StaticOrder S; S.init(T, D, (int)gridDim.x, (int)blockIdx.x);
      pg8::EpiB16 e{(bf16_t*)(ws + WS_RZ), D}; pg8::gemm_phase<pg8::EpiB16, pg8::StaticOrder, true, true>(lds, g, S, e); }
    xcd_barrier(bar);
    phase4c(p, lds, tid, lane, wave);
    xcd_barrier(bar);
    { pg8::Gemm g{(const bf16_t*)(ws + WS_RA), (const bf16_t*)(ws + WS_WQ), T, 2048, D}; pg8::StaticOrder S; S.init(T, 2048, (int)gridDim.x, (int)blockIdx.x);
      pg8::EpiB16 e{(bf16_t*)(ws + WS_RZ), 2048}; pg8::gemm_phase<pg8::EpiB16, pg8::StaticOrder, true, true>(lds, g, S, e); }
    xcd_barrier(bar);
    phase5b(p, lds, tid, lane, wave);
    xcd_barrier(bar);
    phase6(p, lds, tid, lane, wave);
}

extern "C" void kernel_launch(void* const* d_in, const int* in_sizes, int n_in, void* d_out, int out_size, void* d_ws, size_t ws_size, hipStream_t stream) {
    static int grid = 0;
    if (grid == 0) {
        if (n_in != 21 || out_size != T * D || ws_size < WS_END) { fprintf(stderr, "kernel_launch: unexpected shapes (n_in %d out %d ws %zu need %zu)\n", n_in, out_size, ws_size, (size_t)WS_END); grid = -1; return; }
        int dev = 0, cus = 0, per_cu = 0;
        hipGetDevice(&dev); hipDeviceGetAttribute(&cus, hipDeviceAttributeMultiprocessorCount, dev);
        hipFuncSetAttribute((const void*)fwd_megakernel, hipFuncAttributeMaxDynamicSharedMemorySize, LDS_BYTES);
        hipOccupancyMaxActiveBlocksPerMultiprocessor(&per_cu, (const void*)fwd_megakernel, NTH, LDS_BYTES);
        (void)hipGetLastError();
        if (per_cu < 1) fprintf(stderr, "kernel_launch: occupancy query says %d blocks per CU\n", per_cu);
        grid = cus;
    }
    if (grid < 0) return;
    hipMemsetAsync((char*)d_ws + WS_CTL, 0, 64 * 1024, stream);
    Params p{};
    for (int i = 0; i < 21; ++i) p.in[i] = (const float*)d_in[i];
    p.out = (float*)d_out; p.ws = (unsigned char*)d_ws;
    hipLaunchKernelGGL(fwd_megakernel, dim3(grid), dim3(NTH), LDS_BYTES, stream, p);
}
```

```cpp
#include <hip/hip_runtime.h>
#include <cstdio>
#include <cstdint>

#define DI __device__ __forceinline__
#define LAS __attribute__((address_space(3)))
typedef unsigned short bf16_t;
typedef short bf16x8 __attribute__((ext_vector_type(8)));
typedef float f32x4 __attribute__((ext_vector_type(4)));
typedef float f32x2 __attribute__((ext_vector_type(2)));
typedef float f32x16 __attribute__((ext_vector_type(16)));
typedef unsigned u32x4 __attribute__((ext_vector_type(4)));
typedef unsigned u32x2 __attribute__((ext_vector_type(2)));
typedef __bf16 bf16x2v __attribute__((ext_vector_type(2)));

constexpr int T = 32768, D = 1024, SEQ = 4096, NB = 8;
constexpr int NTH = 512, NWV = 8;
constexpr int ZW = 2048;
constexpr int NIN = 2176;
constexpr float EPS = 1e-6f;

constexpr size_t MB = 1024 * 1024;
constexpr size_t WS_CTL   = 0;
constexpr size_t WS_MODP  = 64 * 1024;
constexpr size_t WS_WIN   = WS_MODP + 8 * 8 * 6144 * 4;
constexpr size_t WS_WOUT  = WS_WIN + (size_t)NIN * 1024 * 2;
constexpr size_t WS_WQ    = WS_WOUT + 1024 * 1024 * 2;
constexpr size_t WS_SKB   = WS_WQ + 2048 * 1024 * 2;
constexpr size_t WS_WP    = WS_SKB + 16 * 128 * 128 * 2;
constexpr size_t WS_AFB   = WS_WP + 4 * 128 * 128 * 2;
constexpr size_t WS_UB    = WS_AFB + (size_t)T * 32 * 4;
constexpr size_t WS_VB    = WS_UB + 32 * MB;
constexpr size_t WS_SU    = WS_UB + 16 * MB, WS_SV = WS_VB + 16 * MB;
constexpr size_t WS_RA    = WS_VB + 32 * MB;
constexpr size_t WS_RZ    = WS_RA + 64 * MB;
constexpr size_t WS_RS    = WS_RZ + 128 * MB;
constexpr size_t WS_RO    = WS_RS + 6 * 16 * MB + 1 * MB;
constexpr size_t WS_END   = WS_RO + 128 * MB;
static_assert(WS_END <= 512 * MB, "workspace too large");

struct Params { const float* in[21]; float* out; unsigned char* ws; };

DI unsigned pk2(float a, float b) { f32x2 f = {a, b}; bf16x2v h = __builtin_convertvector(f, bf16x2v); return __builtin_bit_cast(unsigned, h); }
DI float dot2bf(unsigned a, unsigned b, float c) { return __builtin_amdgcn_fdot2_f32_bf16(__builtin_bit_cast(bf16x2v, a), __builtin_bit_cast(bf16x2v, b), c, false); }
DI float bflo(unsigned u) { return __uint_as_float(u << 16); }
DI float bfhi(unsigned u) { return __uint_as_float(u & 0xFFFF0000u); }
DI float wave_sum(float v) {
#pragma unroll
    for (int o = 1; o < 64; o <<= 1) v += __shfl_xor(v, o);
    return v;
}
DI bf16x8 ld_frag16(const bf16_t* p) { return __builtin_bit_cast(bf16x8, *(const u32x4*)p); }
DI bf16x8 ld_frag_perm(const bf16_t* p, int g) {
    const u32x2 lo = *(const u32x2*)(p + 4 * g), hi = *(const u32x2*)(p + 16 + 4 * g);
    u32x4 v = {lo.x, lo.y, hi.x, hi.y}; return __builtin_bit_cast(bf16x8, v);
}
DI int perm32(int k) { return (k & ~31) | (((k >> 2) & 3) << 3) | (((k >> 4) & 1) << 2) | (k & 3); }
DI bf16x8 pack8(const f32x4& a, const f32x4& b) { u32x4 v = {pk2(a[0], a[1]), pk2(a[2], a[3]), pk2(b[0], b[1]), pk2(b[2], b[3])}; return __builtin_bit_cast(bf16x8, v); }
#define MFMA16(a, b, c) __builtin_amdgcn_mfma_f32_16x16x32_bf16((a), (b), (c), 0, 0, 0)
#define MFMA32(a, b, c) __builtin_amdgcn_mfma_f32_32x32x16_bf16((a), (b), (c), 0, 0, 0)

#define XB_TMO      128
#define XB_XCNT(j)  (256  + 64 * (j))
#define XB_XSUB(j)  (1280 + 64 * (j))
#define XB_XGEN(j)  (2304 + 64 * (j))
#define XB_TOP      3328
#define XB_TOPGEN   3392
#define XCD_BAR_WORDS 3456
#define XB_SPIN_CAP (1u << 22)
DI unsigned xb_ld(unsigned* p)              { return __hip_atomic_load(p, __ATOMIC_RELAXED, __HIP_MEMORY_SCOPE_AGENT); }
DI unsigned xb_add(unsigned* p, unsigned v) { return __hip_atomic_fetch_add(p, v, __ATOMIC_RELAXED, __HIP_MEMORY_SCOPE_AGENT); }
DI unsigned xb_xcc_id() { return (unsigned)__builtin_amdgcn_s_getreg((3 << 11) | 20) & 0xFu; }
#define XB_SPIN(cond, bar) do { unsigned _sp = 0; while (cond) { __builtin_amdgcn_s_sleep(1); \
    if ((++_sp & 255u) == 0u) { if (xb_ld(&(bar)[XB_TMO])) break; if (_sp > XB_SPIN_CAP) { atomicAdd(&(bar)[XB_TMO], 1u); break; } } } } while (0)
struct XcdBarrier { unsigned* bar; unsigned x; volatile LAS unsigned* st; };
DI XcdBarrier xcd_barrier_post(unsigned* bar, volatile LAS unsigned* st) {
    XcdBarrier b; b.bar = bar; b.x = xb_xcc_id(); b.st = st;
    if (threadIdx.x == 0) (void)xb_add(&bar[XB_XCNT(b.x)], 1u);
    return b;
}
DI void xcd_barrier_complete(unsigned* bar, unsigned x, unsigned& nloc, unsigned& nx) {
    const unsigned G = gridDim.x * gridDim.y * gridDim.z;
    unsigned sum, cnt, mine, sp = 0u;
    for (;;) {
        sum = 0u; cnt = 0u; mine = 0u;
#pragma unroll
        for (unsigned j = 0; j < 16; ++j) { const unsigned c = xb_ld(&bar[XB_XCNT(j)]); sum += c; cnt += (c > 0u) ? 1u : 0u; mine = (j == x) ? c : mine; }
        if (sum == G) break;
        __builtin_amdgcn_s_sleep(1);
        if ((++sp & 255u) == 0u) { if (xb_ld(&bar[XB_TMO])) break; if (sp > XB_SPIN_CAP) { atomicAdd(&bar[XB_TMO], 1u); break; } }
    }
    nloc = mine > 0u ? mine : 1u; nx = cnt > 0u ? cnt : 1u;
}
DI void xcd_barrier(const XcdBarrier& b) {
    asm volatile("s_waitcnt vmcnt(0)" ::: "memory");
    __syncthreads();
    if (threadIdx.x == 0) {
        unsigned* bar = b.bar;
        __builtin_amdgcn_s_waitcnt(0);
        unsigned nloc = b.st[0], nx = b.st[1];
        if (nloc == 0u) { xcd_barrier_complete(bar, b.x, nloc, nx); b.st[0] = nloc; b.st[1] = nx; }
        const unsigned old = xb_add(&bar[XB_XSUB(b.x)], 1u);
        const unsigned gen = old / nloc;
        if (old + 1u == (gen + 1u) * nloc) {
            __builtin_amdgcn_fence(__ATOMIC_RELEASE, "agent");
            asm volatile("s_waitcnt vmcnt(0)" ::: "memory");
            const unsigned og = xb_add(&bar[XB_TOP], 1u);
            const unsigned tg = og / nx;
            if (og + 1u == (tg + 1u) * nx) xb_add(&bar[XB_TOPGEN], 1u);
            else XB_SPIN(xb_ld(&bar[XB_TOPGEN]) == tg, bar);
            __builtin_amdgcn_fence(__ATOMIC_ACQUIRE, "agent");
            xb_add(&bar[XB_XGEN(b.x)], 1u);
            asm volatile("s_waitcnt vmcnt(0)" ::: "memory");
        } else {
            XB_SPIN(xb_ld(&bar[XB_XGEN(b.x)]) == gen, bar);
            __builtin_amdgcn_fence(__ATOMIC_ACQUIRE, "agent");
            asm volatile("s_waitcnt vmcnt(0)" ::: "memory");
        }
    }
    __syncthreads();
}

constexpr int LDS_BYTES = 152 * 1024;
constexpr int LDS_BARW = LDS_BYTES - 16;

DI void p0_transpose_item(const float* W, int ldw, int K, bf16_t* WT, int dst_row0, int src_col0, float scale, bool zero, LAS float* scr, int kb, int lane) {
    const int k0 = 64 * kb;
#pragma unroll 8
    for (int i = 0; i < 32; ++i) { const int kk = 2 * i + (lane >> 5); scr[kk * 33 + (lane & 31)] = zero ? 0.f : W[(size_t)(k0 + kk) * ldw + src_col0 + (lane & 31)] * scale; }
    asm volatile("s_waitcnt lgkmcnt(0)" ::: "memory");
    const int c = lane & 7;
#pragma unroll
    for (int j = 0; j < 4; ++j) { const int n = (lane >> 3) + 8 * j; const LAS float* s = scr + (8 * c) * 33 + n;
        u32x4 o; o.x = pk2(s[0 * 33], s[1 * 33]); o.y = pk2(s[2 * 33], s[3 * 33]); o.z = pk2(s[4 * 33], s[5 * 33]); o.w = pk2(s[6 * 33], s[7 * 33]);
        *(u32x4*)(WT + (size_t)(dst_row0 + n) * K + k0 + 8 * c) = o; }
    asm volatile("s_waitcnt lgkmcnt(0)" ::: "memory");
}

DI void phase0(const Params& p, LAS unsigned char* lds, int tid, int lane, int wave) {
    asm volatile("" : "+v"(tid), "+v"(lane));
    unsigned char* ws = p.ws;
    LAS float* sl = (LAS float*)lds;
    LAS float* scr = (LAS float*)(lds + 32768 + wave * 8448);
    const float* c = p.in[1];
    for (int e = tid; e < 8192; e += NTH) { const int b = e >> 10, k = e & 1023; const float v = c[e]; sl[k * 8 + b] = v / (1.f + __expf(-v)); }
    __syncthreads();
    const int gw = wave * gridDim.x + blockIdx.x, NGW = gridDim.x * NWV;
    constexpr int I_MOD = 768, I_WIN = 16 * 68, I_WOUT = 16 * 32, I_WQ = 16 * 64, I_WP = 32;
    constexpr int NITEMS = I_MOD + I_WIN + I_WOUT + I_WQ + I_WP;
    for (int it = gw; it < NITEMS; it += NGW) {
        int r = it;
        if (r < I_MOD) {
            const int cg = r % 96, ks = r / 96, n = cg * 64 + lane, k0 = ks * 128;
            const float* W = p.in[2] + (size_t)k0 * 6144 + n;
            float acc[8];
#pragma unroll
            for (int b = 0; b < 8; ++b) acc[b] = 0.f;
#pragma unroll 8
            for (int k = 0; k < 128; ++k) {
                const float w = W[(size_t)k * 6144];
                const f32x4 s0 = *(const LAS f32x4*)(sl + (k0 + k) * 8), s1 = *(const LAS f32x4*)(sl + (k0 + k) * 8 + 4);
                acc[0] += s0[0] * w; acc[1] += s0[1] * w; acc[2] += s0[2] * w; acc[3] += s0[3] * w;
                acc[4] += s1[0] * w; acc[5] += s1[1] * w; acc[6] += s1[2] * w; acc[7] += s1[3] * w;
            }
            float* mp = (float*)(ws + WS_MODP) + (size_t)ks * 8 * 6144 + n;
#pragma unroll
            for (int b = 0; b < 8; ++b) mp[b * 6144] = acc[b];
            continue;
        }
        r -= I_MOD;
        if (r < I_WIN) {
            const int kb = r / 68, nb = r % 68, n0 = nb * 32;
            int src; bool zero = false; float scale = 1.f;
            if (n0 < 1536) { src = n0; if (n0 < 256) scale = 0.125f; } else if (n0 < 2048) src = n0 + 32; else if (n0 < 2080) src = 1536 + (n0 - 2048); else { src = 0; zero = true; }
            p0_transpose_item(p.in[6], 2080, 1024, (bf16_t*)(ws + WS_WIN), n0, src, scale, zero, scr, kb, lane);
            continue;
        }
        r -= I_WIN;
        if (r < I_WOUT) { p0_transpose_item(p.in[14], 1024, 1024, (bf16_t*)(ws + WS_WOUT), (r % 32) * 32, (r % 32) * 32, 1.f, false, scr, r / 32, lane); continue; }
        r -= I_WOUT;
        if (r < I_WQ) { p0_transpose_item(p.in[17], 2048, 1024, (bf16_t*)(ws + WS_WQ), (r % 64) * 32, (r % 64) * 32, 1.f, false, scr, r / 64, lane); continue; }
        r -= I_WQ;
        { const int g = r >> 3, kb = (r >> 2) & 1, nb = r & 3;
          p0_transpose_item(p.in[12] + g * 16384, 128, 128, (bf16_t*)(ws + WS_WP) + g * 16384, nb * 32, nb * 32, 1.f, false, scr, kb, lane); }
    }
    const size_t gt = (size_t)blockIdx.x * NTH + tid, NGT = (size_t)gridDim.x * NTH;
    constexpr size_t NSK = (size_t)16 * 128 * 128 / 8;
    for (size_t j = gt; j < NSK; j += NGT) {
        const float* src = p.in[18]; bf16_t* dst = (bf16_t*)(ws + WS_SKB);
        const f32x4 a = *(const f32x4*)(src + j * 8), b = *(const f32x4*)(src + j * 8 + 4);
        u32x4 o = {pk2(a[0], a[1]), pk2(a[2], a[3]), pk2(b[0], b[1]), pk2(b[2], b[3])};
        *(u32x4*)(dst + j * 8) = o;
    }
}

DI void quant_load(const Params& p, int row, int lane, f32x4 (&v)[4]) {
    const int tb = row >> 14, e = row & 16383;
    const float* src = (tb ? p.in[20] : p.in[19]) + (size_t)e * D + 16 * lane;
#pragma unroll
    for (int q = 0; q < 4; ++q) v[q] = *(const f32x4*)(src + 4 * q);
}
DI void quant_store(const Params& p, int row, int lane, const f32x4 (&v)[4]) {
    unsigned char* ws = p.ws;
    const int tb = row >> 14, e = row & 16383;
    float m = 0.f;
#pragma unroll
    for (int q = 0; q < 4; ++q) m = fmaxf(m, fmaxf(fmaxf(fabsf(v[q][0]), fabsf(v[q][1])), fmaxf(fabsf(v[q][2]), fabsf(v[q][3]))));
#pragma unroll
    for (int o = 1; o < 64; o <<= 1) m = fmaxf(m, __shfl_xor(m, o));
    int ex = (int)((__float_as_uint(m) >> 23) & 0xFFu) - 127;
    if (m < 1e-30f) ex = 7;
    const float sc = __uint_as_float((unsigned)(127 + 7 - ex) << 23), isc = __uint_as_float((unsigned)(127 - 7 + ex) << 23);
    u32x4 o;
    if (tb) {
#pragma unroll
        for (int q = 0; q < 4; ++q) { int w = 0; w = __builtin_amdgcn_cvt_pk_fp8_f32(v[q][0] * sc, v[q][1] * sc, w, false); w = __builtin_amdgcn_cvt_pk_fp8_f32(v[q][2] * sc, v[q][3] * sc, w, true); o[q] = (unsigned)w; }
        if (lane == 0) ((float*)(ws + WS_SV))[e] = isc;
    } else {
        const float s8 = m > 1e-30f ? 127.f / m : 0.f;
#pragma unroll
        for (int q = 0; q < 4; ++q) {
            const int q0 = __float2int_rn(v[q][0] * s8), q1 = __float2int_rn(v[q][1] * s8), q2 = __float2int_rn(v[q][2] * s8), q3 = __float2int_rn(v[q][3] * s8);
            o[q] = (unsigned)(q0 & 0xFF) | ((unsigned)(q1 & 0xFF) << 8) | ((unsigned)(q2 & 0xFF) << 16) | ((unsigned)q3 << 24);
        }
        if (lane == 0) ((float*)(ws + WS_SU))[e] = m * (1.f / 127.f);
    }
    *(u32x4*)(ws + (tb ? WS_VB : WS_UB) + (size_t)e * 1024 + 16 * lane) = o;
}

DI float mod_at(const Params& p, int b, int n) {
    const float* mp = (const float*)(p.ws + WS_MODP) + (size_t)b * 6144 + n;
    float s = p.in[3][n];
#pragma unroll
    for (int ks = 0; ks < 8; ++ks) s += mp[(size_t)ks * 8 * 6144];
    return s;
}

DI void phase1(const Params& p, LAS unsigned char* lds, int tid, int lane, int wave) {
    asm volatile("" : "+v"(tid), "+v"(lane));
    LAS float* lA = (LAS float*)lds; LAS float* lB = lA + 1024;
    const float* x = p.in[0]; bf16_t* H = (bf16_t*)(p.ws + WS_RA);
    for (int rt = blockIdx.x; rt < T / 128; rt += gridDim.x) {
        const int b = rt / 32;
        __syncthreads();
        for (int d = tid; d < 1024; d += NTH) { lA[d] = p.in[4][d] * (1.f + mod_at(p, b, 1024 + d)); lB[d] = mod_at(p, b, d); }
        __syncthreads();
        for (int r0 = wave; r0 < 128; r0 += 4 * NWV) {
            f32x4 v[4][4];
#pragma unroll
            for (int u = 0; u < 4; ++u) { const f32x4* xr = (const f32x4*)(x + ((size_t)rt * 128 + r0 + u * NWV) * D) + lane;
#pragma unroll
                for (int j = 0; j < 4; ++j) v[u][j] = xr[64 * j]; }
#pragma unroll
            for (int u = 0; u < 4; ++u) {
                const size_t row = (size_t)rt * 128 + r0 + u * NWV;
                float ss = 0.f;
#pragma unroll
                for (int j = 0; j < 4; ++j) ss += v[u][j][0] * v[u][j][0] + v[u][j][1] * v[u][j][1] + v[u][j][2] * v[u][j][2] + v[u][j][3] * v[u][j][3];
                const float rstd = rsqrtf(wave_sum(ss) * (1.f / D) + EPS);
                u32x2* o = (u32x2*)(H + row * D) + lane;
#pragma unroll
                for (int j = 0; j < 4; ++j) {
                    const f32x4 a = *(const LAS f32x4*)(lA + 4 * lane + 256 * j), bb = *(const LAS f32x4*)(lB + 4 * lane + 256 * j);
                    u32x2 w = {pk2(v[u][j][0] * rstd * a[0] + bb[0], v[u][j][1] * rstd * a[1] + bb[1]), pk2(v[u][j][2] * rstd * a[2] + bb[2], v[u][j][3] * rstd * a[3] + bb[3])};
                    o[64 * j] = w;
                }
            }
        }
    }
}

DI void afb_tail(const bf16_t* H, const bf16_t* Wt, float* AFB, LAS unsigned char* lds, int tid, int lane, int wave) {
    constexpr int WSTR = 2064;
    asm volatile("" : "+v"(tid), "+v"(lane));
    const int c15 = lane & 15, g = lane >> 4;
    __syncthreads();
#pragma unroll
    for (int ps = 0; ps < 8; ++ps) { const int idx = tid + NTH * ps, n = idx >> 7, ch = idx & 127; *(LAS u32x4*)(lds + n * WSTR + ch * 16) = *(const u32x4*)(Wt + (size_t)n * D + ch * 8); }
    __syncthreads();
    LAS const unsigned char* w0 = lds + c15 * WSTR + 32 * g;
    for (int tile = blockIdx.x; tile < T / 128; tile += gridDim.x) {
        const size_t row = (size_t)tile * 128 + wave * 16 + c15;
        const bf16_t* ap = H + row * D + 16 * g;
        f32x4 acc0 = {0.f, 0.f, 0.f, 0.f}, acc1 = {0.f, 0.f, 0.f, 0.f};
#pragma unroll 1
        for (int hf = 0; hf < 2; ++hf) {
            bf16x8 a[16];
#pragma unroll
            for (int t = 0; t < 8; ++t) { a[2 * t] = *(const bf16x8*)(ap + 512 * hf + 64 * t); a[2 * t + 1] = *(const bf16x8*)(ap + 512 * hf + 64 * t + 8); }
            LAS const unsigned char* wp = w0 + 1024 * hf;
#pragma unroll
            for (int t = 0; t < 8; ++t)
#pragma unroll
                for (int e = 0; e < 2; ++e) {
                    acc0 = MFMA16(*(LAS const bf16x8*)(wp + 128 * t + 16 * e), a[2 * t + e], acc0);
                    acc1 = MFMA16(*(LAS const bf16x8*)(wp + 16 * WSTR + 128 * t + 16 * e), a[2 * t + e], acc1);
                }
        }
        *(f32x4*)(AFB + row * 32 + 4 * g) = acc0;
        *(f32x4*)(AFB + row * 32 + 16 + 4 * g) = acc1;
    }
}

namespace pg8 {
#define PG8_LAS __attribute__((address_space(3)))
constexpr int BM = 256, BK = 64, HALF = 128, HTB = HALF * BK * 2  , STAGE_BYTES = 8 * HTB, NXCD = 8, WGM = 1;

__host__ __device__ __forceinline__ int lds_byte(int r, int c) { const int st = (r >> 4) * 2 + (c >> 5), rr = r & 15, cc = c & 31, ob = rr * 64 + cc * 2; return st * 1024 + (ob ^ (((ob >> 9) & 1) << 5)); }
__host__ __device__ __forceinline__ void stage_rc(int b, int& R, int& C) { const int st = b / 1024, sb = b % 1024, swz = sb ^ (((sb >> 9) & 1) << 5); R = (st >> 1) * 16 + swz / 64; C = (st & 1) * 32 + (swz % 64) / 2; }
__host__ __device__ __forceinline__ int perm32(int rho) { const int n = rho >> 4, i = rho & 15; return 8 * (i >> 2) + 4 * n + (i & 3); }

struct Unit { int pm, pn; };
struct Gemm { const bf16_t* A; const bf16_t* Bt; int M, N, K; };

struct StaticOrder {
    int nM, nN, nwg, G, c;
    __host__ __device__ void init(int M, int N, int G_, int c_) { nM = M / BM; nN = N / BM; nwg = nM * nN; G = G_; c = c_; }
    __host__ __device__ bool next(int i, Unit& u) const {
        const long L = (long)i * G + c; if (L >= nwg) return false;
        int wgid = (int)L; { const int q = nwg / NXCD, r = nwg % NXCD, xcd = wgid % NXCD, off = wgid / NXCD; wgid = (xcd < r ? xcd * (q + 1) : r * (q + 1) + (xcd - r) * q) + off; }
        const int nig = WGM * nN, gid = wgid / nig, fm = gid * WGM, gsz = (nM - fm) < WGM ? (nM - fm) : WGM;
        u.pm = fm + ((wgid % nig) % gsz); u.pn = (wgid % nig) / gsz; return true;
    }
    __device__ __forceinline__ void a_ready(const Unit&) const {}
    __device__ __forceinline__ void done(const Unit&) const {}
};

struct EpiB16 {
    static constexpr bool PERM = true, AFTER_DRAIN = false;
    bf16_t* O; int ldc;
    __device__ __forceinline__ void operator()(const f32x4 (&acc)[2][2][4][2], const Unit& u, int wr, int wc, int fr, int fq) const {
#pragma unroll
        for (int ai = 0; ai < 2; ++ai)
#pragma unroll
            for (int m = 0; m < 4; ++m) { bf16_t* rowp = O + (size_t)(u.pm * BM + ai * HALF + wr * 64 + m * 16 + fr) * ldc + u.pn * BM + wc * 32 + 8 * fq;
#pragma unroll
                for (int bj = 0; bj < 2; ++bj) { const f32x4 v0 = acc[ai][bj][m][0], v1 = acc[ai][bj][m][1];
                    u32x4 w; w.x = ::pk2(v0[0], v0[1]); w.y = ::pk2(v0[2], v0[3]); w.z = ::pk2(v1[0], v1[1]); w.w = ::pk2(v1[2], v1[3]);
                    *(u32x4*)(rowp + bj * HALF) = w; } }
    }
};
struct EpiF {
    static constexpr bool PERM = false, AFTER_DRAIN = false;
    float* O; int ldc;
    __device__ __forceinline__ void operator()(const f32x4 (&acc)[2][2][4][2], const Unit& u, int wr, int wc, int fr, int fq) const {
#pragma unroll
        for (int ai = 0; ai < 2; ++ai)
#pragma unroll
            for (int m = 0; m < 4; ++m) { float* rowp = O + (size_t)(u.pm * BM + ai * HALF + wr * 64 + m * 16 + fr) * ldc + u.pn * BM + wc * 32 + 4 * fq;
#pragma unroll
                for (int bj = 0; bj < 2; ++bj)
#pragma unroll
                    for (int n = 0; n < 2; ++n) *(f32x4*)(rowp + bj * HALF + 16 * n) = acc[ai][bj][m][n]; }
    }
};
template <class Epi, class Sched, bool ALIGN_EPI = false, bool SP2 = false>
__device__ __forceinline__ void gemm_phase(PG8_LAS unsigned char* lds, const Gemm g, const Sched& S, const Epi& E) {
    int tid = threadIdx.x; asm volatile("" : "+v"(tid));
    const int wid = __builtin_amdgcn_readfirstlane(tid >> 6), lane = tid & 63, wr = wid >> 2, wc = wid & 3, fr = lane & 15, fq = lane >> 4;
    const int K = g.K, nt = K / BK;
    unsigned voffA[2], voffB[2];
#pragma unroll
    for (int i = 0; i < 2; ++i) { int R, C; stage_rc(tid * 16 + i * 8192, R, C); const int Rb = Epi::PERM ? ((R & ~31) + perm32(R & 31)) : R;
        voffA[i] = (unsigned)(R * K + C) * 2u; voffB[i] = (unsigned)(Rb * K + C) * 2u; }
    const size_t kstep = (size_t)(BK * 2);
    const size_t hstep = (size_t)HALF * K * 2;
    const size_t tstep = 2 * hstep;
    const unsigned ldsw = (unsigned)wid * 1024u;
    const int aoff = lds_byte(wr * 64 + fr, fq * 8), boff = lds_byte(wc * 32 + fr, fq * 8);
#define PG8_SA(b, h) (((b) * 2 + (h)) * HTB)
#define PG8_SB(b, h) ((4 + (b) * 2 + (h)) * HTB)
#define PG8_STAGE(bufoff, gbase, voff) do { _Pragma("unroll") for (int _i = 0; _i < 2; ++_i) \
        __builtin_amdgcn_global_load_lds((const unsigned*)((const char*)(gbase) + (voff)[_i]), (PG8_LAS unsigned*)(lds + (bufoff) + ldsw + _i * 8192), 16, 0, 0); } while (0)
#define PG8_LDA(dst, b, h) do { _Pragma("unroll") for (int m = 0; m < 4; ++m) _Pragma("unroll") for (int k = 0; k < 2; ++k) dst[m][k] = *(const PG8_LAS bf16x8*)(lds + PG8_SA(b, h) + aoff + m * 2048 + k * 1024); } while (0)
#define PG8_LDB(dst, b, h) do { _Pragma("unroll") for (int n = 0; n < 2; ++n) _Pragma("unroll") for (int k = 0; k < 2; ++k) dst[n][k] = *(const PG8_LAS bf16x8*)(lds + PG8_SB(b, h) + boff + n * 2048 + k * 1024); } while (0)
#define PG8_MMA(ai, bj, At, Bt) do { __builtin_amdgcn_s_setprio(1); _Pragma("unroll") for (int m = 0; m < 4; ++m) _Pragma("unroll") for (int n = 0; n < 2; ++n) _Pragma("unroll") for (int k = 0; k < 2; ++k) \
        acc[ai][bj][m][n] = __builtin_amdgcn_mfma_f32_16x16x32_bf16(Bt[n][k], At[m][k], acc[ai][bj][m][n], 0, 0, 0); __builtin_amdgcn_s_setprio(0); } while (0)
#define PG8_WAIT_V(n) asm volatile("s_waitcnt vmcnt(" #n ")" ::: "memory")
#define PG8_WAIT_L(n) asm volatile("s_waitcnt lgkmcnt(" #n ")" ::: "memory")
#define PG8_BAR __builtin_amdgcn_s_barrier()
#define PG8_SCHED __builtin_amdgcn_sched_barrier(0)
    Unit cur, nxt; int ui = 0;
    if (!S.next(0, cur)) return;
    f32x4 acc[2][2][4][2];
#pragma unroll
    for (int a = 0; a < 2; ++a)
#pragma unroll
        for (int b = 0; b < 2; ++b)
#pragma unroll
            for (int m = 0; m < 4; ++m)
#pragma unroll
                for (int n = 0; n < 2; ++n) acc[a][b][m][n] = (f32x4){0.f, 0.f, 0.f, 0.f};
    bf16x8 At[4][2], B0[2][2], B1[2][2];
    const char* cA = (const char*)g.A + (size_t)cur.pm * tstep; const char* cB = (const char*)g.Bt + (size_t)cur.pn * tstep;
    S.a_ready(cur);
    if constexpr (SP2) {
        PG8_STAGE(PG8_SB(0, 0), cB, voffB); PG8_STAGE(PG8_SB(0, 1), cB + hstep, voffB); PG8_STAGE(PG8_SA(0, 0), cA, voffA); PG8_STAGE(PG8_SA(0, 1), cA + hstep, voffA);
        if (wr == 1) PG8_BAR;
        PG8_WAIT_V(2); PG8_BAR;
        PG8_STAGE(PG8_SB(1, 0), cB + kstep, voffB); PG8_STAGE(PG8_SA(1, 0), cA + kstep, voffA); PG8_STAGE(PG8_SB(1, 1), cB + hstep + kstep, voffB);
        PG8_WAIT_V(6); PG8_BAR;
    } else {
        PG8_STAGE(PG8_SB(0, 0), cB, voffB); PG8_STAGE(PG8_SA(0, 0), cA, voffA); PG8_STAGE(PG8_SB(0, 1), cB + hstep, voffB); PG8_STAGE(PG8_SA(0, 1), cA + hstep, voffA);
        if (wr == 1) PG8_BAR;
        PG8_WAIT_V(4); PG8_BAR;
        PG8_STAGE(PG8_SB(1, 0), cB + kstep, voffB); PG8_STAGE(PG8_SA(1, 0), cA + kstep, voffA); PG8_STAGE(PG8_SB(1, 1), cB + hstep + kstep, voffB);
        PG8_WAIT_V(6); PG8_BAR;
    }
    for (;;) {
        const bool has_next = S.next(ui + 1, nxt);
        const char* nA = has_next ? (const char*)g.A + (size_t)nxt.pm * tstep : cA; const char* nB = has_next ? (const char*)g.Bt + (size_t)nxt.pn * tstep : cB;
        for (int t = 0; t < nt; t += 2) {
            const bool last = (t == nt - 2);
            const char* a1 = cA + (size_t)(t + 1) * kstep;
            const char* a2 = last ? nA : cA + (size_t)(t + 2) * kstep; const char* b2 = last ? nB : cB + (size_t)(t + 2) * kstep;
            const char* a3 = a2 + kstep; const char* b3 = b2 + kstep;
            if (last && has_next) S.a_ready(nxt);
            if constexpr (SP2) {
            PG8_LDB(B0, 0, 0); PG8_LDB(B1, 0, 1); PG8_SCHED; PG8_LDA(At, 0, 0); PG8_STAGE(PG8_SA(1, 1), a1 + hstep, voffA);
            PG8_WAIT_V(8); PG8_WAIT_L(0); PG8_BAR; PG8_MMA(0, 0, At, B0); PG8_MMA(0, 1, At, B1); PG8_BAR; PG8_SCHED;
            PG8_LDA(At, 0, 1); PG8_STAGE(PG8_SB(0, 0), b2, voffB); PG8_STAGE(PG8_SB(0, 1), b2 + hstep, voffB); PG8_STAGE(PG8_SA(0, 0), a2, voffA);
            PG8_WAIT_V(8); PG8_WAIT_L(0); PG8_BAR; PG8_MMA(1, 0, At, B0); PG8_MMA(1, 1, At, B1); PG8_BAR; PG8_SCHED;
            PG8_LDB(B0, 1, 0); PG8_LDB(B1, 1, 1); PG8_SCHED; PG8_LDA(At, 1, 0); PG8_STAGE(PG8_SA(0, 1), a2 + hstep, voffA);
            PG8_WAIT_V(8); PG8_WAIT_L(0); PG8_BAR; PG8_MMA(0, 0, At, B0); PG8_MMA(0, 1, At, B1); PG8_BAR; PG8_SCHED;
            PG8_LDA(At, 1, 1); PG8_STAGE(PG8_SB(1, 0), b3, voffB); PG8_STAGE(PG8_SB(1, 1), b3 + hstep, voffB); PG8_STAGE(PG8_SA(1, 0), a3, voffA);
            PG8_WAIT_V(8); PG8_WAIT_L(0); PG8_BAR; PG8_MMA(1, 0, At, B0); PG8_MMA(1, 1, At, B1); PG8_BAR; PG8_SCHED;
            } else {
            PG8_LDB(B0, 0, 0); PG8_SCHED; PG8_LDA(At, 0, 0); PG8_STAGE(PG8_SA(1, 1), a1 + hstep, voffA);
            PG8_WAIT_L(8); PG8_BAR; PG8_WAIT_L(0); PG8_MMA(0, 0, At, B0); PG8_BAR; PG8_SCHED;
            PG8_LDB(B1, 0, 1); PG8_STAGE(PG8_SB(0, 0), b2, voffB);
            PG8_BAR; PG8_WAIT_L(0); PG8_MMA(0, 1, At, B1); PG8_BAR;
            PG8_LDA(At, 0, 1); PG8_STAGE(PG8_SA(0, 0), a2, voffA);
            PG8_BAR; PG8_WAIT_L(0); PG8_MMA(1, 0, At, B0); PG8_BAR; PG8_SCHED;
            PG8_STAGE(PG8_SB(0, 1), b2 + hstep, voffB);
            PG8_WAIT_V(6); PG8_BAR; PG8_MMA(1, 1, At, B1); PG8_BAR;
            PG8_LDB(B0, 1, 0); PG8_SCHED; PG8_LDA(At, 1, 0); PG8_STAGE(PG8_SA(0, 1), a2 + hstep, voffA);
            PG8_WAIT_L(8); PG8_BAR; PG8_WAIT_L(0); PG8_MMA(0, 0, At, B0); PG8_BAR; PG8_SCHED;
            PG8_LDB(B1, 1, 1); PG8_STAGE(PG8_SB(1, 0), b3, voffB);
            PG8_BAR; PG8_WAIT_L(0); PG8_MMA(0, 1, At, B1); PG8_BAR;
            PG8_LDA(At, 1, 1); PG8_STAGE(PG8_SA(1, 0), a3, voffA);
            PG8_BAR; PG8_WAIT_L(0); PG8_MMA(1, 0, At, B0); PG8_BAR; PG8_SCHED;
            PG8_STAGE(PG8_SB(1, 1), b3 + hstep, voffB);
            PG8_WAIT_V(6); PG8_BAR; PG8_MMA(1, 1, At, B1); PG8_BAR;
            }
        }
        if constexpr (ALIGN_EPI) { if (wr == 0) PG8_BAR; }
        if constexpr (!Epi::AFTER_DRAIN) { E(acc, cur, wr, wc, fr, fq); S.done(cur); }
        if (!has_next) break;
#pragma unroll
        for (int a = 0; a < 2; ++a)
#pragma unroll
            for (int b = 0; b < 2; ++b)
#pragma unroll
                for (int m = 0; m < 4; ++m)
#pragma unroll
                    for (int n = 0; n < 2; ++n) acc[a][b][m][n] = (f32x4){0.f, 0.f, 0.f, 0.f};
        cur = nxt; cA = nA; cB = nB; ++ui;
        if constexpr (ALIGN_EPI) { if (wr == 1) PG8_BAR; }
    }
    PG8_WAIT_V(0);
    if constexpr (!ALIGN_EPI) { if (wr == 0) PG8_BAR; }
    PG8_BAR;
    if constexpr (Epi::AFTER_DRAIN) { E.fused(acc, cur, wr, wc, fr, fq, lds, wid, lane); S.done(cur); }
#undef PG8_SA
#undef PG8_SB
#undef PG8_STAGE
#undef PG8_LDA
#undef PG8_LDB
#undef PG8_MMA
#undef PG8_WAIT_V
#undef PG8_WAIT_L
#undef PG8_BAR
#undef PG8_SCHED
}
}

constexpr size_t WS_QDC  = WS_RS;
constexpr size_t WS_SEGS = WS_RS + 32 * MB;
constexpr size_t WS_GSEG = WS_RS + 48 * MB;
constexpr size_t WS_SC   = WS_RS + 49 * MB;
DI void lds_barrier() { asm volatile("s_waitcnt lgkmcnt(0)" ::: "memory"); __builtin_amdgcn_s_barrier(); asm volatile("" ::: "memory"); }
DI float logsig(float x) { return fminf(x, 0.f) - __logf(1.f + __expf(-fabsf(x))); }

template <int DIR>
DI void ga_task(const Params& p, LAS unsigned char* lds, int tid, int lane, int wave, int task) {
    asm volatile("" : "+v"(tid), "+v"(lane));
    unsigned char* ws = p.ws;
    const bf16_t* Z = (const bf16_t*)(ws + WS_RZ);
    const float* AFB = (const float*)(ws + WS_AFB);
    LAS float* la = (LAS float*)lds;
    LAS float* part = (LAS float*)(lds + 17408);
    LAS float* gs = (LAS float*)(lds + 18432);
    LAS float* elb = (LAS float*)(lds + 18944);
    LAS float* wl = (LAS float*)(lds + 19968);
    LAS bf16_t* sL  = (LAS bf16_t*)(lds + 24064);
    LAS unsigned char* obuf = lds + 42496;
    const int c15 = lane & 15, g = lane >> 4;
    const int i = tid >> 3, dg = tid & 7, d0 = dg * 8;
#define TROW(r) ((r) * 72 + ((r) >> 3) * 8)
    constexpr int dir = DIR; const int h = (task >> 1) & 3, pb = (task >> 3) & 7, b = task >> 6;
    const int bhd = b * 8 + h * 2 + dir, sg = dir ? 7 - pb : pb;
    bf16_t* QDC = (bf16_t*)(ws + WS_QDC + (dir ? 16 : 0) * MB);
    bf16_t* OL = (bf16_t*)(ws + WS_RO + (dir ? 64 : 0) * MB);
    f32x4 S[4];
#pragma unroll
    for (int kt = 0; kt < 4; ++kt) S[kt] = (f32x4){0.f, 0.f, 0.f, 0.f};
    __syncthreads();
    for (int e = tid; e < 128 * 72 / 2; e += NTH) ((LAS unsigned*)sL)[e] = 0u;
    if (tid < 64) gs[tid] = 0.f;
    for (int e = tid; e < 1024; e += NTH) wl[e] = (dir ? p.in[9] : p.in[7])[(e >> 6) * 256 + h * 64 + (e & 63)];
    typedef short s16x4w __attribute__((ext_vector_type(4)));
    s16x4w wfr[2]; float bias[2];
    __syncthreads();
#pragma unroll
    for (int u = 0; u < 2; ++u) {
        const int d = 16 * (2 * (wave >> 2) + u) + c15;
        const u32x2 wp = {pk2(wl[(4 * g) * 64 + d], wl[(4 * g + 1) * 64 + d]), pk2(wl[(4 * g + 2) * 64 + d], wl[(4 * g + 3) * 64 + d])};
        wfr[u] = __builtin_bit_cast(s16x4w, wp);
        bias[u] = (dir ? p.in[10] : p.in[8])[h * 64 + d];
    }
    const int mt = wave & 3;
    f32x4 avn;
    { const int n0 = dir ? pb * 8 + 7 : pb * 8; avn = *(const f32x4*)(AFB + ((size_t)b * SEQ + n0 * 64 + 16 * mt + c15) * 32 + dir * 16 + 4 * g); }
#pragma unroll 1
    for (int ci = -1; ci < 8; ++ci) {
        const bool has_cur = ci >= 0, has_nxt = ci < 7;
        const int cx = ci + 1;
        const int nx = dir ? pb * 8 + 7 - cx : pb * 8 + cx, tokx = b * SEQ + nx * 64;
        const int nc = dir ? pb * 8 + 7 - ci : pb * 8 + ci, tokc = b * SEQ + nc * 64;
        LAS unsigned char* bx = obuf + (cx & 1) * 46464; LAS unsigned char* bc = obuf + (ci & 1) * 46464;
        LAS float* elx = elb + (cx & 1) * 128; LAS float* elc = elb + (ci & 1) * 128;
        u32x4 qv, kv, vvp[2]; f32x4 qa[4]; float lv[2][4];
        const int qrow = (task * 8 + (has_cur ? ci : 0)) * NWV + wave;
        if (ci > 0) {
#pragma unroll
            for (int kt = 0; kt < 4; ++kt) { const u32x2 w = {pk2(S[kt][0], S[kt][1]), pk2(S[kt][2], S[kt][3])}; *(LAS u32x2*)(sL + (16 * wave + c15) * 72 + 16 * kt + 4 * g) = w; }
        }
        if (has_cur) quant_load(p, qrow, lane, qa);
        if (has_nxt) {
            const size_t t = (size_t)tokx + i;
            qv = *(const u32x4*)(Z + t * ZW + h * 64 + d0); kv = *(const u32x4*)(Z + t * ZW + 256 + h * 64 + d0);
#pragma unroll
            for (int ps = 0; ps < 2; ++ps) { const int idx = tid + NTH * ps, vi = idx >> 4, ch = idx & 15; vvp[ps] = *(const u32x4*)(Z + ((size_t)tokx + vi) * ZW + 512 + h * 128 + ch * 8); }
            typedef short s16x4v __attribute__((ext_vector_type(4)));
            const u32x2 ap = {pk2(avn[0], avn[1]), pk2(avn[2], avn[3])};
            const s16x4v af = __builtin_bit_cast(s16x4v, ap);
            { const int c2 = cx < 7 ? cx + 1 : cx, n2 = dir ? pb * 8 + 7 - c2 : pb * 8 + c2; avn = *(const f32x4*)(AFB + ((size_t)b * SEQ + n2 * 64 + 16 * mt + c15) * 32 + dir * 16 + 4 * g); }
#pragma unroll
            for (int u = 0; u < 2; ++u) {
                const int d = 16 * (2 * (wave >> 2) + u) + c15;
                const f32x4 x = __builtin_amdgcn_mfma_f32_16x16x16bf16_1k(af, wfr[u], (f32x4){0.f, 0.f, 0.f, 0.f}, 0, 0, 0);
                float v0 = logsig(x[0] + bias[u]) * 0.0625f, v1 = logsig(x[1] + bias[u]) * 0.0625f, v2 = logsig(x[2] + bias[u]) * 0.0625f, v3 = logsig(x[3] + bias[u]) * 0.0625f;
                float T, T2, T3;
                if (dir == 0) {
                    v1 += v0; v2 += v1; v3 += v2; T = v3;
                    const float t1 = __shfl_up(T, 16); T2 = T + (g >= 1 ? t1 : 0.f);
                    const float t2 = __shfl_up(T2, 32); T3 = T2 + (g >= 2 ? t2 : 0.f);
                    if (g == 3) part[mt * 64 + d] = T3;
                } else {
                    v2 += v3; v1 += v2; v0 += v1; T = v0;
                    const float t1 = __shfl_down(T, 16); T2 = T + (g <= 2 ? t1 : 0.f);
                    const float t2 = __shfl_down(T2, 32); T3 = T2 + (g <= 1 ? t2 : 0.f);
                    if (g == 0) part[mt * 64 + d] = T3;
                }
                const float off = T3 - T;
                lv[u][0] = v0 + off; lv[u][1] = v1 + off; lv[u][2] = v2 + off; lv[u][3] = v3 + off;
            }
        }
        lds_barrier();
        if (has_nxt) {
#pragma unroll
            for (int u = 0; u < 2; ++u) {
                const int d = 16 * (2 * (wave >> 2) + u) + c15;
                float off = 0.f;
#pragma unroll
                for (int m2 = 0; m2 < 4; ++m2) { const bool take = dir ? (m2 > mt) : (m2 < mt); off += take ? part[m2 * 64 + d] : 0.f; }
#pragma unroll
                for (int r = 0; r < 4; ++r) la[(16 * mt + 4 * g + r) * 68 + d] = lv[u][r] + off;
                if (mt == (dir ? 0 : 3) && g == (dir ? 0 : 3)) {
                    const float tot = lv[u][dir ? 0 : 3] + off, gsum = gs[(cx & 1) * 64 + d];
                    elx[d] = __expf(tot); elx[64 + d] = __expf(gsum); gs[((cx + 1) & 1) * 64 + d] = gsum + tot;
                }
            }
        }
        lds_barrier();
        if (has_nxt) {
            LAS bf16_t* qdL = (LAS bf16_t*)bx; LAS bf16_t* kiL = (LAS bf16_t*)(bx + 9216); LAS bf16_t* keT = (LAS bf16_t*)(bx + 18432); LAS bf16_t* vT = (LAS bf16_t*)(bx + 27776);
            const size_t t = (size_t)tokx + i;
            float q[8], k[8];
#pragma unroll
            for (int e = 0; e < 4; ++e) { q[2 * e] = bflo(qv[e]); q[2 * e + 1] = bfhi(qv[e]); k[2 * e] = bflo(kv[e]); k[2 * e + 1] = bfhi(kv[e]); }
            float qd[8], ki[8], ke[8], qc[8];
#pragma unroll
            for (int e = 0; e < 8; ++e) {
                const float E = __expf(la[i * 68 + d0 + e]), R = __builtin_amdgcn_rcpf(E);
                qd[e] = q[e] * E; ki[e] = k[e] * R; ke[e] = ki[e] * elx[d0 + e]; qc[e] = qd[e] * elx[64 + d0 + e];
            }
            const u32x4 o1 = {pk2(qd[0], qd[1]), pk2(qd[2], qd[3]), pk2(qd[4], qd[5]), pk2(qd[6], qd[7])};
            const u32x4 o2 = {pk2(ki[0], ki[1]), pk2(ki[2], ki[3]), pk2(ki[4], ki[5]), pk2(ki[6], ki[7])};
            const u32x4 o3 = {pk2(qc[0], qc[1]), pk2(qc[2], qc[3]), pk2(qc[4], qc[5]), pk2(qc[6], qc[7])};
            *(LAS u32x4*)(qdL + i * 72 + d0) = o1; *(LAS u32x4*)(kiL + i * 72 + d0) = o2;
            *(u32x4*)(QDC + t * 256 + h * 64 + d0) = o3;
#pragma unroll
            for (int e = 0; e < 4; ++e) { const unsigned w = pk2(ke[2 * e], ke[2 * e + 1]); keT[TROW(d0 + 2 * e) + perm32(i)] = (bf16_t)(w & 0xFFFFu); keT[TROW(d0 + 2 * e + 1) + perm32(i)] = (bf16_t)(w >> 16); }
#pragma unroll
            for (int ps = 0; ps < 2; ++ps) {
                const int idx = tid + NTH * ps, vi = idx >> 4, ch = idx & 15;
#pragma unroll
                for (int e = 0; e < 4; ++e) { vT[TROW(ch * 8 + 2 * e) + perm32(vi)] = (bf16_t)(vvp[ps][e] & 0xFFFFu); vT[TROW(ch * 8 + 2 * e + 1) + perm32(vi)] = (bf16_t)(vvp[ps][e] >> 16); }
            }
        }
        if (has_cur) {
            const LAS bf16_t* qdL = (const LAS bf16_t*)bc; const LAS bf16_t* kiL = (const LAS bf16_t*)(bc + 9216); const LAS bf16_t* keT = (const LAS bf16_t*)(bc + 18432); const LAS bf16_t* vT = (const LAS bf16_t*)(bc + 27776);
            const int it = wave & 3, dvh = wave >> 2;
            bf16x8 qdb[2];
#pragma unroll
            for (int s = 0; s < 2; ++s) qdb[s] = *(const LAS bf16x8*)(qdL + (16 * it + c15) * 72 + 32 * s + 8 * g);
            f32x4 sc[4];
#pragma unroll
            for (int jt = 0; jt < 4; ++jt) {
                sc[jt] = (f32x4){0.f, 0.f, 0.f, 0.f};
#pragma unroll
                for (int s = 0; s < 2; ++s) sc[jt] = MFMA16(*(const LAS bf16x8*)(kiL + (16 * jt + c15) * 72 + 32 * s + 8 * g), qdb[s], sc[jt]);
                const int ii = 16 * it + c15;
#pragma unroll
                for (int r = 0; r < 4; ++r) { const int jj = 16 * jt + 4 * g + r; const bool keep = dir ? (jj > ii) : (jj <= ii); sc[jt][r] = keep ? sc[jt][r] : 0.f; }
            }
            const bf16x8 pa[2] = {pack8(sc[0], sc[1]), pack8(sc[2], sc[3])};
#pragma unroll
            for (int nt = 0; nt < 4; ++nt) {
                const int dvr = 64 * dvh + 16 * nt + c15;
                f32x4 o = (f32x4){0.f, 0.f, 0.f, 0.f};
#pragma unroll
                for (int s = 0; s < 2; ++s) {
                    o = MFMA16(*(const LAS bf16x8*)(vT + TROW(dvr) + 32 * s + 8 * g), pa[s], o);
                    o = MFMA16(*(const LAS bf16x8*)(sL + dvr * 72 + 32 * s + 8 * g), qdb[s], o);
                }
                const u32x2 w = {pk2(o[0], o[1]), pk2(o[2], o[3])};
                *(u32x2*)(OL + ((size_t)tokc + 16 * it + c15) * 512 + h * 128 + 64 * dvh + 16 * nt + 4 * g) = w;
            }
            bf16x8 vb[2];
#pragma unroll
            for (int s = 0; s < 2; ++s) vb[s] = *(const LAS bf16x8*)(vT + TROW(16 * wave + c15) + 32 * s + 8 * g);
#pragma unroll
            for (int kt = 0; kt < 4; ++kt) {
                const f32x4 gm = *(const LAS f32x4*)(elc + 16 * kt + 4 * g);
                f32x4 a = S[kt] * gm;
#pragma unroll
                for (int s = 0; s < 2; ++s) a = MFMA16(*(const LAS bf16x8*)(keT + TROW(16 * kt + c15) + 32 * s + 8 * g), vb[s], a);
                S[kt] = a;
            }
            quant_store(p, qrow, lane, qa);
        }
        lds_barrier();
    }
    {
        float* SEGS = (float*)(ws + WS_SEGS) + (size_t)(bhd * 8 + sg) * 64 * 128;
#pragma unroll
        for (int kt = 0; kt < 4; ++kt)
#pragma unroll
            for (int r = 0; r < 4; ++r) SEGS[(16 * kt + 4 * g + r) * 128 + 16 * wave + c15] = S[kt][r];
        if (tid < 64) ((float*)(ws + WS_GSEG))[(bhd * 8 + sg) * 64 + tid] = __expf(gs[tid]);
    }
}
#undef TROW

DI void phaseGA(const Params& p, LAS unsigned char* lds, int tid, int lane, int wave) {
    for (int task = blockIdx.x; task < 512; task += gridDim.x) { if (task & 1) ga_task<1>(p, lds, tid, lane, wave, task); else ga_task<0>(p, lds, tid, lane, wave, task); }
}

DI void phaseGB(const Params& p, int tid) {
    unsigned char* ws = p.ws;
    const float* SEGS = (const float*)(ws + WS_SEGS); const float* GSEG = (const float*)(ws + WS_GSEG); bf16_t* SC = (bf16_t*)(ws + WS_SC);
    for (int e = blockIdx.x * NTH + tid; e < 64 * 128 * 16; e += gridDim.x * NTH) {
        const int dv = e & 127, dk4 = (e >> 7) & 15, bhd = e >> 11;
        float c[4] = {0.f, 0.f, 0.f, 0.f};
        for (int sg = 0; sg < 8; ++sg) {
            const u32x2 w = {pk2(c[0], c[1]), pk2(c[2], c[3])};
            *(u32x2*)(SC + ((size_t)(bhd * 8 + sg) * 128 + dv) * 64 + 4 * dk4) = w;
            const f32x4 gm = *(const f32x4*)(GSEG + (bhd * 8 + sg) * 64 + 4 * dk4);
#pragma unroll
            for (int r = 0; r < 4; ++r) c[r] = gm[r] * c[r] + SEGS[((size_t)(bhd * 8 + sg) * 64 + 4 * dk4 + r) * 128 + dv];
        }
    }
}

DI void phase4a(const Params& p, LAS unsigned char* lds, int tid, int lane, int wave) {
    asm volatile("" : "+v"(tid), "+v"(lane));
    unsigned char* ws = p.ws;
    const bf16_t* Z = (const bf16_t*)(ws + WS_RZ);
    bf16_t* MIX = (bf16_t*)(ws + WS_RA);
    const bf16_t* OF = (const bf16_t*)(ws + WS_RO); const bf16_t* OB = (const bf16_t*)(ws + WS_RO + 64 * MB);
    const bf16_t* WP = (const bf16_t*)(ws + WS_WP);
    LAS bf16_t* pt = (LAS bf16_t*)lds;
    LAS unsigned char* at = lds + 81920;
    const int c15 = lane & 15, g = lane >> 4;
    for (int tile = blockIdx.x; tile < T / 64; tile += gridDim.x) {
        const int tok0 = tile * 64, s0 = tok0 & (SEQ - 1);
        __syncthreads();
#pragma unroll
        for (int ps = 0; ps < 10; ++ps) {
            const int idx = tid + NTH * ps, rr = idx >> 6, ch = idx & 63, sq = s0 - 8 + rr;
            u32x4 v = {0u, 0u, 0u, 0u};
            if (sq >= 0 && sq < SEQ) v = *(const u32x4*)(Z + ((size_t)tok0 - 8 + rr) * ZW + 1536 + ch * 8);
            *(LAS u32x4*)(pt + rr * 512 + ch * 8) = v;
        }
        {
            const int hh = wave >> 1, ih = wave & 1, bb = tok0 / SEQ, nn = s0 >> 6;
            f32x4 acc[8][2];
#pragma unroll
            for (int mt = 0; mt < 8; ++mt) { acc[mt][0] = (f32x4){0.f, 0.f, 0.f, 0.f}; acc[mt][1] = (f32x4){0.f, 0.f, 0.f, 0.f}; }
#pragma unroll
            for (int dir = 0; dir < 2; ++dir) {
                const int sg = dir ? 7 - (nn >> 3) : (nn >> 3), bhd = bb * 8 + hh * 2 + dir;
                const bf16_t* SCp = (const bf16_t*)(ws + WS_SC) + (size_t)(bhd * 8 + sg) * 128 * 64;
                const bf16_t* QCp = (const bf16_t*)(ws + WS_QDC + (dir ? 16 : 0) * MB) + ((size_t)tok0 + 32 * ih) * 256 + hh * 64;
                if (sg != 0)
#pragma unroll
                for (int s = 0; s < 2; ++s) {
                    const bf16x8 q0 = ld_frag16(QCp + (size_t)c15 * 256 + 32 * s + 8 * g), q1 = ld_frag16(QCp + (size_t)(16 + c15) * 256 + 32 * s + 8 * g);
#pragma unroll
                    for (int mt = 0; mt < 8; ++mt) {
                        const bf16x8 af = ld_frag16(SCp + (16 * mt + c15) * 64 + 32 * s + 8 * g);
                        acc[mt][0] = MFMA16(af, q0, acc[mt][0]); acc[mt][1] = MFMA16(af, q1, acc[mt][1]);
                    }
                }
            }
#pragma unroll
            for (int nt = 0; nt < 2; ++nt)
#pragma unroll
                for (int mt = 0; mt < 8; ++mt) { const f32x4 o = acc[mt][nt]; const u32x2 w = {pk2(o[0], o[1]), pk2(o[2], o[3])};
                    *(LAS u32x2*)(at + (32 * ih + 16 * nt + c15) * 1040 + (hh * 128 + 16 * mt + 4 * g) * 2) = w; }
        }
        __syncthreads();
        {
            const f32x4 gh0 = *(const f32x4*)(p.in[11] + 8 * lane), gh1 = *(const f32x4*)(p.in[11] + 8 * lane + 4);
#pragma unroll
            for (int hb = 0; hb < 2; ++hb) {
                u32x4 a[4], bq[4], rv[4], cv[4];
#pragma unroll
                for (int j = 0; j < 4; ++j) { const int tl = wave * 8 + hb * 4 + j; const size_t t = (size_t)tok0 + tl;
                    a[j] = *(const u32x4*)(OF + t * 512 + 8 * lane); bq[j] = *(const u32x4*)(OB + t * 512 + 8 * lane); rv[j] = *(const u32x4*)(Z + t * ZW + 1024 + 8 * lane);
                    cv[j] = *(const LAS u32x4*)(at + tl * 1040 + 16 * lane); }
#pragma unroll
                for (int j = 0; j < 4; ++j) { const size_t t = (size_t)tok0 + wave * 8 + hb * 4 + j;
                    float o[8], r[8];
#pragma unroll
                    for (int e = 0; e < 4; ++e) { o[2 * e] = bflo(a[j][e]) + bflo(bq[j][e]) + bflo(cv[j][e]); o[2 * e + 1] = bfhi(a[j][e]) + bfhi(bq[j][e]) + bfhi(cv[j][e]); r[2 * e] = bflo(rv[j][e]); r[2 * e + 1] = bfhi(rv[j][e]); }
                    float ss = 0.f;
#pragma unroll
                    for (int e = 0; e < 8; ++e) ss += o[e] * o[e];
                    ss += __shfl_xor(ss, 1); ss += __shfl_xor(ss, 2); ss += __shfl_xor(ss, 4); ss += __shfl_xor(ss, 8);
                    const float rstd = rsqrtf(ss * (1.f / 128.f) + EPS);
                    float y[8];
#pragma unroll
                    for (int e = 0; e < 8; ++e) { const float gg = e < 4 ? gh0[e] : gh1[e - 4]; y[e] = o[e] * rstd * gg * (r[e] / (1.f + __expf(-r[e]))); }
                    const u32x4 w = {pk2(y[0], y[1]), pk2(y[2], y[3]), pk2(y[4], y[5]), pk2(y[6], y[7])};
                    *(u32x4*)(MIX + t * D + 8 * lane) = w; }
            }
        }
        __syncthreads();
        {
            const int c = tid, gi = c >> 7, cc = c & 127, hw = 1 << gi;
            LAS unsigned char* ag = at + gi * 16384;
            const LAS bf16_t* pc = pt + c;
            if (s0 >= 8 && s0 + 64 + 8 <= SEQ) {
                const float inv = 0.5f / (float)hw;
                float sum = 0.f;
                for (int rr = 8 - hw; rr < 8 + hw; ++rr) sum += bflo((unsigned)pc[rr * 512]);
#pragma unroll 4
                for (int i = 0; i < 64; ++i) {
                    const float val = sum * inv - bflo((unsigned)pc[(i + 8) * 512]);
                    *(LAS bf16_t*)(ag + i * 256 + (((cc >> 3) ^ (i & 15)) * 16) + (cc & 7) * 2) = (bf16_t)(pk2(val, 0.f) & 0xFFFFu);
                    sum += bflo((unsigned)pc[(i + 8 + hw) * 512]) - bflo((unsigned)pc[(i + 8 - hw) * 512]);
                }
            } else {
                float sum = 0.f;
                {   const int lo = max(s0 - hw, 0), hi = min(s0 + hw, SEQ);
                    for (int rr = lo; rr < hi; ++rr) sum += bflo((unsigned)pc[(rr - s0 + 8) * 512]); }
#pragma unroll 4
                for (int i = 0; i < 64; ++i) {
                    const int sq = s0 + i, lo = max(sq - hw, 0), hi = min(sq + hw, SEQ);
                    const float val = sum * __builtin_amdgcn_rcpf((float)(hi - lo)) - bflo((unsigned)pc[(i + 8) * 512]);
                    *(LAS bf16_t*)(ag + i * 256 + (((cc >> 3) ^ (i & 15)) * 16) + (cc & 7) * 2) = (bf16_t)(pk2(val, 0.f) & 0xFFFFu);
                    if (sq + hw < SEQ) sum += bflo((unsigned)pc[(i + 8 + hw) * 512]);
                    if (sq - hw >= 0) sum -= bflo((unsigned)pc[(i + 8 - hw) * 512]);
                }
            }
        }
        __syncthreads();
        {
            const int gi = wave >> 1, dh = wave & 1;
            LAS unsigned char* ag = at + gi * 16384;
            f32x4 acc[4][4];
#pragma unroll
            for (int mt = 0; mt < 4; ++mt)
#pragma unroll
                for (int nt = 0; nt < 4; ++nt) acc[mt][nt] = (f32x4){0.f, 0.f, 0.f, 0.f};
#pragma unroll
            for (int s = 0; s < 4; ++s) {
                bf16x8 af[4];
#pragma unroll
                for (int mt = 0; mt < 4; ++mt) { const int row = mt * 16 + c15; af[mt] = *(const LAS bf16x8*)(ag + row * 256 + (((4 * s + g) ^ (row & 15)) * 16)); }
#pragma unroll
                for (int nt = 0; nt < 4; ++nt) {
                    const bf16x8 wf = ld_frag16(WP + (size_t)gi * 16384 + (dh * 64 + 16 * nt + c15) * 128 + 32 * s + 8 * g);
#pragma unroll
                    for (int mt = 0; mt < 4; ++mt) acc[mt][nt] = MFMA16(wf, af[mt], acc[mt][nt]);
                }
            }
#pragma unroll
            for (int nt = 0; nt < 4; ++nt) {
                const f32x4 ps = *(const f32x4*)(p.in[13] + gi * 128 + dh * 64 + 16 * nt + 4 * g);
#pragma unroll
                for (int mt = 0; mt < 4; ++mt) {
                    const f32x4 v = acc[mt][nt] * ps;
                    u32x2 w = {pk2(v[0], v[1]), pk2(v[2], v[3])};
                    *(u32x2*)(MIX + ((size_t)tok0 + mt * 16 + c15) * D + 512 + gi * 128 + dh * 64 + 16 * nt + 4 * g) = w;
                }
            }
        }
    }
}

DI void phase4c(const Params& p, LAS unsigned char* lds, int tid, int lane, int wave) {
    asm volatile("" : "+v"(tid), "+v"(lane));
    LAS float* lG = (LAS float*)lds; LAS float* lA = lG + 1024; LAS float* lB = lA + 1024; LAS float* lP = lB + 1024;
    const float* x = p.in[0]; const bf16_t* MIXO = (const bf16_t*)(p.ws + WS_RZ); bf16_t* H2 = (bf16_t*)(p.ws + WS_RA);
    for (int rt = blockIdx.x; rt < T / 128; rt += gridDim.x) {
        const int b = rt / 32;
        __syncthreads();
        for (int d = tid; d < 1024; d += NTH) { lG[d] = mod_at(p, b, 2048 + d); lA[d] = p.in[15][d] * (1.f + mod_at(p, b, 4096 + d)); lB[d] = mod_at(p, b, 3072 + d); lP[d] = p.in[5][d]; }
        __syncthreads();
        for (int r0 = wave; r0 < 128; r0 += 4 * NWV) {
            f32x4 m[4][4], xv[4][4];
#pragma unroll
            for (int u = 0; u < 4; ++u) {
                const size_t row = (size_t)rt * 128 + r0 + u * NWV;
                const u32x2* mr = (const u32x2*)(MIXO + row * D) + lane; const f32x4* xr = (const f32x4*)(x + row * D) + lane;
#pragma unroll
                for (int j = 0; j < 4; ++j) { const u32x2 mv = mr[64 * j]; m[u][j] = (f32x4){bflo(mv.x), bfhi(mv.x), bflo(mv.y), bfhi(mv.y)}; xv[u][j] = xr[64 * j]; }
            }
#pragma unroll
            for (int u = 0; u < 4; ++u) {
                const size_t row = (size_t)rt * 128 + r0 + u * NWV;
                float ss = 0.f;
#pragma unroll
                for (int j = 0; j < 4; ++j) ss += m[u][j][0] * m[u][j][0] + m[u][j][1] * m[u][j][1] + m[u][j][2] * m[u][j][2] + m[u][j][3] * m[u][j][3];
                const float rstd = rsqrtf(wave_sum(ss) * (1.f / D) + EPS);
                float s2 = 0.f;
#pragma unroll
                for (int j = 0; j < 4; ++j) {
                    const f32x4 gt = *(const LAS f32x4*)(lG + 4 * lane + 256 * j), pm = *(const LAS f32x4*)(lP + 4 * lane + 256 * j);
                    xv[u][j] = xv[u][j] + gt * (m[u][j] * rstd * pm);
                    s2 += xv[u][j][0] * xv[u][j][0] + xv[u][j][1] * xv[u][j][1] + xv[u][j][2] * xv[u][j][2] + xv[u][j][3] * xv[u][j][3];
                }
                const float rstd2 = rsqrtf(wave_sum(s2) * (1.f / D) + EPS);
                u32x2* orow = (u32x2*)((bf16_t*)(p.ws + WS_RO) + row * D) + lane; u32x2* hrow = (u32x2*)(H2 + row * D) + lane;
#pragma unroll
                for (int j = 0; j < 4; ++j) {
                    { const u32x2 xw = {pk2(xv[u][j][0], xv[u][j][1]), pk2(xv[u][j][2], xv[u][j][3])}; orow[64 * j] = xw; }
                    const f32x4 a = *(const LAS f32x4*)(lA + 4 * lane + 256 * j), bb = *(const LAS f32x4*)(lB + 4 * lane + 256 * j);
                    const f32x4 hv = xv[u][j] * rstd2 * a + bb;
                    u32x2 w = {pk2(hv[0], hv[1]), pk2(hv[2], hv[3])};
                    hrow[64 * j] = w;
                }
            }
        }
    }
}

DI int skey(float v, int idx, int mask) { int u = __float_as_int(v); u ^= (u >> 31) & 0x7FFFFFFF; return (u & ~mask) | idx; }
DI float sval(int k, int mask) { int u = k & ~mask; u ^= (u >> 31) & 0x7FFFFFFF; return __int_as_float(u); }
DI void cswap(int& a, int& b) { const int mx = max(a, b), mn = min(a, b); a = mx; b = mn; }
DI void sort16_desc(int (&a)[16]) {
    cswap(a[0], a[13]); cswap(a[1], a[12]); cswap(a[2], a[15]); cswap(a[3], a[14]); cswap(a[4], a[8]); cswap(a[5], a[6]); cswap(a[7], a[11]); cswap(a[9], a[10]);
    cswap(a[0], a[5]); cswap(a[1], a[7]); cswap(a[2], a[9]); cswap(a[3], a[4]); cswap(a[6], a[13]); cswap(a[8], a[14]); cswap(a[10], a[15]); cswap(a[11], a[12]);
    cswap(a[0], a[1]); cswap(a[2], a[3]); cswap(a[4], a[5]); cswap(a[6], a[8]); cswap(a[7], a[9]); cswap(a[10], a[11]); cswap(a[12], a[13]); cswap(a[14], a[15]);
    cswap(a[0], a[2]); cswap(a[1], a[3]); cswap(a[4], a[10]); cswap(a[5], a[11]); cswap(a[6], a[7]); cswap(a[8], a[9]); cswap(a[12], a[14]); cswap(a[13], a[15]);
    cswap(a[1], a[2]); cswap(a[3], a[12]); cswap(a[4], a[6]); cswap(a[5], a[7]); cswap(a[8], a[10]); cswap(a[9], a[11]); cswap(a[13], a[14]);
    cswap(a[1], a[4]); cswap(a[2], a[6]); cswap(a[5], a[8]); cswap(a[7], a[10]); cswap(a[9], a[13]); cswap(a[11], a[14]);
    cswap(a[2], a[4]); cswap(a[3], a[6]); cswap(a[9], a[12]); cswap(a[11], a[13]);
    cswap(a[3], a[5]); cswap(a[6], a[8]); cswap(a[7], a[9]); cswap(a[10], a[12]);
    cswap(a[3], a[4]); cswap(a[5], a[6]); cswap(a[7], a[8]); cswap(a[9], a[10]); cswap(a[11], a[12]);
    cswap(a[6], a[7]); cswap(a[8], a[9]);
}
DI void merge16_desc(int (&x)[16], const int (&y)[16]) {
#pragma unroll
    for (int i = 0; i < 16; ++i) x[i] = max(x[i], y[15 - i]);
#pragma unroll
    for (int j = 8; j > 0; j >>= 1) {
#pragma unroll
        for (int i = 0; i < 16; ++i) { const int l = i ^ j; if (l > i) cswap(x[i], x[l]); }
    }
}

DI void phase5b(const Params& p, LAS unsigned char* lds, int tid, int lane, int wave) {
    asm volatile("" : "+v"(tid), "+v"(lane));
    unsigned char* ws = p.ws;
    const bf16_t* Q2 = (const bf16_t*)(ws + WS_RZ);
    const bf16_t* SKB = (const bf16_t*)(ws + WS_SKB);
    int* EIDX = (int*)(ws + WS_RS);
    LAS unsigned char* tab = lds + tid * 32;
    LAS unsigned char* skl = lds + 16384;
    const int c31 = lane & 31, hi = lane >> 5;
    for (int btask = blockIdx.x; btask < 256; btask += gridDim.x) {
        const int h = btask & 7, tgc = btask >> 3;
        __syncthreads();
#pragma unroll
        for (int ps = 0; ps < 8; ++ps) {
            const int idx = tid + NTH * ps, row = idx >> 4, ch = idx & 15;
            const u32x4 v = *(const u32x4*)(SKB + ((size_t)h * 256 + row) * 128 + ch * 8);
            *(LAS u32x4*)(skl + row * 256 + ((ch ^ (row & 15)) * 16)) = v;
        }
        __syncthreads();
      for (int ti = 0; ti < 4; ++ti) {
        const int tg = tgc * 32 + wave * 4 + ti;
        const size_t tok = (size_t)tg * 32 + c31;
        int lst[2][16];
        bf16x8 bq[2][8];
#pragma unroll
        for (int pp = 0; pp < 2; ++pp) {
            const bf16_t* qp = Q2 + tok * 2048 + h * 256 + pp * 128 + 8 * hi;
            asm volatile("" : "+v"(qp));
#pragma unroll
            for (int ks = 0; ks < 8; ++ks) bq[pp][ks] = ld_frag16(qp + 16 * ks);
        }
#pragma unroll
        for (int pp = 0; pp < 2; ++pp) {
            int run[16];
#pragma unroll
            for (int r = 0; r < 16; ++r) run[r] = (int)0x80000000;
#pragma unroll 1
            for (int kt = 0; kt < 4; ++kt) {
                const LAS unsigned char* kb = skl + pp * 32768 + (32 * kt + c31) * 256;
                f32x16 acc;
#pragma unroll
                for (int r = 0; r < 16; ++r) acc[r] = 0.f;
#pragma unroll
                for (int ks = 0; ks < 8; ++ks) acc = MFMA32(*(const LAS bf16x8*)(kb + (((2 * ks + hi) ^ (c31 & 15)) * 16)), bq[pp][ks], acc);
                int cur[16];
#pragma unroll
                for (int r = 0; r < 16; ++r) cur[r] = skey(acc[r], 32 * kt + 8 * (r >> 2) + 4 * hi + (r & 3), 0x7F);
                sort16_desc(cur);
                merge16_desc(run, cur);
            }
            int oth[16];
#pragma unroll
            for (int r = 0; r < 16; ++r) oth[r] = __shfl_xor(run[r], 32);
            merge16_desc(run, oth);
#pragma unroll
            for (int r = 0; r < 16; ++r) lst[pp][r] = run[r];
        }
#pragma unroll
        for (int pp = 0; pp < 2; ++pp) {
            u32x4 w;
#pragma unroll
            for (int q = 0; q < 4; ++q) w[q] = (lst[pp][4 * q] & 0x7F) | ((lst[pp][4 * q + 1] & 0x7F) << 8) | ((lst[pp][4 * q + 2] & 0x7F) << 16) | ((lst[pp][4 * q + 3] & 0x7F) << 24);
            *(LAS u32x4*)(tab + 16 * pp) = w;
        }
        float va[16], vb[16];
#pragma unroll
        for (int r = 0; r < 16; ++r) { va[r] = sval(lst[0][r], 0x7F); vb[r] = sval(lst[1][r], 0x7F); }
        int cand[4][16];
        {
            int cnt = 0;
#pragma unroll
            for (int i = 0; i < 16; ++i)
#pragma unroll
                for (int j = 0; j < 16; ++j)
                    if ((i + 1) * (j + 1) <= 16) { cand[cnt >> 4][cnt & 15] = skey(va[i] + vb[j], (i << 4) | j, 0xFF); ++cnt; }
#pragma unroll
            for (int q = 50; q < 64; ++q) cand[q >> 4][q & 15] = (int)0x80000000;
        }
        sort16_desc(cand[0]); sort16_desc(cand[1]); sort16_desc(cand[2]); sort16_desc(cand[3]);
        merge16_desc(cand[0], cand[1]); merge16_desc(cand[2], cand[3]); merge16_desc(cand[0], cand[2]);
        asm volatile("s_waitcnt lgkmcnt(0)" ::: "memory");
        float sv[16]; int ex[16];
        const float mx = sval(cand[0][0], 0xFF);
        float sum = 0.f;
#pragma unroll
        for (int r = 0; r < 16; ++r) {
            const int ck = cand[0][r];
            const int i1 = tab[(ck >> 4) & 15], i2 = tab[16 + (ck & 15)];
            ex[r] = i1 * 128 + i2;
            sv[r] = __expf(sval(ck, 0xFF) - mx); sum += sv[r];
        }
        const float inv = 1.f / sum;
        unsigned* ep = (unsigned*)EIDX + tok * 128 + h * 16 + 8 * hi;
        unsigned pe[16];
#pragma unroll
        for (int r = 0; r < 16; ++r) pe[r] = (unsigned)ex[r] | (pk2(sv[r] * inv, 0.f) << 16);
        if (hi == 0) { *(u32x4*)ep = (u32x4){pe[0], pe[1], pe[2], pe[3]}; *(u32x4*)(ep + 4) = (u32x4){pe[4], pe[5], pe[6], pe[7]}; }
        else         { *(u32x4*)ep = (u32x4){pe[8], pe[9], pe[10], pe[11]}; *(u32x4*)(ep + 4) = (u32x4){pe[12], pe[13], pe[14], pe[15]}; }
      }
    }
}

template <int K> DI int swz_bcast(int v) { return __builtin_amdgcn_ds_swizzle(v, 0x10 | (K << 5)); }
template <int W> DI int swz_xor(int v) { return __builtin_amdgcn_ds_swizzle(v, 0x1F | (W << 10)); }
template <int K> struct IC { static constexpr int v = K; };
template <int N, int I = 0, class F> DI void static_for(F&& f) { if constexpr (I < N) { f(IC<I>{}); static_for<N, I + 1>(f); } }
DI float row16_sum(float v) {
    v += __builtin_bit_cast(float, __builtin_amdgcn_update_dpp(0, __builtin_bit_cast(int, v), 0xB1, 0xF, 0xF, true));
    v += __builtin_bit_cast(float, __builtin_amdgcn_update_dpp(0, __builtin_bit_cast(int, v), 0x4E, 0xF, 0xF, true));
    v += __builtin_bit_cast(float, __builtin_amdgcn_update_dpp(0, __builtin_bit_cast(int, v), 0x141, 0xF, 0xF, true));
    v += __builtin_bit_cast(float, __builtin_amdgcn_update_dpp(0, __builtin_bit_cast(int, v), 0x140, 0xF, 0xF, true));
    return v;
}
DI void phase6(const Params& p, LAS unsigned char* lds, int tid, int lane, int wave) {
    asm volatile("" : "+v"(tid), "+v"(lane));
    unsigned char* ws = p.ws;
    const bf16_t* H2 = (const bf16_t*)(ws + WS_RA);
    const unsigned char* UQ = ws + WS_UB; const unsigned char* VQ = ws + WS_VB;
    const float* SU = (const float*)(ws + WS_SU); const float* SV = (const float*)(ws + WS_SV);
    const unsigned* EIDX = (const unsigned*)(ws + WS_RS);
    LAS float* lG = (LAS float*)lds;
    const int q = lane >> 4, l16 = lane & 15;
    LAS int* le = (LAS int*)(lds + 4096 + wave * 6144) + q * 128;
    LAS float* lg = (LAS float*)(lds + 4096 + wave * 6144 + 2048) + q * 128;
    LAS float* lc = (LAS float*)(lds + 4096 + wave * 6144 + 4096) + q * 128;
    const unsigned qlo = q < 2 ? (0xFFFFu << (16 * q)) : 0u, qhi = q >= 2 ? (0xFFFFu << (16 * (q - 2))) : 0u;
    for (int rt = blockIdx.x; rt < T / 128; rt += gridDim.x) {
        const int b = rt / 32;
        __syncthreads();
        for (int d = tid; d < 1024; d += NTH) lG[d] = mod_at(p, b, 5120 + d) * p.in[16][d];
        __syncthreads();
#pragma unroll 1
        for (int rd = 0; rd < 4; ++rd) {
            __syncthreads();
            const size_t t = (size_t)rt * 128 + wave * 16 + rd * 4 + q;
            {
                int e[8]; float g[8];
#pragma unroll
                for (int r = 0; r < 8; ++r) { const unsigned pe = EIDX[t * 128 + r * 16 + l16]; e[r] = (int)(pe & 0xFFFFu); g[r] = bfhi(pe); }
                unsigned W[4] = {0u, 0u, 0u, 0u};
#pragma unroll
                for (int r = 0; r < 8; ++r) {
                    const int k = e[r] >> 10; const unsigned inc = 1u << (8 * (k & 3)); const int w = k >> 2;
                    W[0] += (w == 0) ? inc : 0u; W[1] += (w == 1) ? inc : 0u; W[2] += (w == 2) ? inc : 0u; W[3] += (w == 3) ? inc : 0u;
                }
                unsigned C[4];
                {
                    unsigned tot[4], exc[4];
#pragma unroll
                    for (int w = 0; w < 4; ++w) {
                        unsigned x = W[w];
                        x += (unsigned)__builtin_amdgcn_update_dpp(0, (int)x, 0x111, 0xF, 0xF, true);
                        x += (unsigned)__builtin_amdgcn_update_dpp(0, (int)x, 0x112, 0xF, 0xF, true);
                        x += (unsigned)__builtin_amdgcn_update_dpp(0, (int)x, 0x114, 0xF, 0xF, true);
                        x += (unsigned)__builtin_amdgcn_update_dpp(0, (int)x, 0x118, 0xF, 0xF, true);
                        exc[w] = x - W[w];
                        tot[w] = (unsigned)swz_bcast<15>((int)x);
                    }
                    unsigned carry = 0u;
#pragma unroll
                    for (int w = 0; w < 4; ++w) {
                        const unsigned P = tot[w] + (tot[w] << 8) + (tot[w] << 16) + (tot[w] << 24);
                        C[w] = (P - tot[w]) + carry * 0x01010101u + exc[w];
                        carry += P >> 24;
                    }
                }
#pragma unroll
                for (int r = 0; r < 8; ++r) {
                    const int k = e[r] >> 10; const int sh = 8 * (k & 3); const int w = k >> 2; const unsigned inc = 1u << sh;
                    const unsigned cw = (w == 0) ? C[0] : (w == 1) ? C[1] : (w == 2) ? C[2] : C[3];
                    const int pos = (int)((cw >> sh) & 0xFFu);
                    le[pos] = e[r]; lg[pos] = g[r];
                    C[0] += (w == 0) ? inc : 0u; C[1] += (w == 1) ? inc : 0u; C[2] += (w == 2) ? inc : 0u; C[3] += (w == 3) ? inc : 0u;
                }
                asm volatile("s_waitcnt lgkmcnt(0)" ::: "memory");
            }
            {
                int hq[16]; float ish;
                {
                    float hv[64]; float hm = 0.f;
#pragma unroll
                    for (int i = 0; i < 4; ++i) {
                        const u32x4 h0 = *(const u32x4*)(H2 + t * D + 256 * i + 16 * l16), h1 = *(const u32x4*)(H2 + t * D + 256 * i + 16 * l16 + 8);
#pragma unroll
                        for (int c = 0; c < 4; ++c) { hv[16 * i + 2 * c] = bflo(h0[c]); hv[16 * i + 2 * c + 1] = bfhi(h0[c]); hv[16 * i + 8 + 2 * c] = bflo(h1[c]); hv[16 * i + 8 + 2 * c + 1] = bfhi(h1[c]); }
                    }
#pragma unroll
                    for (int j = 0; j < 64; ++j) hm = fmaxf(hm, fabsf(hv[j]));
                    hm = fmaxf(hm, __builtin_bit_cast(float, __builtin_amdgcn_update_dpp(0, __builtin_bit_cast(int, hm), 0xB1, 0xF, 0xF, true)));
                    hm = fmaxf(hm, __builtin_bit_cast(float, __builtin_amdgcn_update_dpp(0, __builtin_bit_cast(int, hm), 0x4E, 0xF, 0xF, true)));
                    hm = fmaxf(hm, __builtin_bit_cast(float, __builtin_amdgcn_update_dpp(0, __builtin_bit_cast(int, hm), 0x141, 0xF, 0xF, true)));
                    hm = fmaxf(hm, __builtin_bit_cast(float, __builtin_amdgcn_update_dpp(0, __builtin_bit_cast(int, hm), 0x140, 0xF, 0xF, true)));
                    const float s8 = hm > 1e-30f ? 127.f / hm : 0.f; ish = hm * (1.f / 127.f);
#pragma unroll
                    for (int d = 0; d < 16; ++d) {
                        const int q0 = __float2int_rn(hv[4 * d] * s8), q1 = __float2int_rn(hv[4 * d + 1] * s8), q2 = __float2int_rn(hv[4 * d + 2] * s8), q3 = __float2int_rn(hv[4 * d + 3] * s8);
                        hq[d] = (int)((unsigned)(q0 & 0xFF) | ((unsigned)(q1 & 0xFF) << 8) | ((unsigned)(q2 & 0xFF) << 16) | ((unsigned)q3 << 24));
                    }
                }
                constexpr int UD = 4;
                u32x4 ub[UD][4];
                int evn = le[l16];
                static_for<UD>([&](auto kc) { constexpr int k = decltype(kc)::v; const unsigned char* up = UQ + (size_t)swz_bcast<k>(evn) * 1024 + 16 * l16;
#pragma unroll
                    for (int i = 0; i < 4; ++i) ub[k][i] = *(const u32x4*)(up + 256 * i); });
#pragma unroll 1
                for (int bt = 0; bt < 8; ++bt) {
                    if (bt) __syncthreads();
                    const int ev = evn; const float gv = lg[bt * 16 + l16];
                    evn = le[(bt < 7 ? bt + 1 : 7) * 16 + l16];
                    const float isu = SU[ev] * ish, isv = SV[ev];
                    int part[16];
                    static_for<16>([&](auto kc) {
                        constexpr int k = decltype(kc)::v, sl = k % UD;
                        int a = 0;
#pragma unroll
                        for (int i = 0; i < 4; ++i) {
                            const u32x4 u = ub[sl][i];
#pragma unroll
                            for (int c = 0; c < 4; ++c) a = __builtin_amdgcn_sdot4((int)u[c], hq[4 * i + c], a, false);
                        }
                        part[k] = a;
                        {
                            constexpr int kn = k + UD;
                            int idx; if constexpr (kn < 16) idx = swz_bcast<(kn & 15)>(ev); else idx = swz_bcast<(kn & 15)>(evn);
                            const unsigned char* up = UQ + (size_t)idx * 1024 + 16 * l16;
#pragma unroll
                            for (int i = 0; i < 4; ++i) ub[sl][i] = *(const u32x4*)(up + 256 * i);
                        }
                    });
                    static_for<4>([&](auto sc) {
                        constexpr int w = 8 >> decltype(sc)::v;
                        const bool up2 = (lane & w) != 0;
#pragma unroll
                        for (int e = 0; e < w; ++e) {
                            const int keep = up2 ? part[e + w] : part[e], send = up2 ? part[e] : part[e + w];
                            part[e] = keep + swz_xor<w>(send);
                        }
                    });
                    const float dot = (float)part[0] * isu;
                    lc[bt * 16 + l16] = gv * 0.5f * dot * (1.f + erff(dot * 0.70710678118654752f)) * isv;
                }
                asm volatile("s_waitcnt lgkmcnt(0)" ::: "memory");
            }
            __syncthreads();
            f32x2 y[32];
#pragma unroll
            for (int i = 0; i < 32; ++i) y[i] = (f32x2){0.f, 0.f};
            {
                constexpr int VD = 4;
                u32x4 vbuf[VD][4];
                int evn = le[l16];
                static_for<VD>([&](auto kc) { constexpr int k = decltype(kc)::v; const unsigned char* vp = VQ + (size_t)swz_bcast<k>(evn) * 1024 + 16 * l16;
#pragma unroll
                    for (int i = 0; i < 4; ++i) vbuf[k][i] = *(const u32x4*)(vp + 256 * i); });
#pragma unroll 1
                for (int bt = 0; bt < 8; ++bt) {
                    if (bt) __syncthreads();
                    const int ev = evn; const int cv = __float_as_int(lc[bt * 16 + l16]);
                    evn = le[(bt < 7 ? bt + 1 : 7) * 16 + l16];
                    static_for<16>([&](auto kc) {
                        constexpr int k = decltype(kc)::v, sl = k % VD;
                        const float cc = __int_as_float(swz_bcast<k>(cv));
                        const f32x2 c2 = (f32x2){cc, cc};
#pragma unroll
                        for (int i = 0; i < 4; ++i) {
                            const u32x4 v = vbuf[sl][i];
#pragma unroll
                            for (int c = 0; c < 4; ++c) {
                                const int w = (int)v[c];
                                y[8 * i + 2 * c] = __builtin_elementwise_fma(__builtin_amdgcn_cvt_pk_f32_fp8(w, false), c2, y[8 * i + 2 * c]);
                                y[8 * i + 2 * c + 1] = __builtin_elementwise_fma(__builtin_amdgcn_cvt_pk_f32_fp8(w, true), c2, y[8 * i + 2 * c + 1]);
                            }
                        }
                        {
                            constexpr int kn = k + VD;
                            int idx; if constexpr (kn < 16) idx = swz_bcast<(kn & 15)>(ev); else idx = swz_bcast<(kn & 15)>(evn);
                            const unsigned char* vp = VQ + (size_t)idx * 1024 + 16 * l16;
#pragma unroll
                            for (int i = 0; i < 4; ++i) vbuf[sl][i] = *(const u32x4*)(vp + 256 * i);
                        }
                    });
                }
            }
            float ss = 0.f;
#pragma unroll
            for (int i = 0; i < 32; ++i) ss += y[i].x * y[i].x + y[i].y * y[i].y;
            const float rstd = rsqrtf(row16_sum(ss) * (1.f / D) + EPS);
            float* orow = p.out + t * D;
#pragma unroll
            for (int i = 0; i < 4; ++i)
#pragma unroll
                for (int c = 0; c < 4; ++c) {
                    const int col = 256 * i + 16 * l16 + 4 * c;
                    const u32x2 xb = *(const u32x2*)((const bf16_t*)(ws + WS_RO) + t * D + col);
                    f32x4 xv = {bflo(xb.x), bfhi(xb.x), bflo(xb.y), bfhi(xb.y)};
                    const f32x4 gg = *(const LAS f32x4*)(lG + col);
                    xv[0] += gg[0] * y[8 * i + 2 * c].x * rstd; xv[1] += gg[1] * y[8 * i + 2 * c].y * rstd; xv[2] += gg[2] * y[8 * i + 2 * c + 1].x * rstd; xv[3] += gg[3] * y[8 * i + 2 * c + 1].y * rstd;
                    *(f32x4*)(orow + col) = xv;
                }
        }
    }
}


__global__ void __launch_bounds__(NTH) fwd_megakernel(Params p) {
    extern __shared__ __attribute__((aligned(16))) unsigned char lds_raw[];
    LAS unsigned char* lds = (LAS unsigned char*)lds_raw;
    const int tid = threadIdx.x, lane = tid & 63, wave = __builtin_amdgcn_readfirstlane(tid >> 6);
    volatile LAS unsigned* st = (volatile LAS unsigned*)(lds + LDS_BARW);
    if (tid == 0) { st[0] = 0u; st[1] = 0u; st[2] = 0u; st[3] = 0u; }
    __syncthreads();
    XcdBarrier bar = xcd_barrier_post((unsigned*)(p.ws + WS_CTL), st);
    unsigned char* ws = p.ws;

    phase0(p, lds, tid, lane, wave);
    xcd_barrier(bar);
    phase1(p, lds, tid, lane, wave);
    afb_tail((const bf16_t*)(ws + WS_RA), (const bf16_t*)(ws + WS_WIN) + (size_t)ZW * D, (float*)(ws + WS_AFB), lds, tid, lane, wave);
    xcd_barrier(bar);
    { pg8::Gemm g{(const bf16_t*)(ws + WS_RA), (const bf16_t*)(ws + WS_WIN), T, ZW, D}; pg8::StaticOrder S; S.init(T, ZW, (int)gridDim.x, (int)blockIdx.x);
      pg8::EpiB16 e{(bf16_t*)(ws + WS_RZ), ZW}; pg8::gemm_phase<pg8::EpiB16, pg8::StaticOrder, true, true>(lds, g, S, e);
 }
    xcd_barrier(bar);
    phaseGA(p, lds, tid, lane, wave);
    xcd_barrier(bar);
    phaseGB(p, tid);
    xcd_barrier(bar);
    phase4a(p, lds, tid, lane, wave);
    xcd_barrier(bar);
    { pg8::Gemm g{(const bf16_t*)(ws + WS_RA), (const bf16_t*)(ws + WS_WOUT), T, D, D}; pg8::StaticOrder S; S.init(T, D, (int)gridDim.x, (int)blockIdx.x);
      pg8::EpiB16 e{(bf16_t*)(ws + WS_RZ), D}; pg8::gemm_phase<pg8::EpiB16, pg8::StaticOrder, true, true>(lds, g, S, e); }
    xcd_barrier(bar);
    phase4c(p, lds, tid, lane, wave);
    xcd_barrier(bar);
    { pg8::Gemm g{(const bf16_t*)(ws + WS_RA), (const bf16_t*)(ws + WS_WQ), T, 2048, D}; pg8::StaticOrder S; S.init(T, 2048, (int)gridDim.x, (int)blockIdx.x);
      pg8::EpiB16 e{(bf16_t*)(ws + WS_RZ), 2048}; pg8::gemm_phase<pg8::EpiB16, pg8::StaticOrder, true, true>(lds, g, S, e); }
    xcd_barrier(bar);
    phase5b(p, lds, tid, lane, wave);
    xcd_barrier(bar);
    phase6(p, lds, tid, lane, wave);
}

extern "C" void kernel_launch(void* const* d_in, const int* in_sizes, int n_in, void* d_out, int out_size, void* d_ws, size_t ws_size, hipStream_t stream) {
    static int grid = 0;
    if (grid == 0) {
        if (n_in != 21 || out_size != T * D || ws_size < WS_END) { fprintf(stderr, "kernel_launch: unexpected shapes (n_in %d out %d ws %zu need %zu)\n", n_in, out_size, ws_size, (size_t)WS_END); grid = -1; return; }
        int dev = 0, cus = 0, per_cu = 0;
        hipGetDevice(&dev); hipDeviceGetAttribute(&cus, hipDeviceAttributeMultiprocessorCount, dev);
        hipFuncSetAttribute((const void*)fwd_megakernel, hipFuncAttributeMaxDynamicSharedMemorySize, LDS_BYTES);
        hipOccupancyMaxActiveBlocksPerMultiprocessor(&per_cu, (const void*)fwd_megakernel, NTH, LDS_BYTES);
        (void)hipGetLastError();
        if (per_cu < 1) fprintf(stderr, "kernel_launch: occupancy query says %d blocks per CU\n", per_cu);
        grid = cus;
    }
    if (grid < 0) return;
    hipMemsetAsync((char*)d_ws + WS_CTL, 0, 64 * 1024, stream);
    Params p{};
    for (int i = 0; i < 21; ++i) p.in[i] = (const float*)d_in[i];
    p.out = (float*)d_out; p.ws = (unsigned char*)d_ws;
    hipLaunchKernelGGL(fwd_megakernel, dim3(grid), dim3(NTH), LDS_BYTES, stream, p);
}
```

```cpp
#include <hip/hip_runtime.h>
#include <cstdio>
#include <cstdint>

#define DI __device__ __forceinline__
#define LAS __attribute__((address_space(3)))
typedef unsigned short bf16_t;
typedef short bf16x8 __attribute__((ext_vector_type(8)));
typedef float f32x4 __attribute__((ext_vector_type(4)));
typedef float f32x2 __attribute__((ext_vector_type(2)));
typedef float f32x16 __attribute__((ext_vector_type(16)));
typedef unsigned u32x4 __attribute__((ext_vector_type(4)));
typedef unsigned u32x2 __attribute__((ext_vector_type(2)));
typedef __bf16 bf16x2v __attribute__((ext_vector_type(2)));

constexpr int T = 32768, D = 1024, SEQ = 4096, NB = 8;
constexpr int NTH = 512, NWV = 8;
constexpr int ZW = 2048;
constexpr int NIN = 2176;
constexpr float EPS = 1e-6f;

constexpr size_t MB = 1024 * 1024;
constexpr size_t WS_CTL   = 0;
constexpr size_t WS_MODP  = 64 * 1024;
constexpr size_t WS_WIN   = WS_MODP + 8 * 8 * 6144 * 4;
constexpr size_t WS_WOUT  = WS_WIN + (size_t)NIN * 1024 * 2;
constexpr size_t WS_WQ    = WS_WOUT + 1024 * 1024 * 2;
constexpr size_t WS_SKB   = WS_WQ + 2048 * 1024 * 2;
constexpr size_t WS_WP    = WS_SKB + 16 * 128 * 128 * 2;
constexpr size_t WS_AFB   = WS_WP + 4 * 128 * 128 * 2;
constexpr size_t WS_UB    = WS_AFB + (size_t)T * 32 * 4;
constexpr size_t WS_VB    = WS_UB + 32 * MB;
constexpr size_t WS_SU    = WS_UB + 16 * MB, WS_SV = WS_VB + 16 * MB;
constexpr size_t WS_RA    = WS_VB + 32 * MB;
constexpr size_t WS_RZ    = WS_RA + 64 * MB;
constexpr size_t WS_RS    = WS_RZ + 128 * MB;
constexpr size_t WS_RO    = WS_RS + 6 * 16 * MB + 1 * MB;
constexpr size_t WS_END   = WS_RO + 128 * MB;
static_assert(WS_END <= 512 * MB, "workspace too large");

struct Params { const float* in[21]; float* out; unsigned char* ws; };

DI unsigned pk2(float a, float b) { f32x2 f = {a, b}; bf16x2v h = __builtin_convertvector(f, bf16x2v); return __builtin_bit_cast(unsigned, h); }
DI float dot2bf(unsigned a, unsigned b, float c) { return __builtin_amdgcn_fdot2_f32_bf16(__builtin_bit_cast(bf16x2v, a), __builtin_bit_cast(bf16x2v, b), c, false); }
DI float bflo(unsigned u) { return __uint_as_float(u << 16); }
DI float bfhi(unsigned u) { return __uint_as_float(u & 0xFFFF0000u); }
DI float wave_sum(float v) {
#pragma unroll
    for (int o = 1; o < 64; o <<= 1) v += __shfl_xor(v, o);
    return v;
}
DI bf16x8 ld_frag16(const bf16_t* p) { return __builtin_bit_cast(bf16x8, *(const u32x4*)p); }
DI bf16x8 ld_frag_perm(const bf16_t* p, int g) {
    const u32x2 lo = *(const u32x2*)(p + 4 * g), hi = *(const u32x2*)(p + 16 + 4 * g);
    u32x4 v = {lo.x, lo.y, hi.x, hi.y}; return __builtin_bit_cast(bf16x8, v);
}
DI int perm32(int k) { return (k & ~31) | (((k >> 2) & 3) << 3) | (((k >> 4) & 1) << 2) | (k & 3); }
DI bf16x8 pack8(const f32x4& a, const f32x4& b) { u32x4 v = {pk2(a[0], a[1]), pk2(a[2], a[3]), pk2(b[0], b[1]), pk2(b[2], b[3])}; return __builtin_bit_cast(bf16x8, v); }
#define MFMA16(a, b, c) __builtin_amdgcn_mfma_f32_16x16x32_bf16((a), (b), (c), 0, 0, 0)
#define MFMA32(a, b, c) __builtin_amdgcn_mfma_f32_32x32x16_bf16((a), (b), (c), 0, 0, 0)

#define XB_TMO      128
#define XB_XCNT(j)  (256  + 64 * (j))
#define XB_XSUB(j)  (1280 + 64 * (j))
#define XB_XGEN(j)  (2304 + 64 * (j))
#define XB_TOP      3328
#define XB_TOPGEN   3392
#define XCD_BAR_WORDS 3456
#define XB_SPIN_CAP (1u << 22)
DI unsigned xb_ld(unsigned* p)              { return __hip_atomic_load(p, __ATOMIC_RELAXED, __HIP_MEMORY_SCOPE_AGENT); }
DI unsigned xb_add(unsigned* p, unsigned v) { return __hip_atomic_fetch_add(p, v, __ATOMIC_RELAXED, __HIP_MEMORY_SCOPE_AGENT); }
DI unsigned xb_xcc_id() { return (unsigned)__builtin_amdgcn_s_getreg((3 << 11) | 20) & 0xFu; }
#define XB_SPIN(cond, bar) do { unsigned _sp = 0; while (cond) { __builtin_amdgcn_s_sleep(1); \
    if ((++_sp & 255u) == 0u) { if (xb_ld(&(bar)[XB_TMO])) break; if (_sp > XB_SPIN_CAP) { atomicAdd(&(bar)[XB_TMO], 1u); break; } } } } while (0)
struct XcdBarrier { unsigned* bar; unsigned x; volatile LAS unsigned* st; };
DI XcdBarrier xcd_barrier_post(unsigned* bar, volatile LAS unsigned* st) {
    XcdBarrier b; b.bar = bar; b.x = xb_xcc_id(); b.st = st;
    if (threadIdx.x == 0) (void)xb_add(&bar[XB_XCNT(b.x)], 1u);
    return b;
}
DI void xcd_barrier_complete(unsigned* bar, unsigned x, unsigned& nloc, unsigned& nx) {
    const unsigned G = gridDim.x * gridDim.y * gridDim.z;
    unsigned sum, cnt, mine, sp = 0u;
    for (;;) {
        sum = 0u; cnt = 0u; mine = 0u;
#pragma unroll
        for (unsigned j = 0; j < 16; ++j) { const unsigned c = xb_ld(&bar[XB_XCNT(j)]); sum += c; cnt += (c > 0u) ? 1u : 0u; mine = (j == x) ? c : mine; }
        if (sum == G) break;
        __builtin_amdgcn_s_sleep(1);
        if ((++sp & 255u) == 0u) { if (xb_ld(&bar[XB_TMO])) break; if (sp > XB_SPIN_CAP) { atomicAdd(&bar[XB_TMO], 1u); break; } }
    }
    nloc = mine > 0u ? mine : 1u; nx = cnt > 0u ? cnt : 1u;
}
DI void xcd_barrier(const XcdBarrier& b) {
    asm volatile("s_waitcnt vmcnt(0)" ::: "memory");
    __syncthreads();
    if (threadIdx.x == 0) {
        unsigned* bar = b.bar;
        __builtin_amdgcn_s_waitcnt(0);
        unsigned nloc = b.st[0], nx = b.st[1];
        if (nloc == 0u) { xcd_barrier_complete(bar, b.x, nloc, nx); b.st[0] = nloc; b.st[1] = nx; }
        const unsigned old = xb_add(&bar[XB_XSUB(b.x)], 1u);
        const unsigned gen = old / nloc;
        if (old + 1u == (gen + 1u) * nloc) {
            __builtin_amdgcn_fence(__ATOMIC_RELEASE, "agent");
            asm volatile("s_waitcnt vmcnt(0)" ::: "memory");
            const unsigned og = xb_add(&bar[XB_TOP], 1u);
            const unsigned tg = og / nx;
            if (og + 1u == (tg + 1u) * nx) xb_add(&bar[XB_TOPGEN], 1u);
            else XB_SPIN(xb_ld(&bar[XB_TOPGEN]) == tg, bar);
            __builtin_amdgcn_fence(__ATOMIC_ACQUIRE, "agent");
            xb_add(&bar[XB_XGEN(b.x)], 1u);
            asm volatile("s_waitcnt vmcnt(0)" ::: "memory");
        } else {
            XB_SPIN(xb_ld(&bar[XB_XGEN(b.x)]) == gen, bar);
            __builtin_amdgcn_fence(__ATOMIC_ACQUIRE, "agent");
            asm volatile("s_waitcnt vmcnt(0)" ::: "memory");
        }
    }
    __syncthreads();
}

constexpr int LDS_BYTES = 152 * 1024;
constexpr int LDS_BARW = LDS_BYTES - 16;

DI void p0_transpose_item(const float* W, int ldw, int K, bf16_t* WT, int dst_row0, int src_col0, float scale, bool zero, LAS float* scr, int kb, int lane) {
    const int k0 = 64 * kb;
#pragma unroll 8
    for (int i = 0; i < 32; ++i) { const int kk = 2 * i + (lane >> 5); scr[kk * 33 + (lane & 31)] = zero ? 0.f : W[(size_t)(k0 + kk) * ldw + src_col0 + (lane & 31)] * scale; }
    asm volatile("s_waitcnt lgkmcnt(0)" ::: "memory");
    const int c = lane & 7;
#pragma unroll
    for (int j = 0; j < 4; ++j) { const int n = (lane >> 3) + 8 * j; const LAS float* s = scr + (8 * c) * 33 + n;
        u32x4 o; o.x = pk2(s[0 * 33], s[1 * 33]); o.y = pk2(s[2 * 33], s[3 * 33]); o.z = pk2(s[4 * 33], s[5 * 33]); o.w = pk2(s[6 * 33], s[7 * 33]);
        *(u32x4*)(WT + (size_t)(dst_row0 + n) * K + k0 + 8 * c) = o; }
    asm volatile("s_waitcnt lgkmcnt(0)" ::: "memory");
}

DI void phase0(const Params& p, LAS unsigned char* lds, int tid, int lane, int wave) {
    asm volatile("" : "+v"(tid), "+v"(lane));
    unsigned char* ws = p.ws;
    LAS float* sl = (LAS float*)lds;
    LAS float* scr = (LAS float*)(lds + 32768 + wave * 8448);
    const float* c = p.in[1];
    for (int e = tid; e < 8192; e += NTH) { const int b = e >> 10, k = e & 1023; const float v = c[e]; sl[k * 8 + b] = v / (1.f + __expf(-v)); }
    __syncthreads();
    const int gw = wave * gridDim.x + blockIdx.x, NGW = gridDim.x * NWV;
    constexpr int I_MOD = 768, I_WIN = 16 * 68, I_WOUT = 16 * 32, I_WQ = 16 * 64, I_WP = 32;
    constexpr int NITEMS = I_MOD + I_WIN + I_WOUT + I_WQ + I_WP;
    for (int it = gw; it < NITEMS; it += NGW) {
        int r = it;
        if (r < I_MOD) {
            const int cg = r % 96, ks = r / 96, n = cg * 64 + lane, k0 = ks * 128;
            const float* W = p.in[2] + (size_t)k0 * 6144 + n;
            float acc[8];
#pragma unroll
            for (int b = 0; b < 8; ++b) acc[b] = 0.f;
#pragma unroll 8
            for (int k = 0; k < 128; ++k) {
                const float w = W[(size_t)k * 6144];
                const f32x4 s0 = *(const LAS f32x4*)(sl + (k0 + k) * 8), s1 = *(const LAS f32x4*)(sl + (k0 + k) * 8 + 4);
                acc[0] += s0[0] * w; acc[1] += s0[1] * w; acc[2] += s0[2] * w; acc[3] += s0[3] * w;
                acc[4] += s1[0] * w; acc[5] += s1[1] * w; acc[6] += s1[2] * w; acc[7] += s1[3] * w;
            }
            float* mp = (float*)(ws + WS_MODP) + (size_t)ks * 8 * 6144 + n;
#pragma unroll
            for (int b = 0; b < 8; ++b) mp[b * 6144] = acc[b];
            continue;
        }
        r -= I_MOD;
        if (r < I_WIN) {
            const int kb = r / 68, nb = r % 68, n0 = nb * 32;
            int src; bool zero = false; float scale = 1.f;
            if (n0 < 1536) { src = n0; if (n0 < 256) scale = 0.125f; } else if (n0 < 2048) src = n0 + 32; else if (n0 < 2080) src = 1536 + (n0 - 2048); else { src = 0; zero = true; }
            p0_transpose_item(p.in[6], 2080, 1024, (bf16_t*)(ws + WS_WIN), n0, src, scale, zero, scr, kb, lane);
            continue;
        }
        r -= I_WIN;
        if (r < I_WOUT) { p0_transpose_item(p.in[14], 1024, 1024, (bf16_t*)(ws + WS_WOUT), (r % 32) * 32, (r % 32) * 32, 1.f, false, scr, r / 32, lane); continue; }
        r -= I_WOUT;
        if (r < I_WQ) { p0_transpose_item(p.in[17], 2048, 1024, (bf16_t*)(ws + WS_WQ), (r % 64) * 32, (r % 64) * 32, 1.f, false, scr, r / 64, lane); continue; }
        r -= I_WQ;
        { const int g = r >> 3, kb = (r >> 2) & 1, nb = r & 3;
          p0_transpose_item(p.in[12] + g * 16384, 128, 128, (bf16_t*)(ws + WS_WP) + g * 16384, nb * 32, nb * 32, 1.f, false, scr, kb, lane); }
    }
    const size_t gt = (size_t)blockIdx.x * NTH + tid, NGT = (size_t)gridDim.x * NTH;
    constexpr size_t NSK = (size_t)16 * 128 * 128 / 8;
    for (size_t j = gt; j < NSK; j += NGT) {
        const float* src = p.in[18]; bf16_t* dst = (bf16_t*)(ws + WS_SKB);
        const f32x4 a = *(const f32x4*)(src + j * 8), b = *(const f32x4*)(src + j * 8 + 4);
        u32x4 o = {pk2(a[0], a[1]), pk2(a[2], a[3]), pk2(b[0], b[1]), pk2(b[2], b[3])};
        *(u32x4*)(dst + j * 8) = o;
    }
}

DI void quant_load(const Params& p, int row, int lane, f32x4 (&v)[4]) {
    const int tb = row >> 14, e = row & 16383;
    const float* src = (tb ? p.in[20] : p.in[19]) + (size_t)e * D + 16 * lane;
#pragma unroll
    for (int q = 0; q < 4; ++q) v[q] = *(const f32x4*)(src + 4 * q);
}
DI void quant_store(const Params& p, int row, int lane, const f32x4 (&v)[4]) {
    unsigned char* ws = p.ws;
    const int tb = row >> 14, e = row & 16383;
    float m = 0.f;
#pragma unroll
    for (int q = 0; q < 4; ++q) m = fmaxf(m, fmaxf(fmaxf(fabsf(v[q][0]), fabsf(v[q][1])), fmaxf(fabsf(v[q][2]), fabsf(v[q][3]))));
#pragma unroll
    for (int o = 1; o < 64; o <<= 1) m = fmaxf(m, __shfl_xor(m, o));
    int ex = (int)((__float_as_uint(m) >> 23) & 0xFFu) - 127;
    if (m < 1e-30f) ex = 7;
    const float sc = __uint_as_float((unsigned)(127 + 7 - ex) << 23), isc = __uint_as_float((unsigned)(127 - 7 + ex) << 23);
    u32x4 o;
    if (tb) {
#pragma unroll
        for (int q = 0; q < 4; ++q) { int w = 0; w = __builtin_amdgcn_cvt_pk_fp8_f32(v[q][0] * sc, v[q][1] * sc, w, false); w = __builtin_amdgcn_cvt_pk_fp8_f32(v[q][2] * sc, v[q][3] * sc, w, true); o[q] = (unsigned)w; }
        if (lane == 0) ((float*)(ws + WS_SV))[e] = isc;
    } else {
        const float s8 = m > 1e-30f ? 127.f / m : 0.f;
#pragma unroll
        for (int q = 0; q < 4; ++q) {
            const int q0 = __float2int_rn(v[q][0] * s8), q1 = __float2int_rn(v[q][1] * s8), q2 = __float2int_rn(v[q][2] * s8), q3 = __float2int_rn(v[q][3] * s8);
            o[q] = (unsigned)(q0 & 0xFF) | ((unsigned)(q1 & 0xFF) << 8) | ((unsigned)(q2 & 0xFF) << 16) | ((unsigned)q3 << 24);
        }
        if (lane == 0) ((float*)(ws + WS_SU))[e] = m * (1.f / 127.f);
    }
    *(u32x4*)(ws + (tb ? WS_VB : WS_UB) + (size_t)e * 1024 + 16 * lane) = o;
}

DI float mod_at(const Params& p, int b, int n) {
    const float* mp = (const float*)(p.ws + WS_MODP) + (size_t)b * 6144 + n;
    float s = p.in[3][n];
#pragma unroll
    for (int ks = 0; ks < 8; ++ks) s += mp[(size_t)ks * 8 * 6144];
    return s;
}

DI void phase1(const Params& p, LAS unsigned char* lds, int tid, int lane, int wave) {
    asm volatile("" : "+v"(tid), "+v"(lane));
    LAS float* lA = (LAS float*)lds; LAS float* lB = lA + 1024;
    const float* x = p.in[0]; bf16_t* H = (bf16_t*)(p.ws + WS_RA);
    for (int rt = blockIdx.x; rt < T / 128; rt += gridDim.x) {
        const int b = rt / 32;
        __syncthreads();
        for (int d = tid; d < 1024; d += NTH) { lA[d] = p.in[4][d] * (1.f + mod_at(p, b, 1024 + d)); lB[d] = mod_at(p, b, d); }
        __syncthreads();
        for (int r0 = wave; r0 < 128; r0 += 4 * NWV) {
            f32x4 v[4][4];
#pragma unroll
            for (int u = 0; u < 4; ++u) { const f32x4* xr = (const f32x4*)(x + ((size_t)rt * 128 + r0 + u * NWV) * D) + lane;
#pragma unroll
                for (int j = 0; j < 4; ++j) v[u][j] = xr[64 * j]; }
#pragma unroll
            for (int u = 0; u < 4; ++u) {
                const size_t row = (size_t)rt * 128 + r0 + u * NWV;
                float ss = 0.f;
#pragma unroll
                for (int j = 0; j < 4; ++j) ss += v[u][j][0] * v[u][j][0] + v[u][j][1] * v[u][j][1] + v[u][j][2] * v[u][j][2] + v[u][j][3] * v[u][j][3];
                const float rstd = rsqrtf(wave_sum(ss) * (1.f / D) + EPS);
                u32x2* o = (u32x2*)(H + row * D) + lane;
#pragma unroll
                for (int j = 0; j < 4; ++j) {
                    const f32x4 a = *(const LAS f32x4*)(lA + 4 * lane + 256 * j), bb = *(const LAS f32x4*)(lB + 4 * lane + 256 * j);
                    u32x2 w = {pk2(v[u][j][0] * rstd * a[0] + bb[0], v[u][j][1] * rstd * a[1] + bb[1]), pk2(v[u][j][2] * rstd * a[2] + bb[2], v[u][j][3] * rstd * a[3] + bb[3])};
                    o[64 * j] = w;
                }
            }
        }
    }
}

DI void afb_tail(const bf16_t* H, const bf16_t* Wt, float* AFB, LAS unsigned char* lds, int tid, int lane, int wave) {
    constexpr int WSTR = 2064;
    asm volatile("" : "+v"(tid), "+v"(lane));
    const int c15 = lane & 15, g = lane >> 4;
    __syncthreads();
#pragma unroll
    for (int ps = 0; ps < 8; ++ps) { const int idx = tid + NTH * ps, n = idx >> 7, ch = idx & 127; *(LAS u32x4*)(lds + n * WSTR + ch * 16) = *(const u32x4*)(Wt + (size_t)n * D + ch * 8); }
    __syncthreads();
    LAS const unsigned char* w0 = lds + c15 * WSTR + 32 * g;
    for (int tile = blockIdx.x; tile < T / 128; tile += gridDim.x) {
        const size_t row = (size_t)tile * 128 + wave * 16 + c15;
        const bf16_t* ap = H + row * D + 16 * g;
        f32x4 acc0 = {0.f, 0.f, 0.f, 0.f}, acc1 = {0.f, 0.f, 0.f, 0.f};
#pragma unroll 1
        for (int hf = 0; hf < 2; ++hf) {
            bf16x8 a[16];
#pragma unroll
            for (int t = 0; t < 8; ++t) { a[2 * t] = *(const bf16x8*)(ap + 512 * hf + 64 * t); a[2 * t + 1] = *(const bf16x8*)(ap + 512 * hf + 64 * t + 8); }
            LAS const unsigned char* wp = w0 + 1024 * hf;
#pragma unroll
            for (int t = 0; t < 8; ++t)
#pragma unroll
                for (int e = 0; e < 2; ++e) {
                    acc0 = MFMA16(*(LAS const bf16x8*)(wp + 128 * t + 16 * e), a[2 * t + e], acc0);
                    acc1 = MFMA16(*(LAS const bf16x8*)(wp + 16 * WSTR + 128 * t + 16 * e), a[2 * t + e], acc1);
                }
        }
        *(f32x4*)(AFB + row * 32 + 4 * g) = acc0;
        *(f32x4*)(AFB + row * 32 + 16 + 4 * g) = acc1;
    }
}

namespace pg8 {
#define PG8_LAS __attribute__((address_space(3)))
constexpr int BM = 256, BK = 64, HALF = 128, HTB = HALF * BK * 2  , STAGE_BYTES = 8 * HTB, NXCD = 8, WGM = 1;

__host__ __device__ __forceinline__ int lds_byte(int r, int c) { const int st = (r >> 4) * 2 + (c >> 5), rr = r & 15, cc = c & 31, ob = rr * 64 + cc * 2; return st * 1024 + (ob ^ (((ob >> 9) & 1) << 5)); }
__host__ __device__ __forceinline__ void stage_rc(int b, int& R, int& C) { const int st = b / 1024, sb = b % 1024, swz = sb ^ (((sb >> 9) & 1) << 5); R = (st >> 1) * 16 + swz / 64; C = (st & 1) * 32 + (swz % 64) / 2; }
__host__ __device__ __forceinline__ int perm32(int rho) { const int n = rho >> 4, i = rho & 15; return 8 * (i >> 2) + 4 * n + (i & 3); }

struct Unit { int pm, pn; };
struct Gemm { const bf16_t* A; const bf16_t* Bt; int M, N, K; };

struct StaticOrder {
    int nM, nN, nwg, G, c;
    __host__ __device__ void init(int M, int N, int G_, int c_) { nM = M / BM; nN = N / BM; nwg = nM * nN; G = G_; c = c_; }
    __host__ __device__ bool next(int i, Unit& u) const {
        const long L = (long)i * G + c; if (L >= nwg) return false;
        int wgid = (int)L; { const int q = nwg / NXCD, r = nwg % NXCD, xcd = wgid % NXCD, off = wgid / NXCD; wgid = (xcd < r ? xcd * (q + 1) : r * (q + 1) + (xcd - r) * q) + off; }
        const int nig = WGM * nN, gid = wgid / nig, fm = gid * WGM, gsz = (nM - fm) < WGM ? (nM - fm) : WGM;
        u.pm = fm + ((wgid % nig) % gsz); u.pn = (wgid % nig) / gsz; return true;
    }
    __device__ __forceinline__ void a_ready(const Unit&) const {}
    __device__ __forceinline__ void done(const Unit&) const {}
};

struct EpiB16 {
    static constexpr bool PERM = true, AFTER_DRAIN = false;
    bf16_t* O; int ldc;
    __device__ __forceinline__ void operator()(const f32x4 (&acc)[2][2][4][2], const Unit& u, int wr, int wc, int fr, int fq) const {
#pragma unroll
        for (int ai = 0; ai < 2; ++ai)
#pragma unroll
            for (int m = 0; m < 4; ++m) { bf16_t* rowp = O + (size_t)(u.pm * BM + ai * HALF + wr * 64 + m * 16 + fr) * ldc + u.pn * BM + wc * 32 + 8 * fq;
#pragma unroll
                for (int bj = 0; bj < 2; ++bj) { const f32x4 v0 = acc[ai][bj][m][0], v1 = acc[ai][bj][m][1];
                    u32x4 w; w.x = ::pk2(v0[0], v0[1]); w.y = ::pk2(v0[2], v0[3]); w.z = ::pk2(v1[0], v1[1]); w.w = ::pk2(v1[2], v1[3]);
                    *(u32x4*)(rowp + bj * HALF) = w; } }
    }
};
struct EpiF {
    static constexpr bool PERM = false, AFTER_DRAIN = false;
    float* O; int ldc;
    __device__ __forceinline__ void operator()(const f32x4 (&acc)[2][2][4][2], const Unit& u, int wr, int wc, int fr, int fq) const {
#pragma unroll
        for (int ai = 0; ai < 2; ++ai)
#pragma unroll
            for (int m = 0; m < 4; ++m) { float* rowp = O + (size_t)(u.pm * BM + ai * HALF + wr * 64 + m * 16 + fr) * ldc + u.pn * BM + wc * 32 + 4 * fq;
#pragma unroll
                for (int bj = 0; bj < 2; ++bj)
#pragma unroll
                    for (int n = 0; n < 2; ++n) *(f32x4*)(rowp + bj * HALF + 16 * n) = acc[ai][bj][m][n]; }
    }
};
template <class Epi, class Sched, bool ALIGN_EPI = false, bool SP2 = false>
__device__ __forceinline__ void gemm_phase(PG8_LAS unsigned char* lds, const Gemm g, const Sched& S, const Epi& E) {
    int tid = threadIdx.x; asm volatile("" : "+v"(tid));
    const int wid = __builtin_amdgcn_readfirstlane(tid >> 6), lane = tid & 63, wr = wid >> 2, wc = wid & 3, fr = lane & 15, fq = lane >> 4;
    const int K = g.K, nt = K / BK;
    unsigned voffA[2], voffB[2];
#pragma unroll
    for (int i = 0; i < 2; ++i) { int R, C; stage_rc(tid * 16 + i * 8192, R, C); const int Rb = Epi::PERM ? ((R & ~31) + perm32(R & 31)) : R;
        voffA[i] = (unsigned)(R * K + C) * 2u; voffB[i] = (unsigned)(Rb * K + C) * 2u; }
    const size_t kstep = (size_t)(BK * 2);
    const size_t hstep = (size_t)HALF * K * 2;
    const size_t tstep = 2 * hstep;
    const unsigned ldsw = (unsigned)wid * 1024u;
    const int aoff = lds_byte(wr * 64 + fr, fq * 8), boff = lds_byte(wc * 32 + fr, fq * 8);
#define PG8_SA(b, h) (((b) * 2 + (h)) * HTB)
#define PG8_SB(b, h) ((4 + (b) * 2 + (h)) * HTB)
#define PG8_STAGE(bufoff, gbase, voff) do { _Pragma("unroll") for (int _i = 0; _i < 2; ++_i) \
        __builtin_amdgcn_global_load_lds((const unsigned*)((const char*)(gbase) + (voff)[_i]), (PG8_LAS unsigned*)(lds + (bufoff) + ldsw + _i * 8192), 16, 0, 0); } while (0)
#define PG8_LDA(dst, b, h) do { _Pragma("unroll") for (int m = 0; m < 4; ++m) _Pragma("unroll") for (int k = 0; k < 2; ++k) dst[m][k] = *(const PG8_LAS bf16x8*)(lds + PG8_SA(b, h) + aoff + m * 2048 + k * 1024); } while (0)
#define PG8_LDB(dst, b, h) do { _Pragma("unroll") for (int n = 0; n < 2; ++n) _Pragma("unroll") for (int k = 0; k < 2; ++k) dst[n][k] = *(const PG8_LAS bf16x8*)(lds + PG8_SB(b, h) + boff + n * 2048 + k * 1024); } while (0)
#define PG8_MMA(ai, bj, At, Bt) do { __builtin_amdgcn_s_setprio(1); _Pragma("unroll") for (int m = 0; m < 4; ++m) _Pragma("unroll") for (int n = 0; n < 2; ++n) _Pragma("unroll") for (int k = 0; k < 2; ++k) \
        acc[ai][bj][m][n] = __builtin_amdgcn_mfma_f32_16x16x32_bf16(Bt[n][k], At[m][k], acc[ai][bj][m][n], 0, 0, 0); __builtin_amdgcn_s_setprio(0); } while (0)
#define PG8_WAIT_V(n) asm volatile("s_waitcnt vmcnt(" #n ")" ::: "memory")
#define PG8_WAIT_L(n) asm volatile("s_waitcnt lgkmcnt(" #n ")" ::: "memory")
#define PG8_BAR __builtin_amdgcn_s_barrier()
#define PG8_SCHED __builtin_amdgcn_sched_barrier(0)
    Unit cur, nxt; int ui = 0;
    if (!S.next(0, cur)) return;
    f32x4 acc[2][2][4][2];
#pragma unroll
    for (int a = 0; a < 2; ++a)
#pragma unroll
        for (int b = 0; b < 2; ++b)
#pragma unroll
            for (int m = 0; m < 4; ++m)
#pragma unroll
                for (int n = 0; n < 2; ++n) acc[a][b][m][n] = (f32x4){0.f, 0.f, 0.f, 0.f};
    bf16x8 At[4][2], B0[2][2], B1[2][2];
    const char* cA = (const char*)g.A + (size_t)cur.pm * tstep; const char* cB = (const char*)g.Bt + (size_t)cur.pn * tstep;
    S.a_ready(cur);
    if constexpr (SP2) {
        PG8_STAGE(PG8_SB(0, 0), cB, voffB); PG8_STAGE(PG8_SB(0, 1), cB + hstep, voffB); PG8_STAGE(PG8_SA(0, 0), cA, voffA); PG8_STAGE(PG8_SA(0, 1), cA + hstep, voffA);
        if (wr == 1) PG8_BAR;
        PG8_WAIT_V(2); PG8_BAR;
        PG8_STAGE(PG8_SB(1, 0), cB + kstep, voffB); PG8_STAGE(PG8_SA(1, 0), cA + kstep, voffA); PG8_STAGE(PG8_SB(1, 1), cB + hstep + kstep, voffB);
        PG8_WAIT_V(6); PG8_BAR;
    } else {
        PG8_STAGE(PG8_SB(0, 0), cB, voffB); PG8_STAGE(PG8_SA(0, 0), cA, voffA); PG8_STAGE(PG8_SB(0, 1), cB + hstep, voffB); PG8_STAGE(PG8_SA(0, 1), cA + hstep, voffA);
        if (wr == 1) PG8_BAR;
        PG8_WAIT_V(4); PG8_BAR;
        PG8_STAGE(PG8_SB(1, 0), cB + kstep, voffB); PG8_STAGE(PG8_SA(1, 0), cA + kstep, voffA); PG8_STAGE(PG8_SB(1, 1), cB + hstep + kstep, voffB);
        PG8_WAIT_V(6); PG8_BAR;
    }
    for (;;) {
        const bool has_next = S.next(ui + 1, nxt);
        const char* nA = has_next ? (const char*)g.A + (size_t)nxt.pm * tstep : cA; const char* nB = has_next ? (const char*)g.Bt + (size_t)nxt.pn * tstep : cB;
        for (int t = 0; t < nt; t += 2) {
            const bool last = (t == nt - 2);
            const char* a1 = cA + (size_t)(t + 1) * kstep;
            const char* a2 = last ? nA : cA + (size_t)(t + 2) * kstep; const char* b2 = last ? nB : cB + (size_t)(t + 2) * kstep;
            const char* a3 = a2 + kstep; const char* b3 = b2 + kstep;
            if (last && has_next) S.a_ready(nxt);
            if constexpr (SP2) {
            PG8_LDB(B0, 0, 0); PG8_LDB(B1, 0, 1); PG8_SCHED; PG8_LDA(At, 0, 0); PG8_STAGE(PG8_SA(1, 1), a1 + hstep, voffA);
            PG8_WAIT_V(8); PG8_WAIT_L(0); PG8_BAR; PG8_MMA(0, 0, At, B0); PG8_MMA(0, 1, At, B1); PG8_BAR; PG8_SCHED;
            PG8_LDA(At, 0, 1); PG8_STAGE(PG8_SB(0, 0), b2, voffB); PG8_STAGE(PG8_SB(0, 1), b2 + hstep, voffB); PG8_STAGE(PG8_SA(0, 0), a2, voffA);
            PG8_WAIT_V(8); PG8_WAIT_L(0); PG8_BAR; PG8_MMA(1, 0, At, B0); PG8_MMA(1, 1, At, B1); PG8_BAR; PG8_SCHED;
            PG8_LDB(B0, 1, 0); PG8_LDB(B1, 1, 1); PG8_SCHED; PG8_LDA(At, 1, 0); PG8_STAGE(PG8_SA(0, 1), a2 + hstep, voffA);
            PG8_WAIT_V(8); PG8_WAIT_L(0); PG8_BAR; PG8_MMA(0, 0, At, B0); PG8_MMA(0, 1, At, B1); PG8_BAR; PG8_SCHED;
            PG8_LDA(At, 1, 1); PG8_STAGE(PG8_SB(1, 0), b3, voffB); PG8_STAGE(PG8_SB(1, 1), b3 + hstep, voffB); PG8_STAGE(PG8_SA(1, 0), a3, voffA);
            PG8_WAIT_V(8); PG8_WAIT_L(0); PG8_BAR; PG8_MMA(1, 0, At, B0); PG8_MMA(1, 1, At, B1); PG8_BAR; PG8_SCHED;
            } else {
            PG8_LDB(B0, 0, 0); PG8_SCHED; PG8_LDA(At, 0, 0); PG8_STAGE(PG8_SA(1, 1), a1 + hstep, voffA);
            PG8_WAIT_L(8); PG8_BAR; PG8_WAIT_L(0); PG8_MMA(0, 0, At, B0); PG8_BAR; PG8_SCHED;
            PG8_LDB(B1, 0, 1); PG8_STAGE(PG8_SB(0, 0), b2, voffB);
            PG8_BAR; PG8_WAIT_L(0); PG8_MMA(0, 1, At, B1); PG8_BAR;
            PG8_LDA(At, 0, 1); PG8_STAGE(PG8_SA(0, 0), a2, voffA);
            PG8_BAR; PG8_WAIT_L(0); PG8_MMA(1, 0, At, B0); PG8_BAR; PG8_SCHED;
            PG8_STAGE(PG8_SB(0, 1), b2 + hstep, voffB);
            PG8_WAIT_V(6); PG8_BAR; PG8_MMA(1, 1, At, B1); PG8_BAR;
            PG8_LDB(B0, 1, 0); PG8_SCHED; PG8_LDA(At, 1, 0); PG8_STAGE(PG8_SA(0, 1), a2 + hstep, voffA);
            PG8_WAIT_L(8); PG8_BAR; PG8_WAIT_L(0); PG8_MMA(0, 0, At, B0); PG8_BAR; PG8_SCHED;
            PG8_LDB(B1, 1, 1); PG8_STAGE(PG8_SB(1, 0), b3, voffB);
            PG8_BAR; PG8_WAIT_L(0); PG8_MMA(0, 1, At, B1); PG8_BAR;
            PG8_LDA(At, 1, 1); PG8_STAGE(PG8_SA(1, 0), a3, voffA);
            PG8_BAR; PG8_WAIT_L(0); PG8_MMA(1, 0, At, B0); PG8_BAR; PG8_SCHED;
            PG8_STAGE(PG8_SB(1, 1), b3 + hstep, voffB);
            PG8_WAIT_V(6); PG8_BAR; PG8_MMA(1, 1, At, B1); PG8_BAR;
            }
        }
        if constexpr (ALIGN_EPI) { if (wr == 0) PG8_BAR; }
        if constexpr (!Epi::AFTER_DRAIN) { E(acc, cur, wr, wc, fr, fq); S.done(cur); }
        if (!has_next) break;
#pragma unroll
        for (int a = 0; a < 2; ++a)
#pragma unroll
            for (int b = 0; b < 2; ++b)
#pragma unroll
                for (int m = 0; m < 4; ++m)
#pragma unroll
                    for (int n = 0; n < 2; ++n) acc[a][b][m][n] = (f32x4){0.f, 0.f, 0.f, 0.f};
        cur = nxt; cA = nA; cB = nB; ++ui;
        if constexpr (ALIGN_EPI) { if (wr == 1) PG8_BAR; }
    }
    PG8_WAIT_V(0);
    if constexpr (!ALIGN_EPI) { if (wr == 0) PG8_BAR; }
    PG8_BAR;
    if constexpr (Epi::AFTER_DRAIN) { E.fused(acc, cur, wr, wc, fr, fq, lds, wid, lane); S.done(cur); }
#undef PG8_SA
#undef PG8_SB
#undef PG8_STAGE
#undef PG8_LDA
#undef PG8_LDB
#undef PG8_MMA
#undef PG8_WAIT_V
#undef PG8_WAIT_L
#undef PG8_BAR
#undef PG8_SCHED
}
}

constexpr size_t WS_QDC  = WS_RS;
constexpr size_t WS_SEGS = WS_RS + 32 * MB;
constexpr size_t WS_GSEG = WS_RS + 48 * MB;
constexpr size_t WS_SC   = WS_RS + 49 * MB;
DI void lds_barrier() { asm volatile("s_waitcnt lgkmcnt(0)" ::: "memory"); __builtin_amdgcn_s_barrier(); asm volatile("" ::: "memory"); }
DI float logsig(float x) { return fminf(x, 0.f) - __logf(1.f + __expf(-fabsf(x))); }

template <int DIR>
DI void ga_task(const Params& p, LAS unsigned char* lds, int tid, int lane, int wave, int task) {
    asm volatile("" : "+v"(tid), "+v"(lane));
    unsigned char* ws = p.ws;
    const bf16_t* Z = (const bf16_t*)(ws + WS_RZ);
    const float* AFB = (const float*)(ws + WS_AFB);
    LAS float* la = (LAS float*)lds;
    LAS float* part = (LAS float*)(lds + 17408);
    LAS float* gs = (LAS float*)(lds + 18432);
    LAS float* elb = (LAS float*)(lds + 18944);
    LAS float* wl = (LAS float*)(lds + 19968);
    LAS bf16_t* sL  = (LAS bf16_t*)(lds + 24064);
    LAS unsigned char* obuf = lds + 42496;
    const int c15 = lane & 15, g = lane >> 4;
    const int i = tid >> 3, dg = tid & 7, d0 = dg * 8;
#define TROW(r) ((r) * 72 + ((r) >> 3) * 8)
    constexpr int dir = DIR; const int h = (task >> 1) & 3, pb = (task >> 3) & 7, b = task >> 6;
    const int bhd = b * 8 + h * 2 + dir, sg = dir ? 7 - pb : pb;
    bf16_t* QDC = (bf16_t*)(ws + WS_QDC + (dir ? 16 : 0) * MB);
    bf16_t* OL = (bf16_t*)(ws + WS_RO + (dir ? 64 : 0) * MB);
    f32x4 S[4];
#pragma unroll
    for (int kt = 0; kt < 4; ++kt) S[kt] = (f32x4){0.f, 0.f, 0.f, 0.f};
    __syncthreads();
    for (int e = tid; e < 128 * 72 / 2; e += NTH) ((LAS unsigned*)sL)[e] = 0u;
    if (tid < 64) gs[tid] = 0.f;
    for (int e = tid; e < 1024; e += NTH) wl[e] = (dir ? p.in[9] : p.in[7])[(e >> 6) * 256 + h * 64 + (e & 63)];
    typedef short s16x4w __attribute__((ext_vector_type(4)));
    s16x4w wfr[2]; float bias[2];
    __syncthreads();
#pragma unroll
    for (int u = 0; u < 2; ++u) {
        const int d = 16 * (2 * (wave >> 2) + u) + c15;
        const u32x2 wp = {pk2(wl[(4 * g) * 64 + d], wl[(4 * g + 1) * 64 + d]), pk2(wl[(4 * g + 2) * 64 + d], wl[(4 * g + 3) * 64 + d])};
        wfr[u] = __builtin_bit_cast(s16x4w, wp);
        bias[u] = (dir ? p.in[10] : p.in[8])[h * 64 + d];
    }
    const int mt = wave & 3;
    f32x4 avn;
    { const int n0 = dir ? pb * 8 + 7 : pb * 8; avn = *(const f32x4*)(AFB + ((size_t)b * SEQ + n0 * 64 + 16 * mt + c15) * 32 + dir * 16 + 4 * g); }
#pragma unroll 1
    for (int ci = -1; ci < 8; ++ci) {
        const bool has_cur = ci >= 0, has_nxt = ci < 7;
        const int cx = ci + 1;
        const int nx = dir ? pb * 8 + 7 - cx : pb * 8 + cx, tokx = b * SEQ + nx * 64;
        const int nc = dir ? pb * 8 + 7 - ci : pb * 8 + ci, tokc = b * SEQ + nc * 64;
        LAS unsigned char* bx = obuf + (cx & 1) * 46464; LAS unsigned char* bc = obuf + (ci & 1) * 46464;
        LAS float* elx = elb + (cx & 1) * 128; LAS float* elc = elb + (ci & 1) * 128;
        u32x4 qv, kv, vvp[2]; float lv[2][4];
        if (ci > 0) {
#pragma unroll
            for (int kt = 0; kt < 4; ++kt) { const u32x2 w = {pk2(S[kt][0], S[kt][1]), pk2(S[kt][2], S[kt][3])}; *(LAS u32x2*)(sL + (16 * wave + c15) * 72 + 16 * kt + 4 * g) = w; }
        }
        if (has_nxt) {
            const size_t t = (size_t)tokx + i;
            qv = *(const u32x4*)(Z + t * ZW + h * 64 + d0); kv = *(const u32x4*)(Z + t * ZW + 256 + h * 64 + d0);
#pragma unroll
            for (int ps = 0; ps < 2; ++ps) { const int idx = tid + NTH * ps, vi = idx >> 4, ch = idx & 15; vvp[ps] = *(const u32x4*)(Z + ((size_t)tokx + vi) * ZW + 512 + h * 128 + ch * 8); }
            typedef short s16x4v __attribute__((ext_vector_type(4)));
            const u32x2 ap = {pk2(avn[0], avn[1]), pk2(avn[2], avn[3])};
            const s16x4v af = __builtin_bit_cast(s16x4v, ap);
            { const int c2 = cx < 7 ? cx + 1 : cx, n2 = dir ? pb * 8 + 7 - c2 : pb * 8 + c2; avn = *(const f32x4*)(AFB + ((size_t)b * SEQ + n2 * 64 + 16 * mt + c15) * 32 + dir * 16 + 4 * g); }
#pragma unroll
            for (int u = 0; u < 2; ++u) {
                const int d = 16 * (2 * (wave >> 2) + u) + c15;
                const f32x4 x = __builtin_amdgcn_mfma_f32_16x16x16bf16_1k(af, wfr[u], (f32x4){0.f, 0.f, 0.f, 0.f}, 0, 0, 0);
                float v0 = logsig(x[0] + bias[u]) * 0.0625f, v1 = logsig(x[1] + bias[u]) * 0.0625f, v2 = logsig(x[2] + bias[u]) * 0.0625f, v3 = logsig(x[3] + bias[u]) * 0.0625f;
                float T, T2, T3;
                if (dir == 0) {
                    v1 += v0; v2 += v1; v3 += v2; T = v3;
                    const float t1 = __shfl_up(T, 16); T2 = T + (g >= 1 ? t1 : 0.f);
                    const float t2 = __shfl_up(T2, 32); T3 = T2 + (g >= 2 ? t2 : 0.f);
                    if (g == 3) part[mt * 64 + d] = T3;
                } else {
                    v2 += v3; v1 += v2; v0 += v1; T = v0;
                    const float t1 = __shfl_down(T, 16); T2 = T + (g <= 2 ? t1 : 0.f);
                    const float t2 = __shfl_down(T2, 32); T3 = T2 + (g <= 1 ? t2 : 0.f);
                    if (g == 0) part[mt * 64 + d] = T3;
                }
                const float off = T3 - T;
                lv[u][0] = v0 + off; lv[u][1] = v1 + off; lv[u][2] = v2 + off; lv[u][3] = v3 + off;
            }
        }
        lds_barrier();
        if (has_nxt) {
#pragma unroll
            for (int u = 0; u < 2; ++u) {
                const int d = 16 * (2 * (wave >> 2) + u) + c15;
                float off = 0.f;
#pragma unroll
                for (int m2 = 0; m2 < 4; ++m2) { const bool take = dir ? (m2 > mt) : (m2 < mt); off += take ? part[m2 * 64 + d] : 0.f; }
#pragma unroll
                for (int r = 0; r < 4; ++r) la[(16 * mt + 4 * g + r) * 68 + d] = lv[u][r] + off;
                if (mt == (dir ? 0 : 3) && g == (dir ? 0 : 3)) {
                    const float tot = lv[u][dir ? 0 : 3] + off, gsum = gs[(cx & 1) * 64 + d];
                    elx[d] = __expf(tot); elx[64 + d] = __expf(gsum); gs[((cx + 1) & 1) * 64 + d] = gsum + tot;
                }
            }
        }
        lds_barrier();
        if (has_nxt) {
            LAS bf16_t* qdL = (LAS bf16_t*)bx; LAS bf16_t* kiL = (LAS bf16_t*)(bx + 9216); LAS bf16_t* keT = (LAS bf16_t*)(bx + 18432); LAS bf16_t* vT = (LAS bf16_t*)(bx + 27776);
            const size_t t = (size_t)tokx + i;
            float q[8], k[8];
#pragma unroll
            for (int e = 0; e < 4; ++e) { q[2 * e] = bflo(qv[e]); q[2 * e + 1] = bfhi(qv[e]); k[2 * e] = bflo(kv[e]); k[2 * e + 1] = bfhi(kv[e]); }
            float qd[8], ki[8], ke[8], qc[8];
#pragma unroll
            for (int e = 0; e < 8; ++e) {
                const float E = __expf(la[i * 68 + d0 + e]), R = __builtin_amdgcn_rcpf(E);
                qd[e] = q[e] * E; ki[e] = k[e] * R; ke[e] = ki[e] * elx[d0 + e]; qc[e] = qd[e] * elx[64 + d0 + e];
            }
            const u32x4 o1 = {pk2(qd[0], qd[1]), pk2(qd[2], qd[3]), pk2(qd[4], qd[5]), pk2(qd[6], qd[7])};
            const u32x4 o2 = {pk2(ki[0], ki[1]), pk2(ki[2], ki[3]), pk2(ki[4], ki[5]), pk2(ki[6], ki[7])};
            const u32x4 o3 = {pk2(qc[0], qc[1]), pk2(qc[2], qc[3]), pk2(qc[4], qc[5]), pk2(qc[6], qc[7])};
            *(LAS u32x4*)(qdL + i * 72 + d0) = o1; *(LAS u32x4*)(kiL + i * 72 + d0) = o2;
            *(u32x4*)(QDC + t * 256 + h * 64 + d0) = o3;
#pragma unroll
            for (int e = 0; e < 4; ++e) { const unsigned w = pk2(ke[2 * e], ke[2 * e + 1]); keT[TROW(d0 + 2 * e) + perm32(i)] = (bf16_t)(w & 0xFFFFu); keT[TROW(d0 + 2 * e + 1) + perm32(i)] = (bf16_t)(w >> 16); }
#pragma unroll
            for (int ps = 0; ps < 2; ++ps) {
                const int idx = tid + NTH * ps, vi = idx >> 4, ch = idx & 15;
#pragma unroll
                for (int e = 0; e < 4; ++e) { vT[TROW(ch * 8 + 2 * e) + perm32(vi)] = (bf16_t)(vvp[ps][e] & 0xFFFFu); vT[TROW(ch * 8 + 2 * e + 1) + perm32(vi)] = (bf16_t)(vvp[ps][e] >> 16); }
            }
        }
        if (has_cur) {
            const LAS bf16_t* qdL = (const LAS bf16_t*)bc; const LAS bf16_t* kiL = (const LAS bf16_t*)(bc + 9216); const LAS bf16_t* keT = (const LAS bf16_t*)(bc + 18432); const LAS bf16_t* vT = (const LAS bf16_t*)(bc + 27776);
            const int it = wave & 3, dvh = wave >> 2;
            bf16x8 qdb[2];
#pragma unroll
            for (int s = 0; s < 2; ++s) qdb[s] = *(const LAS bf16x8*)(qdL + (16 * it + c15) * 72 + 32 * s + 8 * g);
            f32x4 sc[4];
#pragma unroll
            for (int jt = 0; jt < 4; ++jt) {
                sc[jt] = (f32x4){0.f, 0.f, 0.f, 0.f};
#pragma unroll
                for (int s = 0; s < 2; ++s) sc[jt] = MFMA16(*(const LAS bf16x8*)(kiL + (16 * jt + c15) * 72 + 32 * s + 8 * g), qdb[s], sc[jt]);
                const int ii = 16 * it + c15;
#pragma unroll
                for (int r = 0; r < 4; ++r) { const int jj = 16 * jt + 4 * g + r; const bool keep = dir ? (jj > ii) : (jj <= ii); sc[jt][r] = keep ? sc[jt][r] : 0.f; }
            }
            const bf16x8 pa[2] = {pack8(sc[0], sc[1]), pack8(sc[2], sc[3])};
#pragma unroll
            for (int nt = 0; nt < 4; ++nt) {
                const int dvr = 64 * dvh + 16 * nt + c15;
                f32x4 o = (f32x4){0.f, 0.f, 0.f, 0.f};
#pragma unroll
                for (int s = 0; s < 2; ++s) {
                    o = MFMA16(*(const LAS bf16x8*)(vT + TROW(dvr) + 32 * s + 8 * g), pa[s], o);
                    o = MFMA16(*(const LAS bf16x8*)(sL + dvr * 72 + 32 * s + 8 * g), qdb[s], o);
                }
                const u32x2 w = {pk2(o[0], o[1]), pk2(o[2], o[3])};
                *(u32x2*)(OL + ((size_t)tokc + 16 * it + c15) * 512 + h * 128 + 64 * dvh + 16 * nt + 4 * g) = w;
            }
            bf16x8 vb[2];
#pragma unroll
            for (int s = 0; s < 2; ++s) vb[s] = *(const LAS bf16x8*)(vT + TROW(16 * wave + c15) + 32 * s + 8 * g);
#pragma unroll
            for (int kt = 0; kt < 4; ++kt) {
                const f32x4 gm = *(const LAS f32x4*)(elc + 16 * kt + 4 * g);
                f32x4 a = S[kt] * gm;
#pragma unroll
                for (int s = 0; s < 2; ++s) a = MFMA16(*(const LAS bf16x8*)(keT + TROW(16 * kt + c15) + 32 * s + 8 * g), vb[s], a);
                S[kt] = a;
            }
        }
        lds_barrier();
    }
    {
        float* SEGS = (float*)(ws + WS_SEGS) + (size_t)(bhd * 8 + sg) * 64 * 128;
#pragma unroll
        for (int kt = 0; kt < 4; ++kt)
#pragma unroll
            for (int r = 0; r < 4; ++r) SEGS[(16 * kt + 4 * g + r) * 128 + 16 * wave + c15] = S[kt][r];
        if (tid < 64) ((float*)(ws + WS_GSEG))[(bhd * 8 + sg) * 64 + tid] = __expf(gs[tid]);
    }
}
#undef TROW

DI void phaseGA(const Params& p, LAS unsigned char* lds, int tid, int lane, int wave) {
    for (int task = blockIdx.x; task < 512; task += gridDim.x) { if (task & 1) ga_task<1>(p, lds, tid, lane, wave, task); else ga_task<0>(p, lds, tid, lane, wave, task); }
}

DI void phaseGB(const Params& p, int tid) {
    unsigned char* ws = p.ws;
    const float* SEGS = (const float*)(ws + WS_SEGS); const float* GSEG = (const float*)(ws + WS_GSEG); bf16_t* SC = (bf16_t*)(ws + WS_SC);
    for (int e = blockIdx.x * NTH + tid; e < 64 * 128 * 16; e += gridDim.x * NTH) {
        const int dv = e & 127, dk4 = (e >> 7) & 15, bhd = e >> 11;
        float c[4] = {0.f, 0.f, 0.f, 0.f};
        for (int sg = 0; sg < 8; ++sg) {
            const u32x2 w = {pk2(c[0], c[1]), pk2(c[2], c[3])};
            *(u32x2*)(SC + ((size_t)(bhd * 8 + sg) * 128 + dv) * 64 + 4 * dk4) = w;
            const f32x4 gm = *(const f32x4*)(GSEG + (bhd * 8 + sg) * 64 + 4 * dk4);
#pragma unroll
            for (int r = 0; r < 4; ++r) c[r] = gm[r] * c[r] + SEGS[((size_t)(bhd * 8 + sg) * 64 + 4 * dk4 + r) * 128 + dv];
        }
    }
}

DI void phase4a(const Params& p, LAS unsigned char* lds, int tid, int lane, int wave) {
    asm volatile("" : "+v"(tid), "+v"(lane));
    unsigned char* ws = p.ws;
    const bf16_t* Z = (const bf16_t*)(ws + WS_RZ);
    bf16_t* MIX = (bf16_t*)(ws + WS_RA);
    const bf16_t* OF = (const bf16_t*)(ws + WS_RO); const bf16_t* OB = (const bf16_t*)(ws + WS_RO + 64 * MB);
    const bf16_t* WP = (const bf16_t*)(ws + WS_WP);
    LAS bf16_t* pt = (LAS bf16_t*)lds;
    LAS unsigned char* at = lds + 81920;
    const int c15 = lane & 15, g = lane >> 4;
    for (int tile = blockIdx.x; tile < T / 64; tile += gridDim.x) {
        const int tok0 = tile * 64, s0 = tok0 & (SEQ - 1);
        __syncthreads();
#pragma unroll
        for (int ps = 0; ps < 10; ++ps) {
            const int idx = tid + NTH * ps, rr = idx >> 6, ch = idx & 63, sq = s0 - 8 + rr;
            u32x4 v = {0u, 0u, 0u, 0u};
            if (sq >= 0 && sq < SEQ) v = *(const u32x4*)(Z + ((size_t)tok0 - 8 + rr) * ZW + 1536 + ch * 8);
            *(LAS u32x4*)(pt + rr * 512 + ch * 8) = v;
        }
        {
            const int hh = wave >> 1, ih = wave & 1, bb = tok0 / SEQ, nn = s0 >> 6;
            f32x4 acc[8][2];
#pragma unroll
            for (int mt = 0; mt < 8; ++mt) { acc[mt][0] = (f32x4){0.f, 0.f, 0.f, 0.f}; acc[mt][1] = (f32x4){0.f, 0.f, 0.f, 0.f}; }
#pragma unroll
            for (int dir = 0; dir < 2; ++dir) {
                const int sg = dir ? 7 - (nn >> 3) : (nn >> 3), bhd = bb * 8 + hh * 2 + dir;
                const bf16_t* SCp = (const bf16_t*)(ws + WS_SC) + (size_t)(bhd * 8 + sg) * 128 * 64;
                const bf16_t* QCp = (const bf16_t*)(ws + WS_QDC + (dir ? 16 : 0) * MB) + ((size_t)tok0 + 32 * ih) * 256 + hh * 64;
                if (sg != 0)
#pragma unroll
                for (int s = 0; s < 2; ++s) {
                    const bf16x8 q0 = ld_frag16(QCp + (size_t)c15 * 256 + 32 * s + 8 * g), q1 = ld_frag16(QCp + (size_t)(16 + c15) * 256 + 32 * s + 8 * g);
#pragma unroll
                    for (int mt = 0; mt < 8; ++mt) {
                        const bf16x8 af = ld_frag16(SCp + (16 * mt + c15) * 64 + 32 * s + 8 * g);
                        acc[mt][0] = MFMA16(af, q0, acc[mt][0]); acc[mt][1] = MFMA16(af, q1, acc[mt][1]);
                    }
                }
            }
#pragma unroll
            for (int nt = 0; nt < 2; ++nt)
#pragma unroll
                for (int mt = 0; mt < 8; ++mt) { const f32x4 o = acc[mt][nt]; const u32x2 w = {pk2(o[0], o[1]), pk2(o[2], o[3])};
                    *(LAS u32x2*)(at + (32 * ih + 16 * nt + c15) * 1040 + (hh * 128 + 16 * mt + 4 * g) * 2) = w; }
        }
        __syncthreads();
        {
            const f32x4 gh0 = *(const f32x4*)(p.in[11] + 8 * lane), gh1 = *(const f32x4*)(p.in[11] + 8 * lane + 4);
#pragma unroll
            for (int hb = 0; hb < 2; ++hb) {
                u32x4 a[4], bq[4], rv[4], cv[4];
#pragma unroll
                for (int j = 0; j < 4; ++j) { const int tl = wave * 8 + hb * 4 + j; const size_t t = (size_t)tok0 + tl;
                    a[j] = *(const u32x4*)(OF + t * 512 + 8 * lane); bq[j] = *(const u32x4*)(OB + t * 512 + 8 * lane); rv[j] = *(const u32x4*)(Z + t * ZW + 1024 + 8 * lane);
                    cv[j] = *(const LAS u32x4*)(at + tl * 1040 + 16 * lane); }
#pragma unroll
                for (int j = 0; j < 4; ++j) { const size_t t = (size_t)tok0 + wave * 8 + hb * 4 + j;
                    float o[8], r[8];
#pragma unroll
                    for (int e = 0; e < 4; ++e) { o[2 * e] = bflo(a[j][e]) + bflo(bq[j][e]) + bflo(cv[j][e]); o[2 * e + 1] = bfhi(a[j][e]) + bfhi(bq[j][e]) + bfhi(cv[j][e]); r[2 * e] = bflo(rv[j][e]); r[2 * e + 1] = bfhi(rv[j][e]); }
                    float ss = 0.f;
#pragma unroll
                    for (int e = 0; e < 8; ++e) ss += o[e] * o[e];
                    ss += __shfl_xor(ss, 1); ss += __shfl_xor(ss, 2); ss += __shfl_xor(ss, 4); ss += __shfl_xor(ss, 8);
                    const float rstd = rsqrtf(ss * (1.f / 128.f) + EPS);
                    float y[8];
#pragma unroll
                    for (int e = 0; e < 8; ++e) { const float gg = e < 4 ? gh0[e] : gh1[e - 4]; y[e] = o[e] * rstd * gg * (r[e] / (1.f + __expf(-r[e]))); }
                    const u32x4 w = {pk2(y[0], y[1]), pk2(y[2], y[3]), pk2(y[4], y[5]), pk2(y[6], y[7])};
                    *(u32x4*)(MIX + t * D + 8 * lane) = w; }
            }
        }
        __syncthreads();
        {
            const int c = tid, gi = c >> 7, cc = c & 127, hw = 1 << gi;
            LAS unsigned char* ag = at + gi * 16384;
            const LAS bf16_t* pc = pt + c;
            if (s0 >= 8 && s0 + 64 + 8 <= SEQ) {
                const float inv = 0.5f / (float)hw;
                float sum = 0.f;
                for (int rr = 8 - hw; rr < 8 + hw; ++rr) sum += bflo((unsigned)pc[rr * 512]);
#pragma unroll 4
                for (int i = 0; i < 64; ++i) {
                    const float val = sum * inv - bflo((unsigned)pc[(i + 8) * 512]);
                    *(LAS bf16_t*)(ag + i * 256 + (((cc >> 3) ^ (i & 15)) * 16) + (cc & 7) * 2) = (bf16_t)(pk2(val, 0.f) & 0xFFFFu);
                    sum += bflo((unsigned)pc[(i + 8 + hw) * 512]) - bflo((unsigned)pc[(i + 8 - hw) * 512]);
                }
            } else {
                float sum = 0.f;
                {   const int lo = max(s0 - hw, 0), hi = min(s0 + hw, SEQ);
                    for (int rr = lo; rr < hi; ++rr) sum += bflo((unsigned)pc[(rr - s0 + 8) * 512]); }
#pragma unroll 4
                for (int i = 0; i < 64; ++i) {
                    const int sq = s0 + i, lo = max(sq - hw, 0), hi = min(sq + hw, SEQ);
                    const float val = sum * __builtin_amdgcn_rcpf((float)(hi - lo)) - bflo((unsigned)pc[(i + 8) * 512]);
                    *(LAS bf16_t*)(ag + i * 256 + (((cc >> 3) ^ (i & 15)) * 16) + (cc & 7) * 2) = (bf16_t)(pk2(val, 0.f) & 0xFFFFu);
                    if (sq + hw < SEQ) sum += bflo((unsigned)pc[(i + 8 + hw) * 512]);
                    if (sq - hw >= 0) sum -= bflo((unsigned)pc[(i + 8 - hw) * 512]);
                }
            }
        }
        __syncthreads();
        {
            const int gi = wave >> 1, dh = wave & 1;
            LAS unsigned char* ag = at + gi * 16384;
            f32x4 acc[4][4];
#pragma unroll
            for (int mt = 0; mt < 4; ++mt)
#pragma unroll
                for (int nt = 0; nt < 4; ++nt) acc[mt][nt] = (f32x4){0.f, 0.f, 0.f, 0.f};
#pragma unroll
            for (int s = 0; s < 4; ++s) {
                bf16x8 af[4];
#pragma unroll
                for (int mt = 0; mt < 4; ++mt) { const int row = mt * 16 + c15; af[mt] = *(const LAS bf16x8*)(ag + row * 256 + (((4 * s + g) ^ (row & 15)) * 16)); }
#pragma unroll
                for (int nt = 0; nt < 4; ++nt) {
                    const bf16x8 wf = ld_frag16(WP + (size_t)gi * 16384 + (dh * 64 + 16 * nt + c15) * 128 + 32 * s + 8 * g);
#pragma unroll
                    for (int mt = 0; mt < 4; ++mt) acc[mt][nt] = MFMA16(wf, af[mt], acc[mt][nt]);
                }
            }
#pragma unroll
            for (int nt = 0; nt < 4; ++nt) {
                const f32x4 ps = *(const f32x4*)(p.in[13] + gi * 128 + dh * 64 + 16 * nt + 4 * g);
#pragma unroll
                for (int mt = 0; mt < 4; ++mt) {
                    const f32x4 v = acc[mt][nt] * ps;
                    u32x2 w = {pk2(v[0], v[1]), pk2(v[2], v[3])};
                    *(u32x2*)(MIX + ((size_t)tok0 + mt * 16 + c15) * D + 512 + gi * 128 + dh * 64 + 16 * nt + 4 * g) = w;
                }
            }
        }
    }
}

DI void phase4c(const Params& p, LAS unsigned char* lds, int tid, int lane, int wave) {
    asm volatile("" : "+v"(tid), "+v"(lane));
    LAS float* lG = (LAS float*)lds; LAS float* lA = lG + 1024; LAS float* lB = lA + 1024; LAS float* lP = lB + 1024;
    const float* x = p.in[0]; const bf16_t* MIXO = (const bf16_t*)(p.ws + WS_RZ); bf16_t* H2 = (bf16_t*)(p.ws + WS_RA);
    for (int rt = blockIdx.x; rt < T / 128; rt += gridDim.x) {
        const int b = rt / 32;
        __syncthreads();
        for (int d = tid; d < 1024; d += NTH) { lG[d] = mod_at(p, b, 2048 + d); lA[d] = p.in[15][d] * (1.f + mod_at(p, b, 4096 + d)); lB[d] = mod_at(p, b, 3072 + d); lP[d] = p.in[5][d]; }
        __syncthreads();
        for (int r0 = wave; r0 < 128; r0 += 4 * NWV) {
            f32x4 m[4][4], xv[4][4];
#pragma unroll
            for (int u = 0; u < 4; ++u) {
                const size_t row = (size_t)rt * 128 + r0 + u * NWV;
                const u32x2* mr = (const u32x2*)(MIXO + row * D) + lane; const f32x4* xr = (const f32x4*)(x + row * D) + lane;
#pragma unroll
                for (int j = 0; j < 4; ++j) { const u32x2 mv = mr[64 * j]; m[u][j] = (f32x4){bflo(mv.x), bfhi(mv.x), bflo(mv.y), bfhi(mv.y)}; xv[u][j] = xr[64 * j]; }
            }
#pragma unroll
            for (int u = 0; u < 4; ++u) {
                const size_t row = (size_t)rt * 128 + r0 + u * NWV;
                float ss = 0.f;
#pragma unroll
                for (int j = 0; j < 4; ++j) ss += m[u][j][0] * m[u][j][0] + m[u][j][1] * m[u][j][1] + m[u][j][2] * m[u][j][2] + m[u][j][3] * m[u][j][3];
                const float rstd = rsqrtf(wave_sum(ss) * (1.f / D) + EPS);
                float s2 = 0.f;
#pragma unroll
                for (int j = 0; j < 4; ++j) {
                    const f32x4 gt = *(const LAS f32x4*)(lG + 4 * lane + 256 * j), pm = *(const LAS f32x4*)(lP + 4 * lane + 256 * j);
                    xv[u][j] = xv[u][j] + gt * (m[u][j] * rstd * pm);
                    s2 += xv[u][j][0] * xv[u][j][0] + xv[u][j][1] * xv[u][j][1] + xv[u][j][2] * xv[u][j][2] + xv[u][j][3] * xv[u][j][3];
                }
                const float rstd2 = rsqrtf(wave_sum(s2) * (1.f / D) + EPS);
                u32x2* orow = (u32x2*)((bf16_t*)(p.ws + WS_RO) + row * D) + lane; u32x2* hrow = (u32x2*)(H2 + row * D) + lane;
#pragma unroll
                for (int j = 0; j < 4; ++j) {
                    { const u32x2 xw = {pk2(xv[u][j][0], xv[u][j][1]), pk2(xv[u][j][2], xv[u][j][3])}; orow[64 * j] = xw; }
                    const f32x4 a = *(const LAS f32x4*)(lA + 4 * lane + 256 * j), bb = *(const LAS f32x4*)(lB + 4 * lane + 256 * j);
                    const f32x4 hv = xv[u][j] * rstd2 * a + bb;
                    u32x2 w = {pk2(hv[0], hv[1]), pk2(hv[2], hv[3])};
                    hrow[64 * j] = w;
                }
            }
        }
    }
}

DI int skey(float v, int idx, int mask) { int u = __float_as_int(v); u ^= (u >> 31) & 0x7FFFFFFF; return (u & ~mask) | idx; }
DI float sval(int k, int mask) { int u = k & ~mask; u ^= (u >> 31) & 0x7FFFFFFF; return __int_as_float(u); }
DI void cswap(int& a, int& b) { const int mx = max(a, b), mn = min(a, b); a = mx; b = mn; }
DI void sort16_desc(int (&a)[16]) {
    cswap(a[0], a[13]); cswap(a[1], a[12]); cswap(a[2], a[15]); cswap(a[3], a[14]); cswap(a[4], a[8]); cswap(a[5], a[6]); cswap(a[7], a[11]); cswap(a[9], a[10]);
    cswap(a[0], a[5]); cswap(a[1], a[7]); cswap(a[2], a[9]); cswap(a[3], a[4]); cswap(a[6], a[13]); cswap(a[8], a[14]); cswap(a[10], a[15]); cswap(a[11], a[12]);
    cswap(a[0], a[1]); cswap(a[2], a[3]); cswap(a[4], a[5]); cswap(a[6], a[8]); cswap(a[7], a[9]); cswap(a[10], a[11]); cswap(a[12], a[13]); cswap(a[14], a[15]);
    cswap(a[0], a[2]); cswap(a[1], a[3]); cswap(a[4], a[10]); cswap(a[5], a[11]); cswap(a[6], a[7]); cswap(a[8], a[9]); cswap(a[12], a[14]); cswap(a[13], a[15]);
    cswap(a[1], a[2]); cswap(a[3], a[12]); cswap(a[4], a[6]); cswap(a[5], a[7]); cswap(a[8], a[10]); cswap(a[9], a[11]); cswap(a[13], a[14]);
    cswap(a[1], a[4]); cswap(a[2], a[6]); cswap(a[5], a[8]); cswap(a[7], a[10]); cswap(a[9], a[13]); cswap(a[11], a[14]);
    cswap(a[2], a[4]); cswap(a[3], a[6]); cswap(a[9], a[12]); cswap(a[11], a[13]);
    cswap(a[3], a[5]); cswap(a[6], a[8]); cswap(a[7], a[9]); cswap(a[10], a[12]);
    cswap(a[3], a[4]); cswap(a[5], a[6]); cswap(a[7], a[8]); cswap(a[9], a[10]); cswap(a[11], a[12]);
    cswap(a[6], a[7]); cswap(a[8], a[9]);
}
DI void merge16_desc(int (&x)[16], const int (&y)[16]) {
#pragma unroll
    for (int i = 0; i < 16; ++i) x[i] = max(x[i], y[15 - i]);
#pragma unroll
    for (int j = 8; j > 0; j >>= 1) {
#pragma unroll
        for (int i = 0; i < 16; ++i) { const int l = i ^ j; if (l > i) cswap(x[i], x[l]); }
    }
}

DI void phase5b(const Params& p, LAS unsigned char* lds, int tid, int lane, int wave) {
    asm volatile("" : "+v"(tid), "+v"(lane));
    unsigned char* ws = p.ws;
    const bf16_t* Q2 = (const bf16_t*)(ws + WS_RZ);
    const bf16_t* SKB = (const bf16_t*)(ws + WS_SKB);
    int* EIDX = (int*)(ws + WS_RS);
    LAS unsigned char* tab = lds + tid * 32;
    LAS unsigned char* skl = lds + 16384;
    const int c31 = lane & 31, hi = lane >> 5;
    for (int btask = blockIdx.x; btask < 256; btask += gridDim.x) {
        const int h = btask & 7, tgc = btask >> 3;
        __syncthreads();
#pragma unroll
        for (int ps = 0; ps < 8; ++ps) {
            const int idx = tid + NTH * ps, row = idx >> 4, ch = idx & 15;
            const u32x4 v = *(const u32x4*)(SKB + ((size_t)h * 256 + row) * 128 + ch * 8);
            *(LAS u32x4*)(skl + row * 256 + ((ch ^ (row & 15)) * 16)) = v;
        }
        __syncthreads();
      f32x4 qa[4];
      const int qrow0 = (btask * NWV + wave) * 16;
      quant_load(p, qrow0, lane, qa);
      for (int ti = 0; ti < 4; ++ti) {
        const int tg = tgc * 32 + wave * 4 + ti;
        const size_t tok = (size_t)tg * 32 + c31;
        int lst[2][16];
        bf16x8 bq[2][8];
#pragma unroll
        for (int pp = 0; pp < 2; ++pp) {
            const bf16_t* qp = Q2 + tok * 2048 + h * 256 + pp * 128 + 8 * hi;
            asm volatile("" : "+v"(qp));
#pragma unroll
            for (int ks = 0; ks < 8; ++ks) bq[pp][ks] = ld_frag16(qp + 16 * ks);
        }
#pragma unroll
        for (int pp = 0; pp < 2; ++pp) {
            int run[16];
#pragma unroll
            for (int r = 0; r < 16; ++r) run[r] = (int)0x80000000;
#pragma unroll 1
            for (int kt = 0; kt < 4; ++kt) {
                const LAS unsigned char* kb = skl + pp * 32768 + (32 * kt + c31) * 256;
                f32x16 acc;
#pragma unroll
                for (int r = 0; r < 16; ++r) acc[r] = 0.f;
#pragma unroll
                for (int ks = 0; ks < 8; ++ks) acc = MFMA32(*(const LAS bf16x8*)(kb + (((2 * ks + hi) ^ (c31 & 15)) * 16)), bq[pp][ks], acc);
                int cur[16];
#pragma unroll
                for (int r = 0; r < 16; ++r) cur[r] = skey(acc[r], 32 * kt + 8 * (r >> 2) + 4 * hi + (r & 3), 0x7F);
                sort16_desc(cur);
                merge16_desc(run, cur);
                if (kt & 1) { const int qr = ti * 4 + pp * 2 + (kt >> 1); quant_store(p, qrow0 + qr, lane, qa); if (qr < 15) quant_load(p, qrow0 + qr + 1, lane, qa); }
            }
            int oth[16];
#pragma unroll
            for (int r = 0; r < 16; ++r) oth[r] = __shfl_xor(run[r], 32);
            merge16_desc(run, oth);
#pragma unroll
            for (int r = 0; r < 16; ++r) lst[pp][r] = run[r];
        }
#pragma unroll
        for (int pp = 0; pp < 2; ++pp) {
            u32x4 w;
#pragma unroll
            for (int q = 0; q < 4; ++q) w[q] = (lst[pp][4 * q] & 0x7F) | ((lst[pp][4 * q + 1] & 0x7F) << 8) | ((lst[pp][4 * q + 2] & 0x7F) << 16) | ((lst[pp][4 * q + 3] & 0x7F) << 24);
            *(LAS u32x4*)(tab + 16 * pp) = w;
        }
        float va[16], vb[16];
#pragma unroll
        for (int r = 0; r < 16; ++r) { va[r] = sval(lst[0][r], 0x7F); vb[r] = sval(lst[1][r], 0x7F); }
        int cand[4][16];
        {
            int cnt = 0;
#pragma unroll
            for (int i = 0; i < 16; ++i)
#pragma unroll
                for (int j = 0; j < 16; ++j)
                    if ((i + 1) * (j + 1) <= 16) { cand[cnt >> 4][cnt & 15] = skey(va[i] + vb[j], (i << 4) | j, 0xFF); ++cnt; }
#pragma unroll
            for (int q = 50; q < 64; ++q) cand[q >> 4][q & 15] = (int)0x80000000;
        }
        sort16_desc(cand[0]); sort16_desc(cand[1]); sort16_desc(cand[2]); sort16_desc(cand[3]);
        merge16_desc(cand[0], cand[1]); merge16_desc(cand[2], cand[3]); merge16_desc(cand[0], cand[2]);
        asm volatile("s_waitcnt lgkmcnt(0)" ::: "memory");
        float sv[16]; int ex[16];
        const float mx = sval(cand[0][0], 0xFF);
        float sum = 0.f;
#pragma unroll
        for (int r = 0; r < 16; ++r) {
            const int ck = cand[0][r];
            const int i1 = tab[(ck >> 4) & 15], i2 = tab[16 + (ck & 15)];
            ex[r] = i1 * 128 + i2;
            sv[r] = __expf(sval(ck, 0xFF) - mx); sum += sv[r];
        }
        const float inv = 1.f / sum;
        unsigned* ep = (unsigned*)EIDX + tok * 128 + h * 16 + 8 * hi;
        unsigned pe[16];
#pragma unroll
        for (int r = 0; r < 16; ++r) pe[r] = (unsigned)ex[r] | (pk2(sv[r] * inv, 0.f) << 16);
        if (hi == 0) { *(u32x4*)ep = (u32x4){pe[0], pe[1], pe[2], pe[3]}; *(u32x4*)(ep + 4) = (u32x4){pe[4], pe[5], pe[6], pe[7]}; }
        else         { *(u32x4*)ep = (u32x4){pe[8], pe[9], pe[10], pe[11]}; *(u32x4*)(ep + 4) = (u32x4){pe[12], pe[13], pe[14], pe[15]}; }
      }
    }
}

template <int K> DI int swz_bcast(int v) { return __builtin_amdgcn_ds_swizzle(v, 0x10 | (K << 5)); }
template <int W> DI int swz_xor(int v) { return __builtin_amdgcn_ds_swizzle(v, 0x1F | (W << 10)); }
template <int K> struct IC { static constexpr int v = K; };
template <int N, int I = 0, class F> DI void static_for(F&& f) { if constexpr (I < N) { f(IC<I>{}); static_for<N, I + 1>(f); } }
DI float row16_sum(float v) {
    v += __builtin_bit_cast(float, __builtin_amdgcn_update_dpp(0, __builtin_bit_cast(int, v), 0xB1, 0xF, 0xF, true));
    v += __builtin_bit_cast(float, __builtin_amdgcn_update_dpp(0, __builtin_bit_cast(int, v), 0x4E, 0xF, 0xF, true));
    v += __builtin_bit_cast(float, __builtin_amdgcn_update_dpp(0, __builtin_bit_cast(int, v), 0x141, 0xF, 0xF, true));
    v += __builtin_bit_cast(float, __builtin_amdgcn_update_dpp(0, __builtin_bit_cast(int, v), 0x140, 0xF, 0xF, true));
    return v;
}
DI void phase6(const Params& p, LAS unsigned char* lds, int tid, int lane, int wave) {
    asm volatile("" : "+v"(tid), "+v"(lane));
    unsigned char* ws = p.ws;
    const bf16_t* H2 = (const bf16_t*)(ws + WS_RA);
    const unsigned char* UQ = ws + WS_UB; const unsigned char* VQ = ws + WS_VB;
    const float* SU = (const float*)(ws + WS_SU); const float* SV = (const float*)(ws + WS_SV);
    const unsigned* EIDX = (const unsigned*)(ws + WS_RS);
    LAS float* lG = (LAS float*)lds;
    const int q = lane >> 4, l16 = lane & 15;
    LAS int* le = (LAS int*)(lds + 4096 + wave * 6144) + q * 128;
    LAS float* lg = (LAS float*)(lds + 4096 + wave * 6144 + 2048) + q * 128;
    LAS float* lc = (LAS float*)(lds + 4096 + wave * 6144 + 4096) + q * 128;
    const unsigned qlo = q < 2 ? (0xFFFFu << (16 * q)) : 0u, qhi = q >= 2 ? (0xFFFFu << (16 * (q - 2))) : 0u;
    for (int rt = blockIdx.x; rt < T / 128; rt += gridDim.x) {
        const int b = rt / 32;
        __syncthreads();
        for (int d = tid; d < 1024; d += NTH) lG[d] = mod_at(p, b, 5120 + d) * p.in[16][d];
        __syncthreads();
#pragma unroll 1
        for (int rd = 0; rd < 4; ++rd) {
            __syncthreads();
            const size_t t = (size_t)rt * 128 + wave * 16 + rd * 4 + q;
            {
                int e[8]; float g[8];
#pragma unroll
                for (int r = 0; r < 8; ++r) { const unsigned pe = EIDX[t * 128 + r * 16 + l16]; e[r] = (int)(pe & 0xFFFFu); g[r] = bfhi(pe); }
                unsigned W[4] = {0u, 0u, 0u, 0u};
#pragma unroll
                for (int r = 0; r < 8; ++r) {
                    const int k = e[r] >> 10; const unsigned inc = 1u << (8 * (k & 3)); const int w = k >> 2;
                    W[0] += (w == 0) ? inc : 0u; W[1] += (w == 1) ? inc : 0u; W[2] += (w == 2) ? inc : 0u; W[3] += (w == 3) ? inc : 0u;
                }
                unsigned C[4];
                {
                    unsigned tot[4], exc[4];
#pragma unroll
                    for (int w = 0; w < 4; ++w) {
                        unsigned x = W[w];
                        x += (unsigned)__builtin_amdgcn_update_dpp(0, (int)x, 0x111, 0xF, 0xF, true);
                        x += (unsigned)__builtin_amdgcn_update_dpp(0, (int)x, 0x112, 0xF, 0xF, true);
                        x += (unsigned)__builtin_amdgcn_update_dpp(0, (int)x, 0x114, 0xF, 0xF, true);
                        x += (unsigned)__builtin_amdgcn_update_dpp(0, (int)x, 0x118, 0xF, 0xF, true);
                        exc[w] = x - W[w];
                        tot[w] = (unsigned)swz_bcast<15>((int)x);
                    }
                    unsigned carry = 0u;
#pragma unroll
                    for (int w = 0; w < 4; ++w) {
                        const unsigned P = tot[w] + (tot[w] << 8) + (tot[w] << 16) + (tot[w] << 24);
                        C[w] = (P - tot[w]) + carry * 0x01010101u + exc[w];
                        carry += P >> 24;
                    }
                }
#pragma unroll
                for (int r = 0; r < 8; ++r) {
                    const int k = e[r] >> 10; const int sh = 8 * (k & 3); const int w = k >> 2; const unsigned inc = 1u << sh;
                    const unsigned cw = (w == 0) ? C[0] : (w == 1) ? C[1] : (w == 2) ? C[2] : C[3];
                    const int pos = (int)((cw >> sh) & 0xFFu);
                    le[pos] = e[r]; lg[pos] = g[r];
                    C[0] += (w == 0) ? inc : 0u; C[1] += (w == 1) ? inc : 0u; C[2] += (w == 2) ? inc : 0u; C[3] += (w == 3) ? inc : 0u;
                }
                asm volatile("s_waitcnt lgkmcnt(0)" ::: "memory");
            }
            {
                int hq[16]; float ish;
                {
                    float hv[64]; float hm = 0.f;
#pragma unroll
                    for (int i = 0; i < 4; ++i) {
                        const u32x4 h0 = *(const u32x4*)(H2 + t * D + 256 * i + 16 * l16), h1 = *(const u32x4*)(H2 + t * D + 256 * i + 16 * l16 + 8);
#pragma unroll
                        for (int c = 0; c < 4; ++c) { hv[16 * i + 2 * c] = bflo(h0[c]); hv[16 * i + 2 * c + 1] = bfhi(h0[c]); hv[16 * i + 8 + 2 * c] = bflo(h1[c]); hv[16 * i + 8 + 2 * c + 1] = bfhi(h1[c]); }
                    }
#pragma unroll
                    for (int j = 0; j < 64; ++j) hm = fmaxf(hm, fabsf(hv[j]));
                    hm = fmaxf(hm, __builtin_bit_cast(float, __builtin_amdgcn_update_dpp(0, __builtin_bit_cast(int, hm), 0xB1, 0xF, 0xF, true)));
                    hm = fmaxf(hm, __builtin_bit_cast(float, __builtin_amdgcn_update_dpp(0, __builtin_bit_cast(int, hm), 0x4E, 0xF, 0xF, true)));
                    hm = fmaxf(hm, __builtin_bit_cast(float, __builtin_amdgcn_update_dpp(0, __builtin_bit_cast(int, hm), 0x141, 0xF, 0xF, true)));
                    hm = fmaxf(hm, __builtin_bit_cast(float, __builtin_amdgcn_update_dpp(0, __builtin_bit_cast(int, hm), 0x140, 0xF, 0xF, true)));
                    const float s8 = hm > 1e-30f ? 127.f / hm : 0.f; ish = hm * (1.f / 127.f);
#pragma unroll
                    for (int d = 0; d < 16; ++d) {
                        const int q0 = __float2int_rn(hv[4 * d] * s8), q1 = __float2int_rn(hv[4 * d + 1] * s8), q2 = __float2int_rn(hv[4 * d + 2] * s8), q3 = __float2int_rn(hv[4 * d + 3] * s8);
                        hq[d] = (int)((unsigned)(q0 & 0xFF) | ((unsigned)(q1 & 0xFF) << 8) | ((unsigned)(q2 & 0xFF) << 16) | ((unsigned)q3 << 24));
                    }
                }
                constexpr int UD = 4;
                u32x4 ub[UD][4];
                int evn = le[l16];
                static_for<UD>([&](auto kc) { constexpr int k = decltype(kc)::v; const unsigned char* up = UQ + (size_t)swz_bcast<k>(evn) * 1024 + 16 * l16;
#pragma unroll
                    for (int i = 0; i < 4; ++i) ub[k][i] = *(const u32x4*)(up + 256 * i); });
#pragma unroll 1
                for (int bt = 0; bt < 8; ++bt) {
                    if (bt) __syncthreads();
                    const int ev = evn; const float gv = lg[bt * 16 + l16];
                    evn = le[(bt < 7 ? bt + 1 : 7) * 16 + l16];
                    const float isu = SU[ev] * ish, isv = SV[ev];
                    int part[16];
                    static_for<16>([&](auto kc) {
                        constexpr int k = decltype(kc)::v, sl = k % UD;
                        int a = 0;
#pragma unroll
                        for (int i = 0; i < 4; ++i) {
                            const u32x4 u = ub[sl][i];
#pragma unroll
                            for (int c = 0; c < 4; ++c) a = __builtin_amdgcn_sdot4((int)u[c], hq[4 * i + c], a, false);
                        }
                        part[k] = a;
                        {
                            constexpr int kn = k + UD;
                            int idx; if constexpr (kn < 16) idx = swz_bcast<(kn & 15)>(ev); else idx = swz_bcast<(kn & 15)>(evn);
                            const unsigned char* up = UQ + (size_t)idx * 1024 + 16 * l16;
#pragma unroll
                            for (int i = 0; i < 4; ++i) ub[sl][i] = *(const u32x4*)(up + 256 * i);
                        }
                    });
                    static_for<4>([&](auto sc) {
                        constexpr int w = 8 >> decltype(sc)::v;
                        const bool up2 = (lane & w) != 0;
#pragma unroll
                        for (int e = 0; e < w; ++e) {
                            const int keep = up2 ? part[e + w] : part[e], send = up2 ? part[e] : part[e + w];
                            part[e] = keep + swz_xor<w>(send);
                        }
                    });
                    const float dot = (float)part[0] * isu;
                    lc[bt * 16 + l16] = gv * 0.5f * dot * (1.f + erff(dot * 0.70710678118654752f)) * isv;
                }
                asm volatile("s_waitcnt lgkmcnt(0)" ::: "memory");
            }
            __syncthreads();
            f32x2 y[32];
#pragma unroll
            for (int i = 0; i < 32; ++i) y[i] = (f32x2){0.f, 0.f};
            {
                constexpr int VD = 4;
                u32x4 vbuf[VD][4];
                int evn = le[l16];
                static_for<VD>([&](auto kc) { constexpr int k = decltype(kc)::v; const unsigned char* vp = VQ + (size_t)swz_bcast<k>(evn) * 1024 + 16 * l16;
#pragma unroll
                    for (int i = 0; i < 4; ++i) vbuf[k][i] = *(const u32x4*)(vp + 256 * i); });
#pragma unroll 1
                for (int bt = 0; bt < 8; ++bt) {
                    if (bt) __syncthreads();
                    const int ev = evn; const int cv = __float_as_int(lc[bt * 16 + l16]);
                    evn = le[(bt < 7 ? bt + 1 : 7) * 16 + l16];
                    static_for<16>([&](auto kc) {
                        constexpr int k = decltype(kc)::v, sl = k % VD;
                        const float cc = __int_as_float(swz_bcast<k>(cv));
                        const f32x2 c2 = (f32x2){cc, cc};
#pragma unroll
                        for (int i = 0; i < 4; ++i) {
                            const u32x4 v = vbuf[sl][i];
#pragma unroll
                            for (int c = 0; c < 4; ++c) {
                                const int w = (int)v[c];
                                y[8 * i + 2 * c] = __builtin_elementwise_fma(__builtin_amdgcn_cvt_pk_f32_fp8(w, false), c2, y[8 * i + 2 * c]);
                                y[8 * i + 2 * c + 1] = __builtin_elementwise_fma(__builtin_amdgcn_cvt_pk_f32_fp8(w, true), c2, y[8 * i + 2 * c + 1]);
                            }
                        }
                        {
                            constexpr int kn = k + VD;
                            int idx; if constexpr (kn < 16) idx = swz_bcast<(kn & 15)>(ev); else idx = swz_bcast<(kn & 15)>(evn);
                            const unsigned char* vp = VQ + (size_t)idx * 1024 + 16 * l16;
#pragma unroll
                            for (int i = 0; i < 4; ++i) vbuf[sl][i] = *(const u32x4*)(vp + 256 * i);
                        }
                    });
                }
            }
            float ss = 0.f;
#pragma unroll
            for (int i = 0; i < 32; ++i) ss += y[i].x * y[i].x + y[i].y * y[i].y;
            const float rstd = rsqrtf(row16_sum(ss) * (1.f / D) + EPS);
            float* orow = p.out + t * D;
#pragma unroll
            for (int i = 0; i < 4; ++i)
#pragma unroll
                for (int c = 0; c < 4; ++c) {
                    const int col = 256 * i + 16 * l16 + 4 * c;
                    const u32x2 xb = *(const u32x2*)((const bf16_t*)(ws + WS_RO) + t * D + col);
                    f32x4 xv = {bflo(xb.x), bfhi(xb.x), bflo(xb.y), bfhi(xb.y)};
                    const f32x4 gg = *(const LAS f32x4*)(lG + col);
                    xv[0] += gg[0] * y[8 * i + 2 * c].x * rstd; xv[1] += gg[1] * y[8 * i + 2 * c].y * rstd; xv[2] += gg[2] * y[8 * i + 2 * c + 1].x * rstd; xv[3] += gg[3] * y[8 * i + 2 * c + 1].y * rstd;
                    *(f32x4*)(orow + col) = xv;
                }
        }
    }
}


__global__ void __launch_bounds__(NTH) fwd_megakernel(Params p) {
    extern __shared__ __attribute__((aligned(16))) unsigned char lds_raw[];
    LAS unsigned char* lds = (LAS unsigned char*)lds_raw;
    const int tid = threadIdx.x, lane = tid & 63, wave = __builtin_amdgcn_readfirstlane(tid >> 6);
    volatile LAS unsigned* st = (volatile LAS unsigned*)(lds + LDS_BARW);
    if (tid == 0) { st[0] = 0u; st[1] = 0u; st[2] = 0u; st[3] = 0u; }
    __syncthreads();
    XcdBarrier bar = xcd_barrier_post((unsigned*)(p.ws + WS_CTL), st);
    unsigned char* ws = p.ws;

    phase0(p, lds, tid, lane, wave);
    xcd_barrier(bar);
    phase1(p, lds, tid, lane, wave);
    afb_tail((const bf16_t*)(ws + WS_RA), (const bf16_t*)(ws + WS_WIN) + (size_t)ZW * D, (float*)(ws + WS_AFB), lds, tid, lane, wave);
    xcd_barrier(bar);
    { pg8::Gemm g{(const bf16_t*)(ws + WS_RA), (const bf16_t*)(ws + WS_WIN), T, ZW, D}; pg8::StaticOrder S; S.init(T, ZW, (int)gridDim.x, (int)blockIdx.x);
      pg8::EpiB16 e{(bf16_t*)(ws + WS_RZ), ZW}; pg8::gemm_phase<pg8::EpiB16, pg8::StaticOrder, true, true>(lds, g, S, e);
 }
    xcd_barrier(bar);
    phaseGA(p, lds, tid, lane, wave);
    xcd_barrier(bar);
    phaseGB(p, tid);
    xcd_barrier(bar);
    phase4a(p, lds, tid, lane, wave);
    xcd_barrier(bar);
    { pg8::Gemm g{(const bf16_t*)(ws + WS_RA), (const bf16_t*)(ws + WS_WOUT), T, D, D}; pg8::StaticOrder S; S.init(T, D, (int)gridDim.x, (int)blockIdx.x);
      pg8::EpiB16 e{(bf16_t*)(ws + WS_RZ), D}; pg8::gemm_phase<pg8::EpiB16, pg8::StaticOrder, true, true>(lds, g, S, e); }
    xcd_barrier(bar);
    phase4c(p, lds, tid, lane, wave);
    xcd_barrier(bar);
    { pg8::Gemm g{(const bf16_t*)(ws + WS_RA), (const bf16_t*)(ws + WS_WQ), T, 2048, D}; pg8::StaticOrder S; S.init(T, 2048, (int)gridDim.x, (int)blockIdx.x);
      pg8::EpiB16 e{(bf16_t*)(ws + WS_RZ), 2048}; pg8::gemm_phase<pg8::EpiB16, pg8::StaticOrder, true, true>(lds, g, S, e); }
    xcd_barrier(bar);
    phase5b(p, lds, tid, lane, wave);
    xcd_barrier(bar);
    phase6(p, lds, tid, lane, wave);
}

extern "C" void kernel_launch(void* const* d_in, const int* in_sizes, int n_in, void* d_out, int out_size, void* d_ws, size_t ws_size, hipStream_t stream) {
    static int grid = 0;
    if (grid == 0) {
        if (n_in != 21 || out_size != T * D || ws_size < WS_END) { fprintf(stderr, "kernel_launch: unexpected shapes (n_in %d out %d ws %zu need %zu)\n", n_in, out_size, ws_size, (size_t)WS_END); grid = -1; return; }
        int dev = 0, cus = 0, per_cu = 0;
        hipGetDevice(&dev); hipDeviceGetAttribute(&cus, hipDeviceAttributeMultiprocessorCount, dev);
        hipFuncSetAttribute((const void*)fwd_megakernel, hipFuncAttributeMaxDynamicSharedMemorySize, LDS_BYTES);
        hipOccupancyMaxActiveBlocksPerMultiprocessor(&per_cu, (const void*)fwd_megakernel, NTH, LDS_BYTES);
        (void)hipGetLastError();
        if (per_cu < 1) fprintf(stderr, "kernel_launch: occupancy query says %d blocks per CU\n", per_cu);
        grid = cus;
    }
    if (grid < 0) return;
    hipMemsetAsync((char*)d_ws + WS_CTL, 0, 64 * 1024, stream);
    Params p{};
    for (int i = 0; i < 21; ++i) p.in[i] = (const float*)d_in[i];
    p.out = (float*)d_out; p.ws = (unsigned char*)d_ws;
    hipLaunchKernelGGL(fwd_megakernel, dim3(grid), dim3(NTH), LDS_BYTES, stream, p);
}
```

```cpp
#include <hip/hip_runtime.h>
#include <cstdio>
#include <cstdint>

#define DI __device__ __forceinline__
#define LAS __attribute__((address_space(3)))
typedef unsigned short bf16_t;
typedef short bf16x8 __attribute__((ext_vector_type(8)));
typedef float f32x4 __attribute__((ext_vector_type(4)));
typedef float f32x2 __attribute__((ext_vector_type(2)));
typedef float f32x16 __attribute__((ext_vector_type(16)));
typedef unsigned u32x4 __attribute__((ext_vector_type(4)));
typedef unsigned u32x2 __attribute__((ext_vector_type(2)));
typedef __bf16 bf16x2v __attribute__((ext_vector_type(2)));

constexpr int T = 32768, D = 1024, SEQ = 4096, NB = 8;
constexpr int NTH = 512, NWV = 8;
constexpr int ZW = 2048;
constexpr int NIN = 2176;
constexpr float EPS = 1e-6f;

constexpr size_t MB = 1024 * 1024;
constexpr size_t WS_CTL   = 0;
constexpr size_t WS_MODP  = 64 * 1024;
constexpr size_t WS_WIN   = WS_MODP + 8 * 8 * 6144 * 4;
constexpr size_t WS_WOUT  = WS_WIN + (size_t)NIN * 1024 * 2;
constexpr size_t WS_WQ    = WS_WOUT + 1024 * 1024 * 2;
constexpr size_t WS_SKB   = WS_WQ + 2048 * 1024 * 2;
constexpr size_t WS_WP    = WS_SKB + 16 * 128 * 128 * 2;
constexpr size_t WS_AFB   = WS_WP + 4 * 128 * 128 * 2;
constexpr size_t WS_UB    = WS_AFB + (size_t)T * 32 * 4;
constexpr size_t WS_VB    = WS_UB + 32 * MB;
constexpr size_t WS_SU    = WS_UB + 16 * MB, WS_SV = WS_VB + 16 * MB;
constexpr size_t WS_RA    = WS_VB + 32 * MB;
constexpr size_t WS_RZ    = WS_RA + 64 * MB;
constexpr size_t WS_RS    = WS_RZ + 128 * MB;
constexpr size_t WS_RO    = WS_RS + 6 * 16 * MB + 1 * MB;
constexpr size_t WS_END   = WS_RO + 128 * MB;
static_assert(WS_END <= 512 * MB, "workspace too large");

struct Params { const float* in[21]; float* out; unsigned char* ws; };

DI unsigned pk2(float a, float b) { f32x2 f = {a, b}; bf16x2v h = __builtin_convertvector(f, bf16x2v); return __builtin_bit_cast(unsigned, h); }
DI float dot2bf(unsigned a, unsigned b, float c) { return __builtin_amdgcn_fdot2_f32_bf16(__builtin_bit_cast(bf16x2v, a), __builtin_bit_cast(bf16x2v, b), c, false); }
DI float bflo(unsigned u) { return __uint_as_float(u << 16); }
DI float bfhi(unsigned u) { return __uint_as_float(u & 0xFFFF0000u); }
DI float wave_sum(float v) {
#pragma unroll
    for (int o = 1; o < 64; o <<= 1) v += __shfl_xor(v, o);
    return v;
}
DI bf16x8 ld_frag16(const bf16_t* p) { return __builtin_bit_cast(bf16x8, *(const u32x4*)p); }
DI bf16x8 ld_frag_perm(const bf16_t* p, int g) {
    const u32x2 lo = *(const u32x2*)(p + 4 * g), hi = *(const u32x2*)(p + 16 + 4 * g);
    u32x4 v = {lo.x, lo.y, hi.x, hi.y}; return __builtin_bit_cast(bf16x8, v);
}
DI int perm32(int k) { return (k & ~31) | (((k >> 2) & 3) << 3) | (((k >> 4) & 1) << 2) | (k & 3); }
DI bf16x8 pack8(const f32x4& a, const f32x4& b) { u32x4 v = {pk2(a[0], a[1]), pk2(a[2], a[3]), pk2(b[0], b[1]), pk2(b[2], b[3])}; return __builtin_bit_cast(bf16x8, v); }
#define MFMA16(a, b, c) __builtin_amdgcn_mfma_f32_16x16x32_bf16((a), (b), (c), 0, 0, 0)
#define MFMA32(a, b, c) __builtin_amdgcn_mfma_f32_32x32x16_bf16((a), (b), (c), 0, 0, 0)

#define XB_TMO      128
#define XB_XCNT(j)  (256  + 64 * (j))
#define XB_XSUB(j)  (1280 + 64 * (j))
#define XB_XGEN(j)  (2304 + 64 * (j))
#define XB_TOP      3328
#define XB_TOPGEN   3392
#define XCD_BAR_WORDS 3456
#define XB_SPIN_CAP (1u << 22)
DI unsigned xb_ld(unsigned* p)              { return __hip_atomic_load(p, __ATOMIC_RELAXED, __HIP_MEMORY_SCOPE_AGENT); }
DI unsigned xb_add(unsigned* p, unsigned v) { return __hip_atomic_fetch_add(p, v, __ATOMIC_RELAXED, __HIP_MEMORY_SCOPE_AGENT); }
DI unsigned xb_xcc_id() { return (unsigned)__builtin_amdgcn_s_getreg((3 << 11) | 20) & 0xFu; }
#define XB_SPIN(cond, bar) do { unsigned _sp = 0; while (cond) { __builtin_amdgcn_s_sleep(1); \
    if ((++_sp & 255u) == 0u) { if (xb_ld(&(bar)[XB_TMO])) break; if (_sp > XB_SPIN_CAP) { atomicAdd(&(bar)[XB_TMO], 1u); break; } } } } while (0)
struct XcdBarrier { unsigned* bar; unsigned x; volatile LAS unsigned* st; };
DI XcdBarrier xcd_barrier_post(unsigned* bar, volatile LAS unsigned* st) {
    XcdBarrier b; b.bar = bar; b.x = xb_xcc_id(); b.st = st;
    if (threadIdx.x == 0) (void)xb_add(&bar[XB_XCNT(b.x)], 1u);
    return b;
}
DI void xcd_barrier_complete(unsigned* bar, unsigned x, unsigned& nloc, unsigned& nx) {
    const unsigned G = gridDim.x * gridDim.y * gridDim.z;
    unsigned sum, cnt, mine, sp = 0u;
    for (;;) {
        sum = 0u; cnt = 0u; mine = 0u;
#pragma unroll
        for (unsigned j = 0; j < 16; ++j) { const unsigned c = xb_ld(&bar[XB_XCNT(j)]); sum += c; cnt += (c > 0u) ? 1u : 0u; mine = (j == x) ? c : mine; }
        if (sum == G) break;
        __builtin_amdgcn_s_sleep(1);
        if ((++sp & 255u) == 0u) { if (xb_ld(&bar[XB_TMO])) break; if (sp > XB_SPIN_CAP) { atomicAdd(&bar[XB_TMO], 1u); break; } }
    }
    nloc = mine > 0u ? mine : 1u; nx = cnt > 0u ? cnt : 1u;
}
DI void xcd_barrier(const XcdBarrier& b) {
    asm volatile("s_waitcnt vmcnt(0)" ::: "memory");
    __syncthreads();
    if (threadIdx.x == 0) {
        unsigned* bar = b.bar;
        __builtin_amdgcn_s_waitcnt(0);
        unsigned nloc = b.st[0], nx = b.st[1];
        if (nloc == 0u) { xcd_barrier_complete(bar, b.x, nloc, nx); b.st[0] = nloc; b.st[1] = nx; }
        const unsigned old = xb_add(&bar[XB_XSUB(b.x)], 1u);
        const unsigned gen = old / nloc;
        if (old + 1u == (gen + 1u) * nloc) {
            __builtin_amdgcn_fence(__ATOMIC_RELEASE, "agent");
            asm volatile("s_waitcnt vmcnt(0)" ::: "memory");
            const unsigned og = xb_add(&bar[XB_TOP], 1u);
            const unsigned tg = og / nx;
            if (og + 1u == (tg + 1u) * nx) xb_add(&bar[XB_TOPGEN], 1u);
            else XB_SPIN(xb_ld(&bar[XB_TOPGEN]) == tg, bar);
            __builtin_amdgcn_fence(__ATOMIC_ACQUIRE, "agent");
            xb_add(&bar[XB_XGEN(b.x)], 1u);
            asm volatile("s_waitcnt vmcnt(0)" ::: "memory");
        } else {
            XB_SPIN(xb_ld(&bar[XB_XGEN(b.x)]) == gen, bar);
            __builtin_amdgcn_fence(__ATOMIC_ACQUIRE, "agent");
            asm volatile("s_waitcnt vmcnt(0)" ::: "memory");
        }
    }
    __syncthreads();
}

constexpr int LDS_BYTES = 152 * 1024;
constexpr int LDS_BARW = LDS_BYTES - 16;

DI void p0_transpose_item(const float* W, int ldw, int K, bf16_t* WT, int dst_row0, int src_col0, float scale, bool zero, LAS float* scr, int kb, int lane) {
    const int k0 = 64 * kb;
#pragma unroll 8
    for (int i = 0; i < 32; ++i) { const int kk = 2 * i + (lane >> 5); scr[kk * 33 + (lane & 31)] = zero ? 0.f : W[(size_t)(k0 + kk) * ldw + src_col0 + (lane & 31)] * scale; }
    asm volatile("s_waitcnt lgkmcnt(0)" ::: "memory");
    const int c = lane & 7;
#pragma unroll
    for (int j = 0; j < 4; ++j) { const int n = (lane >> 3) + 8 * j; const LAS float* s = scr + (8 * c) * 33 + n;
        u32x4 o; o.x = pk2(s[0 * 33], s[1 * 33]); o.y = pk2(s[2 * 33], s[3 * 33]); o.z = pk2(s[4 * 33], s[5 * 33]); o.w = pk2(s[6 * 33], s[7 * 33]);
        *(u32x4*)(WT + (size_t)(dst_row0 + n) * K + k0 + 8 * c) = o; }
    asm volatile("s_waitcnt lgkmcnt(0)" ::: "memory");
}

DI void phase0(const Params& p, LAS unsigned char* lds, int tid, int lane, int wave) {
    asm volatile("" : "+v"(tid), "+v"(lane));
    unsigned char* ws = p.ws;
    LAS float* sl = (LAS float*)lds;
    LAS float* scr = (LAS float*)(lds + 32768 + wave * 8448);
    const float* c = p.in[1];
    for (int e = tid; e < 8192; e += NTH) { const int b = e >> 10, k = e & 1023; const float v = c[e]; sl[k * 8 + b] = v / (1.f + __expf(-v)); }
    __syncthreads();
    const int gw = wave * gridDim.x + blockIdx.x, NGW = gridDim.x * NWV;
    constexpr int I_MOD = 768, I_WIN = 16 * 68, I_WOUT = 16 * 32, I_WQ = 16 * 64, I_WP = 32;
    constexpr int NITEMS = I_MOD + I_WIN + I_WOUT + I_WQ + I_WP;
    for (int it = gw; it < NITEMS; it += NGW) {
        int r = it;
        if (r < I_MOD) {
            const int cg = r % 96, ks = r / 96, n = cg * 64 + lane, k0 = ks * 128;
            const float* W = p.in[2] + (size_t)k0 * 6144 + n;
            float acc[8];
#pragma unroll
            for (int b = 0; b < 8; ++b) acc[b] = 0.f;
#pragma unroll 32
            for (int k = 0; k < 128; ++k) {
                const float w = W[(size_t)k * 6144];
                const f32x4 s0 = *(const LAS f32x4*)(sl + (k0 + k) * 8), s1 = *(const LAS f32x4*)(sl + (k0 + k) * 8 + 4);
                acc[0] += s0[0] * w; acc[1] += s0[1] * w; acc[2] += s0[2] * w; acc[3] += s0[3] * w;
                acc[4] += s1[0] * w; acc[5] += s1[1] * w; acc[6] += s1[2] * w; acc[7] += s1[3] * w;
            }
            float* mp = (float*)(ws + WS_MODP) + (size_t)ks * 8 * 6144 + n;
#pragma unroll
            for (int b = 0; b < 8; ++b) mp[b * 6144] = acc[b];
            continue;
        }
        r -= I_MOD;
        if (r < I_WIN) {
            const int kb = r / 68, nb = r % 68, n0 = nb * 32;
            int src; bool zero = false; float scale = 1.f;
            if (n0 < 1536) { src = n0; if (n0 < 256) scale = 0.125f; } else if (n0 < 2048) src = n0 + 32; else if (n0 < 2080) src = 1536 + (n0 - 2048); else { src = 0; zero = true; }
            p0_transpose_item(p.in[6], 2080, 1024, (bf16_t*)(ws + WS_WIN), n0, src, scale, zero, scr, kb, lane);
            continue;
        }
        r -= I_WIN;
        if (r < I_WOUT) { p0_transpose_item(p.in[14], 1024, 1024, (bf16_t*)(ws + WS_WOUT), (r % 32) * 32, (r % 32) * 32, 1.f, false, scr, r / 32, lane); continue; }
        r -= I_WOUT;
        if (r < I_WQ) { p0_transpose_item(p.in[17], 2048, 1024, (bf16_t*)(ws + WS_WQ), (r % 64) * 32, (r % 64) * 32, 1.f, false, scr, r / 64, lane); continue; }
        r -= I_WQ;
        { const int g = r >> 3, kb = (r >> 2) & 1, nb = r & 3;
          p0_transpose_item(p.in[12] + g * 16384, 128, 128, (bf16_t*)(ws + WS_WP) + g * 16384, nb * 32, nb * 32, 1.f, false, scr, kb, lane); }
    }
    const size_t gt = (size_t)blockIdx.x * NTH + tid, NGT = (size_t)gridDim.x * NTH;
    constexpr size_t NSK = (size_t)16 * 128 * 128 / 8;
    for (size_t j = gt; j < NSK; j += NGT) {
        const float* src = p.in[18]; bf16_t* dst = (bf16_t*)(ws + WS_SKB);
        const f32x4 a = *(const f32x4*)(src + j * 8), b = *(const f32x4*)(src + j * 8 + 4);
        u32x4 o = {pk2(a[0], a[1]), pk2(a[2], a[3]), pk2(b[0], b[1]), pk2(b[2], b[3])};
        *(u32x4*)(dst + j * 8) = o;
    }
}

DI void quant_load(const Params& p, int row, int lane, f32x4 (&v)[4]) {
    const int tb = row >> 14, e = row & 16383;
    const float* src = (tb ? p.in[20] : p.in[19]) + (size_t)e * D + 16 * lane;
#pragma unroll
    for (int q = 0; q < 4; ++q) v[q] = *(const f32x4*)(src + 4 * q);
}
DI void quant_store(const Params& p, int row, int lane, const f32x4 (&v)[4]) {
    unsigned char* ws = p.ws;
    const int tb = row >> 14, e = row & 16383;
    float m = 0.f;
#pragma unroll
    for (int q = 0; q < 4; ++q) m = fmaxf(m, fmaxf(fmaxf(fabsf(v[q][0]), fabsf(v[q][1])), fmaxf(fabsf(v[q][2]), fabsf(v[q][3]))));
#pragma unroll
    for (int o = 1; o < 64; o <<= 1) m = fmaxf(m, __shfl_xor(m, o));
    int ex = (int)((__float_as_uint(m) >> 23) & 0xFFu) - 127;
    if (m < 1e-30f) ex = 7;
    const float sc = __uint_as_float((unsigned)(127 + 7 - ex) << 23), isc = __uint_as_float((unsigned)(127 - 7 + ex) << 23);
    u32x4 o;
    if (tb) {
#pragma unroll
        for (int q = 0; q < 4; ++q) { int w = 0; w = __builtin_amdgcn_cvt_pk_fp8_f32(v[q][0] * sc, v[q][1] * sc, w, false); w = __builtin_amdgcn_cvt_pk_fp8_f32(v[q][2] * sc, v[q][3] * sc, w, true); o[q] = (unsigned)w; }
        if (lane == 0) ((float*)(ws + WS_SV))[e] = isc;
    } else {
        const float s8 = m > 1e-30f ? 127.f / m : 0.f;
#pragma unroll
        for (int q = 0; q < 4; ++q) {
            const int q0 = __float2int_rn(v[q][0] * s8), q1 = __float2int_rn(v[q][1] * s8), q2 = __float2int_rn(v[q][2] * s8), q3 = __float2int_rn(v[q][3] * s8);
            o[q] = (unsigned)(q0 & 0xFF) | ((unsigned)(q1 & 0xFF) << 8) | ((unsigned)(q2 & 0xFF) << 16) | ((unsigned)q3 << 24);
        }
        if (lane == 0) ((float*)(ws + WS_SU))[e] = m * (1.f / 127.f);
    }
    *(u32x4*)(ws + (tb ? WS_VB : WS_UB) + (size_t)e * 1024 + 16 * lane) = o;
}

DI float mod_at(const Params& p, int b, int n) {
    const float* mp = (const float*)(p.ws + WS_MODP) + (size_t)b * 6144 + n;
    float s = p.in[3][n];
#pragma unroll
    for (int ks = 0; ks < 8; ++ks) s += mp[(size_t)ks * 8 * 6144];
    return s;
}

DI void phase1(const Params& p, LAS unsigned char* lds, int tid, int lane, int wave) {
    asm volatile("" : "+v"(tid), "+v"(lane));
    LAS float* lA = (LAS float*)lds; LAS float* lB = lA + 1024;
    const float* x = p.in[0]; bf16_t* H = (bf16_t*)(p.ws + WS_RA);
    for (int rt = blockIdx.x; rt < T / 128; rt += gridDim.x) {
        const int b = rt / 32;
        __syncthreads();
        for (int d = tid; d < 1024; d += NTH) { lA[d] = p.in[4][d] * (1.f + mod_at(p, b, 1024 + d)); lB[d] = mod_at(p, b, d); }
        __syncthreads();
        for (int r0 = wave; r0 < 128; r0 += 4 * NWV) {
            f32x4 v[4][4];
#pragma unroll
            for (int u = 0; u < 4; ++u) { const f32x4* xr = (const f32x4*)(x + ((size_t)rt * 128 + r0 + u * NWV) * D) + lane;
#pragma unroll
                for (int j = 0; j < 4; ++j) v[u][j] = xr[64 * j]; }
#pragma unroll
            for (int u = 0; u < 4; ++u) {
                const size_t row = (size_t)rt * 128 + r0 + u * NWV;
                float ss = 0.f;
#pragma unroll
                for (int j = 0; j < 4; ++j) ss += v[u][j][0] * v[u][j][0] + v[u][j][1] * v[u][j][1] + v[u][j][2] * v[u][j][2] + v[u][j][3] * v[u][j][3];
                const float rstd = rsqrtf(wave_sum(ss) * (1.f / D) + EPS);
                u32x2* o = (u32x2*)(H + row * D) + lane;
#pragma unroll
                for (int j = 0; j < 4; ++j) {
                    const f32x4 a = *(const LAS f32x4*)(lA + 4 * lane + 256 * j), bb = *(const LAS f32x4*)(lB + 4 * lane + 256 * j);
                    u32x2 w = {pk2(v[u][j][0] * rstd * a[0] + bb[0], v[u][j][1] * rstd * a[1] + bb[1]), pk2(v[u][j][2] * rstd * a[2] + bb[2], v[u][j][3] * rstd * a[3] + bb[3])};
                    o[64 * j] = w;
                }
            }
        }
    }
}

DI void afb_tail(const bf16_t* H, const bf16_t* Wt, float* AFB, LAS unsigned char* lds, int tid, int lane, int wave) {
    constexpr int WSTR = 2064;
    asm volatile("" : "+v"(tid), "+v"(lane));
    const int c15 = lane & 15, g = lane >> 4;
    __syncthreads();
#pragma unroll
    for (int ps = 0; ps < 8; ++ps) { const int idx = tid + NTH * ps, n = idx >> 7, ch = idx & 127; *(LAS u32x4*)(lds + n * WSTR + ch * 16) = *(const u32x4*)(Wt + (size_t)n * D + ch * 8); }
    __syncthreads();
    LAS const unsigned char* w0 = lds + c15 * WSTR + 32 * g;
    for (int tile = blockIdx.x; tile < T / 128; tile += gridDim.x) {
        const size_t row = (size_t)tile * 128 + wave * 16 + c15;
        const bf16_t* ap = H + row * D + 16 * g;
        f32x4 acc0 = {0.f, 0.f, 0.f, 0.f}, acc1 = {0.f, 0.f, 0.f, 0.f};
#pragma unroll 1
        for (int hf = 0; hf < 2; ++hf) {
            bf16x8 a[16];
#pragma unroll
            for (int t = 0; t < 8; ++t) { a[2 * t] = *(const bf16x8*)(ap + 512 * hf + 64 * t); a[2 * t + 1] = *(const bf16x8*)(ap + 512 * hf + 64 * t + 8); }
            LAS const unsigned char* wp = w0 + 1024 * hf;
#pragma unroll
            for (int t = 0; t < 8; ++t)
#pragma unroll
                for (int e = 0; e < 2; ++e) {
                    acc0 = MFMA16(*(LAS const bf16x8*)(wp + 128 * t + 16 * e), a[2 * t + e], acc0);
                    acc1 = MFMA16(*(LAS const bf16x8*)(wp + 16 * WSTR + 128 * t + 16 * e), a[2 * t + e], acc1);
                }
        }
        *(f32x4*)(AFB + row * 32 + 4 * g) = acc0;
        *(f32x4*)(AFB + row * 32 + 16 + 4 * g) = acc1;
    }
}

namespace pg8 {
#define PG8_LAS __attribute__((address_space(3)))
constexpr int BM = 256, BK = 64, HALF = 128, HTB = HALF * BK * 2  , STAGE_BYTES = 8 * HTB, NXCD = 8, WGM = 1;

__host__ __device__ __forceinline__ int lds_byte(int r, int c) { const int st = (r >> 4) * 2 + (c >> 5), rr = r & 15, cc = c & 31, ob = rr * 64 + cc * 2; return st * 1024 + (ob ^ (((ob >> 9) & 1) << 5)); }
__host__ __device__ __forceinline__ void stage_rc(int b, int& R, int& C) { const int st = b / 1024, sb = b % 1024, swz = sb ^ (((sb >> 9) & 1) << 5); R = (st >> 1) * 16 + swz / 64; C = (st & 1) * 32 + (swz % 64) / 2; }
__host__ __device__ __forceinline__ int perm32(int rho) { const int n = rho >> 4, i = rho & 15; return 8 * (i >> 2) + 4 * n + (i & 3); }

struct Unit { int pm, pn; };
struct Gemm { const bf16_t* A; const bf16_t* Bt; int M, N, K; };

struct StaticOrder {
    int nM, nN, nwg, G, c;
    __host__ __device__ void init(int M, int N, int G_, int c_) { nM = M / BM; nN = N / BM; nwg = nM * nN; G = G_; c = c_; }
    __host__ __device__ bool next(int i, Unit& u) const {
        const long L = (long)i * G + c; if (L >= nwg) return false;
        int wgid = (int)L; { const int q = nwg / NXCD, r = nwg % NXCD, xcd = wgid % NXCD, off = wgid / NXCD; wgid = (xcd < r ? xcd * (q + 1) : r * (q + 1) + (xcd - r) * q) + off; }
        const int nig = WGM * nN, gid = wgid / nig, fm = gid * WGM, gsz = (nM - fm) < WGM ? (nM - fm) : WGM;
        u.pm = fm + ((wgid % nig) % gsz); u.pn = (wgid % nig) / gsz; return true;
    }
    __device__ __forceinline__ void a_ready(const Unit&) const {}
    __device__ __forceinline__ void done(const Unit&) const {}
};

struct EpiB16 {
    static constexpr bool PERM = true, AFTER_DRAIN = false;
    bf16_t* O; int ldc;
    __device__ __forceinline__ void operator()(const f32x4 (&acc)[2][2][4][2], const Unit& u, int wr, int wc, int fr, int fq) const {
#pragma unroll
        for (int ai = 0; ai < 2; ++ai)
#pragma unroll
            for (int m = 0; m < 4; ++m) { bf16_t* rowp = O + (size_t)(u.pm * BM + ai * HALF + wr * 64 + m * 16 + fr) * ldc + u.pn * BM + wc * 32 + 8 * fq;
#pragma unroll
                for (int bj = 0; bj < 2; ++bj) { const f32x4 v0 = acc[ai][bj][m][0], v1 = acc[ai][bj][m][1];
                    u32x4 w; w.x = ::pk2(v0[0], v0[1]); w.y = ::pk2(v0[2], v0[3]); w.z = ::pk2(v1[0], v1[1]); w.w = ::pk2(v1[2], v1[3]);
                    *(u32x4*)(rowp + bj * HALF) = w; } }
    }
};
struct EpiF {
    static constexpr bool PERM = false, AFTER_DRAIN = false;
    float* O; int ldc;
    __device__ __forceinline__ void operator()(const f32x4 (&acc)[2][2][4][2], const Unit& u, int wr, int wc, int fr, int fq) const {
#pragma unroll
        for (int ai = 0; ai < 2; ++ai)
#pragma unroll
            for (int m = 0; m < 4; ++m) { float* rowp = O + (size_t)(u.pm * BM + ai * HALF + wr * 64 + m * 16 + fr) * ldc + u.pn * BM + wc * 32 + 4 * fq;
#pragma unroll
                for (int bj = 0; bj < 2; ++bj)
#pragma unroll
                    for (int n = 0; n < 2; ++n) *(f32x4*)(rowp + bj * HALF + 16 * n) = acc[ai][bj][m][n]; }
    }
};
template <class Epi, class Sched, bool ALIGN_EPI = false, bool SP2 = false>
__device__ __forceinline__ void gemm_phase(PG8_LAS unsigned char* lds, const Gemm g, const Sched& S, const Epi& E) {
    int tid = threadIdx.x; asm volatile("" : "+v"(tid));
    const int wid = __builtin_amdgcn_readfirstlane(tid >> 6), lane = tid & 63, wr = wid >> 2, wc = wid & 3, fr = lane & 15, fq = lane >> 4;
    const int K = g.K, nt = K / BK;
    unsigned voffA[2], voffB[2];
#pragma unroll
    for (int i = 0; i < 2; ++i) { int R, C; stage_rc(tid * 16 + i * 8192, R, C); const int Rb = Epi::PERM ? ((R & ~31) + perm32(R & 31)) : R;
        voffA[i] = (unsigned)(R * K + C) * 2u; voffB[i] = (unsigned)(Rb * K + C) * 2u; }
    const size_t kstep = (size_t)(BK * 2);
    const size_t hstep = (size_t)HALF * K * 2;
    const size_t tstep = 2 * hstep;
    const unsigned ldsw = (unsigned)wid * 1024u;
    const int aoff = lds_byte(wr * 64 + fr, fq * 8), boff = lds_byte(wc * 32 + fr, fq * 8);
#define PG8_SA(b, h) (((b) * 2 + (h)) * HTB)
#define PG8_SB(b, h) ((4 + (b) * 2 + (h)) * HTB)
#define PG8_STAGE(bufoff, gbase, voff) do { _Pragma("unroll") for (int _i = 0; _i < 2; ++_i) \
        __builtin_amdgcn_global_load_lds((const unsigned*)((const char*)(gbase) + (voff)[_i]), (PG8_LAS unsigned*)(lds + (bufoff) + ldsw + _i * 8192), 16, 0, 0); } while (0)
#define PG8_LDA(dst, b, h) do { _Pragma("unroll") for (int m = 0; m < 4; ++m) _Pragma("unroll") for (int k = 0; k < 2; ++k) dst[m][k] = *(const PG8_LAS bf16x8*)(lds + PG8_SA(b, h) + aoff + m * 2048 + k * 1024); } while (0)
#define PG8_LDB(dst, b, h) do { _Pragma("unroll") for (int n = 0; n < 2; ++n) _Pragma("unroll") for (int k = 0; k < 2; ++k) dst[n][k] = *(const PG8_LAS bf16x8*)(lds + PG8_SB(b, h) + boff + n * 2048 + k * 1024); } while (0)
#define PG8_MMA(ai, bj, At, Bt) do { __builtin_amdgcn_s_setprio(1); _Pragma("unroll") for (int m = 0; m < 4; ++m) _Pragma("unroll") for (int n = 0; n < 2; ++n) _Pragma("unroll") for (int k = 0; k < 2; ++k) \
        acc[ai][bj][m][n] = __builtin_amdgcn_mfma_f32_16x16x32_bf16(Bt[n][k], At[m][k], acc[ai][bj][m][n], 0, 0, 0); __builtin_amdgcn_s_setprio(0); } while (0)
#define PG8_WAIT_V(n) asm volatile("s_waitcnt vmcnt(" #n ")" ::: "memory")
#define PG8_WAIT_L(n) asm volatile("s_waitcnt lgkmcnt(" #n ")" ::: "memory")
#define PG8_BAR __builtin_amdgcn_s_barrier()
#define PG8_SCHED __builtin_amdgcn_sched_barrier(0)
    Unit cur, nxt; int ui = 0;
    if (!S.next(0, cur)) return;
    f32x4 acc[2][2][4][2];
#pragma unroll
    for (int a = 0; a < 2; ++a)
#pragma unroll
        for (int b = 0; b < 2; ++b)
#pragma unroll
            for (int m = 0; m < 4; ++m)
#pragma unroll
                for (int n = 0; n < 2; ++n) acc[a][b][m][n] = (f32x4){0.f, 0.f, 0.f, 0.f};
    bf16x8 At[4][2], B0[2][2], B1[2][2];
    const char* cA = (const char*)g.A + (size_t)cur.pm * tstep; const char* cB = (const char*)g.Bt + (size_t)cur.pn * tstep;
    S.a_ready(cur);
    if constexpr (SP2) {
        PG8_STAGE(PG8_SB(0, 0), cB, voffB); PG8_STAGE(PG8_SB(0, 1), cB + hstep, voffB); PG8_STAGE(PG8_SA(0, 0), cA, voffA); PG8_STAGE(PG8_SA(0, 1), cA + hstep, voffA);
        if (wr == 1) PG8_BAR;
        PG8_WAIT_V(2); PG8_BAR;
        PG8_STAGE(PG8_SB(1, 0), cB + kstep, voffB); PG8_STAGE(PG8_SA(1, 0), cA + kstep, voffA); PG8_STAGE(PG8_SB(1, 1), cB + hstep + kstep, voffB);
        PG8_WAIT_V(6); PG8_BAR;
    } else {
        PG8_STAGE(PG8_SB(0, 0), cB, voffB); PG8_STAGE(PG8_SA(0, 0), cA, voffA); PG8_STAGE(PG8_SB(0, 1), cB + hstep, voffB); PG8_STAGE(PG8_SA(0, 1), cA + hstep, voffA);
        if (wr == 1) PG8_BAR;
        PG8_WAIT_V(4); PG8_BAR;
        PG8_STAGE(PG8_SB(1, 0), cB + kstep, voffB); PG8_STAGE(PG8_SA(1, 0), cA + kstep, voffA); PG8_STAGE(PG8_SB(1, 1), cB + hstep + kstep, voffB);
        PG8_WAIT_V(6); PG8_BAR;
    }
    for (;;) {
        const bool has_next = S.next(ui + 1, nxt);
        const char* nA = has_next ? (const char*)g.A + (size_t)nxt.pm * tstep : cA; const char* nB = has_next ? (const char*)g.Bt + (size_t)nxt.pn * tstep : cB;
        for (int t = 0; t < nt; t += 2) {
            const bool last = (t == nt - 2);
            const char* a1 = cA + (size_t)(t + 1) * kstep;
            const char* a2 = last ? nA : cA + (size_t)(t + 2) * kstep; const char* b2 = last ? nB : cB + (size_t)(t + 2) * kstep;
            const char* a3 = a2 + kstep; const char* b3 = b2 + kstep;
            if (last && has_next) S.a_ready(nxt);
            if constexpr (SP2) {
            PG8_LDB(B0, 0, 0); PG8_LDB(B1, 0, 1); PG8_SCHED; PG8_LDA(At, 0, 0); PG8_STAGE(PG8_SA(1, 1), a1 + hstep, voffA);
            PG8_WAIT_V(8); PG8_WAIT_L(0); PG8_BAR; PG8_MMA(0, 0, At, B0); PG8_MMA(0, 1, At, B1); PG8_BAR; PG8_SCHED;
            PG8_LDA(At, 0, 1); PG8_STAGE(PG8_SB(0, 0), b2, voffB); PG8_STAGE(PG8_SB(0, 1), b2 + hstep, voffB); PG8_STAGE(PG8_SA(0, 0), a2, voffA);
            PG8_WAIT_V(8); PG8_WAIT_L(0); PG8_BAR; PG8_MMA(1, 0, At, B0); PG8_MMA(1, 1, At, B1); PG8_BAR; PG8_SCHED;
            PG8_LDB(B0, 1, 0); PG8_LDB(B1, 1, 1); PG8_SCHED; PG8_LDA(At, 1, 0); PG8_STAGE(PG8_SA(0, 1), a2 + hstep, voffA);
            PG8_WAIT_V(8); PG8_WAIT_L(0); PG8_BAR; PG8_MMA(0, 0, At, B0); PG8_MMA(0, 1, At, B1); PG8_BAR; PG8_SCHED;
            PG8_LDA(At, 1, 1); PG8_STAGE(PG8_SB(1, 0), b3, voffB); PG8_STAGE(PG8_SB(1, 1), b3 + hstep, voffB); PG8_STAGE(PG8_SA(1, 0), a3, voffA);
            PG8_WAIT_V(8); PG8_WAIT_L(0); PG8_BAR; PG8_MMA(1, 0, At, B0); PG8_MMA(1, 1, At, B1); PG8_BAR; PG8_SCHED;
            } else {
            PG8_LDB(B0, 0, 0); PG8_SCHED; PG8_LDA(At, 0, 0); PG8_STAGE(PG8_SA(1, 1), a1 + hstep, voffA);
            PG8_WAIT_L(8); PG8_BAR; PG8_WAIT_L(0); PG8_MMA(0, 0, At, B0); PG8_BAR; PG8_SCHED;
            PG8_LDB(B1, 0, 1); PG8_STAGE(PG8_SB(0, 0), b2, voffB);
            PG8_BAR; PG8_WAIT_L(0); PG8_MMA(0, 1, At, B1); PG8_BAR;
            PG8_LDA(At, 0, 1); PG8_STAGE(PG8_SA(0, 0), a2, voffA);
            PG8_BAR; PG8_WAIT_L(0); PG8_MMA(1, 0, At, B0); PG8_BAR; PG8_SCHED;
            PG8_STAGE(PG8_SB(0, 1), b2 + hstep, voffB);
            PG8_WAIT_V(6); PG8_BAR; PG8_MMA(1, 1, At, B1); PG8_BAR;
            PG8_LDB(B0, 1, 0); PG8_SCHED; PG8_LDA(At, 1, 0); PG8_STAGE(PG8_SA(0, 1), a2 + hstep, voffA);
            PG8_WAIT_L(8); PG8_BAR; PG8_WAIT_L(0); PG8_MMA(0, 0, At, B0); PG8_BAR; PG8_SCHED;
            PG8_LDB(B1, 1, 1); PG8_STAGE(PG8_SB(1, 0), b3, voffB);
            PG8_BAR; PG8_WAIT_L(0); PG8_MMA(0, 1, At, B1); PG8_BAR;
            PG8_LDA(At, 1, 1); PG8_STAGE(PG8_SA(1, 0), a3, voffA);
            PG8_BAR; PG8_WAIT_L(0); PG8_MMA(1, 0, At, B0); PG8_BAR; PG8_SCHED;
            PG8_STAGE(PG8_SB(1, 1), b3 + hstep, voffB);
            PG8_WAIT_V(6); PG8_BAR; PG8_MMA(1, 1, At, B1); PG8_BAR;
            }
        }
        if constexpr (ALIGN_EPI) { if (wr == 0) PG8_BAR; }
        if constexpr (!Epi::AFTER_DRAIN) { E(acc, cur, wr, wc, fr, fq); S.done(cur); }
        if (!has_next) break;
#pragma unroll
        for (int a = 0; a < 2; ++a)
#pragma unroll
            for (int b = 0; b < 2; ++b)
#pragma unroll
                for (int m = 0; m < 4; ++m)
#pragma unroll
                    for (int n = 0; n < 2; ++n) acc[a][b][m][n] = (f32x4){0.f, 0.f, 0.f, 0.f};
        cur = nxt; cA = nA; cB = nB; ++ui;
        if constexpr (ALIGN_EPI) { if (wr == 1) PG8_BAR; }
    }
    PG8_WAIT_V(0);
    if constexpr (!ALIGN_EPI) { if (wr == 0) PG8_BAR; }
    PG8_BAR;
    if constexpr (Epi::AFTER_DRAIN) { E.fused(acc, cur, wr, wc, fr, fq, lds, wid, lane); S.done(cur); }
#undef PG8_SA
#undef PG8_SB
#undef PG8_STAGE
#undef PG8_LDA
#undef PG8_LDB
#undef PG8_MMA
#undef PG8_WAIT_V
#undef PG8_WAIT_L
#undef PG8_BAR
#undef PG8_SCHED
}
}

constexpr size_t WS_QDC  = WS_RS;
constexpr size_t WS_SEGS = WS_RS + 32 * MB;
constexpr size_t WS_GSEG = WS_RS + 48 * MB;
constexpr size_t WS_SC   = WS_RS + 49 * MB;
DI void lds_barrier() { asm volatile("s_waitcnt lgkmcnt(0)" ::: "memory"); __builtin_amdgcn_s_barrier(); asm volatile("" ::: "memory"); }
DI float logsig(float x) { return fminf(x, 0.f) - __logf(1.f + __expf(-fabsf(x))); }

template <int DIR>
DI void ga_task(const Params& p, LAS unsigned char* lds, int tid, int lane, int wave, int task) {
    asm volatile("" : "+v"(tid), "+v"(lane));
    unsigned char* ws = p.ws;
    const bf16_t* Z = (const bf16_t*)(ws + WS_RZ);
    const float* AFB = (const float*)(ws + WS_AFB);
    LAS float* la = (LAS float*)lds;
    LAS float* part = (LAS float*)(lds + 17408);
    LAS float* gs = (LAS float*)(lds + 18432);
    LAS float* elb = (LAS float*)(lds + 18944);
    LAS float* wl = (LAS float*)(lds + 19968);
    LAS bf16_t* sL  = (LAS bf16_t*)(lds + 24064);
    LAS unsigned char* obuf = lds + 42496;
    const int c15 = lane & 15, g = lane >> 4;
    const int i = tid >> 3, dg = tid & 7, d0 = dg * 8;
#define TROW(r) ((r) * 72 + ((r) >> 3) * 8)
    constexpr int dir = DIR; const int h = (task >> 1) & 3, pb = (task >> 3) & 7, b = task >> 6;
    const int bhd = b * 8 + h * 2 + dir, sg = dir ? 7 - pb : pb;
    bf16_t* QDC = (bf16_t*)(ws + WS_QDC + (dir ? 16 : 0) * MB);
    bf16_t* OL = (bf16_t*)(ws + WS_RO + (dir ? 64 : 0) * MB);
    f32x4 S[4];
#pragma unroll
    for (int kt = 0; kt < 4; ++kt) S[kt] = (f32x4){0.f, 0.f, 0.f, 0.f};
    __syncthreads();
    for (int e = tid; e < 128 * 72 / 2; e += NTH) ((LAS unsigned*)sL)[e] = 0u;
    if (tid < 64) gs[tid] = 0.f;
    for (int e = tid; e < 1024; e += NTH) wl[e] = (dir ? p.in[9] : p.in[7])[(e >> 6) * 256 + h * 64 + (e & 63)];
    typedef short s16x4w __attribute__((ext_vector_type(4)));
    s16x4w wfr[2]; float bias[2];
    __syncthreads();
#pragma unroll
    for (int u = 0; u < 2; ++u) {
        const int d = 16 * (2 * (wave >> 2) + u) + c15;
        const u32x2 wp = {pk2(wl[(4 * g) * 64 + d], wl[(4 * g + 1) * 64 + d]), pk2(wl[(4 * g + 2) * 64 + d], wl[(4 * g + 3) * 64 + d])};
        wfr[u] = __builtin_bit_cast(s16x4w, wp);
        bias[u] = (dir ? p.in[10] : p.in[8])[h * 64 + d];
    }
    const int mt = wave & 3;
    f32x4 avn;
    { const int n0 = dir ? pb * 8 + 7 : pb * 8; avn = *(const f32x4*)(AFB + ((size_t)b * SEQ + n0 * 64 + 16 * mt + c15) * 32 + dir * 16 + 4 * g); }
#pragma unroll 1
    for (int ci = -1; ci < 8; ++ci) {
        const bool has_cur = ci >= 0, has_nxt = ci < 7;
        const int cx = ci + 1;
        const int nx = dir ? pb * 8 + 7 - cx : pb * 8 + cx, tokx = b * SEQ + nx * 64;
        const int nc = dir ? pb * 8 + 7 - ci : pb * 8 + ci, tokc = b * SEQ + nc * 64;
        LAS unsigned char* bx = obuf + (cx & 1) * 46464; LAS unsigned char* bc = obuf + (ci & 1) * 46464;
        LAS float* elx = elb + (cx & 1) * 128; LAS float* elc = elb + (ci & 1) * 128;
        u32x4 qv, kv, vvp[2]; float lv[2][4];
        if (ci > 0) {
#pragma unroll
            for (int kt = 0; kt < 4; ++kt) { const u32x2 w = {pk2(S[kt][0], S[kt][1]), pk2(S[kt][2], S[kt][3])}; *(LAS u32x2*)(sL + (16 * wave + c15) * 72 + 16 * kt + 4 * g) = w; }
        }
        if (has_nxt) {
            const size_t t = (size_t)tokx + i;
            qv = *(const u32x4*)(Z + t * ZW + h * 64 + d0); kv = *(const u32x4*)(Z + t * ZW + 256 + h * 64 + d0);
#pragma unroll
            for (int ps = 0; ps < 2; ++ps) { const int idx = tid + NTH * ps, vi = idx >> 4, ch = idx & 15; vvp[ps] = *(const u32x4*)(Z + ((size_t)tokx + vi) * ZW + 512 + h * 128 + ch * 8); }
            typedef short s16x4v __attribute__((ext_vector_type(4)));
            const u32x2 ap = {pk2(avn[0], avn[1]), pk2(avn[2], avn[3])};
            const s16x4v af = __builtin_bit_cast(s16x4v, ap);
            { const int c2 = cx < 7 ? cx + 1 : cx, n2 = dir ? pb * 8 + 7 - c2 : pb * 8 + c2; avn = *(const f32x4*)(AFB + ((size_t)b * SEQ + n2 * 64 + 16 * mt + c15) * 32 + dir * 16 + 4 * g); }
#pragma unroll
            for (int u = 0; u < 2; ++u) {
                const int d = 16 * (2 * (wave >> 2) + u) + c15;
                const f32x4 x = __builtin_amdgcn_mfma_f32_16x16x16bf16_1k(af, wfr[u], (f32x4){0.f, 0.f, 0.f, 0.f}, 0, 0, 0);
                float v0 = logsig(x[0] + bias[u]) * 0.0625f, v1 = logsig(x[1] + bias[u]) * 0.0625f, v2 = logsig(x[2] + bias[u]) * 0.0625f, v3 = logsig(x[3] + bias[u]) * 0.0625f;
                float T, T2, T3;
                if (dir == 0) {
                    v1 += v0; v2 += v1; v3 += v2; T = v3;
                    const float t1 = __shfl_up(T, 16); T2 = T + (g >= 1 ? t1 : 0.f);
                    const float t2 = __shfl_up(T2, 32); T3 = T2 + (g >= 2 ? t2 : 0.f);
                    if (g == 3) part[mt * 64 + d] = T3;
                } else {
                    v2 += v3; v1 += v2; v0 += v1; T = v0;
                    const float t1 = __shfl_down(T, 16); T2 = T + (g <= 2 ? t1 : 0.f);
                    const float t2 = __shfl_down(T2, 32); T3 = T2 + (g <= 1 ? t2 : 0.f);
                    if (g == 0) part[mt * 64 + d] = T3;
                }
                const float off = T3 - T;
                lv[u][0] = v0 + off; lv[u][1] = v1 + off; lv[u][2] = v2 + off; lv[u][3] = v3 + off;
            }
        }
        lds_barrier();
        if (has_nxt) {
#pragma unroll
            for (int u = 0; u < 2; ++u) {
                const int d = 16 * (2 * (wave >> 2) + u) + c15;
                float off = 0.f;
#pragma unroll
                for (int m2 = 0; m2 < 4; ++m2) { const bool take = dir ? (m2 > mt) : (m2 < mt); off += take ? part[m2 * 64 + d] : 0.f; }
#pragma unroll
                for (int r = 0; r < 4; ++r) la[(16 * mt + 4 * g + r) * 68 + d] = lv[u][r] + off;
                if (mt == (dir ? 0 : 3) && g == (dir ? 0 : 3)) {
                    const float tot = lv[u][dir ? 0 : 3] + off, gsum = gs[(cx & 1) * 64 + d];
                    elx[d] = __expf(tot); elx[64 + d] = __expf(gsum); gs[((cx + 1) & 1) * 64 + d] = gsum + tot;
                }
            }
        }
        lds_barrier();
        if (has_nxt) {
            LAS bf16_t* qdL = (LAS bf16_t*)bx; LAS bf16_t* kiL = (LAS bf16_t*)(bx + 9216); LAS bf16_t* keT = (LAS bf16_t*)(bx + 18432); LAS bf16_t* vT = (LAS bf16_t*)(bx + 27776);
            const size_t t = (size_t)tokx + i;
            float q[8], k[8];
#pragma unroll
            for (int e = 0; e < 4; ++e) { q[2 * e] = bflo(qv[e]); q[2 * e + 1] = bfhi(qv[e]); k[2 * e] = bflo(kv[e]); k[2 * e + 1] = bfhi(kv[e]); }
            float qd[8], ki[8], ke[8], qc[8];
#pragma unroll
            for (int e = 0; e < 8; ++e) {
                const float E = __expf(la[i * 68 + d0 + e]), R = __builtin_amdgcn_rcpf(E);
                qd[e] = q[e] * E; ki[e] = k[e] * R; ke[e] = ki[e] * elx[d0 + e]; qc[e] = qd[e] * elx[64 + d0 + e];
            }
            const u32x4 o1 = {pk2(qd[0], qd[1]), pk2(qd[2], qd[3]), pk2(qd[4], qd[5]), pk2(qd[6], qd[7])};
            const u32x4 o2 = {pk2(ki[0], ki[1]), pk2(ki[2], ki[3]), pk2(ki[4], ki[5]), pk2(ki[6], ki[7])};
            const u32x4 o3 = {pk2(qc[0], qc[1]), pk2(qc[2], qc[3]), pk2(qc[4], qc[5]), pk2(qc[6], qc[7])};
            *(LAS u32x4*)(qdL + i * 72 + d0) = o1; *(LAS u32x4*)(kiL + i * 72 + d0) = o2;
            *(u32x4*)(QDC + t * 256 + h * 64 + d0) = o3;
#pragma unroll
            for (int e = 0; e < 4; ++e) { const unsigned w = pk2(ke[2 * e], ke[2 * e + 1]); keT[TROW(d0 + 2 * e) + perm32(i)] = (bf16_t)(w & 0xFFFFu); keT[TROW(d0 + 2 * e + 1) + perm32(i)] = (bf16_t)(w >> 16); }
#pragma unroll
            for (int ps = 0; ps < 2; ++ps) {
                const int idx = tid + NTH * ps, vi = idx >> 4, ch = idx & 15;
#pragma unroll
                for (int e = 0; e < 4; ++e) { vT[TROW(ch * 8 + 2 * e) + perm32(vi)] = (bf16_t)(vvp[ps][e] & 0xFFFFu); vT[TROW(ch * 8 + 2 * e + 1) + perm32(vi)] = (bf16_t)(vvp[ps][e] >> 16); }
            }
        }
        if (has_cur) {
            const LAS bf16_t* qdL = (const LAS bf16_t*)bc; const LAS bf16_t* kiL = (const LAS bf16_t*)(bc + 9216); const LAS bf16_t* keT = (const LAS bf16_t*)(bc + 18432); const LAS bf16_t* vT = (const LAS bf16_t*)(bc + 27776);
            const int it = wave & 3, dvh = wave >> 2;
            bf16x8 qdb[2];
#pragma unroll
            for (int s = 0; s < 2; ++s) qdb[s] = *(const LAS bf16x8*)(qdL + (16 * it + c15) * 72 + 32 * s + 8 * g);
            f32x4 sc[4];
#pragma unroll
            for (int jt = 0; jt < 4; ++jt) {
                sc[jt] = (f32x4){0.f, 0.f, 0.f, 0.f};
#pragma unroll
                for (int s = 0; s < 2; ++s) sc[jt] = MFMA16(*(const LAS bf16x8*)(kiL + (16 * jt + c15) * 72 + 32 * s + 8 * g), qdb[s], sc[jt]);
                const int ii = 16 * it + c15;
#pragma unroll
                for (int r = 0; r < 4; ++r) { const int jj = 16 * jt + 4 * g + r; const bool keep = dir ? (jj > ii) : (jj <= ii); sc[jt][r] = keep ? sc[jt][r] : 0.f; }
            }
            const bf16x8 pa[2] = {pack8(sc[0], sc[1]), pack8(sc[2], sc[3])};
#pragma unroll
            for (int nt = 0; nt < 4; ++nt) {
                const int dvr = 64 * dvh + 16 * nt + c15;
                f32x4 o = (f32x4){0.f, 0.f, 0.f, 0.f};
#pragma unroll
                for (int s = 0; s < 2; ++s) {
                    o = MFMA16(*(const LAS bf16x8*)(vT + TROW(dvr) + 32 * s + 8 * g), pa[s], o);
                    o = MFMA16(*(const LAS bf16x8*)(sL + dvr * 72 + 32 * s + 8 * g), qdb[s], o);
                }
                const u32x2 w = {pk2(o[0], o[1]), pk2(o[2], o[3])};
                *(u32x2*)(OL + ((size_t)tokc + 16 * it + c15) * 512 + h * 128 + 64 * dvh + 16 * nt + 4 * g) = w;
            }
            bf16x8 vb[2];
#pragma unroll
            for (int s = 0; s < 2; ++s) vb[s] = *(const LAS bf16x8*)(vT + TROW(16 * wave + c15) + 32 * s + 8 * g);
#pragma unroll
            for (int kt = 0; kt < 4; ++kt) {
                const f32x4 gm = *(const LAS f32x4*)(elc + 16 * kt + 4 * g);
                f32x4 a = S[kt] * gm;
#pragma unroll
                for (int s = 0; s < 2; ++s) a = MFMA16(*(const LAS bf16x8*)(keT + TROW(16 * kt + c15) + 32 * s + 8 * g), vb[s], a);
                S[kt] = a;
            }
        }
        lds_barrier();
    }
    {
        float* SEGS = (float*)(ws + WS_SEGS) + (size_t)(bhd * 8 + sg) * 64 * 128;
#pragma unroll
        for (int kt = 0; kt < 4; ++kt)
#pragma unroll
            for (int r = 0; r < 4; ++r) SEGS[(16 * kt + 4 * g + r) * 128 + 16 * wave + c15] = S[kt][r];
        if (tid < 64) ((float*)(ws + WS_GSEG))[(bhd * 8 + sg) * 64 + tid] = __expf(gs[tid]);
    }
}
#undef TROW

DI void phaseGA(const Params& p, LAS unsigned char* lds, int tid, int lane, int wave) {
    for (int task = blockIdx.x; task < 512; task += gridDim.x) { if (task & 1) ga_task<1>(p, lds, tid, lane, wave, task); else ga_task<0>(p, lds, tid, lane, wave, task); }
}

DI void phaseGB(const Params& p, int tid) {
    unsigned char* ws = p.ws;
    const float* SEGS = (const float*)(ws + WS_SEGS); const float* GSEG = (const float*)(ws + WS_GSEG); bf16_t* SC = (bf16_t*)(ws + WS_SC);
    for (int e = blockIdx.x * NTH + tid; e < 64 * 128 * 16; e += gridDim.x * NTH) {
        const int dv = e & 127, dk4 = (e >> 7) & 15, bhd = e >> 11;
        float c[4] = {0.f, 0.f, 0.f, 0.f};
        for (int sg = 0; sg < 8; ++sg) {
            const u32x2 w = {pk2(c[0], c[1]), pk2(c[2], c[3])};
            *(u32x2*)(SC + ((size_t)(bhd * 8 + sg) * 128 + dv) * 64 + 4 * dk4) = w;
            const f32x4 gm = *(const f32x4*)(GSEG + (bhd * 8 + sg) * 64 + 4 * dk4);
#pragma unroll
            for (int r = 0; r < 4; ++r) c[r] = gm[r] * c[r] + SEGS[((size_t)(bhd * 8 + sg) * 64 + 4 * dk4 + r) * 128 + dv];
        }
    }
}

DI void phase4a(const Params& p, LAS unsigned char* lds, int tid, int lane, int wave) {
    asm volatile("" : "+v"(tid), "+v"(lane));
    unsigned char* ws = p.ws;
    const bf16_t* Z = (const bf16_t*)(ws + WS_RZ);
    bf16_t* MIX = (bf16_t*)(ws + WS_RA);
    const bf16_t* OF = (const bf16_t*)(ws + WS_RO); const bf16_t* OB = (const bf16_t*)(ws + WS_RO + 64 * MB);
    const bf16_t* WP = (const bf16_t*)(ws + WS_WP);
    LAS bf16_t* pt = (LAS bf16_t*)lds;
    LAS unsigned char* at = lds + 81920;
    const int c15 = lane & 15, g = lane >> 4;
    for (int tile = blockIdx.x; tile < T / 64; tile += gridDim.x) {
        const int tok0 = tile * 64, s0 = tok0 & (SEQ - 1);
        __syncthreads();
#pragma unroll
        for (int ps = 0; ps < 10; ++ps) {
            const int idx = tid + NTH * ps, rr = idx >> 6, ch = idx & 63, sq = s0 - 8 + rr;
            u32x4 v = {0u, 0u, 0u, 0u};
            if (sq >= 0 && sq < SEQ) v = *(const u32x4*)(Z + ((size_t)tok0 - 8 + rr) * ZW + 1536 + ch * 8);
            *(LAS u32x4*)(pt + rr * 512 + ch * 8) = v;
        }
        {
            const int hh = wave >> 1, ih = wave & 1, bb = tok0 / SEQ, nn = s0 >> 6;
            f32x4 acc[8][2];
#pragma unroll
            for (int mt = 0; mt < 8; ++mt) { acc[mt][0] = (f32x4){0.f, 0.f, 0.f, 0.f}; acc[mt][1] = (f32x4){0.f, 0.f, 0.f, 0.f}; }
#pragma unroll
            for (int dir = 0; dir < 2; ++dir) {
                const int sg = dir ? 7 - (nn >> 3) : (nn >> 3), bhd = bb * 8 + hh * 2 + dir;
                const bf16_t* SCp = (const bf16_t*)(ws + WS_SC) + (size_t)(bhd * 8 + sg) * 128 * 64;
                const bf16_t* QCp = (const bf16_t*)(ws + WS_QDC + (dir ? 16 : 0) * MB) + ((size_t)tok0 + 32 * ih) * 256 + hh * 64;
                if (sg != 0)
#pragma unroll
                for (int s = 0; s < 2; ++s) {
                    const bf16x8 q0 = ld_frag16(QCp + (size_t)c15 * 256 + 32 * s + 8 * g), q1 = ld_frag16(QCp + (size_t)(16 + c15) * 256 + 32 * s + 8 * g);
#pragma unroll
                    for (int mt = 0; mt < 8; ++mt) {
                        const bf16x8 af = ld_frag16(SCp + (16 * mt + c15) * 64 + 32 * s + 8 * g);
                        acc[mt][0] = MFMA16(af, q0, acc[mt][0]); acc[mt][1] = MFMA16(af, q1, acc[mt][1]);
                    }
                }
            }
#pragma unroll
            for (int nt = 0; nt < 2; ++nt)
#pragma unroll
                for (int mt = 0; mt < 8; ++mt) { const f32x4 o = acc[mt][nt]; const u32x2 w = {pk2(o[0], o[1]), pk2(o[2], o[3])};
                    *(LAS u32x2*)(at + (32 * ih + 16 * nt + c15) * 1040 + (hh * 128 + 16 * mt + 4 * g) * 2) = w; }
        }
        __syncthreads();
        {
            const f32x4 gh0 = *(const f32x4*)(p.in[11] + 8 * lane), gh1 = *(const f32x4*)(p.in[11] + 8 * lane + 4);
#pragma unroll
            for (int hb = 0; hb < 2; ++hb) {
                u32x4 a[4], bq[4], rv[4], cv[4];
#pragma unroll
                for (int j = 0; j < 4; ++j) { const int tl = wave * 8 + hb * 4 + j; const size_t t = (size_t)tok0 + tl;
                    a[j] = *(const u32x4*)(OF + t * 512 + 8 * lane); bq[j] = *(const u32x4*)(OB + t * 512 + 8 * lane); rv[j] = *(const u32x4*)(Z + t * ZW + 1024 + 8 * lane);
                    cv[j] = *(const LAS u32x4*)(at + tl * 1040 + 16 * lane); }
#pragma unroll
                for (int j = 0; j < 4; ++j) { const size_t t = (size_t)tok0 + wave * 8 + hb * 4 + j;
                    float o[8], r[8];
#pragma unroll
                    for (int e = 0; e < 4; ++e) { o[2 * e] = bflo(a[j][e]) + bflo(bq[j][e]) + bflo(cv[j][e]); o[2 * e + 1] = bfhi(a[j][e]) + bfhi(bq[j][e]) + bfhi(cv[j][e]); r[2 * e] = bflo(rv[j][e]); r[2 * e + 1] = bfhi(rv[j][e]); }
                    float ss = 0.f;
#pragma unroll
                    for (int e = 0; e < 8; ++e) ss += o[e] * o[e];
                    ss += __shfl_xor(ss, 1); ss += __shfl_xor(ss, 2); ss += __shfl_xor(ss, 4); ss += __shfl_xor(ss, 8);
                    const float rstd = rsqrtf(ss * (1.f / 128.f) + EPS);
                    float y[8];
#pragma unroll
                    for (int e = 0; e < 8; ++e) { const float gg = e < 4 ? gh0[e] : gh1[e - 4]; y[e] = o[e] * rstd * gg * (r[e] / (1.f + __expf(-r[e]))); }
                    const u32x4 w = {pk2(y[0], y[1]), pk2(y[2], y[3]), pk2(y[4], y[5]), pk2(y[6], y[7])};
                    *(u32x4*)(MIX + t * D + 8 * lane) = w; }
            }
        }
        __syncthreads();
        {
            const int c = tid, gi = c >> 7, cc = c & 127, hw = 1 << gi;
            LAS unsigned char* ag = at + gi * 16384;
            const LAS bf16_t* pc = pt + c;
            if (s0 >= 8 && s0 + 64 + 8 <= SEQ) {
                const float inv = 0.5f / (float)hw;
                float sum = 0.f;
                for (int rr = 8 - hw; rr < 8 + hw; ++rr) sum += bflo((unsigned)pc[rr * 512]);
#pragma unroll 4
                for (int i = 0; i < 64; ++i) {
                    const float val = sum * inv - bflo((unsigned)pc[(i + 8) * 512]);
                    *(LAS bf16_t*)(ag + i * 256 + (((cc >> 3) ^ (i & 15)) * 16) + (cc & 7) * 2) = (bf16_t)(pk2(val, 0.f) & 0xFFFFu);
                    sum += bflo((unsigned)pc[(i + 8 + hw) * 512]) - bflo((unsigned)pc[(i + 8 - hw) * 512]);
                }
            } else {
                float sum = 0.f;
                {   const int lo = max(s0 - hw, 0), hi = min(s0 + hw, SEQ);
                    for (int rr = lo; rr < hi; ++rr) sum += bflo((unsigned)pc[(rr - s0 + 8) * 512]); }
#pragma unroll 4
                for (int i = 0; i < 64; ++i) {
                    const int sq = s0 + i, lo = max(sq - hw, 0), hi = min(sq + hw, SEQ);
                    const float val = sum * __builtin_amdgcn_rcpf((float)(hi - lo)) - bflo((unsigned)pc[(i + 8) * 512]);
                    *(LAS bf16_t*)(ag + i * 256 + (((cc >> 3) ^ (i & 15)) * 16) + (cc & 7) * 2) = (bf16_t)(pk2(val, 0.f) & 0xFFFFu);
                    if (sq + hw < SEQ) sum += bflo((unsigned)pc[(i + 8 + hw) * 512]);
                    if (sq - hw >= 0) sum -= bflo((unsigned)pc[(i + 8 - hw) * 512]);
                }
            }
        }
        __syncthreads();
        {
            const int gi = wave >> 1, dh = wave & 1;
            LAS unsigned char* ag = at + gi * 16384;
            f32x4 acc[4][4];
#pragma unroll
            for (int mt = 0; mt < 4; ++mt)
#pragma unroll
                for (int nt = 0; nt < 4; ++nt) acc[mt][nt] = (f32x4){0.f, 0.f, 0.f, 0.f};
#pragma unroll
            for (int s = 0; s < 4; ++s) {
                bf16x8 af[4];
#pragma unroll
                for (int mt = 0; mt < 4; ++mt) { const int row = mt * 16 + c15; af[mt] = *(const LAS bf16x8*)(ag + row * 256 + (((4 * s + g) ^ (row & 15)) * 16)); }
#pragma unroll
                for (int nt = 0; nt < 4; ++nt) {
                    const bf16x8 wf = ld_frag16(WP + (size_t)gi * 16384 + (dh * 64 + 16 * nt + c15) * 128 + 32 * s + 8 * g);
#pragma unroll
                    for (int mt = 0; mt < 4; ++mt) acc[mt][nt] = MFMA16(wf, af[mt], acc[mt][nt]);
                }
            }
#pragma unroll
            for (int nt = 0; nt < 4; ++nt) {
                const f32x4 ps = *(const f32x4*)(p.in[13] + gi * 128 + dh * 64 + 16 * nt + 4 * g);
#pragma unroll
                for (int mt = 0; mt < 4; ++mt) {
                    const f32x4 v = acc[mt][nt] * ps;
                    u32x2 w = {pk2(v[0], v[1]), pk2(v[2], v[3])};
                    *(u32x2*)(MIX + ((size_t)tok0 + mt * 16 + c15) * D + 512 + gi * 128 + dh * 64 + 16 * nt + 4 * g) = w;
                }
            }
        }
    }
}

DI void phase4c(const Params& p, LAS unsigned char* lds, int tid, int lane, int wave) {
    asm volatile("" : "+v"(tid), "+v"(lane));
    LAS float* lG = (LAS float*)lds; LAS float* lA = lG + 1024; LAS float* lB = lA + 1024; LAS float* lP = lB + 1024;
    const float* x = p.in[0]; const bf16_t* MIXO = (const bf16_t*)(p.ws + WS_RZ); bf16_t* H2 = (bf16_t*)(p.ws + WS_RA);
    for (int rt = blockIdx.x; rt < T / 128; rt += gridDim.x) {
        const int b = rt / 32;
        __syncthreads();
        for (int d = tid; d < 1024; d += NTH) { lG[d] = mod_at(p, b, 2048 + d); lA[d] = p.in[15][d] * (1.f + mod_at(p, b, 4096 + d)); lB[d] = mod_at(p, b, 3072 + d); lP[d] = p.in[5][d]; }
        __syncthreads();
        for (int r0 = wave; r0 < 128; r0 += 4 * NWV) {
            f32x4 m[4][4], xv[4][4];
#pragma unroll
            for (int u = 0; u < 4; ++u) {
                const size_t row = (size_t)rt * 128 + r0 + u * NWV;
                const u32x2* mr = (const u32x2*)(MIXO + row * D) + lane; const f32x4* xr = (const f32x4*)(x + row * D) + lane;
#pragma unroll
                for (int j = 0; j < 4; ++j) { const u32x2 mv = mr[64 * j]; m[u][j] = (f32x4){bflo(mv.x), bfhi(mv.x), bflo(mv.y), bfhi(mv.y)}; xv[u][j] = xr[64 * j]; }
            }
#pragma unroll
            for (int u = 0; u < 4; ++u) {
                const size_t row = (size_t)rt * 128 + r0 + u * NWV;
                float ss = 0.f;
#pragma unroll
                for (int j = 0; j < 4; ++j) ss += m[u][j][0] * m[u][j][0] + m[u][j][1] * m[u][j][1] + m[u][j][2] * m[u][j][2] + m[u][j][3] * m[u][j][3];
                const float rstd = rsqrtf(wave_sum(ss) * (1.f / D) + EPS);
                float s2 = 0.f;
#pragma unroll
                for (int j = 0; j < 4; ++j) {
                    const f32x4 gt = *(const LAS f32x4*)(lG + 4 * lane + 256 * j), pm = *(const LAS f32x4*)(lP + 4 * lane + 256 * j);
                    xv[u][j] = xv[u][j] + gt * (m[u][j] * rstd * pm);
                    s2 += xv[u][j][0] * xv[u][j][0] + xv[u][j][1] * xv[u][j][1] + xv[u][j][2] * xv[u][j][2] + xv[u][j][3] * xv[u][j][3];
                }
                const float rstd2 = rsqrtf(wave_sum(s2) * (1.f / D) + EPS);
                u32x2* orow = (u32x2*)((bf16_t*)(p.ws + WS_RO) + row * D) + lane; u32x2* hrow = (u32x2*)(H2 + row * D) + lane;
#pragma unroll
                for (int j = 0; j < 4; ++j) {
                    { const u32x2 xw = {pk2(xv[u][j][0], xv[u][j][1]), pk2(xv[u][j][2], xv[u][j][3])}; orow[64 * j] = xw; }
                    const f32x4 a = *(const LAS f32x4*)(lA + 4 * lane + 256 * j), bb = *(const LAS f32x4*)(lB + 4 * lane + 256 * j);
                    const f32x4 hv = xv[u][j] * rstd2 * a + bb;
                    u32x2 w = {pk2(hv[0], hv[1]), pk2(hv[2], hv[3])};
                    hrow[64 * j] = w;
                }
            }
        }
    }
}

DI int skey(float v, int idx, int mask) { int u = __float_as_int(v); u ^= (u >> 31) & 0x7FFFFFFF; return (u & ~mask) | idx; }
DI float sval(int k, int mask) { int u = k & ~mask; u ^= (u >> 31) & 0x7FFFFFFF; return __int_as_float(u); }
DI void cswap(int& a, int& b) { const int mx = max(a, b), mn = min(a, b); a = mx; b = mn; }
DI void sort16_desc(int (&a)[16]) {
    cswap(a[0], a[13]); cswap(a[1], a[12]); cswap(a[2], a[15]); cswap(a[3], a[14]); cswap(a[4], a[8]); cswap(a[5], a[6]); cswap(a[7], a[11]); cswap(a[9], a[10]);
    cswap(a[0], a[5]); cswap(a[1], a[7]); cswap(a[2], a[9]); cswap(a[3], a[4]); cswap(a[6], a[13]); cswap(a[8], a[14]); cswap(a[10], a[15]); cswap(a[11], a[12]);
    cswap(a[0], a[1]); cswap(a[2], a[3]); cswap(a[4], a[5]); cswap(a[6], a[8]); cswap(a[7], a[9]); cswap(a[10], a[11]); cswap(a[12], a[13]); cswap(a[14], a[15]);
    cswap(a[0], a[2]); cswap(a[1], a[3]); cswap(a[4], a[10]); cswap(a[5], a[11]); cswap(a[6], a[7]); cswap(a[8], a[9]); cswap(a[12], a[14]); cswap(a[13], a[15]);
    cswap(a[1], a[2]); cswap(a[3], a[12]); cswap(a[4], a[6]); cswap(a[5], a[7]); cswap(a[8], a[10]); cswap(a[9], a[11]); cswap(a[13], a[14]);
    cswap(a[1], a[4]); cswap(a[2], a[6]); cswap(a[5], a[8]); cswap(a[7], a[10]); cswap(a[9], a[13]); cswap(a[11], a[14]);
    cswap(a[2], a[4]); cswap(a[3], a[6]); cswap(a[9], a[12]); cswap(a[11], a[13]);
    cswap(a[3], a[5]); cswap(a[6], a[8]); cswap(a[7], a[9]); cswap(a[10], a[12]);
    cswap(a[3], a[4]); cswap(a[5], a[6]); cswap(a[7], a[8]); cswap(a[9], a[10]); cswap(a[11], a[12]);
    cswap(a[6], a[7]); cswap(a[8], a[9]);
}
DI void merge16_desc(int (&x)[16], const int (&y)[16]) {
#pragma unroll
    for (int i = 0; i < 16; ++i) x[i] = max(x[i], y[15 - i]);
#pragma unroll
    for (int j = 8; j > 0; j >>= 1) {
#pragma unroll
        for (int i = 0; i < 16; ++i) { const int l = i ^ j; if (l > i) cswap(x[i], x[l]); }
    }
}

DI void phase5b(const Params& p, LAS unsigned char* lds, int tid, int lane, int wave) {
    asm volatile("" : "+v"(tid), "+v"(lane));
    unsigned char* ws = p.ws;
    const bf16_t* Q2 = (const bf16_t*)(ws + WS_RZ);
    const bf16_t* SKB = (const bf16_t*)(ws + WS_SKB);
    int* EIDX = (int*)(ws + WS_RS);
    LAS unsigned char* tab = lds + tid * 32;
    LAS unsigned char* skl = lds + 16384;
    const int c31 = lane & 31, hi = lane >> 5;
    for (int btask = blockIdx.x; btask < 256; btask += gridDim.x) {
        const int h = btask & 7, tgc = btask >> 3;
        __syncthreads();
#pragma unroll
        for (int ps = 0; ps < 8; ++ps) {
            const int idx = tid + NTH * ps, row = idx >> 4, ch = idx & 15;
            const u32x4 v = *(const u32x4*)(SKB + ((size_t)h * 256 + row) * 128 + ch * 8);
            *(LAS u32x4*)(skl + row * 256 + ((ch ^ (row & 15)) * 16)) = v;
        }
        __syncthreads();
      f32x4 qa[4];
      const int qrow0 = (btask * NWV + wave) * 16;
      quant_load(p, qrow0, lane, qa);
      for (int ti = 0; ti < 4; ++ti) {
        const int tg = tgc * 32 + wave * 4 + ti;
        const size_t tok = (size_t)tg * 32 + c31;
        int lst[2][16];
        bf16x8 bq[2][8];
#pragma unroll
        for (int pp = 0; pp < 2; ++pp) {
            const bf16_t* qp = Q2 + tok * 2048 + h * 256 + pp * 128 + 8 * hi;
            asm volatile("" : "+v"(qp));
#pragma unroll
            for (int ks = 0; ks < 8; ++ks) bq[pp][ks] = ld_frag16(qp + 16 * ks);
        }
#pragma unroll
        for (int pp = 0; pp < 2; ++pp) {
            int run[16];
#pragma unroll
            for (int r = 0; r < 16; ++r) run[r] = (int)0x80000000;
#pragma unroll 1
            for (int kt = 0; kt < 4; ++kt) {
                const LAS unsigned char* kb = skl + pp * 32768 + (32 * kt + c31) * 256;
                f32x16 acc;
#pragma unroll
                for (int r = 0; r < 16; ++r) acc[r] = 0.f;
#pragma unroll
                for (int ks = 0; ks < 8; ++ks) acc = MFMA32(*(const LAS bf16x8*)(kb + (((2 * ks + hi) ^ (c31 & 15)) * 16)), bq[pp][ks], acc);
                int cur[16];
#pragma unroll
                for (int r = 0; r < 16; ++r) cur[r] = skey(acc[r], 32 * kt + 8 * (r >> 2) + 4 * hi + (r & 3), 0x7F);
                sort16_desc(cur);
                merge16_desc(run, cur);
                if (kt & 1) { const int qr = ti * 4 + pp * 2 + (kt >> 1); quant_store(p, qrow0 + qr, lane, qa); if (qr < 15) quant_load(p, qrow0 + qr + 1, lane, qa); }
            }
            int oth[16];
#pragma unroll
            for (int r = 0; r < 16; ++r) oth[r] = __shfl_xor(run[r], 32);
            merge16_desc(run, oth);
#pragma unroll
            for (int r = 0; r < 16; ++r) lst[pp][r] = run[r];
        }
#pragma unroll
        for (int pp = 0; pp < 2; ++pp) {
            u32x4 w;
#pragma unroll
            for (int q = 0; q < 4; ++q) w[q] = (lst[pp][4 * q] & 0x7F) | ((lst[pp][4 * q + 1] & 0x7F) << 8) | ((lst[pp][4 * q + 2] & 0x7F) << 16) | ((lst[pp][4 * q + 3] & 0x7F) << 24);
            *(LAS u32x4*)(tab + 16 * pp) = w;
        }
        float va[16], vb[16];
#pragma unroll
        for (int r = 0; r < 16; ++r) { va[r] = sval(lst[0][r], 0x7F); vb[r] = sval(lst[1][r], 0x7F); }
        int cand[4][16];
        {
            int cnt = 0;
#pragma unroll
            for (int i = 0; i < 16; ++i)
#pragma unroll
                for (int j = 0; j < 16; ++j)
                    if ((i + 1) * (j + 1) <= 16) { cand[cnt >> 4][cnt & 15] = skey(va[i] + vb[j], (i << 4) | j, 0xFF); ++cnt; }
#pragma unroll
            for (int q = 50; q < 64; ++q) cand[q >> 4][q & 15] = (int)0x80000000;
        }
        sort16_desc(cand[0]); sort16_desc(cand[1]); sort16_desc(cand[2]); sort16_desc(cand[3]);
        merge16_desc(cand[0], cand[1]); merge16_desc(cand[2], cand[3]); merge16_desc(cand[0], cand[2]);
        asm volatile("s_waitcnt lgkmcnt(0)" ::: "memory");
        float sv[16]; int ex[16];
        const float mx = sval(cand[0][0], 0xFF);
        float sum = 0.f;
#pragma unroll
        for (int r = 0; r < 16; ++r) {
            const int ck = cand[0][r];
            const int i1 = tab[(ck >> 4) & 15], i2 = tab[16 + (ck & 15)];
            ex[r] = i1 * 128 + i2;
            sv[r] = __expf(sval(ck, 0xFF) - mx); sum += sv[r];
        }
        const float inv = 1.f / sum;
        unsigned* ep = (unsigned*)EIDX + tok * 128 + h * 16 + 8 * hi;
        unsigned pe[16];
#pragma unroll
        for (int r = 0; r < 16; ++r) pe[r] = (unsigned)ex[r] | (pk2(sv[r] * inv, 0.f) << 16);
        if (hi == 0) { *(u32x4*)ep = (u32x4){pe[0], pe[1], pe[2], pe[3]}; *(u32x4*)(ep + 4) = (u32x4){pe[4], pe[5], pe[6], pe[7]}; }
        else         { *(u32x4*)ep = (u32x4){pe[8], pe[9], pe[10], pe[11]}; *(u32x4*)(ep + 4) = (u32x4){pe[12], pe[13], pe[14], pe[15]}; }
      }
    }
}

template <int K> DI int swz_bcast(int v) { return __builtin_amdgcn_ds_swizzle(v, 0x10 | (K << 5)); }
template <int W> DI int swz_xor(int v) { return __builtin_amdgcn_ds_swizzle(v, 0x1F | (W << 10)); }
template <int K> struct IC { static constexpr int v = K; };
template <int N, int I = 0, class F> DI void static_for(F&& f) { if constexpr (I < N) { f(IC<I>{}); static_for<N, I + 1>(f); } }
DI float row16_sum(float v) {
    v += __builtin_bit_cast(float, __builtin_amdgcn_update_dpp(0, __builtin_bit_cast(int, v), 0xB1, 0xF, 0xF, true));
    v += __builtin_bit_cast(float, __builtin_amdgcn_update_dpp(0, __builtin_bit_cast(int, v), 0x4E, 0xF, 0xF, true));
    v += __builtin_bit_cast(float, __builtin_amdgcn_update_dpp(0, __builtin_bit_cast(int, v), 0x141, 0xF, 0xF, true));
    v += __builtin_bit_cast(float, __builtin_amdgcn_update_dpp(0, __builtin_bit_cast(int, v), 0x140, 0xF, 0xF, true));
    return v;
}
DI void phase6(const Params& p, LAS unsigned char* lds, int tid, int lane, int wave) {
    asm volatile("" : "+v"(tid), "+v"(lane));
    unsigned char* ws = p.ws;
    const bf16_t* H2 = (const bf16_t*)(ws + WS_RA);
    const unsigned char* UQ = ws + WS_UB; const unsigned char* VQ = ws + WS_VB;
    const float* SU = (const float*)(ws + WS_SU); const float* SV = (const float*)(ws + WS_SV);
    const unsigned* EIDX = (const unsigned*)(ws + WS_RS);
    LAS float* lG = (LAS float*)lds;
    const int q = lane >> 4, l16 = lane & 15;
    LAS int* le = (LAS int*)(lds + 4096 + wave * 6144) + q * 128;
    LAS float* lg = (LAS float*)(lds + 4096 + wave * 6144 + 2048) + q * 128;
    LAS float* lc = (LAS float*)(lds + 4096 + wave * 6144 + 4096) + q * 128;
    const unsigned qlo = q < 2 ? (0xFFFFu << (16 * q)) : 0u, qhi = q >= 2 ? (0xFFFFu << (16 * (q - 2))) : 0u;
    for (int rt = blockIdx.x; rt < T / 128; rt += gridDim.x) {
        const int b = rt / 32;
        __syncthreads();
        for (int d = tid; d < 1024; d += NTH) lG[d] = mod_at(p, b, 5120 + d) * p.in[16][d];
        __syncthreads();
#pragma unroll 1
        for (int rd = 0; rd < 4; ++rd) {
            __syncthreads();
            const size_t t = (size_t)rt * 128 + wave * 16 + rd * 4 + q;
            {
                int e[8]; float g[8];
#pragma unroll
                for (int r = 0; r < 8; ++r) { const unsigned pe = EIDX[t * 128 + r * 16 + l16]; e[r] = (int)(pe & 0xFFFFu); g[r] = bfhi(pe); }
                unsigned W[4] = {0u, 0u, 0u, 0u};
#pragma unroll
                for (int r = 0; r < 8; ++r) {
                    const int k = e[r] >> 10; const unsigned inc = 1u << (8 * (k & 3)); const int w = k >> 2;
                    W[0] += (w == 0) ? inc : 0u; W[1] += (w == 1) ? inc : 0u; W[2] += (w == 2) ? inc : 0u; W[3] += (w == 3) ? inc : 0u;
                }
                unsigned C[4];
                {
                    unsigned tot[4], exc[4];
#pragma unroll
                    for (int w = 0; w < 4; ++w) {
                        unsigned x = W[w];
                        x += (unsigned)__builtin_amdgcn_update_dpp(0, (int)x, 0x111, 0xF, 0xF, true);
                        x += (unsigned)__builtin_amdgcn_update_dpp(0, (int)x, 0x112, 0xF, 0xF, true);
                        x += (unsigned)__builtin_amdgcn_update_dpp(0, (int)x, 0x114, 0xF, 0xF, true);
                        x += (unsigned)__builtin_amdgcn_update_dpp(0, (int)x, 0x118, 0xF, 0xF, true);
                        exc[w] = x - W[w];
                        tot[w] = (unsigned)swz_bcast<15>((int)x);
                    }
                    unsigned carry = 0u;
#pragma unroll
                    for (int w = 0; w < 4; ++w) {
                        const unsigned P = tot[w] + (tot[w] << 8) + (tot[w] << 16) + (tot[w] << 24);
                        C[w] = (P - tot[w]) + carry * 0x01010101u + exc[w];
                        carry += P >> 24;
                    }
                }
#pragma unroll
                for (int r = 0; r < 8; ++r) {
                    const int k = e[r] >> 10; const int sh = 8 * (k & 3); const int w = k >> 2; const unsigned inc = 1u << sh;
                    const unsigned cw = (w == 0) ? C[0] : (w == 1) ? C[1] : (w == 2) ? C[2] : C[3];
                    const int pos = (int)((cw >> sh) & 0xFFu);
                    le[pos] = e[r]; lg[pos] = g[r];
                    C[0] += (w == 0) ? inc : 0u; C[1] += (w == 1) ? inc : 0u; C[2] += (w == 2) ? inc : 0u; C[3] += (w == 3) ? inc : 0u;
                }
                asm volatile("s_waitcnt lgkmcnt(0)" ::: "memory");
            }
            {
                int hq[16]; float ish;
                {
                    float hv[64]; float hm = 0.f;
#pragma unroll
                    for (int i = 0; i < 4; ++i) {
                        const u32x4 h0 = *(const u32x4*)(H2 + t * D + 256 * i + 16 * l16), h1 = *(const u32x4*)(H2 + t * D + 256 * i + 16 * l16 + 8);
#pragma unroll
                        for (int c = 0; c < 4; ++c) { hv[16 * i + 2 * c] = bflo(h0[c]); hv[16 * i + 2 * c + 1] = bfhi(h0[c]); hv[16 * i + 8 + 2 * c] = bflo(h1[c]); hv[16 * i + 8 + 2 * c + 1] = bfhi(h1[c]); }
                    }
#pragma unroll
                    for (int j = 0; j < 64; ++j) hm = fmaxf(hm, fabsf(hv[j]));
                    hm = fmaxf(hm, __builtin_bit_cast(float, __builtin_amdgcn_update_dpp(0, __builtin_bit_cast(int, hm), 0xB1, 0xF, 0xF, true)));
                    hm = fmaxf(hm, __builtin_bit_cast(float, __builtin_amdgcn_update_dpp(0, __builtin_bit_cast(int, hm), 0x4E, 0xF, 0xF, true)));
                    hm = fmaxf(hm, __builtin_bit_cast(float, __builtin_amdgcn_update_dpp(0, __builtin_bit_cast(int, hm), 0x141, 0xF, 0xF, true)));
                    hm = fmaxf(hm, __builtin_bit_cast(float, __builtin_amdgcn_update_dpp(0, __builtin_bit_cast(int, hm), 0x140, 0xF, 0xF, true)));
                    const float s8 = hm > 1e-30f ? 127.f / hm : 0.f; ish = hm * (1.f / 127.f);
#pragma unroll
                    for (int d = 0; d < 16; ++d) {
                        const int q0 = __float2int_rn(hv[4 * d] * s8), q1 = __float2int_rn(hv[4 * d + 1] * s8), q2 = __float2int_rn(hv[4 * d + 2] * s8), q3 = __float2int_rn(hv[4 * d + 3] * s8);
                        hq[d] = (int)((unsigned)(q0 & 0xFF) | ((unsigned)(q1 & 0xFF) << 8) | ((unsigned)(q2 & 0xFF) << 16) | ((unsigned)q3 << 24));
                    }
                }
                constexpr int UD = 4;
                u32x4 ub[UD][4];
                int evn = le[l16];
                static_for<UD>([&](auto kc) { constexpr int k = decltype(kc)::v; const unsigned char* up = UQ + (size_t)swz_bcast<k>(evn) * 1024 + 16 * l16;
#pragma unroll
                    for (int i = 0; i < 4; ++i) ub[k][i] = *(const u32x4*)(up + 256 * i); });
#pragma unroll 1
                for (int bt = 0; bt < 8; ++bt) {
                    if (bt) __syncthreads();
                    const int ev = evn; const float gv = lg[bt * 16 + l16];
                    evn = le[(bt < 7 ? bt + 1 : 7) * 16 + l16];
                    const float isu = SU[ev] * ish, isv = SV[ev];
                    int part[16];
                    static_for<16>([&](auto kc) {
                        constexpr int k = decltype(kc)::v, sl = k % UD;
                        int a = 0;
#pragma unroll
                        for (int i = 0; i < 4; ++i) {
                            const u32x4 u = ub[sl][i];
#pragma unroll
                            for (int c = 0; c < 4; ++c) a = __builtin_amdgcn_sdot4((int)u[c], hq[4 * i + c], a, false);
                        }
                        part[k] = a;
                        {
                            constexpr int kn = k + UD;
                            int idx; if constexpr (kn < 16) idx = swz_bcast<(kn & 15)>(ev); else idx = swz_bcast<(kn & 15)>(evn);
                            const unsigned char* up = UQ + (size_t)idx * 1024 + 16 * l16;
#pragma unroll
                            for (int i = 0; i < 4; ++i) ub[sl][i] = *(const u32x4*)(up + 256 * i);
                        }
                    });
                    static_for<4>([&](auto sc) {
                        constexpr int w = 8 >> decltype(sc)::v;
                        const bool up2 = (lane & w) != 0;
#pragma unroll
                        for (int e = 0; e < w; ++e) {
                            const int keep = up2 ? part[e + w] : part[e], send = up2 ? part[e] : part[e + w];
                            part[e] = keep + swz_xor<w>(send);
                        }
                    });
                    const float dot = (float)part[0] * isu;
                    lc[bt * 16 + l16] = gv * 0.5f * dot * (1.f + erff(dot * 0.70710678118654752f)) * isv;
                }
                asm volatile("s_waitcnt lgkmcnt(0)" ::: "memory");
            }
            __syncthreads();
            f32x2 y[32];
#pragma unroll
            for (int i = 0; i < 32; ++i) y[i] = (f32x2){0.f, 0.f};
            {
                constexpr int VD = 4;
                u32x4 vbuf[VD][4];
                int evn = le[l16];
                static_for<VD>([&](auto kc) { constexpr int k = decltype(kc)::v; const unsigned char* vp = VQ + (size_t)swz_bcast<k>(evn) * 1024 + 16 * l16;
#pragma unroll
                    for (int i = 0; i < 4; ++i) vbuf[k][i] = *(const u32x4*)(vp + 256 * i); });
#pragma unroll 1
                for (int bt = 0; bt < 8; ++bt) {
                    if (bt) __syncthreads();
                    const int ev = evn; const int cv = __float_as_int(lc[bt * 16 + l16]);
                    evn = le[(bt < 7 ? bt + 1 : 7) * 16 + l16];
                    static_for<16>([&](auto kc) {
                        constexpr int k = decltype(kc)::v, sl = k % VD;
                        const float cc = __int_as_float(swz_bcast<k>(cv));
                        const f32x2 c2 = (f32x2){cc, cc};
#pragma unroll
                        for (int i = 0; i < 4; ++i) {
                            const u32x4 v = vbuf[sl][i];
#pragma unroll
                            for (int c = 0; c < 4; ++c) {
                                const int w = (int)v[c];
                                y[8 * i + 2 * c] = __builtin_elementwise_fma(__builtin_amdgcn_cvt_pk_f32_fp8(w, false), c2, y[8 * i + 2 * c]);
                                y[8 * i + 2 * c + 1] = __builtin_elementwise_fma(__builtin_amdgcn_cvt_pk_f32_fp8(w, true), c2, y[8 * i + 2 * c + 1]);
                            }
                        }
                        {
                            constexpr int kn = k + VD;
                            int idx; if constexpr (kn < 16) idx = swz_bcast<(kn & 15)>(ev); else idx = swz_bcast<(kn & 15)>(evn);
                            const unsigned char* vp = VQ + (size_t)idx * 1024 + 16 * l16;
#pragma unroll
                            for (int i = 0; i < 4; ++i) vbuf[sl][i] = *(const u32x4*)(vp + 256 * i);
                        }
                    });
                }
            }
            float ss = 0.f;
#pragma unroll
            for (int i = 0; i < 32; ++i) ss += y[i].x * y[i].x + y[i].y * y[i].y;
            const float rstd = rsqrtf(row16_sum(ss) * (1.f / D) + EPS);
            float* orow = p.out + t * D;
#pragma unroll
            for (int i = 0; i < 4; ++i)
#pragma unroll
                for (int c = 0; c < 4; ++c) {
                    const int col = 256 * i + 16 * l16 + 4 * c;
                    const u32x2 xb = *(const u32x2*)((const bf16_t*)(ws + WS_RO) + t * D + col);
                    f32x4 xv = {bflo(xb.x), bfhi(xb.x), bflo(xb.y), bfhi(xb.y)};
                    const f32x4 gg = *(const LAS f32x4*)(lG + col);
                    xv[0] += gg[0] * y[8 * i + 2 * c].x * rstd; xv[1] += gg[1] * y[8 * i + 2 * c].y * rstd; xv[2] += gg[2] * y[8 * i + 2 * c + 1].x * rstd; xv[3] += gg[3] * y[8 * i + 2 * c + 1].y * rstd;
                    *(f32x4*)(orow + col) = xv;
                }
        }
    }
}


__global__ void __launch_bounds__(NTH) fwd_megakernel(Params p) {
    extern __shared__ __attribute__((aligned(16))) unsigned char lds_raw[];
    LAS unsigned char* lds = (LAS unsigned char*)lds_raw;
    const int tid = threadIdx.x, lane = tid & 63, wave = __builtin_amdgcn_readfirstlane(tid >> 6);
    volatile LAS unsigned* st = (volatile LAS unsigned*)(lds + LDS_BARW);
    if (tid == 0) { st[0] = 0u; st[1] = 0u; st[2] = 0u; st[3] = 0u; }
    __syncthreads();
    XcdBarrier bar = xcd_barrier_post((unsigned*)(p.ws + WS_CTL), st);
    unsigned char* ws = p.ws;

    phase0(p, lds, tid, lane, wave);
    xcd_barrier(bar);
    phase1(p, lds, tid, lane, wave);
    afb_tail((const bf16_t*)(ws + WS_RA), (const bf16_t*)(ws + WS_WIN) + (size_t)ZW * D, (float*)(ws + WS_AFB), lds, tid, lane, wave);
    xcd_barrier(bar);
    { pg8::Gemm g{(const bf16_t*)(ws + WS_RA), (const bf16_t*)(ws + WS_WIN), T, ZW, D}; pg8::StaticOrder S; S.init(T, ZW, (int)gridDim.x, (int)blockIdx.x);
      pg8::EpiB16 e{(bf16_t*)(ws + WS_RZ), ZW}; pg8::gemm_phase<pg8::EpiB16, pg8::StaticOrder, true, true>(lds, g, S, e);
 }
    xcd_barrier(bar);
    phaseGA(p, lds, tid, lane, wave);
    xcd_barrier(bar);
    phaseGB(p, tid);
    xcd_barrier(bar);
    phase4a(p, lds, tid, lane, wave);
    xcd_barrier(bar);
    { pg8::Gemm g{(const bf16_t*)(ws + WS_RA), (const bf16_t*)(ws + WS_WOUT), T, D, D}; pg8::StaticOrder S; S.init(T, D, (int)gridDim.x, (int)blockIdx.x);
      pg8::EpiB16 e{(bf16_t*)(ws + WS_RZ), D}; pg8::gemm_phase<pg8::EpiB16, pg8::StaticOrder, true, true>(lds, g, S, e); }
    xcd_barrier(bar);
    phase4c(p, lds, tid, lane, wave);
    xcd_barrier(bar);
    { pg8::Gemm g{(const bf16_t*)(ws + WS_RA), (const bf16_t*)(ws + WS_WQ), T, 2048, D}; pg8::StaticOrder S; S.init(T, 2048, (int)gridDim.x, (int)blockIdx.x);
      pg8::EpiB16 e{(bf16_t*)(ws + WS_RZ), 2048}; pg8::gemm_phase<pg8::EpiB16, pg8::StaticOrder, true, true>(lds, g, S, e); }
    xcd_barrier(bar);
    phase5b(p, lds, tid, lane, wave);
    xcd_barrier(bar);
    phase6(p, lds, tid, lane, wave);
}

extern "C" void kernel_launch(void* const* d_in, const int* in_sizes, int n_in, void* d_out, int out_size, void* d_ws, size_t ws_size, hipStream_t stream) {
    static int grid = 0;
    if (grid == 0) {
        if (n_in != 21 || out_size != T * D || ws_size < WS_END) { fprintf(stderr, "kernel_launch: unexpected shapes (n_in %d out %d ws %zu need %zu)\n", n_in, out_size, ws_size, (size_t)WS_END); grid = -1; return; }
        int dev = 0, cus = 0, per_cu = 0;
        hipGetDevice(&dev); hipDeviceGetAttribute(&cus, hipDeviceAttributeMultiprocessorCount, dev);
        hipFuncSetAttribute((const void*)fwd_megakernel, hipFuncAttributeMaxDynamicSharedMemorySize, LDS_BYTES);
        hipOccupancyMaxActiveBlocksPerMultiprocessor(&per_cu, (const void*)fwd_megakernel, NTH, LDS_BYTES);
        (void)hipGetLastError();
        if (per_cu < 1) fprintf(stderr, "kernel_launch: occupancy query says %d blocks per CU\n", per_cu);
        grid = cus;
    }
    if (grid < 0) return;
    hipMemsetAsync((char*)d_ws + WS_CTL, 0, 64 * 1024, stream);
    Params p{};
    for (int i = 0; i < 21; ++i) p.in[i] = (const float*)d_in[i];
    p.out = (float*)d_out; p.ws = (unsigned char*)d_ws;
    hipLaunchKernelGGL(fwd_megakernel, dim3(grid), dim3(NTH), LDS_BYTES, stream, p);
}
```

```cpp
#include <hip/hip_runtime.h>
#include <cstdio>
#include <cstdint>

#define DI __device__ __forceinline__
#define LAS __attribute__((address_space(3)))
typedef unsigned short bf16_t;
typedef short bf16x8 __attribute__((ext_vector_type(8)));
typedef float f32x4 __attribute__((ext_vector_type(4)));
typedef float f32x2 __attribute__((ext_vector_type(2)));
typedef float f32x16 __attribute__((ext_vector_type(16)));
typedef unsigned u32x4 __attribute__((ext_vector_type(4)));
typedef unsigned u32x2 __attribute__((ext_vector_type(2)));
typedef __bf16 bf16x2v __attribute__((ext_vector_type(2)));

constexpr int T = 32768, D = 1024, SEQ = 4096, NB = 8;
constexpr int NTH = 512, NWV = 8;
constexpr int ZW = 2048;
constexpr int NIN = 2176;
constexpr float EPS = 1e-6f;

constexpr size_t MB = 1024 * 1024;
constexpr size_t WS_CTL   = 0;
constexpr size_t WS_MODP  = 64 * 1024;
constexpr size_t WS_WIN   = WS_MODP + 8 * 8 * 6144 * 4;
constexpr size_t WS_WOUT  = WS_WIN + (size_t)NIN * 1024 * 2;
constexpr size_t WS_WQ    = WS_WOUT + 1024 * 1024 * 2;
constexpr size_t WS_SKB   = WS_WQ + 2048 * 1024 * 2;
constexpr size_t WS_WP    = WS_SKB + 16 * 128 * 128 * 2;
constexpr size_t WS_AFB   = WS_WP + 4 * 128 * 128 * 2;
constexpr size_t WS_UB    = WS_AFB + (size_t)T * 32 * 4;
constexpr size_t WS_VB    = WS_UB + 32 * MB;
constexpr size_t WS_SU    = WS_UB + 16 * MB, WS_SV = WS_VB + 16 * MB;
constexpr size_t WS_RA    = WS_VB + 32 * MB;
constexpr size_t WS_RZ    = WS_RA + 64 * MB;
constexpr size_t WS_RS    = WS_RZ + 128 * MB;
constexpr size_t WS_RO    = WS_RS + 6 * 16 * MB + 1 * MB;
constexpr size_t WS_END   = WS_RO + 128 * MB;
static_assert(WS_END <= 512 * MB, "workspace too large");

struct Params { const float* in[21]; float* out; unsigned char* ws; };

DI unsigned pk2(float a, float b) { f32x2 f = {a, b}; bf16x2v h = __builtin_convertvector(f, bf16x2v); return __builtin_bit_cast(unsigned, h); }
DI float dot2bf(unsigned a, unsigned b, float c) { return __builtin_amdgcn_fdot2_f32_bf16(__builtin_bit_cast(bf16x2v, a), __builtin_bit_cast(bf16x2v, b), c, false); }
DI float bflo(unsigned u) { return __uint_as_float(u << 16); }
DI float bfhi(unsigned u) { return __uint_as_float(u & 0xFFFF0000u); }
DI float wave_sum(float v) {
#pragma unroll
    for (int o = 1; o < 64; o <<= 1) v += __shfl_xor(v, o);
    return v;
}
DI bf16x8 ld_frag16(const bf16_t* p) { return __builtin_bit_cast(bf16x8, *(const u32x4*)p); }
DI bf16x8 ld_frag_perm(const bf16_t* p, int g) {
    const u32x2 lo = *(const u32x2*)(p + 4 * g), hi = *(const u32x2*)(p + 16 + 4 * g);
    u32x4 v = {lo.x, lo.y, hi.x, hi.y}; return __builtin_bit_cast(bf16x8, v);
}
DI int perm32(int k) { return (k & ~31) | (((k >> 2) & 3) << 3) | (((k >> 4) & 1) << 2) | (k & 3); }
DI bf16x8 pack8(const f32x4& a, const f32x4& b) { u32x4 v = {pk2(a[0], a[1]), pk2(a[2], a[3]), pk2(b[0], b[1]), pk2(b[2], b[3])}; return __builtin_bit_cast(bf16x8, v); }
#define MFMA16(a, b, c) __builtin_amdgcn_mfma_f32_16x16x32_bf16((a), (b), (c), 0, 0, 0)
#define MFMA32(a, b, c) __builtin_amdgcn_mfma_f32_32x32x16_bf16((a), (b), (c), 0, 0, 0)

#define XB_TMO      128
#define XB_XCNT(j)  (256  + 64 * (j))
#define XB_XSUB(j)  (1280 + 64 * (j))
#define XB_XGEN(j)  (2304 + 64 * (j))
#define XB_TOP      3328
#define XB_TOPGEN   3392
#define XCD_BAR_WORDS 3456
#define XB_SPIN_CAP (1u << 22)
DI unsigned xb_ld(unsigned* p)              { return __hip_atomic_load(p, __ATOMIC_RELAXED, __HIP_MEMORY_SCOPE_AGENT); }
DI unsigned xb_add(unsigned* p, unsigned v) { return __hip_atomic_fetch_add(p, v, __ATOMIC_RELAXED, __HIP_MEMORY_SCOPE_AGENT); }
DI unsigned xb_xcc_id() { return (unsigned)__builtin_amdgcn_s_getreg((3 << 11) | 20) & 0xFu; }
#define XB_SPIN(cond, bar) do { unsigned _sp = 0; while (cond) { __builtin_amdgcn_s_sleep(1); \
    if ((++_sp & 255u) == 0u) { if (xb_ld(&(bar)[XB_TMO])) break; if (_sp > XB_SPIN_CAP) { atomicAdd(&(bar)[XB_TMO], 1u); break; } } } } while (0)
struct XcdBarrier { unsigned* bar; unsigned x; volatile LAS unsigned* st; };
DI XcdBarrier xcd_barrier_post(unsigned* bar, volatile LAS unsigned* st) {
    XcdBarrier b; b.bar = bar; b.x = xb_xcc_id(); b.st = st;
    if (threadIdx.x == 0) (void)xb_add(&bar[XB_XCNT(b.x)], 1u);
    return b;
}
DI void xcd_barrier_complete(unsigned* bar, unsigned x, unsigned& nloc, unsigned& nx) {
    const unsigned G = gridDim.x * gridDim.y * gridDim.z;
    unsigned sum, cnt, mine, sp = 0u;
    for (;;) {
        sum = 0u; cnt = 0u; mine = 0u;
#pragma unroll
        for (unsigned j = 0; j < 16; ++j) { const unsigned c = xb_ld(&bar[XB_XCNT(j)]); sum += c; cnt += (c > 0u) ? 1u : 0u; mine = (j == x) ? c : mine; }
        if (sum == G) break;
        __builtin_amdgcn_s_sleep(1);
        if ((++sp & 255u) == 0u) { if (xb_ld(&bar[XB_TMO])) break; if (sp > XB_SPIN_CAP) { atomicAdd(&bar[XB_TMO], 1u); break; } }
    }
    nloc = mine > 0u ? mine : 1u; nx = cnt > 0u ? cnt : 1u;
}
DI void xcd_barrier(const XcdBarrier& b) {
    asm volatile("s_waitcnt vmcnt(0)" ::: "memory");
    __syncthreads();
    if (threadIdx.x == 0) {
        unsigned* bar = b.bar;
        __builtin_amdgcn_s_waitcnt(0);
        unsigned nloc = b.st[0], nx = b.st[1];
        if (nloc == 0u) { xcd_barrier_complete(bar, b.x, nloc, nx); b.st[0] = nloc; b.st[1] = nx; }
        const unsigned old = xb_add(&bar[XB_XSUB(b.x)], 1u);
        const unsigned gen = old / nloc;
        if (old + 1u == (gen + 1u) * nloc) {
            __builtin_amdgcn_fence(__ATOMIC_RELEASE, "agent");
            asm volatile("s_waitcnt vmcnt(0)" ::: "memory");
            const unsigned og = xb_add(&bar[XB_TOP], 1u);
            const unsigned tg = og / nx;
            if (og + 1u == (tg + 1u) * nx) xb_add(&bar[XB_TOPGEN], 1u);
            else XB_SPIN(xb_ld(&bar[XB_TOPGEN]) == tg, bar);
            __builtin_amdgcn_fence(__ATOMIC_ACQUIRE, "agent");
            xb_add(&bar[XB_XGEN(b.x)], 1u);
            asm volatile("s_waitcnt vmcnt(0)" ::: "memory");
        } else {
            XB_SPIN(xb_ld(&bar[XB_XGEN(b.x)]) == gen, bar);
            __builtin_amdgcn_fence(__ATOMIC_ACQUIRE, "agent");
            asm volatile("s_waitcnt vmcnt(0)" ::: "memory");
        }
    }
    __syncthreads();
}

constexpr int LDS_BYTES = 152 * 1024;
constexpr int LDS_BARW = LDS_BYTES - 16;

DI void p0_transpose_item(const float* W, int ldw, int K, bf16_t* WT, int dst_row0, int src_col0, float scale, bool zero, LAS float* scr, int kb, int lane) {
    const int k0 = 64 * kb;
    if (zero) scale = 0.f;
#pragma unroll 8
    for (int i = 0; i < 32; ++i) { const int kk = 2 * i + (lane >> 5); scr[kk * 33 + (lane & 31)] = W[(size_t)(k0 + kk) * ldw + src_col0 + (lane & 31)] * scale; }
    asm volatile("s_waitcnt lgkmcnt(0)" ::: "memory");
    const int c = lane & 7;
#pragma unroll
    for (int j = 0; j < 4; ++j) { const int n = (lane >> 3) + 8 * j; const LAS float* s = scr + (8 * c) * 33 + n;
        u32x4 o; o.x = pk2(s[0 * 33], s[1 * 33]); o.y = pk2(s[2 * 33], s[3 * 33]); o.z = pk2(s[4 * 33], s[5 * 33]); o.w = pk2(s[6 * 33], s[7 * 33]);
        *(u32x4*)(WT + (size_t)(dst_row0 + n) * K + k0 + 8 * c) = o; }
    asm volatile("s_waitcnt lgkmcnt(0)" ::: "memory");
}

DI void phase0(const Params& p, LAS unsigned char* lds, int tid, int lane, int wave) {
    asm volatile("" : "+v"(tid), "+v"(lane));
    unsigned char* ws = p.ws;
    LAS float* sl = (LAS float*)lds;
    LAS float* scr = (LAS float*)(lds + 32768 + wave * 8448);
    const float* c = p.in[1];
    { float cv[16];
#pragma unroll
      for (int i = 0; i < 16; ++i) cv[i] = c[tid + NTH * i];
#pragma unroll
      for (int i = 0; i < 16; ++i) { const int e = tid + NTH * i, b = e >> 10, k = e & 1023; const float v = cv[i]; sl[k * 8 + b] = v / (1.f + __expf(-v)); } }
    __syncthreads();
    const int gw = wave * gridDim.x + blockIdx.x, NGW = gridDim.x * NWV;
    constexpr int I_MOD = 768, I_WIN = 16 * 68, I_WOUT = 16 * 32, I_WQ = 16 * 64, I_WP = 32;
    constexpr int NITEMS = I_MOD + I_WIN + I_WOUT + I_WQ + I_WP;
    for (int it = gw; it < NITEMS; it += NGW) {
        int r = it;
        if (r < I_MOD) {
            const int cg = r % 96, ks = r / 96, n = cg * 64 + lane, k0 = ks * 128;
            const float* W = p.in[2] + (size_t)k0 * 6144 + n;
            float acc[8];
#pragma unroll
            for (int b = 0; b < 8; ++b) acc[b] = 0.f;
#pragma unroll 32
            for (int k = 0; k < 128; ++k) {
                const float w = W[(size_t)k * 6144];
                const f32x4 s0 = *(const LAS f32x4*)(sl + (k0 + k) * 8), s1 = *(const LAS f32x4*)(sl + (k0 + k) * 8 + 4);
                acc[0] += s0[0] * w; acc[1] += s0[1] * w; acc[2] += s0[2] * w; acc[3] += s0[3] * w;
                acc[4] += s1[0] * w; acc[5] += s1[1] * w; acc[6] += s1[2] * w; acc[7] += s1[3] * w;
            }
            float* mp = (float*)(ws + WS_MODP) + (size_t)ks * 8 * 6144 + n;
#pragma unroll
            for (int b = 0; b < 8; ++b) mp[b * 6144] = acc[b];
            continue;
        }
        r -= I_MOD;
        if (r < I_WIN) {
            const int kb = r / 68, nb = r % 68, n0 = nb * 32;
            int src; bool zero = false; float scale = 1.f;
            if (n0 < 1536) { src = n0; if (n0 < 256) scale = 0.125f; } else if (n0 < 2048) src = n0 + 32; else if (n0 < 2080) src = 1536 + (n0 - 2048); else { src = 0; zero = true; }
            p0_transpose_item(p.in[6], 2080, 1024, (bf16_t*)(ws + WS_WIN), n0, src, scale, zero, scr, kb, lane);
            continue;
        }
        r -= I_WIN;
        if (r < I_WOUT) { p0_transpose_item(p.in[14], 1024, 1024, (bf16_t*)(ws + WS_WOUT), (r % 32) * 32, (r % 32) * 32, 1.f, false, scr, r / 32, lane); continue; }
        r -= I_WOUT;
        if (r < I_WQ) { p0_transpose_item(p.in[17], 2048, 1024, (bf16_t*)(ws + WS_WQ), (r % 64) * 32, (r % 64) * 32, 1.f, false, scr, r / 64, lane); continue; }
        r -= I_WQ;
        { const int g = r >> 3, kb = (r >> 2) & 1, nb = r & 3;
          p0_transpose_item(p.in[12] + g * 16384, 128, 128, (bf16_t*)(ws + WS_WP) + g * 16384, nb * 32, nb * 32, 1.f, false, scr, kb, lane); }
    }
    const size_t gt = (size_t)blockIdx.x * NTH + tid, NGT = (size_t)gridDim.x * NTH;
    constexpr size_t NSK = (size_t)16 * 128 * 128 / 8;
    for (size_t j = gt; j < NSK; j += NGT) {
        const float* src = p.in[18]; bf16_t* dst = (bf16_t*)(ws + WS_SKB);
        const f32x4 a = *(const f32x4*)(src + j * 8), b = *(const f32x4*)(src + j * 8 + 4);
        u32x4 o = {pk2(a[0], a[1]), pk2(a[2], a[3]), pk2(b[0], b[1]), pk2(b[2], b[3])};
        *(u32x4*)(dst + j * 8) = o;
    }
}

DI void quant_load(const Params& p, int row, int lane, f32x4 (&v)[4]) {
    const int tb = row >> 14, e = row & 16383;
    const float* src = (tb ? p.in[20] : p.in[19]) + (size_t)e * D + 16 * lane;
#pragma unroll
    for (int q = 0; q < 4; ++q) v[q] = *(const f32x4*)(src + 4 * q);
}
DI void quant_store(const Params& p, int row, int lane, const f32x4 (&v)[4]) {
    unsigned char* ws = p.ws;
    const int tb = row >> 14, e = row & 16383;
    float m = 0.f;
#pragma unroll
    for (int q = 0; q < 4; ++q) m = fmaxf(m, fmaxf(fmaxf(fabsf(v[q][0]), fabsf(v[q][1])), fmaxf(fabsf(v[q][2]), fabsf(v[q][3]))));
#pragma unroll
    for (int o = 1; o < 64; o <<= 1) m = fmaxf(m, __shfl_xor(m, o));
    int ex = (int)((__float_as_uint(m) >> 23) & 0xFFu) - 127;
    if (m < 1e-30f) ex = 7;
    const float sc = __uint_as_float((unsigned)(127 + 7 - ex) << 23), isc = __uint_as_float((unsigned)(127 - 7 + ex) << 23);
    u32x4 o;
    if (tb) {
#pragma unroll
        for (int q = 0; q < 4; ++q) { int w = 0; w = __builtin_amdgcn_cvt_pk_fp8_f32(v[q][0] * sc, v[q][1] * sc, w, false); w = __builtin_amdgcn_cvt_pk_fp8_f32(v[q][2] * sc, v[q][3] * sc, w, true); o[q] = (unsigned)w; }
        if (lane == 0) ((float*)(ws + WS_SV))[e] = isc;
    } else {
        const float s8 = m > 1e-30f ? 127.f / m : 0.f;
#pragma unroll
        for (int q = 0; q < 4; ++q) {
            const int q0 = __float2int_rn(v[q][0] * s8), q1 = __float2int_rn(v[q][1] * s8), q2 = __float2int_rn(v[q][2] * s8), q3 = __float2int_rn(v[q][3] * s8);
            o[q] = (unsigned)(q0 & 0xFF) | ((unsigned)(q1 & 0xFF) << 8) | ((unsigned)(q2 & 0xFF) << 16) | ((unsigned)q3 << 24);
        }
        if (lane == 0) ((float*)(ws + WS_SU))[e] = m * (1.f / 127.f);
    }
    *(u32x4*)(ws + (tb ? WS_VB : WS_UB) + (size_t)e * 1024 + 16 * lane) = o;
}

DI float mod_at(const Params& p, int b, int n) {
    const float* mp = (const float*)(p.ws + WS_MODP) + (size_t)b * 6144 + n;
    float s = p.in[3][n];
#pragma unroll
    for (int ks = 0; ks < 8; ++ks) s += mp[(size_t)ks * 8 * 6144];
    return s;
}

DI void phase1(const Params& p, LAS unsigned char* lds, int tid, int lane, int wave) {
    asm volatile("" : "+v"(tid), "+v"(lane));
    LAS float* lA = (LAS float*)lds; LAS float* lB = lA + 1024;
    const float* x = p.in[0]; bf16_t* H = (bf16_t*)(p.ws + WS_RA);
    for (int rt = blockIdx.x; rt < T / 128; rt += gridDim.x) {
        const int b = rt / 32;
        __syncthreads();
        for (int d = tid; d < 1024; d += NTH) { lA[d] = p.in[4][d] * (1.f + mod_at(p, b, 1024 + d)); lB[d] = mod_at(p, b, d); }
        __syncthreads();
        for (int r0 = wave; r0 < 128; r0 += 4 * NWV) {
            f32x4 v[4][4];
#pragma unroll
            for (int u = 0; u < 4; ++u) { const f32x4* xr = (const f32x4*)(x + ((size_t)rt * 128 + r0 + u * NWV) * D) + lane;
#pragma unroll
                for (int j = 0; j < 4; ++j) v[u][j] = xr[64 * j]; }
#pragma unroll
            for (int u = 0; u < 4; ++u) {
                const size_t row = (size_t)rt * 128 + r0 + u * NWV;
                float ss = 0.f;
#pragma unroll
                for (int j = 0; j < 4; ++j) ss += v[u][j][0] * v[u][j][0] + v[u][j][1] * v[u][j][1] + v[u][j][2] * v[u][j][2] + v[u][j][3] * v[u][j][3];
                const float rstd = rsqrtf(wave_sum(ss) * (1.f / D) + EPS);
                u32x2* o = (u32x2*)(H + row * D) + lane;
#pragma unroll
                for (int j = 0; j < 4; ++j) {
                    const f32x4 a = *(const LAS f32x4*)(lA + 4 * lane + 256 * j), bb = *(const LAS f32x4*)(lB + 4 * lane + 256 * j);
                    u32x2 w = {pk2(v[u][j][0] * rstd * a[0] + bb[0], v[u][j][1] * rstd * a[1] + bb[1]), pk2(v[u][j][2] * rstd * a[2] + bb[2], v[u][j][3] * rstd * a[3] + bb[3])};
                    o[64 * j] = w;
                }
            }
        }
    }
}

DI void afb_tail(const bf16_t* H, const bf16_t* Wt, float* AFB, LAS unsigned char* lds, int tid, int lane, int wave) {
    constexpr int WSTR = 2064;
    asm volatile("" : "+v"(tid), "+v"(lane));
    const int c15 = lane & 15, g = lane >> 4;
    __syncthreads();
#pragma unroll
    for (int ps = 0; ps < 8; ++ps) { const int idx = tid + NTH * ps, n = idx >> 7, ch = idx & 127; *(LAS u32x4*)(lds + n * WSTR + ch * 16) = *(const u32x4*)(Wt + (size_t)n * D + ch * 8); }
    __syncthreads();
    LAS const unsigned char* w0 = lds + c15 * WSTR + 32 * g;
    for (int tile = blockIdx.x; tile < T / 128; tile += gridDim.x) {
        const size_t row = (size_t)tile * 128 + wave * 16 + c15;
        const bf16_t* ap = H + row * D + 16 * g;
        f32x4 acc0 = {0.f, 0.f, 0.f, 0.f}, acc1 = {0.f, 0.f, 0.f, 0.f};
#pragma unroll 1
        for (int hf = 0; hf < 2; ++hf) {
            bf16x8 a[16];
#pragma unroll
            for (int t = 0; t < 8; ++t) { a[2 * t] = *(const bf16x8*)(ap + 512 * hf + 64 * t); a[2 * t + 1] = *(const bf16x8*)(ap + 512 * hf + 64 * t + 8); }
            LAS const unsigned char* wp = w0 + 1024 * hf;
#pragma unroll
            for (int t = 0; t < 8; ++t)
#pragma unroll
                for (int e = 0; e < 2; ++e) {
                    acc0 = MFMA16(*(LAS const bf16x8*)(wp + 128 * t + 16 * e), a[2 * t + e], acc0);
                    acc1 = MFMA16(*(LAS const bf16x8*)(wp + 16 * WSTR + 128 * t + 16 * e), a[2 * t + e], acc1);
                }
        }
        *(f32x4*)(AFB + row * 32 + 4 * g) = acc0;
        *(f32x4*)(AFB + row * 32 + 16 + 4 * g) = acc1;
    }
}

namespace pg8 {
#define PG8_LAS __attribute__((address_space(3)))
constexpr int BM = 256, BK = 64, HALF = 128, HTB = HALF * BK * 2  , STAGE_BYTES = 8 * HTB, NXCD = 8, WGM = 1;

__host__ __device__ __forceinline__ int lds_byte(int r, int c) { const int st = (r >> 4) * 2 + (c >> 5), rr = r & 15, cc = c & 31, ob = rr * 64 + cc * 2; return st * 1024 + (ob ^ (((ob >> 9) & 1) << 5)); }
__host__ __device__ __forceinline__ void stage_rc(int b, int& R, int& C) { const int st = b / 1024, sb = b % 1024, swz = sb ^ (((sb >> 9) & 1) << 5); R = (st >> 1) * 16 + swz / 64; C = (st & 1) * 32 + (swz % 64) / 2; }
__host__ __device__ __forceinline__ int perm32(int rho) { const int n = rho >> 4, i = rho & 15; return 8 * (i >> 2) + 4 * n + (i & 3); }

struct Unit { int pm, pn; };
struct Gemm { const bf16_t* A; const bf16_t* Bt; int M, N, K; };

struct StaticOrder {
    int nM, nN, nwg, G, c;
    __host__ __device__ void init(int M, int N, int G_, int c_) { nM = M / BM; nN = N / BM; nwg = nM * nN; G = G_; c = c_; }
    __host__ __device__ bool next(int i, Unit& u) const {
        const long L = (long)i * G + c; if (L >= nwg) return false;
        int wgid = (int)L; { const int q = nwg / NXCD, r = nwg % NXCD, xcd = wgid % NXCD, off = wgid / NXCD; wgid = (xcd < r ? xcd * (q + 1) : r * (q + 1) + (xcd - r) * q) + off; }
        const int nig = WGM * nN, gid = wgid / nig, fm = gid * WGM, gsz = (nM - fm) < WGM ? (nM - fm) : WGM;
        u.pm = fm + ((wgid % nig) % gsz); u.pn = (wgid % nig) / gsz; return true;
    }
    __device__ __forceinline__ void a_ready(const Unit&) const {}
    __device__ __forceinline__ void done(const Unit&) const {}
};

struct EpiB16 {
    static constexpr bool PERM = true, AFTER_DRAIN = false;
    bf16_t* O; int ldc;
    __device__ __forceinline__ void operator()(const f32x4 (&acc)[2][2][4][2], const Unit& u, int wr, int wc, int fr, int fq) const {
#pragma unroll
        for (int ai = 0; ai < 2; ++ai)
#pragma unroll
            for (int m = 0; m < 4; ++m) { bf16_t* rowp = O + (size_t)(u.pm * BM + ai * HALF + wr * 64 + m * 16 + fr) * ldc + u.pn * BM + wc * 32 + 8 * fq;
#pragma unroll
                for (int bj = 0; bj < 2; ++bj) { const f32x4 v0 = acc[ai][bj][m][0], v1 = acc[ai][bj][m][1];
                    u32x4 w; w.x = ::pk2(v0[0], v0[1]); w.y = ::pk2(v0[2], v0[3]); w.z = ::pk2(v1[0], v1[1]); w.w = ::pk2(v1[2], v1[3]);
                    *(u32x4*)(rowp + bj * HALF) = w; } }
    }
};
struct EpiF {
    static constexpr bool PERM = false, AFTER_DRAIN = false;
    float* O; int ldc;
    __device__ __forceinline__ void operator()(const f32x4 (&acc)[2][2][4][2], const Unit& u, int wr, int wc, int fr, int fq) const {
#pragma unroll
        for (int ai = 0; ai < 2; ++ai)
#pragma unroll
            for (int m = 0; m < 4; ++m) { float* rowp = O + (size_t)(u.pm * BM + ai * HALF + wr * 64 + m * 16 + fr) * ldc + u.pn * BM + wc * 32 + 4 * fq;
#pragma unroll
                for (int bj = 0; bj < 2; ++bj)
#pragma unroll
                    for (int n = 0; n < 2; ++n) *(f32x4*)(rowp + bj * HALF + 16 * n) = acc[ai][bj][m][n]; }
    }
};
template <class Epi, class Sched, bool ALIGN_EPI = false, bool SP2 = false>
__device__ __forceinline__ void gemm_phase(PG8_LAS unsigned char* lds, const Gemm g, const Sched& S, const Epi& E) {
    int tid = threadIdx.x; asm volatile("" : "+v"(tid));
    const int wid = __builtin_amdgcn_readfirstlane(tid >> 6), lane = tid & 63, wr = wid >> 2, wc = wid & 3, fr = lane & 15, fq = lane >> 4;
    const int K = g.K, nt = K / BK;
    unsigned voffA[2], voffB[2];
#pragma unroll
    for (int i = 0; i < 2; ++i) { int R, C; stage_rc(tid * 16 + i * 8192, R, C); const int Rb = Epi::PERM ? ((R & ~31) + perm32(R & 31)) : R;
        voffA[i] = (unsigned)(R * K + C) * 2u; voffB[i] = (unsigned)(Rb * K + C) * 2u; }
    const size_t kstep = (size_t)(BK * 2);
    const size_t hstep = (size_t)HALF * K * 2;
    const size_t tstep = 2 * hstep;
    const unsigned ldsw = (unsigned)wid * 1024u;
    const int aoff = lds_byte(wr * 64 + fr, fq * 8), boff = lds_byte(wc * 32 + fr, fq * 8);
#define PG8_SA(b, h) (((b) * 2 + (h)) * HTB)
#define PG8_SB(b, h) ((4 + (b) * 2 + (h)) * HTB)
#define PG8_STAGE(bufoff, gbase, voff) do { _Pragma("unroll") for (int _i = 0; _i < 2; ++_i) \
        __builtin_amdgcn_global_load_lds((const unsigned*)((const char*)(gbase) + (voff)[_i]), (PG8_LAS unsigned*)(lds + (bufoff) + ldsw + _i * 8192), 16, 0, 0); } while (0)
#define PG8_LDA(dst, b, h) do { _Pragma("unroll") for (int m = 0; m < 4; ++m) _Pragma("unroll") for (int k = 0; k < 2; ++k) dst[m][k] = *(const PG8_LAS bf16x8*)(lds + PG8_SA(b, h) + aoff + m * 2048 + k * 1024); } while (0)
#define PG8_LDB(dst, b, h) do { _Pragma("unroll") for (int n = 0; n < 2; ++n) _Pragma("unroll") for (int k = 0; k < 2; ++k) dst[n][k] = *(const PG8_LAS bf16x8*)(lds + PG8_SB(b, h) + boff + n * 2048 + k * 1024); } while (0)
#define PG8_MMA(ai, bj, At, Bt) do { __builtin_amdgcn_s_setprio(1); _Pragma("unroll") for (int m = 0; m < 4; ++m) _Pragma("unroll") for (int n = 0; n < 2; ++n) _Pragma("unroll") for (int k = 0; k < 2; ++k) \
        acc[ai][bj][m][n] = __builtin_amdgcn_mfma_f32_16x16x32_bf16(Bt[n][k], At[m][k], acc[ai][bj][m][n], 0, 0, 0); __builtin_amdgcn_s_setprio(0); } while (0)
#define PG8_WAIT_V(n) asm volatile("s_waitcnt vmcnt(" #n ")" ::: "memory")
#define PG8_WAIT_L(n) asm volatile("s_waitcnt lgkmcnt(" #n ")" ::: "memory")
#define PG8_BAR __builtin_amdgcn_s_barrier()
#define PG8_SCHED __builtin_amdgcn_sched_barrier(0)
    Unit cur, nxt; int ui = 0;
    if (!S.next(0, cur)) return;
    f32x4 acc[2][2][4][2];
#pragma unroll
    for (int a = 0; a < 2; ++a)
#pragma unroll
        for (int b = 0; b < 2; ++b)
#pragma unroll
            for (int m = 0; m < 4; ++m)
#pragma unroll
                for (int n = 0; n < 2; ++n) acc[a][b][m][n] = (f32x4){0.f, 0.f, 0.f, 0.f};
    bf16x8 At[4][2], B0[2][2], B1[2][2];
    const char* cA = (const char*)g.A + (size_t)cur.pm * tstep; const char* cB = (const char*)g.Bt + (size_t)cur.pn * tstep;
    S.a_ready(cur);
    if constexpr (SP2) {
        PG8_STAGE(PG8_SB(0, 0), cB, voffB); PG8_STAGE(PG8_SB(0, 1), cB + hstep, voffB); PG8_STAGE(PG8_SA(0, 0), cA, voffA); PG8_STAGE(PG8_SA(0, 1), cA + hstep, voffA);
        if (wr == 1) PG8_BAR;
        PG8_WAIT_V(2); PG8_BAR;
        PG8_STAGE(PG8_SB(1, 0), cB + kstep, voffB); PG8_STAGE(PG8_SA(1, 0), cA + kstep, voffA); PG8_STAGE(PG8_SB(1, 1), cB + hstep + kstep, voffB);
        PG8_WAIT_V(6); PG8_BAR;
    } else {
        PG8_STAGE(PG8_SB(0, 0), cB, voffB); PG8_STAGE(PG8_SA(0, 0), cA, voffA); PG8_STAGE(PG8_SB(0, 1), cB + hstep, voffB); PG8_STAGE(PG8_SA(0, 1), cA + hstep, voffA);
        if (wr == 1) PG8_BAR;
        PG8_WAIT_V(4); PG8_BAR;
        PG8_STAGE(PG8_SB(1, 0), cB + kstep, voffB); PG8_STAGE(PG8_SA(1, 0), cA + kstep, voffA); PG8_STAGE(PG8_SB(1, 1), cB + hstep + kstep, voffB);
        PG8_WAIT_V(6); PG8_BAR;
    }
    for (;;) {
        const bool has_next = S.next(ui + 1, nxt);
        const char* nA = has_next ? (const char*)g.A + (size_t)nxt.pm * tstep : cA; const char* nB = has_next ? (const char*)g.Bt + (size_t)nxt.pn * tstep : cB;
        for (int t = 0; t < nt; t += 2) {
            const bool last = (t == nt - 2);
            const char* a1 = cA + (size_t)(t + 1) * kstep;
            const char* a2 = last ? nA : cA + (size_t)(t + 2) * kstep; const char* b2 = last ? nB : cB + (size_t)(t + 2) * kstep;
            const char* a3 = a2 + kstep; const char* b3 = b2 + kstep;
            if (last && has_next) S.a_ready(nxt);
            if constexpr (SP2) {
            PG8_LDB(B0, 0, 0); PG8_LDB(B1, 0, 1); PG8_SCHED; PG8_LDA(At, 0, 0); PG8_STAGE(PG8_SA(1, 1), a1 + hstep, voffA);
            PG8_WAIT_V(8); PG8_WAIT_L(0); PG8_BAR; PG8_MMA(0, 0, At, B0); PG8_MMA(0, 1, At, B1); PG8_BAR; PG8_SCHED;
            PG8_LDA(At, 0, 1); PG8_STAGE(PG8_SB(0, 0), b2, voffB); PG8_STAGE(PG8_SB(0, 1), b2 + hstep, voffB); PG8_STAGE(PG8_SA(0, 0), a2, voffA);
            PG8_WAIT_V(8); PG8_WAIT_L(0); PG8_BAR; PG8_MMA(1, 0, At, B0); PG8_MMA(1, 1, At, B1); PG8_BAR; PG8_SCHED;
            PG8_LDB(B0, 1, 0); PG8_LDB(B1, 1, 1); PG8_SCHED; PG8_LDA(At, 1, 0); PG8_STAGE(PG8_SA(0, 1), a2 + hstep, voffA);
            PG8_WAIT_V(8); PG8_WAIT_L(0); PG8_BAR; PG8_MMA(0, 0, At, B0); PG8_MMA(0, 1, At, B1); PG8_BAR; PG8_SCHED;
            PG8_LDA(At, 1, 1); PG8_STAGE(PG8_SB(1, 0), b3, voffB); PG8_STAGE(PG8_SB(1, 1), b3 + hstep, voffB); PG8_STAGE(PG8_SA(1, 0), a3, voffA);
            PG8_WAIT_V(8); PG8_WAIT_L(0); PG8_BAR; PG8_MMA(1, 0, At, B0); PG8_MMA(1, 1, At, B1); PG8_BAR; PG8_SCHED;
            } else {
            PG8_LDB(B0, 0, 0); PG8_SCHED; PG8_LDA(At, 0, 0); PG8_STAGE(PG8_SA(1, 1), a1 + hstep, voffA);
            PG8_WAIT_L(8); PG8_BAR; PG8_WAIT_L(0); PG8_MMA(0, 0, At, B0); PG8_BAR; PG8_SCHED;
            PG8_LDB(B1, 0, 1); PG8_STAGE(PG8_SB(0, 0), b2, voffB);
            PG8_BAR; PG8_WAIT_L(0); PG8_MMA(0, 1, At, B1); PG8_BAR;
            PG8_LDA(At, 0, 1); PG8_STAGE(PG8_SA(0, 0), a2, voffA);
            PG8_BAR; PG8_WAIT_L(0); PG8_MMA(1, 0, At, B0); PG8_BAR; PG8_SCHED;
            PG8_STAGE(PG8_SB(0, 1), b2 + hstep, voffB);
            PG8_WAIT_V(6); PG8_BAR; PG8_MMA(1, 1, At, B1); PG8_BAR;
            PG8_LDB(B0, 1, 0); PG8_SCHED; PG8_LDA(At, 1, 0); PG8_STAGE(PG8_SA(0, 1), a2 + hstep, voffA);
            PG8_WAIT_L(8); PG8_BAR; PG8_WAIT_L(0); PG8_MMA(0, 0, At, B0); PG8_BAR; PG8_SCHED;
            PG8_LDB(B1, 1, 1); PG8_STAGE(PG8_SB(1, 0), b3, voffB);
            PG8_BAR; PG8_WAIT_L(0); PG8_MMA(0, 1, At, B1); PG8_BAR;
            PG8_LDA(At, 1, 1); PG8_STAGE(PG8_SA(1, 0), a3, voffA);
            PG8_BAR; PG8_WAIT_L(0); PG8_MMA(1, 0, At, B0); PG8_BAR; PG8_SCHED;
            PG8_STAGE(PG8_SB(1, 1), b3 + hstep, voffB);
            PG8_WAIT_V(6); PG8_BAR; PG8_MMA(1, 1, At, B1); PG8_BAR;
            }
        }
        if constexpr (ALIGN_EPI) { if (wr == 0) PG8_BAR; }
        if constexpr (!Epi::AFTER_DRAIN) { E(acc, cur, wr, wc, fr, fq); S.done(cur); }
        if (!has_next) break;
#pragma unroll
        for (int a = 0; a < 2; ++a)
#pragma unroll
            for (int b = 0; b < 2; ++b)
#pragma unroll
                for (int m = 0; m < 4; ++m)
#pragma unroll
                    for (int n = 0; n < 2; ++n) acc[a][b][m][n] = (f32x4){0.f, 0.f, 0.f, 0.f};
        cur = nxt; cA = nA; cB = nB; ++ui;
        if constexpr (ALIGN_EPI) { if (wr == 1) PG8_BAR; }
    }
    PG8_WAIT_V(0);
    if constexpr (!ALIGN_EPI) { if (wr == 0) PG8_BAR; }
    PG8_BAR;
    if constexpr (Epi::AFTER_DRAIN) { E.fused(acc, cur, wr, wc, fr, fq, lds, wid, lane); S.done(cur); }
#undef PG8_SA
#undef PG8_SB
#undef PG8_STAGE
#undef PG8_LDA
#undef PG8_LDB
#undef PG8_MMA
#undef PG8_WAIT_V
#undef PG8_WAIT_L
#undef PG8_BAR
#undef PG8_SCHED
}
}

constexpr size_t WS_QDC  = WS_RS;
constexpr size_t WS_SEGS = WS_RS + 32 * MB;
constexpr size_t WS_GSEG = WS_RS + 48 * MB;
constexpr size_t WS_SC   = WS_RS + 49 * MB;
DI void lds_barrier() { asm volatile("s_waitcnt lgkmcnt(0)" ::: "memory"); __builtin_amdgcn_s_barrier(); asm volatile("" ::: "memory"); }
DI float logsig(float x) { return fminf(x, 0.f) - __logf(1.f + __expf(-fabsf(x))); }

template <int DIR>
DI void ga_task(const Params& p, LAS unsigned char* lds, int tid, int lane, int wave, int task) {
    asm volatile("" : "+v"(tid), "+v"(lane));
    unsigned char* ws = p.ws;
    const bf16_t* Z = (const bf16_t*)(ws + WS_RZ);
    const float* AFB = (const float*)(ws + WS_AFB);
    LAS float* la = (LAS float*)lds;
    LAS float* part = (LAS float*)(lds + 17408);
    LAS float* gs = (LAS float*)(lds + 18432);
    LAS float* elb = (LAS float*)(lds + 18944);
    LAS float* wl = (LAS float*)(lds + 19968);
    LAS bf16_t* sL  = (LAS bf16_t*)(lds + 24064);
    LAS unsigned char* obuf = lds + 42496;
    const int c15 = lane & 15, g = lane >> 4;
    const int i = tid >> 3, dg = tid & 7, d0 = dg * 8;
#define TROW(r) ((r) * 72 + ((r) >> 3) * 8)
    constexpr int dir = DIR; const int h = (task >> 1) & 3, pb = (task >> 3) & 7, b = task >> 6;
    const int bhd = b * 8 + h * 2 + dir, sg = dir ? 7 - pb : pb;
    bf16_t* QDC = (bf16_t*)(ws + WS_QDC + (dir ? 16 : 0) * MB);
    bf16_t* OL = (bf16_t*)(ws + WS_RO + (dir ? 64 : 0) * MB);
    f32x4 S[4];
#pragma unroll
    for (int kt = 0; kt < 4; ++kt) S[kt] = (f32x4){0.f, 0.f, 0.f, 0.f};
    __syncthreads();
    for (int e = tid; e < 128 * 72 / 2; e += NTH) ((LAS unsigned*)sL)[e] = 0u;
    if (tid < 64) gs[tid] = 0.f;
    for (int e = tid; e < 1024; e += NTH) wl[e] = (dir ? p.in[9] : p.in[7])[(e >> 6) * 256 + h * 64 + (e & 63)];
    typedef short s16x4w __attribute__((ext_vector_type(4)));
    s16x4w wfr[2]; float bias[2];
    __syncthreads();
#pragma unroll
    for (int u = 0; u < 2; ++u) {
        const int d = 16 * (2 * (wave >> 2) + u) + c15;
        const u32x2 wp = {pk2(wl[(4 * g) * 64 + d], wl[(4 * g + 1) * 64 + d]), pk2(wl[(4 * g + 2) * 64 + d], wl[(4 * g + 3) * 64 + d])};
        wfr[u] = __builtin_bit_cast(s16x4w, wp);
        bias[u] = (dir ? p.in[10] : p.in[8])[h * 64 + d];
    }
    const int mt = wave & 3;
    f32x4 avn;
    { const int n0 = dir ? pb * 8 + 7 : pb * 8; avn = *(const f32x4*)(AFB + ((size_t)b * SEQ + n0 * 64 + 16 * mt + c15) * 32 + dir * 16 + 4 * g); }
#pragma unroll 1
    for (int ci = -1; ci < 8; ++ci) {
        const bool has_cur = ci >= 0, has_nxt = ci < 7;
        const int cx = ci + 1;
        const int nx = dir ? pb * 8 + 7 - cx : pb * 8 + cx, tokx = b * SEQ + nx * 64;
        const int nc = dir ? pb * 8 + 7 - ci : pb * 8 + ci, tokc = b * SEQ + nc * 64;
        LAS unsigned char* bx = obuf + (cx & 1) * 46464; LAS unsigned char* bc = obuf + (ci & 1) * 46464;
        LAS float* elx = elb + (cx & 1) * 128; LAS float* elc = elb + (ci & 1) * 128;
        u32x4 qv, kv, vvp[2]; float lv[2][4];
        if (ci > 0) {
#pragma unroll
            for (int kt = 0; kt < 4; ++kt) { const u32x2 w = {pk2(S[kt][0], S[kt][1]), pk2(S[kt][2], S[kt][3])}; *(LAS u32x2*)(sL + (16 * wave + c15) * 72 + 16 * kt + 4 * g) = w; }
        }
        if (has_nxt) {
            const size_t t = (size_t)tokx + i;
            qv = *(const u32x4*)(Z + t * ZW + h * 64 + d0); kv = *(const u32x4*)(Z + t * ZW + 256 + h * 64 + d0);
#pragma unroll
            for (int ps = 0; ps < 2; ++ps) { const int idx = tid + NTH * ps, vi = idx >> 4, ch = idx & 15; vvp[ps] = *(const u32x4*)(Z + ((size_t)tokx + vi) * ZW + 512 + h * 128 + ch * 8); }
            typedef short s16x4v __attribute__((ext_vector_type(4)));
            const u32x2 ap = {pk2(avn[0], avn[1]), pk2(avn[2], avn[3])};
            const s16x4v af = __builtin_bit_cast(s16x4v, ap);
            { const int c2 = cx < 7 ? cx + 1 : cx, n2 = dir ? pb * 8 + 7 - c2 : pb * 8 + c2; avn = *(const f32x4*)(AFB + ((size_t)b * SEQ + n2 * 64 + 16 * mt + c15) * 32 + dir * 16 + 4 * g); }
#pragma unroll
            for (int u = 0; u < 2; ++u) {
                const int d = 16 * (2 * (wave >> 2) + u) + c15;
                const f32x4 x = __builtin_amdgcn_mfma_f32_16x16x16bf16_1k(af, wfr[u], (f32x4){0.f, 0.f, 0.f, 0.f}, 0, 0, 0);
                float v0 = logsig(x[0] + bias[u]) * 0.0625f, v1 = logsig(x[1] + bias[u]) * 0.0625f, v2 = logsig(x[2] + bias[u]) * 0.0625f, v3 = logsig(x[3] + bias[u]) * 0.0625f;
                float T, T2, T3;
                if (dir == 0) {
                    v1 += v0; v2 += v1; v3 += v2; T = v3;
                    const float t1 = __shfl_up(T, 16); T2 = T + (g >= 1 ? t1 : 0.f);
                    const float t2 = __shfl_up(T2, 32); T3 = T2 + (g >= 2 ? t2 : 0.f);
                    if (g == 3) part[mt * 64 + d] = T3;
                } else {
                    v2 += v3; v1 += v2; v0 += v1; T = v0;
                    const float t1 = __shfl_down(T, 16); T2 = T + (g <= 2 ? t1 : 0.f);
                    const float t2 = __shfl_down(T2, 32); T3 = T2 + (g <= 1 ? t2 : 0.f);
                    if (g == 0) part[mt * 64 + d] = T3;
                }
                const float off = T3 - T;
                lv[u][0] = v0 + off; lv[u][1] = v1 + off; lv[u][2] = v2 + off; lv[u][3] = v3 + off;
            }
        }
        lds_barrier();
        if (has_nxt) {
#pragma unroll
            for (int u = 0; u < 2; ++u) {
                const int d = 16 * (2 * (wave >> 2) + u) + c15;
                float off = 0.f;
#pragma unroll
                for (int m2 = 0; m2 < 4; ++m2) { const bool take = dir ? (m2 > mt) : (m2 < mt); off += take ? part[m2 * 64 + d] : 0.f; }
#pragma unroll
                for (int r = 0; r < 4; ++r) la[(16 * mt + 4 * g + r) * 68 + d] = lv[u][r] + off;
                if (mt == (dir ? 0 : 3) && g == (dir ? 0 : 3)) {
                    const float tot = lv[u][dir ? 0 : 3] + off, gsum = gs[(cx & 1) * 64 + d];
                    elx[d] = __expf(tot); elx[64 + d] = __expf(gsum); gs[((cx + 1) & 1) * 64 + d] = gsum + tot;
                }
            }
        }
        lds_barrier();
        if (has_nxt) {
            LAS bf16_t* qdL = (LAS bf16_t*)bx; LAS bf16_t* kiL = (LAS bf16_t*)(bx + 9216); LAS bf16_t* keT = (LAS bf16_t*)(bx + 18432); LAS bf16_t* vT = (LAS bf16_t*)(bx + 27776);
            const size_t t = (size_t)tokx + i;
            float q[8], k[8];
#pragma unroll
            for (int e = 0; e < 4; ++e) { q[2 * e] = bflo(qv[e]); q[2 * e + 1] = bfhi(qv[e]); k[2 * e] = bflo(kv[e]); k[2 * e + 1] = bfhi(kv[e]); }
            float qd[8], ki[8], ke[8], qc[8];
#pragma unroll
            for (int e = 0; e < 8; ++e) {
                const float E = __expf(la[i * 68 + d0 + e]), R = __builtin_amdgcn_rcpf(E);
                qd[e] = q[e] * E; ki[e] = k[e] * R; ke[e] = ki[e] * elx[d0 + e]; qc[e] = qd[e] * elx[64 + d0 + e];
            }
            const u32x4 o1 = {pk2(qd[0], qd[1]), pk2(qd[2], qd[3]), pk2(qd[4], qd[5]), pk2(qd[6], qd[7])};
            const u32x4 o2 = {pk2(ki[0], ki[1]), pk2(ki[2], ki[3]), pk2(ki[4], ki[5]), pk2(ki[6], ki[7])};
            const u32x4 o3 = {pk2(qc[0], qc[1]), pk2(qc[2], qc[3]), pk2(qc[4], qc[5]), pk2(qc[6], qc[7])};
            *(LAS u32x4*)(qdL + i * 72 + d0) = o1; *(LAS u32x4*)(kiL + i * 72 + d0) = o2;
            *(u32x4*)(QDC + t * 256 + h * 64 + d0) = o3;
#pragma unroll
            for (int e = 0; e < 4; ++e) { const unsigned w = pk2(ke[2 * e], ke[2 * e + 1]); keT[TROW(d0 + 2 * e) + perm32(i)] = (bf16_t)(w & 0xFFFFu); keT[TROW(d0 + 2 * e + 1) + perm32(i)] = (bf16_t)(w >> 16); }
#pragma unroll
            for (int ps = 0; ps < 2; ++ps) {
                const int idx = tid + NTH * ps, vi = idx >> 4, ch = idx & 15;
#pragma unroll
                for (int e = 0; e < 4; ++e) { vT[TROW(ch * 8 + 2 * e) + perm32(vi)] = (bf16_t)(vvp[ps][e] & 0xFFFFu); vT[TROW(ch * 8 + 2 * e + 1) + perm32(vi)] = (bf16_t)(vvp[ps][e] >> 16); }
            }
        }
        if (has_cur) {
            const LAS bf16_t* qdL = (const LAS bf16_t*)bc; const LAS bf16_t* kiL = (const LAS bf16_t*)(bc + 9216); const LAS bf16_t* keT = (const LAS bf16_t*)(bc + 18432); const LAS bf16_t* vT = (const LAS bf16_t*)(bc + 27776);
            const int it = wave & 3, dvh = wave >> 2;
            bf16x8 qdb[2];
#pragma unroll
            for (int s = 0; s < 2; ++s) qdb[s] = *(const LAS bf16x8*)(qdL + (16 * it + c15) * 72 + 32 * s + 8 * g);
            f32x4 sc[4];
#pragma unroll
            for (int jt = 0; jt < 4; ++jt) {
                sc[jt] = (f32x4){0.f, 0.f, 0.f, 0.f};
#pragma unroll
                for (int s = 0; s < 2; ++s) sc[jt] = MFMA16(*(const LAS bf16x8*)(kiL + (16 * jt + c15) * 72 + 32 * s + 8 * g), qdb[s], sc[jt]);
                const int ii = 16 * it + c15;
#pragma unroll
                for (int r = 0; r < 4; ++r) { const int jj = 16 * jt + 4 * g + r; const bool keep = dir ? (jj > ii) : (jj <= ii); sc[jt][r] = keep ? sc[jt][r] : 0.f; }
            }
            const bf16x8 pa[2] = {pack8(sc[0], sc[1]), pack8(sc[2], sc[3])};
#pragma unroll
            for (int nt = 0; nt < 4; ++nt) {
                const int dvr = 64 * dvh + 16 * nt + c15;
                f32x4 o = (f32x4){0.f, 0.f, 0.f, 0.f};
#pragma unroll
                for (int s = 0; s < 2; ++s) {
                    o = MFMA16(*(const LAS bf16x8*)(vT + TROW(dvr) + 32 * s + 8 * g), pa[s], o);
                    o = MFMA16(*(const LAS bf16x8*)(sL + dvr * 72 + 32 * s + 8 * g), qdb[s], o);
                }
                const u32x2 w = {pk2(o[0], o[1]), pk2(o[2], o[3])};
                *(u32x2*)(OL + ((size_t)tokc + 16 * it + c15) * 512 + h * 128 + 64 * dvh + 16 * nt + 4 * g) = w;
            }
            bf16x8 vb[2];
#pragma unroll
            for (int s = 0; s < 2; ++s) vb[s] = *(const LAS bf16x8*)(vT + TROW(16 * wave + c15) + 32 * s + 8 * g);
#pragma unroll
            for (int kt = 0; kt < 4; ++kt) {
                const f32x4 gm = *(const LAS f32x4*)(elc + 16 * kt + 4 * g);
                f32x4 a = S[kt] * gm;
#pragma unroll
                for (int s = 0; s < 2; ++s) a = MFMA16(*(const LAS bf16x8*)(keT + TROW(16 * kt + c15) + 32 * s + 8 * g), vb[s], a);
                S[kt] = a;
            }
        }
        lds_barrier();
    }
    {
        float* SEGS = (float*)(ws + WS_SEGS) + (size_t)(bhd * 8 + sg) * 64 * 128;
#pragma unroll
        for (int kt = 0; kt < 4; ++kt)
#pragma unroll
            for (int r = 0; r < 4; ++r) SEGS[(16 * kt + 4 * g + r) * 128 + 16 * wave + c15] = S[kt][r];
        if (tid < 64) ((float*)(ws + WS_GSEG))[(bhd * 8 + sg) * 64 + tid] = __expf(gs[tid]);
    }
}
#undef TROW

DI void phaseGA(const Params& p, LAS unsigned char* lds, int tid, int lane, int wave) {
    for (int task = blockIdx.x; task < 512; task += gridDim.x) { if (task & 1) ga_task<1>(p, lds, tid, lane, wave, task); else ga_task<0>(p, lds, tid, lane, wave, task); }
}

DI void phaseGB(const Params& p, int tid) {
    unsigned char* ws = p.ws;
    const float* SEGS = (const float*)(ws + WS_SEGS); const float* GSEG = (const float*)(ws + WS_GSEG); bf16_t* SC = (bf16_t*)(ws + WS_SC);
    for (int e = blockIdx.x * NTH + tid; e < 64 * 128 * 16; e += gridDim.x * NTH) {
        const int dv = e & 127, dk4 = (e >> 7) & 15, bhd = e >> 11;
        float c[4] = {0.f, 0.f, 0.f, 0.f};
        for (int sg = 0; sg < 8; ++sg) {
            const u32x2 w = {pk2(c[0], c[1]), pk2(c[2], c[3])};
            *(u32x2*)(SC + ((size_t)(bhd * 8 + sg) * 128 + dv) * 64 + 4 * dk4) = w;
            const f32x4 gm = *(const f32x4*)(GSEG + (bhd * 8 + sg) * 64 + 4 * dk4);
#pragma unroll
            for (int r = 0; r < 4; ++r) c[r] = gm[r] * c[r] + SEGS[((size_t)(bhd * 8 + sg) * 64 + 4 * dk4 + r) * 128 + dv];
        }
    }
}

DI void phase4a(const Params& p, LAS unsigned char* lds, int tid, int lane, int wave) {
    asm volatile("" : "+v"(tid), "+v"(lane));
    unsigned char* ws = p.ws;
    const bf16_t* Z = (const bf16_t*)(ws + WS_RZ);
    bf16_t* MIX = (bf16_t*)(ws + WS_RA);
    const bf16_t* OF = (const bf16_t*)(ws + WS_RO); const bf16_t* OB = (const bf16_t*)(ws + WS_RO + 64 * MB);
    const bf16_t* WP = (const bf16_t*)(ws + WS_WP);
    LAS bf16_t* pt = (LAS bf16_t*)lds;
    LAS unsigned char* at = lds + 81920;
    const int c15 = lane & 15, g = lane >> 4;
    for (int tile = blockIdx.x; tile < T / 64; tile += gridDim.x) {
        const int tok0 = tile * 64, s0 = tok0 & (SEQ - 1);
        __syncthreads();
#pragma unroll
        for (int ps = 0; ps < 10; ++ps) {
            const int idx = tid + NTH * ps, rr = idx >> 6, ch = idx & 63, sq = s0 - 8 + rr;
            u32x4 v = {0u, 0u, 0u, 0u};
            if (sq >= 0 && sq < SEQ) v = *(const u32x4*)(Z + ((size_t)tok0 - 8 + rr) * ZW + 1536 + ch * 8);
            *(LAS u32x4*)(pt + rr * 512 + ch * 8) = v;
        }
        {
            const int hh = wave >> 1, ih = wave & 1, bb = tok0 / SEQ, nn = s0 >> 6;
            f32x4 acc[8][2];
#pragma unroll
            for (int mt = 0; mt < 8; ++mt) { acc[mt][0] = (f32x4){0.f, 0.f, 0.f, 0.f}; acc[mt][1] = (f32x4){0.f, 0.f, 0.f, 0.f}; }
#pragma unroll
            for (int dir = 0; dir < 2; ++dir) {
                const int sg = dir ? 7 - (nn >> 3) : (nn >> 3), bhd = bb * 8 + hh * 2 + dir;
                const bf16_t* SCp = (const bf16_t*)(ws + WS_SC) + (size_t)(bhd * 8 + sg) * 128 * 64;
                const bf16_t* QCp = (const bf16_t*)(ws + WS_QDC + (dir ? 16 : 0) * MB) + ((size_t)tok0 + 32 * ih) * 256 + hh * 64;
                if (sg != 0)
#pragma unroll
                for (int s = 0; s < 2; ++s) {
                    const bf16x8 q0 = ld_frag16(QCp + (size_t)c15 * 256 + 32 * s + 8 * g), q1 = ld_frag16(QCp + (size_t)(16 + c15) * 256 + 32 * s + 8 * g);
#pragma unroll
                    for (int mt = 0; mt < 8; ++mt) {
                        const bf16x8 af = ld_frag16(SCp + (16 * mt + c15) * 64 + 32 * s + 8 * g);
                        acc[mt][0] = MFMA16(af, q0, acc[mt][0]); acc[mt][1] = MFMA16(af, q1, acc[mt][1]);
                    }
                }
            }
#pragma unroll
            for (int nt = 0; nt < 2; ++nt)
#pragma unroll
                for (int mt = 0; mt < 8; ++mt) { const f32x4 o = acc[mt][nt]; const u32x2 w = {pk2(o[0], o[1]), pk2(o[2], o[3])};
                    *(LAS u32x2*)(at + (32 * ih + 16 * nt + c15) * 1040 + (hh * 128 + 16 * mt + 4 * g) * 2) = w; }
        }
        __syncthreads();
        {
            const f32x4 gh0 = *(const f32x4*)(p.in[11] + 8 * lane), gh1 = *(const f32x4*)(p.in[11] + 8 * lane + 4);
#pragma unroll
            for (int hb = 0; hb < 2; ++hb) {
                u32x4 a[4], bq[4], rv[4], cv[4];
#pragma unroll
                for (int j = 0; j < 4; ++j) { const int tl = wave * 8 + hb * 4 + j; const size_t t = (size_t)tok0 + tl;
                    a[j] = *(const u32x4*)(OF + t * 512 + 8 * lane); bq[j] = *(const u32x4*)(OB + t * 512 + 8 * lane); rv[j] = *(const u32x4*)(Z + t * ZW + 1024 + 8 * lane);
                    cv[j] = *(const LAS u32x4*)(at + tl * 1040 + 16 * lane); }
#pragma unroll
                for (int j = 0; j < 4; ++j) { const size_t t = (size_t)tok0 + wave * 8 + hb * 4 + j;
                    float o[8], r[8];
#pragma unroll
                    for (int e = 0; e < 4; ++e) { o[2 * e] = bflo(a[j][e]) + bflo(bq[j][e]) + bflo(cv[j][e]); o[2 * e + 1] = bfhi(a[j][e]) + bfhi(bq[j][e]) + bfhi(cv[j][e]); r[2 * e] = bflo(rv[j][e]); r[2 * e + 1] = bfhi(rv[j][e]); }
                    float ss = 0.f;
#pragma unroll
                    for (int e = 0; e < 8; ++e) ss += o[e] * o[e];
                    ss += __shfl_xor(ss, 1); ss += __shfl_xor(ss, 2); ss += __shfl_xor(ss, 4); ss += __shfl_xor(ss, 8);
                    const float rstd = rsqrtf(ss * (1.f / 128.f) + EPS);
                    float y[8];
#pragma unroll
                    for (int e = 0; e < 8; ++e) { const float gg = e < 4 ? gh0[e] : gh1[e - 4]; y[e] = o[e] * rstd * gg * (r[e] / (1.f + __expf(-r[e]))); }
                    const u32x4 w = {pk2(y[0], y[1]), pk2(y[2], y[3]), pk2(y[4], y[5]), pk2(y[6], y[7])};
                    *(u32x4*)(MIX + t * D + 8 * lane) = w; }
            }
        }
        __syncthreads();
        {
            const int c = tid, gi = c >> 7, cc = c & 127, hw = 1 << gi;
            LAS unsigned char* ag = at + gi * 16384;
            const LAS bf16_t* pc = pt + c;
            if (s0 >= 8 && s0 + 64 + 8 <= SEQ) {
                const float inv = 0.5f / (float)hw;
                float sum = 0.f;
                for (int rr = 8 - hw; rr < 8 + hw; ++rr) sum += bflo((unsigned)pc[rr * 512]);
#pragma unroll 4
                for (int i = 0; i < 64; ++i) {
                    const float val = sum * inv - bflo((unsigned)pc[(i + 8) * 512]);
                    *(LAS bf16_t*)(ag + i * 256 + (((cc >> 3) ^ (i & 15)) * 16) + (cc & 7) * 2) = (bf16_t)(pk2(val, 0.f) & 0xFFFFu);
                    sum += bflo((unsigned)pc[(i + 8 + hw) * 512]) - bflo((unsigned)pc[(i + 8 - hw) * 512]);
                }
            } else {
                float sum = 0.f;
                {   const int lo = max(s0 - hw, 0), hi = min(s0 + hw, SEQ);
                    for (int rr = lo; rr < hi; ++rr) sum += bflo((unsigned)pc[(rr - s0 + 8) * 512]); }
#pragma unroll 4
                for (int i = 0; i < 64; ++i) {
                    const int sq = s0 + i, lo = max(sq - hw, 0), hi = min(sq + hw, SEQ);
                    const float val = sum * __builtin_amdgcn_rcpf((float)(hi - lo)) - bflo((unsigned)pc[(i + 8) * 512]);
                    *(LAS bf16_t*)(ag + i * 256 + (((cc >> 3) ^ (i & 15)) * 16) + (cc & 7) * 2) = (bf16_t)(pk2(val, 0.f) & 0xFFFFu);
                    if (sq + hw < SEQ) sum += bflo((unsigned)pc[(i + 8 + hw) * 512]);
                    if (sq - hw >= 0) sum -= bflo((unsigned)pc[(i + 8 - hw) * 512]);
                }
            }
        }
        __syncthreads();
        {
            const int gi = wave >> 1, dh = wave & 1;
            LAS unsigned char* ag = at + gi * 16384;
            f32x4 acc[4][4];
#pragma unroll
            for (int mt = 0; mt < 4; ++mt)
#pragma unroll
                for (int nt = 0; nt < 4; ++nt) acc[mt][nt] = (f32x4){0.f, 0.f, 0.f, 0.f};
#pragma unroll
            for (int s = 0; s < 4; ++s) {
                bf16x8 af[4];
#pragma unroll
                for (int mt = 0; mt < 4; ++mt) { const int row = mt * 16 + c15; af[mt] = *(const LAS bf16x8*)(ag + row * 256 + (((4 * s + g) ^ (row & 15)) * 16)); }
#pragma unroll
                for (int nt = 0; nt < 4; ++nt) {
                    const bf16x8 wf = ld_frag16(WP + (size_t)gi * 16384 + (dh * 64 + 16 * nt + c15) * 128 + 32 * s + 8 * g);
#pragma unroll
                    for (int mt = 0; mt < 4; ++mt) acc[mt][nt] = MFMA16(wf, af[mt], acc[mt][nt]);
                }
            }
#pragma unroll
            for (int nt = 0; nt < 4; ++nt) {
                const f32x4 ps = *(const f32x4*)(p.in[13] + gi * 128 + dh * 64 + 16 * nt + 4 * g);
#pragma unroll
                for (int mt = 0; mt < 4; ++mt) {
                    const f32x4 v = acc[mt][nt] * ps;
                    u32x2 w = {pk2(v[0], v[1]), pk2(v[2], v[3])};
                    *(u32x2*)(MIX + ((size_t)tok0 + mt * 16 + c15) * D + 512 + gi * 128 + dh * 64 + 16 * nt + 4 * g) = w;
                }
            }
        }
    }
}

DI void phase4c(const Params& p, LAS unsigned char* lds, int tid, int lane, int wave) {
    asm volatile("" : "+v"(tid), "+v"(lane));
    LAS float* lG = (LAS float*)lds; LAS float* lA = lG + 1024; LAS float* lB = lA + 1024; LAS float* lP = lB + 1024;
    const float* x = p.in[0]; const bf16_t* MIXO = (const bf16_t*)(p.ws + WS_RZ); bf16_t* H2 = (bf16_t*)(p.ws + WS_RA);
    for (int rt = blockIdx.x; rt < T / 128; rt += gridDim.x) {
        const int b = rt / 32;
        __syncthreads();
        for (int d = tid; d < 1024; d += NTH) { lG[d] = mod_at(p, b, 2048 + d); lA[d] = p.in[15][d] * (1.f + mod_at(p, b, 4096 + d)); lB[d] = mod_at(p, b, 3072 + d); lP[d] = p.in[5][d]; }
        __syncthreads();
        for (int r0 = wave; r0 < 128; r0 += 4 * NWV) {
            f32x4 m[4][4], xv[4][4];
#pragma unroll
            for (int u = 0; u < 4; ++u) {
                const size_t row = (size_t)rt * 128 + r0 + u * NWV;
                const u32x2* mr = (const u32x2*)(MIXO + row * D) + lane; const f32x4* xr = (const f32x4*)(x + row * D) + lane;
#pragma unroll
                for (int j = 0; j < 4; ++j) { const u32x2 mv = mr[64 * j]; m[u][j] = (f32x4){bflo(mv.x), bfhi(mv.x), bflo(mv.y), bfhi(mv.y)}; xv[u][j] = xr[64 * j]; }
            }
#pragma unroll
            for (int u = 0; u < 4; ++u) {
                const size_t row = (size_t)rt * 128 + r0 + u * NWV;
                float ss = 0.f;
#pragma unroll
                for (int j = 0; j < 4; ++j) ss += m[u][j][0] * m[u][j][0] + m[u][j][1] * m[u][j][1] + m[u][j][2] * m[u][j][2] + m[u][j][3] * m[u][j][3];
                const float rstd = rsqrtf(wave_sum(ss) * (1.f / D) + EPS);
                float s2 = 0.f;
#pragma unroll
                for (int j = 0; j < 4; ++j) {
                    const f32x4 gt = *(const LAS f32x4*)(lG + 4 * lane + 256 * j), pm = *(const LAS f32x4*)(lP + 4 * lane + 256 * j);
                    xv[u][j] = xv[u][j] + gt * (m[u][j] * rstd * pm);
                    s2 += xv[u][j][0] * xv[u][j][0] + xv[u][j][1] * xv[u][j][1] + xv[u][j][2] * xv[u][j][2] + xv[u][j][3] * xv[u][j][3];
                }
                const float rstd2 = rsqrtf(wave_sum(s2) * (1.f / D) + EPS);
                u32x2* orow = (u32x2*)((bf16_t*)(p.ws + WS_RO) + row * D) + lane; u32x2* hrow = (u32x2*)(H2 + row * D) + lane;
#pragma unroll
                for (int j = 0; j < 4; ++j) {
                    { const u32x2 xw = {pk2(xv[u][j][0], xv[u][j][1]), pk2(xv[u][j][2], xv[u][j][3])}; orow[64 * j] = xw; }
                    const f32x4 a = *(const LAS f32x4*)(lA + 4 * lane + 256 * j), bb = *(const LAS f32x4*)(lB + 4 * lane + 256 * j);
                    const f32x4 hv = xv[u][j] * rstd2 * a + bb;
                    u32x2 w = {pk2(hv[0], hv[1]), pk2(hv[2], hv[3])};
                    hrow[64 * j] = w;
                }
            }
        }
    }
}

DI int skey(float v, int idx, int mask) { int u = __float_as_int(v); u ^= (u >> 31) & 0x7FFFFFFF; return (u & ~mask) | idx; }
DI float sval(int k, int mask) { int u = k & ~mask; u ^= (u >> 31) & 0x7FFFFFFF; return __int_as_float(u); }
DI void cswap(int& a, int& b) { const int mx = max(a, b), mn = min(a, b); a = mx; b = mn; }
DI void sort16_desc(int (&a)[16]) {
    cswap(a[0], a[13]); cswap(a[1], a[12]); cswap(a[2], a[15]); cswap(a[3], a[14]); cswap(a[4], a[8]); cswap(a[5], a[6]); cswap(a[7], a[11]); cswap(a[9], a[10]);
    cswap(a[0], a[5]); cswap(a[1], a[7]); cswap(a[2], a[9]); cswap(a[3], a[4]); cswap(a[6], a[13]); cswap(a[8], a[14]); cswap(a[10], a[15]); cswap(a[11], a[12]);
    cswap(a[0], a[1]); cswap(a[2], a[3]); cswap(a[4], a[5]); cswap(a[6], a[8]); cswap(a[7], a[9]); cswap(a[10], a[11]); cswap(a[12], a[13]); cswap(a[14], a[15]);
    cswap(a[0], a[2]); cswap(a[1], a[3]); cswap(a[4], a[10]); cswap(a[5], a[11]); cswap(a[6], a[7]); cswap(a[8], a[9]); cswap(a[12], a[14]); cswap(a[13], a[15]);
    cswap(a[1], a[2]); cswap(a[3], a[12]); cswap(a[4], a[6]); cswap(a[5], a[7]); cswap(a[8], a[10]); cswap(a[9], a[11]); cswap(a[13], a[14]);
    cswap(a[1], a[4]); cswap(a[2], a[6]); cswap(a[5], a[8]); cswap(a[7], a[10]); cswap(a[9], a[13]); cswap(a[11], a[14]);
    cswap(a[2], a[4]); cswap(a[3], a[6]); cswap(a[9], a[12]); cswap(a[11], a[13]);
    cswap(a[3], a[5]); cswap(a[6], a[8]); cswap(a[7], a[9]); cswap(a[10], a[12]);
    cswap(a[3], a[4]); cswap(a[5], a[6]); cswap(a[7], a[8]); cswap(a[9], a[10]); cswap(a[11], a[12]);
    cswap(a[6], a[7]); cswap(a[8], a[9]);
}
DI void merge16_desc(int (&x)[16], const int (&y)[16]) {
#pragma unroll
    for (int i = 0; i < 16; ++i) x[i] = max(x[i], y[15 - i]);
#pragma unroll
    for (int j = 8; j > 0; j >>= 1) {
#pragma unroll
        for (int i = 0; i < 16; ++i) { const int l = i ^ j; if (l > i) cswap(x[i], x[l]); }
    }
}

DI void phase5b(const Params& p, LAS unsigned char* lds, int tid, int lane, int wave) {
    asm volatile("" : "+v"(tid), "+v"(lane));
    unsigned char* ws = p.ws;
    const bf16_t* Q2 = (const bf16_t*)(ws + WS_RZ);
    const bf16_t* SKB = (const bf16_t*)(ws + WS_SKB);
    int* EIDX = (int*)(ws + WS_RS);
    LAS unsigned char* tab = lds + tid * 32;
    LAS unsigned char* skl = lds + 16384;
    const int c31 = lane & 31, hi = lane >> 5;
    for (int btask = blockIdx.x; btask < 256; btask += gridDim.x) {
        const int h = btask & 7, tgc = btask >> 3;
        __syncthreads();
#pragma unroll
        for (int ps = 0; ps < 8; ++ps) {
            const int idx = tid + NTH * ps, row = idx >> 4, ch = idx & 15;
            const u32x4 v = *(const u32x4*)(SKB + ((size_t)h * 256 + row) * 128 + ch * 8);
            *(LAS u32x4*)(skl + row * 256 + ((ch ^ (row & 15)) * 16)) = v;
        }
        __syncthreads();
      f32x4 qa[4];
      const int qrow0 = (btask * NWV + wave) * 16;
      quant_load(p, qrow0, lane, qa);
      for (int ti = 0; ti < 4; ++ti) {
        const int tg = tgc * 32 + wave * 4 + ti;
        const size_t tok = (size_t)tg * 32 + c31;
        int lst[2][16];
        bf16x8 bq[2][8];
#pragma unroll
        for (int pp = 0; pp < 2; ++pp) {
            const bf16_t* qp = Q2 + tok * 2048 + h * 256 + pp * 128 + 8 * hi;
            asm volatile("" : "+v"(qp));
#pragma unroll
            for (int ks = 0; ks < 8; ++ks) bq[pp][ks] = ld_frag16(qp + 16 * ks);
        }
#pragma unroll
        for (int pp = 0; pp < 2; ++pp) {
            int run[16];
#pragma unroll
            for (int r = 0; r < 16; ++r) run[r] = (int)0x80000000;
#pragma unroll 1
            for (int kt = 0; kt < 4; ++kt) {
                const LAS unsigned char* kb = skl + pp * 32768 + (32 * kt + c31) * 256;
                f32x16 acc;
#pragma unroll
                for (int r = 0; r < 16; ++r) acc[r] = 0.f;
#pragma unroll
                for (int ks = 0; ks < 8; ++ks) acc = MFMA32(*(const LAS bf16x8*)(kb + (((2 * ks + hi) ^ (c31 & 15)) * 16)), bq[pp][ks], acc);
                int cur[16];
#pragma unroll
                for (int r = 0; r < 16; ++r) cur[r] = skey(acc[r], 32 * kt + 8 * (r >> 2) + 4 * hi + (r & 3), 0x7F);
                sort16_desc(cur);
                merge16_desc(run, cur);
                if (kt & 1) { const int qr = ti * 4 + pp * 2 + (kt >> 1); quant_store(p, qrow0 + qr, lane, qa); if (qr < 15) quant_load(p, qrow0 + qr + 1, lane, qa); }
            }
            int oth[16];
#pragma unroll
            for (int r = 0; r < 16; ++r) oth[r] = __shfl_xor(run[r], 32);
            merge16_desc(run, oth);
#pragma unroll
            for (int r = 0; r < 16; ++r) lst[pp][r] = run[r];
        }
#pragma unroll
        for (int pp = 0; pp < 2; ++pp) {
            u32x4 w;
#pragma unroll
            for (int q = 0; q < 4; ++q) w[q] = (lst[pp][4 * q] & 0x7F) | ((lst[pp][4 * q + 1] & 0x7F) << 8) | ((lst[pp][4 * q + 2] & 0x7F) << 16) | ((lst[pp][4 * q + 3] & 0x7F) << 24);
            *(LAS u32x4*)(tab + 16 * pp) = w;
        }
        float va[16], vb[16];
#pragma unroll
        for (int r = 0; r < 16; ++r) { va[r] = sval(lst[0][r], 0x7F); vb[r] = sval(lst[1][r], 0x7F); }
        int cand[4][16];
        {
            int cnt = 0;
#pragma unroll
            for (int i = 0; i < 16; ++i)
#pragma unroll
                for (int j = 0; j < 16; ++j)
                    if ((i + 1) * (j + 1) <= 16) { cand[cnt >> 4][cnt & 15] = skey(va[i] + vb[j], (i << 4) | j, 0xFF); ++cnt; }
#pragma unroll
            for (int q = 50; q < 64; ++q) cand[q >> 4][q & 15] = (int)0x80000000;
        }
        sort16_desc(cand[0]); sort16_desc(cand[1]); sort16_desc(cand[2]); sort16_desc(cand[3]);
        merge16_desc(cand[0], cand[1]); merge16_desc(cand[2], cand[3]); merge16_desc(cand[0], cand[2]);
        asm volatile("s_waitcnt lgkmcnt(0)" ::: "memory");
        float sv[16]; int ex[16];
        const float mx = sval(cand[0][0], 0xFF);
        float sum = 0.f;
#pragma unroll
        for (int r = 0; r < 16; ++r) {
            const int ck = cand[0][r];
            const int i1 = tab[(ck >> 4) & 15], i2 = tab[16 + (ck & 15)];
            ex[r] = i1 * 128 + i2;
            sv[r] = __expf(sval(ck, 0xFF) - mx); sum += sv[r];
        }
        const float inv = 1.f / sum;
        unsigned* ep = (unsigned*)EIDX + tok * 128 + h * 16 + 8 * hi;
        unsigned pe[16];
#pragma unroll
        for (int r = 0; r < 16; ++r) pe[r] = (unsigned)ex[r] | (pk2(sv[r] * inv, 0.f) << 16);
        if (hi == 0) { *(u32x4*)ep = (u32x4){pe[0], pe[1], pe[2], pe[3]}; *(u32x4*)(ep + 4) = (u32x4){pe[4], pe[5], pe[6], pe[7]}; }
        else         { *(u32x4*)ep = (u32x4){pe[8], pe[9], pe[10], pe[11]}; *(u32x4*)(ep + 4) = (u32x4){pe[12], pe[13], pe[14], pe[15]}; }
      }
    }
}

template <int K> DI int swz_bcast(int v) { return __builtin_amdgcn_ds_swizzle(v, 0x10 | (K << 5)); }
template <int W> DI int swz_xor(int v) { return __builtin_amdgcn_ds_swizzle(v, 0x1F | (W << 10)); }
template <int K> struct IC { static constexpr int v = K; };
template <int N, int I = 0, class F> DI void static_for(F&& f) { if constexpr (I < N) { f(IC<I>{}); static_for<N, I + 1>(f); } }
DI float row16_sum(float v) {
    v += __builtin_bit_cast(float, __builtin_amdgcn_update_dpp(0, __builtin_bit_cast(int, v), 0xB1, 0xF, 0xF, true));
    v += __builtin_bit_cast(float, __builtin_amdgcn_update_dpp(0, __builtin_bit_cast(int, v), 0x4E, 0xF, 0xF, true));
    v += __builtin_bit_cast(float, __builtin_amdgcn_update_dpp(0, __builtin_bit_cast(int, v), 0x141, 0xF, 0xF, true));
    v += __builtin_bit_cast(float, __builtin_amdgcn_update_dpp(0, __builtin_bit_cast(int, v), 0x140, 0xF, 0xF, true));
    return v;
}
DI void phase6(const Params& p, LAS unsigned char* lds, int tid, int lane, int wave) {
    asm volatile("" : "+v"(tid), "+v"(lane));
    unsigned char* ws = p.ws;
    const bf16_t* H2 = (const bf16_t*)(ws + WS_RA);
    const unsigned char* UQ = ws + WS_UB; const unsigned char* VQ = ws + WS_VB;
    const float* SU = (const float*)(ws + WS_SU); const float* SV = (const float*)(ws + WS_SV);
    const unsigned* EIDX = (const unsigned*)(ws + WS_RS);
    LAS float* lG = (LAS float*)lds;
    const int q = lane >> 4, l16 = lane & 15;
    LAS int* le = (LAS int*)(lds + 4096 + wave * 6144) + q * 128;
    LAS float* lg = (LAS float*)(lds + 4096 + wave * 6144 + 2048) + q * 128;
    LAS float* lc = (LAS float*)(lds + 4096 + wave * 6144 + 4096) + q * 128;
    const unsigned qlo = q < 2 ? (0xFFFFu << (16 * q)) : 0u, qhi = q >= 2 ? (0xFFFFu << (16 * (q - 2))) : 0u;
    for (int rt = blockIdx.x; rt < T / 128; rt += gridDim.x) {
        const int b = rt / 32;
        __syncthreads();
        for (int d = tid; d < 1024; d += NTH) lG[d] = mod_at(p, b, 5120 + d) * p.in[16][d];
        __syncthreads();
#pragma unroll 1
        for (int rd = 0; rd < 4; ++rd) {
            __syncthreads();
            const size_t t = (size_t)rt * 128 + wave * 16 + rd * 4 + q;
            {
                int e[8]; float g[8];
#pragma unroll
                for (int r = 0; r < 8; ++r) { const unsigned pe = EIDX[t * 128 + r * 16 + l16]; e[r] = (int)(pe & 0xFFFFu); g[r] = bfhi(pe); }
                unsigned W[4] = {0u, 0u, 0u, 0u};
#pragma unroll
                for (int r = 0; r < 8; ++r) {
                    const int k = e[r] >> 10; const unsigned inc = 1u << (8 * (k & 3)); const int w = k >> 2;
                    W[0] += (w == 0) ? inc : 0u; W[1] += (w == 1) ? inc : 0u; W[2] += (w == 2) ? inc : 0u; W[3] += (w == 3) ? inc : 0u;
                }
                unsigned C[4];
                {
                    unsigned tot[4], exc[4];
#pragma unroll
                    for (int w = 0; w < 4; ++w) {
                        unsigned x = W[w];
                        x += (unsigned)__builtin_amdgcn_update_dpp(0, (int)x, 0x111, 0xF, 0xF, true);
                        x += (unsigned)__builtin_amdgcn_update_dpp(0, (int)x, 0x112, 0xF, 0xF, true);
                        x += (unsigned)__builtin_amdgcn_update_dpp(0, (int)x, 0x114, 0xF, 0xF, true);
                        x += (unsigned)__builtin_amdgcn_update_dpp(0, (int)x, 0x118, 0xF, 0xF, true);
                        exc[w] = x - W[w];
                        tot[w] = (unsigned)swz_bcast<15>((int)x);
                    }
                    unsigned carry = 0u;
#pragma unroll
                    for (int w = 0; w < 4; ++w) {
                        const unsigned P = tot[w] + (tot[w] << 8) + (tot[w] << 16) + (tot[w] << 24);
                        C[w] = (P - tot[w]) + carry * 0x01010101u + exc[w];
                        carry += P >> 24;
                    }
                }
#pragma unroll
                for (int r = 0; r < 8; ++r) {
                    const int k = e[r] >> 10; const int sh = 8 * (k & 3); const int w = k >> 2; const unsigned inc = 1u << sh;
                    const unsigned cw = (w == 0) ? C[0] : (w == 1) ? C[1] : (w == 2) ? C[2] : C[3];
                    const int pos = (int)((cw >> sh) & 0xFFu);
                    le[pos] = e[r]; lg[pos] = g[r];
                    C[0] += (w == 0) ? inc : 0u; C[1] += (w == 1) ? inc : 0u; C[2] += (w == 2) ? inc : 0u; C[3] += (w == 3) ? inc : 0u;
                }
                asm volatile("s_waitcnt lgkmcnt(0)" ::: "memory");
            }
            {
                int hq[16]; float ish;
                {
                    float hv[64]; float hm = 0.f;
#pragma unroll
                    for (int i = 0; i < 4; ++i) {
                        const u32x4 h0 = *(const u32x4*)(H2 + t * D + 256 * i + 16 * l16), h1 = *(const u32x4*)(H2 + t * D + 256 * i + 16 * l16 + 8);
#pragma unroll
                        for (int c = 0; c < 4; ++c) { hv[16 * i + 2 * c] = bflo(h0[c]); hv[16 * i + 2 * c + 1] = bfhi(h0[c]); hv[16 * i + 8 + 2 * c] = bflo(h1[c]); hv[16 * i + 8 + 2 * c + 1] = bfhi(h1[c]); }
                    }
#pragma unroll
                    for (int j = 0; j < 64; ++j) hm = fmaxf(hm, fabsf(hv[j]));
                    hm = fmaxf(hm, __builtin_bit_cast(float, __builtin_amdgcn_update_dpp(0, __builtin_bit_cast(int, hm), 0xB1, 0xF, 0xF, true)));
                    hm = fmaxf(hm, __builtin_bit_cast(float, __builtin_amdgcn_update_dpp(0, __builtin_bit_cast(int, hm), 0x4E, 0xF, 0xF, true)));
                    hm = fmaxf(hm, __builtin_bit_cast(float, __builtin_amdgcn_update_dpp(0, __builtin_bit_cast(int, hm), 0x141, 0xF, 0xF, true)));
                    hm = fmaxf(hm, __builtin_bit_cast(float, __builtin_amdgcn_update_dpp(0, __builtin_bit_cast(int, hm), 0x140, 0xF, 0xF, true)));
                    const float s8 = hm > 1e-30f ? 127.f / hm : 0.f; ish = hm * (1.f / 127.f);
#pragma unroll
                    for (int d = 0; d < 16; ++d) {
                        const int q0 = __float2int_rn(hv[4 * d] * s8), q1 = __float2int_rn(hv[4 * d + 1] * s8), q2 = __float2int_rn(hv[4 * d + 2] * s8), q3 = __float2int_rn(hv[4 * d + 3] * s8);
                        hq[d] = (int)((unsigned)(q0 & 0xFF) | ((unsigned)(q1 & 0xFF) << 8) | ((unsigned)(q2 & 0xFF) << 16) | ((unsigned)q3 << 24));
                    }
                }
                constexpr int UD = 4;
                u32x4 ub[UD][4];
                int evn = le[l16];
                static_for<UD>([&](auto kc) { constexpr int k = decltype(kc)::v; const unsigned char* up = UQ + (size_t)swz_bcast<k>(evn) * 1024 + 16 * l16;
#pragma unroll
                    for (int i = 0; i < 4; ++i) ub[k][i] = *(const u32x4*)(up + 256 * i); });
#pragma unroll 1
                for (int bt = 0; bt < 8; ++bt) {
                    if (bt) __syncthreads();
                    const int ev = evn; const float gv = lg[bt * 16 + l16];
                    evn = le[(bt < 7 ? bt + 1 : 7) * 16 + l16];
                    const float isu = SU[ev] * ish, isv = SV[ev];
                    int part[16];
                    static_for<16>([&](auto kc) {
                        constexpr int k = decltype(kc)::v, sl = k % UD;
                        int a = 0;
#pragma unroll
                        for (int i = 0; i < 4; ++i) {
                            const u32x4 u = ub[sl][i];
#pragma unroll
                            for (int c = 0; c < 4; ++c) a = __builtin_amdgcn_sdot4((int)u[c], hq[4 * i + c], a, false);
                        }
                        part[k] = a;
                        {
                            constexpr int kn = k + UD;
                            int idx; if constexpr (kn < 16) idx = swz_bcast<(kn & 15)>(ev); else idx = swz_bcast<(kn & 15)>(evn);
                            const unsigned char* up = UQ + (size_t)idx * 1024 + 16 * l16;
#pragma unroll
                            for (int i = 0; i < 4; ++i) ub[sl][i] = *(const u32x4*)(up + 256 * i);
                        }
                    });
                    static_for<4>([&](auto sc) {
                        constexpr int w = 8 >> decltype(sc)::v;
                        const bool up2 = (lane & w) != 0;
#pragma unroll
                        for (int e = 0; e < w; ++e) {
                            const int keep = up2 ? part[e + w] : part[e], send = up2 ? part[e] : part[e + w];
                            part[e] = keep + swz_xor<w>(send);
                        }
                    });
                    const float dot = (float)part[0] * isu;
                    lc[bt * 16 + l16] = gv * 0.5f * dot * (1.f + erff(dot * 0.70710678118654752f)) * isv;
                }
                asm volatile("s_waitcnt lgkmcnt(0)" ::: "memory");
            }
            __syncthreads();
            f32x2 y[32];
#pragma unroll
            for (int i = 0; i < 32; ++i) y[i] = (f32x2){0.f, 0.f};
            {
                constexpr int VD = 4;
                u32x4 vbuf[VD][4];
                int evn = le[l16];
                static_for<VD>([&](auto kc) { constexpr int k = decltype(kc)::v; const unsigned char* vp = VQ + (size_t)swz_bcast<k>(evn) * 1024 + 16 * l16;
#pragma unroll
                    for (int i = 0; i < 4; ++i) vbuf[k][i] = *(const u32x4*)(vp + 256 * i); });
#pragma unroll 1
                for (int bt = 0; bt < 8; ++bt) {
                    if (bt) __syncthreads();
                    const int ev = evn; const int cv = __float_as_int(lc[bt * 16 + l16]);
                    evn = le[(bt < 7 ? bt + 1 : 7) * 16 + l16];
                    static_for<16>([&](auto kc) {
                        constexpr int k = decltype(kc)::v, sl = k % VD;
                        const float cc = __int_as_float(swz_bcast<k>(cv));
                        const f32x2 c2 = (f32x2){cc, cc};
#pragma unroll
                        for (int i = 0; i < 4; ++i) {
                            const u32x4 v = vbuf[sl][i];
#pragma unroll
                            for (int c = 0; c < 4; ++c) {
                                const int w = (int)v[c];
                                y[8 * i + 2 * c] = __builtin_elementwise_fma(__builtin_amdgcn_cvt_pk_f32_fp8(w, false), c2, y[8 * i + 2 * c]);
                                y[8 * i + 2 * c + 1] = __builtin_elementwise_fma(__builtin_amdgcn_cvt_pk_f32_fp8(w, true), c2, y[8 * i + 2 * c + 1]);
                            }
                        }
                        {
                            constexpr int kn = k + VD;
                            int idx; if constexpr (kn < 16) idx = swz_bcast<(kn & 15)>(ev); else idx = swz_bcast<(kn & 15)>(evn);
                            const unsigned char* vp = VQ + (size_t)idx * 1024 + 16 * l16;
#pragma unroll
                            for (int i = 0; i < 4; ++i) vbuf[sl][i] = *(const u32x4*)(vp + 256 * i);
                        }
                    });
                }
            }
            float ss = 0.f;
#pragma unroll
            for (int i = 0; i < 32; ++i) ss += y[i].x * y[i].x + y[i].y * y[i].y;
            const float rstd = rsqrtf(row16_sum(ss) * (1.f / D) + EPS);
            float* orow = p.out + t * D;
#pragma unroll
            for (int i = 0; i < 4; ++i)
#pragma unroll
                for (int c = 0; c < 4; ++c) {
                    const int col = 256 * i + 16 * l16 + 4 * c;
                    const u32x2 xb = *(const u32x2*)((const bf16_t*)(ws + WS_RO) + t * D + col);
                    f32x4 xv = {bflo(xb.x), bfhi(xb.x), bflo(xb.y), bfhi(xb.y)};
                    const f32x4 gg = *(const LAS f32x4*)(lG + col);
                    xv[0] += gg[0] * y[8 * i + 2 * c].x * rstd; xv[1] += gg[1] * y[8 * i + 2 * c].y * rstd; xv[2] += gg[2] * y[8 * i + 2 * c + 1].x * rstd; xv[3] += gg[3] * y[8 * i + 2 * c + 1].y * rstd;
                    *(f32x4*)(orow + col) = xv;
                }
        }
    }
}


__global__ void __launch_bounds__(NTH) fwd_megakernel(Params p) {
    extern __shared__ __attribute__((aligned(16))) unsigned char lds_raw[];
    LAS unsigned char* lds = (LAS unsigned char*)lds_raw;
    const int tid = threadIdx.x, lane = tid & 63, wave = __builtin_amdgcn_readfirstlane(tid >> 6);
    volatile LAS unsigned* st = (volatile LAS unsigned*)(lds + LDS_BARW);
    if (tid == 0) { st[0] = 0u; st[1] = 0u; st[2] = 0u; st[3] = 0u; }
    __syncthreads();
    XcdBarrier bar = xcd_barrier_post((unsigned*)(p.ws + WS_CTL), st);
    unsigned char* ws = p.ws;

    phase0(p, lds, tid, lane, wave);
    xcd_barrier(bar);
    phase1(p, lds, tid, lane, wave);
    afb_tail((const bf16_t*)(ws + WS_RA), (const bf16_t*)(ws + WS_WIN) + (size_t)ZW * D, (float*)(ws + WS_AFB), lds, tid, lane, wave);
    xcd_barrier(bar);
    { pg8::Gemm g{(const bf16_t*)(ws + WS_RA), (const bf16_t*)(ws + WS_WIN), T, ZW, D}; pg8::StaticOrder S; S.init(T, ZW, (int)gridDim.x, (int)blockIdx.x);
      pg8::EpiB16 e{(bf16_t*)(ws + WS_RZ), ZW}; pg8::gemm_phase<pg8::EpiB16, pg8::StaticOrder, true, true>(lds, g, S, e);
 }
    xcd_barrier(bar);
    phaseGA(p, lds, tid, lane, wave);
    xcd_barrier(bar);
    phaseGB(p, tid);
    xcd_barrier(bar);
    phase4a(p, lds, tid, lane, wave);
    xcd_barrier(bar);
    { pg8::Gemm g{(const bf16_t*)(ws + WS_RA), (const bf16_t*)(ws + WS_WOUT), T, D, D}; pg8::StaticOrder S; S.init(T, D, (int)gridDim.x, (int)blockIdx.x);
      pg8::EpiB16 e{(bf16_t*)(ws + WS_RZ), D}; pg8::gemm_phase<pg8::EpiB16, pg8::StaticOrder, true, true>(lds, g, S, e); }
    xcd_barrier(bar);
    phase4c(p, lds, tid, lane, wave);
    xcd_barrier(bar);
    { pg8::Gemm g{(const bf16_t*)(ws + WS_RA), (const bf16_t*)(ws + WS_WQ), T, 2048, D}; pg8::StaticOrder S; S.init(T, 2048, (int)gridDim.x, (int)blockIdx.x);
      pg8::EpiB16 e{(bf16_t*)(ws + WS_RZ), 2048}; pg8::gemm_phase<pg8::EpiB16, pg8::StaticOrder, true, true>(lds, g, S, e); }
    xcd_barrier(bar);
    phase5b(p, lds, tid, lane, wave);
    xcd_barrier(bar);
    phase6(p, lds, tid, lane, wave);
}

extern "C" void kernel_launch(void* const* d_in, const int* in_sizes, int n_in, void* d_out, int out_size, void* d_ws, size_t ws_size, hipStream_t stream) {
    static int grid = 0;
    if (grid == 0) {
        if (n_in != 21 || out_size != T * D || ws_size < WS_END) { fprintf(stderr, "kernel_launch: unexpected shapes (n_in %d out %d ws %zu need %zu)\n", n_in, out_size, ws_size, (size_t)WS_END); grid = -1; return; }
        int dev = 0, cus = 0, per_cu = 0;
        hipGetDevice(&dev); hipDeviceGetAttribute(&cus, hipDeviceAttributeMultiprocessorCount, dev);
        hipFuncSetAttribute((const void*)fwd_megakernel, hipFuncAttributeMaxDynamicSharedMemorySize, LDS_BYTES);
        hipOccupancyMaxActiveBlocksPerMultiprocessor(&per_cu, (const void*)fwd_megakernel, NTH, LDS_BYTES);
        (void)hipGetLastError();
        if (per_cu < 1) fprintf(stderr, "kernel_launch: occupancy query says %d blocks per CU\n", per_cu);
        grid = cus;
    }
    if (grid < 0) return;
    hipMemsetAsync((char*)d_ws + WS_CTL, 0, 64 * 1024, stream);
    Params p{};
    for (int i = 0; i < 21; ++i) p.in[i] = (const float*)d_in[i];
    p.out = (float*)d_out; p.ws = (unsigned char*)d_ws;
    hipLaunchKernelGGL(fwd_megakernel, dim3(grid), dim3(NTH), LDS_BYTES, stream, p);
}
```

```cpp
#include <hip/hip_runtime.h>
#include <cstdio>
#include <cstdint>

#define DI __device__ __forceinline__
#define LAS __attribute__((address_space(3)))
typedef unsigned short bf16_t;
typedef short bf16x8 __attribute__((ext_vector_type(8)));
typedef float f32x4 __attribute__((ext_vector_type(4)));
typedef float f32x2 __attribute__((ext_vector_type(2)));
typedef float f32x16 __attribute__((ext_vector_type(16)));
typedef unsigned u32x4 __attribute__((ext_vector_type(4)));
typedef unsigned u32x2 __attribute__((ext_vector_type(2)));
typedef __bf16 bf16x2v __attribute__((ext_vector_type(2)));

constexpr int T = 32768, D = 1024, SEQ = 4096, NB = 8;
constexpr int NTH = 512, NWV = 8;
constexpr int ZW = 2048;
constexpr int NIN = 2176;
constexpr float EPS = 1e-6f;

constexpr size_t MB = 1024 * 1024;
constexpr size_t WS_CTL   = 0;
constexpr size_t WS_MODP  = 64 * 1024;
constexpr size_t WS_WIN   = WS_MODP + 8 * 8 * 6144 * 4;
constexpr size_t WS_WOUT  = WS_WIN + (size_t)NIN * 1024 * 2;
constexpr size_t WS_WQ    = WS_WOUT + 1024 * 1024 * 2;
constexpr size_t WS_SKB   = WS_WQ + 2048 * 1024 * 2;
constexpr size_t WS_WP    = WS_SKB + 16 * 128 * 128 * 2;
constexpr size_t WS_AFB   = WS_WP + 4 * 128 * 128 * 2;
constexpr size_t WS_UB    = WS_AFB + (size_t)T * 32 * 4;
constexpr size_t WS_VB    = WS_UB + 32 * MB;
constexpr size_t WS_SU    = WS_UB + 16 * MB, WS_SV = WS_VB + 16 * MB;
constexpr size_t WS_RA    = WS_VB + 32 * MB;
constexpr size_t WS_RZ    = WS_RA + 64 * MB;
constexpr size_t WS_RS    = WS_RZ + 128 * MB;
constexpr size_t WS_RO    = WS_RS + 6 * 16 * MB + 1 * MB;
constexpr size_t WS_END   = WS_RO + 128 * MB;
static_assert(WS_END <= 512 * MB, "workspace too large");

struct Params { const float* in[21]; float* out; unsigned char* ws; };

DI unsigned pk2(float a, float b) { f32x2 f = {a, b}; bf16x2v h = __builtin_convertvector(f, bf16x2v); return __builtin_bit_cast(unsigned, h); }
DI float dot2bf(unsigned a, unsigned b, float c) { return __builtin_amdgcn_fdot2_f32_bf16(__builtin_bit_cast(bf16x2v, a), __builtin_bit_cast(bf16x2v, b), c, false); }
DI float bflo(unsigned u) { return __uint_as_float(u << 16); }
DI float bfhi(unsigned u) { return __uint_as_float(u & 0xFFFF0000u); }
DI float wave_sum(float v) {
#pragma unroll
    for (int o = 1; o < 64; o <<= 1) v += __shfl_xor(v, o);
    return v;
}
DI bf16x8 ld_frag16(const bf16_t* p) { return __builtin_bit_cast(bf16x8, *(const u32x4*)p); }
DI bf16x8 ld_frag_perm(const bf16_t* p, int g) {
    const u32x2 lo = *(const u32x2*)(p + 4 * g), hi = *(const u32x2*)(p + 16 + 4 * g);
    u32x4 v = {lo.x, lo.y, hi.x, hi.y}; return __builtin_bit_cast(bf16x8, v);
}
DI int perm32(int k) { return (k & ~31) | (((k >> 2) & 3) << 3) | (((k >> 4) & 1) << 2) | (k & 3); }
DI bf16x8 pack8(const f32x4& a, const f32x4& b) { u32x4 v = {pk2(a[0], a[1]), pk2(a[2], a[3]), pk2(b[0], b[1]), pk2(b[2], b[3])}; return __builtin_bit_cast(bf16x8, v); }
#define MFMA16(a, b, c) __builtin_amdgcn_mfma_f32_16x16x32_bf16((a), (b), (c), 0, 0, 0)
#define MFMA32(a, b, c) __builtin_amdgcn_mfma_f32_32x32x16_bf16((a), (b), (c), 0, 0, 0)

#define XB_TMO      128
#define XB_XCNT(j)  (256  + 64 * (j))
#define XB_XSUB(j)  (1280 + 64 * (j))
#define XB_XGEN(j)  (2304 + 64 * (j))
#define XB_TOP      3328
#define XB_TOPGEN   3392
#define XCD_BAR_WORDS 3456
#define XB_SPIN_CAP (1u << 22)
DI unsigned xb_ld(unsigned* p)              { return __hip_atomic_load(p, __ATOMIC_RELAXED, __HIP_MEMORY_SCOPE_AGENT); }
DI unsigned xb_add(unsigned* p, unsigned v) { return __hip_atomic_fetch_add(p, v, __ATOMIC_RELAXED, __HIP_MEMORY_SCOPE_AGENT); }
DI unsigned xb_xcc_id() { return (unsigned)__builtin_amdgcn_s_getreg((3 << 11) | 20) & 0xFu; }
#define XB_SPIN(cond, bar) do { unsigned _sp = 0; while (cond) { __builtin_amdgcn_s_sleep(1); \
    if ((++_sp & 255u) == 0u) { if (xb_ld(&(bar)[XB_TMO])) break; if (_sp > XB_SPIN_CAP) { atomicAdd(&(bar)[XB_TMO], 1u); break; } } } } while (0)
struct XcdBarrier { unsigned* bar; unsigned x; volatile LAS unsigned* st; };
DI XcdBarrier xcd_barrier_post(unsigned* bar, volatile LAS unsigned* st) {
    XcdBarrier b; b.bar = bar; b.x = xb_xcc_id(); b.st = st;
    if (threadIdx.x == 0) (void)xb_add(&bar[XB_XCNT(b.x)], 1u);
    return b;
}
DI void xcd_barrier_complete(unsigned* bar, unsigned x, unsigned& nloc, unsigned& nx) {
    const unsigned G = gridDim.x * gridDim.y * gridDim.z;
    unsigned sum, cnt, mine, sp = 0u;
    for (;;) {
        sum = 0u; cnt = 0u; mine = 0u;
#pragma unroll
        for (unsigned j = 0; j < 16; ++j) { const unsigned c = xb_ld(&bar[XB_XCNT(j)]); sum += c; cnt += (c > 0u) ? 1u : 0u; mine = (j == x) ? c : mine; }
        if (sum == G) break;
        __builtin_amdgcn_s_sleep(1);
        if ((++sp & 255u) == 0u) { if (xb_ld(&bar[XB_TMO])) break; if (sp > XB_SPIN_CAP) { atomicAdd(&bar[XB_TMO], 1u); break; } }
    }
    nloc = mine > 0u ? mine : 1u; nx = cnt > 0u ? cnt : 1u;
}
DI void xcd_barrier(const XcdBarrier& b) {
    asm volatile("s_waitcnt vmcnt(0)" ::: "memory");
    __syncthreads();
    if (threadIdx.x == 0) {
        unsigned* bar = b.bar;
        __builtin_amdgcn_s_waitcnt(0);
        unsigned nloc = b.st[0], nx = b.st[1];
        if (nloc == 0u) { xcd_barrier_complete(bar, b.x, nloc, nx); b.st[0] = nloc; b.st[1] = nx; }
        const unsigned old = xb_add(&bar[XB_XSUB(b.x)], 1u);
        const unsigned gen = old / nloc;
        if (old + 1u == (gen + 1u) * nloc) {
            __builtin_amdgcn_fence(__ATOMIC_RELEASE, "agent");
            asm volatile("s_waitcnt vmcnt(0)" ::: "memory");
            const unsigned og = xb_add(&bar[XB_TOP], 1u);
            const unsigned tg = og / nx;
            if (og + 1u == (tg + 1u) * nx) xb_add(&bar[XB_TOPGEN], 1u);
            else XB_SPIN(xb_ld(&bar[XB_TOPGEN]) == tg, bar);
            __builtin_amdgcn_fence(__ATOMIC_ACQUIRE, "agent");
            xb_add(&bar[XB_XGEN(b.x)], 1u);
            asm volatile("s_waitcnt vmcnt(0)" ::: "memory");
        } else {
            XB_SPIN(xb_ld(&bar[XB_XGEN(b.x)]) == gen, bar);
            __builtin_amdgcn_fence(__ATOMIC_ACQUIRE, "agent");
            asm volatile("s_waitcnt vmcnt(0)" ::: "memory");
        }
    }
    __syncthreads();
}

constexpr int LDS_BYTES = 152 * 1024;
constexpr int LDS_BARW = LDS_BYTES - 16;

DI void p0_transpose_item(const float* W, int ldw, int K, bf16_t* WT, int dst_row0, int src_col0, float scale, bool zero, LAS float* scr, int kb, int lane) {
    const int k0 = 64 * kb;
    if (zero) scale = 0.f;
#pragma unroll 8
    for (int i = 0; i < 32; ++i) { const int kk = 2 * i + (lane >> 5); scr[kk * 33 + (lane & 31)] = W[(size_t)(k0 + kk) * ldw + src_col0 + (lane & 31)] * scale; }
    asm volatile("s_waitcnt lgkmcnt(0)" ::: "memory");
    const int c = lane & 7;
#pragma unroll
    for (int j = 0; j < 4; ++j) { const int n = (lane >> 3) + 8 * j; const LAS float* s = scr + (8 * c) * 33 + n;
        u32x4 o; o.x = pk2(s[0 * 33], s[1 * 33]); o.y = pk2(s[2 * 33], s[3 * 33]); o.z = pk2(s[4 * 33], s[5 * 33]); o.w = pk2(s[6 * 33], s[7 * 33]);
        *(u32x4*)(WT + (size_t)(dst_row0 + n) * K + k0 + 8 * c) = o; }
    asm volatile("s_waitcnt lgkmcnt(0)" ::: "memory");
}

DI void phase0(const Params& p, LAS unsigned char* lds, int tid, int lane, int wave) {
    asm volatile("" : "+v"(tid), "+v"(lane));
    unsigned char* ws = p.ws;
    LAS float* sl = (LAS float*)lds;
    LAS float* scr = (LAS float*)(lds + 32768 + wave * 8448);
    const float* c = p.in[1];
    { float cv[16];
#pragma unroll
      for (int i = 0; i < 16; ++i) cv[i] = c[tid + NTH * i];
#pragma unroll
      for (int i = 0; i < 16; ++i) { const int e = tid + NTH * i, b = e >> 10, k = e & 1023; const float v = cv[i]; sl[k * 8 + b] = v / (1.f + __expf(-v)); } }
    __syncthreads();
    const int gw = wave * gridDim.x + blockIdx.x, NGW = gridDim.x * NWV;
    constexpr int I_MOD = 768, I_WIN = 16 * 68, I_WOUT = 16 * 32, I_WQ = 16 * 64, I_WP = 32;
    constexpr int NITEMS = I_MOD + I_WIN + I_WOUT + I_WQ + I_WP;
    for (int it = gw; it < NITEMS; it += NGW) {
        int r = it;
        if (r < I_MOD) {
            const int cg = r % 96, ks = r / 96, n = cg * 64 + lane, k0 = ks * 128;
            const float* W = p.in[2] + (size_t)k0 * 6144 + n;
            float acc[8];
#pragma unroll
            for (int b = 0; b < 8; ++b) acc[b] = 0.f;
#pragma unroll 32
            for (int k = 0; k < 128; ++k) {
                const float w = W[(size_t)k * 6144];
                const f32x4 s0 = *(const LAS f32x4*)(sl + (k0 + k) * 8), s1 = *(const LAS f32x4*)(sl + (k0 + k) * 8 + 4);
                acc[0] += s0[0] * w; acc[1] += s0[1] * w; acc[2] += s0[2] * w; acc[3] += s0[3] * w;
                acc[4] += s1[0] * w; acc[5] += s1[1] * w; acc[6] += s1[2] * w; acc[7] += s1[3] * w;
            }
            float* mp = (float*)(ws + WS_MODP) + (size_t)ks * 8 * 6144 + n;
#pragma unroll
            for (int b = 0; b < 8; ++b) mp[b * 6144] = acc[b];
            continue;
        }
        r -= I_MOD;
        if (r < I_WIN) {
            const int kb = r / 68, nb = r % 68, n0 = nb * 32;
            int src; bool zero = false; float scale = 1.f;
            if (n0 < 1536) { src = n0; if (n0 < 256) scale = 0.125f; } else if (n0 < 2048) src = n0 + 32; else if (n0 < 2080) src = 1536 + (n0 - 2048); else { src = 0; zero = true; }
            p0_transpose_item(p.in[6], 2080, 1024, (bf16_t*)(ws + WS_WIN), n0, src, scale, zero, scr, kb, lane);
            continue;
        }
        r -= I_WIN;
        if (r < I_WOUT) { p0_transpose_item(p.in[14], 1024, 1024, (bf16_t*)(ws + WS_WOUT), (r % 32) * 32, (r % 32) * 32, 1.f, false, scr, r / 32, lane); continue; }
        r -= I_WOUT;
        if (r < I_WQ) { p0_transpose_item(p.in[17], 2048, 1024, (bf16_t*)(ws + WS_WQ), (r % 64) * 32, (r % 64) * 32, 1.f, false, scr, r / 64, lane); continue; }
        r -= I_WQ;
        { const int g = r >> 3, kb = (r >> 2) & 1, nb = r & 3;
          p0_transpose_item(p.in[12] + g * 16384, 128, 128, (bf16_t*)(ws + WS_WP) + g * 16384, nb * 32, nb * 32, 1.f, false, scr, kb, lane); }
    }
    const size_t gt = (size_t)blockIdx.x * NTH + tid, NGT = (size_t)gridDim.x * NTH;
    constexpr size_t NSK = (size_t)16 * 128 * 128 / 8;
    for (size_t j = gt; j < NSK; j += NGT) {
        const float* src = p.in[18]; bf16_t* dst = (bf16_t*)(ws + WS_SKB);
        const f32x4 a = *(const f32x4*)(src + j * 8), b = *(const f32x4*)(src + j * 8 + 4);
        u32x4 o = {pk2(a[0], a[1]), pk2(a[2], a[3]), pk2(b[0], b[1]), pk2(b[2], b[3])};
        *(u32x4*)(dst + j * 8) = o;
    }
}

DI void quant_load(const Params& p, int row, int lane, f32x4 (&v)[4]) {
    const int tb = row >> 14, e = row & 16383;
    const float* src = (tb ? p.in[20] : p.in[19]) + (size_t)e * D + 16 * lane;
#pragma unroll
    for (int q = 0; q < 4; ++q) v[q] = *(const f32x4*)(src + 4 * q);
}
DI void quant_store(const Params& p, int row, int lane, const f32x4 (&v)[4]) {
    unsigned char* ws = p.ws;
    const int tb = row >> 14, e = row & 16383;
    float m = 0.f;
#pragma unroll
    for (int q = 0; q < 4; ++q) m = fmaxf(m, fmaxf(fmaxf(fabsf(v[q][0]), fabsf(v[q][1])), fmaxf(fabsf(v[q][2]), fabsf(v[q][3]))));
#pragma unroll
    for (int o = 1; o < 64; o <<= 1) m = fmaxf(m, __shfl_xor(m, o));
    int ex = (int)((__float_as_uint(m) >> 23) & 0xFFu) - 127;
    if (m < 1e-30f) ex = 7;
    const float sc = __uint_as_float((unsigned)(127 + 7 - ex) << 23), isc = __uint_as_float((unsigned)(127 - 7 + ex) << 23);
    u32x4 o;
    if (tb) {
#pragma unroll
        for (int q = 0; q < 4; ++q) { int w = 0; w = __builtin_amdgcn_cvt_pk_fp8_f32(v[q][0] * sc, v[q][1] * sc, w, false); w = __builtin_amdgcn_cvt_pk_fp8_f32(v[q][2] * sc, v[q][3] * sc, w, true); o[q] = (unsigned)w; }
        if (lane == 0) ((float*)(ws + WS_SV))[e] = isc;
    } else {
        const float s8 = m > 1e-30f ? 127.f / m : 0.f;
#pragma unroll
        for (int q = 0; q < 4; ++q) {
            const int q0 = __float2int_rn(v[q][0] * s8), q1 = __float2int_rn(v[q][1] * s8), q2 = __float2int_rn(v[q][2] * s8), q3 = __float2int_rn(v[q][3] * s8);
            o[q] = (unsigned)(q0 & 0xFF) | ((unsigned)(q1 & 0xFF) << 8) | ((unsigned)(q2 & 0xFF) << 16) | ((unsigned)q3 << 24);
        }
        if (lane == 0) ((float*)(ws + WS_SU))[e] = m * (1.f / 127.f);
    }
    *(u32x4*)(ws + (tb ? WS_VB : WS_UB) + (size_t)e * 1024 + 16 * lane) = o;
}

DI float mod_at(const Params& p, int b, int n) {
    const float* mp = (const float*)(p.ws + WS_MODP) + (size_t)b * 6144 + n;
    float s = p.in[3][n];
#pragma unroll
    for (int ks = 0; ks < 8; ++ks) s += mp[(size_t)ks * 8 * 6144];
    return s;
}

DI void phase1(const Params& p, LAS unsigned char* lds, int tid, int lane, int wave) {
    asm volatile("" : "+v"(tid), "+v"(lane));
    LAS float* lA = (LAS float*)lds; LAS float* lB = lA + 1024;
    const float* x = p.in[0]; bf16_t* H = (bf16_t*)(p.ws + WS_RA);
    for (int rt = blockIdx.x; rt < T / 128; rt += gridDim.x) {
        const int b = rt / 32;
        __syncthreads();
        for (int d = tid; d < 1024; d += NTH) { lA[d] = p.in[4][d] * (1.f + mod_at(p, b, 1024 + d)); lB[d] = mod_at(p, b, d); }
        __syncthreads();
        for (int r0 = wave; r0 < 128; r0 += 4 * NWV) {
            f32x4 v[4][4];
#pragma unroll
            for (int u = 0; u < 4; ++u) { const f32x4* xr = (const f32x4*)(x + ((size_t)rt * 128 + r0 + u * NWV) * D) + lane;
#pragma unroll
                for (int j = 0; j < 4; ++j) v[u][j] = xr[64 * j]; }
#pragma unroll
            for (int u = 0; u < 4; ++u) {
                const size_t row = (size_t)rt * 128 + r0 + u * NWV;
                float ss = 0.f;
#pragma unroll
                for (int j = 0; j < 4; ++j) ss += v[u][j][0] * v[u][j][0] + v[u][j][1] * v[u][j][1] + v[u][j][2] * v[u][j][2] + v[u][j][3] * v[u][j][3];
                const float rstd = rsqrtf(wave_sum(ss) * (1.f / D) + EPS);
                u32x2* o = (u32x2*)(H + row * D) + lane;
#pragma unroll
                for (int j = 0; j < 4; ++j) {
                    const f32x4 a = *(const LAS f32x4*)(lA + 4 * lane + 256 * j), bb = *(const LAS f32x4*)(lB + 4 * lane + 256 * j);
                    u32x2 w = {pk2(v[u][j][0] * rstd * a[0] + bb[0], v[u][j][1] * rstd * a[1] + bb[1]), pk2(v[u][j][2] * rstd * a[2] + bb[2], v[u][j][3] * rstd * a[3] + bb[3])};
                    o[64 * j] = w;
                }
            }
        }
    }
}

DI void afb_tail(const bf16_t* H, const bf16_t* Wt, float* AFB, LAS unsigned char* lds, int tid, int lane, int wave) {
    constexpr int WSTR = 2064;
    asm volatile("" : "+v"(tid), "+v"(lane));
    const int c15 = lane & 15, g = lane >> 4;
    __syncthreads();
#pragma unroll
    for (int ps = 0; ps < 8; ++ps) { const int idx = tid + NTH * ps, n = idx >> 7, ch = idx & 127; *(LAS u32x4*)(lds + n * WSTR + ch * 16) = *(const u32x4*)(Wt + (size_t)n * D + ch * 8); }
    __syncthreads();
    LAS const unsigned char* w0 = lds + c15 * WSTR + 32 * g;
    for (int tile = blockIdx.x; tile < T / 128; tile += gridDim.x) {
        const size_t row = (size_t)tile * 128 + wave * 16 + c15;
        const bf16_t* ap = H + row * D + 16 * g;
        f32x4 acc0 = {0.f, 0.f, 0.f, 0.f}, acc1 = {0.f, 0.f, 0.f, 0.f};
#pragma unroll 1
        for (int hf = 0; hf < 2; ++hf) {
            bf16x8 a[16];
#pragma unroll
            for (int t = 0; t < 8; ++t) { a[2 * t] = *(const bf16x8*)(ap + 512 * hf + 64 * t); a[2 * t + 1] = *(const bf16x8*)(ap + 512 * hf + 64 * t + 8); }
            LAS const unsigned char* wp = w0 + 1024 * hf;
#pragma unroll
            for (int t = 0; t < 8; ++t)
#pragma unroll
                for (int e = 0; e < 2; ++e) {
                    acc0 = MFMA16(*(LAS const bf16x8*)(wp + 128 * t + 16 * e), a[2 * t + e], acc0);
                    acc1 = MFMA16(*(LAS const bf16x8*)(wp + 16 * WSTR + 128 * t + 16 * e), a[2 * t + e], acc1);
                }
        }
        *(f32x4*)(AFB + row * 32 + 4 * g) = acc0;
        *(f32x4*)(AFB + row * 32 + 16 + 4 * g) = acc1;
    }
}

namespace pg8 {
#define PG8_LAS __attribute__((address_space(3)))
constexpr int BM = 256, BK = 64, HALF = 128, HTB = HALF * BK * 2  , STAGE_BYTES = 8 * HTB, NXCD = 8, WGM = 1;

__host__ __device__ __forceinline__ int lds_byte(int r, int c) { const int st = (r >> 4) * 2 + (c >> 5), rr = r & 15, cc = c & 31, ob = rr * 64 + cc * 2; return st * 1024 + (ob ^ (((ob >> 9) & 1) << 5)); }
__host__ __device__ __forceinline__ void stage_rc(int b, int& R, int& C) { const int st = b / 1024, sb = b % 1024, swz = sb ^ (((sb >> 9) & 1) << 5); R = (st >> 1) * 16 + swz / 64; C = (st & 1) * 32 + (swz % 64) / 2; }
__host__ __device__ __forceinline__ int perm32(int rho) { const int n = rho >> 4, i = rho & 15; return 8 * (i >> 2) + 4 * n + (i & 3); }

struct Unit { int pm, pn; };
struct Gemm { const bf16_t* A; const bf16_t* Bt; int M, N, K; };

struct StaticOrder {
    int nM, nN, nwg, G, c;
    __host__ __device__ void init(int M, int N, int G_, int c_) { nM = M / BM; nN = N / BM; nwg = nM * nN; G = G_; c = c_; }
    __host__ __device__ bool next(int i, Unit& u) const {
        const long L = (long)i * G + c; if (L >= nwg) return false;
        int wgid = (int)L; { const int q = nwg / NXCD, r = nwg % NXCD, xcd = wgid % NXCD, off = wgid / NXCD; wgid = (xcd < r ? xcd * (q + 1) : r * (q + 1) + (xcd - r) * q) + off; }
        const int nig = WGM * nN, gid = wgid / nig, fm = gid * WGM, gsz = (nM - fm) < WGM ? (nM - fm) : WGM;
        u.pm = fm + ((wgid % nig) % gsz); u.pn = (wgid % nig) / gsz; return true;
    }
    __device__ __forceinline__ void a_ready(const Unit&) const {}
    __device__ __forceinline__ void done(const Unit&) const {}
};

struct EpiB16 {
    static constexpr bool PERM = true, AFTER_DRAIN = false;
    bf16_t* O; int ldc;
    __device__ __forceinline__ void operator()(const f32x4 (&acc)[2][2][4][2], const Unit& u, int wr, int wc, int fr, int fq) const {
#pragma unroll
        for (int ai = 0; ai < 2; ++ai)
#pragma unroll
            for (int m = 0; m < 4; ++m) { bf16_t* rowp = O + (size_t)(u.pm * BM + ai * HALF + wr * 64 + m * 16 + fr) * ldc + u.pn * BM + wc * 32 + 8 * fq;
#pragma unroll
                for (int bj = 0; bj < 2; ++bj) { const f32x4 v0 = acc[ai][bj][m][0], v1 = acc[ai][bj][m][1];
                    u32x4 w; w.x = ::pk2(v0[0], v0[1]); w.y = ::pk2(v0[2], v0[3]); w.z = ::pk2(v1[0], v1[1]); w.w = ::pk2(v1[2], v1[3]);
                    *(u32x4*)(rowp + bj * HALF) = w; } }
    }
};
struct EpiF {
    static constexpr bool PERM = false, AFTER_DRAIN = false;
    float* O; int ldc;
    __device__ __forceinline__ void operator()(const f32x4 (&acc)[2][2][4][2], const Unit& u, int wr, int wc, int fr, int fq) const {
#pragma unroll
        for (int ai = 0; ai < 2; ++ai)
#pragma unroll
            for (int m = 0; m < 4; ++m) { float* rowp = O + (size_t)(u.pm * BM + ai * HALF + wr * 64 + m * 16 + fr) * ldc + u.pn * BM + wc * 32 + 4 * fq;
#pragma unroll
                for (int bj = 0; bj < 2; ++bj)
#pragma unroll
                    for (int n = 0; n < 2; ++n) *(f32x4*)(rowp + bj * HALF + 16 * n) = acc[ai][bj][m][n]; }
    }
};
template <class Epi, class Sched, bool ALIGN_EPI = false, bool SP2 = false>
__device__ __forceinline__ void gemm_phase(PG8_LAS unsigned char* lds, const Gemm g, const Sched& S, const Epi& E) {
    int tid = threadIdx.x; asm volatile("" : "+v"(tid));
    const int wid = __builtin_amdgcn_readfirstlane(tid >> 6), lane = tid & 63, wr = wid >> 2, wc = wid & 3, fr = lane & 15, fq = lane >> 4;
    const int K = g.K, nt = K / BK;
    unsigned voffA[2], voffB[2];
#pragma unroll
    for (int i = 0; i < 2; ++i) { int R, C; stage_rc(tid * 16 + i * 8192, R, C); const int Rb = Epi::PERM ? ((R & ~31) + perm32(R & 31)) : R;
        voffA[i] = (unsigned)(R * K + C) * 2u; voffB[i] = (unsigned)(Rb * K + C) * 2u; }
    const size_t kstep = (size_t)(BK * 2);
    const size_t hstep = (size_t)HALF * K * 2;
    const size_t tstep = 2 * hstep;
    const unsigned ldsw = (unsigned)wid * 1024u;
    const int aoff = lds_byte(wr * 64 + fr, fq * 8), boff = lds_byte(wc * 32 + fr, fq * 8);
#define PG8_SA(b, h) (((b) * 2 + (h)) * HTB)
#define PG8_SB(b, h) ((4 + (b) * 2 + (h)) * HTB)
#define PG8_STAGE(bufoff, gbase, voff) do { _Pragma("unroll") for (int _i = 0; _i < 2; ++_i) \
        __builtin_amdgcn_global_load_lds((const unsigned*)((const char*)(gbase) + (voff)[_i]), (PG8_LAS unsigned*)(lds + (bufoff) + ldsw + _i * 8192), 16, 0, 0); } while (0)
#define PG8_LDA(dst, b, h) do { _Pragma("unroll") for (int m = 0; m < 4; ++m) _Pragma("unroll") for (int k = 0; k < 2; ++k) dst[m][k] = *(const PG8_LAS bf16x8*)(lds + PG8_SA(b, h) + aoff + m * 2048 + k * 1024); } while (0)
#define PG8_LDB(dst, b, h) do { _Pragma("unroll") for (int n = 0; n < 2; ++n) _Pragma("unroll") for (int k = 0; k < 2; ++k) dst[n][k] = *(const PG8_LAS bf16x8*)(lds + PG8_SB(b, h) + boff + n * 2048 + k * 1024); } while (0)
#define PG8_MMA(ai, bj, At, Bt) do { __builtin_amdgcn_s_setprio(1); _Pragma("unroll") for (int m = 0; m < 4; ++m) _Pragma("unroll") for (int n = 0; n < 2; ++n) _Pragma("unroll") for (int k = 0; k < 2; ++k) \
        acc[ai][bj][m][n] = __builtin_amdgcn_mfma_f32_16x16x32_bf16(Bt[n][k], At[m][k], acc[ai][bj][m][n], 0, 0, 0); __builtin_amdgcn_s_setprio(0); } while (0)
#define PG8_WAIT_V(n) asm volatile("s_waitcnt vmcnt(" #n ")" ::: "memory")
#define PG8_WAIT_L(n) asm volatile("s_waitcnt lgkmcnt(" #n ")" ::: "memory")
#define PG8_BAR __builtin_amdgcn_s_barrier()
#define PG8_SCHED __builtin_amdgcn_sched_barrier(0)
    Unit cur, nxt; int ui = 0;
    if (!S.next(0, cur)) return;
    f32x4 acc[2][2][4][2];
#pragma unroll
    for (int a = 0; a < 2; ++a)
#pragma unroll
        for (int b = 0; b < 2; ++b)
#pragma unroll
            for (int m = 0; m < 4; ++m)
#pragma unroll
                for (int n = 0; n < 2; ++n) acc[a][b][m][n] = (f32x4){0.f, 0.f, 0.f, 0.f};
    bf16x8 At[4][2], B0[2][2], B1[2][2];
    const char* cA = (const char*)g.A + (size_t)cur.pm * tstep; const char* cB = (const char*)g.Bt + (size_t)cur.pn * tstep;
    S.a_ready(cur);
    if constexpr (SP2) {
        PG8_STAGE(PG8_SB(0, 0), cB, voffB); PG8_STAGE(PG8_SB(0, 1), cB + hstep, voffB); PG8_STAGE(PG8_SA(0, 0), cA, voffA); PG8_STAGE(PG8_SA(0, 1), cA + hstep, voffA);
        if (wr == 1) PG8_BAR;
        PG8_WAIT_V(2); PG8_BAR;
        PG8_STAGE(PG8_SB(1, 0), cB + kstep, voffB); PG8_STAGE(PG8_SA(1, 0), cA + kstep, voffA); PG8_STAGE(PG8_SB(1, 1), cB + hstep + kstep, voffB);
        PG8_WAIT_V(6); PG8_BAR;
    } else {
        PG8_STAGE(PG8_SB(0, 0), cB, voffB); PG8_STAGE(PG8_SA(0, 0), cA, voffA); PG8_STAGE(PG8_SB(0, 1), cB + hstep, voffB); PG8_STAGE(PG8_SA(0, 1), cA + hstep, voffA);
        if (wr == 1) PG8_BAR;
        PG8_WAIT_V(4); PG8_BAR;
        PG8_STAGE(PG8_SB(1, 0), cB + kstep, voffB); PG8_STAGE(PG8_SA(1, 0), cA + kstep, voffA); PG8_STAGE(PG8_SB(1, 1), cB + hstep + kstep, voffB);
        PG8_WAIT_V(6); PG8_BAR;
    }
    for (;;) {
        const bool has_next = S.next(ui + 1, nxt);
        const char* nA = has_next ? (const char*)g.A + (size_t)nxt.pm * tstep : cA; const char* nB = has_next ? (const char*)g.Bt + (size_t)nxt.pn * tstep : cB;
        for (int t = 0; t < nt; t += 2) {
            const bool last = (t == nt - 2);
            const char* a1 = cA + (size_t)(t + 1) * kstep;
            const char* a2 = last ? nA : cA + (size_t)(t + 2) * kstep; const char* b2 = last ? nB : cB + (size_t)(t + 2) * kstep;
            const char* a3 = a2 + kstep; const char* b3 = b2 + kstep;
            if (last && has_next) S.a_ready(nxt);
            if constexpr (SP2) {
            PG8_LDB(B0, 0, 0); PG8_LDB(B1, 0, 1); PG8_SCHED; PG8_LDA(At, 0, 0); PG8_STAGE(PG8_SA(1, 1), a1 + hstep, voffA);
            PG8_WAIT_V(8); PG8_WAIT_L(0); PG8_BAR; PG8_MMA(0, 0, At, B0); PG8_MMA(0, 1, At, B1); PG8_BAR; PG8_SCHED;
            PG8_LDA(At, 0, 1); PG8_STAGE(PG8_SB(0, 0), b2, voffB); PG8_STAGE(PG8_SB(0, 1), b2 + hstep, voffB); PG8_STAGE(PG8_SA(0, 0), a2, voffA);
            PG8_WAIT_V(8); PG8_WAIT_L(0); PG8_BAR; PG8_MMA(1, 0, At, B0); PG8_MMA(1, 1, At, B1); PG8_BAR; PG8_SCHED;
            PG8_LDB(B0, 1, 0); PG8_LDB(B1, 1, 1); PG8_SCHED; PG8_LDA(At, 1, 0); PG8_STAGE(PG8_SA(0, 1), a2 + hstep, voffA);
            PG8_WAIT_V(8); PG8_WAIT_L(0); PG8_BAR; PG8_MMA(0, 0, At, B0); PG8_MMA(0, 1, At, B1); PG8_BAR; PG8_SCHED;
            PG8_LDA(At, 1, 1); PG8_STAGE(PG8_SB(1, 0), b3, voffB); PG8_STAGE(PG8_SB(1, 1), b3 + hstep, voffB); PG8_STAGE(PG8_SA(1, 0), a3, voffA);
            PG8_WAIT_V(8); PG8_WAIT_L(0); PG8_BAR; PG8_MMA(1, 0, At, B0); PG8_MMA(1, 1, At, B1); PG8_BAR; PG8_SCHED;
            } else {
            PG8_LDB(B0, 0, 0); PG8_SCHED; PG8_LDA(At, 0, 0); PG8_STAGE(PG8_SA(1, 1), a1 + hstep, voffA);
            PG8_WAIT_L(8); PG8_BAR; PG8_WAIT_L(0); PG8_MMA(0, 0, At, B0); PG8_BAR; PG8_SCHED;
            PG8_LDB(B1, 0, 1); PG8_STAGE(PG8_SB(0, 0), b2, voffB);
            PG8_BAR; PG8_WAIT_L(0); PG8_MMA(0, 1, At, B1); PG8_BAR;
            PG8_LDA(At, 0, 1); PG8_STAGE(PG8_SA(0, 0), a2, voffA);
            PG8_BAR; PG8_WAIT_L(0); PG8_MMA(1, 0, At, B0); PG8_BAR; PG8_SCHED;
            PG8_STAGE(PG8_SB(0, 1), b2 + hstep, voffB);
            PG8_WAIT_V(6); PG8_BAR; PG8_MMA(1, 1, At, B1); PG8_BAR;
            PG8_LDB(B0, 1, 0); PG8_SCHED; PG8_LDA(At, 1, 0); PG8_STAGE(PG8_SA(0, 1), a2 + hstep, voffA);
            PG8_WAIT_L(8); PG8_BAR; PG8_WAIT_L(0); PG8_MMA(0, 0, At, B0); PG8_BAR; PG8_SCHED;
            PG8_LDB(B1, 1, 1); PG8_STAGE(PG8_SB(1, 0), b3, voffB);
            PG8_BAR; PG8_WAIT_L(0); PG8_MMA(0, 1, At, B1); PG8_BAR;
            PG8_LDA(At, 1, 1); PG8_STAGE(PG8_SA(1, 0), a3, voffA);
            PG8_BAR; PG8_WAIT_L(0); PG8_MMA(1, 0, At, B0); PG8_BAR; PG8_SCHED;
            PG8_STAGE(PG8_SB(1, 1), b3 + hstep, voffB);
            PG8_WAIT_V(6); PG8_BAR; PG8_MMA(1, 1, At, B1); PG8_BAR;
            }
        }
        if constexpr (ALIGN_EPI) { if (wr == 0) PG8_BAR; }
        if constexpr (!Epi::AFTER_DRAIN) { E(acc, cur, wr, wc, fr, fq); S.done(cur); }
        if (!has_next) break;
#pragma unroll
        for (int a = 0; a < 2; ++a)
#pragma unroll
            for (int b = 0; b < 2; ++b)
#pragma unroll
                for (int m = 0; m < 4; ++m)
#pragma unroll
                    for (int n = 0; n < 2; ++n) acc[a][b][m][n] = (f32x4){0.f, 0.f, 0.f, 0.f};
        cur = nxt; cA = nA; cB = nB; ++ui;
        if constexpr (ALIGN_EPI) { if (wr == 1) PG8_BAR; }
    }
    PG8_WAIT_V(0);
    if constexpr (!ALIGN_EPI) { if (wr == 0) PG8_BAR; }
    PG8_BAR;
    if constexpr (Epi::AFTER_DRAIN) { E.fused(acc, cur, wr, wc, fr, fq, lds, wid, lane); S.done(cur); }
#undef PG8_SA
#undef PG8_SB
#undef PG8_STAGE
#undef PG8_LDA
#undef PG8_LDB
#undef PG8_MMA
#undef PG8_WAIT_V
#undef PG8_WAIT_L
#undef PG8_BAR
#undef PG8_SCHED
}
}

constexpr size_t WS_QDC  = WS_RS;
constexpr size_t WS_SEGS = WS_RS + 32 * MB;
constexpr size_t WS_GSEG = WS_RS + 48 * MB;
constexpr size_t WS_SC   = WS_RS + 49 * MB;
DI void lds_barrier() { asm volatile("s_waitcnt lgkmcnt(0)" ::: "memory"); __builtin_amdgcn_s_barrier(); asm volatile("" ::: "memory"); }
DI float logsig(float x) { return fminf(x, 0.f) - __logf(1.f + __expf(-fabsf(x))); }

template <int DIR>
DI void ga_task(const Params& p, LAS unsigned char* lds, int tid, int lane, int wave, int task) {
    asm volatile("" : "+v"(tid), "+v"(lane));
    unsigned char* ws = p.ws;
    const bf16_t* Z = (const bf16_t*)(ws + WS_RZ);
    const float* AFB = (const float*)(ws + WS_AFB);
    LAS float* la = (LAS float*)lds;
    LAS float* part = (LAS float*)(lds + 17408);
    LAS float* gs = (LAS float*)(lds + 18432);
    LAS float* elb = (LAS float*)(lds + 18944);
    LAS float* wl = (LAS float*)(lds + 19968);
    LAS bf16_t* sL  = (LAS bf16_t*)(lds + 24064);
    LAS unsigned char* obuf = lds + 42496;
    const int c15 = lane & 15, g = lane >> 4;
    const int i = tid >> 3, dg = tid & 7, d0 = dg * 8;
#define TROW(r) ((r) * 72 + ((r) >> 3) * 8)
    constexpr int dir = DIR; const int h = (task >> 1) & 3, pb = (task >> 3) & 7, b = task >> 6;
    const int bhd = b * 8 + h * 2 + dir, sg = dir ? 7 - pb : pb;
    bf16_t* QDC = (bf16_t*)(ws + WS_QDC + (dir ? 16 : 0) * MB);
    bf16_t* OL = (bf16_t*)(ws + WS_RO + (dir ? 64 : 0) * MB);
    f32x4 S[4];
#pragma unroll
    for (int kt = 0; kt < 4; ++kt) S[kt] = (f32x4){0.f, 0.f, 0.f, 0.f};
    __syncthreads();
    for (int e = tid; e < 128 * 72 / 2; e += NTH) ((LAS unsigned*)sL)[e] = 0u;
    if (tid < 64) gs[tid] = 0.f;
    for (int e = tid; e < 1024; e += NTH) wl[e] = (dir ? p.in[9] : p.in[7])[(e >> 6) * 256 + h * 64 + (e & 63)];
    typedef short s16x4w __attribute__((ext_vector_type(4)));
    s16x4w wfr[2]; float bias[2];
    __syncthreads();
#pragma unroll
    for (int u = 0; u < 2; ++u) {
        const int d = 16 * (2 * (wave >> 2) + u) + c15;
        const u32x2 wp = {pk2(wl[(4 * g) * 64 + d], wl[(4 * g + 1) * 64 + d]), pk2(wl[(4 * g + 2) * 64 + d], wl[(4 * g + 3) * 64 + d])};
        wfr[u] = __builtin_bit_cast(s16x4w, wp);
        bias[u] = (dir ? p.in[10] : p.in[8])[h * 64 + d];
    }
    const int mt = wave & 3;
    f32x4 avn;
    { const int n0 = dir ? pb * 8 + 7 : pb * 8; avn = *(const f32x4*)(AFB + ((size_t)b * SEQ + n0 * 64 + 16 * mt + c15) * 32 + dir * 16 + 4 * g); }
#pragma unroll 1
    for (int ci = -1; ci < 8; ++ci) {
        const bool has_cur = ci >= 0, has_nxt = ci < 7;
        const int cx = ci + 1;
        const int nx = dir ? pb * 8 + 7 - cx : pb * 8 + cx, tokx = b * SEQ + nx * 64;
        const int nc = dir ? pb * 8 + 7 - ci : pb * 8 + ci, tokc = b * SEQ + nc * 64;
        LAS unsigned char* bx = obuf + (cx & 1) * 46464; LAS unsigned char* bc = obuf + (ci & 1) * 46464;
        LAS float* elx = elb + (cx & 1) * 128; LAS float* elc = elb + (ci & 1) * 128;
        u32x4 qv, kv, vvp[2]; float lv[2][4];
        if (ci > 0) {
#pragma unroll
            for (int kt = 0; kt < 4; ++kt) { const u32x2 w = {pk2(S[kt][0], S[kt][1]), pk2(S[kt][2], S[kt][3])}; *(LAS u32x2*)(sL + (16 * wave + c15) * 72 + 16 * kt + 4 * g) = w; }
        }
        if (has_nxt) {
            const size_t t = (size_t)tokx + i;
            qv = *(const u32x4*)(Z + t * ZW + h * 64 + d0); kv = *(const u32x4*)(Z + t * ZW + 256 + h * 64 + d0);
#pragma unroll
            for (int ps = 0; ps < 2; ++ps) { const int idx = tid + NTH * ps, vi = idx >> 4, ch = idx & 15; vvp[ps] = *(const u32x4*)(Z + ((size_t)tokx + vi) * ZW + 512 + h * 128 + ch * 8); }
            typedef short s16x4v __attribute__((ext_vector_type(4)));
            const u32x2 ap = {pk2(avn[0], avn[1]), pk2(avn[2], avn[3])};
            const s16x4v af = __builtin_bit_cast(s16x4v, ap);
            { const int c2 = cx < 7 ? cx + 1 : cx, n2 = dir ? pb * 8 + 7 - c2 : pb * 8 + c2; avn = *(const f32x4*)(AFB + ((size_t)b * SEQ + n2 * 64 + 16 * mt + c15) * 32 + dir * 16 + 4 * g); }
#pragma unroll
            for (int u = 0; u < 2; ++u) {
                const int d = 16 * (2 * (wave >> 2) + u) + c15;
                const f32x4 x = __builtin_amdgcn_mfma_f32_16x16x16bf16_1k(af, wfr[u], (f32x4){0.f, 0.f, 0.f, 0.f}, 0, 0, 0);
                float v0 = logsig(x[0] + bias[u]) * 0.0625f, v1 = logsig(x[1] + bias[u]) * 0.0625f, v2 = logsig(x[2] + bias[u]) * 0.0625f, v3 = logsig(x[3] + bias[u]) * 0.0625f;
                float T, T2, T3;
                if (dir == 0) {
                    v1 += v0; v2 += v1; v3 += v2; T = v3;
                    const float t1 = __shfl_up(T, 16); T2 = T + (g >= 1 ? t1 : 0.f);
                    const float t2 = __shfl_up(T2, 32); T3 = T2 + (g >= 2 ? t2 : 0.f);
                    if (g == 3) part[mt * 64 + d] = T3;
                } else {
                    v2 += v3; v1 += v2; v0 += v1; T = v0;
                    const float t1 = __shfl_down(T, 16); T2 = T + (g <= 2 ? t1 : 0.f);
                    const float t2 = __shfl_down(T2, 32); T3 = T2 + (g <= 1 ? t2 : 0.f);
                    if (g == 0) part[mt * 64 + d] = T3;
                }
                const float off = T3 - T;
                lv[u][0] = v0 + off; lv[u][1] = v1 + off; lv[u][2] = v2 + off; lv[u][3] = v3 + off;
            }
        }
        lds_barrier();
        if (has_nxt) {
#pragma unroll
            for (int u = 0; u < 2; ++u) {
                const int d = 16 * (2 * (wave >> 2) + u) + c15;
                float off = 0.f;
#pragma unroll
                for (int m2 = 0; m2 < 4; ++m2) { const bool take = dir ? (m2 > mt) : (m2 < mt); off += take ? part[m2 * 64 + d] : 0.f; }
#pragma unroll
                for (int r = 0; r < 4; ++r) la[(16 * mt + 4 * g + r) * 68 + d] = lv[u][r] + off;
                if (mt == (dir ? 0 : 3) && g == (dir ? 0 : 3)) {
                    const float tot = lv[u][dir ? 0 : 3] + off, gsum = gs[(cx & 1) * 64 + d];
                    elx[d] = __expf(tot); elx[64 + d] = __expf(gsum); gs[((cx + 1) & 1) * 64 + d] = gsum + tot;
                }
            }
        }
        lds_barrier();
        if (has_nxt) {
            LAS bf16_t* qdL = (LAS bf16_t*)bx; LAS bf16_t* kiL = (LAS bf16_t*)(bx + 9216); LAS bf16_t* keT = (LAS bf16_t*)(bx + 18432); LAS bf16_t* vT = (LAS bf16_t*)(bx + 27776);
            const size_t t = (size_t)tokx + i;
            float q[8], k[8];
#pragma unroll
            for (int e = 0; e < 4; ++e) { q[2 * e] = bflo(qv[e]); q[2 * e + 1] = bfhi(qv[e]); k[2 * e] = bflo(kv[e]); k[2 * e + 1] = bfhi(kv[e]); }
            float qd[8], ki[8], ke[8], qc[8];
#pragma unroll
            for (int e = 0; e < 8; ++e) {
                const float E = __expf(la[i * 68 + d0 + e]), R = __builtin_amdgcn_rcpf(E);
                qd[e] = q[e] * E; ki[e] = k[e] * R; ke[e] = ki[e] * elx[d0 + e]; qc[e] = qd[e] * elx[64 + d0 + e];
            }
            const u32x4 o1 = {pk2(qd[0], qd[1]), pk2(qd[2], qd[3]), pk2(qd[4], qd[5]), pk2(qd[6], qd[7])};
            const u32x4 o2 = {pk2(ki[0], ki[1]), pk2(ki[2], ki[3]), pk2(ki[4], ki[5]), pk2(ki[6], ki[7])};
            const u32x4 o3 = {pk2(qc[0], qc[1]), pk2(qc[2], qc[3]), pk2(qc[4], qc[5]), pk2(qc[6], qc[7])};
            *(LAS u32x4*)(qdL + i * 72 + d0) = o1; *(LAS u32x4*)(kiL + i * 72 + d0) = o2;
            *(u32x4*)(QDC + t * 256 + h * 64 + d0) = o3;
#pragma unroll
            for (int e = 0; e < 4; ++e) { const unsigned w = pk2(ke[2 * e], ke[2 * e + 1]); keT[TROW(d0 + 2 * e) + perm32(i)] = (bf16_t)(w & 0xFFFFu); keT[TROW(d0 + 2 * e + 1) + perm32(i)] = (bf16_t)(w >> 16); }
#pragma unroll
            for (int ps = 0; ps < 2; ++ps) {
                const int idx = tid + NTH * ps, vi = idx >> 4, ch = idx & 15;
#pragma unroll
                for (int e = 0; e < 4; ++e) { vT[TROW(ch * 8 + 2 * e) + perm32(vi)] = (bf16_t)(vvp[ps][e] & 0xFFFFu); vT[TROW(ch * 8 + 2 * e + 1) + perm32(vi)] = (bf16_t)(vvp[ps][e] >> 16); }
            }
        }
        if (has_cur) {
            const LAS bf16_t* qdL = (const LAS bf16_t*)bc; const LAS bf16_t* kiL = (const LAS bf16_t*)(bc + 9216); const LAS bf16_t* keT = (const LAS bf16_t*)(bc + 18432); const LAS bf16_t* vT = (const LAS bf16_t*)(bc + 27776);
            const int it = wave & 3, dvh = wave >> 2;
            bf16x8 qdb[2];
#pragma unroll
            for (int s = 0; s < 2; ++s) qdb[s] = *(const LAS bf16x8*)(qdL + (16 * it + c15) * 72 + 32 * s + 8 * g);
            f32x4 sc[4];
#pragma unroll
            for (int jt = 0; jt < 4; ++jt) {
                sc[jt] = (f32x4){0.f, 0.f, 0.f, 0.f};
#pragma unroll
                for (int s = 0; s < 2; ++s) sc[jt] = MFMA16(*(const LAS bf16x8*)(kiL + (16 * jt + c15) * 72 + 32 * s + 8 * g), qdb[s], sc[jt]);
                const int ii = 16 * it + c15;
#pragma unroll
                for (int r = 0; r < 4; ++r) { const int jj = 16 * jt + 4 * g + r; const bool keep = dir ? (jj > ii) : (jj <= ii); sc[jt][r] = keep ? sc[jt][r] : 0.f; }
            }
            const bf16x8 pa[2] = {pack8(sc[0], sc[1]), pack8(sc[2], sc[3])};
#pragma unroll
            for (int nt = 0; nt < 4; ++nt) {
                const int dvr = 64 * dvh + 16 * nt + c15;
                f32x4 o = (f32x4){0.f, 0.f, 0.f, 0.f};
#pragma unroll
                for (int s = 0; s < 2; ++s) {
                    o = MFMA16(*(const LAS bf16x8*)(vT + TROW(dvr) + 32 * s + 8 * g), pa[s], o);
                    o = MFMA16(*(const LAS bf16x8*)(sL + dvr * 72 + 32 * s + 8 * g), qdb[s], o);
                }
                const u32x2 w = {pk2(o[0], o[1]), pk2(o[2], o[3])};
                *(u32x2*)(OL + ((size_t)tokc + 16 * it + c15) * 512 + h * 128 + 64 * dvh + 16 * nt + 4 * g) = w;
            }
            bf16x8 vb[2];
#pragma unroll
            for (int s = 0; s < 2; ++s) vb[s] = *(const LAS bf16x8*)(vT + TROW(16 * wave + c15) + 32 * s + 8 * g);
#pragma unroll
            for (int kt = 0; kt < 4; ++kt) {
                const f32x4 gm = *(const LAS f32x4*)(elc + 16 * kt + 4 * g);
                f32x4 a = S[kt] * gm;
#pragma unroll
                for (int s = 0; s < 2; ++s) a = MFMA16(*(const LAS bf16x8*)(keT + TROW(16 * kt + c15) + 32 * s + 8 * g), vb[s], a);
                S[kt] = a;
            }
        }
        lds_barrier();
    }
    {
        float* SEGS = (float*)(ws + WS_SEGS) + (size_t)(bhd * 8 + sg) * 64 * 128;
#pragma unroll
        for (int kt = 0; kt < 4; ++kt)
#pragma unroll
            for (int r = 0; r < 4; ++r) SEGS[(16 * kt + 4 * g + r) * 128 + 16 * wave + c15] = S[kt][r];
        if (tid < 64) ((float*)(ws + WS_GSEG))[(bhd * 8 + sg) * 64 + tid] = __expf(gs[tid]);
    }
}
#undef TROW

DI void phaseGA(const Params& p, LAS unsigned char* lds, int tid, int lane, int wave) {
    for (int task = blockIdx.x; task < 512; task += gridDim.x) { if (task & 1) ga_task<1>(p, lds, tid, lane, wave, task); else ga_task<0>(p, lds, tid, lane, wave, task); }
}

DI void phaseGB(const Params& p, int tid) {
    unsigned char* ws = p.ws;
    const float* SEGS = (const float*)(ws + WS_SEGS); const float* GSEG = (const float*)(ws + WS_GSEG); bf16_t* SC = (bf16_t*)(ws + WS_SC);
    for (int e = blockIdx.x * NTH + tid; e < 64 * 128 * 16; e += gridDim.x * NTH) {
        const int dv = e & 127, dk4 = (e >> 7) & 15, bhd = e >> 11;
        float c[4] = {0.f, 0.f, 0.f, 0.f};
        for (int sg = 0; sg < 8; ++sg) {
            const u32x2 w = {pk2(c[0], c[1]), pk2(c[2], c[3])};
            *(u32x2*)(SC + ((size_t)(bhd * 8 + sg) * 128 + dv) * 64 + 4 * dk4) = w;
            const f32x4 gm = *(const f32x4*)(GSEG + (bhd * 8 + sg) * 64 + 4 * dk4);
#pragma unroll
            for (int r = 0; r < 4; ++r) c[r] = gm[r] * c[r] + SEGS[((size_t)(bhd * 8 + sg) * 64 + 4 * dk4 + r) * 128 + dv];
        }
    }
}

DI void phase4a(const Params& p, LAS unsigned char* lds, int tid, int lane, int wave) {
    asm volatile("" : "+v"(tid), "+v"(lane));
    unsigned char* ws = p.ws;
    const bf16_t* Z = (const bf16_t*)(ws + WS_RZ);
    bf16_t* MIX = (bf16_t*)(ws + WS_RA);
    const bf16_t* OF = (const bf16_t*)(ws + WS_RO); const bf16_t* OB = (const bf16_t*)(ws + WS_RO + 64 * MB);
    const bf16_t* WP = (const bf16_t*)(ws + WS_WP);
    LAS bf16_t* pt = (LAS bf16_t*)lds;
    LAS unsigned char* at = lds + 81920;
    const int c15 = lane & 15, g = lane >> 4;
    for (int tile = blockIdx.x; tile < T / 64; tile += gridDim.x) {
        const int tok0 = tile * 64, s0 = tok0 & (SEQ - 1);
        __syncthreads();
        {
            u32x4 pv[10];
#pragma unroll
            for (int ps = 0; ps < 10; ++ps) {
                const int idx = tid + NTH * ps, rr = idx >> 6, ch = idx & 63, sq = s0 - 8 + rr;
                const int ro = (sq >= 0 && sq < SEQ) ? rr - 8 : 0;
                pv[ps] = *(const u32x4*)(Z + (size_t)(tok0 + ro) * ZW + 1536 + ch * 8);
            }
#pragma unroll
            for (int ps = 0; ps < 10; ++ps) {
                const int idx = tid + NTH * ps, rr = idx >> 6, ch = idx & 63, sq = s0 - 8 + rr;
                u32x4 v = pv[ps];
                if (!(sq >= 0 && sq < SEQ)) v = (u32x4){0u, 0u, 0u, 0u};
                *(LAS u32x4*)(pt + rr * 512 + ch * 8) = v;
            }
        }
        {
            const int hh = wave >> 1, ih = wave & 1, bb = tok0 / SEQ, nn = s0 >> 6;
            f32x4 acc[8][2];
#pragma unroll
            for (int mt = 0; mt < 8; ++mt) { acc[mt][0] = (f32x4){0.f, 0.f, 0.f, 0.f}; acc[mt][1] = (f32x4){0.f, 0.f, 0.f, 0.f}; }
#pragma unroll
            for (int dir = 0; dir < 2; ++dir) {
                const int sg = dir ? 7 - (nn >> 3) : (nn >> 3), bhd = bb * 8 + hh * 2 + dir;
                const bf16_t* SCp = (const bf16_t*)(ws + WS_SC) + (size_t)(bhd * 8 + sg) * 128 * 64;
                const bf16_t* QCp = (const bf16_t*)(ws + WS_QDC + (dir ? 16 : 0) * MB) + ((size_t)tok0 + 32 * ih) * 256 + hh * 64;
                if (sg != 0)
#pragma unroll
                for (int s = 0; s < 2; ++s) {
                    const bf16x8 q0 = ld_frag16(QCp + (size_t)c15 * 256 + 32 * s + 8 * g), q1 = ld_frag16(QCp + (size_t)(16 + c15) * 256 + 32 * s + 8 * g);
#pragma unroll
                    for (int mt = 0; mt < 8; ++mt) {
                        const bf16x8 af = ld_frag16(SCp + (16 * mt + c15) * 64 + 32 * s + 8 * g);
                        acc[mt][0] = MFMA16(af, q0, acc[mt][0]); acc[mt][1] = MFMA16(af, q1, acc[mt][1]);
                    }
                }
            }
#pragma unroll
            for (int nt = 0; nt < 2; ++nt)
#pragma unroll
                for (int mt = 0; mt < 8; ++mt) { const f32x4 o = acc[mt][nt]; const u32x2 w = {pk2(o[0], o[1]), pk2(o[2], o[3])};
                    *(LAS u32x2*)(at + (32 * ih + 16 * nt + c15) * 1040 + (hh * 128 + 16 * mt + 4 * g) * 2) = w; }
        }
        __syncthreads();
        {
            const f32x4 gh0 = *(const f32x4*)(p.in[11] + 8 * lane), gh1 = *(const f32x4*)(p.in[11] + 8 * lane + 4);
#pragma unroll
            for (int hb = 0; hb < 2; ++hb) {
                u32x4 a[4], bq[4], rv[4], cv[4];
#pragma unroll
                for (int j = 0; j < 4; ++j) { const int tl = wave * 8 + hb * 4 + j; const size_t t = (size_t)tok0 + tl;
                    a[j] = *(const u32x4*)(OF + t * 512 + 8 * lane); bq[j] = *(const u32x4*)(OB + t * 512 + 8 * lane); rv[j] = *(const u32x4*)(Z + t * ZW + 1024 + 8 * lane);
                    cv[j] = *(const LAS u32x4*)(at + tl * 1040 + 16 * lane); }
#pragma unroll
                for (int j = 0; j < 4; ++j) { const size_t t = (size_t)tok0 + wave * 8 + hb * 4 + j;
                    float o[8], r[8];
#pragma unroll
                    for (int e = 0; e < 4; ++e) { o[2 * e] = bflo(a[j][e]) + bflo(bq[j][e]) + bflo(cv[j][e]); o[2 * e + 1] = bfhi(a[j][e]) + bfhi(bq[j][e]) + bfhi(cv[j][e]); r[2 * e] = bflo(rv[j][e]); r[2 * e + 1] = bfhi(rv[j][e]); }
                    float ss = 0.f;
#pragma unroll
                    for (int e = 0; e < 8; ++e) ss += o[e] * o[e];
                    ss += __shfl_xor(ss, 1); ss += __shfl_xor(ss, 2); ss += __shfl_xor(ss, 4); ss += __shfl_xor(ss, 8);
                    const float rstd = rsqrtf(ss * (1.f / 128.f) + EPS);
                    float y[8];
#pragma unroll
                    for (int e = 0; e < 8; ++e) { const float gg = e < 4 ? gh0[e] : gh1[e - 4]; y[e] = o[e] * rstd * gg * (r[e] / (1.f + __expf(-r[e]))); }
                    const u32x4 w = {pk2(y[0], y[1]), pk2(y[2], y[3]), pk2(y[4], y[5]), pk2(y[6], y[7])};
                    *(u32x4*)(MIX + t * D + 8 * lane) = w; }
            }
        }
        __syncthreads();
        {
            const int c = tid, gi = c >> 7, cc = c & 127, hw = 1 << gi;
            LAS unsigned char* ag = at + gi * 16384;
            const LAS bf16_t* pc = pt + c;
            if (s0 >= 8 && s0 + 64 + 8 <= SEQ) {
                const float inv = 0.5f / (float)hw;
                float sum = 0.f;
                for (int rr = 8 - hw; rr < 8 + hw; ++rr) sum += bflo((unsigned)pc[rr * 512]);
#pragma unroll 4
                for (int i = 0; i < 64; ++i) {
                    const float val = sum * inv - bflo((unsigned)pc[(i + 8) * 512]);
                    *(LAS bf16_t*)(ag + i * 256 + (((cc >> 3) ^ (i & 15)) * 16) + (cc & 7) * 2) = (bf16_t)(pk2(val, 0.f) & 0xFFFFu);
                    sum += bflo((unsigned)pc[(i + 8 + hw) * 512]) - bflo((unsigned)pc[(i + 8 - hw) * 512]);
                }
            } else {
                float sum = 0.f;
                {   const int lo = max(s0 - hw, 0), hi = min(s0 + hw, SEQ);
                    for (int rr = lo; rr < hi; ++rr) sum += bflo((unsigned)pc[(rr - s0 + 8) * 512]); }
#pragma unroll 4
                for (int i = 0; i < 64; ++i) {
                    const int sq = s0 + i, lo = max(sq - hw, 0), hi = min(sq + hw, SEQ);
                    const float val = sum * __builtin_amdgcn_rcpf((float)(hi - lo)) - bflo((unsigned)pc[(i + 8) * 512]);
                    *(LAS bf16_t*)(ag + i * 256 + (((cc >> 3) ^ (i & 15)) * 16) + (cc & 7) * 2) = (bf16_t)(pk2(val, 0.f) & 0xFFFFu);
                    if (sq + hw < SEQ) sum += bflo((unsigned)pc[(i + 8 + hw) * 512]);
                    if (sq - hw >= 0) sum -= bflo((unsigned)pc[(i + 8 - hw) * 512]);
                }
            }
        }
        __syncthreads();
        {
            const int gi = wave >> 1, dh = wave & 1;
            LAS unsigned char* ag = at + gi * 16384;
            f32x4 psv[4];
#pragma unroll
            for (int nt = 0; nt < 4; ++nt) psv[nt] = *(const f32x4*)(p.in[13] + gi * 128 + dh * 64 + 16 * nt + 4 * g);
            f32x4 acc[4][4];
#pragma unroll
            for (int mt = 0; mt < 4; ++mt)
#pragma unroll
                for (int nt = 0; nt < 4; ++nt) acc[mt][nt] = (f32x4){0.f, 0.f, 0.f, 0.f};
#pragma unroll
            for (int s = 0; s < 4; ++s) {
                bf16x8 af[4];
#pragma unroll
                for (int mt = 0; mt < 4; ++mt) { const int row = mt * 16 + c15; af[mt] = *(const LAS bf16x8*)(ag + row * 256 + (((4 * s + g) ^ (row & 15)) * 16)); }
#pragma unroll
                for (int nt = 0; nt < 4; ++nt) {
                    const bf16x8 wf = ld_frag16(WP + (size_t)gi * 16384 + (dh * 64 + 16 * nt + c15) * 128 + 32 * s + 8 * g);
#pragma unroll
                    for (int mt = 0; mt < 4; ++mt) acc[mt][nt] = MFMA16(wf, af[mt], acc[mt][nt]);
                }
            }
#pragma unroll
            for (int nt = 0; nt < 4; ++nt) {
                const f32x4 ps = psv[nt];
#pragma unroll
                for (int mt = 0; mt < 4; ++mt) {
                    const f32x4 v = acc[mt][nt] * ps;
                    u32x2 w = {pk2(v[0], v[1]), pk2(v[2], v[3])};
                    *(u32x2*)(MIX + ((size_t)tok0 + mt * 16 + c15) * D + 512 + gi * 128 + dh * 64 + 16 * nt + 4 * g) = w;
                }
            }
        }
    }
}

DI void phase4c(const Params& p, LAS unsigned char* lds, int tid, int lane, int wave) {
    asm volatile("" : "+v"(tid), "+v"(lane));
    LAS float* lG = (LAS float*)lds; LAS float* lA = lG + 1024; LAS float* lB = lA + 1024; LAS float* lP = lB + 1024;
    const float* x = p.in[0]; const bf16_t* MIXO = (const bf16_t*)(p.ws + WS_RZ); bf16_t* H2 = (bf16_t*)(p.ws + WS_RA);
    for (int rt = blockIdx.x; rt < T / 128; rt += gridDim.x) {
        const int b = rt / 32;
        __syncthreads();
        for (int d = tid; d < 1024; d += NTH) { lG[d] = mod_at(p, b, 2048 + d); lA[d] = p.in[15][d] * (1.f + mod_at(p, b, 4096 + d)); lB[d] = mod_at(p, b, 3072 + d); lP[d] = p.in[5][d]; }
        __syncthreads();
        for (int r0 = wave; r0 < 128; r0 += 4 * NWV) {
            f32x4 m[4][4], xv[4][4];
#pragma unroll
            for (int u = 0; u < 4; ++u) {
                const size_t row = (size_t)rt * 128 + r0 + u * NWV;
                const u32x2* mr = (const u32x2*)(MIXO + row * D) + lane; const f32x4* xr = (const f32x4*)(x + row * D) + lane;
#pragma unroll
                for (int j = 0; j < 4; ++j) { const u32x2 mv = mr[64 * j]; m[u][j] = (f32x4){bflo(mv.x), bfhi(mv.x), bflo(mv.y), bfhi(mv.y)}; xv[u][j] = xr[64 * j]; }
            }
#pragma unroll
            for (int u = 0; u < 4; ++u) {
                const size_t row = (size_t)rt * 128 + r0 + u * NWV;
                float ss = 0.f;
#pragma unroll
                for (int j = 0; j < 4; ++j) ss += m[u][j][0] * m[u][j][0] + m[u][j][1] * m[u][j][1] + m[u][j][2] * m[u][j][2] + m[u][j][3] * m[u][j][3];
                const float rstd = rsqrtf(wave_sum(ss) * (1.f / D) + EPS);
                float s2 = 0.f;
#pragma unroll
                for (int j = 0; j < 4; ++j) {
                    const f32x4 gt = *(const LAS f32x4*)(lG + 4 * lane + 256 * j), pm = *(const LAS f32x4*)(lP + 4 * lane + 256 * j);
                    xv[u][j] = xv[u][j] + gt * (m[u][j] * rstd * pm);
                    s2 += xv[u][j][0] * xv[u][j][0] + xv[u][j][1] * xv[u][j][1] + xv[u][j][2] * xv[u][j][2] + xv[u][j][3] * xv[u][j][3];
                }
                const float rstd2 = rsqrtf(wave_sum(s2) * (1.f / D) + EPS);
                u32x2* orow = (u32x2*)((bf16_t*)(p.ws + WS_RO) + row * D) + lane; u32x2* hrow = (u32x2*)(H2 + row * D) + lane;
#pragma unroll
                for (int j = 0; j < 4; ++j) {
                    { const u32x2 xw = {pk2(xv[u][j][0], xv[u][j][1]), pk2(xv[u][j][2], xv[u][j][3])}; orow[64 * j] = xw; }
                    const f32x4 a = *(const LAS f32x4*)(lA + 4 * lane + 256 * j), bb = *(const LAS f32x4*)(lB + 4 * lane + 256 * j);
                    const f32x4 hv = xv[u][j] * rstd2 * a + bb;
                    u32x2 w = {pk2(hv[0], hv[1]), pk2(hv[2], hv[3])};
                    hrow[64 * j] = w;
                }
            }
        }
    }
}

DI int skey(float v, int idx, int mask) { int u = __float_as_int(v); u ^= (u >> 31) & 0x7FFFFFFF; return (u & ~mask) | idx; }
DI float sval(int k, int mask) { int u = k & ~mask; u ^= (u >> 31) & 0x7FFFFFFF; return __int_as_float(u); }
DI void cswap(int& a, int& b) { const int mx = max(a, b), mn = min(a, b); a = mx; b = mn; }
DI void sort16_desc(int (&a)[16]) {
    cswap(a[0], a[13]); cswap(a[1], a[12]); cswap(a[2], a[15]); cswap(a[3], a[14]); cswap(a[4], a[8]); cswap(a[5], a[6]); cswap(a[7], a[11]); cswap(a[9], a[10]);
    cswap(a[0], a[5]); cswap(a[1], a[7]); cswap(a[2], a[9]); cswap(a[3], a[4]); cswap(a[6], a[13]); cswap(a[8], a[14]); cswap(a[10], a[15]); cswap(a[11], a[12]);
    cswap(a[0], a[1]); cswap(a[2], a[3]); cswap(a[4], a[5]); cswap(a[6], a[8]); cswap(a[7], a[9]); cswap(a[10], a[11]); cswap(a[12], a[13]); cswap(a[14], a[15]);
    cswap(a[0], a[2]); cswap(a[1], a[3]); cswap(a[4], a[10]); cswap(a[5], a[11]); cswap(a[6], a[7]); cswap(a[8], a[9]); cswap(a[12], a[14]); cswap(a[13], a[15]);
    cswap(a[1], a[2]); cswap(a[3], a[12]); cswap(a[4], a[6]); cswap(a[5], a[7]); cswap(a[8], a[10]); cswap(a[9], a[11]); cswap(a[13], a[14]);
    cswap(a[1], a[4]); cswap(a[2], a[6]); cswap(a[5], a[8]); cswap(a[7], a[10]); cswap(a[9], a[13]); cswap(a[11], a[14]);
    cswap(a[2], a[4]); cswap(a[3], a[6]); cswap(a[9], a[12]); cswap(a[11], a[13]);
    cswap(a[3], a[5]); cswap(a[6], a[8]); cswap(a[7], a[9]); cswap(a[10], a[12]);
    cswap(a[3], a[4]); cswap(a[5], a[6]); cswap(a[7], a[8]); cswap(a[9], a[10]); cswap(a[11], a[12]);
    cswap(a[6], a[7]); cswap(a[8], a[9]);
}
DI void merge16_desc(int (&x)[16], const int (&y)[16]) {
#pragma unroll
    for (int i = 0; i < 16; ++i) x[i] = max(x[i], y[15 - i]);
#pragma unroll
    for (int j = 8; j > 0; j >>= 1) {
#pragma unroll
        for (int i = 0; i < 16; ++i) { const int l = i ^ j; if (l > i) cswap(x[i], x[l]); }
    }
}

DI void phase5b(const Params& p, LAS unsigned char* lds, int tid, int lane, int wave) {
    asm volatile("" : "+v"(tid), "+v"(lane));
    unsigned char* ws = p.ws;
    const bf16_t* Q2 = (const bf16_t*)(ws + WS_RZ);
    const bf16_t* SKB = (const bf16_t*)(ws + WS_SKB);
    int* EIDX = (int*)(ws + WS_RS);
    LAS unsigned char* tab = lds + tid * 32;
    LAS unsigned char* skl = lds + 16384;
    const int c31 = lane & 31, hi = lane >> 5;
    for (int btask = blockIdx.x; btask < 256; btask += gridDim.x) {
        const int h = btask & 7, tgc = btask >> 3;
        __syncthreads();
#pragma unroll
        for (int ps = 0; ps < 8; ++ps) {
            const int idx = tid + NTH * ps, row = idx >> 4, ch = idx & 15;
            const u32x4 v = *(const u32x4*)(SKB + ((size_t)h * 256 + row) * 128 + ch * 8);
            *(LAS u32x4*)(skl + row * 256 + ((ch ^ (row & 15)) * 16)) = v;
        }
        __syncthreads();
      f32x4 qa[4];
      const int qrow0 = (btask * NWV + wave) * 16;
      quant_load(p, qrow0, lane, qa);
      for (int ti = 0; ti < 4; ++ti) {
        const int tg = tgc * 32 + wave * 4 + ti;
        const size_t tok = (size_t)tg * 32 + c31;
        int lst[2][16];
        bf16x8 bq[2][8];
#pragma unroll
        for (int pp = 0; pp < 2; ++pp) {
            const bf16_t* qp = Q2 + tok * 2048 + h * 256 + pp * 128 + 8 * hi;
            asm volatile("" : "+v"(qp));
#pragma unroll
            for (int ks = 0; ks < 8; ++ks) bq[pp][ks] = ld_frag16(qp + 16 * ks);
        }
#pragma unroll
        for (int pp = 0; pp < 2; ++pp) {
            int run[16];
#pragma unroll
            for (int r = 0; r < 16; ++r) run[r] = (int)0x80000000;
#pragma unroll 1
            for (int kt = 0; kt < 4; ++kt) {
                const LAS unsigned char* kb = skl + pp * 32768 + (32 * kt + c31) * 256;
                f32x16 acc;
#pragma unroll
                for (int r = 0; r < 16; ++r) acc[r] = 0.f;
#pragma unroll
                for (int ks = 0; ks < 8; ++ks) acc = MFMA32(*(const LAS bf16x8*)(kb + (((2 * ks + hi) ^ (c31 & 15)) * 16)), bq[pp][ks], acc);
                int cur[16];
#pragma unroll
                for (int r = 0; r < 16; ++r) cur[r] = skey(acc[r], 32 * kt + 8 * (r >> 2) + 4 * hi + (r & 3), 0x7F);
                sort16_desc(cur);
                merge16_desc(run, cur);
                if (kt & 1) { const int qr = ti * 4 + pp * 2 + (kt >> 1); quant_store(p, qrow0 + qr, lane, qa); if (qr < 15) quant_load(p, qrow0 + qr + 1, lane, qa); }
            }
            int oth[16];
#pragma unroll
            for (int r = 0; r < 16; ++r) oth[r] = __shfl_xor(run[r], 32);
            merge16_desc(run, oth);
#pragma unroll
            for (int r = 0; r < 16; ++r) lst[pp][r] = run[r];
        }
#pragma unroll
        for (int pp = 0; pp < 2; ++pp) {
            u32x4 w;
#pragma unroll
            for (int q = 0; q < 4; ++q) w[q] = (lst[pp][4 * q] & 0x7F) | ((lst[pp][4 * q + 1] & 0x7F) << 8) | ((lst[pp][4 * q + 2] & 0x7F) << 16) | ((lst[pp][4 * q + 3] & 0x7F) << 24);
            *(LAS u32x4*)(tab + 16 * pp) = w;
        }
        float va[16], vb[16];
#pragma unroll
        for (int r = 0; r < 16; ++r) { va[r] = sval(lst[0][r], 0x7F); vb[r] = sval(lst[1][r], 0x7F); }
        int cand[4][16];
        {
            int cnt = 0;
#pragma unroll
            for (int i = 0; i < 16; ++i)
#pragma unroll
                for (int j = 0; j < 16; ++j)
                    if ((i + 1) * (j + 1) <= 16) { cand[cnt >> 4][cnt & 15] = skey(va[i] + vb[j], (i << 4) | j, 0xFF); ++cnt; }
#pragma unroll
            for (int q = 50; q < 64; ++q) cand[q >> 4][q & 15] = (int)0x80000000;
        }
        sort16_desc(cand[0]); sort16_desc(cand[1]); sort16_desc(cand[2]); sort16_desc(cand[3]);
        merge16_desc(cand[0], cand[1]); merge16_desc(cand[2], cand[3]); merge16_desc(cand[0], cand[2]);
        asm volatile("s_waitcnt lgkmcnt(0)" ::: "memory");
        float sv[16]; int ex[16];
        const float mx = sval(cand[0][0], 0xFF);
        float sum = 0.f;
#pragma unroll
        for (int r = 0; r < 16; ++r) {
            const int ck = cand[0][r];
            const int i1 = tab[(ck >> 4) & 15], i2 = tab[16 + (ck & 15)];
            ex[r] = i1 * 128 + i2;
            sv[r] = __expf(sval(ck, 0xFF) - mx); sum += sv[r];
        }
        const float inv = 1.f / sum;
        unsigned* ep = (unsigned*)EIDX + tok * 128 + h * 16 + 8 * hi;
        unsigned pe[16];
#pragma unroll
        for (int r = 0; r < 16; ++r) pe[r] = (unsigned)ex[r] | (pk2(sv[r] * inv, 0.f) << 16);
        if (hi == 0) { *(u32x4*)ep = (u32x4){pe[0], pe[1], pe[2], pe[3]}; *(u32x4*)(ep + 4) = (u32x4){pe[4], pe[5], pe[6], pe[7]}; }
        else         { *(u32x4*)ep = (u32x4){pe[8], pe[9], pe[10], pe[11]}; *(u32x4*)(ep + 4) = (u32x4){pe[12], pe[13], pe[14], pe[15]}; }
      }
    }
}

template <int K> DI int swz_bcast(int v) { return __builtin_amdgcn_ds_swizzle(v, 0x10 | (K << 5)); }
template <int W> DI int swz_xor(int v) { return __builtin_amdgcn_ds_swizzle(v, 0x1F | (W << 10)); }
template <int K> struct IC { static constexpr int v = K; };
template <int N, int I = 0, class F> DI void static_for(F&& f) { if constexpr (I < N) { f(IC<I>{}); static_for<N, I + 1>(f); } }
DI float row16_sum(float v) {
    v += __builtin_bit_cast(float, __builtin_amdgcn_update_dpp(0, __builtin_bit_cast(int, v), 0xB1, 0xF, 0xF, true));
    v += __builtin_bit_cast(float, __builtin_amdgcn_update_dpp(0, __builtin_bit_cast(int, v), 0x4E, 0xF, 0xF, true));
    v += __builtin_bit_cast(float, __builtin_amdgcn_update_dpp(0, __builtin_bit_cast(int, v), 0x141, 0xF, 0xF, true));
    v += __builtin_bit_cast(float, __builtin_amdgcn_update_dpp(0, __builtin_bit_cast(int, v), 0x140, 0xF, 0xF, true));
    return v;
}
DI void phase6(const Params& p, LAS unsigned char* lds, int tid, int lane, int wave) {
    asm volatile("" : "+v"(tid), "+v"(lane));
    unsigned char* ws = p.ws;
    const bf16_t* H2 = (const bf16_t*)(ws + WS_RA);
    const unsigned char* UQ = ws + WS_UB; const unsigned char* VQ = ws + WS_VB;
    const float* SU = (const float*)(ws + WS_SU); const float* SV = (const float*)(ws + WS_SV);
    const unsigned* EIDX = (const unsigned*)(ws + WS_RS);
    LAS float* lG = (LAS float*)lds;
    const int q = lane >> 4, l16 = lane & 15;
    LAS int* le = (LAS int*)(lds + 4096 + wave * 6144) + q * 128;
    LAS float* lg = (LAS float*)(lds + 4096 + wave * 6144 + 2048) + q * 128;
    LAS float* lc = (LAS float*)(lds + 4096 + wave * 6144 + 4096) + q * 128;
    const unsigned qlo = q < 2 ? (0xFFFFu << (16 * q)) : 0u, qhi = q >= 2 ? (0xFFFFu << (16 * (q - 2))) : 0u;
    for (int rt = blockIdx.x; rt < T / 128; rt += gridDim.x) {
        const int b = rt / 32;
        __syncthreads();
        for (int d = tid; d < 1024; d += NTH) lG[d] = mod_at(p, b, 5120 + d) * p.in[16][d];
        __syncthreads();
#pragma unroll 1
        for (int rd = 0; rd < 4; ++rd) {
            __syncthreads();
            const size_t t = (size_t)rt * 128 + wave * 16 + rd * 4 + q;
            {
                int e[8]; float g[8];
#pragma unroll
                for (int r = 0; r < 8; ++r) { const unsigned pe = EIDX[t * 128 + r * 16 + l16]; e[r] = (int)(pe & 0xFFFFu); g[r] = bfhi(pe); }
                unsigned W[4] = {0u, 0u, 0u, 0u};
#pragma unroll
                for (int r = 0; r < 8; ++r) {
                    const int k = e[r] >> 10; const unsigned inc = 1u << (8 * (k & 3)); const int w = k >> 2;
                    W[0] += (w == 0) ? inc : 0u; W[1] += (w == 1) ? inc : 0u; W[2] += (w == 2) ? inc : 0u; W[3] += (w == 3) ? inc : 0u;
                }
                unsigned C[4];
                {
                    unsigned tot[4], exc[4];
#pragma unroll
                    for (int w = 0; w < 4; ++w) {
                        unsigned x = W[w];
                        x += (unsigned)__builtin_amdgcn_update_dpp(0, (int)x, 0x111, 0xF, 0xF, true);
                        x += (unsigned)__builtin_amdgcn_update_dpp(0, (int)x, 0x112, 0xF, 0xF, true);
                        x += (unsigned)__builtin_amdgcn_update_dpp(0, (int)x, 0x114, 0xF, 0xF, true);
                        x += (unsigned)__builtin_amdgcn_update_dpp(0, (int)x, 0x118, 0xF, 0xF, true);
                        exc[w] = x - W[w];
                        tot[w] = (unsigned)swz_bcast<15>((int)x);
                    }
                    unsigned carry = 0u;
#pragma unroll
                    for (int w = 0; w < 4; ++w) {
                        const unsigned P = tot[w] + (tot[w] << 8) + (tot[w] << 16) + (tot[w] << 24);
                        C[w] = (P - tot[w]) + carry * 0x01010101u + exc[w];
                        carry += P >> 24;
                    }
                }
#pragma unroll
                for (int r = 0; r < 8; ++r) {
                    const int k = e[r] >> 10; const int sh = 8 * (k & 3); const int w = k >> 2; const unsigned inc = 1u << sh;
                    const unsigned cw = (w == 0) ? C[0] : (w == 1) ? C[1] : (w == 2) ? C[2] : C[3];
                    const int pos = (int)((cw >> sh) & 0xFFu);
                    le[pos] = e[r]; lg[pos] = g[r];
                    C[0] += (w == 0) ? inc : 0u; C[1] += (w == 1) ? inc : 0u; C[2] += (w == 2) ? inc : 0u; C[3] += (w == 3) ? inc : 0u;
                }
                asm volatile("s_waitcnt lgkmcnt(0)" ::: "memory");
            }
            {
                int hq[16]; float ish;
                {
                    float hv[64]; float hm = 0.f;
#pragma unroll
                    for (int i = 0; i < 4; ++i) {
                        const u32x4 h0 = *(const u32x4*)(H2 + t * D + 256 * i + 16 * l16), h1 = *(const u32x4*)(H2 + t * D + 256 * i + 16 * l16 + 8);
#pragma unroll
                        for (int c = 0; c < 4; ++c) { hv[16 * i + 2 * c] = bflo(h0[c]); hv[16 * i + 2 * c + 1] = bfhi(h0[c]); hv[16 * i + 8 + 2 * c] = bflo(h1[c]); hv[16 * i + 8 + 2 * c + 1] = bfhi(h1[c]); }
                    }
#pragma unroll
                    for (int j = 0; j < 64; ++j) hm = fmaxf(hm, fabsf(hv[j]));
                    hm = fmaxf(hm, __builtin_bit_cast(float, __builtin_amdgcn_update_dpp(0, __builtin_bit_cast(int, hm), 0xB1, 0xF, 0xF, true)));
                    hm = fmaxf(hm, __builtin_bit_cast(float, __builtin_amdgcn_update_dpp(0, __builtin_bit_cast(int, hm), 0x4E, 0xF, 0xF, true)));
                    hm = fmaxf(hm, __builtin_bit_cast(float, __builtin_amdgcn_update_dpp(0, __builtin_bit_cast(int, hm), 0x141, 0xF, 0xF, true)));
                    hm = fmaxf(hm, __builtin_bit_cast(float, __builtin_amdgcn_update_dpp(0, __builtin_bit_cast(int, hm), 0x140, 0xF, 0xF, true)));
                    const float s8 = hm > 1e-30f ? 127.f / hm : 0.f; ish = hm * (1.f / 127.f);
#pragma unroll
                    for (int d = 0; d < 16; ++d) {
                        const int q0 = __float2int_rn(hv[4 * d] * s8), q1 = __float2int_rn(hv[4 * d + 1] * s8), q2 = __float2int_rn(hv[4 * d + 2] * s8), q3 = __float2int_rn(hv[4 * d + 3] * s8);
                        hq[d] = (int)((unsigned)(q0 & 0xFF) | ((unsigned)(q1 & 0xFF) << 8) | ((unsigned)(q2 & 0xFF) << 16) | ((unsigned)q3 << 24));
                    }
                }
                constexpr int UD = 4;
                u32x4 ub[UD][4];
                int evn = le[l16];
                static_for<UD>([&](auto kc) { constexpr int k = decltype(kc)::v; const unsigned char* up = UQ + (size_t)swz_bcast<k>(evn) * 1024 + 16 * l16;
#pragma unroll
                    for (int i = 0; i < 4; ++i) ub[k][i] = *(const u32x4*)(up + 256 * i); });
#pragma unroll 1
                for (int bt = 0; bt < 8; ++bt) {
                    if (bt) __syncthreads();
                    const int ev = evn; const float gv = lg[bt * 16 + l16];
                    evn = le[(bt < 7 ? bt + 1 : 7) * 16 + l16];
                    const float isu = SU[ev] * ish, isv = SV[ev];
                    int part[16];
                    static_for<16>([&](auto kc) {
                        constexpr int k = decltype(kc)::v, sl = k % UD;
                        int a = 0;
#pragma unroll
                        for (int i = 0; i < 4; ++i) {
                            const u32x4 u = ub[sl][i];
#pragma unroll
                            for (int c = 0; c < 4; ++c) a = __builtin_amdgcn_sdot4((int)u[c], hq[4 * i + c], a, false);
                        }
                        part[k] = a;
                        {
                            constexpr int kn = k + UD;
                            int idx; if constexpr (kn < 16) idx = swz_bcast<(kn & 15)>(ev); else idx = swz_bcast<(kn & 15)>(evn);
                            const unsigned char* up = UQ + (size_t)idx * 1024 + 16 * l16;
#pragma unroll
                            for (int i = 0; i < 4; ++i) ub[sl][i] = *(const u32x4*)(up + 256 * i);
                        }
                    });
                    static_for<4>([&](auto sc) {
                        constexpr int w = 8 >> decltype(sc)::v;
                        const bool up2 = (lane & w) != 0;
#pragma unroll
                        for (int e = 0; e < w; ++e) {
                            const int keep = up2 ? part[e + w] : part[e], send = up2 ? part[e] : part[e + w];
                            part[e] = keep + swz_xor<w>(send);
                        }
                    });
                    const float dot = (float)part[0] * isu;
                    lc[bt * 16 + l16] = gv * 0.5f * dot * (1.f + erff(dot * 0.70710678118654752f)) * isv;
                }
                asm volatile("s_waitcnt lgkmcnt(0)" ::: "memory");
            }
            __syncthreads();
            f32x2 y[32];
#pragma unroll
            for (int i = 0; i < 32; ++i) y[i] = (f32x2){0.f, 0.f};
            {
                constexpr int VD = 4;
                u32x4 vbuf[VD][4];
                int evn = le[l16];
                static_for<VD>([&](auto kc) { constexpr int k = decltype(kc)::v; const unsigned char* vp = VQ + (size_t)swz_bcast<k>(evn) * 1024 + 16 * l16;
#pragma unroll
                    for (int i = 0; i < 4; ++i) vbuf[k][i] = *(const u32x4*)(vp + 256 * i); });
#pragma unroll 1
                for (int bt = 0; bt < 8; ++bt) {
                    if (bt) __syncthreads();
                    const int ev = evn; const int cv = __float_as_int(lc[bt * 16 + l16]);
                    evn = le[(bt < 7 ? bt + 1 : 7) * 16 + l16];
                    static_for<16>([&](auto kc) {
                        constexpr int k = decltype(kc)::v, sl = k % VD;
                        const float cc = __int_as_float(swz_bcast<k>(cv));
                        const f32x2 c2 = (f32x2){cc, cc};
#pragma unroll
                        for (int i = 0; i < 4; ++i) {
                            const u32x4 v = vbuf[sl][i];
#pragma unroll
                            for (int c = 0; c < 4; ++c) {
                                const int w = (int)v[c];
                                y[8 * i + 2 * c] = __builtin_elementwise_fma(__builtin_amdgcn_cvt_pk_f32_fp8(w, false), c2, y[8 * i + 2 * c]);
                                y[8 * i + 2 * c + 1] = __builtin_elementwise_fma(__builtin_amdgcn_cvt_pk_f32_fp8(w, true), c2, y[8 * i + 2 * c + 1]);
                            }
                        }
                        {
                            constexpr int kn = k + VD;
                            int idx; if constexpr (kn < 16) idx = swz_bcast<(kn & 15)>(ev); else idx = swz_bcast<(kn & 15)>(evn);
                            const unsigned char* vp = VQ + (size_t)idx * 1024 + 16 * l16;
#pragma unroll
                            for (int i = 0; i < 4; ++i) vbuf[sl][i] = *(const u32x4*)(vp + 256 * i);
                        }
                    });
                }
            }
            float ss = 0.f;
#pragma unroll
            for (int i = 0; i < 32; ++i) ss += y[i].x * y[i].x + y[i].y * y[i].y;
            const float rstd = rsqrtf(row16_sum(ss) * (1.f / D) + EPS);
            float* orow = p.out + t * D;
            u32x4 xq[4][2];
#pragma unroll
            for (int i = 0; i < 4; ++i) { const bf16_t* xp = (const bf16_t*)(ws + WS_RO) + t * D + 256 * i + 16 * l16; xq[i][0] = *(const u32x4*)xp; xq[i][1] = *(const u32x4*)(xp + 8); }
#pragma unroll
            for (int i = 0; i < 4; ++i)
#pragma unroll
                for (int c = 0; c < 4; ++c) {
                    const int col = 256 * i + 16 * l16 + 4 * c;
                    const u32x2 xb = {xq[i][c >> 1][2 * (c & 1)], xq[i][c >> 1][2 * (c & 1) + 1]};
                    f32x4 xv = {bflo(xb.x), bfhi(xb.x), bflo(xb.y), bfhi(xb.y)};
                    const f32x4 gg = *(const LAS f32x4*)(lG + col);
                    xv[0] += gg[0] * y[8 * i + 2 * c].x * rstd; xv[1] += gg[1] * y[8 * i + 2 * c].y * rstd; xv[2] += gg[2] * y[8 * i + 2 * c + 1].x * rstd; xv[3] += gg[3] * y[8 * i + 2 * c + 1].y * rstd;
                    *(f32x4*)(orow + col) = xv;
                }
        }
    }
}


__global__ void __launch_bounds__(NTH) fwd_megakernel(Params p) {
    extern __shared__ __attribute__((aligned(16))) unsigned char lds_raw[];
    LAS unsigned char* lds = (LAS unsigned char*)lds_raw;
    const int tid = threadIdx.x, lane = tid & 63, wave = __builtin_amdgcn_readfirstlane(tid >> 6);
    volatile LAS unsigned* st = (volatile LAS unsigned*)(lds + LDS_BARW);
    if (tid == 0) { st[0] = 0u; st[1] = 0u; st[2] = 0u; st[3] = 0u; }
    __syncthreads();
    XcdBarrier bar = xcd_barrier_post((unsigned*)(p.ws + WS_CTL), st);
    unsigned char* ws = p.ws;

    phase0(p, lds, tid, lane, wave);
    xcd_barrier(bar);
    phase1(p, lds, tid, lane, wave);
    afb_tail((const bf16_t*)(ws + WS_RA), (const bf16_t*)(ws + WS_WIN) + (size_t)ZW * D, (float*)(ws + WS_AFB), lds, tid, lane, wave);
    xcd_barrier(bar);
    { pg8::Gemm g{(const bf16_t*)(ws + WS_RA), (const bf16_t*)(ws + WS_WIN), T, ZW, D}; pg8::StaticOrder S; S.init(T, ZW, (int)gridDim.x, (int)blockIdx.x);
      pg8::EpiB16 e{(bf16_t*)(ws + WS_RZ), ZW}; pg8::gemm_phase<pg8::EpiB16, pg8::StaticOrder, true, true>(lds, g, S, e);
 }
    xcd_barrier(bar);
    phaseGA(p, lds, tid, lane, wave);
    xcd_barrier(bar);
    phaseGB(p, tid);
    xcd_barrier(bar);
    phase4a(p, lds, tid, lane, wave);
    xcd_barrier(bar);
    { pg8::Gemm g{(const bf16_t*)(ws + WS_RA), (const bf16_t*)(ws + WS_WOUT), T, D, D}; pg8::StaticOrder S; S.init(T, D, (int)gridDim.x, (int)blockIdx.x);
      pg8::EpiB16 e{(bf16_t*)(ws + WS_RZ), D}; pg8::gemm_phase<pg8::EpiB16, pg8::StaticOrder, true, true>(lds, g, S, e); }
    xcd_barrier(bar);
    phase4c(p, lds, tid, lane, wave);
    xcd_barrier(bar);
    { pg8::Gemm g{(const bf16_t*)(ws + WS_RA), (const bf16_t*)(ws + WS_WQ), T, 2048, D}; pg8::StaticOrder S; S.init(T, 2048, (int)gridDim.x, (int)blockIdx.x);
      pg8::EpiB16 e{(bf16_t*)(ws + WS_RZ), 2048}; pg8::gemm_phase<pg8::EpiB16, pg8::StaticOrder, true, true>(lds, g, S, e); }
    xcd_barrier(bar);
    phase5b(p, lds, tid, lane, wave);
    xcd_barrier(bar);
    phase6(p, lds, tid, lane, wave);
}

extern "C" void kernel_launch(void* const* d_in, const int* in_sizes, int n_in, void* d_out, int out_size, void* d_ws, size_t ws_size, hipStream_t stream) {
    static int grid = 0;
    if (grid == 0) {
        if (n_in != 21 || out_size != T * D || ws_size < WS_END) { fprintf(stderr, "kernel_launch: unexpected shapes (n_in %d out %d ws %zu need %zu)\n", n_in, out_size, ws_size, (size_t)WS_END); grid = -1; return; }
        int dev = 0, cus = 0, per_cu = 0;
        hipGetDevice(&dev); hipDeviceGetAttribute(&cus, hipDeviceAttributeMultiprocessorCount, dev);
        hipFuncSetAttribute((const void*)fwd_megakernel, hipFuncAttributeMaxDynamicSharedMemorySize, LDS_BYTES);
        hipOccupancyMaxActiveBlocksPerMultiprocessor(&per_cu, (const void*)fwd_megakernel, NTH, LDS_BYTES);
        (void)hipGetLastError();
        if (per_cu < 1) fprintf(stderr, "kernel_launch: occupancy query says %d blocks per CU\n", per_cu);
        grid = cus;
    }
    if (grid < 0) return;
    hipMemsetAsync((char*)d_ws + WS_CTL, 0, 64 * 1024, stream);
    Params p{};
    for (int i = 0; i < 21; ++i) p.in[i] = (const float*)d_in[i];
    p.out = (float*)d_out; p.ws = (unsigned char*)d_ws;
    hipLaunchKernelGGL(fwd_megakernel, dim3(grid), dim3(NTH), LDS_BYTES, stream, p);
}
```
